# Optimizing an MI355X kernel written in HIP

```python
import jax
import jax.numpy as jnp
from jax import lax
import numpy as np

D_MODEL = 1024
BATCH = 16
SEQ = 2048
DEPTH = 4

GRID_W = 64
CTX_LEN = 256
N_EVEN = (DEPTH + 1) // 2
N_ODD = DEPTH // 2
NORM_EPS = 1e-6

A_HEAD_DIM = 64
A_HEADS = D_MODEL // (2 * A_HEAD_DIM)
A_WIDTH = A_HEADS * A_HEAD_DIM
A_DECAY_RANK = 64
A_ICLR_RANK = 64
A_GATE_RANK = 128
A_DECAY_SCALE = 0.606531
A_LN_EPS = 64e-5
A_COLS = 3 * A_WIDTH + 2 * A_DECAY_RANK + 2 * A_ICLR_RANK + A_GATE_RANK

B_HEADS = D_MODEL // 128
B_NOPE = 64
B_ROPE = 32
B_QK = B_NOPE + B_ROPE
B_V = 64
B_WIDTH = B_HEADS * B_V
B_Q_RANK = D_MODEL // 4
B_KV_RANK = D_MODEL // 8
B_COLS = B_Q_RANK + B_KV_RANK + B_ROPE
ATTN_SCALE = B_QK ** -0.5
ROPE_BASE = 10000.0
Q_BLOCK = 128

IN_COLS = A_COLS + B_COLS
MIX_WIDTH = A_WIDTH + B_WIDTH

C_GROUPS = 8
C_GROUP_DIM = D_MODEL // C_GROUPS

N_EXPERTS = 16
N_GROUPS = 4
EXPERTS_PER_GROUP = N_EXPERTS // N_GROUPS
TOP_K = 2
D_EXPERT = D_MODEL // 2
D_SHARED = D_MODEL // 2
MOE_BLOCK = 128

kernel_name = 'hybrid_rwkv7_mla_fnet_moe_dit'


def rms_norm(x, g, eps=NORM_EPS):
    xf = x.astype(jnp.float32)
    y = xf * lax.rsqrt(jnp.mean(xf * xf, axis=-1, keepdims=True) + eps)
    return (y * g.astype(jnp.float32)).astype(x.dtype)


def modulate(x, g, shift, scale):
    return rms_norm(x, g) * (1 + scale) + shift


def centred_shift(p, mu):
    zeros = jnp.zeros_like(p[:, :1])
    prev = jnp.concatenate([zeros, p[:, :-1]], axis=1)
    nxt = jnp.concatenate([p[:, 1:], zeros], axis=1)
    return p + mu * (0.5 * (prev + nxt) - p)


def rwkv7_scan(s0, r, w, k, v, a_vec, b_vec, reverse):
    def step(s, xs):
        r_t, w_t, k_t, v_t, a_t, b_t = xs
        sa = jnp.einsum('bhvk,bhk->bhv', s, a_t)
        s = s * w_t[:, :, None, :] + sa[..., None] * b_t[:, :, None, :] + v_t[..., None] * k_t[:, :, None, :]
        return s, jnp.einsum('bhvk,bhk->bhv', s, r_t)
    xs = (jnp.swapaxes(r, 0, 1), jnp.swapaxes(w, 0, 1), jnp.swapaxes(k, 0, 1),
          jnp.swapaxes(v, 0, 1), jnp.swapaxes(a_vec, 0, 1), jnp.swapaxes(b_vec, 0, 1))
    s, ys = lax.scan(step, s0, xs, reverse=reverse)
    return s, jnp.swapaxes(ys, 0, 1)


def heads_a(t):
    return t.reshape(t.shape[:-1] + (A_HEADS, A_HEAD_DIM))


def rwkv7_mix(p, s0, mu, w0, w2, a0, a2, g2, k_k, k_a, r_k, ln_w, ln_b):
    dt = p.dtype
    bsz, t_len, _ = p.shape
    p = centred_shift(p, mu).astype(jnp.float32)
    o1, o2, o3 = A_WIDTH, 2 * A_WIDTH, 3 * A_WIDTH
    o4 = o3 + 2 * A_DECAY_RANK
    o5 = o4 + 2 * A_ICLR_RANK
    r, k, v = p[..., :o1], p[..., o1:o2], p[..., o2:o3]
    wd = p[..., o3:o4].reshape(bsz, t_len, 2, A_DECAY_RANK)
    ad = p[..., o4:o5].reshape(bsz, t_len, 2, A_ICLR_RANK)
    gd = p[..., o5:]
    w = jnp.exp(-A_DECAY_SCALE * jax.nn.sigmoid(w0 + jnp.einsum('btdr,drc->btdc', jnp.tanh(wd), w2)))
    a = jax.nn.sigmoid(a0 + jnp.einsum('btdr,drc->btdc', ad, a2))
    g = jnp.einsum('btr,rc->btc', jax.nn.sigmoid(gd), g2)
    kk = heads_a(k * k_k)
    kk = kk * lax.rsqrt(jnp.sum(kk * kk, axis=-1, keepdims=True) + 1e-12)
    kd = heads_a(k[:, :, None, :] * (1 + (a - 1) * k_a))
    bd = kk[:, :, None] * heads_a(a)
    w_h = heads_a(w)
    r_h, v_h = heads_a(r), heads_a(v)
    s_f, y_f = rwkv7_scan(s0[0], r_h, w_h[:, :, 0], kd[:, :, 0], v_h, -kk, bd[:, :, 0], False)
    s_b, y_b = rwkv7_scan(s0[1], r_h, w_h[:, :, 1], kd[:, :, 1], v_h, -kk, bd[:, :, 1], True)
    y = y_f + y_b
    mean = jnp.mean(y, axis=-1, keepdims=True)
    var = jnp.mean(jnp.square(y - mean), axis=-1, keepdims=True)
    y = ((y - mean) * lax.rsqrt(var + A_LN_EPS)).reshape(bsz, t_len, A_WIDTH) * ln_w + ln_b
    bonus = jnp.sum(jnp.sum(r_h[:, :, None] * kd * r_k, axis=-1, keepdims=True) * v_h[:, :, None], axis=2)
    y = (y + bonus.reshape(bsz, t_len, A_WIDTH)) * g
    return y.astype(dt), jnp.stack([s_f, s_b])


def axial_rope_tables(seq_len):
    rows = seq_len // GRID_W
    row = jnp.repeat(jnp.arange(rows), GRID_W).astype(jnp.float32)
    col = jnp.tile(jnp.arange(GRID_W), rows).astype(jnp.float32)
    axis_dim = B_ROPE // 2
    inv = ROPE_BASE ** (-jnp.arange(0, axis_dim, 2, dtype=jnp.float32) / axis_dim)
    ang = jnp.concatenate([row[:, None] * inv, col[:, None] * inv], axis=-1)
    return jnp.cos(ang), jnp.sin(ang)


def apply_axial_rope(x, cos, sin):
    half = B_ROPE // 2
    xn, x1, x2 = x[..., :B_NOPE], x[..., B_NOPE:B_NOPE + half], x[..., B_NOPE + half:]
    c = cos[None, :, None, :].astype(x.dtype)
    s = sin[None, :, None, :].astype(x.dtype)
    return jnp.concatenate([xn, x1 * c - x2 * s, x2 * c + x1 * s], axis=-1)


def mla_qkv(p, rope, q_norm, w_q_up, kv_norm, w_kv_up, q_gain, k_gain):
    bsz, t_len, _ = p.shape
    pq = p[..., :B_Q_RANK]
    pkv = p[..., B_Q_RANK:B_Q_RANK + B_KV_RANK]
    pkr = p[..., B_Q_RANK + B_KV_RANK:]
    q = jnp.einsum('btr,rc->btc', rms_norm(pq, q_norm), w_q_up).reshape(bsz, t_len, B_HEADS, B_QK)
    kv = jnp.einsum('btr,rc->btc', rms_norm(pkv, kv_norm), w_kv_up).reshape(bsz, t_len, B_HEADS, B_NOPE + B_V)
    k = jnp.concatenate([kv[..., :B_NOPE], jnp.broadcast_to(pkr[:, :, None, :], (bsz, t_len, B_HEADS, B_ROPE))], axis=-1)
    v = kv[..., B_NOPE:]
    q, k = rms_norm(q, q_gain), rms_norm(k, k_gain)
    if rope is not None:
        q, k = apply_axial_rope(q, *rope), apply_axial_rope(k, *rope)
    return q, k, v


def attention(q, k, v):
    s = jnp.einsum('bqhd,bkhd->bhqk', q, k).astype(jnp.float32) * ATTN_SCALE
    pr = jax.nn.softmax(s, axis=-1).astype(v.dtype)
    return jnp.einsum('bhqk,bkhd->bqhd', pr, v)


def blocked_attention(q, k, v):
    bsz, t_len, nh, dq = q.shape
    nb = t_len // Q_BLOCK
    qb = jnp.moveaxis(q.reshape(bsz, nb, Q_BLOCK, nh, dq), 1, 0)
    out = lax.map(lambda qi: attention(qi, k, v), qb)
    return jnp.moveaxis(out, 0, 1).reshape(bsz, t_len, nh, v.shape[-1])


def even_mixer(h_lat, h_ctx, w_in, w_out, a_prm, b_prm, rope, need_ctx_out):
    bsz, seq, _ = h_lat.shape
    ctx_len = h_ctx.shape[1]
    p_lat = jnp.einsum('btd,dc->btc', h_lat, w_in)
    p_ctx = jnp.einsum('btd,dc->btc', h_ctx, w_in)
    s_zero = jnp.zeros((2, bsz, A_HEADS, A_HEAD_DIM, A_HEAD_DIM), jnp.float32)
    ya_ctx, s_ctx = rwkv7_mix(p_ctx[..., :A_COLS], s_zero, *a_prm)
    ya_lat, _ = rwkv7_mix(p_lat[..., :A_COLS], s_ctx, *a_prm)
    q_c, k_c, v_c = mla_qkv(p_ctx[..., A_COLS:], None, *b_prm)
    q_l, k_l, v_l = mla_qkv(p_lat[..., A_COLS:], rope, *b_prm)
    yb_lat = blocked_attention(q_l, jnp.concatenate([k_c, k_l], axis=1), jnp.concatenate([v_c, v_l], axis=1))
    o_lat = jnp.einsum('btc,cd->btd', jnp.concatenate([ya_lat, yb_lat.reshape(bsz, seq, B_WIDTH)], axis=-1), w_out)
    if not need_ctx_out:
        return o_lat, None
    yb_ctx = attention(q_c, k_c, v_c)
    o_ctx = jnp.einsum('btc,cd->btd', jnp.concatenate([ya_ctx, yb_ctx.reshape(bsz, ctx_len, B_WIDTH)], axis=-1), w_out)
    return o_lat, o_ctx


def fourier_mixer(h, w_out):
    bsz, t_len, d = h.shape
    hg = h.astype(jnp.float32).reshape(bsz, t_len, C_GROUPS, C_GROUP_DIM)
    f = jnp.fft.fft2(hg, axes=(1, 3), norm='ortho').real.reshape(bsz, t_len, d).astype(h.dtype)
    return jnp.einsum('btd,de->bte', f, w_out)


def swiglu(h, wg, wu, wd):
    return jnp.dot(jax.nn.silu(jnp.dot(h, wg)) * jnp.dot(h, wu), wd)


def moe_ffn(h, router_w, router_b, w_gate, w_up, w_down, sh_gate, sh_up, sh_down):
    n_tok, d = h.shape
    scores = jax.nn.sigmoid(jnp.dot(h.astype(jnp.float32), router_w.astype(jnp.float32)))
    sel = (scores + router_b.astype(jnp.float32)).reshape(n_tok, N_GROUPS, EXPERTS_PER_GROUP)
    group_score = jnp.sum(lax.top_k(sel, 2)[0], axis=-1)
    g_idx = jnp.argmax(group_score, axis=-1)
    sel_in = jnp.take_along_axis(sel, g_idx[:, None, None], axis=1)[:, 0]
    _, local = lax.top_k(sel_in, TOP_K)
    e_idx = g_idx[:, None] * EXPERTS_PER_GROUP + local
    wts = jnp.take_along_axis(scores, e_idx, axis=1)
    wts = wts / jnp.sum(wts, axis=-1, keepdims=True)
    n_asg = n_tok * TOP_K
    flat_e = e_idx.reshape(n_asg)
    flat_tok = jnp.repeat(jnp.arange(n_tok), TOP_K)
    order = jnp.argsort(flat_e)
    e_sorted, tok_sorted, w_sorted = flat_e[order], flat_tok[order], wts.reshape(n_asg)[order]
    counts = jnp.bincount(flat_e, length=N_EXPERTS)
    start = jnp.cumsum(counts) - counts
    padded = (counts + MOE_BLOCK - 1) // MOE_BLOCK * MOE_BLOCK
    pend = jnp.cumsum(padded)
    pstart = pend - padded
    dest = pstart[e_sorted] + (jnp.arange(n_asg) - start[e_sorted])
    n_blocks = (n_asg + N_EXPERTS * (MOE_BLOCK - 1) + MOE_BLOCK - 1) // MOE_BLOCK
    slot_tok = jnp.full((n_blocks * MOE_BLOCK,), n_tok, jnp.int32).at[dest].set(tok_sorted.astype(jnp.int32))
    block_e = jnp.minimum(jnp.searchsorted(pend, jnp.arange(n_blocks) * MOE_BLOCK, side='right'), N_EXPERTS - 1)
    h_pad = jnp.concatenate([h, jnp.zeros((1, d), h.dtype)], axis=0)
    xb = h_pad[slot_tok].reshape(n_blocks, MOE_BLOCK, d)
    yb = lax.map(lambda a: swiglu(a[0], w_gate[a[1]], w_up[a[1]], w_down[a[1]]), (xb, block_e))
    y_asg = yb.reshape(n_blocks * MOE_BLOCK, d)[dest] * w_sorted[:, None]
    routed = jax.ops.segment_sum(y_asg, tok_sorted, num_segments=n_tok)
    return (swiglu(h, sh_gate, sh_up, sh_down) + routed).astype(h.dtype)


def setup_inputs(seed: int = 0) -> dict:
    key = jax.random.key(seed)
    ks = iter(jax.random.split(key, 40))
    f32 = jnp.float32

    def nrm(shape, scale):
        return jax.random.normal(next(ks), shape, f32) * scale

    def gain(shape):
        return 1.0 + nrm(shape, 0.02)

    return {
        'x': nrm((BATCH, SEQ, D_MODEL), 1.0),
        'c': nrm((BATCH, D_MODEL), 1.0),
        'ctx': nrm((BATCH, CTX_LEN, D_MODEL), 1.0),
        'c_ctx': nrm((D_MODEL,), 1.0),
        'norm1_g': gain((DEPTH, D_MODEL)),
        'norm2_g': gain((DEPTH, D_MODEL)),
        'mod_w': nrm((DEPTH, D_MODEL, 6 * D_MODEL), 0.5 * D_MODEL ** -0.5),
        'mod_b': nrm((DEPTH, 6 * D_MODEL), 0.02),
        'w_in': nrm((N_EVEN, D_MODEL, IN_COLS), D_MODEL ** -0.5),
        'a_mu': jax.random.uniform(next(ks), (N_EVEN, A_COLS), f32),
        'a_w0': nrm((N_EVEN, 2, A_WIDTH), 1.5) - 1.0,
        'a_w2': nrm((N_EVEN, 2, A_DECAY_RANK, A_WIDTH), 0.5 * A_DECAY_RANK ** -0.5),
        'a_a0': nrm((N_EVEN, 2, A_WIDTH), 0.3),
        'a_a2': nrm((N_EVEN, 2, A_ICLR_RANK, A_WIDTH), 0.5 * A_ICLR_RANK ** -0.5),
        'a_g2': nrm((N_EVEN, A_GATE_RANK, A_WIDTH), A_GATE_RANK ** -0.5),
        'a_k_k': 0.85 + nrm((N_EVEN, A_WIDTH), 0.05),
        'a_k_a': 1.0 + nrm((N_EVEN, A_WIDTH), 0.05),
        'a_r_k': nrm((N_EVEN, A_HEADS, A_HEAD_DIM), 0.1),
        'a_ln_w': gain((N_EVEN, A_WIDTH)),
        'a_ln_b': nrm((N_EVEN, A_WIDTH), 0.02),
        'b_q_norm': gain((N_EVEN, B_Q_RANK)),
        'b_w_q_up': nrm((N_EVEN, B_Q_RANK, B_HEADS * B_QK), B_Q_RANK ** -0.5),
        'b_kv_norm': gain((N_EVEN, B_KV_RANK)),
        'b_w_kv_up': nrm((N_EVEN, B_KV_RANK, B_HEADS * (B_NOPE + B_V)), B_KV_RANK ** -0.5),
        'b_q_gain': gain((N_EVEN, B_QK)),
        'b_k_gain': gain((N_EVEN, B_QK)),
        'w_out_even': nrm((N_EVEN, MIX_WIDTH, D_MODEL), MIX_WIDTH ** -0.5),
        'w_out_fourier': nrm((N_ODD, D_MODEL, D_MODEL), D_MODEL ** -0.5),
        'router_w': nrm((D_MODEL, N_EXPERTS), D_MODEL ** -0.5),
        'router_b': nrm((N_EXPERTS,), 0.01),
        'moe_w_gate': nrm((DEPTH, N_EXPERTS, D_MODEL, D_EXPERT), D_MODEL ** -0.5),
        'moe_w_up': nrm((DEPTH, N_EXPERTS, D_MODEL, D_EXPERT), D_MODEL ** -0.5),
        'moe_w_down': nrm((DEPTH, N_EXPERTS, D_EXPERT, D_MODEL), D_EXPERT ** -0.5),
        'shared_w_gate': nrm((DEPTH, D_MODEL, D_SHARED), D_MODEL ** -0.5),
        'shared_w_up': nrm((DEPTH, D_MODEL, D_SHARED), D_MODEL ** -0.5),
        'shared_w_down': nrm((DEPTH, D_SHARED, D_MODEL), D_SHARED ** -0.5),
    }


def reference(x, c, ctx, c_ctx, norm1_g, norm2_g, mod_w, mod_b, w_in, a_mu, a_w0, a_w2, a_a0, a_a2, a_g2,
              a_k_k, a_k_a, a_r_k, a_ln_w, a_ln_b, b_q_norm, b_w_q_up, b_kv_norm, b_w_kv_up, b_q_gain, b_k_gain,
              w_out_even, w_out_fourier, router_w, router_b, moe_w_gate, moe_w_up, moe_w_down,
              shared_w_gate, shared_w_up, shared_w_down):
    bsz, seq, d = x.shape
    ctx_len = ctx.shape[1]
    rope = axial_rope_tables(seq)
    for i in range(DEPTH):
        last = i == DEPTH - 1
        j = i // 2
        sh1, sc1, g1, sh2, sc2, g2 = jnp.split((jnp.dot(jax.nn.silu(c), mod_w[i]) + mod_b[i])[:, None, :], 6, axis=-1)
        sh1c, sc1c, g1c, sh2c, sc2c, g2c = jnp.split(jnp.dot(jax.nn.silu(c_ctx), mod_w[i]) + mod_b[i], 6, axis=-1)
        h_l = modulate(x, norm1_g[i], sh1, sc1)
        h_c = modulate(ctx, norm1_g[i], sh1c, sc1c)
        if i % 2 == 0:
            a_prm = (a_mu[j], a_w0[j], a_w2[j], a_a0[j], a_a2[j], a_g2[j], a_k_k[j], a_k_a[j], a_r_k[j], a_ln_w[j], a_ln_b[j])
            b_prm = (b_q_norm[j], b_w_q_up[j], b_kv_norm[j], b_w_kv_up[j], b_q_gain[j], b_k_gain[j])
            o_l, o_c = even_mixer(h_l, h_c, w_in[j], w_out_even[j], a_prm, b_prm, rope, not last)
        else:
            o_l = fourier_mixer(h_l, w_out_fourier[j])
            o_c = None if last else fourier_mixer(h_c, w_out_fourier[j])
        x = x + g1 * o_l
        moe_prm = (router_w, router_b, moe_w_gate[i], moe_w_up[i], moe_w_down[i],
                   shared_w_gate[i], shared_w_up[i], shared_w_down[i])
        h2_l = modulate(x, norm2_g[i], sh2, sc2).reshape(bsz * seq, d)
        if last:
            x = x + g2 * moe_ffn(h2_l, *moe_prm).reshape(bsz, seq, d)
        else:
            ctx = ctx + g1c * o_c
            h2_c = modulate(ctx, norm2_g[i], sh2c, sc2c).reshape(bsz * ctx_len, d)
            y = moe_ffn(jnp.concatenate([h2_l, h2_c], axis=0), *moe_prm)
            x = x + g2 * y[:bsz * seq].reshape(bsz, seq, d)
            ctx = ctx + g2c * y[bsz * seq:].reshape(bsz, ctx_len, d)
    return x
```

```cpp
#include <hip/hip_runtime.h>
#include <cstdio>
#include <cstdint>

#ifndef ONE_LAUNCH
#define ONE_LAUNCH 1
#endif

typedef unsigned short bf16_t;
#define DI __device__ __forceinline__
#define LAS __attribute__((address_space(3)))

constexpr int D = 1024, NB = 16, SEQ = 2048, CTXL = 256, NLAT = NB * SEQ, NCTX = NB * CTXL, NT = NLAT + NCTX;
constexpr int PLD = 2560;
constexpr int INC = 2336, ACOLS = 1920;
constexpr int WLD = 2560;
constexpr int NTHR = 512;

#define XB_TMO      128
#define XB_XCNT(j)  (256  + 64 * (j))
#define XB_XSUB(j)  (1280 + 64 * (j))
#define XB_XGEN(j)  (2304 + 64 * (j))
#define XB_TOP      3328
#define XB_TOPGEN   3392
#define XCD_BAR_WORDS 3456
#define XB_SPIN_CAP (1u << 24)
DI unsigned xb_ld(unsigned* p)              { return __hip_atomic_load(p, __ATOMIC_RELAXED, __HIP_MEMORY_SCOPE_AGENT); }
DI unsigned xb_add(unsigned* p, unsigned v) { return __hip_atomic_fetch_add(p, v, __ATOMIC_RELAXED, __HIP_MEMORY_SCOPE_AGENT); }
DI unsigned xb_xcc_id() { return (unsigned)__builtin_amdgcn_s_getreg((3 << 11) | 20) & 0xFu; }
#define XB_SPIN(cond, bar) do { unsigned _sp = 0; while (cond) { __builtin_amdgcn_s_sleep(1); \
    if ((++_sp & 255u) == 0u) { if (xb_ld(&(bar)[XB_TMO])) break; if (_sp > XB_SPIN_CAP) { atomicAdd(&(bar)[XB_TMO], 1u); break; } } } } while (0)
struct XcdBarrier { unsigned* bar; unsigned x; volatile LAS unsigned* st; };
DI XcdBarrier xcd_barrier_post(unsigned* bar, volatile LAS unsigned* st) {
    XcdBarrier b; b.bar = bar; b.x = xb_xcc_id(); b.st = st;
    if (threadIdx.x == 0) (void)xb_add(&bar[XB_XCNT(b.x)], 1u);
    return b;
}
DI void xcd_barrier_complete(unsigned* bar, unsigned x, unsigned& nloc, unsigned& nx) {
    const unsigned G = gridDim.x * gridDim.y * gridDim.z;
    unsigned sum, cnt, mine, sp = 0u;
    for (;;) {
        sum = 0u; cnt = 0u; mine = 0u;
#pragma unroll
        for (unsigned j = 0; j < 16; ++j) { const unsigned c = xb_ld(&bar[XB_XCNT(j)]); sum += c; cnt += (c > 0u) ? 1u : 0u; mine = (j == x) ? c : mine; }
        if (sum == G) break;
        __builtin_amdgcn_s_sleep(1);
        if ((++sp & 255u) == 0u) { if (xb_ld(&bar[XB_TMO])) break; if (sp > XB_SPIN_CAP) { atomicAdd(&bar[XB_TMO], 1u); break; } }
    }
    nloc = mine > 0u ? mine : 1u; nx = cnt > 0u ? cnt : 1u;
}
DI void xcd_barrier(const XcdBarrier& b) {
    asm volatile("s_waitcnt vmcnt(0)" ::: "memory");
    __syncthreads();
    if (threadIdx.x == 0) {
        unsigned* bar = b.bar;
        __builtin_amdgcn_s_waitcnt(0);
        unsigned nloc = b.st[0], nx = b.st[1];
        if (nloc == 0u) { xcd_barrier_complete(bar, b.x, nloc, nx); b.st[0] = nloc; b.st[1] = nx; }
        const unsigned old = xb_add(&bar[XB_XSUB(b.x)], 1u);
        const unsigned gen = old / nloc;
        if (old + 1u == (gen + 1u) * nloc) {
            __builtin_amdgcn_fence(__ATOMIC_RELEASE, "agent");
            asm volatile("s_waitcnt vmcnt(0)" ::: "memory");
            const unsigned og = xb_add(&bar[XB_TOP], 1u);
            const unsigned tg = og / nx;
            if (og + 1u == (tg + 1u) * nx) xb_add(&bar[XB_TOPGEN], 1u);
            else XB_SPIN(xb_ld(&bar[XB_TOPGEN]) == tg, bar);
            __builtin_amdgcn_fence(__ATOMIC_ACQUIRE, "agent");
            xb_add(&bar[XB_XGEN(b.x)], 1u);
            asm volatile("s_waitcnt vmcnt(0)" ::: "memory");
        } else {
            XB_SPIN(xb_ld(&bar[XB_XGEN(b.x)]) == gen, bar);
            __builtin_amdgcn_fence(__ATOMIC_ACQUIRE, "agent");
            asm volatile("s_waitcnt vmcnt(0)" ::: "memory");
        }
    }
    __syncthreads();
}

struct Params {
    const float *x, *c, *ctx, *c_ctx, *norm1_g, *norm2_g, *mod_w, *mod_b, *w_in, *a_mu, *a_w0, *a_w2, *a_a0, *a_a2, *a_g2,
                *a_k_k, *a_k_a, *a_r_k, *a_ln_w, *a_ln_b, *b_q_norm, *b_w_q_up, *b_kv_norm, *b_w_kv_up, *b_q_gain, *b_k_gain,
                *w_out_even, *w_out_fourier, *router_w, *router_b, *moe_w_gate, *moe_w_up, *moe_w_down, *sh_gate, *sh_up, *sh_down;
    float* out;
    unsigned* bar; int* cnt; float* mod; float* ctxs; bf16_t* dftl; bf16_t* dftc; int* slot; float* tokw;
    bf16_t *H, *P, *LR, *WAG, *YF, *YB, *QN, *Qraw, *KVraw, *Kf, *Vt, *ACT, *Y, *F; float* G;
};

struct Ctx { int tid, bid, nblk; };
DI Ctx make_ctx() { Ctx c; c.tid = threadIdx.x; c.bid = blockIdx.x; c.nblk = gridDim.x; asm volatile("" : "+v"(c.tid), "+s"(c.bid), "+s"(c.nblk)); return c; }

DI bf16_t f2bf(float f) { unsigned u = __float_as_uint(f); u += 0x7fffu + ((u >> 16) & 1u); return (bf16_t)(u >> 16); }
DI float bf2f(bf16_t b) { return __uint_as_float(((unsigned)b) << 16); }
DI float bflo(unsigned u) { return __uint_as_float(u << 16); }
DI float bfhi(unsigned u) { return __uint_as_float(u & 0xffff0000u); }
DI unsigned pack2(float lo, float hi) { return (unsigned)f2bf(lo) | ((unsigned)f2bf(hi) << 16); }
DI float siluf(float v) { return v / (1.f + expf(-v)); }
DI float sigm(float v) { return 1.f / (1.f + expf(-v)); }
DI float wave_sum(float v) {
#pragma unroll
    for (int o = 32; o >= 1; o >>= 1) v += __shfl_xor(v, o);
    return v;
}

template <bool DUAL, class AFn, class BFn, class BFn2, class Epi>
DI void ngemm(const Ctx& cx, float* lds, int nbz, int M, int N, int K, AFn afn, BFn bfn, BFn2 bfn2, Epi epi) {
    float* As = lds; float* Bs = lds + 16 * 132; float* B2s = Bs + 16 * 128;
    const int tid = cx.tid, ty = tid >> 5, tx = tid & 31;
    const int tm = (M + 127) / 128, tn = (N + 127) / 128, ntile = tm * tn * nbz;
    const int arow = tid >> 2, akc = (tid & 3) * 4, bk = tid >> 5, bnn = (tid & 31) * 4;
    for (int tile = cx.bid; tile < ntile; tile += cx.nblk) {
        const int bz = tile / (tm * tn), rem = tile % (tm * tn), bm = rem / tn, bn = rem % tn;
        float acc[8][4], acc2[8][4];
#pragma unroll
        for (int i = 0; i < 8; ++i)
#pragma unroll
            for (int j = 0; j < 4; ++j) { acc[i][j] = 0.f; acc2[i][j] = 0.f; }
        const int m_a = bm * 128 + arow;
        const bf16_t* aptr = (m_a < M) ? afn(bz, m_a) : nullptr;
        const int nB = bn * 128 + bnn;
        for (int k0 = 0; k0 < K; k0 += 16) {
            float av0 = 0.f, av1 = 0.f, av2 = 0.f, av3 = 0.f;
            if (aptr) { const uint2 u = *(const uint2*)(aptr + k0 + akc); av0 = bflo(u.x); av1 = bfhi(u.x); av2 = bflo(u.y); av3 = bfhi(u.y); }
            float4 bv = make_float4(0.f, 0.f, 0.f, 0.f), bv2 = make_float4(0.f, 0.f, 0.f, 0.f);
            if (nB < N) { bv = *(const float4*)(bfn(bz, k0 + bk) + nB); if (DUAL) bv2 = *(const float4*)(bfn2(bz, k0 + bk) + nB); }
            __syncthreads();
            As[(akc + 0) * 132 + arow] = av0; As[(akc + 1) * 132 + arow] = av1; As[(akc + 2) * 132 + arow] = av2; As[(akc + 3) * 132 + arow] = av3;
            *(float4*)&Bs[bk * 128 + bnn] = bv;
            if (DUAL) *(float4*)&B2s[bk * 128 + bnn] = bv2;
            __syncthreads();
#pragma unroll 4
            for (int kk = 0; kk < 16; ++kk) {
                const float4 a0 = *(const float4*)&As[kk * 132 + ty * 8], a1 = *(const float4*)&As[kk * 132 + ty * 8 + 4];
                const float4 b = *(const float4*)&Bs[kk * 128 + tx * 4];
                const float a[8] = {a0.x, a0.y, a0.z, a0.w, a1.x, a1.y, a1.z, a1.w};
                const float bb[4] = {b.x, b.y, b.z, b.w};
#pragma unroll
                for (int i = 0; i < 8; ++i)
#pragma unroll
                    for (int j = 0; j < 4; ++j) acc[i][j] += a[i] * bb[j];
                if (DUAL) {
                    const float4 b2 = *(const float4*)&B2s[kk * 128 + tx * 4];
                    const float cc[4] = {b2.x, b2.y, b2.z, b2.w};
#pragma unroll
                    for (int i = 0; i < 8; ++i)
#pragma unroll
                        for (int j = 0; j < 4; ++j) acc2[i][j] += a[i] * cc[j];
                }
            }
        }
#pragma unroll
        for (int i = 0; i < 8; ++i) {
            const int m = bm * 128 + ty * 8 + i;
            if (m < M) {
#pragma unroll
                for (int j = 0; j < 4; ++j) { const int n = bn * 128 + tx * 4 + j; if (n < N) epi(bz, m, n, acc[i][j], acc2[i][j]); }
            }
        }
    }
    __syncthreads();
}

DI void ph_prologue(const Ctx& cx, const Params& p, float* lds) {
    const int tid = cx.tid, gtid = cx.bid * NTHR + tid, gsz = cx.nblk * NTHR;
    for (int i = tid; i < 17 * 1024; i += NTHR) { const int j = i >> 10, k = i & 1023; const float v = (j < 16) ? p.c[j * 1024 + k] : p.c_ctx[k]; lds[i] = siluf(v); }
    __syncthreads();
    for (int idx = gtid; idx < 4 * 6144; idx += gsz) {
        const int l = idx / 6144, n = idx % 6144;
        const float* w = p.mod_w + (size_t)l * 1024 * 6144 + n;
        float acc[17]; const float b0 = p.mod_b[l * 6144 + n];
#pragma unroll
        for (int j = 0; j < 17; ++j) acc[j] = b0;
        for (int k = 0; k < 1024; ++k) {
            const float wv = w[(size_t)k * 6144];
#pragma unroll
            for (int j = 0; j < 17; ++j) acc[j] += lds[j * 1024 + k] * wv;
        }
#pragma unroll
        for (int j = 0; j < 17; ++j) p.mod[((size_t)l * 17 + j) * 6144 + n] = acc[j];
    }
    for (int i = gtid; i < 2048 * 4096; i += gsz) {
        const int f = i >> 12, k = i & 4095, t = k & 2047, m = (f * t) & 2047; const float a = (float)m * (1.f / 1024.f);
        p.dftl[i] = f2bf((k < 2048) ? cospif(a) : sinpif(a));
    }
    for (int i = gtid; i < 256 * 512; i += gsz) {
        const int f = i >> 9, k = i & 511, t = k & 255, m = (f * t) & 255; const float a = (float)m * (1.f / 128.f);
        p.dftc[i] = f2bf((k < 256) ? cospif(a) : sinpif(a));
    }
    for (int i = gtid; i < 1024; i += gsz) p.H[(size_t)NT * 1024 + i] = 0;
    __syncthreads();
}

DI float pick4(float a0, float a1, float a2, float a3, int i) { return i == 0 ? a0 : (i == 1 ? a1 : (i == 2 ? a2 : a3)); }
template <bool COMBINE, bool NORM, bool ROUTER>
DI void ph_norm(const Ctx& cx, const Params& p, float* lds, int nrows, const float* xin_lat, const float* xin_ctx, const float* gain, const float* modl, int sh_idx, int sc_idx,
                const float* modprev, int layer) {
    const int tid = cx.tid, wid = tid >> 6, lane = tid & 63;
    float* rw = lds;
    float* scr = lds + 16 * 1024;
    if (ROUTER) {
        for (int i = tid; i < 16 * 1024; i += NTHR) { const int e = i >> 10, col = i & 1023; rw[i] = p.router_w[col * 16 + e]; }
        __syncthreads();
    }
    for (int row = cx.bid * 8 + wid; row < nrows; row += cx.nblk * 8) {
        const bool lat = row < NLAT; const int j = lat ? (row >> 11) : 16;
        const float* xr = lat ? xin_lat + (size_t)row * 1024 : xin_ctx + (size_t)(row - NLAT) * 1024;
        float4 xv[4];
#pragma unroll
        for (int i = 0; i < 4; ++i) xv[i] = *(const float4*)(xr + i * 256 + lane * 4);
        if (COMBINE) {
            const float* g2 = modprev + (size_t)j * 6144 + 5 * 1024;
            float* xo = lat ? p.out + (size_t)row * 1024 : p.ctxs + (size_t)(row - NLAT) * 1024;
#pragma unroll
            for (int i = 0; i < 4; ++i) {
                const int col = i * 256 + lane * 4;
                const float4 gv = *(const float4*)(g2 + col);
                float s0 = 0.f, s1 = 0.f, s2 = 0.f, s3 = 0.f;
#pragma unroll
                for (int s = 0; s < 3; ++s) { const uint2 u = *(const uint2*)(p.Y + ((size_t)s * NT + row) * 1024 + col); s0 += bflo(u.x); s1 += bfhi(u.x); s2 += bflo(u.y); s3 += bfhi(u.y); }
                xv[i].x += gv.x * s0; xv[i].y += gv.y * s1; xv[i].z += gv.z * s2; xv[i].w += gv.w * s3;
                *(float4*)(xo + col) = xv[i];
            }
        }
        if (NORM) {
            float ss = 0.f;
#pragma unroll
            for (int i = 0; i < 4; ++i) ss += xv[i].x * xv[i].x + xv[i].y * xv[i].y + xv[i].z * xv[i].z + xv[i].w * xv[i].w;
            ss = wave_sum(ss);
            const float rstd = rsqrtf(ss * (1.f / 1024.f) + 1e-6f);
            const float* shp = modl + (size_t)j * 6144 + sh_idx * 1024; const float* scp = modl + (size_t)j * 6144 + sc_idx * 1024;
            float4 hv[4];
#pragma unroll
            for (int i = 0; i < 4; ++i) {
                const int col = i * 256 + lane * 4;
                const float4 g = *(const float4*)(gain + col), sh = *(const float4*)(shp + col), sc = *(const float4*)(scp + col);
                hv[i].x = xv[i].x * rstd * g.x * (1.f + sc.x) + sh.x; hv[i].y = xv[i].y * rstd * g.y * (1.f + sc.y) + sh.y;
                hv[i].z = xv[i].z * rstd * g.z * (1.f + sc.z) + sh.z; hv[i].w = xv[i].w * rstd * g.w * (1.f + sc.w) + sh.w;
                uint2 u; u.x = pack2(hv[i].x, hv[i].y); u.y = pack2(hv[i].z, hv[i].w);
                *(uint2*)(p.H + (size_t)row * 1024 + col) = u;
            }
            if (ROUTER) {
                float part[16];
#pragma unroll
                for (int e = 0; e < 16; ++e) {
                    float a = 0.f;
#pragma unroll
                    for (int i = 0; i < 4; ++i) { const float4 w = *(const float4*)(rw + e * 1024 + i * 256 + lane * 4); a += hv[i].x * w.x + hv[i].y * w.y + hv[i].z * w.z + hv[i].w * w.w; }
                    part[e] = wave_sum(a);
                }
                float* my = scr + wid * 32;
#pragma unroll
                for (int e = 0; e < 16; ++e) if (lane == e) { const float sg = sigm(part[e]); my[e] = sg; my[16 + e] = sg + p.router_b[e]; }
                __builtin_amdgcn_wave_barrier();
                if (lane == 0) {
                    float best = -3.0e38f; int be1 = 0, be2 = 1;
                    for (int g = 0; g < 4; ++g) {
                        const float v0 = my[16 + 4 * g], v1 = my[16 + 4 * g + 1], v2 = my[16 + 4 * g + 2], v3 = my[16 + 4 * g + 3];
                        int i1 = 0; float m1 = v0;
                        if (v1 > m1) { m1 = v1; i1 = 1; } if (v2 > m1) { m1 = v2; i1 = 2; } if (v3 > m1) { m1 = v3; i1 = 3; }
                        int i2 = -1; float m2 = -3.0e38f;
                        if (i1 != 0 && v0 > m2) { m2 = v0; i2 = 0; } if (i1 != 1 && v1 > m2) { m2 = v1; i2 = 1; }
                        if (i1 != 2 && v2 > m2) { m2 = v2; i2 = 2; } if (i1 != 3 && v3 > m2) { m2 = v3; i2 = 3; }
                        const float gs = m1 + m2;
                        if (gs > best) { best = gs; be1 = 4 * g + i1; be2 = 4 * g + i2; }
                    }
                    const float bs1 = my[be1], bs2 = my[be2];
                    const float inv = 1.f / (bs1 + bs2);
                    const int p1 = atomicAdd(p.cnt + layer * 16 + be1, 1), p2 = atomicAdd(p.cnt + layer * 16 + be2, 1);
                    p.slot[(size_t)be1 * NT + p1] = row * 2; p.slot[(size_t)be2 * NT + p2] = row * 2 + 1;
                    p.tokw[row * 2] = bs1 * inv; p.tokw[row * 2 + 1] = bs2 * inv;
                }
                __builtin_amdgcn_wave_barrier();
            }
        }
    }
    (void)scr;
    __syncthreads();
}

DI void ph_win(const Ctx& cx, const Params& p, float* lds, int j) {
    const float* W = p.w_in + (size_t)j * 1024 * INC;
    ngemm<false>(cx, lds, 1, NT, INC, 1024,
        [&](int, int m) { return p.H + (size_t)m * 1024; },
        [&](int, int k) { return W + (size_t)k * INC; }, [&](int, int) { return (const float*)nullptr; },
        [&](int, int m, int n, float v, float) { p.P[(size_t)m * PLD + n] = f2bf(v); });
}
DI void ph_prepB(const Ctx& cx, const Params& p, int j) {
    const int tid = cx.tid, wid = tid >> 6, lane = tid & 63;
    for (int row = cx.bid * 8 + wid; row < NT; row += cx.nblk * 8) {
        const bf16_t* pr = p.P + (size_t)row * PLD + ACOLS;
        const uint2 uq = *(const uint2*)(pr + lane * 4); const unsigned ukv = *(const unsigned*)(pr + 256 + lane * 2);
        const float q0 = bflo(uq.x), q1 = bfhi(uq.x), q2 = bflo(uq.y), q3 = bfhi(uq.y), k0 = bflo(ukv), k1 = bfhi(ukv);
        const float sq = wave_sum(q0 * q0 + q1 * q1 + q2 * q2 + q3 * q3), sk = wave_sum(k0 * k0 + k1 * k1);
        const float rq = rsqrtf(sq * (1.f / 256.f) + 1e-6f), rk = rsqrtf(sk * (1.f / 128.f) + 1e-6f);
        const float* gq = p.b_q_norm + j * 256 + lane * 4; const float* gk = p.b_kv_norm + j * 128 + lane * 2;
        uint2 o; o.x = pack2(q0 * rq * gq[0], q1 * rq * gq[1]); o.y = pack2(q2 * rq * gq[2], q3 * rq * gq[3]);
        bf16_t* qn = p.QN + (size_t)row * 512;
        *(uint2*)(qn + lane * 4) = o;
        *(unsigned*)(qn + 256 + lane * 2) = pack2(k0 * rk * gk[0], k1 * rk * gk[1]);
        *(unsigned*)(qn + 384 + lane * 2) = 0u;
    }
}
DI void ph_qkvup(const Ctx& cx, const Params& p, float* lds, int j, int mq) {
    const float* Wq = p.b_w_q_up + (size_t)j * 256 * 768; const float* Wkv = p.b_w_kv_up + (size_t)j * 128 * 1024;
    ngemm<false>(cx, lds, 1, mq, 768, 256,
        [&](int, int m) { return p.QN + (size_t)m * 512; },
        [&](int, int k) { return Wq + (size_t)k * 768; }, [&](int, int) { return (const float*)nullptr; },
        [&](int, int m, int n, float v, float) { p.Qraw[(size_t)m * 768 + n] = f2bf(v); });
    ngemm<false>(cx, lds, 1, NT, 1024, 128,
        [&](int, int m) { return p.QN + (size_t)m * 512 + 256; },
        [&](int, int k) { return Wkv + (size_t)k * 1024; }, [&](int, int) { return (const float*)nullptr; },
        [&](int, int m, int n, float v, float) { p.KVraw[(size_t)m * 1024 + n] = f2bf(v); });
}
DI void unpack8(const uint4 u, float* d) { d[0] = bflo(u.x); d[1] = bfhi(u.x); d[2] = bflo(u.y); d[3] = bfhi(u.y); d[4] = bflo(u.z); d[5] = bfhi(u.z); d[6] = bflo(u.w); d[7] = bfhi(u.w); }
DI uint4 pack8(const float* d, float scl) { uint4 u; u.x = pack2(d[0] * scl, d[1] * scl); u.y = pack2(d[2] * scl, d[3] * scl); u.z = pack2(d[4] * scl, d[5] * scl); u.w = pack2(d[6] * scl, d[7] * scl); return u; }
DI float ssq8(const uint4 u) { float d[8]; unpack8(u, d); float s = 0.f;
#pragma unroll
    for (int i = 0; i < 8; ++i) s += d[i] * d[i];
    return s; }
DI void norm_rope_store(const uint4 (&raw)[12], const float* gain, int t, bool lat, float scl, bf16_t* dst) {
    float ss = 0.f;
#pragma unroll
    for (int i = 0; i < 12; ++i) ss += ssq8(raw[i]);
    const float r = rsqrtf(ss * (1.f / 96.f) + 1e-6f);
#pragma unroll
    for (int i = 0; i < 8; ++i) { float d[8]; unpack8(raw[i], d);
#pragma unroll
        for (int c = 0; c < 8; ++c) d[c] = d[c] * r * gain[i * 8 + c];
        *(uint4*)(dst + i * 8) = pack8(d, scl); }
    const float invf[8] = {1.f, 0.316227766016838f, 0.1f, 0.0316227766016838f, 0.01f, 0.00316227766016838f, 0.001f, 0.000316227766016838f};
    const float ri = (float)(t >> 6), ci = (float)(t & 63);
#pragma unroll
    for (int half = 0; half < 2; ++half) {
        float x1[8], x2[8], o1[8], o2[8]; unpack8(raw[8 + half], x1); unpack8(raw[10 + half], x2);
#pragma unroll
        for (int c = 0; c < 8; ++c) {
            const float ang = (half == 0 ? ri : ci) * invf[c];
            const float cs = lat ? __cosf(ang) : 1.f, sn = lat ? __sinf(ang) : 0.f;
            const float a = x1[c] * r * gain[64 + half * 8 + c], b = x2[c] * r * gain[80 + half * 8 + c];
            o1[c] = a * cs - b * sn; o2[c] = b * cs + a * sn;
        }
        *(uint4*)(dst + 64 + half * 8) = pack8(o1, scl); *(uint4*)(dst + 80 + half * 8) = pack8(o2, scl);
    }
}
DI void ph_finalize(const Ctx& cx, const Params& p, int j, int mq) {
    const int gtid = cx.bid * NTHR + cx.tid, gsz = cx.nblk * NTHR;
    const float* qg = p.b_q_gain + j * 96; const float* kg = p.b_k_gain + j * 96;
    for (int idx = gtid; idx < 8 * mq; idx += gsz) {
        const int h = idx / mq, row = idx % mq;
        const bool lat = row < NLAT; const int t = lat ? (row & 2047) : ((row - NLAT) & 255);
        bf16_t* qp = p.Qraw + (size_t)row * 768 + h * 96;
        uint4 raw[12];
#pragma unroll
        for (int i = 0; i < 12; ++i) raw[i] = *(const uint4*)(qp + i * 8);
        norm_rope_store(raw, qg, t, lat, 0.10206207261596577f, qp);
    }
    for (int idx = gtid; idx < 8 * NT; idx += gsz) {
        const int h = idx / NT, row = idx % NT;
        const bool lat = row < NLAT; const int b = lat ? (row >> 11) : ((row - NLAT) >> 8); const int t = lat ? (row & 2047) : ((row - NLAT) & 255);
        const int key = lat ? 256 + t : t;
        const bf16_t* kvp = p.KVraw + (size_t)row * 1024 + h * 128; const bf16_t* krp = p.P + (size_t)row * PLD + ACOLS + 384;
        uint4 raw[12];
#pragma unroll
        for (int i = 0; i < 8; ++i) raw[i] = *(const uint4*)(kvp + i * 8);
#pragma unroll
        for (int i = 0; i < 4; ++i) raw[8 + i] = *(const uint4*)(krp + i * 8);
        norm_rope_store(raw, kg, t, lat, 1.f, p.Kf + ((size_t)(b * 8 + h) * 2304 + key) * 96);
    }
    for (int idx = gtid; idx < 8 * NT; idx += gsz) {
        const int h = idx / NT, row = idx % NT;
        const bool lat = row < NLAT; const int b = lat ? (row >> 11) : ((row - NLAT) >> 8); const int t = lat ? (row & 2047) : ((row - NLAT) & 255);
        const int key = lat ? 256 + t : t;
        const bf16_t* vp = p.KVraw + (size_t)row * 1024 + h * 128 + 64;
        bf16_t* vo = p.Vt + (size_t)(b * 8 + h) * 64 * 2304 + key;
#pragma unroll 1
        for (int i = 0; i < 8; ++i) { const uint4 u = *(const uint4*)(vp + i * 8);
            vo[0] = (bf16_t)(u.x & 0xffff); vo[2304] = (bf16_t)(u.x >> 16); vo[2 * 2304] = (bf16_t)(u.y & 0xffff); vo[3 * 2304] = (bf16_t)(u.y >> 16);
            vo[4 * 2304] = (bf16_t)(u.z & 0xffff); vo[5 * 2304] = (bf16_t)(u.z >> 16); vo[6 * 2304] = (bf16_t)(u.w & 0xffff); vo[7 * 2304] = (bf16_t)(u.w >> 16);
            vo += 8 * 2304; }
    }
}
DI void ph_attn(const Ctx& cx, const Params& p, bool with_ctx) {
    const int gtid = cx.bid * NTHR + cx.tid, gsz = cx.nblk * NTHR;
    const int total = NLAT * 8 + (with_ctx ? NCTX * 8 : 0);
    for (int idx = gtid; idx < total; idx += gsz) {
        int b, h, row, nkeys;
        if (idx < NLAT * 8) { b = idx >> 14; h = (idx >> 11) & 7; row = b * 2048 + (idx & 2047); nkeys = 2304; }
        else { const int i2 = idx - NLAT * 8; b = i2 >> 11; h = (i2 >> 8) & 7; row = NLAT + b * 256 + (i2 & 255); nkeys = 256; }
        const bf16_t* qp = p.Qraw + (size_t)row * 768 + h * 96;
        const bf16_t* Kb = p.Kf + (size_t)(b * 8 + h) * 2304 * 96; const bf16_t* Vb = p.Vt + (size_t)(b * 8 + h) * 64 * 2304;
        float q[96];
#pragma unroll
        for (int i = 0; i < 12; ++i) { const uint4 u = *(const uint4*)(qp + i * 8); q[i * 8] = bflo(u.x); q[i * 8 + 1] = bfhi(u.x); q[i * 8 + 2] = bflo(u.y); q[i * 8 + 3] = bfhi(u.y);
            q[i * 8 + 4] = bflo(u.z); q[i * 8 + 5] = bfhi(u.z); q[i * 8 + 6] = bflo(u.w); q[i * 8 + 7] = bfhi(u.w); }
        float acc[64];
#pragma unroll
        for (int i = 0; i < 64; ++i) acc[i] = 0.f;
        float mx = -3.0e38f, l = 0.f;
        for (int key0 = 0; key0 < nkeys; key0 += 8) {
            float s[8];
#pragma unroll
            for (int kk = 0; kk < 8; ++kk) {
                const uint4* kp = (const uint4*)(Kb + (size_t)(key0 + kk) * 96); float a = 0.f;
#pragma unroll
                for (int i = 0; i < 12; ++i) { const uint4 u = kp[i]; a += q[i * 8] * bflo(u.x) + q[i * 8 + 1] * bfhi(u.x) + q[i * 8 + 2] * bflo(u.y) + q[i * 8 + 3] * bfhi(u.y)
                    + q[i * 8 + 4] * bflo(u.z) + q[i * 8 + 5] * bfhi(u.z) + q[i * 8 + 6] * bflo(u.w) + q[i * 8 + 7] * bfhi(u.w); }
                s[kk] = a;
            }
            float cm = s[0];
#pragma unroll
            for (int kk = 1; kk < 8; ++kk) cm = fmaxf(cm, s[kk]);
            const float mn = fmaxf(mx, cm), alpha = expf(mx - mn);
            float ps = 0.f;
#pragma unroll
            for (int kk = 0; kk < 8; ++kk) { s[kk] = expf(s[kk] - mn); ps += s[kk]; }
            l = l * alpha + ps; mx = mn;
#pragma unroll
            for (int dv = 0; dv < 64; ++dv) {
                const uint4 u = *(const uint4*)(Vb + (size_t)dv * 2304 + key0);
                acc[dv] = acc[dv] * alpha + s[0] * bflo(u.x) + s[1] * bfhi(u.x) + s[2] * bflo(u.y) + s[3] * bfhi(u.y) + s[4] * bflo(u.z) + s[5] * bfhi(u.z) + s[6] * bflo(u.w) + s[7] * bfhi(u.w);
            }
        }
        const float il = 1.f / l;
        bf16_t* o = p.H + (size_t)row * 1024 + 512 + h * 64;
#pragma unroll
        for (int i = 0; i < 8; ++i) { uint4 u; u.x = pack2(acc[i * 8] * il, acc[i * 8 + 1] * il); u.y = pack2(acc[i * 8 + 2] * il, acc[i * 8 + 3] * il);
            u.z = pack2(acc[i * 8 + 4] * il, acc[i * 8 + 5] * il); u.w = pack2(acc[i * 8 + 6] * il, acc[i * 8 + 7] * il); *(uint4*)(o + i * 8) = u; }
    }
}
DI float shiftp(const bf16_t* P, int row, int t, int T, int col, float mu) {
    const float c = bf2f(P[(size_t)row * PLD + col]);
    const float pv = (t > 0) ? bf2f(P[(size_t)(row - 1) * PLD + col]) : 0.f;
    const float nx = (t < T - 1) ? bf2f(P[(size_t)(row + 1) * PLD + col]) : 0.f;
    return c + mu * (0.5f * (pv + nx) - c);
}
DI void ph_prepLR(const Ctx& cx, const Params& p, int j) {
    const int gtid = cx.bid * NTHR + cx.tid, gsz = cx.nblk * NTHR;
    const float* mu = p.a_mu + j * ACOLS + 1536;
    for (int idx = gtid; idx < NT * 384; idx += gsz) {
        const int row = idx / 384, col = idx % 384;
        const bool lat = row < NLAT; const int t = lat ? (row & 2047) : ((row - NLAT) & 255); const int T = lat ? 2048 : 256;
        float v = shiftp(p.P, row, t, T, 1536 + col, mu[col]);
        if (col < 128) v = tanhf(v); else if (col >= 256) v = sigm(v);
        p.LR[(size_t)row * 384 + col] = f2bf(v);
    }
}
DI void ph_wag(const Ctx& cx, const Params& p, float* lds, int j) {
    for (int d = 0; d < 2; ++d) {
        const float* W2 = p.a_w2 + (size_t)(j * 2 + d) * 64 * 512; const float* w0 = p.a_w0 + (j * 2 + d) * 512;
        ngemm<false>(cx, lds, 1, NT, 512, 64,
            [&](int, int m) { return p.LR + (size_t)m * 384 + d * 64; },
            [&](int, int k) { return W2 + (size_t)k * 512; }, [&](int, int) { return (const float*)nullptr; },
            [&](int, int m, int n, float v, float) { const float z = -0.606531f * sigm(w0[n] + v); p.WAG[(size_t)m * WLD + d * 512 + n] = f2bf(-expm1f(z)); });
        const float* A2 = p.a_a2 + (size_t)(j * 2 + d) * 64 * 512; const float* a0 = p.a_a0 + (j * 2 + d) * 512;
        ngemm<false>(cx, lds, 1, NT, 512, 64,
            [&](int, int m) { return p.LR + (size_t)m * 384 + 128 + d * 64; },
            [&](int, int k) { return A2 + (size_t)k * 512; }, [&](int, int) { return (const float*)nullptr; },
            [&](int, int m, int n, float v, float) { p.WAG[(size_t)m * WLD + 1024 + d * 512 + n] = f2bf(sigm(a0[n] + v)); });
    }
    const float* G2 = p.a_g2 + (size_t)j * 128 * 512;
    ngemm<false>(cx, lds, 1, NT, 512, 128,
        [&](int, int m) { return p.LR + (size_t)m * 384 + 256; },
        [&](int, int k) { return G2 + (size_t)k * 512; }, [&](int, int) { return (const float*)nullptr; },
        [&](int, int m, int n, float v, float) { p.WAG[(size_t)m * WLD + 2048 + n] = f2bf(v); });
}
DI void ph_scan(const Ctx& cx, const Params& p, float* lds, int j) {
    const int tid = cx.tid, lane = tid & 63;
    if (tid < 64) {
        for (int item = cx.bid; item < 256; item += cx.nblk) {
            const int b = item >> 4, h = (item >> 1) & 7, dir = item & 1, hc = h * 64 + lane;
            float S[64];
#pragma unroll
            for (int k = 0; k < 64; ++k) S[k] = 0.f;
            const float kkc = p.a_k_k[j * 512 + hc], kac = p.a_k_a[j * 512 + hc];
            const float mur = p.a_mu[j * ACOLS + hc], muk = p.a_mu[j * ACOLS + 512 + hc], muv = p.a_mu[j * ACOLS + 1024 + hc];
            bf16_t* yout = dir ? p.YB : p.YF;
            for (int step = 0; step < 2304; ++step) {
                const bool cp = step < 256; const int tt = cp ? step : step - 256, T = cp ? 256 : 2048, t = dir ? (T - 1 - tt) : tt;
                const int row = cp ? NLAT + b * 256 + t : b * 2048 + t;
                const float R = shiftp(p.P, row, t, T, hc, mur), K = shiftp(p.P, row, t, T, 512 + hc, muk), V = shiftp(p.P, row, t, T, 1024 + hc, muv);
                const float w = 1.f - bf2f(p.WAG[(size_t)row * WLD + dir * 512 + hc]), a = bf2f(p.WAG[(size_t)row * WLD + 1024 + dir * 512 + hc]);
                const float kkv = K * kkc, ssq = wave_sum(kkv * kkv), kk = kkv * rsqrtf(ssq + 1e-12f);
                const float kd = K * (1.f + (a - 1.f) * kac), bd = kk * a;
                lds[lane] = -kk; lds[64 + lane] = w; lds[128 + lane] = bd; lds[192 + lane] = kd; lds[256 + lane] = R;
                __builtin_amdgcn_wave_barrier();
                float sa = 0.f;
#pragma unroll
                for (int k4 = 0; k4 < 16; ++k4) { const float4 v = *(const float4*)(lds + k4 * 4); sa += S[k4 * 4] * v.x + S[k4 * 4 + 1] * v.y + S[k4 * 4 + 2] * v.z + S[k4 * 4 + 3] * v.w; }
                float y = 0.f;
#pragma unroll
                for (int k4 = 0; k4 < 16; ++k4) {
                    const float4 wv = *(const float4*)(lds + 64 + k4 * 4), bv = *(const float4*)(lds + 128 + k4 * 4), kv = *(const float4*)(lds + 192 + k4 * 4), rv = *(const float4*)(lds + 256 + k4 * 4);
                    S[k4 * 4] = S[k4 * 4] * wv.x + sa * bv.x + V * kv.x; S[k4 * 4 + 1] = S[k4 * 4 + 1] * wv.y + sa * bv.y + V * kv.y;
                    S[k4 * 4 + 2] = S[k4 * 4 + 2] * wv.z + sa * bv.z + V * kv.z; S[k4 * 4 + 3] = S[k4 * 4 + 3] * wv.w + sa * bv.w + V * kv.w;
                    y += S[k4 * 4] * rv.x + S[k4 * 4 + 1] * rv.y + S[k4 * 4 + 2] * rv.z + S[k4 * 4 + 3] * rv.w;
                }
                __builtin_amdgcn_wave_barrier();
                yout[(size_t)row * 512 + hc] = f2bf(y);
            }
        }
    }
    __syncthreads();
}
DI void ph_post(const Ctx& cx, const Params& p, int j, int nrows) {
    const int gtid = cx.bid * NTHR + cx.tid, gsz = cx.nblk * NTHR;
    for (int idx = gtid; idx < 8 * nrows; idx += gsz) {
        const int h = idx / nrows, row = idx % nrows;
        const bool lat = row < NLAT; const int t = lat ? (row & 2047) : ((row - NLAT) & 255); const int T = lat ? 2048 : 256;
        float sum = 0.f, sb = 0.f;
#pragma unroll 8
        for (int n = 0; n < 64; ++n) {
            const int hc = h * 64 + n;
            const float yy = bf2f(p.YF[(size_t)row * 512 + hc]) + bf2f(p.YB[(size_t)row * 512 + hc]);
            sum += yy;
            const float R = shiftp(p.P, row, t, T, hc, p.a_mu[j * ACOLS + hc]), K = shiftp(p.P, row, t, T, 512 + hc, p.a_mu[j * ACOLS + 512 + hc]);
            const float af = bf2f(p.WAG[(size_t)row * WLD + 1024 + hc]), ab = bf2f(p.WAG[(size_t)row * WLD + 1536 + hc]);
            const float ka = p.a_k_a[j * 512 + hc], rk = p.a_r_k[j * 512 + hc];
            sb += R * rk * (K * (1.f + (af - 1.f) * ka) + K * (1.f + (ab - 1.f) * ka));
        }
        const float mean = sum * (1.f / 64.f); float var = 0.f;
#pragma unroll 8
        for (int n = 0; n < 64; ++n) { const int hc = h * 64 + n; const float yy = bf2f(p.YF[(size_t)row * 512 + hc]) + bf2f(p.YB[(size_t)row * 512 + hc]); var += (yy - mean) * (yy - mean); }
        const float rstd = rsqrtf(var * (1.f / 64.f) + 64e-5f);
#pragma unroll 8
        for (int n = 0; n < 64; ++n) {
            const int hc = h * 64 + n;
            const float yy = bf2f(p.YF[(size_t)row * 512 + hc]) + bf2f(p.YB[(size_t)row * 512 + hc]);
            const float V = shiftp(p.P, row, t, T, 1024 + hc, p.a_mu[j * ACOLS + 1024 + hc]);
            const float g = bf2f(p.WAG[(size_t)row * WLD + 2048 + hc]);
            const float o = ((yy - mean) * rstd * p.a_ln_w[j * 512 + hc] + p.a_ln_b[j * 512 + hc] + sb * V) * g;
            p.H[(size_t)row * 1024 + hc] = f2bf(o);
        }
    }
}
DI void ph_wout(const Ctx& cx, const Params& p, float* lds, const bf16_t* A, const float* W, int nrows, const float* xin_lat, const float* xin_ctx, const float* modl) {
    ngemm<false>(cx, lds, 1, nrows, 1024, 1024,
        [&](int, int m) { return A + (size_t)m * 1024; },
        [&](int, int k) { return W + (size_t)k * 1024; }, [&](int, int) { return (const float*)nullptr; },
        [&](int, int m, int n, float v, float) {
            const bool lat = m < NLAT; const int jj = lat ? (m >> 11) : 16; const float g1 = modl[(size_t)jj * 6144 + 2 * 1024 + n];
            if (lat) p.out[(size_t)m * 1024 + n] = xin_lat[(size_t)m * 1024 + n] + g1 * v;
            else p.ctxs[(size_t)(m - NLAT) * 1024 + n] = xin_ctx[(size_t)(m - NLAT) * 1024 + n] + g1 * v; });
}

DI void ph_chdft(const Ctx& cx, const Params& p, float* lds, int nrows) {
    const int tid = cx.tid, gtid = cx.bid * NTHR + tid, gsz = cx.nblk * NTHR;
    for (int i = tid; i < 128; i += NTHR) { lds[i] = cospif((float)i * (1.f / 64.f)); lds[128 + i] = sinpif((float)i * (1.f / 64.f)); }
    __syncthreads();
    for (int idx = gtid; idx < nrows * 1024; idx += gsz) {
        const int row = idx >> 10, col = idx & 1023, grp = col >> 7, g = col & 127;
        const bf16_t* hp = p.H + (size_t)row * 1024 + grp * 128;
        float gr = 0.f, gi = 0.f;
        for (int c = 0; c < 128; ++c) { const float xv = bf2f(hp[c]); const int m = (c * g) & 127; gr += xv * lds[m]; gi -= xv * lds[128 + m]; }
        p.G[(size_t)row * 2048 + col] = gr; p.G[(size_t)row * 2048 + 1024 + col] = gi;
    }
    __syncthreads();
}
DI void ph_posdft(const Ctx& cx, const Params& p, float* lds, bool with_ctx) {
    ngemm<false>(cx, lds, 16, 2048, 1024, 4096,
        [&](int, int m) { return p.dftl + (size_t)m * 4096; },
        [&](int bz, int k) { return (k < 2048) ? p.G + (size_t)(bz * 2048 + k) * 2048 : p.G + (size_t)(bz * 2048 + k - 2048) * 2048 + 1024; }, [&](int, int) { return (const float*)nullptr; },
        [&](int bz, int m, int n, float v, float) { p.F[(size_t)(bz * 2048 + m) * 1024 + n] = f2bf(v * (1.f / 512.f)); });
    if (with_ctx)
        ngemm<false>(cx, lds, 16, 256, 1024, 512,
            [&](int, int m) { return p.dftc + (size_t)m * 512; },
            [&](int bz, int k) { return (k < 256) ? p.G + (size_t)(NLAT + bz * 256 + k) * 2048 : p.G + (size_t)(NLAT + bz * 256 + k - 256) * 2048 + 1024; }, [&](int, int) { return (const float*)nullptr; },
            [&](int bz, int m, int n, float v, float) { p.F[(size_t)(NLAT + bz * 256 + m) * 1024 + n] = f2bf(v * 0.0055242717280199f); });
}

DI void ph_moe_up(const Ctx& cx, const Params& p, float* lds, int layer, int nrows) {
    for (int e = 0; e < 17; ++e) {
        const int M = (e < 16) ? __builtin_amdgcn_readfirstlane(p.cnt[layer * 16 + e]) : nrows;
        const float* Wg = (e < 16) ? p.moe_w_gate + ((size_t)layer * 16 + e) * 1024 * 512 : p.sh_gate + (size_t)layer * 1024 * 512;
        const float* Wu = (e < 16) ? p.moe_w_up + ((size_t)layer * 16 + e) * 1024 * 512 : p.sh_up + (size_t)layer * 1024 * 512;
        const int* sl = p.slot + (size_t)(e & 15) * NT;
        ngemm<true>(cx, lds, 1, M, 512, 1024,
            [&](int, int m) { const int tok = (e < 16) ? (sl[m] >> 1) : m; return p.H + (size_t)tok * 1024; },
            [&](int, int k) { return Wg + (size_t)k * 512; }, [&](int, int k) { return Wu + (size_t)k * 512; },
            [&](int, int m, int n, float g, float u) { const int s = (e < 16) ? sl[m] : 0; const int tok = (e < 16) ? (s >> 1) : m, slab = (e < 16) ? (s & 1) : 2;
                p.ACT[((size_t)slab * NT + tok) * 512 + n] = f2bf(siluf(g) * u); });
    }
}
DI void ph_moe_down(const Ctx& cx, const Params& p, float* lds, int layer, int nrows) {
    for (int e = 0; e < 17; ++e) {
        const int M = (e < 16) ? __builtin_amdgcn_readfirstlane(p.cnt[layer * 16 + e]) : nrows;
        const float* Wd = (e < 16) ? p.moe_w_down + ((size_t)layer * 16 + e) * 512 * 1024 : p.sh_down + (size_t)layer * 512 * 1024;
        const int* sl = p.slot + (size_t)(e & 15) * NT;
        ngemm<false>(cx, lds, 1, M, 1024, 512,
            [&](int, int m) { const int s = (e < 16) ? sl[m] : 0; const int tok = (e < 16) ? (s >> 1) : m, slab = (e < 16) ? (s & 1) : 2; return p.ACT + ((size_t)slab * NT + tok) * 512; },
            [&](int, int k) { return Wd + (size_t)k * 1024; }, [&](int, int) { return (const float*)nullptr; },
            [&](int, int m, int n, float v, float) { const int s = (e < 16) ? sl[m] : 0; const int tok = (e < 16) ? (s >> 1) : m, slab = (e < 16) ? (s & 1) : 2;
                const float w = (e < 16) ? p.tokw[s] : 1.f; p.Y[((size_t)slab * NT + tok) * 1024 + n] = f2bf(w * v); });
    }
}

template <int PH>
DI void run_phase(const Params& p, float* lds, int L) {
    const Ctx cx = make_ctx();
    const int j = L >> 1;
    const float* modl = p.mod + (size_t)L * 17 * 6144;
    const float* modprev = p.mod + (size_t)(L > 0 ? L - 1 : 0) * 17 * 6144;
    const bool last = (L == 3);
    const int rows_layer = (L == 3) ? NLAT : NT;
    const int rows_out = (L >= 2) ? NLAT : NT;
    const float* xin_lat = (L == 0) ? p.x : p.out; const float* xin_ctx = (L == 0) ? p.ctx : p.ctxs;
    if constexpr (PH == 0) ph_prologue(cx, p, lds);
    if constexpr (PH == 1) {
        if (L == 0) ph_norm<false, true, false>(cx, p, lds, rows_layer, xin_lat, xin_ctx, p.norm1_g + L * 1024, modl, 0, 1, modprev, L);
        else ph_norm<true, true, false>(cx, p, lds, rows_layer, xin_lat, xin_ctx, p.norm1_g + L * 1024, modl, 0, 1, modprev, L);
    }
    if constexpr (PH == 2) ph_win(cx, p, lds, j);
    if constexpr (PH == 3) ph_prepB(cx, p, j);
    if constexpr (PH == 4) ph_qkvup(cx, p, lds, j, rows_out);
    if constexpr (PH == 5) ph_finalize(cx, p, j, rows_out);
    if constexpr (PH == 6) ph_attn(cx, p, rows_out == NT);
    if constexpr (PH == 7) ph_prepLR(cx, p, j);
    if constexpr (PH == 8) ph_wag(cx, p, lds, j);
    if constexpr (PH == 9) ph_scan(cx, p, lds, j);
    if constexpr (PH == 10) ph_post(cx, p, j, rows_out);
    if constexpr (PH == 11) ph_wout(cx, p, lds, p.H, p.w_out_even + (size_t)j * 1024 * 1024, rows_out, xin_lat, xin_ctx, modl);
    if constexpr (PH == 12) ph_chdft(cx, p, lds, rows_layer);
    if constexpr (PH == 13) ph_posdft(cx, p, lds, !last);
    if constexpr (PH == 14) ph_wout(cx, p, lds, p.F, p.w_out_fourier + (size_t)j * 1024 * 1024, rows_out, xin_lat, xin_ctx, modl);
    if constexpr (PH == 15) ph_norm<false, true, true>(cx, p, lds, rows_out, p.out, p.ctxs, p.norm2_g + L * 1024, modl, 3, 4, modprev, L);
    if constexpr (PH == 16) ph_moe_up(cx, p, lds, L, rows_out);
    if constexpr (PH == 17) ph_moe_down(cx, p, lds, L, rows_out);
    if constexpr (PH == 18) ph_norm<true, false, false>(cx, p, lds, NLAT, p.out, p.ctxs, p.norm1_g, p.mod + (size_t)3 * 17 * 6144, 0, 1, p.mod + (size_t)3 * 17 * 6144, 3);
}

template <int PH>
__global__ void __launch_bounds__(NTHR, 2) k_phase(Params p, int L) {
    extern __shared__ __attribute__((aligned(16))) float shm[];
    run_phase<PH>(p, shm, L);
}

#if ONE_LAUNCH
constexpr int PARAM_WORDS = (int)(sizeof(Params) / 4);
DI Params load_params(const unsigned* lp) {
    Params q; unsigned* d = (unsigned*)&q;
#pragma unroll
    for (int i = 0; i < PARAM_WORDS; ++i) d[i] = (unsigned)__builtin_amdgcn_readfirstlane((int)lp[i]);
    return q;
}
#define PHASE(PH, L) do { const Params q_ = load_params(lp); run_phase<PH>(q_, lds, (L)); xcd_barrier(bar); } while (0)
__global__ void __launch_bounds__(NTHR, 2) k_mega(Params p) {
    extern __shared__ __attribute__((aligned(16))) float shm[];
    unsigned* lp = (unsigned*)(shm + 4);
    float* lds = shm + 4 + ((PARAM_WORDS + 3) & ~3);
    if (threadIdx.x == 0) { shm[0] = 0.f; shm[1] = 0.f; shm[2] = 0.f; shm[3] = 0.f; }
    if (threadIdx.x < PARAM_WORDS) lp[threadIdx.x] = ((const unsigned*)&p)[threadIdx.x];
    __syncthreads();
    XcdBarrier bar; { const Params q_ = load_params(lp); bar = xcd_barrier_post(q_.bar, (volatile LAS unsigned*)shm); }
    PHASE(0, 0);
#define LAYER_EVEN(L) PHASE(1, L); PHASE(2, L); PHASE(3, L); PHASE(4, L); PHASE(5, L); PHASE(6, L); PHASE(7, L); PHASE(8, L); PHASE(9, L); PHASE(10, L); PHASE(11, L); PHASE(15, L); PHASE(16, L); PHASE(17, L)
#define LAYER_ODD(L) PHASE(1, L); PHASE(12, L); PHASE(13, L); PHASE(14, L); PHASE(15, L); PHASE(16, L); PHASE(17, L)
    LAYER_EVEN(0); LAYER_ODD(1); LAYER_EVEN(2); LAYER_ODD(3);
    { const Params q_ = load_params(lp); run_phase<18>(q_, lds, 3); }
}
#endif

static inline size_t al256(size_t v) { return (v + 255) & ~(size_t)255; }
constexpr size_t LDS_BYTES = 136 * 1024;

template <int PH> static void launch_phase(const Params& p, int L, int grid, hipStream_t s) {
    static bool attr = false;
    if (!attr) { hipFuncSetAttribute((const void*)k_phase<PH>, hipFuncAttributeMaxDynamicSharedMemorySize, (int)LDS_BYTES); attr = true; }
    hipLaunchKernelGGL(k_phase<PH>, dim3(grid), dim3(NTHR), LDS_BYTES, s, p, L);
}

extern "C" void kernel_launch(void* const* d_in, const int* in_sizes, int n_in, void* d_out, int out_size, void* d_ws, size_t ws_size, hipStream_t stream) {
    (void)in_sizes; (void)n_in; (void)out_size;
    Params p{};
    const float** ip = (const float**)&p.x;
    for (int i = 0; i < 36; ++i) ip[i] = (const float*)d_in[i];
    p.out = (float*)d_out;
    char* w = (char*)d_ws; size_t o = 0;
    auto take = [&](size_t bytes) { char* r = w + o; o += al256(bytes); return r; };
    p.bar = (unsigned*)take(XCD_BAR_WORDS * 4);
    p.cnt = (int*)take(64 * 4);
    const size_t zero_bytes = o;
    p.mod = (float*)take((size_t)4 * 17 * 6144 * 4);
    p.ctxs = (float*)take((size_t)NCTX * 1024 * 4);
    p.dftl = (bf16_t*)take((size_t)2048 * 4096 * 2);
    p.dftc = (bf16_t*)take((size_t)256 * 512 * 2);
    p.slot = (int*)take((size_t)16 * NT * 4);
    p.tokw = (float*)take((size_t)NT * 2 * 4);
    p.H = (bf16_t*)take((size_t)(NT + 1) * 1024 * 2);
    char* big = w + o;
    p.P = (bf16_t*)take((size_t)NT * PLD * 2);
    char* r1 = w + o;
    p.LR = (bf16_t*)take((size_t)NT * 384 * 2);
    p.WAG = (bf16_t*)take((size_t)NT * WLD * 2);
    p.YF = (bf16_t*)take((size_t)NT * 512 * 2);
    p.YB = (bf16_t*)take((size_t)NT * 512 * 2);
    const size_t total = o;
    { size_t q = 0; auto t2 = [&](size_t bytes) { char* r = r1 + q; q += al256(bytes); return r; };
      p.QN = (bf16_t*)t2((size_t)NT * 512 * 2); p.Qraw = (bf16_t*)t2((size_t)NT * 768 * 2); p.KVraw = (bf16_t*)t2((size_t)NT * 1024 * 2);
      p.Kf = (bf16_t*)t2((size_t)NB * 8 * 2304 * 96 * 2); p.Vt = (bf16_t*)t2((size_t)NB * 8 * 64 * 2304 * 2); }
    { size_t q = 0; auto t3 = [&](size_t bytes) { char* r = big + q; q += al256(bytes); return r; };
      p.ACT = (bf16_t*)t3((size_t)3 * NT * 512 * 2); p.Y = (bf16_t*)t3((size_t)3 * NT * 1024 * 2); }
    { size_t q = 0; auto t4 = [&](size_t bytes) { char* r = big + q; q += al256(bytes); return r; };
      p.G = (float*)t4((size_t)NT * 2048 * 4); p.F = (bf16_t*)t4((size_t)NT * 1024 * 2); }
    if (total > ws_size) { fprintf(stderr, "workspace too small: need %zu have %zu\n", total, ws_size); return; }
    static int grid = 0;
    if (!grid) { int dev = 0, cus = 0; hipGetDevice(&dev); hipDeviceGetAttribute(&cus, hipDeviceAttributeMultiprocessorCount, dev); grid = cus > 0 ? cus : 256; if (grid > 256) grid = 256; }
    hipMemsetAsync(d_ws, 0, zero_bytes, stream);
#if ONE_LAUNCH
    static bool attr = false;
    if (!attr) { hipFuncSetAttribute((const void*)k_mega, hipFuncAttributeMaxDynamicSharedMemorySize, (int)LDS_BYTES); attr = true; }
    hipLaunchKernelGGL(k_mega, dim3(grid), dim3(NTHR), LDS_BYTES, stream, p);
#else
    launch_phase<0>(p, 0, grid, stream);
    for (int L = 0; L < 4; ++L) {
        launch_phase<1>(p, L, grid, stream);
        if ((L & 1) == 0) {
            launch_phase<2>(p, L, grid, stream); launch_phase<3>(p, L, grid, stream); launch_phase<4>(p, L, grid, stream); launch_phase<5>(p, L, grid, stream);
            launch_phase<6>(p, L, grid, stream); launch_phase<7>(p, L, grid, stream); launch_phase<8>(p, L, grid, stream); launch_phase<9>(p, L, grid, stream);
            launch_phase<10>(p, L, grid, stream); launch_phase<11>(p, L, grid, stream);
        } else {
            launch_phase<12>(p, L, grid, stream); launch_phase<13>(p, L, grid, stream); launch_phase<14>(p, L, grid, stream);
        }
        launch_phase<15>(p, L, grid, stream); launch_phase<16>(p, L, grid, stream); launch_phase<17>(p, L, grid, stream);
    }
    launch_phase<18>(p, 3, grid, stream);
#endif
}
```

```cpp
#include <hip/hip_runtime.h>
#include <cstdio>
#include <cstdint>

#ifndef ONE_LAUNCH
#define ONE_LAUNCH 1
#endif
#ifndef OPT
#define OPT 7
#endif

typedef unsigned short bf16_t;
#define DI __device__ __forceinline__
#define LAS __attribute__((address_space(3)))

constexpr int D = 1024, NB = 16, SEQ = 2048, CTXL = 256, NLAT = NB * SEQ, NCTX = NB * CTXL, NT = NLAT + NCTX;
constexpr int PLD = 2560;
constexpr int INC = 2336, ACOLS = 1920;
constexpr int WLD = 2560;
constexpr int NTHR = 512;

#define XB_TMO      128
#define XB_XCNT(j)  (256  + 64 * (j))
#define XB_XSUB(j)  (1280 + 64 * (j))
#define XB_XGEN(j)  (2304 + 64 * (j))
#define XB_TOP      3328
#define XB_TOPGEN   3392
#define XCD_BAR_WORDS 3456
#define XB_SPIN_CAP (1u << 24)
DI unsigned xb_ld(unsigned* p)              { return __hip_atomic_load(p, __ATOMIC_RELAXED, __HIP_MEMORY_SCOPE_AGENT); }
DI unsigned xb_add(unsigned* p, unsigned v) { return __hip_atomic_fetch_add(p, v, __ATOMIC_RELAXED, __HIP_MEMORY_SCOPE_AGENT); }
DI unsigned xb_xcc_id() { return (unsigned)__builtin_amdgcn_s_getreg((3 << 11) | 20) & 0xFu; }
#define XB_SPIN(cond, bar) do { unsigned _sp = 0; while (cond) { __builtin_amdgcn_s_sleep(1); \
    if ((++_sp & 255u) == 0u) { if (xb_ld(&(bar)[XB_TMO])) break; if (_sp > XB_SPIN_CAP) { atomicAdd(&(bar)[XB_TMO], 1u); break; } } } } while (0)
struct XcdBarrier { unsigned* bar; unsigned x; volatile LAS unsigned* st; };
DI XcdBarrier xcd_barrier_post(unsigned* bar, volatile LAS unsigned* st) {
    XcdBarrier b; b.bar = bar; b.x = xb_xcc_id(); b.st = st;
    if (threadIdx.x == 0) (void)xb_add(&bar[XB_XCNT(b.x)], 1u);
    return b;
}
DI void xcd_barrier_complete(unsigned* bar, unsigned x, unsigned& nloc, unsigned& nx) {
    const unsigned G = gridDim.x * gridDim.y * gridDim.z;
    unsigned sum, cnt, mine, sp = 0u;
    for (;;) {
        sum = 0u; cnt = 0u; mine = 0u;
#pragma unroll
        for (unsigned j = 0; j < 16; ++j) { const unsigned c = xb_ld(&bar[XB_XCNT(j)]); sum += c; cnt += (c > 0u) ? 1u : 0u; mine = (j == x) ? c : mine; }
        if (sum == G) break;
        __builtin_amdgcn_s_sleep(1);
        if ((++sp & 255u) == 0u) { if (xb_ld(&bar[XB_TMO])) break; if (sp > XB_SPIN_CAP) { atomicAdd(&bar[XB_TMO], 1u); break; } }
    }
    nloc = mine > 0u ? mine : 1u; nx = cnt > 0u ? cnt : 1u;
}
DI void xcd_barrier(const XcdBarrier& b) {
    asm volatile("s_waitcnt vmcnt(0)" ::: "memory");
    __syncthreads();
    if (threadIdx.x == 0) {
        unsigned* bar = b.bar;
        __builtin_amdgcn_s_waitcnt(0);
        unsigned nloc = b.st[0], nx = b.st[1];
        if (nloc == 0u) { xcd_barrier_complete(bar, b.x, nloc, nx); b.st[0] = nloc; b.st[1] = nx; }
        const unsigned old = xb_add(&bar[XB_XSUB(b.x)], 1u);
        const unsigned gen = old / nloc;
        if (old + 1u == (gen + 1u) * nloc) {
            __builtin_amdgcn_fence(__ATOMIC_RELEASE, "agent");
            asm volatile("s_waitcnt vmcnt(0)" ::: "memory");
            const unsigned og = xb_add(&bar[XB_TOP], 1u);
            const unsigned tg = og / nx;
            if (og + 1u == (tg + 1u) * nx) xb_add(&bar[XB_TOPGEN], 1u);
            else XB_SPIN(xb_ld(&bar[XB_TOPGEN]) == tg, bar);
            __builtin_amdgcn_fence(__ATOMIC_ACQUIRE, "agent");
            xb_add(&bar[XB_XGEN(b.x)], 1u);
            asm volatile("s_waitcnt vmcnt(0)" ::: "memory");
        } else {
            XB_SPIN(xb_ld(&bar[XB_XGEN(b.x)]) == gen, bar);
            __builtin_amdgcn_fence(__ATOMIC_ACQUIRE, "agent");
            asm volatile("s_waitcnt vmcnt(0)" ::: "memory");
        }
    }
    __syncthreads();
}

struct Params {
    const float *x, *c, *ctx, *c_ctx, *norm1_g, *norm2_g, *mod_w, *mod_b, *w_in, *a_mu, *a_w0, *a_w2, *a_a0, *a_a2, *a_g2,
                *a_k_k, *a_k_a, *a_r_k, *a_ln_w, *a_ln_b, *b_q_norm, *b_w_q_up, *b_kv_norm, *b_w_kv_up, *b_q_gain, *b_k_gain,
                *w_out_even, *w_out_fourier, *router_w, *router_b, *moe_w_gate, *moe_w_up, *moe_w_down, *sh_gate, *sh_up, *sh_down;
    float* out;
    unsigned* bar; int* cnt; float* mod; float* ctxs; bf16_t* dftl; bf16_t* dftc; int* slot; float* tokw;
    bf16_t *H, *P, *LR, *WAG, *YF, *YB, *QN, *Qraw, *KVraw, *Kf, *Vt, *ACT, *Y, *F; float* G;
    bf16_t *WinT, *WqT, *WkvT, *WlrT, *WoutT, *A1, *A2, *A2c, *WguT, *WdT, *ZT, *ZTC;
};

struct Ctx { int tid, bid, nblk; };
DI Ctx make_ctx() { Ctx c; c.tid = threadIdx.x; c.bid = blockIdx.x; c.nblk = gridDim.x; asm volatile("" : "+v"(c.tid), "+s"(c.bid), "+s"(c.nblk)); return c; }

DI bf16_t f2bf(float f) { unsigned u = __float_as_uint(f); u += 0x7fffu + ((u >> 16) & 1u); return (bf16_t)(u >> 16); }
DI float bf2f(bf16_t b) { return __uint_as_float(((unsigned)b) << 16); }
DI float bflo(unsigned u) { return __uint_as_float(u << 16); }
DI float bfhi(unsigned u) { return __uint_as_float(u & 0xffff0000u); }
DI unsigned pack2(float lo, float hi) { return (unsigned)f2bf(lo) | ((unsigned)f2bf(hi) << 16); }
DI float siluf(float v) { return v / (1.f + expf(-v)); }
DI float sigm(float v) { return 1.f / (1.f + expf(-v)); }
DI float wave_sum(float v) {
#pragma unroll
    for (int o = 32; o >= 1; o >>= 1) v += __shfl_xor(v, o);
    return v;
}

template <bool DUAL, class AFn, class BFn, class BFn2, class Epi>
DI void ngemm(const Ctx& cx, float* lds, int nbz, int M, int N, int K, AFn afn, BFn bfn, BFn2 bfn2, Epi epi) {
    float* As = lds; float* Bs = lds + 16 * 132; float* B2s = Bs + 16 * 128;
    const int tid = cx.tid, ty = tid >> 5, tx = tid & 31;
    const int tm = (M + 127) / 128, tn = (N + 127) / 128, ntile = tm * tn * nbz;
    const int arow = tid >> 2, akc = (tid & 3) * 4, bk = tid >> 5, bnn = (tid & 31) * 4;
    for (int tile = cx.bid; tile < ntile; tile += cx.nblk) {
        const int bz = tile / (tm * tn), rem = tile % (tm * tn), bm = rem / tn, bn = rem % tn;
        float acc[8][4], acc2[8][4];
#pragma unroll
        for (int i = 0; i < 8; ++i)
#pragma unroll
            for (int j = 0; j < 4; ++j) { acc[i][j] = 0.f; acc2[i][j] = 0.f; }
        const int m_a = bm * 128 + arow;
        const bf16_t* aptr = (m_a < M) ? afn(bz, m_a) : nullptr;
        const int nB = bn * 128 + bnn;
        for (int k0 = 0; k0 < K; k0 += 16) {
            float av0 = 0.f, av1 = 0.f, av2 = 0.f, av3 = 0.f;
            if (aptr) { const uint2 u = *(const uint2*)(aptr + k0 + akc); av0 = bflo(u.x); av1 = bfhi(u.x); av2 = bflo(u.y); av3 = bfhi(u.y); }
            float4 bv = make_float4(0.f, 0.f, 0.f, 0.f), bv2 = make_float4(0.f, 0.f, 0.f, 0.f);
            if (nB < N) { bv = *(const float4*)(bfn(bz, k0 + bk) + nB); if (DUAL) bv2 = *(const float4*)(bfn2(bz, k0 + bk) + nB); }
            __syncthreads();
            As[(akc + 0) * 132 + arow] = av0; As[(akc + 1) * 132 + arow] = av1; As[(akc + 2) * 132 + arow] = av2; As[(akc + 3) * 132 + arow] = av3;
            *(float4*)&Bs[bk * 128 + bnn] = bv;
            if (DUAL) *(float4*)&B2s[bk * 128 + bnn] = bv2;
            __syncthreads();
#pragma unroll 4
            for (int kk = 0; kk < 16; ++kk) {
                const float4 a0 = *(const float4*)&As[kk * 132 + ty * 8], a1 = *(const float4*)&As[kk * 132 + ty * 8 + 4];
                const float4 b = *(const float4*)&Bs[kk * 128 + tx * 4];
                const float a[8] = {a0.x, a0.y, a0.z, a0.w, a1.x, a1.y, a1.z, a1.w};
                const float bb[4] = {b.x, b.y, b.z, b.w};
#pragma unroll
                for (int i = 0; i < 8; ++i)
#pragma unroll
                    for (int j = 0; j < 4; ++j) acc[i][j] += a[i] * bb[j];
                if (DUAL) {
                    const float4 b2 = *(const float4*)&B2s[kk * 128 + tx * 4];
                    const float cc[4] = {b2.x, b2.y, b2.z, b2.w};
#pragma unroll
                    for (int i = 0; i < 8; ++i)
#pragma unroll
                        for (int j = 0; j < 4; ++j) acc2[i][j] += a[i] * cc[j];
                }
            }
        }
#pragma unroll
        for (int i = 0; i < 8; ++i) {
            const int m = bm * 128 + ty * 8 + i;
            if (m < M) {
#pragma unroll
                for (int j = 0; j < 4; ++j) { const int n = bn * 128 + tx * 4 + j; if (n < N) epi(bz, m, n, acc[i][j], acc2[i][j]); }
            }
        }
    }
    __syncthreads();
}

DI void ph_prologue(const Ctx& cx, const Params& p, float* lds) {
    const int tid = cx.tid, gtid = cx.bid * NTHR + tid, gsz = cx.nblk * NTHR;
    for (int i = tid; i < 17 * 1024; i += NTHR) { const int j = i >> 10, k = i & 1023; const float v = (j < 16) ? p.c[j * 1024 + k] : p.c_ctx[k]; lds[i] = siluf(v); }
    __syncthreads();
    for (int idx = gtid; idx < 4 * 6144; idx += gsz) {
        const int l = idx / 6144, n = idx % 6144;
        const float* w = p.mod_w + (size_t)l * 1024 * 6144 + n;
        float acc[17]; const float b0 = p.mod_b[l * 6144 + n];
#pragma unroll
        for (int j = 0; j < 17; ++j) acc[j] = b0;
        for (int k = 0; k < 1024; ++k) {
            const float wv = w[(size_t)k * 6144];
#pragma unroll
            for (int j = 0; j < 17; ++j) acc[j] += lds[j * 1024 + k] * wv;
        }
#pragma unroll
        for (int j = 0; j < 17; ++j) p.mod[((size_t)l * 17 + j) * 6144 + n] = acc[j];
    }
    for (int i = gtid; i < 2048 * 4096; i += gsz) {
        const int f = i >> 12, k = i & 4095, t = k & 2047, m = (f * t) & 2047; const float a = (float)m * (1.f / 1024.f);
        p.dftl[i] = f2bf((k < 2048) ? cospif(a) : sinpif(a));
    }
    for (int i = gtid; i < 256 * 512; i += gsz) {
        const int f = i >> 9, k = i & 511, t = k & 255, m = (f * t) & 255; const float a = (float)m * (1.f / 128.f);
        p.dftc[i] = f2bf((k < 256) ? cospif(a) : sinpif(a));
    }
    for (int i = gtid; i < 1024; i += gsz) p.H[(size_t)NT * 1024 + i] = 0;
    __syncthreads();
}

DI float pick4(float a0, float a1, float a2, float a3, int i) { return i == 0 ? a0 : (i == 1 ? a1 : (i == 2 ? a2 : a3)); }
template <bool COMBINE, bool NORM, bool ROUTER>
DI void ph_norm(const Ctx& cx, const Params& p, float* lds, int nrows, const float* xin_lat, const float* xin_ctx, const float* gain, const float* modl, int sh_idx, int sc_idx,
                const float* modprev, int layer) {
    const int tid = cx.tid, wid = tid >> 6, lane = tid & 63;
    float* rw = lds;
    float* scr = lds + 16 * 1024;
    if (ROUTER) {
        for (int i = tid; i < 16 * 1024; i += NTHR) { const int e = i >> 10, col = i & 1023; rw[i] = p.router_w[col * 16 + e]; }
        __syncthreads();
    }
    for (int row = cx.bid * 8 + wid; row < nrows; row += cx.nblk * 8) {
        const bool lat = row < NLAT; const int j = lat ? (row >> 11) : 16;
        const float* xr = lat ? xin_lat + (size_t)row * 1024 : xin_ctx + (size_t)(row - NLAT) * 1024;
        float4 xv[4];
#pragma unroll
        for (int i = 0; i < 4; ++i) xv[i] = *(const float4*)(xr + i * 256 + lane * 4);
        if (COMBINE) {
            const float* g2 = modprev + (size_t)j * 6144 + 5 * 1024;
            float* xo = lat ? p.out + (size_t)row * 1024 : p.ctxs + (size_t)(row - NLAT) * 1024;
#pragma unroll
            for (int i = 0; i < 4; ++i) {
                const int col = i * 256 + lane * 4;
                const float4 gv = *(const float4*)(g2 + col);
                float s0 = 0.f, s1 = 0.f, s2 = 0.f, s3 = 0.f;
#pragma unroll
                for (int s = 0; s < 3; ++s) { const uint2 u = *(const uint2*)(p.Y + ((size_t)s * NT + row) * 1024 + col); s0 += bflo(u.x); s1 += bfhi(u.x); s2 += bflo(u.y); s3 += bfhi(u.y); }
                xv[i].x += gv.x * s0; xv[i].y += gv.y * s1; xv[i].z += gv.z * s2; xv[i].w += gv.w * s3;
                *(float4*)(xo + col) = xv[i];
            }
        }
        if (NORM) {
            float ss = 0.f;
#pragma unroll
            for (int i = 0; i < 4; ++i) ss += xv[i].x * xv[i].x + xv[i].y * xv[i].y + xv[i].z * xv[i].z + xv[i].w * xv[i].w;
            ss = wave_sum(ss);
            const float rstd = rsqrtf(ss * (1.f / 1024.f) + 1e-6f);
            const float* shp = modl + (size_t)j * 6144 + sh_idx * 1024; const float* scp = modl + (size_t)j * 6144 + sc_idx * 1024;
            float4 hv[4];
#pragma unroll
            for (int i = 0; i < 4; ++i) {
                const int col = i * 256 + lane * 4;
                const float4 g = *(const float4*)(gain + col), sh = *(const float4*)(shp + col), sc = *(const float4*)(scp + col);
                hv[i].x = xv[i].x * rstd * g.x * (1.f + sc.x) + sh.x; hv[i].y = xv[i].y * rstd * g.y * (1.f + sc.y) + sh.y;
                hv[i].z = xv[i].z * rstd * g.z * (1.f + sc.z) + sh.z; hv[i].w = xv[i].w * rstd * g.w * (1.f + sc.w) + sh.w;
                uint2 u; u.x = pack2(hv[i].x, hv[i].y); u.y = pack2(hv[i].z, hv[i].w);
                *(uint2*)(p.H + (size_t)row * 1024 + col) = u;
            }
            if (ROUTER) {
                float part[16];
#pragma unroll
                for (int e = 0; e < 16; ++e) {
                    float a = 0.f;
#pragma unroll
                    for (int i = 0; i < 4; ++i) { const float4 w = *(const float4*)(rw + e * 1024 + i * 256 + lane * 4); a += hv[i].x * w.x + hv[i].y * w.y + hv[i].z * w.z + hv[i].w * w.w; }
                    part[e] = wave_sum(a);
                }
                float* my = scr + wid * 32;
#pragma unroll
                for (int e = 0; e < 16; ++e) if (lane == e) { const float sg = sigm(part[e]); my[e] = sg; my[16 + e] = sg + p.router_b[e]; }
                __builtin_amdgcn_wave_barrier();
                if (lane == 0) {
                    float best = -3.0e38f; int be1 = 0, be2 = 1;
                    for (int g = 0; g < 4; ++g) {
                        const float v0 = my[16 + 4 * g], v1 = my[16 + 4 * g + 1], v2 = my[16 + 4 * g + 2], v3 = my[16 + 4 * g + 3];
                        int i1 = 0; float m1 = v0;
                        if (v1 > m1) { m1 = v1; i1 = 1; } if (v2 > m1) { m1 = v2; i1 = 2; } if (v3 > m1) { m1 = v3; i1 = 3; }
                        int i2 = -1; float m2 = -3.0e38f;
                        if (i1 != 0 && v0 > m2) { m2 = v0; i2 = 0; } if (i1 != 1 && v1 > m2) { m2 = v1; i2 = 1; }
                        if (i1 != 2 && v2 > m2) { m2 = v2; i2 = 2; } if (i1 != 3 && v3 > m2) { m2 = v3; i2 = 3; }
                        const float gs = m1 + m2;
                        if (gs > best) { best = gs; be1 = 4 * g + i1; be2 = 4 * g + i2; }
                    }
                    const float bs1 = my[be1], bs2 = my[be2];
                    const float inv = 1.f / (bs1 + bs2);
                    const int p1 = atomicAdd(p.cnt + layer * 16 + be1, 1), p2 = atomicAdd(p.cnt + layer * 16 + be2, 1);
                    p.slot[(size_t)be1 * NT + p1] = row * 2; p.slot[(size_t)be2 * NT + p2] = row * 2 + 1;
                    p.tokw[row * 2] = bs1 * inv; p.tokw[row * 2 + 1] = bs2 * inv;
                }
                __builtin_amdgcn_wave_barrier();
            }
        }
    }
    (void)scr;
    __syncthreads();
}

DI void ph_win(const Ctx& cx, const Params& p, float* lds, int j) {
    const float* W = p.w_in + (size_t)j * 1024 * INC;
    ngemm<false>(cx, lds, 1, NT, INC, 1024,
        [&](int, int m) { return p.H + (size_t)m * 1024; },
        [&](int, int k) { return W + (size_t)k * INC; }, [&](int, int) { return (const float*)nullptr; },
        [&](int, int m, int n, float v, float) { p.P[(size_t)m * PLD + n] = f2bf(v); });
}
DI void ph_prepB(const Ctx& cx, const Params& p, int j) {
    const int tid = cx.tid, wid = tid >> 6, lane = tid & 63;
    for (int row = cx.bid * 8 + wid; row < NT; row += cx.nblk * 8) {
        const bf16_t* pr = p.P + (size_t)row * PLD + ACOLS;
        const uint2 uq = *(const uint2*)(pr + lane * 4); const unsigned ukv = *(const unsigned*)(pr + 256 + lane * 2);
        const float q0 = bflo(uq.x), q1 = bfhi(uq.x), q2 = bflo(uq.y), q3 = bfhi(uq.y), k0 = bflo(ukv), k1 = bfhi(ukv);
        const float sq = wave_sum(q0 * q0 + q1 * q1 + q2 * q2 + q3 * q3), sk = wave_sum(k0 * k0 + k1 * k1);
        const float rq = rsqrtf(sq * (1.f / 256.f) + 1e-6f), rk = rsqrtf(sk * (1.f / 128.f) + 1e-6f);
        const float* gq = p.b_q_norm + j * 256 + lane * 4; const float* gk = p.b_kv_norm + j * 128 + lane * 2;
        uint2 o; o.x = pack2(q0 * rq * gq[0], q1 * rq * gq[1]); o.y = pack2(q2 * rq * gq[2], q3 * rq * gq[3]);
        bf16_t* qn = p.QN + (size_t)row * 512;
        *(uint2*)(qn + lane * 4) = o;
        *(unsigned*)(qn + 256 + lane * 2) = pack2(k0 * rk * gk[0], k1 * rk * gk[1]);
        *(unsigned*)(qn + 384 + lane * 2) = 0u;
    }
}
DI void ph_qkvup(const Ctx& cx, const Params& p, float* lds, int j, int mq) {
    const float* Wq = p.b_w_q_up + (size_t)j * 256 * 768; const float* Wkv = p.b_w_kv_up + (size_t)j * 128 * 1024;
    ngemm<false>(cx, lds, 1, mq, 768, 256,
        [&](int, int m) { return p.QN + (size_t)m * 512; },
        [&](int, int k) { return Wq + (size_t)k * 768; }, [&](int, int) { return (const float*)nullptr; },
        [&](int, int m, int n, float v, float) { p.Qraw[(size_t)m * 768 + n] = f2bf(v); });
    ngemm<false>(cx, lds, 1, NT, 1024, 128,
        [&](int, int m) { return p.QN + (size_t)m * 512 + 256; },
        [&](int, int k) { return Wkv + (size_t)k * 1024; }, [&](int, int) { return (const float*)nullptr; },
        [&](int, int m, int n, float v, float) { p.KVraw[(size_t)m * 1024 + n] = f2bf(v); });
}
DI void unpack8(const uint4 u, float* d) { d[0] = bflo(u.x); d[1] = bfhi(u.x); d[2] = bflo(u.y); d[3] = bfhi(u.y); d[4] = bflo(u.z); d[5] = bfhi(u.z); d[6] = bflo(u.w); d[7] = bfhi(u.w); }
DI uint4 pack8(const float* d, float scl) { uint4 u; u.x = pack2(d[0] * scl, d[1] * scl); u.y = pack2(d[2] * scl, d[3] * scl); u.z = pack2(d[4] * scl, d[5] * scl); u.w = pack2(d[6] * scl, d[7] * scl); return u; }
DI float ssq8(const uint4 u) { float d[8]; unpack8(u, d); float s = 0.f;
#pragma unroll
    for (int i = 0; i < 8; ++i) s += d[i] * d[i];
    return s; }
DI void norm_rope_store(const uint4 (&raw)[12], const float* gain, int t, bool lat, float scl, bf16_t* dst) {
    float ss = 0.f;
#pragma unroll
    for (int i = 0; i < 12; ++i) ss += ssq8(raw[i]);
    const float r = rsqrtf(ss * (1.f / 96.f) + 1e-6f);
#pragma unroll
    for (int i = 0; i < 8; ++i) { float d[8]; unpack8(raw[i], d);
#pragma unroll
        for (int c = 0; c < 8; ++c) d[c] = d[c] * r * gain[i * 8 + c];
        *(uint4*)(dst + i * 8) = pack8(d, scl); }
    const float invf[8] = {1.f, 0.316227766016838f, 0.1f, 0.0316227766016838f, 0.01f, 0.00316227766016838f, 0.001f, 0.000316227766016838f};
    const float ri = (float)(t >> 6), ci = (float)(t & 63);
#pragma unroll
    for (int half = 0; half < 2; ++half) {
        float x1[8], x2[8], o1[8], o2[8]; unpack8(raw[8 + half], x1); unpack8(raw[10 + half], x2);
#pragma unroll
        for (int c = 0; c < 8; ++c) {
            const float ang = (half == 0 ? ri : ci) * invf[c];
            const float cs = lat ? __cosf(ang) : 1.f, sn = lat ? __sinf(ang) : 0.f;
            const float a = x1[c] * r * gain[64 + half * 8 + c], b = x2[c] * r * gain[80 + half * 8 + c];
            o1[c] = a * cs - b * sn; o2[c] = b * cs + a * sn;
        }
        *(uint4*)(dst + 64 + half * 8) = pack8(o1, scl); *(uint4*)(dst + 80 + half * 8) = pack8(o2, scl);
    }
}
DI void ph_finalize(const Ctx& cx, const Params& p, int j, int mq) {
    const int gtid = cx.bid * NTHR + cx.tid, gsz = cx.nblk * NTHR;
    const float* qg = p.b_q_gain + j * 96; const float* kg = p.b_k_gain + j * 96;
    for (int idx = gtid; idx < 8 * mq; idx += gsz) {
        const int h = idx / mq, row = idx % mq;
        const bool lat = row < NLAT; const int t = lat ? (row & 2047) : ((row - NLAT) & 255);
        bf16_t* qp = p.Qraw + (size_t)row * 768 + h * 96;
        uint4 raw[12];
#pragma unroll
        for (int i = 0; i < 12; ++i) raw[i] = *(const uint4*)(qp + i * 8);
        norm_rope_store(raw, qg, t, lat, (OPT >= 5) ? 0.10206207261596577f * 1.4426950408889634f : 0.10206207261596577f, qp);
    }
    for (int idx = gtid; idx < 8 * NT; idx += gsz) {
        const int h = idx / NT, row = idx % NT;
        const bool lat = row < NLAT; const int b = lat ? (row >> 11) : ((row - NLAT) >> 8); const int t = lat ? (row & 2047) : ((row - NLAT) & 255);
        const int key = lat ? 256 + t : t;
        const bf16_t* kvp = p.KVraw + (size_t)row * 1024 + h * 128; const bf16_t* krp = p.P + (size_t)row * PLD + ACOLS + 384;
        uint4 raw[12];
#pragma unroll
        for (int i = 0; i < 8; ++i) raw[i] = *(const uint4*)(kvp + i * 8);
#pragma unroll
        for (int i = 0; i < 4; ++i) raw[8 + i] = *(const uint4*)(krp + i * 8);
        norm_rope_store(raw, kg, t, lat, 1.f, p.Kf + ((size_t)(b * 8 + h) * 2304 + key) * 96);
    }
    for (int idx = gtid; idx < 8 * NT; idx += gsz) {
        const int h = idx / NT, row = idx % NT;
        const bool lat = row < NLAT; const int b = lat ? (row >> 11) : ((row - NLAT) >> 8); const int t = lat ? (row & 2047) : ((row - NLAT) & 255);
        const int key = lat ? 256 + t : t;
        const bf16_t* vp = p.KVraw + (size_t)row * 1024 + h * 128 + 64;
        bf16_t* vo = p.Vt + (size_t)(b * 8 + h) * 64 * 2304 + key;
#pragma unroll 1
        for (int i = 0; i < 8; ++i) { const uint4 u = *(const uint4*)(vp + i * 8);
            vo[0] = (bf16_t)(u.x & 0xffff); vo[2304] = (bf16_t)(u.x >> 16); vo[2 * 2304] = (bf16_t)(u.y & 0xffff); vo[3 * 2304] = (bf16_t)(u.y >> 16);
            vo[4 * 2304] = (bf16_t)(u.z & 0xffff); vo[5 * 2304] = (bf16_t)(u.z >> 16); vo[6 * 2304] = (bf16_t)(u.w & 0xffff); vo[7 * 2304] = (bf16_t)(u.w >> 16);
            vo += 8 * 2304; }
    }
}
DI void ph_attn(const Ctx& cx, const Params& p, bool with_ctx) {
    const int gtid = cx.bid * NTHR + cx.tid, gsz = cx.nblk * NTHR;
    const int total = NLAT * 8 + (with_ctx ? NCTX * 8 : 0);
    for (int idx = gtid; idx < total; idx += gsz) {
        int b, h, row, nkeys;
        if (idx < NLAT * 8) { b = idx >> 14; h = (idx >> 11) & 7; row = b * 2048 + (idx & 2047); nkeys = 2304; }
        else { const int i2 = idx - NLAT * 8; b = i2 >> 11; h = (i2 >> 8) & 7; row = NLAT + b * 256 + (i2 & 255); nkeys = 256; }
        const bf16_t* qp = p.Qraw + (size_t)row * 768 + h * 96;
        const bf16_t* Kb = p.Kf + (size_t)(b * 8 + h) * 2304 * 96; const bf16_t* Vb = p.Vt + (size_t)(b * 8 + h) * 64 * 2304;
        float q[96];
#pragma unroll
        for (int i = 0; i < 12; ++i) { const uint4 u = *(const uint4*)(qp + i * 8); q[i * 8] = bflo(u.x); q[i * 8 + 1] = bfhi(u.x); q[i * 8 + 2] = bflo(u.y); q[i * 8 + 3] = bfhi(u.y);
            q[i * 8 + 4] = bflo(u.z); q[i * 8 + 5] = bfhi(u.z); q[i * 8 + 6] = bflo(u.w); q[i * 8 + 7] = bfhi(u.w); }
        float acc[64];
#pragma unroll
        for (int i = 0; i < 64; ++i) acc[i] = 0.f;
        float mx = -3.0e38f, l = 0.f;
        for (int key0 = 0; key0 < nkeys; key0 += 8) {
            float s[8];
#pragma unroll
            for (int kk = 0; kk < 8; ++kk) {
                const uint4* kp = (const uint4*)(Kb + (size_t)(key0 + kk) * 96); float a = 0.f;
#pragma unroll
                for (int i = 0; i < 12; ++i) { const uint4 u = kp[i]; a += q[i * 8] * bflo(u.x) + q[i * 8 + 1] * bfhi(u.x) + q[i * 8 + 2] * bflo(u.y) + q[i * 8 + 3] * bfhi(u.y)
                    + q[i * 8 + 4] * bflo(u.z) + q[i * 8 + 5] * bfhi(u.z) + q[i * 8 + 6] * bflo(u.w) + q[i * 8 + 7] * bfhi(u.w); }
                s[kk] = a;
            }
            float cm = s[0];
#pragma unroll
            for (int kk = 1; kk < 8; ++kk) cm = fmaxf(cm, s[kk]);
            const float mn = fmaxf(mx, cm), alpha = expf(mx - mn);
            float ps = 0.f;
#pragma unroll
            for (int kk = 0; kk < 8; ++kk) { s[kk] = expf(s[kk] - mn); ps += s[kk]; }
            l = l * alpha + ps; mx = mn;
#pragma unroll
            for (int dv = 0; dv < 64; ++dv) {
                const uint4 u = *(const uint4*)(Vb + (size_t)dv * 2304 + key0);
                acc[dv] = acc[dv] * alpha + s[0] * bflo(u.x) + s[1] * bfhi(u.x) + s[2] * bflo(u.y) + s[3] * bfhi(u.y) + s[4] * bflo(u.z) + s[5] * bfhi(u.z) + s[6] * bflo(u.w) + s[7] * bfhi(u.w);
            }
        }
        const float il = 1.f / l;
        bf16_t* o = p.H + (size_t)row * 1024 + 512 + h * 64;
#pragma unroll
        for (int i = 0; i < 8; ++i) { uint4 u; u.x = pack2(acc[i * 8] * il, acc[i * 8 + 1] * il); u.y = pack2(acc[i * 8 + 2] * il, acc[i * 8 + 3] * il);
            u.z = pack2(acc[i * 8 + 4] * il, acc[i * 8 + 5] * il); u.w = pack2(acc[i * 8 + 6] * il, acc[i * 8 + 7] * il); *(uint4*)(o + i * 8) = u; }
    }
}
DI float shiftp(const bf16_t* P, int row, int t, int T, int col, float mu) {
    const float c = bf2f(P[(size_t)row * PLD + col]);
    const float pv = (t > 0) ? bf2f(P[(size_t)(row - 1) * PLD + col]) : 0.f;
    const float nx = (t < T - 1) ? bf2f(P[(size_t)(row + 1) * PLD + col]) : 0.f;
    return c + mu * (0.5f * (pv + nx) - c);
}
DI void ph_prepLR(const Ctx& cx, const Params& p, int j) {
    const int gtid = cx.bid * NTHR + cx.tid, gsz = cx.nblk * NTHR;
    const float* mu = p.a_mu + j * ACOLS + 1536;
    for (int idx = gtid; idx < NT * 384; idx += gsz) {
        const int row = idx / 384, col = idx % 384;
        const bool lat = row < NLAT; const int t = lat ? (row & 2047) : ((row - NLAT) & 255); const int T = lat ? 2048 : 256;
        float v = shiftp(p.P, row, t, T, 1536 + col, mu[col]);
        if (col < 128) v = tanhf(v); else if (col >= 256) v = sigm(v);
        p.LR[(size_t)row * 384 + col] = f2bf(v);
    }
}
DI void ph_wag(const Ctx& cx, const Params& p, float* lds, int j) {
    for (int d = 0; d < 2; ++d) {
        const float* W2 = p.a_w2 + (size_t)(j * 2 + d) * 64 * 512; const float* w0 = p.a_w0 + (j * 2 + d) * 512;
        ngemm<false>(cx, lds, 1, NT, 512, 64,
            [&](int, int m) { return p.LR + (size_t)m * 384 + d * 64; },
            [&](int, int k) { return W2 + (size_t)k * 512; }, [&](int, int) { return (const float*)nullptr; },
            [&](int, int m, int n, float v, float) { const float z = -0.606531f * sigm(w0[n] + v); p.WAG[(size_t)m * WLD + d * 512 + n] = f2bf(-expm1f(z)); });
        const float* A2 = p.a_a2 + (size_t)(j * 2 + d) * 64 * 512; const float* a0 = p.a_a0 + (j * 2 + d) * 512;
        ngemm<false>(cx, lds, 1, NT, 512, 64,
            [&](int, int m) { return p.LR + (size_t)m * 384 + 128 + d * 64; },
            [&](int, int k) { return A2 + (size_t)k * 512; }, [&](int, int) { return (const float*)nullptr; },
            [&](int, int m, int n, float v, float) { p.WAG[(size_t)m * WLD + 1024 + d * 512 + n] = f2bf(sigm(a0[n] + v)); });
    }
    const float* G2 = p.a_g2 + (size_t)j * 128 * 512;
    ngemm<false>(cx, lds, 1, NT, 512, 128,
        [&](int, int m) { return p.LR + (size_t)m * 384 + 256; },
        [&](int, int k) { return G2 + (size_t)k * 512; }, [&](int, int) { return (const float*)nullptr; },
        [&](int, int m, int n, float v, float) { p.WAG[(size_t)m * WLD + 2048 + n] = f2bf(v); });
}
DI void ph_scan(const Ctx& cx, const Params& p, float* lds, int j) {
    const int tid = cx.tid, lane = tid & 63;
    if (tid < 64) {
        for (int item = cx.bid; item < 256; item += cx.nblk) {
            const int b = item >> 4, h = (item >> 1) & 7, dir = item & 1, hc = h * 64 + lane;
            float S[64];
#pragma unroll
            for (int k = 0; k < 64; ++k) S[k] = 0.f;
            const float kkc = p.a_k_k[j * 512 + hc], kac = p.a_k_a[j * 512 + hc];
            const float mur = p.a_mu[j * ACOLS + hc], muk = p.a_mu[j * ACOLS + 512 + hc], muv = p.a_mu[j * ACOLS + 1024 + hc];
            bf16_t* yout = dir ? p.YB : p.YF;
            for (int step = 0; step < 2304; ++step) {
                const bool cp = step < 256; const int tt = cp ? step : step - 256, T = cp ? 256 : 2048, t = dir ? (T - 1 - tt) : tt;
                const int row = cp ? NLAT + b * 256 + t : b * 2048 + t;
                const float R = shiftp(p.P, row, t, T, hc, mur), K = shiftp(p.P, row, t, T, 512 + hc, muk), V = shiftp(p.P, row, t, T, 1024 + hc, muv);
                const float w = 1.f - bf2f(p.WAG[(size_t)row * WLD + dir * 512 + hc]), a = bf2f(p.WAG[(size_t)row * WLD + 1024 + dir * 512 + hc]);
                const float kkv = K * kkc, ssq = wave_sum(kkv * kkv), kk = kkv * rsqrtf(ssq + 1e-12f);
                const float kd = K * (1.f + (a - 1.f) * kac), bd = kk * a;
                lds[lane] = -kk; lds[64 + lane] = w; lds[128 + lane] = bd; lds[192 + lane] = kd; lds[256 + lane] = R;
                __builtin_amdgcn_wave_barrier();
                float sa = 0.f;
#pragma unroll
                for (int k4 = 0; k4 < 16; ++k4) { const float4 v = *(const float4*)(lds + k4 * 4); sa += S[k4 * 4] * v.x + S[k4 * 4 + 1] * v.y + S[k4 * 4 + 2] * v.z + S[k4 * 4 + 3] * v.w; }
                float y = 0.f;
#pragma unroll
                for (int k4 = 0; k4 < 16; ++k4) {
                    const float4 wv = *(const float4*)(lds + 64 + k4 * 4), bv = *(const float4*)(lds + 128 + k4 * 4), kv = *(const float4*)(lds + 192 + k4 * 4), rv = *(const float4*)(lds + 256 + k4 * 4);
                    S[k4 * 4] = S[k4 * 4] * wv.x + sa * bv.x + V * kv.x; S[k4 * 4 + 1] = S[k4 * 4 + 1] * wv.y + sa * bv.y + V * kv.y;
                    S[k4 * 4 + 2] = S[k4 * 4 + 2] * wv.z + sa * bv.z + V * kv.z; S[k4 * 4 + 3] = S[k4 * 4 + 3] * wv.w + sa * bv.w + V * kv.w;
                    y += S[k4 * 4] * rv.x + S[k4 * 4 + 1] * rv.y + S[k4 * 4 + 2] * rv.z + S[k4 * 4 + 3] * rv.w;
                }
                __builtin_amdgcn_wave_barrier();
                yout[(size_t)row * 512 + hc] = f2bf(y);
            }
        }
    }
    __syncthreads();
}
DI void ph_post(const Ctx& cx, const Params& p, int j, int nrows) {
    const int gtid = cx.bid * NTHR + cx.tid, gsz = cx.nblk * NTHR;
    for (int idx = gtid; idx < 8 * nrows; idx += gsz) {
        const int h = idx / nrows, row = idx % nrows;
        const bool lat = row < NLAT; const int t = lat ? (row & 2047) : ((row - NLAT) & 255); const int T = lat ? 2048 : 256;
        float sum = 0.f, sb = 0.f;
#pragma unroll 8
        for (int n = 0; n < 64; ++n) {
            const int hc = h * 64 + n;
            const float yy = bf2f(p.YF[(size_t)row * 512 + hc]) + bf2f(p.YB[(size_t)row * 512 + hc]);
            sum += yy;
            const float R = shiftp(p.P, row, t, T, hc, p.a_mu[j * ACOLS + hc]), K = shiftp(p.P, row, t, T, 512 + hc, p.a_mu[j * ACOLS + 512 + hc]);
            const float af = bf2f(p.WAG[(size_t)row * WLD + 1024 + hc]), ab = bf2f(p.WAG[(size_t)row * WLD + 1536 + hc]);
            const float ka = p.a_k_a[j * 512 + hc], rk = p.a_r_k[j * 512 + hc];
            sb += R * rk * (K * (1.f + (af - 1.f) * ka) + K * (1.f + (ab - 1.f) * ka));
        }
        const float mean = sum * (1.f / 64.f); float var = 0.f;
#pragma unroll 8
        for (int n = 0; n < 64; ++n) { const int hc = h * 64 + n; const float yy = bf2f(p.YF[(size_t)row * 512 + hc]) + bf2f(p.YB[(size_t)row * 512 + hc]); var += (yy - mean) * (yy - mean); }
        const float rstd = rsqrtf(var * (1.f / 64.f) + 64e-5f);
#pragma unroll 8
        for (int n = 0; n < 64; ++n) {
            const int hc = h * 64 + n;
            const float yy = bf2f(p.YF[(size_t)row * 512 + hc]) + bf2f(p.YB[(size_t)row * 512 + hc]);
            const float V = shiftp(p.P, row, t, T, 1024 + hc, p.a_mu[j * ACOLS + 1024 + hc]);
            const float g = bf2f(p.WAG[(size_t)row * WLD + 2048 + hc]);
            const float o = ((yy - mean) * rstd * p.a_ln_w[j * 512 + hc] + p.a_ln_b[j * 512 + hc] + sb * V) * g;
            p.H[(size_t)row * 1024 + hc] = f2bf(o);
        }
    }
}
DI void ph_wout(const Ctx& cx, const Params& p, float* lds, const bf16_t* A, const float* W, int nrows, const float* xin_lat, const float* xin_ctx, const float* modl) {
    ngemm<false>(cx, lds, 1, nrows, 1024, 1024,
        [&](int, int m) { return A + (size_t)m * 1024; },
        [&](int, int k) { return W + (size_t)k * 1024; }, [&](int, int) { return (const float*)nullptr; },
        [&](int, int m, int n, float v, float) {
            const bool lat = m < NLAT; const int jj = lat ? (m >> 11) : 16; const float g1 = modl[(size_t)jj * 6144 + 2 * 1024 + n];
            if (lat) p.out[(size_t)m * 1024 + n] = xin_lat[(size_t)m * 1024 + n] + g1 * v;
            else p.ctxs[(size_t)(m - NLAT) * 1024 + n] = xin_ctx[(size_t)(m - NLAT) * 1024 + n] + g1 * v; });
}

DI void ph_chdft(const Ctx& cx, const Params& p, float* lds, int nrows) {
    const int tid = cx.tid, gtid = cx.bid * NTHR + tid, gsz = cx.nblk * NTHR;
    for (int i = tid; i < 128; i += NTHR) { lds[i] = cospif((float)i * (1.f / 64.f)); lds[128 + i] = sinpif((float)i * (1.f / 64.f)); }
    __syncthreads();
    for (int idx = gtid; idx < nrows * 1024; idx += gsz) {
        const int row = idx >> 10, col = idx & 1023, grp = col >> 7, g = col & 127;
        const bf16_t* hp = p.H + (size_t)row * 1024 + grp * 128;
        float gr = 0.f, gi = 0.f;
        for (int c = 0; c < 128; ++c) { const float xv = bf2f(hp[c]); const int m = (c * g) & 127; gr += xv * lds[m]; gi -= xv * lds[128 + m]; }
        p.G[(size_t)row * 2048 + col] = gr; p.G[(size_t)row * 2048 + 1024 + col] = gi;
    }
    __syncthreads();
}
DI void ph_posdft(const Ctx& cx, const Params& p, float* lds, bool with_ctx) {
    ngemm<false>(cx, lds, 16, 2048, 1024, 4096,
        [&](int, int m) { return p.dftl + (size_t)m * 4096; },
        [&](int bz, int k) { return (k < 2048) ? p.G + (size_t)(bz * 2048 + k) * 2048 : p.G + (size_t)(bz * 2048 + k - 2048) * 2048 + 1024; }, [&](int, int) { return (const float*)nullptr; },
        [&](int bz, int m, int n, float v, float) { p.F[(size_t)(bz * 2048 + m) * 1024 + n] = f2bf(v * (1.f / 512.f)); });
    if (with_ctx)
        ngemm<false>(cx, lds, 16, 256, 1024, 512,
            [&](int, int m) { return p.dftc + (size_t)m * 512; },
            [&](int bz, int k) { return (k < 256) ? p.G + (size_t)(NLAT + bz * 256 + k) * 2048 : p.G + (size_t)(NLAT + bz * 256 + k - 256) * 2048 + 1024; }, [&](int, int) { return (const float*)nullptr; },
            [&](int bz, int m, int n, float v, float) { p.F[(size_t)(NLAT + bz * 256 + m) * 1024 + n] = f2bf(v * 0.0055242717280199f); });
}

DI void ph_moe_up(const Ctx& cx, const Params& p, float* lds, int layer, int nrows) {
    for (int e = 0; e < 17; ++e) {
        const int M = (e < 16) ? __builtin_amdgcn_readfirstlane(p.cnt[layer * 16 + e]) : nrows;
        const float* Wg = (e < 16) ? p.moe_w_gate + ((size_t)layer * 16 + e) * 1024 * 512 : p.sh_gate + (size_t)layer * 1024 * 512;
        const float* Wu = (e < 16) ? p.moe_w_up + ((size_t)layer * 16 + e) * 1024 * 512 : p.sh_up + (size_t)layer * 1024 * 512;
        const int* sl = p.slot + (size_t)(e & 15) * NT;
        ngemm<true>(cx, lds, 1, M, 512, 1024,
            [&](int, int m) { const int tok = (e < 16) ? (sl[m] >> 1) : m; return p.H + (size_t)tok * 1024; },
            [&](int, int k) { return Wg + (size_t)k * 512; }, [&](int, int k) { return Wu + (size_t)k * 512; },
            [&](int, int m, int n, float g, float u) { const int s = (e < 16) ? sl[m] : 0; const int tok = (e < 16) ? (s >> 1) : m, slab = (e < 16) ? (s & 1) : 2;
                p.ACT[((size_t)slab * NT + tok) * 512 + n] = f2bf(siluf(g) * u); });
    }
}
DI void ph_moe_down(const Ctx& cx, const Params& p, float* lds, int layer, int nrows) {
    for (int e = 0; e < 17; ++e) {
        const int M = (e < 16) ? __builtin_amdgcn_readfirstlane(p.cnt[layer * 16 + e]) : nrows;
        const float* Wd = (e < 16) ? p.moe_w_down + ((size_t)layer * 16 + e) * 512 * 1024 : p.sh_down + (size_t)layer * 512 * 1024;
        const int* sl = p.slot + (size_t)(e & 15) * NT;
        ngemm<false>(cx, lds, 1, M, 1024, 512,
            [&](int, int m) { const int s = (e < 16) ? sl[m] : 0; const int tok = (e < 16) ? (s >> 1) : m, slab = (e < 16) ? (s & 1) : 2; return p.ACT + ((size_t)slab * NT + tok) * 512; },
            [&](int, int k) { return Wd + (size_t)k * 1024; }, [&](int, int) { return (const float*)nullptr; },
            [&](int, int m, int n, float v, float) { const int s = (e < 16) ? sl[m] : 0; const int tok = (e < 16) ? (s >> 1) : m, slab = (e < 16) ? (s & 1) : 2;
                const float w = (e < 16) ? p.tokw[s] : 1.f; p.Y[((size_t)slab * NT + tok) * 1024 + n] = f2bf(w * v); });
    }
}

namespace mm {
typedef short bf16x8 __attribute__((ext_vector_type(8)));
typedef float f32x4 __attribute__((ext_vector_type(4)));
typedef unsigned u32x4 __attribute__((ext_vector_type(4)));
constexpr int BM = 256, BK = 64, HALF = 128, HTB = HALF * BK * 2, STAGE_BYTES = 8 * HTB;
DI int lds_byte(int r, int c) { const int st = (r >> 4) * 2 + (c >> 5), rr = r & 15, cc = c & 31, ob = rr * 64 + cc * 2; return st * 1024 + (ob ^ (((ob >> 9) & 1) << 5)); }
DI void stage_rc(int b, int& R, int& C) { const int st = b / 1024, sb = b % 1024, swz = sb ^ (((sb >> 9) & 1) << 5); R = (st >> 1) * 16 + swz / 64; C = (st & 1) * 32 + (swz % 64) / 2; }
DI int perm32(int rho) { const int n = rho >> 4, i = rho & 15; return 8 * (i >> 2) + 4 * n + (i & 3); }
DI unsigned cvt_pk_bf16(float lo, float hi) { unsigned r; asm volatile("v_cvt_pk_bf16_f32 %0, %1, %2" : "=v"(r) : "v"(lo), "v"(hi)); return r; }
struct Unit { const char* A; const char* B; int pm, pn, e, m; };
template <class Sched, class Epi>
DI void gemm_phase(LAS unsigned char* lds, const int K, const Sched& S, const Epi& E, const int tid) {
    const int wid = __builtin_amdgcn_readfirstlane(tid >> 6), lane = tid & 63, wr = wid >> 2, wc = wid & 3, fr = lane & 15, fq = lane >> 4;
    const int nt = K / BK;
    int R0, C0, R1, C1; stage_rc(tid * 16, R0, C0); stage_rc(tid * 16 + 8192, R1, C1);
    unsigned voffB[2];
    { const int Rb0 = Epi::PERM ? ((R0 & ~31) + perm32(R0 & 31)) : R0, Rb1 = Epi::PERM ? ((R1 & ~31) + perm32(R1 & 31)) : R1;
      voffB[0] = (unsigned)(Rb0 * K + C0) * 2u; voffB[1] = (unsigned)(Rb1 * K + C1) * 2u; }
    const size_t kstep = (size_t)(BK * 2), hstepB = (size_t)HALF * K * 2;
    const unsigned ldsw = (unsigned)wid * 1024u;
    const int aoff = lds_byte(wr * 64 + fr, fq * 8), boff = lds_byte(wc * 32 + fr, fq * 8);
#define MM_SA(b, h) (((b) * 2 + (h)) * HTB)
#define MM_SB(b, h) ((4 + (b) * 2 + (h)) * HTB)
#define MM_STAGE_A(bufoff, gbase, h, offs) do { _Pragma("unroll") for (int _i = 0; _i < 2; ++_i) \
        __builtin_amdgcn_global_load_lds((const unsigned*)((const char*)(gbase) + (offs)[h][_i]), (LAS unsigned*)(lds + (bufoff) + ldsw + _i * 8192), 16, 0, 0); } while (0)
#define MM_STAGE_B(bufoff, gbase) do { _Pragma("unroll") for (int _i = 0; _i < 2; ++_i) \
        __builtin_amdgcn_global_load_lds((const unsigned*)((const char*)(gbase) + voffB[_i]), (LAS unsigned*)(lds + (bufoff) + ldsw + _i * 8192), 16, 0, 0); } while (0)
#define MM_LDA(dst, b, h) do { _Pragma("unroll") for (int m = 0; m < 4; ++m) _Pragma("unroll") for (int k = 0; k < 2; ++k) dst[m][k] = *(const LAS bf16x8*)(lds + MM_SA(b, h) + aoff + m * 2048 + k * 1024); } while (0)
#define MM_LDB(dst, b, h) do { _Pragma("unroll") for (int n = 0; n < 2; ++n) _Pragma("unroll") for (int k = 0; k < 2; ++k) dst[n][k] = *(const LAS bf16x8*)(lds + MM_SB(b, h) + boff + n * 2048 + k * 1024); } while (0)
#define MM_MMA(ai, bj, At, Bt) do { __builtin_amdgcn_s_setprio(1); _Pragma("unroll") for (int m = 0; m < 4; ++m) _Pragma("unroll") for (int n = 0; n < 2; ++n) _Pragma("unroll") for (int k = 0; k < 2; ++k) \
        acc[ai][bj][m][n] = __builtin_amdgcn_mfma_f32_16x16x32_bf16(Bt[n][k], At[m][k], acc[ai][bj][m][n], 0, 0, 0); __builtin_amdgcn_s_setprio(0); } while (0)
#define MM_WAIT_V(n) asm volatile("s_waitcnt vmcnt(" #n ")" ::: "memory")
#define MM_WAIT_L(n) asm volatile("s_waitcnt lgkmcnt(" #n ")" ::: "memory")
#define MM_BAR __builtin_amdgcn_s_barrier()
#define MM_SCHED __builtin_amdgcn_sched_barrier(0)
    Unit cur, nxt; int ui = 0;
    if (!S.next(0, cur)) return;
    unsigned oa[2][2], on[2][2];
    S.aoff(cur, R0, C0, R1, C1, oa);
    f32x4 acc[2][2][4][2];
#pragma unroll
    for (int a = 0; a < 2; ++a)
#pragma unroll
        for (int b = 0; b < 2; ++b)
#pragma unroll
            for (int m = 0; m < 4; ++m)
#pragma unroll
                for (int n = 0; n < 2; ++n) acc[a][b][m][n] = (f32x4){0.f, 0.f, 0.f, 0.f};
    bf16x8 At[4][2], B0[2][2], B1[2][2];
    const char* cA = cur.A; const char* cB = cur.B;
    MM_STAGE_B(MM_SB(0, 0), cB); MM_STAGE_A(MM_SA(0, 0), cA, 0, oa); MM_STAGE_B(MM_SB(0, 1), cB + hstepB); MM_STAGE_A(MM_SA(0, 1), cA, 1, oa);
    if (wr == 1) MM_BAR;
    MM_WAIT_V(4); MM_BAR;
    MM_STAGE_B(MM_SB(1, 0), cB + kstep); MM_STAGE_A(MM_SA(1, 0), cA + kstep, 0, oa); MM_STAGE_B(MM_SB(1, 1), cB + hstepB + kstep);
    MM_WAIT_V(6); MM_BAR;
    for (;;) {
        const bool has_next = S.next(ui + 1, nxt);
        if (has_next) S.aoff(nxt, R0, C0, R1, C1, on);
        else { on[0][0] = oa[0][0]; on[0][1] = oa[0][1]; on[1][0] = oa[1][0]; on[1][1] = oa[1][1]; }
        const char* nA = has_next ? nxt.A : cA; const char* nB = has_next ? nxt.B : cB;
        for (int t = 0; t < nt; t += 2) {
            const bool last = (t == nt - 2);
            const char* a1 = cA + (size_t)(t + 1) * kstep;
            const char* a2 = last ? nA : cA + (size_t)(t + 2) * kstep; const char* b2 = last ? nB : cB + (size_t)(t + 2) * kstep;
            const char* a3 = a2 + kstep; const char* b3 = b2 + kstep;
            unsigned o2[2][2];
            o2[0][0] = last ? on[0][0] : oa[0][0]; o2[0][1] = last ? on[0][1] : oa[0][1]; o2[1][0] = last ? on[1][0] : oa[1][0]; o2[1][1] = last ? on[1][1] : oa[1][1];
            MM_LDB(B0, 0, 0); MM_SCHED; MM_LDA(At, 0, 0); MM_STAGE_A(MM_SA(1, 1), a1, 1, oa);
            MM_WAIT_L(8); MM_BAR; MM_WAIT_L(0); MM_MMA(0, 0, At, B0); MM_BAR; MM_SCHED;
            MM_LDB(B1, 0, 1); MM_STAGE_B(MM_SB(0, 0), b2);
            MM_BAR; MM_WAIT_L(0); MM_MMA(0, 1, At, B1); MM_BAR;
            MM_LDA(At, 0, 1); MM_STAGE_A(MM_SA(0, 0), a2, 0, o2);
            MM_BAR; MM_WAIT_L(0); MM_MMA(1, 0, At, B0); MM_BAR; MM_SCHED;
            MM_STAGE_B(MM_SB(0, 1), b2 + hstepB);
            MM_WAIT_V(6); MM_BAR; MM_MMA(1, 1, At, B1); MM_BAR;
            MM_LDB(B0, 1, 0); MM_SCHED; MM_LDA(At, 1, 0); MM_STAGE_A(MM_SA(0, 1), a2, 1, o2);
            MM_WAIT_L(8); MM_BAR; MM_WAIT_L(0); MM_MMA(0, 0, At, B0); MM_BAR; MM_SCHED;
            MM_LDB(B1, 1, 1); MM_STAGE_B(MM_SB(1, 0), b3);
            MM_BAR; MM_WAIT_L(0); MM_MMA(0, 1, At, B1); MM_BAR;
            MM_LDA(At, 1, 1); MM_STAGE_A(MM_SA(1, 0), a3, 0, o2);
            MM_BAR; MM_WAIT_L(0); MM_MMA(1, 0, At, B0); MM_BAR; MM_SCHED;
            MM_STAGE_B(MM_SB(1, 1), b3 + hstepB);
            MM_WAIT_V(6); MM_BAR; MM_MMA(1, 1, At, B1); MM_BAR;
        }
        E(acc, cur, wr, wc, fr, fq);
        if (!has_next) break;
#pragma unroll
        for (int a = 0; a < 2; ++a)
#pragma unroll
            for (int b = 0; b < 2; ++b)
#pragma unroll
                for (int m = 0; m < 4; ++m)
#pragma unroll
                    for (int n = 0; n < 2; ++n) acc[a][b][m][n] = (f32x4){0.f, 0.f, 0.f, 0.f};
        cur = nxt; cA = nA; cB = nB; ++ui;
        oa[0][0] = on[0][0]; oa[0][1] = on[0][1]; oa[1][0] = on[1][0]; oa[1][1] = on[1][1];
    }
    MM_WAIT_V(0);
    if (wr == 0) MM_BAR;
    MM_BAR;
#undef MM_SA
#undef MM_SB
#undef MM_STAGE_A
#undef MM_STAGE_B
#undef MM_LDA
#undef MM_LDB
#undef MM_MMA
#undef MM_WAIT_V
#undef MM_WAIT_L
#undef MM_BAR
#undef MM_SCHED
}
struct StaticSched {
    const char* A; const char* Bt; int lda, K, nM, nN, nwg, G, c;
    DI void init(const void* A_, const void* Bt_, int M, int N, int K_, int lda_, int G_, int c_) { A = (const char*)A_; Bt = (const char*)Bt_; lda = lda_; K = K_; nM = M / BM; nN = N / BM; nwg = nM * nN; G = G_; c = c_; }
    DI bool next(int i, Unit& u) const {
        const int L = i * G + c; if (L >= nwg) return false;
        int wgid = L; { const int q = nwg / 8, r = nwg % 8, xcd = wgid % 8, off = wgid / 8; wgid = (xcd < r ? xcd * (q + 1) : r * (q + 1) + (xcd - r) * q) + off; }
        const int nig = 8 * nN, gid = wgid / nig, fm = gid * 8, gsz = (nM - fm) < 8 ? (nM - fm) : 8;
        u.pm = fm + ((wgid % nig) % gsz); u.pn = (wgid % nig) / gsz; u.e = 0; u.m = 0;
        u.A = A + (size_t)u.pm * BM * lda * 2; u.B = Bt + (size_t)u.pn * BM * K * 2; return true;
    }
    DI void aoff(const Unit&, int R0, int C0, int R1, int C1, unsigned (&o)[2][2]) const {
        o[0][0] = (unsigned)(R0 * lda + C0) * 2u; o[0][1] = (unsigned)(R1 * lda + C1) * 2u;
        o[1][0] = (unsigned)((HALF + R0) * lda + C0) * 2u; o[1][1] = (unsigned)((HALF + R1) * lda + C1) * 2u;
    }
};
struct BatchSched {
    const char* A; const char* Bt; int K, nM, nN, nb, G, c; size_t bstride;
    DI void init(const void* A_, const void* Bt_, size_t bstride_bytes, int nb_, int M, int N, int K_, int G_, int c_) { A = (const char*)A_; Bt = (const char*)Bt_; bstride = bstride_bytes; nb = nb_; K = K_; nM = M / BM; nN = N / BM; G = G_; c = c_; }
    DI bool next(int i, Unit& u) const {
        const int L = i * G + c; if (L >= nb * nM * nN) return false;
        const int b = L / (nM * nN), rem = L % (nM * nN); u.pm = rem / nN; u.pn = rem % nN; u.e = b; u.m = 0;
        u.A = A + (size_t)u.pm * BM * K * 2; u.B = Bt + (size_t)b * bstride + (size_t)u.pn * BM * K * 2; return true;
    }
    DI void aoff(const Unit&, int R0, int C0, int R1, int C1, unsigned (&o)[2][2]) const {
        o[0][0] = (unsigned)(R0 * K + C0) * 2u; o[0][1] = (unsigned)(R1 * K + C1) * 2u;
        o[1][0] = (unsigned)((HALF + R0) * K + C0) * 2u; o[1][1] = (unsigned)((HALF + R1) * K + C1) * 2u;
    }
};
struct EpiBf16Store {
    static constexpr bool PERM = true;
    bf16_t* O; int ldc;
    DI void operator()(const f32x4 (&acc)[2][2][4][2], const Unit& u, int wr, int wc, int fr, int fq) const {
        const int row0 = u.pm * BM + wr * 64 + fr, col0 = u.pn * BM + wc * 32 + 8 * fq;
#pragma unroll
        for (int ai = 0; ai < 2; ++ai)
#pragma unroll
            for (int m = 0; m < 4; ++m) { bf16_t* rowp = O + (size_t)(row0 + ai * HALF + m * 16) * ldc + col0;
#pragma unroll
                for (int bj = 0; bj < 2; ++bj) { const f32x4 v0 = acc[ai][bj][m][0], v1 = acc[ai][bj][m][1];
                    u32x4 w; w.x = cvt_pk_bf16(v0[0], v0[1]); w.y = cvt_pk_bf16(v0[2], v0[3]); w.z = cvt_pk_bf16(v1[0], v1[1]); w.w = cvt_pk_bf16(v1[2], v1[3]);
                    *(u32x4*)(rowp + bj * HALF) = w; } }
    }
};
struct EpiResid {
    static constexpr bool PERM = false;
    const float* xin_lat; const float* xin_ctx; float* out_lat; float* out_ctx; const float* modl; int batched_T;
    DI void operator()(const f32x4 (&acc)[2][2][4][2], const Unit& u, int wr, int wc, int fr, int fq) const {
        int grow0; if (batched_T == 0) grow0 = u.pm * BM; else if (batched_T > 0) grow0 = u.e * 2048 + u.pm * BM; else grow0 = NLAT + u.e * 256 + u.pm * BM;
        const bool lat = grow0 < NLAT; const int jj = lat ? (grow0 >> 11) : 16;
        const float* xi = lat ? xin_lat + (size_t)grow0 * 1024 : xin_ctx + (size_t)(grow0 - NLAT) * 1024;
        float* xo = lat ? out_lat + (size_t)grow0 * 1024 : out_ctx + (size_t)(grow0 - NLAT) * 1024;
        const float* g1 = modl + (size_t)jj * 6144 + 2 * 1024;
        const int r0 = wr * 64 + fr, col0 = u.pn * BM + wc * 32 + 4 * fq;
        f32x4 gv[2][2];
#pragma unroll
        for (int bj = 0; bj < 2; ++bj)
#pragma unroll
            for (int n = 0; n < 2; ++n) gv[bj][n] = *(const f32x4*)(g1 + col0 + bj * HALF + n * 16);
#pragma unroll
        for (int ai = 0; ai < 2; ++ai)
#pragma unroll
            for (int m = 0; m < 4; ++m) { const size_t off = (size_t)(r0 + ai * HALF + m * 16) * 1024 + col0;
#pragma unroll
                for (int bj = 0; bj < 2; ++bj)
#pragma unroll
                    for (int n = 0; n < 2; ++n) { const f32x4 xv = *(const f32x4*)(xi + off + bj * HALF + n * 16); *(f32x4*)(xo + off + bj * HALF + n * 16) = xv + gv[bj][n] * acc[ai][bj][m][n]; }
                asm volatile("" ::: "memory"); }
    }
};
}

DI void tconv_tile(const Ctx& cx, float* T, const float* src, int ld_src, int k0, int n0, int kvalid, int nvalid, bf16_t* dst, int ldd, int drow0) {
    const int tid = cx.tid;
#pragma unroll
    for (int rr = 0; rr < 2; ++rr) {
        const int i = (tid >> 4) + 32 * rr, j = (tid & 15) * 4;
        float4 v = make_float4(0.f, 0.f, 0.f, 0.f);
        if (k0 + i < kvalid && n0 + j < nvalid) v = *(const float4*)(src + (size_t)(k0 + i) * ld_src + n0 + j);
        T[i * 65 + j] = v.x; T[i * 65 + j + 1] = v.y; T[i * 65 + j + 2] = v.z; T[i * 65 + j + 3] = v.w;
    }
    __syncthreads();
    { const int j = tid >> 3, ch = tid & 7; uint4 o;
      o.x = pack2(T[(ch * 8 + 0) * 65 + j], T[(ch * 8 + 1) * 65 + j]); o.y = pack2(T[(ch * 8 + 2) * 65 + j], T[(ch * 8 + 3) * 65 + j]);
      o.z = pack2(T[(ch * 8 + 4) * 65 + j], T[(ch * 8 + 5) * 65 + j]); o.w = pack2(T[(ch * 8 + 6) * 65 + j], T[(ch * 8 + 7) * 65 + j]);
      *(uint4*)(dst + (size_t)(drow0 + j) * ldd + k0 + ch * 8) = o; }
    __syncthreads();
}
DI void ph_prep_weights(const Ctx& cx, const Params& p, float* lds) {
    const int tid = cx.tid, gtid = cx.bid * NTHR + tid, gsz = cx.nblk * NTHR;
    for (int it = cx.bid; it < 2 * 1008; it += cx.nblk) {
        const int j = it / 1008; int r = it % 1008;
        if (r < 640) { const int kt = r / 40, ntl = r % 40; tconv_tile(cx, lds, p.w_in + (size_t)j * 1024 * INC, INC, kt * 64, ntl * 64, 1024, INC, p.WinT + (size_t)j * 2560 * 1024, 1024, ntl * 64); continue; } r -= 640;
        if (r < 48) { const int kt = r / 12, ntl = r % 12; tconv_tile(cx, lds, p.b_w_q_up + (size_t)j * 256 * 768, 768, kt * 64, ntl * 64, 256, 768, p.WqT + (size_t)j * 768 * 256, 256, ntl * 64); continue; } r -= 48;
        if (r < 64) { const int kt = r / 16, ntl = r % 16; tconv_tile(cx, lds, p.b_w_kv_up + (size_t)j * 128 * 1024, 1024, kt * 64, ntl * 64, 128, 1024, p.WkvT + (size_t)j * 1024 * 256, 256, ntl * 64); continue; } r -= 64;
        { const int kt = r / 16, ntl = r % 16; tconv_tile(cx, lds, p.w_out_even + (size_t)j * 1024 * 1024, 1024, kt * 64, ntl * 64, 1024, 1024, p.WoutT + (size_t)j * 1024 * 1024, 1024, ntl * 64); }
    }
    for (int idx = gtid; idx < 2 * 2560 * 384; idx += gsz) {
        const int j = idx / (2560 * 384), rem = idx % (2560 * 384), n = rem / 384, k = rem % 384; const int seg = n >> 9, nn = n & 511;
        float v = 0.f;
        if (seg < 2) { if ((k >> 6) == seg) v = p.a_w2[((size_t)(j * 2 + seg) * 64 + (k & 63)) * 512 + nn]; }
        else if (seg < 4) { if ((k >> 6) == seg) v = p.a_a2[((size_t)(j * 2 + seg - 2) * 64 + (k & 63)) * 512 + nn]; }
        else { if (k >= 256) v = p.a_g2[((size_t)j * 128 + (k - 256)) * 512 + nn]; }
        p.WlrT[idx] = f2bf(v);
    }
    {
        float* Tc = lds; float* Ts = lds + 64 * 65; float* tab = lds + 2 * 64 * 65;
        for (int i = tid; i < 128; i += NTHR) { tab[i] = cospif((float)i * (1.f / 64.f)); tab[128 + i] = sinpif((float)i * (1.f / 64.f)); }
        __syncthreads();
        for (int it = cx.bid; it < 2 * 256; it += cx.nblk) {
            const int j = it >> 8, ct = (it >> 4) & 15, et = it & 15; const float* Wf = p.w_out_fourier + (size_t)j * 1024 * 1024;
            const int el = tid & 63, e = et * 64 + el;
#pragma unroll 1
            for (int i = 0; i < 8; ++i) {
                const int chl = (tid >> 6) + 8 * i, ch = ct * 64 + chl, grp = ch >> 7, c = ch & 127;
                float sc = 0.f, ss = 0.f;
                for (int g = 0; g < 128; ++g) { const float w = Wf[(size_t)(grp * 128 + g) * 1024 + e]; const int m = (c * g) & 127; sc += tab[m] * w; ss += tab[128 + m] * w; }
                Tc[chl * 65 + el] = sc; Ts[chl * 65 + el] = ss;
            }
            __syncthreads();
            { const int el2 = tid >> 3, chunk = tid & 7; uint4 o, o2; const float* a = Tc + chunk * 8 * 65 + el2; const float* b = Ts + chunk * 8 * 65 + el2;
              o.x = pack2(a[0], a[65]); o.y = pack2(a[2 * 65], a[3 * 65]); o.z = pack2(a[4 * 65], a[5 * 65]); o.w = pack2(a[6 * 65], a[7 * 65]);
              o2.x = pack2(b[0], b[65]); o2.y = pack2(b[2 * 65], b[3 * 65]); o2.z = pack2(b[4 * 65], b[5 * 65]); o2.w = pack2(b[6 * 65], b[7 * 65]);
              bf16_t* d = p.A1 + (size_t)j * 2048 * 1024 + (size_t)(et * 64 + el2) * 1024 + ct * 64 + chunk * 8;
              *(uint4*)d = o; *(uint4*)(d + (size_t)1024 * 1024) = o2; }
            __syncthreads();
        }
    }
    for (int i = gtid; i < 2048 * 4096; i += gsz) {
        const int f = i >> 12, k = i & 4095, t = k & 2047, m = (f * t) & 2047; const float a = (float)m * (1.f / 1024.f);
        p.A2[i] = f2bf(((k < 2048) ? cospif(a) : -sinpif(a)) * (1.f / 512.f));
    }
    for (int i = gtid; i < 256 * 512; i += gsz) {
        const int f = i >> 9, k = i & 511, t = k & 255, m = (f * t) & 255; const float a = (float)m * (1.f / 128.f);
        p.A2c[i] = f2bf(((k < 256) ? cospif(a) : -sinpif(a)) * 0.0055242717280199f);
    }
    __syncthreads();
}
DI void ph_prep_moe(const Ctx& cx, const Params& p, float* lds, int layer) {
    for (int it = cx.bid; it < 17 * 384; it += cx.nblk) {
        const int e = it / 384; int r = it % 384;
        const float* Wg = (e < 16) ? p.moe_w_gate + ((size_t)layer * 16 + e) * 1024 * 512 : p.sh_gate + (size_t)layer * 1024 * 512;
        const float* Wu = (e < 16) ? p.moe_w_up + ((size_t)layer * 16 + e) * 1024 * 512 : p.sh_up + (size_t)layer * 1024 * 512;
        const float* Wd = (e < 16) ? p.moe_w_down + ((size_t)layer * 16 + e) * 512 * 1024 : p.sh_down + (size_t)layer * 512 * 1024;
        if (r < 256) { const int bj = r >> 7, kt = (r >> 3) & 15, ntl = r & 7, n0 = ntl * 64;
            tconv_tile(cx, lds, bj ? Wu : Wg, 512, kt * 64, n0, 1024, 512, p.WguT + (size_t)e * 1024 * 1024, 1024, (n0 >> 7) * 256 + bj * 128 + (n0 & 127)); }
        else { r -= 256; const int kt = r >> 4, ntl = r & 15; tconv_tile(cx, lds, Wd, 1024, kt * 64, ntl * 64, 512, 1024, p.WdT + (size_t)e * 1024 * 512, 512, ntl * 64); }
    }
}

#define GEMM_LDS(lds) ((LAS unsigned char*)(lds))
DI void ph_win_mm(const Ctx& cx, const Params& p, float* lds, int j) {
    mm::StaticSched S; S.init(p.H, p.WinT + (size_t)j * 2560 * 1024, NT, 2560, 1024, 1024, cx.nblk, cx.bid);
    mm::EpiBf16Store E{p.P, PLD};
    mm::gemm_phase(GEMM_LDS(lds), 1024, S, E, cx.tid);
}
DI void ph_wout_mm(const Ctx& cx, const Params& p, float* lds, const bf16_t* A, const bf16_t* Bt, int nrows, const float* xin_lat, const float* xin_ctx, const float* modl) {
    mm::StaticSched S; S.init(A, Bt, nrows, 1024, 1024, 1024, cx.nblk, cx.bid);
    mm::EpiResid E{xin_lat, xin_ctx, p.out, p.ctxs, modl, 0};
    mm::gemm_phase(GEMM_LDS(lds), 1024, S, E, cx.tid);
}

DI void ph_qkvup_mm(const Ctx& cx, const Params& p, float* lds, int j, int mq) {
    { mm::StaticSched S; S.init(p.QN, p.WqT + (size_t)j * 768 * 256, mq, 768, 256, 512, cx.nblk, cx.bid); mm::EpiBf16Store E{p.Qraw, 768}; mm::gemm_phase(GEMM_LDS(lds), 256, S, E, cx.tid); }
    { mm::StaticSched S; S.init(p.QN + 256, p.WkvT + (size_t)j * 1024 * 256, NT, 1024, 256, 512, cx.nblk, cx.bid); mm::EpiBf16Store E{p.KVraw, 1024}; mm::gemm_phase(GEMM_LDS(lds), 256, S, E, cx.tid); }
}
struct EpiWag {
    static constexpr bool PERM = true;
    bf16_t* O; const float* w0; const float* a0;
    DI void operator()(const mm::f32x4 (&acc)[2][2][4][2], const mm::Unit& u, int wr, int wc, int fr, int fq) const {
        const int row0 = u.pm * 256 + wr * 64 + fr, col0 = u.pn * 256 + wc * 32 + 8 * fq; const int seg = u.pn >> 2;
        const float* bp = (seg == 0) ? w0 + col0 : a0 + (col0 - 1024);
#pragma unroll
        for (int bj = 0; bj < 2; ++bj) {
            mm::f32x4 b0 = (mm::f32x4){0.f, 0.f, 0.f, 0.f}, b1 = b0;
            if (seg < 2) { b0 = *(const mm::f32x4*)(bp + bj * 128); b1 = *(const mm::f32x4*)(bp + bj * 128 + 4); }
#pragma unroll
            for (int ai = 0; ai < 2; ++ai)
#pragma unroll
                for (int m = 0; m < 4; ++m) {
                    mm::f32x4 v0 = acc[ai][bj][m][0] + b0, v1 = acc[ai][bj][m][1] + b1;
                    if (seg == 0) {
#pragma unroll
                        for (int c = 0; c < 4; ++c) { v0[c] = 1.f - __expf(-0.606531f * __builtin_amdgcn_rcpf(1.f + __expf(-v0[c]))); v1[c] = 1.f - __expf(-0.606531f * __builtin_amdgcn_rcpf(1.f + __expf(-v1[c]))); }
                    } else if (seg == 1) {
#pragma unroll
                        for (int c = 0; c < 4; ++c) { v0[c] = __builtin_amdgcn_rcpf(1.f + __expf(-v0[c])); v1[c] = __builtin_amdgcn_rcpf(1.f + __expf(-v1[c])); }
                    }
                    mm::u32x4 w; w.x = mm::cvt_pk_bf16(v0[0], v0[1]); w.y = mm::cvt_pk_bf16(v0[2], v0[3]); w.z = mm::cvt_pk_bf16(v1[0], v1[1]); w.w = mm::cvt_pk_bf16(v1[2], v1[3]);
                    *(mm::u32x4*)(O + (size_t)(row0 + ai * 128 + m * 16) * WLD + col0 + bj * 128) = w;
                }
        }
    }
};
DI void ph_wag_mm(const Ctx& cx, const Params& p, float* lds, int j) {
    mm::StaticSched S; S.init(p.LR, p.WlrT + (size_t)j * 2560 * 384, NT, 2560, 384, 384, cx.nblk, cx.bid);
    EpiWag E{p.WAG, p.a_w0 + j * 1024, p.a_a0 + j * 1024};
    mm::gemm_phase(GEMM_LDS(lds), 384, S, E, cx.tid);
}
struct EpiZT {
    static constexpr bool PERM = true;
    bf16_t* Z; int T;
    DI void operator()(const mm::f32x4 (&acc)[2][2][4][2], const mm::Unit& u, int wr, int wc, int fr, int fq) const {
        const int b = (T == 2048) ? (u.pn >> 3) : u.pn, t0 = (T == 2048) ? ((u.pn & 7) * 256) : 0;
        const int m0 = u.pm * 256 + wr * 64 + fr; const int c0 = t0 + wc * 32 + 8 * fq;
#pragma unroll
        for (int ai = 0; ai < 2; ++ai)
#pragma unroll
            for (int m = 0; m < 4; ++m) { const int mr = m0 + ai * 128 + m * 16, part = mr >> 10, ch = mr & 1023;
                bf16_t* rowp = Z + ((size_t)(b * 1024 + ch) * 2 + part) * T + c0;
#pragma unroll
                for (int bj = 0; bj < 2; ++bj) { const mm::f32x4 v0 = acc[ai][bj][m][0], v1 = acc[ai][bj][m][1];
                    mm::u32x4 w; w.x = mm::cvt_pk_bf16(v0[0], v0[1]); w.y = mm::cvt_pk_bf16(v0[2], v0[3]); w.z = mm::cvt_pk_bf16(v1[0], v1[1]); w.w = mm::cvt_pk_bf16(v1[2], v1[3]);
                    *(mm::u32x4*)(rowp + bj * 128) = w; } }
    }
};
DI void ph_f1_mm(const Ctx& cx, const Params& p, float* lds, int j, bool with_ctx) {
    { mm::StaticSched S; S.init(p.A1 + (size_t)j * 2048 * 1024, p.H, 2048, NLAT, 1024, 1024, cx.nblk, cx.bid); EpiZT E{p.ZT, 2048}; mm::gemm_phase(GEMM_LDS(lds), 1024, S, E, cx.tid); }
    if (with_ctx) { mm::StaticSched S; S.init(p.A1 + (size_t)j * 2048 * 1024, p.H + (size_t)NLAT * 1024, 2048, NCTX, 1024, 1024, cx.nblk, cx.bid); EpiZT E{p.ZTC, 256}; mm::gemm_phase(GEMM_LDS(lds), 1024, S, E, cx.tid); }
}
DI void ph_f2_mm(const Ctx& cx, const Params& p, float* lds, bool with_ctx, const float* xin_lat, const float* xin_ctx, const float* modl) {
    { mm::BatchSched S; S.init(p.A2, p.ZT, (size_t)1024 * 4096 * 2, 16, 2048, 1024, 4096, cx.nblk, cx.bid); mm::EpiResid E{xin_lat, xin_ctx, p.out, p.ctxs, modl, 1}; mm::gemm_phase(GEMM_LDS(lds), 4096, S, E, cx.tid); }
    if (with_ctx) { mm::BatchSched S; S.init(p.A2c, p.ZTC, (size_t)1024 * 512 * 2, 16, 256, 1024, 512, cx.nblk, cx.bid); mm::EpiResid E{xin_lat, xin_ctx, p.out, p.ctxs, modl, -1}; mm::gemm_phase(GEMM_LDS(lds), 512, S, E, cx.tid); }
}
struct MoeSched {
    const char* A; const char* Bt; const int* slot; const int* tab; int lda, K, G, c, down;
    DI bool next(int i, mm::Unit& u) const {
        const int L = i * G + c; const int total = __builtin_amdgcn_readfirstlane(tab[17]);
        if (L >= total * 4) return false;
        const int rtg = L >> 2; int e = 0;
        for (int q = 1; q < 17; ++q) e += (__builtin_amdgcn_readfirstlane(tab[q]) <= rtg) ? 1 : 0;
        u.e = e; u.m = rtg - __builtin_amdgcn_readfirstlane(tab[e]); u.pm = u.m; u.pn = L & 3;
        u.A = A; u.B = Bt + ((size_t)e * 1024 + (size_t)u.pn * 256) * K * 2; return true;
    }
    DI unsigned rowoff(const mm::Unit& u, int Me, int idx, int C) const {
        int row;
        if (u.e < 16) { const int s = (idx < Me) ? slot[(size_t)u.e * NT + idx] : 0; row = down ? ((s & 1) * NT + (s >> 1)) : (s >> 1); }
        else row = down ? (2 * NT + idx) : idx;
        return (unsigned)(row * lda + C) * 2u;
    }
    DI void aoff(const mm::Unit& u, int R0, int C0, int R1, int C1, unsigned (&o)[2][2]) const {
        const int Me = __builtin_amdgcn_readfirstlane(tab[32 + u.e]), base = u.m * 256;
        o[0][0] = rowoff(u, Me, base + R0, C0); o[0][1] = rowoff(u, Me, base + R1, C1);
        o[1][0] = rowoff(u, Me, base + 128 + R0, C0); o[1][1] = rowoff(u, Me, base + 128 + R1, C1);
    }
};
DI void moe_table(const Ctx& cx, const Params& p, int* tab, int layer, int nrows) {
    if (cx.tid == 0) { int acc = 0;
        for (int e = 0; e < 17; ++e) { const int M = (e < 16) ? p.cnt[layer * 16 + e] : nrows; tab[e] = acc; tab[32 + e] = M; acc += (M + 255) >> 8; }
        tab[17] = acc; }
    __syncthreads();
}
struct EpiSwiglu {
    static constexpr bool PERM = true;
    bf16_t* ACT; const int* slot; const int* tab;
    DI void operator()(const mm::f32x4 (&acc)[2][2][4][2], const mm::Unit& u, int wr, int wc, int fr, int fq) const {
        const int Me = __builtin_amdgcn_readfirstlane(tab[32 + u.e]); const int col = u.pn * 128 + wc * 32 + 8 * fq;
#pragma unroll
        for (int ai = 0; ai < 2; ++ai)
#pragma unroll
            for (int m = 0; m < 4; ++m) {
                const int idx = u.m * 256 + ai * 128 + wr * 64 + m * 16 + fr;
                if (idx < Me) {
                    int drow; if (u.e < 16) { const int s = slot[(size_t)u.e * NT + idx]; drow = (s & 1) * NT + (s >> 1); } else drow = 2 * NT + idx;
                    float o[8];
#pragma unroll
                    for (int n = 0; n < 2; ++n)
#pragma unroll
                        for (int c = 0; c < 4; ++c) { const float g = acc[ai][0][m][n][c], uu = acc[ai][1][m][n][c]; o[n * 4 + c] = g * __builtin_amdgcn_rcpf(1.f + __expf(-g)) * uu; }
                    mm::u32x4 w; w.x = mm::cvt_pk_bf16(o[0], o[1]); w.y = mm::cvt_pk_bf16(o[2], o[3]); w.z = mm::cvt_pk_bf16(o[4], o[5]); w.w = mm::cvt_pk_bf16(o[6], o[7]);
                    *(mm::u32x4*)(ACT + (size_t)drow * 512 + col) = w;
                }
            }
    }
};
struct EpiDown {
    static constexpr bool PERM = true;
    bf16_t* Y; const int* slot; const float* tokw; const int* tab;
    DI void operator()(const mm::f32x4 (&acc)[2][2][4][2], const mm::Unit& u, int wr, int wc, int fr, int fq) const {
        const int Me = __builtin_amdgcn_readfirstlane(tab[32 + u.e]); const int col = u.pn * 256 + wc * 32 + 8 * fq;
#pragma unroll
        for (int ai = 0; ai < 2; ++ai)
#pragma unroll
            for (int m = 0; m < 4; ++m) {
                const int idx = u.m * 256 + ai * 128 + wr * 64 + m * 16 + fr;
                if (idx < Me) {
                    int drow; float w = 1.f;
                    if (u.e < 16) { const int s = slot[(size_t)u.e * NT + idx]; drow = (s & 1) * NT + (s >> 1); w = tokw[s]; } else drow = 2 * NT + idx;
#pragma unroll
                    for (int bj = 0; bj < 2; ++bj) { const mm::f32x4 v0 = acc[ai][bj][m][0] * w, v1 = acc[ai][bj][m][1] * w;
                        mm::u32x4 o; o.x = mm::cvt_pk_bf16(v0[0], v0[1]); o.y = mm::cvt_pk_bf16(v0[2], v0[3]); o.z = mm::cvt_pk_bf16(v1[0], v1[1]); o.w = mm::cvt_pk_bf16(v1[2], v1[3]);
                        *(mm::u32x4*)(Y + (size_t)drow * 1024 + col + bj * 128) = o; }
                }
            }
    }
};
DI void ph_moe_up_mm(const Ctx& cx, const Params& p, float* lds, int layer, int nrows) {
    int* tab = (int*)(lds + 32768); moe_table(cx, p, tab, layer, nrows);
    MoeSched S{(const char*)p.H, (const char*)p.WguT, p.slot, tab, 1024, 1024, cx.nblk, cx.bid, 0};
    EpiSwiglu E{p.ACT, p.slot, tab};
    mm::gemm_phase(GEMM_LDS(lds), 1024, S, E, cx.tid);
}
DI void ph_moe_down_mm(const Ctx& cx, const Params& p, float* lds, int layer, int nrows) {
    int* tab = (int*)(lds + 32768); moe_table(cx, p, tab, layer, nrows);
    MoeSched S{(const char*)p.ACT, (const char*)p.WdT, p.slot, tab, 512, 512, cx.nblk, cx.bid, 1};
    EpiDown E{p.Y, p.slot, p.tokw, tab};
    mm::gemm_phase(GEMM_LDS(lds), 512, S, E, cx.tid);
}

namespace att {
typedef short bf16x8 __attribute__((ext_vector_type(8)));
typedef float f32x16 __attribute__((ext_vector_type(16)));
typedef unsigned u32x4 __attribute__((ext_vector_type(4)));
typedef unsigned u32x2 __attribute__((ext_vector_type(2)));
typedef __bf16 bf16x2_t __attribute__((ext_vector_type(2)));
typedef float f32x2_t __attribute__((ext_vector_type(2)));
constexpr int KP = 208, VP = 264, KT_BYTES = 128 * KP, VT_BYTES = 64 * VP, BUF = KT_BYTES + VT_BYTES;
DI unsigned pk(float a, float b) { f32x2_t f = {a, b}; bf16x2_t h = __builtin_convertvector(f, bf16x2_t); return __builtin_bit_cast(unsigned, h); }
#define ATT_MFMA(a, b, c) __builtin_amdgcn_mfma_f32_32x32x16_bf16((a), (b), (c), 0, 0, 0)
}
DI void ph_attn_mm(const Ctx& cx, const Params& p, float* ldsf, bool with_ctx) {
    using namespace att;
    LAS unsigned char* lds = (LAS unsigned char*)ldsf;
    const int tid = cx.tid, wid = __builtin_amdgcn_readfirstlane(tid >> 6), lane = tid & 63, r = lane & 31, hh = lane >> 5;
    const int nunits = 1024 + (with_ctx ? 128 : 0);
    int kg[3], kl[3], vg[2], vl[2];
#pragma unroll
    for (int i = 0; i < 3; ++i) { const int c = tid + 512 * i, row = c / 12, part = c % 12; kg[i] = row * 96 + part * 8; kl[i] = row * KP + part * 16; }
#pragma unroll
    for (int i = 0; i < 2; ++i) { const int c = tid + 512 * i, row = c >> 4, part = c & 15; vg[i] = row * 2304 + part * 8; vl[i] = KT_BYTES + row * VP + part * 16; }
    for (int u = cx.bid; u < nunits; u += cx.nblk) {
        int bh, qrow0, nkeys;
        if (u < 1024) { bh = u >> 3; qrow0 = (bh >> 3) * 2048 + (u & 7) * 256; nkeys = 2304; }
        else { bh = u - 1024; qrow0 = NLAT + (bh >> 3) * 256; nkeys = 256; }
        const int h = bh & 7;
        const bf16_t* Kb = p.Kf + (size_t)bh * 2304 * 96; const bf16_t* Vb = p.Vt + (size_t)bh * 64 * 2304;
        const bf16_t* qp = p.Qraw + (size_t)(qrow0 + wid * 32 + r) * 768 + h * 96 + 8 * hh;
        bf16x8 qf[6];
#pragma unroll
        for (int s = 0; s < 6; ++s) qf[s] = *(const bf16x8*)(qp + 16 * s);
        f32x16 ot0, ot1;
#pragma unroll
        for (int i = 0; i < 16; ++i) { ot0[i] = 0.f; ot1[i] = 0.f; }
        float mrun = -3.0e38f, lrun = 0.f;
        const int ntiles = nkeys >> 7;
        u32x4 kr[3], vr[2];
#pragma unroll
        for (int i = 0; i < 3; ++i) kr[i] = *(const u32x4*)(Kb + kg[i]);
#pragma unroll
        for (int i = 0; i < 2; ++i) vr[i] = *(const u32x4*)(Vb + vg[i]);
#pragma unroll
        for (int i = 0; i < 3; ++i) *(LAS u32x4*)(lds + kl[i]) = kr[i];
#pragma unroll
        for (int i = 0; i < 2; ++i) { *(LAS u32x2*)(lds + vl[i]) = (u32x2){vr[i].x, vr[i].y}; *(LAS u32x2*)(lds + vl[i] + 8) = (u32x2){vr[i].z, vr[i].w}; }
        __syncthreads();
        for (int it = 0; it < ntiles; ++it) {
            const int bo = (it & 1) * BUF, bn = ((it + 1) & 1) * BUF;
            const bool more = (it + 1 < ntiles);
            if (more) {
                const bf16_t* Kn = Kb + (size_t)(it + 1) * 128 * 96; const bf16_t* Vn = Vb + (it + 1) * 128;
#pragma unroll
                for (int i = 0; i < 3; ++i) kr[i] = *(const u32x4*)(Kn + kg[i]);
#pragma unroll
                for (int i = 0; i < 2; ++i) vr[i] = *(const u32x4*)(Vn + vg[i]);
            }
            f32x16 st[4];
#pragma unroll
            for (int kb = 0; kb < 4; ++kb) {
#pragma unroll
                for (int i = 0; i < 16; ++i) st[kb][i] = 0.f;
#pragma unroll
                for (int s = 0; s < 6; ++s) { const bf16x8 kf = *(const LAS bf16x8*)(lds + bo + (kb * 32 + r) * KP + 32 * s + 16 * hh); st[kb] = ATT_MFMA(kf, qf[s], st[kb]); }
            }
            float mt = st[0][0];
#pragma unroll
            for (int kb = 0; kb < 4; ++kb)
#pragma unroll
                for (int i = 0; i < 16; ++i) mt = fmaxf(mt, st[kb][i]);
            mt = fmaxf(mt, __shfl_xor(mt, 32));
            const float mnew = fmaxf(mrun, mt), alpha = __builtin_amdgcn_exp2f(mrun - mnew);
            mrun = mnew;
            float ps = 0.f;
#pragma unroll
            for (int kb = 0; kb < 4; ++kb)
#pragma unroll
                for (int i = 0; i < 16; ++i) { st[kb][i] = __builtin_amdgcn_exp2f(st[kb][i] - mnew); ps += st[kb][i]; }
            lrun = lrun * alpha + ps;
#pragma unroll
            for (int i = 0; i < 16; ++i) { ot0[i] *= alpha; ot1[i] *= alpha; }
#pragma unroll
            for (int kb = 0; kb < 4; ++kb)
#pragma unroll
                for (int s = 0; s < 2; ++s) {
                    u32x4 pw; pw.x = pk(st[kb][8 * s], st[kb][8 * s + 1]); pw.y = pk(st[kb][8 * s + 2], st[kb][8 * s + 3]); pw.z = pk(st[kb][8 * s + 4], st[kb][8 * s + 5]); pw.w = pk(st[kb][8 * s + 6], st[kb][8 * s + 7]);
                    const bf16x8 pb = __builtin_bit_cast(bf16x8, pw);
                    const int col = (kb * 32 + 16 * s + 4 * hh) * 2;
                    const u32x2 a0 = *(const LAS u32x2*)(lds + bo + KT_BYTES + r * VP + col), a1 = *(const LAS u32x2*)(lds + bo + KT_BYTES + r * VP + col + 16);
                    const u32x2 b0 = *(const LAS u32x2*)(lds + bo + KT_BYTES + (32 + r) * VP + col), b1 = *(const LAS u32x2*)(lds + bo + KT_BYTES + (32 + r) * VP + col + 16);
                    const u32x4 va = {a0.x, a0.y, a1.x, a1.y}, vb = {b0.x, b0.y, b1.x, b1.y};
                    ot0 = ATT_MFMA(__builtin_bit_cast(bf16x8, va), pb, ot0);
                    ot1 = ATT_MFMA(__builtin_bit_cast(bf16x8, vb), pb, ot1);
                }
            if (more) {
#pragma unroll
                for (int i = 0; i < 3; ++i) *(LAS u32x4*)(lds + bn + kl[i]) = kr[i];
#pragma unroll
                for (int i = 0; i < 2; ++i) { *(LAS u32x2*)(lds + bn + vl[i]) = (u32x2){vr[i].x, vr[i].y}; *(LAS u32x2*)(lds + bn + vl[i] + 8) = (u32x2){vr[i].z, vr[i].w}; }
            }
            __syncthreads();
        }
        const float il = 1.f / (lrun + __shfl_xor(lrun, 32));
        bf16_t* op = p.H + (size_t)(qrow0 + wid * 32 + r) * 1024 + 512 + h * 64 + 4 * hh;
#pragma unroll
        for (int g = 0; g < 4; ++g) {
            u32x2 w0 = {pk(ot0[4 * g] * il, ot0[4 * g + 1] * il), pk(ot0[4 * g + 2] * il, ot0[4 * g + 3] * il)};
            u32x2 w1 = {pk(ot1[4 * g] * il, ot1[4 * g + 1] * il), pk(ot1[4 * g + 2] * il, ot1[4 * g + 3] * il)};
            *(u32x2*)(op + 8 * g) = w0; *(u32x2*)(op + 32 + 8 * g) = w1;
        }
    }
}

namespace scan {
constexpr int REC = 400, CH = 32, BUFF = CH * REC, YOFF = 2 * BUFF;
DI float dppf(float v, int ctrl_sel) {
    const int x = __builtin_bit_cast(int, v);
    int r;
    if (ctrl_sel == 0) r = __builtin_amdgcn_update_dpp(0, x, 0xB1, 0xf, 0xf, true);
    else if (ctrl_sel == 1) r = __builtin_amdgcn_update_dpp(0, x, 0x4E, 0xf, 0xf, true);
    else r = __builtin_amdgcn_update_dpp(0, x, 0x141, 0xf, 0xf, true);
    return __builtin_bit_cast(float, r);
}
DI float red8(float v) { v += dppf(v, 0); v += dppf(v, 1); v += dppf(v, 2); return v; }
}
DI void ph_scan_opt(const Ctx& cx, const Params& p, float* lds, int j) {
    using namespace scan;
    const int tid = cx.tid, wid = __builtin_amdgcn_readfirstlane(tid >> 6), lane = tid & 63;
    for (int item = cx.bid; item < 256; item += cx.nblk) {
        const int b = item >> 4, h = (item >> 1) & 7, dir = item & 1;
        bf16_t* yout = dir ? p.YB : p.YF;
        if (wid >= 4) {
            const int pw = wid - 4, hc = h * 64 + lane;
            const float kkc = p.a_k_k[j * 512 + hc], kac = p.a_k_a[j * 512 + hc];
            const float mur = p.a_mu[j * ACOLS + hc], muk = p.a_mu[j * ACOLS + 512 + hc], muv = p.a_mu[j * ACOLS + 1024 + hc];
            for (int c = 0; c <= 73; ++c) {
                if (c >= 2) {
                    const float* yb = lds + YOFF + ((c - 2) & 1) * (CH * 64);
#pragma unroll
                    for (int it = 0; it < 8; ++it) {
                        const int sl = pw + 4 * it, step = (c - 2) * CH + sl;
                        const bool cp = step < 256; const int tt = cp ? step : step - 256, T = cp ? 256 : 2048, t = dir ? (T - 1 - tt) : tt;
                        const int row = cp ? NLAT + b * 256 + t : b * 2048 + t;
                        yout[(size_t)row * 512 + hc] = f2bf(yb[sl * 64 + lane]);
                    }
                }
                if (c < 72) {
                    float* buf = lds + (c & 1) * BUFF;
#pragma unroll
                    for (int it = 0; it < 8; ++it) {
                        const int sl = pw + 4 * it, step = c * CH + sl;
                        const bool cp = step < 256; const int tt = cp ? step : step - 256, T = cp ? 256 : 2048, t = dir ? (T - 1 - tt) : tt;
                        const int row = cp ? NLAT + b * 256 + t : b * 2048 + t;
                        const float R = shiftp(p.P, row, t, T, hc, mur), K = shiftp(p.P, row, t, T, 512 + hc, muk), V = shiftp(p.P, row, t, T, 1024 + hc, muv);
                        const float w = 1.f - bf2f(p.WAG[(size_t)row * WLD + dir * 512 + hc]), a = bf2f(p.WAG[(size_t)row * WLD + 1024 + dir * 512 + hc]);
                        const float kkv = K * kkc, ssq = wave_sum(kkv * kkv), kk = kkv * rsqrtf(ssq + 1e-12f);
                        const float kd = K * (1.f + (a - 1.f) * kac), bd = kk * a;
                        const float br = wave_sum(bd * R), kr = wave_sum(kd * R);
                        float* rec = buf + sl * REC;
                        rec[lane] = w; rec[64 + lane] = -kk; rec[128 + lane] = bd; rec[192 + lane] = kd; rec[256 + lane] = w * R; rec[320 + lane] = V;
                        if (lane == 0) { rec[384] = br; rec[385] = kr; }
                    }
                }
                __syncthreads();
            }
        } else {
            const int ct = tid, rp = ct >> 3, k8 = ct & 7;
            float S0[8], S1[8];
#pragma unroll
            for (int q = 0; q < 8; ++q) { S0[q] = 0.f; S1[q] = 0.f; }
            __syncthreads();
            for (int c = 0; c < 72; ++c) {
                const float* buf = lds + (c & 1) * BUFF; float* yb = lds + YOFF + (c & 1) * (CH * 64);
#pragma unroll 2
                for (int sl = 0; sl < CH; ++sl) {
                    const float* rec = buf + sl * REC;
                    const float4 w0 = *(const float4*)(rec + k8 * 8), w1 = *(const float4*)(rec + k8 * 8 + 4);
                    const float4 n0 = *(const float4*)(rec + 64 + k8 * 8), n1 = *(const float4*)(rec + 64 + k8 * 8 + 4);
                    const float4 b0 = *(const float4*)(rec + 128 + k8 * 8), b1 = *(const float4*)(rec + 128 + k8 * 8 + 4);
                    const float4 d0 = *(const float4*)(rec + 192 + k8 * 8), d1 = *(const float4*)(rec + 192 + k8 * 8 + 4);
                    const float4 r0 = *(const float4*)(rec + 256 + k8 * 8), r1 = *(const float4*)(rec + 256 + k8 * 8 + 4);
                    const float2 vv = *(const float2*)(rec + 320 + 2 * rp), sc = *(const float2*)(rec + 384);
                    const float wv[8] = {w0.x, w0.y, w0.z, w0.w, w1.x, w1.y, w1.z, w1.w}, nv[8] = {n0.x, n0.y, n0.z, n0.w, n1.x, n1.y, n1.z, n1.w};
                    const float bv[8] = {b0.x, b0.y, b0.z, b0.w, b1.x, b1.y, b1.z, b1.w}, dv[8] = {d0.x, d0.y, d0.z, d0.w, d1.x, d1.y, d1.z, d1.w};
                    const float rv[8] = {r0.x, r0.y, r0.z, r0.w, r1.x, r1.y, r1.z, r1.w};
                    float sa0 = 0.f, sa1 = 0.f, y0 = 0.f, y1 = 0.f;
#pragma unroll
                    for (int q = 0; q < 8; ++q) { sa0 += S0[q] * nv[q]; sa1 += S1[q] * nv[q]; y0 += S0[q] * rv[q]; y1 += S1[q] * rv[q]; }
                    sa0 = red8(sa0); sa1 = red8(sa1); y0 = red8(y0); y1 = red8(y1);
                    y0 += sa0 * sc.x + vv.x * sc.y; y1 += sa1 * sc.x + vv.y * sc.y;
#pragma unroll
                    for (int q = 0; q < 8; ++q) { S0[q] = S0[q] * wv[q] + sa0 * bv[q] + vv.x * dv[q]; S1[q] = S1[q] * wv[q] + sa1 * bv[q] + vv.y * dv[q]; }
                    if (k8 == 0) *(float2*)(yb + sl * 64 + 2 * rp) = make_float2(y0, y1);
                }
                __syncthreads();
            }
            __syncthreads();
        }
    }
}

DI void unpack8u(const uint4 u, float (&d)[8]) { d[0] = bflo(u.x); d[1] = bfhi(u.x); d[2] = bflo(u.y); d[3] = bfhi(u.y); d[4] = bflo(u.z); d[5] = bfhi(u.z); d[6] = bflo(u.w); d[7] = bfhi(u.w); }
DI uint4 pack8u(const float (&d)[8]) { uint4 u; u.x = att::pk(d[0], d[1]); u.y = att::pk(d[2], d[3]); u.z = att::pk(d[4], d[5]); u.w = att::pk(d[6], d[7]); return u; }
DI void shift8(const bf16_t* P, int row, int t, int T, int col0, const float (&mu)[8], float (&o)[8]) {
    float c[8], pv[8], nx[8];
    unpack8u(*(const uint4*)(P + (size_t)row * PLD + col0), c);
    if (t > 0) unpack8u(*(const uint4*)(P + (size_t)(row - 1) * PLD + col0), pv); else {
#pragma unroll
        for (int i = 0; i < 8; ++i) pv[i] = 0.f; }
    if (t < T - 1) unpack8u(*(const uint4*)(P + (size_t)(row + 1) * PLD + col0), nx); else {
#pragma unroll
        for (int i = 0; i < 8; ++i) nx[i] = 0.f; }
#pragma unroll
    for (int i = 0; i < 8; ++i) o[i] = c[i] + mu[i] * (0.5f * (pv[i] + nx[i]) - c[i]);
}
DI void ld8f(const float* p, float (&d)[8]) { const float4 a = *(const float4*)p, b = *(const float4*)(p + 4); d[0] = a.x; d[1] = a.y; d[2] = a.z; d[3] = a.w; d[4] = b.x; d[5] = b.y; d[6] = b.z; d[7] = b.w; }
DI void ph_post_opt(const Ctx& cx, const Params& p, int j, int nrows) {
    const int tid = cx.tid, wid = tid >> 6, lane = tid & 63, c0 = lane * 8;
    float mur[8], muk[8], muv[8], ka[8], rk[8], lw[8], lb[8];
    ld8f(p.a_mu + j * ACOLS + c0, mur); ld8f(p.a_mu + j * ACOLS + 512 + c0, muk); ld8f(p.a_mu + j * ACOLS + 1024 + c0, muv);
    ld8f(p.a_k_a + j * 512 + c0, ka); ld8f(p.a_r_k + j * 512 + c0, rk); ld8f(p.a_ln_w + j * 512 + c0, lw); ld8f(p.a_ln_b + j * 512 + c0, lb);
    for (int row = cx.bid * 8 + wid; row < nrows; row += cx.nblk * 8) {
        const bool lat = row < NLAT; const int t = lat ? (row & 2047) : ((row - NLAT) & 255); const int T = lat ? 2048 : 256;
        float yf[8], yb[8], R[8], K[8], V[8], af[8], ab[8], g[8];
        unpack8u(*(const uint4*)(p.YF + (size_t)row * 512 + c0), yf); unpack8u(*(const uint4*)(p.YB + (size_t)row * 512 + c0), yb);
        shift8(p.P, row, t, T, c0, mur, R); shift8(p.P, row, t, T, 512 + c0, muk, K); shift8(p.P, row, t, T, 1024 + c0, muv, V);
        unpack8u(*(const uint4*)(p.WAG + (size_t)row * WLD + 1024 + c0), af); unpack8u(*(const uint4*)(p.WAG + (size_t)row * WLD + 1536 + c0), ab); unpack8u(*(const uint4*)(p.WAG + (size_t)row * WLD + 2048 + c0), g);
        float sum = 0.f, sb = 0.f;
#pragma unroll
        for (int i = 0; i < 8; ++i) { yf[i] += yb[i]; sum += yf[i]; sb += R[i] * rk[i] * K[i] * (2.f + (af[i] + ab[i] - 2.f) * ka[i]); }
        sum = scan::red8(sum); sb = scan::red8(sb);
        const float mean = sum * (1.f / 64.f); float var = 0.f;
#pragma unroll
        for (int i = 0; i < 8; ++i) { const float d = yf[i] - mean; var += d * d; }
        var = scan::red8(var);
        const float rstd = rsqrtf(var * (1.f / 64.f) + 64e-5f);
        float o[8];
#pragma unroll
        for (int i = 0; i < 8; ++i) o[i] = ((yf[i] - mean) * rstd * lw[i] + lb[i] + sb * V[i]) * g[i];
        *(uint4*)(p.H + (size_t)row * 1024 + c0) = pack8u(o);
    }
}
DI void fin_vec(float (&x)[8], int c, int t, bool lat, const float* gain, float scl, bf16_t* dst) {
    float ss = 0.f;
#pragma unroll
    for (int i = 0; i < 8; ++i) ss += x[i] * x[i];
    ss += __shfl_xor(ss, 1); ss += __shfl_xor(ss, 2); ss += __shfl_xor(ss, 4); ss += __shfl_xor(ss, 8);
    const float r = rsqrtf(ss * (1.f / 96.f) + 1e-6f);
    float gn[8]; ld8f(gain + (c < 12 ? c : 0) * 8, gn);
#pragma unroll
    for (int i = 0; i < 8; ++i) x[i] = x[i] * r * gn[i];
    float y[8];
#pragma unroll
    for (int i = 0; i < 8; ++i) { const float up = __shfl_down(x[i], 2), dn = __shfl_up(x[i], 2); y[i] = (c < 10) ? up : dn; }
    if (lat && c >= 8 && c < 12) {
        const float invf[8] = {1.f, 0.316227766016838f, 0.1f, 0.0316227766016838f, 0.01f, 0.00316227766016838f, 0.001f, 0.000316227766016838f};
        const float pos = (c & 1) ? (float)(t & 63) : (float)(t >> 6);
#pragma unroll
        for (int i = 0; i < 8; ++i) { const float ang = pos * invf[i], cs = __cosf(ang), sn = __sinf(ang); x[i] = (c < 10) ? (x[i] * cs - y[i] * sn) : (x[i] * cs + y[i] * sn); }
    }
    if (c < 12) {
#pragma unroll
        for (int i = 0; i < 8; ++i) x[i] *= scl;
        *(uint4*)(dst + c * 8) = pack8u(x);
    }
}
DI void ph_finalize_opt(const Ctx& cx, const Params& p, float* ldsf, int j, int mq) {
    const int tid = cx.tid, wid = tid >> 6, lane = tid & 63, c = lane & 15, hq = lane >> 4;
    const float* qg = p.b_q_gain + j * 96; const float* kg = p.b_k_gain + j * 96;
    for (int it = cx.bid * 8 + wid; it < 2 * NT; it += cx.nblk * 8) {
        const int row = it >> 1, h = (it & 1) * 4 + hq;
        const bool lat = row < NLAT; const int b = lat ? (row >> 11) : ((row - NLAT) >> 8); const int t = lat ? (row & 2047) : ((row - NLAT) & 255);
        if (row < mq) {
            bf16_t* qp = p.Qraw + (size_t)row * 768 + h * 96;
            float x[8];
            if (c < 12) unpack8u(*(const uint4*)(qp + c * 8), x); else {
#pragma unroll
                for (int i = 0; i < 8; ++i) x[i] = 0.f; }
            fin_vec(x, c, t, lat, qg, 0.10206207261596577f * 1.4426950408889634f, qp);
        }
        {
            float x[8];
            if (c < 8) unpack8u(*(const uint4*)(p.KVraw + (size_t)row * 1024 + h * 128 + c * 8), x);
            else if (c < 12) unpack8u(*(const uint4*)(p.P + (size_t)row * PLD + ACOLS + 384 + (c - 8) * 8), x);
            else {
#pragma unroll
                for (int i = 0; i < 8; ++i) x[i] = 0.f; }
            const int key = lat ? 256 + t : t;
            fin_vec(x, c, t, lat, kg, 1.f, p.Kf + ((size_t)(b * 8 + h) * 2304 + key) * 96);
        }
    }
    bf16_t* T = (bf16_t*)ldsf; constexpr int TP = 520;
    for (int tile = cx.bid; tile < NT / 64; tile += cx.nblk) {
        const int row0 = tile * 64; const bool lat = row0 < NLAT; const int b = lat ? (row0 >> 11) : ((row0 - NLAT) >> 8); const int t0 = lat ? (row0 & 2047) : ((row0 - NLAT) & 255);
        const int key0 = lat ? 256 + t0 : t0;
        __syncthreads();
#pragma unroll
        for (int i = 0; i < 8; ++i) { const int ch = tid + 512 * i, kr = ch >> 6, cc = ch & 63, h = cc >> 3, part = cc & 7;
            *(uint4*)(T + kr * TP + h * 64 + part * 8) = *(const uint4*)(p.KVraw + (size_t)(row0 + kr) * 1024 + h * 128 + 64 + part * 8); }
        __syncthreads();
#pragma unroll
        for (int i = 0; i < 8; ++i) { const int ch = tid + 512 * i, hd = ch >> 3, kc = ch & 7;
            float v[8];
#pragma unroll
            for (int q = 0; q < 8; ++q) v[q] = bf2f(T[(kc * 8 + q) * TP + hd]);
            uint4 o; o.x = (unsigned)T[(kc * 8 + 0) * TP + hd] | ((unsigned)T[(kc * 8 + 1) * TP + hd] << 16); o.y = (unsigned)T[(kc * 8 + 2) * TP + hd] | ((unsigned)T[(kc * 8 + 3) * TP + hd] << 16);
            o.z = (unsigned)T[(kc * 8 + 4) * TP + hd] | ((unsigned)T[(kc * 8 + 5) * TP + hd] << 16); o.w = (unsigned)T[(kc * 8 + 6) * TP + hd] | ((unsigned)T[(kc * 8 + 7) * TP + hd] << 16);
            (void)v;
            *(uint4*)(p.Vt + ((size_t)(b * 8 + (hd >> 6)) * 64 + (hd & 63)) * 2304 + key0 + kc * 8) = o; }
    }
    __syncthreads();
}
DI void ph_mod_opt(const Ctx& cx, const Params& p, float* lds) {
    const int tid = cx.tid, wid = tid >> 6, lane = tid & 63;
    float* part = lds + 17 * 1024;
    for (int i = tid; i < 17 * 1024; i += NTHR) { const int jj = i >> 10, k = i & 1023; const float v = (jj < 16) ? p.c[jj * 1024 + k] : p.c_ctx[k]; lds[i] = siluf(v); }
    __syncthreads();
    for (int item = cx.bid; item < 4 * 96; item += cx.nblk) {
        const int l = item / 96, n = (item % 96) * 64 + lane;
        const float* w = p.mod_w + (size_t)l * 1024 * 6144 + n;
        float acc[17];
#pragma unroll
        for (int jj = 0; jj < 17; ++jj) acc[jj] = 0.f;
#pragma unroll 4
        for (int k = wid * 128; k < wid * 128 + 128; ++k) {
            const float wv = w[(size_t)k * 6144];
#pragma unroll
            for (int jj = 0; jj < 17; ++jj) acc[jj] += lds[jj * 1024 + k] * wv;
        }
#pragma unroll
        for (int jj = 0; jj < 17; ++jj) part[(wid * 17 + jj) * 64 + lane] = acc[jj];
        __syncthreads();
        for (int o = tid; o < 17 * 64; o += NTHR) { const int jj = o >> 6, ln = o & 63; float sacc = p.mod_b[l * 6144 + (item % 96) * 64 + ln];
#pragma unroll
            for (int q = 0; q < 8; ++q) sacc += part[(q * 17 + jj) * 64 + ln];
            p.mod[((size_t)l * 17 + jj) * 6144 + (item % 96) * 64 + ln] = sacc; }
        __syncthreads();
    }
}

template <int PH>
DI void run_phase(const Params& p, float* lds, int L) {
    const Ctx cx = make_ctx();
    const int j = L >> 1;
    const float* modl = p.mod + (size_t)L * 17 * 6144;
    const float* modprev = p.mod + (size_t)(L > 0 ? L - 1 : 0) * 17 * 6144;
    const bool last = (L == 3);
    const int rows_layer = (L == 3) ? NLAT : NT;
    const int rows_out = (L >= 2) ? NLAT : NT;
    const float* xin_lat = (L == 0) ? p.x : p.out; const float* xin_ctx = (L == 0) ? p.ctx : p.ctxs;
    if constexpr (PH == 0) { if (OPT >= 7) { ph_mod_opt(cx, p, lds); for (int i = cx.bid * NTHR + cx.tid; i < 1024; i += cx.nblk * NTHR) p.H[(size_t)NT * 1024 + i] = 0; } else ph_prologue(cx, p, lds); ph_prep_weights(cx, p, lds); }
    if constexpr (PH == 1) {
        if (OPT >= 4) ph_prep_moe(cx, p, lds, L);
        if (L == 0) ph_norm<false, true, false>(cx, p, lds, rows_layer, xin_lat, xin_ctx, p.norm1_g + L * 1024, modl, 0, 1, modprev, L);
        else ph_norm<true, true, false>(cx, p, lds, rows_layer, xin_lat, xin_ctx, p.norm1_g + L * 1024, modl, 0, 1, modprev, L);
    }
    if constexpr (PH == 2) { if (OPT >= 1) ph_win_mm(cx, p, lds, j); else ph_win(cx, p, lds, j); }
    if constexpr (PH == 3) ph_prepB(cx, p, j);
    if constexpr (PH == 4) { if (OPT >= 2) ph_qkvup_mm(cx, p, lds, j, rows_out); else ph_qkvup(cx, p, lds, j, rows_out); }
    if constexpr (PH == 5) { if (OPT >= 7) ph_finalize_opt(cx, p, lds, j, rows_out); else ph_finalize(cx, p, j, rows_out); }
    if constexpr (PH == 6) { if (OPT >= 5) ph_attn_mm(cx, p, lds, rows_out == NT); else ph_attn(cx, p, rows_out == NT); }
    if constexpr (PH == 7) ph_prepLR(cx, p, j);
    if constexpr (PH == 8) { if (OPT >= 2) ph_wag_mm(cx, p, lds, j); else ph_wag(cx, p, lds, j); }
    if constexpr (PH == 9) { if (OPT >= 6) ph_scan_opt(cx, p, lds, j); else ph_scan(cx, p, lds, j); }
    if constexpr (PH == 10) { if (OPT >= 7) ph_post_opt(cx, p, j, rows_out); else ph_post(cx, p, j, rows_out); }
    if constexpr (PH == 11) { if (OPT >= 1) ph_wout_mm(cx, p, lds, p.H, p.WoutT + (size_t)j * 1024 * 1024, rows_out, xin_lat, xin_ctx, modl); else ph_wout(cx, p, lds, p.H, p.w_out_even + (size_t)j * 1024 * 1024, rows_out, xin_lat, xin_ctx, modl); }
    if constexpr (PH == 12) { if (OPT >= 3) ph_f1_mm(cx, p, lds, j, !last); else ph_chdft(cx, p, lds, rows_layer); }
    if constexpr (PH == 13) { if (OPT >= 3) ph_f2_mm(cx, p, lds, !last, xin_lat, xin_ctx, modl); else ph_posdft(cx, p, lds, !last); }
    if constexpr (PH == 14) { if (OPT < 3) ph_wout(cx, p, lds, p.F, p.w_out_fourier + (size_t)j * 1024 * 1024, rows_out, xin_lat, xin_ctx, modl); }
    if constexpr (PH == 15) ph_norm<false, true, true>(cx, p, lds, rows_out, p.out, p.ctxs, p.norm2_g + L * 1024, modl, 3, 4, modprev, L);
    if constexpr (PH == 16) { if (OPT >= 4) ph_moe_up_mm(cx, p, lds, L, rows_out); else ph_moe_up(cx, p, lds, L, rows_out); }
    if constexpr (PH == 17) { if (OPT >= 4) ph_moe_down_mm(cx, p, lds, L, rows_out); else ph_moe_down(cx, p, lds, L, rows_out); }
    if constexpr (PH == 18) ph_norm<true, false, false>(cx, p, lds, NLAT, p.out, p.ctxs, p.norm1_g, p.mod + (size_t)3 * 17 * 6144, 0, 1, p.mod + (size_t)3 * 17 * 6144, 3);
}

template <int PH>
__global__ void __launch_bounds__(NTHR, 2) k_phase(Params p, int L) {
    extern __shared__ __attribute__((aligned(16))) float shm[];
    run_phase<PH>(p, shm, L);
}

#if ONE_LAUNCH
constexpr int PARAM_WORDS = (int)(sizeof(Params) / 4);
DI Params load_params(const unsigned* lp) {
    Params q; unsigned* d = (unsigned*)&q;
#pragma unroll
    for (int i = 0; i < PARAM_WORDS; ++i) d[i] = (unsigned)__builtin_amdgcn_readfirstlane((int)lp[i]);
    return q;
}
#define PHASE(PH, L) do { const Params q_ = load_params(lp); run_phase<PH>(q_, lds, (L)); xcd_barrier(bar); } while (0)
__global__ void __launch_bounds__(NTHR, 2) k_mega(Params p) {
    extern __shared__ __attribute__((aligned(16))) float shm[];
    unsigned* lp = (unsigned*)(shm + 4);
    float* lds = shm + 4 + ((PARAM_WORDS + 3) & ~3);
    if (threadIdx.x == 0) { shm[0] = 0.f; shm[1] = 0.f; shm[2] = 0.f; shm[3] = 0.f; }
    if (threadIdx.x < PARAM_WORDS) lp[threadIdx.x] = ((const unsigned*)&p)[threadIdx.x];
    __syncthreads();
    XcdBarrier bar; { const Params q_ = load_params(lp); bar = xcd_barrier_post(q_.bar, (volatile LAS unsigned*)shm); }
    PHASE(0, 0);
#define LAYER_EVEN(L) PHASE(1, L); PHASE(2, L); PHASE(3, L); PHASE(4, L); PHASE(5, L); PHASE(6, L); PHASE(7, L); PHASE(8, L); PHASE(9, L); PHASE(10, L); PHASE(11, L); PHASE(15, L); PHASE(16, L); PHASE(17, L)
#define LAYER_ODD(L) PHASE(1, L); PHASE(12, L); PHASE(13, L); PHASE(14, L); PHASE(15, L); PHASE(16, L); PHASE(17, L)
    LAYER_EVEN(0); LAYER_ODD(1); LAYER_EVEN(2); LAYER_ODD(3);
    { const Params q_ = load_params(lp); run_phase<18>(q_, lds, 3); }
}
#endif

static inline size_t al256(size_t v) { return (v + 255) & ~(size_t)255; }
constexpr size_t LDS_BYTES = 136 * 1024;

template <int PH> static void launch_phase(const Params& p, int L, int grid, hipStream_t s) {
    static bool attr = false;
    if (!attr) { hipFuncSetAttribute((const void*)k_phase<PH>, hipFuncAttributeMaxDynamicSharedMemorySize, (int)LDS_BYTES); attr = true; }
    hipLaunchKernelGGL(k_phase<PH>, dim3(grid), dim3(NTHR), LDS_BYTES, s, p, L);
}

extern "C" void kernel_launch(void* const* d_in, const int* in_sizes, int n_in, void* d_out, int out_size, void* d_ws, size_t ws_size, hipStream_t stream) {
    (void)in_sizes; (void)n_in; (void)out_size;
    Params p{};
    const float** ip = (const float**)&p.x;
    for (int i = 0; i < 36; ++i) ip[i] = (const float*)d_in[i];
    p.out = (float*)d_out;
    char* w = (char*)d_ws; size_t o = 0;
    auto take = [&](size_t bytes) { char* r = w + o; o += al256(bytes); return r; };
    p.bar = (unsigned*)take(XCD_BAR_WORDS * 4);
    p.cnt = (int*)take(64 * 4);
    const size_t zero_bytes = o;
    p.mod = (float*)take((size_t)4 * 17 * 6144 * 4);
    p.ctxs = (float*)take((size_t)NCTX * 1024 * 4);
    p.dftl = (bf16_t*)take((size_t)2048 * 4096 * 2);
    p.dftc = (bf16_t*)take((size_t)256 * 512 * 2);
    p.slot = (int*)take((size_t)16 * NT * 4);
    p.tokw = (float*)take((size_t)NT * 2 * 4);
    p.H = (bf16_t*)take((size_t)(NT + 1) * 1024 * 2);
    char* big = w + o;
    p.P = (bf16_t*)take((size_t)NT * PLD * 2);
    char* r1 = w + o;
    p.LR = (bf16_t*)take((size_t)NT * 384 * 2);
    p.WAG = (bf16_t*)take((size_t)NT * WLD * 2);
    p.YF = (bf16_t*)take((size_t)NT * 512 * 2);
    p.YB = (bf16_t*)take((size_t)NT * 512 * 2);
    p.WinT = (bf16_t*)take((size_t)2 * 2560 * 1024 * 2); p.WqT = (bf16_t*)take((size_t)2 * 768 * 256 * 2); p.WkvT = (bf16_t*)take((size_t)2 * 1024 * 256 * 2);
    p.WlrT = (bf16_t*)take((size_t)2 * 2560 * 384 * 2); p.WoutT = (bf16_t*)take((size_t)2 * 1024 * 1024 * 2); p.A1 = (bf16_t*)take((size_t)2 * 2048 * 1024 * 2);
    p.A2 = (bf16_t*)take((size_t)2048 * 4096 * 2); p.A2c = (bf16_t*)take((size_t)256 * 512 * 2);
    p.WguT = (bf16_t*)take((size_t)17 * 1024 * 1024 * 2); p.WdT = (bf16_t*)take((size_t)17 * 1024 * 512 * 2);
    const size_t total = o;
    { size_t q = 0; auto t2 = [&](size_t bytes) { char* r = r1 + q; q += al256(bytes); return r; };
      p.QN = (bf16_t*)t2((size_t)NT * 512 * 2); p.Qraw = (bf16_t*)t2((size_t)NT * 768 * 2); p.KVraw = (bf16_t*)t2((size_t)NT * 1024 * 2);
      p.Kf = (bf16_t*)t2((size_t)NB * 8 * 2304 * 96 * 2); p.Vt = (bf16_t*)t2((size_t)NB * 8 * 64 * 2304 * 2); }
    { size_t q = 0; auto t3 = [&](size_t bytes) { char* r = big + q; q += al256(bytes); return r; };
      p.ACT = (bf16_t*)t3((size_t)3 * NT * 512 * 2); p.Y = (bf16_t*)t3((size_t)3 * NT * 1024 * 2); }
    { size_t q = 0; auto t4 = [&](size_t bytes) { char* r = big + q; q += al256(bytes); return r; };
      p.G = (float*)t4((size_t)NT * 2048 * 4); p.F = (bf16_t*)t4((size_t)NT * 1024 * 2); }
    { size_t q = 0; auto t5 = [&](size_t bytes) { char* r = big + q; q += al256(bytes); return r; };
      p.ZT = (bf16_t*)t5((size_t)16 * 1024 * 4096 * 2); p.ZTC = (bf16_t*)t5((size_t)16 * 1024 * 512 * 2); }
    if (total > ws_size) { fprintf(stderr, "workspace too small: need %zu have %zu\n", total, ws_size); return; }
    static int grid = 0;
    if (!grid) { int dev = 0, cus = 0; hipGetDevice(&dev); hipDeviceGetAttribute(&cus, hipDeviceAttributeMultiprocessorCount, dev); grid = cus > 0 ? cus : 256; if (grid > 256) grid = 256; }
    hipMemsetAsync(d_ws, 0, zero_bytes, stream);
#if ONE_LAUNCH
    static bool attr = false;
    if (!attr) { hipFuncSetAttribute((const void*)k_mega, hipFuncAttributeMaxDynamicSharedMemorySize, (int)LDS_BYTES); attr = true; }
    hipLaunchKernelGGL(k_mega, dim3(grid), dim3(NTHR), LDS_BYTES, stream, p);
#else
    launch_phase<0>(p, 0, grid, stream);
    for (int L = 0; L < 4; ++L) {
        launch_phase<1>(p, L, grid, stream);
        if ((L & 1) == 0) {
            launch_phase<2>(p, L, grid, stream); launch_phase<3>(p, L, grid, stream); launch_phase<4>(p, L, grid, stream); launch_phase<5>(p, L, grid, stream);
            launch_phase<6>(p, L, grid, stream); launch_phase<7>(p, L, grid, stream); launch_phase<8>(p, L, grid, stream); launch_phase<9>(p, L, grid, stream);
            launch_phase<10>(p, L, grid, stream); launch_phase<11>(p, L, grid, stream);
        } else {
            launch_phase<12>(p, L, grid, stream); launch_phase<13>(p, L, grid, stream); launch_phase<14>(p, L, grid, stream);
        }
        launch_phase<15>(p, L, grid, stream); launch_phase<16>(p, L, grid, stream); launch_phase<17>(p, L, grid, stream);
    }
    launch_phase<18>(p, 3, grid, stream);
#endif
}
```

```cpp
#include <hip/hip_runtime.h>
#include <cstdio>
#include <cstdint>

#ifndef ONE_LAUNCH
#define ONE_LAUNCH 1
#endif
#ifndef PROBE_SCAN
#define PROBE_SCAN 0
#endif
#ifndef OPT
#define OPT 9
#endif

typedef unsigned short bf16_t;
#define DI __device__ __forceinline__
#define LAS __attribute__((address_space(3)))

constexpr int D = 1024, NB = 16, SEQ = 2048, CTXL = 256, NLAT = NB * SEQ, NCTX = NB * CTXL, NT = NLAT + NCTX;
constexpr int PLD = 2560;
constexpr int INC = 2336, ACOLS = 1920;
constexpr int WLD = 2560;
constexpr int NTHR = 512;

#define XB_TMO      128
#define XB_XCNT(j)  (256  + 64 * (j))
#define XB_XSUB(j)  (1280 + 64 * (j))
#define XB_XGEN(j)  (2304 + 64 * (j))
#define XB_TOP      3328
#define XB_TOPGEN   3392
#define XCD_BAR_WORDS 3456
#define XB_SPIN_CAP (1u << 24)
DI unsigned xb_ld(unsigned* p)              { return __hip_atomic_load(p, __ATOMIC_RELAXED, __HIP_MEMORY_SCOPE_AGENT); }
DI unsigned xb_add(unsigned* p, unsigned v) { return __hip_atomic_fetch_add(p, v, __ATOMIC_RELAXED, __HIP_MEMORY_SCOPE_AGENT); }
DI unsigned xb_xcc_id() { return (unsigned)__builtin_amdgcn_s_getreg((3 << 11) | 20) & 0xFu; }
#define XB_SPIN(cond, bar) do { unsigned _sp = 0; while (cond) { __builtin_amdgcn_s_sleep(1); \
    if ((++_sp & 255u) == 0u) { if (xb_ld(&(bar)[XB_TMO])) break; if (_sp > XB_SPIN_CAP) { atomicAdd(&(bar)[XB_TMO], 1u); break; } } } } while (0)
struct XcdBarrier { unsigned* bar; unsigned x; volatile LAS unsigned* st; };
DI XcdBarrier xcd_barrier_post(unsigned* bar, volatile LAS unsigned* st) {
    XcdBarrier b; b.bar = bar; b.x = xb_xcc_id(); b.st = st;
    if (threadIdx.x == 0) (void)xb_add(&bar[XB_XCNT(b.x)], 1u);
    return b;
}
DI void xcd_barrier_complete(unsigned* bar, unsigned x, unsigned& nloc, unsigned& nx) {
    const unsigned G = gridDim.x * gridDim.y * gridDim.z;
    unsigned sum, cnt, mine, sp = 0u;
    for (;;) {
        sum = 0u; cnt = 0u; mine = 0u;
#pragma unroll
        for (unsigned j = 0; j < 16; ++j) { const unsigned c = xb_ld(&bar[XB_XCNT(j)]); sum += c; cnt += (c > 0u) ? 1u : 0u; mine = (j == x) ? c : mine; }
        if (sum == G) break;
        __builtin_amdgcn_s_sleep(1);
        if ((++sp & 255u) == 0u) { if (xb_ld(&bar[XB_TMO])) break; if (sp > XB_SPIN_CAP) { atomicAdd(&bar[XB_TMO], 1u); break; } }
    }
    nloc = mine > 0u ? mine : 1u; nx = cnt > 0u ? cnt : 1u;
}
DI void xcd_barrier(const XcdBarrier& b) {
    asm volatile("s_waitcnt vmcnt(0)" ::: "memory");
    __syncthreads();
    if (threadIdx.x == 0) {
        unsigned* bar = b.bar;
        __builtin_amdgcn_s_waitcnt(0);
        unsigned nloc = b.st[0], nx = b.st[1];
        if (nloc == 0u) { xcd_barrier_complete(bar, b.x, nloc, nx); b.st[0] = nloc; b.st[1] = nx; }
        const unsigned old = xb_add(&bar[XB_XSUB(b.x)], 1u);
        const unsigned gen = old / nloc;
        if (old + 1u == (gen + 1u) * nloc) {
            __builtin_amdgcn_fence(__ATOMIC_RELEASE, "agent");
            asm volatile("s_waitcnt vmcnt(0)" ::: "memory");
            const unsigned og = xb_add(&bar[XB_TOP], 1u);
            const unsigned tg = og / nx;
            if (og + 1u == (tg + 1u) * nx) xb_add(&bar[XB_TOPGEN], 1u);
            else XB_SPIN(xb_ld(&bar[XB_TOPGEN]) == tg, bar);
            __builtin_amdgcn_fence(__ATOMIC_ACQUIRE, "agent");
            xb_add(&bar[XB_XGEN(b.x)], 1u);
            asm volatile("s_waitcnt vmcnt(0)" ::: "memory");
        } else {
            XB_SPIN(xb_ld(&bar[XB_XGEN(b.x)]) == gen, bar);
            __builtin_amdgcn_fence(__ATOMIC_ACQUIRE, "agent");
            asm volatile("s_waitcnt vmcnt(0)" ::: "memory");
        }
    }
    __syncthreads();
}

struct Params {
    const float *x, *c, *ctx, *c_ctx, *norm1_g, *norm2_g, *mod_w, *mod_b, *w_in, *a_mu, *a_w0, *a_w2, *a_a0, *a_a2, *a_g2,
                *a_k_k, *a_k_a, *a_r_k, *a_ln_w, *a_ln_b, *b_q_norm, *b_w_q_up, *b_kv_norm, *b_w_kv_up, *b_q_gain, *b_k_gain,
                *w_out_even, *w_out_fourier, *router_w, *router_b, *moe_w_gate, *moe_w_up, *moe_w_down, *sh_gate, *sh_up, *sh_down;
    float* out;
    unsigned* bar; int* cnt; float* mod; float* ctxs; bf16_t* dftl; bf16_t* dftc; int* slot; float* tokw;
    bf16_t *H, *P, *LR, *WAG, *YF, *YB, *QN, *Qraw, *KVraw, *Kf, *Vt, *ACT, *Y, *F; float* G;
    bf16_t *WinT, *WqT, *WkvT, *WlrT, *WoutT, *A1, *A2, *A2c, *WguT, *WdT, *ZT, *ZTC;
};

struct Ctx { int tid, bid, nblk; };
DI Ctx make_ctx() { Ctx c; c.tid = threadIdx.x; c.bid = blockIdx.x; c.nblk = gridDim.x; asm volatile("" : "+v"(c.tid), "+s"(c.bid), "+s"(c.nblk)); return c; }

DI bf16_t f2bf(float f) { unsigned u = __float_as_uint(f); u += 0x7fffu + ((u >> 16) & 1u); return (bf16_t)(u >> 16); }
DI float bf2f(bf16_t b) { return __uint_as_float(((unsigned)b) << 16); }
DI float bflo(unsigned u) { return __uint_as_float(u << 16); }
DI float bfhi(unsigned u) { return __uint_as_float(u & 0xffff0000u); }
DI unsigned pack2(float lo, float hi) { return (unsigned)f2bf(lo) | ((unsigned)f2bf(hi) << 16); }
DI float siluf(float v) { return v / (1.f + expf(-v)); }
DI float sigm(float v) { return 1.f / (1.f + expf(-v)); }
template <int CTRL> DI float dpp_f(float v) { return __builtin_bit_cast(float, __builtin_amdgcn_update_dpp(0, __builtin_bit_cast(int, v), CTRL, 0xf, 0xf, true)); }
DI float wave_sum(float v) {
    v += dpp_f<0xB1>(v); v += dpp_f<0x4E>(v); v += dpp_f<0x141>(v); v += dpp_f<0x140>(v);
    const int x = __builtin_bit_cast(int, v);
    const float a = __builtin_bit_cast(float, __builtin_amdgcn_readlane(x, 0)), b = __builtin_bit_cast(float, __builtin_amdgcn_readlane(x, 16));
    const float c = __builtin_bit_cast(float, __builtin_amdgcn_readlane(x, 32)), d = __builtin_bit_cast(float, __builtin_amdgcn_readlane(x, 48));
    return (a + b) + (c + d);
}

template <bool DUAL, class AFn, class BFn, class BFn2, class Epi>
DI void ngemm(const Ctx& cx, float* lds, int nbz, int M, int N, int K, AFn afn, BFn bfn, BFn2 bfn2, Epi epi) {
    float* As = lds; float* Bs = lds + 16 * 132; float* B2s = Bs + 16 * 128;
    const int tid = cx.tid, ty = tid >> 5, tx = tid & 31;
    const int tm = (M + 127) / 128, tn = (N + 127) / 128, ntile = tm * tn * nbz;
    const int arow = tid >> 2, akc = (tid & 3) * 4, bk = tid >> 5, bnn = (tid & 31) * 4;
    for (int tile = cx.bid; tile < ntile; tile += cx.nblk) {
        const int bz = tile / (tm * tn), rem = tile % (tm * tn), bm = rem / tn, bn = rem % tn;
        float acc[8][4], acc2[8][4];
#pragma unroll
        for (int i = 0; i < 8; ++i)
#pragma unroll
            for (int j = 0; j < 4; ++j) { acc[i][j] = 0.f; acc2[i][j] = 0.f; }
        const int m_a = bm * 128 + arow;
        const bf16_t* aptr = (m_a < M) ? afn(bz, m_a) : nullptr;
        const int nB = bn * 128 + bnn;
        for (int k0 = 0; k0 < K; k0 += 16) {
            float av0 = 0.f, av1 = 0.f, av2 = 0.f, av3 = 0.f;
            if (aptr) { const uint2 u = *(const uint2*)(aptr + k0 + akc); av0 = bflo(u.x); av1 = bfhi(u.x); av2 = bflo(u.y); av3 = bfhi(u.y); }
            float4 bv = make_float4(0.f, 0.f, 0.f, 0.f), bv2 = make_float4(0.f, 0.f, 0.f, 0.f);
            if (nB < N) { bv = *(const float4*)(bfn(bz, k0 + bk) + nB); if (DUAL) bv2 = *(const float4*)(bfn2(bz, k0 + bk) + nB); }
            __syncthreads();
            As[(akc + 0) * 132 + arow] = av0; As[(akc + 1) * 132 + arow] = av1; As[(akc + 2) * 132 + arow] = av2; As[(akc + 3) * 132 + arow] = av3;
            *(float4*)&Bs[bk * 128 + bnn] = bv;
            if (DUAL) *(float4*)&B2s[bk * 128 + bnn] = bv2;
            __syncthreads();
#pragma unroll 4
            for (int kk = 0; kk < 16; ++kk) {
                const float4 a0 = *(const float4*)&As[kk * 132 + ty * 8], a1 = *(const float4*)&As[kk * 132 + ty * 8 + 4];
                const float4 b = *(const float4*)&Bs[kk * 128 + tx * 4];
                const float a[8] = {a0.x, a0.y, a0.z, a0.w, a1.x, a1.y, a1.z, a1.w};
                const float bb[4] = {b.x, b.y, b.z, b.w};
#pragma unroll
                for (int i = 0; i < 8; ++i)
#pragma unroll
                    for (int j = 0; j < 4; ++j) acc[i][j] += a[i] * bb[j];
                if (DUAL) {
                    const float4 b2 = *(const float4*)&B2s[kk * 128 + tx * 4];
                    const float cc[4] = {b2.x, b2.y, b2.z, b2.w};
#pragma unroll
                    for (int i = 0; i < 8; ++i)
#pragma unroll
                        for (int j = 0; j < 4; ++j) acc2[i][j] += a[i] * cc[j];
                }
            }
        }
#pragma unroll
        for (int i = 0; i < 8; ++i) {
            const int m = bm * 128 + ty * 8 + i;
            if (m < M) {
#pragma unroll
                for (int j = 0; j < 4; ++j) { const int n = bn * 128 + tx * 4 + j; if (n < N) epi(bz, m, n, acc[i][j], acc2[i][j]); }
            }
        }
    }
    __syncthreads();
}

DI void ph_prologue(const Ctx& cx, const Params& p, float* lds) {
    const int tid = cx.tid, gtid = cx.bid * NTHR + tid, gsz = cx.nblk * NTHR;
    for (int i = tid; i < 17 * 1024; i += NTHR) { const int j = i >> 10, k = i & 1023; const float v = (j < 16) ? p.c[j * 1024 + k] : p.c_ctx[k]; lds[i] = siluf(v); }
    __syncthreads();
    for (int idx = gtid; idx < 4 * 6144; idx += gsz) {
        const int l = idx / 6144, n = idx % 6144;
        const float* w = p.mod_w + (size_t)l * 1024 * 6144 + n;
        float acc[17]; const float b0 = p.mod_b[l * 6144 + n];
#pragma unroll
        for (int j = 0; j < 17; ++j) acc[j] = b0;
        for (int k = 0; k < 1024; ++k) {
            const float wv = w[(size_t)k * 6144];
#pragma unroll
            for (int j = 0; j < 17; ++j) acc[j] += lds[j * 1024 + k] * wv;
        }
#pragma unroll
        for (int j = 0; j < 17; ++j) p.mod[((size_t)l * 17 + j) * 6144 + n] = acc[j];
    }
    for (int i = gtid; i < 2048 * 4096; i += gsz) {
        const int f = i >> 12, k = i & 4095, t = k & 2047, m = (f * t) & 2047; const float a = (float)m * (1.f / 1024.f);
        p.dftl[i] = f2bf((k < 2048) ? cospif(a) : sinpif(a));
    }
    for (int i = gtid; i < 256 * 512; i += gsz) {
        const int f = i >> 9, k = i & 511, t = k & 255, m = (f * t) & 255; const float a = (float)m * (1.f / 128.f);
        p.dftc[i] = f2bf((k < 256) ? cospif(a) : sinpif(a));
    }
    for (int i = gtid; i < 1024; i += gsz) p.H[(size_t)NT * 1024 + i] = 0;
    __syncthreads();
}

DI float pick4(float a0, float a1, float a2, float a3, int i) { return i == 0 ? a0 : (i == 1 ? a1 : (i == 2 ? a2 : a3)); }
template <bool COMBINE, bool NORM, bool ROUTER>
DI void ph_norm(const Ctx& cx, const Params& p, float* lds, int nrows, const float* xin_lat, const float* xin_ctx, const float* gain, const float* modl, int sh_idx, int sc_idx,
                const float* modprev, int layer) {
    const int tid = cx.tid, wid = tid >> 6, lane = tid & 63;
    float* rw = lds;
    float* scr = lds + 16 * 1024;
    int* lcnt = (int*)(lds + 16 * 1024 + 256); int* lbase = lcnt + 16; int* rlist = lcnt + 32;
    int nlist = 0;
    if (ROUTER) {
        for (int i = tid; i < 16 * 1024; i += NTHR) { const int e = i >> 10, col = i & 1023; rw[i] = p.router_w[col * 16 + e]; }
        if (tid < 16) lcnt[tid] = 0;
        __syncthreads();
    }
    for (int row = cx.bid * 8 + wid; row < nrows; row += cx.nblk * 8) {
        const bool lat = row < NLAT; const int j = lat ? (row >> 11) : 16;
        const float* xr = lat ? xin_lat + (size_t)row * 1024 : xin_ctx + (size_t)(row - NLAT) * 1024;
        float4 xv[4];
#pragma unroll
        for (int i = 0; i < 4; ++i) xv[i] = *(const float4*)(xr + i * 256 + lane * 4);
        if (COMBINE) {
            const float* g2 = modprev + (size_t)j * 6144 + 5 * 1024;
            float* xo = lat ? p.out + (size_t)row * 1024 : p.ctxs + (size_t)(row - NLAT) * 1024;
#pragma unroll
            for (int i = 0; i < 4; ++i) {
                const int col = i * 256 + lane * 4;
                const float4 gv = *(const float4*)(g2 + col);
                float s0 = 0.f, s1 = 0.f, s2 = 0.f, s3 = 0.f;
#pragma unroll
                for (int s = 0; s < 3; ++s) { const uint2 u = *(const uint2*)(p.Y + ((size_t)s * NT + row) * 1024 + col); s0 += bflo(u.x); s1 += bfhi(u.x); s2 += bflo(u.y); s3 += bfhi(u.y); }
                xv[i].x += gv.x * s0; xv[i].y += gv.y * s1; xv[i].z += gv.z * s2; xv[i].w += gv.w * s3;
                *(float4*)(xo + col) = xv[i];
            }
        }
        if (NORM) {
            float ss = 0.f;
#pragma unroll
            for (int i = 0; i < 4; ++i) ss += xv[i].x * xv[i].x + xv[i].y * xv[i].y + xv[i].z * xv[i].z + xv[i].w * xv[i].w;
            ss = wave_sum(ss);
            const float rstd = rsqrtf(ss * (1.f / 1024.f) + 1e-6f);
            const float* shp = modl + (size_t)j * 6144 + sh_idx * 1024; const float* scp = modl + (size_t)j * 6144 + sc_idx * 1024;
            float4 hv[4];
#pragma unroll
            for (int i = 0; i < 4; ++i) {
                const int col = i * 256 + lane * 4;
                const float4 g = *(const float4*)(gain + col), sh = *(const float4*)(shp + col), sc = *(const float4*)(scp + col);
                hv[i].x = xv[i].x * rstd * g.x * (1.f + sc.x) + sh.x; hv[i].y = xv[i].y * rstd * g.y * (1.f + sc.y) + sh.y;
                hv[i].z = xv[i].z * rstd * g.z * (1.f + sc.z) + sh.z; hv[i].w = xv[i].w * rstd * g.w * (1.f + sc.w) + sh.w;
                uint2 u; u.x = pack2(hv[i].x, hv[i].y); u.y = pack2(hv[i].z, hv[i].w);
                *(uint2*)(p.H + (size_t)row * 1024 + col) = u;
            }
            if (ROUTER) {
                float part[16];
#pragma unroll
                for (int e = 0; e < 16; ++e) {
                    float a = 0.f;
#pragma unroll
                    for (int i = 0; i < 4; ++i) { const float4 w = *(const float4*)(rw + e * 1024 + i * 256 + lane * 4); a += hv[i].x * w.x + hv[i].y * w.y + hv[i].z * w.z + hv[i].w * w.w; }
                    part[e] = wave_sum(a);
                }
                float* my = scr + wid * 32;
#pragma unroll
                for (int e = 0; e < 16; ++e) if (lane == e) { const float sg = sigm(part[e]); my[e] = sg; my[16 + e] = sg + p.router_b[e]; }
                __builtin_amdgcn_wave_barrier();
                if (lane == 0) {
                    float best = -3.0e38f; int be1 = 0, be2 = 1;
                    for (int g = 0; g < 4; ++g) {
                        const float v0 = my[16 + 4 * g], v1 = my[16 + 4 * g + 1], v2 = my[16 + 4 * g + 2], v3 = my[16 + 4 * g + 3];
                        int i1 = 0; float m1 = v0;
                        if (v1 > m1) { m1 = v1; i1 = 1; } if (v2 > m1) { m1 = v2; i1 = 2; } if (v3 > m1) { m1 = v3; i1 = 3; }
                        int i2 = -1; float m2 = -3.0e38f;
                        if (i1 != 0 && v0 > m2) { m2 = v0; i2 = 0; } if (i1 != 1 && v1 > m2) { m2 = v1; i2 = 1; }
                        if (i1 != 2 && v2 > m2) { m2 = v2; i2 = 2; } if (i1 != 3 && v3 > m2) { m2 = v3; i2 = 3; }
                        const float gs = m1 + m2;
                        if (gs > best) { best = gs; be1 = 4 * g + i1; be2 = 4 * g + i2; }
                    }
                    const float bs1 = my[be1], bs2 = my[be2];
                    const float inv = 1.f / (bs1 + bs2);
                    const int p1 = atomicAdd(&lcnt[be1], 1), p2 = atomicAdd(&lcnt[be2], 1);
                    int* ent = rlist + (wid * 24 + nlist) * 4;
                    ent[0] = row; ent[1] = be1 | (be2 << 8); ent[2] = p1; ent[3] = p2;
                    p.tokw[row * 2] = bs1 * inv; p.tokw[row * 2 + 1] = bs2 * inv;
                }
                ++nlist;
                __builtin_amdgcn_wave_barrier();
            }
        }
    }
    if (ROUTER) {
        __syncthreads();
        if (tid < 16) lbase[tid] = atomicAdd(p.cnt + (layer * 16 + tid) * 64, lcnt[tid]);
        __syncthreads();
        for (int k = lane; k < nlist; k += 64) {
            const int* ent = rlist + (wid * 24 + k) * 4; const int row = ent[0], be1 = ent[1] & 255, be2 = ent[1] >> 8;
            p.slot[(size_t)be1 * NT + lbase[be1] + ent[2]] = row * 2; p.slot[(size_t)be2 * NT + lbase[be2] + ent[3]] = row * 2 + 1;
        }
    }
    (void)scr;
    __syncthreads();
}

DI void ph_win(const Ctx& cx, const Params& p, float* lds, int j) {
    const float* W = p.w_in + (size_t)j * 1024 * INC;
    ngemm<false>(cx, lds, 1, NT, INC, 1024,
        [&](int, int m) { return p.H + (size_t)m * 1024; },
        [&](int, int k) { return W + (size_t)k * INC; }, [&](int, int) { return (const float*)nullptr; },
        [&](int, int m, int n, float v, float) { p.P[(size_t)m * PLD + n] = f2bf(v); });
}
DI void ph_prepB(const Ctx& cx, const Params& p, int j) {
    const int tid = cx.tid, wid = tid >> 6, lane = tid & 63;
    for (int row = cx.bid * 8 + wid; row < NT; row += cx.nblk * 8) {
        const bf16_t* pr = p.P + (size_t)row * PLD + ACOLS;
        const uint2 uq = *(const uint2*)(pr + lane * 4); const unsigned ukv = *(const unsigned*)(pr + 256 + lane * 2);
        const float q0 = bflo(uq.x), q1 = bfhi(uq.x), q2 = bflo(uq.y), q3 = bfhi(uq.y), k0 = bflo(ukv), k1 = bfhi(ukv);
        const float sq = wave_sum(q0 * q0 + q1 * q1 + q2 * q2 + q3 * q3), sk = wave_sum(k0 * k0 + k1 * k1);
        const float rq = rsqrtf(sq * (1.f / 256.f) + 1e-6f), rk = rsqrtf(sk * (1.f / 128.f) + 1e-6f);
        const float* gq = p.b_q_norm + j * 256 + lane * 4; const float* gk = p.b_kv_norm + j * 128 + lane * 2;
        uint2 o; o.x = pack2(q0 * rq * gq[0], q1 * rq * gq[1]); o.y = pack2(q2 * rq * gq[2], q3 * rq * gq[3]);
        bf16_t* qn = p.QN + (size_t)row * 512;
        *(uint2*)(qn + lane * 4) = o;
        *(unsigned*)(qn + 256 + lane * 2) = pack2(k0 * rk * gk[0], k1 * rk * gk[1]);
        *(unsigned*)(qn + 384 + lane * 2) = 0u;
    }
}
DI void ph_qkvup(const Ctx& cx, const Params& p, float* lds, int j, int mq) {
    const float* Wq = p.b_w_q_up + (size_t)j * 256 * 768; const float* Wkv = p.b_w_kv_up + (size_t)j * 128 * 1024;
    ngemm<false>(cx, lds, 1, mq, 768, 256,
        [&](int, int m) { return p.QN + (size_t)m * 512; },
        [&](int, int k) { return Wq + (size_t)k * 768; }, [&](int, int) { return (const float*)nullptr; },
        [&](int, int m, int n, float v, float) { p.Qraw[(size_t)m * 768 + n] = f2bf(v); });
    ngemm<false>(cx, lds, 1, NT, 1024, 128,
        [&](int, int m) { return p.QN + (size_t)m * 512 + 256; },
        [&](int, int k) { return Wkv + (size_t)k * 1024; }, [&](int, int) { return (const float*)nullptr; },
        [&](int, int m, int n, float v, float) { p.KVraw[(size_t)m * 1024 + n] = f2bf(v); });
}
DI void unpack8(const uint4 u, float* d) { d[0] = bflo(u.x); d[1] = bfhi(u.x); d[2] = bflo(u.y); d[3] = bfhi(u.y); d[4] = bflo(u.z); d[5] = bfhi(u.z); d[6] = bflo(u.w); d[7] = bfhi(u.w); }
DI uint4 pack8(const float* d, float scl) { uint4 u; u.x = pack2(d[0] * scl, d[1] * scl); u.y = pack2(d[2] * scl, d[3] * scl); u.z = pack2(d[4] * scl, d[5] * scl); u.w = pack2(d[6] * scl, d[7] * scl); return u; }
DI float ssq8(const uint4 u) { float d[8]; unpack8(u, d); float s = 0.f;
#pragma unroll
    for (int i = 0; i < 8; ++i) s += d[i] * d[i];
    return s; }
DI void norm_rope_store(const uint4 (&raw)[12], const float* gain, int t, bool lat, float scl, bf16_t* dst) {
    float ss = 0.f;
#pragma unroll
    for (int i = 0; i < 12; ++i) ss += ssq8(raw[i]);
    const float r = rsqrtf(ss * (1.f / 96.f) + 1e-6f);
#pragma unroll
    for (int i = 0; i < 8; ++i) { float d[8]; unpack8(raw[i], d);
#pragma unroll
        for (int c = 0; c < 8; ++c) d[c] = d[c] * r * gain[i * 8 + c];
        *(uint4*)(dst + i * 8) = pack8(d, scl); }
    const float invf[8] = {1.f, 0.316227766016838f, 0.1f, 0.0316227766016838f, 0.01f, 0.00316227766016838f, 0.001f, 0.000316227766016838f};
    const float ri = (float)(t >> 6), ci = (float)(t & 63);
#pragma unroll
    for (int half = 0; half < 2; ++half) {
        float x1[8], x2[8], o1[8], o2[8]; unpack8(raw[8 + half], x1); unpack8(raw[10 + half], x2);
#pragma unroll
        for (int c = 0; c < 8; ++c) {
            const float ang = (half == 0 ? ri : ci) * invf[c];
            const float cs = lat ? __cosf(ang) : 1.f, sn = lat ? __sinf(ang) : 0.f;
            const float a = x1[c] * r * gain[64 + half * 8 + c], b = x2[c] * r * gain[80 + half * 8 + c];
            o1[c] = a * cs - b * sn; o2[c] = b * cs + a * sn;
        }
        *(uint4*)(dst + 64 + half * 8) = pack8(o1, scl); *(uint4*)(dst + 80 + half * 8) = pack8(o2, scl);
    }
}
DI void ph_finalize(const Ctx& cx, const Params& p, int j, int mq) {
    const int gtid = cx.bid * NTHR + cx.tid, gsz = cx.nblk * NTHR;
    const float* qg = p.b_q_gain + j * 96; const float* kg = p.b_k_gain + j * 96;
    for (int idx = gtid; idx < 8 * mq; idx += gsz) {
        const int h = idx / mq, row = idx % mq;
        const bool lat = row < NLAT; const int t = lat ? (row & 2047) : ((row - NLAT) & 255);
        bf16_t* qp = p.Qraw + (size_t)row * 768 + h * 96;
        uint4 raw[12];
#pragma unroll
        for (int i = 0; i < 12; ++i) raw[i] = *(const uint4*)(qp + i * 8);
        norm_rope_store(raw, qg, t, lat, (OPT >= 5) ? 0.10206207261596577f * 1.4426950408889634f : 0.10206207261596577f, qp);
    }
    for (int idx = gtid; idx < 8 * NT; idx += gsz) {
        const int h = idx / NT, row = idx % NT;
        const bool lat = row < NLAT; const int b = lat ? (row >> 11) : ((row - NLAT) >> 8); const int t = lat ? (row & 2047) : ((row - NLAT) & 255);
        const int key = lat ? 256 + t : t;
        const bf16_t* kvp = p.KVraw + (size_t)row * 1024 + h * 128; const bf16_t* krp = p.P + (size_t)row * PLD + ACOLS + 384;
        uint4 raw[12];
#pragma unroll
        for (int i = 0; i < 8; ++i) raw[i] = *(const uint4*)(kvp + i * 8);
#pragma unroll
        for (int i = 0; i < 4; ++i) raw[8 + i] = *(const uint4*)(krp + i * 8);
        norm_rope_store(raw, kg, t, lat, 1.f, p.Kf + ((size_t)(b * 8 + h) * 2304 + key) * 96);
    }
    for (int idx = gtid; idx < 8 * NT; idx += gsz) {
        const int h = idx / NT, row = idx % NT;
        const bool lat = row < NLAT; const int b = lat ? (row >> 11) : ((row - NLAT) >> 8); const int t = lat ? (row & 2047) : ((row - NLAT) & 255);
        const int key = lat ? 256 + t : t;
        const bf16_t* vp = p.KVraw + (size_t)row * 1024 + h * 128 + 64;
        bf16_t* vo = p.Vt + (size_t)(b * 8 + h) * 64 * 2304 + key;
#pragma unroll 1
        for (int i = 0; i < 8; ++i) { const uint4 u = *(const uint4*)(vp + i * 8);
            vo[0] = (bf16_t)(u.x & 0xffff); vo[2304] = (bf16_t)(u.x >> 16); vo[2 * 2304] = (bf16_t)(u.y & 0xffff); vo[3 * 2304] = (bf16_t)(u.y >> 16);
            vo[4 * 2304] = (bf16_t)(u.z & 0xffff); vo[5 * 2304] = (bf16_t)(u.z >> 16); vo[6 * 2304] = (bf16_t)(u.w & 0xffff); vo[7 * 2304] = (bf16_t)(u.w >> 16);
            vo += 8 * 2304; }
    }
}
DI void ph_attn(const Ctx& cx, const Params& p, bool with_ctx) {
    const int gtid = cx.bid * NTHR + cx.tid, gsz = cx.nblk * NTHR;
    const int total = NLAT * 8 + (with_ctx ? NCTX * 8 : 0);
    for (int idx = gtid; idx < total; idx += gsz) {
        int b, h, row, nkeys;
        if (idx < NLAT * 8) { b = idx >> 14; h = (idx >> 11) & 7; row = b * 2048 + (idx & 2047); nkeys = 2304; }
        else { const int i2 = idx - NLAT * 8; b = i2 >> 11; h = (i2 >> 8) & 7; row = NLAT + b * 256 + (i2 & 255); nkeys = 256; }
        const bf16_t* qp = p.Qraw + (size_t)row * 768 + h * 96;
        const bf16_t* Kb = p.Kf + (size_t)(b * 8 + h) * 2304 * 96; const bf16_t* Vb = p.Vt + (size_t)(b * 8 + h) * 64 * 2304;
        float q[96];
#pragma unroll
        for (int i = 0; i < 12; ++i) { const uint4 u = *(const uint4*)(qp + i * 8); q[i * 8] = bflo(u.x); q[i * 8 + 1] = bfhi(u.x); q[i * 8 + 2] = bflo(u.y); q[i * 8 + 3] = bfhi(u.y);
            q[i * 8 + 4] = bflo(u.z); q[i * 8 + 5] = bfhi(u.z); q[i * 8 + 6] = bflo(u.w); q[i * 8 + 7] = bfhi(u.w); }
        float acc[64];
#pragma unroll
        for (int i = 0; i < 64; ++i) acc[i] = 0.f;
        float mx = -3.0e38f, l = 0.f;
        for (int key0 = 0; key0 < nkeys; key0 += 8) {
            float s[8];
#pragma unroll
            for (int kk = 0; kk < 8; ++kk) {
                const uint4* kp = (const uint4*)(Kb + (size_t)(key0 + kk) * 96); float a = 0.f;
#pragma unroll
                for (int i = 0; i < 12; ++i) { const uint4 u = kp[i]; a += q[i * 8] * bflo(u.x) + q[i * 8 + 1] * bfhi(u.x) + q[i * 8 + 2] * bflo(u.y) + q[i * 8 + 3] * bfhi(u.y)
                    + q[i * 8 + 4] * bflo(u.z) + q[i * 8 + 5] * bfhi(u.z) + q[i * 8 + 6] * bflo(u.w) + q[i * 8 + 7] * bfhi(u.w); }
                s[kk] = a;
            }
            float cm = s[0];
#pragma unroll
            for (int kk = 1; kk < 8; ++kk) cm = fmaxf(cm, s[kk]);
            const float mn = fmaxf(mx, cm), alpha = expf(mx - mn);
            float ps = 0.f;
#pragma unroll
            for (int kk = 0; kk < 8; ++kk) { s[kk] = expf(s[kk] - mn); ps += s[kk]; }
            l = l * alpha + ps; mx = mn;
#pragma unroll
            for (int dv = 0; dv < 64; ++dv) {
                const uint4 u = *(const uint4*)(Vb + (size_t)dv * 2304 + key0);
                acc[dv] = acc[dv] * alpha + s[0] * bflo(u.x) + s[1] * bfhi(u.x) + s[2] * bflo(u.y) + s[3] * bfhi(u.y) + s[4] * bflo(u.z) + s[5] * bfhi(u.z) + s[6] * bflo(u.w) + s[7] * bfhi(u.w);
            }
        }
        const float il = 1.f / l;
        bf16_t* o = p.H + (size_t)row * 1024 + 512 + h * 64;
#pragma unroll
        for (int i = 0; i < 8; ++i) { uint4 u; u.x = pack2(acc[i * 8] * il, acc[i * 8 + 1] * il); u.y = pack2(acc[i * 8 + 2] * il, acc[i * 8 + 3] * il);
            u.z = pack2(acc[i * 8 + 4] * il, acc[i * 8 + 5] * il); u.w = pack2(acc[i * 8 + 6] * il, acc[i * 8 + 7] * il); *(uint4*)(o + i * 8) = u; }
    }
}
DI float shiftp(const bf16_t* P, int row, int t, int T, int col, float mu) {
    const float c = bf2f(P[(size_t)row * PLD + col]);
    const float pv = (t > 0) ? bf2f(P[(size_t)(row - 1) * PLD + col]) : 0.f;
    const float nx = (t < T - 1) ? bf2f(P[(size_t)(row + 1) * PLD + col]) : 0.f;
    return c + mu * (0.5f * (pv + nx) - c);
}
DI void ph_prepLR(const Ctx& cx, const Params& p, int j) {
    const int gtid = cx.bid * NTHR + cx.tid, gsz = cx.nblk * NTHR;
    const float* mu = p.a_mu + j * ACOLS + 1536;
    for (int idx = gtid; idx < NT * 384; idx += gsz) {
        const int row = idx / 384, col = idx % 384;
        const bool lat = row < NLAT; const int t = lat ? (row & 2047) : ((row - NLAT) & 255); const int T = lat ? 2048 : 256;
        float v = shiftp(p.P, row, t, T, 1536 + col, mu[col]);
        if (col < 128) v = tanhf(v); else if (col >= 256) v = sigm(v);
        p.LR[(size_t)row * 384 + col] = f2bf(v);
    }
}
DI void ph_wag(const Ctx& cx, const Params& p, float* lds, int j) {
    for (int d = 0; d < 2; ++d) {
        const float* W2 = p.a_w2 + (size_t)(j * 2 + d) * 64 * 512; const float* w0 = p.a_w0 + (j * 2 + d) * 512;
        ngemm<false>(cx, lds, 1, NT, 512, 64,
            [&](int, int m) { return p.LR + (size_t)m * 384 + d * 64; },
            [&](int, int k) { return W2 + (size_t)k * 512; }, [&](int, int) { return (const float*)nullptr; },
            [&](int, int m, int n, float v, float) { const float z = -0.606531f * sigm(w0[n] + v); p.WAG[(size_t)m * WLD + d * 512 + n] = f2bf(-expm1f(z)); });
        const float* A2 = p.a_a2 + (size_t)(j * 2 + d) * 64 * 512; const float* a0 = p.a_a0 + (j * 2 + d) * 512;
        ngemm<false>(cx, lds, 1, NT, 512, 64,
            [&](int, int m) { return p.LR + (size_t)m * 384 + 128 + d * 64; },
            [&](int, int k) { return A2 + (size_t)k * 512; }, [&](int, int) { return (const float*)nullptr; },
            [&](int, int m, int n, float v, float) { p.WAG[(size_t)m * WLD + 1024 + d * 512 + n] = f2bf(sigm(a0[n] + v)); });
    }
    const float* G2 = p.a_g2 + (size_t)j * 128 * 512;
    ngemm<false>(cx, lds, 1, NT, 512, 128,
        [&](int, int m) { return p.LR + (size_t)m * 384 + 256; },
        [&](int, int k) { return G2 + (size_t)k * 512; }, [&](int, int) { return (const float*)nullptr; },
        [&](int, int m, int n, float v, float) { p.WAG[(size_t)m * WLD + 2048 + n] = f2bf(v); });
}
DI void ph_scan(const Ctx& cx, const Params& p, float* lds, int j) {
    const int tid = cx.tid, lane = tid & 63;
    if (tid < 64) {
        for (int item = cx.bid; item < 256; item += cx.nblk) {
            const int b = item >> 4, h = (item >> 1) & 7, dir = item & 1, hc = h * 64 + lane;
            float S[64];
#pragma unroll
            for (int k = 0; k < 64; ++k) S[k] = 0.f;
            const float kkc = p.a_k_k[j * 512 + hc], kac = p.a_k_a[j * 512 + hc];
            const float mur = p.a_mu[j * ACOLS + hc], muk = p.a_mu[j * ACOLS + 512 + hc], muv = p.a_mu[j * ACOLS + 1024 + hc];
            bf16_t* yout = dir ? p.YB : p.YF;
            for (int step = 0; step < 2304; ++step) {
                const bool cp = step < 256; const int tt = cp ? step : step - 256, T = cp ? 256 : 2048, t = dir ? (T - 1 - tt) : tt;
                const int row = cp ? NLAT + b * 256 + t : b * 2048 + t;
                const float R = shiftp(p.P, row, t, T, hc, mur), K = shiftp(p.P, row, t, T, 512 + hc, muk), V = shiftp(p.P, row, t, T, 1024 + hc, muv);
                const float w = 1.f - bf2f(p.WAG[(size_t)row * WLD + dir * 512 + hc]), a = bf2f(p.WAG[(size_t)row * WLD + 1024 + dir * 512 + hc]);
                const float kkv = K * kkc, ssq = wave_sum(kkv * kkv), kk = kkv * rsqrtf(ssq + 1e-12f);
                const float kd = K * (1.f + (a - 1.f) * kac), bd = kk * a;
                lds[lane] = -kk; lds[64 + lane] = w; lds[128 + lane] = bd; lds[192 + lane] = kd; lds[256 + lane] = R;
                __builtin_amdgcn_wave_barrier();
                float sa = 0.f;
#pragma unroll
                for (int k4 = 0; k4 < 16; ++k4) { const float4 v = *(const float4*)(lds + k4 * 4); sa += S[k4 * 4] * v.x + S[k4 * 4 + 1] * v.y + S[k4 * 4 + 2] * v.z + S[k4 * 4 + 3] * v.w; }
                float y = 0.f;
#pragma unroll
                for (int k4 = 0; k4 < 16; ++k4) {
                    const float4 wv = *(const float4*)(lds + 64 + k4 * 4), bv = *(const float4*)(lds + 128 + k4 * 4), kv = *(const float4*)(lds + 192 + k4 * 4), rv = *(const float4*)(lds + 256 + k4 * 4);
                    S[k4 * 4] = S[k4 * 4] * wv.x + sa * bv.x + V * kv.x; S[k4 * 4 + 1] = S[k4 * 4 + 1] * wv.y + sa * bv.y + V * kv.y;
                    S[k4 * 4 + 2] = S[k4 * 4 + 2] * wv.z + sa * bv.z + V * kv.z; S[k4 * 4 + 3] = S[k4 * 4 + 3] * wv.w + sa * bv.w + V * kv.w;
                    y += S[k4 * 4] * rv.x + S[k4 * 4 + 1] * rv.y + S[k4 * 4 + 2] * rv.z + S[k4 * 4 + 3] * rv.w;
                }
                __builtin_amdgcn_wave_barrier();
                yout[(size_t)row * 512 + hc] = f2bf(y);
            }
        }
    }
    __syncthreads();
}
DI void ph_post(const Ctx& cx, const Params& p, int j, int nrows) {
    const int gtid = cx.bid * NTHR + cx.tid, gsz = cx.nblk * NTHR;
    for (int idx = gtid; idx < 8 * nrows; idx += gsz) {
        const int h = idx / nrows, row = idx % nrows;
        const bool lat = row < NLAT; const int t = lat ? (row & 2047) : ((row - NLAT) & 255); const int T = lat ? 2048 : 256;
        float sum = 0.f, sb = 0.f;
#pragma unroll 8
        for (int n = 0; n < 64; ++n) {
            const int hc = h * 64 + n;
            const float yy = bf2f(p.YF[(size_t)row * 512 + hc]) + bf2f(p.YB[(size_t)row * 512 + hc]);
            sum += yy;
            const float R = shiftp(p.P, row, t, T, hc, p.a_mu[j * ACOLS + hc]), K = shiftp(p.P, row, t, T, 512 + hc, p.a_mu[j * ACOLS + 512 + hc]);
            const float af = bf2f(p.WAG[(size_t)row * WLD + 1024 + hc]), ab = bf2f(p.WAG[(size_t)row * WLD + 1536 + hc]);
            const float ka = p.a_k_a[j * 512 + hc], rk = p.a_r_k[j * 512 + hc];
            sb += R * rk * (K * (1.f + (af - 1.f) * ka) + K * (1.f + (ab - 1.f) * ka));
        }
        const float mean = sum * (1.f / 64.f); float var = 0.f;
#pragma unroll 8
        for (int n = 0; n < 64; ++n) { const int hc = h * 64 + n; const float yy = bf2f(p.YF[(size_t)row * 512 + hc]) + bf2f(p.YB[(size_t)row * 512 + hc]); var += (yy - mean) * (yy - mean); }
        const float rstd = rsqrtf(var * (1.f / 64.f) + 64e-5f);
#pragma unroll 8
        for (int n = 0; n < 64; ++n) {
            const int hc = h * 64 + n;
            const float yy = bf2f(p.YF[(size_t)row * 512 + hc]) + bf2f(p.YB[(size_t)row * 512 + hc]);
            const float V = shiftp(p.P, row, t, T, 1024 + hc, p.a_mu[j * ACOLS + 1024 + hc]);
            const float g = bf2f(p.WAG[(size_t)row * WLD + 2048 + hc]);
            const float o = ((yy - mean) * rstd * p.a_ln_w[j * 512 + hc] + p.a_ln_b[j * 512 + hc] + sb * V) * g;
            p.H[(size_t)row * 1024 + hc] = f2bf(o);
        }
    }
}
DI void ph_wout(const Ctx& cx, const Params& p, float* lds, const bf16_t* A, const float* W, int nrows, const float* xin_lat, const float* xin_ctx, const float* modl) {
    ngemm<false>(cx, lds, 1, nrows, 1024, 1024,
        [&](int, int m) { return A + (size_t)m * 1024; },
        [&](int, int k) { return W + (size_t)k * 1024; }, [&](int, int) { return (const float*)nullptr; },
        [&](int, int m, int n, float v, float) {
            const bool lat = m < NLAT; const int jj = lat ? (m >> 11) : 16; const float g1 = modl[(size_t)jj * 6144 + 2 * 1024 + n];
            if (lat) p.out[(size_t)m * 1024 + n] = xin_lat[(size_t)m * 1024 + n] + g1 * v;
            else p.ctxs[(size_t)(m - NLAT) * 1024 + n] = xin_ctx[(size_t)(m - NLAT) * 1024 + n] + g1 * v; });
}

DI void ph_chdft(const Ctx& cx, const Params& p, float* lds, int nrows) {
    const int tid = cx.tid, gtid = cx.bid * NTHR + tid, gsz = cx.nblk * NTHR;
    for (int i = tid; i < 128; i += NTHR) { lds[i] = cospif((float)i * (1.f / 64.f)); lds[128 + i] = sinpif((float)i * (1.f / 64.f)); }
    __syncthreads();
    for (int idx = gtid; idx < nrows * 1024; idx += gsz) {
        const int row = idx >> 10, col = idx & 1023, grp = col >> 7, g = col & 127;
        const bf16_t* hp = p.H + (size_t)row * 1024 + grp * 128;
        float gr = 0.f, gi = 0.f;
        for (int c = 0; c < 128; ++c) { const float xv = bf2f(hp[c]); const int m = (c * g) & 127; gr += xv * lds[m]; gi -= xv * lds[128 + m]; }
        p.G[(size_t)row * 2048 + col] = gr; p.G[(size_t)row * 2048 + 1024 + col] = gi;
    }
    __syncthreads();
}
DI void ph_posdft(const Ctx& cx, const Params& p, float* lds, bool with_ctx) {
    ngemm<false>(cx, lds, 16, 2048, 1024, 4096,
        [&](int, int m) { return p.dftl + (size_t)m * 4096; },
        [&](int bz, int k) { return (k < 2048) ? p.G + (size_t)(bz * 2048 + k) * 2048 : p.G + (size_t)(bz * 2048 + k - 2048) * 2048 + 1024; }, [&](int, int) { return (const float*)nullptr; },
        [&](int bz, int m, int n, float v, float) { p.F[(size_t)(bz * 2048 + m) * 1024 + n] = f2bf(v * (1.f / 512.f)); });
    if (with_ctx)
        ngemm<false>(cx, lds, 16, 256, 1024, 512,
            [&](int, int m) { return p.dftc + (size_t)m * 512; },
            [&](int bz, int k) { return (k < 256) ? p.G + (size_t)(NLAT + bz * 256 + k) * 2048 : p.G + (size_t)(NLAT + bz * 256 + k - 256) * 2048 + 1024; }, [&](int, int) { return (const float*)nullptr; },
            [&](int bz, int m, int n, float v, float) { p.F[(size_t)(NLAT + bz * 256 + m) * 1024 + n] = f2bf(v * 0.0055242717280199f); });
}

DI void ph_moe_up(const Ctx& cx, const Params& p, float* lds, int layer, int nrows) {
    for (int e = 0; e < 17; ++e) {
        const int M = (e < 16) ? __builtin_amdgcn_readfirstlane(p.cnt[(layer * 16 + e) * 64]) : nrows;
        const float* Wg = (e < 16) ? p.moe_w_gate + ((size_t)layer * 16 + e) * 1024 * 512 : p.sh_gate + (size_t)layer * 1024 * 512;
        const float* Wu = (e < 16) ? p.moe_w_up + ((size_t)layer * 16 + e) * 1024 * 512 : p.sh_up + (size_t)layer * 1024 * 512;
        const int* sl = p.slot + (size_t)(e & 15) * NT;
        ngemm<true>(cx, lds, 1, M, 512, 1024,
            [&](int, int m) { const int tok = (e < 16) ? (sl[m] >> 1) : m; return p.H + (size_t)tok * 1024; },
            [&](int, int k) { return Wg + (size_t)k * 512; }, [&](int, int k) { return Wu + (size_t)k * 512; },
            [&](int, int m, int n, float g, float u) { const int s = (e < 16) ? sl[m] : 0; const int tok = (e < 16) ? (s >> 1) : m, slab = (e < 16) ? (s & 1) : 2;
                p.ACT[((size_t)slab * NT + tok) * 512 + n] = f2bf(siluf(g) * u); });
    }
}
DI void ph_moe_down(const Ctx& cx, const Params& p, float* lds, int layer, int nrows) {
    for (int e = 0; e < 17; ++e) {
        const int M = (e < 16) ? __builtin_amdgcn_readfirstlane(p.cnt[(layer * 16 + e) * 64]) : nrows;
        const float* Wd = (e < 16) ? p.moe_w_down + ((size_t)layer * 16 + e) * 512 * 1024 : p.sh_down + (size_t)layer * 512 * 1024;
        const int* sl = p.slot + (size_t)(e & 15) * NT;
        ngemm<false>(cx, lds, 1, M, 1024, 512,
            [&](int, int m) { const int s = (e < 16) ? sl[m] : 0; const int tok = (e < 16) ? (s >> 1) : m, slab = (e < 16) ? (s & 1) : 2; return p.ACT + ((size_t)slab * NT + tok) * 512; },
            [&](int, int k) { return Wd + (size_t)k * 1024; }, [&](int, int) { return (const float*)nullptr; },
            [&](int, int m, int n, float v, float) { const int s = (e < 16) ? sl[m] : 0; const int tok = (e < 16) ? (s >> 1) : m, slab = (e < 16) ? (s & 1) : 2;
                const float w = (e < 16) ? p.tokw[s] : 1.f; p.Y[((size_t)slab * NT + tok) * 1024 + n] = f2bf(w * v); });
    }
}

namespace mm {
typedef short bf16x8 __attribute__((ext_vector_type(8)));
typedef float f32x4 __attribute__((ext_vector_type(4)));
typedef unsigned u32x4 __attribute__((ext_vector_type(4)));
constexpr int BM = 256, BK = 64, HALF = 128, HTB = HALF * BK * 2, STAGE_BYTES = 8 * HTB;
DI int lds_byte(int r, int c) { const int st = (r >> 4) * 2 + (c >> 5), rr = r & 15, cc = c & 31, ob = rr * 64 + cc * 2; return st * 1024 + (ob ^ (((ob >> 9) & 1) << 5)); }
DI void stage_rc(int b, int& R, int& C) { const int st = b / 1024, sb = b % 1024, swz = sb ^ (((sb >> 9) & 1) << 5); R = (st >> 1) * 16 + swz / 64; C = (st & 1) * 32 + (swz % 64) / 2; }
DI int perm32(int rho) { const int n = rho >> 4, i = rho & 15; return 8 * (i >> 2) + 4 * n + (i & 3); }
DI unsigned cvt_pk_bf16(float lo, float hi) { unsigned r; asm volatile("v_cvt_pk_bf16_f32 %0, %1, %2" : "=v"(r) : "v"(lo), "v"(hi)); return r; }
struct Unit { const char* A; const char* B; int pm, pn, e, m; };
template <class Sched, class Epi>
DI void gemm_phase(LAS unsigned char* lds, const int K, const Sched& S, const Epi& E, const int tid) {
    const int wid = __builtin_amdgcn_readfirstlane(tid >> 6), lane = tid & 63, wr = wid >> 2, wc = wid & 3, fr = lane & 15, fq = lane >> 4;
    const int nt = K / BK;
    int R0, C0, R1, C1; stage_rc(tid * 16, R0, C0); stage_rc(tid * 16 + 8192, R1, C1);
    unsigned voffB[2];
    { const int Rb0 = Epi::PERM ? ((R0 & ~31) + perm32(R0 & 31)) : R0, Rb1 = Epi::PERM ? ((R1 & ~31) + perm32(R1 & 31)) : R1;
      voffB[0] = (unsigned)(Rb0 * K + C0) * 2u; voffB[1] = (unsigned)(Rb1 * K + C1) * 2u; }
    const size_t kstep = (size_t)(BK * 2), hstepB = (size_t)HALF * K * 2, hstepA = S.hstep_a();
    const unsigned ldsw = (unsigned)wid * 1024u;
    const int aoff = lds_byte(wr * 64 + fr, fq * 8), boff = lds_byte(wc * 32 + fr, fq * 8);
#define MM_SA(b, h) (((b) * 2 + (h)) * HTB)
#define MM_SB(b, h) ((4 + (b) * 2 + (h)) * HTB)
#define MM_STAGE_A(bufoff, gbase, h, offs) do { _Pragma("unroll") for (int _i = 0; _i < 2; ++_i) { \
        if constexpr (Sched::GATHER) __builtin_amdgcn_global_load_lds((const unsigned*)((const char*)(gbase) + (offs)[h][_i]), (LAS unsigned*)(lds + (bufoff) + ldsw + _i * 8192), 16, 0, 0); \
        else __builtin_amdgcn_global_load_lds((const unsigned*)((const char*)(gbase) + (size_t)(h) * hstepA + (offs)[0][_i]), (LAS unsigned*)(lds + (bufoff) + ldsw + _i * 8192), 16, 0, 0); } } while (0)
#define MM_STAGE_B(bufoff, gbase) do { _Pragma("unroll") for (int _i = 0; _i < 2; ++_i) \
        __builtin_amdgcn_global_load_lds((const unsigned*)((const char*)(gbase) + voffB[_i]), (LAS unsigned*)(lds + (bufoff) + ldsw + _i * 8192), 16, 0, 0); } while (0)
#define MM_LDA(dst, b, h) do { _Pragma("unroll") for (int m = 0; m < 4; ++m) _Pragma("unroll") for (int k = 0; k < 2; ++k) dst[m][k] = *(const LAS bf16x8*)(lds + MM_SA(b, h) + aoff + m * 2048 + k * 1024); } while (0)
#define MM_LDB(dst, b, h) do { _Pragma("unroll") for (int n = 0; n < 2; ++n) _Pragma("unroll") for (int k = 0; k < 2; ++k) dst[n][k] = *(const LAS bf16x8*)(lds + MM_SB(b, h) + boff + n * 2048 + k * 1024); } while (0)
#define MM_MMA(ai, bj, At, Bt) do { __builtin_amdgcn_s_setprio(1); _Pragma("unroll") for (int m = 0; m < 4; ++m) _Pragma("unroll") for (int n = 0; n < 2; ++n) _Pragma("unroll") for (int k = 0; k < 2; ++k) \
        acc[ai][bj][m][n] = __builtin_amdgcn_mfma_f32_16x16x32_bf16(Bt[n][k], At[m][k], acc[ai][bj][m][n], 0, 0, 0); __builtin_amdgcn_s_setprio(0); } while (0)
#define MM_WAIT_V(n) asm volatile("s_waitcnt vmcnt(" #n ")" ::: "memory")
#define MM_WAIT_L(n) asm volatile("s_waitcnt lgkmcnt(" #n ")" ::: "memory")
#define MM_BAR __builtin_amdgcn_s_barrier()
#define MM_SCHED __builtin_amdgcn_sched_barrier(0)
    Unit cur, nxt; int ui = 0;
    if (!S.next(0, cur)) return;
    unsigned oa[2][2], on[2][2];
    S.aoff(cur, R0, C0, R1, C1, oa);
    f32x4 acc[2][2][4][2];
#pragma unroll
    for (int a = 0; a < 2; ++a)
#pragma unroll
        for (int b = 0; b < 2; ++b)
#pragma unroll
            for (int m = 0; m < 4; ++m)
#pragma unroll
                for (int n = 0; n < 2; ++n) acc[a][b][m][n] = (f32x4){0.f, 0.f, 0.f, 0.f};
    bf16x8 At[4][2], B0[2][2], B1[2][2];
    const char* cA = cur.A; const char* cB = cur.B;
    MM_STAGE_B(MM_SB(0, 0), cB); MM_STAGE_A(MM_SA(0, 0), cA, 0, oa); MM_STAGE_B(MM_SB(0, 1), cB + hstepB); MM_STAGE_A(MM_SA(0, 1), cA, 1, oa);
    if (wr == 1) MM_BAR;
    MM_WAIT_V(4); MM_BAR;
    MM_STAGE_B(MM_SB(1, 0), cB + kstep); MM_STAGE_A(MM_SA(1, 0), cA + kstep, 0, oa); MM_STAGE_B(MM_SB(1, 1), cB + hstepB + kstep);
    MM_WAIT_V(6); MM_BAR;
    for (;;) {
        const bool has_next = S.next(ui + 1, nxt);
        if constexpr (Sched::GATHER) { if (has_next) S.aoff(nxt, R0, C0, R1, C1, on);
            else { on[0][0] = oa[0][0]; on[0][1] = oa[0][1]; on[1][0] = oa[1][0]; on[1][1] = oa[1][1]; } }
        const char* nA = has_next ? nxt.A : cA; const char* nB = has_next ? nxt.B : cB;
        for (int t = 0; t < nt; t += 2) {
            const bool last = (t == nt - 2);
            const char* a1 = cA + (size_t)(t + 1) * kstep;
            const char* a2 = last ? nA : cA + (size_t)(t + 2) * kstep; const char* b2 = last ? nB : cB + (size_t)(t + 2) * kstep;
            const char* a3 = a2 + kstep; const char* b3 = b2 + kstep;
            unsigned o2[2][2];
            if constexpr (Sched::GATHER) { o2[0][0] = last ? on[0][0] : oa[0][0]; o2[0][1] = last ? on[0][1] : oa[0][1]; o2[1][0] = last ? on[1][0] : oa[1][0]; o2[1][1] = last ? on[1][1] : oa[1][1]; }
            else { o2[0][0] = oa[0][0]; o2[0][1] = oa[0][1]; o2[1][0] = oa[1][0]; o2[1][1] = oa[1][1]; }
            MM_LDB(B0, 0, 0); MM_SCHED; MM_LDA(At, 0, 0); MM_STAGE_A(MM_SA(1, 1), a1, 1, oa);
            MM_WAIT_L(8); MM_BAR; MM_WAIT_L(0); MM_MMA(0, 0, At, B0); MM_BAR; MM_SCHED;
            MM_LDB(B1, 0, 1); MM_STAGE_B(MM_SB(0, 0), b2);
            MM_BAR; MM_WAIT_L(0); MM_MMA(0, 1, At, B1); MM_BAR;
            MM_LDA(At, 0, 1); MM_STAGE_A(MM_SA(0, 0), a2, 0, o2);
            MM_BAR; MM_WAIT_L(0); MM_MMA(1, 0, At, B0); MM_BAR; MM_SCHED;
            MM_STAGE_B(MM_SB(0, 1), b2 + hstepB);
            MM_WAIT_V(6); MM_BAR; MM_MMA(1, 1, At, B1); MM_BAR;
            MM_LDB(B0, 1, 0); MM_SCHED; MM_LDA(At, 1, 0); MM_STAGE_A(MM_SA(0, 1), a2, 1, o2);
            MM_WAIT_L(8); MM_BAR; MM_WAIT_L(0); MM_MMA(0, 0, At, B0); MM_BAR; MM_SCHED;
            MM_LDB(B1, 1, 1); MM_STAGE_B(MM_SB(1, 0), b3);
            MM_BAR; MM_WAIT_L(0); MM_MMA(0, 1, At, B1); MM_BAR;
            MM_LDA(At, 1, 1); MM_STAGE_A(MM_SA(1, 0), a3, 0, o2);
            MM_BAR; MM_WAIT_L(0); MM_MMA(1, 0, At, B0); MM_BAR; MM_SCHED;
            MM_STAGE_B(MM_SB(1, 1), b3 + hstepB);
            MM_WAIT_V(6); MM_BAR; MM_MMA(1, 1, At, B1); MM_BAR;
        }
        E(acc, cur, wr, wc, fr, fq);
        if (!has_next) break;
#pragma unroll
        for (int a = 0; a < 2; ++a)
#pragma unroll
            for (int b = 0; b < 2; ++b)
#pragma unroll
                for (int m = 0; m < 4; ++m)
#pragma unroll
                    for (int n = 0; n < 2; ++n) acc[a][b][m][n] = (f32x4){0.f, 0.f, 0.f, 0.f};
        cur = nxt; cA = nA; cB = nB; ++ui;
        if constexpr (Sched::GATHER) { oa[0][0] = on[0][0]; oa[0][1] = on[0][1]; oa[1][0] = on[1][0]; oa[1][1] = on[1][1]; }
    }
    MM_WAIT_V(0);
    if (wr == 0) MM_BAR;
    MM_BAR;
#undef MM_SA
#undef MM_SB
#undef MM_STAGE_A
#undef MM_STAGE_B
#undef MM_LDA
#undef MM_LDB
#undef MM_MMA
#undef MM_WAIT_V
#undef MM_WAIT_L
#undef MM_BAR
#undef MM_SCHED
}
struct StaticSched {
    static constexpr bool GATHER = false;
    const char* A; const char* Bt; int lda, K, nM, nN, nwg, G, c;
    DI size_t hstep_a() const { return (size_t)HALF * lda * 2; }
    DI void init(const void* A_, const void* Bt_, int M, int N, int K_, int lda_, int G_, int c_) { A = (const char*)A_; Bt = (const char*)Bt_; lda = lda_; K = K_; nM = M / BM; nN = N / BM; nwg = nM * nN; G = G_; c = c_; }
    DI bool next(int i, Unit& u) const {
        const int L = i * G + c; if (L >= nwg) return false;
        int wgid = L; { const int q = nwg / 8, r = nwg % 8, xcd = wgid % 8, off = wgid / 8; wgid = (xcd < r ? xcd * (q + 1) : r * (q + 1) + (xcd - r) * q) + off; }
        const int nig = 8 * nN, gid = wgid / nig, fm = gid * 8, gsz = (nM - fm) < 8 ? (nM - fm) : 8;
        u.pm = fm + ((wgid % nig) % gsz); u.pn = (wgid % nig) / gsz; u.e = 0; u.m = 0;
        u.A = A + (size_t)u.pm * BM * lda * 2; u.B = Bt + (size_t)u.pn * BM * K * 2; return true;
    }
    DI void aoff(const Unit&, int R0, int C0, int R1, int C1, unsigned (&o)[2][2]) const {
        o[0][0] = (unsigned)(R0 * lda + C0) * 2u; o[0][1] = (unsigned)(R1 * lda + C1) * 2u;
        o[1][0] = (unsigned)((HALF + R0) * lda + C0) * 2u; o[1][1] = (unsigned)((HALF + R1) * lda + C1) * 2u;
    }
};
struct BatchSched {
    static constexpr bool GATHER = false;
    const char* A; const char* Bt; int K, nM, nN, nb, G, c; size_t bstride;
    DI size_t hstep_a() const { return (size_t)HALF * K * 2; }
    DI void init(const void* A_, const void* Bt_, size_t bstride_bytes, int nb_, int M, int N, int K_, int G_, int c_) { A = (const char*)A_; Bt = (const char*)Bt_; bstride = bstride_bytes; nb = nb_; K = K_; nM = M / BM; nN = N / BM; G = G_; c = c_; }
    DI bool next(int i, Unit& u) const {
        const int L = i * G + c; if (L >= nb * nM * nN) return false;
        const int b = L / (nM * nN), rem = L % (nM * nN); u.pm = rem / nN; u.pn = rem % nN; u.e = b; u.m = 0;
        u.A = A + (size_t)u.pm * BM * K * 2; u.B = Bt + (size_t)b * bstride + (size_t)u.pn * BM * K * 2; return true;
    }
    DI void aoff(const Unit&, int R0, int C0, int R1, int C1, unsigned (&o)[2][2]) const {
        o[0][0] = (unsigned)(R0 * K + C0) * 2u; o[0][1] = (unsigned)(R1 * K + C1) * 2u;
        o[1][0] = (unsigned)((HALF + R0) * K + C0) * 2u; o[1][1] = (unsigned)((HALF + R1) * K + C1) * 2u;
    }
};
struct EpiBf16Store {
    static constexpr bool PERM = true;
    bf16_t* O; int ldc;
    DI void operator()(const f32x4 (&acc)[2][2][4][2], const Unit& u, int wr, int wc, int fr, int fq) const {
        const int row0 = u.pm * BM + wr * 64 + fr, col0 = u.pn * BM + wc * 32 + 8 * fq;
#pragma unroll
        for (int ai = 0; ai < 2; ++ai)
#pragma unroll
            for (int m = 0; m < 4; ++m) { bf16_t* rowp = O + (size_t)(row0 + ai * HALF + m * 16) * ldc + col0;
#pragma unroll
                for (int bj = 0; bj < 2; ++bj) { const f32x4 v0 = acc[ai][bj][m][0], v1 = acc[ai][bj][m][1];
                    u32x4 w; w.x = cvt_pk_bf16(v0[0], v0[1]); w.y = cvt_pk_bf16(v0[2], v0[3]); w.z = cvt_pk_bf16(v1[0], v1[1]); w.w = cvt_pk_bf16(v1[2], v1[3]);
                    *(u32x4*)(rowp + bj * HALF) = w; } }
    }
};
struct EpiResid {
    static constexpr bool PERM = false;
    const float* xin_lat; const float* xin_ctx; float* out_lat; float* out_ctx; const float* modl; int batched_T;
    DI void operator()(const f32x4 (&acc)[2][2][4][2], const Unit& u, int wr, int wc, int fr, int fq) const {
        int grow0; if (batched_T == 0) grow0 = u.pm * BM; else if (batched_T > 0) grow0 = u.e * 2048 + u.pm * BM; else grow0 = NLAT + u.e * 256 + u.pm * BM;
        const bool lat = grow0 < NLAT; const int jj = lat ? (grow0 >> 11) : 16;
        const float* xi = lat ? xin_lat + (size_t)grow0 * 1024 : xin_ctx + (size_t)(grow0 - NLAT) * 1024;
        float* xo = lat ? out_lat + (size_t)grow0 * 1024 : out_ctx + (size_t)(grow0 - NLAT) * 1024;
        const float* g1 = modl + (size_t)jj * 6144 + 2 * 1024;
        const int r0 = wr * 64 + fr, col0 = u.pn * BM + wc * 32 + 4 * fq;
        f32x4 gv[2][2];
#pragma unroll
        for (int bj = 0; bj < 2; ++bj)
#pragma unroll
            for (int n = 0; n < 2; ++n) gv[bj][n] = *(const f32x4*)(g1 + col0 + bj * HALF + n * 16);
#pragma unroll
        for (int ai = 0; ai < 2; ++ai)
#pragma unroll
            for (int m = 0; m < 4; ++m) { const size_t off = (size_t)(r0 + ai * HALF + m * 16) * 1024 + col0;
#pragma unroll
                for (int bj = 0; bj < 2; ++bj)
#pragma unroll
                    for (int n = 0; n < 2; ++n) { const f32x4 xv = *(const f32x4*)(xi + off + bj * HALF + n * 16); *(f32x4*)(xo + off + bj * HALF + n * 16) = xv + gv[bj][n] * acc[ai][bj][m][n]; }
                asm volatile("" ::: "memory"); }
    }
};
}

DI void tconv_tile(const Ctx& cx, float* T, const float* src, int ld_src, int k0, int n0, int kvalid, int nvalid, bf16_t* dst, int ldd, int drow0) {
    const int tid = cx.tid;
#pragma unroll
    for (int rr = 0; rr < 2; ++rr) {
        const int i = (tid >> 4) + 32 * rr, j = (tid & 15) * 4;
        float4 v = make_float4(0.f, 0.f, 0.f, 0.f);
        if (k0 + i < kvalid && n0 + j < nvalid) v = *(const float4*)(src + (size_t)(k0 + i) * ld_src + n0 + j);
        T[i * 65 + j] = v.x; T[i * 65 + j + 1] = v.y; T[i * 65 + j + 2] = v.z; T[i * 65 + j + 3] = v.w;
    }
    __syncthreads();
    { const int j = tid >> 3, ch = tid & 7; uint4 o;
      o.x = pack2(T[(ch * 8 + 0) * 65 + j], T[(ch * 8 + 1) * 65 + j]); o.y = pack2(T[(ch * 8 + 2) * 65 + j], T[(ch * 8 + 3) * 65 + j]);
      o.z = pack2(T[(ch * 8 + 4) * 65 + j], T[(ch * 8 + 5) * 65 + j]); o.w = pack2(T[(ch * 8 + 6) * 65 + j], T[(ch * 8 + 7) * 65 + j]);
      *(uint4*)(dst + (size_t)(drow0 + j) * ldd + k0 + ch * 8) = o; }
    __syncthreads();
}
DI void ph_prep_weights(const Ctx& cx, const Params& p, float* lds) {
    const int tid = cx.tid, gtid = cx.bid * NTHR + tid, gsz = cx.nblk * NTHR;
    for (int it = cx.bid; it < 2 * 1008; it += cx.nblk) {
        const int j = it / 1008; int r = it % 1008;
        if (r < 640) { const int kt = r / 40, ntl = r % 40; tconv_tile(cx, lds, p.w_in + (size_t)j * 1024 * INC, INC, kt * 64, ntl * 64, 1024, INC, p.WinT + (size_t)j * 2560 * 1024, 1024, ntl * 64); continue; } r -= 640;
        if (r < 48) { const int kt = r / 12, ntl = r % 12; tconv_tile(cx, lds, p.b_w_q_up + (size_t)j * 256 * 768, 768, kt * 64, ntl * 64, 256, 768, p.WqT + (size_t)j * 768 * 256, 256, ntl * 64); continue; } r -= 48;
        if (r < 64) { const int kt = r / 16, ntl = r % 16; tconv_tile(cx, lds, p.b_w_kv_up + (size_t)j * 128 * 1024, 1024, kt * 64, ntl * 64, 128, 1024, p.WkvT + (size_t)j * 1024 * 256, 256, ntl * 64); continue; } r -= 64;
        { const int kt = r / 16, ntl = r % 16; tconv_tile(cx, lds, p.w_out_even + (size_t)j * 1024 * 1024, 1024, kt * 64, ntl * 64, 1024, 1024, p.WoutT + (size_t)j * 1024 * 1024, 1024, ntl * 64); }
    }
    for (int idx = gtid; idx < 2 * 2560 * 384; idx += gsz) {
        const int j = idx / (2560 * 384), rem = idx % (2560 * 384), n = rem / 384, k = rem % 384; const int seg = n >> 9, nn = n & 511;
        float v = 0.f;
        if (seg < 2) { if ((k >> 6) == seg) v = p.a_w2[((size_t)(j * 2 + seg) * 64 + (k & 63)) * 512 + nn]; }
        else if (seg < 4) { if ((k >> 6) == seg) v = p.a_a2[((size_t)(j * 2 + seg - 2) * 64 + (k & 63)) * 512 + nn]; }
        else { if (k >= 256) v = p.a_g2[((size_t)j * 128 + (k - 256)) * 512 + nn]; }
        p.WlrT[idx] = f2bf(v);
    }
    {
        float* Tc = lds; float* Ts = lds + 64 * 65; float* tab = lds + 2 * 64 * 65;
        for (int i = tid; i < 128; i += NTHR) { tab[i] = cospif((float)i * (1.f / 64.f)); tab[128 + i] = sinpif((float)i * (1.f / 64.f)); }
        __syncthreads();
        for (int it = cx.bid; it < 2 * 256; it += cx.nblk) {
            const int j = it >> 8, ct = (it >> 4) & 15, et = it & 15; const float* Wf = p.w_out_fourier + (size_t)j * 1024 * 1024;
            const int el = tid & 63, e = et * 64 + el;
#pragma unroll 1
            for (int i = 0; i < 8; ++i) {
                const int chl = (tid >> 6) + 8 * i, ch = ct * 64 + chl, grp = ch >> 7, c = ch & 127;
                float sc = 0.f, ss = 0.f;
                for (int g = 0; g < 128; ++g) { const float w = Wf[(size_t)(grp * 128 + g) * 1024 + e]; const int m = (c * g) & 127; sc += tab[m] * w; ss += tab[128 + m] * w; }
                Tc[chl * 65 + el] = sc; Ts[chl * 65 + el] = ss;
            }
            __syncthreads();
            { const int el2 = tid >> 3, chunk = tid & 7; uint4 o, o2; const float* a = Tc + chunk * 8 * 65 + el2; const float* b = Ts + chunk * 8 * 65 + el2;
              o.x = pack2(a[0], a[65]); o.y = pack2(a[2 * 65], a[3 * 65]); o.z = pack2(a[4 * 65], a[5 * 65]); o.w = pack2(a[6 * 65], a[7 * 65]);
              o2.x = pack2(b[0], b[65]); o2.y = pack2(b[2 * 65], b[3 * 65]); o2.z = pack2(b[4 * 65], b[5 * 65]); o2.w = pack2(b[6 * 65], b[7 * 65]);
              bf16_t* d = p.A1 + (size_t)j * 2048 * 1024 + (size_t)(et * 64 + el2) * 1024 + ct * 64 + chunk * 8;
              *(uint4*)d = o; *(uint4*)(d + (size_t)1024 * 1024) = o2; }
            __syncthreads();
        }
    }
    for (int i = gtid; i < 2048 * 4096; i += gsz) {
        const int f = i >> 12, k = i & 4095, t = k & 2047, m = (f * t) & 2047; const float a = (float)m * (1.f / 1024.f);
        p.A2[i] = f2bf(((k < 2048) ? cospif(a) : -sinpif(a)) * (1.f / 512.f));
    }
    for (int i = gtid; i < 256 * 512; i += gsz) {
        const int f = i >> 9, k = i & 511, t = k & 255, m = (f * t) & 255; const float a = (float)m * (1.f / 128.f);
        p.A2c[i] = f2bf(((k < 256) ? cospif(a) : -sinpif(a)) * 0.0055242717280199f);
    }
    __syncthreads();
}
DI void ph_prep_moe(const Ctx& cx, const Params& p, float* lds, int layer) {
    for (int it = cx.bid; it < 17 * 384; it += cx.nblk) {
        const int e = it / 384; int r = it % 384;
        const float* Wg = (e < 16) ? p.moe_w_gate + ((size_t)layer * 16 + e) * 1024 * 512 : p.sh_gate + (size_t)layer * 1024 * 512;
        const float* Wu = (e < 16) ? p.moe_w_up + ((size_t)layer * 16 + e) * 1024 * 512 : p.sh_up + (size_t)layer * 1024 * 512;
        const float* Wd = (e < 16) ? p.moe_w_down + ((size_t)layer * 16 + e) * 512 * 1024 : p.sh_down + (size_t)layer * 512 * 1024;
        if (r < 256) { const int bj = r >> 7, kt = (r >> 3) & 15, ntl = r & 7, n0 = ntl * 64;
            tconv_tile(cx, lds, bj ? Wu : Wg, 512, kt * 64, n0, 1024, 512, p.WguT + (size_t)e * 1024 * 1024, 1024, (n0 >> 7) * 256 + bj * 128 + (n0 & 127)); }
        else { r -= 256; const int kt = r >> 4, ntl = r & 15; tconv_tile(cx, lds, Wd, 1024, kt * 64, ntl * 64, 512, 1024, p.WdT + (size_t)e * 1024 * 512, 512, ntl * 64); }
    }
}

#define GEMM_LDS(lds) ((LAS unsigned char*)(lds))
DI void ph_win_mm(const Ctx& cx, const Params& p, float* lds, int j) {
    mm::StaticSched S; S.init(p.H, p.WinT + (size_t)j * 2560 * 1024, NT, 2560, 1024, 1024, cx.nblk, cx.bid);
    mm::EpiBf16Store E{p.P, PLD};
    mm::gemm_phase(GEMM_LDS(lds), 1024, S, E, cx.tid);
}
DI void ph_wout_mm(const Ctx& cx, const Params& p, float* lds, const bf16_t* A, const bf16_t* Bt, int nrows, const float* xin_lat, const float* xin_ctx, const float* modl) {
    mm::StaticSched S; S.init(A, Bt, nrows, 1024, 1024, 1024, cx.nblk, cx.bid);
    mm::EpiResid E{xin_lat, xin_ctx, p.out, p.ctxs, modl, 0};
    mm::gemm_phase(GEMM_LDS(lds), 1024, S, E, cx.tid);
}

DI void ph_qkvup_mm(const Ctx& cx, const Params& p, float* lds, int j, int mq) {
    { mm::StaticSched S; S.init(p.QN, p.WqT + (size_t)j * 768 * 256, mq, 768, 256, 512, cx.nblk, cx.bid); mm::EpiBf16Store E{p.Qraw, 768}; mm::gemm_phase(GEMM_LDS(lds), 256, S, E, cx.tid); }
    { mm::StaticSched S; S.init(p.QN + 256, p.WkvT + (size_t)j * 1024 * 256, NT, 1024, 256, 512, cx.nblk, cx.bid); mm::EpiBf16Store E{p.KVraw, 1024}; mm::gemm_phase(GEMM_LDS(lds), 256, S, E, cx.tid); }
}
struct EpiWag {
    static constexpr bool PERM = true;
    bf16_t* O; const float* w0; const float* a0;
    DI void operator()(const mm::f32x4 (&acc)[2][2][4][2], const mm::Unit& u, int wr, int wc, int fr, int fq) const {
        const int row0 = u.pm * 256 + wr * 64 + fr, col0 = u.pn * 256 + wc * 32 + 8 * fq; const int seg = u.pn >> 2;
        const float* bp = (seg == 0) ? w0 + col0 : a0 + (col0 - 1024);
#pragma unroll
        for (int bj = 0; bj < 2; ++bj) {
            mm::f32x4 b0 = (mm::f32x4){0.f, 0.f, 0.f, 0.f}, b1 = b0;
            if (seg < 2) { b0 = *(const mm::f32x4*)(bp + bj * 128); b1 = *(const mm::f32x4*)(bp + bj * 128 + 4); }
#pragma unroll
            for (int ai = 0; ai < 2; ++ai)
#pragma unroll
                for (int m = 0; m < 4; ++m) {
                    mm::f32x4 v0 = acc[ai][bj][m][0] + b0, v1 = acc[ai][bj][m][1] + b1;
                    if (seg == 0) {
#pragma unroll
                        for (int c = 0; c < 4; ++c) { v0[c] = 1.f - __expf(-0.606531f * __builtin_amdgcn_rcpf(1.f + __expf(-v0[c]))); v1[c] = 1.f - __expf(-0.606531f * __builtin_amdgcn_rcpf(1.f + __expf(-v1[c]))); }
                    } else if (seg == 1) {
#pragma unroll
                        for (int c = 0; c < 4; ++c) { v0[c] = __builtin_amdgcn_rcpf(1.f + __expf(-v0[c])); v1[c] = __builtin_amdgcn_rcpf(1.f + __expf(-v1[c])); }
                    }
                    mm::u32x4 w; w.x = mm::cvt_pk_bf16(v0[0], v0[1]); w.y = mm::cvt_pk_bf16(v0[2], v0[3]); w.z = mm::cvt_pk_bf16(v1[0], v1[1]); w.w = mm::cvt_pk_bf16(v1[2], v1[3]);
                    *(mm::u32x4*)(O + (size_t)(row0 + ai * 128 + m * 16) * WLD + col0 + bj * 128) = w;
                }
        }
    }
};
DI void ph_wag_mm(const Ctx& cx, const Params& p, float* lds, int j) {
    mm::StaticSched S; S.init(p.LR, p.WlrT + (size_t)j * 2560 * 384, NT, 2560, 384, 384, cx.nblk, cx.bid);
    EpiWag E{p.WAG, p.a_w0 + j * 1024, p.a_a0 + j * 1024};
    mm::gemm_phase(GEMM_LDS(lds), 384, S, E, cx.tid);
}
struct EpiZT {
    static constexpr bool PERM = true;
    bf16_t* Z; int T;
    DI void operator()(const mm::f32x4 (&acc)[2][2][4][2], const mm::Unit& u, int wr, int wc, int fr, int fq) const {
        const int b = (T == 2048) ? (u.pn >> 3) : u.pn, t0 = (T == 2048) ? ((u.pn & 7) * 256) : 0;
        const int m0 = u.pm * 256 + wr * 64 + fr; const int c0 = t0 + wc * 32 + 8 * fq;
#pragma unroll
        for (int ai = 0; ai < 2; ++ai)
#pragma unroll
            for (int m = 0; m < 4; ++m) { const int mr = m0 + ai * 128 + m * 16, part = mr >> 10, ch = mr & 1023;
                bf16_t* rowp = Z + ((size_t)(b * 1024 + ch) * 2 + part) * T + c0;
#pragma unroll
                for (int bj = 0; bj < 2; ++bj) { const mm::f32x4 v0 = acc[ai][bj][m][0], v1 = acc[ai][bj][m][1];
                    mm::u32x4 w; w.x = mm::cvt_pk_bf16(v0[0], v0[1]); w.y = mm::cvt_pk_bf16(v0[2], v0[3]); w.z = mm::cvt_pk_bf16(v1[0], v1[1]); w.w = mm::cvt_pk_bf16(v1[2], v1[3]);
                    *(mm::u32x4*)(rowp + bj * 128) = w; } }
    }
};
DI void ph_f1_mm(const Ctx& cx, const Params& p, float* lds, int j, bool with_ctx) {
    { mm::StaticSched S; S.init(p.A1 + (size_t)j * 2048 * 1024, p.H, 2048, NLAT, 1024, 1024, cx.nblk, cx.bid); EpiZT E{p.ZT, 2048}; mm::gemm_phase(GEMM_LDS(lds), 1024, S, E, cx.tid); }
    if (with_ctx) { mm::StaticSched S; S.init(p.A1 + (size_t)j * 2048 * 1024, p.H + (size_t)NLAT * 1024, 2048, NCTX, 1024, 1024, cx.nblk, cx.bid); EpiZT E{p.ZTC, 256}; mm::gemm_phase(GEMM_LDS(lds), 1024, S, E, cx.tid); }
}
DI void ph_f2_mm(const Ctx& cx, const Params& p, float* lds, bool with_ctx, const float* xin_lat, const float* xin_ctx, const float* modl) {
    { mm::BatchSched S; S.init(p.A2, p.ZT, (size_t)1024 * 4096 * 2, 16, 2048, 1024, 4096, cx.nblk, cx.bid); mm::EpiResid E{xin_lat, xin_ctx, p.out, p.ctxs, modl, 1}; mm::gemm_phase(GEMM_LDS(lds), 4096, S, E, cx.tid); }
    if (with_ctx) { mm::BatchSched S; S.init(p.A2c, p.ZTC, (size_t)1024 * 512 * 2, 16, 256, 1024, 512, cx.nblk, cx.bid); mm::EpiResid E{xin_lat, xin_ctx, p.out, p.ctxs, modl, -1}; mm::gemm_phase(GEMM_LDS(lds), 512, S, E, cx.tid); }
}
struct MoeSched {
    static constexpr bool GATHER = true;
    const char* A; const char* Bt; const int* slot; const int* tab; int lda, K, G, c, down;
    DI size_t hstep_a() const { return 0; }
    DI bool next(int i, mm::Unit& u) const {
        const int L = i * G + c; const int total = __builtin_amdgcn_readfirstlane(tab[17]);
        if (L >= total * 4) return false;
        const int rtg = L >> 2; int e = 0;
        for (int q = 1; q < 17; ++q) e += (__builtin_amdgcn_readfirstlane(tab[q]) <= rtg) ? 1 : 0;
        u.e = e; u.m = rtg - __builtin_amdgcn_readfirstlane(tab[e]); u.pm = u.m; u.pn = L & 3;
        u.A = A; u.B = Bt + ((size_t)e * 1024 + (size_t)u.pn * 256) * K * 2; return true;
    }
    DI unsigned rowoff(const mm::Unit& u, int Me, int idx, int C) const {
        int row;
        if (u.e < 16) { const int s = (idx < Me) ? slot[(size_t)u.e * NT + idx] : 0; row = down ? ((s & 1) * NT + (s >> 1)) : (s >> 1); }
        else row = down ? (2 * NT + idx) : idx;
        return (unsigned)(row * lda + C) * 2u;
    }
    DI void aoff(const mm::Unit& u, int R0, int C0, int R1, int C1, unsigned (&o)[2][2]) const {
        const int Me = __builtin_amdgcn_readfirstlane(tab[32 + u.e]), base = u.m * 256;
        o[0][0] = rowoff(u, Me, base + R0, C0); o[0][1] = rowoff(u, Me, base + R1, C1);
        o[1][0] = rowoff(u, Me, base + 128 + R0, C0); o[1][1] = rowoff(u, Me, base + 128 + R1, C1);
    }
};
DI void moe_table(const Ctx& cx, const Params& p, int* tab, int layer, int nrows) {
    if (cx.tid == 0) { int acc = 0;
        for (int e = 0; e < 17; ++e) { const int M = (e < 16) ? p.cnt[(layer * 16 + e) * 64] : nrows; tab[e] = acc; tab[32 + e] = M; acc += (M + 255) >> 8; }
        tab[17] = acc; }
    __syncthreads();
}
struct EpiSwiglu {
    static constexpr bool PERM = true;
    bf16_t* ACT; const int* slot; const int* tab;
    DI void operator()(const mm::f32x4 (&acc)[2][2][4][2], const mm::Unit& u, int wr, int wc, int fr, int fq) const {
        const int Me = __builtin_amdgcn_readfirstlane(tab[32 + u.e]); const int col = u.pn * 128 + wc * 32 + 8 * fq;
#pragma unroll
        for (int ai = 0; ai < 2; ++ai)
#pragma unroll
            for (int m = 0; m < 4; ++m) {
                const int idx = u.m * 256 + ai * 128 + wr * 64 + m * 16 + fr;
                if (idx < Me) {
                    int drow; if (u.e < 16) { const int s = slot[(size_t)u.e * NT + idx]; drow = (s & 1) * NT + (s >> 1); } else drow = 2 * NT + idx;
                    float o[8];
#pragma unroll
                    for (int n = 0; n < 2; ++n)
#pragma unroll
                        for (int c = 0; c < 4; ++c) { const float g = acc[ai][0][m][n][c], uu = acc[ai][1][m][n][c]; o[n * 4 + c] = g * __builtin_amdgcn_rcpf(1.f + __expf(-g)) * uu; }
                    mm::u32x4 w; w.x = mm::cvt_pk_bf16(o[0], o[1]); w.y = mm::cvt_pk_bf16(o[2], o[3]); w.z = mm::cvt_pk_bf16(o[4], o[5]); w.w = mm::cvt_pk_bf16(o[6], o[7]);
                    *(mm::u32x4*)(ACT + (size_t)drow * 512 + col) = w;
                }
            }
    }
};
struct EpiDown {
    static constexpr bool PERM = true;
    bf16_t* Y; const int* slot; const float* tokw; const int* tab;
    DI void operator()(const mm::f32x4 (&acc)[2][2][4][2], const mm::Unit& u, int wr, int wc, int fr, int fq) const {
        const int Me = __builtin_amdgcn_readfirstlane(tab[32 + u.e]); const int col = u.pn * 256 + wc * 32 + 8 * fq;
#pragma unroll
        for (int ai = 0; ai < 2; ++ai)
#pragma unroll
            for (int m = 0; m < 4; ++m) {
                const int idx = u.m * 256 + ai * 128 + wr * 64 + m * 16 + fr;
                if (idx < Me) {
                    int drow; float w = 1.f;
                    if (u.e < 16) { const int s = slot[(size_t)u.e * NT + idx]; drow = (s & 1) * NT + (s >> 1); w = tokw[s]; } else drow = 2 * NT + idx;
#pragma unroll
                    for (int bj = 0; bj < 2; ++bj) { const mm::f32x4 v0 = acc[ai][bj][m][0] * w, v1 = acc[ai][bj][m][1] * w;
                        mm::u32x4 o; o.x = mm::cvt_pk_bf16(v0[0], v0[1]); o.y = mm::cvt_pk_bf16(v0[2], v0[3]); o.z = mm::cvt_pk_bf16(v1[0], v1[1]); o.w = mm::cvt_pk_bf16(v1[2], v1[3]);
                        *(mm::u32x4*)(Y + (size_t)drow * 1024 + col + bj * 128) = o; }
                }
            }
    }
};
DI void ph_moe_up_mm(const Ctx& cx, const Params& p, float* lds, int layer, int nrows) {
    int* tab = (int*)(lds + 32768); moe_table(cx, p, tab, layer, nrows);
    MoeSched S{(const char*)p.H, (const char*)p.WguT, p.slot, tab, 1024, 1024, cx.nblk, cx.bid, 0};
    EpiSwiglu E{p.ACT, p.slot, tab};
    mm::gemm_phase(GEMM_LDS(lds), 1024, S, E, cx.tid);
}
DI void ph_moe_down_mm(const Ctx& cx, const Params& p, float* lds, int layer, int nrows) {
    int* tab = (int*)(lds + 32768); moe_table(cx, p, tab, layer, nrows);
    MoeSched S{(const char*)p.ACT, (const char*)p.WdT, p.slot, tab, 512, 512, cx.nblk, cx.bid, 1};
    EpiDown E{p.Y, p.slot, p.tokw, tab};
    mm::gemm_phase(GEMM_LDS(lds), 512, S, E, cx.tid);
}

namespace att {
typedef short bf16x8 __attribute__((ext_vector_type(8)));
typedef float f32x16 __attribute__((ext_vector_type(16)));
typedef unsigned u32x4 __attribute__((ext_vector_type(4)));
typedef unsigned u32x2 __attribute__((ext_vector_type(2)));
typedef __bf16 bf16x2_t __attribute__((ext_vector_type(2)));
typedef float f32x2_t __attribute__((ext_vector_type(2)));
constexpr int KP = 208, VP = 264, KT_BYTES = 128 * KP, VT_BYTES = 64 * VP, BUF = KT_BYTES + VT_BYTES;
DI unsigned pk(float a, float b) { f32x2_t f = {a, b}; bf16x2_t h = __builtin_convertvector(f, bf16x2_t); return __builtin_bit_cast(unsigned, h); }
#define ATT_MFMA(a, b, c) __builtin_amdgcn_mfma_f32_32x32x16_bf16((a), (b), (c), 0, 0, 0)
}
DI void ph_attn_mm(const Ctx& cx, const Params& p, float* ldsf, bool with_ctx) {
    using namespace att;
    LAS unsigned char* lds = (LAS unsigned char*)ldsf;
    const int tid = cx.tid, wid = __builtin_amdgcn_readfirstlane(tid >> 6), lane = tid & 63, r = lane & 31, hh = lane >> 5;
    const int nunits = 1024 + (with_ctx ? 128 : 0);
    int kg[3], kl[3], vg[2], vl[2];
#pragma unroll
    for (int i = 0; i < 3; ++i) { const int c = tid + 512 * i, row = c / 12, part = c % 12; kg[i] = row * 96 + part * 8; kl[i] = row * KP + part * 16; }
#pragma unroll
    for (int i = 0; i < 2; ++i) { const int c = tid + 512 * i, row = c >> 4, part = c & 15; vg[i] = row * 2304 + part * 8; vl[i] = KT_BYTES + row * VP + part * 16; }
    for (int u = cx.bid; u < nunits; u += cx.nblk) {
        int bh, qrow0, nkeys;
        if (u < 1024) { bh = u >> 3; qrow0 = (bh >> 3) * 2048 + (u & 7) * 256; nkeys = 2304; }
        else { bh = u - 1024; qrow0 = NLAT + (bh >> 3) * 256; nkeys = 256; }
        const int h = bh & 7;
        const bf16_t* Kb = p.Kf + (size_t)bh * 2304 * 96; const bf16_t* Vb = p.Vt + (size_t)bh * 64 * 2304;
        const bf16_t* qp = p.Qraw + (size_t)(qrow0 + wid * 32 + r) * 768 + h * 96 + 8 * hh;
        bf16x8 qf[6];
#pragma unroll
        for (int s = 0; s < 6; ++s) qf[s] = *(const bf16x8*)(qp + 16 * s);
        f32x16 ot0, ot1;
#pragma unroll
        for (int i = 0; i < 16; ++i) { ot0[i] = 0.f; ot1[i] = 0.f; }
        float mrun = -3.0e38f, lrun = 0.f;
        const int ntiles = nkeys >> 7;
        u32x4 kr[3], vr[2];
#pragma unroll
        for (int i = 0; i < 3; ++i) kr[i] = *(const u32x4*)(Kb + kg[i]);
#pragma unroll
        for (int i = 0; i < 2; ++i) vr[i] = *(const u32x4*)(Vb + vg[i]);
#pragma unroll
        for (int i = 0; i < 3; ++i) *(LAS u32x4*)(lds + kl[i]) = kr[i];
#pragma unroll
        for (int i = 0; i < 2; ++i) { *(LAS u32x2*)(lds + vl[i]) = (u32x2){vr[i].x, vr[i].y}; *(LAS u32x2*)(lds + vl[i] + 8) = (u32x2){vr[i].z, vr[i].w}; }
        __syncthreads();
        for (int it = 0; it < ntiles; ++it) {
            const int bo = (it & 1) * BUF, bn = ((it + 1) & 1) * BUF;
            const bool more = (it + 1 < ntiles);
            if (more) {
                const bf16_t* Kn = Kb + (size_t)(it + 1) * 128 * 96; const bf16_t* Vn = Vb + (it + 1) * 128;
#pragma unroll
                for (int i = 0; i < 3; ++i) kr[i] = *(const u32x4*)(Kn + kg[i]);
#pragma unroll
                for (int i = 0; i < 2; ++i) vr[i] = *(const u32x4*)(Vn + vg[i]);
            }
            f32x16 st[4];
#pragma unroll
            for (int kb = 0; kb < 4; ++kb) {
#pragma unroll
                for (int i = 0; i < 16; ++i) st[kb][i] = 0.f;
#pragma unroll
                for (int s = 0; s < 6; ++s) { const bf16x8 kf = *(const LAS bf16x8*)(lds + bo + (kb * 32 + r) * KP + 32 * s + 16 * hh); st[kb] = ATT_MFMA(kf, qf[s], st[kb]); }
            }
            float mt = st[0][0];
#pragma unroll
            for (int kb = 0; kb < 4; ++kb)
#pragma unroll
                for (int i = 0; i < 16; ++i) mt = fmaxf(mt, st[kb][i]);
            mt = fmaxf(mt, __shfl_xor(mt, 32));
            const float mnew = fmaxf(mrun, mt), alpha = __builtin_amdgcn_exp2f(mrun - mnew);
            mrun = mnew;
            float ps = 0.f;
#pragma unroll
            for (int kb = 0; kb < 4; ++kb)
#pragma unroll
                for (int i = 0; i < 16; ++i) { st[kb][i] = __builtin_amdgcn_exp2f(st[kb][i] - mnew); ps += st[kb][i]; }
            lrun = lrun * alpha + ps;
#pragma unroll
            for (int i = 0; i < 16; ++i) { ot0[i] *= alpha; ot1[i] *= alpha; }
#pragma unroll
            for (int kb = 0; kb < 4; ++kb)
#pragma unroll
                for (int s = 0; s < 2; ++s) {
                    u32x4 pw; pw.x = pk(st[kb][8 * s], st[kb][8 * s + 1]); pw.y = pk(st[kb][8 * s + 2], st[kb][8 * s + 3]); pw.z = pk(st[kb][8 * s + 4], st[kb][8 * s + 5]); pw.w = pk(st[kb][8 * s + 6], st[kb][8 * s + 7]);
                    const bf16x8 pb = __builtin_bit_cast(bf16x8, pw);
                    const int col = (kb * 32 + 16 * s + 4 * hh) * 2;
                    const u32x2 a0 = *(const LAS u32x2*)(lds + bo + KT_BYTES + r * VP + col), a1 = *(const LAS u32x2*)(lds + bo + KT_BYTES + r * VP + col + 16);
                    const u32x2 b0 = *(const LAS u32x2*)(lds + bo + KT_BYTES + (32 + r) * VP + col), b1 = *(const LAS u32x2*)(lds + bo + KT_BYTES + (32 + r) * VP + col + 16);
                    const u32x4 va = {a0.x, a0.y, a1.x, a1.y}, vb = {b0.x, b0.y, b1.x, b1.y};
                    ot0 = ATT_MFMA(__builtin_bit_cast(bf16x8, va), pb, ot0);
                    ot1 = ATT_MFMA(__builtin_bit_cast(bf16x8, vb), pb, ot1);
                }
            if (more) {
#pragma unroll
                for (int i = 0; i < 3; ++i) *(LAS u32x4*)(lds + bn + kl[i]) = kr[i];
#pragma unroll
                for (int i = 0; i < 2; ++i) { *(LAS u32x2*)(lds + bn + vl[i]) = (u32x2){vr[i].x, vr[i].y}; *(LAS u32x2*)(lds + bn + vl[i] + 8) = (u32x2){vr[i].z, vr[i].w}; }
            }
            __syncthreads();
        }
        const float il = 1.f / (lrun + __shfl_xor(lrun, 32));
        bf16_t* op = p.H + (size_t)(qrow0 + wid * 32 + r) * 1024 + 512 + h * 64 + 4 * hh;
#pragma unroll
        for (int g = 0; g < 4; ++g) {
            u32x2 w0 = {pk(ot0[4 * g] * il, ot0[4 * g + 1] * il), pk(ot0[4 * g + 2] * il, ot0[4 * g + 3] * il)};
            u32x2 w1 = {pk(ot1[4 * g] * il, ot1[4 * g + 1] * il), pk(ot1[4 * g + 2] * il, ot1[4 * g + 3] * il)};
            *(u32x2*)(op + 8 * g) = w0; *(u32x2*)(op + 32 + 8 * g) = w1;
        }
    }
}

namespace scan {
typedef float f32x2 __attribute__((ext_vector_type(2)));
constexpr int REC = 400, CH = 32, BUFF = CH * REC, YOFF = 2 * BUFF;
DI float dppf(float v, int ctrl_sel) {
    const int x = __builtin_bit_cast(int, v);
    int r;
    if (ctrl_sel == 0) r = __builtin_amdgcn_update_dpp(0, x, 0xB1, 0xf, 0xf, true);
    else if (ctrl_sel == 1) r = __builtin_amdgcn_update_dpp(0, x, 0x4E, 0xf, 0xf, true);
    else r = __builtin_amdgcn_update_dpp(0, x, 0x141, 0xf, 0xf, true);
    return __builtin_bit_cast(float, r);
}
DI float red8(float v) { v += dppf(v, 0); v += dppf(v, 1); v += dppf(v, 2); return v; }
}
template <int ABL>
DI void ph_scan_opt(const Ctx& cx, const Params& p, float* lds, int j) {
    using namespace scan;
    const int tid = cx.tid, wid = __builtin_amdgcn_readfirstlane(tid >> 6), lane = tid & 63;
    for (int item = cx.bid; item < 256; item += cx.nblk) {
        const int b = item >> 4, h = (item >> 1) & 7, dir = item & 1;
        bf16_t* yout = dir ? p.YB : p.YF;
        if (wid >= 4) {
            const int pw = wid - 4, hc = h * 64 + lane;
            const float kkc = p.a_k_k[j * 512 + hc], kac = p.a_k_a[j * 512 + hc];
            const float mur = p.a_mu[j * ACOLS + hc], muk = p.a_mu[j * ACOLS + 512 + hc], muv = p.a_mu[j * ACOLS + 1024 + hc];
            LAS float* L = (LAS float*)lds;
            bf16_t raw[8][11];
#define SCAN_ROW(stepv, row_, t_, T_) const bool cp_ = (stepv) < 256; const int tt_ = cp_ ? (stepv) : (stepv) - 256, T_ = cp_ ? 256 : 2048, t_ = dir ? (T_ - 1 - tt_) : tt_; const int row_ = cp_ ? NLAT + b * 256 + t_ : b * 2048 + t_
#define SCAN_LOAD(cc) do { _Pragma("unroll") for (int it = 0; it < 8; ++it) { const int step = (cc) * CH + pw + 4 * it; SCAN_ROW(step, row, t, T); \
                const int rp_ = (t > 0) ? row - 1 : row, rn_ = (t < T - 1) ? row + 1 : row; \
                const bf16_t* pc = p.P + (size_t)row * PLD + hc; const bf16_t* pp = p.P + (size_t)rp_ * PLD + hc; const bf16_t* pn = p.P + (size_t)rn_ * PLD + hc; \
                raw[it][0] = pc[0]; raw[it][1] = pp[0]; raw[it][2] = pn[0]; raw[it][3] = pc[512]; raw[it][4] = pp[512]; raw[it][5] = pn[512]; raw[it][6] = pc[1024]; raw[it][7] = pp[1024]; raw[it][8] = pn[1024]; \
                raw[it][9] = p.WAG[(size_t)row * WLD + dir * 512 + hc]; raw[it][10] = p.WAG[(size_t)row * WLD + 1024 + dir * 512 + hc]; } } while (0)
            if (ABL != 1) SCAN_LOAD(0);
            for (int c = 0; c <= 73; ++c) {
                if (c >= 2 && ABL == 0) {
                    const LAS float* yb = L + YOFF + ((c - 2) & 1) * (CH * 64);
#pragma unroll
                    for (int it = 0; it < 8; ++it) {
                        const int sl = pw + 4 * it, step = (c - 2) * CH + sl; SCAN_ROW(step, row, t, T);
                        yout[(size_t)row * 512 + hc] = f2bf(yb[sl * 64 + lane]);
                    }
                }
                if (c < 72 && ABL != 1) {
                    LAS float* buf = L + (c & 1) * BUFF;
#pragma unroll
                    for (int it = 0; it < 8; ++it) {
                        const int sl = pw + 4 * it, step = c * CH + sl; SCAN_ROW(step, row, t, T); (void)row;
                        const float mp = (t > 0) ? 0.5f : 0.f, mn = (t < T - 1) ? 0.5f : 0.f;
                        const float rc = bf2f(raw[it][0]), kc_ = bf2f(raw[it][3]), vc = bf2f(raw[it][6]);
                        const float R = rc + mur * (mp * bf2f(raw[it][1]) + mn * bf2f(raw[it][2]) - rc);
                        const float K = kc_ + muk * (mp * bf2f(raw[it][4]) + mn * bf2f(raw[it][5]) - kc_);
                        const float V = vc + muv * (mp * bf2f(raw[it][7]) + mn * bf2f(raw[it][8]) - vc);
                        const float w = 1.f - bf2f(raw[it][9]), a = bf2f(raw[it][10]);
                        const float kkv = K * kkc, ssq = wave_sum(kkv * kkv), kk = kkv * rsqrtf(ssq + 1e-12f);
                        const float kd = K * (1.f + (a - 1.f) * kac), bd = kk * a;
                        const float br = wave_sum(bd * R), kr = wave_sum(kd * R);
                        LAS float* rec = buf + sl * REC;
                        rec[lane] = w; rec[64 + lane] = -kk; rec[128 + lane] = bd; rec[192 + lane] = kd; rec[256 + lane] = w * R; rec[320 + lane] = V;
                        if (lane == 0) { rec[384] = br; rec[385] = kr; }
                    }
                    if (c + 1 < 72) SCAN_LOAD(c + 1);
                }
                __syncthreads();
            }
#undef SCAN_LOAD
#undef SCAN_ROW
        } else {
            const int ct = tid, rp = ct >> 3, k8 = ct & 7;
            float S0[8], S1[8];
#pragma unroll
            for (int q = 0; q < 8; ++q) { S0[q] = 0.f; S1[q] = 0.f; }
            __syncthreads();
            for (int c = 0; c < 72; ++c) {
                const LAS float* buf = (const LAS float*)lds + (c & 1) * BUFF; LAS float* yb = (LAS float*)lds + YOFF + (c & 1) * (CH * 64);
                mm::f32x4 cw0, cw1, cn0, cn1, cb0, cb1, cd0, cd1, cr0, cr1; scan::f32x2 cvv, csc;
#define SCAN_LD(recp, W0, W1, N0, N1, B0, B1, D0, D1, R0_, R1_, VV, SC) do { const LAS float* r_ = (recp); \
                    W0 = *(const LAS mm::f32x4*)(r_ + k8 * 8); W1 = *(const LAS mm::f32x4*)(r_ + k8 * 8 + 4); N0 = *(const LAS mm::f32x4*)(r_ + 64 + k8 * 8); N1 = *(const LAS mm::f32x4*)(r_ + 64 + k8 * 8 + 4); \
                    B0 = *(const LAS mm::f32x4*)(r_ + 128 + k8 * 8); B1 = *(const LAS mm::f32x4*)(r_ + 128 + k8 * 8 + 4); D0 = *(const LAS mm::f32x4*)(r_ + 192 + k8 * 8); D1 = *(const LAS mm::f32x4*)(r_ + 192 + k8 * 8 + 4); \
                    R0_ = *(const LAS mm::f32x4*)(r_ + 256 + k8 * 8); R1_ = *(const LAS mm::f32x4*)(r_ + 256 + k8 * 8 + 4); VV = *(const LAS scan::f32x2*)(r_ + 320 + 2 * rp); SC = *(const LAS scan::f32x2*)(r_ + 384); } while (0)
                SCAN_LD(buf, cw0, cw1, cn0, cn1, cb0, cb1, cd0, cd1, cr0, cr1, cvv, csc);
#pragma unroll 2
                for (int sl = 0; sl < (ABL == 2 ? 0 : CH); ++sl) {
                    mm::f32x4 nw0, nw1, nn0, nn1, nb0, nb1, nd0, nd1, nr0, nr1; scan::f32x2 nvv, nsc;
                    SCAN_LD(buf + (sl + 1 < CH ? sl + 1 : sl) * REC, nw0, nw1, nn0, nn1, nb0, nb1, nd0, nd1, nr0, nr1, nvv, nsc);
                    const float wv[8] = {cw0[0], cw0[1], cw0[2], cw0[3], cw1[0], cw1[1], cw1[2], cw1[3]}, nv[8] = {cn0[0], cn0[1], cn0[2], cn0[3], cn1[0], cn1[1], cn1[2], cn1[3]};
                    const float bv[8] = {cb0[0], cb0[1], cb0[2], cb0[3], cb1[0], cb1[1], cb1[2], cb1[3]}, dv[8] = {cd0[0], cd0[1], cd0[2], cd0[3], cd1[0], cd1[1], cd1[2], cd1[3]};
                    const float rv[8] = {cr0[0], cr0[1], cr0[2], cr0[3], cr1[0], cr1[1], cr1[2], cr1[3]};
                    float sa0 = 0.f, sa1 = 0.f, y0 = 0.f, y1 = 0.f;
#pragma unroll
                    for (int q = 0; q < 8; ++q) { sa0 += S0[q] * nv[q]; sa1 += S1[q] * nv[q]; y0 += S0[q] * rv[q]; y1 += S1[q] * rv[q]; }
                    sa0 = red8(sa0); sa1 = red8(sa1); y0 = red8(y0); y1 = red8(y1);
                    y0 += sa0 * csc[0] + cvv[0] * csc[1]; y1 += sa1 * csc[0] + cvv[1] * csc[1];
#pragma unroll
                    for (int q = 0; q < 8; ++q) { S0[q] = S0[q] * wv[q] + sa0 * bv[q] + cvv[0] * dv[q]; S1[q] = S1[q] * wv[q] + sa1 * bv[q] + cvv[1] * dv[q]; }
                    if (k8 == 0) *(LAS scan::f32x2*)(yb + sl * 64 + 2 * rp) = (scan::f32x2){y0, y1};
                    cw0 = nw0; cw1 = nw1; cn0 = nn0; cn1 = nn1; cb0 = nb0; cb1 = nb1; cd0 = nd0; cd1 = nd1; cr0 = nr0; cr1 = nr1; cvv = nvv; csc = nsc;
                }
#undef SCAN_LD
                __syncthreads();
            }
            __syncthreads();
        }
    }
}

namespace sc2 {
typedef short bf16x8 __attribute__((ext_vector_type(8)));
typedef float f32x4 __attribute__((ext_vector_type(4)));
typedef unsigned u32x4 __attribute__((ext_vector_type(4)));
typedef unsigned u32x2 __attribute__((ext_vector_type(2)));
constexpr int NP = 6;
constexpr int O_AH = 0, O_RH = 2048, O_BK = 4096, O_VM = 8192, O_GC = 10240, O_AAB = 10496, O_AAK = 11520, O_ARK = 12032, O_BH = 13056, O_KH = 15104, SLOT = 17152;
constexpr int O_S0 = NP * SLOT, O_RHS = O_S0 + 8192, O_ZU = O_RHS + 4096, O_FLAG = O_ZU + 2048, TOTAL = O_FLAG + 256;
#define SC_MFMA(a, b, c) __builtin_amdgcn_mfma_f32_16x16x32_bf16((a), (b), (c), 0, 0, 0)
DI unsigned pk2(float a, float b) { return att::pk(a, b); }
DI int ldv(volatile LAS int* p) { return *p; }
}
DI void ph_scan_chunk(const Ctx& cx, const Params& p, float* ldsg, int j) {
    using namespace sc2;
    static_assert(TOTAL <= 128 * 1024, "scan LDS map");
    LAS unsigned char* L = (LAS unsigned char*)ldsg;
    volatile LAS int* ready = (volatile LAS int*)(L + O_FLAG); volatile LAS int* done = ready + 8;
    const int tid = cx.tid, wid = __builtin_amdgcn_readfirstlane(tid >> 6), lane = tid & 63, lq = lane >> 4, lr = lane & 15;
    constexpr int NCH = 144;
    for (int item = cx.bid; item < 256; item += cx.nblk) {
        const int b = item >> 4, h = (item >> 1) & 7, dir = item & 1;
        bf16_t* yout = dir ? p.YB : p.YF;
        __syncthreads();
        if (tid < 16) ready[tid] = 0;
        __syncthreads();
#define SC_ROW(stepv, row_, t_, T_) const bool cp_ = (stepv) < 256; const int tt_ = cp_ ? (stepv) : (stepv) - 256, T_ = cp_ ? 256 : 2048, t_ = dir ? (T_ - 1 - tt_) : tt_; const int row_ = cp_ ? NLAT + b * 256 + t_ : b * 2048 + t_
        if (wid == 0) {
            f32x4 S[4][4];
#pragma unroll
            for (int kb = 0; kb < 4; ++kb)
#pragma unroll
                for (int vb = 0; vb < 4; ++vb) S[kb][vb] = (f32x4){0.f, 0.f, 0.f, 0.f};
            for (int c = 0; c < NCH; ++c) {
                const int sl = c % NP; LAS unsigned char* SB = L + sl * SLOT;
                { unsigned spins = 0; while (ldv(ready + sl) != c + 1) { __builtin_amdgcn_s_sleep(1); if (++spins > (1u << 22)) break; } }
                asm volatile("" ::: "memory");
#pragma unroll
                for (int kb = 0; kb < 4; ++kb)
#pragma unroll
                    for (int vb = 0; vb < 4; ++vb) { const f32x4 x = S[kb][vb]; *(LAS u32x2*)(L + O_S0 + (16 * vb + lr) * 128 + (16 * kb + 4 * lq) * 2) = (u32x2){pk2(x[0], x[1]), pk2(x[2], x[3])}; }
                bf16x8 ah[2], ak;
#pragma unroll
                for (int ks = 0; ks < 2; ++ks) ah[ks] = *(const LAS bf16x8*)(SB + O_AH + lr * 128 + ks * 64 + lq * 16);
                { u32x4 z = {0u, 0u, 0u, 0u}; if (lq < 2) z = *(const LAS u32x4*)(SB + O_AAK + lr * 32 + lq * 16); ak = __builtin_bit_cast(bf16x8, z); }
#pragma unroll
                for (int vb = 0; vb < 4; ++vb) {
                    f32x4 acc = {0.f, 0.f, 0.f, 0.f};
#pragma unroll
                    for (int ks = 0; ks < 2; ++ks) { const bf16x8 sf = *(const LAS bf16x8*)(L + O_S0 + (16 * vb + lr) * 128 + ks * 64 + lq * 16); acc = SC_MFMA(sf, ah[ks], acc); }
                    { u32x4 z = {0u, 0u, 0u, 0u}; if (lq < 2) z = *(const LAS u32x4*)(SB + O_VM + (16 * vb + lr) * 32 + lq * 16); acc = SC_MFMA(__builtin_bit_cast(bf16x8, z), ak, acc); }
#pragma unroll
                    for (int q = 0; q < 4; ++q) *(LAS float*)(L + O_RHS + ((16 * vb + 4 * lq + q) * 16 + lr) * 4) = acc[q];
                }
                float u[16];
                { const LAS f32x4* rp = (const LAS f32x4*)(L + O_RHS + lane * 64);
#pragma unroll
                  for (int q = 0; q < 4; ++q) { const f32x4 x = rp[q]; u[4 * q] = x[0]; u[4 * q + 1] = x[1]; u[4 * q + 2] = x[2]; u[4 * q + 3] = x[3]; } }
#pragma unroll
                for (int t = 1; t < 16; ++t) {
                    asm volatile("" ::: "memory");
                    const LAS f32x4* cp = (const LAS f32x4*)(SB + O_AAB + t * 64);
                    float a0 = u[t], a1 = 0.f;
#pragma unroll
                    for (int q = 0; q < 4; ++q) { if (4 * q < t) { const f32x4 cf = cp[q];
#pragma unroll
                        for (int e = 0; e < 4; ++e) { if (4 * q + e < t) { if (e & 1) a1 += cf[e] * u[4 * q + e]; else a0 += cf[e] * u[4 * q + e]; } } } }
                    u[t] = a0 + a1;
                }
                { u32x4 w0 = {pk2(u[0], u[1]), pk2(u[2], u[3]), pk2(u[4], u[5]), pk2(u[6], u[7])}, w1 = {pk2(u[8], u[9]), pk2(u[10], u[11]), pk2(u[12], u[13]), pk2(u[14], u[15])};
                  *(LAS u32x4*)(L + O_ZU + lane * 32) = w0; *(LAS u32x4*)(L + O_ZU + lane * 32 + 16) = w1; }
                bf16x8 zf[4];
#pragma unroll
                for (int vb = 0; vb < 4; ++vb) zf[vb] = (lq < 2) ? *(const LAS bf16x8*)(L + O_ZU + (16 * vb + lr) * 32 + lq * 16) : *(const LAS bf16x8*)(SB + O_VM + (16 * vb + lr) * 32 + (lq - 2) * 16);
                { const bf16x8 rk = *(const LAS bf16x8*)(SB + O_ARK + lr * 64 + lq * 16);
                  const bf16x8 rh0 = *(const LAS bf16x8*)(SB + O_RH + lr * 128 + lq * 16), rh1 = *(const LAS bf16x8*)(SB + O_RH + lr * 128 + 64 + lq * 16);
                  const int step = c * 16 + lr; SC_ROW(step, row, tq, Tq); (void)tq; (void)Tq;
#pragma unroll
                  for (int vb = 0; vb < 4; ++vb) { f32x4 y = {0.f, 0.f, 0.f, 0.f};
                      y = SC_MFMA(*(const LAS bf16x8*)(L + O_S0 + (16 * vb + lr) * 128 + lq * 16), rh0, y); y = SC_MFMA(*(const LAS bf16x8*)(L + O_S0 + (16 * vb + lr) * 128 + 64 + lq * 16), rh1, y);
                      y = SC_MFMA(zf[vb], rk, y);
                      *(u32x2*)(yout + (size_t)row * 512 + h * 64 + 16 * vb + 4 * lq) = (u32x2){pk2(y[0], y[1]), pk2(y[2], y[3])}; } }
#pragma unroll
                for (int kb = 0; kb < 4; ++kb) {
                    const f32x4 gc = *(const LAS f32x4*)(SB + O_GC + (16 * kb + 4 * lq) * 4);
                    const bf16x8 bkf = *(const LAS bf16x8*)(SB + O_BK + (16 * kb + lr) * 64 + lq * 16);
#pragma unroll
                    for (int vb = 0; vb < 4; ++vb) S[kb][vb] = SC_MFMA(bkf, zf[vb], S[kb][vb] * gc);
                }
                asm volatile("s_waitcnt lgkmcnt(0)" ::: "memory");
                if (lane == 0) done[sl] = c + 1;
            }
        } else if (wid <= NP) {
            const int pw = wid - 1, hc = h * 64 + lane; LAS unsigned char* SB = L + pw * SLOT;
            const float kkc = p.a_k_k[j * 512 + hc], kac = p.a_k_a[j * 512 + hc];
            const float mur = p.a_mu[j * ACOLS + hc], muk = p.a_mu[j * ACOLS + 512 + hc], muv = p.a_mu[j * ACOLS + 1024 + hc];
            for (int c = pw; c < NCH; c += NP) {
                bf16_t raw[16][11];
#define SC_LOAD(t) do { const int step = c * 16 + (t); SC_ROW(step, row, tq, Tq); \
                    const int rp_ = (tq > 0) ? row - 1 : row, rn_ = (tq < Tq - 1) ? row + 1 : row; \
                    const bf16_t* pc = p.P + (size_t)row * PLD + hc; const bf16_t* pp = p.P + (size_t)rp_ * PLD + hc; const bf16_t* pn = p.P + (size_t)rn_ * PLD + hc; \
                    raw[t][0] = pc[0]; raw[t][1] = pp[0]; raw[t][2] = pn[0]; raw[t][3] = pc[512]; raw[t][4] = pp[512]; raw[t][5] = pn[512]; raw[t][6] = pc[1024]; raw[t][7] = pp[1024]; raw[t][8] = pn[1024]; \
                    raw[t][9] = p.WAG[(size_t)row * WLD + dir * 512 + hc]; raw[t][10] = p.WAG[(size_t)row * WLD + 1024 + dir * 512 + hc]; } while (0)
#define SC_STEP(t) do { const int step = c * 16 + (t); SC_ROW(step, row, tq, Tq); (void)row; \
                    const float mp = (tq > 0) ? 0.5f : 0.f, mn = (tq < Tq - 1) ? 0.5f : 0.f; \
                    const float rc = bf2f(raw[t][0]), kc_ = bf2f(raw[t][3]), vc = bf2f(raw[t][6]); \
                    const float R = rc + mur * (mp * bf2f(raw[t][1]) + mn * bf2f(raw[t][2]) - rc); \
                    const float K = kc_ + muk * (mp * bf2f(raw[t][4]) + mn * bf2f(raw[t][5]) - kc_); \
                    const float Vv = vc + muv * (mp * bf2f(raw[t][7]) + mn * bf2f(raw[t][8]) - vc); \
                    const float w = 1.f - bf2f(raw[t][9]), a = bf2f(raw[t][10]); \
                    const float kkv = K * kkc, ssq = wave_sum(kkv * kkv), kk = kkv * rsqrtf(ssq + 1e-12f); \
                    const float kd = K * (1.f + (a - 1.f) * kac), bd = kk * a; \
                    const float gprev = g; g *= w; const float ig = __builtin_amdgcn_rcpf(g); \
                    *(LAS bf16_t*)(SB + O_AH + (t) * 128 + lane * 2) = f2bf(-kk * gprev); \
                    *(LAS bf16_t*)(SB + O_RH + (t) * 128 + lane * 2) = f2bf(R * g); \
                    *(LAS bf16_t*)(SB + O_BH + (t) * 128 + lane * 2) = f2bf(bd * ig); \
                    *(LAS bf16_t*)(SB + O_KH + (t) * 128 + lane * 2) = f2bf(kd * ig); \
                    *(LAS bf16_t*)(SB + O_VM + lane * 32 + (t) * 2) = f2bf(Vv); } while (0)
                SC_LOAD(0); SC_LOAD(1); SC_LOAD(2); SC_LOAD(3); SC_LOAD(4); SC_LOAD(5); SC_LOAD(6); SC_LOAD(7);
                if (c >= NP) { unsigned spins = 0; while (ldv(done + pw) != c - NP + 1) { __builtin_amdgcn_s_sleep(2); if (++spins > (1u << 22)) break; } }
                asm volatile("" ::: "memory");
                float g = 1.f;
                SC_STEP(0); SC_STEP(1); SC_STEP(2); SC_STEP(3);
                asm volatile("" ::: "memory");
                SC_LOAD(8); SC_LOAD(9); SC_LOAD(10); SC_LOAD(11);
                asm volatile("" ::: "memory");
                SC_STEP(4); SC_STEP(5); SC_STEP(6); SC_STEP(7);
                asm volatile("" ::: "memory");
                SC_LOAD(12); SC_LOAD(13); SC_LOAD(14); SC_LOAD(15);
                asm volatile("" ::: "memory");
                SC_STEP(8); SC_STEP(9); SC_STEP(10); SC_STEP(11); SC_STEP(12); SC_STEP(13); SC_STEP(14); SC_STEP(15);
#undef SC_LOAD
#undef SC_STEP
#pragma unroll
                for (int q = 0; q < 2; ++q) {
                    float bq[8], kq[8];
#pragma unroll
                    for (int e = 0; e < 8; ++e) { bq[e] = bf2f(*(const LAS bf16_t*)(SB + O_BH + (8 * q + e) * 128 + lane * 2)) * g; kq[e] = bf2f(*(const LAS bf16_t*)(SB + O_KH + (8 * q + e) * 128 + lane * 2)) * g; }
                    u32x4 wb = {pk2(bq[0], bq[1]), pk2(bq[2], bq[3]), pk2(bq[4], bq[5]), pk2(bq[6], bq[7])}, wk = {pk2(kq[0], kq[1]), pk2(kq[2], kq[3]), pk2(kq[4], kq[5]), pk2(kq[6], kq[7])};
                    *(LAS u32x4*)(SB + O_BK + lane * 64 + q * 16) = wb; *(LAS u32x4*)(SB + O_BK + lane * 64 + 32 + q * 16) = wk;
                }
                *(LAS float*)(SB + O_GC + lane * 4) = g;
                f32x4 sab = {0.f, 0.f, 0.f, 0.f}, sak = sab, srb = sab, srk = sab;
#pragma unroll
                for (int ks = 0; ks < 2; ++ks) {
                    const bf16x8 fa = *(const LAS bf16x8*)(SB + O_AH + lr * 128 + ks * 64 + lq * 16), fr = *(const LAS bf16x8*)(SB + O_RH + lr * 128 + ks * 64 + lq * 16);
                    const bf16x8 fb = *(const LAS bf16x8*)(SB + O_BH + lr * 128 + ks * 64 + lq * 16), fk = *(const LAS bf16x8*)(SB + O_KH + lr * 128 + ks * 64 + lq * 16);
                    sab = SC_MFMA(fa, fb, sab); sak = SC_MFMA(fa, fk, sak); srb = SC_MFMA(fr, fb, srb); srk = SC_MFMA(fr, fk, srk);
                }
#pragma unroll
                for (int q = 0; q < 4; ++q) { const int t = 4 * lq + q; const bool lo = lr < t, le = lr <= t;
                    *(LAS float*)(SB + O_AAB + (t * 16 + lr) * 4) = lo ? sab[q] : 0.f;
                    *(LAS bf16_t*)(SB + O_AAK + (t * 16 + lr) * 2) = f2bf(lo ? sak[q] : 0.f);
                    *(LAS bf16_t*)(SB + O_ARK + (t * 32 + lr) * 2) = f2bf(le ? srb[q] : 0.f);
                    *(LAS bf16_t*)(SB + O_ARK + (t * 32 + 16 + lr) * 2) = f2bf(le ? srk[q] : 0.f); }
                asm volatile("s_waitcnt lgkmcnt(0)" ::: "memory");
                if (lane == 0) ready[pw] = c + 1;
            }
        }
#undef SC_ROW
        __syncthreads();
    }
}

DI void unpack8u(const uint4 u, float (&d)[8]) { d[0] = bflo(u.x); d[1] = bfhi(u.x); d[2] = bflo(u.y); d[3] = bfhi(u.y); d[4] = bflo(u.z); d[5] = bfhi(u.z); d[6] = bflo(u.w); d[7] = bfhi(u.w); }
DI uint4 pack8u(const float (&d)[8]) { uint4 u; u.x = att::pk(d[0], d[1]); u.y = att::pk(d[2], d[3]); u.z = att::pk(d[4], d[5]); u.w = att::pk(d[6], d[7]); return u; }
DI void shift8(const bf16_t* P, int row, int t, int T, int col0, const float (&mu)[8], float (&o)[8]) {
    float c[8], pv[8], nx[8];
    unpack8u(*(const uint4*)(P + (size_t)row * PLD + col0), c);
    if (t > 0) unpack8u(*(const uint4*)(P + (size_t)(row - 1) * PLD + col0), pv); else {
#pragma unroll
        for (int i = 0; i < 8; ++i) pv[i] = 0.f; }
    if (t < T - 1) unpack8u(*(const uint4*)(P + (size_t)(row + 1) * PLD + col0), nx); else {
#pragma unroll
        for (int i = 0; i < 8; ++i) nx[i] = 0.f; }
#pragma unroll
    for (int i = 0; i < 8; ++i) o[i] = c[i] + mu[i] * (0.5f * (pv[i] + nx[i]) - c[i]);
}
DI void ld8f(const float* p, float (&d)[8]) { const float4 a = *(const float4*)p, b = *(const float4*)(p + 4); d[0] = a.x; d[1] = a.y; d[2] = a.z; d[3] = a.w; d[4] = b.x; d[5] = b.y; d[6] = b.z; d[7] = b.w; }
DI void ph_post_opt(const Ctx& cx, const Params& p, int j, int nrows) {
    const int tid = cx.tid, wid = tid >> 6, lane = tid & 63, c0 = lane * 8;
    float mur[8], muk[8], muv[8], ka[8], rk[8], lw[8], lb[8];
    ld8f(p.a_mu + j * ACOLS + c0, mur); ld8f(p.a_mu + j * ACOLS + 512 + c0, muk); ld8f(p.a_mu + j * ACOLS + 1024 + c0, muv);
    ld8f(p.a_k_a + j * 512 + c0, ka); ld8f(p.a_r_k + j * 512 + c0, rk); ld8f(p.a_ln_w + j * 512 + c0, lw); ld8f(p.a_ln_b + j * 512 + c0, lb);
    for (int row = cx.bid * 8 + wid; row < nrows; row += cx.nblk * 8) {
        const bool lat = row < NLAT; const int t = lat ? (row & 2047) : ((row - NLAT) & 255); const int T = lat ? 2048 : 256;
        float yf[8], yb[8], R[8], K[8], V[8], af[8], ab[8], g[8];
        unpack8u(*(const uint4*)(p.YF + (size_t)row * 512 + c0), yf); unpack8u(*(const uint4*)(p.YB + (size_t)row * 512 + c0), yb);
        shift8(p.P, row, t, T, c0, mur, R); shift8(p.P, row, t, T, 512 + c0, muk, K); shift8(p.P, row, t, T, 1024 + c0, muv, V);
        unpack8u(*(const uint4*)(p.WAG + (size_t)row * WLD + 1024 + c0), af); unpack8u(*(const uint4*)(p.WAG + (size_t)row * WLD + 1536 + c0), ab); unpack8u(*(const uint4*)(p.WAG + (size_t)row * WLD + 2048 + c0), g);
        float sum = 0.f, sb = 0.f;
#pragma unroll
        for (int i = 0; i < 8; ++i) { yf[i] += yb[i]; sum += yf[i]; sb += R[i] * rk[i] * K[i] * (2.f + (af[i] + ab[i] - 2.f) * ka[i]); }
        sum = scan::red8(sum); sb = scan::red8(sb);
        const float mean = sum * (1.f / 64.f); float var = 0.f;
#pragma unroll
        for (int i = 0; i < 8; ++i) { const float d = yf[i] - mean; var += d * d; }
        var = scan::red8(var);
        const float rstd = rsqrtf(var * (1.f / 64.f) + 64e-5f);
        float o[8];
#pragma unroll
        for (int i = 0; i < 8; ++i) o[i] = ((yf[i] - mean) * rstd * lw[i] + lb[i] + sb * V[i]) * g[i];
        *(uint4*)(p.H + (size_t)row * 1024 + c0) = pack8u(o);
    }
}
DI void fin_vec(float (&x)[8], int c, int t, bool lat, const float* gain, float scl, bf16_t* dst) {
    float ss = 0.f;
#pragma unroll
    for (int i = 0; i < 8; ++i) ss += x[i] * x[i];
    ss += __shfl_xor(ss, 1); ss += __shfl_xor(ss, 2); ss += __shfl_xor(ss, 4); ss += __shfl_xor(ss, 8);
    const float r = rsqrtf(ss * (1.f / 96.f) + 1e-6f);
    float gn[8]; ld8f(gain + (c < 12 ? c : 0) * 8, gn);
#pragma unroll
    for (int i = 0; i < 8; ++i) x[i] = x[i] * r * gn[i];
    float y[8];
#pragma unroll
    for (int i = 0; i < 8; ++i) { const float up = __shfl_down(x[i], 2), dn = __shfl_up(x[i], 2); y[i] = (c < 10) ? up : dn; }
    if (lat && c >= 8 && c < 12) {
        const float invf[8] = {1.f, 0.316227766016838f, 0.1f, 0.0316227766016838f, 0.01f, 0.00316227766016838f, 0.001f, 0.000316227766016838f};
        const float pos = (c & 1) ? (float)(t & 63) : (float)(t >> 6);
#pragma unroll
        for (int i = 0; i < 8; ++i) { const float ang = pos * invf[i], cs = __cosf(ang), sn = __sinf(ang); x[i] = (c < 10) ? (x[i] * cs - y[i] * sn) : (x[i] * cs + y[i] * sn); }
    }
    if (c < 12) {
#pragma unroll
        for (int i = 0; i < 8; ++i) x[i] *= scl;
        *(uint4*)(dst + c * 8) = pack8u(x);
    }
}
DI void ph_finalize_opt(const Ctx& cx, const Params& p, float* ldsf, int j, int mq) {
    const int tid = cx.tid, wid = tid >> 6, lane = tid & 63, c = lane & 15, hq = lane >> 4;
    const float* qg = p.b_q_gain + j * 96; const float* kg = p.b_k_gain + j * 96;
    for (int it = cx.bid * 8 + wid; it < 2 * NT; it += cx.nblk * 8) {
        const int row = it >> 1, h = (it & 1) * 4 + hq;
        const bool lat = row < NLAT; const int b = lat ? (row >> 11) : ((row - NLAT) >> 8); const int t = lat ? (row & 2047) : ((row - NLAT) & 255);
        if (row < mq) {
            bf16_t* qp = p.Qraw + (size_t)row * 768 + h * 96;
            float x[8];
            if (c < 12) unpack8u(*(const uint4*)(qp + c * 8), x); else {
#pragma unroll
                for (int i = 0; i < 8; ++i) x[i] = 0.f; }
            fin_vec(x, c, t, lat, qg, 0.10206207261596577f * 1.4426950408889634f, qp);
        }
        {
            float x[8];
            if (c < 8) unpack8u(*(const uint4*)(p.KVraw + (size_t)row * 1024 + h * 128 + c * 8), x);
            else if (c < 12) unpack8u(*(const uint4*)(p.P + (size_t)row * PLD + ACOLS + 384 + (c - 8) * 8), x);
            else {
#pragma unroll
                for (int i = 0; i < 8; ++i) x[i] = 0.f; }
            const int key = lat ? 256 + t : t;
            fin_vec(x, c, t, lat, kg, 1.f, p.Kf + ((size_t)(b * 8 + h) * 2304 + key) * 96);
        }
    }
    bf16_t* T = (bf16_t*)ldsf; constexpr int TP = 520;
    for (int tile = cx.bid; tile < NT / 64; tile += cx.nblk) {
        const int row0 = tile * 64; const bool lat = row0 < NLAT; const int b = lat ? (row0 >> 11) : ((row0 - NLAT) >> 8); const int t0 = lat ? (row0 & 2047) : ((row0 - NLAT) & 255);
        const int key0 = lat ? 256 + t0 : t0;
        __syncthreads();
#pragma unroll
        for (int i = 0; i < 8; ++i) { const int ch = tid + 512 * i, kr = ch >> 6, cc = ch & 63, h = cc >> 3, part = cc & 7;
            *(uint4*)(T + kr * TP + h * 64 + part * 8) = *(const uint4*)(p.KVraw + (size_t)(row0 + kr) * 1024 + h * 128 + 64 + part * 8); }
        __syncthreads();
#pragma unroll
        for (int i = 0; i < 8; ++i) { const int ch = tid + 512 * i, hd = ch >> 3, kc = ch & 7;
            float v[8];
#pragma unroll
            for (int q = 0; q < 8; ++q) v[q] = bf2f(T[(kc * 8 + q) * TP + hd]);
            uint4 o; o.x = (unsigned)T[(kc * 8 + 0) * TP + hd] | ((unsigned)T[(kc * 8 + 1) * TP + hd] << 16); o.y = (unsigned)T[(kc * 8 + 2) * TP + hd] | ((unsigned)T[(kc * 8 + 3) * TP + hd] << 16);
            o.z = (unsigned)T[(kc * 8 + 4) * TP + hd] | ((unsigned)T[(kc * 8 + 5) * TP + hd] << 16); o.w = (unsigned)T[(kc * 8 + 6) * TP + hd] | ((unsigned)T[(kc * 8 + 7) * TP + hd] << 16);
            (void)v;
            *(uint4*)(p.Vt + ((size_t)(b * 8 + (hd >> 6)) * 64 + (hd & 63)) * 2304 + key0 + kc * 8) = o; }
    }
    __syncthreads();
}
DI void ph_mod_opt(const Ctx& cx, const Params& p, float* lds) {
    const int tid = cx.tid, wid = tid >> 6, lane = tid & 63;
    float* part = lds + 17 * 1024;
    for (int i = tid; i < 17 * 1024; i += NTHR) { const int jj = i >> 10, k = i & 1023; const float v = (jj < 16) ? p.c[jj * 1024 + k] : p.c_ctx[k]; lds[i] = siluf(v); }
    __syncthreads();
    for (int item = cx.bid; item < 4 * 96; item += cx.nblk) {
        const int l = item / 96, n = (item % 96) * 64 + lane;
        const float* w = p.mod_w + (size_t)l * 1024 * 6144 + n;
        float acc[17];
#pragma unroll
        for (int jj = 0; jj < 17; ++jj) acc[jj] = 0.f;
#pragma unroll 4
        for (int k = wid * 128; k < wid * 128 + 128; ++k) {
            const float wv = w[(size_t)k * 6144];
#pragma unroll
            for (int jj = 0; jj < 17; ++jj) acc[jj] += lds[jj * 1024 + k] * wv;
        }
#pragma unroll
        for (int jj = 0; jj < 17; ++jj) part[(wid * 17 + jj) * 64 + lane] = acc[jj];
        __syncthreads();
        for (int o = tid; o < 17 * 64; o += NTHR) { const int jj = o >> 6, ln = o & 63; float sacc = p.mod_b[l * 6144 + (item % 96) * 64 + ln];
#pragma unroll
            for (int q = 0; q < 8; ++q) sacc += part[(q * 17 + jj) * 64 + ln];
            p.mod[((size_t)l * 17 + jj) * 6144 + (item % 96) * 64 + ln] = sacc; }
        __syncthreads();
    }
}

DI void ph_norm2_router(const Ctx& cx, const Params& p, float* ldsg, int nrows, const float* gain, const float* modl, int layer) {
    LAS float* lds = (LAS float*)ldsg;
    const int tid = cx.tid, wid = tid >> 6, lane = tid & 63;
    LAS float* rw = lds; LAS float* red = lds + 16 * 1024 + wid * (32 * 64 + 64); LAS float* my = red + 32 * 64;
    LAS int* lcnt = (LAS int*)(lds + 16 * 1024 + 8 * (32 * 64 + 64)); LAS int* lbase = lcnt + 16; LAS int* rlist = lcnt + 32;
    for (int i = tid; i < 16 * 1024; i += NTHR) { const int e = i >> 10, col = i & 1023; rw[i] = p.router_w[col * 16 + e]; }
    if (tid < 16) lcnt[tid] = 0;
    __syncthreads();
    int nlist = 0;
    for (int pidx = cx.bid * 8 + wid; pidx < (nrows >> 1); pidx += cx.nblk * 8) {
        float4 xv[2][4];
#pragma unroll
        for (int r = 0; r < 2; ++r) { const int row = 2 * pidx + r; const float* xr = (row < NLAT) ? p.out + (size_t)row * 1024 : p.ctxs + (size_t)(row - NLAT) * 1024;
#pragma unroll
            for (int i = 0; i < 4; ++i) xv[r][i] = *(const float4*)(xr + i * 256 + lane * 4); }
        const int row0 = 2 * pidx; const int jj = (row0 < NLAT) ? (row0 >> 11) : 16;
        const float* shp = modl + (size_t)jj * 6144 + 3 * 1024; const float* scp = modl + (size_t)jj * 6144 + 4 * 1024;
        float4 hv[2][4];
#pragma unroll
        for (int r = 0; r < 2; ++r) {
            float ss = 0.f;
#pragma unroll
            for (int i = 0; i < 4; ++i) ss += xv[r][i].x * xv[r][i].x + xv[r][i].y * xv[r][i].y + xv[r][i].z * xv[r][i].z + xv[r][i].w * xv[r][i].w;
            ss = wave_sum(ss);
            const float rstd = rsqrtf(ss * (1.f / 1024.f) + 1e-6f);
#pragma unroll
            for (int i = 0; i < 4; ++i) {
                const int col = i * 256 + lane * 4;
                const float4 g = *(const float4*)(gain + col), sh = *(const float4*)(shp + col), sc = *(const float4*)(scp + col);
                hv[r][i].x = xv[r][i].x * rstd * g.x * (1.f + sc.x) + sh.x; hv[r][i].y = xv[r][i].y * rstd * g.y * (1.f + sc.y) + sh.y;
                hv[r][i].z = xv[r][i].z * rstd * g.z * (1.f + sc.z) + sh.z; hv[r][i].w = xv[r][i].w * rstd * g.w * (1.f + sc.w) + sh.w;
                uint2 u; u.x = att::pk(hv[r][i].x, hv[r][i].y); u.y = att::pk(hv[r][i].z, hv[r][i].w);
                *(uint2*)(p.H + (size_t)(row0 + r) * 1024 + col) = u;
            }
        }
#pragma unroll
        for (int e = 0; e < 16; ++e) {
            float a0 = 0.f, a1 = 0.f;
#pragma unroll
            for (int i = 0; i < 4; ++i) { const mm::f32x4 w = *(const LAS mm::f32x4*)(rw + e * 1024 + i * 256 + lane * 4);
                a0 += hv[0][i].x * w[0] + hv[0][i].y * w[1] + hv[0][i].z * w[2] + hv[0][i].w * w[3]; a1 += hv[1][i].x * w[0] + hv[1][i].y * w[1] + hv[1][i].z * w[2] + hv[1][i].w * w[3]; }
            red[e * 64 + lane] = a0; red[(16 + e) * 64 + lane] = a1;
        }
        __builtin_amdgcn_wave_barrier();
        {
            const int r = lane >> 5, e = (lane >> 1) & 15, half = lane & 1; const LAS float* src = red + (r * 16 + e) * 64 + half * 32;
            float sacc = 0.f;
#pragma unroll
            for (int q = 0; q < 8; ++q) { const mm::f32x4 v = *(const LAS mm::f32x4*)(src + q * 4); sacc += (v[0] + v[1]) + (v[2] + v[3]); }
            sacc += dpp_f<0xB1>(sacc);
            const float sg = 1.f / (1.f + __expf(-sacc));
            if (half == 0) { my[r * 32 + e] = sg; my[r * 32 + 16 + e] = sg + p.router_b[e]; }
        }
        __builtin_amdgcn_wave_barrier();
        if ((lane & 31) == 0) {
            const int r = lane >> 5; const LAS float* m = my + r * 32;
            float best = -3.0e38f; int be1 = 0, be2 = 1;
#pragma unroll
            for (int g = 0; g < 4; ++g) {
                const mm::f32x4 v = *(const LAS mm::f32x4*)(m + 16 + 4 * g);
                int i1 = 0; float m1 = v[0];
                if (v[1] > m1) { m1 = v[1]; i1 = 1; } if (v[2] > m1) { m1 = v[2]; i1 = 2; } if (v[3] > m1) { m1 = v[3]; i1 = 3; }
                int i2 = -1; float m2 = -3.0e38f;
                if (i1 != 0 && v[0] > m2) { m2 = v[0]; i2 = 0; } if (i1 != 1 && v[1] > m2) { m2 = v[1]; i2 = 1; }
                if (i1 != 2 && v[2] > m2) { m2 = v[2]; i2 = 2; } if (i1 != 3 && v[3] > m2) { m2 = v[3]; i2 = 3; }
                const float gs = m1 + m2;
                if (gs > best) { best = gs; be1 = 4 * g + i1; be2 = 4 * g + i2; }
            }
            const float bs1 = m[be1], bs2 = m[be2]; const float inv = 1.f / (bs1 + bs2);
            const int p1 = atomicAdd((int*)&lcnt[be1], 1), p2 = atomicAdd((int*)&lcnt[be2], 1);
            LAS int* ent = rlist + (wid * 24 + nlist * 2 + r) * 4;
            const int row = row0 + r;
            ent[0] = row; ent[1] = be1 | (be2 << 8); ent[2] = p1; ent[3] = p2;
            p.tokw[row * 2] = bs1 * inv; p.tokw[row * 2 + 1] = bs2 * inv;
        }
        ++nlist;
        __builtin_amdgcn_wave_barrier();
    }
    __syncthreads();
    if (tid < 16) lbase[tid] = atomicAdd(p.cnt + (layer * 16 + tid) * 64, lcnt[tid]);
    __syncthreads();
    for (int k = lane; k < 2 * nlist; k += 64) {
        const LAS int* ent = rlist + (wid * 24 + k) * 4; const int row = ent[0], be1 = ent[1] & 255, be2 = ent[1] >> 8;
        p.slot[(size_t)be1 * NT + lbase[be1] + ent[2]] = row * 2; p.slot[(size_t)be2 * NT + lbase[be2] + ent[3]] = row * 2 + 1;
    }
    __syncthreads();
}

template <int PH>
DI void run_phase(const Params& p, float* lds, int L) {
    const Ctx cx = make_ctx();
    const int j = L >> 1;
    const float* modl = p.mod + (size_t)L * 17 * 6144;
    const float* modprev = p.mod + (size_t)(L > 0 ? L - 1 : 0) * 17 * 6144;
    const bool last = (L == 3);
    const int rows_layer = (L == 3) ? NLAT : NT;
    const int rows_out = (L >= 2) ? NLAT : NT;
    const float* xin_lat = (L == 0) ? p.x : p.out; const float* xin_ctx = (L == 0) ? p.ctx : p.ctxs;
    if constexpr (PH == 0) { if (OPT >= 7) { ph_mod_opt(cx, p, lds); for (int i = cx.bid * NTHR + cx.tid; i < 1024; i += cx.nblk * NTHR) p.H[(size_t)NT * 1024 + i] = 0; } else ph_prologue(cx, p, lds); ph_prep_weights(cx, p, lds); }
    if constexpr (PH == 1) {
        if (OPT >= 4) ph_prep_moe(cx, p, lds, L);
        if (L == 0) ph_norm<false, true, false>(cx, p, lds, rows_layer, xin_lat, xin_ctx, p.norm1_g + L * 1024, modl, 0, 1, modprev, L);
        else ph_norm<true, true, false>(cx, p, lds, rows_layer, xin_lat, xin_ctx, p.norm1_g + L * 1024, modl, 0, 1, modprev, L);
    }
    if constexpr (PH == 2) { if (OPT >= 1) ph_win_mm(cx, p, lds, j); else ph_win(cx, p, lds, j); }
    if constexpr (PH == 3) ph_prepB(cx, p, j);
    if constexpr (PH == 4) { if (OPT >= 2) ph_qkvup_mm(cx, p, lds, j, rows_out); else ph_qkvup(cx, p, lds, j, rows_out); }
    if constexpr (PH == 5) { if (OPT >= 7) ph_finalize_opt(cx, p, lds, j, rows_out); else ph_finalize(cx, p, j, rows_out); }
    if constexpr (PH == 6) { if (OPT >= 5) ph_attn_mm(cx, p, lds, rows_out == NT); else ph_attn(cx, p, rows_out == NT); }
    if constexpr (PH == 7) ph_prepLR(cx, p, j);
    if constexpr (PH == 8) { if (OPT >= 2) ph_wag_mm(cx, p, lds, j); else ph_wag(cx, p, lds, j); }
    if constexpr (PH == 9) { if (OPT >= 9) ph_scan_chunk(cx, p, lds, j); else if (OPT >= 6) ph_scan_opt<0>(cx, p, lds, j); else ph_scan(cx, p, lds, j); }
    if constexpr (PH == 19) ph_scan_opt<PROBE_SCAN>(cx, p, lds, j);
    if constexpr (PH == 10) { if (OPT >= 7) ph_post_opt(cx, p, j, rows_out); else ph_post(cx, p, j, rows_out); }
    if constexpr (PH == 11) { if (OPT >= 1) ph_wout_mm(cx, p, lds, p.H, p.WoutT + (size_t)j * 1024 * 1024, rows_out, xin_lat, xin_ctx, modl); else ph_wout(cx, p, lds, p.H, p.w_out_even + (size_t)j * 1024 * 1024, rows_out, xin_lat, xin_ctx, modl); }
    if constexpr (PH == 12) { if (OPT >= 3) ph_f1_mm(cx, p, lds, j, !last); else ph_chdft(cx, p, lds, rows_layer); }
    if constexpr (PH == 13) { if (OPT >= 3) ph_f2_mm(cx, p, lds, !last, xin_lat, xin_ctx, modl); else ph_posdft(cx, p, lds, !last); }
    if constexpr (PH == 14) { if (OPT < 3) ph_wout(cx, p, lds, p.F, p.w_out_fourier + (size_t)j * 1024 * 1024, rows_out, xin_lat, xin_ctx, modl); }
    if constexpr (PH == 15) { if (OPT >= 8) ph_norm2_router(cx, p, lds, rows_out, p.norm2_g + L * 1024, modl, L); else ph_norm<false, true, true>(cx, p, lds, rows_out, p.out, p.ctxs, p.norm2_g + L * 1024, modl, 3, 4, modprev, L); }
    if constexpr (PH == 16) { if (OPT >= 4) ph_moe_up_mm(cx, p, lds, L, rows_out); else ph_moe_up(cx, p, lds, L, rows_out); }
    if constexpr (PH == 17) { if (OPT >= 4) ph_moe_down_mm(cx, p, lds, L, rows_out); else ph_moe_down(cx, p, lds, L, rows_out); }
    if constexpr (PH == 18) ph_norm<true, false, false>(cx, p, lds, NLAT, p.out, p.ctxs, p.norm1_g, p.mod + (size_t)3 * 17 * 6144, 0, 1, p.mod + (size_t)3 * 17 * 6144, 3);
}

template <int PH>
__global__ void __launch_bounds__(NTHR, 2) k_phase(Params p, int L) {
    extern __shared__ __attribute__((aligned(16))) float shm[];
    run_phase<PH>(p, shm, L);
}

#if ONE_LAUNCH
constexpr int PARAM_WORDS = (int)(sizeof(Params) / 4);
DI Params load_params(const unsigned* lp) {
    Params q; unsigned* d = (unsigned*)&q;
#pragma unroll
    for (int i = 0; i < PARAM_WORDS; ++i) d[i] = (unsigned)__builtin_amdgcn_readfirstlane((int)lp[i]);
    void** pp = (void**)&q;
#pragma unroll
    for (int i = 0; i < PARAM_WORDS / 2; ++i) pp[i] = (void*)(__attribute__((address_space(1))) void*)pp[i];
    return q;
}
#ifndef PROBE_MASK
#define PROBE_MASK 0u
#endif

#define PHASE(PH, L) do { unsigned long long t0_ = 0; if (PROBE_MASK & (1u << (PH))) t0_ = wall_clock64(); \
    { run_phase<PH>(p, lds, (L)); } xcd_barrier(bar); \
    if (PROBE_MASK & (1u << (PH))) tacc += wall_clock64() - t0_; } while (0)
__global__ void __launch_bounds__(NTHR, 2) k_mega(Params p) {
    extern __shared__ __attribute__((aligned(16))) float shm[];
    unsigned* lp = (unsigned*)(shm + 4);
    float* lds = shm + 4 + ((PARAM_WORDS + 3) & ~3);
    if (threadIdx.x == 0) { shm[0] = 0.f; shm[1] = 0.f; shm[2] = 0.f; shm[3] = 0.f; }
    if (threadIdx.x < PARAM_WORDS) lp[threadIdx.x] = ((const unsigned*)&p)[threadIdx.x];
    __syncthreads();
    XcdBarrier bar; { const Params q_ = load_params(lp); bar = xcd_barrier_post(q_.bar, (volatile LAS unsigned*)shm); }
    unsigned long long tacc = 0;
    PHASE(0, 0);
#define LAYER_EVEN(L) PHASE(1, L); PHASE(2, L); PHASE(3, L); PHASE(4, L); PHASE(5, L); PHASE(6, L); PHASE(7, L); PHASE(8, L); PHASE(9, L); if (PROBE_SCAN) { PHASE(19, L); } PHASE(10, L); PHASE(11, L); PHASE(15, L); PHASE(16, L); PHASE(17, L)
#define LAYER_ODD(L) PHASE(1, L); PHASE(12, L); PHASE(13, L); PHASE(14, L); PHASE(15, L); PHASE(16, L); PHASE(17, L)
    LAYER_EVEN(0); LAYER_ODD(1); LAYER_EVEN(2); LAYER_ODD(3);
    { unsigned long long t0_ = 0; if (PROBE_MASK & (1u << 18)) t0_ = wall_clock64(); run_phase<18>(p, lds, 3);
      if (PROBE_MASK & (1u << 18)) { xcd_barrier(bar); tacc += wall_clock64() - t0_; } }
    if (PROBE_MASK != 0u && blockIdx.x == 0 && threadIdx.x == 0) {
        const unsigned long long t1 = wall_clock64(); while (wall_clock64() - t1 < 20ull * tacc) __builtin_amdgcn_s_sleep(8); }
}
#endif

static inline size_t al256(size_t v) { return (v + 255) & ~(size_t)255; }
constexpr size_t LDS_BYTES = 136 * 1024;

template <int PH> static void launch_phase(const Params& p, int L, int grid, hipStream_t s) {
    static bool attr = false;
    if (!attr) { hipFuncSetAttribute((const void*)k_phase<PH>, hipFuncAttributeMaxDynamicSharedMemorySize, (int)LDS_BYTES); attr = true; }
    hipLaunchKernelGGL(k_phase<PH>, dim3(grid), dim3(NTHR), LDS_BYTES, s, p, L);
}

extern "C" void kernel_launch(void* const* d_in, const int* in_sizes, int n_in, void* d_out, int out_size, void* d_ws, size_t ws_size, hipStream_t stream) {
    (void)in_sizes; (void)n_in; (void)out_size;
    Params p{};
    const float** ip = (const float**)&p.x;
    for (int i = 0; i < 36; ++i) ip[i] = (const float*)d_in[i];
    p.out = (float*)d_out;
    char* w = (char*)d_ws; size_t o = 0;
    auto take = [&](size_t bytes) { char* r = w + o; o += al256(bytes); return r; };
    p.bar = (unsigned*)take(XCD_BAR_WORDS * 4);
    p.cnt = (int*)take(64 * 64 * 4);
    const size_t zero_bytes = o;
    p.mod = (float*)take((size_t)4 * 17 * 6144 * 4);
    p.ctxs = (float*)take((size_t)NCTX * 1024 * 4);
    p.dftl = (bf16_t*)take((size_t)2048 * 4096 * 2);
    p.dftc = (bf16_t*)take((size_t)256 * 512 * 2);
    p.slot = (int*)take((size_t)16 * NT * 4);
    p.tokw = (float*)take((size_t)NT * 2 * 4);
    p.H = (bf16_t*)take((size_t)(NT + 1) * 1024 * 2);
    char* big = w + o;
    p.P = (bf16_t*)take((size_t)NT * PLD * 2);
    char* r1 = w + o;
    p.LR = (bf16_t*)take((size_t)NT * 384 * 2);
    p.WAG = (bf16_t*)take((size_t)NT * WLD * 2);
    p.YF = (bf16_t*)take((size_t)NT * 512 * 2);
    p.YB = (bf16_t*)take((size_t)NT * 512 * 2);
    p.WinT = (bf16_t*)take((size_t)2 * 2560 * 1024 * 2); p.WqT = (bf16_t*)take((size_t)2 * 768 * 256 * 2); p.WkvT = (bf16_t*)take((size_t)2 * 1024 * 256 * 2);
    p.WlrT = (bf16_t*)take((size_t)2 * 2560 * 384 * 2); p.WoutT = (bf16_t*)take((size_t)2 * 1024 * 1024 * 2); p.A1 = (bf16_t*)take((size_t)2 * 2048 * 1024 * 2);
    p.A2 = (bf16_t*)take((size_t)2048 * 4096 * 2); p.A2c = (bf16_t*)take((size_t)256 * 512 * 2);
    p.WguT = (bf16_t*)take((size_t)17 * 1024 * 1024 * 2); p.WdT = (bf16_t*)take((size_t)17 * 1024 * 512 * 2);
    const size_t total = o;
    { size_t q = 0; auto t2 = [&](size_t bytes) { char* r = r1 + q; q += al256(bytes); return r; };
      p.QN = (bf16_t*)t2((size_t)NT * 512 * 2); p.Qraw = (bf16_t*)t2((size_t)NT * 768 * 2); p.KVraw = (bf16_t*)t2((size_t)NT * 1024 * 2);
      p.Kf = (bf16_t*)t2((size_t)NB * 8 * 2304 * 96 * 2); p.Vt = (bf16_t*)t2((size_t)NB * 8 * 64 * 2304 * 2); }
    { size_t q = 0; auto t3 = [&](size_t bytes) { char* r = big + q; q += al256(bytes); return r; };
      p.ACT = (bf16_t*)t3((size_t)3 * NT * 512 * 2); p.Y = (bf16_t*)t3((size_t)3 * NT * 1024 * 2); }
    { size_t q = 0; auto t4 = [&](size_t bytes) { char* r = big + q; q += al256(bytes); return r; };
      p.G = (float*)t4((size_t)NT * 2048 * 4); p.F = (bf16_t*)t4((size_t)NT * 1024 * 2); }
    { size_t q = 0; auto t5 = [&](size_t bytes) { char* r = big + q; q += al256(bytes); return r; };
      p.ZT = (bf16_t*)t5((size_t)16 * 1024 * 4096 * 2); p.ZTC = (bf16_t*)t5((size_t)16 * 1024 * 512 * 2); }
    if (total > ws_size) { fprintf(stderr, "workspace too small: need %zu have %zu\n", total, ws_size); return; }
    static int grid = 0;
    if (!grid) { int dev = 0, cus = 0; hipGetDevice(&dev); hipDeviceGetAttribute(&cus, hipDeviceAttributeMultiprocessorCount, dev); grid = cus > 0 ? cus : 256; if (grid > 256) grid = 256; }
    hipMemsetAsync(d_ws, 0, zero_bytes, stream);
#if ONE_LAUNCH
    static bool attr = false;
    if (!attr) { hipFuncSetAttribute((const void*)k_mega, hipFuncAttributeMaxDynamicSharedMemorySize, (int)LDS_BYTES); attr = true; }
    hipLaunchKernelGGL(k_mega, dim3(grid), dim3(NTHR), LDS_BYTES, stream, p);
#else
    launch_phase<0>(p, 0, grid, stream);
    for (int L = 0; L < 4; ++L) {
        launch_phase<1>(p, L, grid, stream);
        if ((L & 1) == 0) {
            launch_phase<2>(p, L, grid, stream); launch_phase<3>(p, L, grid, stream); launch_phase<4>(p, L, grid, stream); launch_phase<5>(p, L, grid, stream);
            launch_phase<6>(p, L, grid, stream); launch_phase<7>(p, L, grid, stream); launch_phase<8>(p, L, grid, stream); launch_phase<9>(p, L, grid, stream);
            launch_phase<10>(p, L, grid, stream); launch_phase<11>(p, L, grid, stream);
        } else {
            launch_phase<12>(p, L, grid, stream); launch_phase<13>(p, L, grid, stream); launch_phase<14>(p, L, grid, stream);
        }
        launch_phase<15>(p, L, grid, stream); launch_phase<16>(p, L, grid, stream); launch_phase<17>(p, L, grid, stream);
    }
    launch_phase<18>(p, 3, grid, stream);
#endif
}
```

```cpp
#include <hip/hip_runtime.h>
#include <cstdio>
#include <cstdint>

#ifndef ONE_LAUNCH
#define ONE_LAUNCH 1
#endif
#ifndef PROBE_SCAN
#define PROBE_SCAN 0
#endif
#ifndef OPT
#define OPT 10
#endif

typedef unsigned short bf16_t;
#define DI __device__ __forceinline__
#define LAS __attribute__((address_space(3)))

constexpr int D = 1024, NB = 16, SEQ = 2048, CTXL = 256, NLAT = NB * SEQ, NCTX = NB * CTXL, NT = NLAT + NCTX;
constexpr int PLD = 2560;
constexpr int INC = 2336, ACOLS = 1920;
constexpr int WLD = 2560;
constexpr int NTHR = 512;

#define XB_TMO      128
#define XB_XCNT(j)  (256  + 64 * (j))
#define XB_XSUB(j)  (1280 + 64 * (j))
#define XB_XGEN(j)  (2304 + 64 * (j))
#define XB_TOP      3328
#define XB_TOPGEN   3392
#define XCD_BAR_WORDS 3456
#define XB_SPIN_CAP (1u << 24)
DI unsigned xb_ld(unsigned* p)              { return __hip_atomic_load(p, __ATOMIC_RELAXED, __HIP_MEMORY_SCOPE_AGENT); }
DI unsigned xb_add(unsigned* p, unsigned v) { return __hip_atomic_fetch_add(p, v, __ATOMIC_RELAXED, __HIP_MEMORY_SCOPE_AGENT); }
DI unsigned xb_xcc_id() { return (unsigned)__builtin_amdgcn_s_getreg((3 << 11) | 20) & 0xFu; }
#define XB_SPIN(cond, bar) do { unsigned _sp = 0; while (cond) { __builtin_amdgcn_s_sleep(1); \
    if ((++_sp & 255u) == 0u) { if (xb_ld(&(bar)[XB_TMO])) break; if (_sp > XB_SPIN_CAP) { atomicAdd(&(bar)[XB_TMO], 1u); break; } } } } while (0)
struct XcdBarrier { unsigned* bar; unsigned x; volatile LAS unsigned* st; };
DI XcdBarrier xcd_barrier_post(unsigned* bar, volatile LAS unsigned* st) {
    XcdBarrier b; b.bar = bar; b.x = xb_xcc_id(); b.st = st;
    if (threadIdx.x == 0) (void)xb_add(&bar[XB_XCNT(b.x)], 1u);
    return b;
}
DI void xcd_barrier_complete(unsigned* bar, unsigned x, unsigned& nloc, unsigned& nx) {
    const unsigned G = gridDim.x * gridDim.y * gridDim.z;
    unsigned sum, cnt, mine, sp = 0u;
    for (;;) {
        sum = 0u; cnt = 0u; mine = 0u;
#pragma unroll
        for (unsigned j = 0; j < 16; ++j) { const unsigned c = xb_ld(&bar[XB_XCNT(j)]); sum += c; cnt += (c > 0u) ? 1u : 0u; mine = (j == x) ? c : mine; }
        if (sum == G) break;
        __builtin_amdgcn_s_sleep(1);
        if ((++sp & 255u) == 0u) { if (xb_ld(&bar[XB_TMO])) break; if (sp > XB_SPIN_CAP) { atomicAdd(&bar[XB_TMO], 1u); break; } }
    }
    nloc = mine > 0u ? mine : 1u; nx = cnt > 0u ? cnt : 1u;
}
DI void xcd_barrier(const XcdBarrier& b) {
    asm volatile("s_waitcnt vmcnt(0)" ::: "memory");
    __syncthreads();
    if (threadIdx.x == 0) {
        unsigned* bar = b.bar;
        __builtin_amdgcn_s_waitcnt(0);
        unsigned nloc = b.st[0], nx = b.st[1];
        if (nloc == 0u) { xcd_barrier_complete(bar, b.x, nloc, nx); b.st[0] = nloc; b.st[1] = nx; }
        const unsigned old = xb_add(&bar[XB_XSUB(b.x)], 1u);
        const unsigned gen = old / nloc;
        if (old + 1u == (gen + 1u) * nloc) {
            __builtin_amdgcn_fence(__ATOMIC_RELEASE, "agent");
            asm volatile("s_waitcnt vmcnt(0)" ::: "memory");
            const unsigned og = xb_add(&bar[XB_TOP], 1u);
            const unsigned tg = og / nx;
            if (og + 1u == (tg + 1u) * nx) xb_add(&bar[XB_TOPGEN], 1u);
            else XB_SPIN(xb_ld(&bar[XB_TOPGEN]) == tg, bar);
            __builtin_amdgcn_fence(__ATOMIC_ACQUIRE, "agent");
            xb_add(&bar[XB_XGEN(b.x)], 1u);
            asm volatile("s_waitcnt vmcnt(0)" ::: "memory");
        } else {
            XB_SPIN(xb_ld(&bar[XB_XGEN(b.x)]) == gen, bar);
            __builtin_amdgcn_fence(__ATOMIC_ACQUIRE, "agent");
            asm volatile("s_waitcnt vmcnt(0)" ::: "memory");
        }
    }
    __syncthreads();
}

struct Params {
    const float *x, *c, *ctx, *c_ctx, *norm1_g, *norm2_g, *mod_w, *mod_b, *w_in, *a_mu, *a_w0, *a_w2, *a_a0, *a_a2, *a_g2,
                *a_k_k, *a_k_a, *a_r_k, *a_ln_w, *a_ln_b, *b_q_norm, *b_w_q_up, *b_kv_norm, *b_w_kv_up, *b_q_gain, *b_k_gain,
                *w_out_even, *w_out_fourier, *router_w, *router_b, *moe_w_gate, *moe_w_up, *moe_w_down, *sh_gate, *sh_up, *sh_down;
    float* out;
    unsigned* bar; int* cnt; float* mod; float* ctxs; bf16_t* dftl; bf16_t* dftc; int* slot; float* tokw; float* slotw;
    bf16_t *H, *P, *LR, *WAG, *YF, *YB, *QN, *Qraw, *KVraw, *Kf, *Vt, *ACT, *Y, *F; float* G;
    bf16_t *WinT, *WqT, *WkvT, *WlrT, *WoutT, *A1, *A2, *A2c, *WguT, *WdT, *ZT, *ZTC;
};

struct Ctx { int tid, bid, nblk; };
DI Ctx make_ctx() { Ctx c; c.tid = threadIdx.x; c.bid = blockIdx.x; c.nblk = gridDim.x; asm volatile("" : "+v"(c.tid), "+s"(c.bid), "+s"(c.nblk)); return c; }

DI bf16_t f2bf(float f) { unsigned u = __float_as_uint(f); u += 0x7fffu + ((u >> 16) & 1u); return (bf16_t)(u >> 16); }
DI float bf2f(bf16_t b) { return __uint_as_float(((unsigned)b) << 16); }
DI float bflo(unsigned u) { return __uint_as_float(u << 16); }
DI float bfhi(unsigned u) { return __uint_as_float(u & 0xffff0000u); }
DI unsigned pack2(float lo, float hi) { return (unsigned)f2bf(lo) | ((unsigned)f2bf(hi) << 16); }
DI float siluf(float v) { return v / (1.f + expf(-v)); }
DI float sigm(float v) { return 1.f / (1.f + expf(-v)); }
template <int CTRL> DI float dpp_f(float v) { return __builtin_bit_cast(float, __builtin_amdgcn_update_dpp(0, __builtin_bit_cast(int, v), CTRL, 0xf, 0xf, true)); }
DI float wave_sum(float v) {
    v += dpp_f<0xB1>(v); v += dpp_f<0x4E>(v); v += dpp_f<0x141>(v); v += dpp_f<0x140>(v);
    const int x = __builtin_bit_cast(int, v);
    const float a = __builtin_bit_cast(float, __builtin_amdgcn_readlane(x, 0)), b = __builtin_bit_cast(float, __builtin_amdgcn_readlane(x, 16));
    const float c = __builtin_bit_cast(float, __builtin_amdgcn_readlane(x, 32)), d = __builtin_bit_cast(float, __builtin_amdgcn_readlane(x, 48));
    return (a + b) + (c + d);
}

template <bool DUAL, class AFn, class BFn, class BFn2, class Epi>
DI void ngemm(const Ctx& cx, float* lds, int nbz, int M, int N, int K, AFn afn, BFn bfn, BFn2 bfn2, Epi epi) {
    float* As = lds; float* Bs = lds + 16 * 132; float* B2s = Bs + 16 * 128;
    const int tid = cx.tid, ty = tid >> 5, tx = tid & 31;
    const int tm = (M + 127) / 128, tn = (N + 127) / 128, ntile = tm * tn * nbz;
    const int arow = tid >> 2, akc = (tid & 3) * 4, bk = tid >> 5, bnn = (tid & 31) * 4;
    for (int tile = cx.bid; tile < ntile; tile += cx.nblk) {
        const int bz = tile / (tm * tn), rem = tile % (tm * tn), bm = rem / tn, bn = rem % tn;
        float acc[8][4], acc2[8][4];
#pragma unroll
        for (int i = 0; i < 8; ++i)
#pragma unroll
            for (int j = 0; j < 4; ++j) { acc[i][j] = 0.f; acc2[i][j] = 0.f; }
        const int m_a = bm * 128 + arow;
        const bf16_t* aptr = (m_a < M) ? afn(bz, m_a) : nullptr;
        const int nB = bn * 128 + bnn;
        for (int k0 = 0; k0 < K; k0 += 16) {
            float av0 = 0.f, av1 = 0.f, av2 = 0.f, av3 = 0.f;
            if (aptr) { const uint2 u = *(const uint2*)(aptr + k0 + akc); av0 = bflo(u.x); av1 = bfhi(u.x); av2 = bflo(u.y); av3 = bfhi(u.y); }
            float4 bv = make_float4(0.f, 0.f, 0.f, 0.f), bv2 = make_float4(0.f, 0.f, 0.f, 0.f);
            if (nB < N) { bv = *(const float4*)(bfn(bz, k0 + bk) + nB); if (DUAL) bv2 = *(const float4*)(bfn2(bz, k0 + bk) + nB); }
            __syncthreads();
            As[(akc + 0) * 132 + arow] = av0; As[(akc + 1) * 132 + arow] = av1; As[(akc + 2) * 132 + arow] = av2; As[(akc + 3) * 132 + arow] = av3;
            *(float4*)&Bs[bk * 128 + bnn] = bv;
            if (DUAL) *(float4*)&B2s[bk * 128 + bnn] = bv2;
            __syncthreads();
#pragma unroll 4
            for (int kk = 0; kk < 16; ++kk) {
                const float4 a0 = *(const float4*)&As[kk * 132 + ty * 8], a1 = *(const float4*)&As[kk * 132 + ty * 8 + 4];
                const float4 b = *(const float4*)&Bs[kk * 128 + tx * 4];
                const float a[8] = {a0.x, a0.y, a0.z, a0.w, a1.x, a1.y, a1.z, a1.w};
                const float bb[4] = {b.x, b.y, b.z, b.w};
#pragma unroll
                for (int i = 0; i < 8; ++i)
#pragma unroll
                    for (int j = 0; j < 4; ++j) acc[i][j] += a[i] * bb[j];
                if (DUAL) {
                    const float4 b2 = *(const float4*)&B2s[kk * 128 + tx * 4];
                    const float cc[4] = {b2.x, b2.y, b2.z, b2.w};
#pragma unroll
                    for (int i = 0; i < 8; ++i)
#pragma unroll
                        for (int j = 0; j < 4; ++j) acc2[i][j] += a[i] * cc[j];
                }
            }
        }
#pragma unroll
        for (int i = 0; i < 8; ++i) {
            const int m = bm * 128 + ty * 8 + i;
            if (m < M) {
#pragma unroll
                for (int j = 0; j < 4; ++j) { const int n = bn * 128 + tx * 4 + j; if (n < N) epi(bz, m, n, acc[i][j], acc2[i][j]); }
            }
        }
    }
    __syncthreads();
}

DI void ph_prologue(const Ctx& cx, const Params& p, float* lds) {
    const int tid = cx.tid, gtid = cx.bid * NTHR + tid, gsz = cx.nblk * NTHR;
    for (int i = tid; i < 17 * 1024; i += NTHR) { const int j = i >> 10, k = i & 1023; const float v = (j < 16) ? p.c[j * 1024 + k] : p.c_ctx[k]; lds[i] = siluf(v); }
    __syncthreads();
    for (int idx = gtid; idx < 4 * 6144; idx += gsz) {
        const int l = idx / 6144, n = idx % 6144;
        const float* w = p.mod_w + (size_t)l * 1024 * 6144 + n;
        float acc[17]; const float b0 = p.mod_b[l * 6144 + n];
#pragma unroll
        for (int j = 0; j < 17; ++j) acc[j] = b0;
        for (int k = 0; k < 1024; ++k) {
            const float wv = w[(size_t)k * 6144];
#pragma unroll
            for (int j = 0; j < 17; ++j) acc[j] += lds[j * 1024 + k] * wv;
        }
#pragma unroll
        for (int j = 0; j < 17; ++j) p.mod[((size_t)l * 17 + j) * 6144 + n] = acc[j];
    }
    for (int i = gtid; i < 2048 * 4096; i += gsz) {
        const int f = i >> 12, k = i & 4095, t = k & 2047, m = (f * t) & 2047; const float a = (float)m * (1.f / 1024.f);
        p.dftl[i] = f2bf((k < 2048) ? cospif(a) : sinpif(a));
    }
    for (int i = gtid; i < 256 * 512; i += gsz) {
        const int f = i >> 9, k = i & 511, t = k & 255, m = (f * t) & 255; const float a = (float)m * (1.f / 128.f);
        p.dftc[i] = f2bf((k < 256) ? cospif(a) : sinpif(a));
    }
    for (int i = gtid; i < 1024; i += gsz) p.H[(size_t)NT * 1024 + i] = 0;
    __syncthreads();
}

DI float pick4(float a0, float a1, float a2, float a3, int i) { return i == 0 ? a0 : (i == 1 ? a1 : (i == 2 ? a2 : a3)); }
template <bool COMBINE, bool NORM, bool ROUTER>
DI void ph_norm(const Ctx& cx, const Params& p, float* lds, int nrows, const float* xin_lat, const float* xin_ctx, const float* gain, const float* modl, int sh_idx, int sc_idx,
                const float* modprev, int layer) {
    const int tid = cx.tid, wid = tid >> 6, lane = tid & 63;
    float* rw = lds;
    float* scr = lds + 16 * 1024;
    int* lcnt = (int*)(lds + 16 * 1024 + 256); int* lbase = lcnt + 16; int* rlist = lcnt + 32;
    int nlist = 0;
    if (ROUTER) {
        for (int i = tid; i < 16 * 1024; i += NTHR) { const int e = i >> 10, col = i & 1023; rw[i] = p.router_w[col * 16 + e]; }
        if (tid < 16) lcnt[tid] = 0;
        __syncthreads();
    }
    for (int row = cx.bid * 8 + wid; row < nrows; row += cx.nblk * 8) {
        const bool lat = row < NLAT; const int j = lat ? (row >> 11) : 16;
        const float* xr = lat ? xin_lat + (size_t)row * 1024 : xin_ctx + (size_t)(row - NLAT) * 1024;
        float4 xv[4];
#pragma unroll
        for (int i = 0; i < 4; ++i) xv[i] = *(const float4*)(xr + i * 256 + lane * 4);
        if (COMBINE) {
            const float* g2 = modprev + (size_t)j * 6144 + 5 * 1024;
            float* xo = lat ? p.out + (size_t)row * 1024 : p.ctxs + (size_t)(row - NLAT) * 1024;
#pragma unroll
            for (int i = 0; i < 4; ++i) {
                const int col = i * 256 + lane * 4;
                const float4 gv = *(const float4*)(g2 + col);
                float s0 = 0.f, s1 = 0.f, s2 = 0.f, s3 = 0.f;
#pragma unroll
                for (int s = 0; s < 3; ++s) { const uint2 u = *(const uint2*)(p.Y + ((size_t)s * NT + row) * 1024 + col); s0 += bflo(u.x); s1 += bfhi(u.x); s2 += bflo(u.y); s3 += bfhi(u.y); }
                xv[i].x += gv.x * s0; xv[i].y += gv.y * s1; xv[i].z += gv.z * s2; xv[i].w += gv.w * s3;
                *(float4*)(xo + col) = xv[i];
            }
        }
        if (NORM) {
            float ss = 0.f;
#pragma unroll
            for (int i = 0; i < 4; ++i) ss += xv[i].x * xv[i].x + xv[i].y * xv[i].y + xv[i].z * xv[i].z + xv[i].w * xv[i].w;
            ss = wave_sum(ss);
            const float rstd = rsqrtf(ss * (1.f / 1024.f) + 1e-6f);
            const float* shp = modl + (size_t)j * 6144 + sh_idx * 1024; const float* scp = modl + (size_t)j * 6144 + sc_idx * 1024;
            float4 hv[4];
#pragma unroll
            for (int i = 0; i < 4; ++i) {
                const int col = i * 256 + lane * 4;
                const float4 g = *(const float4*)(gain + col), sh = *(const float4*)(shp + col), sc = *(const float4*)(scp + col);
                hv[i].x = xv[i].x * rstd * g.x * (1.f + sc.x) + sh.x; hv[i].y = xv[i].y * rstd * g.y * (1.f + sc.y) + sh.y;
                hv[i].z = xv[i].z * rstd * g.z * (1.f + sc.z) + sh.z; hv[i].w = xv[i].w * rstd * g.w * (1.f + sc.w) + sh.w;
                uint2 u; u.x = pack2(hv[i].x, hv[i].y); u.y = pack2(hv[i].z, hv[i].w);
                *(uint2*)(p.H + (size_t)row * 1024 + col) = u;
            }
            if (ROUTER) {
                float part[16];
#pragma unroll
                for (int e = 0; e < 16; ++e) {
                    float a = 0.f;
#pragma unroll
                    for (int i = 0; i < 4; ++i) { const float4 w = *(const float4*)(rw + e * 1024 + i * 256 + lane * 4); a += hv[i].x * w.x + hv[i].y * w.y + hv[i].z * w.z + hv[i].w * w.w; }
                    part[e] = wave_sum(a);
                }
                float* my = scr + wid * 32;
#pragma unroll
                for (int e = 0; e < 16; ++e) if (lane == e) { const float sg = sigm(part[e]); my[e] = sg; my[16 + e] = sg + p.router_b[e]; }
                __builtin_amdgcn_wave_barrier();
                if (lane == 0) {
                    float best = -3.0e38f; int be1 = 0, be2 = 1;
                    for (int g = 0; g < 4; ++g) {
                        const float v0 = my[16 + 4 * g], v1 = my[16 + 4 * g + 1], v2 = my[16 + 4 * g + 2], v3 = my[16 + 4 * g + 3];
                        int i1 = 0; float m1 = v0;
                        if (v1 > m1) { m1 = v1; i1 = 1; } if (v2 > m1) { m1 = v2; i1 = 2; } if (v3 > m1) { m1 = v3; i1 = 3; }
                        int i2 = -1; float m2 = -3.0e38f;
                        if (i1 != 0 && v0 > m2) { m2 = v0; i2 = 0; } if (i1 != 1 && v1 > m2) { m2 = v1; i2 = 1; }
                        if (i1 != 2 && v2 > m2) { m2 = v2; i2 = 2; } if (i1 != 3 && v3 > m2) { m2 = v3; i2 = 3; }
                        const float gs = m1 + m2;
                        if (gs > best) { best = gs; be1 = 4 * g + i1; be2 = 4 * g + i2; }
                    }
                    const float bs1 = my[be1], bs2 = my[be2];
                    const float inv = 1.f / (bs1 + bs2);
                    const int p1 = atomicAdd(&lcnt[be1], 1), p2 = atomicAdd(&lcnt[be2], 1);
                    int* ent = rlist + (wid * 24 + nlist) * 4;
                    ent[0] = row; ent[1] = be1 | (be2 << 8); ent[2] = p1; ent[3] = p2;
                    p.tokw[row * 2] = bs1 * inv; p.tokw[row * 2 + 1] = bs2 * inv;
                }
                ++nlist;
                __builtin_amdgcn_wave_barrier();
            }
        }
    }
    if (ROUTER) {
        __syncthreads();
        if (tid < 16) lbase[tid] = atomicAdd(p.cnt + (layer * 16 + tid) * 64, lcnt[tid]);
        __syncthreads();
        for (int k = lane; k < nlist; k += 64) {
            const int* ent = rlist + (wid * 24 + k) * 4; const int row = ent[0], be1 = ent[1] & 255, be2 = ent[1] >> 8;
            p.slot[(size_t)be1 * NT + lbase[be1] + ent[2]] = row * 2; p.slot[(size_t)be2 * NT + lbase[be2] + ent[3]] = row * 2 + 1;
        }
    }
    (void)scr;
    __syncthreads();
}

DI void ph_win(const Ctx& cx, const Params& p, float* lds, int j) {
    const float* W = p.w_in + (size_t)j * 1024 * INC;
    ngemm<false>(cx, lds, 1, NT, INC, 1024,
        [&](int, int m) { return p.H + (size_t)m * 1024; },
        [&](int, int k) { return W + (size_t)k * INC; }, [&](int, int) { return (const float*)nullptr; },
        [&](int, int m, int n, float v, float) { p.P[(size_t)m * PLD + n] = f2bf(v); });
}
DI void ph_prepB(const Ctx& cx, const Params& p, int j) {
    const int tid = cx.tid, wid = tid >> 6, lane = tid & 63;
    for (int row = cx.bid * 8 + wid; row < NT; row += cx.nblk * 8) {
        const bf16_t* pr = p.P + (size_t)row * PLD + ACOLS;
        const uint2 uq = *(const uint2*)(pr + lane * 4); const unsigned ukv = *(const unsigned*)(pr + 256 + lane * 2);
        const float q0 = bflo(uq.x), q1 = bfhi(uq.x), q2 = bflo(uq.y), q3 = bfhi(uq.y), k0 = bflo(ukv), k1 = bfhi(ukv);
        const float sq = wave_sum(q0 * q0 + q1 * q1 + q2 * q2 + q3 * q3), sk = wave_sum(k0 * k0 + k1 * k1);
        const float rq = rsqrtf(sq * (1.f / 256.f) + 1e-6f), rk = rsqrtf(sk * (1.f / 128.f) + 1e-6f);
        const float* gq = p.b_q_norm + j * 256 + lane * 4; const float* gk = p.b_kv_norm + j * 128 + lane * 2;
        uint2 o; o.x = pack2(q0 * rq * gq[0], q1 * rq * gq[1]); o.y = pack2(q2 * rq * gq[2], q3 * rq * gq[3]);
        bf16_t* qn = p.QN + (size_t)row * 512;
        *(uint2*)(qn + lane * 4) = o;
        *(unsigned*)(qn + 256 + lane * 2) = pack2(k0 * rk * gk[0], k1 * rk * gk[1]);
        *(unsigned*)(qn + 384 + lane * 2) = 0u;
    }
}
DI void ph_qkvup(const Ctx& cx, const Params& p, float* lds, int j, int mq) {
    const float* Wq = p.b_w_q_up + (size_t)j * 256 * 768; const float* Wkv = p.b_w_kv_up + (size_t)j * 128 * 1024;
    ngemm<false>(cx, lds, 1, mq, 768, 256,
        [&](int, int m) { return p.QN + (size_t)m * 512; },
        [&](int, int k) { return Wq + (size_t)k * 768; }, [&](int, int) { return (const float*)nullptr; },
        [&](int, int m, int n, float v, float) { p.Qraw[(size_t)m * 768 + n] = f2bf(v); });
    ngemm<false>(cx, lds, 1, NT, 1024, 128,
        [&](int, int m) { return p.QN + (size_t)m * 512 + 256; },
        [&](int, int k) { return Wkv + (size_t)k * 1024; }, [&](int, int) { return (const float*)nullptr; },
        [&](int, int m, int n, float v, float) { p.KVraw[(size_t)m * 1024 + n] = f2bf(v); });
}
DI void unpack8(const uint4 u, float* d) { d[0] = bflo(u.x); d[1] = bfhi(u.x); d[2] = bflo(u.y); d[3] = bfhi(u.y); d[4] = bflo(u.z); d[5] = bfhi(u.z); d[6] = bflo(u.w); d[7] = bfhi(u.w); }
DI uint4 pack8(const float* d, float scl) { uint4 u; u.x = pack2(d[0] * scl, d[1] * scl); u.y = pack2(d[2] * scl, d[3] * scl); u.z = pack2(d[4] * scl, d[5] * scl); u.w = pack2(d[6] * scl, d[7] * scl); return u; }
DI float ssq8(const uint4 u) { float d[8]; unpack8(u, d); float s = 0.f;
#pragma unroll
    for (int i = 0; i < 8; ++i) s += d[i] * d[i];
    return s; }
DI void norm_rope_store(const uint4 (&raw)[12], const float* gain, int t, bool lat, float scl, bf16_t* dst) {
    float ss = 0.f;
#pragma unroll
    for (int i = 0; i < 12; ++i) ss += ssq8(raw[i]);
    const float r = rsqrtf(ss * (1.f / 96.f) + 1e-6f);
#pragma unroll
    for (int i = 0; i < 8; ++i) { float d[8]; unpack8(raw[i], d);
#pragma unroll
        for (int c = 0; c < 8; ++c) d[c] = d[c] * r * gain[i * 8 + c];
        *(uint4*)(dst + i * 8) = pack8(d, scl); }
    const float invf[8] = {1.f, 0.316227766016838f, 0.1f, 0.0316227766016838f, 0.01f, 0.00316227766016838f, 0.001f, 0.000316227766016838f};
    const float ri = (float)(t >> 6), ci = (float)(t & 63);
#pragma unroll
    for (int half = 0; half < 2; ++half) {
        float x1[8], x2[8], o1[8], o2[8]; unpack8(raw[8 + half], x1); unpack8(raw[10 + half], x2);
#pragma unroll
        for (int c = 0; c < 8; ++c) {
            const float ang = (half == 0 ? ri : ci) * invf[c];
            const float cs = lat ? __cosf(ang) : 1.f, sn = lat ? __sinf(ang) : 0.f;
            const float a = x1[c] * r * gain[64 + half * 8 + c], b = x2[c] * r * gain[80 + half * 8 + c];
            o1[c] = a * cs - b * sn; o2[c] = b * cs + a * sn;
        }
        *(uint4*)(dst + 64 + half * 8) = pack8(o1, scl); *(uint4*)(dst + 80 + half * 8) = pack8(o2, scl);
    }
}
DI void ph_finalize(const Ctx& cx, const Params& p, int j, int mq) {
    const int gtid = cx.bid * NTHR + cx.tid, gsz = cx.nblk * NTHR;
    const float* qg = p.b_q_gain + j * 96; const float* kg = p.b_k_gain + j * 96;
    for (int idx = gtid; idx < 8 * mq; idx += gsz) {
        const int h = idx / mq, row = idx % mq;
        const bool lat = row < NLAT; const int t = lat ? (row & 2047) : ((row - NLAT) & 255);
        bf16_t* qp = p.Qraw + (size_t)row * 768 + h * 96;
        uint4 raw[12];
#pragma unroll
        for (int i = 0; i < 12; ++i) raw[i] = *(const uint4*)(qp + i * 8);
        norm_rope_store(raw, qg, t, lat, (OPT >= 5) ? 0.10206207261596577f * 1.4426950408889634f : 0.10206207261596577f, qp);
    }
    for (int idx = gtid; idx < 8 * NT; idx += gsz) {
        const int h = idx / NT, row = idx % NT;
        const bool lat = row < NLAT; const int b = lat ? (row >> 11) : ((row - NLAT) >> 8); const int t = lat ? (row & 2047) : ((row - NLAT) & 255);
        const int key = lat ? 256 + t : t;
        const bf16_t* kvp = p.KVraw + (size_t)row * 1024 + h * 128; const bf16_t* krp = p.P + (size_t)row * PLD + ACOLS + 384;
        uint4 raw[12];
#pragma unroll
        for (int i = 0; i < 8; ++i) raw[i] = *(const uint4*)(kvp + i * 8);
#pragma unroll
        for (int i = 0; i < 4; ++i) raw[8 + i] = *(const uint4*)(krp + i * 8);
        norm_rope_store(raw, kg, t, lat, 1.f, p.Kf + ((size_t)(b * 8 + h) * 2304 + key) * 96);
    }
    for (int idx = gtid; idx < 8 * NT; idx += gsz) {
        const int h = idx / NT, row = idx % NT;
        const bool lat = row < NLAT; const int b = lat ? (row >> 11) : ((row - NLAT) >> 8); const int t = lat ? (row & 2047) : ((row - NLAT) & 255);
        const int key = lat ? 256 + t : t;
        const bf16_t* vp = p.KVraw + (size_t)row * 1024 + h * 128 + 64;
        bf16_t* vo = p.Vt + (size_t)(b * 8 + h) * 64 * 2304 + key;
#pragma unroll 1
        for (int i = 0; i < 8; ++i) { const uint4 u = *(const uint4*)(vp + i * 8);
            vo[0] = (bf16_t)(u.x & 0xffff); vo[2304] = (bf16_t)(u.x >> 16); vo[2 * 2304] = (bf16_t)(u.y & 0xffff); vo[3 * 2304] = (bf16_t)(u.y >> 16);
            vo[4 * 2304] = (bf16_t)(u.z & 0xffff); vo[5 * 2304] = (bf16_t)(u.z >> 16); vo[6 * 2304] = (bf16_t)(u.w & 0xffff); vo[7 * 2304] = (bf16_t)(u.w >> 16);
            vo += 8 * 2304; }
    }
}
DI void ph_attn(const Ctx& cx, const Params& p, bool with_ctx) {
    const int gtid = cx.bid * NTHR + cx.tid, gsz = cx.nblk * NTHR;
    const int total = NLAT * 8 + (with_ctx ? NCTX * 8 : 0);
    for (int idx = gtid; idx < total; idx += gsz) {
        int b, h, row, nkeys;
        if (idx < NLAT * 8) { b = idx >> 14; h = (idx >> 11) & 7; row = b * 2048 + (idx & 2047); nkeys = 2304; }
        else { const int i2 = idx - NLAT * 8; b = i2 >> 11; h = (i2 >> 8) & 7; row = NLAT + b * 256 + (i2 & 255); nkeys = 256; }
        const bf16_t* qp = p.Qraw + (size_t)row * 768 + h * 96;
        const bf16_t* Kb = p.Kf + (size_t)(b * 8 + h) * 2304 * 96; const bf16_t* Vb = p.Vt + (size_t)(b * 8 + h) * 64 * 2304;
        float q[96];
#pragma unroll
        for (int i = 0; i < 12; ++i) { const uint4 u = *(const uint4*)(qp + i * 8); q[i * 8] = bflo(u.x); q[i * 8 + 1] = bfhi(u.x); q[i * 8 + 2] = bflo(u.y); q[i * 8 + 3] = bfhi(u.y);
            q[i * 8 + 4] = bflo(u.z); q[i * 8 + 5] = bfhi(u.z); q[i * 8 + 6] = bflo(u.w); q[i * 8 + 7] = bfhi(u.w); }
        float acc[64];
#pragma unroll
        for (int i = 0; i < 64; ++i) acc[i] = 0.f;
        float mx = -3.0e38f, l = 0.f;
        for (int key0 = 0; key0 < nkeys; key0 += 8) {
            float s[8];
#pragma unroll
            for (int kk = 0; kk < 8; ++kk) {
                const uint4* kp = (const uint4*)(Kb + (size_t)(key0 + kk) * 96); float a = 0.f;
#pragma unroll
                for (int i = 0; i < 12; ++i) { const uint4 u = kp[i]; a += q[i * 8] * bflo(u.x) + q[i * 8 + 1] * bfhi(u.x) + q[i * 8 + 2] * bflo(u.y) + q[i * 8 + 3] * bfhi(u.y)
                    + q[i * 8 + 4] * bflo(u.z) + q[i * 8 + 5] * bfhi(u.z) + q[i * 8 + 6] * bflo(u.w) + q[i * 8 + 7] * bfhi(u.w); }
                s[kk] = a;
            }
            float cm = s[0];
#pragma unroll
            for (int kk = 1; kk < 8; ++kk) cm = fmaxf(cm, s[kk]);
            const float mn = fmaxf(mx, cm), alpha = expf(mx - mn);
            float ps = 0.f;
#pragma unroll
            for (int kk = 0; kk < 8; ++kk) { s[kk] = expf(s[kk] - mn); ps += s[kk]; }
            l = l * alpha + ps; mx = mn;
#pragma unroll
            for (int dv = 0; dv < 64; ++dv) {
                const uint4 u = *(const uint4*)(Vb + (size_t)dv * 2304 + key0);
                acc[dv] = acc[dv] * alpha + s[0] * bflo(u.x) + s[1] * bfhi(u.x) + s[2] * bflo(u.y) + s[3] * bfhi(u.y) + s[4] * bflo(u.z) + s[5] * bfhi(u.z) + s[6] * bflo(u.w) + s[7] * bfhi(u.w);
            }
        }
        const float il = 1.f / l;
        bf16_t* o = p.H + (size_t)row * 1024 + 512 + h * 64;
#pragma unroll
        for (int i = 0; i < 8; ++i) { uint4 u; u.x = pack2(acc[i * 8] * il, acc[i * 8 + 1] * il); u.y = pack2(acc[i * 8 + 2] * il, acc[i * 8 + 3] * il);
            u.z = pack2(acc[i * 8 + 4] * il, acc[i * 8 + 5] * il); u.w = pack2(acc[i * 8 + 6] * il, acc[i * 8 + 7] * il); *(uint4*)(o + i * 8) = u; }
    }
}
DI float shiftp(const bf16_t* P, int row, int t, int T, int col, float mu) {
    const float c = bf2f(P[(size_t)row * PLD + col]);
    const float pv = (t > 0) ? bf2f(P[(size_t)(row - 1) * PLD + col]) : 0.f;
    const float nx = (t < T - 1) ? bf2f(P[(size_t)(row + 1) * PLD + col]) : 0.f;
    return c + mu * (0.5f * (pv + nx) - c);
}
DI void ph_prepLR(const Ctx& cx, const Params& p, int j) {
    const int gtid = cx.bid * NTHR + cx.tid, gsz = cx.nblk * NTHR;
    const float* mu = p.a_mu + j * ACOLS + 1536;
    for (int idx = gtid; idx < NT * 384; idx += gsz) {
        const int row = idx / 384, col = idx % 384;
        const bool lat = row < NLAT; const int t = lat ? (row & 2047) : ((row - NLAT) & 255); const int T = lat ? 2048 : 256;
        float v = shiftp(p.P, row, t, T, 1536 + col, mu[col]);
        if (col < 128) v = tanhf(v); else if (col >= 256) v = sigm(v);
        p.LR[(size_t)row * 384 + col] = f2bf(v);
    }
}
DI void ph_wag(const Ctx& cx, const Params& p, float* lds, int j) {
    for (int d = 0; d < 2; ++d) {
        const float* W2 = p.a_w2 + (size_t)(j * 2 + d) * 64 * 512; const float* w0 = p.a_w0 + (j * 2 + d) * 512;
        ngemm<false>(cx, lds, 1, NT, 512, 64,
            [&](int, int m) { return p.LR + (size_t)m * 384 + d * 64; },
            [&](int, int k) { return W2 + (size_t)k * 512; }, [&](int, int) { return (const float*)nullptr; },
            [&](int, int m, int n, float v, float) { const float z = -0.606531f * sigm(w0[n] + v); p.WAG[(size_t)m * WLD + d * 512 + n] = f2bf(-expm1f(z)); });
        const float* A2 = p.a_a2 + (size_t)(j * 2 + d) * 64 * 512; const float* a0 = p.a_a0 + (j * 2 + d) * 512;
        ngemm<false>(cx, lds, 1, NT, 512, 64,
            [&](int, int m) { return p.LR + (size_t)m * 384 + 128 + d * 64; },
            [&](int, int k) { return A2 + (size_t)k * 512; }, [&](int, int) { return (const float*)nullptr; },
            [&](int, int m, int n, float v, float) { p.WAG[(size_t)m * WLD + 1024 + d * 512 + n] = f2bf(sigm(a0[n] + v)); });
    }
    const float* G2 = p.a_g2 + (size_t)j * 128 * 512;
    ngemm<false>(cx, lds, 1, NT, 512, 128,
        [&](int, int m) { return p.LR + (size_t)m * 384 + 256; },
        [&](int, int k) { return G2 + (size_t)k * 512; }, [&](int, int) { return (const float*)nullptr; },
        [&](int, int m, int n, float v, float) { p.WAG[(size_t)m * WLD + 2048 + n] = f2bf(v); });
}
DI void ph_scan(const Ctx& cx, const Params& p, float* lds, int j) {
    const int tid = cx.tid, lane = tid & 63;
    if (tid < 64) {
        for (int item = cx.bid; item < 256; item += cx.nblk) {
            const int b = item >> 4, h = (item >> 1) & 7, dir = item & 1, hc = h * 64 + lane;
            float S[64];
#pragma unroll
            for (int k = 0; k < 64; ++k) S[k] = 0.f;
            const float kkc = p.a_k_k[j * 512 + hc], kac = p.a_k_a[j * 512 + hc];
            const float mur = p.a_mu[j * ACOLS + hc], muk = p.a_mu[j * ACOLS + 512 + hc], muv = p.a_mu[j * ACOLS + 1024 + hc];
            bf16_t* yout = dir ? p.YB : p.YF;
            for (int step = 0; step < 2304; ++step) {
                const bool cp = step < 256; const int tt = cp ? step : step - 256, T = cp ? 256 : 2048, t = dir ? (T - 1 - tt) : tt;
                const int row = cp ? NLAT + b * 256 + t : b * 2048 + t;
                const float R = shiftp(p.P, row, t, T, hc, mur), K = shiftp(p.P, row, t, T, 512 + hc, muk), V = shiftp(p.P, row, t, T, 1024 + hc, muv);
                const float w = 1.f - bf2f(p.WAG[(size_t)row * WLD + dir * 512 + hc]), a = bf2f(p.WAG[(size_t)row * WLD + 1024 + dir * 512 + hc]);
                const float kkv = K * kkc, ssq = wave_sum(kkv * kkv), kk = kkv * rsqrtf(ssq + 1e-12f);
                const float kd = K * (1.f + (a - 1.f) * kac), bd = kk * a;
                lds[lane] = -kk; lds[64 + lane] = w; lds[128 + lane] = bd; lds[192 + lane] = kd; lds[256 + lane] = R;
                __builtin_amdgcn_wave_barrier();
                float sa = 0.f;
#pragma unroll
                for (int k4 = 0; k4 < 16; ++k4) { const float4 v = *(const float4*)(lds + k4 * 4); sa += S[k4 * 4] * v.x + S[k4 * 4 + 1] * v.y + S[k4 * 4 + 2] * v.z + S[k4 * 4 + 3] * v.w; }
                float y = 0.f;
#pragma unroll
                for (int k4 = 0; k4 < 16; ++k4) {
                    const float4 wv = *(const float4*)(lds + 64 + k4 * 4), bv = *(const float4*)(lds + 128 + k4 * 4), kv = *(const float4*)(lds + 192 + k4 * 4), rv = *(const float4*)(lds + 256 + k4 * 4);
                    S[k4 * 4] = S[k4 * 4] * wv.x + sa * bv.x + V * kv.x; S[k4 * 4 + 1] = S[k4 * 4 + 1] * wv.y + sa * bv.y + V * kv.y;
                    S[k4 * 4 + 2] = S[k4 * 4 + 2] * wv.z + sa * bv.z + V * kv.z; S[k4 * 4 + 3] = S[k4 * 4 + 3] * wv.w + sa * bv.w + V * kv.w;
                    y += S[k4 * 4] * rv.x + S[k4 * 4 + 1] * rv.y + S[k4 * 4 + 2] * rv.z + S[k4 * 4 + 3] * rv.w;
                }
                __builtin_amdgcn_wave_barrier();
                yout[(size_t)row * 512 + hc] = f2bf(y);
            }
        }
    }
    __syncthreads();
}
DI void ph_post(const Ctx& cx, const Params& p, int j, int nrows) {
    const int gtid = cx.bid * NTHR + cx.tid, gsz = cx.nblk * NTHR;
    for (int idx = gtid; idx < 8 * nrows; idx += gsz) {
        const int h = idx / nrows, row = idx % nrows;
        const bool lat = row < NLAT; const int t = lat ? (row & 2047) : ((row - NLAT) & 255); const int T = lat ? 2048 : 256;
        float sum = 0.f, sb = 0.f;
#pragma unroll 8
        for (int n = 0; n < 64; ++n) {
            const int hc = h * 64 + n;
            const float yy = bf2f(p.YF[(size_t)row * 512 + hc]) + bf2f(p.YB[(size_t)row * 512 + hc]);
            sum += yy;
            const float R = shiftp(p.P, row, t, T, hc, p.a_mu[j * ACOLS + hc]), K = shiftp(p.P, row, t, T, 512 + hc, p.a_mu[j * ACOLS + 512 + hc]);
            const float af = bf2f(p.WAG[(size_t)row * WLD + 1024 + hc]), ab = bf2f(p.WAG[(size_t)row * WLD + 1536 + hc]);
            const float ka = p.a_k_a[j * 512 + hc], rk = p.a_r_k[j * 512 + hc];
            sb += R * rk * (K * (1.f + (af - 1.f) * ka) + K * (1.f + (ab - 1.f) * ka));
        }
        const float mean = sum * (1.f / 64.f); float var = 0.f;
#pragma unroll 8
        for (int n = 0; n < 64; ++n) { const int hc = h * 64 + n; const float yy = bf2f(p.YF[(size_t)row * 512 + hc]) + bf2f(p.YB[(size_t)row * 512 + hc]); var += (yy - mean) * (yy - mean); }
        const float rstd = rsqrtf(var * (1.f / 64.f) + 64e-5f);
#pragma unroll 8
        for (int n = 0; n < 64; ++n) {
            const int hc = h * 64 + n;
            const float yy = bf2f(p.YF[(size_t)row * 512 + hc]) + bf2f(p.YB[(size_t)row * 512 + hc]);
            const float V = shiftp(p.P, row, t, T, 1024 + hc, p.a_mu[j * ACOLS + 1024 + hc]);
            const float g = bf2f(p.WAG[(size_t)row * WLD + 2048 + hc]);
            const float o = ((yy - mean) * rstd * p.a_ln_w[j * 512 + hc] + p.a_ln_b[j * 512 + hc] + sb * V) * g;
            p.H[(size_t)row * 1024 + hc] = f2bf(o);
        }
    }
}
DI void ph_wout(const Ctx& cx, const Params& p, float* lds, const bf16_t* A, const float* W, int nrows, const float* xin_lat, const float* xin_ctx, const float* modl) {
    ngemm<false>(cx, lds, 1, nrows, 1024, 1024,
        [&](int, int m) { return A + (size_t)m * 1024; },
        [&](int, int k) { return W + (size_t)k * 1024; }, [&](int, int) { return (const float*)nullptr; },
        [&](int, int m, int n, float v, float) {
            const bool lat = m < NLAT; const int jj = lat ? (m >> 11) : 16; const float g1 = modl[(size_t)jj * 6144 + 2 * 1024 + n];
            if (lat) p.out[(size_t)m * 1024 + n] = xin_lat[(size_t)m * 1024 + n] + g1 * v;
            else p.ctxs[(size_t)(m - NLAT) * 1024 + n] = xin_ctx[(size_t)(m - NLAT) * 1024 + n] + g1 * v; });
}

DI void ph_chdft(const Ctx& cx, const Params& p, float* lds, int nrows) {
    const int tid = cx.tid, gtid = cx.bid * NTHR + tid, gsz = cx.nblk * NTHR;
    for (int i = tid; i < 128; i += NTHR) { lds[i] = cospif((float)i * (1.f / 64.f)); lds[128 + i] = sinpif((float)i * (1.f / 64.f)); }
    __syncthreads();
    for (int idx = gtid; idx < nrows * 1024; idx += gsz) {
        const int row = idx >> 10, col = idx & 1023, grp = col >> 7, g = col & 127;
        const bf16_t* hp = p.H + (size_t)row * 1024 + grp * 128;
        float gr = 0.f, gi = 0.f;
        for (int c = 0; c < 128; ++c) { const float xv = bf2f(hp[c]); const int m = (c * g) & 127; gr += xv * lds[m]; gi -= xv * lds[128 + m]; }
        p.G[(size_t)row * 2048 + col] = gr; p.G[(size_t)row * 2048 + 1024 + col] = gi;
    }
    __syncthreads();
}
DI void ph_posdft(const Ctx& cx, const Params& p, float* lds, bool with_ctx) {
    ngemm<false>(cx, lds, 16, 2048, 1024, 4096,
        [&](int, int m) { return p.dftl + (size_t)m * 4096; },
        [&](int bz, int k) { return (k < 2048) ? p.G + (size_t)(bz * 2048 + k) * 2048 : p.G + (size_t)(bz * 2048 + k - 2048) * 2048 + 1024; }, [&](int, int) { return (const float*)nullptr; },
        [&](int bz, int m, int n, float v, float) { p.F[(size_t)(bz * 2048 + m) * 1024 + n] = f2bf(v * (1.f / 512.f)); });
    if (with_ctx)
        ngemm<false>(cx, lds, 16, 256, 1024, 512,
            [&](int, int m) { return p.dftc + (size_t)m * 512; },
            [&](int bz, int k) { return (k < 256) ? p.G + (size_t)(NLAT + bz * 256 + k) * 2048 : p.G + (size_t)(NLAT + bz * 256 + k - 256) * 2048 + 1024; }, [&](int, int) { return (const float*)nullptr; },
            [&](int bz, int m, int n, float v, float) { p.F[(size_t)(NLAT + bz * 256 + m) * 1024 + n] = f2bf(v * 0.0055242717280199f); });
}

DI void ph_moe_up(const Ctx& cx, const Params& p, float* lds, int layer, int nrows) {
    for (int e = 0; e < 17; ++e) {
        const int M = (e < 16) ? __builtin_amdgcn_readfirstlane(p.cnt[(layer * 16 + e) * 64]) : nrows;
        const float* Wg = (e < 16) ? p.moe_w_gate + ((size_t)layer * 16 + e) * 1024 * 512 : p.sh_gate + (size_t)layer * 1024 * 512;
        const float* Wu = (e < 16) ? p.moe_w_up + ((size_t)layer * 16 + e) * 1024 * 512 : p.sh_up + (size_t)layer * 1024 * 512;
        const int* sl = p.slot + (size_t)(e & 15) * NT;
        ngemm<true>(cx, lds, 1, M, 512, 1024,
            [&](int, int m) { const int tok = (e < 16) ? (sl[m] >> 1) : m; return p.H + (size_t)tok * 1024; },
            [&](int, int k) { return Wg + (size_t)k * 512; }, [&](int, int k) { return Wu + (size_t)k * 512; },
            [&](int, int m, int n, float g, float u) { const int s = (e < 16) ? sl[m] : 0; const int tok = (e < 16) ? (s >> 1) : m, slab = (e < 16) ? (s & 1) : 2;
                p.ACT[((size_t)slab * NT + tok) * 512 + n] = f2bf(siluf(g) * u); });
    }
}
DI void ph_moe_down(const Ctx& cx, const Params& p, float* lds, int layer, int nrows) {
    for (int e = 0; e < 17; ++e) {
        const int M = (e < 16) ? __builtin_amdgcn_readfirstlane(p.cnt[(layer * 16 + e) * 64]) : nrows;
        const float* Wd = (e < 16) ? p.moe_w_down + ((size_t)layer * 16 + e) * 512 * 1024 : p.sh_down + (size_t)layer * 512 * 1024;
        const int* sl = p.slot + (size_t)(e & 15) * NT;
        ngemm<false>(cx, lds, 1, M, 1024, 512,
            [&](int, int m) { const int s = (e < 16) ? sl[m] : 0; const int tok = (e < 16) ? (s >> 1) : m, slab = (e < 16) ? (s & 1) : 2; return p.ACT + ((size_t)slab * NT + tok) * 512; },
            [&](int, int k) { return Wd + (size_t)k * 1024; }, [&](int, int) { return (const float*)nullptr; },
            [&](int, int m, int n, float v, float) { const int s = (e < 16) ? sl[m] : 0; const int tok = (e < 16) ? (s >> 1) : m, slab = (e < 16) ? (s & 1) : 2;
                const float w = (e < 16) ? p.tokw[s] : 1.f; p.Y[((size_t)slab * NT + tok) * 1024 + n] = f2bf(w * v); });
    }
}

namespace mm {
typedef short bf16x8 __attribute__((ext_vector_type(8)));
typedef float f32x4 __attribute__((ext_vector_type(4)));
typedef unsigned u32x4 __attribute__((ext_vector_type(4)));
constexpr int BM = 256, BK = 64, HALF = 128, HTB = HALF * BK * 2, STAGE_BYTES = 8 * HTB;
DI int lds_byte(int r, int c) { const int st = (r >> 4) * 2 + (c >> 5), rr = r & 15, cc = c & 31, ob = rr * 64 + cc * 2; return st * 1024 + (ob ^ (((ob >> 9) & 1) << 5)); }
DI void stage_rc(int b, int& R, int& C) { const int st = b / 1024, sb = b % 1024, swz = sb ^ (((sb >> 9) & 1) << 5); R = (st >> 1) * 16 + swz / 64; C = (st & 1) * 32 + (swz % 64) / 2; }
DI int perm32(int rho) { const int n = rho >> 4, i = rho & 15; return 8 * (i >> 2) + 4 * n + (i & 3); }
DI unsigned cvt_pk_bf16(float lo, float hi) { unsigned r; asm volatile("v_cvt_pk_bf16_f32 %0, %1, %2" : "=v"(r) : "v"(lo), "v"(hi)); return r; }
struct Unit { const char* A; const char* B; int pm, pn, e, m, tb; };
template <class Sched, class Epi>
DI void gemm_phase(LAS unsigned char* lds, const int K, const Sched& S, const Epi& E, const int tid) {
    const int wid = __builtin_amdgcn_readfirstlane(tid >> 6), lane = tid & 63, wr = wid >> 2, wc = wid & 3, fr = lane & 15, fq = lane >> 4;
    const int nt = K / BK;
    int R0, C0, R1, C1; stage_rc(tid * 16, R0, C0); stage_rc(tid * 16 + 8192, R1, C1);
    unsigned voffB[2];
    { const int Rb0 = Epi::PERM ? ((R0 & ~31) + perm32(R0 & 31)) : R0, Rb1 = Epi::PERM ? ((R1 & ~31) + perm32(R1 & 31)) : R1;
      voffB[0] = (unsigned)(Rb0 * K + C0) * 2u; voffB[1] = (unsigned)(Rb1 * K + C1) * 2u; }
    const size_t kstep = (size_t)(BK * 2), hstepB = (size_t)HALF * K * 2, hstepA = S.hstep_a();
    const unsigned ldsw = (unsigned)wid * 1024u;
    const int aoff = lds_byte(wr * 64 + fr, fq * 8), boff = lds_byte(wc * 32 + fr, fq * 8);
#define MM_SA(b, h) (((b) * 2 + (h)) * HTB)
#define MM_SB(b, h) ((4 + (b) * 2 + (h)) * HTB)
#define MM_STAGE_A(bufoff, gbase, h, offs) do { _Pragma("unroll") for (int _i = 0; _i < 2; ++_i) { \
        if constexpr (Sched::GATHER) __builtin_amdgcn_global_load_lds((const unsigned*)((const char*)(gbase) + (offs)[h][_i]), (LAS unsigned*)(lds + (bufoff) + ldsw + _i * 8192), 16, 0, 0); \
        else __builtin_amdgcn_global_load_lds((const unsigned*)((const char*)(gbase) + (size_t)(h) * hstepA + (offs)[0][_i]), (LAS unsigned*)(lds + (bufoff) + ldsw + _i * 8192), 16, 0, 0); } } while (0)
#define MM_STAGE_B(bufoff, gbase) do { _Pragma("unroll") for (int _i = 0; _i < 2; ++_i) \
        __builtin_amdgcn_global_load_lds((const unsigned*)((const char*)(gbase) + voffB[_i]), (LAS unsigned*)(lds + (bufoff) + ldsw + _i * 8192), 16, 0, 0); } while (0)
#define MM_LDA(dst, b, h) do { _Pragma("unroll") for (int m = 0; m < 4; ++m) _Pragma("unroll") for (int k = 0; k < 2; ++k) dst[m][k] = *(const LAS bf16x8*)(lds + MM_SA(b, h) + aoff + m * 2048 + k * 1024); } while (0)
#define MM_LDB(dst, b, h) do { _Pragma("unroll") for (int n = 0; n < 2; ++n) _Pragma("unroll") for (int k = 0; k < 2; ++k) dst[n][k] = *(const LAS bf16x8*)(lds + MM_SB(b, h) + boff + n * 2048 + k * 1024); } while (0)
#define MM_MMA(ai, bj, At, Bt) do { __builtin_amdgcn_s_setprio(1); _Pragma("unroll") for (int m = 0; m < 4; ++m) _Pragma("unroll") for (int n = 0; n < 2; ++n) _Pragma("unroll") for (int k = 0; k < 2; ++k) \
        acc[ai][bj][m][n] = __builtin_amdgcn_mfma_f32_16x16x32_bf16(Bt[n][k], At[m][k], acc[ai][bj][m][n], 0, 0, 0); __builtin_amdgcn_s_setprio(0); } while (0)
#define MM_WAIT_V(n) asm volatile("s_waitcnt vmcnt(" #n ")" ::: "memory")
#define MM_WAIT_L(n) asm volatile("s_waitcnt lgkmcnt(" #n ")" ::: "memory")
#define MM_BAR __builtin_amdgcn_s_barrier()
#define MM_SCHED __builtin_amdgcn_sched_barrier(0)
    Unit cur, nxt; int ui = 0;
    if (!S.next(0, cur)) return;
    unsigned oa[2][2], on[2][2];
    S.aoff(cur, R0, C0, R1, C1, oa);
    on[0][0] = oa[0][0]; on[0][1] = oa[0][1]; on[1][0] = oa[1][0]; on[1][1] = oa[1][1];
    if constexpr (Sched::TABLE) S.tab_dma(cur, lds + STAGE_BYTES + 1024, tid);
    f32x4 acc[2][2][4][2];
#pragma unroll
    for (int a = 0; a < 2; ++a)
#pragma unroll
        for (int b = 0; b < 2; ++b)
#pragma unroll
            for (int m = 0; m < 4; ++m)
#pragma unroll
                for (int n = 0; n < 2; ++n) acc[a][b][m][n] = (f32x4){0.f, 0.f, 0.f, 0.f};
    bf16x8 At[4][2], B0[2][2], B1[2][2];
    const char* cA = cur.A; const char* cB = cur.B;
    MM_STAGE_B(MM_SB(0, 0), cB); MM_STAGE_A(MM_SA(0, 0), cA, 0, oa); MM_STAGE_B(MM_SB(0, 1), cB + hstepB); MM_STAGE_A(MM_SA(0, 1), cA, 1, oa);
    if (wr == 1) MM_BAR;
    MM_WAIT_V(4); MM_BAR;
    MM_STAGE_B(MM_SB(1, 0), cB + kstep); MM_STAGE_A(MM_SA(1, 0), cA + kstep, 0, oa); MM_STAGE_B(MM_SB(1, 1), cB + hstepB + kstep);
    MM_WAIT_V(6); MM_BAR;
    for (;;) {
        cur.tb = ui % 3;
        const bool has_next = S.next(ui + 1, nxt);
        if constexpr (Sched::TABLE) { if (has_next) S.tab_dma(nxt, lds + STAGE_BYTES + 1024 + ((ui + 1) % 3) * 2048, tid); }
        const char* nA = has_next ? nxt.A : cA; const char* nB = has_next ? nxt.B : cB;
        for (int t = 0; t < nt; t += 2) {
            const bool last = (t == nt - 2);
            if constexpr (Sched::GATHER) { if (last) { if (has_next) S.aoff_lds(nxt, (const LAS int*)(lds + STAGE_BYTES + 1024 + ((ui + 1) % 3) * 2048), R0, C0, R1, C1, on);
                else { on[0][0] = oa[0][0]; on[0][1] = oa[0][1]; on[1][0] = oa[1][0]; on[1][1] = oa[1][1]; } } }
            const char* a1 = cA + (size_t)(t + 1) * kstep;
            const char* a2 = last ? nA : cA + (size_t)(t + 2) * kstep; const char* b2 = last ? nB : cB + (size_t)(t + 2) * kstep;
            const char* a3 = a2 + kstep; const char* b3 = b2 + kstep;
            unsigned o2[2][2];
            if constexpr (Sched::GATHER) { o2[0][0] = last ? on[0][0] : oa[0][0]; o2[0][1] = last ? on[0][1] : oa[0][1]; o2[1][0] = last ? on[1][0] : oa[1][0]; o2[1][1] = last ? on[1][1] : oa[1][1]; }
            else { o2[0][0] = oa[0][0]; o2[0][1] = oa[0][1]; o2[1][0] = oa[1][0]; o2[1][1] = oa[1][1]; }
            MM_LDB(B0, 0, 0); MM_SCHED; MM_LDA(At, 0, 0); MM_STAGE_A(MM_SA(1, 1), a1, 1, oa);
            MM_WAIT_L(8); MM_BAR; MM_WAIT_L(0); MM_MMA(0, 0, At, B0); MM_BAR; MM_SCHED;
            MM_LDB(B1, 0, 1); MM_STAGE_B(MM_SB(0, 0), b2);
            MM_BAR; MM_WAIT_L(0); MM_MMA(0, 1, At, B1); MM_BAR;
            MM_LDA(At, 0, 1); MM_STAGE_A(MM_SA(0, 0), a2, 0, o2);
            MM_BAR; MM_WAIT_L(0); MM_MMA(1, 0, At, B0); MM_BAR; MM_SCHED;
            MM_STAGE_B(MM_SB(0, 1), b2 + hstepB);
            MM_WAIT_V(6); MM_BAR; MM_MMA(1, 1, At, B1); MM_BAR;
            MM_LDB(B0, 1, 0); MM_SCHED; MM_LDA(At, 1, 0); MM_STAGE_A(MM_SA(0, 1), a2, 1, o2);
            MM_WAIT_L(8); MM_BAR; MM_WAIT_L(0); MM_MMA(0, 0, At, B0); MM_BAR; MM_SCHED;
            MM_LDB(B1, 1, 1); MM_STAGE_B(MM_SB(1, 0), b3);
            MM_BAR; MM_WAIT_L(0); MM_MMA(0, 1, At, B1); MM_BAR;
            MM_LDA(At, 1, 1); MM_STAGE_A(MM_SA(1, 0), a3, 0, o2);
            MM_BAR; MM_WAIT_L(0); MM_MMA(1, 0, At, B0); MM_BAR; MM_SCHED;
            MM_STAGE_B(MM_SB(1, 1), b3 + hstepB);
            MM_WAIT_V(6); MM_BAR; MM_MMA(1, 1, At, B1); MM_BAR;
        }
        E(acc, cur, wr, wc, fr, fq);
        if (!has_next) break;
#pragma unroll
        for (int a = 0; a < 2; ++a)
#pragma unroll
            for (int b = 0; b < 2; ++b)
#pragma unroll
                for (int m = 0; m < 4; ++m)
#pragma unroll
                    for (int n = 0; n < 2; ++n) acc[a][b][m][n] = (f32x4){0.f, 0.f, 0.f, 0.f};
        cur = nxt; cA = nA; cB = nB; ++ui;
        if constexpr (Sched::GATHER) { oa[0][0] = on[0][0]; oa[0][1] = on[0][1]; oa[1][0] = on[1][0]; oa[1][1] = on[1][1]; }
    }
    MM_WAIT_V(0);
    if (wr == 0) MM_BAR;
    MM_BAR;
#undef MM_SA
#undef MM_SB
#undef MM_STAGE_A
#undef MM_STAGE_B
#undef MM_LDA
#undef MM_LDB
#undef MM_MMA
#undef MM_WAIT_V
#undef MM_WAIT_L
#undef MM_BAR
#undef MM_SCHED
}
struct StaticSched {
    static constexpr bool GATHER = false, TABLE = false;
    const char* A; const char* Bt; int lda, K, nM, nN, nwg, G, c;
    DI size_t hstep_a() const { return (size_t)HALF * lda * 2; }
    DI void init(const void* A_, const void* Bt_, int M, int N, int K_, int lda_, int G_, int c_) { A = (const char*)A_; Bt = (const char*)Bt_; lda = lda_; K = K_; nM = M / BM; nN = N / BM; nwg = nM * nN; G = G_; c = c_; }
    DI bool next(int i, Unit& u) const {
        const int L = i * G + c; if (L >= nwg) return false;
        int wgid = L; { const int q = nwg / 8, r = nwg % 8, xcd = wgid % 8, off = wgid / 8; wgid = (xcd < r ? xcd * (q + 1) : r * (q + 1) + (xcd - r) * q) + off; }
        const int nig = 8 * nN, gid = wgid / nig, fm = gid * 8, gsz = (nM - fm) < 8 ? (nM - fm) : 8;
        u.pm = fm + ((wgid % nig) % gsz); u.pn = (wgid % nig) / gsz; u.e = 0; u.m = 0;
        u.A = A + (size_t)u.pm * BM * lda * 2; u.B = Bt + (size_t)u.pn * BM * K * 2; return true;
    }
    DI void aoff(const Unit&, int R0, int C0, int R1, int C1, unsigned (&o)[2][2]) const {
        o[0][0] = (unsigned)(R0 * lda + C0) * 2u; o[0][1] = (unsigned)(R1 * lda + C1) * 2u;
        o[1][0] = (unsigned)((HALF + R0) * lda + C0) * 2u; o[1][1] = (unsigned)((HALF + R1) * lda + C1) * 2u;
    }
};
struct BatchSched {
    static constexpr bool GATHER = false, TABLE = false;
    const char* A; const char* Bt; int K, nM, nN, nb, G, c; size_t bstride;
    DI size_t hstep_a() const { return (size_t)HALF * K * 2; }
    DI void init(const void* A_, const void* Bt_, size_t bstride_bytes, int nb_, int M, int N, int K_, int G_, int c_) { A = (const char*)A_; Bt = (const char*)Bt_; bstride = bstride_bytes; nb = nb_; K = K_; nM = M / BM; nN = N / BM; G = G_; c = c_; }
    DI bool next(int i, Unit& u) const {
        const int L = i * G + c; if (L >= nb * nM * nN) return false;
        const int b = L / (nM * nN), rem = L % (nM * nN); u.pm = rem / nN; u.pn = rem % nN; u.e = b; u.m = 0;
        u.A = A + (size_t)u.pm * BM * K * 2; u.B = Bt + (size_t)b * bstride + (size_t)u.pn * BM * K * 2; return true;
    }
    DI void aoff(const Unit&, int R0, int C0, int R1, int C1, unsigned (&o)[2][2]) const {
        o[0][0] = (unsigned)(R0 * K + C0) * 2u; o[0][1] = (unsigned)(R1 * K + C1) * 2u;
        o[1][0] = (unsigned)((HALF + R0) * K + C0) * 2u; o[1][1] = (unsigned)((HALF + R1) * K + C1) * 2u;
    }
};
struct EpiBf16Store {
    static constexpr bool PERM = true;
    bf16_t* O; int ldc;
    DI void operator()(const f32x4 (&acc)[2][2][4][2], const Unit& u, int wr, int wc, int fr, int fq) const {
        const int row0 = u.pm * BM + wr * 64 + fr, col0 = u.pn * BM + wc * 32 + 8 * fq;
#pragma unroll
        for (int ai = 0; ai < 2; ++ai)
#pragma unroll
            for (int m = 0; m < 4; ++m) { bf16_t* rowp = O + (size_t)(row0 + ai * HALF + m * 16) * ldc + col0;
#pragma unroll
                for (int bj = 0; bj < 2; ++bj) { const f32x4 v0 = acc[ai][bj][m][0], v1 = acc[ai][bj][m][1];
                    u32x4 w; w.x = cvt_pk_bf16(v0[0], v0[1]); w.y = cvt_pk_bf16(v0[2], v0[3]); w.z = cvt_pk_bf16(v1[0], v1[1]); w.w = cvt_pk_bf16(v1[2], v1[3]);
                    *(u32x4*)(rowp + bj * HALF) = w; } }
    }
};
struct EpiResid {
    static constexpr bool PERM = false;
    const float* xin_lat; const float* xin_ctx; float* out_lat; float* out_ctx; const float* modl; int batched_T;
    DI void operator()(const f32x4 (&acc)[2][2][4][2], const Unit& u, int wr, int wc, int fr, int fq) const {
        int grow0; if (batched_T == 0) grow0 = u.pm * BM; else if (batched_T > 0) grow0 = u.e * 2048 + u.pm * BM; else grow0 = NLAT + u.e * 256 + u.pm * BM;
        const bool lat = grow0 < NLAT; const int jj = lat ? (grow0 >> 11) : 16;
        const float* xi = lat ? xin_lat + (size_t)grow0 * 1024 : xin_ctx + (size_t)(grow0 - NLAT) * 1024;
        float* xo = lat ? out_lat + (size_t)grow0 * 1024 : out_ctx + (size_t)(grow0 - NLAT) * 1024;
        const float* g1 = modl + (size_t)jj * 6144 + 2 * 1024;
        const int r0 = wr * 64 + fr, col0 = u.pn * BM + wc * 32 + 4 * fq;
        f32x4 gv[2][2];
#pragma unroll
        for (int bj = 0; bj < 2; ++bj)
#pragma unroll
            for (int n = 0; n < 2; ++n) gv[bj][n] = *(const f32x4*)(g1 + col0 + bj * HALF + n * 16);
#pragma unroll
        for (int ai = 0; ai < 2; ++ai) {
            f32x4 xv[4][2][2];
#pragma unroll
            for (int m = 0; m < 4; ++m)
#pragma unroll
                for (int bj = 0; bj < 2; ++bj)
#pragma unroll
                    for (int n = 0; n < 2; ++n) xv[m][bj][n] = *(const f32x4*)(xi + (size_t)(r0 + ai * HALF + m * 16) * 1024 + col0 + bj * HALF + n * 16);
#pragma unroll
            for (int m = 0; m < 4; ++m)
#pragma unroll
                for (int bj = 0; bj < 2; ++bj)
#pragma unroll
                    for (int n = 0; n < 2; ++n) *(f32x4*)(xo + (size_t)(r0 + ai * HALF + m * 16) * 1024 + col0 + bj * HALF + n * 16) = xv[m][bj][n] + gv[bj][n] * acc[ai][bj][m][n];
            asm volatile("" ::: "memory");
        }
    }
};
}

DI void tconv_tile(const Ctx& cx, float* T, const float* src, int ld_src, int k0, int n0, int kvalid, int nvalid, bf16_t* dst, int ldd, int drow0) {
    const int tid = cx.tid;
#pragma unroll
    for (int rr = 0; rr < 2; ++rr) {
        const int i = (tid >> 4) + 32 * rr, j = (tid & 15) * 4;
        float4 v = make_float4(0.f, 0.f, 0.f, 0.f);
        if (k0 + i < kvalid && n0 + j < nvalid) v = *(const float4*)(src + (size_t)(k0 + i) * ld_src + n0 + j);
        T[i * 65 + j] = v.x; T[i * 65 + j + 1] = v.y; T[i * 65 + j + 2] = v.z; T[i * 65 + j + 3] = v.w;
    }
    __syncthreads();
    { const int j = tid >> 3, ch = tid & 7; uint4 o;
      o.x = pack2(T[(ch * 8 + 0) * 65 + j], T[(ch * 8 + 1) * 65 + j]); o.y = pack2(T[(ch * 8 + 2) * 65 + j], T[(ch * 8 + 3) * 65 + j]);
      o.z = pack2(T[(ch * 8 + 4) * 65 + j], T[(ch * 8 + 5) * 65 + j]); o.w = pack2(T[(ch * 8 + 6) * 65 + j], T[(ch * 8 + 7) * 65 + j]);
      *(uint4*)(dst + (size_t)(drow0 + j) * ldd + k0 + ch * 8) = o; }
    __syncthreads();
}
DI void ph_prep_weights(const Ctx& cx, const Params& p, float* lds) {
    const int tid = cx.tid, gtid = cx.bid * NTHR + tid, gsz = cx.nblk * NTHR;
    for (int it = cx.bid; it < 2 * 1008; it += cx.nblk) {
        const int j = it / 1008; int r = it % 1008;
        if (r < 640) { const int kt = r / 40, ntl = r % 40; tconv_tile(cx, lds, p.w_in + (size_t)j * 1024 * INC, INC, kt * 64, ntl * 64, 1024, INC, p.WinT + (size_t)j * 2560 * 1024, 1024, ntl * 64); continue; } r -= 640;
        if (r < 48) { const int kt = r / 12, ntl = r % 12; tconv_tile(cx, lds, p.b_w_q_up + (size_t)j * 256 * 768, 768, kt * 64, ntl * 64, 256, 768, p.WqT + (size_t)j * 768 * 256, 256, ntl * 64); continue; } r -= 48;
        if (r < 64) { const int kt = r / 16, ntl = r % 16; tconv_tile(cx, lds, p.b_w_kv_up + (size_t)j * 128 * 1024, 1024, kt * 64, ntl * 64, 128, 1024, p.WkvT + (size_t)j * 1024 * 256, 256, ntl * 64); continue; } r -= 64;
        { const int kt = r / 16, ntl = r % 16; tconv_tile(cx, lds, p.w_out_even + (size_t)j * 1024 * 1024, 1024, kt * 64, ntl * 64, 1024, 1024, p.WoutT + (size_t)j * 1024 * 1024, 1024, ntl * 64); }
    }
    for (int idx = gtid; idx < 2 * 2560 * 384; idx += gsz) {
        const int j = idx / (2560 * 384), rem = idx % (2560 * 384), n = rem / 384, k = rem % 384; const int seg = n >> 9, nn = n & 511;
        float v = 0.f;
        if (seg < 2) { if ((k >> 6) == seg) v = p.a_w2[((size_t)(j * 2 + seg) * 64 + (k & 63)) * 512 + nn]; }
        else if (seg < 4) { if ((k >> 6) == seg) v = p.a_a2[((size_t)(j * 2 + seg - 2) * 64 + (k & 63)) * 512 + nn]; }
        else { if (k >= 256) v = p.a_g2[((size_t)j * 128 + (k - 256)) * 512 + nn]; }
        p.WlrT[idx] = f2bf(v);
    }
    {
        float* Tc = lds; float* Ts = lds + 64 * 65; float* tab = lds + 2 * 64 * 65;
        for (int i = tid; i < 128; i += NTHR) { tab[i] = cospif((float)i * (1.f / 64.f)); tab[128 + i] = sinpif((float)i * (1.f / 64.f)); }
        __syncthreads();
        for (int it = cx.bid; it < 2 * 256; it += cx.nblk) {
            const int j = it >> 8, ct = (it >> 4) & 15, et = it & 15; const float* Wf = p.w_out_fourier + (size_t)j * 1024 * 1024;
            const int el = tid & 63, e = et * 64 + el;
#pragma unroll 1
            for (int i = 0; i < 8; ++i) {
                const int chl = (tid >> 6) + 8 * i, ch = ct * 64 + chl, grp = ch >> 7, c = ch & 127;
                float sc = 0.f, ss = 0.f;
                for (int g = 0; g < 128; ++g) { const float w = Wf[(size_t)(grp * 128 + g) * 1024 + e]; const int m = (c * g) & 127; sc += tab[m] * w; ss += tab[128 + m] * w; }
                Tc[chl * 65 + el] = sc; Ts[chl * 65 + el] = ss;
            }
            __syncthreads();
            { const int el2 = tid >> 3, chunk = tid & 7; uint4 o, o2; const float* a = Tc + chunk * 8 * 65 + el2; const float* b = Ts + chunk * 8 * 65 + el2;
              o.x = pack2(a[0], a[65]); o.y = pack2(a[2 * 65], a[3 * 65]); o.z = pack2(a[4 * 65], a[5 * 65]); o.w = pack2(a[6 * 65], a[7 * 65]);
              o2.x = pack2(b[0], b[65]); o2.y = pack2(b[2 * 65], b[3 * 65]); o2.z = pack2(b[4 * 65], b[5 * 65]); o2.w = pack2(b[6 * 65], b[7 * 65]);
              bf16_t* d = p.A1 + (size_t)j * 2048 * 1024 + (size_t)(et * 64 + el2) * 1024 + ct * 64 + chunk * 8;
              *(uint4*)d = o; *(uint4*)(d + (size_t)1024 * 1024) = o2; }
            __syncthreads();
        }
    }
    for (int i = gtid; i < 2048 * 4096; i += gsz) {
        const int f = i >> 12, k = i & 4095, t = k & 2047, m = (f * t) & 2047; const float a = (float)m * (1.f / 1024.f);
        p.A2[i] = f2bf(((k < 2048) ? cospif(a) : -sinpif(a)) * (1.f / 512.f));
    }
    for (int i = gtid; i < 256 * 512; i += gsz) {
        const int f = i >> 9, k = i & 511, t = k & 255, m = (f * t) & 255; const float a = (float)m * (1.f / 128.f);
        p.A2c[i] = f2bf(((k < 256) ? cospif(a) : -sinpif(a)) * 0.0055242717280199f);
    }
    __syncthreads();
}
DI void ph_prep_moe(const Ctx& cx, const Params& p, float* lds, int layer) {
    for (int it = cx.bid; it < 17 * 384; it += cx.nblk) {
        const int e = it / 384; int r = it % 384;
        const float* Wg = (e < 16) ? p.moe_w_gate + ((size_t)layer * 16 + e) * 1024 * 512 : p.sh_gate + (size_t)layer * 1024 * 512;
        const float* Wu = (e < 16) ? p.moe_w_up + ((size_t)layer * 16 + e) * 1024 * 512 : p.sh_up + (size_t)layer * 1024 * 512;
        const float* Wd = (e < 16) ? p.moe_w_down + ((size_t)layer * 16 + e) * 512 * 1024 : p.sh_down + (size_t)layer * 512 * 1024;
        if (r < 256) { const int bj = r >> 7, kt = (r >> 3) & 15, ntl = r & 7, n0 = ntl * 64;
            tconv_tile(cx, lds, bj ? Wu : Wg, 512, kt * 64, n0, 1024, 512, p.WguT + (size_t)e * 1024 * 1024, 1024, (n0 >> 7) * 256 + bj * 128 + (n0 & 127)); }
        else { r -= 256; const int kt = r >> 4, ntl = r & 15; tconv_tile(cx, lds, Wd, 1024, kt * 64, ntl * 64, 512, 1024, p.WdT + (size_t)e * 1024 * 512, 512, ntl * 64); }
    }
}

#define GEMM_LDS(lds) ((LAS unsigned char*)(lds))
DI void ph_win_mm(const Ctx& cx, const Params& p, float* lds, int j) {
    mm::StaticSched S; S.init(p.H, p.WinT + (size_t)j * 2560 * 1024, NT, 2560, 1024, 1024, cx.nblk, cx.bid);
    mm::EpiBf16Store E{p.P, PLD};
    mm::gemm_phase(GEMM_LDS(lds), 1024, S, E, cx.tid);
}
DI void ph_wout_mm(const Ctx& cx, const Params& p, float* lds, const bf16_t* A, const bf16_t* Bt, int nrows, const float* xin_lat, const float* xin_ctx, const float* modl) {
    mm::StaticSched S; S.init(A, Bt, nrows, 1024, 1024, 1024, cx.nblk, cx.bid);
    mm::EpiResid E{xin_lat, xin_ctx, p.out, p.ctxs, modl, 0};
    mm::gemm_phase(GEMM_LDS(lds), 1024, S, E, cx.tid);
}

DI void ph_qkvup_mm(const Ctx& cx, const Params& p, float* lds, int j, int mq) {
    { mm::StaticSched S; S.init(p.QN, p.WqT + (size_t)j * 768 * 256, mq, 768, 256, 512, cx.nblk, cx.bid); mm::EpiBf16Store E{p.Qraw, 768}; mm::gemm_phase(GEMM_LDS(lds), 256, S, E, cx.tid); }
    { mm::StaticSched S; S.init(p.QN + 256, p.WkvT + (size_t)j * 1024 * 256, NT, 1024, 256, 512, cx.nblk, cx.bid); mm::EpiBf16Store E{p.KVraw, 1024}; mm::gemm_phase(GEMM_LDS(lds), 256, S, E, cx.tid); }
}
struct EpiWag {
    static constexpr bool PERM = true;
    bf16_t* O; const LAS float* bias;
    DI void operator()(const mm::f32x4 (&acc)[2][2][4][2], const mm::Unit& u, int wr, int wc, int fr, int fq) const {
        const int row0 = u.pm * 256 + wr * 64 + fr, col0 = u.pn * 256 + wc * 32 + 8 * fq; const int seg = u.pn >> 2;
        const LAS float* bp = bias + col0;
#pragma unroll
        for (int bj = 0; bj < 2; ++bj) {
            mm::f32x4 b0 = (mm::f32x4){0.f, 0.f, 0.f, 0.f}, b1 = b0;
            if (seg < 2) { b0 = *(const LAS mm::f32x4*)(bp + bj * 128); b1 = *(const LAS mm::f32x4*)(bp + bj * 128 + 4); }
#pragma unroll
            for (int ai = 0; ai < 2; ++ai)
#pragma unroll
                for (int m = 0; m < 4; ++m) {
                    mm::f32x4 v0 = acc[ai][bj][m][0] + b0, v1 = acc[ai][bj][m][1] + b1;
                    if (seg == 0) {
#pragma unroll
                        for (int c = 0; c < 4; ++c) { v0[c] = 1.f - __expf(-0.606531f * __builtin_amdgcn_rcpf(1.f + __expf(-v0[c]))); v1[c] = 1.f - __expf(-0.606531f * __builtin_amdgcn_rcpf(1.f + __expf(-v1[c]))); }
                    } else if (seg == 1) {
#pragma unroll
                        for (int c = 0; c < 4; ++c) { v0[c] = __builtin_amdgcn_rcpf(1.f + __expf(-v0[c])); v1[c] = __builtin_amdgcn_rcpf(1.f + __expf(-v1[c])); }
                    }
                    mm::u32x4 w; w.x = mm::cvt_pk_bf16(v0[0], v0[1]); w.y = mm::cvt_pk_bf16(v0[2], v0[3]); w.z = mm::cvt_pk_bf16(v1[0], v1[1]); w.w = mm::cvt_pk_bf16(v1[2], v1[3]);
                    *(mm::u32x4*)(O + (size_t)(row0 + ai * 128 + m * 16) * WLD + col0 + bj * 128) = w;
                }
        }
    }
};
DI void ph_wag_mm(const Ctx& cx, const Params& p, float* lds, int j) {
    mm::StaticSched S; S.init(p.LR, p.WlrT + (size_t)j * 2560 * 384, NT, 2560, 384, 384, cx.nblk, cx.bid);
    LAS float* bl = (LAS float*)lds + 32768 + 256 + 1024;
    for (int i = cx.tid; i < 2048; i += NTHR) bl[i] = (i < 1024) ? p.a_w0[j * 1024 + i] : p.a_a0[j * 1024 + i - 1024];
    __syncthreads();
    EpiWag E{p.WAG, bl};
    mm::gemm_phase(GEMM_LDS(lds), 384, S, E, cx.tid);
}
struct EpiZT {
    static constexpr bool PERM = true;
    bf16_t* Z; int T;
    DI void operator()(const mm::f32x4 (&acc)[2][2][4][2], const mm::Unit& u, int wr, int wc, int fr, int fq) const {
        const int b = (T == 2048) ? (u.pn >> 3) : u.pn, t0 = (T == 2048) ? ((u.pn & 7) * 256) : 0;
        const int m0 = u.pm * 256 + wr * 64 + fr; const int c0 = t0 + wc * 32 + 8 * fq;
#pragma unroll
        for (int ai = 0; ai < 2; ++ai)
#pragma unroll
            for (int m = 0; m < 4; ++m) { const int mr = m0 + ai * 128 + m * 16, part = mr >> 10, ch = mr & 1023;
                bf16_t* rowp = Z + ((size_t)(b * 1024 + ch) * 2 + part) * T + c0;
#pragma unroll
                for (int bj = 0; bj < 2; ++bj) { const mm::f32x4 v0 = acc[ai][bj][m][0], v1 = acc[ai][bj][m][1];
                    mm::u32x4 w; w.x = mm::cvt_pk_bf16(v0[0], v0[1]); w.y = mm::cvt_pk_bf16(v0[2], v0[3]); w.z = mm::cvt_pk_bf16(v1[0], v1[1]); w.w = mm::cvt_pk_bf16(v1[2], v1[3]);
                    *(mm::u32x4*)(rowp + bj * 128) = w; } }
    }
};
DI void ph_f1_mm(const Ctx& cx, const Params& p, float* lds, int j, bool with_ctx) {
    { mm::StaticSched S; S.init(p.A1 + (size_t)j * 2048 * 1024, p.H, 2048, NLAT, 1024, 1024, cx.nblk, cx.bid); EpiZT E{p.ZT, 2048}; mm::gemm_phase(GEMM_LDS(lds), 1024, S, E, cx.tid); }
    if (with_ctx) { mm::StaticSched S; S.init(p.A1 + (size_t)j * 2048 * 1024, p.H + (size_t)NLAT * 1024, 2048, NCTX, 1024, 1024, cx.nblk, cx.bid); EpiZT E{p.ZTC, 256}; mm::gemm_phase(GEMM_LDS(lds), 1024, S, E, cx.tid); }
}
DI void ph_f2_mm(const Ctx& cx, const Params& p, float* lds, bool with_ctx, const float* xin_lat, const float* xin_ctx, const float* modl) {
    { mm::BatchSched S; S.init(p.A2, p.ZT, (size_t)1024 * 4096 * 2, 16, 2048, 1024, 4096, cx.nblk, cx.bid); mm::EpiResid E{xin_lat, xin_ctx, p.out, p.ctxs, modl, 1}; mm::gemm_phase(GEMM_LDS(lds), 4096, S, E, cx.tid); }
    if (with_ctx) { mm::BatchSched S; S.init(p.A2c, p.ZTC, (size_t)1024 * 512 * 2, 16, 256, 1024, 512, cx.nblk, cx.bid); mm::EpiResid E{xin_lat, xin_ctx, p.out, p.ctxs, modl, -1}; mm::gemm_phase(GEMM_LDS(lds), 512, S, E, cx.tid); }
}
struct MoeSched {
    static constexpr bool GATHER = true, TABLE = true;
    const char* A; const char* Bt; const int* slot; const float* slotw; const int* tab; int lda, K, G, c, down;
    DI void tab_dma(const mm::Unit& u, LAS unsigned char* dst, int tid) const {
        const int Me = __builtin_amdgcn_readfirstlane(tab[32 + u.e]); const int r = tid & 255; int idx = u.m * 256 + r; idx = idx < Me ? idx : 0;
        const size_t off = (u.e < 16) ? (size_t)u.e * NT + idx : 0;
        const unsigned* src = (tid < 256) ? (const unsigned*)(slot + off) : (const unsigned*)(slotw + off);
        __builtin_amdgcn_global_load_lds(src, (LAS unsigned*)(dst + (tid >> 6) * 256), 4, 0, 0);
    }
    DI size_t hstep_a() const { return 0; }
    DI bool next(int i, mm::Unit& u) const {
        const int L = i * G + c; const int total = __builtin_amdgcn_readfirstlane(tab[17]);
        if (L >= total * 4) return false;
        const int rtg = L >> 2; int e = 0;
        for (int q = 1; q < 17; ++q) e += (__builtin_amdgcn_readfirstlane(tab[q]) <= rtg) ? 1 : 0;
        u.e = e; u.m = rtg - __builtin_amdgcn_readfirstlane(tab[e]); u.pm = u.m; u.pn = L & 3;
        u.A = A; u.B = Bt + ((size_t)e * 1024 + (size_t)u.pn * 256) * K * 2; return true;
    }
    DI unsigned rowoff(const mm::Unit& u, int Me, int idx, int C) const {
        int row;
        if (u.e < 16) { const int s = (idx < Me) ? slot[(size_t)u.e * NT + idx] : 0; row = down ? ((s & 1) * NT + (s >> 1)) : (s >> 1); }
        else row = down ? (2 * NT + idx) : idx;
        return (unsigned)(row * lda + C) * 2u;
    }
    DI unsigned rowoff_s(const mm::Unit& u, int s, int r, int C) const { int row; if (u.e < 16) row = down ? ((s & 1) * NT + (s >> 1)) : (s >> 1); else row = down ? (2 * NT + u.m * 256 + r) : (u.m * 256 + r); return (unsigned)(row * lda + C) * 2u; }
    DI void aoff_lds(const mm::Unit& u, const LAS int* et, int R0, int C0, int R1, int C1, unsigned (&o)[2][2]) const {
        o[0][0] = rowoff_s(u, et[R0], R0, C0); o[0][1] = rowoff_s(u, et[R1], R1, C1); o[1][0] = rowoff_s(u, et[128 + R0], 128 + R0, C0); o[1][1] = rowoff_s(u, et[128 + R1], 128 + R1, C1);
    }
    DI void aoff(const mm::Unit& u, int R0, int C0, int R1, int C1, unsigned (&o)[2][2]) const {
        const int Me = __builtin_amdgcn_readfirstlane(tab[32 + u.e]), base = u.m * 256;
        o[0][0] = rowoff(u, Me, base + R0, C0); o[0][1] = rowoff(u, Me, base + R1, C1);
        o[1][0] = rowoff(u, Me, base + 128 + R0, C0); o[1][1] = rowoff(u, Me, base + 128 + R1, C1);
    }
};
DI void moe_table(const Ctx& cx, const Params& p, int* tab, int layer, int nrows) {
    if (cx.tid == 0) { int acc = 0;
        for (int e = 0; e < 17; ++e) { const int M = (e < 16) ? p.cnt[(layer * 16 + e) * 64] : nrows; tab[e] = acc; tab[32 + e] = M; acc += (M + 255) >> 8; }
        tab[17] = acc; }
    __syncthreads();
}
DI void lds_read8(const LAS int* base, int r0, int (&o)[8]) {
    const unsigned a = (unsigned)(size_t)(base + r0);
    asm volatile("ds_read_b32 %0, %8\n\tds_read_b32 %1, %8 offset:64\n\tds_read_b32 %2, %8 offset:128\n\tds_read_b32 %3, %8 offset:192\n\t"
                 "ds_read_b32 %4, %8 offset:512\n\tds_read_b32 %5, %8 offset:576\n\tds_read_b32 %6, %8 offset:640\n\tds_read_b32 %7, %8 offset:704\n\ts_waitcnt lgkmcnt(0)"
                 : "=&v"(o[0]), "=&v"(o[1]), "=&v"(o[2]), "=&v"(o[3]), "=&v"(o[4]), "=&v"(o[5]), "=&v"(o[6]), "=&v"(o[7]) : "v"(a) : "memory");
}
struct EpiSwiglu {
    static constexpr bool PERM = true;
    bf16_t* ACT; const int* slot; const int* tab; const LAS int* etab;
    DI void operator()(const mm::f32x4 (&acc)[2][2][4][2], const mm::Unit& u, int wr, int wc, int fr, int fq) const {
        const int Me = __builtin_amdgcn_readfirstlane(tab[32 + u.e]); const int col = u.pn * 128 + wc * 32 + 8 * fq; const LAS int* et = etab + u.tb * 512;
        int sl8[8]; lds_read8(et, wr * 64 + fr, sl8);
#pragma unroll
        for (int ai = 0; ai < 2; ++ai)
#pragma unroll
            for (int m = 0; m < 4; ++m) {
                const int idx = u.m * 256 + ai * 128 + wr * 64 + m * 16 + fr;
                if (idx < Me) {
                    int drow; if (u.e < 16) { const int s = sl8[ai * 4 + m]; drow = (s & 1) * NT + (s >> 1); } else drow = 2 * NT + idx;
                    float o[8];
#pragma unroll
                    for (int n = 0; n < 2; ++n)
#pragma unroll
                        for (int c = 0; c < 4; ++c) { const float g = acc[ai][0][m][n][c], uu = acc[ai][1][m][n][c]; o[n * 4 + c] = g * __builtin_amdgcn_rcpf(1.f + __expf(-g)) * uu; }
                    mm::u32x4 w; w.x = mm::cvt_pk_bf16(o[0], o[1]); w.y = mm::cvt_pk_bf16(o[2], o[3]); w.z = mm::cvt_pk_bf16(o[4], o[5]); w.w = mm::cvt_pk_bf16(o[6], o[7]);
                    *(mm::u32x4*)(ACT + (size_t)drow * 512 + col) = w;
                }
            }
    }
};
struct EpiDown {
    static constexpr bool PERM = true;
    bf16_t* Y; const int* slot; const float* tokw; const int* tab; const LAS int* etab;
    DI void operator()(const mm::f32x4 (&acc)[2][2][4][2], const mm::Unit& u, int wr, int wc, int fr, int fq) const {
        const int Me = __builtin_amdgcn_readfirstlane(tab[32 + u.e]); const int col = u.pn * 256 + wc * 32 + 8 * fq; const LAS int* et = etab + u.tb * 512;
        int sl8[8], sw8[8]; lds_read8(et, wr * 64 + fr, sl8); lds_read8(et + 256, wr * 64 + fr, sw8);
#pragma unroll
        for (int ai = 0; ai < 2; ++ai)
#pragma unroll
            for (int m = 0; m < 4; ++m) {
                const int idx = u.m * 256 + ai * 128 + wr * 64 + m * 16 + fr;
                if (idx < Me) {
                    int drow; float w = 1.f;
                    if (u.e < 16) { const int s = sl8[ai * 4 + m]; drow = (s & 1) * NT + (s >> 1); w = __int_as_float(sw8[ai * 4 + m]); } else drow = 2 * NT + idx;
#pragma unroll
                    for (int bj = 0; bj < 2; ++bj) { const mm::f32x4 v0 = acc[ai][bj][m][0] * w, v1 = acc[ai][bj][m][1] * w;
                        mm::u32x4 o; o.x = mm::cvt_pk_bf16(v0[0], v0[1]); o.y = mm::cvt_pk_bf16(v0[2], v0[3]); o.z = mm::cvt_pk_bf16(v1[0], v1[1]); o.w = mm::cvt_pk_bf16(v1[2], v1[3]);
                        *(mm::u32x4*)(Y + (size_t)drow * 1024 + col + bj * 128) = o; }
                }
            }
    }
};
DI void ph_moe_up_mm(const Ctx& cx, const Params& p, float* lds, int layer, int nrows) {
    int* tab = (int*)(lds + 32768); moe_table(cx, p, tab, layer, nrows);
    MoeSched S{(const char*)p.H, (const char*)p.WguT, p.slot, p.slotw, tab, 1024, 1024, cx.nblk, cx.bid, 0};
    EpiSwiglu E{p.ACT, p.slot, tab, (const LAS int*)((LAS float*)lds + 32768 + 256)};
    mm::gemm_phase(GEMM_LDS(lds), 1024, S, E, cx.tid);
}
DI void ph_moe_down_mm(const Ctx& cx, const Params& p, float* lds, int layer, int nrows) {
    int* tab = (int*)(lds + 32768); moe_table(cx, p, tab, layer, nrows);
    MoeSched S{(const char*)p.ACT, (const char*)p.WdT, p.slot, p.slotw, tab, 512, 512, cx.nblk, cx.bid, 1};
    EpiDown E{p.Y, p.slot, p.tokw, tab, (const LAS int*)((LAS float*)lds + 32768 + 256)};
    mm::gemm_phase(GEMM_LDS(lds), 512, S, E, cx.tid);
}

namespace att {
typedef short bf16x8 __attribute__((ext_vector_type(8)));
typedef float f32x16 __attribute__((ext_vector_type(16)));
typedef unsigned u32x4 __attribute__((ext_vector_type(4)));
typedef unsigned u32x2 __attribute__((ext_vector_type(2)));
typedef __bf16 bf16x2_t __attribute__((ext_vector_type(2)));
typedef float f32x2_t __attribute__((ext_vector_type(2)));
constexpr int KP = 208, VP = 264, KT_BYTES = 128 * KP, VT_BYTES = 64 * VP, BUF = KT_BYTES + VT_BYTES;
DI unsigned pk(float a, float b) { f32x2_t f = {a, b}; bf16x2_t h = __builtin_convertvector(f, bf16x2_t); return __builtin_bit_cast(unsigned, h); }
#define ATT_MFMA(a, b, c) __builtin_amdgcn_mfma_f32_32x32x16_bf16((a), (b), (c), 0, 0, 0)
}
DI void ph_attn_mm(const Ctx& cx, const Params& p, float* ldsf, bool with_ctx) {
    using namespace att;
    LAS unsigned char* lds = (LAS unsigned char*)ldsf;
    const int tid = cx.tid, wid = __builtin_amdgcn_readfirstlane(tid >> 6), lane = tid & 63, r = lane & 31, hh = lane >> 5;
    const int nunits = 1024 + (with_ctx ? 128 : 0);
    int kg[3], kl[3], vg[2], vl[2];
#pragma unroll
    for (int i = 0; i < 3; ++i) { const int c = tid + 512 * i, row = c / 12, part = c % 12; kg[i] = row * 96 + part * 8; kl[i] = row * KP + part * 16; }
#pragma unroll
    for (int i = 0; i < 2; ++i) { const int c = tid + 512 * i, row = c >> 4, part = c & 15; vg[i] = row * 2304 + part * 8; vl[i] = KT_BYTES + row * VP + part * 16; }
    for (int u = cx.bid; u < nunits; u += cx.nblk) {
        int bh, qrow0, nkeys;
        if (u < 1024) { bh = u >> 3; qrow0 = (bh >> 3) * 2048 + (u & 7) * 256; nkeys = 2304; }
        else { bh = u - 1024; qrow0 = NLAT + (bh >> 3) * 256; nkeys = 256; }
        const int h = bh & 7;
        const bf16_t* Kb = p.Kf + (size_t)bh * 2304 * 96; const bf16_t* Vb = p.Vt + (size_t)bh * 64 * 2304;
        const bf16_t* qp = p.Qraw + (size_t)(qrow0 + wid * 32 + r) * 768 + h * 96 + 8 * hh;
        bf16x8 qf[6];
#pragma unroll
        for (int s = 0; s < 6; ++s) qf[s] = *(const bf16x8*)(qp + 16 * s);
        f32x16 ot0, ot1;
#pragma unroll
        for (int i = 0; i < 16; ++i) { ot0[i] = 0.f; ot1[i] = 0.f; }
        float mrun = -3.0e38f, lrun = 0.f;
        const int ntiles = nkeys >> 7;
        u32x4 kr[3], vr[2];
#pragma unroll
        for (int i = 0; i < 3; ++i) kr[i] = *(const u32x4*)(Kb + kg[i]);
#pragma unroll
        for (int i = 0; i < 2; ++i) vr[i] = *(const u32x4*)(Vb + vg[i]);
#pragma unroll
        for (int i = 0; i < 3; ++i) *(LAS u32x4*)(lds + kl[i]) = kr[i];
#pragma unroll
        for (int i = 0; i < 2; ++i) { *(LAS u32x2*)(lds + vl[i]) = (u32x2){vr[i].x, vr[i].y}; *(LAS u32x2*)(lds + vl[i] + 8) = (u32x2){vr[i].z, vr[i].w}; }
        __syncthreads();
        for (int it = 0; it < ntiles; ++it) {
            const int bo = (it & 1) * BUF, bn = ((it + 1) & 1) * BUF;
            const bool more = (it + 1 < ntiles);
            if (more) {
                const bf16_t* Kn = Kb + (size_t)(it + 1) * 128 * 96; const bf16_t* Vn = Vb + (it + 1) * 128;
#pragma unroll
                for (int i = 0; i < 3; ++i) kr[i] = *(const u32x4*)(Kn + kg[i]);
#pragma unroll
                for (int i = 0; i < 2; ++i) vr[i] = *(const u32x4*)(Vn + vg[i]);
            }
            f32x16 st[4];
#pragma unroll
            for (int kb = 0; kb < 4; ++kb) {
#pragma unroll
                for (int i = 0; i < 16; ++i) st[kb][i] = 0.f;
#pragma unroll
                for (int s = 0; s < 6; ++s) { const bf16x8 kf = *(const LAS bf16x8*)(lds + bo + (kb * 32 + r) * KP + 32 * s + 16 * hh); st[kb] = ATT_MFMA(kf, qf[s], st[kb]); }
            }
            float mt = st[0][0];
#pragma unroll
            for (int kb = 0; kb < 4; ++kb)
#pragma unroll
                for (int i = 0; i < 16; ++i) mt = fmaxf(mt, st[kb][i]);
            mt = fmaxf(mt, __shfl_xor(mt, 32));
            const float mnew = fmaxf(mrun, mt), alpha = __builtin_amdgcn_exp2f(mrun - mnew);
            mrun = mnew;
            float ps = 0.f;
#pragma unroll
            for (int kb = 0; kb < 4; ++kb)
#pragma unroll
                for (int i = 0; i < 16; ++i) { st[kb][i] = __builtin_amdgcn_exp2f(st[kb][i] - mnew); ps += st[kb][i]; }
            lrun = lrun * alpha + ps;
#pragma unroll
            for (int i = 0; i < 16; ++i) { ot0[i] *= alpha; ot1[i] *= alpha; }
#pragma unroll
            for (int kb = 0; kb < 4; ++kb)
#pragma unroll
                for (int s = 0; s < 2; ++s) {
                    u32x4 pw; pw.x = pk(st[kb][8 * s], st[kb][8 * s + 1]); pw.y = pk(st[kb][8 * s + 2], st[kb][8 * s + 3]); pw.z = pk(st[kb][8 * s + 4], st[kb][8 * s + 5]); pw.w = pk(st[kb][8 * s + 6], st[kb][8 * s + 7]);
                    const bf16x8 pb = __builtin_bit_cast(bf16x8, pw);
                    const int col = (kb * 32 + 16 * s + 4 * hh) * 2;
                    const u32x2 a0 = *(const LAS u32x2*)(lds + bo + KT_BYTES + r * VP + col), a1 = *(const LAS u32x2*)(lds + bo + KT_BYTES + r * VP + col + 16);
                    const u32x2 b0 = *(const LAS u32x2*)(lds + bo + KT_BYTES + (32 + r) * VP + col), b1 = *(const LAS u32x2*)(lds + bo + KT_BYTES + (32 + r) * VP + col + 16);
                    const u32x4 va = {a0.x, a0.y, a1.x, a1.y}, vb = {b0.x, b0.y, b1.x, b1.y};
                    ot0 = ATT_MFMA(__builtin_bit_cast(bf16x8, va), pb, ot0);
                    ot1 = ATT_MFMA(__builtin_bit_cast(bf16x8, vb), pb, ot1);
                }
            if (more) {
#pragma unroll
                for (int i = 0; i < 3; ++i) *(LAS u32x4*)(lds + bn + kl[i]) = kr[i];
#pragma unroll
                for (int i = 0; i < 2; ++i) { *(LAS u32x2*)(lds + bn + vl[i]) = (u32x2){vr[i].x, vr[i].y}; *(LAS u32x2*)(lds + bn + vl[i] + 8) = (u32x2){vr[i].z, vr[i].w}; }
            }
            __syncthreads();
        }
        const float il = 1.f / (lrun + __shfl_xor(lrun, 32));
        bf16_t* op = p.H + (size_t)(qrow0 + wid * 32 + r) * 1024 + 512 + h * 64 + 4 * hh;
#pragma unroll
        for (int g = 0; g < 4; ++g) {
            u32x2 w0 = {pk(ot0[4 * g] * il, ot0[4 * g + 1] * il), pk(ot0[4 * g + 2] * il, ot0[4 * g + 3] * il)};
            u32x2 w1 = {pk(ot1[4 * g] * il, ot1[4 * g + 1] * il), pk(ot1[4 * g + 2] * il, ot1[4 * g + 3] * il)};
            *(u32x2*)(op + 8 * g) = w0; *(u32x2*)(op + 32 + 8 * g) = w1;
        }
    }
}

namespace scan {
typedef float f32x2 __attribute__((ext_vector_type(2)));
constexpr int REC = 400, CH = 32, BUFF = CH * REC, YOFF = 2 * BUFF;
DI float dppf(float v, int ctrl_sel) {
    const int x = __builtin_bit_cast(int, v);
    int r;
    if (ctrl_sel == 0) r = __builtin_amdgcn_update_dpp(0, x, 0xB1, 0xf, 0xf, true);
    else if (ctrl_sel == 1) r = __builtin_amdgcn_update_dpp(0, x, 0x4E, 0xf, 0xf, true);
    else r = __builtin_amdgcn_update_dpp(0, x, 0x141, 0xf, 0xf, true);
    return __builtin_bit_cast(float, r);
}
DI float red8(float v) { v += dppf(v, 0); v += dppf(v, 1); v += dppf(v, 2); return v; }
}
template <int ABL>
DI void ph_scan_opt(const Ctx& cx, const Params& p, float* lds, int j) {
    using namespace scan;
    const int tid = cx.tid, wid = __builtin_amdgcn_readfirstlane(tid >> 6), lane = tid & 63;
    for (int item = cx.bid; item < 256; item += cx.nblk) {
        const int b = item >> 4, h = (item >> 1) & 7, dir = item & 1;
        bf16_t* yout = dir ? p.YB : p.YF;
        if (wid >= 4) {
            const int pw = wid - 4, hc = h * 64 + lane;
            const float kkc = p.a_k_k[j * 512 + hc], kac = p.a_k_a[j * 512 + hc];
            const float mur = p.a_mu[j * ACOLS + hc], muk = p.a_mu[j * ACOLS + 512 + hc], muv = p.a_mu[j * ACOLS + 1024 + hc];
            LAS float* L = (LAS float*)lds;
            bf16_t raw[8][11];
#define SCAN_ROW(stepv, row_, t_, T_) const bool cp_ = (stepv) < 256; const int tt_ = cp_ ? (stepv) : (stepv) - 256, T_ = cp_ ? 256 : 2048, t_ = dir ? (T_ - 1 - tt_) : tt_; const int row_ = cp_ ? NLAT + b * 256 + t_ : b * 2048 + t_
#define SCAN_LOAD(cc) do { _Pragma("unroll") for (int it = 0; it < 8; ++it) { const int step = (cc) * CH + pw + 4 * it; SCAN_ROW(step, row, t, T); \
                const int rp_ = (t > 0) ? row - 1 : row, rn_ = (t < T - 1) ? row + 1 : row; \
                const bf16_t* pc = p.P + (size_t)row * PLD + hc; const bf16_t* pp = p.P + (size_t)rp_ * PLD + hc; const bf16_t* pn = p.P + (size_t)rn_ * PLD + hc; \
                raw[it][0] = pc[0]; raw[it][1] = pp[0]; raw[it][2] = pn[0]; raw[it][3] = pc[512]; raw[it][4] = pp[512]; raw[it][5] = pn[512]; raw[it][6] = pc[1024]; raw[it][7] = pp[1024]; raw[it][8] = pn[1024]; \
                raw[it][9] = p.WAG[(size_t)row * WLD + dir * 512 + hc]; raw[it][10] = p.WAG[(size_t)row * WLD + 1024 + dir * 512 + hc]; } } while (0)
            if (ABL != 1) SCAN_LOAD(0);
            for (int c = 0; c <= 73; ++c) {
                if (c >= 2 && ABL == 0) {
                    const LAS float* yb = L + YOFF + ((c - 2) & 1) * (CH * 64);
#pragma unroll
                    for (int it = 0; it < 8; ++it) {
                        const int sl = pw + 4 * it, step = (c - 2) * CH + sl; SCAN_ROW(step, row, t, T);
                        yout[(size_t)row * 512 + hc] = f2bf(yb[sl * 64 + lane]);
                    }
                }
                if (c < 72 && ABL != 1) {
                    LAS float* buf = L + (c & 1) * BUFF;
#pragma unroll
                    for (int it = 0; it < 8; ++it) {
                        const int sl = pw + 4 * it, step = c * CH + sl; SCAN_ROW(step, row, t, T); (void)row;
                        const float mp = (t > 0) ? 0.5f : 0.f, mn = (t < T - 1) ? 0.5f : 0.f;
                        const float rc = bf2f(raw[it][0]), kc_ = bf2f(raw[it][3]), vc = bf2f(raw[it][6]);
                        const float R = rc + mur * (mp * bf2f(raw[it][1]) + mn * bf2f(raw[it][2]) - rc);
                        const float K = kc_ + muk * (mp * bf2f(raw[it][4]) + mn * bf2f(raw[it][5]) - kc_);
                        const float V = vc + muv * (mp * bf2f(raw[it][7]) + mn * bf2f(raw[it][8]) - vc);
                        const float w = 1.f - bf2f(raw[it][9]), a = bf2f(raw[it][10]);
                        const float kkv = K * kkc, ssq = wave_sum(kkv * kkv), kk = kkv * rsqrtf(ssq + 1e-12f);
                        const float kd = K * (1.f + (a - 1.f) * kac), bd = kk * a;
                        const float br = wave_sum(bd * R), kr = wave_sum(kd * R);
                        LAS float* rec = buf + sl * REC;
                        rec[lane] = w; rec[64 + lane] = -kk; rec[128 + lane] = bd; rec[192 + lane] = kd; rec[256 + lane] = w * R; rec[320 + lane] = V;
                        if (lane == 0) { rec[384] = br; rec[385] = kr; }
                    }
                    if (c + 1 < 72) SCAN_LOAD(c + 1);
                }
                __syncthreads();
            }
#undef SCAN_LOAD
#undef SCAN_ROW
        } else {
            const int ct = tid, rp = ct >> 3, k8 = ct & 7;
            float S0[8], S1[8];
#pragma unroll
            for (int q = 0; q < 8; ++q) { S0[q] = 0.f; S1[q] = 0.f; }
            __syncthreads();
            for (int c = 0; c < 72; ++c) {
                const LAS float* buf = (const LAS float*)lds + (c & 1) * BUFF; LAS float* yb = (LAS float*)lds + YOFF + (c & 1) * (CH * 64);
                mm::f32x4 cw0, cw1, cn0, cn1, cb0, cb1, cd0, cd1, cr0, cr1; scan::f32x2 cvv, csc;
#define SCAN_LD(recp, W0, W1, N0, N1, B0, B1, D0, D1, R0_, R1_, VV, SC) do { const LAS float* r_ = (recp); \
                    W0 = *(const LAS mm::f32x4*)(r_ + k8 * 8); W1 = *(const LAS mm::f32x4*)(r_ + k8 * 8 + 4); N0 = *(const LAS mm::f32x4*)(r_ + 64 + k8 * 8); N1 = *(const LAS mm::f32x4*)(r_ + 64 + k8 * 8 + 4); \
                    B0 = *(const LAS mm::f32x4*)(r_ + 128 + k8 * 8); B1 = *(const LAS mm::f32x4*)(r_ + 128 + k8 * 8 + 4); D0 = *(const LAS mm::f32x4*)(r_ + 192 + k8 * 8); D1 = *(const LAS mm::f32x4*)(r_ + 192 + k8 * 8 + 4); \
                    R0_ = *(const LAS mm::f32x4*)(r_ + 256 + k8 * 8); R1_ = *(const LAS mm::f32x4*)(r_ + 256 + k8 * 8 + 4); VV = *(const LAS scan::f32x2*)(r_ + 320 + 2 * rp); SC = *(const LAS scan::f32x2*)(r_ + 384); } while (0)
                SCAN_LD(buf, cw0, cw1, cn0, cn1, cb0, cb1, cd0, cd1, cr0, cr1, cvv, csc);
#pragma unroll 2
                for (int sl = 0; sl < (ABL == 2 ? 0 : CH); ++sl) {
                    mm::f32x4 nw0, nw1, nn0, nn1, nb0, nb1, nd0, nd1, nr0, nr1; scan::f32x2 nvv, nsc;
                    SCAN_LD(buf + (sl + 1 < CH ? sl + 1 : sl) * REC, nw0, nw1, nn0, nn1, nb0, nb1, nd0, nd1, nr0, nr1, nvv, nsc);
                    const float wv[8] = {cw0[0], cw0[1], cw0[2], cw0[3], cw1[0], cw1[1], cw1[2], cw1[3]}, nv[8] = {cn0[0], cn0[1], cn0[2], cn0[3], cn1[0], cn1[1], cn1[2], cn1[3]};
                    const float bv[8] = {cb0[0], cb0[1], cb0[2], cb0[3], cb1[0], cb1[1], cb1[2], cb1[3]}, dv[8] = {cd0[0], cd0[1], cd0[2], cd0[3], cd1[0], cd1[1], cd1[2], cd1[3]};
                    const float rv[8] = {cr0[0], cr0[1], cr0[2], cr0[3], cr1[0], cr1[1], cr1[2], cr1[3]};
                    float sa0 = 0.f, sa1 = 0.f, y0 = 0.f, y1 = 0.f;
#pragma unroll
                    for (int q = 0; q < 8; ++q) { sa0 += S0[q] * nv[q]; sa1 += S1[q] * nv[q]; y0 += S0[q] * rv[q]; y1 += S1[q] * rv[q]; }
                    sa0 = red8(sa0); sa1 = red8(sa1); y0 = red8(y0); y1 = red8(y1);
                    y0 += sa0 * csc[0] + cvv[0] * csc[1]; y1 += sa1 * csc[0] + cvv[1] * csc[1];
#pragma unroll
                    for (int q = 0; q < 8; ++q) { S0[q] = S0[q] * wv[q] + sa0 * bv[q] + cvv[0] * dv[q]; S1[q] = S1[q] * wv[q] + sa1 * bv[q] + cvv[1] * dv[q]; }
                    if (k8 == 0) *(LAS scan::f32x2*)(yb + sl * 64 + 2 * rp) = (scan::f32x2){y0, y1};
                    cw0 = nw0; cw1 = nw1; cn0 = nn0; cn1 = nn1; cb0 = nb0; cb1 = nb1; cd0 = nd0; cd1 = nd1; cr0 = nr0; cr1 = nr1; cvv = nvv; csc = nsc;
                }
#undef SCAN_LD
                __syncthreads();
            }
            __syncthreads();
        }
    }
}

namespace sc2 {
typedef short bf16x8 __attribute__((ext_vector_type(8)));
typedef float f32x4 __attribute__((ext_vector_type(4)));
typedef unsigned u32x4 __attribute__((ext_vector_type(4)));
typedef unsigned u32x2 __attribute__((ext_vector_type(2)));
constexpr int NP = 6;
constexpr int O_AH = 0, O_RH = 2048, O_BK = 4096, O_VM = 8192, O_GC = 10240, O_AAB = 10496, O_AAK = 11520, O_ARK = 12032, O_BH = 13056, O_KH = 15104, SLOT = 17152;
constexpr int O_S0 = NP * SLOT, O_RHS = O_S0 + 8192, O_ZU = O_RHS + 4096, O_FLAG = O_ZU + 2048, TOTAL = O_FLAG + 256;
#define SC_MFMA(a, b, c) __builtin_amdgcn_mfma_f32_16x16x32_bf16((a), (b), (c), 0, 0, 0)
DI unsigned pk2(float a, float b) { return att::pk(a, b); }
DI int ldv(volatile LAS int* p) { return *p; }
}
template <int ABL>
DI void ph_scan_chunk(const Ctx& cx, const Params& p, float* ldsg, int j) {
    using namespace sc2;
    static_assert(TOTAL <= 128 * 1024, "scan LDS map");
    LAS unsigned char* L = (LAS unsigned char*)ldsg;
    volatile LAS int* ready = (volatile LAS int*)(L + O_FLAG); volatile LAS int* done = ready + 8;
    const int tid = cx.tid, wid = __builtin_amdgcn_readfirstlane(tid >> 6), lane = tid & 63, lq = lane >> 4, lr = lane & 15;
    constexpr int NCH = 144;
    for (int item = cx.bid; item < 256; item += cx.nblk) {
        const int b = item >> 4, h = (item >> 1) & 7, dir = item & 1;
        bf16_t* yout = dir ? p.YB : p.YF;
        __syncthreads();
        if (tid < 16) ready[tid] = 0;
        __syncthreads();
#define SC_ROW(stepv, row_, t_, T_) const bool cp_ = (stepv) < 256; const int tt_ = cp_ ? (stepv) : (stepv) - 256, T_ = cp_ ? 256 : 2048, t_ = dir ? (T_ - 1 - tt_) : tt_; const int row_ = cp_ ? NLAT + b * 256 + t_ : b * 2048 + t_
        if (wid == 0) {
            __builtin_amdgcn_s_setprio(3);
            f32x4 S[4][4];
#pragma unroll
            for (int kb = 0; kb < 4; ++kb)
#pragma unroll
                for (int vb = 0; vb < 4; ++vb) S[kb][vb] = (f32x4){0.f, 0.f, 0.f, 0.f};
            for (int c = 0; c < NCH; ++c) {
                const int sl = c % NP; LAS unsigned char* SB = L + sl * SLOT;
                { unsigned spins = 0; while (ldv(ready + sl) != c + 1) { __builtin_amdgcn_s_sleep(1); if (++spins > (1u << 22)) break; } }
                asm volatile("" ::: "memory");
                if (ABL == 2) { if (lane == 0) done[sl] = c + 1; continue; }
                f32x4 cA[8][2];
#pragma unroll
                for (int t = 1; t <= 8; ++t)
#pragma unroll
                    for (int q = 0; q < 2; ++q) if (4 * q < t) cA[t - 1][q] = *(const LAS f32x4*)(SB + O_AAB + t * 64 + q * 16);
#pragma unroll
                for (int kb = 0; kb < 4; ++kb)
#pragma unroll
                    for (int vb = 0; vb < 4; ++vb) { const f32x4 x = S[kb][vb]; *(LAS u32x2*)(L + O_S0 + (16 * vb + lr) * 128 + (16 * kb + 4 * lq) * 2) = (u32x2){pk2(x[0], x[1]), pk2(x[2], x[3])}; }
                bf16x8 ah[2], ak;
#pragma unroll
                for (int ks = 0; ks < 2; ++ks) ah[ks] = *(const LAS bf16x8*)(SB + O_AH + lr * 128 + ks * 64 + lq * 16);
                { u32x4 z = {0u, 0u, 0u, 0u}; if (lq < 2) z = *(const LAS u32x4*)(SB + O_AAK + lr * 32 + lq * 16); ak = __builtin_bit_cast(bf16x8, z); }
#pragma unroll
                for (int vb = 0; vb < 4; ++vb) {
                    f32x4 acc = {0.f, 0.f, 0.f, 0.f};
#pragma unroll
                    for (int ks = 0; ks < 2; ++ks) { const bf16x8 sf = *(const LAS bf16x8*)(L + O_S0 + (16 * vb + lr) * 128 + ks * 64 + lq * 16); acc = SC_MFMA(sf, ah[ks], acc); }
                    { u32x4 z = {0u, 0u, 0u, 0u}; if (lq < 2) z = *(const LAS u32x4*)(SB + O_VM + (16 * vb + lr) * 32 + lq * 16); acc = SC_MFMA(__builtin_bit_cast(bf16x8, z), ak, acc); }
#pragma unroll
                    for (int q = 0; q < 4; ++q) *(LAS float*)(L + O_RHS + ((16 * vb + 4 * lq + q) * 16 + lr) * 4) = acc[q];
                }
                float u[16];
                { const LAS f32x4* rp = (const LAS f32x4*)(L + O_RHS + lane * 64);
#pragma unroll
                  for (int q = 0; q < 4; ++q) { const f32x4 x = rp[q]; u[4 * q] = x[0]; u[4 * q + 1] = x[1]; u[4 * q + 2] = x[2]; u[4 * q + 3] = x[3]; } }
#define SC_SUBST(t, CF) do { float a0 = u[t], a1 = 0.f; \
                    _Pragma("unroll") for (int q = 0; q < 4; ++q) { if (4 * q < (t)) { const f32x4 cf = CF[q]; \
                        _Pragma("unroll") for (int e = 0; e < 4; ++e) { if (4 * q + e < (t)) { if (e & 1) a1 += cf[e] * u[4 * q + e]; else a0 += cf[e] * u[4 * q + e]; } } } } \
                    u[t] = a0 + a1; } while (0)
                f32x4 cB[4][3], cC[3][4];
#pragma unroll
                for (int t = 9; t <= 12; ++t)
#pragma unroll
                    for (int q = 0; q < 3; ++q) cB[t - 9][q] = *(const LAS f32x4*)(SB + O_AAB + t * 64 + q * 16);
                asm volatile("" ::: "memory");
                SC_SUBST(1, cA[0]); SC_SUBST(2, cA[1]); SC_SUBST(3, cA[2]); SC_SUBST(4, cA[3]); SC_SUBST(5, cA[4]); SC_SUBST(6, cA[5]); SC_SUBST(7, cA[6]); SC_SUBST(8, cA[7]);
                asm volatile("" ::: "memory");
#pragma unroll
                for (int t = 13; t <= 15; ++t)
#pragma unroll
                    for (int q = 0; q < 4; ++q) cC[t - 13][q] = *(const LAS f32x4*)(SB + O_AAB + t * 64 + q * 16);
                asm volatile("" ::: "memory");
                SC_SUBST(9, cB[0]); SC_SUBST(10, cB[1]); SC_SUBST(11, cB[2]); SC_SUBST(12, cB[3]);
                SC_SUBST(13, cC[0]); SC_SUBST(14, cC[1]); SC_SUBST(15, cC[2]);
#undef SC_SUBST
                { u32x4 w0 = {pk2(u[0], u[1]), pk2(u[2], u[3]), pk2(u[4], u[5]), pk2(u[6], u[7])}, w1 = {pk2(u[8], u[9]), pk2(u[10], u[11]), pk2(u[12], u[13]), pk2(u[14], u[15])};
                  *(LAS u32x4*)(L + O_ZU + lane * 32) = w0; *(LAS u32x4*)(L + O_ZU + lane * 32 + 16) = w1; }
                bf16x8 zf[4];
#pragma unroll
                for (int vb = 0; vb < 4; ++vb) zf[vb] = (lq < 2) ? *(const LAS bf16x8*)(L + O_ZU + (16 * vb + lr) * 32 + lq * 16) : *(const LAS bf16x8*)(SB + O_VM + (16 * vb + lr) * 32 + (lq - 2) * 16);
                { const bf16x8 rk = *(const LAS bf16x8*)(SB + O_ARK + lr * 64 + lq * 16);
                  const bf16x8 rh0 = *(const LAS bf16x8*)(SB + O_RH + lr * 128 + lq * 16), rh1 = *(const LAS bf16x8*)(SB + O_RH + lr * 128 + 64 + lq * 16);
                  const int step = c * 16 + lr; SC_ROW(step, row, tq, Tq); (void)tq; (void)Tq;
#pragma unroll
                  for (int vb = 0; vb < 4; ++vb) { f32x4 y = {0.f, 0.f, 0.f, 0.f};
                      y = SC_MFMA(*(const LAS bf16x8*)(L + O_S0 + (16 * vb + lr) * 128 + lq * 16), rh0, y); y = SC_MFMA(*(const LAS bf16x8*)(L + O_S0 + (16 * vb + lr) * 128 + 64 + lq * 16), rh1, y);
                      y = SC_MFMA(zf[vb], rk, y);
                      if (ABL == 0) *(u32x2*)(yout + (size_t)row * 512 + h * 64 + 16 * vb + 4 * lq) = (u32x2){pk2(y[0], y[1]), pk2(y[2], y[3])}; else asm volatile("" :: "v"(y[0]), "v"(y[1]), "v"(y[2]), "v"(y[3])); } }
#pragma unroll
                for (int kb = 0; kb < 4; ++kb) {
                    const f32x4 gc = *(const LAS f32x4*)(SB + O_GC + (16 * kb + 4 * lq) * 4);
                    const bf16x8 bkf = *(const LAS bf16x8*)(SB + O_BK + (16 * kb + lr) * 64 + lq * 16);
#pragma unroll
                    for (int vb = 0; vb < 4; ++vb) S[kb][vb] = SC_MFMA(bkf, zf[vb], S[kb][vb] * gc);
                }
                asm volatile("s_waitcnt lgkmcnt(0)" ::: "memory");
                if (lane == 0) done[sl] = c + 1;
            }
            __builtin_amdgcn_s_setprio(0);
        } else if (wid != 4) {
            const int pw = (wid < 4) ? wid - 1 : wid - 2, hc = h * 64 + lane; LAS unsigned char* SB = L + pw * SLOT;
            const float kkc = p.a_k_k[j * 512 + hc], kac = p.a_k_a[j * 512 + hc];
            const float mur = p.a_mu[j * ACOLS + hc], muk = p.a_mu[j * ACOLS + 512 + hc], muv = p.a_mu[j * ACOLS + 1024 + hc];
            for (int c = pw; c < NCH; c += NP) {
                if (ABL == 1) { if (c >= NP) { unsigned spins = 0; while (ldv(done + pw) != c - NP + 1) { __builtin_amdgcn_s_sleep(2); if (++spins > (1u << 22)) break; } } if (lane == 0) ready[pw] = c + 1; continue; }
                bf16_t raw[16][11];
#define SC_LOAD(t) do { const int step = c * 16 + (t); SC_ROW(step, row, tq, Tq); \
                    const int rp_ = (tq > 0) ? row - 1 : row, rn_ = (tq < Tq - 1) ? row + 1 : row; \
                    const bf16_t* pc = p.P + (size_t)row * PLD + hc; const bf16_t* pp = p.P + (size_t)rp_ * PLD + hc; const bf16_t* pn = p.P + (size_t)rn_ * PLD + hc; \
                    raw[t][0] = pc[0]; raw[t][1] = pp[0]; raw[t][2] = pn[0]; raw[t][3] = pc[512]; raw[t][4] = pp[512]; raw[t][5] = pn[512]; raw[t][6] = pc[1024]; raw[t][7] = pp[1024]; raw[t][8] = pn[1024]; \
                    raw[t][9] = p.WAG[(size_t)row * WLD + dir * 512 + hc]; raw[t][10] = p.WAG[(size_t)row * WLD + 1024 + dir * 512 + hc]; } while (0)
#define SC_STEP(t) do { const int step = c * 16 + (t); SC_ROW(step, row, tq, Tq); (void)row; \
                    const float mp = (tq > 0) ? 0.5f : 0.f, mn = (tq < Tq - 1) ? 0.5f : 0.f; \
                    const float rc = bf2f(raw[t][0]), kc_ = bf2f(raw[t][3]), vc = bf2f(raw[t][6]); \
                    const float R = rc + mur * (mp * bf2f(raw[t][1]) + mn * bf2f(raw[t][2]) - rc); \
                    const float K = kc_ + muk * (mp * bf2f(raw[t][4]) + mn * bf2f(raw[t][5]) - kc_); \
                    const float Vv = vc + muv * (mp * bf2f(raw[t][7]) + mn * bf2f(raw[t][8]) - vc); \
                    const float w = 1.f - bf2f(raw[t][9]), a = bf2f(raw[t][10]); \
                    const float kkv = K * kkc, ssq = wave_sum(kkv * kkv), kk = kkv * rsqrtf(ssq + 1e-12f); \
                    const float kd = K * (1.f + (a - 1.f) * kac), bd = kk * a; \
                    const float gprev = g; g *= w; const float ig = __builtin_amdgcn_rcpf(g); \
                    *(LAS bf16_t*)(SB + O_AH + (t) * 128 + lane * 2) = f2bf(-kk * gprev); \
                    *(LAS bf16_t*)(SB + O_RH + (t) * 128 + lane * 2) = f2bf(R * g); \
                    *(LAS bf16_t*)(SB + O_BH + (t) * 128 + lane * 2) = f2bf(bd * ig); \
                    *(LAS bf16_t*)(SB + O_KH + (t) * 128 + lane * 2) = f2bf(kd * ig); \
                    *(LAS bf16_t*)(SB + O_VM + lane * 32 + (t) * 2) = f2bf(Vv); } while (0)
                SC_LOAD(0); SC_LOAD(1); SC_LOAD(2); SC_LOAD(3); SC_LOAD(4); SC_LOAD(5); SC_LOAD(6); SC_LOAD(7);
                if (c >= NP) { unsigned spins = 0; while (ldv(done + pw) != c - NP + 1) { __builtin_amdgcn_s_sleep(2); if (++spins > (1u << 22)) break; } }
                asm volatile("" ::: "memory");
                float g = 1.f;
                SC_STEP(0); SC_STEP(1); SC_STEP(2); SC_STEP(3);
                asm volatile("" ::: "memory");
                SC_LOAD(8); SC_LOAD(9); SC_LOAD(10); SC_LOAD(11);
                asm volatile("" ::: "memory");
                SC_STEP(4); SC_STEP(5); SC_STEP(6); SC_STEP(7);
                asm volatile("" ::: "memory");
                SC_LOAD(12); SC_LOAD(13); SC_LOAD(14); SC_LOAD(15);
                asm volatile("" ::: "memory");
                SC_STEP(8); SC_STEP(9); SC_STEP(10); SC_STEP(11); SC_STEP(12); SC_STEP(13); SC_STEP(14); SC_STEP(15);
#undef SC_LOAD
#undef SC_STEP
#pragma unroll
                for (int q = 0; q < 2; ++q) {
                    float bq[8], kq[8];
#pragma unroll
                    for (int e = 0; e < 8; ++e) { bq[e] = bf2f(*(const LAS bf16_t*)(SB + O_BH + (8 * q + e) * 128 + lane * 2)) * g; kq[e] = bf2f(*(const LAS bf16_t*)(SB + O_KH + (8 * q + e) * 128 + lane * 2)) * g; }
                    u32x4 wb = {pk2(bq[0], bq[1]), pk2(bq[2], bq[3]), pk2(bq[4], bq[5]), pk2(bq[6], bq[7])}, wk = {pk2(kq[0], kq[1]), pk2(kq[2], kq[3]), pk2(kq[4], kq[5]), pk2(kq[6], kq[7])};
                    *(LAS u32x4*)(SB + O_BK + lane * 64 + q * 16) = wb; *(LAS u32x4*)(SB + O_BK + lane * 64 + 32 + q * 16) = wk;
                }
                *(LAS float*)(SB + O_GC + lane * 4) = g;
                f32x4 sab = {0.f, 0.f, 0.f, 0.f}, sak = sab, srb = sab, srk = sab;
#pragma unroll
                for (int ks = 0; ks < 2; ++ks) {
                    const bf16x8 fa = *(const LAS bf16x8*)(SB + O_AH + lr * 128 + ks * 64 + lq * 16), fr = *(const LAS bf16x8*)(SB + O_RH + lr * 128 + ks * 64 + lq * 16);
                    const bf16x8 fb = *(const LAS bf16x8*)(SB + O_BH + lr * 128 + ks * 64 + lq * 16), fk = *(const LAS bf16x8*)(SB + O_KH + lr * 128 + ks * 64 + lq * 16);
                    sab = SC_MFMA(fa, fb, sab); sak = SC_MFMA(fa, fk, sak); srb = SC_MFMA(fr, fb, srb); srk = SC_MFMA(fr, fk, srk);
                }
#pragma unroll
                for (int q = 0; q < 4; ++q) { const int t = 4 * lq + q; const bool lo = lr < t, le = lr <= t;
                    *(LAS float*)(SB + O_AAB + (t * 16 + lr) * 4) = lo ? sab[q] : 0.f;
                    *(LAS bf16_t*)(SB + O_AAK + (t * 16 + lr) * 2) = f2bf(lo ? sak[q] : 0.f);
                    *(LAS bf16_t*)(SB + O_ARK + (t * 32 + lr) * 2) = f2bf(le ? srb[q] : 0.f);
                    *(LAS bf16_t*)(SB + O_ARK + (t * 32 + 16 + lr) * 2) = f2bf(le ? srk[q] : 0.f); }
                asm volatile("s_waitcnt lgkmcnt(0)" ::: "memory");
                if (lane == 0) ready[pw] = c + 1;
            }
        }
#undef SC_ROW
        __syncthreads();
    }
}

DI void unpack8u(const uint4 u, float (&d)[8]) { d[0] = bflo(u.x); d[1] = bfhi(u.x); d[2] = bflo(u.y); d[3] = bfhi(u.y); d[4] = bflo(u.z); d[5] = bfhi(u.z); d[6] = bflo(u.w); d[7] = bfhi(u.w); }
DI uint4 pack8u(const float (&d)[8]) { uint4 u; u.x = att::pk(d[0], d[1]); u.y = att::pk(d[2], d[3]); u.z = att::pk(d[4], d[5]); u.w = att::pk(d[6], d[7]); return u; }
DI void shift8(const bf16_t* P, int row, int t, int T, int col0, const float (&mu)[8], float (&o)[8]) {
    float c[8], pv[8], nx[8];
    unpack8u(*(const uint4*)(P + (size_t)row * PLD + col0), c);
    if (t > 0) unpack8u(*(const uint4*)(P + (size_t)(row - 1) * PLD + col0), pv); else {
#pragma unroll
        for (int i = 0; i < 8; ++i) pv[i] = 0.f; }
    if (t < T - 1) unpack8u(*(const uint4*)(P + (size_t)(row + 1) * PLD + col0), nx); else {
#pragma unroll
        for (int i = 0; i < 8; ++i) nx[i] = 0.f; }
#pragma unroll
    for (int i = 0; i < 8; ++i) o[i] = c[i] + mu[i] * (0.5f * (pv[i] + nx[i]) - c[i]);
}
DI void ld8f(const float* p, float (&d)[8]) { const float4 a = *(const float4*)p, b = *(const float4*)(p + 4); d[0] = a.x; d[1] = a.y; d[2] = a.z; d[3] = a.w; d[4] = b.x; d[5] = b.y; d[6] = b.z; d[7] = b.w; }
DI void ph_post_opt(const Ctx& cx, const Params& p, int j, int nrows) {
    const int tid = cx.tid, wid = tid >> 6, lane = tid & 63, c0 = lane * 8;
    float mur[8], muk[8], muv[8], ka[8], rk[8], lw[8], lb[8];
    ld8f(p.a_mu + j * ACOLS + c0, mur); ld8f(p.a_mu + j * ACOLS + 512 + c0, muk); ld8f(p.a_mu + j * ACOLS + 1024 + c0, muv);
    ld8f(p.a_k_a + j * 512 + c0, ka); ld8f(p.a_r_k + j * 512 + c0, rk); ld8f(p.a_ln_w + j * 512 + c0, lw); ld8f(p.a_ln_b + j * 512 + c0, lb);
    for (int row = cx.bid * 8 + wid; row < nrows; row += cx.nblk * 8) {
        const bool lat = row < NLAT; const int t = lat ? (row & 2047) : ((row - NLAT) & 255); const int T = lat ? 2048 : 256;
        float yf[8], yb[8], R[8], K[8], V[8], af[8], ab[8], g[8];
        unpack8u(*(const uint4*)(p.YF + (size_t)row * 512 + c0), yf); unpack8u(*(const uint4*)(p.YB + (size_t)row * 512 + c0), yb);
        shift8(p.P, row, t, T, c0, mur, R); shift8(p.P, row, t, T, 512 + c0, muk, K); shift8(p.P, row, t, T, 1024 + c0, muv, V);
        unpack8u(*(const uint4*)(p.WAG + (size_t)row * WLD + 1024 + c0), af); unpack8u(*(const uint4*)(p.WAG + (size_t)row * WLD + 1536 + c0), ab); unpack8u(*(const uint4*)(p.WAG + (size_t)row * WLD + 2048 + c0), g);
        float sum = 0.f, sb = 0.f;
#pragma unroll
        for (int i = 0; i < 8; ++i) { yf[i] += yb[i]; sum += yf[i]; sb += R[i] * rk[i] * K[i] * (2.f + (af[i] + ab[i] - 2.f) * ka[i]); }
        sum = scan::red8(sum); sb = scan::red8(sb);
        const float mean = sum * (1.f / 64.f); float var = 0.f;
#pragma unroll
        for (int i = 0; i < 8; ++i) { const float d = yf[i] - mean; var += d * d; }
        var = scan::red8(var);
        const float rstd = rsqrtf(var * (1.f / 64.f) + 64e-5f);
        float o[8];
#pragma unroll
        for (int i = 0; i < 8; ++i) o[i] = ((yf[i] - mean) * rstd * lw[i] + lb[i] + sb * V[i]) * g[i];
        *(uint4*)(p.H + (size_t)row * 1024 + c0) = pack8u(o);
    }
}
DI void fin_vec(float (&x)[8], int c, int t, bool lat, const float* gain, float scl, bf16_t* dst) {
    float ss = 0.f;
#pragma unroll
    for (int i = 0; i < 8; ++i) ss += x[i] * x[i];
    ss += __shfl_xor(ss, 1); ss += __shfl_xor(ss, 2); ss += __shfl_xor(ss, 4); ss += __shfl_xor(ss, 8);
    const float r = rsqrtf(ss * (1.f / 96.f) + 1e-6f);
    float gn[8]; ld8f(gain + (c < 12 ? c : 0) * 8, gn);
#pragma unroll
    for (int i = 0; i < 8; ++i) x[i] = x[i] * r * gn[i];
    float y[8];
#pragma unroll
    for (int i = 0; i < 8; ++i) { const float up = __shfl_down(x[i], 2), dn = __shfl_up(x[i], 2); y[i] = (c < 10) ? up : dn; }
    if (lat && c >= 8 && c < 12) {
        const float invf[8] = {1.f, 0.316227766016838f, 0.1f, 0.0316227766016838f, 0.01f, 0.00316227766016838f, 0.001f, 0.000316227766016838f};
        const float pos = (c & 1) ? (float)(t & 63) : (float)(t >> 6);
#pragma unroll
        for (int i = 0; i < 8; ++i) { const float ang = pos * invf[i], cs = __cosf(ang), sn = __sinf(ang); x[i] = (c < 10) ? (x[i] * cs - y[i] * sn) : (x[i] * cs + y[i] * sn); }
    }
    if (c < 12) {
#pragma unroll
        for (int i = 0; i < 8; ++i) x[i] *= scl;
        *(uint4*)(dst + c * 8) = pack8u(x);
    }
}
DI void ph_finalize_opt(const Ctx& cx, const Params& p, float* ldsf, int j, int mq) {
    const int tid = cx.tid, wid = tid >> 6, lane = tid & 63, c = lane & 15, hq = lane >> 4;
    const float* qg = p.b_q_gain + j * 96; const float* kg = p.b_k_gain + j * 96;
    for (int row0 = (cx.bid * 8 + wid) * 2; row0 < NT; row0 += cx.nblk * 16) {
        float xq[4][8], xk[4][8];
#pragma unroll
        for (int u = 0; u < 4; ++u) {
            const int row = row0 + (u >> 1), h = (u & 1) * 4 + hq;
#pragma unroll
            for (int i = 0; i < 8; ++i) { xq[u][i] = 0.f; xk[u][i] = 0.f; }
            if (row < mq && c < 12) unpack8u(*(const uint4*)(p.Qraw + (size_t)row * 768 + h * 96 + c * 8), xq[u]);
            if (c < 8) unpack8u(*(const uint4*)(p.KVraw + (size_t)row * 1024 + h * 128 + c * 8), xk[u]);
            else if (c < 12) unpack8u(*(const uint4*)(p.P + (size_t)row * PLD + ACOLS + 384 + (c - 8) * 8), xk[u]);
        }
#pragma unroll
        for (int u = 0; u < 4; ++u) {
            const int row = row0 + (u >> 1), h = (u & 1) * 4 + hq;
            const bool lat = row < NLAT; const int b = lat ? (row >> 11) : ((row - NLAT) >> 8); const int t = lat ? (row & 2047) : ((row - NLAT) & 255);
            if (row < mq) fin_vec(xq[u], c, t, lat, qg, 0.10206207261596577f * 1.4426950408889634f, p.Qraw + (size_t)row * 768 + h * 96);
            const int key = lat ? 256 + t : t;
            fin_vec(xk[u], c, t, lat, kg, 1.f, p.Kf + ((size_t)(b * 8 + h) * 2304 + key) * 96);
        }
    }
    bf16_t* T = (bf16_t*)ldsf; constexpr int TP = 520;
    for (int tile = cx.bid; tile < NT / 64; tile += cx.nblk) {
        const int row0 = tile * 64; const bool lat = row0 < NLAT; const int b = lat ? (row0 >> 11) : ((row0 - NLAT) >> 8); const int t0 = lat ? (row0 & 2047) : ((row0 - NLAT) & 255);
        const int key0 = lat ? 256 + t0 : t0;
        __syncthreads();
#pragma unroll
        for (int i = 0; i < 8; ++i) { const int ch = tid + 512 * i, kr = ch >> 6, cc = ch & 63, h = cc >> 3, part = cc & 7;
            *(uint4*)(T + kr * TP + h * 64 + part * 8) = *(const uint4*)(p.KVraw + (size_t)(row0 + kr) * 1024 + h * 128 + 64 + part * 8); }
        __syncthreads();
#pragma unroll
        for (int i = 0; i < 8; ++i) { const int ch = tid + 512 * i, hd = ch >> 3, kc = ch & 7;
            float v[8];
#pragma unroll
            for (int q = 0; q < 8; ++q) v[q] = bf2f(T[(kc * 8 + q) * TP + hd]);
            uint4 o; o.x = (unsigned)T[(kc * 8 + 0) * TP + hd] | ((unsigned)T[(kc * 8 + 1) * TP + hd] << 16); o.y = (unsigned)T[(kc * 8 + 2) * TP + hd] | ((unsigned)T[(kc * 8 + 3) * TP + hd] << 16);
            o.z = (unsigned)T[(kc * 8 + 4) * TP + hd] | ((unsigned)T[(kc * 8 + 5) * TP + hd] << 16); o.w = (unsigned)T[(kc * 8 + 6) * TP + hd] | ((unsigned)T[(kc * 8 + 7) * TP + hd] << 16);
            (void)v;
            *(uint4*)(p.Vt + ((size_t)(b * 8 + (hd >> 6)) * 64 + (hd & 63)) * 2304 + key0 + kc * 8) = o; }
    }
    __syncthreads();
}
DI void ph_mod_opt(const Ctx& cx, const Params& p, float* lds) {
    const int tid = cx.tid, wid = tid >> 6, lane = tid & 63;
    float* part = lds + 17 * 1024;
    for (int i = tid; i < 17 * 1024; i += NTHR) { const int jj = i >> 10, k = i & 1023; const float v = (jj < 16) ? p.c[jj * 1024 + k] : p.c_ctx[k]; lds[i] = siluf(v); }
    __syncthreads();
    for (int item = cx.bid; item < 4 * 96; item += cx.nblk) {
        const int l = item / 96, n = (item % 96) * 64 + lane;
        const float* w = p.mod_w + (size_t)l * 1024 * 6144 + n;
        float acc[17];
#pragma unroll
        for (int jj = 0; jj < 17; ++jj) acc[jj] = 0.f;
#pragma unroll 4
        for (int k = wid * 128; k < wid * 128 + 128; ++k) {
            const float wv = w[(size_t)k * 6144];
#pragma unroll
            for (int jj = 0; jj < 17; ++jj) acc[jj] += lds[jj * 1024 + k] * wv;
        }
#pragma unroll
        for (int jj = 0; jj < 17; ++jj) part[(wid * 17 + jj) * 64 + lane] = acc[jj];
        __syncthreads();
        for (int o = tid; o < 17 * 64; o += NTHR) { const int jj = o >> 6, ln = o & 63; float sacc = p.mod_b[l * 6144 + (item % 96) * 64 + ln];
#pragma unroll
            for (int q = 0; q < 8; ++q) sacc += part[(q * 17 + jj) * 64 + ln];
            p.mod[((size_t)l * 17 + jj) * 6144 + (item % 96) * 64 + ln] = sacc; }
        __syncthreads();
    }
}

DI void ph_norm2_router(const Ctx& cx, const Params& p, float* ldsg, int nrows, const float* gain, const float* modl, int layer) {
    LAS float* lds = (LAS float*)ldsg;
    const int tid = cx.tid, wid = tid >> 6, lane = tid & 63;
    LAS float* rw = lds; LAS float* red = lds + 16 * 1024 + wid * (32 * 64 + 64); LAS float* my = red + 32 * 64;
    LAS int* lcnt = (LAS int*)(lds + 16 * 1024 + 8 * (32 * 64 + 64)); LAS int* lbase = lcnt + 16; LAS int* rlist = lcnt + 32;
    for (int i = tid; i < 16 * 1024; i += NTHR) { const int e = i >> 10, col = i & 1023; rw[i] = p.router_w[col * 16 + e]; }
    if (tid < 16) lcnt[tid] = 0;
    __syncthreads();
    int nlist = 0;
    for (int pidx = cx.bid * 8 + wid; pidx < (nrows >> 1); pidx += cx.nblk * 8) {
        float4 xv[2][4];
#pragma unroll
        for (int r = 0; r < 2; ++r) { const int row = 2 * pidx + r; const float* xr = (row < NLAT) ? p.out + (size_t)row * 1024 : p.ctxs + (size_t)(row - NLAT) * 1024;
#pragma unroll
            for (int i = 0; i < 4; ++i) xv[r][i] = *(const float4*)(xr + i * 256 + lane * 4); }
        const int row0 = 2 * pidx; const int jj = (row0 < NLAT) ? (row0 >> 11) : 16;
        const float* shp = modl + (size_t)jj * 6144 + 3 * 1024; const float* scp = modl + (size_t)jj * 6144 + 4 * 1024;
        float4 hv[2][4];
#pragma unroll
        for (int r = 0; r < 2; ++r) {
            float ss = 0.f;
#pragma unroll
            for (int i = 0; i < 4; ++i) ss += xv[r][i].x * xv[r][i].x + xv[r][i].y * xv[r][i].y + xv[r][i].z * xv[r][i].z + xv[r][i].w * xv[r][i].w;
            ss = wave_sum(ss);
            const float rstd = rsqrtf(ss * (1.f / 1024.f) + 1e-6f);
#pragma unroll
            for (int i = 0; i < 4; ++i) {
                const int col = i * 256 + lane * 4;
                const float4 g = *(const float4*)(gain + col), sh = *(const float4*)(shp + col), sc = *(const float4*)(scp + col);
                hv[r][i].x = xv[r][i].x * rstd * g.x * (1.f + sc.x) + sh.x; hv[r][i].y = xv[r][i].y * rstd * g.y * (1.f + sc.y) + sh.y;
                hv[r][i].z = xv[r][i].z * rstd * g.z * (1.f + sc.z) + sh.z; hv[r][i].w = xv[r][i].w * rstd * g.w * (1.f + sc.w) + sh.w;
                uint2 u; u.x = att::pk(hv[r][i].x, hv[r][i].y); u.y = att::pk(hv[r][i].z, hv[r][i].w);
                *(uint2*)(p.H + (size_t)(row0 + r) * 1024 + col) = u;
            }
        }
#pragma unroll
        for (int e = 0; e < 16; ++e) {
            float a0 = 0.f, a1 = 0.f;
#pragma unroll
            for (int i = 0; i < 4; ++i) { const mm::f32x4 w = *(const LAS mm::f32x4*)(rw + e * 1024 + i * 256 + lane * 4);
                a0 += hv[0][i].x * w[0] + hv[0][i].y * w[1] + hv[0][i].z * w[2] + hv[0][i].w * w[3]; a1 += hv[1][i].x * w[0] + hv[1][i].y * w[1] + hv[1][i].z * w[2] + hv[1][i].w * w[3]; }
            red[e * 64 + lane] = a0; red[(16 + e) * 64 + lane] = a1;
        }
        __builtin_amdgcn_wave_barrier();
        {
            const int r = lane >> 5, e = (lane >> 1) & 15, half = lane & 1; const LAS float* src = red + (r * 16 + e) * 64 + half * 32;
            float sacc = 0.f;
#pragma unroll
            for (int q = 0; q < 8; ++q) { const mm::f32x4 v = *(const LAS mm::f32x4*)(src + q * 4); sacc += (v[0] + v[1]) + (v[2] + v[3]); }
            sacc += dpp_f<0xB1>(sacc);
            const float sg = 1.f / (1.f + __expf(-sacc));
            if (half == 0) { my[r * 32 + e] = sg; my[r * 32 + 16 + e] = sg + p.router_b[e]; }
        }
        __builtin_amdgcn_wave_barrier();
        if ((lane & 31) == 0) {
            const int r = lane >> 5; const LAS float* m = my + r * 32;
            float best = -3.0e38f; int be1 = 0, be2 = 1;
#pragma unroll
            for (int g = 0; g < 4; ++g) {
                const mm::f32x4 v = *(const LAS mm::f32x4*)(m + 16 + 4 * g);
                int i1 = 0; float m1 = v[0];
                if (v[1] > m1) { m1 = v[1]; i1 = 1; } if (v[2] > m1) { m1 = v[2]; i1 = 2; } if (v[3] > m1) { m1 = v[3]; i1 = 3; }
                int i2 = -1; float m2 = -3.0e38f;
                if (i1 != 0 && v[0] > m2) { m2 = v[0]; i2 = 0; } if (i1 != 1 && v[1] > m2) { m2 = v[1]; i2 = 1; }
                if (i1 != 2 && v[2] > m2) { m2 = v[2]; i2 = 2; } if (i1 != 3 && v[3] > m2) { m2 = v[3]; i2 = 3; }
                const float gs = m1 + m2;
                if (gs > best) { best = gs; be1 = 4 * g + i1; be2 = 4 * g + i2; }
            }
            const float bs1 = m[be1], bs2 = m[be2]; const float inv = 1.f / (bs1 + bs2);
            const int p1 = atomicAdd((int*)&lcnt[be1], 1), p2 = atomicAdd((int*)&lcnt[be2], 1);
            LAS int* ent = rlist + (wid * 24 + nlist * 2 + r) * 6;
            const int row = row0 + r;
            ent[0] = row; ent[1] = be1 | (be2 << 8); ent[2] = p1; ent[3] = p2; ent[4] = __float_as_int(bs1 * inv); ent[5] = __float_as_int(bs2 * inv);
        }
        ++nlist;
        __builtin_amdgcn_wave_barrier();
    }
    __syncthreads();
    if (tid < 16) lbase[tid] = atomicAdd(p.cnt + (layer * 16 + tid) * 64, lcnt[tid]);
    __syncthreads();
    for (int k = lane; k < 2 * nlist; k += 64) {
        const LAS int* ent = rlist + (wid * 24 + k) * 6; const int row = ent[0], be1 = ent[1] & 255, be2 = ent[1] >> 8;
        const size_t s1 = (size_t)be1 * NT + lbase[be1] + ent[2], s2 = (size_t)be2 * NT + lbase[be2] + ent[3];
        p.slot[s1] = row * 2; p.slot[s2] = row * 2 + 1; p.slotw[s1] = __int_as_float(ent[4]); p.slotw[s2] = __int_as_float(ent[5]);
    }
    __syncthreads();
}

DI void ph_prepBLR_opt(const Ctx& cx, const Params& p, int j) {
    const int tid = cx.tid, wid = tid >> 6, lane = tid & 63;
    const float4 gq = *(const float4*)(p.b_q_norm + j * 256 + lane * 4); const float2 gk = *(const float2*)(p.b_kv_norm + j * 128 + lane * 2);
    constexpr int U = 8;
    for (int row0 = (cx.bid * 8 + wid) * U; row0 < NT; row0 += cx.nblk * 8 * U) {
        uint2 uq[U]; unsigned ukv[U];
#pragma unroll
        for (int u = 0; u < U; ++u) { const bf16_t* pr = p.P + (size_t)(row0 + u) * PLD + ACOLS; uq[u] = *(const uint2*)(pr + lane * 4); ukv[u] = *(const unsigned*)(pr + 256 + lane * 2); }
#pragma unroll
        for (int u = 0; u < U; ++u) {
            const float q0 = bflo(uq[u].x), q1 = bfhi(uq[u].x), q2 = bflo(uq[u].y), q3 = bfhi(uq[u].y), k0 = bflo(ukv[u]), k1 = bfhi(ukv[u]);
            const float sq = wave_sum(q0 * q0 + q1 * q1 + q2 * q2 + q3 * q3), sk = wave_sum(k0 * k0 + k1 * k1);
            const float rq = rsqrtf(sq * (1.f / 256.f) + 1e-6f), rk = rsqrtf(sk * (1.f / 128.f) + 1e-6f);
            uint2 o; o.x = att::pk(q0 * rq * gq.x, q1 * rq * gq.y); o.y = att::pk(q2 * rq * gq.z, q3 * rq * gq.w);
            bf16_t* qn = p.QN + (size_t)(row0 + u) * 512;
            *(uint2*)(qn + lane * 4) = o; *(unsigned*)(qn + 256 + lane * 2) = att::pk(k0 * rk * gk.x, k1 * rk * gk.y); *(unsigned*)(qn + 384 + lane * 2) = 0u;
        }
    }
    const int gtid = cx.bid * NTHR + tid, gsz = cx.nblk * NTHR;
    for (int idx = gtid; idx < NT * 48; idx += gsz) {
        const int row = idx / 48, cg = idx % 48, col0 = cg * 8;
        const bool lat = row < NLAT; const int t = lat ? (row & 2047) : ((row - NLAT) & 255); const int T = lat ? 2048 : 256;
        float mu[8]; ld8f(p.a_mu + j * ACOLS + 1536 + col0, mu);
        float v[8]; shift8(p.P, row, t, T, 1536 + col0, mu, v);
        if (cg < 16) {
#pragma unroll
            for (int i = 0; i < 8; ++i) { const float e = __expf(2.f * v[i]); v[i] = 1.f - 2.f * __builtin_amdgcn_rcpf(e + 1.f); }
        } else if (cg >= 32) {
#pragma unroll
            for (int i = 0; i < 8; ++i) v[i] = __builtin_amdgcn_rcpf(1.f + __expf(-v[i]));
        }
        *(uint4*)(p.LR + (size_t)row * 384 + col0) = pack8u(v);
    }
}

template <int PH>
DI void run_phase(const Params& p, float* lds, int L) {
    const Ctx cx = make_ctx();
    const int j = L >> 1;
    const float* modl = p.mod + (size_t)L * 17 * 6144;
    const float* modprev = p.mod + (size_t)(L > 0 ? L - 1 : 0) * 17 * 6144;
    const bool last = (L == 3);
    const int rows_layer = (L == 3) ? NLAT : NT;
    const int rows_out = (L >= 2) ? NLAT : NT;
    const float* xin_lat = (L == 0) ? p.x : p.out; const float* xin_ctx = (L == 0) ? p.ctx : p.ctxs;
    if constexpr (PH == 0) { if (OPT >= 7) { ph_mod_opt(cx, p, lds); for (int i = cx.bid * NTHR + cx.tid; i < 1024; i += cx.nblk * NTHR) p.H[(size_t)NT * 1024 + i] = 0; } else ph_prologue(cx, p, lds); ph_prep_weights(cx, p, lds); }
    if constexpr (PH == 1) {
        if (OPT >= 4) ph_prep_moe(cx, p, lds, L);
        if (L == 0) ph_norm<false, true, false>(cx, p, lds, rows_layer, xin_lat, xin_ctx, p.norm1_g + L * 1024, modl, 0, 1, modprev, L);
        else ph_norm<true, true, false>(cx, p, lds, rows_layer, xin_lat, xin_ctx, p.norm1_g + L * 1024, modl, 0, 1, modprev, L);
    }
    if constexpr (PH == 2) { if (OPT >= 1) ph_win_mm(cx, p, lds, j); else ph_win(cx, p, lds, j); }
    if constexpr (PH == 3) { if (OPT >= 10) ph_prepBLR_opt(cx, p, j); else ph_prepB(cx, p, j); }
    if constexpr (PH == 4) { if (OPT >= 2) ph_qkvup_mm(cx, p, lds, j, rows_out); else ph_qkvup(cx, p, lds, j, rows_out); }
    if constexpr (PH == 5) { if (OPT >= 7) ph_finalize_opt(cx, p, lds, j, rows_out); else ph_finalize(cx, p, j, rows_out); }
    if constexpr (PH == 6) { if (OPT >= 5) ph_attn_mm(cx, p, lds, rows_out == NT); else ph_attn(cx, p, rows_out == NT); }
    if constexpr (PH == 7) { if (OPT < 10) ph_prepLR(cx, p, j); }
    if constexpr (PH == 8) { if (OPT >= 2) ph_wag_mm(cx, p, lds, j); else ph_wag(cx, p, lds, j); }
    if constexpr (PH == 9) { if (OPT >= 9) ph_scan_chunk<0>(cx, p, lds, j); else if (OPT >= 6) ph_scan_opt<0>(cx, p, lds, j); else ph_scan(cx, p, lds, j); }
    if constexpr (PH == 19) ph_scan_chunk<PROBE_SCAN>(cx, p, lds, j);
    if constexpr (PH == 10) { if (OPT >= 7) ph_post_opt(cx, p, j, rows_out); else ph_post(cx, p, j, rows_out); }
    if constexpr (PH == 11) { if (OPT >= 1) ph_wout_mm(cx, p, lds, p.H, p.WoutT + (size_t)j * 1024 * 1024, rows_out, xin_lat, xin_ctx, modl); else ph_wout(cx, p, lds, p.H, p.w_out_even + (size_t)j * 1024 * 1024, rows_out, xin_lat, xin_ctx, modl); }
    if constexpr (PH == 12) { if (OPT >= 3) ph_f1_mm(cx, p, lds, j, !last); else ph_chdft(cx, p, lds, rows_layer); }
    if constexpr (PH == 13) { if (OPT >= 3) ph_f2_mm(cx, p, lds, !last, xin_lat, xin_ctx, modl); else ph_posdft(cx, p, lds, !last); }
    if constexpr (PH == 14) { if (OPT < 3) ph_wout(cx, p, lds, p.F, p.w_out_fourier + (size_t)j * 1024 * 1024, rows_out, xin_lat, xin_ctx, modl); }
    if constexpr (PH == 15) { if (OPT >= 8) ph_norm2_router(cx, p, lds, rows_out, p.norm2_g + L * 1024, modl, L); else ph_norm<false, true, true>(cx, p, lds, rows_out, p.out, p.ctxs, p.norm2_g + L * 1024, modl, 3, 4, modprev, L); }
    if constexpr (PH == 16) { if (OPT >= 4) ph_moe_up_mm(cx, p, lds, L, rows_out); else ph_moe_up(cx, p, lds, L, rows_out); }
    if constexpr (PH == 17) { if (OPT >= 4) ph_moe_down_mm(cx, p, lds, L, rows_out); else ph_moe_down(cx, p, lds, L, rows_out); }
    if constexpr (PH == 18) ph_norm<true, false, false>(cx, p, lds, NLAT, p.out, p.ctxs, p.norm1_g, p.mod + (size_t)3 * 17 * 6144, 0, 1, p.mod + (size_t)3 * 17 * 6144, 3);
}

template <int PH>
__global__ void __launch_bounds__(NTHR, 2) k_phase(Params p, int L) {
    extern __shared__ __attribute__((aligned(16))) float shm[];
    run_phase<PH>(p, shm, L);
}

#if ONE_LAUNCH
constexpr int PARAM_WORDS = (int)(sizeof(Params) / 4);
DI Params load_params(const unsigned* lp) {
    Params q; unsigned* d = (unsigned*)&q;
#pragma unroll
    for (int i = 0; i < PARAM_WORDS; ++i) d[i] = (unsigned)__builtin_amdgcn_readfirstlane((int)lp[i]);
    void** pp = (void**)&q;
#pragma unroll
    for (int i = 0; i < PARAM_WORDS / 2; ++i) pp[i] = (void*)(__attribute__((address_space(1))) void*)pp[i];
    return q;
}
#ifndef PROBE_MASK
#define PROBE_MASK 0u
#endif

#define PHASE(PH, L) do { unsigned long long t0_ = 0; if (PROBE_MASK & (1u << (PH))) t0_ = wall_clock64(); \
    { run_phase<PH>(p, lds, (L)); } xcd_barrier(bar); \
    if (PROBE_MASK & (1u << (PH))) tacc += wall_clock64() - t0_; } while (0)
__global__ void __launch_bounds__(NTHR, 2) k_mega(Params p) {
    extern __shared__ __attribute__((aligned(16))) float shm[];
    unsigned* lp = (unsigned*)(shm + 4);
    float* lds = shm + 4 + ((PARAM_WORDS + 3) & ~3);
    if (threadIdx.x == 0) { shm[0] = 0.f; shm[1] = 0.f; shm[2] = 0.f; shm[3] = 0.f; }
    if (threadIdx.x < PARAM_WORDS) lp[threadIdx.x] = ((const unsigned*)&p)[threadIdx.x];
    __syncthreads();
    XcdBarrier bar; { const Params q_ = load_params(lp); bar = xcd_barrier_post(q_.bar, (volatile LAS unsigned*)shm); }
    unsigned long long tacc = 0;
    PHASE(0, 0);
#define LAYER_EVEN(L) PHASE(1, L); PHASE(2, L); PHASE(3, L); PHASE(4, L); PHASE(5, L); PHASE(6, L); if (OPT < 10) { PHASE(7, L); } PHASE(8, L); PHASE(9, L); if (PROBE_SCAN) { PHASE(19, L); } PHASE(10, L); PHASE(11, L); PHASE(15, L); PHASE(16, L); PHASE(17, L)
#define LAYER_ODD(L) PHASE(1, L); PHASE(12, L); PHASE(13, L); PHASE(14, L); PHASE(15, L); PHASE(16, L); PHASE(17, L)
    LAYER_EVEN(0); LAYER_ODD(1); LAYER_EVEN(2); LAYER_ODD(3);
    { unsigned long long t0_ = 0; if (PROBE_MASK & (1u << 18)) t0_ = wall_clock64(); run_phase<18>(p, lds, 3);
      if (PROBE_MASK & (1u << 18)) { xcd_barrier(bar); tacc += wall_clock64() - t0_; } }
    if (PROBE_MASK != 0u && blockIdx.x == 0 && threadIdx.x == 0) {
        const unsigned long long t1 = wall_clock64(); while (wall_clock64() - t1 < 20ull * tacc) __builtin_amdgcn_s_sleep(8); }
}
#endif

static inline size_t al256(size_t v) { return (v + 255) & ~(size_t)255; }
constexpr size_t LDS_BYTES = 148 * 1024;

template <int PH> static void launch_phase(const Params& p, int L, int grid, hipStream_t s) {
    static bool attr = false;
    if (!attr) { hipFuncSetAttribute((const void*)k_phase<PH>, hipFuncAttributeMaxDynamicSharedMemorySize, (int)LDS_BYTES); attr = true; }
    hipLaunchKernelGGL(k_phase<PH>, dim3(grid), dim3(NTHR), LDS_BYTES, s, p, L);
}

extern "C" void kernel_launch(void* const* d_in, const int* in_sizes, int n_in, void* d_out, int out_size, void* d_ws, size_t ws_size, hipStream_t stream) {
    (void)in_sizes; (void)n_in; (void)out_size;
    Params p{};
    const float** ip = (const float**)&p.x;
    for (int i = 0; i < 36; ++i) ip[i] = (const float*)d_in[i];
    p.out = (float*)d_out;
    char* w = (char*)d_ws; size_t o = 0;
    auto take = [&](size_t bytes) { char* r = w + o; o += al256(bytes); return r; };
    p.bar = (unsigned*)take(XCD_BAR_WORDS * 4);
    p.cnt = (int*)take(64 * 64 * 4);
    const size_t zero_bytes = o;
    p.mod = (float*)take((size_t)4 * 17 * 6144 * 4);
    p.ctxs = (float*)take((size_t)NCTX * 1024 * 4);
    p.dftl = (bf16_t*)take((size_t)2048 * 4096 * 2);
    p.dftc = (bf16_t*)take((size_t)256 * 512 * 2);
    p.slot = (int*)take((size_t)16 * NT * 4);
    p.tokw = (float*)take((size_t)NT * 2 * 4);
    p.slotw = (float*)take((size_t)16 * NT * 4);
    p.H = (bf16_t*)take((size_t)(NT + 1) * 1024 * 2);
    char* big = w + o;
    p.P = (bf16_t*)take((size_t)NT * PLD * 2);
    char* r1 = w + o;
    p.WAG = (bf16_t*)take((size_t)NT * WLD * 2);
    p.YF = (bf16_t*)take((size_t)NT * 512 * 2);
    p.YB = (bf16_t*)take((size_t)NT * 512 * 2);
    p.LR = (bf16_t*)take((size_t)NT * 384 * 2);
    p.WinT = (bf16_t*)take((size_t)2 * 2560 * 1024 * 2); p.WqT = (bf16_t*)take((size_t)2 * 768 * 256 * 2); p.WkvT = (bf16_t*)take((size_t)2 * 1024 * 256 * 2);
    p.WlrT = (bf16_t*)take((size_t)2 * 2560 * 384 * 2); p.WoutT = (bf16_t*)take((size_t)2 * 1024 * 1024 * 2); p.A1 = (bf16_t*)take((size_t)2 * 2048 * 1024 * 2);
    p.A2 = (bf16_t*)take((size_t)2048 * 4096 * 2); p.A2c = (bf16_t*)take((size_t)256 * 512 * 2);
    p.WguT = (bf16_t*)take((size_t)17 * 1024 * 1024 * 2); p.WdT = (bf16_t*)take((size_t)17 * 1024 * 512 * 2);
    const size_t total = o;
    { size_t q = 0; auto t2 = [&](size_t bytes) { char* r = r1 + q; q += al256(bytes); return r; };
      p.QN = (bf16_t*)t2((size_t)NT * 512 * 2); p.Qraw = (bf16_t*)t2((size_t)NT * 768 * 2); p.KVraw = (bf16_t*)t2((size_t)NT * 1024 * 2);
      p.Kf = (bf16_t*)t2((size_t)NB * 8 * 2304 * 96 * 2); p.Vt = (bf16_t*)t2((size_t)NB * 8 * 64 * 2304 * 2); }
    { size_t q = 0; auto t3 = [&](size_t bytes) { char* r = big + q; q += al256(bytes); return r; };
      p.ACT = (bf16_t*)t3((size_t)3 * NT * 512 * 2); p.Y = (bf16_t*)t3((size_t)3 * NT * 1024 * 2); }
    { size_t q = 0; auto t4 = [&](size_t bytes) { char* r = big + q; q += al256(bytes); return r; };
      p.G = (float*)t4((size_t)NT * 2048 * 4); p.F = (bf16_t*)t4((size_t)NT * 1024 * 2); }
    { size_t q = 0; auto t5 = [&](size_t bytes) { char* r = big + q; q += al256(bytes); return r; };
      p.ZT = (bf16_t*)t5((size_t)16 * 1024 * 4096 * 2); p.ZTC = (bf16_t*)t5((size_t)16 * 1024 * 512 * 2); }
    if (total > ws_size) { fprintf(stderr, "workspace too small: need %zu have %zu\n", total, ws_size); return; }
    static int grid = 0;
    if (!grid) { int dev = 0, cus = 0; hipGetDevice(&dev); hipDeviceGetAttribute(&cus, hipDeviceAttributeMultiprocessorCount, dev); grid = cus > 0 ? cus : 256; if (grid > 256) grid = 256; }
    hipMemsetAsync(d_ws, 0, zero_bytes, stream);
#if ONE_LAUNCH
    static bool attr = false;
    if (!attr) { hipFuncSetAttribute((const void*)k_mega, hipFuncAttributeMaxDynamicSharedMemorySize, (int)LDS_BYTES); attr = true; }
    hipLaunchKernelGGL(k_mega, dim3(grid), dim3(NTHR), LDS_BYTES, stream, p);
#else
    launch_phase<0>(p, 0, grid, stream);
    for (int L = 0; L < 4; ++L) {
        launch_phase<1>(p, L, grid, stream);
        if ((L & 1) == 0) {
            launch_phase<2>(p, L, grid, stream); launch_phase<3>(p, L, grid, stream); launch_phase<4>(p, L, grid, stream); launch_phase<5>(p, L, grid, stream);
            launch_phase<6>(p, L, grid, stream); launch_phase<7>(p, L, grid, stream); launch_phase<8>(p, L, grid, stream); launch_phase<9>(p, L, grid, stream);
            launch_phase<10>(p, L, grid, stream); launch_phase<11>(p, L, grid, stream);
        } else {
            launch_phase<12>(p, L, grid, stream); launch_phase<13>(p, L, grid, stream); launch_phase<14>(p, L, grid, stream);
        }
        launch_phase<15>(p, L, grid, stream); launch_phase<16>(p, L, grid, stream); launch_phase<17>(p, L, grid, stream);
    }
    launch_phase<18>(p, 3, grid, stream);
#endif
}
```

```cpp
#include <hip/hip_runtime.h>
#include <cstdio>
#include <cstdint>

#ifndef ONE_LAUNCH
#define ONE_LAUNCH 1
#endif
#ifndef PROBE_SCAN
#define PROBE_SCAN 0
#endif
#ifndef OPT
#define OPT 11
#endif

typedef unsigned short bf16_t;
#define DI __device__ __forceinline__
#define LAS __attribute__((address_space(3)))

constexpr int D = 1024, NB = 16, SEQ = 2048, CTXL = 256, NLAT = NB * SEQ, NCTX = NB * CTXL, NT = NLAT + NCTX;
constexpr int PLD = 2560;
constexpr int INC = 2336, ACOLS = 1920;
constexpr int WLD = 2560;
constexpr int NTHR = 512;

#define XB_TMO      128
#define XB_XCNT(j)  (256  + 64 * (j))
#define XB_XSUB(j)  (1280 + 64 * (j))
#define XB_XGEN(j)  (2304 + 64 * (j))
#define XB_TOP      3328
#define XB_TOPGEN   3392
#define XCD_BAR_WORDS 3456
#define XB_SPIN_CAP (1u << 24)
DI unsigned xb_ld(unsigned* p)              { return __hip_atomic_load(p, __ATOMIC_RELAXED, __HIP_MEMORY_SCOPE_AGENT); }
DI unsigned xb_add(unsigned* p, unsigned v) { return __hip_atomic_fetch_add(p, v, __ATOMIC_RELAXED, __HIP_MEMORY_SCOPE_AGENT); }
DI unsigned xb_xcc_id() { return (unsigned)__builtin_amdgcn_s_getreg((3 << 11) | 20) & 0xFu; }
#define XB_SPIN(cond, bar) do { unsigned _sp = 0; while (cond) { __builtin_amdgcn_s_sleep(1); \
    if ((++_sp & 255u) == 0u) { if (xb_ld(&(bar)[XB_TMO])) break; if (_sp > XB_SPIN_CAP) { atomicAdd(&(bar)[XB_TMO], 1u); break; } } } } while (0)
struct XcdBarrier { unsigned* bar; unsigned x; volatile LAS unsigned* st; };
DI XcdBarrier xcd_barrier_post(unsigned* bar, volatile LAS unsigned* st) {
    XcdBarrier b; b.bar = bar; b.x = xb_xcc_id(); b.st = st;
    if (threadIdx.x == 0) (void)xb_add(&bar[XB_XCNT(b.x)], 1u);
    return b;
}
DI void xcd_barrier_complete(unsigned* bar, unsigned x, unsigned& nloc, unsigned& nx) {
    const unsigned G = gridDim.x * gridDim.y * gridDim.z;
    unsigned sum, cnt, mine, sp = 0u;
    for (;;) {
        sum = 0u; cnt = 0u; mine = 0u;
#pragma unroll
        for (unsigned j = 0; j < 16; ++j) { const unsigned c = xb_ld(&bar[XB_XCNT(j)]); sum += c; cnt += (c > 0u) ? 1u : 0u; mine = (j == x) ? c : mine; }
        if (sum == G) break;
        __builtin_amdgcn_s_sleep(1);
        if ((++sp & 255u) == 0u) { if (xb_ld(&bar[XB_TMO])) break; if (sp > XB_SPIN_CAP) { atomicAdd(&bar[XB_TMO], 1u); break; } }
    }
    nloc = mine > 0u ? mine : 1u; nx = cnt > 0u ? cnt : 1u;
}
DI void xcd_barrier(const XcdBarrier& b) {
    asm volatile("s_waitcnt vmcnt(0)" ::: "memory");
    __syncthreads();
    if (threadIdx.x == 0) {
        unsigned* bar = b.bar;
        __builtin_amdgcn_s_waitcnt(0);
        unsigned nloc = b.st[0], nx = b.st[1];
        if (nloc == 0u) { xcd_barrier_complete(bar, b.x, nloc, nx); b.st[0] = nloc; b.st[1] = nx; }
        const unsigned old = xb_add(&bar[XB_XSUB(b.x)], 1u);
        const unsigned gen = old / nloc;
        if (old + 1u == (gen + 1u) * nloc) {
            __builtin_amdgcn_fence(__ATOMIC_RELEASE, "agent");
            asm volatile("s_waitcnt vmcnt(0)" ::: "memory");
            const unsigned og = xb_add(&bar[XB_TOP], 1u);
            const unsigned tg = og / nx;
            if (og + 1u == (tg + 1u) * nx) xb_add(&bar[XB_TOPGEN], 1u);
            else XB_SPIN(xb_ld(&bar[XB_TOPGEN]) == tg, bar);
            __builtin_amdgcn_fence(__ATOMIC_ACQUIRE, "agent");
            xb_add(&bar[XB_XGEN(b.x)], 1u);
            asm volatile("s_waitcnt vmcnt(0)" ::: "memory");
        } else {
            XB_SPIN(xb_ld(&bar[XB_XGEN(b.x)]) == gen, bar);
            __builtin_amdgcn_fence(__ATOMIC_ACQUIRE, "agent");
            asm volatile("s_waitcnt vmcnt(0)" ::: "memory");
        }
    }
    __syncthreads();
}

struct Params {
    const float *x, *c, *ctx, *c_ctx, *norm1_g, *norm2_g, *mod_w, *mod_b, *w_in, *a_mu, *a_w0, *a_w2, *a_a0, *a_a2, *a_g2,
                *a_k_k, *a_k_a, *a_r_k, *a_ln_w, *a_ln_b, *b_q_norm, *b_w_q_up, *b_kv_norm, *b_w_kv_up, *b_q_gain, *b_k_gain,
                *w_out_even, *w_out_fourier, *router_w, *router_b, *moe_w_gate, *moe_w_up, *moe_w_down, *sh_gate, *sh_up, *sh_down;
    float* out;
    unsigned* bar; int* cnt; float* mod; float* ctxs; bf16_t* dftl; bf16_t* dftc; int* slot; float* tokw; float* slotw;
    bf16_t *H, *P, *LR, *WAG, *YF, *YB, *QN, *Qraw, *KVraw, *Kf, *Vt, *ACT, *Y, *F; float* G;
    bf16_t *WinT, *WqT, *WkvT, *WlrT, *WoutT, *A1, *A2, *A2c, *WguT, *WdT, *ZT, *ZTC;
    bf16_t *xs, *cs, *xs3;
};

struct Ctx { int tid, bid, nblk; };
DI Ctx make_ctx() { Ctx c; c.tid = threadIdx.x; c.bid = blockIdx.x; c.nblk = gridDim.x; asm volatile("" : "+v"(c.tid), "+s"(c.bid), "+s"(c.nblk)); return c; }

DI bf16_t f2bf(float f) { unsigned u = __float_as_uint(f); u += 0x7fffu + ((u >> 16) & 1u); return (bf16_t)(u >> 16); }
DI float bf2f(bf16_t b) { return __uint_as_float(((unsigned)b) << 16); }
DI float bflo(unsigned u) { return __uint_as_float(u << 16); }
DI float bfhi(unsigned u) { return __uint_as_float(u & 0xffff0000u); }
DI unsigned pack2(float lo, float hi) { return (unsigned)f2bf(lo) | ((unsigned)f2bf(hi) << 16); }
typedef __bf16 g_bf16x2_t __attribute__((ext_vector_type(2)));
typedef float g_f32x2_t __attribute__((ext_vector_type(2)));
DI unsigned att_pk(float a, float b) { g_f32x2_t f = {a, b}; g_bf16x2_t h = __builtin_convertvector(f, g_bf16x2_t); return __builtin_bit_cast(unsigned, h); }
DI float siluf(float v) { return v / (1.f + expf(-v)); }
DI float sigm(float v) { return 1.f / (1.f + expf(-v)); }
template <int CTRL> DI float dpp_f(float v) { return __builtin_bit_cast(float, __builtin_amdgcn_update_dpp(0, __builtin_bit_cast(int, v), CTRL, 0xf, 0xf, true)); }
DI float wave_sum(float v) {
    v += dpp_f<0xB1>(v); v += dpp_f<0x4E>(v); v += dpp_f<0x141>(v); v += dpp_f<0x140>(v);
    const int x = __builtin_bit_cast(int, v);
    const float a = __builtin_bit_cast(float, __builtin_amdgcn_readlane(x, 0)), b = __builtin_bit_cast(float, __builtin_amdgcn_readlane(x, 16));
    const float c = __builtin_bit_cast(float, __builtin_amdgcn_readlane(x, 32)), d = __builtin_bit_cast(float, __builtin_amdgcn_readlane(x, 48));
    return (a + b) + (c + d);
}

template <bool DUAL, class AFn, class BFn, class BFn2, class Epi>
DI void ngemm(const Ctx& cx, float* lds, int nbz, int M, int N, int K, AFn afn, BFn bfn, BFn2 bfn2, Epi epi) {
    float* As = lds; float* Bs = lds + 16 * 132; float* B2s = Bs + 16 * 128;
    const int tid = cx.tid, ty = tid >> 5, tx = tid & 31;
    const int tm = (M + 127) / 128, tn = (N + 127) / 128, ntile = tm * tn * nbz;
    const int arow = tid >> 2, akc = (tid & 3) * 4, bk = tid >> 5, bnn = (tid & 31) * 4;
    for (int tile = cx.bid; tile < ntile; tile += cx.nblk) {
        const int bz = tile / (tm * tn), rem = tile % (tm * tn), bm = rem / tn, bn = rem % tn;
        float acc[8][4], acc2[8][4];
#pragma unroll
        for (int i = 0; i < 8; ++i)
#pragma unroll
            for (int j = 0; j < 4; ++j) { acc[i][j] = 0.f; acc2[i][j] = 0.f; }
        const int m_a = bm * 128 + arow;
        const bf16_t* aptr = (m_a < M) ? afn(bz, m_a) : nullptr;
        const int nB = bn * 128 + bnn;
        for (int k0 = 0; k0 < K; k0 += 16) {
            float av0 = 0.f, av1 = 0.f, av2 = 0.f, av3 = 0.f;
            if (aptr) { const uint2 u = *(const uint2*)(aptr + k0 + akc); av0 = bflo(u.x); av1 = bfhi(u.x); av2 = bflo(u.y); av3 = bfhi(u.y); }
            float4 bv = make_float4(0.f, 0.f, 0.f, 0.f), bv2 = make_float4(0.f, 0.f, 0.f, 0.f);
            if (nB < N) { bv = *(const float4*)(bfn(bz, k0 + bk) + nB); if (DUAL) bv2 = *(const float4*)(bfn2(bz, k0 + bk) + nB); }
            __syncthreads();
            As[(akc + 0) * 132 + arow] = av0; As[(akc + 1) * 132 + arow] = av1; As[(akc + 2) * 132 + arow] = av2; As[(akc + 3) * 132 + arow] = av3;
            *(float4*)&Bs[bk * 128 + bnn] = bv;
            if (DUAL) *(float4*)&B2s[bk * 128 + bnn] = bv2;
            __syncthreads();
#pragma unroll 4
            for (int kk = 0; kk < 16; ++kk) {
                const float4 a0 = *(const float4*)&As[kk * 132 + ty * 8], a1 = *(const float4*)&As[kk * 132 + ty * 8 + 4];
                const float4 b = *(const float4*)&Bs[kk * 128 + tx * 4];
                const float a[8] = {a0.x, a0.y, a0.z, a0.w, a1.x, a1.y, a1.z, a1.w};
                const float bb[4] = {b.x, b.y, b.z, b.w};
#pragma unroll
                for (int i = 0; i < 8; ++i)
#pragma unroll
                    for (int j = 0; j < 4; ++j) acc[i][j] += a[i] * bb[j];
                if (DUAL) {
                    const float4 b2 = *(const float4*)&B2s[kk * 128 + tx * 4];
                    const float cc[4] = {b2.x, b2.y, b2.z, b2.w};
#pragma unroll
                    for (int i = 0; i < 8; ++i)
#pragma unroll
                        for (int j = 0; j < 4; ++j) acc2[i][j] += a[i] * cc[j];
                }
            }
        }
#pragma unroll
        for (int i = 0; i < 8; ++i) {
            const int m = bm * 128 + ty * 8 + i;
            if (m < M) {
#pragma unroll
                for (int j = 0; j < 4; ++j) { const int n = bn * 128 + tx * 4 + j; if (n < N) epi(bz, m, n, acc[i][j], acc2[i][j]); }
            }
        }
    }
    __syncthreads();
}

DI void ph_prologue(const Ctx& cx, const Params& p, float* lds) {
    const int tid = cx.tid, gtid = cx.bid * NTHR + tid, gsz = cx.nblk * NTHR;
    for (int i = tid; i < 17 * 1024; i += NTHR) { const int j = i >> 10, k = i & 1023; const float v = (j < 16) ? p.c[j * 1024 + k] : p.c_ctx[k]; lds[i] = siluf(v); }
    __syncthreads();
    for (int idx = gtid; idx < 4 * 6144; idx += gsz) {
        const int l = idx / 6144, n = idx % 6144;
        const float* w = p.mod_w + (size_t)l * 1024 * 6144 + n;
        float acc[17]; const float b0 = p.mod_b[l * 6144 + n];
#pragma unroll
        for (int j = 0; j < 17; ++j) acc[j] = b0;
        for (int k = 0; k < 1024; ++k) {
            const float wv = w[(size_t)k * 6144];
#pragma unroll
            for (int j = 0; j < 17; ++j) acc[j] += lds[j * 1024 + k] * wv;
        }
#pragma unroll
        for (int j = 0; j < 17; ++j) p.mod[((size_t)l * 17 + j) * 6144 + n] = acc[j];
    }
    for (int i = gtid; i < 2048 * 4096; i += gsz) {
        const int f = i >> 12, k = i & 4095, t = k & 2047, m = (f * t) & 2047; const float a = (float)m * (1.f / 1024.f);
        p.dftl[i] = f2bf((k < 2048) ? cospif(a) : sinpif(a));
    }
    for (int i = gtid; i < 256 * 512; i += gsz) {
        const int f = i >> 9, k = i & 511, t = k & 255, m = (f * t) & 255; const float a = (float)m * (1.f / 128.f);
        p.dftc[i] = f2bf((k < 256) ? cospif(a) : sinpif(a));
    }
    for (int i = gtid; i < 1024; i += gsz) p.H[(size_t)NT * 1024 + i] = 0;
    __syncthreads();
}

DI float pick4(float a0, float a1, float a2, float a3, int i) { return i == 0 ? a0 : (i == 1 ? a1 : (i == 2 ? a2 : a3)); }
template <bool COMBINE, bool NORM, bool ROUTER>
DI void ph_norm(const Ctx& cx, const Params& p, float* lds, int nrows, const float* xin_lat, const float* xin_ctx, const float* gain, const float* modl, int sh_idx, int sc_idx,
                const float* modprev, int layer) {
    const int tid = cx.tid, wid = tid >> 6, lane = tid & 63;
    float* rw = lds;
    float* scr = lds + 16 * 1024;
    int* lcnt = (int*)(lds + 16 * 1024 + 256); int* lbase = lcnt + 16; int* rlist = lcnt + 32;
    int nlist = 0;
    if (ROUTER) {
        for (int i = tid; i < 16 * 1024; i += NTHR) { const int e = i >> 10, col = i & 1023; rw[i] = p.router_w[col * 16 + e]; }
        if (tid < 16) lcnt[tid] = 0;
        __syncthreads();
    }
    for (int row = cx.bid * 8 + wid; row < nrows; row += cx.nblk * 8) {
        const bool lat = row < NLAT; const int j = lat ? (row >> 11) : 16;
        const float* xr = lat ? xin_lat + (size_t)row * 1024 : xin_ctx + (size_t)(row - NLAT) * 1024;
        float4 xv[4];
#pragma unroll
        for (int i = 0; i < 4; ++i) xv[i] = *(const float4*)(xr + i * 256 + lane * 4);
        if (COMBINE) {
            const float* g2 = modprev + (size_t)j * 6144 + 5 * 1024;
            float* xo = lat ? p.out + (size_t)row * 1024 : p.ctxs + (size_t)(row - NLAT) * 1024;
#pragma unroll
            for (int i = 0; i < 4; ++i) {
                const int col = i * 256 + lane * 4;
                const float4 gv = *(const float4*)(g2 + col);
                float s0 = 0.f, s1 = 0.f, s2 = 0.f, s3 = 0.f;
#pragma unroll
                for (int s = 0; s < 3; ++s) { const uint2 u = *(const uint2*)(p.Y + ((size_t)s * NT + row) * 1024 + col); s0 += bflo(u.x); s1 += bfhi(u.x); s2 += bflo(u.y); s3 += bfhi(u.y); }
                xv[i].x += gv.x * s0; xv[i].y += gv.y * s1; xv[i].z += gv.z * s2; xv[i].w += gv.w * s3;
                *(float4*)(xo + col) = xv[i];
            }
        }
        if (NORM) {
            float ss = 0.f;
#pragma unroll
            for (int i = 0; i < 4; ++i) ss += xv[i].x * xv[i].x + xv[i].y * xv[i].y + xv[i].z * xv[i].z + xv[i].w * xv[i].w;
            ss = wave_sum(ss);
            const float rstd = rsqrtf(ss * (1.f / 1024.f) + 1e-6f);
            const float* shp = modl + (size_t)j * 6144 + sh_idx * 1024; const float* scp = modl + (size_t)j * 6144 + sc_idx * 1024;
            float4 hv[4];
#pragma unroll
            for (int i = 0; i < 4; ++i) {
                const int col = i * 256 + lane * 4;
                const float4 g = *(const float4*)(gain + col), sh = *(const float4*)(shp + col), sc = *(const float4*)(scp + col);
                hv[i].x = xv[i].x * rstd * g.x * (1.f + sc.x) + sh.x; hv[i].y = xv[i].y * rstd * g.y * (1.f + sc.y) + sh.y;
                hv[i].z = xv[i].z * rstd * g.z * (1.f + sc.z) + sh.z; hv[i].w = xv[i].w * rstd * g.w * (1.f + sc.w) + sh.w;
                uint2 u; u.x = pack2(hv[i].x, hv[i].y); u.y = pack2(hv[i].z, hv[i].w);
                *(uint2*)(p.H + (size_t)row * 1024 + col) = u;
            }
            if (ROUTER) {
                float part[16];
#pragma unroll
                for (int e = 0; e < 16; ++e) {
                    float a = 0.f;
#pragma unroll
                    for (int i = 0; i < 4; ++i) { const float4 w = *(const float4*)(rw + e * 1024 + i * 256 + lane * 4); a += hv[i].x * w.x + hv[i].y * w.y + hv[i].z * w.z + hv[i].w * w.w; }
                    part[e] = wave_sum(a);
                }
                float* my = scr + wid * 32;
#pragma unroll
                for (int e = 0; e < 16; ++e) if (lane == e) { const float sg = sigm(part[e]); my[e] = sg; my[16 + e] = sg + p.router_b[e]; }
                __builtin_amdgcn_wave_barrier();
                if (lane == 0) {
                    float best = -3.0e38f; int be1 = 0, be2 = 1;
                    for (int g = 0; g < 4; ++g) {
                        const float v0 = my[16 + 4 * g], v1 = my[16 + 4 * g + 1], v2 = my[16 + 4 * g + 2], v3 = my[16 + 4 * g + 3];
                        int i1 = 0; float m1 = v0;
                        if (v1 > m1) { m1 = v1; i1 = 1; } if (v2 > m1) { m1 = v2; i1 = 2; } if (v3 > m1) { m1 = v3; i1 = 3; }
                        int i2 = -1; float m2 = -3.0e38f;
                        if (i1 != 0 && v0 > m2) { m2 = v0; i2 = 0; } if (i1 != 1 && v1 > m2) { m2 = v1; i2 = 1; }
                        if (i1 != 2 && v2 > m2) { m2 = v2; i2 = 2; } if (i1 != 3 && v3 > m2) { m2 = v3; i2 = 3; }
                        const float gs = m1 + m2;
                        if (gs > best) { best = gs; be1 = 4 * g + i1; be2 = 4 * g + i2; }
                    }
                    const float bs1 = my[be1], bs2 = my[be2];
                    const float inv = 1.f / (bs1 + bs2);
                    const int p1 = atomicAdd(&lcnt[be1], 1), p2 = atomicAdd(&lcnt[be2], 1);
                    int* ent = rlist + (wid * 24 + nlist) * 4;
                    ent[0] = row; ent[1] = be1 | (be2 << 8); ent[2] = p1; ent[3] = p2;
                    p.tokw[row * 2] = bs1 * inv; p.tokw[row * 2 + 1] = bs2 * inv;
                }
                ++nlist;
                __builtin_amdgcn_wave_barrier();
            }
        }
    }
    if (ROUTER) {
        __syncthreads();
        if (tid < 16) lbase[tid] = atomicAdd(p.cnt + (layer * 16 + tid) * 64, lcnt[tid]);
        __syncthreads();
        for (int k = lane; k < nlist; k += 64) {
            const int* ent = rlist + (wid * 24 + k) * 4; const int row = ent[0], be1 = ent[1] & 255, be2 = ent[1] >> 8;
            p.slot[(size_t)be1 * NT + lbase[be1] + ent[2]] = row * 2; p.slot[(size_t)be2 * NT + lbase[be2] + ent[3]] = row * 2 + 1;
        }
    }
    (void)scr;
    __syncthreads();
}

DI void ph_win(const Ctx& cx, const Params& p, float* lds, int j) {
    const float* W = p.w_in + (size_t)j * 1024 * INC;
    ngemm<false>(cx, lds, 1, NT, INC, 1024,
        [&](int, int m) { return p.H + (size_t)m * 1024; },
        [&](int, int k) { return W + (size_t)k * INC; }, [&](int, int) { return (const float*)nullptr; },
        [&](int, int m, int n, float v, float) { p.P[(size_t)m * PLD + n] = f2bf(v); });
}
DI void ph_prepB(const Ctx& cx, const Params& p, int j) {
    const int tid = cx.tid, wid = tid >> 6, lane = tid & 63;
    for (int row = cx.bid * 8 + wid; row < NT; row += cx.nblk * 8) {
        const bf16_t* pr = p.P + (size_t)row * PLD + ACOLS;
        const uint2 uq = *(const uint2*)(pr + lane * 4); const unsigned ukv = *(const unsigned*)(pr + 256 + lane * 2);
        const float q0 = bflo(uq.x), q1 = bfhi(uq.x), q2 = bflo(uq.y), q3 = bfhi(uq.y), k0 = bflo(ukv), k1 = bfhi(ukv);
        const float sq = wave_sum(q0 * q0 + q1 * q1 + q2 * q2 + q3 * q3), sk = wave_sum(k0 * k0 + k1 * k1);
        const float rq = rsqrtf(sq * (1.f / 256.f) + 1e-6f), rk = rsqrtf(sk * (1.f / 128.f) + 1e-6f);
        const float* gq = p.b_q_norm + j * 256 + lane * 4; const float* gk = p.b_kv_norm + j * 128 + lane * 2;
        uint2 o; o.x = pack2(q0 * rq * gq[0], q1 * rq * gq[1]); o.y = pack2(q2 * rq * gq[2], q3 * rq * gq[3]);
        bf16_t* qn = p.QN + (size_t)row * 512;
        *(uint2*)(qn + lane * 4) = o;
        *(unsigned*)(qn + 256 + lane * 2) = pack2(k0 * rk * gk[0], k1 * rk * gk[1]);
        *(unsigned*)(qn + 384 + lane * 2) = 0u;
    }
}
DI void ph_qkvup(const Ctx& cx, const Params& p, float* lds, int j, int mq) {
    const float* Wq = p.b_w_q_up + (size_t)j * 256 * 768; const float* Wkv = p.b_w_kv_up + (size_t)j * 128 * 1024;
    ngemm<false>(cx, lds, 1, mq, 768, 256,
        [&](int, int m) { return p.QN + (size_t)m * 512; },
        [&](int, int k) { return Wq + (size_t)k * 768; }, [&](int, int) { return (const float*)nullptr; },
        [&](int, int m, int n, float v, float) { p.Qraw[(size_t)m * 768 + n] = f2bf(v); });
    ngemm<false>(cx, lds, 1, NT, 1024, 128,
        [&](int, int m) { return p.QN + (size_t)m * 512 + 256; },
        [&](int, int k) { return Wkv + (size_t)k * 1024; }, [&](int, int) { return (const float*)nullptr; },
        [&](int, int m, int n, float v, float) { p.KVraw[(size_t)m * 1024 + n] = f2bf(v); });
}
DI void unpack8(const uint4 u, float* d) { d[0] = bflo(u.x); d[1] = bfhi(u.x); d[2] = bflo(u.y); d[3] = bfhi(u.y); d[4] = bflo(u.z); d[5] = bfhi(u.z); d[6] = bflo(u.w); d[7] = bfhi(u.w); }
DI uint4 pack8(const float* d, float scl) { uint4 u; u.x = pack2(d[0] * scl, d[1] * scl); u.y = pack2(d[2] * scl, d[3] * scl); u.z = pack2(d[4] * scl, d[5] * scl); u.w = pack2(d[6] * scl, d[7] * scl); return u; }
DI float ssq8(const uint4 u) { float d[8]; unpack8(u, d); float s = 0.f;
#pragma unroll
    for (int i = 0; i < 8; ++i) s += d[i] * d[i];
    return s; }
DI void norm_rope_store(const uint4 (&raw)[12], const float* gain, int t, bool lat, float scl, bf16_t* dst) {
    float ss = 0.f;
#pragma unroll
    for (int i = 0; i < 12; ++i) ss += ssq8(raw[i]);
    const float r = rsqrtf(ss * (1.f / 96.f) + 1e-6f);
#pragma unroll
    for (int i = 0; i < 8; ++i) { float d[8]; unpack8(raw[i], d);
#pragma unroll
        for (int c = 0; c < 8; ++c) d[c] = d[c] * r * gain[i * 8 + c];
        *(uint4*)(dst + i * 8) = pack8(d, scl); }
    const float invf[8] = {1.f, 0.316227766016838f, 0.1f, 0.0316227766016838f, 0.01f, 0.00316227766016838f, 0.001f, 0.000316227766016838f};
    const float ri = (float)(t >> 6), ci = (float)(t & 63);
#pragma unroll
    for (int half = 0; half < 2; ++half) {
        float x1[8], x2[8], o1[8], o2[8]; unpack8(raw[8 + half], x1); unpack8(raw[10 + half], x2);
#pragma unroll
        for (int c = 0; c < 8; ++c) {
            const float ang = (half == 0 ? ri : ci) * invf[c];
            const float cs = lat ? __cosf(ang) : 1.f, sn = lat ? __sinf(ang) : 0.f;
            const float a = x1[c] * r * gain[64 + half * 8 + c], b = x2[c] * r * gain[80 + half * 8 + c];
            o1[c] = a * cs - b * sn; o2[c] = b * cs + a * sn;
        }
        *(uint4*)(dst + 64 + half * 8) = pack8(o1, scl); *(uint4*)(dst + 80 + half * 8) = pack8(o2, scl);
    }
}
DI void ph_finalize(const Ctx& cx, const Params& p, int j, int mq) {
    const int gtid = cx.bid * NTHR + cx.tid, gsz = cx.nblk * NTHR;
    const float* qg = p.b_q_gain + j * 96; const float* kg = p.b_k_gain + j * 96;
    for (int idx = gtid; idx < 8 * mq; idx += gsz) {
        const int h = idx / mq, row = idx % mq;
        const bool lat = row < NLAT; const int t = lat ? (row & 2047) : ((row - NLAT) & 255);
        bf16_t* qp = p.Qraw + (size_t)row * 768 + h * 96;
        uint4 raw[12];
#pragma unroll
        for (int i = 0; i < 12; ++i) raw[i] = *(const uint4*)(qp + i * 8);
        norm_rope_store(raw, qg, t, lat, (OPT >= 5) ? 0.10206207261596577f * 1.4426950408889634f : 0.10206207261596577f, qp);
    }
    for (int idx = gtid; idx < 8 * NT; idx += gsz) {
        const int h = idx / NT, row = idx % NT;
        const bool lat = row < NLAT; const int b = lat ? (row >> 11) : ((row - NLAT) >> 8); const int t = lat ? (row & 2047) : ((row - NLAT) & 255);
        const int key = lat ? 256 + t : t;
        const bf16_t* kvp = p.KVraw + (size_t)row * 1024 + h * 128; const bf16_t* krp = p.P + (size_t)row * PLD + ACOLS + 384;
        uint4 raw[12];
#pragma unroll
        for (int i = 0; i < 8; ++i) raw[i] = *(const uint4*)(kvp + i * 8);
#pragma unroll
        for (int i = 0; i < 4; ++i) raw[8 + i] = *(const uint4*)(krp + i * 8);
        norm_rope_store(raw, kg, t, lat, 1.f, p.Kf + ((size_t)(b * 8 + h) * 2304 + key) * 96);
    }
    for (int idx = gtid; idx < 8 * NT; idx += gsz) {
        const int h = idx / NT, row = idx % NT;
        const bool lat = row < NLAT; const int b = lat ? (row >> 11) : ((row - NLAT) >> 8); const int t = lat ? (row & 2047) : ((row - NLAT) & 255);
        const int key = lat ? 256 + t : t;
        const bf16_t* vp = p.KVraw + (size_t)row * 1024 + h * 128 + 64;
        bf16_t* vo = p.Vt + (size_t)(b * 8 + h) * 64 * 2304 + key;
#pragma unroll 1
        for (int i = 0; i < 8; ++i) { const uint4 u = *(const uint4*)(vp + i * 8);
            vo[0] = (bf16_t)(u.x & 0xffff); vo[2304] = (bf16_t)(u.x >> 16); vo[2 * 2304] = (bf16_t)(u.y & 0xffff); vo[3 * 2304] = (bf16_t)(u.y >> 16);
            vo[4 * 2304] = (bf16_t)(u.z & 0xffff); vo[5 * 2304] = (bf16_t)(u.z >> 16); vo[6 * 2304] = (bf16_t)(u.w & 0xffff); vo[7 * 2304] = (bf16_t)(u.w >> 16);
            vo += 8 * 2304; }
    }
}
DI void ph_attn(const Ctx& cx, const Params& p, bool with_ctx) {
    const int gtid = cx.bid * NTHR + cx.tid, gsz = cx.nblk * NTHR;
    const int total = NLAT * 8 + (with_ctx ? NCTX * 8 : 0);
    for (int idx = gtid; idx < total; idx += gsz) {
        int b, h, row, nkeys;
        if (idx < NLAT * 8) { b = idx >> 14; h = (idx >> 11) & 7; row = b * 2048 + (idx & 2047); nkeys = 2304; }
        else { const int i2 = idx - NLAT * 8; b = i2 >> 11; h = (i2 >> 8) & 7; row = NLAT + b * 256 + (i2 & 255); nkeys = 256; }
        const bf16_t* qp = p.Qraw + (size_t)row * 768 + h * 96;
        const bf16_t* Kb = p.Kf + (size_t)(b * 8 + h) * 2304 * 96; const bf16_t* Vb = p.Vt + (size_t)(b * 8 + h) * 64 * 2304;
        float q[96];
#pragma unroll
        for (int i = 0; i < 12; ++i) { const uint4 u = *(const uint4*)(qp + i * 8); q[i * 8] = bflo(u.x); q[i * 8 + 1] = bfhi(u.x); q[i * 8 + 2] = bflo(u.y); q[i * 8 + 3] = bfhi(u.y);
            q[i * 8 + 4] = bflo(u.z); q[i * 8 + 5] = bfhi(u.z); q[i * 8 + 6] = bflo(u.w); q[i * 8 + 7] = bfhi(u.w); }
        float acc[64];
#pragma unroll
        for (int i = 0; i < 64; ++i) acc[i] = 0.f;
        float mx = -3.0e38f, l = 0.f;
        for (int key0 = 0; key0 < nkeys; key0 += 8) {
            float s[8];
#pragma unroll
            for (int kk = 0; kk < 8; ++kk) {
                const uint4* kp = (const uint4*)(Kb + (size_t)(key0 + kk) * 96); float a = 0.f;
#pragma unroll
                for (int i = 0; i < 12; ++i) { const uint4 u = kp[i]; a += q[i * 8] * bflo(u.x) + q[i * 8 + 1] * bfhi(u.x) + q[i * 8 + 2] * bflo(u.y) + q[i * 8 + 3] * bfhi(u.y)
                    + q[i * 8 + 4] * bflo(u.z) + q[i * 8 + 5] * bfhi(u.z) + q[i * 8 + 6] * bflo(u.w) + q[i * 8 + 7] * bfhi(u.w); }
                s[kk] = a;
            }
            float cm = s[0];
#pragma unroll
            for (int kk = 1; kk < 8; ++kk) cm = fmaxf(cm, s[kk]);
            const float mn = fmaxf(mx, cm), alpha = expf(mx - mn);
            float ps = 0.f;
#pragma unroll
            for (int kk = 0; kk < 8; ++kk) { s[kk] = expf(s[kk] - mn); ps += s[kk]; }
            l = l * alpha + ps; mx = mn;
#pragma unroll
            for (int dv = 0; dv < 64; ++dv) {
                const uint4 u = *(const uint4*)(Vb + (size_t)dv * 2304 + key0);
                acc[dv] = acc[dv] * alpha + s[0] * bflo(u.x) + s[1] * bfhi(u.x) + s[2] * bflo(u.y) + s[3] * bfhi(u.y) + s[4] * bflo(u.z) + s[5] * bfhi(u.z) + s[6] * bflo(u.w) + s[7] * bfhi(u.w);
            }
        }
        const float il = 1.f / l;
        bf16_t* o = p.H + (size_t)row * 1024 + 512 + h * 64;
#pragma unroll
        for (int i = 0; i < 8; ++i) { uint4 u; u.x = pack2(acc[i * 8] * il, acc[i * 8 + 1] * il); u.y = pack2(acc[i * 8 + 2] * il, acc[i * 8 + 3] * il);
            u.z = pack2(acc[i * 8 + 4] * il, acc[i * 8 + 5] * il); u.w = pack2(acc[i * 8 + 6] * il, acc[i * 8 + 7] * il); *(uint4*)(o + i * 8) = u; }
    }
}
DI float shiftp(const bf16_t* P, int row, int t, int T, int col, float mu) {
    const float c = bf2f(P[(size_t)row * PLD + col]);
    const float pv = (t > 0) ? bf2f(P[(size_t)(row - 1) * PLD + col]) : 0.f;
    const float nx = (t < T - 1) ? bf2f(P[(size_t)(row + 1) * PLD + col]) : 0.f;
    return c + mu * (0.5f * (pv + nx) - c);
}
DI void ph_prepLR(const Ctx& cx, const Params& p, int j) {
    const int gtid = cx.bid * NTHR + cx.tid, gsz = cx.nblk * NTHR;
    const float* mu = p.a_mu + j * ACOLS + 1536;
    for (int idx = gtid; idx < NT * 384; idx += gsz) {
        const int row = idx / 384, col = idx % 384;
        const bool lat = row < NLAT; const int t = lat ? (row & 2047) : ((row - NLAT) & 255); const int T = lat ? 2048 : 256;
        float v = shiftp(p.P, row, t, T, 1536 + col, mu[col]);
        if (col < 128) v = tanhf(v); else if (col >= 256) v = sigm(v);
        p.LR[(size_t)row * 384 + col] = f2bf(v);
    }
}
DI void ph_wag(const Ctx& cx, const Params& p, float* lds, int j) {
    for (int d = 0; d < 2; ++d) {
        const float* W2 = p.a_w2 + (size_t)(j * 2 + d) * 64 * 512; const float* w0 = p.a_w0 + (j * 2 + d) * 512;
        ngemm<false>(cx, lds, 1, NT, 512, 64,
            [&](int, int m) { return p.LR + (size_t)m * 384 + d * 64; },
            [&](int, int k) { return W2 + (size_t)k * 512; }, [&](int, int) { return (const float*)nullptr; },
            [&](int, int m, int n, float v, float) { const float z = -0.606531f * sigm(w0[n] + v); p.WAG[(size_t)m * WLD + d * 512 + n] = f2bf(-expm1f(z)); });
        const float* A2 = p.a_a2 + (size_t)(j * 2 + d) * 64 * 512; const float* a0 = p.a_a0 + (j * 2 + d) * 512;
        ngemm<false>(cx, lds, 1, NT, 512, 64,
            [&](int, int m) { return p.LR + (size_t)m * 384 + 128 + d * 64; },
            [&](int, int k) { return A2 + (size_t)k * 512; }, [&](int, int) { return (const float*)nullptr; },
            [&](int, int m, int n, float v, float) { p.WAG[(size_t)m * WLD + 1024 + d * 512 + n] = f2bf(sigm(a0[n] + v)); });
    }
    const float* G2 = p.a_g2 + (size_t)j * 128 * 512;
    ngemm<false>(cx, lds, 1, NT, 512, 128,
        [&](int, int m) { return p.LR + (size_t)m * 384 + 256; },
        [&](int, int k) { return G2 + (size_t)k * 512; }, [&](int, int) { return (const float*)nullptr; },
        [&](int, int m, int n, float v, float) { p.WAG[(size_t)m * WLD + 2048 + n] = f2bf(v); });
}
DI void ph_scan(const Ctx& cx, const Params& p, float* lds, int j) {
    const int tid = cx.tid, lane = tid & 63;
    if (tid < 64) {
        for (int item = cx.bid; item < 256; item += cx.nblk) {
            const int b = item >> 4, h = (item >> 1) & 7, dir = item & 1, hc = h * 64 + lane;
            float S[64];
#pragma unroll
            for (int k = 0; k < 64; ++k) S[k] = 0.f;
            const float kkc = p.a_k_k[j * 512 + hc], kac = p.a_k_a[j * 512 + hc];
            const float mur = p.a_mu[j * ACOLS + hc], muk = p.a_mu[j * ACOLS + 512 + hc], muv = p.a_mu[j * ACOLS + 1024 + hc];
            bf16_t* yout = dir ? p.YB : p.YF;
            for (int step = 0; step < 2304; ++step) {
                const bool cp = step < 256; const int tt = cp ? step : step - 256, T = cp ? 256 : 2048, t = dir ? (T - 1 - tt) : tt;
                const int row = cp ? NLAT + b * 256 + t : b * 2048 + t;
                const float R = shiftp(p.P, row, t, T, hc, mur), K = shiftp(p.P, row, t, T, 512 + hc, muk), V = shiftp(p.P, row, t, T, 1024 + hc, muv);
                const float w = 1.f - bf2f(p.WAG[(size_t)row * WLD + dir * 512 + hc]), a = bf2f(p.WAG[(size_t)row * WLD + 1024 + dir * 512 + hc]);
                const float kkv = K * kkc, ssq = wave_sum(kkv * kkv), kk = kkv * rsqrtf(ssq + 1e-12f);
                const float kd = K * (1.f + (a - 1.f) * kac), bd = kk * a;
                lds[lane] = -kk; lds[64 + lane] = w; lds[128 + lane] = bd; lds[192 + lane] = kd; lds[256 + lane] = R;
                __builtin_amdgcn_wave_barrier();
                float sa = 0.f;
#pragma unroll
                for (int k4 = 0; k4 < 16; ++k4) { const float4 v = *(const float4*)(lds + k4 * 4); sa += S[k4 * 4] * v.x + S[k4 * 4 + 1] * v.y + S[k4 * 4 + 2] * v.z + S[k4 * 4 + 3] * v.w; }
                float y = 0.f;
#pragma unroll
                for (int k4 = 0; k4 < 16; ++k4) {
                    const float4 wv = *(const float4*)(lds + 64 + k4 * 4), bv = *(const float4*)(lds + 128 + k4 * 4), kv = *(const float4*)(lds + 192 + k4 * 4), rv = *(const float4*)(lds + 256 + k4 * 4);
                    S[k4 * 4] = S[k4 * 4] * wv.x + sa * bv.x + V * kv.x; S[k4 * 4 + 1] = S[k4 * 4 + 1] * wv.y + sa * bv.y + V * kv.y;
                    S[k4 * 4 + 2] = S[k4 * 4 + 2] * wv.z + sa * bv.z + V * kv.z; S[k4 * 4 + 3] = S[k4 * 4 + 3] * wv.w + sa * bv.w + V * kv.w;
                    y += S[k4 * 4] * rv.x + S[k4 * 4 + 1] * rv.y + S[k4 * 4 + 2] * rv.z + S[k4 * 4 + 3] * rv.w;
                }
                __builtin_amdgcn_wave_barrier();
                yout[(size_t)row * 512 + hc] = f2bf(y);
            }
        }
    }
    __syncthreads();
}
DI void ph_post(const Ctx& cx, const Params& p, int j, int nrows) {
    const int gtid = cx.bid * NTHR + cx.tid, gsz = cx.nblk * NTHR;
    for (int idx = gtid; idx < 8 * nrows; idx += gsz) {
        const int h = idx / nrows, row = idx % nrows;
        const bool lat = row < NLAT; const int t = lat ? (row & 2047) : ((row - NLAT) & 255); const int T = lat ? 2048 : 256;
        float sum = 0.f, sb = 0.f;
#pragma unroll 8
        for (int n = 0; n < 64; ++n) {
            const int hc = h * 64 + n;
            const float yy = bf2f(p.YF[(size_t)row * 512 + hc]) + bf2f(p.YB[(size_t)row * 512 + hc]);
            sum += yy;
            const float R = shiftp(p.P, row, t, T, hc, p.a_mu[j * ACOLS + hc]), K = shiftp(p.P, row, t, T, 512 + hc, p.a_mu[j * ACOLS + 512 + hc]);
            const float af = bf2f(p.WAG[(size_t)row * WLD + 1024 + hc]), ab = bf2f(p.WAG[(size_t)row * WLD + 1536 + hc]);
            const float ka = p.a_k_a[j * 512 + hc], rk = p.a_r_k[j * 512 + hc];
            sb += R * rk * (K * (1.f + (af - 1.f) * ka) + K * (1.f + (ab - 1.f) * ka));
        }
        const float mean = sum * (1.f / 64.f); float var = 0.f;
#pragma unroll 8
        for (int n = 0; n < 64; ++n) { const int hc = h * 64 + n; const float yy = bf2f(p.YF[(size_t)row * 512 + hc]) + bf2f(p.YB[(size_t)row * 512 + hc]); var += (yy - mean) * (yy - mean); }
        const float rstd = rsqrtf(var * (1.f / 64.f) + 64e-5f);
#pragma unroll 8
        for (int n = 0; n < 64; ++n) {
            const int hc = h * 64 + n;
            const float yy = bf2f(p.YF[(size_t)row * 512 + hc]) + bf2f(p.YB[(size_t)row * 512 + hc]);
            const float V = shiftp(p.P, row, t, T, 1024 + hc, p.a_mu[j * ACOLS + 1024 + hc]);
            const float g = bf2f(p.WAG[(size_t)row * WLD + 2048 + hc]);
            const float o = ((yy - mean) * rstd * p.a_ln_w[j * 512 + hc] + p.a_ln_b[j * 512 + hc] + sb * V) * g;
            p.H[(size_t)row * 1024 + hc] = f2bf(o);
        }
    }
}
DI void ph_wout(const Ctx& cx, const Params& p, float* lds, const bf16_t* A, const float* W, int nrows, const float* xin_lat, const float* xin_ctx, const float* modl) {
    ngemm<false>(cx, lds, 1, nrows, 1024, 1024,
        [&](int, int m) { return A + (size_t)m * 1024; },
        [&](int, int k) { return W + (size_t)k * 1024; }, [&](int, int) { return (const float*)nullptr; },
        [&](int, int m, int n, float v, float) {
            const bool lat = m < NLAT; const int jj = lat ? (m >> 11) : 16; const float g1 = modl[(size_t)jj * 6144 + 2 * 1024 + n];
            if (lat) p.out[(size_t)m * 1024 + n] = xin_lat[(size_t)m * 1024 + n] + g1 * v;
            else p.ctxs[(size_t)(m - NLAT) * 1024 + n] = xin_ctx[(size_t)(m - NLAT) * 1024 + n] + g1 * v; });
}

DI void ph_chdft(const Ctx& cx, const Params& p, float* lds, int nrows) {
    const int tid = cx.tid, gtid = cx.bid * NTHR + tid, gsz = cx.nblk * NTHR;
    for (int i = tid; i < 128; i += NTHR) { lds[i] = cospif((float)i * (1.f / 64.f)); lds[128 + i] = sinpif((float)i * (1.f / 64.f)); }
    __syncthreads();
    for (int idx = gtid; idx < nrows * 1024; idx += gsz) {
        const int row = idx >> 10, col = idx & 1023, grp = col >> 7, g = col & 127;
        const bf16_t* hp = p.H + (size_t)row * 1024 + grp * 128;
        float gr = 0.f, gi = 0.f;
        for (int c = 0; c < 128; ++c) { const float xv = bf2f(hp[c]); const int m = (c * g) & 127; gr += xv * lds[m]; gi -= xv * lds[128 + m]; }
        p.G[(size_t)row * 2048 + col] = gr; p.G[(size_t)row * 2048 + 1024 + col] = gi;
    }
    __syncthreads();
}
DI void ph_posdft(const Ctx& cx, const Params& p, float* lds, bool with_ctx) {
    ngemm<false>(cx, lds, 16, 2048, 1024, 4096,
        [&](int, int m) { return p.dftl + (size_t)m * 4096; },
        [&](int bz, int k) { return (k < 2048) ? p.G + (size_t)(bz * 2048 + k) * 2048 : p.G + (size_t)(bz * 2048 + k - 2048) * 2048 + 1024; }, [&](int, int) { return (const float*)nullptr; },
        [&](int bz, int m, int n, float v, float) { p.F[(size_t)(bz * 2048 + m) * 1024 + n] = f2bf(v * (1.f / 512.f)); });
    if (with_ctx)
        ngemm<false>(cx, lds, 16, 256, 1024, 512,
            [&](int, int m) { return p.dftc + (size_t)m * 512; },
            [&](int bz, int k) { return (k < 256) ? p.G + (size_t)(NLAT + bz * 256 + k) * 2048 : p.G + (size_t)(NLAT + bz * 256 + k - 256) * 2048 + 1024; }, [&](int, int) { return (const float*)nullptr; },
            [&](int bz, int m, int n, float v, float) { p.F[(size_t)(NLAT + bz * 256 + m) * 1024 + n] = f2bf(v * 0.0055242717280199f); });
}

DI void ph_moe_up(const Ctx& cx, const Params& p, float* lds, int layer, int nrows) {
    for (int e = 0; e < 17; ++e) {
        const int M = (e < 16) ? __builtin_amdgcn_readfirstlane(p.cnt[(layer * 16 + e) * 64]) : nrows;
        const float* Wg = (e < 16) ? p.moe_w_gate + ((size_t)layer * 16 + e) * 1024 * 512 : p.sh_gate + (size_t)layer * 1024 * 512;
        const float* Wu = (e < 16) ? p.moe_w_up + ((size_t)layer * 16 + e) * 1024 * 512 : p.sh_up + (size_t)layer * 1024 * 512;
        const int* sl = p.slot + (size_t)(e & 15) * NT;
        ngemm<true>(cx, lds, 1, M, 512, 1024,
            [&](int, int m) { const int tok = (e < 16) ? (sl[m] >> 1) : m; return p.H + (size_t)tok * 1024; },
            [&](int, int k) { return Wg + (size_t)k * 512; }, [&](int, int k) { return Wu + (size_t)k * 512; },
            [&](int, int m, int n, float g, float u) { const int s = (e < 16) ? sl[m] : 0; const int tok = (e < 16) ? (s >> 1) : m, slab = (e < 16) ? (s & 1) : 2;
                p.ACT[((size_t)slab * NT + tok) * 512 + n] = f2bf(siluf(g) * u); });
    }
}
DI void ph_moe_down(const Ctx& cx, const Params& p, float* lds, int layer, int nrows) {
    for (int e = 0; e < 17; ++e) {
        const int M = (e < 16) ? __builtin_amdgcn_readfirstlane(p.cnt[(layer * 16 + e) * 64]) : nrows;
        const float* Wd = (e < 16) ? p.moe_w_down + ((size_t)layer * 16 + e) * 512 * 1024 : p.sh_down + (size_t)layer * 512 * 1024;
        const int* sl = p.slot + (size_t)(e & 15) * NT;
        ngemm<false>(cx, lds, 1, M, 1024, 512,
            [&](int, int m) { const int s = (e < 16) ? sl[m] : 0; const int tok = (e < 16) ? (s >> 1) : m, slab = (e < 16) ? (s & 1) : 2; return p.ACT + ((size_t)slab * NT + tok) * 512; },
            [&](int, int k) { return Wd + (size_t)k * 1024; }, [&](int, int) { return (const float*)nullptr; },
            [&](int, int m, int n, float v, float) { const int s = (e < 16) ? sl[m] : 0; const int tok = (e < 16) ? (s >> 1) : m, slab = (e < 16) ? (s & 1) : 2;
                const float w = (e < 16) ? p.tokw[s] : 1.f; p.Y[((size_t)slab * NT + tok) * 1024 + n] = f2bf(w * v); });
    }
}

namespace mm {
typedef short bf16x8 __attribute__((ext_vector_type(8)));
typedef float f32x4 __attribute__((ext_vector_type(4)));
typedef unsigned u32x4 __attribute__((ext_vector_type(4)));
constexpr int BM = 256, BK = 64, HALF = 128, HTB = HALF * BK * 2, STAGE_BYTES = 8 * HTB;
DI int lds_byte(int r, int c) { const int st = (r >> 4) * 2 + (c >> 5), rr = r & 15, cc = c & 31, ob = rr * 64 + cc * 2; return st * 1024 + (ob ^ (((ob >> 9) & 1) << 5)); }
DI void stage_rc(int b, int& R, int& C) { const int st = b / 1024, sb = b % 1024, swz = sb ^ (((sb >> 9) & 1) << 5); R = (st >> 1) * 16 + swz / 64; C = (st & 1) * 32 + (swz % 64) / 2; }
DI int perm32(int rho) { const int n = rho >> 4, i = rho & 15; return 8 * (i >> 2) + 4 * n + (i & 3); }
DI unsigned cvt_pk_bf16(float lo, float hi) { unsigned r; asm volatile("v_cvt_pk_bf16_f32 %0, %1, %2" : "=v"(r) : "v"(lo), "v"(hi)); return r; }
struct Unit { const char* A; const char* B; int pm, pn, e, m, tb; };
template <class Sched, class Epi>
DI void gemm_phase(LAS unsigned char* lds, const int K, const Sched& S, const Epi& E, const int tid) {
    const int wid = __builtin_amdgcn_readfirstlane(tid >> 6), lane = tid & 63, wr = wid >> 2, wc = wid & 3, fr = lane & 15, fq = lane >> 4;
    const int nt = K / BK;
    int R0, C0, R1, C1; stage_rc(tid * 16, R0, C0); stage_rc(tid * 16 + 8192, R1, C1);
    unsigned voffB[2];
    { const int Rb0 = Epi::PERM ? ((R0 & ~31) + perm32(R0 & 31)) : R0, Rb1 = Epi::PERM ? ((R1 & ~31) + perm32(R1 & 31)) : R1;
      voffB[0] = (unsigned)(Rb0 * K + C0) * 2u; voffB[1] = (unsigned)(Rb1 * K + C1) * 2u; }
    const size_t kstep = (size_t)(BK * 2), hstepB = (size_t)HALF * K * 2, hstepA = S.hstep_a();
    const unsigned ldsw = (unsigned)wid * 1024u;
    const int aoff = lds_byte(wr * 64 + fr, fq * 8), boff = lds_byte(wc * 32 + fr, fq * 8);
#define MM_SA(b, h) (((b) * 2 + (h)) * HTB)
#define MM_SB(b, h) ((4 + (b) * 2 + (h)) * HTB)
#define MM_STAGE_A(bufoff, gbase, h, offs) do { _Pragma("unroll") for (int _i = 0; _i < 2; ++_i) { \
        if constexpr (Sched::GATHER) __builtin_amdgcn_global_load_lds((const unsigned*)((const char*)(gbase) + (offs)[h][_i]), (LAS unsigned*)(lds + (bufoff) + ldsw + _i * 8192), 16, 0, 0); \
        else __builtin_amdgcn_global_load_lds((const unsigned*)((const char*)(gbase) + (size_t)(h) * hstepA + (offs)[0][_i]), (LAS unsigned*)(lds + (bufoff) + ldsw + _i * 8192), 16, 0, 0); } } while (0)
#define MM_STAGE_B(bufoff, gbase) do { _Pragma("unroll") for (int _i = 0; _i < 2; ++_i) \
        __builtin_amdgcn_global_load_lds((const unsigned*)((const char*)(gbase) + voffB[_i]), (LAS unsigned*)(lds + (bufoff) + ldsw + _i * 8192), 16, 0, 0); } while (0)
#define MM_LDA(dst, b, h) do { _Pragma("unroll") for (int m = 0; m < 4; ++m) _Pragma("unroll") for (int k = 0; k < 2; ++k) dst[m][k] = *(const LAS bf16x8*)(lds + MM_SA(b, h) + aoff + m * 2048 + k * 1024); } while (0)
#define MM_LDB(dst, b, h) do { _Pragma("unroll") for (int n = 0; n < 2; ++n) _Pragma("unroll") for (int k = 0; k < 2; ++k) dst[n][k] = *(const LAS bf16x8*)(lds + MM_SB(b, h) + boff + n * 2048 + k * 1024); } while (0)
#define MM_MMA(ai, bj, At, Bt) do { __builtin_amdgcn_s_setprio(1); _Pragma("unroll") for (int m = 0; m < 4; ++m) _Pragma("unroll") for (int n = 0; n < 2; ++n) _Pragma("unroll") for (int k = 0; k < 2; ++k) \
        acc[ai][bj][m][n] = __builtin_amdgcn_mfma_f32_16x16x32_bf16(Bt[n][k], At[m][k], acc[ai][bj][m][n], 0, 0, 0); __builtin_amdgcn_s_setprio(0); } while (0)
#define MM_WAIT_V(n) asm volatile("s_waitcnt vmcnt(" #n ")" ::: "memory")
#define MM_WAIT_L(n) asm volatile("s_waitcnt lgkmcnt(" #n ")" ::: "memory")
#define MM_BAR __builtin_amdgcn_s_barrier()
#define MM_SCHED __builtin_amdgcn_sched_barrier(0)
    Unit cur, nxt; int ui = 0;
    if (!S.next(0, cur)) return;
    unsigned oa[2][2], on[2][2];
    S.aoff(cur, R0, C0, R1, C1, oa);
    on[0][0] = oa[0][0]; on[0][1] = oa[0][1]; on[1][0] = oa[1][0]; on[1][1] = oa[1][1];
    if constexpr (Sched::TABLE) S.tab_dma(cur, lds + STAGE_BYTES + 1024, tid);
    f32x4 acc[2][2][4][2];
#pragma unroll
    for (int a = 0; a < 2; ++a)
#pragma unroll
        for (int b = 0; b < 2; ++b)
#pragma unroll
            for (int m = 0; m < 4; ++m)
#pragma unroll
                for (int n = 0; n < 2; ++n) acc[a][b][m][n] = (f32x4){0.f, 0.f, 0.f, 0.f};
    bf16x8 At[4][2], B0[2][2], B1[2][2];
    const char* cA = cur.A; const char* cB = cur.B;
    MM_STAGE_B(MM_SB(0, 0), cB); MM_STAGE_A(MM_SA(0, 0), cA, 0, oa); MM_STAGE_B(MM_SB(0, 1), cB + hstepB); MM_STAGE_A(MM_SA(0, 1), cA, 1, oa);
    if (wr == 1) MM_BAR;
    MM_WAIT_V(4); MM_BAR;
    MM_STAGE_B(MM_SB(1, 0), cB + kstep); MM_STAGE_A(MM_SA(1, 0), cA + kstep, 0, oa); MM_STAGE_B(MM_SB(1, 1), cB + hstepB + kstep);
    MM_WAIT_V(6); MM_BAR;
    for (;;) {
        cur.tb = ui % 3;
        const bool has_next = S.next(ui + 1, nxt);
        if constexpr (Sched::TABLE) { if (has_next) S.tab_dma(nxt, lds + STAGE_BYTES + 1024 + ((ui + 1) % 3) * 2048, tid); }
        const char* nA = has_next ? nxt.A : cA; const char* nB = has_next ? nxt.B : cB;
        for (int t = 0; t < nt; t += 2) {
            const bool last = (t == nt - 2);
            if constexpr (Sched::GATHER) { if (last) { if (has_next) S.aoff_lds(nxt, (const LAS int*)(lds + STAGE_BYTES + 1024 + ((ui + 1) % 3) * 2048), R0, C0, R1, C1, on);
                else { on[0][0] = oa[0][0]; on[0][1] = oa[0][1]; on[1][0] = oa[1][0]; on[1][1] = oa[1][1]; } } }
            const char* a1 = cA + (size_t)(t + 1) * kstep;
            const char* a2 = last ? nA : cA + (size_t)(t + 2) * kstep; const char* b2 = last ? nB : cB + (size_t)(t + 2) * kstep;
            const char* a3 = a2 + kstep; const char* b3 = b2 + kstep;
            unsigned o2[2][2];
            if constexpr (Sched::GATHER) { o2[0][0] = last ? on[0][0] : oa[0][0]; o2[0][1] = last ? on[0][1] : oa[0][1]; o2[1][0] = last ? on[1][0] : oa[1][0]; o2[1][1] = last ? on[1][1] : oa[1][1]; }
            else { o2[0][0] = oa[0][0]; o2[0][1] = oa[0][1]; o2[1][0] = oa[1][0]; o2[1][1] = oa[1][1]; }
            MM_LDB(B0, 0, 0); MM_SCHED; MM_LDA(At, 0, 0); MM_STAGE_A(MM_SA(1, 1), a1, 1, oa);
            MM_WAIT_L(8); MM_BAR; MM_WAIT_L(0); MM_MMA(0, 0, At, B0); MM_BAR; MM_SCHED;
            MM_LDB(B1, 0, 1); MM_STAGE_B(MM_SB(0, 0), b2);
            MM_BAR; MM_WAIT_L(0); MM_MMA(0, 1, At, B1); MM_BAR;
            MM_LDA(At, 0, 1); MM_STAGE_A(MM_SA(0, 0), a2, 0, o2);
            MM_BAR; MM_WAIT_L(0); MM_MMA(1, 0, At, B0); MM_BAR; MM_SCHED;
            MM_STAGE_B(MM_SB(0, 1), b2 + hstepB);
            MM_WAIT_V(6); MM_BAR; MM_MMA(1, 1, At, B1); MM_BAR;
            MM_LDB(B0, 1, 0); MM_SCHED; MM_LDA(At, 1, 0); MM_STAGE_A(MM_SA(0, 1), a2, 1, o2);
            MM_WAIT_L(8); MM_BAR; MM_WAIT_L(0); MM_MMA(0, 0, At, B0); MM_BAR; MM_SCHED;
            MM_LDB(B1, 1, 1); MM_STAGE_B(MM_SB(1, 0), b3);
            MM_BAR; MM_WAIT_L(0); MM_MMA(0, 1, At, B1); MM_BAR;
            MM_LDA(At, 1, 1); MM_STAGE_A(MM_SA(1, 0), a3, 0, o2);
            MM_BAR; MM_WAIT_L(0); MM_MMA(1, 0, At, B0); MM_BAR; MM_SCHED;
            MM_STAGE_B(MM_SB(1, 1), b3 + hstepB);
            MM_WAIT_V(6); MM_BAR; MM_MMA(1, 1, At, B1); MM_BAR;
        }
        E(acc, cur, wr, wc, fr, fq);
        if (!has_next) break;
#pragma unroll
        for (int a = 0; a < 2; ++a)
#pragma unroll
            for (int b = 0; b < 2; ++b)
#pragma unroll
                for (int m = 0; m < 4; ++m)
#pragma unroll
                    for (int n = 0; n < 2; ++n) acc[a][b][m][n] = (f32x4){0.f, 0.f, 0.f, 0.f};
        cur = nxt; cA = nA; cB = nB; ++ui;
        if constexpr (Sched::GATHER) { oa[0][0] = on[0][0]; oa[0][1] = on[0][1]; oa[1][0] = on[1][0]; oa[1][1] = on[1][1]; }
    }
    MM_WAIT_V(0);
    if (wr == 0) MM_BAR;
    MM_BAR;
#undef MM_SA
#undef MM_SB
#undef MM_STAGE_A
#undef MM_STAGE_B
#undef MM_LDA
#undef MM_LDB
#undef MM_MMA
#undef MM_WAIT_V
#undef MM_WAIT_L
#undef MM_BAR
#undef MM_SCHED
}
struct StaticSched {
    static constexpr bool GATHER = false, TABLE = false;
    const char* A; const char* Bt; int lda, K, nM, nN, nwg, G, c;
    DI size_t hstep_a() const { return (size_t)HALF * lda * 2; }
    DI void init(const void* A_, const void* Bt_, int M, int N, int K_, int lda_, int G_, int c_) { A = (const char*)A_; Bt = (const char*)Bt_; lda = lda_; K = K_; nM = M / BM; nN = N / BM; nwg = nM * nN; G = G_; c = c_; }
    DI bool next(int i, Unit& u) const {
        const int L = i * G + c; if (L >= nwg) return false;
        int wgid = L; { const int q = nwg / 8, r = nwg % 8, xcd = wgid % 8, off = wgid / 8; wgid = (xcd < r ? xcd * (q + 1) : r * (q + 1) + (xcd - r) * q) + off; }
        const int nig = 8 * nN, gid = wgid / nig, fm = gid * 8, gsz = (nM - fm) < 8 ? (nM - fm) : 8;
        u.pm = fm + ((wgid % nig) % gsz); u.pn = (wgid % nig) / gsz; u.e = 0; u.m = 0;
        u.A = A + (size_t)u.pm * BM * lda * 2; u.B = Bt + (size_t)u.pn * BM * K * 2; return true;
    }
    DI void aoff(const Unit&, int R0, int C0, int R1, int C1, unsigned (&o)[2][2]) const {
        o[0][0] = (unsigned)(R0 * lda + C0) * 2u; o[0][1] = (unsigned)(R1 * lda + C1) * 2u;
        o[1][0] = (unsigned)((HALF + R0) * lda + C0) * 2u; o[1][1] = (unsigned)((HALF + R1) * lda + C1) * 2u;
    }
};
struct BatchSched {
    static constexpr bool GATHER = false, TABLE = false;
    const char* A; const char* Bt; int K, nM, nN, nb, G, c; size_t bstride;
    DI size_t hstep_a() const { return (size_t)HALF * K * 2; }
    DI void init(const void* A_, const void* Bt_, size_t bstride_bytes, int nb_, int M, int N, int K_, int G_, int c_) { A = (const char*)A_; Bt = (const char*)Bt_; bstride = bstride_bytes; nb = nb_; K = K_; nM = M / BM; nN = N / BM; G = G_; c = c_; }
    DI bool next(int i, Unit& u) const {
        const int L = i * G + c; if (L >= nb * nM * nN) return false;
        const int b = L / (nM * nN), rem = L % (nM * nN); u.pm = rem / nN; u.pn = rem % nN; u.e = b; u.m = 0;
        u.A = A + (size_t)u.pm * BM * K * 2; u.B = Bt + (size_t)b * bstride + (size_t)u.pn * BM * K * 2; return true;
    }
    DI void aoff(const Unit&, int R0, int C0, int R1, int C1, unsigned (&o)[2][2]) const {
        o[0][0] = (unsigned)(R0 * K + C0) * 2u; o[0][1] = (unsigned)(R1 * K + C1) * 2u;
        o[1][0] = (unsigned)((HALF + R0) * K + C0) * 2u; o[1][1] = (unsigned)((HALF + R1) * K + C1) * 2u;
    }
};
struct EpiBf16Store {
    static constexpr bool PERM = true;
    bf16_t* O; int ldc;
    DI void operator()(const f32x4 (&acc)[2][2][4][2], const Unit& u, int wr, int wc, int fr, int fq) const {
        const int row0 = u.pm * BM + wr * 64 + fr, col0 = u.pn * BM + wc * 32 + 8 * fq;
#pragma unroll
        for (int ai = 0; ai < 2; ++ai)
#pragma unroll
            for (int m = 0; m < 4; ++m) { bf16_t* rowp = O + (size_t)(row0 + ai * HALF + m * 16) * ldc + col0;
#pragma unroll
                for (int bj = 0; bj < 2; ++bj) { const f32x4 v0 = acc[ai][bj][m][0], v1 = acc[ai][bj][m][1];
                    u32x4 w; w.x = cvt_pk_bf16(v0[0], v0[1]); w.y = cvt_pk_bf16(v0[2], v0[3]); w.z = cvt_pk_bf16(v1[0], v1[1]); w.w = cvt_pk_bf16(v1[2], v1[3]);
                    *(u32x4*)(rowp + bj * HALF) = w; } }
    }
};
struct EpiResid {
    static constexpr bool PERM = false;
    const float* xin_lat; const float* xin_ctx; float* out_lat; float* out_ctx; const float* modl; int batched_T;
    DI void operator()(const f32x4 (&acc)[2][2][4][2], const Unit& u, int wr, int wc, int fr, int fq) const {
        int grow0; if (batched_T == 0) grow0 = u.pm * BM; else if (batched_T > 0) grow0 = u.e * 2048 + u.pm * BM; else grow0 = NLAT + u.e * 256 + u.pm * BM;
        const bool lat = grow0 < NLAT; const int jj = lat ? (grow0 >> 11) : 16;
        const float* xi = lat ? xin_lat + (size_t)grow0 * 1024 : xin_ctx + (size_t)(grow0 - NLAT) * 1024;
        float* xo = lat ? out_lat + (size_t)grow0 * 1024 : out_ctx + (size_t)(grow0 - NLAT) * 1024;
        const float* g1 = modl + (size_t)jj * 6144 + 2 * 1024;
        const int r0 = wr * 64 + fr, col0 = u.pn * BM + wc * 32 + 4 * fq;
        f32x4 gv[2][2];
#pragma unroll
        for (int bj = 0; bj < 2; ++bj)
#pragma unroll
            for (int n = 0; n < 2; ++n) gv[bj][n] = *(const f32x4*)(g1 + col0 + bj * HALF + n * 16);
#pragma unroll
        for (int ai = 0; ai < 2; ++ai) {
            f32x4 xv[4][2][2];
#pragma unroll
            for (int m = 0; m < 4; ++m)
#pragma unroll
                for (int bj = 0; bj < 2; ++bj)
#pragma unroll
                    for (int n = 0; n < 2; ++n) xv[m][bj][n] = *(const f32x4*)(xi + (size_t)(r0 + ai * HALF + m * 16) * 1024 + col0 + bj * HALF + n * 16);
#pragma unroll
            for (int m = 0; m < 4; ++m)
#pragma unroll
                for (int bj = 0; bj < 2; ++bj)
#pragma unroll
                    for (int n = 0; n < 2; ++n) *(f32x4*)(xo + (size_t)(r0 + ai * HALF + m * 16) * 1024 + col0 + bj * HALF + n * 16) = xv[m][bj][n] + gv[bj][n] * acc[ai][bj][m][n];
            asm volatile("" ::: "memory");
        }
    }
};
struct EpiResidB {
    static constexpr bool PERM = true;
    const void* xin_lat; const void* xin_ctx; bf16_t* out_lat; bf16_t* out_ctx; const float* modl; int batched_T; int in_f32;
    DI void operator()(const f32x4 (&acc)[2][2][4][2], const Unit& u, int wr, int wc, int fr, int fq) const {
        int grow0; if (batched_T == 0) grow0 = u.pm * BM; else if (batched_T > 0) grow0 = u.e * 2048 + u.pm * BM; else grow0 = NLAT + u.e * 256 + u.pm * BM;
        const bool lat = grow0 < NLAT; const int jj = lat ? (grow0 >> 11) : 16; const size_t rb = lat ? (size_t)grow0 : (size_t)(grow0 - NLAT);
        const float* g1 = modl + (size_t)jj * 6144 + 2 * 1024;
        bf16_t* xo = (lat ? out_lat : out_ctx) + rb * 1024;
        const int r0 = wr * 64 + fr, col0 = u.pn * BM + wc * 32 + 8 * fq;
        f32x4 gv[2][2];
#pragma unroll
        for (int bj = 0; bj < 2; ++bj)
#pragma unroll
            for (int n = 0; n < 2; ++n) gv[bj][n] = *(const f32x4*)(g1 + col0 + bj * HALF + 4 * n);
        if (in_f32) {
            const float* xi = (const float*)(lat ? xin_lat : xin_ctx) + rb * 1024;
#pragma unroll
            for (int ai = 0; ai < 2; ++ai)
#pragma unroll
                for (int mp = 0; mp < 2; ++mp) {
                    f32x4 xv[2][2][2];
#pragma unroll
                    for (int mm_ = 0; mm_ < 2; ++mm_)
#pragma unroll
                        for (int bj = 0; bj < 2; ++bj)
#pragma unroll
                            for (int n = 0; n < 2; ++n) xv[mm_][bj][n] = *(const f32x4*)(xi + (size_t)(r0 + ai * HALF + (2 * mp + mm_) * 16) * 1024 + col0 + bj * HALF + 4 * n);
#pragma unroll
                    for (int mm_ = 0; mm_ < 2; ++mm_)
#pragma unroll
                        for (int bj = 0; bj < 2; ++bj) { const int m = 2 * mp + mm_; const f32x4 o0 = xv[mm_][bj][0] + gv[bj][0] * acc[ai][bj][m][0], o1 = xv[mm_][bj][1] + gv[bj][1] * acc[ai][bj][m][1];
                            u32x4 w; w.x = att_pk(o0[0], o0[1]); w.y = att_pk(o0[2], o0[3]); w.z = att_pk(o1[0], o1[1]); w.w = att_pk(o1[2], o1[3]);
                            *(u32x4*)(xo + (size_t)(r0 + ai * HALF + m * 16) * 1024 + col0 + bj * HALF) = w; }
                    asm volatile("" ::: "memory");
                }
        } else {
            const bf16_t* xi = (const bf16_t*)(lat ? xin_lat : xin_ctx) + rb * 1024;
#pragma unroll
            for (int ai = 0; ai < 2; ++ai) {
                u32x4 xv[4][2];
#pragma unroll
                for (int m = 0; m < 4; ++m)
#pragma unroll
                    for (int bj = 0; bj < 2; ++bj) xv[m][bj] = *(const u32x4*)(xi + (size_t)(r0 + ai * HALF + m * 16) * 1024 + col0 + bj * HALF);
#pragma unroll
                for (int m = 0; m < 4; ++m)
#pragma unroll
                    for (int bj = 0; bj < 2; ++bj) { const u32x4 x = xv[m][bj];
                        const f32x4 x0 = {__uint_as_float(x.x << 16), __uint_as_float(x.x & 0xffff0000u), __uint_as_float(x.y << 16), __uint_as_float(x.y & 0xffff0000u)};
                        const f32x4 x1 = {__uint_as_float(x.z << 16), __uint_as_float(x.z & 0xffff0000u), __uint_as_float(x.w << 16), __uint_as_float(x.w & 0xffff0000u)};
                        const f32x4 o0 = x0 + gv[bj][0] * acc[ai][bj][m][0], o1 = x1 + gv[bj][1] * acc[ai][bj][m][1];
                        u32x4 w; w.x = att_pk(o0[0], o0[1]); w.y = att_pk(o0[2], o0[3]); w.z = att_pk(o1[0], o1[1]); w.w = att_pk(o1[2], o1[3]);
                        *(u32x4*)(xo + (size_t)(r0 + ai * HALF + m * 16) * 1024 + col0 + bj * HALF) = w; }
                asm volatile("" ::: "memory");
            }
        }
    }
};
}

DI void tconv_tile(const Ctx& cx, float* T, const float* src, int ld_src, int k0, int n0, int kvalid, int nvalid, bf16_t* dst, int ldd, int drow0) {
    const int tid = cx.tid;
#pragma unroll
    for (int rr = 0; rr < 2; ++rr) {
        const int i = (tid >> 4) + 32 * rr, j = (tid & 15) * 4;
        float4 v = make_float4(0.f, 0.f, 0.f, 0.f);
        if (k0 + i < kvalid && n0 + j < nvalid) v = *(const float4*)(src + (size_t)(k0 + i) * ld_src + n0 + j);
        T[i * 65 + j] = v.x; T[i * 65 + j + 1] = v.y; T[i * 65 + j + 2] = v.z; T[i * 65 + j + 3] = v.w;
    }
    __syncthreads();
    { const int j = tid >> 3, ch = tid & 7; uint4 o;
      o.x = pack2(T[(ch * 8 + 0) * 65 + j], T[(ch * 8 + 1) * 65 + j]); o.y = pack2(T[(ch * 8 + 2) * 65 + j], T[(ch * 8 + 3) * 65 + j]);
      o.z = pack2(T[(ch * 8 + 4) * 65 + j], T[(ch * 8 + 5) * 65 + j]); o.w = pack2(T[(ch * 8 + 6) * 65 + j], T[(ch * 8 + 7) * 65 + j]);
      *(uint4*)(dst + (size_t)(drow0 + j) * ldd + k0 + ch * 8) = o; }
    __syncthreads();
}
DI void ph_prep_weights(const Ctx& cx, const Params& p, float* lds) {
    const int tid = cx.tid, gtid = cx.bid * NTHR + tid, gsz = cx.nblk * NTHR;
    for (int it = cx.bid; it < 2 * 1008; it += cx.nblk) {
        const int j = it / 1008; int r = it % 1008;
        if (r < 640) { const int kt = r / 40, ntl = r % 40; tconv_tile(cx, lds, p.w_in + (size_t)j * 1024 * INC, INC, kt * 64, ntl * 64, 1024, INC, p.WinT + (size_t)j * 2560 * 1024, 1024, ntl * 64); continue; } r -= 640;
        if (r < 48) { const int kt = r / 12, ntl = r % 12; tconv_tile(cx, lds, p.b_w_q_up + (size_t)j * 256 * 768, 768, kt * 64, ntl * 64, 256, 768, p.WqT + (size_t)j * 768 * 256, 256, ntl * 64); continue; } r -= 48;
        if (r < 64) { const int kt = r / 16, ntl = r % 16; tconv_tile(cx, lds, p.b_w_kv_up + (size_t)j * 128 * 1024, 1024, kt * 64, ntl * 64, 128, 1024, p.WkvT + (size_t)j * 1024 * 256, 256, ntl * 64); continue; } r -= 64;
        { const int kt = r / 16, ntl = r % 16; tconv_tile(cx, lds, p.w_out_even + (size_t)j * 1024 * 1024, 1024, kt * 64, ntl * 64, 1024, 1024, p.WoutT + (size_t)j * 1024 * 1024, 1024, ntl * 64); }
    }
    for (int idx = gtid; idx < 2 * 2560 * 384; idx += gsz) {
        const int j = idx / (2560 * 384), rem = idx % (2560 * 384), n = rem / 384, k = rem % 384; const int seg = n >> 9, nn = n & 511;
        float v = 0.f;
        if (seg < 2) { if ((k >> 6) == seg) v = p.a_w2[((size_t)(j * 2 + seg) * 64 + (k & 63)) * 512 + nn]; }
        else if (seg < 4) { if ((k >> 6) == seg) v = p.a_a2[((size_t)(j * 2 + seg - 2) * 64 + (k & 63)) * 512 + nn]; }
        else { if (k >= 256) v = p.a_g2[((size_t)j * 128 + (k - 256)) * 512 + nn]; }
        p.WlrT[idx] = f2bf(v);
    }
    {
        float* Tc = lds; float* Ts = lds + 64 * 65; float* tab = lds + 2 * 64 * 65;
        for (int i = tid; i < 128; i += NTHR) { tab[i] = cospif((float)i * (1.f / 64.f)); tab[128 + i] = sinpif((float)i * (1.f / 64.f)); }
        __syncthreads();
        for (int it = cx.bid; it < 2 * 256; it += cx.nblk) {
            const int j = it >> 8, ct = (it >> 4) & 15, et = it & 15; const float* Wf = p.w_out_fourier + (size_t)j * 1024 * 1024;
            const int el = tid & 63, e = et * 64 + el;
#pragma unroll 1
            for (int i = 0; i < 8; ++i) {
                const int chl = (tid >> 6) + 8 * i, ch = ct * 64 + chl, grp = ch >> 7, c = ch & 127;
                float sc = 0.f, ss = 0.f;
                for (int g = 0; g < 128; ++g) { const float w = Wf[(size_t)(grp * 128 + g) * 1024 + e]; const int m = (c * g) & 127; sc += tab[m] * w; ss += tab[128 + m] * w; }
                Tc[chl * 65 + el] = sc; Ts[chl * 65 + el] = ss;
            }
            __syncthreads();
            { const int el2 = tid >> 3, chunk = tid & 7; uint4 o, o2; const float* a = Tc + chunk * 8 * 65 + el2; const float* b = Ts + chunk * 8 * 65 + el2;
              o.x = pack2(a[0], a[65]); o.y = pack2(a[2 * 65], a[3 * 65]); o.z = pack2(a[4 * 65], a[5 * 65]); o.w = pack2(a[6 * 65], a[7 * 65]);
              o2.x = pack2(b[0], b[65]); o2.y = pack2(b[2 * 65], b[3 * 65]); o2.z = pack2(b[4 * 65], b[5 * 65]); o2.w = pack2(b[6 * 65], b[7 * 65]);
              bf16_t* d = p.A1 + (size_t)j * 2048 * 1024 + (size_t)(et * 64 + el2) * 1024 + ct * 64 + chunk * 8;
              *(uint4*)d = o; *(uint4*)(d + (size_t)1024 * 1024) = o2; }
            __syncthreads();
        }
    }
    for (int i = gtid; i < 2048 * 4096; i += gsz) {
        const int f = i >> 12, k = i & 4095, t = k & 2047, m = (f * t) & 2047; const float a = (float)m * (1.f / 1024.f);
        p.A2[i] = f2bf(((k < 2048) ? cospif(a) : -sinpif(a)) * (1.f / 512.f));
    }
    for (int i = gtid; i < 256 * 512; i += gsz) {
        const int f = i >> 9, k = i & 511, t = k & 255, m = (f * t) & 255; const float a = (float)m * (1.f / 128.f);
        p.A2c[i] = f2bf(((k < 256) ? cospif(a) : -sinpif(a)) * 0.0055242717280199f);
    }
    __syncthreads();
}
DI void ph_prep_moe(const Ctx& cx, const Params& p, float* lds, int layer) {
    for (int it = cx.bid; it < 17 * 384; it += cx.nblk) {
        const int e = it / 384; int r = it % 384;
        const float* Wg = (e < 16) ? p.moe_w_gate + ((size_t)layer * 16 + e) * 1024 * 512 : p.sh_gate + (size_t)layer * 1024 * 512;
        const float* Wu = (e < 16) ? p.moe_w_up + ((size_t)layer * 16 + e) * 1024 * 512 : p.sh_up + (size_t)layer * 1024 * 512;
        const float* Wd = (e < 16) ? p.moe_w_down + ((size_t)layer * 16 + e) * 512 * 1024 : p.sh_down + (size_t)layer * 512 * 1024;
        if (r < 256) { const int bj = r >> 7, kt = (r >> 3) & 15, ntl = r & 7, n0 = ntl * 64;
            tconv_tile(cx, lds, bj ? Wu : Wg, 512, kt * 64, n0, 1024, 512, p.WguT + (size_t)e * 1024 * 1024, 1024, (n0 >> 7) * 256 + bj * 128 + (n0 & 127)); }
        else { r -= 256; const int kt = r >> 4, ntl = r & 15; tconv_tile(cx, lds, Wd, 1024, kt * 64, ntl * 64, 512, 1024, p.WdT + (size_t)e * 1024 * 512, 512, ntl * 64); }
    }
}

#define GEMM_LDS(lds) ((LAS unsigned char*)(lds))
DI void ph_win_mm(const Ctx& cx, const Params& p, float* lds, int j) {
    mm::StaticSched S; S.init(p.H, p.WinT + (size_t)j * 2560 * 1024, NT, 2560, 1024, 1024, cx.nblk, cx.bid);
    mm::EpiBf16Store E{p.P, PLD};
    mm::gemm_phase(GEMM_LDS(lds), 1024, S, E, cx.tid);
}
DI void ph_wout_mmB(const Ctx& cx, const Params& p, float* lds, const bf16_t* A, const bf16_t* Bt, int nrows, const void* xin_lat, const void* xin_ctx, bf16_t* xo_lat, int in_f32, const float* modl) {
    mm::StaticSched S; S.init(A, Bt, nrows, 1024, 1024, 1024, cx.nblk, cx.bid);
    mm::EpiResidB E{xin_lat, xin_ctx, xo_lat, p.cs, modl, 0, in_f32};
    mm::gemm_phase(GEMM_LDS(lds), 1024, S, E, cx.tid);
}
DI void ph_wout_mm(const Ctx& cx, const Params& p, float* lds, const bf16_t* A, const bf16_t* Bt, int nrows, const float* xin_lat, const float* xin_ctx, const float* modl) {
    mm::StaticSched S; S.init(A, Bt, nrows, 1024, 1024, 1024, cx.nblk, cx.bid);
    mm::EpiResid E{xin_lat, xin_ctx, p.out, p.ctxs, modl, 0};
    mm::gemm_phase(GEMM_LDS(lds), 1024, S, E, cx.tid);
}

DI void ph_qkvup_mm(const Ctx& cx, const Params& p, float* lds, int j, int mq) {
    { mm::StaticSched S; S.init(p.QN, p.WqT + (size_t)j * 768 * 256, mq, 768, 256, 512, cx.nblk, cx.bid); mm::EpiBf16Store E{p.Qraw, 768}; mm::gemm_phase(GEMM_LDS(lds), 256, S, E, cx.tid); }
    { mm::StaticSched S; S.init(p.QN + 256, p.WkvT + (size_t)j * 1024 * 256, NT, 1024, 256, 512, cx.nblk, cx.bid); mm::EpiBf16Store E{p.KVraw, 1024}; mm::gemm_phase(GEMM_LDS(lds), 256, S, E, cx.tid); }
}
struct EpiWag {
    static constexpr bool PERM = true;
    bf16_t* O; const LAS float* bias;
    DI void operator()(const mm::f32x4 (&acc)[2][2][4][2], const mm::Unit& u, int wr, int wc, int fr, int fq) const {
        const int row0 = u.pm * 256 + wr * 64 + fr, col0 = u.pn * 256 + wc * 32 + 8 * fq; const int seg = u.pn >> 2;
        const LAS float* bp = bias + col0;
#pragma unroll
        for (int bj = 0; bj < 2; ++bj) {
            mm::f32x4 b0 = (mm::f32x4){0.f, 0.f, 0.f, 0.f}, b1 = b0;
            if (seg < 2) { b0 = *(const LAS mm::f32x4*)(bp + bj * 128); b1 = *(const LAS mm::f32x4*)(bp + bj * 128 + 4); }
#pragma unroll
            for (int ai = 0; ai < 2; ++ai)
#pragma unroll
                for (int m = 0; m < 4; ++m) {
                    mm::f32x4 v0 = acc[ai][bj][m][0] + b0, v1 = acc[ai][bj][m][1] + b1;
                    if (seg == 0) {
#pragma unroll
                        for (int c = 0; c < 4; ++c) { v0[c] = 1.f - __expf(-0.606531f * __builtin_amdgcn_rcpf(1.f + __expf(-v0[c]))); v1[c] = 1.f - __expf(-0.606531f * __builtin_amdgcn_rcpf(1.f + __expf(-v1[c]))); }
                    } else if (seg == 1) {
#pragma unroll
                        for (int c = 0; c < 4; ++c) { v0[c] = __builtin_amdgcn_rcpf(1.f + __expf(-v0[c])); v1[c] = __builtin_amdgcn_rcpf(1.f + __expf(-v1[c])); }
                    }
                    mm::u32x4 w; w.x = mm::cvt_pk_bf16(v0[0], v0[1]); w.y = mm::cvt_pk_bf16(v0[2], v0[3]); w.z = mm::cvt_pk_bf16(v1[0], v1[1]); w.w = mm::cvt_pk_bf16(v1[2], v1[3]);
                    *(mm::u32x4*)(O + (size_t)(row0 + ai * 128 + m * 16) * WLD + col0 + bj * 128) = w;
                }
        }
    }
};
DI void ph_wag_mm(const Ctx& cx, const Params& p, float* lds, int j) {
    mm::StaticSched S; S.init(p.LR, p.WlrT + (size_t)j * 2560 * 384, NT, 2560, 384, 384, cx.nblk, cx.bid);
    LAS float* bl = (LAS float*)lds + 32768 + 256 + 1024;
    for (int i = cx.tid; i < 2048; i += NTHR) bl[i] = (i < 1024) ? p.a_w0[j * 1024 + i] : p.a_a0[j * 1024 + i - 1024];
    __syncthreads();
    EpiWag E{p.WAG, bl};
    mm::gemm_phase(GEMM_LDS(lds), 384, S, E, cx.tid);
}
struct EpiZT {
    static constexpr bool PERM = true;
    bf16_t* Z; int T;
    DI void operator()(const mm::f32x4 (&acc)[2][2][4][2], const mm::Unit& u, int wr, int wc, int fr, int fq) const {
        const int b = (T == 2048) ? (u.pn >> 3) : u.pn, t0 = (T == 2048) ? ((u.pn & 7) * 256) : 0;
        const int m0 = u.pm * 256 + wr * 64 + fr; const int c0 = t0 + wc * 32 + 8 * fq;
#pragma unroll
        for (int ai = 0; ai < 2; ++ai)
#pragma unroll
            for (int m = 0; m < 4; ++m) { const int mr = m0 + ai * 128 + m * 16, part = mr >> 10, ch = mr & 1023;
                bf16_t* rowp = Z + ((size_t)(b * 1024 + ch) * 2 + part) * T + c0;
#pragma unroll
                for (int bj = 0; bj < 2; ++bj) { const mm::f32x4 v0 = acc[ai][bj][m][0], v1 = acc[ai][bj][m][1];
                    mm::u32x4 w; w.x = mm::cvt_pk_bf16(v0[0], v0[1]); w.y = mm::cvt_pk_bf16(v0[2], v0[3]); w.z = mm::cvt_pk_bf16(v1[0], v1[1]); w.w = mm::cvt_pk_bf16(v1[2], v1[3]);
                    *(mm::u32x4*)(rowp + bj * 128) = w; } }
    }
};
DI void ph_f1_mm(const Ctx& cx, const Params& p, float* lds, int j, bool with_ctx) {
    { mm::StaticSched S; S.init(p.A1 + (size_t)j * 2048 * 1024, p.H, 2048, NLAT, 1024, 1024, cx.nblk, cx.bid); EpiZT E{p.ZT, 2048}; mm::gemm_phase(GEMM_LDS(lds), 1024, S, E, cx.tid); }
    if (with_ctx) { mm::StaticSched S; S.init(p.A1 + (size_t)j * 2048 * 1024, p.H + (size_t)NLAT * 1024, 2048, NCTX, 1024, 1024, cx.nblk, cx.bid); EpiZT E{p.ZTC, 256}; mm::gemm_phase(GEMM_LDS(lds), 1024, S, E, cx.tid); }
}
DI void ph_f2_mmB(const Ctx& cx, const Params& p, float* lds, bool with_ctx, const void* xin_lat, const void* xin_ctx, bf16_t* xo_lat, const float* modl) {
    { mm::BatchSched S; S.init(p.A2, p.ZT, (size_t)1024 * 4096 * 2, 16, 2048, 1024, 4096, cx.nblk, cx.bid); mm::EpiResidB E{xin_lat, xin_ctx, xo_lat, p.cs, modl, 1, 0}; mm::gemm_phase(GEMM_LDS(lds), 4096, S, E, cx.tid); }
    if (with_ctx) { mm::BatchSched S; S.init(p.A2c, p.ZTC, (size_t)1024 * 512 * 2, 16, 256, 1024, 512, cx.nblk, cx.bid); mm::EpiResidB E{xin_lat, xin_ctx, xo_lat, p.cs, modl, -1, 0}; mm::gemm_phase(GEMM_LDS(lds), 512, S, E, cx.tid); }
}
DI void ph_f2_mm(const Ctx& cx, const Params& p, float* lds, bool with_ctx, const float* xin_lat, const float* xin_ctx, const float* modl) {
    { mm::BatchSched S; S.init(p.A2, p.ZT, (size_t)1024 * 4096 * 2, 16, 2048, 1024, 4096, cx.nblk, cx.bid); mm::EpiResid E{xin_lat, xin_ctx, p.out, p.ctxs, modl, 1}; mm::gemm_phase(GEMM_LDS(lds), 4096, S, E, cx.tid); }
    if (with_ctx) { mm::BatchSched S; S.init(p.A2c, p.ZTC, (size_t)1024 * 512 * 2, 16, 256, 1024, 512, cx.nblk, cx.bid); mm::EpiResid E{xin_lat, xin_ctx, p.out, p.ctxs, modl, -1}; mm::gemm_phase(GEMM_LDS(lds), 512, S, E, cx.tid); }
}
struct MoeSched {
    static constexpr bool GATHER = true, TABLE = true;
    const char* A; const char* Bt; const int* slot; const float* slotw; const int* tab; int lda, K, G, c, down;
    DI void tab_dma(const mm::Unit& u, LAS unsigned char* dst, int tid) const {
        const int Me = __builtin_amdgcn_readfirstlane(tab[32 + u.e]); const int r = tid & 255; int idx = u.m * 256 + r; idx = idx < Me ? idx : 0;
        const size_t off = (u.e < 16) ? (size_t)u.e * NT + idx : 0;
        const unsigned* src = (tid < 256) ? (const unsigned*)(slot + off) : (const unsigned*)(slotw + off);
        __builtin_amdgcn_global_load_lds(src, (LAS unsigned*)(dst + (tid >> 6) * 256), 4, 0, 0);
    }
    DI size_t hstep_a() const { return 0; }
    DI bool next(int i, mm::Unit& u) const {
        const int L = i * G + c; const int total = __builtin_amdgcn_readfirstlane(tab[17]);
        if (L >= total * 4) return false;
        const int rtg = L >> 2; int e = 0;
        for (int q = 1; q < 17; ++q) e += (__builtin_amdgcn_readfirstlane(tab[q]) <= rtg) ? 1 : 0;
        u.e = e; u.m = rtg - __builtin_amdgcn_readfirstlane(tab[e]); u.pm = u.m; u.pn = L & 3;
        u.A = A; u.B = Bt + ((size_t)e * 1024 + (size_t)u.pn * 256) * K * 2; return true;
    }
    DI unsigned rowoff(const mm::Unit& u, int Me, int idx, int C) const {
        int row;
        if (u.e < 16) { const int s = (idx < Me) ? slot[(size_t)u.e * NT + idx] : 0; row = down ? ((s & 1) * NT + (s >> 1)) : (s >> 1); }
        else row = down ? (2 * NT + idx) : idx;
        return (unsigned)(row * lda + C) * 2u;
    }
    DI unsigned rowoff_s(const mm::Unit& u, int s, int r, int C) const { int row; if (u.e < 16) row = down ? ((s & 1) * NT + (s >> 1)) : (s >> 1); else row = down ? (2 * NT + u.m * 256 + r) : (u.m * 256 + r); return (unsigned)(row * lda + C) * 2u; }
    DI void aoff_lds(const mm::Unit& u, const LAS int* et, int R0, int C0, int R1, int C1, unsigned (&o)[2][2]) const {
        o[0][0] = rowoff_s(u, et[R0], R0, C0); o[0][1] = rowoff_s(u, et[R1], R1, C1); o[1][0] = rowoff_s(u, et[128 + R0], 128 + R0, C0); o[1][1] = rowoff_s(u, et[128 + R1], 128 + R1, C1);
    }
    DI void aoff(const mm::Unit& u, int R0, int C0, int R1, int C1, unsigned (&o)[2][2]) const {
        const int Me = __builtin_amdgcn_readfirstlane(tab[32 + u.e]), base = u.m * 256;
        o[0][0] = rowoff(u, Me, base + R0, C0); o[0][1] = rowoff(u, Me, base + R1, C1);
        o[1][0] = rowoff(u, Me, base + 128 + R0, C0); o[1][1] = rowoff(u, Me, base + 128 + R1, C1);
    }
};
DI void moe_table(const Ctx& cx, const Params& p, int* tab, int layer, int nrows) {
    if (cx.tid == 0) { int acc = 0;
        for (int e = 0; e < 17; ++e) { const int M = (e < 16) ? p.cnt[(layer * 16 + e) * 64] : nrows; tab[e] = acc; tab[32 + e] = M; acc += (M + 255) >> 8; }
        tab[17] = acc; }
    __syncthreads();
}
DI void lds_read8(const LAS int* base, int r0, int (&o)[8]) {
    const unsigned a = (unsigned)(size_t)(base + r0);
    asm volatile("ds_read_b32 %0, %8\n\tds_read_b32 %1, %8 offset:64\n\tds_read_b32 %2, %8 offset:128\n\tds_read_b32 %3, %8 offset:192\n\t"
                 "ds_read_b32 %4, %8 offset:512\n\tds_read_b32 %5, %8 offset:576\n\tds_read_b32 %6, %8 offset:640\n\tds_read_b32 %7, %8 offset:704\n\ts_waitcnt lgkmcnt(0)"
                 : "=&v"(o[0]), "=&v"(o[1]), "=&v"(o[2]), "=&v"(o[3]), "=&v"(o[4]), "=&v"(o[5]), "=&v"(o[6]), "=&v"(o[7]) : "v"(a) : "memory");
}
struct EpiSwiglu {
    static constexpr bool PERM = true;
    bf16_t* ACT; const int* slot; const int* tab; const LAS int* etab;
    DI void operator()(const mm::f32x4 (&acc)[2][2][4][2], const mm::Unit& u, int wr, int wc, int fr, int fq) const {
        const int Me = __builtin_amdgcn_readfirstlane(tab[32 + u.e]); const int col = u.pn * 128 + wc * 32 + 8 * fq; const LAS int* et = etab + u.tb * 512;
        int sl8[8]; lds_read8(et, wr * 64 + fr, sl8);
#pragma unroll
        for (int ai = 0; ai < 2; ++ai)
#pragma unroll
            for (int m = 0; m < 4; ++m) {
                const int idx = u.m * 256 + ai * 128 + wr * 64 + m * 16 + fr;
                if (idx < Me) {
                    int drow; if (u.e < 16) { const int s = sl8[ai * 4 + m]; drow = (s & 1) * NT + (s >> 1); } else drow = 2 * NT + idx;
                    float o[8];
#pragma unroll
                    for (int n = 0; n < 2; ++n)
#pragma unroll
                        for (int c = 0; c < 4; ++c) { const float g = acc[ai][0][m][n][c], uu = acc[ai][1][m][n][c]; o[n * 4 + c] = g * __builtin_amdgcn_rcpf(1.f + __expf(-g)) * uu; }
                    mm::u32x4 w; w.x = mm::cvt_pk_bf16(o[0], o[1]); w.y = mm::cvt_pk_bf16(o[2], o[3]); w.z = mm::cvt_pk_bf16(o[4], o[5]); w.w = mm::cvt_pk_bf16(o[6], o[7]);
                    *(mm::u32x4*)(ACT + (size_t)drow * 512 + col) = w;
                }
            }
    }
};
struct EpiDown {
    static constexpr bool PERM = true;
    bf16_t* Y; const int* slot; const float* tokw; const int* tab; const LAS int* etab;
    DI void operator()(const mm::f32x4 (&acc)[2][2][4][2], const mm::Unit& u, int wr, int wc, int fr, int fq) const {
        const int Me = __builtin_amdgcn_readfirstlane(tab[32 + u.e]); const int col = u.pn * 256 + wc * 32 + 8 * fq; const LAS int* et = etab + u.tb * 512;
        int sl8[8], sw8[8]; lds_read8(et, wr * 64 + fr, sl8); lds_read8(et + 256, wr * 64 + fr, sw8);
#pragma unroll
        for (int ai = 0; ai < 2; ++ai)
#pragma unroll
            for (int m = 0; m < 4; ++m) {
                const int idx = u.m * 256 + ai * 128 + wr * 64 + m * 16 + fr;
                if (idx < Me) {
                    int drow; float w = 1.f;
                    if (u.e < 16) { const int s = sl8[ai * 4 + m]; drow = (s & 1) * NT + (s >> 1); w = __int_as_float(sw8[ai * 4 + m]); } else drow = 2 * NT + idx;
#pragma unroll
                    for (int bj = 0; bj < 2; ++bj) { const mm::f32x4 v0 = acc[ai][bj][m][0] * w, v1 = acc[ai][bj][m][1] * w;
                        mm::u32x4 o; o.x = mm::cvt_pk_bf16(v0[0], v0[1]); o.y = mm::cvt_pk_bf16(v0[2], v0[3]); o.z = mm::cvt_pk_bf16(v1[0], v1[1]); o.w = mm::cvt_pk_bf16(v1[2], v1[3]);
                        *(mm::u32x4*)(Y + (size_t)drow * 1024 + col + bj * 128) = o; }
                }
            }
    }
};
DI void ph_moe_up_mm(const Ctx& cx, const Params& p, float* lds, int layer, int nrows) {
    int* tab = (int*)(lds + 32768); moe_table(cx, p, tab, layer, nrows);
    MoeSched S{(const char*)p.H, (const char*)p.WguT, p.slot, p.slotw, tab, 1024, 1024, cx.nblk, cx.bid, 0};
    EpiSwiglu E{p.ACT, p.slot, tab, (const LAS int*)((LAS float*)lds + 32768 + 256)};
    mm::gemm_phase(GEMM_LDS(lds), 1024, S, E, cx.tid);
}
DI void ph_moe_down_mm(const Ctx& cx, const Params& p, float* lds, int layer, int nrows) {
    int* tab = (int*)(lds + 32768); moe_table(cx, p, tab, layer, nrows);
    MoeSched S{(const char*)p.ACT, (const char*)p.WdT, p.slot, p.slotw, tab, 512, 512, cx.nblk, cx.bid, 1};
    EpiDown E{p.Y, p.slot, p.tokw, tab, (const LAS int*)((LAS float*)lds + 32768 + 256)};
    mm::gemm_phase(GEMM_LDS(lds), 512, S, E, cx.tid);
}

namespace att {
typedef short bf16x8 __attribute__((ext_vector_type(8)));
typedef float f32x16 __attribute__((ext_vector_type(16)));
typedef unsigned u32x4 __attribute__((ext_vector_type(4)));
typedef unsigned u32x2 __attribute__((ext_vector_type(2)));
typedef __bf16 bf16x2_t __attribute__((ext_vector_type(2)));
typedef float f32x2_t __attribute__((ext_vector_type(2)));
constexpr int KP = 208, VP = 264, KT_BYTES = 128 * KP, VT_BYTES = 64 * VP, BUF = KT_BYTES + VT_BYTES;
DI unsigned pk(float a, float b) { f32x2_t f = {a, b}; bf16x2_t h = __builtin_convertvector(f, bf16x2_t); return __builtin_bit_cast(unsigned, h); }
#define ATT_MFMA(a, b, c) __builtin_amdgcn_mfma_f32_32x32x16_bf16((a), (b), (c), 0, 0, 0)
}
DI void ph_attn_mm(const Ctx& cx, const Params& p, float* ldsf, bool with_ctx) {
    using namespace att;
    LAS unsigned char* lds = (LAS unsigned char*)ldsf;
    const int tid = cx.tid, wid = __builtin_amdgcn_readfirstlane(tid >> 6), lane = tid & 63, r = lane & 31, hh = lane >> 5;
    const int nunits = 1024 + (with_ctx ? 128 : 0);
    int kg[3], kl[3], vg[2], vl[2];
#pragma unroll
    for (int i = 0; i < 3; ++i) { const int c = tid + 512 * i, row = c / 12, part = c % 12; kg[i] = row * 96 + part * 8; kl[i] = row * KP + part * 16; }
#pragma unroll
    for (int i = 0; i < 2; ++i) { const int c = tid + 512 * i, row = c >> 4, part = c & 15; vg[i] = row * 2304 + part * 8; vl[i] = KT_BYTES + row * VP + part * 16; }
    for (int u = cx.bid; u < nunits; u += cx.nblk) {
        int bh, qrow0, nkeys;
        if (u < 1024) { bh = u >> 3; qrow0 = (bh >> 3) * 2048 + (u & 7) * 256; nkeys = 2304; }
        else { bh = u - 1024; qrow0 = NLAT + (bh >> 3) * 256; nkeys = 256; }
        const int h = bh & 7;
        const bf16_t* Kb = p.Kf + (size_t)bh * 2304 * 96; const bf16_t* Vb = p.Vt + (size_t)bh * 64 * 2304;
        const bf16_t* qp = p.Qraw + (size_t)(qrow0 + wid * 32 + r) * 768 + h * 96 + 8 * hh;
        bf16x8 qf[6];
#pragma unroll
        for (int s = 0; s < 6; ++s) qf[s] = *(const bf16x8*)(qp + 16 * s);
        f32x16 ot0, ot1;
#pragma unroll
        for (int i = 0; i < 16; ++i) { ot0[i] = 0.f; ot1[i] = 0.f; }
        float mrun = -3.0e38f, lrun = 0.f;
        const int ntiles = nkeys >> 7;
        u32x4 kr[3], vr[2];
#pragma unroll
        for (int i = 0; i < 3; ++i) kr[i] = *(const u32x4*)(Kb + kg[i]);
#pragma unroll
        for (int i = 0; i < 2; ++i) vr[i] = *(const u32x4*)(Vb + vg[i]);
#pragma unroll
        for (int i = 0; i < 3; ++i) *(LAS u32x4*)(lds + kl[i]) = kr[i];
#pragma unroll
        for (int i = 0; i < 2; ++i) { *(LAS u32x2*)(lds + vl[i]) = (u32x2){vr[i].x, vr[i].y}; *(LAS u32x2*)(lds + vl[i] + 8) = (u32x2){vr[i].z, vr[i].w}; }
        __syncthreads();
        for (int it = 0; it < ntiles; ++it) {
            const int bo = (it & 1) * BUF, bn = ((it + 1) & 1) * BUF;
            const bool more = (it + 1 < ntiles);
            if (more) {
                const bf16_t* Kn = Kb + (size_t)(it + 1) * 128 * 96; const bf16_t* Vn = Vb + (it + 1) * 128;
#pragma unroll
                for (int i = 0; i < 3; ++i) kr[i] = *(const u32x4*)(Kn + kg[i]);
#pragma unroll
                for (int i = 0; i < 2; ++i) vr[i] = *(const u32x4*)(Vn + vg[i]);
            }
            f32x16 st[4];
#pragma unroll
            for (int kb = 0; kb < 4; ++kb) {
#pragma unroll
                for (int i = 0; i < 16; ++i) st[kb][i] = 0.f;
#pragma unroll
                for (int s = 0; s < 6; ++s) { const bf16x8 kf = *(const LAS bf16x8*)(lds + bo + (kb * 32 + r) * KP + 32 * s + 16 * hh); st[kb] = ATT_MFMA(kf, qf[s], st[kb]); }
            }
            float mt = st[0][0];
#pragma unroll
            for (int kb = 0; kb < 4; ++kb)
#pragma unroll
                for (int i = 0; i < 16; ++i) mt = fmaxf(mt, st[kb][i]);
            mt = fmaxf(mt, __shfl_xor(mt, 32));
            const float mnew = fmaxf(mrun, mt), alpha = __builtin_amdgcn_exp2f(mrun - mnew);
            mrun = mnew;
            float ps = 0.f;
#pragma unroll
            for (int kb = 0; kb < 4; ++kb)
#pragma unroll
                for (int i = 0; i < 16; ++i) { st[kb][i] = __builtin_amdgcn_exp2f(st[kb][i] - mnew); ps += st[kb][i]; }
            lrun = lrun * alpha + ps;
#pragma unroll
            for (int i = 0; i < 16; ++i) { ot0[i] *= alpha; ot1[i] *= alpha; }
#pragma unroll
            for (int kb = 0; kb < 4; ++kb)
#pragma unroll
                for (int s = 0; s < 2; ++s) {
                    u32x4 pw; pw.x = pk(st[kb][8 * s], st[kb][8 * s + 1]); pw.y = pk(st[kb][8 * s + 2], st[kb][8 * s + 3]); pw.z = pk(st[kb][8 * s + 4], st[kb][8 * s + 5]); pw.w = pk(st[kb][8 * s + 6], st[kb][8 * s + 7]);
                    const bf16x8 pb = __builtin_bit_cast(bf16x8, pw);
                    const int col = (kb * 32 + 16 * s + 4 * hh) * 2;
                    const u32x2 a0 = *(const LAS u32x2*)(lds + bo + KT_BYTES + r * VP + col), a1 = *(const LAS u32x2*)(lds + bo + KT_BYTES + r * VP + col + 16);
                    const u32x2 b0 = *(const LAS u32x2*)(lds + bo + KT_BYTES + (32 + r) * VP + col), b1 = *(const LAS u32x2*)(lds + bo + KT_BYTES + (32 + r) * VP + col + 16);
                    const u32x4 va = {a0.x, a0.y, a1.x, a1.y}, vb = {b0.x, b0.y, b1.x, b1.y};
                    ot0 = ATT_MFMA(__builtin_bit_cast(bf16x8, va), pb, ot0);
                    ot1 = ATT_MFMA(__builtin_bit_cast(bf16x8, vb), pb, ot1);
                }
            if (more) {
#pragma unroll
                for (int i = 0; i < 3; ++i) *(LAS u32x4*)(lds + bn + kl[i]) = kr[i];
#pragma unroll
                for (int i = 0; i < 2; ++i) { *(LAS u32x2*)(lds + bn + vl[i]) = (u32x2){vr[i].x, vr[i].y}; *(LAS u32x2*)(lds + bn + vl[i] + 8) = (u32x2){vr[i].z, vr[i].w}; }
            }
            __syncthreads();
        }
        const float il = 1.f / (lrun + __shfl_xor(lrun, 32));
        bf16_t* op = p.H + (size_t)(qrow0 + wid * 32 + r) * 1024 + 512 + h * 64 + 4 * hh;
#pragma unroll
        for (int g = 0; g < 4; ++g) {
            u32x2 w0 = {pk(ot0[4 * g] * il, ot0[4 * g + 1] * il), pk(ot0[4 * g + 2] * il, ot0[4 * g + 3] * il)};
            u32x2 w1 = {pk(ot1[4 * g] * il, ot1[4 * g + 1] * il), pk(ot1[4 * g + 2] * il, ot1[4 * g + 3] * il)};
            *(u32x2*)(op + 8 * g) = w0; *(u32x2*)(op + 32 + 8 * g) = w1;
        }
    }
}

namespace scan {
typedef float f32x2 __attribute__((ext_vector_type(2)));
constexpr int REC = 400, CH = 32, BUFF = CH * REC, YOFF = 2 * BUFF;
DI float dppf(float v, int ctrl_sel) {
    const int x = __builtin_bit_cast(int, v);
    int r;
    if (ctrl_sel == 0) r = __builtin_amdgcn_update_dpp(0, x, 0xB1, 0xf, 0xf, true);
    else if (ctrl_sel == 1) r = __builtin_amdgcn_update_dpp(0, x, 0x4E, 0xf, 0xf, true);
    else r = __builtin_amdgcn_update_dpp(0, x, 0x141, 0xf, 0xf, true);
    return __builtin_bit_cast(float, r);
}
DI float red8(float v) { v += dppf(v, 0); v += dppf(v, 1); v += dppf(v, 2); return v; }
}
template <int ABL>
DI void ph_scan_opt(const Ctx& cx, const Params& p, float* lds, int j) {
    using namespace scan;
    const int tid = cx.tid, wid = __builtin_amdgcn_readfirstlane(tid >> 6), lane = tid & 63;
    for (int item = cx.bid; item < 256; item += cx.nblk) {
        const int b = item >> 4, h = (item >> 1) & 7, dir = item & 1;
        bf16_t* yout = dir ? p.YB : p.YF;
        if (wid >= 4) {
            const int pw = wid - 4, hc = h * 64 + lane;
            const float kkc = p.a_k_k[j * 512 + hc], kac = p.a_k_a[j * 512 + hc];
            const float mur = p.a_mu[j * ACOLS + hc], muk = p.a_mu[j * ACOLS + 512 + hc], muv = p.a_mu[j * ACOLS + 1024 + hc];
            LAS float* L = (LAS float*)lds;
            bf16_t raw[8][11];
#define SCAN_ROW(stepv, row_, t_, T_) const bool cp_ = (stepv) < 256; const int tt_ = cp_ ? (stepv) : (stepv) - 256, T_ = cp_ ? 256 : 2048, t_ = dir ? (T_ - 1 - tt_) : tt_; const int row_ = cp_ ? NLAT + b * 256 + t_ : b * 2048 + t_
#define SCAN_LOAD(cc) do { _Pragma("unroll") for (int it = 0; it < 8; ++it) { const int step = (cc) * CH + pw + 4 * it; SCAN_ROW(step, row, t, T); \
                const int rp_ = (t > 0) ? row - 1 : row, rn_ = (t < T - 1) ? row + 1 : row; \
                const bf16_t* pc = p.P + (size_t)row * PLD + hc; const bf16_t* pp = p.P + (size_t)rp_ * PLD + hc; const bf16_t* pn = p.P + (size_t)rn_ * PLD + hc; \
                raw[it][0] = pc[0]; raw[it][1] = pp[0]; raw[it][2] = pn[0]; raw[it][3] = pc[512]; raw[it][4] = pp[512]; raw[it][5] = pn[512]; raw[it][6] = pc[1024]; raw[it][7] = pp[1024]; raw[it][8] = pn[1024]; \
                raw[it][9] = p.WAG[(size_t)row * WLD + dir * 512 + hc]; raw[it][10] = p.WAG[(size_t)row * WLD + 1024 + dir * 512 + hc]; } } while (0)
            if (ABL != 1) SCAN_LOAD(0);
            for (int c = 0; c <= 73; ++c) {
                if (c >= 2 && ABL == 0) {
                    const LAS float* yb = L + YOFF + ((c - 2) & 1) * (CH * 64);
#pragma unroll
                    for (int it = 0; it < 8; ++it) {
                        const int sl = pw + 4 * it, step = (c - 2) * CH + sl; SCAN_ROW(step, row, t, T);
                        yout[(size_t)row * 512 + hc] = f2bf(yb[sl * 64 + lane]);
                    }
                }
                if (c < 72 && ABL != 1) {
                    LAS float* buf = L + (c & 1) * BUFF;
#pragma unroll
                    for (int it = 0; it < 8; ++it) {
                        const int sl = pw + 4 * it, step = c * CH + sl; SCAN_ROW(step, row, t, T); (void)row;
                        const float mp = (t > 0) ? 0.5f : 0.f, mn = (t < T - 1) ? 0.5f : 0.f;
                        const float rc = bf2f(raw[it][0]), kc_ = bf2f(raw[it][3]), vc = bf2f(raw[it][6]);
                        const float R = rc + mur * (mp * bf2f(raw[it][1]) + mn * bf2f(raw[it][2]) - rc);
                        const float K = kc_ + muk * (mp * bf2f(raw[it][4]) + mn * bf2f(raw[it][5]) - kc_);
                        const float V = vc + muv * (mp * bf2f(raw[it][7]) + mn * bf2f(raw[it][8]) - vc);
                        const float w = 1.f - bf2f(raw[it][9]), a = bf2f(raw[it][10]);
                        const float kkv = K * kkc, ssq = wave_sum(kkv * kkv), kk = kkv * rsqrtf(ssq + 1e-12f);
                        const float kd = K * (1.f + (a - 1.f) * kac), bd = kk * a;
                        const float br = wave_sum(bd * R), kr = wave_sum(kd * R);
                        LAS float* rec = buf + sl * REC;
                        rec[lane] = w; rec[64 + lane] = -kk; rec[128 + lane] = bd; rec[192 + lane] = kd; rec[256 + lane] = w * R; rec[320 + lane] = V;
                        if (lane == 0) { rec[384] = br; rec[385] = kr; }
                    }
                    if (c + 1 < 72) SCAN_LOAD(c + 1);
                }
                __syncthreads();
            }
#undef SCAN_LOAD
#undef SCAN_ROW
        } else {
            const int ct = tid, rp = ct >> 3, k8 = ct & 7;
            float S0[8], S1[8];
#pragma unroll
            for (int q = 0; q < 8; ++q) { S0[q] = 0.f; S1[q] = 0.f; }
            __syncthreads();
            for (int c = 0; c < 72; ++c) {
                const LAS float* buf = (const LAS float*)lds + (c & 1) * BUFF; LAS float* yb = (LAS float*)lds + YOFF + (c & 1) * (CH * 64);
                mm::f32x4 cw0, cw1, cn0, cn1, cb0, cb1, cd0, cd1, cr0, cr1; scan::f32x2 cvv, csc;
#define SCAN_LD(recp, W0, W1, N0, N1, B0, B1, D0, D1, R0_, R1_, VV, SC) do { const LAS float* r_ = (recp); \
                    W0 = *(const LAS mm::f32x4*)(r_ + k8 * 8); W1 = *(const LAS mm::f32x4*)(r_ + k8 * 8 + 4); N0 = *(const LAS mm::f32x4*)(r_ + 64 + k8 * 8); N1 = *(const LAS mm::f32x4*)(r_ + 64 + k8 * 8 + 4); \
                    B0 = *(const LAS mm::f32x4*)(r_ + 128 + k8 * 8); B1 = *(const LAS mm::f32x4*)(r_ + 128 + k8 * 8 + 4); D0 = *(const LAS mm::f32x4*)(r_ + 192 + k8 * 8); D1 = *(const LAS mm::f32x4*)(r_ + 192 + k8 * 8 + 4); \
                    R0_ = *(const LAS mm::f32x4*)(r_ + 256 + k8 * 8); R1_ = *(const LAS mm::f32x4*)(r_ + 256 + k8 * 8 + 4); VV = *(const LAS scan::f32x2*)(r_ + 320 + 2 * rp); SC = *(const LAS scan::f32x2*)(r_ + 384); } while (0)
                SCAN_LD(buf, cw0, cw1, cn0, cn1, cb0, cb1, cd0, cd1, cr0, cr1, cvv, csc);
#pragma unroll 2
                for (int sl = 0; sl < (ABL == 2 ? 0 : CH); ++sl) {
                    mm::f32x4 nw0, nw1, nn0, nn1, nb0, nb1, nd0, nd1, nr0, nr1; scan::f32x2 nvv, nsc;
                    SCAN_LD(buf + (sl + 1 < CH ? sl + 1 : sl) * REC, nw0, nw1, nn0, nn1, nb0, nb1, nd0, nd1, nr0, nr1, nvv, nsc);
                    const float wv[8] = {cw0[0], cw0[1], cw0[2], cw0[3], cw1[0], cw1[1], cw1[2], cw1[3]}, nv[8] = {cn0[0], cn0[1], cn0[2], cn0[3], cn1[0], cn1[1], cn1[2], cn1[3]};
                    const float bv[8] = {cb0[0], cb0[1], cb0[2], cb0[3], cb1[0], cb1[1], cb1[2], cb1[3]}, dv[8] = {cd0[0], cd0[1], cd0[2], cd0[3], cd1[0], cd1[1], cd1[2], cd1[3]};
                    const float rv[8] = {cr0[0], cr0[1], cr0[2], cr0[3], cr1[0], cr1[1], cr1[2], cr1[3]};
                    float sa0 = 0.f, sa1 = 0.f, y0 = 0.f, y1 = 0.f;
#pragma unroll
                    for (int q = 0; q < 8; ++q) { sa0 += S0[q] * nv[q]; sa1 += S1[q] * nv[q]; y0 += S0[q] * rv[q]; y1 += S1[q] * rv[q]; }
                    sa0 = red8(sa0); sa1 = red8(sa1); y0 = red8(y0); y1 = red8(y1);
                    y0 += sa0 * csc[0] + cvv[0] * csc[1]; y1 += sa1 * csc[0] + cvv[1] * csc[1];
#pragma unroll
                    for (int q = 0; q < 8; ++q) { S0[q] = S0[q] * wv[q] + sa0 * bv[q] + cvv[0] * dv[q]; S1[q] = S1[q] * wv[q] + sa1 * bv[q] + cvv[1] * dv[q]; }
                    if (k8 == 0) *(LAS scan::f32x2*)(yb + sl * 64 + 2 * rp) = (scan::f32x2){y0, y1};
                    cw0 = nw0; cw1 = nw1; cn0 = nn0; cn1 = nn1; cb0 = nb0; cb1 = nb1; cd0 = nd0; cd1 = nd1; cr0 = nr0; cr1 = nr1; cvv = nvv; csc = nsc;
                }
#undef SCAN_LD
                __syncthreads();
            }
            __syncthreads();
        }
    }
}

namespace sc2 {
typedef short bf16x8 __attribute__((ext_vector_type(8)));
typedef float f32x4 __attribute__((ext_vector_type(4)));
typedef unsigned u32x4 __attribute__((ext_vector_type(4)));
typedef unsigned u32x2 __attribute__((ext_vector_type(2)));
constexpr int NP = 6;
constexpr int O_AH = 0, O_RH = 2048, O_BK = 4096, O_VM = 8192, O_GC = 10240, O_AAB = 10496, O_AAK = 11520, O_ARK = 12032, O_BH = 13056, O_KH = 15104, SLOT = 17152;
constexpr int O_S0 = NP * SLOT, O_RHS = O_S0 + 8192, O_ZU = O_RHS + 4096, O_FLAG = O_ZU + 2048, TOTAL = O_FLAG + 256;
#define SC_MFMA(a, b, c) __builtin_amdgcn_mfma_f32_16x16x32_bf16((a), (b), (c), 0, 0, 0)
DI unsigned pk2(float a, float b) { return att::pk(a, b); }
DI int ldv(volatile LAS int* p) { return *p; }
}
template <int ABL>
DI void ph_scan_chunk(const Ctx& cx, const Params& p, float* ldsg, int j) {
    using namespace sc2;
    static_assert(TOTAL <= 128 * 1024, "scan LDS map");
    LAS unsigned char* L = (LAS unsigned char*)ldsg;
    volatile LAS int* ready = (volatile LAS int*)(L + O_FLAG); volatile LAS int* done = ready + 8;
    const int tid = cx.tid, wid = __builtin_amdgcn_readfirstlane(tid >> 6), lane = tid & 63, lq = lane >> 4, lr = lane & 15;
    constexpr int NCH = 144;
    for (int item = cx.bid; item < 256; item += cx.nblk) {
        const int b = item >> 4, h = (item >> 1) & 7, dir = item & 1;
        bf16_t* yout = dir ? p.YB : p.YF;
        __syncthreads();
        if (tid < 16) ready[tid] = 0;
        __syncthreads();
#define SC_ROW(stepv, row_, t_, T_) const bool cp_ = (stepv) < 256; const int tt_ = cp_ ? (stepv) : (stepv) - 256, T_ = cp_ ? 256 : 2048, t_ = dir ? (T_ - 1 - tt_) : tt_; const int row_ = cp_ ? NLAT + b * 256 + t_ : b * 2048 + t_
        if (wid == 0) {
            __builtin_amdgcn_s_setprio(3);
            f32x4 S[4][4];
#pragma unroll
            for (int kb = 0; kb < 4; ++kb)
#pragma unroll
                for (int vb = 0; vb < 4; ++vb) S[kb][vb] = (f32x4){0.f, 0.f, 0.f, 0.f};
            for (int c = 0; c < NCH; ++c) {
                const int sl = c % NP; LAS unsigned char* SB = L + sl * SLOT;
                { unsigned spins = 0; while (ldv(ready + sl) != c + 1) { __builtin_amdgcn_s_sleep(1); if (++spins > (1u << 22)) break; } }
                asm volatile("" ::: "memory");
                if (ABL == 2) { if (lane == 0) done[sl] = c + 1; continue; }
                f32x4 cA[8][2];
#pragma unroll
                for (int t = 1; t <= 8; ++t)
#pragma unroll
                    for (int q = 0; q < 2; ++q) if (4 * q < t) cA[t - 1][q] = *(const LAS f32x4*)(SB + O_AAB + t * 64 + q * 16);
#pragma unroll
                for (int kb = 0; kb < 4; ++kb)
#pragma unroll
                    for (int vb = 0; vb < 4; ++vb) { const f32x4 x = S[kb][vb]; *(LAS u32x2*)(L + O_S0 + (16 * vb + lr) * 128 + (16 * kb + 4 * lq) * 2) = (u32x2){pk2(x[0], x[1]), pk2(x[2], x[3])}; }
                {
                    bf16x8 ah[2], ak, sf[4][2], vmf[4];
#pragma unroll
                    for (int ks = 0; ks < 2; ++ks) ah[ks] = *(const LAS bf16x8*)(SB + O_AH + lr * 128 + ks * 64 + lq * 16);
                    { u32x4 z = {0u, 0u, 0u, 0u}; if (lq < 2) z = *(const LAS u32x4*)(SB + O_AAK + lr * 32 + lq * 16); ak = __builtin_bit_cast(bf16x8, z); }
#pragma unroll
                    for (int vb = 0; vb < 4; ++vb) {
#pragma unroll
                        for (int ks = 0; ks < 2; ++ks) sf[vb][ks] = *(const LAS bf16x8*)(L + O_S0 + (16 * vb + lr) * 128 + ks * 64 + lq * 16);
                        u32x4 z = {0u, 0u, 0u, 0u}; if (lq < 2) z = *(const LAS u32x4*)(SB + O_VM + (16 * vb + lr) * 32 + lq * 16); vmf[vb] = __builtin_bit_cast(bf16x8, z);
                    }
                    f32x4 acc[4];
#pragma unroll
                    for (int vb = 0; vb < 4; ++vb) { acc[vb] = (f32x4){0.f, 0.f, 0.f, 0.f}; acc[vb] = SC_MFMA(sf[vb][0], ah[0], acc[vb]); acc[vb] = SC_MFMA(sf[vb][1], ah[1], acc[vb]); acc[vb] = SC_MFMA(vmf[vb], ak, acc[vb]); }
#pragma unroll
                    for (int vb = 0; vb < 4; ++vb)
#pragma unroll
                        for (int q = 0; q < 4; ++q) *(LAS float*)(L + O_RHS + ((16 * vb + 4 * lq + q) * 16 + lr) * 4) = acc[vb][q];
                }
                float u[16];
                { const LAS f32x4* rp = (const LAS f32x4*)(L + O_RHS + lane * 64);
#pragma unroll
                  for (int q = 0; q < 4; ++q) { const f32x4 x = rp[q]; u[4 * q] = x[0]; u[4 * q + 1] = x[1]; u[4 * q + 2] = x[2]; u[4 * q + 3] = x[3]; } }
#define SC_SUBST(t, CF) do { float a0 = u[t], a1 = 0.f; \
                    _Pragma("unroll") for (int q = 0; q < 4; ++q) { if (4 * q < (t)) { const f32x4 cf = CF[q]; \
                        _Pragma("unroll") for (int e = 0; e < 4; ++e) { if (4 * q + e < (t)) { if (e & 1) a1 += cf[e] * u[4 * q + e]; else a0 += cf[e] * u[4 * q + e]; } } } } \
                    u[t] = a0 + a1; } while (0)
                f32x4 cB[4][3], cC[3][4];
#pragma unroll
                for (int t = 9; t <= 12; ++t)
#pragma unroll
                    for (int q = 0; q < 3; ++q) cB[t - 9][q] = *(const LAS f32x4*)(SB + O_AAB + t * 64 + q * 16);
                asm volatile("" ::: "memory");
                SC_SUBST(1, cA[0]); SC_SUBST(2, cA[1]); SC_SUBST(3, cA[2]); SC_SUBST(4, cA[3]); SC_SUBST(5, cA[4]); SC_SUBST(6, cA[5]); SC_SUBST(7, cA[6]); SC_SUBST(8, cA[7]);
                asm volatile("" ::: "memory");
#pragma unroll
                for (int t = 13; t <= 15; ++t)
#pragma unroll
                    for (int q = 0; q < 4; ++q) cC[t - 13][q] = *(const LAS f32x4*)(SB + O_AAB + t * 64 + q * 16);
                asm volatile("" ::: "memory");
                SC_SUBST(9, cB[0]); SC_SUBST(10, cB[1]); SC_SUBST(11, cB[2]); SC_SUBST(12, cB[3]);
                SC_SUBST(13, cC[0]); SC_SUBST(14, cC[1]); SC_SUBST(15, cC[2]);
#undef SC_SUBST
                { u32x4 w0 = {pk2(u[0], u[1]), pk2(u[2], u[3]), pk2(u[4], u[5]), pk2(u[6], u[7])}, w1 = {pk2(u[8], u[9]), pk2(u[10], u[11]), pk2(u[12], u[13]), pk2(u[14], u[15])};
                  *(LAS u32x4*)(L + O_ZU + lane * 32) = w0; *(LAS u32x4*)(L + O_ZU + lane * 32 + 16) = w1; }
                {
                    bf16x8 zf[4], sf[4][2], bkf[4]; f32x4 gc[4];
#pragma unroll
                    for (int vb = 0; vb < 4; ++vb) {
                        zf[vb] = (lq < 2) ? *(const LAS bf16x8*)(L + O_ZU + (16 * vb + lr) * 32 + lq * 16) : *(const LAS bf16x8*)(SB + O_VM + (16 * vb + lr) * 32 + (lq - 2) * 16);
#pragma unroll
                        for (int ks = 0; ks < 2; ++ks) sf[vb][ks] = *(const LAS bf16x8*)(L + O_S0 + (16 * vb + lr) * 128 + ks * 64 + lq * 16);
                    }
                    const bf16x8 rk = *(const LAS bf16x8*)(SB + O_ARK + lr * 64 + lq * 16);
                    const bf16x8 rh0 = *(const LAS bf16x8*)(SB + O_RH + lr * 128 + lq * 16), rh1 = *(const LAS bf16x8*)(SB + O_RH + lr * 128 + 64 + lq * 16);
#pragma unroll
                    for (int kb = 0; kb < 4; ++kb) { gc[kb] = *(const LAS f32x4*)(SB + O_GC + (16 * kb + 4 * lq) * 4); bkf[kb] = *(const LAS bf16x8*)(SB + O_BK + (16 * kb + lr) * 64 + lq * 16); }
                    const int step = c * 16 + lr; SC_ROW(step, row, tq, Tq); (void)tq; (void)Tq;
#pragma unroll
                    for (int vb = 0; vb < 4; ++vb) { f32x4 y = {0.f, 0.f, 0.f, 0.f};
                        y = SC_MFMA(sf[vb][0], rh0, y); y = SC_MFMA(sf[vb][1], rh1, y); y = SC_MFMA(zf[vb], rk, y);
                        if (ABL == 0) *(u32x2*)(yout + (size_t)row * 512 + h * 64 + 16 * vb + 4 * lq) = (u32x2){pk2(y[0], y[1]), pk2(y[2], y[3])}; else asm volatile("" :: "v"(y[0]), "v"(y[1]), "v"(y[2]), "v"(y[3])); }
#pragma unroll
                    for (int kb = 0; kb < 4; ++kb)
#pragma unroll
                        for (int vb = 0; vb < 4; ++vb) S[kb][vb] = SC_MFMA(bkf[kb], zf[vb], S[kb][vb] * gc[kb]);
                }
                asm volatile("s_waitcnt lgkmcnt(0)" ::: "memory");
                if (lane == 0) done[sl] = c + 1;
            }
            __builtin_amdgcn_s_setprio(0);
        } else if (wid != 4) {
            const int pw = (wid < 4) ? wid - 1 : wid - 2, hc = h * 64 + lane; LAS unsigned char* SB = L + pw * SLOT;
            const float kkc = p.a_k_k[j * 512 + hc], kac = p.a_k_a[j * 512 + hc];
            const float mur = p.a_mu[j * ACOLS + hc], muk = p.a_mu[j * ACOLS + 512 + hc], muv = p.a_mu[j * ACOLS + 1024 + hc];
            for (int c = pw; c < NCH; c += NP) {
                if (ABL == 1) { if (c >= NP) { unsigned spins = 0; while (ldv(done + pw) != c - NP + 1) { __builtin_amdgcn_s_sleep(2); if (++spins > (1u << 22)) break; } } if (lane == 0) ready[pw] = c + 1; continue; }
                bf16_t raw[16][11];
#define SC_LOAD(t) do { const int step = c * 16 + (t); SC_ROW(step, row, tq, Tq); \
                    const int rp_ = (tq > 0) ? row - 1 : row, rn_ = (tq < Tq - 1) ? row + 1 : row; \
                    const bf16_t* pc = p.P + (size_t)row * PLD + hc; const bf16_t* pp = p.P + (size_t)rp_ * PLD + hc; const bf16_t* pn = p.P + (size_t)rn_ * PLD + hc; \
                    raw[t][0] = pc[0]; raw[t][1] = pp[0]; raw[t][2] = pn[0]; raw[t][3] = pc[512]; raw[t][4] = pp[512]; raw[t][5] = pn[512]; raw[t][6] = pc[1024]; raw[t][7] = pp[1024]; raw[t][8] = pn[1024]; \
                    raw[t][9] = p.WAG[(size_t)row * WLD + dir * 512 + hc]; raw[t][10] = p.WAG[(size_t)row * WLD + 1024 + dir * 512 + hc]; } while (0)
#define SC_STEP(t) do { const int step = c * 16 + (t); SC_ROW(step, row, tq, Tq); (void)row; \
                    const float mp = (tq > 0) ? 0.5f : 0.f, mn = (tq < Tq - 1) ? 0.5f : 0.f; \
                    const float rc = bf2f(raw[t][0]), kc_ = bf2f(raw[t][3]), vc = bf2f(raw[t][6]); \
                    const float R = rc + mur * (mp * bf2f(raw[t][1]) + mn * bf2f(raw[t][2]) - rc); \
                    const float K = kc_ + muk * (mp * bf2f(raw[t][4]) + mn * bf2f(raw[t][5]) - kc_); \
                    const float Vv = vc + muv * (mp * bf2f(raw[t][7]) + mn * bf2f(raw[t][8]) - vc); \
                    const float w = 1.f - bf2f(raw[t][9]), a = bf2f(raw[t][10]); \
                    const float kkv = K * kkc, ssq = wave_sum(kkv * kkv), kk = kkv * rsqrtf(ssq + 1e-12f); \
                    const float kd = K * (1.f + (a - 1.f) * kac), bd = kk * a; \
                    const float gprev = g; g *= w; const float ig = __builtin_amdgcn_rcpf(g); \
                    *(LAS bf16_t*)(SB + O_AH + (t) * 128 + lane * 2) = f2bf(-kk * gprev); \
                    *(LAS bf16_t*)(SB + O_RH + (t) * 128 + lane * 2) = f2bf(R * g); \
                    *(LAS bf16_t*)(SB + O_BH + (t) * 128 + lane * 2) = f2bf(bd * ig); \
                    *(LAS bf16_t*)(SB + O_KH + (t) * 128 + lane * 2) = f2bf(kd * ig); \
                    *(LAS bf16_t*)(SB + O_VM + lane * 32 + (t) * 2) = f2bf(Vv); } while (0)
                SC_LOAD(0); SC_LOAD(1); SC_LOAD(2); SC_LOAD(3); SC_LOAD(4); SC_LOAD(5); SC_LOAD(6); SC_LOAD(7);
                if (c >= NP) { unsigned spins = 0; while (ldv(done + pw) != c - NP + 1) { __builtin_amdgcn_s_sleep(2); if (++spins > (1u << 22)) break; } }
                asm volatile("" ::: "memory");
                float g = 1.f;
                SC_STEP(0); SC_STEP(1); SC_STEP(2); SC_STEP(3);
                asm volatile("" ::: "memory");
                SC_LOAD(8); SC_LOAD(9); SC_LOAD(10); SC_LOAD(11);
                asm volatile("" ::: "memory");
                SC_STEP(4); SC_STEP(5); SC_STEP(6); SC_STEP(7);
                asm volatile("" ::: "memory");
                SC_LOAD(12); SC_LOAD(13); SC_LOAD(14); SC_LOAD(15);
                asm volatile("" ::: "memory");
                SC_STEP(8); SC_STEP(9); SC_STEP(10); SC_STEP(11); SC_STEP(12); SC_STEP(13); SC_STEP(14); SC_STEP(15);
#undef SC_LOAD
#undef SC_STEP
#pragma unroll
                for (int q = 0; q < 2; ++q) {
                    float bq[8], kq[8];
#pragma unroll
                    for (int e = 0; e < 8; ++e) { bq[e] = bf2f(*(const LAS bf16_t*)(SB + O_BH + (8 * q + e) * 128 + lane * 2)) * g; kq[e] = bf2f(*(const LAS bf16_t*)(SB + O_KH + (8 * q + e) * 128 + lane * 2)) * g; }
                    u32x4 wb = {pk2(bq[0], bq[1]), pk2(bq[2], bq[3]), pk2(bq[4], bq[5]), pk2(bq[6], bq[7])}, wk = {pk2(kq[0], kq[1]), pk2(kq[2], kq[3]), pk2(kq[4], kq[5]), pk2(kq[6], kq[7])};
                    *(LAS u32x4*)(SB + O_BK + lane * 64 + q * 16) = wb; *(LAS u32x4*)(SB + O_BK + lane * 64 + 32 + q * 16) = wk;
                }
                *(LAS float*)(SB + O_GC + lane * 4) = g;
                f32x4 sab = {0.f, 0.f, 0.f, 0.f}, sak = sab, srb = sab, srk = sab;
#pragma unroll
                for (int ks = 0; ks < 2; ++ks) {
                    const bf16x8 fa = *(const LAS bf16x8*)(SB + O_AH + lr * 128 + ks * 64 + lq * 16), fr = *(const LAS bf16x8*)(SB + O_RH + lr * 128 + ks * 64 + lq * 16);
                    const bf16x8 fb = *(const LAS bf16x8*)(SB + O_BH + lr * 128 + ks * 64 + lq * 16), fk = *(const LAS bf16x8*)(SB + O_KH + lr * 128 + ks * 64 + lq * 16);
                    sab = SC_MFMA(fa, fb, sab); sak = SC_MFMA(fa, fk, sak); srb = SC_MFMA(fr, fb, srb); srk = SC_MFMA(fr, fk, srk);
                }
#pragma unroll
                for (int q = 0; q < 4; ++q) { const int t = 4 * lq + q; const bool lo = lr < t, le = lr <= t;
                    *(LAS float*)(SB + O_AAB + (t * 16 + lr) * 4) = lo ? sab[q] : 0.f;
                    *(LAS bf16_t*)(SB + O_AAK + (t * 16 + lr) * 2) = f2bf(lo ? sak[q] : 0.f);
                    *(LAS bf16_t*)(SB + O_ARK + (t * 32 + lr) * 2) = f2bf(le ? srb[q] : 0.f);
                    *(LAS bf16_t*)(SB + O_ARK + (t * 32 + 16 + lr) * 2) = f2bf(le ? srk[q] : 0.f); }
                asm volatile("s_waitcnt lgkmcnt(0)" ::: "memory");
                if (lane == 0) ready[pw] = c + 1;
            }
        }
#undef SC_ROW
        __syncthreads();
    }
}

DI void unpack8u(const uint4 u, float (&d)[8]) { d[0] = bflo(u.x); d[1] = bfhi(u.x); d[2] = bflo(u.y); d[3] = bfhi(u.y); d[4] = bflo(u.z); d[5] = bfhi(u.z); d[6] = bflo(u.w); d[7] = bfhi(u.w); }
DI uint4 pack8u(const float (&d)[8]) { uint4 u; u.x = att::pk(d[0], d[1]); u.y = att::pk(d[2], d[3]); u.z = att::pk(d[4], d[5]); u.w = att::pk(d[6], d[7]); return u; }
DI void shift8(const bf16_t* P, int row, int t, int T, int col0, const float (&mu)[8], float (&o)[8]) {
    float c[8], pv[8], nx[8];
    unpack8u(*(const uint4*)(P + (size_t)row * PLD + col0), c);
    if (t > 0) unpack8u(*(const uint4*)(P + (size_t)(row - 1) * PLD + col0), pv); else {
#pragma unroll
        for (int i = 0; i < 8; ++i) pv[i] = 0.f; }
    if (t < T - 1) unpack8u(*(const uint4*)(P + (size_t)(row + 1) * PLD + col0), nx); else {
#pragma unroll
        for (int i = 0; i < 8; ++i) nx[i] = 0.f; }
#pragma unroll
    for (int i = 0; i < 8; ++i) o[i] = c[i] + mu[i] * (0.5f * (pv[i] + nx[i]) - c[i]);
}
DI void ld8f(const float* p, float (&d)[8]) { const float4 a = *(const float4*)p, b = *(const float4*)(p + 4); d[0] = a.x; d[1] = a.y; d[2] = a.z; d[3] = a.w; d[4] = b.x; d[5] = b.y; d[6] = b.z; d[7] = b.w; }
DI void ph_post_opt(const Ctx& cx, const Params& p, int j, int nrows) {
    const int tid = cx.tid, wid = tid >> 6, lane = tid & 63, c0 = lane * 8;
    float mur[8], muk[8], muv[8], ka[8], rk[8], lw[8], lb[8];
    ld8f(p.a_mu + j * ACOLS + c0, mur); ld8f(p.a_mu + j * ACOLS + 512 + c0, muk); ld8f(p.a_mu + j * ACOLS + 1024 + c0, muv);
    ld8f(p.a_k_a + j * 512 + c0, ka); ld8f(p.a_r_k + j * 512 + c0, rk); ld8f(p.a_ln_w + j * 512 + c0, lw); ld8f(p.a_ln_b + j * 512 + c0, lb);
    for (int row = cx.bid * 8 + wid; row < nrows; row += cx.nblk * 8) {
        const bool lat = row < NLAT; const int t = lat ? (row & 2047) : ((row - NLAT) & 255); const int T = lat ? 2048 : 256;
        float yf[8], yb[8], R[8], K[8], V[8], af[8], ab[8], g[8];
        unpack8u(*(const uint4*)(p.YF + (size_t)row * 512 + c0), yf); unpack8u(*(const uint4*)(p.YB + (size_t)row * 512 + c0), yb);
        shift8(p.P, row, t, T, c0, mur, R); shift8(p.P, row, t, T, 512 + c0, muk, K); shift8(p.P, row, t, T, 1024 + c0, muv, V);
        unpack8u(*(const uint4*)(p.WAG + (size_t)row * WLD + 1024 + c0), af); unpack8u(*(const uint4*)(p.WAG + (size_t)row * WLD + 1536 + c0), ab); unpack8u(*(const uint4*)(p.WAG + (size_t)row * WLD + 2048 + c0), g);
        float sum = 0.f, sb = 0.f;
#pragma unroll
        for (int i = 0; i < 8; ++i) { yf[i] += yb[i]; sum += yf[i]; sb += R[i] * rk[i] * K[i] * (2.f + (af[i] + ab[i] - 2.f) * ka[i]); }
        sum = scan::red8(sum); sb = scan::red8(sb);
        const float mean = sum * (1.f / 64.f); float var = 0.f;
#pragma unroll
        for (int i = 0; i < 8; ++i) { const float d = yf[i] - mean; var += d * d; }
        var = scan::red8(var);
        const float rstd = rsqrtf(var * (1.f / 64.f) + 64e-5f);
        float o[8];
#pragma unroll
        for (int i = 0; i < 8; ++i) o[i] = ((yf[i] - mean) * rstd * lw[i] + lb[i] + sb * V[i]) * g[i];
        *(uint4*)(p.H + (size_t)row * 1024 + c0) = pack8u(o);
    }
}
DI void fin_vec(float (&x)[8], int c, int t, bool lat, const float* gain, float scl, bf16_t* dst) {
    float ss = 0.f;
#pragma unroll
    for (int i = 0; i < 8; ++i) ss += x[i] * x[i];
    ss += __shfl_xor(ss, 1); ss += __shfl_xor(ss, 2); ss += __shfl_xor(ss, 4); ss += __shfl_xor(ss, 8);
    const float r = rsqrtf(ss * (1.f / 96.f) + 1e-6f);
    float gn[8]; ld8f(gain + (c < 12 ? c : 0) * 8, gn);
#pragma unroll
    for (int i = 0; i < 8; ++i) x[i] = x[i] * r * gn[i];
    float y[8];
#pragma unroll
    for (int i = 0; i < 8; ++i) { const float up = __shfl_down(x[i], 2), dn = __shfl_up(x[i], 2); y[i] = (c < 10) ? up : dn; }
    if (lat && c >= 8 && c < 12) {
        const float invf[8] = {1.f, 0.316227766016838f, 0.1f, 0.0316227766016838f, 0.01f, 0.00316227766016838f, 0.001f, 0.000316227766016838f};
        const float pos = (c & 1) ? (float)(t & 63) : (float)(t >> 6);
#pragma unroll
        for (int i = 0; i < 8; ++i) { const float ang = pos * invf[i], cs = __cosf(ang), sn = __sinf(ang); x[i] = (c < 10) ? (x[i] * cs - y[i] * sn) : (x[i] * cs + y[i] * sn); }
    }
    if (c < 12) {
#pragma unroll
        for (int i = 0; i < 8; ++i) x[i] *= scl;
        *(uint4*)(dst + c * 8) = pack8u(x);
    }
}
DI void ph_finalize_opt(const Ctx& cx, const Params& p, float* ldsf, int j, int mq) {
    const int tid = cx.tid, wid = tid >> 6, lane = tid & 63, c = lane & 15, hq = lane >> 4;
    const float* qg = p.b_q_gain + j * 96; const float* kg = p.b_k_gain + j * 96;
    for (int row0 = (cx.bid * 8 + wid) * 2; row0 < NT; row0 += cx.nblk * 16) {
        float xq[4][8], xk[4][8];
#pragma unroll
        for (int u = 0; u < 4; ++u) {
            const int row = row0 + (u >> 1), h = (u & 1) * 4 + hq;
#pragma unroll
            for (int i = 0; i < 8; ++i) { xq[u][i] = 0.f; xk[u][i] = 0.f; }
            if (row < mq && c < 12) unpack8u(*(const uint4*)(p.Qraw + (size_t)row * 768 + h * 96 + c * 8), xq[u]);
            if (c < 8) unpack8u(*(const uint4*)(p.KVraw + (size_t)row * 1024 + h * 128 + c * 8), xk[u]);
            else if (c < 12) unpack8u(*(const uint4*)(p.P + (size_t)row * PLD + ACOLS + 384 + (c - 8) * 8), xk[u]);
        }
#pragma unroll
        for (int u = 0; u < 4; ++u) {
            const int row = row0 + (u >> 1), h = (u & 1) * 4 + hq;
            const bool lat = row < NLAT; const int b = lat ? (row >> 11) : ((row - NLAT) >> 8); const int t = lat ? (row & 2047) : ((row - NLAT) & 255);
            if (row < mq) fin_vec(xq[u], c, t, lat, qg, 0.10206207261596577f * 1.4426950408889634f, p.Qraw + (size_t)row * 768 + h * 96);
            const int key = lat ? 256 + t : t;
            fin_vec(xk[u], c, t, lat, kg, 1.f, p.Kf + ((size_t)(b * 8 + h) * 2304 + key) * 96);
        }
    }
    bf16_t* T = (bf16_t*)ldsf; constexpr int TP = 520;
    for (int tile = cx.bid; tile < NT / 64; tile += cx.nblk) {
        const int row0 = tile * 64; const bool lat = row0 < NLAT; const int b = lat ? (row0 >> 11) : ((row0 - NLAT) >> 8); const int t0 = lat ? (row0 & 2047) : ((row0 - NLAT) & 255);
        const int key0 = lat ? 256 + t0 : t0;
        __syncthreads();
#pragma unroll
        for (int i = 0; i < 8; ++i) { const int ch = tid + 512 * i, kr = ch >> 6, cc = ch & 63, h = cc >> 3, part = cc & 7;
            *(uint4*)(T + kr * TP + h * 64 + part * 8) = *(const uint4*)(p.KVraw + (size_t)(row0 + kr) * 1024 + h * 128 + 64 + part * 8); }
        __syncthreads();
#pragma unroll
        for (int i = 0; i < 8; ++i) { const int ch = tid + 512 * i, hd = ch >> 3, kc = ch & 7;
            float v[8];
#pragma unroll
            for (int q = 0; q < 8; ++q) v[q] = bf2f(T[(kc * 8 + q) * TP + hd]);
            uint4 o; o.x = (unsigned)T[(kc * 8 + 0) * TP + hd] | ((unsigned)T[(kc * 8 + 1) * TP + hd] << 16); o.y = (unsigned)T[(kc * 8 + 2) * TP + hd] | ((unsigned)T[(kc * 8 + 3) * TP + hd] << 16);
            o.z = (unsigned)T[(kc * 8 + 4) * TP + hd] | ((unsigned)T[(kc * 8 + 5) * TP + hd] << 16); o.w = (unsigned)T[(kc * 8 + 6) * TP + hd] | ((unsigned)T[(kc * 8 + 7) * TP + hd] << 16);
            (void)v;
            *(uint4*)(p.Vt + ((size_t)(b * 8 + (hd >> 6)) * 64 + (hd & 63)) * 2304 + key0 + kc * 8) = o; }
    }
    __syncthreads();
}
DI void ph_mod_opt(const Ctx& cx, const Params& p, float* lds) {
    const int tid = cx.tid, wid = tid >> 6, lane = tid & 63;
    float* part = lds + 17 * 1024;
    for (int i = tid; i < 17 * 1024; i += NTHR) { const int jj = i >> 10, k = i & 1023; const float v = (jj < 16) ? p.c[jj * 1024 + k] : p.c_ctx[k]; lds[i] = siluf(v); }
    __syncthreads();
    for (int item = cx.bid; item < 4 * 96; item += cx.nblk) {
        const int l = item / 96, n = (item % 96) * 64 + lane;
        const float* w = p.mod_w + (size_t)l * 1024 * 6144 + n;
        float acc[17];
#pragma unroll
        for (int jj = 0; jj < 17; ++jj) acc[jj] = 0.f;
#pragma unroll 4
        for (int k = wid * 128; k < wid * 128 + 128; ++k) {
            const float wv = w[(size_t)k * 6144];
#pragma unroll
            for (int jj = 0; jj < 17; ++jj) acc[jj] += lds[jj * 1024 + k] * wv;
        }
#pragma unroll
        for (int jj = 0; jj < 17; ++jj) part[(wid * 17 + jj) * 64 + lane] = acc[jj];
        __syncthreads();
        for (int o = tid; o < 17 * 64; o += NTHR) { const int jj = o >> 6, ln = o & 63; float sacc = p.mod_b[l * 6144 + (item % 96) * 64 + ln];
#pragma unroll
            for (int q = 0; q < 8; ++q) sacc += part[(q * 17 + jj) * 64 + ln];
            p.mod[((size_t)l * 17 + jj) * 6144 + (item % 96) * 64 + ln] = sacc; }
        __syncthreads();
    }
}

DI void ph_norm2_router(const Ctx& cx, const Params& p, float* ldsg, int nrows, const float* gain, const float* modl, int layer, const bf16_t* xb_lat) {
    LAS float* lds = (LAS float*)ldsg;
    const int tid = cx.tid, wid = tid >> 6, lane = tid & 63;
    LAS float* rw = lds; LAS float* red = lds + 16 * 1024 + wid * (32 * 64 + 64); LAS float* my = red + 32 * 64;
    LAS int* lcnt = (LAS int*)(lds + 16 * 1024 + 8 * (32 * 64 + 64)); LAS int* lbase = lcnt + 16; LAS int* rlist = lcnt + 32;
    for (int i = tid; i < 16 * 1024; i += NTHR) { const int e = i >> 10, col = i & 1023; rw[i] = p.router_w[col * 16 + e]; }
    if (tid < 16) lcnt[tid] = 0;
    __syncthreads();
    int nlist = 0;
    for (int pidx = cx.bid * 8 + wid; pidx < (nrows >> 1); pidx += cx.nblk * 8) {
        float4 xv[2][4];
#pragma unroll
        for (int r = 0; r < 2; ++r) { const int row = 2 * pidx + r;
            if (xb_lat) { const bf16_t* xr = (row < NLAT) ? xb_lat + (size_t)row * 1024 : p.cs + (size_t)(row - NLAT) * 1024;
#pragma unroll
                for (int i = 0; i < 4; ++i) { const uint2 u = *(const uint2*)(xr + i * 256 + lane * 4); xv[r][i] = make_float4(bflo(u.x), bfhi(u.x), bflo(u.y), bfhi(u.y)); } }
            else { const float* xr = (row < NLAT) ? p.out + (size_t)row * 1024 : p.ctxs + (size_t)(row - NLAT) * 1024;
#pragma unroll
                for (int i = 0; i < 4; ++i) xv[r][i] = *(const float4*)(xr + i * 256 + lane * 4); } }
        const int row0 = 2 * pidx; const int jj = (row0 < NLAT) ? (row0 >> 11) : 16;
        const float* shp = modl + (size_t)jj * 6144 + 3 * 1024; const float* scp = modl + (size_t)jj * 6144 + 4 * 1024;
        float4 hv[2][4];
#pragma unroll
        for (int r = 0; r < 2; ++r) {
            float ss = 0.f;
#pragma unroll
            for (int i = 0; i < 4; ++i) ss += xv[r][i].x * xv[r][i].x + xv[r][i].y * xv[r][i].y + xv[r][i].z * xv[r][i].z + xv[r][i].w * xv[r][i].w;
            ss = wave_sum(ss);
            const float rstd = rsqrtf(ss * (1.f / 1024.f) + 1e-6f);
#pragma unroll
            for (int i = 0; i < 4; ++i) {
                const int col = i * 256 + lane * 4;
                const float4 g = *(const float4*)(gain + col), sh = *(const float4*)(shp + col), sc = *(const float4*)(scp + col);
                hv[r][i].x = xv[r][i].x * rstd * g.x * (1.f + sc.x) + sh.x; hv[r][i].y = xv[r][i].y * rstd * g.y * (1.f + sc.y) + sh.y;
                hv[r][i].z = xv[r][i].z * rstd * g.z * (1.f + sc.z) + sh.z; hv[r][i].w = xv[r][i].w * rstd * g.w * (1.f + sc.w) + sh.w;
                uint2 u; u.x = att::pk(hv[r][i].x, hv[r][i].y); u.y = att::pk(hv[r][i].z, hv[r][i].w);
                *(uint2*)(p.H + (size_t)(row0 + r) * 1024 + col) = u;
            }
        }
#pragma unroll
        for (int e = 0; e < 16; ++e) {
            float a0 = 0.f, a1 = 0.f;
#pragma unroll
            for (int i = 0; i < 4; ++i) { const mm::f32x4 w = *(const LAS mm::f32x4*)(rw + e * 1024 + i * 256 + lane * 4);
                a0 += hv[0][i].x * w[0] + hv[0][i].y * w[1] + hv[0][i].z * w[2] + hv[0][i].w * w[3]; a1 += hv[1][i].x * w[0] + hv[1][i].y * w[1] + hv[1][i].z * w[2] + hv[1][i].w * w[3]; }
            red[e * 64 + lane] = a0; red[(16 + e) * 64 + lane] = a1;
        }
        __builtin_amdgcn_wave_barrier();
        {
            const int r = lane >> 5, e = (lane >> 1) & 15, half = lane & 1; const LAS float* src = red + (r * 16 + e) * 64 + half * 32;
            float sacc = 0.f;
#pragma unroll
            for (int q = 0; q < 8; ++q) { const mm::f32x4 v = *(const LAS mm::f32x4*)(src + q * 4); sacc += (v[0] + v[1]) + (v[2] + v[3]); }
            sacc += dpp_f<0xB1>(sacc);
            const float sg = 1.f / (1.f + __expf(-sacc));
            if (half == 0) { my[r * 32 + e] = sg; my[r * 32 + 16 + e] = sg + p.router_b[e]; }
        }
        __builtin_amdgcn_wave_barrier();
        if ((lane & 31) == 0) {
            const int r = lane >> 5; const LAS float* m = my + r * 32;
            float best = -3.0e38f; int be1 = 0, be2 = 1;
#pragma unroll
            for (int g = 0; g < 4; ++g) {
                const mm::f32x4 v = *(const LAS mm::f32x4*)(m + 16 + 4 * g);
                int i1 = 0; float m1 = v[0];
                if (v[1] > m1) { m1 = v[1]; i1 = 1; } if (v[2] > m1) { m1 = v[2]; i1 = 2; } if (v[3] > m1) { m1 = v[3]; i1 = 3; }
                int i2 = -1; float m2 = -3.0e38f;
                if (i1 != 0 && v[0] > m2) { m2 = v[0]; i2 = 0; } if (i1 != 1 && v[1] > m2) { m2 = v[1]; i2 = 1; }
                if (i1 != 2 && v[2] > m2) { m2 = v[2]; i2 = 2; } if (i1 != 3 && v[3] > m2) { m2 = v[3]; i2 = 3; }
                const float gs = m1 + m2;
                if (gs > best) { best = gs; be1 = 4 * g + i1; be2 = 4 * g + i2; }
            }
            const float bs1 = m[be1], bs2 = m[be2]; const float inv = 1.f / (bs1 + bs2);
            const int p1 = atomicAdd((int*)&lcnt[be1], 1), p2 = atomicAdd((int*)&lcnt[be2], 1);
            LAS int* ent = rlist + (wid * 24 + nlist * 2 + r) * 6;
            const int row = row0 + r;
            ent[0] = row; ent[1] = be1 | (be2 << 8); ent[2] = p1; ent[3] = p2; ent[4] = __float_as_int(bs1 * inv); ent[5] = __float_as_int(bs2 * inv);
        }
        ++nlist;
        __builtin_amdgcn_wave_barrier();
    }
    __syncthreads();
    if (tid < 16) lbase[tid] = atomicAdd(p.cnt + (layer * 16 + tid) * 64, lcnt[tid]);
    __syncthreads();
    for (int k = lane; k < 2 * nlist; k += 64) {
        const LAS int* ent = rlist + (wid * 24 + k) * 6; const int row = ent[0], be1 = ent[1] & 255, be2 = ent[1] >> 8;
        const size_t s1 = (size_t)be1 * NT + lbase[be1] + ent[2], s2 = (size_t)be2 * NT + lbase[be2] + ent[3];
        p.slot[s1] = row * 2; p.slot[s2] = row * 2 + 1; p.slotw[s1] = __int_as_float(ent[4]); p.slotw[s2] = __int_as_float(ent[5]);
    }
    __syncthreads();
}

DI void ph_prepBLR_opt(const Ctx& cx, const Params& p, int j) {
    const int tid = cx.tid, wid = tid >> 6, lane = tid & 63;
    const float4 gq = *(const float4*)(p.b_q_norm + j * 256 + lane * 4); const float2 gk = *(const float2*)(p.b_kv_norm + j * 128 + lane * 2);
    constexpr int U = 8;
    for (int row0 = (cx.bid * 8 + wid) * U; row0 < NT; row0 += cx.nblk * 8 * U) {
        uint2 uq[U]; unsigned ukv[U];
#pragma unroll
        for (int u = 0; u < U; ++u) { const bf16_t* pr = p.P + (size_t)(row0 + u) * PLD + ACOLS; uq[u] = *(const uint2*)(pr + lane * 4); ukv[u] = *(const unsigned*)(pr + 256 + lane * 2); }
#pragma unroll
        for (int u = 0; u < U; ++u) {
            const float q0 = bflo(uq[u].x), q1 = bfhi(uq[u].x), q2 = bflo(uq[u].y), q3 = bfhi(uq[u].y), k0 = bflo(ukv[u]), k1 = bfhi(ukv[u]);
            const float sq = wave_sum(q0 * q0 + q1 * q1 + q2 * q2 + q3 * q3), sk = wave_sum(k0 * k0 + k1 * k1);
            const float rq = rsqrtf(sq * (1.f / 256.f) + 1e-6f), rk = rsqrtf(sk * (1.f / 128.f) + 1e-6f);
            uint2 o; o.x = att::pk(q0 * rq * gq.x, q1 * rq * gq.y); o.y = att::pk(q2 * rq * gq.z, q3 * rq * gq.w);
            bf16_t* qn = p.QN + (size_t)(row0 + u) * 512;
            *(uint2*)(qn + lane * 4) = o; *(unsigned*)(qn + 256 + lane * 2) = att::pk(k0 * rk * gk.x, k1 * rk * gk.y); *(unsigned*)(qn + 384 + lane * 2) = 0u;
        }
    }
    const int gtid = cx.bid * NTHR + tid, gsz = cx.nblk * NTHR;
    for (int idx = gtid; idx < NT * 48; idx += gsz) {
        const int row = idx / 48, cg = idx % 48, col0 = cg * 8;
        const bool lat = row < NLAT; const int t = lat ? (row & 2047) : ((row - NLAT) & 255); const int T = lat ? 2048 : 256;
        float mu[8]; ld8f(p.a_mu + j * ACOLS + 1536 + col0, mu);
        float v[8]; shift8(p.P, row, t, T, 1536 + col0, mu, v);
        if (cg < 16) {
#pragma unroll
            for (int i = 0; i < 8; ++i) { const float e = __expf(2.f * v[i]); v[i] = 1.f - 2.f * __builtin_amdgcn_rcpf(e + 1.f); }
        } else if (cg >= 32) {
#pragma unroll
            for (int i = 0; i < 8; ++i) v[i] = __builtin_amdgcn_rcpf(1.f + __expf(-v[i]));
        }
        *(uint4*)(p.LR + (size_t)row * 384 + col0) = pack8u(v);
    }
}

template <bool FINAL>
DI void ph_normc(const Ctx& cx, const Params& p, int nrows, const bf16_t* xin_lat, bf16_t* xout_lat, const float* gain, const float* modl, const float* modprev) {
    const int tid = cx.tid, wid = tid >> 6, lane = tid & 63;
    for (int row = cx.bid * 8 + wid; row < nrows; row += cx.nblk * 8) {
        const bool lat = row < NLAT; const int jj = lat ? (row >> 11) : 16; const size_t rb = lat ? (size_t)row : (size_t)(row - NLAT);
        const bf16_t* xr = (lat ? xin_lat : p.cs) + rb * 1024;
        const float* g2 = modprev + (size_t)jj * 6144 + 5 * 1024;
        float4 xv[4];
#pragma unroll
        for (int i = 0; i < 4; ++i) {
            const int col = i * 256 + lane * 4;
            const uint2 ux = *(const uint2*)(xr + col);
            float s0 = 0.f, s1 = 0.f, s2 = 0.f, s3 = 0.f;
#pragma unroll
            for (int sl = 0; sl < 3; ++sl) { const uint2 u = *(const uint2*)(p.Y + ((size_t)sl * NT + row) * 1024 + col); s0 += bflo(u.x); s1 += bfhi(u.x); s2 += bflo(u.y); s3 += bfhi(u.y); }
            const float4 gv = *(const float4*)(g2 + col);
            xv[i].x = bflo(ux.x) + gv.x * s0; xv[i].y = bfhi(ux.x) + gv.y * s1; xv[i].z = bflo(ux.y) + gv.z * s2; xv[i].w = bfhi(ux.y) + gv.w * s3;
            if (FINAL) *(float4*)(p.out + (size_t)row * 1024 + col) = xv[i];
            else { uint2 o; o.x = att_pk(xv[i].x, xv[i].y); o.y = att_pk(xv[i].z, xv[i].w); *(uint2*)((lat ? xout_lat : p.cs) + rb * 1024 + col) = o; }
        }
        if (!FINAL) {
            float ss = 0.f;
#pragma unroll
            for (int i = 0; i < 4; ++i) ss += xv[i].x * xv[i].x + xv[i].y * xv[i].y + xv[i].z * xv[i].z + xv[i].w * xv[i].w;
            ss = wave_sum(ss);
            const float rstd = rsqrtf(ss * (1.f / 1024.f) + 1e-6f);
            const float* shp = modl + (size_t)jj * 6144; const float* scp = modl + (size_t)jj * 6144 + 1024;
#pragma unroll
            for (int i = 0; i < 4; ++i) {
                const int col = i * 256 + lane * 4;
                const float4 g = *(const float4*)(gain + col), sh = *(const float4*)(shp + col), sc = *(const float4*)(scp + col);
                uint2 u; u.x = att_pk(xv[i].x * rstd * g.x * (1.f + sc.x) + sh.x, xv[i].y * rstd * g.y * (1.f + sc.y) + sh.y);
                u.y = att_pk(xv[i].z * rstd * g.z * (1.f + sc.z) + sh.z, xv[i].w * rstd * g.w * (1.f + sc.w) + sh.w);
                *(uint2*)(p.H + (size_t)row * 1024 + col) = u;
            }
        }
    }
}

template <int PH>
DI void run_phase(const Params& p, float* lds, int L) {
    const Ctx cx = make_ctx();
    const int j = L >> 1;
    const float* modl = p.mod + (size_t)L * 17 * 6144;
    const float* modprev = p.mod + (size_t)(L > 0 ? L - 1 : 0) * 17 * 6144;
    const bool last = (L == 3);
    const int rows_layer = (L == 3) ? NLAT : NT;
    const int rows_out = (L >= 2) ? NLAT : NT;
    const float* xin_lat = (L == 0) ? p.x : p.out; const float* xin_ctx = (L == 0) ? p.ctx : p.ctxs;
    constexpr bool BFS = (OPT >= 11);
    const void* bin_lat = (L == 0) ? (const void*)p.x : (const void*)p.xs; const void* bin_ctx = (L == 0) ? (const void*)p.ctx : (const void*)p.cs;
    bf16_t* bout_lat = (L == 3) ? p.xs3 : p.xs;
    if constexpr (PH == 0) { if (OPT >= 7) { ph_mod_opt(cx, p, lds); for (int i = cx.bid * NTHR + cx.tid; i < 1024; i += cx.nblk * NTHR) p.H[(size_t)NT * 1024 + i] = 0; } else ph_prologue(cx, p, lds); ph_prep_weights(cx, p, lds); }
    if constexpr (PH == 1) {
        if (OPT >= 4) ph_prep_moe(cx, p, lds, L);
        if (BFS && L > 0) { ph_normc<false>(cx, p, rows_layer, p.xs, p.xs, p.norm1_g + L * 1024, modl, modprev); return; }
        if (L == 0) ph_norm<false, true, false>(cx, p, lds, rows_layer, xin_lat, xin_ctx, p.norm1_g + L * 1024, modl, 0, 1, modprev, L);
        else ph_norm<true, true, false>(cx, p, lds, rows_layer, xin_lat, xin_ctx, p.norm1_g + L * 1024, modl, 0, 1, modprev, L);
    }
    if constexpr (PH == 2) { if (OPT >= 1) ph_win_mm(cx, p, lds, j); else ph_win(cx, p, lds, j); }
    if constexpr (PH == 3) { if (OPT >= 10) ph_prepBLR_opt(cx, p, j); else ph_prepB(cx, p, j); }
    if constexpr (PH == 4) { if (OPT >= 2) ph_qkvup_mm(cx, p, lds, j, rows_out); else ph_qkvup(cx, p, lds, j, rows_out); }
    if constexpr (PH == 5) { if (OPT >= 7) ph_finalize_opt(cx, p, lds, j, rows_out); else ph_finalize(cx, p, j, rows_out); }
    if constexpr (PH == 6) { if (OPT >= 5) ph_attn_mm(cx, p, lds, rows_out == NT); else ph_attn(cx, p, rows_out == NT); }
    if constexpr (PH == 7) { if (OPT < 10) ph_prepLR(cx, p, j); }
    if constexpr (PH == 8) { if (OPT >= 2) ph_wag_mm(cx, p, lds, j); else ph_wag(cx, p, lds, j); }
    if constexpr (PH == 9) { if (OPT >= 9) ph_scan_chunk<0>(cx, p, lds, j); else if (OPT >= 6) ph_scan_opt<0>(cx, p, lds, j); else ph_scan(cx, p, lds, j); }
    if constexpr (PH == 19) ph_scan_chunk<PROBE_SCAN>(cx, p, lds, j);
    if constexpr (PH == 10) { if (OPT >= 7) ph_post_opt(cx, p, j, rows_out); else ph_post(cx, p, j, rows_out); }
    if constexpr (PH == 11) { if (BFS) ph_wout_mmB(cx, p, lds, p.H, p.WoutT + (size_t)j * 1024 * 1024, rows_out, bin_lat, bin_ctx, bout_lat, L == 0, modl); else if (OPT >= 1) ph_wout_mm(cx, p, lds, p.H, p.WoutT + (size_t)j * 1024 * 1024, rows_out, xin_lat, xin_ctx, modl); else ph_wout(cx, p, lds, p.H, p.w_out_even + (size_t)j * 1024 * 1024, rows_out, xin_lat, xin_ctx, modl); }
    if constexpr (PH == 12) { if (OPT >= 3) ph_f1_mm(cx, p, lds, j, !last); else ph_chdft(cx, p, lds, rows_layer); }
    if constexpr (PH == 13) { if (BFS) ph_f2_mmB(cx, p, lds, !last, bin_lat, bin_ctx, bout_lat, modl); else if (OPT >= 3) ph_f2_mm(cx, p, lds, !last, xin_lat, xin_ctx, modl); else ph_posdft(cx, p, lds, !last); }
    if constexpr (PH == 14) { if (OPT < 3) ph_wout(cx, p, lds, p.F, p.w_out_fourier + (size_t)j * 1024 * 1024, rows_out, xin_lat, xin_ctx, modl); }
    if constexpr (PH == 15) { if (OPT >= 8) ph_norm2_router(cx, p, lds, rows_out, p.norm2_g + L * 1024, modl, L, BFS ? bout_lat : (const bf16_t*)nullptr); else ph_norm<false, true, true>(cx, p, lds, rows_out, p.out, p.ctxs, p.norm2_g + L * 1024, modl, 3, 4, modprev, L); }
    if constexpr (PH == 16) { if (OPT >= 4) ph_moe_up_mm(cx, p, lds, L, rows_out); else ph_moe_up(cx, p, lds, L, rows_out); }
    if constexpr (PH == 17) { if (OPT >= 4) ph_moe_down_mm(cx, p, lds, L, rows_out); else ph_moe_down(cx, p, lds, L, rows_out); }
    if constexpr (PH == 18) { if (BFS) { ph_normc<true>(cx, p, NLAT, p.xs3, nullptr, p.norm1_g, p.mod + (size_t)3 * 17 * 6144, p.mod + (size_t)3 * 17 * 6144); return; } }
    if constexpr (PH == 18) ph_norm<true, false, false>(cx, p, lds, NLAT, p.out, p.ctxs, p.norm1_g, p.mod + (size_t)3 * 17 * 6144, 0, 1, p.mod + (size_t)3 * 17 * 6144, 3);
}

template <int PH>
__global__ void __launch_bounds__(NTHR, 2) k_phase(Params p, int L) {
    extern __shared__ __attribute__((aligned(16))) float shm[];
    run_phase<PH>(p, shm, L);
}

#if ONE_LAUNCH
constexpr int PARAM_WORDS = (int)(sizeof(Params) / 4);
DI Params load_params(const unsigned* lp) {
    Params q; unsigned* d = (unsigned*)&q;
#pragma unroll
    for (int i = 0; i < PARAM_WORDS; ++i) d[i] = (unsigned)__builtin_amdgcn_readfirstlane((int)lp[i]);
    void** pp = (void**)&q;
#pragma unroll
    for (int i = 0; i < PARAM_WORDS / 2; ++i) pp[i] = (void*)(__attribute__((address_space(1))) void*)pp[i];
    return q;
}
#ifndef PROBE_MASK
#define PROBE_MASK 0u
#endif

#define PHASE(PH, L) do { unsigned long long t0_ = 0; if (PROBE_MASK & (1u << (PH))) t0_ = wall_clock64(); \
    { run_phase<PH>(p, lds, (L)); } xcd_barrier(bar); \
    if (PROBE_MASK & (1u << (PH))) tacc += wall_clock64() - t0_; } while (0)
__global__ void __launch_bounds__(NTHR, 2) k_mega(Params p) {
    extern __shared__ __attribute__((aligned(16))) float shm[];
    unsigned* lp = (unsigned*)(shm + 4);
    float* lds = shm + 4 + ((PARAM_WORDS + 3) & ~3);
    if (threadIdx.x == 0) { shm[0] = 0.f; shm[1] = 0.f; shm[2] = 0.f; shm[3] = 0.f; }
    if (threadIdx.x < PARAM_WORDS) lp[threadIdx.x] = ((const unsigned*)&p)[threadIdx.x];
    __syncthreads();
    XcdBarrier bar; { const Params q_ = load_params(lp); bar = xcd_barrier_post(q_.bar, (volatile LAS unsigned*)shm); }
    unsigned long long tacc = 0;
    PHASE(0, 0);
#define LAYER_EVEN(L) PHASE(1, L); PHASE(2, L); PHASE(3, L); PHASE(4, L); PHASE(5, L); PHASE(6, L); if (OPT < 10) { PHASE(7, L); } PHASE(8, L); PHASE(9, L); if (PROBE_SCAN) { PHASE(19, L); } PHASE(10, L); PHASE(11, L); PHASE(15, L); PHASE(16, L); PHASE(17, L)
#define LAYER_ODD(L) PHASE(1, L); PHASE(12, L); PHASE(13, L); if (OPT < 3) { PHASE(14, L); } PHASE(15, L); PHASE(16, L); PHASE(17, L)
    LAYER_EVEN(0); LAYER_ODD(1); LAYER_EVEN(2); LAYER_ODD(3);
    { unsigned long long t0_ = 0; if (PROBE_MASK & (1u << 18)) t0_ = wall_clock64(); run_phase<18>(p, lds, 3);
      if (PROBE_MASK & (1u << 18)) { xcd_barrier(bar); tacc += wall_clock64() - t0_; } }
    if (PROBE_MASK != 0u && blockIdx.x == 0 && threadIdx.x == 0) {
        const unsigned long long t1 = wall_clock64(); while (wall_clock64() - t1 < 20ull * tacc) __builtin_amdgcn_s_sleep(8); }
}
#endif

static inline size_t al256(size_t v) { return (v + 255) & ~(size_t)255; }
constexpr size_t LDS_BYTES = 148 * 1024;

template <int PH> static void launch_phase(const Params& p, int L, int grid, hipStream_t s) {
    static bool attr = false;
    if (!attr) { hipFuncSetAttribute((const void*)k_phase<PH>, hipFuncAttributeMaxDynamicSharedMemorySize, (int)LDS_BYTES); attr = true; }
    hipLaunchKernelGGL(k_phase<PH>, dim3(grid), dim3(NTHR), LDS_BYTES, s, p, L);
}

extern "C" void kernel_launch(void* const* d_in, const int* in_sizes, int n_in, void* d_out, int out_size, void* d_ws, size_t ws_size, hipStream_t stream) {
    (void)in_sizes; (void)n_in; (void)out_size;
    Params p{};
    const float** ip = (const float**)&p.x;
    for (int i = 0; i < 36; ++i) ip[i] = (const float*)d_in[i];
    p.out = (float*)d_out;
    char* w = (char*)d_ws; size_t o = 0;
    auto take = [&](size_t bytes) { char* r = w + o; o += al256(bytes); return r; };
    p.bar = (unsigned*)take(XCD_BAR_WORDS * 4);
    p.cnt = (int*)take(64 * 64 * 4);
    const size_t zero_bytes = o;
    p.mod = (float*)take((size_t)4 * 17 * 6144 * 4);
    p.ctxs = (float*)take((size_t)NCTX * 1024 * 4);
    p.dftl = (bf16_t*)take((size_t)2048 * 4096 * 2);
    p.dftc = (bf16_t*)take((size_t)256 * 512 * 2);
    p.slot = (int*)take((size_t)16 * NT * 4);
    p.tokw = (float*)take((size_t)NT * 2 * 4);
    p.slotw = (float*)take((size_t)16 * NT * 4);
    p.H = (bf16_t*)take((size_t)(NT + 1) * 1024 * 2);
    char* big = w + o;
    p.P = (bf16_t*)take((size_t)NT * PLD * 2);
    char* r1 = w + o;
    p.WAG = (bf16_t*)take((size_t)NT * WLD * 2);
    p.YF = (bf16_t*)take((size_t)NT * 512 * 2);
    p.YB = (bf16_t*)take((size_t)NT * 512 * 2);
    p.LR = (bf16_t*)take((size_t)NT * 384 * 2);
    p.WinT = (bf16_t*)take((size_t)2 * 2560 * 1024 * 2); p.WqT = (bf16_t*)take((size_t)2 * 768 * 256 * 2); p.WkvT = (bf16_t*)take((size_t)2 * 1024 * 256 * 2);
    p.WlrT = (bf16_t*)take((size_t)2 * 2560 * 384 * 2); p.WoutT = (bf16_t*)take((size_t)2 * 1024 * 1024 * 2); p.A1 = (bf16_t*)take((size_t)2 * 2048 * 1024 * 2);
    p.A2 = (bf16_t*)take((size_t)2048 * 4096 * 2); p.A2c = (bf16_t*)take((size_t)256 * 512 * 2);
    p.WguT = (bf16_t*)take((size_t)17 * 1024 * 1024 * 2); p.WdT = (bf16_t*)take((size_t)17 * 1024 * 512 * 2);
    const size_t total = o;
    { size_t q = 0; auto t2 = [&](size_t bytes) { char* r = r1 + q; q += al256(bytes); return r; };
      p.QN = (bf16_t*)t2((size_t)NT * 512 * 2); p.Qraw = (bf16_t*)t2((size_t)NT * 768 * 2); p.KVraw = (bf16_t*)t2((size_t)NT * 1024 * 2);
      p.Kf = (bf16_t*)t2((size_t)NB * 8 * 2304 * 96 * 2); p.Vt = (bf16_t*)t2((size_t)NB * 8 * 64 * 2304 * 2); }
    { size_t q = 0; auto t3 = [&](size_t bytes) { char* r = big + q; q += al256(bytes); return r; };
      p.ACT = (bf16_t*)t3((size_t)3 * NT * 512 * 2); p.Y = (bf16_t*)t3((size_t)3 * NT * 1024 * 2); }
    { size_t q = 0; auto t4 = [&](size_t bytes) { char* r = big + q; q += al256(bytes); return r; };
      p.G = (float*)t4((size_t)NT * 2048 * 4); p.F = (bf16_t*)t4((size_t)NT * 1024 * 2); }
    { size_t q = 0; auto t5 = [&](size_t bytes) { char* r = big + q; q += al256(bytes); return r; };
      p.ZT = (bf16_t*)t5((size_t)16 * 1024 * 4096 * 2); p.ZTC = (bf16_t*)t5((size_t)16 * 1024 * 512 * 2); }
    p.xs = (bf16_t*)d_out; p.cs = (bf16_t*)p.ctxs; p.xs3 = (bf16_t*)(big + (size_t)344 * 1024 * 1024);
    if (total > ws_size) { fprintf(stderr, "workspace too small: need %zu have %zu\n", total, ws_size); return; }
    static int grid = 0;
    if (!grid) { int dev = 0, cus = 0; hipGetDevice(&dev); hipDeviceGetAttribute(&cus, hipDeviceAttributeMultiprocessorCount, dev); grid = cus > 0 ? cus : 256; if (grid > 256) grid = 256; }
    hipMemsetAsync(d_ws, 0, zero_bytes, stream);
#if ONE_LAUNCH
    static bool attr = false;
    if (!attr) { hipFuncSetAttribute((const void*)k_mega, hipFuncAttributeMaxDynamicSharedMemorySize, (int)LDS_BYTES); attr = true; }
    hipLaunchKernelGGL(k_mega, dim3(grid), dim3(NTHR), LDS_BYTES, stream, p);
#else
    launch_phase<0>(p, 0, grid, stream);
    for (int L = 0; L < 4; ++L) {
        launch_phase<1>(p, L, grid, stream);
        if ((L & 1) == 0) {
            launch_phase<2>(p, L, grid, stream); launch_phase<3>(p, L, grid, stream); launch_phase<4>(p, L, grid, stream); launch_phase<5>(p, L, grid, stream);
            launch_phase<6>(p, L, grid, stream); launch_phase<7>(p, L, grid, stream); launch_phase<8>(p, L, grid, stream); launch_phase<9>(p, L, grid, stream);
            launch_phase<10>(p, L, grid, stream); launch_phase<11>(p, L, grid, stream);
        } else {
            launch_phase<12>(p, L, grid, stream); launch_phase<13>(p, L, grid, stream); launch_phase<14>(p, L, grid, stream);
        }
        launch_phase<15>(p, L, grid, stream); launch_phase<16>(p, L, grid, stream); launch_phase<17>(p, L, grid, stream);
    }
    launch_phase<18>(p, 3, grid, stream);
#endif
}
```

```cpp
#include <hip/hip_runtime.h>
#include <cstdio>
#include <cstdint>

#ifndef ONE_LAUNCH
#define ONE_LAUNCH 1
#endif
#ifndef PROBE_SCAN
#define PROBE_SCAN 0
#endif
#ifndef OPT
#define OPT 12
#endif

typedef unsigned short bf16_t;
#define DI __device__ __forceinline__
#define LAS __attribute__((address_space(3)))

constexpr int D = 1024, NB = 16, SEQ = 2048, CTXL = 256, NLAT = NB * SEQ, NCTX = NB * CTXL, NT = NLAT + NCTX;
constexpr int PLD = 2560;
constexpr int INC = 2336, ACOLS = 1920;
constexpr int WLD = 2560;
constexpr int NTHR = 512;

#define XB_TMO      128
#define XB_XCNT(j)  (256  + 64 * (j))
#define XB_XSUB(j)  (1280 + 64 * (j))
#define XB_XGEN(j)  (2304 + 64 * (j))
#define XB_TOP      3328
#define XB_TOPGEN   3392
#define XCD_BAR_WORDS 3456
#define XB_SPIN_CAP (1u << 24)
DI unsigned xb_ld(unsigned* p)              { return __hip_atomic_load(p, __ATOMIC_RELAXED, __HIP_MEMORY_SCOPE_AGENT); }
DI unsigned xb_add(unsigned* p, unsigned v) { return __hip_atomic_fetch_add(p, v, __ATOMIC_RELAXED, __HIP_MEMORY_SCOPE_AGENT); }
DI unsigned xb_xcc_id() { return (unsigned)__builtin_amdgcn_s_getreg((3 << 11) | 20) & 0xFu; }
#define XB_SPIN(cond, bar) do { unsigned _sp = 0; while (cond) { __builtin_amdgcn_s_sleep(1); \
    if ((++_sp & 255u) == 0u) { if (xb_ld(&(bar)[XB_TMO])) break; if (_sp > XB_SPIN_CAP) { atomicAdd(&(bar)[XB_TMO], 1u); break; } } } } while (0)
struct XcdBarrier { unsigned* bar; unsigned x; volatile LAS unsigned* st; };
DI XcdBarrier xcd_barrier_post(unsigned* bar, volatile LAS unsigned* st) {
    XcdBarrier b; b.bar = bar; b.x = xb_xcc_id(); b.st = st;
    if (threadIdx.x == 0) (void)xb_add(&bar[XB_XCNT(b.x)], 1u);
    return b;
}
DI void xcd_barrier_complete(unsigned* bar, unsigned x, unsigned& nloc, unsigned& nx) {
    const unsigned G = gridDim.x * gridDim.y * gridDim.z;
    unsigned sum, cnt, mine, sp = 0u;
    for (;;) {
        sum = 0u; cnt = 0u; mine = 0u;
#pragma unroll
        for (unsigned j = 0; j < 16; ++j) { const unsigned c = xb_ld(&bar[XB_XCNT(j)]); sum += c; cnt += (c > 0u) ? 1u : 0u; mine = (j == x) ? c : mine; }
        if (sum == G) break;
        __builtin_amdgcn_s_sleep(1);
        if ((++sp & 255u) == 0u) { if (xb_ld(&bar[XB_TMO])) break; if (sp > XB_SPIN_CAP) { atomicAdd(&bar[XB_TMO], 1u); break; } }
    }
    nloc = mine > 0u ? mine : 1u; nx = cnt > 0u ? cnt : 1u;
}
DI void xcd_barrier(const XcdBarrier& b, const bool t0) {
    asm volatile("s_waitcnt vmcnt(0)" ::: "memory");
    __syncthreads();
    if (t0) {
        unsigned* bar = b.bar;
        __builtin_amdgcn_s_waitcnt(0);
        unsigned nloc = b.st[0], nx = b.st[1];
        if (nloc == 0u) { xcd_barrier_complete(bar, b.x, nloc, nx); b.st[0] = nloc; b.st[1] = nx; }
        const unsigned old = xb_add(&bar[XB_XSUB(b.x)], 1u);
        const unsigned gen = old / nloc;
        if (old + 1u == (gen + 1u) * nloc) {
            __builtin_amdgcn_fence(__ATOMIC_RELEASE, "agent");
            asm volatile("s_waitcnt vmcnt(0)" ::: "memory");
            const unsigned og = xb_add(&bar[XB_TOP], 1u);
            const unsigned tg = og / nx;
            if (og + 1u == (tg + 1u) * nx) xb_add(&bar[XB_TOPGEN], 1u);
            else XB_SPIN(xb_ld(&bar[XB_TOPGEN]) == tg, bar);
            __builtin_amdgcn_fence(__ATOMIC_ACQUIRE, "agent");
            xb_add(&bar[XB_XGEN(b.x)], 1u);
            asm volatile("s_waitcnt vmcnt(0)" ::: "memory");
        } else {
            XB_SPIN(xb_ld(&bar[XB_XGEN(b.x)]) == gen, bar);
            __builtin_amdgcn_fence(__ATOMIC_ACQUIRE, "agent");
            asm volatile("s_waitcnt vmcnt(0)" ::: "memory");
        }
    }
    __syncthreads();
}

struct Params {
    const float *x, *c, *ctx, *c_ctx, *norm1_g, *norm2_g, *mod_w, *mod_b, *w_in, *a_mu, *a_w0, *a_w2, *a_a0, *a_a2, *a_g2,
                *a_k_k, *a_k_a, *a_r_k, *a_ln_w, *a_ln_b, *b_q_norm, *b_w_q_up, *b_kv_norm, *b_w_kv_up, *b_q_gain, *b_k_gain,
                *w_out_even, *w_out_fourier, *router_w, *router_b, *moe_w_gate, *moe_w_up, *moe_w_down, *sh_gate, *sh_up, *sh_down;
    float* out;
    unsigned* bar; int* cnt; float* mod; float* ctxs; bf16_t* dftl; bf16_t* dftc; int* slot; float* tokw; float* slotw;
    bf16_t *H, *P, *LR, *WAG, *YF, *YB, *QN, *Qraw, *KVraw, *Kf, *Vt, *ACT, *Y, *F; float* G;
    bf16_t *WinT, *WqT, *WkvT, *WlrT, *WoutT, *A1, *A2, *A2c, *WguT, *WdT, *ZT, *ZTC;
    bf16_t *M1, *YF1, *YF1c;
    bf16_t *xs, *cs, *xs3;
};

struct Ctx { int tid, bid, nblk; };
DI int lane_id_asm() { int l; asm volatile("v_mbcnt_lo_u32_b32 %0, -1, 0\n\tv_mbcnt_hi_u32_b32 %0, -1, %0" : "=v"(l)); return l; }
DI Ctx make_ctx(int wave_id) { Ctx c; c.tid = wave_id * 64 + lane_id_asm(); c.bid = blockIdx.x; c.nblk = gridDim.x; asm volatile("" : "+v"(c.tid), "+s"(c.bid), "+s"(c.nblk)); return c; }

DI bf16_t f2bf(float f) { unsigned u = __float_as_uint(f); u += 0x7fffu + ((u >> 16) & 1u); return (bf16_t)(u >> 16); }
DI float bf2f(bf16_t b) { return __uint_as_float(((unsigned)b) << 16); }
DI float bflo(unsigned u) { return __uint_as_float(u << 16); }
DI float bfhi(unsigned u) { return __uint_as_float(u & 0xffff0000u); }
DI unsigned pack2(float lo, float hi) { return (unsigned)f2bf(lo) | ((unsigned)f2bf(hi) << 16); }
typedef __bf16 g_bf16x2_t __attribute__((ext_vector_type(2)));
typedef float g_f32x2_t __attribute__((ext_vector_type(2)));
DI unsigned att_pk(float a, float b) { g_f32x2_t f = {a, b}; g_bf16x2_t h = __builtin_convertvector(f, g_bf16x2_t); return __builtin_bit_cast(unsigned, h); }
DI float siluf(float v) { return v / (1.f + expf(-v)); }
DI float sigm(float v) { return 1.f / (1.f + expf(-v)); }
template <int CTRL> DI float dpp_f(float v) { return __builtin_bit_cast(float, __builtin_amdgcn_update_dpp(0, __builtin_bit_cast(int, v), CTRL, 0xf, 0xf, true)); }
DI float wave_sum(float v) {
    v += dpp_f<0xB1>(v); v += dpp_f<0x4E>(v); v += dpp_f<0x141>(v); v += dpp_f<0x140>(v);
    const int x = __builtin_bit_cast(int, v);
    const float a = __builtin_bit_cast(float, __builtin_amdgcn_readlane(x, 0)), b = __builtin_bit_cast(float, __builtin_amdgcn_readlane(x, 16));
    const float c = __builtin_bit_cast(float, __builtin_amdgcn_readlane(x, 32)), d = __builtin_bit_cast(float, __builtin_amdgcn_readlane(x, 48));
    return (a + b) + (c + d);
}

template <bool DUAL, class AFn, class BFn, class BFn2, class Epi>
DI void ngemm(const Ctx& cx, float* lds, int nbz, int M, int N, int K, AFn afn, BFn bfn, BFn2 bfn2, Epi epi) {
    float* As = lds; float* Bs = lds + 16 * 132; float* B2s = Bs + 16 * 128;
    const int tid = cx.tid, ty = tid >> 5, tx = tid & 31;
    const int tm = (M + 127) / 128, tn = (N + 127) / 128, ntile = tm * tn * nbz;
    const int arow = tid >> 2, akc = (tid & 3) * 4, bk = tid >> 5, bnn = (tid & 31) * 4;
    for (int tile = cx.bid; tile < ntile; tile += cx.nblk) {
        const int bz = tile / (tm * tn), rem = tile % (tm * tn), bm = rem / tn, bn = rem % tn;
        float acc[8][4], acc2[8][4];
#pragma unroll
        for (int i = 0; i < 8; ++i)
#pragma unroll
            for (int j = 0; j < 4; ++j) { acc[i][j] = 0.f; acc2[i][j] = 0.f; }
        const int m_a = bm * 128 + arow;
        const bf16_t* aptr = (m_a < M) ? afn(bz, m_a) : nullptr;
        const int nB = bn * 128 + bnn;
        for (int k0 = 0; k0 < K; k0 += 16) {
            float av0 = 0.f, av1 = 0.f, av2 = 0.f, av3 = 0.f;
            if (aptr) { const uint2 u = *(const uint2*)(aptr + k0 + akc); av0 = bflo(u.x); av1 = bfhi(u.x); av2 = bflo(u.y); av3 = bfhi(u.y); }
            float4 bv = make_float4(0.f, 0.f, 0.f, 0.f), bv2 = make_float4(0.f, 0.f, 0.f, 0.f);
            if (nB < N) { bv = *(const float4*)(bfn(bz, k0 + bk) + nB); if (DUAL) bv2 = *(const float4*)(bfn2(bz, k0 + bk) + nB); }
            __syncthreads();
            As[(akc + 0) * 132 + arow] = av0; As[(akc + 1) * 132 + arow] = av1; As[(akc + 2) * 132 + arow] = av2; As[(akc + 3) * 132 + arow] = av3;
            *(float4*)&Bs[bk * 128 + bnn] = bv;
            if (DUAL) *(float4*)&B2s[bk * 128 + bnn] = bv2;
            __syncthreads();
#pragma unroll 4
            for (int kk = 0; kk < 16; ++kk) {
                const float4 a0 = *(const float4*)&As[kk * 132 + ty * 8], a1 = *(const float4*)&As[kk * 132 + ty * 8 + 4];
                const float4 b = *(const float4*)&Bs[kk * 128 + tx * 4];
                const float a[8] = {a0.x, a0.y, a0.z, a0.w, a1.x, a1.y, a1.z, a1.w};
                const float bb[4] = {b.x, b.y, b.z, b.w};
#pragma unroll
                for (int i = 0; i < 8; ++i)
#pragma unroll
                    for (int j = 0; j < 4; ++j) acc[i][j] += a[i] * bb[j];
                if (DUAL) {
                    const float4 b2 = *(const float4*)&B2s[kk * 128 + tx * 4];
                    const float cc[4] = {b2.x, b2.y, b2.z, b2.w};
#pragma unroll
                    for (int i = 0; i < 8; ++i)
#pragma unroll
                        for (int j = 0; j < 4; ++j) acc2[i][j] += a[i] * cc[j];
                }
            }
        }
#pragma unroll
        for (int i = 0; i < 8; ++i) {
            const int m = bm * 128 + ty * 8 + i;
            if (m < M) {
#pragma unroll
                for (int j = 0; j < 4; ++j) { const int n = bn * 128 + tx * 4 + j; if (n < N) epi(bz, m, n, acc[i][j], acc2[i][j]); }
            }
        }
    }
    __syncthreads();
}

DI void ph_prologue(const Ctx& cx, const Params& p, float* lds) {
    const int tid = cx.tid, gtid = cx.bid * NTHR + tid, gsz = cx.nblk * NTHR;
    for (int i = tid; i < 17 * 1024; i += NTHR) { const int j = i >> 10, k = i & 1023; const float v = (j < 16) ? p.c[j * 1024 + k] : p.c_ctx[k]; lds[i] = siluf(v); }
    __syncthreads();
    for (int idx = gtid; idx < 4 * 6144; idx += gsz) {
        const int l = idx / 6144, n = idx % 6144;
        const float* w = p.mod_w + (size_t)l * 1024 * 6144 + n;
        float acc[17]; const float b0 = p.mod_b[l * 6144 + n];
#pragma unroll
        for (int j = 0; j < 17; ++j) acc[j] = b0;
        for (int k = 0; k < 1024; ++k) {
            const float wv = w[(size_t)k * 6144];
#pragma unroll
            for (int j = 0; j < 17; ++j) acc[j] += lds[j * 1024 + k] * wv;
        }
#pragma unroll
        for (int j = 0; j < 17; ++j) p.mod[((size_t)l * 17 + j) * 6144 + n] = acc[j];
    }
    for (int i = gtid; i < 2048 * 4096; i += gsz) {
        const int f = i >> 12, k = i & 4095, t = k & 2047, m = (f * t) & 2047; const float a = (float)m * (1.f / 1024.f);
        p.dftl[i] = f2bf((k < 2048) ? cospif(a) : sinpif(a));
    }
    for (int i = gtid; i < 256 * 512; i += gsz) {
        const int f = i >> 9, k = i & 511, t = k & 255, m = (f * t) & 255; const float a = (float)m * (1.f / 128.f);
        p.dftc[i] = f2bf((k < 256) ? cospif(a) : sinpif(a));
    }
    for (int i = gtid; i < 1024; i += gsz) p.H[(size_t)NT * 1024 + i] = 0;
    __syncthreads();
}

DI float pick4(float a0, float a1, float a2, float a3, int i) { return i == 0 ? a0 : (i == 1 ? a1 : (i == 2 ? a2 : a3)); }
template <bool COMBINE, bool NORM, bool ROUTER>
DI void ph_norm(const Ctx& cx, const Params& p, float* lds, int nrows, const float* xin_lat, const float* xin_ctx, const float* gain, const float* modl, int sh_idx, int sc_idx,
                const float* modprev, int layer) {
    const int tid = cx.tid, wid = tid >> 6, lane = tid & 63;
    float* rw = lds;
    float* scr = lds + 16 * 1024;
    int* lcnt = (int*)(lds + 16 * 1024 + 256); int* lbase = lcnt + 16; int* rlist = lcnt + 32;
    int nlist = 0;
    if (ROUTER) {
        for (int i = tid; i < 16 * 1024; i += NTHR) { const int e = i >> 10, col = i & 1023; rw[i] = p.router_w[col * 16 + e]; }
        if (tid < 16) lcnt[tid] = 0;
        __syncthreads();
    }
    for (int row = cx.bid * 8 + wid; row < nrows; row += cx.nblk * 8) {
        const bool lat = row < NLAT; const int j = lat ? (row >> 11) : 16;
        const float* xr = lat ? xin_lat + (size_t)row * 1024 : xin_ctx + (size_t)(row - NLAT) * 1024;
        float4 xv[4];
#pragma unroll
        for (int i = 0; i < 4; ++i) xv[i] = *(const float4*)(xr + i * 256 + lane * 4);
        if (COMBINE) {
            const float* g2 = modprev + (size_t)j * 6144 + 5 * 1024;
            float* xo = lat ? p.out + (size_t)row * 1024 : p.ctxs + (size_t)(row - NLAT) * 1024;
#pragma unroll
            for (int i = 0; i < 4; ++i) {
                const int col = i * 256 + lane * 4;
                const float4 gv = *(const float4*)(g2 + col);
                float s0 = 0.f, s1 = 0.f, s2 = 0.f, s3 = 0.f;
#pragma unroll
                for (int s = 0; s < 3; ++s) { const uint2 u = *(const uint2*)(p.Y + ((size_t)s * NT + row) * 1024 + col); s0 += bflo(u.x); s1 += bfhi(u.x); s2 += bflo(u.y); s3 += bfhi(u.y); }
                xv[i].x += gv.x * s0; xv[i].y += gv.y * s1; xv[i].z += gv.z * s2; xv[i].w += gv.w * s3;
                *(float4*)(xo + col) = xv[i];
            }
        }
        if (NORM) {
            float ss = 0.f;
#pragma unroll
            for (int i = 0; i < 4; ++i) ss += xv[i].x * xv[i].x + xv[i].y * xv[i].y + xv[i].z * xv[i].z + xv[i].w * xv[i].w;
            ss = wave_sum(ss);
            const float rstd = rsqrtf(ss * (1.f / 1024.f) + 1e-6f);
            const float* shp = modl + (size_t)j * 6144 + sh_idx * 1024; const float* scp = modl + (size_t)j * 6144 + sc_idx * 1024;
            float4 hv[4];
#pragma unroll
            for (int i = 0; i < 4; ++i) {
                const int col = i * 256 + lane * 4;
                const float4 g = *(const float4*)(gain + col), sh = *(const float4*)(shp + col), sc = *(const float4*)(scp + col);
                hv[i].x = xv[i].x * rstd * g.x * (1.f + sc.x) + sh.x; hv[i].y = xv[i].y * rstd * g.y * (1.f + sc.y) + sh.y;
                hv[i].z = xv[i].z * rstd * g.z * (1.f + sc.z) + sh.z; hv[i].w = xv[i].w * rstd * g.w * (1.f + sc.w) + sh.w;
                uint2 u; u.x = pack2(hv[i].x, hv[i].y); u.y = pack2(hv[i].z, hv[i].w);
                *(uint2*)(p.H + (size_t)row * 1024 + col) = u;
            }
            if (ROUTER) {
                float part[16];
#pragma unroll
                for (int e = 0; e < 16; ++e) {
                    float a = 0.f;
#pragma unroll
                    for (int i = 0; i < 4; ++i) { const float4 w = *(const float4*)(rw + e * 1024 + i * 256 + lane * 4); a += hv[i].x * w.x + hv[i].y * w.y + hv[i].z * w.z + hv[i].w * w.w; }
                    part[e] = wave_sum(a);
                }
                float* my = scr + wid * 32;
#pragma unroll
                for (int e = 0; e < 16; ++e) if (lane == e) { const float sg = sigm(part[e]); my[e] = sg; my[16 + e] = sg + p.router_b[e]; }
                __builtin_amdgcn_wave_barrier();
                if (lane == 0) {
                    float best = -3.0e38f; int be1 = 0, be2 = 1;
                    for (int g = 0; g < 4; ++g) {
                        const float v0 = my[16 + 4 * g], v1 = my[16 + 4 * g + 1], v2 = my[16 + 4 * g + 2], v3 = my[16 + 4 * g + 3];
                        int i1 = 0; float m1 = v0;
                        if (v1 > m1) { m1 = v1; i1 = 1; } if (v2 > m1) { m1 = v2; i1 = 2; } if (v3 > m1) { m1 = v3; i1 = 3; }
                        int i2 = -1; float m2 = -3.0e38f;
                        if (i1 != 0 && v0 > m2) { m2 = v0; i2 = 0; } if (i1 != 1 && v1 > m2) { m2 = v1; i2 = 1; }
                        if (i1 != 2 && v2 > m2) { m2 = v2; i2 = 2; } if (i1 != 3 && v3 > m2) { m2 = v3; i2 = 3; }
                        const float gs = m1 + m2;
                        if (gs > best) { best = gs; be1 = 4 * g + i1; be2 = 4 * g + i2; }
                    }
                    const float bs1 = my[be1], bs2 = my[be2];
                    const float inv = 1.f / (bs1 + bs2);
                    const int p1 = atomicAdd(&lcnt[be1], 1), p2 = atomicAdd(&lcnt[be2], 1);
                    int* ent = rlist + (wid * 24 + nlist) * 4;
                    ent[0] = row; ent[1] = be1 | (be2 << 8); ent[2] = p1; ent[3] = p2;
                    p.tokw[row * 2] = bs1 * inv; p.tokw[row * 2 + 1] = bs2 * inv;
                }
                ++nlist;
                __builtin_amdgcn_wave_barrier();
            }
        }
    }
    if (ROUTER) {
        __syncthreads();
        if (tid < 16) lbase[tid] = atomicAdd(p.cnt + (layer * 16 + tid) * 64, lcnt[tid]);
        __syncthreads();
        for (int k = lane; k < nlist; k += 64) {
            const int* ent = rlist + (wid * 24 + k) * 4; const int row = ent[0], be1 = ent[1] & 255, be2 = ent[1] >> 8;
            p.slot[(size_t)be1 * NT + lbase[be1] + ent[2]] = row * 2; p.slot[(size_t)be2 * NT + lbase[be2] + ent[3]] = row * 2 + 1;
        }
    }
    (void)scr;
    __syncthreads();
}

DI void ph_win(const Ctx& cx, const Params& p, float* lds, int j) {
    const float* W = p.w_in + (size_t)j * 1024 * INC;
    ngemm<false>(cx, lds, 1, NT, INC, 1024,
        [&](int, int m) { return p.H + (size_t)m * 1024; },
        [&](int, int k) { return W + (size_t)k * INC; }, [&](int, int) { return (const float*)nullptr; },
        [&](int, int m, int n, float v, float) { p.P[(size_t)m * PLD + n] = f2bf(v); });
}
DI void ph_prepB(const Ctx& cx, const Params& p, int j) {
    const int tid = cx.tid, wid = tid >> 6, lane = tid & 63;
    for (int row = cx.bid * 8 + wid; row < NT; row += cx.nblk * 8) {
        const bf16_t* pr = p.P + (size_t)row * PLD + ACOLS;
        const uint2 uq = *(const uint2*)(pr + lane * 4); const unsigned ukv = *(const unsigned*)(pr + 256 + lane * 2);
        const float q0 = bflo(uq.x), q1 = bfhi(uq.x), q2 = bflo(uq.y), q3 = bfhi(uq.y), k0 = bflo(ukv), k1 = bfhi(ukv);
        const float sq = wave_sum(q0 * q0 + q1 * q1 + q2 * q2 + q3 * q3), sk = wave_sum(k0 * k0 + k1 * k1);
        const float rq = rsqrtf(sq * (1.f / 256.f) + 1e-6f), rk = rsqrtf(sk * (1.f / 128.f) + 1e-6f);
        const float* gq = p.b_q_norm + j * 256 + lane * 4; const float* gk = p.b_kv_norm + j * 128 + lane * 2;
        uint2 o; o.x = pack2(q0 * rq * gq[0], q1 * rq * gq[1]); o.y = pack2(q2 * rq * gq[2], q3 * rq * gq[3]);
        bf16_t* qn = p.QN + (size_t)row * 512;
        *(uint2*)(qn + lane * 4) = o;
        *(unsigned*)(qn + 256 + lane * 2) = pack2(k0 * rk * gk[0], k1 * rk * gk[1]);
        *(unsigned*)(qn + 384 + lane * 2) = 0u;
    }
}
DI void ph_qkvup(const Ctx& cx, const Params& p, float* lds, int j, int mq) {
    const float* Wq = p.b_w_q_up + (size_t)j * 256 * 768; const float* Wkv = p.b_w_kv_up + (size_t)j * 128 * 1024;
    ngemm<false>(cx, lds, 1, mq, 768, 256,
        [&](int, int m) { return p.QN + (size_t)m * 512; },
        [&](int, int k) { return Wq + (size_t)k * 768; }, [&](int, int) { return (const float*)nullptr; },
        [&](int, int m, int n, float v, float) { p.Qraw[(size_t)m * 768 + n] = f2bf(v); });
    ngemm<false>(cx, lds, 1, NT, 1024, 128,
        [&](int, int m) { return p.QN + (size_t)m * 512 + 256; },
        [&](int, int k) { return Wkv + (size_t)k * 1024; }, [&](int, int) { return (const float*)nullptr; },
        [&](int, int m, int n, float v, float) { p.KVraw[(size_t)m * 1024 + n] = f2bf(v); });
}
DI void unpack8(const uint4 u, float* d) { d[0] = bflo(u.x); d[1] = bfhi(u.x); d[2] = bflo(u.y); d[3] = bfhi(u.y); d[4] = bflo(u.z); d[5] = bfhi(u.z); d[6] = bflo(u.w); d[7] = bfhi(u.w); }
DI uint4 pack8(const float* d, float scl) { uint4 u; u.x = pack2(d[0] * scl, d[1] * scl); u.y = pack2(d[2] * scl, d[3] * scl); u.z = pack2(d[4] * scl, d[5] * scl); u.w = pack2(d[6] * scl, d[7] * scl); return u; }
DI float ssq8(const uint4 u) { float d[8]; unpack8(u, d); float s = 0.f;
#pragma unroll
    for (int i = 0; i < 8; ++i) s += d[i] * d[i];
    return s; }
DI void norm_rope_store(const uint4 (&raw)[12], const float* gain, int t, bool lat, float scl, bf16_t* dst) {
    float ss = 0.f;
#pragma unroll
    for (int i = 0; i < 12; ++i) ss += ssq8(raw[i]);
    const float r = rsqrtf(ss * (1.f / 96.f) + 1e-6f);
#pragma unroll
    for (int i = 0; i < 8; ++i) { float d[8]; unpack8(raw[i], d);
#pragma unroll
        for (int c = 0; c < 8; ++c) d[c] = d[c] * r * gain[i * 8 + c];
        *(uint4*)(dst + i * 8) = pack8(d, scl); }
    const float invf[8] = {1.f, 0.316227766016838f, 0.1f, 0.0316227766016838f, 0.01f, 0.00316227766016838f, 0.001f, 0.000316227766016838f};
    const float ri = (float)(t >> 6), ci = (float)(t & 63);
#pragma unroll
    for (int half = 0; half < 2; ++half) {
        float x1[8], x2[8], o1[8], o2[8]; unpack8(raw[8 + half], x1); unpack8(raw[10 + half], x2);
#pragma unroll
        for (int c = 0; c < 8; ++c) {
            const float ang = (half == 0 ? ri : ci) * invf[c];
            const float cs = lat ? __cosf(ang) : 1.f, sn = lat ? __sinf(ang) : 0.f;
            const float a = x1[c] * r * gain[64 + half * 8 + c], b = x2[c] * r * gain[80 + half * 8 + c];
            o1[c] = a * cs - b * sn; o2[c] = b * cs + a * sn;
        }
        *(uint4*)(dst + 64 + half * 8) = pack8(o1, scl); *(uint4*)(dst + 80 + half * 8) = pack8(o2, scl);
    }
}
DI void ph_finalize(const Ctx& cx, const Params& p, int j, int mq) {
    const int gtid = cx.bid * NTHR + cx.tid, gsz = cx.nblk * NTHR;
    const float* qg = p.b_q_gain + j * 96; const float* kg = p.b_k_gain + j * 96;
    for (int idx = gtid; idx < 8 * mq; idx += gsz) {
        const int h = idx / mq, row = idx % mq;
        const bool lat = row < NLAT; const int t = lat ? (row & 2047) : ((row - NLAT) & 255);
        bf16_t* qp = p.Qraw + (size_t)row * 768 + h * 96;
        uint4 raw[12];
#pragma unroll
        for (int i = 0; i < 12; ++i) raw[i] = *(const uint4*)(qp + i * 8);
        norm_rope_store(raw, qg, t, lat, (OPT >= 5) ? 0.10206207261596577f * 1.4426950408889634f : 0.10206207261596577f, qp);
    }
    for (int idx = gtid; idx < 8 * NT; idx += gsz) {
        const int h = idx / NT, row = idx % NT;
        const bool lat = row < NLAT; const int b = lat ? (row >> 11) : ((row - NLAT) >> 8); const int t = lat ? (row & 2047) : ((row - NLAT) & 255);
        const int key = lat ? 256 + t : t;
        const bf16_t* kvp = p.KVraw + (size_t)row * 1024 + h * 128; const bf16_t* krp = p.P + (size_t)row * PLD + ACOLS + 384;
        uint4 raw[12];
#pragma unroll
        for (int i = 0; i < 8; ++i) raw[i] = *(const uint4*)(kvp + i * 8);
#pragma unroll
        for (int i = 0; i < 4; ++i) raw[8 + i] = *(const uint4*)(krp + i * 8);
        norm_rope_store(raw, kg, t, lat, 1.f, p.Kf + ((size_t)(b * 8 + h) * 2304 + key) * 96);
    }
    for (int idx = gtid; idx < 8 * NT; idx += gsz) {
        const int h = idx / NT, row = idx % NT;
        const bool lat = row < NLAT; const int b = lat ? (row >> 11) : ((row - NLAT) >> 8); const int t = lat ? (row & 2047) : ((row - NLAT) & 255);
        const int key = lat ? 256 + t : t;
        const bf16_t* vp = p.KVraw + (size_t)row * 1024 + h * 128 + 64;
        bf16_t* vo = p.Vt + (size_t)(b * 8 + h) * 64 * 2304 + key;
#pragma unroll 1
        for (int i = 0; i < 8; ++i) { const uint4 u = *(const uint4*)(vp + i * 8);
            vo[0] = (bf16_t)(u.x & 0xffff); vo[2304] = (bf16_t)(u.x >> 16); vo[2 * 2304] = (bf16_t)(u.y & 0xffff); vo[3 * 2304] = (bf16_t)(u.y >> 16);
            vo[4 * 2304] = (bf16_t)(u.z & 0xffff); vo[5 * 2304] = (bf16_t)(u.z >> 16); vo[6 * 2304] = (bf16_t)(u.w & 0xffff); vo[7 * 2304] = (bf16_t)(u.w >> 16);
            vo += 8 * 2304; }
    }
}
DI void ph_attn(const Ctx& cx, const Params& p, bool with_ctx) {
    const int gtid = cx.bid * NTHR + cx.tid, gsz = cx.nblk * NTHR;
    const int total = NLAT * 8 + (with_ctx ? NCTX * 8 : 0);
    for (int idx = gtid; idx < total; idx += gsz) {
        int b, h, row, nkeys;
        if (idx < NLAT * 8) { b = idx >> 14; h = (idx >> 11) & 7; row = b * 2048 + (idx & 2047); nkeys = 2304; }
        else { const int i2 = idx - NLAT * 8; b = i2 >> 11; h = (i2 >> 8) & 7; row = NLAT + b * 256 + (i2 & 255); nkeys = 256; }
        const bf16_t* qp = p.Qraw + (size_t)row * 768 + h * 96;
        const bf16_t* Kb = p.Kf + (size_t)(b * 8 + h) * 2304 * 96; const bf16_t* Vb = p.Vt + (size_t)(b * 8 + h) * 64 * 2304;
        float q[96];
#pragma unroll
        for (int i = 0; i < 12; ++i) { const uint4 u = *(const uint4*)(qp + i * 8); q[i * 8] = bflo(u.x); q[i * 8 + 1] = bfhi(u.x); q[i * 8 + 2] = bflo(u.y); q[i * 8 + 3] = bfhi(u.y);
            q[i * 8 + 4] = bflo(u.z); q[i * 8 + 5] = bfhi(u.z); q[i * 8 + 6] = bflo(u.w); q[i * 8 + 7] = bfhi(u.w); }
        float acc[64];
#pragma unroll
        for (int i = 0; i < 64; ++i) acc[i] = 0.f;
        float mx = -3.0e38f, l = 0.f;
        for (int key0 = 0; key0 < nkeys; key0 += 8) {
            float s[8];
#pragma unroll
            for (int kk = 0; kk < 8; ++kk) {
                const uint4* kp = (const uint4*)(Kb + (size_t)(key0 + kk) * 96); float a = 0.f;
#pragma unroll
                for (int i = 0; i < 12; ++i) { const uint4 u = kp[i]; a += q[i * 8] * bflo(u.x) + q[i * 8 + 1] * bfhi(u.x) + q[i * 8 + 2] * bflo(u.y) + q[i * 8 + 3] * bfhi(u.y)
                    + q[i * 8 + 4] * bflo(u.z) + q[i * 8 + 5] * bfhi(u.z) + q[i * 8 + 6] * bflo(u.w) + q[i * 8 + 7] * bfhi(u.w); }
                s[kk] = a;
            }
            float cm = s[0];
#pragma unroll
            for (int kk = 1; kk < 8; ++kk) cm = fmaxf(cm, s[kk]);
            const float mn = fmaxf(mx, cm), alpha = expf(mx - mn);
            float ps = 0.f;
#pragma unroll
            for (int kk = 0; kk < 8; ++kk) { s[kk] = expf(s[kk] - mn); ps += s[kk]; }
            l = l * alpha + ps; mx = mn;
#pragma unroll
            for (int dv = 0; dv < 64; ++dv) {
                const uint4 u = *(const uint4*)(Vb + (size_t)dv * 2304 + key0);
                acc[dv] = acc[dv] * alpha + s[0] * bflo(u.x) + s[1] * bfhi(u.x) + s[2] * bflo(u.y) + s[3] * bfhi(u.y) + s[4] * bflo(u.z) + s[5] * bfhi(u.z) + s[6] * bflo(u.w) + s[7] * bfhi(u.w);
            }
        }
        const float il = 1.f / l;
        bf16_t* o = p.H + (size_t)row * 1024 + 512 + h * 64;
#pragma unroll
        for (int i = 0; i < 8; ++i) { uint4 u; u.x = pack2(acc[i * 8] * il, acc[i * 8 + 1] * il); u.y = pack2(acc[i * 8 + 2] * il, acc[i * 8 + 3] * il);
            u.z = pack2(acc[i * 8 + 4] * il, acc[i * 8 + 5] * il); u.w = pack2(acc[i * 8 + 6] * il, acc[i * 8 + 7] * il); *(uint4*)(o + i * 8) = u; }
    }
}
DI float shiftp(const bf16_t* P, int row, int t, int T, int col, float mu) {
    const float c = bf2f(P[(size_t)row * PLD + col]);
    const float pv = (t > 0) ? bf2f(P[(size_t)(row - 1) * PLD + col]) : 0.f;
    const float nx = (t < T - 1) ? bf2f(P[(size_t)(row + 1) * PLD + col]) : 0.f;
    return c + mu * (0.5f * (pv + nx) - c);
}
DI void ph_prepLR(const Ctx& cx, const Params& p, int j) {
    const int gtid = cx.bid * NTHR + cx.tid, gsz = cx.nblk * NTHR;
    const float* mu = p.a_mu + j * ACOLS + 1536;
    for (int idx = gtid; idx < NT * 384; idx += gsz) {
        const int row = idx / 384, col = idx % 384;
        const bool lat = row < NLAT; const int t = lat ? (row & 2047) : ((row - NLAT) & 255); const int T = lat ? 2048 : 256;
        float v = shiftp(p.P, row, t, T, 1536 + col, mu[col]);
        if (col < 128) v = tanhf(v); else if (col >= 256) v = sigm(v);
        p.LR[(size_t)row * 384 + col] = f2bf(v);
    }
}
DI void ph_wag(const Ctx& cx, const Params& p, float* lds, int j) {
    for (int d = 0; d < 2; ++d) {
        const float* W2 = p.a_w2 + (size_t)(j * 2 + d) * 64 * 512; const float* w0 = p.a_w0 + (j * 2 + d) * 512;
        ngemm<false>(cx, lds, 1, NT, 512, 64,
            [&](int, int m) { return p.LR + (size_t)m * 384 + d * 64; },
            [&](int, int k) { return W2 + (size_t)k * 512; }, [&](int, int) { return (const float*)nullptr; },
            [&](int, int m, int n, float v, float) { const float z = -0.606531f * sigm(w0[n] + v); p.WAG[(size_t)m * WLD + d * 512 + n] = f2bf(-expm1f(z)); });
        const float* A2 = p.a_a2 + (size_t)(j * 2 + d) * 64 * 512; const float* a0 = p.a_a0 + (j * 2 + d) * 512;
        ngemm<false>(cx, lds, 1, NT, 512, 64,
            [&](int, int m) { return p.LR + (size_t)m * 384 + 128 + d * 64; },
            [&](int, int k) { return A2 + (size_t)k * 512; }, [&](int, int) { return (const float*)nullptr; },
            [&](int, int m, int n, float v, float) { p.WAG[(size_t)m * WLD + 1024 + d * 512 + n] = f2bf(sigm(a0[n] + v)); });
    }
    const float* G2 = p.a_g2 + (size_t)j * 128 * 512;
    ngemm<false>(cx, lds, 1, NT, 512, 128,
        [&](int, int m) { return p.LR + (size_t)m * 384 + 256; },
        [&](int, int k) { return G2 + (size_t)k * 512; }, [&](int, int) { return (const float*)nullptr; },
        [&](int, int m, int n, float v, float) { p.WAG[(size_t)m * WLD + 2048 + n] = f2bf(v); });
}
DI void ph_scan(const Ctx& cx, const Params& p, float* lds, int j) {
    const int tid = cx.tid, lane = tid & 63;
    if (tid < 64) {
        for (int item = cx.bid; item < 256; item += cx.nblk) {
            const int b = item >> 4, h = (item >> 1) & 7, dir = item & 1, hc = h * 64 + lane;
            float S[64];
#pragma unroll
            for (int k = 0; k < 64; ++k) S[k] = 0.f;
            const float kkc = p.a_k_k[j * 512 + hc], kac = p.a_k_a[j * 512 + hc];
            const float mur = p.a_mu[j * ACOLS + hc], muk = p.a_mu[j * ACOLS + 512 + hc], muv = p.a_mu[j * ACOLS + 1024 + hc];
            bf16_t* yout = dir ? p.YB : p.YF;
            for (int step = 0; step < 2304; ++step) {
                const bool cp = step < 256; const int tt = cp ? step : step - 256, T = cp ? 256 : 2048, t = dir ? (T - 1 - tt) : tt;
                const int row = cp ? NLAT + b * 256 + t : b * 2048 + t;
                const float R = shiftp(p.P, row, t, T, hc, mur), K = shiftp(p.P, row, t, T, 512 + hc, muk), V = shiftp(p.P, row, t, T, 1024 + hc, muv);
                const float w = 1.f - bf2f(p.WAG[(size_t)row * WLD + dir * 512 + hc]), a = bf2f(p.WAG[(size_t)row * WLD + 1024 + dir * 512 + hc]);
                const float kkv = K * kkc, ssq = wave_sum(kkv * kkv), kk = kkv * rsqrtf(ssq + 1e-12f);
                const float kd = K * (1.f + (a - 1.f) * kac), bd = kk * a;
                lds[lane] = -kk; lds[64 + lane] = w; lds[128 + lane] = bd; lds[192 + lane] = kd; lds[256 + lane] = R;
                __builtin_amdgcn_wave_barrier();
                float sa = 0.f;
#pragma unroll
                for (int k4 = 0; k4 < 16; ++k4) { const float4 v = *(const float4*)(lds + k4 * 4); sa += S[k4 * 4] * v.x + S[k4 * 4 + 1] * v.y + S[k4 * 4 + 2] * v.z + S[k4 * 4 + 3] * v.w; }
                float y = 0.f;
#pragma unroll
                for (int k4 = 0; k4 < 16; ++k4) {
                    const float4 wv = *(const float4*)(lds + 64 + k4 * 4), bv = *(const float4*)(lds + 128 + k4 * 4), kv = *(const float4*)(lds + 192 + k4 * 4), rv = *(const float4*)(lds + 256 + k4 * 4);
                    S[k4 * 4] = S[k4 * 4] * wv.x + sa * bv.x + V * kv.x; S[k4 * 4 + 1] = S[k4 * 4 + 1] * wv.y + sa * bv.y + V * kv.y;
                    S[k4 * 4 + 2] = S[k4 * 4 + 2] * wv.z + sa * bv.z + V * kv.z; S[k4 * 4 + 3] = S[k4 * 4 + 3] * wv.w + sa * bv.w + V * kv.w;
                    y += S[k4 * 4] * rv.x + S[k4 * 4 + 1] * rv.y + S[k4 * 4 + 2] * rv.z + S[k4 * 4 + 3] * rv.w;
                }
                __builtin_amdgcn_wave_barrier();
                yout[(size_t)row * 512 + hc] = f2bf(y);
            }
        }
    }
    __syncthreads();
}
DI void ph_post(const Ctx& cx, const Params& p, int j, int nrows) {
    const int gtid = cx.bid * NTHR + cx.tid, gsz = cx.nblk * NTHR;
    for (int idx = gtid; idx < 8 * nrows; idx += gsz) {
        const int h = idx / nrows, row = idx % nrows;
        const bool lat = row < NLAT; const int t = lat ? (row & 2047) : ((row - NLAT) & 255); const int T = lat ? 2048 : 256;
        float sum = 0.f, sb = 0.f;
#pragma unroll 8
        for (int n = 0; n < 64; ++n) {
            const int hc = h * 64 + n;
            const float yy = bf2f(p.YF[(size_t)row * 512 + hc]) + bf2f(p.YB[(size_t)row * 512 + hc]);
            sum += yy;
            const float R = shiftp(p.P, row, t, T, hc, p.a_mu[j * ACOLS + hc]), K = shiftp(p.P, row, t, T, 512 + hc, p.a_mu[j * ACOLS + 512 + hc]);
            const float af = bf2f(p.WAG[(size_t)row * WLD + 1024 + hc]), ab = bf2f(p.WAG[(size_t)row * WLD + 1536 + hc]);
            const float ka = p.a_k_a[j * 512 + hc], rk = p.a_r_k[j * 512 + hc];
            sb += R * rk * (K * (1.f + (af - 1.f) * ka) + K * (1.f + (ab - 1.f) * ka));
        }
        const float mean = sum * (1.f / 64.f); float var = 0.f;
#pragma unroll 8
        for (int n = 0; n < 64; ++n) { const int hc = h * 64 + n; const float yy = bf2f(p.YF[(size_t)row * 512 + hc]) + bf2f(p.YB[(size_t)row * 512 + hc]); var += (yy - mean) * (yy - mean); }
        const float rstd = rsqrtf(var * (1.f / 64.f) + 64e-5f);
#pragma unroll 8
        for (int n = 0; n < 64; ++n) {
            const int hc = h * 64 + n;
            const float yy = bf2f(p.YF[(size_t)row * 512 + hc]) + bf2f(p.YB[(size_t)row * 512 + hc]);
            const float V = shiftp(p.P, row, t, T, 1024 + hc, p.a_mu[j * ACOLS + 1024 + hc]);
            const float g = bf2f(p.WAG[(size_t)row * WLD + 2048 + hc]);
            const float o = ((yy - mean) * rstd * p.a_ln_w[j * 512 + hc] + p.a_ln_b[j * 512 + hc] + sb * V) * g;
            p.H[(size_t)row * 1024 + hc] = f2bf(o);
        }
    }
}
DI void ph_wout(const Ctx& cx, const Params& p, float* lds, const bf16_t* A, const float* W, int nrows, const float* xin_lat, const float* xin_ctx, const float* modl) {
    ngemm<false>(cx, lds, 1, nrows, 1024, 1024,
        [&](int, int m) { return A + (size_t)m * 1024; },
        [&](int, int k) { return W + (size_t)k * 1024; }, [&](int, int) { return (const float*)nullptr; },
        [&](int, int m, int n, float v, float) {
            const bool lat = m < NLAT; const int jj = lat ? (m >> 11) : 16; const float g1 = modl[(size_t)jj * 6144 + 2 * 1024 + n];
            if (lat) p.out[(size_t)m * 1024 + n] = xin_lat[(size_t)m * 1024 + n] + g1 * v;
            else p.ctxs[(size_t)(m - NLAT) * 1024 + n] = xin_ctx[(size_t)(m - NLAT) * 1024 + n] + g1 * v; });
}

DI void ph_chdft(const Ctx& cx, const Params& p, float* lds, int nrows) {
    const int tid = cx.tid, gtid = cx.bid * NTHR + tid, gsz = cx.nblk * NTHR;
    for (int i = tid; i < 128; i += NTHR) { lds[i] = cospif((float)i * (1.f / 64.f)); lds[128 + i] = sinpif((float)i * (1.f / 64.f)); }
    __syncthreads();
    for (int idx = gtid; idx < nrows * 1024; idx += gsz) {
        const int row = idx >> 10, col = idx & 1023, grp = col >> 7, g = col & 127;
        const bf16_t* hp = p.H + (size_t)row * 1024 + grp * 128;
        float gr = 0.f, gi = 0.f;
        for (int c = 0; c < 128; ++c) { const float xv = bf2f(hp[c]); const int m = (c * g) & 127; gr += xv * lds[m]; gi -= xv * lds[128 + m]; }
        p.G[(size_t)row * 2048 + col] = gr; p.G[(size_t)row * 2048 + 1024 + col] = gi;
    }
    __syncthreads();
}
DI void ph_posdft(const Ctx& cx, const Params& p, float* lds, bool with_ctx) {
    ngemm<false>(cx, lds, 16, 2048, 1024, 4096,
        [&](int, int m) { return p.dftl + (size_t)m * 4096; },
        [&](int bz, int k) { return (k < 2048) ? p.G + (size_t)(bz * 2048 + k) * 2048 : p.G + (size_t)(bz * 2048 + k - 2048) * 2048 + 1024; }, [&](int, int) { return (const float*)nullptr; },
        [&](int bz, int m, int n, float v, float) { p.F[(size_t)(bz * 2048 + m) * 1024 + n] = f2bf(v * (1.f / 512.f)); });
    if (with_ctx)
        ngemm<false>(cx, lds, 16, 256, 1024, 512,
            [&](int, int m) { return p.dftc + (size_t)m * 512; },
            [&](int bz, int k) { return (k < 256) ? p.G + (size_t)(NLAT + bz * 256 + k) * 2048 : p.G + (size_t)(NLAT + bz * 256 + k - 256) * 2048 + 1024; }, [&](int, int) { return (const float*)nullptr; },
            [&](int bz, int m, int n, float v, float) { p.F[(size_t)(NLAT + bz * 256 + m) * 1024 + n] = f2bf(v * 0.0055242717280199f); });
}

DI void ph_moe_up(const Ctx& cx, const Params& p, float* lds, int layer, int nrows) {
    for (int e = 0; e < 17; ++e) {
        const int M = (e < 16) ? __builtin_amdgcn_readfirstlane(p.cnt[(layer * 16 + e) * 64]) : nrows;
        const float* Wg = (e < 16) ? p.moe_w_gate + ((size_t)layer * 16 + e) * 1024 * 512 : p.sh_gate + (size_t)layer * 1024 * 512;
        const float* Wu = (e < 16) ? p.moe_w_up + ((size_t)layer * 16 + e) * 1024 * 512 : p.sh_up + (size_t)layer * 1024 * 512;
        const int* sl = p.slot + (size_t)(e & 15) * NT;
        ngemm<true>(cx, lds, 1, M, 512, 1024,
            [&](int, int m) { const int tok = (e < 16) ? (sl[m] >> 1) : m; return p.H + (size_t)tok * 1024; },
            [&](int, int k) { return Wg + (size_t)k * 512; }, [&](int, int k) { return Wu + (size_t)k * 512; },
            [&](int, int m, int n, float g, float u) { const int s = (e < 16) ? sl[m] : 0; const int tok = (e < 16) ? (s >> 1) : m, slab = (e < 16) ? (s & 1) : 2;
                p.ACT[((size_t)slab * NT + tok) * 512 + n] = f2bf(siluf(g) * u); });
    }
}
DI void ph_moe_down(const Ctx& cx, const Params& p, float* lds, int layer, int nrows) {
    for (int e = 0; e < 17; ++e) {
        const int M = (e < 16) ? __builtin_amdgcn_readfirstlane(p.cnt[(layer * 16 + e) * 64]) : nrows;
        const float* Wd = (e < 16) ? p.moe_w_down + ((size_t)layer * 16 + e) * 512 * 1024 : p.sh_down + (size_t)layer * 512 * 1024;
        const int* sl = p.slot + (size_t)(e & 15) * NT;
        ngemm<false>(cx, lds, 1, M, 1024, 512,
            [&](int, int m) { const int s = (e < 16) ? sl[m] : 0; const int tok = (e < 16) ? (s >> 1) : m, slab = (e < 16) ? (s & 1) : 2; return p.ACT + ((size_t)slab * NT + tok) * 512; },
            [&](int, int k) { return Wd + (size_t)k * 1024; }, [&](int, int) { return (const float*)nullptr; },
            [&](int, int m, int n, float v, float) { const int s = (e < 16) ? sl[m] : 0; const int tok = (e < 16) ? (s >> 1) : m, slab = (e < 16) ? (s & 1) : 2;
                const float w = (e < 16) ? p.tokw[s] : 1.f; p.Y[((size_t)slab * NT + tok) * 1024 + n] = f2bf(w * v); });
    }
}

namespace mm {
typedef short bf16x8 __attribute__((ext_vector_type(8)));
typedef float f32x4 __attribute__((ext_vector_type(4)));
typedef unsigned u32x4 __attribute__((ext_vector_type(4)));
constexpr int BM = 256, BK = 64, HALF = 128, HTB = HALF * BK * 2, STAGE_BYTES = 8 * HTB;
DI int lds_byte(int r, int c) { const int st = (r >> 4) * 2 + (c >> 5), rr = r & 15, cc = c & 31, ob = rr * 64 + cc * 2; return st * 1024 + (ob ^ (((ob >> 9) & 1) << 5)); }
DI void stage_rc(int b, int& R, int& C) { const int st = b / 1024, sb = b % 1024, swz = sb ^ (((sb >> 9) & 1) << 5); R = (st >> 1) * 16 + swz / 64; C = (st & 1) * 32 + (swz % 64) / 2; }
DI int perm32(int rho) { const int n = rho >> 4, i = rho & 15; return 8 * (i >> 2) + 4 * n + (i & 3); }
DI unsigned cvt_pk_bf16(float lo, float hi) { unsigned r; asm volatile("v_cvt_pk_bf16_f32 %0, %1, %2" : "=v"(r) : "v"(lo), "v"(hi)); return r; }
struct Unit { const char* A; const char* B; int pm, pn, e, m, tb; };
template <class Sched, class Epi>
DI void gemm_phase(LAS unsigned char* lds, const int K, const Sched& S, const Epi& E, const int tid) {
    const int wid = __builtin_amdgcn_readfirstlane(tid >> 6), lane = tid & 63, wr = wid >> 2, wc = wid & 3, fr = lane & 15, fq = lane >> 4;
    const int nt = K / BK;
    int R0, C0, R1, C1; stage_rc(tid * 16, R0, C0); stage_rc(tid * 16 + 8192, R1, C1);
    unsigned voffB[2];
    { const int Rb0 = Epi::PERM ? ((R0 & ~31) + perm32(R0 & 31)) : R0, Rb1 = Epi::PERM ? ((R1 & ~31) + perm32(R1 & 31)) : R1;
      voffB[0] = S.boff(Rb0, C0, K); voffB[1] = S.boff(Rb1, C1, K); }
    const size_t kstep = (size_t)(BK * 2), hstepB = S.hstep_b(K), hstepA = S.hstep_a();
    const unsigned ldsw = (unsigned)wid * 1024u;
    const int aoff = lds_byte(wr * 64 + fr, fq * 8), boff = lds_byte(wc * 32 + fr, fq * 8);
#define MM_SA(b, h) (((b) * 2 + (h)) * HTB)
#define MM_SB(b, h) ((4 + (b) * 2 + (h)) * HTB)
#define MM_STAGE_A(bufoff, gbase, h, offs) do { _Pragma("unroll") for (int _i = 0; _i < 2; ++_i) { \
        if constexpr (Sched::GATHER) __builtin_amdgcn_global_load_lds((const unsigned*)((const char*)(gbase) + (offs)[h][_i]), (LAS unsigned*)(lds + (bufoff) + ldsw + _i * 8192), 16, 0, 0); \
        else __builtin_amdgcn_global_load_lds((const unsigned*)((const char*)(gbase) + (size_t)(h) * hstepA + (offs)[0][_i]), (LAS unsigned*)(lds + (bufoff) + ldsw + _i * 8192), 16, 0, 0); } } while (0)
#define MM_STAGE_B(bufoff, gbase) do { _Pragma("unroll") for (int _i = 0; _i < 2; ++_i) \
        __builtin_amdgcn_global_load_lds((const unsigned*)((const char*)(gbase) + voffB[_i]), (LAS unsigned*)(lds + (bufoff) + ldsw + _i * 8192), 16, 0, 0); } while (0)
#define MM_LDA(dst, b, h) do { _Pragma("unroll") for (int m = 0; m < 4; ++m) _Pragma("unroll") for (int k = 0; k < 2; ++k) dst[m][k] = *(const LAS bf16x8*)(lds + MM_SA(b, h) + aoff + m * 2048 + k * 1024); } while (0)
#define MM_LDB(dst, b, h) do { _Pragma("unroll") for (int n = 0; n < 2; ++n) _Pragma("unroll") for (int k = 0; k < 2; ++k) dst[n][k] = *(const LAS bf16x8*)(lds + MM_SB(b, h) + boff + n * 2048 + k * 1024); } while (0)
#define MM_MMA(ai, bj, At, Bt) do { __builtin_amdgcn_s_setprio(1); _Pragma("unroll") for (int m = 0; m < 4; ++m) _Pragma("unroll") for (int n = 0; n < 2; ++n) _Pragma("unroll") for (int k = 0; k < 2; ++k) \
        acc[ai][bj][m][n] = __builtin_amdgcn_mfma_f32_16x16x32_bf16(Bt[n][k], At[m][k], acc[ai][bj][m][n], 0, 0, 0); __builtin_amdgcn_s_setprio(0); } while (0)
#define MM_WAIT_V(n) asm volatile("s_waitcnt vmcnt(" #n ")" ::: "memory")
#define MM_WAIT_L(n) asm volatile("s_waitcnt lgkmcnt(" #n ")" ::: "memory")
#define MM_BAR __builtin_amdgcn_s_barrier()
#define MM_SCHED __builtin_amdgcn_sched_barrier(0)
    Unit cur, nxt; int ui = 0;
    if (!S.next(0, cur)) return;
    unsigned oa[2][2], on[2][2];
    S.aoff(cur, R0, C0, R1, C1, oa);
    on[0][0] = oa[0][0]; on[0][1] = oa[0][1]; on[1][0] = oa[1][0]; on[1][1] = oa[1][1];
    if constexpr (Sched::TABLE) S.tab_dma(cur, lds + STAGE_BYTES + 1024, tid);
    f32x4 acc[2][2][4][2];
#pragma unroll
    for (int a = 0; a < 2; ++a)
#pragma unroll
        for (int b = 0; b < 2; ++b)
#pragma unroll
            for (int m = 0; m < 4; ++m)
#pragma unroll
                for (int n = 0; n < 2; ++n) acc[a][b][m][n] = (f32x4){0.f, 0.f, 0.f, 0.f};
    bf16x8 At[4][2], B0[2][2], B1[2][2];
    const char* cA = cur.A; const char* cB = cur.B;
    MM_STAGE_B(MM_SB(0, 0), cB); MM_STAGE_A(MM_SA(0, 0), cA, 0, oa); MM_STAGE_B(MM_SB(0, 1), cB + hstepB); MM_STAGE_A(MM_SA(0, 1), cA, 1, oa);
    if (wr == 1) MM_BAR;
    MM_WAIT_V(4); MM_BAR;
    MM_STAGE_B(MM_SB(1, 0), cB + kstep); MM_STAGE_A(MM_SA(1, 0), cA + kstep, 0, oa); MM_STAGE_B(MM_SB(1, 1), cB + hstepB + kstep);
    MM_WAIT_V(6); MM_BAR;
    for (;;) {
        cur.tb = ui % 3;
        const bool has_next = S.next(ui + 1, nxt);
        if constexpr (Sched::TABLE) { if (has_next) S.tab_dma(nxt, lds + STAGE_BYTES + 1024 + ((ui + 1) % 3) * 2048, tid); }
        const char* nA = has_next ? nxt.A : cA; const char* nB = has_next ? nxt.B : cB;
        for (int t = 0; t < nt; t += 2) {
            const bool last = (t == nt - 2);
            if constexpr (Sched::GATHER) { if (last) { if (has_next) S.aoff_lds(nxt, (const LAS int*)(lds + STAGE_BYTES + 1024 + ((ui + 1) % 3) * 2048), R0, C0, R1, C1, on);
                else { on[0][0] = oa[0][0]; on[0][1] = oa[0][1]; on[1][0] = oa[1][0]; on[1][1] = oa[1][1]; } } }
            const char* a1 = cA + (size_t)(t + 1) * kstep;
            const char* a2 = last ? nA : cA + (size_t)(t + 2) * kstep; const char* b2 = last ? nB : cB + (size_t)(t + 2) * kstep;
            const char* a3 = a2 + kstep; const char* b3 = b2 + kstep;
            unsigned o2[2][2];
            if constexpr (Sched::GATHER) { o2[0][0] = last ? on[0][0] : oa[0][0]; o2[0][1] = last ? on[0][1] : oa[0][1]; o2[1][0] = last ? on[1][0] : oa[1][0]; o2[1][1] = last ? on[1][1] : oa[1][1]; }
            else { o2[0][0] = oa[0][0]; o2[0][1] = oa[0][1]; o2[1][0] = oa[1][0]; o2[1][1] = oa[1][1]; }
            MM_LDB(B0, 0, 0); MM_SCHED; MM_LDA(At, 0, 0); MM_STAGE_A(MM_SA(1, 1), a1, 1, oa);
            MM_WAIT_L(8); MM_BAR; MM_WAIT_L(0); MM_MMA(0, 0, At, B0); MM_BAR; MM_SCHED;
            MM_LDB(B1, 0, 1); MM_STAGE_B(MM_SB(0, 0), b2);
            MM_BAR; MM_WAIT_L(0); MM_MMA(0, 1, At, B1); MM_BAR;
            MM_LDA(At, 0, 1); MM_STAGE_A(MM_SA(0, 0), a2, 0, o2);
            MM_BAR; MM_WAIT_L(0); MM_MMA(1, 0, At, B0); MM_BAR; MM_SCHED;
            MM_STAGE_B(MM_SB(0, 1), b2 + hstepB);
            MM_WAIT_V(6); MM_BAR; MM_MMA(1, 1, At, B1); MM_BAR;
            MM_LDB(B0, 1, 0); MM_SCHED; MM_LDA(At, 1, 0); MM_STAGE_A(MM_SA(0, 1), a2, 1, o2);
            MM_WAIT_L(8); MM_BAR; MM_WAIT_L(0); MM_MMA(0, 0, At, B0); MM_BAR; MM_SCHED;
            MM_LDB(B1, 1, 1); MM_STAGE_B(MM_SB(1, 0), b3);
            MM_BAR; MM_WAIT_L(0); MM_MMA(0, 1, At, B1); MM_BAR;
            MM_LDA(At, 1, 1); MM_STAGE_A(MM_SA(1, 0), a3, 0, o2);
            MM_BAR; MM_WAIT_L(0); MM_MMA(1, 0, At, B0); MM_BAR; MM_SCHED;
            MM_STAGE_B(MM_SB(1, 1), b3 + hstepB);
            MM_WAIT_V(6); MM_BAR; MM_MMA(1, 1, At, B1); MM_BAR;
        }
        {
          int tz = tid; asm volatile("" : "+v"(tz)); const int wz = tz >> 6, lz = tz & 63;
          E(acc, cur, wz >> 2, wz & 3, lz & 15, lz >> 4); }
        if (!has_next) break;
#pragma unroll
        for (int a = 0; a < 2; ++a)
#pragma unroll
            for (int b = 0; b < 2; ++b)
#pragma unroll
                for (int m = 0; m < 4; ++m)
#pragma unroll
                    for (int n = 0; n < 2; ++n) acc[a][b][m][n] = (f32x4){0.f, 0.f, 0.f, 0.f};
        cur = nxt; cA = nA; cB = nB; ++ui;
        if constexpr (Sched::GATHER) { oa[0][0] = on[0][0]; oa[0][1] = on[0][1]; oa[1][0] = on[1][0]; oa[1][1] = on[1][1]; }
    }
    MM_WAIT_V(0);
    if (wr == 0) MM_BAR;
    MM_BAR;
#undef MM_SA
#undef MM_SB
#undef MM_STAGE_A
#undef MM_STAGE_B
#undef MM_LDA
#undef MM_LDB
#undef MM_MMA
#undef MM_WAIT_V
#undef MM_WAIT_L
#undef MM_BAR
#undef MM_SCHED
}
struct StaticSched {
    static constexpr bool GATHER = false, TABLE = false;
    const char* A; const char* Bt; int lda, K, nM, nN, nwg, G, c;
    DI size_t hstep_a() const { return (size_t)HALF * lda * 2; }
    DI unsigned boff(int Rb, int C, int Kk) const { return (unsigned)(Rb * Kk + C) * 2u; }
    DI size_t hstep_b(int Kk) const { return (size_t)HALF * Kk * 2; }
    DI void init(const void* A_, const void* Bt_, int M, int N, int K_, int lda_, int G_, int c_) { A = (const char*)A_; Bt = (const char*)Bt_; lda = lda_; K = K_; nM = M / BM; nN = N / BM; nwg = nM * nN; G = G_; c = c_; }
    DI bool next(int i, Unit& u) const {
        const int L = i * G + c; if (L >= nwg) return false;
        int wgid = L; { const int q = nwg / 8, r = nwg % 8, xcd = wgid % 8, off = wgid / 8; wgid = (xcd < r ? xcd * (q + 1) : r * (q + 1) + (xcd - r) * q) + off; }
        const int nig = 8 * nN, gid = wgid / nig, fm = gid * 8, gsz = (nM - fm) < 8 ? (nM - fm) : 8;
        u.pm = fm + ((wgid % nig) % gsz); u.pn = (wgid % nig) / gsz; u.e = 0; u.m = 0;
        u.A = A + (size_t)u.pm * BM * lda * 2; u.B = Bt + (size_t)u.pn * BM * K * 2; return true;
    }
    DI void aoff(const Unit&, int R0, int C0, int R1, int C1, unsigned (&o)[2][2]) const {
        o[0][0] = (unsigned)(R0 * lda + C0) * 2u; o[0][1] = (unsigned)(R1 * lda + C1) * 2u;
        o[1][0] = (unsigned)((HALF + R0) * lda + C0) * 2u; o[1][1] = (unsigned)((HALF + R1) * lda + C1) * 2u;
    }
};
struct BatchSched {
    static constexpr bool GATHER = false, TABLE = false;
    const char* A; const char* Bt; int K, nM, nN, nb, G, c; size_t bstride;
    DI size_t hstep_a() const { return (size_t)HALF * K * 2; }
    DI unsigned boff(int Rb, int C, int Kk) const { return (unsigned)(Rb * Kk + C) * 2u; }
    DI size_t hstep_b(int Kk) const { return (size_t)HALF * Kk * 2; }
    DI void init(const void* A_, const void* Bt_, size_t bstride_bytes, int nb_, int M, int N, int K_, int G_, int c_) { A = (const char*)A_; Bt = (const char*)Bt_; bstride = bstride_bytes; nb = nb_; K = K_; nM = M / BM; nN = N / BM; G = G_; c = c_; }
    DI bool next(int i, Unit& u) const {
        const int L = i * G + c; if (L >= nb * nM * nN) return false;
        const int b = L / (nM * nN), rem = L % (nM * nN); u.pm = rem / nN; u.pn = rem % nN; u.e = b; u.m = 0;
        u.A = A + (size_t)u.pm * BM * K * 2; u.B = Bt + (size_t)b * bstride + (size_t)u.pn * BM * K * 2; return true;
    }
    DI void aoff(const Unit&, int R0, int C0, int R1, int C1, unsigned (&o)[2][2]) const {
        o[0][0] = (unsigned)(R0 * K + C0) * 2u; o[0][1] = (unsigned)(R1 * K + C1) * 2u;
        o[1][0] = (unsigned)((HALF + R0) * K + C0) * 2u; o[1][1] = (unsigned)((HALF + R1) * K + C1) * 2u;
    }
};
struct EpiBf16Store {
    static constexpr bool PERM = true;
    bf16_t* O0; int ldc; size_t bstr = 0;
    DI void operator()(const f32x4 (&acc)[2][2][4][2], const Unit& u, int wr, int wc, int fr, int fq) const {
        bf16_t* O = O0 + (size_t)u.e * bstr;
        const int row0 = u.pm * BM + wr * 64 + fr, col0 = u.pn * BM + wc * 32 + 8 * fq;
#pragma unroll
        for (int ai = 0; ai < 2; ++ai)
#pragma unroll
            for (int m = 0; m < 4; ++m) { bf16_t* rowp = O + (size_t)(row0 + ai * HALF + m * 16) * ldc + col0;
#pragma unroll
                for (int bj = 0; bj < 2; ++bj) { const f32x4 v0 = acc[ai][bj][m][0], v1 = acc[ai][bj][m][1];
                    u32x4 w; w.x = cvt_pk_bf16(v0[0], v0[1]); w.y = cvt_pk_bf16(v0[2], v0[3]); w.z = cvt_pk_bf16(v1[0], v1[1]); w.w = cvt_pk_bf16(v1[2], v1[3]);
                    *(u32x4*)(rowp + bj * HALF) = w; } }
    }
};
struct EpiResid {
    static constexpr bool PERM = false;
    const float* xin_lat; const float* xin_ctx; float* out_lat; float* out_ctx; const float* modl; int batched_T;
    DI void operator()(const f32x4 (&acc)[2][2][4][2], const Unit& u, int wr, int wc, int fr, int fq) const {
        int grow0; if (batched_T == 0) grow0 = u.pm * BM; else if (batched_T > 0) grow0 = u.e * 2048 + u.pm * BM; else grow0 = NLAT + u.e * 256 + u.pm * BM;
        const bool lat = grow0 < NLAT; const int jj = lat ? (grow0 >> 11) : 16;
        const float* xi = lat ? xin_lat + (size_t)grow0 * 1024 : xin_ctx + (size_t)(grow0 - NLAT) * 1024;
        float* xo = lat ? out_lat + (size_t)grow0 * 1024 : out_ctx + (size_t)(grow0 - NLAT) * 1024;
        const float* g1 = modl + (size_t)jj * 6144 + 2 * 1024;
        const int r0 = wr * 64 + fr, col0 = u.pn * BM + wc * 32 + 4 * fq;
        f32x4 gv[2][2];
#pragma unroll
        for (int bj = 0; bj < 2; ++bj)
#pragma unroll
            for (int n = 0; n < 2; ++n) gv[bj][n] = *(const f32x4*)(g1 + col0 + bj * HALF + n * 16);
#pragma unroll
        for (int ai = 0; ai < 2; ++ai) {
            f32x4 xv[4][2][2];
#pragma unroll
            for (int m = 0; m < 4; ++m)
#pragma unroll
                for (int bj = 0; bj < 2; ++bj)
#pragma unroll
                    for (int n = 0; n < 2; ++n) xv[m][bj][n] = *(const f32x4*)(xi + (size_t)(r0 + ai * HALF + m * 16) * 1024 + col0 + bj * HALF + n * 16);
#pragma unroll
            for (int m = 0; m < 4; ++m)
#pragma unroll
                for (int bj = 0; bj < 2; ++bj)
#pragma unroll
                    for (int n = 0; n < 2; ++n) *(f32x4*)(xo + (size_t)(r0 + ai * HALF + m * 16) * 1024 + col0 + bj * HALF + n * 16) = xv[m][bj][n] + gv[bj][n] * acc[ai][bj][m][n];
            asm volatile("" ::: "memory");
        }
    }
};
struct EpiResidB {
    static constexpr bool PERM = true;
    const void* xin_lat; const void* xin_ctx; bf16_t* out_lat; bf16_t* out_ctx; const float* modl; int batched_T; int in_f32;
    DI void operator()(const f32x4 (&acc)[2][2][4][2], const Unit& u, int wr, int wc, int fr, int fq) const {
        int grow0; if (batched_T == 0) grow0 = u.pm * BM; else if (batched_T > 0) grow0 = u.e * 2048 + u.pm * BM; else grow0 = NLAT + u.e * 256 + u.pm * BM;
        const bool lat = grow0 < NLAT; const int jj = lat ? (grow0 >> 11) : 16; const size_t rb = lat ? (size_t)grow0 : (size_t)(grow0 - NLAT);
        const float* g1 = modl + (size_t)jj * 6144 + 2 * 1024;
        bf16_t* xo = (lat ? out_lat : out_ctx) + rb * 1024;
        const int r0 = wr * 64 + fr, col0 = u.pn * BM + wc * 32 + 8 * fq;
        f32x4 gv[2][2];
#pragma unroll
        for (int bj = 0; bj < 2; ++bj)
#pragma unroll
            for (int n = 0; n < 2; ++n) gv[bj][n] = *(const f32x4*)(g1 + col0 + bj * HALF + 4 * n);
        if (in_f32) {
            const float* xi = (const float*)(lat ? xin_lat : xin_ctx) + rb * 1024;
#pragma unroll
            for (int ai = 0; ai < 2; ++ai)
#pragma unroll
                for (int mp = 0; mp < 2; ++mp) {
                    f32x4 xv[2][2][2];
#pragma unroll
                    for (int mm_ = 0; mm_ < 2; ++mm_)
#pragma unroll
                        for (int bj = 0; bj < 2; ++bj)
#pragma unroll
                            for (int n = 0; n < 2; ++n) xv[mm_][bj][n] = *(const f32x4*)(xi + (size_t)(r0 + ai * HALF + (2 * mp + mm_) * 16) * 1024 + col0 + bj * HALF + 4 * n);
#pragma unroll
                    for (int mm_ = 0; mm_ < 2; ++mm_)
#pragma unroll
                        for (int bj = 0; bj < 2; ++bj) { const int m = 2 * mp + mm_; const f32x4 o0 = xv[mm_][bj][0] + gv[bj][0] * acc[ai][bj][m][0], o1 = xv[mm_][bj][1] + gv[bj][1] * acc[ai][bj][m][1];
                            u32x4 w; w.x = att_pk(o0[0], o0[1]); w.y = att_pk(o0[2], o0[3]); w.z = att_pk(o1[0], o1[1]); w.w = att_pk(o1[2], o1[3]);
                            *(u32x4*)(xo + (size_t)(r0 + ai * HALF + m * 16) * 1024 + col0 + bj * HALF) = w; }
                    asm volatile("" ::: "memory");
                }
        } else {
            const bf16_t* xi = (const bf16_t*)(lat ? xin_lat : xin_ctx) + rb * 1024;
#pragma unroll
            for (int ai = 0; ai < 2; ++ai) {
                u32x4 xv[4][2];
#pragma unroll
                for (int m = 0; m < 4; ++m)
#pragma unroll
                    for (int bj = 0; bj < 2; ++bj) xv[m][bj] = *(const u32x4*)(xi + (size_t)(r0 + ai * HALF + m * 16) * 1024 + col0 + bj * HALF);
#pragma unroll
                for (int m = 0; m < 4; ++m)
#pragma unroll
                    for (int bj = 0; bj < 2; ++bj) { const u32x4 x = xv[m][bj];
                        const f32x4 x0 = {__uint_as_float(x.x << 16), __uint_as_float(x.x & 0xffff0000u), __uint_as_float(x.y << 16), __uint_as_float(x.y & 0xffff0000u)};
                        const f32x4 x1 = {__uint_as_float(x.z << 16), __uint_as_float(x.z & 0xffff0000u), __uint_as_float(x.w << 16), __uint_as_float(x.w & 0xffff0000u)};
                        const f32x4 o0 = x0 + gv[bj][0] * acc[ai][bj][m][0], o1 = x1 + gv[bj][1] * acc[ai][bj][m][1];
                        u32x4 w; w.x = att_pk(o0[0], o0[1]); w.y = att_pk(o0[2], o0[3]); w.z = att_pk(o1[0], o1[1]); w.w = att_pk(o1[2], o1[3]);
                        *(u32x4*)(xo + (size_t)(r0 + ai * HALF + m * 16) * 1024 + col0 + bj * HALF) = w; }
                asm volatile("" ::: "memory");
            }
        }
    }
};
}

DI void tconv_tile(const Ctx& cx, float* T, const float* src, int ld_src, int k0, int n0, int kvalid, int nvalid, bf16_t* dst, int ldd, int drow0) {
    const int tid = cx.tid;
#pragma unroll
    for (int rr = 0; rr < 2; ++rr) {
        const int i = (tid >> 4) + 32 * rr, j = (tid & 15) * 4;
        float4 v = make_float4(0.f, 0.f, 0.f, 0.f);
        if (k0 + i < kvalid && n0 + j < nvalid) v = *(const float4*)(src + (size_t)(k0 + i) * ld_src + n0 + j);
        T[i * 65 + j] = v.x; T[i * 65 + j + 1] = v.y; T[i * 65 + j + 2] = v.z; T[i * 65 + j + 3] = v.w;
    }
    __syncthreads();
    { const int j = tid >> 3, ch = tid & 7; uint4 o;
      o.x = pack2(T[(ch * 8 + 0) * 65 + j], T[(ch * 8 + 1) * 65 + j]); o.y = pack2(T[(ch * 8 + 2) * 65 + j], T[(ch * 8 + 3) * 65 + j]);
      o.z = pack2(T[(ch * 8 + 4) * 65 + j], T[(ch * 8 + 5) * 65 + j]); o.w = pack2(T[(ch * 8 + 6) * 65 + j], T[(ch * 8 + 7) * 65 + j]);
      *(uint4*)(dst + (size_t)(drow0 + j) * ldd + k0 + ch * 8) = o; }
    __syncthreads();
}
DI void ph_prep_weights(const Ctx& cx, const Params& p, float* lds) {
    const int tid = cx.tid, gtid = cx.bid * NTHR + tid, gsz = cx.nblk * NTHR;
    for (int it = cx.bid; it < 2 * 1008; it += cx.nblk) {
        const int j = it / 1008; int r = it % 1008;
        if (r < 640) { const int kt = r / 40, ntl = r % 40; tconv_tile(cx, lds, p.w_in + (size_t)j * 1024 * INC, INC, kt * 64, ntl * 64, 1024, INC, p.WinT + (size_t)j * 2560 * 1024, 1024, ntl * 64); continue; } r -= 640;
        if (r < 48) { const int kt = r / 12, ntl = r % 12; tconv_tile(cx, lds, p.b_w_q_up + (size_t)j * 256 * 768, 768, kt * 64, ntl * 64, 256, 768, p.WqT + (size_t)j * 768 * 256, 256, ntl * 64); continue; } r -= 48;
        if (r < 64) { const int kt = r / 16, ntl = r % 16; tconv_tile(cx, lds, p.b_w_kv_up + (size_t)j * 128 * 1024, 1024, kt * 64, ntl * 64, 128, 1024, p.WkvT + (size_t)j * 1024 * 256, 256, ntl * 64); continue; } r -= 64;
        { const int kt = r / 16, ntl = r % 16; tconv_tile(cx, lds, p.w_out_even + (size_t)j * 1024 * 1024, 1024, kt * 64, ntl * 64, 1024, 1024, p.WoutT + (size_t)j * 1024 * 1024, 1024, ntl * 64); }
    }
    for (int idx = gtid; idx < 2 * 2560 * 384; idx += gsz) {
        const int j = idx / (2560 * 384), rem = idx % (2560 * 384), n = rem / 384, k = rem % 384; const int seg = n >> 9, nn = n & 511;
        float v = 0.f;
        if (seg < 2) { if ((k >> 6) == seg) v = p.a_w2[((size_t)(j * 2 + seg) * 64 + (k & 63)) * 512 + nn]; }
        else if (seg < 4) { if ((k >> 6) == seg) v = p.a_a2[((size_t)(j * 2 + seg - 2) * 64 + (k & 63)) * 512 + nn]; }
        else { if (k >= 256) v = p.a_g2[((size_t)j * 128 + (k - 256)) * 512 + nn]; }
        p.WlrT[idx] = f2bf(v);
    }
    {
        float* Tc = lds; float* Ts = lds + 64 * 65; float* tab = lds + 2 * 64 * 65;
        for (int i = tid; i < 128; i += NTHR) { tab[i] = cospif((float)i * (1.f / 64.f)); tab[128 + i] = sinpif((float)i * (1.f / 64.f)); }
        __syncthreads();
        for (int it = cx.bid; it < 2 * 256; it += cx.nblk) {
            const int j = it >> 8, ct = (it >> 4) & 15, et = it & 15; const float* Wf = p.w_out_fourier + (size_t)j * 1024 * 1024;
            const int el = tid & 63, e = et * 64 + el;
#pragma unroll 1
            for (int i = 0; i < 8; ++i) {
                const int chl = (tid >> 6) + 8 * i, ch = ct * 64 + chl, grp = ch >> 7, c = ch & 127;
                float sc = 0.f, ss = 0.f;
                for (int g = 0; g < 128; ++g) { const float w = Wf[(size_t)(grp * 128 + g) * 1024 + e]; const int m = (c * g) & 127; sc += tab[m] * w; ss += tab[128 + m] * w; }
                Tc[chl * 65 + el] = sc; Ts[chl * 65 + el] = ss;
            }
            __syncthreads();
            { const int el2 = tid >> 3, chunk = tid & 7; uint4 o, o2; const float* a = Tc + chunk * 8 * 65 + el2; const float* b = Ts + chunk * 8 * 65 + el2;
              o.x = pack2(a[0], a[65]); o.y = pack2(a[2 * 65], a[3 * 65]); o.z = pack2(a[4 * 65], a[5 * 65]); o.w = pack2(a[6 * 65], a[7 * 65]);
              o2.x = pack2(b[0], b[65]); o2.y = pack2(b[2 * 65], b[3 * 65]); o2.z = pack2(b[4 * 65], b[5 * 65]); o2.w = pack2(b[6 * 65], b[7 * 65]);
              bf16_t* d = p.A1 + (size_t)j * 2048 * 1024 + (size_t)(et * 64 + el2) * 1024 + ct * 64 + chunk * 8;
              *(uint4*)d = o; *(uint4*)(d + (size_t)1024 * 1024) = o2; }
            __syncthreads();
        }
    }
    for (int i = gtid; i < 256 * 256; i += gsz) {
        const int m = i >> 8, k = i & 255, f1 = m & 127, t1 = k & 127; const float a = (float)((f1 * t1) & 127) * (1.f / 64.f); const float cs = cospif(a), sn = sinpif(a);
        const float v = (m < 128) ? ((k < 128) ? cs : -sn) : ((k < 128) ? -sn : -cs);
        p.M1[i] = f2bf(v);
    }
    for (int i = gtid; i < 2048 * 4096; i += gsz) {
        const int f = i >> 12, k = i & 4095, t = k & 2047, m = (f * t) & 2047; const float a = (float)m * (1.f / 1024.f);
        p.A2[i] = f2bf(((k < 2048) ? cospif(a) : -sinpif(a)) * (1.f / 512.f));
    }
    for (int i = gtid; i < 256 * 512; i += gsz) {
        const int f = i >> 9, k = i & 511, t = k & 255, m = (f * t) & 255; const float a = (float)m * (1.f / 128.f);
        p.A2c[i] = f2bf(((k < 256) ? cospif(a) : -sinpif(a)) * 0.0055242717280199f);
    }
    __syncthreads();
}
DI void ph_prep_moe(const Ctx& cx, const Params& p, float* lds, int layer) {
    for (int it = cx.bid; it < 17 * 384; it += cx.nblk) {
        const int e = it / 384; int r = it % 384;
        const float* Wg = (e < 16) ? p.moe_w_gate + ((size_t)layer * 16 + e) * 1024 * 512 : p.sh_gate + (size_t)layer * 1024 * 512;
        const float* Wu = (e < 16) ? p.moe_w_up + ((size_t)layer * 16 + e) * 1024 * 512 : p.sh_up + (size_t)layer * 1024 * 512;
        const float* Wd = (e < 16) ? p.moe_w_down + ((size_t)layer * 16 + e) * 512 * 1024 : p.sh_down + (size_t)layer * 512 * 1024;
        if (r < 256) { const int bj = r >> 7, kt = (r >> 3) & 15, ntl = r & 7, n0 = ntl * 64;
            tconv_tile(cx, lds, bj ? Wu : Wg, 512, kt * 64, n0, 1024, 512, p.WguT + (size_t)e * 1024 * 1024, 1024, (n0 >> 7) * 256 + bj * 128 + (n0 & 127)); }
        else { r -= 256; const int kt = r >> 4, ntl = r & 15; tconv_tile(cx, lds, Wd, 1024, kt * 64, ntl * 64, 512, 1024, p.WdT + (size_t)e * 1024 * 512, 512, ntl * 64); }
    }
}

#define GEMM_LDS(lds) ((LAS unsigned char*)(lds))
DI void ph_win_mm(const Ctx& cx, const Params& p, float* lds, int j) {
    mm::StaticSched S; S.init(p.H, p.WinT + (size_t)j * 2560 * 1024, NT, 2560, 1024, 1024, cx.nblk, cx.bid);
    mm::EpiBf16Store E{p.P, PLD};
    mm::gemm_phase(GEMM_LDS(lds), 1024, S, E, cx.tid);
}
DI void ph_wout_mmB(const Ctx& cx, const Params& p, float* lds, const bf16_t* A, const bf16_t* Bt, int nrows, const void* xin_lat, const void* xin_ctx, bf16_t* xo_lat, int in_f32, const float* modl) {
    mm::StaticSched S; S.init(A, Bt, nrows, 1024, 1024, 1024, cx.nblk, cx.bid);
    mm::EpiResidB E{xin_lat, xin_ctx, xo_lat, p.cs, modl, 0, in_f32};
    mm::gemm_phase(GEMM_LDS(lds), 1024, S, E, cx.tid);
}
DI void ph_wout_mm(const Ctx& cx, const Params& p, float* lds, const bf16_t* A, const bf16_t* Bt, int nrows, const float* xin_lat, const float* xin_ctx, const float* modl) {
    mm::StaticSched S; S.init(A, Bt, nrows, 1024, 1024, 1024, cx.nblk, cx.bid);
    mm::EpiResid E{xin_lat, xin_ctx, p.out, p.ctxs, modl, 0};
    mm::gemm_phase(GEMM_LDS(lds), 1024, S, E, cx.tid);
}

DI void ph_qkvup_mm(const Ctx& cx, const Params& p, float* lds, int j, int mq) {
    { mm::StaticSched S; S.init(p.QN, p.WqT + (size_t)j * 768 * 256, mq, 768, 256, 512, cx.nblk, cx.bid); mm::EpiBf16Store E{p.Qraw, 768}; mm::gemm_phase(GEMM_LDS(lds), 256, S, E, cx.tid); }
    { mm::StaticSched S; S.init(p.QN + 256, p.WkvT + (size_t)j * 1024 * 256, NT, 1024, 256, 512, cx.nblk, cx.bid); mm::EpiBf16Store E{p.KVraw, 1024}; mm::gemm_phase(GEMM_LDS(lds), 256, S, E, cx.tid); }
}
struct EpiWag {
    static constexpr bool PERM = true;
    bf16_t* O; const LAS float* bias;
    DI void operator()(const mm::f32x4 (&acc)[2][2][4][2], const mm::Unit& u, int wr, int wc, int fr, int fq) const {
        const int row0 = u.pm * 256 + wr * 64 + fr, col0 = u.pn * 256 + wc * 32 + 8 * fq; const int seg = u.pn >> 2;
        const LAS float* bp = bias + col0;
#pragma unroll
        for (int bj = 0; bj < 2; ++bj) {
            mm::f32x4 b0 = (mm::f32x4){0.f, 0.f, 0.f, 0.f}, b1 = b0;
            if (seg < 2) { b0 = *(const LAS mm::f32x4*)(bp + bj * 128); b1 = *(const LAS mm::f32x4*)(bp + bj * 128 + 4); }
#pragma unroll
            for (int ai = 0; ai < 2; ++ai)
#pragma unroll
                for (int m = 0; m < 4; ++m) {
                    mm::f32x4 v0 = acc[ai][bj][m][0] + b0, v1 = acc[ai][bj][m][1] + b1;
                    if (seg == 0) {
#pragma unroll
                        for (int c = 0; c < 4; ++c) { v0[c] = 1.f - __expf(-0.606531f * __builtin_amdgcn_rcpf(1.f + __expf(-v0[c]))); v1[c] = 1.f - __expf(-0.606531f * __builtin_amdgcn_rcpf(1.f + __expf(-v1[c]))); }
                    } else if (seg == 1) {
#pragma unroll
                        for (int c = 0; c < 4; ++c) { v0[c] = __builtin_amdgcn_rcpf(1.f + __expf(-v0[c])); v1[c] = __builtin_amdgcn_rcpf(1.f + __expf(-v1[c])); }
                    }
                    mm::u32x4 w; w.x = mm::cvt_pk_bf16(v0[0], v0[1]); w.y = mm::cvt_pk_bf16(v0[2], v0[3]); w.z = mm::cvt_pk_bf16(v1[0], v1[1]); w.w = mm::cvt_pk_bf16(v1[2], v1[3]);
                    *(mm::u32x4*)(O + (size_t)(row0 + ai * 128 + m * 16) * WLD + col0 + bj * 128) = w;
                }
        }
    }
};
DI void ph_wag_mm(const Ctx& cx, const Params& p, float* lds, int j) {
    mm::StaticSched S; S.init(p.LR, p.WlrT + (size_t)j * 2560 * 384, NT, 2560, 384, 384, cx.nblk, cx.bid);
    LAS float* bl = (LAS float*)lds + 32768 + 256 + 1024;
    for (int i = cx.tid; i < 2048; i += NTHR) bl[i] = (i < 1024) ? p.a_w0[j * 1024 + i] : p.a_a0[j * 1024 + i - 1024];
    __syncthreads();
    EpiWag E{p.WAG, bl};
    mm::gemm_phase(GEMM_LDS(lds), 384, S, E, cx.tid);
}
struct EpiZT {
    static constexpr bool PERM = true;
    bf16_t* Z; int T;
    DI void operator()(const mm::f32x4 (&acc)[2][2][4][2], const mm::Unit& u, int wr, int wc, int fr, int fq) const {
        const int b = (T == 2048) ? (u.pn >> 3) : u.pn, t0 = (T == 2048) ? ((u.pn & 7) * 256) : 0;
        const int m0 = u.pm * 256 + wr * 64 + fr; const int c0 = t0 + wc * 32 + 8 * fq;
#pragma unroll
        for (int ai = 0; ai < 2; ++ai)
#pragma unroll
            for (int m = 0; m < 4; ++m) { const int mr = m0 + ai * 128 + m * 16, part = mr >> 10, ch = mr & 1023;
                bf16_t* rowp = Z + ((size_t)(b * 1024 + ch) * 2 + part) * T + c0;
#pragma unroll
                for (int bj = 0; bj < 2; ++bj) { const mm::f32x4 v0 = acc[ai][bj][m][0], v1 = acc[ai][bj][m][1];
                    mm::u32x4 w; w.x = mm::cvt_pk_bf16(v0[0], v0[1]); w.y = mm::cvt_pk_bf16(v0[2], v0[3]); w.z = mm::cvt_pk_bf16(v1[0], v1[1]); w.w = mm::cvt_pk_bf16(v1[2], v1[3]);
                    *(mm::u32x4*)(rowp + bj * 128) = w; } }
    }
};
DI void ph_f1_mm(const Ctx& cx, const Params& p, float* lds, int j, bool with_ctx) {
    { mm::StaticSched S; S.init(p.A1 + (size_t)j * 2048 * 1024, p.H, 2048, NLAT, 1024, 1024, cx.nblk, cx.bid); EpiZT E{p.ZT, 2048}; mm::gemm_phase(GEMM_LDS(lds), 1024, S, E, cx.tid); }
    if (with_ctx) { mm::StaticSched S; S.init(p.A1 + (size_t)j * 2048 * 1024, p.H + (size_t)NLAT * 1024, 2048, NCTX, 1024, 1024, cx.nblk, cx.bid); EpiZT E{p.ZTC, 256}; mm::gemm_phase(GEMM_LDS(lds), 1024, S, E, cx.tid); }
}
DI void ph_f2_mmB(const Ctx& cx, const Params& p, float* lds, bool with_ctx, const void* xin_lat, const void* xin_ctx, bf16_t* xo_lat, const float* modl) {
    { mm::BatchSched S; S.init(p.A2, p.ZT, (size_t)1024 * 4096 * 2, 16, 2048, 1024, 4096, cx.nblk, cx.bid); mm::EpiResidB E{xin_lat, xin_ctx, xo_lat, p.cs, modl, 1, 0}; mm::gemm_phase(GEMM_LDS(lds), 4096, S, E, cx.tid); }
    if (with_ctx) { mm::BatchSched S; S.init(p.A2c, p.ZTC, (size_t)1024 * 512 * 2, 16, 256, 1024, 512, cx.nblk, cx.bid); mm::EpiResidB E{xin_lat, xin_ctx, xo_lat, p.cs, modl, -1, 0}; mm::gemm_phase(GEMM_LDS(lds), 512, S, E, cx.tid); }
}
DI void ph_f2_mm(const Ctx& cx, const Params& p, float* lds, bool with_ctx, const float* xin_lat, const float* xin_ctx, const float* modl) {
    { mm::BatchSched S; S.init(p.A2, p.ZT, (size_t)1024 * 4096 * 2, 16, 2048, 1024, 4096, cx.nblk, cx.bid); mm::EpiResid E{xin_lat, xin_ctx, p.out, p.ctxs, modl, 1}; mm::gemm_phase(GEMM_LDS(lds), 4096, S, E, cx.tid); }
    if (with_ctx) { mm::BatchSched S; S.init(p.A2c, p.ZTC, (size_t)1024 * 512 * 2, 16, 256, 1024, 512, cx.nblk, cx.bid); mm::EpiResid E{xin_lat, xin_ctx, p.out, p.ctxs, modl, -1}; mm::gemm_phase(GEMM_LDS(lds), 512, S, E, cx.tid); }
}
struct MoeSched {
    static constexpr bool GATHER = true, TABLE = true;
    const char* A; const char* Bt; const int* slot; const float* slotw; const int* tab; int lda, K, G, c, down;
    DI void tab_dma(const mm::Unit& u, LAS unsigned char* dst, int tid) const {
        const int Me = __builtin_amdgcn_readfirstlane(tab[32 + u.e]); const int r = tid & 255; int idx = u.m * 256 + r; idx = idx < Me ? idx : 0;
        const size_t off = (u.e < 16) ? (size_t)u.e * NT + idx : 0;
        const unsigned* src = (tid < 256) ? (const unsigned*)(slot + off) : (const unsigned*)(slotw + off);
        __builtin_amdgcn_global_load_lds(src, (LAS unsigned*)(dst + (tid >> 6) * 256), 4, 0, 0);
    }
    DI size_t hstep_a() const { return 0; }
    DI unsigned boff(int Rb, int C, int Kk) const { return (unsigned)(Rb * Kk + C) * 2u; }
    DI size_t hstep_b(int Kk) const { return (size_t)mm::HALF * Kk * 2; }
    DI bool next(int i, mm::Unit& u) const {
        const int L = i * G + c; const int total = __builtin_amdgcn_readfirstlane(tab[17]);
        if (L >= total * 4) return false;
        const int rtg = L >> 2; int e = 0;
        for (int q = 1; q < 17; ++q) e += (__builtin_amdgcn_readfirstlane(tab[q]) <= rtg) ? 1 : 0;
        u.e = e; u.m = rtg - __builtin_amdgcn_readfirstlane(tab[e]); u.pm = u.m; u.pn = L & 3;
        u.A = A; u.B = Bt + ((size_t)e * 1024 + (size_t)u.pn * 256) * K * 2; return true;
    }
    DI unsigned rowoff(const mm::Unit& u, int Me, int idx, int C) const {
        int row;
        if (u.e < 16) { const int s = (idx < Me) ? slot[(size_t)u.e * NT + idx] : 0; row = down ? ((s & 1) * NT + (s >> 1)) : (s >> 1); }
        else row = down ? (2 * NT + idx) : idx;
        return (unsigned)(row * lda + C) * 2u;
    }
    DI unsigned rowoff_s(const mm::Unit& u, int s, int r, int C) const { int row; if (u.e < 16) row = down ? ((s & 1) * NT + (s >> 1)) : (s >> 1); else row = down ? (2 * NT + u.m * 256 + r) : (u.m * 256 + r); return (unsigned)(row * lda + C) * 2u; }
    DI void aoff_lds(const mm::Unit& u, const LAS int* et, int R0, int C0, int R1, int C1, unsigned (&o)[2][2]) const {
        o[0][0] = rowoff_s(u, et[R0], R0, C0); o[0][1] = rowoff_s(u, et[R1], R1, C1); o[1][0] = rowoff_s(u, et[128 + R0], 128 + R0, C0); o[1][1] = rowoff_s(u, et[128 + R1], 128 + R1, C1);
    }
    DI void aoff(const mm::Unit& u, int R0, int C0, int R1, int C1, unsigned (&o)[2][2]) const {
        const int Me = __builtin_amdgcn_readfirstlane(tab[32 + u.e]), base = u.m * 256;
        o[0][0] = rowoff(u, Me, base + R0, C0); o[0][1] = rowoff(u, Me, base + R1, C1);
        o[1][0] = rowoff(u, Me, base + 128 + R0, C0); o[1][1] = rowoff(u, Me, base + 128 + R1, C1);
    }
};
DI void moe_table(const Ctx& cx, const Params& p, int* tab, int layer, int nrows) {
    if (cx.tid == 0) { int acc = 0;
        for (int e = 0; e < 17; ++e) { const int M = (e < 16) ? p.cnt[(layer * 16 + e) * 64] : nrows; tab[e] = acc; tab[32 + e] = M; acc += (M + 255) >> 8; }
        tab[17] = acc; }
    __syncthreads();
}
DI void lds_read8(const LAS int* base, int r0, int (&o)[8]) {
    const unsigned a = (unsigned)(size_t)(base + r0);
    asm volatile("ds_read_b32 %0, %8\n\tds_read_b32 %1, %8 offset:64\n\tds_read_b32 %2, %8 offset:128\n\tds_read_b32 %3, %8 offset:192\n\t"
                 "ds_read_b32 %4, %8 offset:512\n\tds_read_b32 %5, %8 offset:576\n\tds_read_b32 %6, %8 offset:640\n\tds_read_b32 %7, %8 offset:704\n\ts_waitcnt lgkmcnt(0)"
                 : "=&v"(o[0]), "=&v"(o[1]), "=&v"(o[2]), "=&v"(o[3]), "=&v"(o[4]), "=&v"(o[5]), "=&v"(o[6]), "=&v"(o[7]) : "v"(a) : "memory");
}
struct EpiSwiglu {
    static constexpr bool PERM = true;
    bf16_t* ACT; const int* slot; const int* tab; const LAS int* etab;
    DI void operator()(const mm::f32x4 (&acc)[2][2][4][2], const mm::Unit& u, int wr, int wc, int fr, int fq) const {
        const int Me = __builtin_amdgcn_readfirstlane(tab[32 + u.e]); const int col = u.pn * 128 + wc * 32 + 8 * fq; const LAS int* et = etab + u.tb * 512;
        int sl8[8]; lds_read8(et, wr * 64 + fr, sl8);
#pragma unroll
        for (int ai = 0; ai < 2; ++ai)
#pragma unroll
            for (int m = 0; m < 4; ++m) {
                const int idx = u.m * 256 + ai * 128 + wr * 64 + m * 16 + fr;
                if (idx < Me) {
                    int drow; if (u.e < 16) { const int s = sl8[ai * 4 + m]; drow = (s & 1) * NT + (s >> 1); } else drow = 2 * NT + idx;
                    float o[8];
#pragma unroll
                    for (int n = 0; n < 2; ++n)
#pragma unroll
                        for (int c = 0; c < 4; ++c) { const float g = acc[ai][0][m][n][c], uu = acc[ai][1][m][n][c]; o[n * 4 + c] = g * __builtin_amdgcn_rcpf(1.f + __expf(-g)) * uu; }
                    mm::u32x4 w; w.x = mm::cvt_pk_bf16(o[0], o[1]); w.y = mm::cvt_pk_bf16(o[2], o[3]); w.z = mm::cvt_pk_bf16(o[4], o[5]); w.w = mm::cvt_pk_bf16(o[6], o[7]);
                    *(mm::u32x4*)(ACT + (size_t)drow * 512 + col) = w;
                }
            }
    }
};
struct EpiDown {
    static constexpr bool PERM = true;
    bf16_t* Y; const int* slot; const float* tokw; const int* tab; const LAS int* etab;
    DI void operator()(const mm::f32x4 (&acc)[2][2][4][2], const mm::Unit& u, int wr, int wc, int fr, int fq) const {
        const int Me = __builtin_amdgcn_readfirstlane(tab[32 + u.e]); const int col = u.pn * 256 + wc * 32 + 8 * fq; const LAS int* et = etab + u.tb * 512;
        int sl8[8], sw8[8]; lds_read8(et, wr * 64 + fr, sl8); lds_read8(et + 256, wr * 64 + fr, sw8);
#pragma unroll
        for (int ai = 0; ai < 2; ++ai)
#pragma unroll
            for (int m = 0; m < 4; ++m) {
                const int idx = u.m * 256 + ai * 128 + wr * 64 + m * 16 + fr;
                if (idx < Me) {
                    int drow; float w = 1.f;
                    if (u.e < 16) { const int s = sl8[ai * 4 + m]; drow = (s & 1) * NT + (s >> 1); w = __int_as_float(sw8[ai * 4 + m]); } else drow = 2 * NT + idx;
#pragma unroll
                    for (int bj = 0; bj < 2; ++bj) { const mm::f32x4 v0 = acc[ai][bj][m][0] * w, v1 = acc[ai][bj][m][1] * w;
                        mm::u32x4 o; o.x = mm::cvt_pk_bf16(v0[0], v0[1]); o.y = mm::cvt_pk_bf16(v0[2], v0[3]); o.z = mm::cvt_pk_bf16(v1[0], v1[1]); o.w = mm::cvt_pk_bf16(v1[2], v1[3]);
                        *(mm::u32x4*)(Y + (size_t)drow * 1024 + col + bj * 128) = o; }
                }
            }
    }
};
DI void ph_moe_up_mm(const Ctx& cx, const Params& p, float* lds, int layer, int nrows) {
    int* tab = (int*)(lds + 32768); moe_table(cx, p, tab, layer, nrows);
    MoeSched S{(const char*)p.H, (const char*)p.WguT, p.slot, p.slotw, tab, 1024, 1024, cx.nblk, cx.bid, 0};
    EpiSwiglu E{p.ACT, p.slot, tab, (const LAS int*)((LAS float*)lds + 32768 + 256)};
    mm::gemm_phase(GEMM_LDS(lds), 1024, S, E, cx.tid);
}
DI void ph_moe_down_mm(const Ctx& cx, const Params& p, float* lds, int layer, int nrows) {
    int* tab = (int*)(lds + 32768); moe_table(cx, p, tab, layer, nrows);
    MoeSched S{(const char*)p.ACT, (const char*)p.WdT, p.slot, p.slotw, tab, 512, 512, cx.nblk, cx.bid, 1};
    EpiDown E{p.Y, p.slot, p.tokw, tab, (const LAS int*)((LAS float*)lds + 32768 + 256)};
    mm::gemm_phase(GEMM_LDS(lds), 512, S, E, cx.tid);
}

namespace att {
typedef short bf16x8 __attribute__((ext_vector_type(8)));
typedef float f32x16 __attribute__((ext_vector_type(16)));
typedef unsigned u32x4 __attribute__((ext_vector_type(4)));
typedef unsigned u32x2 __attribute__((ext_vector_type(2)));
typedef __bf16 bf16x2_t __attribute__((ext_vector_type(2)));
typedef float f32x2_t __attribute__((ext_vector_type(2)));
constexpr int KP = 208, VP = 264, KT_BYTES = 128 * KP, VT_BYTES = 64 * VP, BUF = KT_BYTES + VT_BYTES;
DI unsigned pk(float a, float b) { f32x2_t f = {a, b}; bf16x2_t h = __builtin_convertvector(f, bf16x2_t); return __builtin_bit_cast(unsigned, h); }
DI float xhalf_max(float x) { const auto r = __builtin_amdgcn_permlane32_swap(__builtin_bit_cast(unsigned, x), __builtin_bit_cast(unsigned, x), false, false); return fmaxf(__builtin_bit_cast(float, r[0]), __builtin_bit_cast(float, r[1])); }
DI float xhalf_sum(float x) { const auto r = __builtin_amdgcn_permlane32_swap(__builtin_bit_cast(unsigned, x), __builtin_bit_cast(unsigned, x), false, false); return __builtin_bit_cast(float, r[0]) + __builtin_bit_cast(float, r[1]); }
#define ATT_MFMA(a, b, c) __builtin_amdgcn_mfma_f32_32x32x16_bf16((a), (b), (c), 0, 0, 0)
}
DI void ph_attn_mm(const Ctx& cx, const Params& p, float* ldsf, bool with_ctx) {
    using namespace att;
    LAS unsigned char* lds = (LAS unsigned char*)ldsf;
    const int tid = cx.tid, wid = __builtin_amdgcn_readfirstlane(tid >> 6), lane = tid & 63, r = lane & 31, hh = lane >> 5;
    const int nunits = 1024 + (with_ctx ? 128 : 0);
    int kg[3], kl[3], vg[2], vl[2];
#pragma unroll
    for (int i = 0; i < 3; ++i) { const int c = tid + 512 * i, row = c / 12, part = c % 12; kg[i] = row * 96 + part * 8; kl[i] = row * KP + part * 16; }
#pragma unroll
    for (int i = 0; i < 2; ++i) { const int c = tid + 512 * i, row = c >> 4, part = c & 15; vg[i] = row * 2304 + part * 8; vl[i] = KT_BYTES + row * VP + part * 16; }
    for (int u = cx.bid; u < nunits; u += cx.nblk) {
        int bh, qrow0, nkeys;
        if (u < 1024) { bh = u >> 3; qrow0 = (bh >> 3) * 2048 + (u & 7) * 256; nkeys = 2304; }
        else { bh = u - 1024; qrow0 = NLAT + (bh >> 3) * 256; nkeys = 256; }
        const int h = bh & 7;
        const bf16_t* Kb = p.Kf + (size_t)bh * 2304 * 96; const bf16_t* Vb = p.Vt + (size_t)bh * 64 * 2304;
        const bf16_t* qp = p.Qraw + (size_t)(qrow0 + wid * 32 + r) * 768 + h * 96 + 8 * hh;
        bf16x8 qf[6];
#pragma unroll
        for (int s = 0; s < 6; ++s) qf[s] = *(const bf16x8*)(qp + 16 * s);
        f32x16 ot0, ot1;
#pragma unroll
        for (int i = 0; i < 16; ++i) { ot0[i] = 0.f; ot1[i] = 0.f; }
        float mrun = -3.0e38f, lrun = 0.f;
        const int ntiles = nkeys >> 7;
        u32x4 kr[3], vr[2];
#pragma unroll
        for (int i = 0; i < 3; ++i) kr[i] = *(const u32x4*)(Kb + kg[i]);
#pragma unroll
        for (int i = 0; i < 2; ++i) vr[i] = *(const u32x4*)(Vb + vg[i]);
#pragma unroll
        for (int i = 0; i < 3; ++i) *(LAS u32x4*)(lds + kl[i]) = kr[i];
#pragma unroll
        for (int i = 0; i < 2; ++i) { *(LAS u32x2*)(lds + vl[i]) = (u32x2){vr[i].x, vr[i].y}; *(LAS u32x2*)(lds + vl[i] + 8) = (u32x2){vr[i].z, vr[i].w}; }
        __syncthreads();
        for (int it = 0; it < ntiles; ++it) {
            const int bo = (it & 1) * BUF, bn = ((it + 1) & 1) * BUF;
            const bool more = (it + 1 < ntiles);
            if (more) {
                const bf16_t* Kn = Kb + (size_t)(it + 1) * 128 * 96; const bf16_t* Vn = Vb + (it + 1) * 128;
#pragma unroll
                for (int i = 0; i < 3; ++i) kr[i] = *(const u32x4*)(Kn + kg[i]);
#pragma unroll
                for (int i = 0; i < 2; ++i) vr[i] = *(const u32x4*)(Vn + vg[i]);
            }
            f32x16 st[4];
#pragma unroll
            for (int kb = 0; kb < 4; ++kb) {
#pragma unroll
                for (int i = 0; i < 16; ++i) st[kb][i] = 0.f;
#pragma unroll
                for (int s = 0; s < 6; ++s) { const bf16x8 kf = *(const LAS bf16x8*)(lds + bo + (kb * 32 + r) * KP + 32 * s + 16 * hh); st[kb] = ATT_MFMA(kf, qf[s], st[kb]); }
            }
            float mq[4];
#pragma unroll
            for (int kb = 0; kb < 4; ++kb) { float a = fmaxf(st[kb][0], st[kb][1]), b = fmaxf(st[kb][2], st[kb][3]), c2 = fmaxf(st[kb][4], st[kb][5]), d = fmaxf(st[kb][6], st[kb][7]);
                a = fmaxf(a, fmaxf(st[kb][8], st[kb][9])); b = fmaxf(b, fmaxf(st[kb][10], st[kb][11])); c2 = fmaxf(c2, fmaxf(st[kb][12], st[kb][13])); d = fmaxf(d, fmaxf(st[kb][14], st[kb][15]));
                mq[kb] = fmaxf(fmaxf(a, b), fmaxf(c2, d)); }
            float mt = fmaxf(fmaxf(mq[0], mq[1]), fmaxf(mq[2], mq[3]));
            mt = xhalf_max(mt);
            const float mnew = fmaxf(mrun, mt), alpha = __builtin_amdgcn_exp2f(mrun - mnew);
            mrun = mnew;
            float pq[4];
#pragma unroll
            for (int kb = 0; kb < 4; ++kb) { float a = 0.f, b = 0.f;
#pragma unroll
                for (int i = 0; i < 16; i += 2) { st[kb][i] = __builtin_amdgcn_exp2f(st[kb][i] - mnew); st[kb][i + 1] = __builtin_amdgcn_exp2f(st[kb][i + 1] - mnew); a += st[kb][i]; b += st[kb][i + 1]; }
                pq[kb] = a + b; }
            lrun = lrun * alpha + ((pq[0] + pq[1]) + (pq[2] + pq[3]));
#pragma unroll
            for (int i = 0; i < 16; ++i) { ot0[i] *= alpha; ot1[i] *= alpha; }
#pragma unroll
            for (int kb = 0; kb < 4; ++kb)
#pragma unroll
                for (int s = 0; s < 2; ++s) {
                    u32x4 pw; pw.x = pk(st[kb][8 * s], st[kb][8 * s + 1]); pw.y = pk(st[kb][8 * s + 2], st[kb][8 * s + 3]); pw.z = pk(st[kb][8 * s + 4], st[kb][8 * s + 5]); pw.w = pk(st[kb][8 * s + 6], st[kb][8 * s + 7]);
                    const bf16x8 pb = __builtin_bit_cast(bf16x8, pw);
                    const int col = (kb * 32 + 16 * s + 4 * hh) * 2;
                    const u32x2 a0 = *(const LAS u32x2*)(lds + bo + KT_BYTES + r * VP + col), a1 = *(const LAS u32x2*)(lds + bo + KT_BYTES + r * VP + col + 16);
                    const u32x2 b0 = *(const LAS u32x2*)(lds + bo + KT_BYTES + (32 + r) * VP + col), b1 = *(const LAS u32x2*)(lds + bo + KT_BYTES + (32 + r) * VP + col + 16);
                    const u32x4 va = {a0.x, a0.y, a1.x, a1.y}, vb = {b0.x, b0.y, b1.x, b1.y};
                    ot0 = ATT_MFMA(__builtin_bit_cast(bf16x8, va), pb, ot0);
                    ot1 = ATT_MFMA(__builtin_bit_cast(bf16x8, vb), pb, ot1);
                }
            if (more) {
#pragma unroll
                for (int i = 0; i < 3; ++i) *(LAS u32x4*)(lds + bn + kl[i]) = kr[i];
#pragma unroll
                for (int i = 0; i < 2; ++i) { *(LAS u32x2*)(lds + bn + vl[i]) = (u32x2){vr[i].x, vr[i].y}; *(LAS u32x2*)(lds + bn + vl[i] + 8) = (u32x2){vr[i].z, vr[i].w}; }
            }
            __syncthreads();
        }
        const float il = 1.f / xhalf_sum(lrun);
        bf16_t* op = p.H + (size_t)(qrow0 + wid * 32 + r) * 1024 + 512 + h * 64 + 4 * hh;
#pragma unroll
        for (int g = 0; g < 4; ++g) {
            u32x2 w0 = {pk(ot0[4 * g] * il, ot0[4 * g + 1] * il), pk(ot0[4 * g + 2] * il, ot0[4 * g + 3] * il)};
            u32x2 w1 = {pk(ot1[4 * g] * il, ot1[4 * g + 1] * il), pk(ot1[4 * g + 2] * il, ot1[4 * g + 3] * il)};
            *(u32x2*)(op + 8 * g) = w0; *(u32x2*)(op + 32 + 8 * g) = w1;
        }
    }
}

DI void ph_attn_mm_stag(const Ctx& cx, const Params& p, float* ldsf, bool with_ctx) {
    using namespace att;
    LAS unsigned char* lds = (LAS unsigned char*)ldsf;
    const int tid = cx.tid, wid = __builtin_amdgcn_readfirstlane(tid >> 6), lane = tid & 63, r = lane & 31, hh = lane >> 5, G = wid >> 2;
    const int nunits = 1024 + (with_ctx ? 128 : 0);
    int kg[3], kl[3], vg[2], vl[2];
#pragma unroll
    for (int i = 0; i < 3; ++i) { const int c = tid + 512 * i, row = c / 12, part = c % 12; kg[i] = row * 96 + part * 8; kl[i] = row * KP + part * 16; }
#pragma unroll
    for (int i = 0; i < 2; ++i) { const int c = tid + 512 * i, row = c >> 4, part = c & 15; vg[i] = row * 2304 + part * 8; vl[i] = KT_BYTES + row * VP + part * 16; }
    for (int u = cx.bid; u < nunits; u += cx.nblk) {
        int bh, qrow0, nkeys;
        if (u < 1024) { bh = u >> 3; qrow0 = (bh >> 3) * 2048 + (u & 7) * 256; nkeys = 2304; }
        else { bh = u - 1024; qrow0 = NLAT + (bh >> 3) * 256; nkeys = 256; }
        const int h = bh & 7;
        const bf16_t* Kb = p.Kf + (size_t)bh * 2304 * 96; const bf16_t* Vb = p.Vt + (size_t)bh * 64 * 2304;
        const bf16_t* qp = p.Qraw + (size_t)(qrow0 + wid * 32 + r) * 768 + h * 96 + 8 * hh;
        bf16x8 qf[6];
#pragma unroll
        for (int s = 0; s < 6; ++s) qf[s] = *(const bf16x8*)(qp + 16 * s);
        f32x16 ot0, ot1;
#pragma unroll
        for (int i = 0; i < 16; ++i) { ot0[i] = 0.f; ot1[i] = 0.f; }
        float mrun = -3.0e38f, lrun = 0.f;
        const int ntiles = nkeys >> 7;
        u32x4 kr[3], vr[2];
#define ATT_LOAD(t) do { const bf16_t* Kn = Kb + (size_t)(t) * 128 * 96; const bf16_t* Vn = Vb + (t) * 128; \
            _Pragma("unroll") for (int i = 0; i < 3; ++i) kr[i] = *(const u32x4*)(Kn + kg[i]); _Pragma("unroll") for (int i = 0; i < 2; ++i) vr[i] = *(const u32x4*)(Vn + vg[i]); } while (0)
#define ATT_WRITE(bufo) do { _Pragma("unroll") for (int i = 0; i < 3; ++i) *(LAS u32x4*)(lds + (bufo) + kl[i]) = kr[i]; \
            _Pragma("unroll") for (int i = 0; i < 2; ++i) { *(LAS u32x2*)(lds + (bufo) + vl[i]) = (u32x2){vr[i].x, vr[i].y}; *(LAS u32x2*)(lds + (bufo) + vl[i] + 8) = (u32x2){vr[i].z, vr[i].w}; } } while (0)
        ATT_LOAD(0); ATT_WRITE(0);
        ATT_LOAD(1); ATT_WRITE(BUF);
        __syncthreads();
        f32x16 st[4];
        for (int ph = 0; ph <= 2 * ntiles; ++ph) {
            if (ph & 1) {
                const int tw = (ph + 1) >> 1;
                if (tw >= 2 && tw < ntiles) ATT_WRITE((tw & 1) * BUF);
                if (tw + 1 < ntiles) ATT_LOAD(tw + 1);
            }
            const int e = ph - G;
            if (e >= 0 && e < 2 * ntiles) {
                const int bo = ((e >> 1) & 1) * BUF;
                if ((e & 1) == 0) {
#pragma unroll
                    for (int kb = 0; kb < 4; ++kb) {
#pragma unroll
                        for (int i = 0; i < 16; ++i) st[kb][i] = 0.f;
#pragma unroll
                        for (int s = 0; s < 6; ++s) { const bf16x8 kf = *(const LAS bf16x8*)(lds + bo + (kb * 32 + r) * KP + 32 * s + 16 * hh); st[kb] = ATT_MFMA(kf, qf[s], st[kb]); }
                    }
                    float mq[4];
#pragma unroll
                    for (int kb = 0; kb < 4; ++kb) { float a = fmaxf(st[kb][0], st[kb][1]), b = fmaxf(st[kb][2], st[kb][3]), c2 = fmaxf(st[kb][4], st[kb][5]), d = fmaxf(st[kb][6], st[kb][7]);
                        a = fmaxf(a, fmaxf(st[kb][8], st[kb][9])); b = fmaxf(b, fmaxf(st[kb][10], st[kb][11])); c2 = fmaxf(c2, fmaxf(st[kb][12], st[kb][13])); d = fmaxf(d, fmaxf(st[kb][14], st[kb][15]));
                        mq[kb] = fmaxf(fmaxf(a, b), fmaxf(c2, d)); }
                    float mt = fmaxf(fmaxf(mq[0], mq[1]), fmaxf(mq[2], mq[3]));
                    mt = xhalf_max(mt);
                    const float mnew = fmaxf(mrun, mt), alpha = __builtin_amdgcn_exp2f(mrun - mnew);
                    mrun = mnew;
                    float pq[4];
#pragma unroll
                    for (int kb = 0; kb < 4; ++kb) { float a = 0.f, b = 0.f;
#pragma unroll
                        for (int i = 0; i < 16; i += 2) { st[kb][i] = __builtin_amdgcn_exp2f(st[kb][i] - mnew); st[kb][i + 1] = __builtin_amdgcn_exp2f(st[kb][i + 1] - mnew); a += st[kb][i]; b += st[kb][i + 1]; }
                        pq[kb] = a + b; }
                    lrun = lrun * alpha + ((pq[0] + pq[1]) + (pq[2] + pq[3]));
#pragma unroll
                    for (int i = 0; i < 16; ++i) { ot0[i] *= alpha; ot1[i] *= alpha; }
                } else {
#pragma unroll
                    for (int kb = 0; kb < 4; ++kb)
#pragma unroll
                        for (int s = 0; s < 2; ++s) {
                            u32x4 pw; pw.x = pk(st[kb][8 * s], st[kb][8 * s + 1]); pw.y = pk(st[kb][8 * s + 2], st[kb][8 * s + 3]); pw.z = pk(st[kb][8 * s + 4], st[kb][8 * s + 5]); pw.w = pk(st[kb][8 * s + 6], st[kb][8 * s + 7]);
                            const bf16x8 pb = __builtin_bit_cast(bf16x8, pw);
                            const int col = (kb * 32 + 16 * s + 4 * hh) * 2;
                            const u32x2 a0 = *(const LAS u32x2*)(lds + bo + KT_BYTES + r * VP + col), a1 = *(const LAS u32x2*)(lds + bo + KT_BYTES + r * VP + col + 16);
                            const u32x2 b0 = *(const LAS u32x2*)(lds + bo + KT_BYTES + (32 + r) * VP + col), b1 = *(const LAS u32x2*)(lds + bo + KT_BYTES + (32 + r) * VP + col + 16);
                            const u32x4 va = {a0.x, a0.y, a1.x, a1.y}, vb = {b0.x, b0.y, b1.x, b1.y};
                            ot0 = ATT_MFMA(__builtin_bit_cast(bf16x8, va), pb, ot0);
                            ot1 = ATT_MFMA(__builtin_bit_cast(bf16x8, vb), pb, ot1);
                        }
                }
            }
            __syncthreads();
        }
#undef ATT_LOAD
#undef ATT_WRITE
        const float il = 1.f / xhalf_sum(lrun);
        bf16_t* op = p.H + (size_t)(qrow0 + wid * 32 + r) * 1024 + 512 + h * 64 + 4 * hh;
#pragma unroll
        for (int g = 0; g < 4; ++g) {
            u32x2 w0 = {pk(ot0[4 * g] * il, ot0[4 * g + 1] * il), pk(ot0[4 * g + 2] * il, ot0[4 * g + 3] * il)};
            u32x2 w1 = {pk(ot1[4 * g] * il, ot1[4 * g + 1] * il), pk(ot1[4 * g + 2] * il, ot1[4 * g + 3] * il)};
            *(u32x2*)(op + 8 * g) = w0; *(u32x2*)(op + 32 + 8 * g) = w1;
        }
    }
}

namespace scan {
typedef float f32x2 __attribute__((ext_vector_type(2)));
constexpr int REC = 400, CH = 32, BUFF = CH * REC, YOFF = 2 * BUFF;
DI float dppf(float v, int ctrl_sel) {
    const int x = __builtin_bit_cast(int, v);
    int r;
    if (ctrl_sel == 0) r = __builtin_amdgcn_update_dpp(0, x, 0xB1, 0xf, 0xf, true);
    else if (ctrl_sel == 1) r = __builtin_amdgcn_update_dpp(0, x, 0x4E, 0xf, 0xf, true);
    else r = __builtin_amdgcn_update_dpp(0, x, 0x141, 0xf, 0xf, true);
    return __builtin_bit_cast(float, r);
}
DI float red8(float v) { v += dppf(v, 0); v += dppf(v, 1); v += dppf(v, 2); return v; }
}
template <int ABL>
DI void ph_scan_opt(const Ctx& cx, const Params& p, float* lds, int j) {
    using namespace scan;
    const int tid = cx.tid, wid = __builtin_amdgcn_readfirstlane(tid >> 6), lane = tid & 63;
    for (int item = cx.bid; item < 256; item += cx.nblk) {
        const int b = item >> 4, h = (item >> 1) & 7, dir = item & 1;
        bf16_t* yout = dir ? p.YB : p.YF;
        if (wid >= 4) {
            const int pw = wid - 4, hc = h * 64 + lane;
            const float kkc = p.a_k_k[j * 512 + hc], kac = p.a_k_a[j * 512 + hc];
            const float mur = p.a_mu[j * ACOLS + hc], muk = p.a_mu[j * ACOLS + 512 + hc], muv = p.a_mu[j * ACOLS + 1024 + hc];
            LAS float* L = (LAS float*)lds;
            bf16_t raw[8][11];
#define SCAN_ROW(stepv, row_, t_, T_) const bool cp_ = (stepv) < 256; const int tt_ = cp_ ? (stepv) : (stepv) - 256, T_ = cp_ ? 256 : 2048, t_ = dir ? (T_ - 1 - tt_) : tt_; const int row_ = cp_ ? NLAT + b * 256 + t_ : b * 2048 + t_
#define SCAN_LOAD(cc) do { _Pragma("unroll") for (int it = 0; it < 8; ++it) { const int step = (cc) * CH + pw + 4 * it; SCAN_ROW(step, row, t, T); \
                const int rp_ = (t > 0) ? row - 1 : row, rn_ = (t < T - 1) ? row + 1 : row; \
                const bf16_t* pc = p.P + (size_t)row * PLD + hc; const bf16_t* pp = p.P + (size_t)rp_ * PLD + hc; const bf16_t* pn = p.P + (size_t)rn_ * PLD + hc; \
                raw[it][0] = pc[0]; raw[it][1] = pp[0]; raw[it][2] = pn[0]; raw[it][3] = pc[512]; raw[it][4] = pp[512]; raw[it][5] = pn[512]; raw[it][6] = pc[1024]; raw[it][7] = pp[1024]; raw[it][8] = pn[1024]; \
                raw[it][9] = p.WAG[(size_t)row * WLD + dir * 512 + hc]; raw[it][10] = p.WAG[(size_t)row * WLD + 1024 + dir * 512 + hc]; } } while (0)
            if (ABL != 1) SCAN_LOAD(0);
            for (int c = 0; c <= 73; ++c) {
                if (c >= 2 && ABL == 0) {
                    const LAS float* yb = L + YOFF + ((c - 2) & 1) * (CH * 64);
#pragma unroll
                    for (int it = 0; it < 8; ++it) {
                        const int sl = pw + 4 * it, step = (c - 2) * CH + sl; SCAN_ROW(step, row, t, T);
                        yout[(size_t)row * 512 + hc] = f2bf(yb[sl * 64 + lane]);
                    }
                }
                if (c < 72 && ABL != 1) {
                    LAS float* buf = L + (c & 1) * BUFF;
#pragma unroll
                    for (int it = 0; it < 8; ++it) {
                        const int sl = pw + 4 * it, step = c * CH + sl; SCAN_ROW(step, row, t, T); (void)row;
                        const float mp = (t > 0) ? 0.5f : 0.f, mn = (t < T - 1) ? 0.5f : 0.f;
                        const float rc = bf2f(raw[it][0]), kc_ = bf2f(raw[it][3]), vc = bf2f(raw[it][6]);
                        const float R = rc + mur * (mp * bf2f(raw[it][1]) + mn * bf2f(raw[it][2]) - rc);
                        const float K = kc_ + muk * (mp * bf2f(raw[it][4]) + mn * bf2f(raw[it][5]) - kc_);
                        const float V = vc + muv * (mp * bf2f(raw[it][7]) + mn * bf2f(raw[it][8]) - vc);
                        const float w = 1.f - bf2f(raw[it][9]), a = bf2f(raw[it][10]);
                        const float kkv = K * kkc, ssq = wave_sum(kkv * kkv), kk = kkv * rsqrtf(ssq + 1e-12f);
                        const float kd = K * (1.f + (a - 1.f) * kac), bd = kk * a;
                        const float br = wave_sum(bd * R), kr = wave_sum(kd * R);
                        LAS float* rec = buf + sl * REC;
                        rec[lane] = w; rec[64 + lane] = -kk; rec[128 + lane] = bd; rec[192 + lane] = kd; rec[256 + lane] = w * R; rec[320 + lane] = V;
                        if (lane == 0) { rec[384] = br; rec[385] = kr; }
                    }
                    if (c + 1 < 72) SCAN_LOAD(c + 1);
                }
                __syncthreads();
            }
#undef SCAN_LOAD
#undef SCAN_ROW
        } else {
            const int ct = tid, rp = ct >> 3, k8 = ct & 7;
            float S0[8], S1[8];
#pragma unroll
            for (int q = 0; q < 8; ++q) { S0[q] = 0.f; S1[q] = 0.f; }
            __syncthreads();
            for (int c = 0; c < 72; ++c) {
                const LAS float* buf = (const LAS float*)lds + (c & 1) * BUFF; LAS float* yb = (LAS float*)lds + YOFF + (c & 1) * (CH * 64);
                mm::f32x4 cw0, cw1, cn0, cn1, cb0, cb1, cd0, cd1, cr0, cr1; scan::f32x2 cvv, csc;
#define SCAN_LD(recp, W0, W1, N0, N1, B0, B1, D0, D1, R0_, R1_, VV, SC) do { const LAS float* r_ = (recp); \
                    W0 = *(const LAS mm::f32x4*)(r_ + k8 * 8); W1 = *(const LAS mm::f32x4*)(r_ + k8 * 8 + 4); N0 = *(const LAS mm::f32x4*)(r_ + 64 + k8 * 8); N1 = *(const LAS mm::f32x4*)(r_ + 64 + k8 * 8 + 4); \
                    B0 = *(const LAS mm::f32x4*)(r_ + 128 + k8 * 8); B1 = *(const LAS mm::f32x4*)(r_ + 128 + k8 * 8 + 4); D0 = *(const LAS mm::f32x4*)(r_ + 192 + k8 * 8); D1 = *(const LAS mm::f32x4*)(r_ + 192 + k8 * 8 + 4); \
                    R0_ = *(const LAS mm::f32x4*)(r_ + 256 + k8 * 8); R1_ = *(const LAS mm::f32x4*)(r_ + 256 + k8 * 8 + 4); VV = *(const LAS scan::f32x2*)(r_ + 320 + 2 * rp); SC = *(const LAS scan::f32x2*)(r_ + 384); } while (0)
                SCAN_LD(buf, cw0, cw1, cn0, cn1, cb0, cb1, cd0, cd1, cr0, cr1, cvv, csc);
#pragma unroll 2
                for (int sl = 0; sl < (ABL == 2 ? 0 : CH); ++sl) {
                    mm::f32x4 nw0, nw1, nn0, nn1, nb0, nb1, nd0, nd1, nr0, nr1; scan::f32x2 nvv, nsc;
                    SCAN_LD(buf + (sl + 1 < CH ? sl + 1 : sl) * REC, nw0, nw1, nn0, nn1, nb0, nb1, nd0, nd1, nr0, nr1, nvv, nsc);
                    const float wv[8] = {cw0[0], cw0[1], cw0[2], cw0[3], cw1[0], cw1[1], cw1[2], cw1[3]}, nv[8] = {cn0[0], cn0[1], cn0[2], cn0[3], cn1[0], cn1[1], cn1[2], cn1[3]};
                    const float bv[8] = {cb0[0], cb0[1], cb0[2], cb0[3], cb1[0], cb1[1], cb1[2], cb1[3]}, dv[8] = {cd0[0], cd0[1], cd0[2], cd0[3], cd1[0], cd1[1], cd1[2], cd1[3]};
                    const float rv[8] = {cr0[0], cr0[1], cr0[2], cr0[3], cr1[0], cr1[1], cr1[2], cr1[3]};
                    float sa0 = 0.f, sa1 = 0.f, y0 = 0.f, y1 = 0.f;
#pragma unroll
                    for (int q = 0; q < 8; ++q) { sa0 += S0[q] * nv[q]; sa1 += S1[q] * nv[q]; y0 += S0[q] * rv[q]; y1 += S1[q] * rv[q]; }
                    sa0 = red8(sa0); sa1 = red8(sa1); y0 = red8(y0); y1 = red8(y1);
                    y0 += sa0 * csc[0] + cvv[0] * csc[1]; y1 += sa1 * csc[0] + cvv[1] * csc[1];
#pragma unroll
                    for (int q = 0; q < 8; ++q) { S0[q] = S0[q] * wv[q] + sa0 * bv[q] + cvv[0] * dv[q]; S1[q] = S1[q] * wv[q] + sa1 * bv[q] + cvv[1] * dv[q]; }
                    if (k8 == 0) *(LAS scan::f32x2*)(yb + sl * 64 + 2 * rp) = (scan::f32x2){y0, y1};
                    cw0 = nw0; cw1 = nw1; cn0 = nn0; cn1 = nn1; cb0 = nb0; cb1 = nb1; cd0 = nd0; cd1 = nd1; cr0 = nr0; cr1 = nr1; cvv = nvv; csc = nsc;
                }
#undef SCAN_LD
                __syncthreads();
            }
            __syncthreads();
        }
    }
}

namespace sc2 {
typedef short bf16x8 __attribute__((ext_vector_type(8)));
typedef float f32x4 __attribute__((ext_vector_type(4)));
typedef unsigned u32x4 __attribute__((ext_vector_type(4)));
typedef unsigned u32x2 __attribute__((ext_vector_type(2)));
constexpr int NP = 6;
constexpr int O_AH = 0, O_RH = 2048, O_BK = 4096, O_VM = 8192, O_GC = 10240, O_AAB = 10496, O_AAK = 11520, O_ARK = 12032, O_BH = 13056, O_KH = 15104, SLOT = 17152;
constexpr int O_S0 = NP * SLOT, O_RHS = O_S0 + 8192, O_ZU = O_RHS + 4096, O_FLAG = O_ZU + 2048, TOTAL = O_FLAG + 256;
#define SC_MFMA(a, b, c) __builtin_amdgcn_mfma_f32_16x16x32_bf16((a), (b), (c), 0, 0, 0)
DI unsigned pk2(float a, float b) { return att::pk(a, b); }
DI int ldv(volatile LAS int* p) { return *p; }
}
template <int ABL>
DI void ph_scan_chunk(const Ctx& cx, const Params& p, float* ldsg, int j) {
    using namespace sc2;
    static_assert(TOTAL <= 128 * 1024, "scan LDS map");
    LAS unsigned char* L = (LAS unsigned char*)ldsg;
    volatile LAS int* ready = (volatile LAS int*)(L + O_FLAG); volatile LAS int* done = ready + 8;
    const int tid = cx.tid, wid = __builtin_amdgcn_readfirstlane(tid >> 6), lane = tid & 63, lq = lane >> 4, lr = lane & 15;
    constexpr int NCH = 144;
    for (int item = cx.bid; item < 256; item += cx.nblk) {
        const int b = item >> 4, h = (item >> 1) & 7, dir = item & 1;
        bf16_t* yout = dir ? p.YB : p.YF;
        __syncthreads();
        if (tid < 16) ready[tid] = 0;
        __syncthreads();
#define SC_ROW(stepv, row_, t_, T_) const bool cp_ = (stepv) < 256; const int tt_ = cp_ ? (stepv) : (stepv) - 256, T_ = cp_ ? 256 : 2048, t_ = dir ? (T_ - 1 - tt_) : tt_; const int row_ = cp_ ? NLAT + b * 256 + t_ : b * 2048 + t_
        if (wid == 0) {
            __builtin_amdgcn_s_setprio(3);
            f32x4 S[4][4];
#pragma unroll
            for (int kb = 0; kb < 4; ++kb)
#pragma unroll
                for (int vb = 0; vb < 4; ++vb) S[kb][vb] = (f32x4){0.f, 0.f, 0.f, 0.f};
            for (int c = 0; c < NCH; ++c) {
                const int sl = c % NP; LAS unsigned char* SB = L + sl * SLOT;
                { unsigned spins = 0; while (ldv(ready + sl) != c + 1) { __builtin_amdgcn_s_sleep(1); if (++spins > (1u << 22)) break; } }
                asm volatile("" ::: "memory");
                if (ABL == 2) { if (lane == 0) done[sl] = c + 1; continue; }
                f32x4 cA[8][2];
#pragma unroll
                for (int t = 1; t <= 8; ++t)
#pragma unroll
                    for (int q = 0; q < 2; ++q) if (4 * q < t) cA[t - 1][q] = *(const LAS f32x4*)(SB + O_AAB + t * 64 + q * 16);
#pragma unroll
                for (int kb = 0; kb < 4; ++kb)
#pragma unroll
                    for (int vb = 0; vb < 4; ++vb) { const f32x4 x = S[kb][vb]; *(LAS u32x2*)(L + O_S0 + (16 * vb + lr) * 128 + (16 * kb + 4 * lq) * 2) = (u32x2){pk2(x[0], x[1]), pk2(x[2], x[3])}; }
                {
                    bf16x8 ah[2], ak, sf[4][2], vmf[4];
#pragma unroll
                    for (int ks = 0; ks < 2; ++ks) ah[ks] = *(const LAS bf16x8*)(SB + O_AH + lr * 128 + ks * 64 + lq * 16);
                    { u32x4 z = {0u, 0u, 0u, 0u}; if (lq < 2) z = *(const LAS u32x4*)(SB + O_AAK + lr * 32 + lq * 16); ak = __builtin_bit_cast(bf16x8, z); }
#pragma unroll
                    for (int vb = 0; vb < 4; ++vb) {
#pragma unroll
                        for (int ks = 0; ks < 2; ++ks) sf[vb][ks] = *(const LAS bf16x8*)(L + O_S0 + (16 * vb + lr) * 128 + ks * 64 + lq * 16);
                        u32x4 z = {0u, 0u, 0u, 0u}; if (lq < 2) z = *(const LAS u32x4*)(SB + O_VM + (16 * vb + lr) * 32 + lq * 16); vmf[vb] = __builtin_bit_cast(bf16x8, z);
                    }
                    f32x4 acc[4];
#pragma unroll
                    for (int vb = 0; vb < 4; ++vb) { acc[vb] = (f32x4){0.f, 0.f, 0.f, 0.f}; acc[vb] = SC_MFMA(sf[vb][0], ah[0], acc[vb]); acc[vb] = SC_MFMA(sf[vb][1], ah[1], acc[vb]); acc[vb] = SC_MFMA(vmf[vb], ak, acc[vb]); }
#pragma unroll
                    for (int vb = 0; vb < 4; ++vb)
#pragma unroll
                        for (int q = 0; q < 4; ++q) *(LAS float*)(L + O_RHS + ((16 * vb + 4 * lq + q) * 16 + lr) * 4) = acc[vb][q];
                }
                float u[16];
                { const LAS f32x4* rp = (const LAS f32x4*)(L + O_RHS + lane * 64);
#pragma unroll
                  for (int q = 0; q < 4; ++q) { const f32x4 x = rp[q]; u[4 * q] = x[0]; u[4 * q + 1] = x[1]; u[4 * q + 2] = x[2]; u[4 * q + 3] = x[3]; } }
#define SC_SUBST(t, CF) do { float a0 = u[t], a1 = 0.f; \
                    _Pragma("unroll") for (int q = 0; q < 4; ++q) { if (4 * q < (t)) { const f32x4 cf = CF[q]; \
                        _Pragma("unroll") for (int e = 0; e < 4; ++e) { if (4 * q + e < (t)) { if (e & 1) a1 += cf[e] * u[4 * q + e]; else a0 += cf[e] * u[4 * q + e]; } } } } \
                    u[t] = a0 + a1; } while (0)
                f32x4 cB[4][3], cC[3][4];
#pragma unroll
                for (int t = 9; t <= 12; ++t)
#pragma unroll
                    for (int q = 0; q < 3; ++q) cB[t - 9][q] = *(const LAS f32x4*)(SB + O_AAB + t * 64 + q * 16);
                asm volatile("" ::: "memory");
                SC_SUBST(1, cA[0]); SC_SUBST(2, cA[1]); SC_SUBST(3, cA[2]); SC_SUBST(4, cA[3]); SC_SUBST(5, cA[4]); SC_SUBST(6, cA[5]); SC_SUBST(7, cA[6]); SC_SUBST(8, cA[7]);
                asm volatile("" ::: "memory");
#pragma unroll
                for (int t = 13; t <= 15; ++t)
#pragma unroll
                    for (int q = 0; q < 4; ++q) cC[t - 13][q] = *(const LAS f32x4*)(SB + O_AAB + t * 64 + q * 16);
                asm volatile("" ::: "memory");
                SC_SUBST(9, cB[0]); SC_SUBST(10, cB[1]); SC_SUBST(11, cB[2]); SC_SUBST(12, cB[3]);
                SC_SUBST(13, cC[0]); SC_SUBST(14, cC[1]); SC_SUBST(15, cC[2]);
#undef SC_SUBST
                { u32x4 w0 = {pk2(u[0], u[1]), pk2(u[2], u[3]), pk2(u[4], u[5]), pk2(u[6], u[7])}, w1 = {pk2(u[8], u[9]), pk2(u[10], u[11]), pk2(u[12], u[13]), pk2(u[14], u[15])};
                  *(LAS u32x4*)(L + O_ZU + lane * 32) = w0; *(LAS u32x4*)(L + O_ZU + lane * 32 + 16) = w1; }
                {
                    bf16x8 zf[4], sf[4][2], bkf[4]; f32x4 gc[4];
#pragma unroll
                    for (int vb = 0; vb < 4; ++vb) {
                        zf[vb] = (lq < 2) ? *(const LAS bf16x8*)(L + O_ZU + (16 * vb + lr) * 32 + lq * 16) : *(const LAS bf16x8*)(SB + O_VM + (16 * vb + lr) * 32 + (lq - 2) * 16);
#pragma unroll
                        for (int ks = 0; ks < 2; ++ks) sf[vb][ks] = *(const LAS bf16x8*)(L + O_S0 + (16 * vb + lr) * 128 + ks * 64 + lq * 16);
                    }
                    const bf16x8 rk = *(const LAS bf16x8*)(SB + O_ARK + lr * 64 + lq * 16);
                    const bf16x8 rh0 = *(const LAS bf16x8*)(SB + O_RH + lr * 128 + lq * 16), rh1 = *(const LAS bf16x8*)(SB + O_RH + lr * 128 + 64 + lq * 16);
#pragma unroll
                    for (int kb = 0; kb < 4; ++kb) { gc[kb] = *(const LAS f32x4*)(SB + O_GC + (16 * kb + 4 * lq) * 4); bkf[kb] = *(const LAS bf16x8*)(SB + O_BK + (16 * kb + lr) * 64 + lq * 16); }
                    const int step = c * 16 + lr; SC_ROW(step, row, tq, Tq); (void)tq; (void)Tq;
#pragma unroll
                    for (int vb = 0; vb < 4; ++vb) { f32x4 y = {0.f, 0.f, 0.f, 0.f};
                        y = SC_MFMA(sf[vb][0], rh0, y); y = SC_MFMA(sf[vb][1], rh1, y); y = SC_MFMA(zf[vb], rk, y);
                        if (ABL == 0) *(u32x2*)(yout + (size_t)row * 512 + h * 64 + 16 * vb + 4 * lq) = (u32x2){pk2(y[0], y[1]), pk2(y[2], y[3])}; else asm volatile("" :: "v"(y[0]), "v"(y[1]), "v"(y[2]), "v"(y[3])); }
#pragma unroll
                    for (int kb = 0; kb < 4; ++kb)
#pragma unroll
                        for (int vb = 0; vb < 4; ++vb) S[kb][vb] = SC_MFMA(bkf[kb], zf[vb], S[kb][vb] * gc[kb]);
                }
                asm volatile("s_waitcnt lgkmcnt(0)" ::: "memory");
                if (lane == 0) done[sl] = c + 1;
            }
            __builtin_amdgcn_s_setprio(0);
        } else if (wid != 4) {
            const int pw = (wid < 4) ? wid - 1 : wid - 2, hc = h * 64 + lane; LAS unsigned char* SB = L + pw * SLOT;
            const float kkc = p.a_k_k[j * 512 + hc], kac = p.a_k_a[j * 512 + hc];
            const float mur = p.a_mu[j * ACOLS + hc], muk = p.a_mu[j * ACOLS + 512 + hc], muv = p.a_mu[j * ACOLS + 1024 + hc];
            for (int c = pw; c < NCH; c += NP) {
                if (ABL == 1) { if (c >= NP) { unsigned spins = 0; while (ldv(done + pw) != c - NP + 1) { __builtin_amdgcn_s_sleep(2); if (++spins > (1u << 22)) break; } } if (lane == 0) ready[pw] = c + 1; continue; }
                bf16_t raw[16][11];
#define SC_LOAD(t) do { const int step = c * 16 + (t); SC_ROW(step, row, tq, Tq); \
                    const int rp_ = (tq > 0) ? row - 1 : row, rn_ = (tq < Tq - 1) ? row + 1 : row; \
                    const bf16_t* pc = p.P + (size_t)row * PLD + hc; const bf16_t* pp = p.P + (size_t)rp_ * PLD + hc; const bf16_t* pn = p.P + (size_t)rn_ * PLD + hc; \
                    raw[t][0] = pc[0]; raw[t][1] = pp[0]; raw[t][2] = pn[0]; raw[t][3] = pc[512]; raw[t][4] = pp[512]; raw[t][5] = pn[512]; raw[t][6] = pc[1024]; raw[t][7] = pp[1024]; raw[t][8] = pn[1024]; \
                    raw[t][9] = p.WAG[(size_t)row * WLD + dir * 512 + hc]; raw[t][10] = p.WAG[(size_t)row * WLD + 1024 + dir * 512 + hc]; } while (0)
#define SC_STEP(t) do { const int step = c * 16 + (t); SC_ROW(step, row, tq, Tq); (void)row; \
                    const float mp = (tq > 0) ? 0.5f : 0.f, mn = (tq < Tq - 1) ? 0.5f : 0.f; \
                    const float rc = bf2f(raw[t][0]), kc_ = bf2f(raw[t][3]), vc = bf2f(raw[t][6]); \
                    const float R = rc + mur * (mp * bf2f(raw[t][1]) + mn * bf2f(raw[t][2]) - rc); \
                    const float K = kc_ + muk * (mp * bf2f(raw[t][4]) + mn * bf2f(raw[t][5]) - kc_); \
                    const float Vv = vc + muv * (mp * bf2f(raw[t][7]) + mn * bf2f(raw[t][8]) - vc); \
                    const float w = 1.f - bf2f(raw[t][9]), a = bf2f(raw[t][10]); \
                    const float kkv = K * kkc, ssq = wave_sum(kkv * kkv), kk = kkv * rsqrtf(ssq + 1e-12f); \
                    const float kd = K * (1.f + (a - 1.f) * kac), bd = kk * a; \
                    const float gprev = g; g *= w; const float ig = __builtin_amdgcn_rcpf(g); \
                    *(LAS bf16_t*)(SB + O_AH + (t) * 128 + lane * 2) = f2bf(-kk * gprev); \
                    *(LAS bf16_t*)(SB + O_RH + (t) * 128 + lane * 2) = f2bf(R * g); \
                    *(LAS bf16_t*)(SB + O_BH + (t) * 128 + lane * 2) = f2bf(bd * ig); \
                    *(LAS bf16_t*)(SB + O_KH + (t) * 128 + lane * 2) = f2bf(kd * ig); \
                    *(LAS bf16_t*)(SB + O_VM + lane * 32 + (t) * 2) = f2bf(Vv); } while (0)
                SC_LOAD(0); SC_LOAD(1); SC_LOAD(2); SC_LOAD(3); SC_LOAD(4); SC_LOAD(5); SC_LOAD(6); SC_LOAD(7);
                if (c >= NP) { unsigned spins = 0; while (ldv(done + pw) != c - NP + 1) { __builtin_amdgcn_s_sleep(2); if (++spins > (1u << 22)) break; } }
                asm volatile("" ::: "memory");
                float g = 1.f;
                SC_STEP(0); SC_STEP(1); SC_STEP(2); SC_STEP(3);
                asm volatile("" ::: "memory");
                SC_LOAD(8); SC_LOAD(9); SC_LOAD(10); SC_LOAD(11);
                asm volatile("" ::: "memory");
                SC_STEP(4); SC_STEP(5); SC_STEP(6); SC_STEP(7);
                asm volatile("" ::: "memory");
                SC_LOAD(12); SC_LOAD(13); SC_LOAD(14); SC_LOAD(15);
                asm volatile("" ::: "memory");
                SC_STEP(8); SC_STEP(9); SC_STEP(10); SC_STEP(11); SC_STEP(12); SC_STEP(13); SC_STEP(14); SC_STEP(15);
#undef SC_LOAD
#undef SC_STEP
#pragma unroll
                for (int q = 0; q < 2; ++q) {
                    float bq[8], kq[8];
#pragma unroll
                    for (int e = 0; e < 8; ++e) { bq[e] = bf2f(*(const LAS bf16_t*)(SB + O_BH + (8 * q + e) * 128 + lane * 2)) * g; kq[e] = bf2f(*(const LAS bf16_t*)(SB + O_KH + (8 * q + e) * 128 + lane * 2)) * g; }
                    u32x4 wb = {pk2(bq[0], bq[1]), pk2(bq[2], bq[3]), pk2(bq[4], bq[5]), pk2(bq[6], bq[7])}, wk = {pk2(kq[0], kq[1]), pk2(kq[2], kq[3]), pk2(kq[4], kq[5]), pk2(kq[6], kq[7])};
                    *(LAS u32x4*)(SB + O_BK + lane * 64 + q * 16) = wb; *(LAS u32x4*)(SB + O_BK + lane * 64 + 32 + q * 16) = wk;
                }
                *(LAS float*)(SB + O_GC + lane * 4) = g;
                f32x4 sab = {0.f, 0.f, 0.f, 0.f}, sak = sab, srb = sab, srk = sab;
#pragma unroll
                for (int ks = 0; ks < 2; ++ks) {
                    const bf16x8 fa = *(const LAS bf16x8*)(SB + O_AH + lr * 128 + ks * 64 + lq * 16), fr = *(const LAS bf16x8*)(SB + O_RH + lr * 128 + ks * 64 + lq * 16);
                    const bf16x8 fb = *(const LAS bf16x8*)(SB + O_BH + lr * 128 + ks * 64 + lq * 16), fk = *(const LAS bf16x8*)(SB + O_KH + lr * 128 + ks * 64 + lq * 16);
                    sab = SC_MFMA(fa, fb, sab); sak = SC_MFMA(fa, fk, sak); srb = SC_MFMA(fr, fb, srb); srk = SC_MFMA(fr, fk, srk);
                }
#pragma unroll
                for (int q = 0; q < 4; ++q) { const int t = 4 * lq + q; const bool lo = lr < t, le = lr <= t;
                    *(LAS float*)(SB + O_AAB + (t * 16 + lr) * 4) = lo ? sab[q] : 0.f;
                    *(LAS bf16_t*)(SB + O_AAK + (t * 16 + lr) * 2) = f2bf(lo ? sak[q] : 0.f);
                    *(LAS bf16_t*)(SB + O_ARK + (t * 32 + lr) * 2) = f2bf(le ? srb[q] : 0.f);
                    *(LAS bf16_t*)(SB + O_ARK + (t * 32 + 16 + lr) * 2) = f2bf(le ? srk[q] : 0.f); }
                asm volatile("s_waitcnt lgkmcnt(0)" ::: "memory");
                if (lane == 0) ready[pw] = c + 1;
            }
        }
#undef SC_ROW
        __syncthreads();
    }
}

DI void unpack8u(const uint4 u, float (&d)[8]) { d[0] = bflo(u.x); d[1] = bfhi(u.x); d[2] = bflo(u.y); d[3] = bfhi(u.y); d[4] = bflo(u.z); d[5] = bfhi(u.z); d[6] = bflo(u.w); d[7] = bfhi(u.w); }
DI uint4 pack8u(const float (&d)[8]) { uint4 u; u.x = att::pk(d[0], d[1]); u.y = att::pk(d[2], d[3]); u.z = att::pk(d[4], d[5]); u.w = att::pk(d[6], d[7]); return u; }
DI void shift8(const bf16_t* P, int row, int t, int T, int col0, const float (&mu)[8], float (&o)[8]) {
    float c[8], pv[8], nx[8];
    unpack8u(*(const uint4*)(P + (size_t)row * PLD + col0), c);
    if (t > 0) unpack8u(*(const uint4*)(P + (size_t)(row - 1) * PLD + col0), pv); else {
#pragma unroll
        for (int i = 0; i < 8; ++i) pv[i] = 0.f; }
    if (t < T - 1) unpack8u(*(const uint4*)(P + (size_t)(row + 1) * PLD + col0), nx); else {
#pragma unroll
        for (int i = 0; i < 8; ++i) nx[i] = 0.f; }
#pragma unroll
    for (int i = 0; i < 8; ++i) o[i] = c[i] + mu[i] * (0.5f * (pv[i] + nx[i]) - c[i]);
}
DI void ld8f(const float* p, float (&d)[8]) { const float4 a = *(const float4*)p, b = *(const float4*)(p + 4); d[0] = a.x; d[1] = a.y; d[2] = a.z; d[3] = a.w; d[4] = b.x; d[5] = b.y; d[6] = b.z; d[7] = b.w; }
DI void ph_post_opt(const Ctx& cx, const Params& p, int j, int nrows) {
    const int tid = cx.tid, wid = tid >> 6, lane = tid & 63, c0 = lane * 8;
    float mur[8], muk[8], muv[8], ka[8], rk[8], lw[8], lb[8];
    ld8f(p.a_mu + j * ACOLS + c0, mur); ld8f(p.a_mu + j * ACOLS + 512 + c0, muk); ld8f(p.a_mu + j * ACOLS + 1024 + c0, muv);
    ld8f(p.a_k_a + j * 512 + c0, ka); ld8f(p.a_r_k + j * 512 + c0, rk); ld8f(p.a_ln_w + j * 512 + c0, lw); ld8f(p.a_ln_b + j * 512 + c0, lb);
    for (int row = cx.bid * 8 + wid; row < nrows; row += cx.nblk * 8) {
        const bool lat = row < NLAT; const int t = lat ? (row & 2047) : ((row - NLAT) & 255); const int T = lat ? 2048 : 256;
        float yf[8], yb[8], R[8], K[8], V[8], af[8], ab[8], g[8];
        unpack8u(*(const uint4*)(p.YF + (size_t)row * 512 + c0), yf); unpack8u(*(const uint4*)(p.YB + (size_t)row * 512 + c0), yb);
        shift8(p.P, row, t, T, c0, mur, R); shift8(p.P, row, t, T, 512 + c0, muk, K); shift8(p.P, row, t, T, 1024 + c0, muv, V);
        unpack8u(*(const uint4*)(p.WAG + (size_t)row * WLD + 1024 + c0), af); unpack8u(*(const uint4*)(p.WAG + (size_t)row * WLD + 1536 + c0), ab); unpack8u(*(const uint4*)(p.WAG + (size_t)row * WLD + 2048 + c0), g);
        float sum = 0.f, sb = 0.f;
#pragma unroll
        for (int i = 0; i < 8; ++i) { yf[i] += yb[i]; sum += yf[i]; sb += R[i] * rk[i] * K[i] * (2.f + (af[i] + ab[i] - 2.f) * ka[i]); }
        sum = scan::red8(sum); sb = scan::red8(sb);
        const float mean = sum * (1.f / 64.f); float var = 0.f;
#pragma unroll
        for (int i = 0; i < 8; ++i) { const float d = yf[i] - mean; var += d * d; }
        var = scan::red8(var);
        const float rstd = rsqrtf(var * (1.f / 64.f) + 64e-5f);
        float o[8];
#pragma unroll
        for (int i = 0; i < 8; ++i) o[i] = ((yf[i] - mean) * rstd * lw[i] + lb[i] + sb * V[i]) * g[i];
        *(uint4*)(p.H + (size_t)row * 1024 + c0) = pack8u(o);
    }
}
DI void fin_vec(float (&x)[8], int c, int t, bool lat, const float* gain, float scl, bf16_t* dst) {
    float ss = 0.f;
#pragma unroll
    for (int i = 0; i < 8; ++i) ss += x[i] * x[i];
    ss += dpp_f<0xB1>(ss); ss += dpp_f<0x4E>(ss); ss += dpp_f<0x141>(ss); ss += dpp_f<0x140>(ss);
    const float r = rsqrtf(ss * (1.f / 96.f) + 1e-6f);
    float gn[8]; ld8f(gain + (c < 12 ? c : 0) * 8, gn);
#pragma unroll
    for (int i = 0; i < 8; ++i) x[i] = x[i] * r * gn[i];
    float y[8];
#pragma unroll
    for (int i = 0; i < 8; ++i) { const float up = dpp_f<0x102>(x[i]), dn = dpp_f<0x112>(x[i]); y[i] = (c < 10) ? up : dn; }
    if (lat && c >= 8 && c < 12) {
        const float invf[8] = {1.f, 0.316227766016838f, 0.1f, 0.0316227766016838f, 0.01f, 0.00316227766016838f, 0.001f, 0.000316227766016838f};
        const float pos = (c & 1) ? (float)(t & 63) : (float)(t >> 6);
#pragma unroll
        for (int i = 0; i < 8; ++i) { const float ang = pos * invf[i], cs = __cosf(ang), sn = __sinf(ang); x[i] = (c < 10) ? (x[i] * cs - y[i] * sn) : (x[i] * cs + y[i] * sn); }
    }
    if (c < 12) {
#pragma unroll
        for (int i = 0; i < 8; ++i) x[i] *= scl;
        *(uint4*)(dst + c * 8) = pack8u(x);
    }
}
DI void ph_finalize_opt(const Ctx& cx, const Params& p, float* ldsf, int j, int mq) {
    const int tid = cx.tid, wid = tid >> 6, lane = tid & 63, c = lane & 15, hq = lane >> 4;
    const float* qg = p.b_q_gain + j * 96; const float* kg = p.b_k_gain + j * 96;
    for (int row0 = (cx.bid * 8 + wid) * 2; row0 < NT; row0 += cx.nblk * 16) {
        float xq[4][8], xk[4][8];
#pragma unroll
        for (int u = 0; u < 4; ++u) {
            const int row = row0 + (u >> 1), h = (u & 1) * 4 + hq;
#pragma unroll
            for (int i = 0; i < 8; ++i) { xq[u][i] = 0.f; xk[u][i] = 0.f; }
            if (row < mq && c < 12) unpack8u(*(const uint4*)(p.Qraw + (size_t)row * 768 + h * 96 + c * 8), xq[u]);
            if (c < 8) unpack8u(*(const uint4*)(p.KVraw + (size_t)row * 1024 + h * 128 + c * 8), xk[u]);
            else if (c < 12) unpack8u(*(const uint4*)(p.P + (size_t)row * PLD + ACOLS + 384 + (c - 8) * 8), xk[u]);
        }
#pragma unroll
        for (int u = 0; u < 4; ++u) {
            const int row = row0 + (u >> 1), h = (u & 1) * 4 + hq;
            const bool lat = row < NLAT; const int b = lat ? (row >> 11) : ((row - NLAT) >> 8); const int t = lat ? (row & 2047) : ((row - NLAT) & 255);
            if (row < mq) fin_vec(xq[u], c, t, lat, qg, 0.10206207261596577f * 1.4426950408889634f, p.Qraw + (size_t)row * 768 + h * 96);
            const int key = lat ? 256 + t : t;
            fin_vec(xk[u], c, t, lat, kg, 1.f, p.Kf + ((size_t)(b * 8 + h) * 2304 + key) * 96);
        }
    }
    bf16_t* T = (bf16_t*)ldsf; constexpr int TP = 520;
    for (int tile = cx.bid; tile < NT / 64; tile += cx.nblk) {
        const int row0 = tile * 64; const bool lat = row0 < NLAT; const int b = lat ? (row0 >> 11) : ((row0 - NLAT) >> 8); const int t0 = lat ? (row0 & 2047) : ((row0 - NLAT) & 255);
        const int key0 = lat ? 256 + t0 : t0;
        __syncthreads();
#pragma unroll
        for (int i = 0; i < 8; ++i) { const int ch = tid + 512 * i, kr = ch >> 6, cc = ch & 63, h = cc >> 3, part = cc & 7;
            *(uint4*)(T + kr * TP + h * 64 + part * 8) = *(const uint4*)(p.KVraw + (size_t)(row0 + kr) * 1024 + h * 128 + 64 + part * 8); }
        __syncthreads();
#pragma unroll
        for (int i = 0; i < 8; ++i) { const int ch = tid + 512 * i, hd = ch >> 3, kc = ch & 7;
            float v[8];
#pragma unroll
            for (int q = 0; q < 8; ++q) v[q] = bf2f(T[(kc * 8 + q) * TP + hd]);
            uint4 o; o.x = (unsigned)T[(kc * 8 + 0) * TP + hd] | ((unsigned)T[(kc * 8 + 1) * TP + hd] << 16); o.y = (unsigned)T[(kc * 8 + 2) * TP + hd] | ((unsigned)T[(kc * 8 + 3) * TP + hd] << 16);
            o.z = (unsigned)T[(kc * 8 + 4) * TP + hd] | ((unsigned)T[(kc * 8 + 5) * TP + hd] << 16); o.w = (unsigned)T[(kc * 8 + 6) * TP + hd] | ((unsigned)T[(kc * 8 + 7) * TP + hd] << 16);
            (void)v;
            *(uint4*)(p.Vt + ((size_t)(b * 8 + (hd >> 6)) * 64 + (hd & 63)) * 2304 + key0 + kc * 8) = o; }
    }
    __syncthreads();
}
DI void ph_mod_opt(const Ctx& cx, const Params& p, float* lds) {
    const int tid = cx.tid, wid = tid >> 6, lane = tid & 63;
    float* part = lds + 17 * 1024;
    for (int i = tid; i < 17 * 1024; i += NTHR) { const int jj = i >> 10, k = i & 1023; const float v = (jj < 16) ? p.c[jj * 1024 + k] : p.c_ctx[k]; lds[i] = siluf(v); }
    __syncthreads();
    for (int item = cx.bid; item < 4 * 96; item += cx.nblk) {
        const int l = item / 96, n = (item % 96) * 64 + lane;
        const float* w = p.mod_w + (size_t)l * 1024 * 6144 + n;
        float acc[17];
#pragma unroll
        for (int jj = 0; jj < 17; ++jj) acc[jj] = 0.f;
#pragma unroll 4
        for (int k = wid * 128; k < wid * 128 + 128; ++k) {
            const float wv = w[(size_t)k * 6144];
#pragma unroll
            for (int jj = 0; jj < 17; ++jj) acc[jj] += lds[jj * 1024 + k] * wv;
        }
#pragma unroll
        for (int jj = 0; jj < 17; ++jj) part[(wid * 17 + jj) * 64 + lane] = acc[jj];
        __syncthreads();
        for (int o = tid; o < 17 * 64; o += NTHR) { const int jj = o >> 6, ln = o & 63; float sacc = p.mod_b[l * 6144 + (item % 96) * 64 + ln];
#pragma unroll
            for (int q = 0; q < 8; ++q) sacc += part[(q * 17 + jj) * 64 + ln];
            p.mod[((size_t)l * 17 + jj) * 6144 + (item % 96) * 64 + ln] = sacc; }
        __syncthreads();
    }
}

DI void ph_norm2_router(const Ctx& cx, const Params& p, float* ldsg, int nrows, const float* gain, const float* modl, int layer, const bf16_t* xb_lat) {
    LAS float* lds = (LAS float*)ldsg;
    const int tid = cx.tid, wid = tid >> 6, lane = tid & 63;
    LAS float* rw = lds; LAS float* red = lds + 16 * 1024 + wid * (32 * 64 + 64); LAS float* my = red + 32 * 64;
    LAS int* lcnt = (LAS int*)(lds + 16 * 1024 + 8 * (32 * 64 + 64)); LAS int* lbase = lcnt + 16; LAS int* rlist = lcnt + 32;
    for (int i = tid; i < 16 * 1024; i += NTHR) { const int e = i >> 10, col = i & 1023; rw[i] = p.router_w[col * 16 + e]; }
    if (tid < 16) lcnt[tid] = 0;
    __syncthreads();
    int nlist = 0;
    for (int pidx = cx.bid * 8 + wid; pidx < (nrows >> 1); pidx += cx.nblk * 8) {
        float4 xv[2][4];
#pragma unroll
        for (int r = 0; r < 2; ++r) { const int row = 2 * pidx + r;
            if (xb_lat) { const bf16_t* xr = (row < NLAT) ? xb_lat + (size_t)row * 1024 : p.cs + (size_t)(row - NLAT) * 1024;
#pragma unroll
                for (int i = 0; i < 4; ++i) { const uint2 u = *(const uint2*)(xr + i * 256 + lane * 4); xv[r][i] = make_float4(bflo(u.x), bfhi(u.x), bflo(u.y), bfhi(u.y)); } }
            else { const float* xr = (row < NLAT) ? p.out + (size_t)row * 1024 : p.ctxs + (size_t)(row - NLAT) * 1024;
#pragma unroll
                for (int i = 0; i < 4; ++i) xv[r][i] = *(const float4*)(xr + i * 256 + lane * 4); } }
        const int row0 = 2 * pidx; const int jj = (row0 < NLAT) ? (row0 >> 11) : 16;
        const float* shp = modl + (size_t)jj * 6144 + 3 * 1024; const float* scp = modl + (size_t)jj * 6144 + 4 * 1024;
        float4 hv[2][4];
#pragma unroll
        for (int r = 0; r < 2; ++r) {
            float ss = 0.f;
#pragma unroll
            for (int i = 0; i < 4; ++i) ss += xv[r][i].x * xv[r][i].x + xv[r][i].y * xv[r][i].y + xv[r][i].z * xv[r][i].z + xv[r][i].w * xv[r][i].w;
            ss = wave_sum(ss);
            const float rstd = rsqrtf(ss * (1.f / 1024.f) + 1e-6f);
#pragma unroll
            for (int i = 0; i < 4; ++i) {
                const int col = i * 256 + lane * 4;
                const float4 g = *(const float4*)(gain + col), sh = *(const float4*)(shp + col), sc = *(const float4*)(scp + col);
                hv[r][i].x = xv[r][i].x * rstd * g.x * (1.f + sc.x) + sh.x; hv[r][i].y = xv[r][i].y * rstd * g.y * (1.f + sc.y) + sh.y;
                hv[r][i].z = xv[r][i].z * rstd * g.z * (1.f + sc.z) + sh.z; hv[r][i].w = xv[r][i].w * rstd * g.w * (1.f + sc.w) + sh.w;
                uint2 u; u.x = att::pk(hv[r][i].x, hv[r][i].y); u.y = att::pk(hv[r][i].z, hv[r][i].w);
                *(uint2*)(p.H + (size_t)(row0 + r) * 1024 + col) = u;
            }
        }
#pragma unroll
        for (int e = 0; e < 16; ++e) {
            float a0 = 0.f, a1 = 0.f;
#pragma unroll
            for (int i = 0; i < 4; ++i) { const mm::f32x4 w = *(const LAS mm::f32x4*)(rw + e * 1024 + i * 256 + lane * 4);
                a0 += hv[0][i].x * w[0] + hv[0][i].y * w[1] + hv[0][i].z * w[2] + hv[0][i].w * w[3]; a1 += hv[1][i].x * w[0] + hv[1][i].y * w[1] + hv[1][i].z * w[2] + hv[1][i].w * w[3]; }
            red[e * 64 + lane] = a0; red[(16 + e) * 64 + lane] = a1;
        }
        __builtin_amdgcn_wave_barrier();
        {
            const int r = lane >> 5, e = (lane >> 1) & 15, half = lane & 1; const LAS float* src = red + (r * 16 + e) * 64 + half * 32;
            float sacc = 0.f;
#pragma unroll
            for (int q = 0; q < 8; ++q) { const mm::f32x4 v = *(const LAS mm::f32x4*)(src + q * 4); sacc += (v[0] + v[1]) + (v[2] + v[3]); }
            sacc += dpp_f<0xB1>(sacc);
            const float sg = 1.f / (1.f + __expf(-sacc));
            if (half == 0) { my[r * 32 + e] = sg; my[r * 32 + 16 + e] = sg + p.router_b[e]; }
        }
        __builtin_amdgcn_wave_barrier();
        if ((lane & 31) == 0) {
            const int r = lane >> 5; const LAS float* m = my + r * 32;
            float best = -3.0e38f; int be1 = 0, be2 = 1;
#pragma unroll
            for (int g = 0; g < 4; ++g) {
                const mm::f32x4 v = *(const LAS mm::f32x4*)(m + 16 + 4 * g);
                int i1 = 0; float m1 = v[0];
                if (v[1] > m1) { m1 = v[1]; i1 = 1; } if (v[2] > m1) { m1 = v[2]; i1 = 2; } if (v[3] > m1) { m1 = v[3]; i1 = 3; }
                int i2 = -1; float m2 = -3.0e38f;
                if (i1 != 0 && v[0] > m2) { m2 = v[0]; i2 = 0; } if (i1 != 1 && v[1] > m2) { m2 = v[1]; i2 = 1; }
                if (i1 != 2 && v[2] > m2) { m2 = v[2]; i2 = 2; } if (i1 != 3 && v[3] > m2) { m2 = v[3]; i2 = 3; }
                const float gs = m1 + m2;
                if (gs > best) { best = gs; be1 = 4 * g + i1; be2 = 4 * g + i2; }
            }
            const float bs1 = m[be1], bs2 = m[be2]; const float inv = 1.f / (bs1 + bs2);
            const int p1 = atomicAdd((int*)&lcnt[be1], 1), p2 = atomicAdd((int*)&lcnt[be2], 1);
            LAS int* ent = rlist + (wid * 24 + nlist * 2 + r) * 6;
            const int row = row0 + r;
            ent[0] = row; ent[1] = be1 | (be2 << 8); ent[2] = p1; ent[3] = p2; ent[4] = __float_as_int(bs1 * inv); ent[5] = __float_as_int(bs2 * inv);
        }
        ++nlist;
        __builtin_amdgcn_wave_barrier();
    }
    __syncthreads();
    if (tid < 16) lbase[tid] = atomicAdd(p.cnt + (layer * 16 + tid) * 64, lcnt[tid]);
    __syncthreads();
    for (int k = lane; k < 2 * nlist; k += 64) {
        const LAS int* ent = rlist + (wid * 24 + k) * 6; const int row = ent[0], be1 = ent[1] & 255, be2 = ent[1] >> 8;
        const size_t s1 = (size_t)be1 * NT + lbase[be1] + ent[2], s2 = (size_t)be2 * NT + lbase[be2] + ent[3];
        p.slot[s1] = row * 2; p.slot[s2] = row * 2 + 1; p.slotw[s1] = __int_as_float(ent[4]); p.slotw[s2] = __int_as_float(ent[5]);
    }
    __syncthreads();
}

DI void ph_prepBLR_opt(const Ctx& cx, const Params& p, int j) {
    const int tid = cx.tid, wid = tid >> 6, lane = tid & 63;
    const float4 gq = *(const float4*)(p.b_q_norm + j * 256 + lane * 4); const float2 gk = *(const float2*)(p.b_kv_norm + j * 128 + lane * 2);
    constexpr int U = 8;
    for (int row0 = (cx.bid * 8 + wid) * U; row0 < NT; row0 += cx.nblk * 8 * U) {
        uint2 uq[U]; unsigned ukv[U];
#pragma unroll
        for (int u = 0; u < U; ++u) { const bf16_t* pr = p.P + (size_t)(row0 + u) * PLD + ACOLS; uq[u] = *(const uint2*)(pr + lane * 4); ukv[u] = *(const unsigned*)(pr + 256 + lane * 2); }
#pragma unroll
        for (int u = 0; u < U; ++u) {
            const float q0 = bflo(uq[u].x), q1 = bfhi(uq[u].x), q2 = bflo(uq[u].y), q3 = bfhi(uq[u].y), k0 = bflo(ukv[u]), k1 = bfhi(ukv[u]);
            const float sq = wave_sum(q0 * q0 + q1 * q1 + q2 * q2 + q3 * q3), sk = wave_sum(k0 * k0 + k1 * k1);
            const float rq = rsqrtf(sq * (1.f / 256.f) + 1e-6f), rk = rsqrtf(sk * (1.f / 128.f) + 1e-6f);
            uint2 o; o.x = att::pk(q0 * rq * gq.x, q1 * rq * gq.y); o.y = att::pk(q2 * rq * gq.z, q3 * rq * gq.w);
            bf16_t* qn = p.QN + (size_t)(row0 + u) * 512;
            *(uint2*)(qn + lane * 4) = o; *(unsigned*)(qn + 256 + lane * 2) = att::pk(k0 * rk * gk.x, k1 * rk * gk.y); *(unsigned*)(qn + 384 + lane * 2) = 0u;
        }
    }
    const int gtid = cx.bid * NTHR + tid, gsz = cx.nblk * NTHR;
    for (int idx = gtid; idx < NT * 48; idx += gsz) {
        const int row = idx / 48, cg = idx % 48, col0 = cg * 8;
        const bool lat = row < NLAT; const int t = lat ? (row & 2047) : ((row - NLAT) & 255); const int T = lat ? 2048 : 256;
        float mu[8]; ld8f(p.a_mu + j * ACOLS + 1536 + col0, mu);
        float v[8]; shift8(p.P, row, t, T, 1536 + col0, mu, v);
        if (cg < 16) {
#pragma unroll
            for (int i = 0; i < 8; ++i) { const float e = __expf(2.f * v[i]); v[i] = 1.f - 2.f * __builtin_amdgcn_rcpf(e + 1.f); }
        } else if (cg >= 32) {
#pragma unroll
            for (int i = 0; i < 8; ++i) v[i] = __builtin_amdgcn_rcpf(1.f + __expf(-v[i]));
        }
        *(uint4*)(p.LR + (size_t)row * 384 + col0) = pack8u(v);
    }
}

template <bool FINAL>
DI void ph_normc(const Ctx& cx, const Params& p, int nrows, const bf16_t* xin_lat, bf16_t* xout_lat, const float* gain, const float* modl, const float* modprev) {
    const int tid = cx.tid, wid = tid >> 6, lane = tid & 63;
    for (int row = cx.bid * 8 + wid; row < nrows; row += cx.nblk * 8) {
        const bool lat = row < NLAT; const int jj = lat ? (row >> 11) : 16; const size_t rb = lat ? (size_t)row : (size_t)(row - NLAT);
        const bf16_t* xr = (lat ? xin_lat : p.cs) + rb * 1024;
        const float* g2 = modprev + (size_t)jj * 6144 + 5 * 1024;
        float4 xv[4];
#pragma unroll
        for (int i = 0; i < 4; ++i) {
            const int col = i * 256 + lane * 4;
            const uint2 ux = *(const uint2*)(xr + col);
            float s0 = 0.f, s1 = 0.f, s2 = 0.f, s3 = 0.f;
#pragma unroll
            for (int sl = 0; sl < 3; ++sl) { const uint2 u = *(const uint2*)(p.Y + ((size_t)sl * NT + row) * 1024 + col); s0 += bflo(u.x); s1 += bfhi(u.x); s2 += bflo(u.y); s3 += bfhi(u.y); }
            const float4 gv = *(const float4*)(g2 + col);
            xv[i].x = bflo(ux.x) + gv.x * s0; xv[i].y = bfhi(ux.x) + gv.y * s1; xv[i].z = bflo(ux.y) + gv.z * s2; xv[i].w = bfhi(ux.y) + gv.w * s3;
            if (FINAL) *(float4*)(p.out + (size_t)row * 1024 + col) = xv[i];
            else { uint2 o; o.x = att_pk(xv[i].x, xv[i].y); o.y = att_pk(xv[i].z, xv[i].w); *(uint2*)((lat ? xout_lat : p.cs) + rb * 1024 + col) = o; }
        }
        if (!FINAL) {
            float ss = 0.f;
#pragma unroll
            for (int i = 0; i < 4; ++i) ss += xv[i].x * xv[i].x + xv[i].y * xv[i].y + xv[i].z * xv[i].z + xv[i].w * xv[i].w;
            ss = wave_sum(ss);
            const float rstd = rsqrtf(ss * (1.f / 1024.f) + 1e-6f);
            const float* shp = modl + (size_t)jj * 6144; const float* scp = modl + (size_t)jj * 6144 + 1024;
#pragma unroll
            for (int i = 0; i < 4; ++i) {
                const int col = i * 256 + lane * 4;
                const float4 g = *(const float4*)(gain + col), sh = *(const float4*)(shp + col), sc = *(const float4*)(scp + col);
                uint2 u; u.x = att_pk(xv[i].x * rstd * g.x * (1.f + sc.x) + sh.x, xv[i].y * rstd * g.y * (1.f + sc.y) + sh.y);
                u.y = att_pk(xv[i].z * rstd * g.z * (1.f + sc.z) + sh.z, xv[i].w * rstd * g.w * (1.f + sc.w) + sh.w);
                *(uint2*)(p.H + (size_t)row * 1024 + col) = u;
            }
        }
    }
}

struct F1Sched {
    static constexpr bool GATHER = false, TABLE = false;
    const char* A; const char* Hb; int T2, nN, G, c;
    DI size_t hstep_a() const { return (size_t)mm::HALF * 1024 * 2; }
    DI unsigned boff(int Rb, int C, int Kk) const { return (unsigned)(Rb * T2 * Kk + C) * 2u; }
    DI size_t hstep_b(int Kk) const { return (size_t)Kk * 2; }
    DI bool next(int i, mm::Unit& u) const {
        const int L = i * G + c; if (L >= 8 * nN) return false;
        u.pm = L & 7; u.pn = L >> 3; u.e = 0; u.m = 0;
        const int b = (T2 == 16) ? (u.pn >> 3) : u.pn, t20 = (T2 == 16) ? 2 * (u.pn & 7) : 0;
        u.A = A + (size_t)u.pm * 256 * 1024 * 2; u.B = Hb + ((size_t)b * (128 * T2) + t20) * 1024 * 2; return true;
    }
    DI void aoff(const mm::Unit&, int R0, int C0, int R1, int C1, unsigned (&o)[2][2]) const {
        o[0][0] = (unsigned)(R0 * 1024 + C0) * 2u; o[0][1] = (unsigned)(R1 * 1024 + C1) * 2u; o[1][0] = o[0][0]; o[1][1] = o[0][1];
    }
};
struct EpiZT3 {
    static constexpr bool PERM = true;
    bf16_t* Z; int T2;
    DI void operator()(const mm::f32x4 (&acc)[2][2][4][2], const mm::Unit& u, int wr, int wc, int fr, int fq) const {
        const int b = (T2 == 16) ? (u.pn >> 3) : u.pn, t20 = (T2 == 16) ? 2 * (u.pn & 7) : 0;
        const int m0 = u.pm * 256 + wr * 64 + fr, t1 = wc * 32 + 8 * fq;
#pragma unroll
        for (int ai = 0; ai < 2; ++ai)
#pragma unroll
            for (int m = 0; m < 4; ++m) { const int mr = m0 + ai * 128 + m * 16, part = mr >> 10, ch = mr & 1023;
#pragma unroll
                for (int bj = 0; bj < 2; ++bj) { const mm::f32x4 v0 = acc[ai][bj][m][0], v1 = acc[ai][bj][m][1];
                    mm::u32x4 w; w.x = att_pk(v0[0], v0[1]); w.y = att_pk(v0[2], v0[3]); w.z = att_pk(v1[0], v1[1]); w.w = att_pk(v1[2], v1[3]);
                    *(mm::u32x4*)(Z + ((size_t)(b * 1024 + ch) * T2 + t20 + bj) * 256 + part * 128 + t1) = w; } }
    }
};
DI void ph_f1b(const Ctx& cx, const Params& p, float* lds, int j, bool with_ctx) {
    { F1Sched S{(const char*)(p.A1 + (size_t)j * 2048 * 1024), (const char*)p.H, 16, NLAT / 256, cx.nblk, cx.bid}; EpiZT3 E{p.ZT, 16}; mm::gemm_phase(GEMM_LDS(lds), 1024, S, E, cx.tid); }
    if (with_ctx) { F1Sched S{(const char*)(p.A1 + (size_t)j * 2048 * 1024), (const char*)(p.H + (size_t)NLAT * 1024), 2, NCTX / 256, cx.nblk, cx.bid}; EpiZT3 E{p.ZTC, 2}; mm::gemm_phase(GEMM_LDS(lds), 1024, S, E, cx.tid); }
}
DI void ph_fa(const Ctx& cx, const Params& p, float* lds, bool with_ctx) {
    int Kr = 256; asm volatile("" : "+s"(Kr));
    { mm::BatchSched S; S.init(p.M1, p.ZT, (size_t)16384 * 256 * 2, 16, 256, 16384, Kr, cx.nblk, cx.bid); mm::EpiBf16Store E{p.YF1, 16384, (size_t)256 * 16384}; mm::gemm_phase(GEMM_LDS(lds), Kr, S, E, cx.tid); }
    if (with_ctx) { mm::BatchSched S; S.init(p.M1, p.ZTC, (size_t)2048 * 256 * 2, 16, 256, 2048, Kr, cx.nblk, cx.bid); mm::EpiBf16Store E{p.YF1c, 2048, (size_t)256 * 2048}; mm::gemm_phase(GEMM_LDS(lds), Kr, S, E, cx.tid); }
}
template <int T2>
DI void fb_items(const Ctx& cx, const Params& p, const LAS float* tw, const bf16_t* Y, const bf16_t* xin, bf16_t* xout, const float* modl, bool ctx, float scale) {
    constexpr int T = 128 * T2; constexpr size_t NB = (size_t)1024 * T2;
    const int gtid = cx.bid * NTHR + cx.tid, gsz = cx.nblk * NTHR;
    for (int idx = gtid; idx < 16 * 128 * 512; idx += gsz) {
        const int cp = idx & 511, f1 = (idx >> 9) & 127, b = idx >> 16;
        float yr[2][T2], yi[2][T2];
        { const bf16_t* pr = Y + ((size_t)b * 256 + f1) * NB + (size_t)(2 * cp) * T2; const bf16_t* pi = pr + (size_t)128 * NB;
          if constexpr (T2 == 2) { const uint2 ur = *(const uint2*)pr, ui = *(const uint2*)pi;
              yr[0][0] = bflo(ur.x); yr[0][1] = bfhi(ur.x); yr[1][0] = bflo(ur.y); yr[1][1] = bfhi(ur.y); yi[0][0] = bflo(ui.x); yi[0][1] = bfhi(ui.x); yi[1][0] = bflo(ui.y); yi[1][1] = bfhi(ui.y); }
          else {
#pragma unroll
          for (int q = 0; q < (2 * T2) / 8; ++q) { float d[8]; unpack8u(*(const uint4*)(pr + q * 8), d);
#pragma unroll
              for (int e = 0; e < 8; ++e) yr[(q * 8 + e) / T2][(q * 8 + e) % T2] = d[e];
              unpack8u(*(const uint4*)(pi + q * 8), d);
#pragma unroll
              for (int e = 0; e < 8; ++e) yi[(q * 8 + e) / T2][(q * 8 + e) % T2] = d[e]; } } }
        const int jj = ctx ? 16 : b; const float2 g1 = *(const float2*)(modl + (size_t)jj * 6144 + 2 * 1024 + 2 * cp);
        constexpr int FG = (T2 >= 4) ? 4 : T2;
#pragma unroll 1
        for (int fg = 0; fg < T2; fg += FG) {
            unsigned xv[FG];
#pragma unroll
            for (int q = 0; q < FG; ++q) xv[q] = *(const unsigned*)(xin + ((size_t)b * T + f1 + 128 * (fg + q)) * 1024 + 2 * cp);
#pragma unroll
            for (int q = 0; q < FG; ++q) {
                const int f = f1 + 128 * (fg + q); float a0 = 0.f, a1 = 0.f;
#pragma unroll
                for (int t2 = 0; t2 < T2; ++t2) { const int mi = ((t2 * f) & (T - 1)) * (2048 / T); const float cs = tw[2 * mi], sn = tw[2 * mi + 1];
                    a0 += cs * yr[0][t2] + sn * yi[0][t2]; a1 += cs * yr[1][t2] + sn * yi[1][t2]; }
                *(unsigned*)(xout + ((size_t)b * T + f) * 1024 + 2 * cp) = att_pk(bflo(xv[q]) + g1.x * scale * a0, bfhi(xv[q]) + g1.y * scale * a1);
            }
        }
    }
}
DI void fb_mfma(const Ctx& cx, const Params& p, const LAS float* tw, const bf16_t* Y, const bf16_t* xin, bf16_t* xout, const float* modl) {
    typedef short bf16x8 __attribute__((ext_vector_type(8)));
    constexpr size_t NB = (size_t)1024 * 16;
    const int tid = cx.tid, wid = tid >> 6, lane = tid & 63, lq = lane >> 4, lr = lane & 15;
    const int part = lq >> 1, t20 = 8 * (lq & 1);
    for (int item = cx.bid * 8 + wid; item < 16 * 128 * 32; item += cx.nblk * 8) {
        const int cb = item & 31, f1 = (item >> 5) & 127, b = item >> 12, c0 = cb * 32;
        const bf16_t* yb = Y + ((size_t)b * 256 + part * 128 + f1) * NB + t20;
        const int chA = c0 + 8 * (lr >> 2) + (lr & 3);
        const bf16x8 a0 = *(const bf16x8*)(yb + (size_t)chA * 16), a1 = *(const bf16x8*)(yb + (size_t)(chA + 4) * 16);
        const int f = f1 + 128 * lr;
        mm::u32x4 bw;
        { float tv[8];
#pragma unroll
          for (int jj = 0; jj < 8; ++jj) { const int mi = ((t20 + jj) * f) & 2047; tv[jj] = tw[2 * mi + part]; }
          bw.x = att_pk(tv[0], tv[1]); bw.y = att_pk(tv[2], tv[3]); bw.z = att_pk(tv[4], tv[5]); bw.w = att_pk(tv[6], tv[7]); }
        const bf16x8 bf = __builtin_bit_cast(bf16x8, bw);
        mm::f32x4 d0 = {0.f, 0.f, 0.f, 0.f}, d1 = d0;
        d0 = __builtin_amdgcn_mfma_f32_16x16x32_bf16(a0, bf, d0, 0, 0, 0);
        d1 = __builtin_amdgcn_mfma_f32_16x16x32_bf16(a1, bf, d1, 0, 0, 0);
        const float* g1 = modl + (size_t)b * 6144 + 2 * 1024 + c0 + 8 * lq;
        const mm::f32x4 g0 = *(const mm::f32x4*)g1, g4 = *(const mm::f32x4*)(g1 + 4);
        const size_t off = ((size_t)b * 2048 + f) * 1024 + c0 + 8 * lq;
        const mm::u32x4 xv = *(const mm::u32x4*)(xin + off);
        const float sc = 1.f / 512.f;
        mm::u32x4 o;
        o.x = att_pk(bflo(xv.x) + g0[0] * sc * d0[0], bfhi(xv.x) + g0[1] * sc * d0[1]); o.y = att_pk(bflo(xv.y) + g0[2] * sc * d0[2], bfhi(xv.y) + g0[3] * sc * d0[3]);
        o.z = att_pk(bflo(xv.z) + g4[0] * sc * d1[0], bfhi(xv.z) + g4[1] * sc * d1[1]); o.w = att_pk(bflo(xv.w) + g4[2] * sc * d1[2], bfhi(xv.w) + g4[3] * sc * d1[3]);
        *(mm::u32x4*)(xout + off) = o;
    }
}
DI void ph_fb(const Ctx& cx, const Params& p, float* ldsg, bool with_ctx, const bf16_t* xin_lat, bf16_t* xout_lat, const float* modl) {
    LAS float* tw = (LAS float*)ldsg;
    for (int i = cx.tid; i < 2048; i += NTHR) { const float a = (float)i * (1.f / 1024.f); tw[2 * i] = cospif(a); tw[2 * i + 1] = sinpif(a); }
    __syncthreads();
    fb_mfma(cx, p, tw, p.YF1, xin_lat, xout_lat, modl);
    if (with_ctx) fb_items<2>(cx, p, tw, p.YF1c, p.cs, p.cs, modl, true, 0.0055242717280199f);
    __syncthreads();
}

template <int PH>
DI void run_phase(const Params& p, float* lds, int L, int wave_id) {
    const Ctx cx = make_ctx(wave_id);
    const int j = L >> 1;
    const float* modl = p.mod + (size_t)L * 17 * 6144;
    const float* modprev = p.mod + (size_t)(L > 0 ? L - 1 : 0) * 17 * 6144;
    const bool last = (L == 3);
    const int rows_layer = (L == 3) ? NLAT : NT;
    const int rows_out = (L >= 2) ? NLAT : NT;
    const float* xin_lat = (L == 0) ? p.x : p.out; const float* xin_ctx = (L == 0) ? p.ctx : p.ctxs;
    constexpr bool BFS = (OPT >= 11);
    const void* bin_lat = (L == 0) ? (const void*)p.x : (const void*)p.xs; const void* bin_ctx = (L == 0) ? (const void*)p.ctx : (const void*)p.cs;
    bf16_t* bout_lat = (L == 3) ? p.xs3 : p.xs;
    if constexpr (PH == 0) { if (OPT >= 7) { ph_mod_opt(cx, p, lds); for (int i = cx.bid * NTHR + cx.tid; i < 1024; i += cx.nblk * NTHR) p.H[(size_t)NT * 1024 + i] = 0; } else ph_prologue(cx, p, lds); ph_prep_weights(cx, p, lds); }
    if constexpr (PH == 1) {
        if (OPT >= 4) ph_prep_moe(cx, p, lds, L);
        if (BFS && L > 0) { ph_normc<false>(cx, p, rows_layer, p.xs, p.xs, p.norm1_g + L * 1024, modl, modprev); return; }
        if (L == 0) ph_norm<false, true, false>(cx, p, lds, rows_layer, xin_lat, xin_ctx, p.norm1_g + L * 1024, modl, 0, 1, modprev, L);
        else ph_norm<true, true, false>(cx, p, lds, rows_layer, xin_lat, xin_ctx, p.norm1_g + L * 1024, modl, 0, 1, modprev, L);
    }
    if constexpr (PH == 2) { if (OPT >= 1) ph_win_mm(cx, p, lds, j); else ph_win(cx, p, lds, j); }
    if constexpr (PH == 3) { if (OPT >= 10) ph_prepBLR_opt(cx, p, j); else ph_prepB(cx, p, j); }
    if constexpr (PH == 4) { if (OPT >= 2) ph_qkvup_mm(cx, p, lds, j, rows_out); else ph_qkvup(cx, p, lds, j, rows_out); }
    if constexpr (PH == 5) { if (OPT >= 7) ph_finalize_opt(cx, p, lds, j, rows_out); else ph_finalize(cx, p, j, rows_out); }
    if constexpr (PH == 6) { if (OPT >= 5) ph_attn_mm(cx, p, lds, rows_out == NT); else ph_attn(cx, p, rows_out == NT); }
    if constexpr (PH == 7) { if (OPT < 10) ph_prepLR(cx, p, j); }
    if constexpr (PH == 8) { if (OPT >= 2) ph_wag_mm(cx, p, lds, j); else ph_wag(cx, p, lds, j); }
    if constexpr (PH == 9) { if (OPT >= 9) ph_scan_chunk<0>(cx, p, lds, j); else if (OPT >= 6) ph_scan_opt<0>(cx, p, lds, j); else ph_scan(cx, p, lds, j); }
    if constexpr (PH == 19) ph_scan_chunk<PROBE_SCAN>(cx, p, lds, j);
    if constexpr (PH == 10) { if (OPT >= 7) ph_post_opt(cx, p, j, rows_out); else ph_post(cx, p, j, rows_out); }
    if constexpr (PH == 11) { if (BFS) ph_wout_mmB(cx, p, lds, p.H, p.WoutT + (size_t)j * 1024 * 1024, rows_out, bin_lat, bin_ctx, bout_lat, L == 0, modl); else if (OPT >= 1) ph_wout_mm(cx, p, lds, p.H, p.WoutT + (size_t)j * 1024 * 1024, rows_out, xin_lat, xin_ctx, modl); else ph_wout(cx, p, lds, p.H, p.w_out_even + (size_t)j * 1024 * 1024, rows_out, xin_lat, xin_ctx, modl); }
    if constexpr (PH == 12) { if (OPT >= 12) ph_f1b(cx, p, lds, j, !last); else if (OPT >= 3) ph_f1_mm(cx, p, lds, j, !last); else ph_chdft(cx, p, lds, rows_layer); }
    if constexpr (PH == 13) { if (OPT >= 12) ph_fa(cx, p, lds, !last); else if (BFS) ph_f2_mmB(cx, p, lds, !last, bin_lat, bin_ctx, bout_lat, modl); else if (OPT >= 3) ph_f2_mm(cx, p, lds, !last, xin_lat, xin_ctx, modl); else ph_posdft(cx, p, lds, !last); }
    if constexpr (PH == 14) { if (OPT >= 12) ph_fb(cx, p, lds, !last, p.xs, bout_lat, modl); }
    if constexpr (PH == 14) { if (OPT < 3) ph_wout(cx, p, lds, p.F, p.w_out_fourier + (size_t)j * 1024 * 1024, rows_out, xin_lat, xin_ctx, modl); }
    if constexpr (PH == 15) { if (OPT >= 8) ph_norm2_router(cx, p, lds, rows_out, p.norm2_g + L * 1024, modl, L, BFS ? bout_lat : (const bf16_t*)nullptr); else ph_norm<false, true, true>(cx, p, lds, rows_out, p.out, p.ctxs, p.norm2_g + L * 1024, modl, 3, 4, modprev, L); }
    if constexpr (PH == 16) { if (OPT >= 4) ph_moe_up_mm(cx, p, lds, L, rows_out); else ph_moe_up(cx, p, lds, L, rows_out); }
    if constexpr (PH == 17) { if (OPT >= 4) ph_moe_down_mm(cx, p, lds, L, rows_out); else ph_moe_down(cx, p, lds, L, rows_out); }
    if constexpr (PH == 18) { if (BFS) { ph_normc<true>(cx, p, NLAT, p.xs3, nullptr, p.norm1_g, p.mod + (size_t)3 * 17 * 6144, p.mod + (size_t)3 * 17 * 6144); return; } }
    if constexpr (PH == 18) ph_norm<true, false, false>(cx, p, lds, NLAT, p.out, p.ctxs, p.norm1_g, p.mod + (size_t)3 * 17 * 6144, 0, 1, p.mod + (size_t)3 * 17 * 6144, 3);
}

template <int PH>
__global__ void __launch_bounds__(NTHR, 2) k_phase(Params p, int L) {
    extern __shared__ __attribute__((aligned(16))) float shm[];
    run_phase<PH>(p, shm, L, (int)(threadIdx.x >> 6));
}

#if ONE_LAUNCH
constexpr int PARAM_WORDS = (int)(sizeof(Params) / 4);
DI Params load_params(const unsigned* lp) {
    Params q; unsigned* d = (unsigned*)&q;
#pragma unroll
    for (int i = 0; i < PARAM_WORDS; ++i) d[i] = (unsigned)__builtin_amdgcn_readfirstlane((int)lp[i]);
    void** pp = (void**)&q;
#pragma unroll
    for (int i = 0; i < PARAM_WORDS / 2; ++i) pp[i] = (void*)(__attribute__((address_space(1))) void*)pp[i];
    return q;
}
#ifndef PROBE_MASK
#define PROBE_MASK 0u
#endif

#define PHASE(PH, L) do { unsigned long long t0_ = 0; if (PROBE_MASK & (1u << (PH))) t0_ = wall_clock64(); \
    { run_phase<PH>(p, lds, (L), wave_id); } xcd_barrier(bar, wave_id == 0 && lane_id_asm() == 0); \
    if (PROBE_MASK & (1u << (PH))) tacc += wall_clock64() - t0_; } while (0)
__global__ void __launch_bounds__(NTHR, 2) k_mega(Params p) {
    extern __shared__ __attribute__((aligned(16))) float shm[];
    unsigned* lp = (unsigned*)(shm + 4);
    float* lds = shm + 4 + ((PARAM_WORDS + 3) & ~3);
    if (threadIdx.x == 0) { shm[0] = 0.f; shm[1] = 0.f; shm[2] = 0.f; shm[3] = 0.f; }
    if (threadIdx.x < PARAM_WORDS) lp[threadIdx.x] = ((const unsigned*)&p)[threadIdx.x];
    __syncthreads();
    XcdBarrier bar; { const Params q_ = load_params(lp); bar = xcd_barrier_post(q_.bar, (volatile LAS unsigned*)shm); }
    unsigned long long tacc = 0;
    const int wave_id = __builtin_amdgcn_readfirstlane((int)(threadIdx.x >> 6));
    PHASE(0, 0);
#define LAYER_EVEN(L) PHASE(1, L); PHASE(2, L); PHASE(3, L); PHASE(4, L); PHASE(5, L); PHASE(6, L); if (OPT < 10) { PHASE(7, L); } PHASE(8, L); PHASE(9, L); if (PROBE_SCAN) { PHASE(19, L); } PHASE(10, L); PHASE(11, L); PHASE(15, L); PHASE(16, L); PHASE(17, L)
#define LAYER_ODD(L) PHASE(1, L); PHASE(12, L); PHASE(13, L); if (OPT < 3 || OPT >= 12) { PHASE(14, L); } PHASE(15, L); PHASE(16, L); PHASE(17, L)
    LAYER_EVEN(0); LAYER_ODD(1); LAYER_EVEN(2); LAYER_ODD(3);
    { unsigned long long t0_ = 0; if (PROBE_MASK & (1u << 18)) t0_ = wall_clock64(); run_phase<18>(p, lds, 3, wave_id);
      if (PROBE_MASK & (1u << 18)) { xcd_barrier(bar, wave_id == 0 && lane_id_asm() == 0); tacc += wall_clock64() - t0_; } }
    if (PROBE_MASK != 0u && blockIdx.x == 0 && threadIdx.x == 0) {
        const unsigned long long t1 = wall_clock64(); while (wall_clock64() - t1 < 20ull * tacc) __builtin_amdgcn_s_sleep(8); }
}
#endif

static inline size_t al256(size_t v) { return (v + 255) & ~(size_t)255; }
constexpr size_t LDS_BYTES = 148 * 1024;

template <int PH> static void launch_phase(const Params& p, int L, int grid, hipStream_t s) {
    static bool attr = false;
    if (!attr) { hipFuncSetAttribute((const void*)k_phase<PH>, hipFuncAttributeMaxDynamicSharedMemorySize, (int)LDS_BYTES); attr = true; }
    hipLaunchKernelGGL(k_phase<PH>, dim3(grid), dim3(NTHR), LDS_BYTES, s, p, L);
}

extern "C" void kernel_launch(void* const* d_in, const int* in_sizes, int n_in, void* d_out, int out_size, void* d_ws, size_t ws_size, hipStream_t stream) {
    (void)in_sizes; (void)n_in; (void)out_size;
    Params p{};
    const float** ip = (const float**)&p.x;
    for (int i = 0; i < 36; ++i) ip[i] = (const float*)d_in[i];
    p.out = (float*)d_out;
    char* w = (char*)d_ws; size_t o = 0;
    auto take = [&](size_t bytes) { char* r = w + o; o += al256(bytes); return r; };
    p.bar = (unsigned*)take(XCD_BAR_WORDS * 4);
    p.cnt = (int*)take(64 * 64 * 4);
    const size_t zero_bytes = o;
    p.mod = (float*)take((size_t)4 * 17 * 6144 * 4);
    p.ctxs = (float*)take((size_t)NCTX * 1024 * 4);
    p.dftl = (bf16_t*)take((size_t)2048 * 4096 * 2);
    p.dftc = (bf16_t*)take((size_t)256 * 512 * 2);
    p.slot = (int*)take((size_t)16 * NT * 4);
    p.tokw = (float*)take((size_t)NT * 2 * 4);
    p.slotw = (float*)take((size_t)16 * NT * 4);
    p.H = (bf16_t*)take((size_t)(NT + 1) * 1024 * 2);
    char* big = w + o;
    p.P = (bf16_t*)take((size_t)NT * PLD * 2);
    char* r1 = w + o;
    p.WAG = (bf16_t*)take((size_t)NT * WLD * 2);
    p.YF = (bf16_t*)take((size_t)NT * 512 * 2);
    p.YB = (bf16_t*)take((size_t)NT * 512 * 2);
    p.LR = (bf16_t*)take((size_t)NT * 384 * 2);
    p.WinT = (bf16_t*)take((size_t)2 * 2560 * 1024 * 2); p.WqT = (bf16_t*)take((size_t)2 * 768 * 256 * 2); p.WkvT = (bf16_t*)take((size_t)2 * 1024 * 256 * 2);
    p.WlrT = (bf16_t*)take((size_t)2 * 2560 * 384 * 2); p.WoutT = (bf16_t*)take((size_t)2 * 1024 * 1024 * 2); p.A1 = (bf16_t*)take((size_t)2 * 2048 * 1024 * 2);
    p.A2 = (bf16_t*)take((size_t)2048 * 4096 * 2); p.A2c = (bf16_t*)take((size_t)256 * 512 * 2); p.M1 = (bf16_t*)take((size_t)256 * 256 * 2);
    p.WguT = (bf16_t*)take((size_t)17 * 1024 * 1024 * 2); p.WdT = (bf16_t*)take((size_t)17 * 1024 * 512 * 2);
    const size_t total = o;
    { size_t q = 0; auto t2 = [&](size_t bytes) { char* r = r1 + q; q += al256(bytes); return r; };
      p.QN = (bf16_t*)t2((size_t)NT * 512 * 2); p.Qraw = (bf16_t*)t2((size_t)NT * 768 * 2); p.KVraw = (bf16_t*)t2((size_t)NT * 1024 * 2);
      p.Kf = (bf16_t*)t2((size_t)NB * 8 * 2304 * 96 * 2); p.Vt = (bf16_t*)t2((size_t)NB * 8 * 64 * 2304 * 2); }
    { size_t q = 0; auto t3 = [&](size_t bytes) { char* r = big + q; q += al256(bytes); return r; };
      p.ACT = (bf16_t*)t3((size_t)3 * NT * 512 * 2); p.Y = (bf16_t*)t3((size_t)3 * NT * 1024 * 2); }
    { size_t q = 0; auto t4 = [&](size_t bytes) { char* r = big + q; q += al256(bytes); return r; };
      p.G = (float*)t4((size_t)NT * 2048 * 4); p.F = (bf16_t*)t4((size_t)NT * 1024 * 2); }
    { size_t q = 0; auto t5 = [&](size_t bytes) { char* r = big + q; q += al256(bytes); return r; };
      p.ZT = (bf16_t*)t5((size_t)16 * 1024 * 4096 * 2); p.ZTC = (bf16_t*)t5((size_t)16 * 1024 * 512 * 2);
      p.YF1 = (bf16_t*)t5((size_t)256 * 16 * 1024 * 16 * 2); p.YF1c = (bf16_t*)t5((size_t)256 * 16 * 1024 * 2 * 2); }
    p.xs = (bf16_t*)d_out; p.cs = (bf16_t*)p.ctxs; p.xs3 = (bf16_t*)(big + (size_t)344 * 1024 * 1024);
    if (total > ws_size) { fprintf(stderr, "workspace too small: need %zu have %zu\n", total, ws_size); return; }
    static int grid = 0;
    if (!grid) { int dev = 0, cus = 0; hipGetDevice(&dev); hipDeviceGetAttribute(&cus, hipDeviceAttributeMultiprocessorCount, dev); grid = cus > 0 ? cus : 256; if (grid > 256) grid = 256; }
    hipMemsetAsync(d_ws, 0, zero_bytes, stream);
#if ONE_LAUNCH
    static bool attr = false;
    if (!attr) { hipFuncSetAttribute((const void*)k_mega, hipFuncAttributeMaxDynamicSharedMemorySize, (int)LDS_BYTES); attr = true; }
    hipLaunchKernelGGL(k_mega, dim3(grid), dim3(NTHR), LDS_BYTES, stream, p);
#else
    launch_phase<0>(p, 0, grid, stream);
    for (int L = 0; L < 4; ++L) {
        launch_phase<1>(p, L, grid, stream);
        if ((L & 1) == 0) {
            launch_phase<2>(p, L, grid, stream); launch_phase<3>(p, L, grid, stream); launch_phase<4>(p, L, grid, stream); launch_phase<5>(p, L, grid, stream);
            launch_phase<6>(p, L, grid, stream); launch_phase<7>(p, L, grid, stream); launch_phase<8>(p, L, grid, stream); launch_phase<9>(p, L, grid, stream);
            launch_phase<10>(p, L, grid, stream); launch_phase<11>(p, L, grid, stream);
        } else {
            launch_phase<12>(p, L, grid, stream); launch_phase<13>(p, L, grid, stream); launch_phase<14>(p, L, grid, stream);
        }
        launch_phase<15>(p, L, grid, stream); launch_phase<16>(p, L, grid, stream); launch_phase<17>(p, L, grid, stream);
    }
    launch_phase<18>(p, 3, grid, stream);
#endif
}
```

```cpp
#include <hip/hip_runtime.h>
#include <cstdio>
#include <cstdint>

#ifndef ONE_LAUNCH
#define ONE_LAUNCH 1
#endif
#ifndef PROBE_SCAN
#define PROBE_SCAN 0
#endif
#ifndef OPT
#define OPT 12
#endif

typedef unsigned short bf16_t;
#define DI __device__ __forceinline__
#define LAS __attribute__((address_space(3)))

constexpr int D = 1024, NB = 16, SEQ = 2048, CTXL = 256, NLAT = NB * SEQ, NCTX = NB * CTXL, NT = NLAT + NCTX;
constexpr int PLD = 2560;
constexpr int INC = 2336, ACOLS = 1920;
constexpr int WLD = 2560;
constexpr int NTHR = 512;

#define XB_TMO      128
#define XB_XCNT(j)  (256  + 64 * (j))
#define XB_XSUB(j)  (1280 + 64 * (j))
#define XB_XGEN(j)  (2304 + 64 * (j))
#define XB_TOP      3328
#define XB_TOPGEN   3392
#define XCD_BAR_WORDS 3456
#define XB_SPIN_CAP (1u << 24)
DI unsigned xb_ld(unsigned* p)              { return __hip_atomic_load(p, __ATOMIC_RELAXED, __HIP_MEMORY_SCOPE_AGENT); }
DI unsigned xb_add(unsigned* p, unsigned v) { return __hip_atomic_fetch_add(p, v, __ATOMIC_RELAXED, __HIP_MEMORY_SCOPE_AGENT); }
DI unsigned xb_xcc_id() { return (unsigned)__builtin_amdgcn_s_getreg((3 << 11) | 20) & 0xFu; }
#define XB_SPIN(cond, bar) do { unsigned _sp = 0; while (cond) { __builtin_amdgcn_s_sleep(1); \
    if ((++_sp & 255u) == 0u) { if (xb_ld(&(bar)[XB_TMO])) break; if (_sp > XB_SPIN_CAP) { atomicAdd(&(bar)[XB_TMO], 1u); break; } } } } while (0)
struct XcdBarrier { unsigned* bar; unsigned x; volatile LAS unsigned* st; };
DI XcdBarrier xcd_barrier_post(unsigned* bar, volatile LAS unsigned* st) {
    XcdBarrier b; b.bar = bar; b.x = xb_xcc_id(); b.st = st;
    if (threadIdx.x == 0) (void)xb_add(&bar[XB_XCNT(b.x)], 1u);
    return b;
}
DI void xcd_barrier_complete(unsigned* bar, unsigned x, unsigned& nloc, unsigned& nx) {
    const unsigned G = gridDim.x * gridDim.y * gridDim.z;
    unsigned sum, cnt, mine, sp = 0u;
    for (;;) {
        sum = 0u; cnt = 0u; mine = 0u;
#pragma unroll
        for (unsigned j = 0; j < 16; ++j) { const unsigned c = xb_ld(&bar[XB_XCNT(j)]); sum += c; cnt += (c > 0u) ? 1u : 0u; mine = (j == x) ? c : mine; }
        if (sum == G) break;
        __builtin_amdgcn_s_sleep(1);
        if ((++sp & 255u) == 0u) { if (xb_ld(&bar[XB_TMO])) break; if (sp > XB_SPIN_CAP) { atomicAdd(&bar[XB_TMO], 1u); break; } }
    }
    nloc = mine > 0u ? mine : 1u; nx = cnt > 0u ? cnt : 1u;
}
DI void xcd_barrier(const XcdBarrier& b, const bool t0) {
    asm volatile("s_waitcnt vmcnt(0)" ::: "memory");
    __syncthreads();
    if (t0) {
        unsigned* bar = b.bar;
        __builtin_amdgcn_s_waitcnt(0);
        unsigned nloc = b.st[0], nx = b.st[1];
        if (nloc == 0u) { xcd_barrier_complete(bar, b.x, nloc, nx); b.st[0] = nloc; b.st[1] = nx; }
        const unsigned old = xb_add(&bar[XB_XSUB(b.x)], 1u);
        const unsigned gen = old / nloc;
        if (old + 1u == (gen + 1u) * nloc) {
            __builtin_amdgcn_fence(__ATOMIC_RELEASE, "agent");
            asm volatile("s_waitcnt vmcnt(0)" ::: "memory");
            const unsigned og = xb_add(&bar[XB_TOP], 1u);
            const unsigned tg = og / nx;
            if (og + 1u == (tg + 1u) * nx) xb_add(&bar[XB_TOPGEN], 1u);
            else XB_SPIN(xb_ld(&bar[XB_TOPGEN]) == tg, bar);
            __builtin_amdgcn_fence(__ATOMIC_ACQUIRE, "agent");
            xb_add(&bar[XB_XGEN(b.x)], 1u);
            asm volatile("s_waitcnt vmcnt(0)" ::: "memory");
        } else {
            XB_SPIN(xb_ld(&bar[XB_XGEN(b.x)]) == gen, bar);
            __builtin_amdgcn_fence(__ATOMIC_ACQUIRE, "agent");
            asm volatile("s_waitcnt vmcnt(0)" ::: "memory");
        }
    }
    __syncthreads();
}

struct Params {
    const float *x, *c, *ctx, *c_ctx, *norm1_g, *norm2_g, *mod_w, *mod_b, *w_in, *a_mu, *a_w0, *a_w2, *a_a0, *a_a2, *a_g2,
                *a_k_k, *a_k_a, *a_r_k, *a_ln_w, *a_ln_b, *b_q_norm, *b_w_q_up, *b_kv_norm, *b_w_kv_up, *b_q_gain, *b_k_gain,
                *w_out_even, *w_out_fourier, *router_w, *router_b, *moe_w_gate, *moe_w_up, *moe_w_down, *sh_gate, *sh_up, *sh_down;
    float* out;
    unsigned* bar; int* cnt; float* mod; float* ctxs; bf16_t* dftl; bf16_t* dftc; int* slot; float* tokw; float* slotw;
    bf16_t *H, *P, *LR, *WAG, *YF, *YB, *QN, *Qraw, *KVraw, *Kf, *Vt, *ACT, *Y, *F; float* G;
    bf16_t *WinT, *WqT, *WkvT, *WlrT, *WoutT, *A1, *A2, *A2c, *WguT, *WdT, *ZT, *ZTC;
    bf16_t *M1, *YF1, *YF1c;
    bf16_t *xs, *cs, *xs3;
};

struct Ctx { int tid, bid, nblk; };
DI int lane_id_asm() { int l; asm volatile("v_mbcnt_lo_u32_b32 %0, -1, 0\n\tv_mbcnt_hi_u32_b32 %0, -1, %0" : "=v"(l)); return l; }
DI Ctx make_ctx(int wave_id) { Ctx c; c.tid = wave_id * 64 + lane_id_asm(); c.bid = blockIdx.x; c.nblk = gridDim.x; asm volatile("" : "+v"(c.tid), "+s"(c.bid), "+s"(c.nblk)); return c; }

DI bf16_t f2bf(float f) { unsigned u = __float_as_uint(f); u += 0x7fffu + ((u >> 16) & 1u); return (bf16_t)(u >> 16); }
DI float bf2f(bf16_t b) { return __uint_as_float(((unsigned)b) << 16); }
DI float bflo(unsigned u) { return __uint_as_float(u << 16); }
DI float bfhi(unsigned u) { return __uint_as_float(u & 0xffff0000u); }
DI unsigned pack2(float lo, float hi) { return (unsigned)f2bf(lo) | ((unsigned)f2bf(hi) << 16); }
typedef __bf16 g_bf16x2_t __attribute__((ext_vector_type(2)));
typedef float g_f32x2_t __attribute__((ext_vector_type(2)));
DI unsigned att_pk(float a, float b) { g_f32x2_t f = {a, b}; g_bf16x2_t h = __builtin_convertvector(f, g_bf16x2_t); return __builtin_bit_cast(unsigned, h); }
DI float siluf(float v) { return v / (1.f + expf(-v)); }
DI float sigm(float v) { return 1.f / (1.f + expf(-v)); }
template <int CTRL> DI float dpp_f(float v) { return __builtin_bit_cast(float, __builtin_amdgcn_update_dpp(0, __builtin_bit_cast(int, v), CTRL, 0xf, 0xf, true)); }
DI float wave_sum(float v) {
    v += dpp_f<0xB1>(v); v += dpp_f<0x4E>(v); v += dpp_f<0x141>(v); v += dpp_f<0x140>(v);
    const int x = __builtin_bit_cast(int, v);
    const float a = __builtin_bit_cast(float, __builtin_amdgcn_readlane(x, 0)), b = __builtin_bit_cast(float, __builtin_amdgcn_readlane(x, 16));
    const float c = __builtin_bit_cast(float, __builtin_amdgcn_readlane(x, 32)), d = __builtin_bit_cast(float, __builtin_amdgcn_readlane(x, 48));
    return (a + b) + (c + d);
}

template <bool DUAL, class AFn, class BFn, class BFn2, class Epi>
DI void ngemm(const Ctx& cx, float* lds, int nbz, int M, int N, int K, AFn afn, BFn bfn, BFn2 bfn2, Epi epi) {
    float* As = lds; float* Bs = lds + 16 * 132; float* B2s = Bs + 16 * 128;
    const int tid = cx.tid, ty = tid >> 5, tx = tid & 31;
    const int tm = (M + 127) / 128, tn = (N + 127) / 128, ntile = tm * tn * nbz;
    const int arow = tid >> 2, akc = (tid & 3) * 4, bk = tid >> 5, bnn = (tid & 31) * 4;
    for (int tile = cx.bid; tile < ntile; tile += cx.nblk) {
        const int bz = tile / (tm * tn), rem = tile % (tm * tn), bm = rem / tn, bn = rem % tn;
        float acc[8][4], acc2[8][4];
#pragma unroll
        for (int i = 0; i < 8; ++i)
#pragma unroll
            for (int j = 0; j < 4; ++j) { acc[i][j] = 0.f; acc2[i][j] = 0.f; }
        const int m_a = bm * 128 + arow;
        const bf16_t* aptr = (m_a < M) ? afn(bz, m_a) : nullptr;
        const int nB = bn * 128 + bnn;
        for (int k0 = 0; k0 < K; k0 += 16) {
            float av0 = 0.f, av1 = 0.f, av2 = 0.f, av3 = 0.f;
            if (aptr) { const uint2 u = *(const uint2*)(aptr + k0 + akc); av0 = bflo(u.x); av1 = bfhi(u.x); av2 = bflo(u.y); av3 = bfhi(u.y); }
            float4 bv = make_float4(0.f, 0.f, 0.f, 0.f), bv2 = make_float4(0.f, 0.f, 0.f, 0.f);
            if (nB < N) { bv = *(const float4*)(bfn(bz, k0 + bk) + nB); if (DUAL) bv2 = *(const float4*)(bfn2(bz, k0 + bk) + nB); }
            __syncthreads();
            As[(akc + 0) * 132 + arow] = av0; As[(akc + 1) * 132 + arow] = av1; As[(akc + 2) * 132 + arow] = av2; As[(akc + 3) * 132 + arow] = av3;
            *(float4*)&Bs[bk * 128 + bnn] = bv;
            if (DUAL) *(float4*)&B2s[bk * 128 + bnn] = bv2;
            __syncthreads();
#pragma unroll 4
            for (int kk = 0; kk < 16; ++kk) {
                const float4 a0 = *(const float4*)&As[kk * 132 + ty * 8], a1 = *(const float4*)&As[kk * 132 + ty * 8 + 4];
                const float4 b = *(const float4*)&Bs[kk * 128 + tx * 4];
                const float a[8] = {a0.x, a0.y, a0.z, a0.w, a1.x, a1.y, a1.z, a1.w};
                const float bb[4] = {b.x, b.y, b.z, b.w};
#pragma unroll
                for (int i = 0; i < 8; ++i)
#pragma unroll
                    for (int j = 0; j < 4; ++j) acc[i][j] += a[i] * bb[j];
                if (DUAL) {
                    const float4 b2 = *(const float4*)&B2s[kk * 128 + tx * 4];
                    const float cc[4] = {b2.x, b2.y, b2.z, b2.w};
#pragma unroll
                    for (int i = 0; i < 8; ++i)
#pragma unroll
                        for (int j = 0; j < 4; ++j) acc2[i][j] += a[i] * cc[j];
                }
            }
        }
#pragma unroll
        for (int i = 0; i < 8; ++i) {
            const int m = bm * 128 + ty * 8 + i;
            if (m < M) {
#pragma unroll
                for (int j = 0; j < 4; ++j) { const int n = bn * 128 + tx * 4 + j; if (n < N) epi(bz, m, n, acc[i][j], acc2[i][j]); }
            }
        }
    }
    __syncthreads();
}

DI void ph_prologue(const Ctx& cx, const Params& p, float* lds) {
    const int tid = cx.tid, gtid = cx.bid * NTHR + tid, gsz = cx.nblk * NTHR;
    for (int i = tid; i < 17 * 1024; i += NTHR) { const int j = i >> 10, k = i & 1023; const float v = (j < 16) ? p.c[j * 1024 + k] : p.c_ctx[k]; lds[i] = siluf(v); }
    __syncthreads();
    for (int idx = gtid; idx < 4 * 6144; idx += gsz) {
        const int l = idx / 6144, n = idx % 6144;
        const float* w = p.mod_w + (size_t)l * 1024 * 6144 + n;
        float acc[17]; const float b0 = p.mod_b[l * 6144 + n];
#pragma unroll
        for (int j = 0; j < 17; ++j) acc[j] = b0;
        for (int k = 0; k < 1024; ++k) {
            const float wv = w[(size_t)k * 6144];
#pragma unroll
            for (int j = 0; j < 17; ++j) acc[j] += lds[j * 1024 + k] * wv;
        }
#pragma unroll
        for (int j = 0; j < 17; ++j) p.mod[((size_t)l * 17 + j) * 6144 + n] = acc[j];
    }
    for (int i = gtid; i < 2048 * 4096; i += gsz) {
        const int f = i >> 12, k = i & 4095, t = k & 2047, m = (f * t) & 2047; const float a = (float)m * (1.f / 1024.f);
        p.dftl[i] = f2bf((k < 2048) ? cospif(a) : sinpif(a));
    }
    for (int i = gtid; i < 256 * 512; i += gsz) {
        const int f = i >> 9, k = i & 511, t = k & 255, m = (f * t) & 255; const float a = (float)m * (1.f / 128.f);
        p.dftc[i] = f2bf((k < 256) ? cospif(a) : sinpif(a));
    }
    for (int i = gtid; i < 1024; i += gsz) p.H[(size_t)NT * 1024 + i] = 0;
    __syncthreads();
}

DI float pick4(float a0, float a1, float a2, float a3, int i) { return i == 0 ? a0 : (i == 1 ? a1 : (i == 2 ? a2 : a3)); }
template <bool COMBINE, bool NORM, bool ROUTER>
DI void ph_norm(const Ctx& cx, const Params& p, float* lds, int nrows, const float* xin_lat, const float* xin_ctx, const float* gain, const float* modl, int sh_idx, int sc_idx,
                const float* modprev, int layer) {
    const int tid = cx.tid, wid = tid >> 6, lane = tid & 63;
    float* rw = lds;
    float* scr = lds + 16 * 1024;
    int* lcnt = (int*)(lds + 16 * 1024 + 256); int* lbase = lcnt + 16; int* rlist = lcnt + 32;
    int nlist = 0;
    if (ROUTER) {
        for (int i = tid; i < 16 * 1024; i += NTHR) { const int e = i >> 10, col = i & 1023; rw[i] = p.router_w[col * 16 + e]; }
        if (tid < 16) lcnt[tid] = 0;
        __syncthreads();
    }
    for (int row = cx.bid * 8 + wid; row < nrows; row += cx.nblk * 8) {
        const bool lat = row < NLAT; const int j = lat ? (row >> 11) : 16;
        const float* xr = lat ? xin_lat + (size_t)row * 1024 : xin_ctx + (size_t)(row - NLAT) * 1024;
        float4 xv[4];
#pragma unroll
        for (int i = 0; i < 4; ++i) xv[i] = *(const float4*)(xr + i * 256 + lane * 4);
        if (COMBINE) {
            const float* g2 = modprev + (size_t)j * 6144 + 5 * 1024;
            float* xo = lat ? p.out + (size_t)row * 1024 : p.ctxs + (size_t)(row - NLAT) * 1024;
#pragma unroll
            for (int i = 0; i < 4; ++i) {
                const int col = i * 256 + lane * 4;
                const float4 gv = *(const float4*)(g2 + col);
                float s0 = 0.f, s1 = 0.f, s2 = 0.f, s3 = 0.f;
#pragma unroll
                for (int s = 0; s < 3; ++s) { const uint2 u = *(const uint2*)(p.Y + ((size_t)s * NT + row) * 1024 + col); s0 += bflo(u.x); s1 += bfhi(u.x); s2 += bflo(u.y); s3 += bfhi(u.y); }
                xv[i].x += gv.x * s0; xv[i].y += gv.y * s1; xv[i].z += gv.z * s2; xv[i].w += gv.w * s3;
                *(float4*)(xo + col) = xv[i];
            }
        }
        if (NORM) {
            float ss = 0.f;
#pragma unroll
            for (int i = 0; i < 4; ++i) ss += xv[i].x * xv[i].x + xv[i].y * xv[i].y + xv[i].z * xv[i].z + xv[i].w * xv[i].w;
            ss = wave_sum(ss);
            const float rstd = rsqrtf(ss * (1.f / 1024.f) + 1e-6f);
            const float* shp = modl + (size_t)j * 6144 + sh_idx * 1024; const float* scp = modl + (size_t)j * 6144 + sc_idx * 1024;
            float4 hv[4];
#pragma unroll
            for (int i = 0; i < 4; ++i) {
                const int col = i * 256 + lane * 4;
                const float4 g = *(const float4*)(gain + col), sh = *(const float4*)(shp + col), sc = *(const float4*)(scp + col);
                hv[i].x = xv[i].x * rstd * g.x * (1.f + sc.x) + sh.x; hv[i].y = xv[i].y * rstd * g.y * (1.f + sc.y) + sh.y;
                hv[i].z = xv[i].z * rstd * g.z * (1.f + sc.z) + sh.z; hv[i].w = xv[i].w * rstd * g.w * (1.f + sc.w) + sh.w;
                uint2 u; u.x = pack2(hv[i].x, hv[i].y); u.y = pack2(hv[i].z, hv[i].w);
                *(uint2*)(p.H + (size_t)row * 1024 + col) = u;
            }
            if (ROUTER) {
                float part[16];
#pragma unroll
                for (int e = 0; e < 16; ++e) {
                    float a = 0.f;
#pragma unroll
                    for (int i = 0; i < 4; ++i) { const float4 w = *(const float4*)(rw + e * 1024 + i * 256 + lane * 4); a += hv[i].x * w.x + hv[i].y * w.y + hv[i].z * w.z + hv[i].w * w.w; }
                    part[e] = wave_sum(a);
                }
                float* my = scr + wid * 32;
#pragma unroll
                for (int e = 0; e < 16; ++e) if (lane == e) { const float sg = sigm(part[e]); my[e] = sg; my[16 + e] = sg + p.router_b[e]; }
                __builtin_amdgcn_wave_barrier();
                if (lane == 0) {
                    float best = -3.0e38f; int be1 = 0, be2 = 1;
                    for (int g = 0; g < 4; ++g) {
                        const float v0 = my[16 + 4 * g], v1 = my[16 + 4 * g + 1], v2 = my[16 + 4 * g + 2], v3 = my[16 + 4 * g + 3];
                        int i1 = 0; float m1 = v0;
                        if (v1 > m1) { m1 = v1; i1 = 1; } if (v2 > m1) { m1 = v2; i1 = 2; } if (v3 > m1) { m1 = v3; i1 = 3; }
                        int i2 = -1; float m2 = -3.0e38f;
                        if (i1 != 0 && v0 > m2) { m2 = v0; i2 = 0; } if (i1 != 1 && v1 > m2) { m2 = v1; i2 = 1; }
                        if (i1 != 2 && v2 > m2) { m2 = v2; i2 = 2; } if (i1 != 3 && v3 > m2) { m2 = v3; i2 = 3; }
                        const float gs = m1 + m2;
                        if (gs > best) { best = gs; be1 = 4 * g + i1; be2 = 4 * g + i2; }
                    }
                    const float bs1 = my[be1], bs2 = my[be2];
                    const float inv = 1.f / (bs1 + bs2);
                    const int p1 = atomicAdd(&lcnt[be1], 1), p2 = atomicAdd(&lcnt[be2], 1);
                    int* ent = rlist + (wid * 24 + nlist) * 4;
                    ent[0] = row; ent[1] = be1 | (be2 << 8); ent[2] = p1; ent[3] = p2;
                    p.tokw[row * 2] = bs1 * inv; p.tokw[row * 2 + 1] = bs2 * inv;
                }
                ++nlist;
                __builtin_amdgcn_wave_barrier();
            }
        }
    }
    if (ROUTER) {
        __syncthreads();
        if (tid < 16) lbase[tid] = atomicAdd(p.cnt + (layer * 16 + tid) * 64, lcnt[tid]);
        __syncthreads();
        for (int k = lane; k < nlist; k += 64) {
            const int* ent = rlist + (wid * 24 + k) * 4; const int row = ent[0], be1 = ent[1] & 255, be2 = ent[1] >> 8;
            p.slot[(size_t)be1 * NT + lbase[be1] + ent[2]] = row * 2; p.slot[(size_t)be2 * NT + lbase[be2] + ent[3]] = row * 2 + 1;
        }
    }
    (void)scr;
    __syncthreads();
}

DI void ph_win(const Ctx& cx, const Params& p, float* lds, int j) {
    const float* W = p.w_in + (size_t)j * 1024 * INC;
    ngemm<false>(cx, lds, 1, NT, INC, 1024,
        [&](int, int m) { return p.H + (size_t)m * 1024; },
        [&](int, int k) { return W + (size_t)k * INC; }, [&](int, int) { return (const float*)nullptr; },
        [&](int, int m, int n, float v, float) { p.P[(size_t)m * PLD + n] = f2bf(v); });
}
DI void ph_prepB(const Ctx& cx, const Params& p, int j) {
    const int tid = cx.tid, wid = tid >> 6, lane = tid & 63;
    for (int row = cx.bid * 8 + wid; row < NT; row += cx.nblk * 8) {
        const bf16_t* pr = p.P + (size_t)row * PLD + ACOLS;
        const uint2 uq = *(const uint2*)(pr + lane * 4); const unsigned ukv = *(const unsigned*)(pr + 256 + lane * 2);
        const float q0 = bflo(uq.x), q1 = bfhi(uq.x), q2 = bflo(uq.y), q3 = bfhi(uq.y), k0 = bflo(ukv), k1 = bfhi(ukv);
        const float sq = wave_sum(q0 * q0 + q1 * q1 + q2 * q2 + q3 * q3), sk = wave_sum(k0 * k0 + k1 * k1);
        const float rq = rsqrtf(sq * (1.f / 256.f) + 1e-6f), rk = rsqrtf(sk * (1.f / 128.f) + 1e-6f);
        const float* gq = p.b_q_norm + j * 256 + lane * 4; const float* gk = p.b_kv_norm + j * 128 + lane * 2;
        uint2 o; o.x = pack2(q0 * rq * gq[0], q1 * rq * gq[1]); o.y = pack2(q2 * rq * gq[2], q3 * rq * gq[3]);
        bf16_t* qn = p.QN + (size_t)row * 512;
        *(uint2*)(qn + lane * 4) = o;
        *(unsigned*)(qn + 256 + lane * 2) = pack2(k0 * rk * gk[0], k1 * rk * gk[1]);
        *(unsigned*)(qn + 384 + lane * 2) = 0u;
    }
}
DI void ph_qkvup(const Ctx& cx, const Params& p, float* lds, int j, int mq) {
    const float* Wq = p.b_w_q_up + (size_t)j * 256 * 768; const float* Wkv = p.b_w_kv_up + (size_t)j * 128 * 1024;
    ngemm<false>(cx, lds, 1, mq, 768, 256,
        [&](int, int m) { return p.QN + (size_t)m * 512; },
        [&](int, int k) { return Wq + (size_t)k * 768; }, [&](int, int) { return (const float*)nullptr; },
        [&](int, int m, int n, float v, float) { p.Qraw[(size_t)m * 768 + n] = f2bf(v); });
    ngemm<false>(cx, lds, 1, NT, 1024, 128,
        [&](int, int m) { return p.QN + (size_t)m * 512 + 256; },
        [&](int, int k) { return Wkv + (size_t)k * 1024; }, [&](int, int) { return (const float*)nullptr; },
        [&](int, int m, int n, float v, float) { p.KVraw[(size_t)m * 1024 + n] = f2bf(v); });
}
DI void unpack8(const uint4 u, float* d) { d[0] = bflo(u.x); d[1] = bfhi(u.x); d[2] = bflo(u.y); d[3] = bfhi(u.y); d[4] = bflo(u.z); d[5] = bfhi(u.z); d[6] = bflo(u.w); d[7] = bfhi(u.w); }
DI uint4 pack8(const float* d, float scl) { uint4 u; u.x = pack2(d[0] * scl, d[1] * scl); u.y = pack2(d[2] * scl, d[3] * scl); u.z = pack2(d[4] * scl, d[5] * scl); u.w = pack2(d[6] * scl, d[7] * scl); return u; }
DI float ssq8(const uint4 u) { float d[8]; unpack8(u, d); float s = 0.f;
#pragma unroll
    for (int i = 0; i < 8; ++i) s += d[i] * d[i];
    return s; }
DI void norm_rope_store(const uint4 (&raw)[12], const float* gain, int t, bool lat, float scl, bf16_t* dst) {
    float ss = 0.f;
#pragma unroll
    for (int i = 0; i < 12; ++i) ss += ssq8(raw[i]);
    const float r = rsqrtf(ss * (1.f / 96.f) + 1e-6f);
#pragma unroll
    for (int i = 0; i < 8; ++i) { float d[8]; unpack8(raw[i], d);
#pragma unroll
        for (int c = 0; c < 8; ++c) d[c] = d[c] * r * gain[i * 8 + c];
        *(uint4*)(dst + i * 8) = pack8(d, scl); }
    const float invf[8] = {1.f, 0.316227766016838f, 0.1f, 0.0316227766016838f, 0.01f, 0.00316227766016838f, 0.001f, 0.000316227766016838f};
    const float ri = (float)(t >> 6), ci = (float)(t & 63);
#pragma unroll
    for (int half = 0; half < 2; ++half) {
        float x1[8], x2[8], o1[8], o2[8]; unpack8(raw[8 + half], x1); unpack8(raw[10 + half], x2);
#pragma unroll
        for (int c = 0; c < 8; ++c) {
            const float ang = (half == 0 ? ri : ci) * invf[c];
            const float cs = lat ? __cosf(ang) : 1.f, sn = lat ? __sinf(ang) : 0.f;
            const float a = x1[c] * r * gain[64 + half * 8 + c], b = x2[c] * r * gain[80 + half * 8 + c];
            o1[c] = a * cs - b * sn; o2[c] = b * cs + a * sn;
        }
        *(uint4*)(dst + 64 + half * 8) = pack8(o1, scl); *(uint4*)(dst + 80 + half * 8) = pack8(o2, scl);
    }
}
DI void ph_finalize(const Ctx& cx, const Params& p, int j, int mq) {
    const int gtid = cx.bid * NTHR + cx.tid, gsz = cx.nblk * NTHR;
    const float* qg = p.b_q_gain + j * 96; const float* kg = p.b_k_gain + j * 96;
    for (int idx = gtid; idx < 8 * mq; idx += gsz) {
        const int h = idx / mq, row = idx % mq;
        const bool lat = row < NLAT; const int t = lat ? (row & 2047) : ((row - NLAT) & 255);
        bf16_t* qp = p.Qraw + (size_t)row * 768 + h * 96;
        uint4 raw[12];
#pragma unroll
        for (int i = 0; i < 12; ++i) raw[i] = *(const uint4*)(qp + i * 8);
        norm_rope_store(raw, qg, t, lat, (OPT >= 5) ? 0.10206207261596577f * 1.4426950408889634f : 0.10206207261596577f, qp);
    }
    for (int idx = gtid; idx < 8 * NT; idx += gsz) {
        const int h = idx / NT, row = idx % NT;
        const bool lat = row < NLAT; const int b = lat ? (row >> 11) : ((row - NLAT) >> 8); const int t = lat ? (row & 2047) : ((row - NLAT) & 255);
        const int key = lat ? 256 + t : t;
        const bf16_t* kvp = p.KVraw + (size_t)row * 1024 + h * 128; const bf16_t* krp = p.P + (size_t)row * PLD + ACOLS + 384;
        uint4 raw[12];
#pragma unroll
        for (int i = 0; i < 8; ++i) raw[i] = *(const uint4*)(kvp + i * 8);
#pragma unroll
        for (int i = 0; i < 4; ++i) raw[8 + i] = *(const uint4*)(krp + i * 8);
        norm_rope_store(raw, kg, t, lat, 1.f, p.Kf + ((size_t)(b * 8 + h) * 2304 + key) * 96);
    }
    for (int idx = gtid; idx < 8 * NT; idx += gsz) {
        const int h = idx / NT, row = idx % NT;
        const bool lat = row < NLAT; const int b = lat ? (row >> 11) : ((row - NLAT) >> 8); const int t = lat ? (row & 2047) : ((row - NLAT) & 255);
        const int key = lat ? 256 + t : t;
        const bf16_t* vp = p.KVraw + (size_t)row * 1024 + h * 128 + 64;
        bf16_t* vo = p.Vt + (size_t)(b * 8 + h) * 64 * 2304 + key;
#pragma unroll 1
        for (int i = 0; i < 8; ++i) { const uint4 u = *(const uint4*)(vp + i * 8);
            vo[0] = (bf16_t)(u.x & 0xffff); vo[2304] = (bf16_t)(u.x >> 16); vo[2 * 2304] = (bf16_t)(u.y & 0xffff); vo[3 * 2304] = (bf16_t)(u.y >> 16);
            vo[4 * 2304] = (bf16_t)(u.z & 0xffff); vo[5 * 2304] = (bf16_t)(u.z >> 16); vo[6 * 2304] = (bf16_t)(u.w & 0xffff); vo[7 * 2304] = (bf16_t)(u.w >> 16);
            vo += 8 * 2304; }
    }
}
DI void ph_attn(const Ctx& cx, const Params& p, bool with_ctx) {
    const int gtid = cx.bid * NTHR + cx.tid, gsz = cx.nblk * NTHR;
    const int total = NLAT * 8 + (with_ctx ? NCTX * 8 : 0);
    for (int idx = gtid; idx < total; idx += gsz) {
        int b, h, row, nkeys;
        if (idx < NLAT * 8) { b = idx >> 14; h = (idx >> 11) & 7; row = b * 2048 + (idx & 2047); nkeys = 2304; }
        else { const int i2 = idx - NLAT * 8; b = i2 >> 11; h = (i2 >> 8) & 7; row = NLAT + b * 256 + (i2 & 255); nkeys = 256; }
        const bf16_t* qp = p.Qraw + (size_t)row * 768 + h * 96;
        const bf16_t* Kb = p.Kf + (size_t)(b * 8 + h) * 2304 * 96; const bf16_t* Vb = p.Vt + (size_t)(b * 8 + h) * 64 * 2304;
        float q[96];
#pragma unroll
        for (int i = 0; i < 12; ++i) { const uint4 u = *(const uint4*)(qp + i * 8); q[i * 8] = bflo(u.x); q[i * 8 + 1] = bfhi(u.x); q[i * 8 + 2] = bflo(u.y); q[i * 8 + 3] = bfhi(u.y);
            q[i * 8 + 4] = bflo(u.z); q[i * 8 + 5] = bfhi(u.z); q[i * 8 + 6] = bflo(u.w); q[i * 8 + 7] = bfhi(u.w); }
        float acc[64];
#pragma unroll
        for (int i = 0; i < 64; ++i) acc[i] = 0.f;
        float mx = -3.0e38f, l = 0.f;
        for (int key0 = 0; key0 < nkeys; key0 += 8) {
            float s[8];
#pragma unroll
            for (int kk = 0; kk < 8; ++kk) {
                const uint4* kp = (const uint4*)(Kb + (size_t)(key0 + kk) * 96); float a = 0.f;
#pragma unroll
                for (int i = 0; i < 12; ++i) { const uint4 u = kp[i]; a += q[i * 8] * bflo(u.x) + q[i * 8 + 1] * bfhi(u.x) + q[i * 8 + 2] * bflo(u.y) + q[i * 8 + 3] * bfhi(u.y)
                    + q[i * 8 + 4] * bflo(u.z) + q[i * 8 + 5] * bfhi(u.z) + q[i * 8 + 6] * bflo(u.w) + q[i * 8 + 7] * bfhi(u.w); }
                s[kk] = a;
            }
            float cm = s[0];
#pragma unroll
            for (int kk = 1; kk < 8; ++kk) cm = fmaxf(cm, s[kk]);
            const float mn = fmaxf(mx, cm), alpha = expf(mx - mn);
            float ps = 0.f;
#pragma unroll
            for (int kk = 0; kk < 8; ++kk) { s[kk] = expf(s[kk] - mn); ps += s[kk]; }
            l = l * alpha + ps; mx = mn;
#pragma unroll
            for (int dv = 0; dv < 64; ++dv) {
                const uint4 u = *(const uint4*)(Vb + (size_t)dv * 2304 + key0);
                acc[dv] = acc[dv] * alpha + s[0] * bflo(u.x) + s[1] * bfhi(u.x) + s[2] * bflo(u.y) + s[3] * bfhi(u.y) + s[4] * bflo(u.z) + s[5] * bfhi(u.z) + s[6] * bflo(u.w) + s[7] * bfhi(u.w);
            }
        }
        const float il = 1.f / l;
        bf16_t* o = p.H + (size_t)row * 1024 + 512 + h * 64;
#pragma unroll
        for (int i = 0; i < 8; ++i) { uint4 u; u.x = pack2(acc[i * 8] * il, acc[i * 8 + 1] * il); u.y = pack2(acc[i * 8 + 2] * il, acc[i * 8 + 3] * il);
            u.z = pack2(acc[i * 8 + 4] * il, acc[i * 8 + 5] * il); u.w = pack2(acc[i * 8 + 6] * il, acc[i * 8 + 7] * il); *(uint4*)(o + i * 8) = u; }
    }
}
DI float shiftp(const bf16_t* P, int row, int t, int T, int col, float mu) {
    const float c = bf2f(P[(size_t)row * PLD + col]);
    const float pv = (t > 0) ? bf2f(P[(size_t)(row - 1) * PLD + col]) : 0.f;
    const float nx = (t < T - 1) ? bf2f(P[(size_t)(row + 1) * PLD + col]) : 0.f;
    return c + mu * (0.5f * (pv + nx) - c);
}
DI void ph_prepLR(const Ctx& cx, const Params& p, int j) {
    const int gtid = cx.bid * NTHR + cx.tid, gsz = cx.nblk * NTHR;
    const float* mu = p.a_mu + j * ACOLS + 1536;
    for (int idx = gtid; idx < NT * 384; idx += gsz) {
        const int row = idx / 384, col = idx % 384;
        const bool lat = row < NLAT; const int t = lat ? (row & 2047) : ((row - NLAT) & 255); const int T = lat ? 2048 : 256;
        float v = shiftp(p.P, row, t, T, 1536 + col, mu[col]);
        if (col < 128) v = tanhf(v); else if (col >= 256) v = sigm(v);
        p.LR[(size_t)row * 384 + col] = f2bf(v);
    }
}
DI void ph_wag(const Ctx& cx, const Params& p, float* lds, int j) {
    for (int d = 0; d < 2; ++d) {
        const float* W2 = p.a_w2 + (size_t)(j * 2 + d) * 64 * 512; const float* w0 = p.a_w0 + (j * 2 + d) * 512;
        ngemm<false>(cx, lds, 1, NT, 512, 64,
            [&](int, int m) { return p.LR + (size_t)m * 384 + d * 64; },
            [&](int, int k) { return W2 + (size_t)k * 512; }, [&](int, int) { return (const float*)nullptr; },
            [&](int, int m, int n, float v, float) { const float z = -0.606531f * sigm(w0[n] + v); p.WAG[(size_t)m * WLD + d * 512 + n] = f2bf(-expm1f(z)); });
        const float* A2 = p.a_a2 + (size_t)(j * 2 + d) * 64 * 512; const float* a0 = p.a_a0 + (j * 2 + d) * 512;
        ngemm<false>(cx, lds, 1, NT, 512, 64,
            [&](int, int m) { return p.LR + (size_t)m * 384 + 128 + d * 64; },
            [&](int, int k) { return A2 + (size_t)k * 512; }, [&](int, int) { return (const float*)nullptr; },
            [&](int, int m, int n, float v, float) { p.WAG[(size_t)m * WLD + 1024 + d * 512 + n] = f2bf(sigm(a0[n] + v)); });
    }
    const float* G2 = p.a_g2 + (size_t)j * 128 * 512;
    ngemm<false>(cx, lds, 1, NT, 512, 128,
        [&](int, int m) { return p.LR + (size_t)m * 384 + 256; },
        [&](int, int k) { return G2 + (size_t)k * 512; }, [&](int, int) { return (const float*)nullptr; },
        [&](int, int m, int n, float v, float) { p.WAG[(size_t)m * WLD + 2048 + n] = f2bf(v); });
}
DI void ph_scan(const Ctx& cx, const Params& p, float* lds, int j) {
    const int tid = cx.tid, lane = tid & 63;
    if (tid < 64) {
        for (int item = cx.bid; item < 256; item += cx.nblk) {
            const int b = item >> 4, h = (item >> 1) & 7, dir = item & 1, hc = h * 64 + lane;
            float S[64];
#pragma unroll
            for (int k = 0; k < 64; ++k) S[k] = 0.f;
            const float kkc = p.a_k_k[j * 512 + hc], kac = p.a_k_a[j * 512 + hc];
            const float mur = p.a_mu[j * ACOLS + hc], muk = p.a_mu[j * ACOLS + 512 + hc], muv = p.a_mu[j * ACOLS + 1024 + hc];
            bf16_t* yout = dir ? p.YB : p.YF;
            for (int step = 0; step < 2304; ++step) {
                const bool cp = step < 256; const int tt = cp ? step : step - 256, T = cp ? 256 : 2048, t = dir ? (T - 1 - tt) : tt;
                const int row = cp ? NLAT + b * 256 + t : b * 2048 + t;
                const float R = shiftp(p.P, row, t, T, hc, mur), K = shiftp(p.P, row, t, T, 512 + hc, muk), V = shiftp(p.P, row, t, T, 1024 + hc, muv);
                const float w = 1.f - bf2f(p.WAG[(size_t)row * WLD + dir * 512 + hc]), a = bf2f(p.WAG[(size_t)row * WLD + 1024 + dir * 512 + hc]);
                const float kkv = K * kkc, ssq = wave_sum(kkv * kkv), kk = kkv * rsqrtf(ssq + 1e-12f);
                const float kd = K * (1.f + (a - 1.f) * kac), bd = kk * a;
                lds[lane] = -kk; lds[64 + lane] = w; lds[128 + lane] = bd; lds[192 + lane] = kd; lds[256 + lane] = R;
                __builtin_amdgcn_wave_barrier();
                float sa = 0.f;
#pragma unroll
                for (int k4 = 0; k4 < 16; ++k4) { const float4 v = *(const float4*)(lds + k4 * 4); sa += S[k4 * 4] * v.x + S[k4 * 4 + 1] * v.y + S[k4 * 4 + 2] * v.z + S[k4 * 4 + 3] * v.w; }
                float y = 0.f;
#pragma unroll
                for (int k4 = 0; k4 < 16; ++k4) {
                    const float4 wv = *(const float4*)(lds + 64 + k4 * 4), bv = *(const float4*)(lds + 128 + k4 * 4), kv = *(const float4*)(lds + 192 + k4 * 4), rv = *(const float4*)(lds + 256 + k4 * 4);
                    S[k4 * 4] = S[k4 * 4] * wv.x + sa * bv.x + V * kv.x; S[k4 * 4 + 1] = S[k4 * 4 + 1] * wv.y + sa * bv.y + V * kv.y;
                    S[k4 * 4 + 2] = S[k4 * 4 + 2] * wv.z + sa * bv.z + V * kv.z; S[k4 * 4 + 3] = S[k4 * 4 + 3] * wv.w + sa * bv.w + V * kv.w;
                    y += S[k4 * 4] * rv.x + S[k4 * 4 + 1] * rv.y + S[k4 * 4 + 2] * rv.z + S[k4 * 4 + 3] * rv.w;
                }
                __builtin_amdgcn_wave_barrier();
                yout[(size_t)row * 512 + hc] = f2bf(y);
            }
        }
    }
    __syncthreads();
}
DI void ph_post(const Ctx& cx, const Params& p, int j, int nrows) {
    const int gtid = cx.bid * NTHR + cx.tid, gsz = cx.nblk * NTHR;
    for (int idx = gtid; idx < 8 * nrows; idx += gsz) {
        const int h = idx / nrows, row = idx % nrows;
        const bool lat = row < NLAT; const int t = lat ? (row & 2047) : ((row - NLAT) & 255); const int T = lat ? 2048 : 256;
        float sum = 0.f, sb = 0.f;
#pragma unroll 8
        for (int n = 0; n < 64; ++n) {
            const int hc = h * 64 + n;
            const float yy = bf2f(p.YF[(size_t)row * 512 + hc]) + bf2f(p.YB[(size_t)row * 512 + hc]);
            sum += yy;
            const float R = shiftp(p.P, row, t, T, hc, p.a_mu[j * ACOLS + hc]), K = shiftp(p.P, row, t, T, 512 + hc, p.a_mu[j * ACOLS + 512 + hc]);
            const float af = bf2f(p.WAG[(size_t)row * WLD + 1024 + hc]), ab = bf2f(p.WAG[(size_t)row * WLD + 1536 + hc]);
            const float ka = p.a_k_a[j * 512 + hc], rk = p.a_r_k[j * 512 + hc];
            sb += R * rk * (K * (1.f + (af - 1.f) * ka) + K * (1.f + (ab - 1.f) * ka));
        }
        const float mean = sum * (1.f / 64.f); float var = 0.f;
#pragma unroll 8
        for (int n = 0; n < 64; ++n) { const int hc = h * 64 + n; const float yy = bf2f(p.YF[(size_t)row * 512 + hc]) + bf2f(p.YB[(size_t)row * 512 + hc]); var += (yy - mean) * (yy - mean); }
        const float rstd = rsqrtf(var * (1.f / 64.f) + 64e-5f);
#pragma unroll 8
        for (int n = 0; n < 64; ++n) {
            const int hc = h * 64 + n;
            const float yy = bf2f(p.YF[(size_t)row * 512 + hc]) + bf2f(p.YB[(size_t)row * 512 + hc]);
            const float V = shiftp(p.P, row, t, T, 1024 + hc, p.a_mu[j * ACOLS + 1024 + hc]);
            const float g = bf2f(p.WAG[(size_t)row * WLD + 2048 + hc]);
            const float o = ((yy - mean) * rstd * p.a_ln_w[j * 512 + hc] + p.a_ln_b[j * 512 + hc] + sb * V) * g;
            p.H[(size_t)row * 1024 + hc] = f2bf(o);
        }
    }
}
DI void ph_wout(const Ctx& cx, const Params& p, float* lds, const bf16_t* A, const float* W, int nrows, const float* xin_lat, const float* xin_ctx, const float* modl) {
    ngemm<false>(cx, lds, 1, nrows, 1024, 1024,
        [&](int, int m) { return A + (size_t)m * 1024; },
        [&](int, int k) { return W + (size_t)k * 1024; }, [&](int, int) { return (const float*)nullptr; },
        [&](int, int m, int n, float v, float) {
            const bool lat = m < NLAT; const int jj = lat ? (m >> 11) : 16; const float g1 = modl[(size_t)jj * 6144 + 2 * 1024 + n];
            if (lat) p.out[(size_t)m * 1024 + n] = xin_lat[(size_t)m * 1024 + n] + g1 * v;
            else p.ctxs[(size_t)(m - NLAT) * 1024 + n] = xin_ctx[(size_t)(m - NLAT) * 1024 + n] + g1 * v; });
}

DI void ph_chdft(const Ctx& cx, const Params& p, float* lds, int nrows) {
    const int tid = cx.tid, gtid = cx.bid * NTHR + tid, gsz = cx.nblk * NTHR;
    for (int i = tid; i < 128; i += NTHR) { lds[i] = cospif((float)i * (1.f / 64.f)); lds[128 + i] = sinpif((float)i * (1.f / 64.f)); }
    __syncthreads();
    for (int idx = gtid; idx < nrows * 1024; idx += gsz) {
        const int row = idx >> 10, col = idx & 1023, grp = col >> 7, g = col & 127;
        const bf16_t* hp = p.H + (size_t)row * 1024 + grp * 128;
        float gr = 0.f, gi = 0.f;
        for (int c = 0; c < 128; ++c) { const float xv = bf2f(hp[c]); const int m = (c * g) & 127; gr += xv * lds[m]; gi -= xv * lds[128 + m]; }
        p.G[(size_t)row * 2048 + col] = gr; p.G[(size_t)row * 2048 + 1024 + col] = gi;
    }
    __syncthreads();
}
DI void ph_posdft(const Ctx& cx, const Params& p, float* lds, bool with_ctx) {
    ngemm<false>(cx, lds, 16, 2048, 1024, 4096,
        [&](int, int m) { return p.dftl + (size_t)m * 4096; },
        [&](int bz, int k) { return (k < 2048) ? p.G + (size_t)(bz * 2048 + k) * 2048 : p.G + (size_t)(bz * 2048 + k - 2048) * 2048 + 1024; }, [&](int, int) { return (const float*)nullptr; },
        [&](int bz, int m, int n, float v, float) { p.F[(size_t)(bz * 2048 + m) * 1024 + n] = f2bf(v * (1.f / 512.f)); });
    if (with_ctx)
        ngemm<false>(cx, lds, 16, 256, 1024, 512,
            [&](int, int m) { return p.dftc + (size_t)m * 512; },
            [&](int bz, int k) { return (k < 256) ? p.G + (size_t)(NLAT + bz * 256 + k) * 2048 : p.G + (size_t)(NLAT + bz * 256 + k - 256) * 2048 + 1024; }, [&](int, int) { return (const float*)nullptr; },
            [&](int bz, int m, int n, float v, float) { p.F[(size_t)(NLAT + bz * 256 + m) * 1024 + n] = f2bf(v * 0.0055242717280199f); });
}

DI void ph_moe_up(const Ctx& cx, const Params& p, float* lds, int layer, int nrows) {
    for (int e = 0; e < 17; ++e) {
        const int M = (e < 16) ? __builtin_amdgcn_readfirstlane(p.cnt[(layer * 16 + e) * 64]) : nrows;
        const float* Wg = (e < 16) ? p.moe_w_gate + ((size_t)layer * 16 + e) * 1024 * 512 : p.sh_gate + (size_t)layer * 1024 * 512;
        const float* Wu = (e < 16) ? p.moe_w_up + ((size_t)layer * 16 + e) * 1024 * 512 : p.sh_up + (size_t)layer * 1024 * 512;
        const int* sl = p.slot + (size_t)(e & 15) * NT;
        ngemm<true>(cx, lds, 1, M, 512, 1024,
            [&](int, int m) { const int tok = (e < 16) ? (sl[m] >> 1) : m; return p.H + (size_t)tok * 1024; },
            [&](int, int k) { return Wg + (size_t)k * 512; }, [&](int, int k) { return Wu + (size_t)k * 512; },
            [&](int, int m, int n, float g, float u) { const int s = (e < 16) ? sl[m] : 0; const int tok = (e < 16) ? (s >> 1) : m, slab = (e < 16) ? (s & 1) : 2;
                p.ACT[((size_t)slab * NT + tok) * 512 + n] = f2bf(siluf(g) * u); });
    }
}
DI void ph_moe_down(const Ctx& cx, const Params& p, float* lds, int layer, int nrows) {
    for (int e = 0; e < 17; ++e) {
        const int M = (e < 16) ? __builtin_amdgcn_readfirstlane(p.cnt[(layer * 16 + e) * 64]) : nrows;
        const float* Wd = (e < 16) ? p.moe_w_down + ((size_t)layer * 16 + e) * 512 * 1024 : p.sh_down + (size_t)layer * 512 * 1024;
        const int* sl = p.slot + (size_t)(e & 15) * NT;
        ngemm<false>(cx, lds, 1, M, 1024, 512,
            [&](int, int m) { const int s = (e < 16) ? sl[m] : 0; const int tok = (e < 16) ? (s >> 1) : m, slab = (e < 16) ? (s & 1) : 2; return p.ACT + ((size_t)slab * NT + tok) * 512; },
            [&](int, int k) { return Wd + (size_t)k * 1024; }, [&](int, int) { return (const float*)nullptr; },
            [&](int, int m, int n, float v, float) { const int s = (e < 16) ? sl[m] : 0; const int tok = (e < 16) ? (s >> 1) : m, slab = (e < 16) ? (s & 1) : 2;
                const float w = (e < 16) ? p.tokw[s] : 1.f; p.Y[((size_t)slab * NT + tok) * 1024 + n] = f2bf(w * v); });
    }
}

namespace mm {
typedef short bf16x8 __attribute__((ext_vector_type(8)));
typedef float f32x4 __attribute__((ext_vector_type(4)));
typedef unsigned u32x4 __attribute__((ext_vector_type(4)));
constexpr int BM = 256, BK = 64, HALF = 128, HTB = HALF * BK * 2, STAGE_BYTES = 8 * HTB;
DI int lds_byte(int r, int c) { const int st = (r >> 4) * 2 + (c >> 5), rr = r & 15, cc = c & 31, ob = rr * 64 + cc * 2; return st * 1024 + (ob ^ (((ob >> 9) & 1) << 5)); }
DI void stage_rc(int b, int& R, int& C) { const int st = b / 1024, sb = b % 1024, swz = sb ^ (((sb >> 9) & 1) << 5); R = (st >> 1) * 16 + swz / 64; C = (st & 1) * 32 + (swz % 64) / 2; }
DI int perm32(int rho) { const int n = rho >> 4, i = rho & 15; return 8 * (i >> 2) + 4 * n + (i & 3); }
DI unsigned cvt_pk_bf16(float lo, float hi) { unsigned r; asm volatile("v_cvt_pk_bf16_f32 %0, %1, %2" : "=v"(r) : "v"(lo), "v"(hi)); return r; }
struct Unit { const char* A; const char* B; int pm, pn, e, m, tb; };
template <class Sched, class Epi>
DI void gemm_phase(LAS unsigned char* lds, const int K, const Sched& S, const Epi& E, const int tid) {
    const int wid = __builtin_amdgcn_readfirstlane(tid >> 6), lane = tid & 63, wr = wid >> 2, wc = wid & 3, fr = lane & 15, fq = lane >> 4;
    const int nt = K / BK;
    int R0, C0, R1, C1; stage_rc(tid * 16, R0, C0); stage_rc(tid * 16 + 8192, R1, C1);
    unsigned voffB[2];
    { const int Rb0 = Epi::PERM ? ((R0 & ~31) + perm32(R0 & 31)) : R0, Rb1 = Epi::PERM ? ((R1 & ~31) + perm32(R1 & 31)) : R1;
      voffB[0] = S.boff(Rb0, C0, K); voffB[1] = S.boff(Rb1, C1, K); }
    const size_t kstep = (size_t)(BK * 2), hstepB = S.hstep_b(K), hstepA = S.hstep_a();
    const unsigned ldsw = (unsigned)wid * 1024u;
    const int aoff = lds_byte(wr * 64 + fr, fq * 8), boff = lds_byte(wc * 32 + fr, fq * 8);
#define MM_SA(b, h) (((b) * 2 + (h)) * HTB)
#define MM_SB(b, h) ((4 + (b) * 2 + (h)) * HTB)
#define MM_STAGE_A(bufoff, gbase, h, offs) do { _Pragma("unroll") for (int _i = 0; _i < 2; ++_i) { \
        if constexpr (Sched::GATHER) __builtin_amdgcn_global_load_lds((const unsigned*)((const char*)(gbase) + (offs)[h][_i]), (LAS unsigned*)(lds + (bufoff) + ldsw + _i * 8192), 16, 0, 0); \
        else __builtin_amdgcn_global_load_lds((const unsigned*)((const char*)(gbase) + (size_t)(h) * hstepA + (offs)[0][_i]), (LAS unsigned*)(lds + (bufoff) + ldsw + _i * 8192), 16, 0, 0); } } while (0)
#define MM_STAGE_B(bufoff, gbase) do { _Pragma("unroll") for (int _i = 0; _i < 2; ++_i) \
        __builtin_amdgcn_global_load_lds((const unsigned*)((const char*)(gbase) + voffB[_i]), (LAS unsigned*)(lds + (bufoff) + ldsw + _i * 8192), 16, 0, 0); } while (0)
#define MM_LDA(dst, b, h) do { _Pragma("unroll") for (int m = 0; m < 4; ++m) _Pragma("unroll") for (int k = 0; k < 2; ++k) dst[m][k] = *(const LAS bf16x8*)(lds + MM_SA(b, h) + aoff + m * 2048 + k * 1024); } while (0)
#define MM_LDB(dst, b, h) do { _Pragma("unroll") for (int n = 0; n < 2; ++n) _Pragma("unroll") for (int k = 0; k < 2; ++k) dst[n][k] = *(const LAS bf16x8*)(lds + MM_SB(b, h) + boff + n * 2048 + k * 1024); } while (0)
#define MM_MMA(ai, bj, At, Bt) do { __builtin_amdgcn_s_setprio(1); _Pragma("unroll") for (int m = 0; m < 4; ++m) _Pragma("unroll") for (int n = 0; n < 2; ++n) _Pragma("unroll") for (int k = 0; k < 2; ++k) \
        acc[ai][bj][m][n] = __builtin_amdgcn_mfma_f32_16x16x32_bf16(Bt[n][k], At[m][k], acc[ai][bj][m][n], 0, 0, 0); __builtin_amdgcn_s_setprio(0); } while (0)
#define MM_WAIT_V(n) asm volatile("s_waitcnt vmcnt(" #n ")" ::: "memory")
#define MM_WAIT_L(n) asm volatile("s_waitcnt lgkmcnt(" #n ")" ::: "memory")
#define MM_BAR __builtin_amdgcn_s_barrier()
#define MM_SCHED __builtin_amdgcn_sched_barrier(0)
    Unit cur, nxt; int ui = 0;
    if (!S.next(0, cur)) return;
    unsigned oa[2][2], on[2][2];
    S.aoff(cur, R0, C0, R1, C1, oa);
    on[0][0] = oa[0][0]; on[0][1] = oa[0][1]; on[1][0] = oa[1][0]; on[1][1] = oa[1][1];
    if constexpr (Sched::TABLE) S.tab_dma(cur, lds + STAGE_BYTES + 1024, tid);
    f32x4 acc[2][2][4][2];
#pragma unroll
    for (int a = 0; a < 2; ++a)
#pragma unroll
        for (int b = 0; b < 2; ++b)
#pragma unroll
            for (int m = 0; m < 4; ++m)
#pragma unroll
                for (int n = 0; n < 2; ++n) acc[a][b][m][n] = (f32x4){0.f, 0.f, 0.f, 0.f};
    bf16x8 At[4][2], B0[2][2], B1[2][2];
    const char* cA = cur.A; const char* cB = cur.B;
    MM_STAGE_B(MM_SB(0, 0), cB); MM_STAGE_A(MM_SA(0, 0), cA, 0, oa); MM_STAGE_B(MM_SB(0, 1), cB + hstepB); MM_STAGE_A(MM_SA(0, 1), cA, 1, oa);
    if (wr == 1) MM_BAR;
    MM_WAIT_V(4); MM_BAR;
    MM_STAGE_B(MM_SB(1, 0), cB + kstep); MM_STAGE_A(MM_SA(1, 0), cA + kstep, 0, oa); MM_STAGE_B(MM_SB(1, 1), cB + hstepB + kstep);
    MM_WAIT_V(6); MM_BAR;
    for (;;) {
        cur.tb = ui % 3;
        const bool has_next = S.next(ui + 1, nxt);
        if constexpr (Sched::TABLE) { if (has_next) S.tab_dma(nxt, lds + STAGE_BYTES + 1024 + ((ui + 1) % 3) * 2048, tid); }
        const char* nA = has_next ? nxt.A : cA; const char* nB = has_next ? nxt.B : cB;
        for (int t = 0; t < nt; t += 2) {
            const bool last = (t == nt - 2);
            if constexpr (Sched::GATHER) { if (last) { if (has_next) S.aoff_lds(nxt, (const LAS int*)(lds + STAGE_BYTES + 1024 + ((ui + 1) % 3) * 2048), R0, C0, R1, C1, on);
                else { on[0][0] = oa[0][0]; on[0][1] = oa[0][1]; on[1][0] = oa[1][0]; on[1][1] = oa[1][1]; } } }
            const char* a1 = cA + (size_t)(t + 1) * kstep;
            const char* a2 = last ? nA : cA + (size_t)(t + 2) * kstep; const char* b2 = last ? nB : cB + (size_t)(t + 2) * kstep;
            const char* a3 = a2 + kstep; const char* b3 = b2 + kstep;
            unsigned o2[2][2];
            if constexpr (Sched::GATHER) { o2[0][0] = last ? on[0][0] : oa[0][0]; o2[0][1] = last ? on[0][1] : oa[0][1]; o2[1][0] = last ? on[1][0] : oa[1][0]; o2[1][1] = last ? on[1][1] : oa[1][1]; }
            else { o2[0][0] = oa[0][0]; o2[0][1] = oa[0][1]; o2[1][0] = oa[1][0]; o2[1][1] = oa[1][1]; }
            MM_LDB(B0, 0, 0); MM_SCHED; MM_LDA(At, 0, 0); MM_STAGE_A(MM_SA(1, 1), a1, 1, oa);
            MM_WAIT_L(8); MM_BAR; MM_WAIT_L(0); MM_MMA(0, 0, At, B0); MM_BAR; MM_SCHED;
            MM_LDB(B1, 0, 1); MM_STAGE_B(MM_SB(0, 0), b2);
            MM_BAR; MM_WAIT_L(0); MM_MMA(0, 1, At, B1); MM_BAR;
            MM_LDA(At, 0, 1); MM_STAGE_A(MM_SA(0, 0), a2, 0, o2);
            MM_BAR; MM_WAIT_L(0); MM_MMA(1, 0, At, B0); MM_BAR; MM_SCHED;
            MM_STAGE_B(MM_SB(0, 1), b2 + hstepB);
            MM_WAIT_V(6); MM_BAR; MM_MMA(1, 1, At, B1); MM_BAR;
            MM_LDB(B0, 1, 0); MM_SCHED; MM_LDA(At, 1, 0); MM_STAGE_A(MM_SA(0, 1), a2, 1, o2);
            MM_WAIT_L(8); MM_BAR; MM_WAIT_L(0); MM_MMA(0, 0, At, B0); MM_BAR; MM_SCHED;
            MM_LDB(B1, 1, 1); MM_STAGE_B(MM_SB(1, 0), b3);
            MM_BAR; MM_WAIT_L(0); MM_MMA(0, 1, At, B1); MM_BAR;
            MM_LDA(At, 1, 1); MM_STAGE_A(MM_SA(1, 0), a3, 0, o2);
            MM_BAR; MM_WAIT_L(0); MM_MMA(1, 0, At, B0); MM_BAR; MM_SCHED;
            MM_STAGE_B(MM_SB(1, 1), b3 + hstepB);
            MM_WAIT_V(6); MM_BAR; MM_MMA(1, 1, At, B1); MM_BAR;
        }
        {
          int tz = tid; asm volatile("" : "+v"(tz)); const int wz = tz >> 6, lz = tz & 63;
          E(acc, cur, wz >> 2, wz & 3, lz & 15, lz >> 4); }
        if (!has_next) break;
#pragma unroll
        for (int a = 0; a < 2; ++a)
#pragma unroll
            for (int b = 0; b < 2; ++b)
#pragma unroll
                for (int m = 0; m < 4; ++m)
#pragma unroll
                    for (int n = 0; n < 2; ++n) acc[a][b][m][n] = (f32x4){0.f, 0.f, 0.f, 0.f};
        cur = nxt; cA = nA; cB = nB; ++ui;
        if constexpr (Sched::GATHER) { oa[0][0] = on[0][0]; oa[0][1] = on[0][1]; oa[1][0] = on[1][0]; oa[1][1] = on[1][1]; }
    }
    MM_WAIT_V(0);
    if (wr == 0) MM_BAR;
    MM_BAR;
#undef MM_SA
#undef MM_SB
#undef MM_STAGE_A
#undef MM_STAGE_B
#undef MM_LDA
#undef MM_LDB
#undef MM_MMA
#undef MM_WAIT_V
#undef MM_WAIT_L
#undef MM_BAR
#undef MM_SCHED
}
struct StaticSched {
    static constexpr bool GATHER = false, TABLE = false;
    const char* A; const char* Bt; int lda, K, nM, nN, nwg, G, c;
    DI size_t hstep_a() const { return (size_t)HALF * lda * 2; }
    DI unsigned boff(int Rb, int C, int Kk) const { return (unsigned)(Rb * Kk + C) * 2u; }
    DI size_t hstep_b(int Kk) const { return (size_t)HALF * Kk * 2; }
    DI void init(const void* A_, const void* Bt_, int M, int N, int K_, int lda_, int G_, int c_) { A = (const char*)A_; Bt = (const char*)Bt_; lda = lda_; K = K_; nM = M / BM; nN = N / BM; nwg = nM * nN; G = G_; c = c_; }
    DI bool next(int i, Unit& u) const {
        const int L = i * G + c; if (L >= nwg) return false;
        int wgid = L; { const int q = nwg / 8, r = nwg % 8, xcd = wgid % 8, off = wgid / 8; wgid = (xcd < r ? xcd * (q + 1) : r * (q + 1) + (xcd - r) * q) + off; }
        const int nig = 8 * nN, gid = wgid / nig, fm = gid * 8, gsz = (nM - fm) < 8 ? (nM - fm) : 8;
        u.pm = fm + ((wgid % nig) % gsz); u.pn = (wgid % nig) / gsz; u.e = 0; u.m = 0;
        u.A = A + (size_t)u.pm * BM * lda * 2; u.B = Bt + (size_t)u.pn * BM * K * 2; return true;
    }
    DI void aoff(const Unit&, int R0, int C0, int R1, int C1, unsigned (&o)[2][2]) const {
        o[0][0] = (unsigned)(R0 * lda + C0) * 2u; o[0][1] = (unsigned)(R1 * lda + C1) * 2u;
        o[1][0] = (unsigned)((HALF + R0) * lda + C0) * 2u; o[1][1] = (unsigned)((HALF + R1) * lda + C1) * 2u;
    }
};
struct BatchSched {
    static constexpr bool GATHER = false, TABLE = false;
    const char* A; const char* Bt; int K, nM, nN, nb, G, c; size_t bstride;
    DI size_t hstep_a() const { return (size_t)HALF * K * 2; }
    DI unsigned boff(int Rb, int C, int Kk) const { return (unsigned)(Rb * Kk + C) * 2u; }
    DI size_t hstep_b(int Kk) const { return (size_t)HALF * Kk * 2; }
    DI void init(const void* A_, const void* Bt_, size_t bstride_bytes, int nb_, int M, int N, int K_, int G_, int c_) { A = (const char*)A_; Bt = (const char*)Bt_; bstride = bstride_bytes; nb = nb_; K = K_; nM = M / BM; nN = N / BM; G = G_; c = c_; }
    DI bool next(int i, Unit& u) const {
        const int L = i * G + c; if (L >= nb * nM * nN) return false;
        const int b = L / (nM * nN), rem = L % (nM * nN); u.pm = rem / nN; u.pn = rem % nN; u.e = b; u.m = 0;
        u.A = A + (size_t)u.pm * BM * K * 2; u.B = Bt + (size_t)b * bstride + (size_t)u.pn * BM * K * 2; return true;
    }
    DI void aoff(const Unit&, int R0, int C0, int R1, int C1, unsigned (&o)[2][2]) const {
        o[0][0] = (unsigned)(R0 * K + C0) * 2u; o[0][1] = (unsigned)(R1 * K + C1) * 2u;
        o[1][0] = (unsigned)((HALF + R0) * K + C0) * 2u; o[1][1] = (unsigned)((HALF + R1) * K + C1) * 2u;
    }
};
struct EpiBf16Store {
    static constexpr bool PERM = true;
    bf16_t* O0; int ldc; size_t bstr = 0;
    DI void operator()(const f32x4 (&acc)[2][2][4][2], const Unit& u, int wr, int wc, int fr, int fq) const {
        bf16_t* O = O0 + (size_t)u.e * bstr;
        const int row0 = u.pm * BM + wr * 64 + fr, col0 = u.pn * BM + wc * 32 + 8 * fq;
#pragma unroll
        for (int ai = 0; ai < 2; ++ai)
#pragma unroll
            for (int m = 0; m < 4; ++m) { bf16_t* rowp = O + (size_t)(row0 + ai * HALF + m * 16) * ldc + col0;
#pragma unroll
                for (int bj = 0; bj < 2; ++bj) { const f32x4 v0 = acc[ai][bj][m][0], v1 = acc[ai][bj][m][1];
                    u32x4 w; w.x = cvt_pk_bf16(v0[0], v0[1]); w.y = cvt_pk_bf16(v0[2], v0[3]); w.z = cvt_pk_bf16(v1[0], v1[1]); w.w = cvt_pk_bf16(v1[2], v1[3]);
                    *(u32x4*)(rowp + bj * HALF) = w; } }
    }
};
struct EpiResid {
    static constexpr bool PERM = false;
    const float* xin_lat; const float* xin_ctx; float* out_lat; float* out_ctx; const float* modl; int batched_T;
    DI void operator()(const f32x4 (&acc)[2][2][4][2], const Unit& u, int wr, int wc, int fr, int fq) const {
        int grow0; if (batched_T == 0) grow0 = u.pm * BM; else if (batched_T > 0) grow0 = u.e * 2048 + u.pm * BM; else grow0 = NLAT + u.e * 256 + u.pm * BM;
        const bool lat = grow0 < NLAT; const int jj = lat ? (grow0 >> 11) : 16;
        const float* xi = lat ? xin_lat + (size_t)grow0 * 1024 : xin_ctx + (size_t)(grow0 - NLAT) * 1024;
        float* xo = lat ? out_lat + (size_t)grow0 * 1024 : out_ctx + (size_t)(grow0 - NLAT) * 1024;
        const float* g1 = modl + (size_t)jj * 6144 + 2 * 1024;
        const int r0 = wr * 64 + fr, col0 = u.pn * BM + wc * 32 + 4 * fq;
        f32x4 gv[2][2];
#pragma unroll
        for (int bj = 0; bj < 2; ++bj)
#pragma unroll
            for (int n = 0; n < 2; ++n) gv[bj][n] = *(const f32x4*)(g1 + col0 + bj * HALF + n * 16);
#pragma unroll
        for (int ai = 0; ai < 2; ++ai) {
            f32x4 xv[4][2][2];
#pragma unroll
            for (int m = 0; m < 4; ++m)
#pragma unroll
                for (int bj = 0; bj < 2; ++bj)
#pragma unroll
                    for (int n = 0; n < 2; ++n) xv[m][bj][n] = *(const f32x4*)(xi + (size_t)(r0 + ai * HALF + m * 16) * 1024 + col0 + bj * HALF + n * 16);
#pragma unroll
            for (int m = 0; m < 4; ++m)
#pragma unroll
                for (int bj = 0; bj < 2; ++bj)
#pragma unroll
                    for (int n = 0; n < 2; ++n) *(f32x4*)(xo + (size_t)(r0 + ai * HALF + m * 16) * 1024 + col0 + bj * HALF + n * 16) = xv[m][bj][n] + gv[bj][n] * acc[ai][bj][m][n];
            asm volatile("" ::: "memory");
        }
    }
};
struct EpiResidB {
    static constexpr bool PERM = true;
    const void* xin_lat; const void* xin_ctx; bf16_t* out_lat; bf16_t* out_ctx; const float* modl; int batched_T; int in_f32;
    DI void operator()(const f32x4 (&acc)[2][2][4][2], const Unit& u, int wr, int wc, int fr, int fq) const {
        int grow0; if (batched_T == 0) grow0 = u.pm * BM; else if (batched_T > 0) grow0 = u.e * 2048 + u.pm * BM; else grow0 = NLAT + u.e * 256 + u.pm * BM;
        const bool lat = grow0 < NLAT; const int jj = lat ? (grow0 >> 11) : 16; const size_t rb = lat ? (size_t)grow0 : (size_t)(grow0 - NLAT);
        const float* g1 = modl + (size_t)jj * 6144 + 2 * 1024;
        bf16_t* xo = (lat ? out_lat : out_ctx) + rb * 1024;
        const int r0 = wr * 64 + fr, col0 = u.pn * BM + wc * 32 + 8 * fq;
        f32x4 gv[2][2];
#pragma unroll
        for (int bj = 0; bj < 2; ++bj)
#pragma unroll
            for (int n = 0; n < 2; ++n) gv[bj][n] = *(const f32x4*)(g1 + col0 + bj * HALF + 4 * n);
        if (in_f32) {
            const float* xi = (const float*)(lat ? xin_lat : xin_ctx) + rb * 1024;
#pragma unroll
            for (int ai = 0; ai < 2; ++ai)
#pragma unroll
                for (int mp = 0; mp < 2; ++mp) {
                    f32x4 xv[2][2][2];
#pragma unroll
                    for (int mm_ = 0; mm_ < 2; ++mm_)
#pragma unroll
                        for (int bj = 0; bj < 2; ++bj)
#pragma unroll
                            for (int n = 0; n < 2; ++n) xv[mm_][bj][n] = *(const f32x4*)(xi + (size_t)(r0 + ai * HALF + (2 * mp + mm_) * 16) * 1024 + col0 + bj * HALF + 4 * n);
#pragma unroll
                    for (int mm_ = 0; mm_ < 2; ++mm_)
#pragma unroll
                        for (int bj = 0; bj < 2; ++bj) { const int m = 2 * mp + mm_; const f32x4 o0 = xv[mm_][bj][0] + gv[bj][0] * acc[ai][bj][m][0], o1 = xv[mm_][bj][1] + gv[bj][1] * acc[ai][bj][m][1];
                            u32x4 w; w.x = att_pk(o0[0], o0[1]); w.y = att_pk(o0[2], o0[3]); w.z = att_pk(o1[0], o1[1]); w.w = att_pk(o1[2], o1[3]);
                            *(u32x4*)(xo + (size_t)(r0 + ai * HALF + m * 16) * 1024 + col0 + bj * HALF) = w; }
                    asm volatile("" ::: "memory");
                }
        } else {
            const bf16_t* xi = (const bf16_t*)(lat ? xin_lat : xin_ctx) + rb * 1024;
#pragma unroll
            for (int ai = 0; ai < 2; ++ai) {
                u32x4 xv[4][2];
#pragma unroll
                for (int m = 0; m < 4; ++m)
#pragma unroll
                    for (int bj = 0; bj < 2; ++bj) xv[m][bj] = *(const u32x4*)(xi + (size_t)(r0 + ai * HALF + m * 16) * 1024 + col0 + bj * HALF);
#pragma unroll
                for (int m = 0; m < 4; ++m)
#pragma unroll
                    for (int bj = 0; bj < 2; ++bj) { const u32x4 x = xv[m][bj];
                        const f32x4 x0 = {__uint_as_float(x.x << 16), __uint_as_float(x.x & 0xffff0000u), __uint_as_float(x.y << 16), __uint_as_float(x.y & 0xffff0000u)};
                        const f32x4 x1 = {__uint_as_float(x.z << 16), __uint_as_float(x.z & 0xffff0000u), __uint_as_float(x.w << 16), __uint_as_float(x.w & 0xffff0000u)};
                        const f32x4 o0 = x0 + gv[bj][0] * acc[ai][bj][m][0], o1 = x1 + gv[bj][1] * acc[ai][bj][m][1];
                        u32x4 w; w.x = att_pk(o0[0], o0[1]); w.y = att_pk(o0[2], o0[3]); w.z = att_pk(o1[0], o1[1]); w.w = att_pk(o1[2], o1[3]);
                        *(u32x4*)(xo + (size_t)(r0 + ai * HALF + m * 16) * 1024 + col0 + bj * HALF) = w; }
                asm volatile("" ::: "memory");
            }
        }
    }
};
}

DI void tconv_tile(const Ctx& cx, float* T, const float* src, int ld_src, int k0, int n0, int kvalid, int nvalid, bf16_t* dst, int ldd, int drow0) {
    const int tid = cx.tid;
#pragma unroll
    for (int rr = 0; rr < 2; ++rr) {
        const int i = (tid >> 4) + 32 * rr, j = (tid & 15) * 4;
        float4 v = make_float4(0.f, 0.f, 0.f, 0.f);
        if (k0 + i < kvalid && n0 + j < nvalid) v = *(const float4*)(src + (size_t)(k0 + i) * ld_src + n0 + j);
        T[i * 65 + j] = v.x; T[i * 65 + j + 1] = v.y; T[i * 65 + j + 2] = v.z; T[i * 65 + j + 3] = v.w;
    }
    __syncthreads();
    { const int j = tid >> 3, ch = tid & 7; uint4 o;
      o.x = pack2(T[(ch * 8 + 0) * 65 + j], T[(ch * 8 + 1) * 65 + j]); o.y = pack2(T[(ch * 8 + 2) * 65 + j], T[(ch * 8 + 3) * 65 + j]);
      o.z = pack2(T[(ch * 8 + 4) * 65 + j], T[(ch * 8 + 5) * 65 + j]); o.w = pack2(T[(ch * 8 + 6) * 65 + j], T[(ch * 8 + 7) * 65 + j]);
      *(uint4*)(dst + (size_t)(drow0 + j) * ldd + k0 + ch * 8) = o; }
    __syncthreads();
}
DI void ph_prep_weights(const Ctx& cx, const Params& p, float* lds) {
    const int tid = cx.tid, gtid = cx.bid * NTHR + tid, gsz = cx.nblk * NTHR;
    for (int it = cx.bid; it < 2 * 1008; it += cx.nblk) {
        const int j = it / 1008; int r = it % 1008;
        if (r < 640) { const int kt = r / 40, ntl = r % 40; tconv_tile(cx, lds, p.w_in + (size_t)j * 1024 * INC, INC, kt * 64, ntl * 64, 1024, INC, p.WinT + (size_t)j * 2560 * 1024, 1024, ntl * 64); continue; } r -= 640;
        if (r < 48) { const int kt = r / 12, ntl = r % 12; tconv_tile(cx, lds, p.b_w_q_up + (size_t)j * 256 * 768, 768, kt * 64, ntl * 64, 256, 768, p.WqT + (size_t)j * 768 * 256, 256, ntl * 64); continue; } r -= 48;
        if (r < 64) { const int kt = r / 16, ntl = r % 16; tconv_tile(cx, lds, p.b_w_kv_up + (size_t)j * 128 * 1024, 1024, kt * 64, ntl * 64, 128, 1024, p.WkvT + (size_t)j * 1024 * 256, 256, ntl * 64); continue; } r -= 64;
        { const int kt = r / 16, ntl = r % 16; tconv_tile(cx, lds, p.w_out_even + (size_t)j * 1024 * 1024, 1024, kt * 64, ntl * 64, 1024, 1024, p.WoutT + (size_t)j * 1024 * 1024, 1024, ntl * 64); }
    }
    for (int idx = gtid; idx < 2 * 2560 * 384; idx += gsz) {
        const int j = idx / (2560 * 384), rem = idx % (2560 * 384), n = rem / 384, k = rem % 384; const int seg = n >> 9, nn = n & 511;
        float v = 0.f;
        if (seg < 2) { if ((k >> 6) == seg) v = p.a_w2[((size_t)(j * 2 + seg) * 64 + (k & 63)) * 512 + nn]; }
        else if (seg < 4) { if ((k >> 6) == seg) v = p.a_a2[((size_t)(j * 2 + seg - 2) * 64 + (k & 63)) * 512 + nn]; }
        else { if (k >= 256) v = p.a_g2[((size_t)j * 128 + (k - 256)) * 512 + nn]; }
        p.WlrT[idx] = f2bf(v);
    }
    {
        float* Tc = lds; float* Ts = lds + 64 * 65; float* tab = lds + 2 * 64 * 65;
        for (int i = tid; i < 128; i += NTHR) { tab[i] = cospif((float)i * (1.f / 64.f)); tab[128 + i] = sinpif((float)i * (1.f / 64.f)); }
        __syncthreads();
        for (int it = cx.bid; it < 2 * 256; it += cx.nblk) {
            const int j = it >> 8, ct = (it >> 4) & 15, et = it & 15; const float* Wf = p.w_out_fourier + (size_t)j * 1024 * 1024;
            const int el = tid & 63, e = et * 64 + el;
#pragma unroll 1
            for (int i = 0; i < 8; ++i) {
                const int chl = (tid >> 6) + 8 * i, ch = ct * 64 + chl, grp = ch >> 7, c = ch & 127;
                float sc = 0.f, ss = 0.f;
                for (int g = 0; g < 128; ++g) { const float w = Wf[(size_t)(grp * 128 + g) * 1024 + e]; const int m = (c * g) & 127; sc += tab[m] * w; ss += tab[128 + m] * w; }
                Tc[chl * 65 + el] = sc; Ts[chl * 65 + el] = ss;
            }
            __syncthreads();
            { const int el2 = tid >> 3, chunk = tid & 7; uint4 o, o2; const float* a = Tc + chunk * 8 * 65 + el2; const float* b = Ts + chunk * 8 * 65 + el2;
              o.x = pack2(a[0], a[65]); o.y = pack2(a[2 * 65], a[3 * 65]); o.z = pack2(a[4 * 65], a[5 * 65]); o.w = pack2(a[6 * 65], a[7 * 65]);
              o2.x = pack2(b[0], b[65]); o2.y = pack2(b[2 * 65], b[3 * 65]); o2.z = pack2(b[4 * 65], b[5 * 65]); o2.w = pack2(b[6 * 65], b[7 * 65]);
              bf16_t* d = p.A1 + (size_t)j * 2048 * 1024 + (size_t)(et * 64 + el2) * 1024 + ct * 64 + chunk * 8;
              *(uint4*)d = o; *(uint4*)(d + (size_t)1024 * 1024) = o2; }
            __syncthreads();
        }
    }
    for (int i = gtid; i < 256 * 256; i += gsz) {
        const int m = i >> 8, k = i & 255, f1 = m & 127, t1 = k & 127; const float a = (float)((f1 * t1) & 127) * (1.f / 64.f); const float cs = cospif(a), sn = sinpif(a);
        const float v = (m < 128) ? ((k < 128) ? cs : -sn) : ((k < 128) ? -sn : -cs);
        p.M1[i] = f2bf(v);
    }
    for (int i = gtid; i < 2048 * 4096; i += gsz) {
        const int f = i >> 12, k = i & 4095, t = k & 2047, m = (f * t) & 2047; const float a = (float)m * (1.f / 1024.f);
        p.A2[i] = f2bf(((k < 2048) ? cospif(a) : -sinpif(a)) * (1.f / 512.f));
    }
    for (int i = gtid; i < 256 * 512; i += gsz) {
        const int f = i >> 9, k = i & 511, t = k & 255, m = (f * t) & 255; const float a = (float)m * (1.f / 128.f);
        p.A2c[i] = f2bf(((k < 256) ? cospif(a) : -sinpif(a)) * 0.0055242717280199f);
    }
    __syncthreads();
}
DI void ph_prep_moe(const Ctx& cx, const Params& p, float* lds, int layer) {
    for (int it = cx.bid; it < 17 * 384; it += cx.nblk) {
        const int e = it / 384; int r = it % 384;
        const float* Wg = (e < 16) ? p.moe_w_gate + ((size_t)layer * 16 + e) * 1024 * 512 : p.sh_gate + (size_t)layer * 1024 * 512;
        const float* Wu = (e < 16) ? p.moe_w_up + ((size_t)layer * 16 + e) * 1024 * 512 : p.sh_up + (size_t)layer * 1024 * 512;
        const float* Wd = (e < 16) ? p.moe_w_down + ((size_t)layer * 16 + e) * 512 * 1024 : p.sh_down + (size_t)layer * 512 * 1024;
        if (r < 256) { const int bj = r >> 7, kt = (r >> 3) & 15, ntl = r & 7, n0 = ntl * 64;
            tconv_tile(cx, lds, bj ? Wu : Wg, 512, kt * 64, n0, 1024, 512, p.WguT + (size_t)e * 1024 * 1024, 1024, (n0 >> 7) * 256 + bj * 128 + (n0 & 127)); }
        else { r -= 256; const int kt = r >> 4, ntl = r & 15; tconv_tile(cx, lds, Wd, 1024, kt * 64, ntl * 64, 512, 1024, p.WdT + (size_t)e * 1024 * 512, 512, ntl * 64); }
    }
}

#define GEMM_LDS(lds) ((LAS unsigned char*)(lds))
DI void ph_win_mm(const Ctx& cx, const Params& p, float* lds, int j) {
    mm::StaticSched S; S.init(p.H, p.WinT + (size_t)j * 2560 * 1024, NT, 2560, 1024, 1024, cx.nblk, cx.bid);
    mm::EpiBf16Store E{p.P, PLD};
    mm::gemm_phase(GEMM_LDS(lds), 1024, S, E, cx.tid);
}
DI void ph_wout_mmB(const Ctx& cx, const Params& p, float* lds, const bf16_t* A, const bf16_t* Bt, int nrows, const void* xin_lat, const void* xin_ctx, bf16_t* xo_lat, int in_f32, const float* modl) {
    mm::StaticSched S; S.init(A, Bt, nrows, 1024, 1024, 1024, cx.nblk, cx.bid);
    mm::EpiResidB E{xin_lat, xin_ctx, xo_lat, p.cs, modl, 0, in_f32};
    mm::gemm_phase(GEMM_LDS(lds), 1024, S, E, cx.tid);
}
DI void ph_wout_mm(const Ctx& cx, const Params& p, float* lds, const bf16_t* A, const bf16_t* Bt, int nrows, const float* xin_lat, const float* xin_ctx, const float* modl) {
    mm::StaticSched S; S.init(A, Bt, nrows, 1024, 1024, 1024, cx.nblk, cx.bid);
    mm::EpiResid E{xin_lat, xin_ctx, p.out, p.ctxs, modl, 0};
    mm::gemm_phase(GEMM_LDS(lds), 1024, S, E, cx.tid);
}

DI void ph_qkvup_mm(const Ctx& cx, const Params& p, float* lds, int j, int mq) {
    { mm::StaticSched S; S.init(p.QN, p.WqT + (size_t)j * 768 * 256, mq, 768, 256, 512, cx.nblk, cx.bid); mm::EpiBf16Store E{p.Qraw, 768}; mm::gemm_phase(GEMM_LDS(lds), 256, S, E, cx.tid); }
    { mm::StaticSched S; S.init(p.QN + 256, p.WkvT + (size_t)j * 1024 * 256, NT, 1024, 256, 512, cx.nblk, cx.bid); mm::EpiBf16Store E{p.KVraw, 1024}; mm::gemm_phase(GEMM_LDS(lds), 256, S, E, cx.tid); }
}
struct EpiWag {
    static constexpr bool PERM = true;
    bf16_t* O; const LAS float* bias;
    DI void operator()(const mm::f32x4 (&acc)[2][2][4][2], const mm::Unit& u, int wr, int wc, int fr, int fq) const {
        const int row0 = u.pm * 256 + wr * 64 + fr, col0 = u.pn * 256 + wc * 32 + 8 * fq; const int seg = u.pn >> 2;
        const LAS float* bp = bias + col0;
#pragma unroll
        for (int bj = 0; bj < 2; ++bj) {
            mm::f32x4 b0 = (mm::f32x4){0.f, 0.f, 0.f, 0.f}, b1 = b0;
            if (seg < 2) { b0 = *(const LAS mm::f32x4*)(bp + bj * 128); b1 = *(const LAS mm::f32x4*)(bp + bj * 128 + 4); }
#pragma unroll
            for (int ai = 0; ai < 2; ++ai)
#pragma unroll
                for (int m = 0; m < 4; ++m) {
                    mm::f32x4 v0 = acc[ai][bj][m][0] + b0, v1 = acc[ai][bj][m][1] + b1;
                    if (seg == 0) {
#pragma unroll
                        for (int c = 0; c < 4; ++c) { v0[c] = 1.f - __expf(-0.606531f * __builtin_amdgcn_rcpf(1.f + __expf(-v0[c]))); v1[c] = 1.f - __expf(-0.606531f * __builtin_amdgcn_rcpf(1.f + __expf(-v1[c]))); }
                    } else if (seg == 1) {
#pragma unroll
                        for (int c = 0; c < 4; ++c) { v0[c] = __builtin_amdgcn_rcpf(1.f + __expf(-v0[c])); v1[c] = __builtin_amdgcn_rcpf(1.f + __expf(-v1[c])); }
                    }
                    mm::u32x4 w; w.x = mm::cvt_pk_bf16(v0[0], v0[1]); w.y = mm::cvt_pk_bf16(v0[2], v0[3]); w.z = mm::cvt_pk_bf16(v1[0], v1[1]); w.w = mm::cvt_pk_bf16(v1[2], v1[3]);
                    *(mm::u32x4*)(O + (size_t)(row0 + ai * 128 + m * 16) * WLD + col0 + bj * 128) = w;
                }
        }
    }
};
DI void ph_wag_mm(const Ctx& cx, const Params& p, float* lds, int j) {
    mm::StaticSched S; S.init(p.LR, p.WlrT + (size_t)j * 2560 * 384, NT, 2560, 384, 384, cx.nblk, cx.bid);
    LAS float* bl = (LAS float*)lds + 32768 + 256 + 1024;
    for (int i = cx.tid; i < 2048; i += NTHR) bl[i] = (i < 1024) ? p.a_w0[j * 1024 + i] : p.a_a0[j * 1024 + i - 1024];
    __syncthreads();
    EpiWag E{p.WAG, bl};
    mm::gemm_phase(GEMM_LDS(lds), 384, S, E, cx.tid);
}
struct EpiZT {
    static constexpr bool PERM = true;
    bf16_t* Z; int T;
    DI void operator()(const mm::f32x4 (&acc)[2][2][4][2], const mm::Unit& u, int wr, int wc, int fr, int fq) const {
        const int b = (T == 2048) ? (u.pn >> 3) : u.pn, t0 = (T == 2048) ? ((u.pn & 7) * 256) : 0;
        const int m0 = u.pm * 256 + wr * 64 + fr; const int c0 = t0 + wc * 32 + 8 * fq;
#pragma unroll
        for (int ai = 0; ai < 2; ++ai)
#pragma unroll
            for (int m = 0; m < 4; ++m) { const int mr = m0 + ai * 128 + m * 16, part = mr >> 10, ch = mr & 1023;
                bf16_t* rowp = Z + ((size_t)(b * 1024 + ch) * 2 + part) * T + c0;
#pragma unroll
                for (int bj = 0; bj < 2; ++bj) { const mm::f32x4 v0 = acc[ai][bj][m][0], v1 = acc[ai][bj][m][1];
                    mm::u32x4 w; w.x = mm::cvt_pk_bf16(v0[0], v0[1]); w.y = mm::cvt_pk_bf16(v0[2], v0[3]); w.z = mm::cvt_pk_bf16(v1[0], v1[1]); w.w = mm::cvt_pk_bf16(v1[2], v1[3]);
                    *(mm::u32x4*)(rowp + bj * 128) = w; } }
    }
};
DI void ph_f1_mm(const Ctx& cx, const Params& p, float* lds, int j, bool with_ctx) {
    { mm::StaticSched S; S.init(p.A1 + (size_t)j * 2048 * 1024, p.H, 2048, NLAT, 1024, 1024, cx.nblk, cx.bid); EpiZT E{p.ZT, 2048}; mm::gemm_phase(GEMM_LDS(lds), 1024, S, E, cx.tid); }
    if (with_ctx) { mm::StaticSched S; S.init(p.A1 + (size_t)j * 2048 * 1024, p.H + (size_t)NLAT * 1024, 2048, NCTX, 1024, 1024, cx.nblk, cx.bid); EpiZT E{p.ZTC, 256}; mm::gemm_phase(GEMM_LDS(lds), 1024, S, E, cx.tid); }
}
DI void ph_f2_mmB(const Ctx& cx, const Params& p, float* lds, bool with_ctx, const void* xin_lat, const void* xin_ctx, bf16_t* xo_lat, const float* modl) {
    { mm::BatchSched S; S.init(p.A2, p.ZT, (size_t)1024 * 4096 * 2, 16, 2048, 1024, 4096, cx.nblk, cx.bid); mm::EpiResidB E{xin_lat, xin_ctx, xo_lat, p.cs, modl, 1, 0}; mm::gemm_phase(GEMM_LDS(lds), 4096, S, E, cx.tid); }
    if (with_ctx) { mm::BatchSched S; S.init(p.A2c, p.ZTC, (size_t)1024 * 512 * 2, 16, 256, 1024, 512, cx.nblk, cx.bid); mm::EpiResidB E{xin_lat, xin_ctx, xo_lat, p.cs, modl, -1, 0}; mm::gemm_phase(GEMM_LDS(lds), 512, S, E, cx.tid); }
}
DI void ph_f2_mm(const Ctx& cx, const Params& p, float* lds, bool with_ctx, const float* xin_lat, const float* xin_ctx, const float* modl) {
    { mm::BatchSched S; S.init(p.A2, p.ZT, (size_t)1024 * 4096 * 2, 16, 2048, 1024, 4096, cx.nblk, cx.bid); mm::EpiResid E{xin_lat, xin_ctx, p.out, p.ctxs, modl, 1}; mm::gemm_phase(GEMM_LDS(lds), 4096, S, E, cx.tid); }
    if (with_ctx) { mm::BatchSched S; S.init(p.A2c, p.ZTC, (size_t)1024 * 512 * 2, 16, 256, 1024, 512, cx.nblk, cx.bid); mm::EpiResid E{xin_lat, xin_ctx, p.out, p.ctxs, modl, -1}; mm::gemm_phase(GEMM_LDS(lds), 512, S, E, cx.tid); }
}
struct MoeSched {
    static constexpr bool GATHER = true, TABLE = true;
    const char* A; const char* Bt; const int* slot; const float* slotw; const int* tab; int lda, K, G, c, down;
    DI void tab_dma(const mm::Unit& u, LAS unsigned char* dst, int tid) const {
        const int Me = __builtin_amdgcn_readfirstlane(tab[32 + u.e]); const int r = tid & 255; int idx = u.m * 256 + r; idx = idx < Me ? idx : 0;
        const size_t off = (u.e < 16) ? (size_t)u.e * NT + idx : 0;
        const unsigned* src = (tid < 256) ? (const unsigned*)(slot + off) : (const unsigned*)(slotw + off);
        __builtin_amdgcn_global_load_lds(src, (LAS unsigned*)(dst + (tid >> 6) * 256), 4, 0, 0);
    }
    DI size_t hstep_a() const { return 0; }
    DI unsigned boff(int Rb, int C, int Kk) const { return (unsigned)(Rb * Kk + C) * 2u; }
    DI size_t hstep_b(int Kk) const { return (size_t)mm::HALF * Kk * 2; }
    DI bool next(int i, mm::Unit& u) const {
        const int L = i * G + c; const int total = __builtin_amdgcn_readfirstlane(tab[17]);
        if (L >= total * 4) return false;
        const int rtg = L >> 2; int e = 0;
        for (int q = 1; q < 17; ++q) e += (__builtin_amdgcn_readfirstlane(tab[q]) <= rtg) ? 1 : 0;
        u.e = e; u.m = rtg - __builtin_amdgcn_readfirstlane(tab[e]); u.pm = u.m; u.pn = L & 3;
        u.A = A; u.B = Bt + ((size_t)e * 1024 + (size_t)u.pn * 256) * K * 2; return true;
    }
    DI unsigned rowoff(const mm::Unit& u, int Me, int idx, int C) const {
        int row;
        if (u.e < 16) { const int s = (idx < Me) ? slot[(size_t)u.e * NT + idx] : 0; row = down ? ((s & 1) * NT + (s >> 1)) : (s >> 1); }
        else row = down ? (2 * NT + idx) : idx;
        return (unsigned)(row * lda + C) * 2u;
    }
    DI unsigned rowoff_s(const mm::Unit& u, int s, int r, int C) const { int row; if (u.e < 16) row = down ? ((s & 1) * NT + (s >> 1)) : (s >> 1); else row = down ? (2 * NT + u.m * 256 + r) : (u.m * 256 + r); return (unsigned)(row * lda + C) * 2u; }
    DI void aoff_lds(const mm::Unit& u, const LAS int* et, int R0, int C0, int R1, int C1, unsigned (&o)[2][2]) const {
        o[0][0] = rowoff_s(u, et[R0], R0, C0); o[0][1] = rowoff_s(u, et[R1], R1, C1); o[1][0] = rowoff_s(u, et[128 + R0], 128 + R0, C0); o[1][1] = rowoff_s(u, et[128 + R1], 128 + R1, C1);
    }
    DI void aoff(const mm::Unit& u, int R0, int C0, int R1, int C1, unsigned (&o)[2][2]) const {
        const int Me = __builtin_amdgcn_readfirstlane(tab[32 + u.e]), base = u.m * 256;
        o[0][0] = rowoff(u, Me, base + R0, C0); o[0][1] = rowoff(u, Me, base + R1, C1);
        o[1][0] = rowoff(u, Me, base + 128 + R0, C0); o[1][1] = rowoff(u, Me, base + 128 + R1, C1);
    }
};
DI void moe_table(const Ctx& cx, const Params& p, int* tab, int layer, int nrows) {
    if (cx.tid == 0) { int acc = 0;
        for (int e = 0; e < 17; ++e) { const int M = (e < 16) ? p.cnt[(layer * 16 + e) * 64] : nrows; tab[e] = acc; tab[32 + e] = M; acc += (M + 255) >> 8; }
        tab[17] = acc; }
    __syncthreads();
}
DI void lds_read8(const LAS int* base, int r0, int (&o)[8]) {
    const unsigned a = (unsigned)(size_t)(base + r0);
    asm volatile("ds_read_b32 %0, %8\n\tds_read_b32 %1, %8 offset:64\n\tds_read_b32 %2, %8 offset:128\n\tds_read_b32 %3, %8 offset:192\n\t"
                 "ds_read_b32 %4, %8 offset:512\n\tds_read_b32 %5, %8 offset:576\n\tds_read_b32 %6, %8 offset:640\n\tds_read_b32 %7, %8 offset:704\n\ts_waitcnt lgkmcnt(0)"
                 : "=&v"(o[0]), "=&v"(o[1]), "=&v"(o[2]), "=&v"(o[3]), "=&v"(o[4]), "=&v"(o[5]), "=&v"(o[6]), "=&v"(o[7]) : "v"(a) : "memory");
}
struct EpiSwiglu {
    static constexpr bool PERM = true;
    bf16_t* ACT; const int* slot; const int* tab; const LAS int* etab;
    DI void operator()(const mm::f32x4 (&acc)[2][2][4][2], const mm::Unit& u, int wr, int wc, int fr, int fq) const {
        const int Me = __builtin_amdgcn_readfirstlane(tab[32 + u.e]); const int col = u.pn * 128 + wc * 32 + 8 * fq; const LAS int* et = etab + u.tb * 512;
        int sl8[8]; lds_read8(et, wr * 64 + fr, sl8);
#pragma unroll
        for (int ai = 0; ai < 2; ++ai)
#pragma unroll
            for (int m = 0; m < 4; ++m) {
                const int idx = u.m * 256 + ai * 128 + wr * 64 + m * 16 + fr;
                if (idx < Me) {
                    int drow; if (u.e < 16) { const int s = sl8[ai * 4 + m]; drow = (s & 1) * NT + (s >> 1); } else drow = 2 * NT + idx;
                    float o[8];
#pragma unroll
                    for (int n = 0; n < 2; ++n)
#pragma unroll
                        for (int c = 0; c < 4; ++c) { const float g = acc[ai][0][m][n][c], uu = acc[ai][1][m][n][c]; o[n * 4 + c] = g * __builtin_amdgcn_rcpf(1.f + __expf(-g)) * uu; }
                    mm::u32x4 w; w.x = mm::cvt_pk_bf16(o[0], o[1]); w.y = mm::cvt_pk_bf16(o[2], o[3]); w.z = mm::cvt_pk_bf16(o[4], o[5]); w.w = mm::cvt_pk_bf16(o[6], o[7]);
                    *(mm::u32x4*)(ACT + (size_t)drow * 512 + col) = w;
                }
            }
    }
};
struct EpiDown {
    static constexpr bool PERM = true;
    bf16_t* Y; const int* slot; const float* tokw; const int* tab; const LAS int* etab;
    DI void operator()(const mm::f32x4 (&acc)[2][2][4][2], const mm::Unit& u, int wr, int wc, int fr, int fq) const {
        const int Me = __builtin_amdgcn_readfirstlane(tab[32 + u.e]); const int col = u.pn * 256 + wc * 32 + 8 * fq; const LAS int* et = etab + u.tb * 512;
        int sl8[8], sw8[8]; lds_read8(et, wr * 64 + fr, sl8); lds_read8(et + 256, wr * 64 + fr, sw8);
#pragma unroll
        for (int ai = 0; ai < 2; ++ai)
#pragma unroll
            for (int m = 0; m < 4; ++m) {
                const int idx = u.m * 256 + ai * 128 + wr * 64 + m * 16 + fr;
                if (idx < Me) {
                    int drow; float w = 1.f;
                    if (u.e < 16) { const int s = sl8[ai * 4 + m]; drow = (s & 1) * NT + (s >> 1); w = __int_as_float(sw8[ai * 4 + m]); } else drow = 2 * NT + idx;
#pragma unroll
                    for (int bj = 0; bj < 2; ++bj) { const mm::f32x4 v0 = acc[ai][bj][m][0] * w, v1 = acc[ai][bj][m][1] * w;
                        mm::u32x4 o; o.x = mm::cvt_pk_bf16(v0[0], v0[1]); o.y = mm::cvt_pk_bf16(v0[2], v0[3]); o.z = mm::cvt_pk_bf16(v1[0], v1[1]); o.w = mm::cvt_pk_bf16(v1[2], v1[3]);
                        *(mm::u32x4*)(Y + (size_t)drow * 1024 + col + bj * 128) = o; }
                }
            }
    }
};
DI void ph_moe_up_mm(const Ctx& cx, const Params& p, float* lds, int layer, int nrows) {
    int* tab = (int*)(lds + 32768); moe_table(cx, p, tab, layer, nrows);
    MoeSched S{(const char*)p.H, (const char*)p.WguT, p.slot, p.slotw, tab, 1024, 1024, cx.nblk, cx.bid, 0};
    EpiSwiglu E{p.ACT, p.slot, tab, (const LAS int*)((LAS float*)lds + 32768 + 256)};
    mm::gemm_phase(GEMM_LDS(lds), 1024, S, E, cx.tid);
}
DI void ph_moe_down_mm(const Ctx& cx, const Params& p, float* lds, int layer, int nrows) {
    int* tab = (int*)(lds + 32768); moe_table(cx, p, tab, layer, nrows);
    MoeSched S{(const char*)p.ACT, (const char*)p.WdT, p.slot, p.slotw, tab, 512, 512, cx.nblk, cx.bid, 1};
    EpiDown E{p.Y, p.slot, p.tokw, tab, (const LAS int*)((LAS float*)lds + 32768 + 256)};
    mm::gemm_phase(GEMM_LDS(lds), 512, S, E, cx.tid);
}

namespace att {
typedef short bf16x8 __attribute__((ext_vector_type(8)));
typedef float f32x16 __attribute__((ext_vector_type(16)));
typedef unsigned u32x4 __attribute__((ext_vector_type(4)));
typedef unsigned u32x2 __attribute__((ext_vector_type(2)));
typedef __bf16 bf16x2_t __attribute__((ext_vector_type(2)));
typedef float f32x2_t __attribute__((ext_vector_type(2)));
constexpr int KP = 208, VP = 264, KT_BYTES = 128 * KP, VT_BYTES = 64 * VP, BUF = KT_BYTES + VT_BYTES;
DI unsigned pk(float a, float b) { f32x2_t f = {a, b}; bf16x2_t h = __builtin_convertvector(f, bf16x2_t); return __builtin_bit_cast(unsigned, h); }
DI float xhalf_max(float x) { const auto r = __builtin_amdgcn_permlane32_swap(__builtin_bit_cast(unsigned, x), __builtin_bit_cast(unsigned, x), false, false); return fmaxf(__builtin_bit_cast(float, r[0]), __builtin_bit_cast(float, r[1])); }
DI float xhalf_sum(float x) { const auto r = __builtin_amdgcn_permlane32_swap(__builtin_bit_cast(unsigned, x), __builtin_bit_cast(unsigned, x), false, false); return __builtin_bit_cast(float, r[0]) + __builtin_bit_cast(float, r[1]); }
#define ATT_MFMA(a, b, c) __builtin_amdgcn_mfma_f32_32x32x16_bf16((a), (b), (c), 0, 0, 0)
}
DI void ph_attn_mm(const Ctx& cx, const Params& p, float* ldsf, bool with_ctx) {
    using namespace att;
    LAS unsigned char* lds = (LAS unsigned char*)ldsf;
    const int tid = cx.tid, wid = __builtin_amdgcn_readfirstlane(tid >> 6), lane = tid & 63, r = lane & 31, hh = lane >> 5;
    const int nunits = 1024 + (with_ctx ? 128 : 0);
    int kg[3], kl[3], vg[2], vl[2];
#pragma unroll
    for (int i = 0; i < 3; ++i) { const int c = tid + 512 * i, row = c / 12, part = c % 12; kg[i] = row * 96 + part * 8; kl[i] = row * KP + part * 16; }
#pragma unroll
    for (int i = 0; i < 2; ++i) { const int c = tid + 512 * i, row = c >> 4, part = c & 15; vg[i] = row * 2304 + part * 8; vl[i] = KT_BYTES + row * VP + part * 16; }
    for (int u = cx.bid; u < nunits; u += cx.nblk) {
        int bh, qrow0, nkeys;
        if (u < 1024) { bh = u >> 3; qrow0 = (bh >> 3) * 2048 + (u & 7) * 256; nkeys = 2304; }
        else { bh = u - 1024; qrow0 = NLAT + (bh >> 3) * 256; nkeys = 256; }
        const int h = bh & 7;
        const bf16_t* Kb = p.Kf + (size_t)bh * 2304 * 96; const bf16_t* Vb = p.Vt + (size_t)bh * 64 * 2304;
        const bf16_t* qp = p.Qraw + (size_t)(qrow0 + wid * 32 + r) * 768 + h * 96 + 8 * hh;
        bf16x8 qf[6];
#pragma unroll
        for (int s = 0; s < 6; ++s) qf[s] = *(const bf16x8*)(qp + 16 * s);
        f32x16 ot0, ot1;
#pragma unroll
        for (int i = 0; i < 16; ++i) { ot0[i] = 0.f; ot1[i] = 0.f; }
        float mrun = -3.0e38f, lrun = 0.f;
        const int ntiles = nkeys >> 7;
        u32x4 kr[3], vr[2];
#pragma unroll
        for (int i = 0; i < 3; ++i) kr[i] = *(const u32x4*)(Kb + kg[i]);
#pragma unroll
        for (int i = 0; i < 2; ++i) vr[i] = *(const u32x4*)(Vb + vg[i]);
#pragma unroll
        for (int i = 0; i < 3; ++i) *(LAS u32x4*)(lds + kl[i]) = kr[i];
#pragma unroll
        for (int i = 0; i < 2; ++i) { *(LAS u32x2*)(lds + vl[i]) = (u32x2){vr[i].x, vr[i].y}; *(LAS u32x2*)(lds + vl[i] + 8) = (u32x2){vr[i].z, vr[i].w}; }
        __syncthreads();
        for (int it = 0; it < ntiles; ++it) {
            const int bo = (it & 1) * BUF, bn = ((it + 1) & 1) * BUF;
            const bool more = (it + 1 < ntiles);
            if (more) {
                const bf16_t* Kn = Kb + (size_t)(it + 1) * 128 * 96; const bf16_t* Vn = Vb + (it + 1) * 128;
#pragma unroll
                for (int i = 0; i < 3; ++i) kr[i] = *(const u32x4*)(Kn + kg[i]);
#pragma unroll
                for (int i = 0; i < 2; ++i) vr[i] = *(const u32x4*)(Vn + vg[i]);
            }
            f32x16 st[4];
#pragma unroll
            for (int kb = 0; kb < 4; ++kb) {
#pragma unroll
                for (int i = 0; i < 16; ++i) st[kb][i] = 0.f;
#pragma unroll
                for (int s = 0; s < 6; ++s) { const bf16x8 kf = *(const LAS bf16x8*)(lds + bo + (kb * 32 + r) * KP + 32 * s + 16 * hh); st[kb] = ATT_MFMA(kf, qf[s], st[kb]); }
            }
            float mq[4];
#pragma unroll
            for (int kb = 0; kb < 4; ++kb) { float a = fmaxf(st[kb][0], st[kb][1]), b = fmaxf(st[kb][2], st[kb][3]), c2 = fmaxf(st[kb][4], st[kb][5]), d = fmaxf(st[kb][6], st[kb][7]);
                a = fmaxf(a, fmaxf(st[kb][8], st[kb][9])); b = fmaxf(b, fmaxf(st[kb][10], st[kb][11])); c2 = fmaxf(c2, fmaxf(st[kb][12], st[kb][13])); d = fmaxf(d, fmaxf(st[kb][14], st[kb][15]));
                mq[kb] = fmaxf(fmaxf(a, b), fmaxf(c2, d)); }
            float mt = fmaxf(fmaxf(mq[0], mq[1]), fmaxf(mq[2], mq[3]));
            mt = xhalf_max(mt);
            const float mnew = fmaxf(mrun, mt), alpha = __builtin_amdgcn_exp2f(mrun - mnew);
            mrun = mnew;
            float pq[4];
#pragma unroll
            for (int kb = 0; kb < 4; ++kb) { float a = 0.f, b = 0.f;
#pragma unroll
                for (int i = 0; i < 16; i += 2) { st[kb][i] = __builtin_amdgcn_exp2f(st[kb][i] - mnew); st[kb][i + 1] = __builtin_amdgcn_exp2f(st[kb][i + 1] - mnew); a += st[kb][i]; b += st[kb][i + 1]; }
                pq[kb] = a + b; }
            lrun = lrun * alpha + ((pq[0] + pq[1]) + (pq[2] + pq[3]));
#pragma unroll
            for (int i = 0; i < 16; ++i) { ot0[i] *= alpha; ot1[i] *= alpha; }
#pragma unroll
            for (int kb = 0; kb < 4; ++kb)
#pragma unroll
                for (int s = 0; s < 2; ++s) {
                    u32x4 pw; pw.x = pk(st[kb][8 * s], st[kb][8 * s + 1]); pw.y = pk(st[kb][8 * s + 2], st[kb][8 * s + 3]); pw.z = pk(st[kb][8 * s + 4], st[kb][8 * s + 5]); pw.w = pk(st[kb][8 * s + 6], st[kb][8 * s + 7]);
                    const bf16x8 pb = __builtin_bit_cast(bf16x8, pw);
                    const int col = (kb * 32 + 16 * s + 4 * hh) * 2;
                    const u32x2 a0 = *(const LAS u32x2*)(lds + bo + KT_BYTES + r * VP + col), a1 = *(const LAS u32x2*)(lds + bo + KT_BYTES + r * VP + col + 16);
                    const u32x2 b0 = *(const LAS u32x2*)(lds + bo + KT_BYTES + (32 + r) * VP + col), b1 = *(const LAS u32x2*)(lds + bo + KT_BYTES + (32 + r) * VP + col + 16);
                    const u32x4 va = {a0.x, a0.y, a1.x, a1.y}, vb = {b0.x, b0.y, b1.x, b1.y};
                    ot0 = ATT_MFMA(__builtin_bit_cast(bf16x8, va), pb, ot0);
                    ot1 = ATT_MFMA(__builtin_bit_cast(bf16x8, vb), pb, ot1);
                }
            if (more) {
#pragma unroll
                for (int i = 0; i < 3; ++i) *(LAS u32x4*)(lds + bn + kl[i]) = kr[i];
#pragma unroll
                for (int i = 0; i < 2; ++i) { *(LAS u32x2*)(lds + bn + vl[i]) = (u32x2){vr[i].x, vr[i].y}; *(LAS u32x2*)(lds + bn + vl[i] + 8) = (u32x2){vr[i].z, vr[i].w}; }
            }
            __syncthreads();
        }
        const float il = 1.f / xhalf_sum(lrun);
        bf16_t* op = p.H + (size_t)(qrow0 + wid * 32 + r) * 1024 + 512 + h * 64 + 4 * hh;
#pragma unroll
        for (int g = 0; g < 4; ++g) {
            u32x2 w0 = {pk(ot0[4 * g] * il, ot0[4 * g + 1] * il), pk(ot0[4 * g + 2] * il, ot0[4 * g + 3] * il)};
            u32x2 w1 = {pk(ot1[4 * g] * il, ot1[4 * g + 1] * il), pk(ot1[4 * g + 2] * il, ot1[4 * g + 3] * il)};
            *(u32x2*)(op + 8 * g) = w0; *(u32x2*)(op + 32 + 8 * g) = w1;
        }
    }
}

DI void ph_attn_mm_stag(const Ctx& cx, const Params& p, float* ldsf, bool with_ctx) {
    using namespace att;
    LAS unsigned char* lds = (LAS unsigned char*)ldsf;
    const int tid = cx.tid, wid = __builtin_amdgcn_readfirstlane(tid >> 6), lane = tid & 63, r = lane & 31, hh = lane >> 5, G = wid >> 2;
    const int nunits = 1024 + (with_ctx ? 128 : 0);
    int kg[3], kl[3], vg[2], vl[2];
#pragma unroll
    for (int i = 0; i < 3; ++i) { const int c = tid + 512 * i, row = c / 12, part = c % 12; kg[i] = row * 96 + part * 8; kl[i] = row * KP + part * 16; }
#pragma unroll
    for (int i = 0; i < 2; ++i) { const int c = tid + 512 * i, row = c >> 4, part = c & 15; vg[i] = row * 2304 + part * 8; vl[i] = KT_BYTES + row * VP + part * 16; }
    for (int u = cx.bid; u < nunits; u += cx.nblk) {
        int bh, qrow0, nkeys;
        if (u < 1024) { bh = u >> 3; qrow0 = (bh >> 3) * 2048 + (u & 7) * 256; nkeys = 2304; }
        else { bh = u - 1024; qrow0 = NLAT + (bh >> 3) * 256; nkeys = 256; }
        const int h = bh & 7;
        const bf16_t* Kb = p.Kf + (size_t)bh * 2304 * 96; const bf16_t* Vb = p.Vt + (size_t)bh * 64 * 2304;
        const bf16_t* qp = p.Qraw + (size_t)(qrow0 + wid * 32 + r) * 768 + h * 96 + 8 * hh;
        bf16x8 qf[6];
#pragma unroll
        for (int s = 0; s < 6; ++s) qf[s] = *(const bf16x8*)(qp + 16 * s);
        f32x16 ot0, ot1;
#pragma unroll
        for (int i = 0; i < 16; ++i) { ot0[i] = 0.f; ot1[i] = 0.f; }
        float mrun = -3.0e38f, lrun = 0.f;
        const int ntiles = nkeys >> 7;
        u32x4 kr[3], vr[2];
#define ATT_LOAD(t) do { const bf16_t* Kn = Kb + (size_t)(t) * 128 * 96; const bf16_t* Vn = Vb + (t) * 128; \
            _Pragma("unroll") for (int i = 0; i < 3; ++i) kr[i] = *(const u32x4*)(Kn + kg[i]); _Pragma("unroll") for (int i = 0; i < 2; ++i) vr[i] = *(const u32x4*)(Vn + vg[i]); } while (0)
#define ATT_WRITE(bufo) do { _Pragma("unroll") for (int i = 0; i < 3; ++i) *(LAS u32x4*)(lds + (bufo) + kl[i]) = kr[i]; \
            _Pragma("unroll") for (int i = 0; i < 2; ++i) { *(LAS u32x2*)(lds + (bufo) + vl[i]) = (u32x2){vr[i].x, vr[i].y}; *(LAS u32x2*)(lds + (bufo) + vl[i] + 8) = (u32x2){vr[i].z, vr[i].w}; } } while (0)
        ATT_LOAD(0); ATT_WRITE(0);
        ATT_LOAD(1); ATT_WRITE(BUF);
        __syncthreads();
        f32x16 st[4];
        for (int ph = 0; ph <= 2 * ntiles; ++ph) {
            if (ph & 1) {
                const int tw = (ph + 1) >> 1;
                if (tw >= 2 && tw < ntiles) ATT_WRITE((tw & 1) * BUF);
                if (tw + 1 < ntiles) ATT_LOAD(tw + 1);
            }
            const int e = ph - G;
            if (e >= 0 && e < 2 * ntiles) {
                const int bo = ((e >> 1) & 1) * BUF;
                if ((e & 1) == 0) {
#pragma unroll
                    for (int kb = 0; kb < 4; ++kb) {
#pragma unroll
                        for (int i = 0; i < 16; ++i) st[kb][i] = 0.f;
#pragma unroll
                        for (int s = 0; s < 6; ++s) { const bf16x8 kf = *(const LAS bf16x8*)(lds + bo + (kb * 32 + r) * KP + 32 * s + 16 * hh); st[kb] = ATT_MFMA(kf, qf[s], st[kb]); }
                    }
                    float mq[4];
#pragma unroll
                    for (int kb = 0; kb < 4; ++kb) { float a = fmaxf(st[kb][0], st[kb][1]), b = fmaxf(st[kb][2], st[kb][3]), c2 = fmaxf(st[kb][4], st[kb][5]), d = fmaxf(st[kb][6], st[kb][7]);
                        a = fmaxf(a, fmaxf(st[kb][8], st[kb][9])); b = fmaxf(b, fmaxf(st[kb][10], st[kb][11])); c2 = fmaxf(c2, fmaxf(st[kb][12], st[kb][13])); d = fmaxf(d, fmaxf(st[kb][14], st[kb][15]));
                        mq[kb] = fmaxf(fmaxf(a, b), fmaxf(c2, d)); }
                    float mt = fmaxf(fmaxf(mq[0], mq[1]), fmaxf(mq[2], mq[3]));
                    mt = xhalf_max(mt);
                    const float mnew = fmaxf(mrun, mt), alpha = __builtin_amdgcn_exp2f(mrun - mnew);
                    mrun = mnew;
                    float pq[4];
#pragma unroll
                    for (int kb = 0; kb < 4; ++kb) { float a = 0.f, b = 0.f;
#pragma unroll
                        for (int i = 0; i < 16; i += 2) { st[kb][i] = __builtin_amdgcn_exp2f(st[kb][i] - mnew); st[kb][i + 1] = __builtin_amdgcn_exp2f(st[kb][i + 1] - mnew); a += st[kb][i]; b += st[kb][i + 1]; }
                        pq[kb] = a + b; }
                    lrun = lrun * alpha + ((pq[0] + pq[1]) + (pq[2] + pq[3]));
#pragma unroll
                    for (int i = 0; i < 16; ++i) { ot0[i] *= alpha; ot1[i] *= alpha; }
                } else {
#pragma unroll
                    for (int kb = 0; kb < 4; ++kb)
#pragma unroll
                        for (int s = 0; s < 2; ++s) {
                            u32x4 pw; pw.x = pk(st[kb][8 * s], st[kb][8 * s + 1]); pw.y = pk(st[kb][8 * s + 2], st[kb][8 * s + 3]); pw.z = pk(st[kb][8 * s + 4], st[kb][8 * s + 5]); pw.w = pk(st[kb][8 * s + 6], st[kb][8 * s + 7]);
                            const bf16x8 pb = __builtin_bit_cast(bf16x8, pw);
                            const int col = (kb * 32 + 16 * s + 4 * hh) * 2;
                            const u32x2 a0 = *(const LAS u32x2*)(lds + bo + KT_BYTES + r * VP + col), a1 = *(const LAS u32x2*)(lds + bo + KT_BYTES + r * VP + col + 16);
                            const u32x2 b0 = *(const LAS u32x2*)(lds + bo + KT_BYTES + (32 + r) * VP + col), b1 = *(const LAS u32x2*)(lds + bo + KT_BYTES + (32 + r) * VP + col + 16);
                            const u32x4 va = {a0.x, a0.y, a1.x, a1.y}, vb = {b0.x, b0.y, b1.x, b1.y};
                            ot0 = ATT_MFMA(__builtin_bit_cast(bf16x8, va), pb, ot0);
                            ot1 = ATT_MFMA(__builtin_bit_cast(bf16x8, vb), pb, ot1);
                        }
                }
            }
            __syncthreads();
        }
#undef ATT_LOAD
#undef ATT_WRITE
        const float il = 1.f / xhalf_sum(lrun);
        bf16_t* op = p.H + (size_t)(qrow0 + wid * 32 + r) * 1024 + 512 + h * 64 + 4 * hh;
#pragma unroll
        for (int g = 0; g < 4; ++g) {
            u32x2 w0 = {pk(ot0[4 * g] * il, ot0[4 * g + 1] * il), pk(ot0[4 * g + 2] * il, ot0[4 * g + 3] * il)};
            u32x2 w1 = {pk(ot1[4 * g] * il, ot1[4 * g + 1] * il), pk(ot1[4 * g + 2] * il, ot1[4 * g + 3] * il)};
            *(u32x2*)(op + 8 * g) = w0; *(u32x2*)(op + 32 + 8 * g) = w1;
        }
    }
}

namespace scan {
typedef float f32x2 __attribute__((ext_vector_type(2)));
constexpr int REC = 400, CH = 32, BUFF = CH * REC, YOFF = 2 * BUFF;
DI float dppf(float v, int ctrl_sel) {
    const int x = __builtin_bit_cast(int, v);
    int r;
    if (ctrl_sel == 0) r = __builtin_amdgcn_update_dpp(0, x, 0xB1, 0xf, 0xf, true);
    else if (ctrl_sel == 1) r = __builtin_amdgcn_update_dpp(0, x, 0x4E, 0xf, 0xf, true);
    else r = __builtin_amdgcn_update_dpp(0, x, 0x141, 0xf, 0xf, true);
    return __builtin_bit_cast(float, r);
}
DI float red8(float v) { v += dppf(v, 0); v += dppf(v, 1); v += dppf(v, 2); return v; }
}
template <int ABL>
DI void ph_scan_opt(const Ctx& cx, const Params& p, float* lds, int j) {
    using namespace scan;
    const int tid = cx.tid, wid = __builtin_amdgcn_readfirstlane(tid >> 6), lane = tid & 63;
    for (int item = cx.bid; item < 256; item += cx.nblk) {
        const int b = item >> 4, h = (item >> 1) & 7, dir = item & 1;
        bf16_t* yout = dir ? p.YB : p.YF;
        if (wid >= 4) {
            const int pw = wid - 4, hc = h * 64 + lane;
            const float kkc = p.a_k_k[j * 512 + hc], kac = p.a_k_a[j * 512 + hc];
            const float mur = p.a_mu[j * ACOLS + hc], muk = p.a_mu[j * ACOLS + 512 + hc], muv = p.a_mu[j * ACOLS + 1024 + hc];
            LAS float* L = (LAS float*)lds;
            bf16_t raw[8][11];
#define SCAN_ROW(stepv, row_, t_, T_) const bool cp_ = (stepv) < 256; const int tt_ = cp_ ? (stepv) : (stepv) - 256, T_ = cp_ ? 256 : 2048, t_ = dir ? (T_ - 1 - tt_) : tt_; const int row_ = cp_ ? NLAT + b * 256 + t_ : b * 2048 + t_
#define SCAN_LOAD(cc) do { _Pragma("unroll") for (int it = 0; it < 8; ++it) { const int step = (cc) * CH + pw + 4 * it; SCAN_ROW(step, row, t, T); \
                const int rp_ = (t > 0) ? row - 1 : row, rn_ = (t < T - 1) ? row + 1 : row; \
                const bf16_t* pc = p.P + (size_t)row * PLD + hc; const bf16_t* pp = p.P + (size_t)rp_ * PLD + hc; const bf16_t* pn = p.P + (size_t)rn_ * PLD + hc; \
                raw[it][0] = pc[0]; raw[it][1] = pp[0]; raw[it][2] = pn[0]; raw[it][3] = pc[512]; raw[it][4] = pp[512]; raw[it][5] = pn[512]; raw[it][6] = pc[1024]; raw[it][7] = pp[1024]; raw[it][8] = pn[1024]; \
                raw[it][9] = p.WAG[(size_t)row * WLD + dir * 512 + hc]; raw[it][10] = p.WAG[(size_t)row * WLD + 1024 + dir * 512 + hc]; } } while (0)
            if (ABL != 1) SCAN_LOAD(0);
            for (int c = 0; c <= 73; ++c) {
                if (c >= 2 && ABL == 0) {
                    const LAS float* yb = L + YOFF + ((c - 2) & 1) * (CH * 64);
#pragma unroll
                    for (int it = 0; it < 8; ++it) {
                        const int sl = pw + 4 * it, step = (c - 2) * CH + sl; SCAN_ROW(step, row, t, T);
                        yout[(size_t)row * 512 + hc] = f2bf(yb[sl * 64 + lane]);
                    }
                }
                if (c < 72 && ABL != 1) {
                    LAS float* buf = L + (c & 1) * BUFF;
#pragma unroll
                    for (int it = 0; it < 8; ++it) {
                        const int sl = pw + 4 * it, step = c * CH + sl; SCAN_ROW(step, row, t, T); (void)row;
                        const float mp = (t > 0) ? 0.5f : 0.f, mn = (t < T - 1) ? 0.5f : 0.f;
                        const float rc = bf2f(raw[it][0]), kc_ = bf2f(raw[it][3]), vc = bf2f(raw[it][6]);
                        const float R = rc + mur * (mp * bf2f(raw[it][1]) + mn * bf2f(raw[it][2]) - rc);
                        const float K = kc_ + muk * (mp * bf2f(raw[it][4]) + mn * bf2f(raw[it][5]) - kc_);
                        const float V = vc + muv * (mp * bf2f(raw[it][7]) + mn * bf2f(raw[it][8]) - vc);
                        const float w = 1.f - bf2f(raw[it][9]), a = bf2f(raw[it][10]);
                        const float kkv = K * kkc, ssq = wave_sum(kkv * kkv), kk = kkv * rsqrtf(ssq + 1e-12f);
                        const float kd = K * (1.f + (a - 1.f) * kac), bd = kk * a;
                        const float br = wave_sum(bd * R), kr = wave_sum(kd * R);
                        LAS float* rec = buf + sl * REC;
                        rec[lane] = w; rec[64 + lane] = -kk; rec[128 + lane] = bd; rec[192 + lane] = kd; rec[256 + lane] = w * R; rec[320 + lane] = V;
                        if (lane == 0) { rec[384] = br; rec[385] = kr; }
                    }
                    if (c + 1 < 72) SCAN_LOAD(c + 1);
                }
                __syncthreads();
            }
#undef SCAN_LOAD
#undef SCAN_ROW
        } else {
            const int ct = tid, rp = ct >> 3, k8 = ct & 7;
            float S0[8], S1[8];
#pragma unroll
            for (int q = 0; q < 8; ++q) { S0[q] = 0.f; S1[q] = 0.f; }
            __syncthreads();
            for (int c = 0; c < 72; ++c) {
                const LAS float* buf = (const LAS float*)lds + (c & 1) * BUFF; LAS float* yb = (LAS float*)lds + YOFF + (c & 1) * (CH * 64);
                mm::f32x4 cw0, cw1, cn0, cn1, cb0, cb1, cd0, cd1, cr0, cr1; scan::f32x2 cvv, csc;
#define SCAN_LD(recp, W0, W1, N0, N1, B0, B1, D0, D1, R0_, R1_, VV, SC) do { const LAS float* r_ = (recp); \
                    W0 = *(const LAS mm::f32x4*)(r_ + k8 * 8); W1 = *(const LAS mm::f32x4*)(r_ + k8 * 8 + 4); N0 = *(const LAS mm::f32x4*)(r_ + 64 + k8 * 8); N1 = *(const LAS mm::f32x4*)(r_ + 64 + k8 * 8 + 4); \
                    B0 = *(const LAS mm::f32x4*)(r_ + 128 + k8 * 8); B1 = *(const LAS mm::f32x4*)(r_ + 128 + k8 * 8 + 4); D0 = *(const LAS mm::f32x4*)(r_ + 192 + k8 * 8); D1 = *(const LAS mm::f32x4*)(r_ + 192 + k8 * 8 + 4); \
                    R0_ = *(const LAS mm::f32x4*)(r_ + 256 + k8 * 8); R1_ = *(const LAS mm::f32x4*)(r_ + 256 + k8 * 8 + 4); VV = *(const LAS scan::f32x2*)(r_ + 320 + 2 * rp); SC = *(const LAS scan::f32x2*)(r_ + 384); } while (0)
                SCAN_LD(buf, cw0, cw1, cn0, cn1, cb0, cb1, cd0, cd1, cr0, cr1, cvv, csc);
#pragma unroll 2
                for (int sl = 0; sl < (ABL == 2 ? 0 : CH); ++sl) {
                    mm::f32x4 nw0, nw1, nn0, nn1, nb0, nb1, nd0, nd1, nr0, nr1; scan::f32x2 nvv, nsc;
                    SCAN_LD(buf + (sl + 1 < CH ? sl + 1 : sl) * REC, nw0, nw1, nn0, nn1, nb0, nb1, nd0, nd1, nr0, nr1, nvv, nsc);
                    const float wv[8] = {cw0[0], cw0[1], cw0[2], cw0[3], cw1[0], cw1[1], cw1[2], cw1[3]}, nv[8] = {cn0[0], cn0[1], cn0[2], cn0[3], cn1[0], cn1[1], cn1[2], cn1[3]};
                    const float bv[8] = {cb0[0], cb0[1], cb0[2], cb0[3], cb1[0], cb1[1], cb1[2], cb1[3]}, dv[8] = {cd0[0], cd0[1], cd0[2], cd0[3], cd1[0], cd1[1], cd1[2], cd1[3]};
                    const float rv[8] = {cr0[0], cr0[1], cr0[2], cr0[3], cr1[0], cr1[1], cr1[2], cr1[3]};
                    float sa0 = 0.f, sa1 = 0.f, y0 = 0.f, y1 = 0.f;
#pragma unroll
                    for (int q = 0; q < 8; ++q) { sa0 += S0[q] * nv[q]; sa1 += S1[q] * nv[q]; y0 += S0[q] * rv[q]; y1 += S1[q] * rv[q]; }
                    sa0 = red8(sa0); sa1 = red8(sa1); y0 = red8(y0); y1 = red8(y1);
                    y0 += sa0 * csc[0] + cvv[0] * csc[1]; y1 += sa1 * csc[0] + cvv[1] * csc[1];
#pragma unroll
                    for (int q = 0; q < 8; ++q) { S0[q] = S0[q] * wv[q] + sa0 * bv[q] + cvv[0] * dv[q]; S1[q] = S1[q] * wv[q] + sa1 * bv[q] + cvv[1] * dv[q]; }
                    if (k8 == 0) *(LAS scan::f32x2*)(yb + sl * 64 + 2 * rp) = (scan::f32x2){y0, y1};
                    cw0 = nw0; cw1 = nw1; cn0 = nn0; cn1 = nn1; cb0 = nb0; cb1 = nb1; cd0 = nd0; cd1 = nd1; cr0 = nr0; cr1 = nr1; cvv = nvv; csc = nsc;
                }
#undef SCAN_LD
                __syncthreads();
            }
            __syncthreads();
        }
    }
}

namespace sc2 {
typedef short bf16x8 __attribute__((ext_vector_type(8)));
typedef float f32x4 __attribute__((ext_vector_type(4)));
typedef unsigned u32x4 __attribute__((ext_vector_type(4)));
typedef unsigned u32x2 __attribute__((ext_vector_type(2)));
constexpr int NP = 6;
constexpr int O_AH = 0, O_RH = 2048, O_BK = 4096, O_VM = 8192, O_GC = 10240, O_AAB = 10496, O_AAK = 11520, O_ARK = 12032, O_BH = 13056, O_KH = 15104, SLOT = 17152;
constexpr int O_S0 = NP * SLOT, O_RHS = O_S0 + 8192, O_ZU = O_RHS + 4096, O_FLAG = O_ZU + 2048, TOTAL = O_FLAG + 256;
#define SC_MFMA(a, b, c) __builtin_amdgcn_mfma_f32_16x16x32_bf16((a), (b), (c), 0, 0, 0)
DI unsigned pk2(float a, float b) { return att::pk(a, b); }
DI int ldv(volatile LAS int* p) { return *p; }
}
template <int ABL>
DI void ph_scan_chunk(const Ctx& cx, const Params& p, float* ldsg, int j) {
    using namespace sc2;
    static_assert(TOTAL <= 128 * 1024, "scan LDS map");
    LAS unsigned char* L = (LAS unsigned char*)ldsg;
    volatile LAS int* ready = (volatile LAS int*)(L + O_FLAG); volatile LAS int* done = ready + 8;
    const int tid = cx.tid, wid = __builtin_amdgcn_readfirstlane(tid >> 6), lane = tid & 63, lq = lane >> 4, lr = lane & 15;
    constexpr int NCH = 144;
    for (int item = cx.bid; item < 256; item += cx.nblk) {
        const int b = item >> 4, h = (item >> 1) & 7, dir = item & 1;
        bf16_t* yout = dir ? p.YB : p.YF;
        __syncthreads();
        if (tid < 32) ready[tid] = 0;
        __syncthreads();
#define SC_ROW(stepv, row_, t_, T_) const bool cp_ = (stepv) < 256; const int tt_ = cp_ ? (stepv) : (stepv) - 256, T_ = cp_ ? 256 : 2048, t_ = dir ? (T_ - 1 - tt_) : tt_; const int row_ = cp_ ? NLAT + b * 256 + t_ : b * 2048 + t_
        if (wid < 2) {
            __builtin_amdgcn_s_setprio(3);
            const int g = wid, vb0 = 2 * g;
            f32x4 S[4][2];
#pragma unroll
            for (int kb = 0; kb < 4; ++kb)
#pragma unroll
                for (int vb = 0; vb < 2; ++vb) S[kb][vb] = (f32x4){0.f, 0.f, 0.f, 0.f};
            for (int c = 0; c < NCH; ++c) {
                const int sl = c % NP; LAS unsigned char* SB = L + sl * SLOT;
                { unsigned spins = 0; while (ldv(ready + sl) != c + 1) { __builtin_amdgcn_s_sleep(1); if (++spins > (1u << 22)) break; } }
                asm volatile("" ::: "memory");
                if (ABL == 2) { if (lane == 0) done[g * 8 + sl] = c + 1; continue; }
                f32x4 cA[8][2];
#pragma unroll
                for (int t = 1; t <= 8; ++t)
#pragma unroll
                    for (int q = 0; q < 2; ++q) if (4 * q < t) cA[t - 1][q] = *(const LAS f32x4*)(SB + O_AAB + t * 64 + q * 16);
#pragma unroll
                for (int kb = 0; kb < 4; ++kb)
#pragma unroll
                    for (int vq = 0; vq < 2; ++vq) { const f32x4 x = S[kb][vq]; *(LAS u32x2*)(L + O_S0 + (16 * (vb0 + vq) + lr) * 128 + (16 * kb + 4 * lq) * 2) = (u32x2){pk2(x[0], x[1]), pk2(x[2], x[3])}; }
                {
                    bf16x8 ah[2], ak, sf[2][2], vmf[2];
#pragma unroll
                    for (int ks = 0; ks < 2; ++ks) ah[ks] = *(const LAS bf16x8*)(SB + O_AH + lr * 128 + ks * 64 + lq * 16);
                    { u32x4 z = {0u, 0u, 0u, 0u}; if (lq < 2) z = *(const LAS u32x4*)(SB + O_AAK + lr * 32 + lq * 16); ak = __builtin_bit_cast(bf16x8, z); }
#pragma unroll
                    for (int vq = 0; vq < 2; ++vq) { const int vb = vb0 + vq;
#pragma unroll
                        for (int ks = 0; ks < 2; ++ks) sf[vq][ks] = *(const LAS bf16x8*)(L + O_S0 + (16 * vb + lr) * 128 + ks * 64 + lq * 16);
                        u32x4 z = {0u, 0u, 0u, 0u}; if (lq < 2) z = *(const LAS u32x4*)(SB + O_VM + (16 * vb + lr) * 32 + lq * 16); vmf[vq] = __builtin_bit_cast(bf16x8, z);
                    }
                    f32x4 acc[2];
#pragma unroll
                    for (int vq = 0; vq < 2; ++vq) { acc[vq] = (f32x4){0.f, 0.f, 0.f, 0.f}; acc[vq] = SC_MFMA(sf[vq][0], ah[0], acc[vq]); acc[vq] = SC_MFMA(sf[vq][1], ah[1], acc[vq]); acc[vq] = SC_MFMA(vmf[vq], ak, acc[vq]); }
#pragma unroll
                    for (int vq = 0; vq < 2; ++vq)
#pragma unroll
                        for (int q = 0; q < 4; ++q) *(LAS float*)(L + O_RHS + ((16 * (vb0 + vq) + 4 * lq + q) * 16 + lr) * 4) = acc[vq][q];
                }
                float u[16];
                const int vl = 32 * g + (lane & 31);
                { const LAS f32x4* rp = (const LAS f32x4*)(L + O_RHS + vl * 64);
#pragma unroll
                  for (int q = 0; q < 4; ++q) { const f32x4 x = rp[q]; u[4 * q] = x[0]; u[4 * q + 1] = x[1]; u[4 * q + 2] = x[2]; u[4 * q + 3] = x[3]; } }
#define SC_SUBST(t, CF) do { float a0 = u[t], a1 = 0.f; \
                    _Pragma("unroll") for (int q = 0; q < 4; ++q) { if (4 * q < (t)) { const f32x4 cf = CF[q]; \
                        _Pragma("unroll") for (int e = 0; e < 4; ++e) { if (4 * q + e < (t)) { if (e & 1) a1 += cf[e] * u[4 * q + e]; else a0 += cf[e] * u[4 * q + e]; } } } } \
                    u[t] = a0 + a1; } while (0)
                f32x4 cB[4][3], cC[3][4];
#pragma unroll
                for (int t = 9; t <= 12; ++t)
#pragma unroll
                    for (int q = 0; q < 3; ++q) cB[t - 9][q] = *(const LAS f32x4*)(SB + O_AAB + t * 64 + q * 16);
                asm volatile("" ::: "memory");
                SC_SUBST(1, cA[0]); SC_SUBST(2, cA[1]); SC_SUBST(3, cA[2]); SC_SUBST(4, cA[3]); SC_SUBST(5, cA[4]); SC_SUBST(6, cA[5]); SC_SUBST(7, cA[6]); SC_SUBST(8, cA[7]);
                asm volatile("" ::: "memory");
#pragma unroll
                for (int t = 13; t <= 15; ++t)
#pragma unroll
                    for (int q = 0; q < 4; ++q) cC[t - 13][q] = *(const LAS f32x4*)(SB + O_AAB + t * 64 + q * 16);
                asm volatile("" ::: "memory");
                SC_SUBST(9, cB[0]); SC_SUBST(10, cB[1]); SC_SUBST(11, cB[2]); SC_SUBST(12, cB[3]);
                SC_SUBST(13, cC[0]); SC_SUBST(14, cC[1]); SC_SUBST(15, cC[2]);
#undef SC_SUBST
                { u32x4 w0 = {pk2(u[0], u[1]), pk2(u[2], u[3]), pk2(u[4], u[5]), pk2(u[6], u[7])}, w1 = {pk2(u[8], u[9]), pk2(u[10], u[11]), pk2(u[12], u[13]), pk2(u[14], u[15])};
                  if (lane < 32) { *(LAS u32x4*)(L + O_ZU + vl * 32) = w0; *(LAS u32x4*)(L + O_ZU + vl * 32 + 16) = w1; } }
                {
                    bf16x8 zf[2], sf[2][2], bkf[4]; f32x4 gc[4];
#pragma unroll
                    for (int vq = 0; vq < 2; ++vq) { const int vb = vb0 + vq;
                        zf[vq] = (lq < 2) ? *(const LAS bf16x8*)(L + O_ZU + (16 * vb + lr) * 32 + lq * 16) : *(const LAS bf16x8*)(SB + O_VM + (16 * vb + lr) * 32 + (lq - 2) * 16);
#pragma unroll
                        for (int ks = 0; ks < 2; ++ks) sf[vq][ks] = *(const LAS bf16x8*)(L + O_S0 + (16 * vb + lr) * 128 + ks * 64 + lq * 16);
                    }
                    const bf16x8 rk = *(const LAS bf16x8*)(SB + O_ARK + lr * 64 + lq * 16);
                    const bf16x8 rh0 = *(const LAS bf16x8*)(SB + O_RH + lr * 128 + lq * 16), rh1 = *(const LAS bf16x8*)(SB + O_RH + lr * 128 + 64 + lq * 16);
#pragma unroll
                    for (int kb = 0; kb < 4; ++kb) { gc[kb] = *(const LAS f32x4*)(SB + O_GC + (16 * kb + 4 * lq) * 4); bkf[kb] = *(const LAS bf16x8*)(SB + O_BK + (16 * kb + lr) * 64 + lq * 16); }
                    const int step = c * 16 + lr; SC_ROW(step, row, tq, Tq); (void)tq; (void)Tq;
#pragma unroll
                    for (int vq = 0; vq < 2; ++vq) { f32x4 y = {0.f, 0.f, 0.f, 0.f};
                        y = SC_MFMA(sf[vq][0], rh0, y); y = SC_MFMA(sf[vq][1], rh1, y); y = SC_MFMA(zf[vq], rk, y);
                        if (ABL == 0) *(u32x2*)(yout + (size_t)row * 512 + h * 64 + 16 * (vb0 + vq) + 4 * lq) = (u32x2){pk2(y[0], y[1]), pk2(y[2], y[3])}; else asm volatile("" :: "v"(y[0]), "v"(y[1]), "v"(y[2]), "v"(y[3])); }
#pragma unroll
                    for (int kb = 0; kb < 4; ++kb)
#pragma unroll
                        for (int vq = 0; vq < 2; ++vq) S[kb][vq] = SC_MFMA(bkf[kb], zf[vq], S[kb][vq] * gc[kb]);
                }
                asm volatile("s_waitcnt lgkmcnt(0)" ::: "memory");
                if (lane == 0) done[g * 8 + sl] = c + 1;
            }
            __builtin_amdgcn_s_setprio(0);
        } else {
            const int pw = wid - 2, hc = h * 64 + lane; LAS unsigned char* SB = L + pw * SLOT;
            const float kkc = p.a_k_k[j * 512 + hc], kac = p.a_k_a[j * 512 + hc];
            const float mur = p.a_mu[j * ACOLS + hc], muk = p.a_mu[j * ACOLS + 512 + hc], muv = p.a_mu[j * ACOLS + 1024 + hc];
            for (int c = pw; c < NCH; c += NP) {
                if (ABL == 1) { if (c >= NP) { unsigned spins = 0; while (ldv(done + pw) != c - NP + 1 || ldv(done + 8 + pw) != c - NP + 1) { __builtin_amdgcn_s_sleep(2); if (++spins > (1u << 22)) break; } } if (lane == 0) ready[pw] = c + 1; continue; }
                bf16_t raw[16][11];
#define SC_LOAD(t) do { const int step = c * 16 + (t); SC_ROW(step, row, tq, Tq); \
                    const int rp_ = (tq > 0) ? row - 1 : row, rn_ = (tq < Tq - 1) ? row + 1 : row; \
                    const bf16_t* pc = p.P + (size_t)row * PLD + hc; const bf16_t* pp = p.P + (size_t)rp_ * PLD + hc; const bf16_t* pn = p.P + (size_t)rn_ * PLD + hc; \
                    raw[t][0] = pc[0]; raw[t][1] = pp[0]; raw[t][2] = pn[0]; raw[t][3] = pc[512]; raw[t][4] = pp[512]; raw[t][5] = pn[512]; raw[t][6] = pc[1024]; raw[t][7] = pp[1024]; raw[t][8] = pn[1024]; \
                    raw[t][9] = p.WAG[(size_t)row * WLD + dir * 512 + hc]; raw[t][10] = p.WAG[(size_t)row * WLD + 1024 + dir * 512 + hc]; } while (0)
#define SC_STEP(t) do { const int step = c * 16 + (t); SC_ROW(step, row, tq, Tq); (void)row; \
                    const float mp = (tq > 0) ? 0.5f : 0.f, mn = (tq < Tq - 1) ? 0.5f : 0.f; \
                    const float rc = bf2f(raw[t][0]), kc_ = bf2f(raw[t][3]), vc = bf2f(raw[t][6]); \
                    const float R = rc + mur * (mp * bf2f(raw[t][1]) + mn * bf2f(raw[t][2]) - rc); \
                    const float K = kc_ + muk * (mp * bf2f(raw[t][4]) + mn * bf2f(raw[t][5]) - kc_); \
                    const float Vv = vc + muv * (mp * bf2f(raw[t][7]) + mn * bf2f(raw[t][8]) - vc); \
                    const float w = 1.f - bf2f(raw[t][9]), a = bf2f(raw[t][10]); \
                    const float kkv = K * kkc, ssq = wave_sum(kkv * kkv), kk = kkv * rsqrtf(ssq + 1e-12f); \
                    const float kd = K * (1.f + (a - 1.f) * kac), bd = kk * a; \
                    const float gprev = g; g *= w; const float ig = __builtin_amdgcn_rcpf(g); \
                    *(LAS bf16_t*)(SB + O_AH + (t) * 128 + lane * 2) = f2bf(-kk * gprev); \
                    *(LAS bf16_t*)(SB + O_RH + (t) * 128 + lane * 2) = f2bf(R * g); \
                    *(LAS bf16_t*)(SB + O_BH + (t) * 128 + lane * 2) = f2bf(bd * ig); \
                    *(LAS bf16_t*)(SB + O_KH + (t) * 128 + lane * 2) = f2bf(kd * ig); \
                    *(LAS bf16_t*)(SB + O_VM + lane * 32 + (t) * 2) = f2bf(Vv); } while (0)
                SC_LOAD(0); SC_LOAD(1); SC_LOAD(2); SC_LOAD(3); SC_LOAD(4); SC_LOAD(5); SC_LOAD(6); SC_LOAD(7);
                if (c >= NP) { unsigned spins = 0; while (ldv(done + pw) != c - NP + 1 || ldv(done + 8 + pw) != c - NP + 1) { __builtin_amdgcn_s_sleep(2); if (++spins > (1u << 22)) break; } }
                asm volatile("" ::: "memory");
                float g = 1.f;
                SC_STEP(0); SC_STEP(1); SC_STEP(2); SC_STEP(3);
                asm volatile("" ::: "memory");
                SC_LOAD(8); SC_LOAD(9); SC_LOAD(10); SC_LOAD(11);
                asm volatile("" ::: "memory");
                SC_STEP(4); SC_STEP(5); SC_STEP(6); SC_STEP(7);
                asm volatile("" ::: "memory");
                SC_LOAD(12); SC_LOAD(13); SC_LOAD(14); SC_LOAD(15);
                asm volatile("" ::: "memory");
                SC_STEP(8); SC_STEP(9); SC_STEP(10); SC_STEP(11); SC_STEP(12); SC_STEP(13); SC_STEP(14); SC_STEP(15);
#undef SC_LOAD
#undef SC_STEP
#pragma unroll
                for (int q = 0; q < 2; ++q) {
                    float bq[8], kq[8];
#pragma unroll
                    for (int e = 0; e < 8; ++e) { bq[e] = bf2f(*(const LAS bf16_t*)(SB + O_BH + (8 * q + e) * 128 + lane * 2)) * g; kq[e] = bf2f(*(const LAS bf16_t*)(SB + O_KH + (8 * q + e) * 128 + lane * 2)) * g; }
                    u32x4 wb = {pk2(bq[0], bq[1]), pk2(bq[2], bq[3]), pk2(bq[4], bq[5]), pk2(bq[6], bq[7])}, wk = {pk2(kq[0], kq[1]), pk2(kq[2], kq[3]), pk2(kq[4], kq[5]), pk2(kq[6], kq[7])};
                    *(LAS u32x4*)(SB + O_BK + lane * 64 + q * 16) = wb; *(LAS u32x4*)(SB + O_BK + lane * 64 + 32 + q * 16) = wk;
                }
                *(LAS float*)(SB + O_GC + lane * 4) = g;
                f32x4 sab = {0.f, 0.f, 0.f, 0.f}, sak = sab, srb = sab, srk = sab;
#pragma unroll
                for (int ks = 0; ks < 2; ++ks) {
                    const bf16x8 fa = *(const LAS bf16x8*)(SB + O_AH + lr * 128 + ks * 64 + lq * 16), fr = *(const LAS bf16x8*)(SB + O_RH + lr * 128 + ks * 64 + lq * 16);
                    const bf16x8 fb = *(const LAS bf16x8*)(SB + O_BH + lr * 128 + ks * 64 + lq * 16), fk = *(const LAS bf16x8*)(SB + O_KH + lr * 128 + ks * 64 + lq * 16);
                    sab = SC_MFMA(fa, fb, sab); sak = SC_MFMA(fa, fk, sak); srb = SC_MFMA(fr, fb, srb); srk = SC_MFMA(fr, fk, srk);
                }
#pragma unroll
                for (int q = 0; q < 4; ++q) { const int t = 4 * lq + q; const bool lo = lr < t, le = lr <= t;
                    *(LAS float*)(SB + O_AAB + (t * 16 + lr) * 4) = lo ? sab[q] : 0.f;
                    *(LAS bf16_t*)(SB + O_AAK + (t * 16 + lr) * 2) = f2bf(lo ? sak[q] : 0.f);
                    *(LAS bf16_t*)(SB + O_ARK + (t * 32 + lr) * 2) = f2bf(le ? srb[q] : 0.f);
                    *(LAS bf16_t*)(SB + O_ARK + (t * 32 + 16 + lr) * 2) = f2bf(le ? srk[q] : 0.f); }
                asm volatile("s_waitcnt lgkmcnt(0)" ::: "memory");
                if (lane == 0) ready[pw] = c + 1;
            }
        }
#undef SC_ROW
        __syncthreads();
    }
}

DI void unpack8u(const uint4 u, float (&d)[8]) { d[0] = bflo(u.x); d[1] = bfhi(u.x); d[2] = bflo(u.y); d[3] = bfhi(u.y); d[4] = bflo(u.z); d[5] = bfhi(u.z); d[6] = bflo(u.w); d[7] = bfhi(u.w); }
DI uint4 pack8u(const float (&d)[8]) { uint4 u; u.x = att::pk(d[0], d[1]); u.y = att::pk(d[2], d[3]); u.z = att::pk(d[4], d[5]); u.w = att::pk(d[6], d[7]); return u; }
DI void shift8(const bf16_t* P, int row, int t, int T, int col0, const float (&mu)[8], float (&o)[8]) {
    float c[8], pv[8], nx[8];
    unpack8u(*(const uint4*)(P + (size_t)row * PLD + col0), c);
    if (t > 0) unpack8u(*(const uint4*)(P + (size_t)(row - 1) * PLD + col0), pv); else {
#pragma unroll
        for (int i = 0; i < 8; ++i) pv[i] = 0.f; }
    if (t < T - 1) unpack8u(*(const uint4*)(P + (size_t)(row + 1) * PLD + col0), nx); else {
#pragma unroll
        for (int i = 0; i < 8; ++i) nx[i] = 0.f; }
#pragma unroll
    for (int i = 0; i < 8; ++i) o[i] = c[i] + mu[i] * (0.5f * (pv[i] + nx[i]) - c[i]);
}
DI void ld8f(const float* p, float (&d)[8]) { const float4 a = *(const float4*)p, b = *(const float4*)(p + 4); d[0] = a.x; d[1] = a.y; d[2] = a.z; d[3] = a.w; d[4] = b.x; d[5] = b.y; d[6] = b.z; d[7] = b.w; }
DI void ph_post_opt(const Ctx& cx, const Params& p, int j, int nrows) {
    const int tid = cx.tid, wid = tid >> 6, lane = tid & 63, c0 = lane * 8;
    float mur[8], muk[8], muv[8], ka[8], rk[8], lw[8], lb[8];
    ld8f(p.a_mu + j * ACOLS + c0, mur); ld8f(p.a_mu + j * ACOLS + 512 + c0, muk); ld8f(p.a_mu + j * ACOLS + 1024 + c0, muv);
    ld8f(p.a_k_a + j * 512 + c0, ka); ld8f(p.a_r_k + j * 512 + c0, rk); ld8f(p.a_ln_w + j * 512 + c0, lw); ld8f(p.a_ln_b + j * 512 + c0, lb);
    for (int row = cx.bid * 8 + wid; row < nrows; row += cx.nblk * 8) {
        const bool lat = row < NLAT; const int t = lat ? (row & 2047) : ((row - NLAT) & 255); const int T = lat ? 2048 : 256;
        float yf[8], yb[8], R[8], K[8], V[8], af[8], ab[8], g[8];
        unpack8u(*(const uint4*)(p.YF + (size_t)row * 512 + c0), yf); unpack8u(*(const uint4*)(p.YB + (size_t)row * 512 + c0), yb);
        shift8(p.P, row, t, T, c0, mur, R); shift8(p.P, row, t, T, 512 + c0, muk, K); shift8(p.P, row, t, T, 1024 + c0, muv, V);
        unpack8u(*(const uint4*)(p.WAG + (size_t)row * WLD + 1024 + c0), af); unpack8u(*(const uint4*)(p.WAG + (size_t)row * WLD + 1536 + c0), ab); unpack8u(*(const uint4*)(p.WAG + (size_t)row * WLD + 2048 + c0), g);
        float sum = 0.f, sb = 0.f;
#pragma unroll
        for (int i = 0; i < 8; ++i) { yf[i] += yb[i]; sum += yf[i]; sb += R[i] * rk[i] * K[i] * (2.f + (af[i] + ab[i] - 2.f) * ka[i]); }
        sum = scan::red8(sum); sb = scan::red8(sb);
        const float mean = sum * (1.f / 64.f); float var = 0.f;
#pragma unroll
        for (int i = 0; i < 8; ++i) { const float d = yf[i] - mean; var += d * d; }
        var = scan::red8(var);
        const float rstd = rsqrtf(var * (1.f / 64.f) + 64e-5f);
        float o[8];
#pragma unroll
        for (int i = 0; i < 8; ++i) o[i] = ((yf[i] - mean) * rstd * lw[i] + lb[i] + sb * V[i]) * g[i];
        *(uint4*)(p.H + (size_t)row * 1024 + c0) = pack8u(o);
    }
}
DI void fin_vec(float (&x)[8], int c, int t, bool lat, const float (&gn)[8], float scl, bf16_t* dst) {
    float ss = 0.f;
#pragma unroll
    for (int i = 0; i < 8; ++i) ss += x[i] * x[i];
    ss += dpp_f<0xB1>(ss); ss += dpp_f<0x4E>(ss); ss += dpp_f<0x141>(ss); ss += dpp_f<0x140>(ss);
    const float r = rsqrtf(ss * (1.f / 96.f) + 1e-6f);
#pragma unroll
    for (int i = 0; i < 8; ++i) x[i] = x[i] * r * gn[i];
    float y[8];
#pragma unroll
    for (int i = 0; i < 8; ++i) { const float up = dpp_f<0x102>(x[i]), dn = dpp_f<0x112>(x[i]); y[i] = (c < 10) ? up : dn; }
    if (lat && c >= 8 && c < 12) {
        const float invf[8] = {1.f, 0.316227766016838f, 0.1f, 0.0316227766016838f, 0.01f, 0.00316227766016838f, 0.001f, 0.000316227766016838f};
        const float pos = (c & 1) ? (float)(t & 63) : (float)(t >> 6);
#pragma unroll
        for (int i = 0; i < 8; ++i) { const float ang = pos * invf[i], cs = __cosf(ang), sn = __sinf(ang); x[i] = (c < 10) ? (x[i] * cs - y[i] * sn) : (x[i] * cs + y[i] * sn); }
    }
    if (c < 12) {
#pragma unroll
        for (int i = 0; i < 8; ++i) x[i] *= scl;
        *(uint4*)(dst + c * 8) = pack8u(x);
    }
}
DI void ph_finalize_opt(const Ctx& cx, const Params& p, float* ldsf, int j, int mq) {
    const int tid = cx.tid, wid = tid >> 6, lane = tid & 63, c = lane & 15, hq = lane >> 4;
    float qg[8], kg[8]; ld8f(p.b_q_gain + j * 96 + (c < 12 ? c : 0) * 8, qg); ld8f(p.b_k_gain + j * 96 + (c < 12 ? c : 0) * 8, kg);
    for (int row0 = (cx.bid * 8 + wid) * 2; row0 < NT; row0 += cx.nblk * 16) {
        float xq[4][8], xk[4][8];
#pragma unroll
        for (int u = 0; u < 4; ++u) {
            const int row = row0 + (u >> 1), h = (u & 1) * 4 + hq;
#pragma unroll
            for (int i = 0; i < 8; ++i) { xq[u][i] = 0.f; xk[u][i] = 0.f; }
            if (row < mq && c < 12) unpack8u(*(const uint4*)(p.Qraw + (size_t)row * 768 + h * 96 + c * 8), xq[u]);
            if (c < 8) unpack8u(*(const uint4*)(p.KVraw + (size_t)row * 1024 + h * 128 + c * 8), xk[u]);
            else if (c < 12) unpack8u(*(const uint4*)(p.P + (size_t)row * PLD + ACOLS + 384 + (c - 8) * 8), xk[u]);
        }
#pragma unroll
        for (int u = 0; u < 4; ++u) {
            const int row = row0 + (u >> 1), h = (u & 1) * 4 + hq;
            const bool lat = row < NLAT; const int b = lat ? (row >> 11) : ((row - NLAT) >> 8); const int t = lat ? (row & 2047) : ((row - NLAT) & 255);
            if (row < mq) fin_vec(xq[u], c, t, lat, qg, 0.10206207261596577f * 1.4426950408889634f, p.Qraw + (size_t)row * 768 + h * 96);
            const int key = lat ? 256 + t : t;
            fin_vec(xk[u], c, t, lat, kg, 1.f, p.Kf + ((size_t)(b * 8 + h) * 2304 + key) * 96);
        }
    }
    bf16_t* T = (bf16_t*)ldsf; constexpr int TP = 520;
    for (int tile = cx.bid; tile < NT / 64; tile += cx.nblk) {
        const int row0 = tile * 64; const bool lat = row0 < NLAT; const int b = lat ? (row0 >> 11) : ((row0 - NLAT) >> 8); const int t0 = lat ? (row0 & 2047) : ((row0 - NLAT) & 255);
        const int key0 = lat ? 256 + t0 : t0;
        __syncthreads();
#pragma unroll
        for (int i = 0; i < 8; ++i) { const int ch = tid + 512 * i, kr = ch >> 6, cc = ch & 63, h = cc >> 3, part = cc & 7;
            *(uint4*)(T + kr * TP + h * 64 + part * 8) = *(const uint4*)(p.KVraw + (size_t)(row0 + kr) * 1024 + h * 128 + 64 + part * 8); }
        __syncthreads();
#pragma unroll
        for (int i = 0; i < 8; ++i) { const int ch = tid + 512 * i, hd = ch >> 3, kc = ch & 7;
            float v[8];
#pragma unroll
            for (int q = 0; q < 8; ++q) v[q] = bf2f(T[(kc * 8 + q) * TP + hd]);
            uint4 o; o.x = (unsigned)T[(kc * 8 + 0) * TP + hd] | ((unsigned)T[(kc * 8 + 1) * TP + hd] << 16); o.y = (unsigned)T[(kc * 8 + 2) * TP + hd] | ((unsigned)T[(kc * 8 + 3) * TP + hd] << 16);
            o.z = (unsigned)T[(kc * 8 + 4) * TP + hd] | ((unsigned)T[(kc * 8 + 5) * TP + hd] << 16); o.w = (unsigned)T[(kc * 8 + 6) * TP + hd] | ((unsigned)T[(kc * 8 + 7) * TP + hd] << 16);
            (void)v;
            *(uint4*)(p.Vt + ((size_t)(b * 8 + (hd >> 6)) * 64 + (hd & 63)) * 2304 + key0 + kc * 8) = o; }
    }
    __syncthreads();
}
DI void ph_mod_opt(const Ctx& cx, const Params& p, float* lds) {
    const int tid = cx.tid, wid = tid >> 6, lane = tid & 63;
    float* part = lds + 17 * 1024;
    for (int i = tid; i < 17 * 1024; i += NTHR) { const int jj = i >> 10, k = i & 1023; const float v = (jj < 16) ? p.c[jj * 1024 + k] : p.c_ctx[k]; lds[i] = siluf(v); }
    __syncthreads();
    for (int item = cx.bid; item < 4 * 96; item += cx.nblk) {
        const int l = item / 96, n = (item % 96) * 64 + lane;
        const float* w = p.mod_w + (size_t)l * 1024 * 6144 + n;
        float acc[17];
#pragma unroll
        for (int jj = 0; jj < 17; ++jj) acc[jj] = 0.f;
        for (int k0 = wid * 128; k0 < wid * 128 + 128; k0 += 16) {
            float wv[16];
#pragma unroll
            for (int q = 0; q < 16; ++q) wv[q] = w[(size_t)(k0 + q) * 6144];
#pragma unroll
            for (int q = 0; q < 16; ++q)
#pragma unroll
                for (int jj = 0; jj < 17; ++jj) acc[jj] += lds[jj * 1024 + k0 + q] * wv[q];
        }
#pragma unroll
        for (int jj = 0; jj < 17; ++jj) part[(wid * 17 + jj) * 64 + lane] = acc[jj];
        __syncthreads();
        for (int o = tid; o < 17 * 64; o += NTHR) { const int jj = o >> 6, ln = o & 63; float sacc = p.mod_b[l * 6144 + (item % 96) * 64 + ln];
#pragma unroll
            for (int q = 0; q < 8; ++q) sacc += part[(q * 17 + jj) * 64 + ln];
            p.mod[((size_t)l * 17 + jj) * 6144 + (item % 96) * 64 + ln] = sacc; }
        __syncthreads();
    }
}

DI void ph_norm2_router(const Ctx& cx, const Params& p, float* ldsg, int nrows, const float* gain, const float* modl, int layer, const bf16_t* xb_lat) {
    LAS float* lds = (LAS float*)ldsg;
    const int tid = cx.tid, wid = tid >> 6, lane = tid & 63;
    LAS float* rw = lds; LAS float* red = lds + 16 * 1024 + wid * (32 * 64 + 64); LAS float* my = red + 32 * 64;
    LAS int* lcnt = (LAS int*)(lds + 16 * 1024 + 8 * (32 * 64 + 64)); LAS int* lbase = lcnt + 16; LAS int* rlist = lcnt + 32;
    for (int i = tid; i < 16 * 1024; i += NTHR) { const int e = i >> 10, col = i & 1023; rw[i] = p.router_w[col * 16 + e]; }
    if (tid < 16) lcnt[tid] = 0;
    __syncthreads();
    int nlist = 0;
    uint2 raw[2][4];
#define N2_LOAD(pi) do { _Pragma("unroll") for (int r = 0; r < 2; ++r) { const int row = 2 * (pi) + r; const bf16_t* xr = (row < NLAT) ? xb_lat + (size_t)row * 1024 : p.cs + (size_t)(row - NLAT) * 1024; \
            _Pragma("unroll") for (int i = 0; i < 4; ++i) raw[r][i] = *(const uint2*)(xr + i * 256 + lane * 4); } } while (0)
    { const int p0 = cx.bid * 8 + wid; if (xb_lat && p0 < (nrows >> 1)) N2_LOAD(p0); }
    for (int pidx = cx.bid * 8 + wid; pidx < (nrows >> 1); pidx += cx.nblk * 8) {
        float4 xv[2][4];
        if (xb_lat) {
#pragma unroll
            for (int r = 0; r < 2; ++r)
#pragma unroll
                for (int i = 0; i < 4; ++i) xv[r][i] = make_float4(bflo(raw[r][i].x), bfhi(raw[r][i].x), bflo(raw[r][i].y), bfhi(raw[r][i].y));
            const int pn = pidx + cx.nblk * 8; if (pn < (nrows >> 1)) N2_LOAD(pn);
        } else {
#pragma unroll
            for (int r = 0; r < 2; ++r) { const int row = 2 * pidx + r; const float* xr = (row < NLAT) ? p.out + (size_t)row * 1024 : p.ctxs + (size_t)(row - NLAT) * 1024;
#pragma unroll
                for (int i = 0; i < 4; ++i) xv[r][i] = *(const float4*)(xr + i * 256 + lane * 4); }
        }
        const int row0 = 2 * pidx; const int jj = (row0 < NLAT) ? (row0 >> 11) : 16;
        const float* shp = modl + (size_t)jj * 6144 + 3 * 1024; const float* scp = modl + (size_t)jj * 6144 + 4 * 1024;
        float4 hv[2][4];
#pragma unroll
        for (int r = 0; r < 2; ++r) {
            float ss = 0.f;
#pragma unroll
            for (int i = 0; i < 4; ++i) ss += xv[r][i].x * xv[r][i].x + xv[r][i].y * xv[r][i].y + xv[r][i].z * xv[r][i].z + xv[r][i].w * xv[r][i].w;
            ss = wave_sum(ss);
            const float rstd = rsqrtf(ss * (1.f / 1024.f) + 1e-6f);
#pragma unroll
            for (int i = 0; i < 4; ++i) {
                const int col = i * 256 + lane * 4;
                const float4 g = *(const float4*)(gain + col), sh = *(const float4*)(shp + col), sc = *(const float4*)(scp + col);
                hv[r][i].x = xv[r][i].x * rstd * g.x * (1.f + sc.x) + sh.x; hv[r][i].y = xv[r][i].y * rstd * g.y * (1.f + sc.y) + sh.y;
                hv[r][i].z = xv[r][i].z * rstd * g.z * (1.f + sc.z) + sh.z; hv[r][i].w = xv[r][i].w * rstd * g.w * (1.f + sc.w) + sh.w;
                uint2 u; u.x = att::pk(hv[r][i].x, hv[r][i].y); u.y = att::pk(hv[r][i].z, hv[r][i].w);
                *(uint2*)(p.H + (size_t)(row0 + r) * 1024 + col) = u;
            }
        }
#pragma unroll
        for (int e = 0; e < 16; ++e) {
            float a0 = 0.f, a1 = 0.f;
#pragma unroll
            for (int i = 0; i < 4; ++i) { const mm::f32x4 w = *(const LAS mm::f32x4*)(rw + e * 1024 + i * 256 + lane * 4);
                a0 += hv[0][i].x * w[0] + hv[0][i].y * w[1] + hv[0][i].z * w[2] + hv[0][i].w * w[3]; a1 += hv[1][i].x * w[0] + hv[1][i].y * w[1] + hv[1][i].z * w[2] + hv[1][i].w * w[3]; }
            red[e * 64 + lane] = a0; red[(16 + e) * 64 + lane] = a1;
        }
        __builtin_amdgcn_wave_barrier();
        {
            const int r = lane >> 5, e = (lane >> 1) & 15, half = lane & 1; const LAS float* src = red + (r * 16 + e) * 64 + half * 32;
            float sacc = 0.f;
#pragma unroll
            for (int q = 0; q < 8; ++q) { const mm::f32x4 v = *(const LAS mm::f32x4*)(src + q * 4); sacc += (v[0] + v[1]) + (v[2] + v[3]); }
            sacc += dpp_f<0xB1>(sacc);
            const float sg = 1.f / (1.f + __expf(-sacc));
            if (half == 0) { my[r * 32 + e] = sg; my[r * 32 + 16 + e] = sg + p.router_b[e]; }
        }
        __builtin_amdgcn_wave_barrier();
        if ((lane & 31) == 0) {
            const int r = lane >> 5; const LAS float* m = my + r * 32;
            float best = -3.0e38f; int be1 = 0, be2 = 1;
#pragma unroll
            for (int g = 0; g < 4; ++g) {
                const mm::f32x4 v = *(const LAS mm::f32x4*)(m + 16 + 4 * g);
                int i1 = 0; float m1 = v[0];
                if (v[1] > m1) { m1 = v[1]; i1 = 1; } if (v[2] > m1) { m1 = v[2]; i1 = 2; } if (v[3] > m1) { m1 = v[3]; i1 = 3; }
                int i2 = -1; float m2 = -3.0e38f;
                if (i1 != 0 && v[0] > m2) { m2 = v[0]; i2 = 0; } if (i1 != 1 && v[1] > m2) { m2 = v[1]; i2 = 1; }
                if (i1 != 2 && v[2] > m2) { m2 = v[2]; i2 = 2; } if (i1 != 3 && v[3] > m2) { m2 = v[3]; i2 = 3; }
                const float gs = m1 + m2;
                if (gs > best) { best = gs; be1 = 4 * g + i1; be2 = 4 * g + i2; }
            }
            const float bs1 = m[be1], bs2 = m[be2]; const float inv = 1.f / (bs1 + bs2);
            const int p1 = atomicAdd((int*)&lcnt[be1], 1), p2 = atomicAdd((int*)&lcnt[be2], 1);
            LAS int* ent = rlist + (wid * 24 + nlist * 2 + r) * 6;
            const int row = row0 + r;
            ent[0] = row; ent[1] = be1 | (be2 << 8); ent[2] = p1; ent[3] = p2; ent[4] = __float_as_int(bs1 * inv); ent[5] = __float_as_int(bs2 * inv);
        }
        ++nlist;
        __builtin_amdgcn_wave_barrier();
    }
#undef N2_LOAD
    __syncthreads();
    if (tid < 16) lbase[tid] = atomicAdd(p.cnt + (layer * 16 + tid) * 64, lcnt[tid]);
    __syncthreads();
    for (int k = lane; k < 2 * nlist; k += 64) {
        const LAS int* ent = rlist + (wid * 24 + k) * 6; const int row = ent[0], be1 = ent[1] & 255, be2 = ent[1] >> 8;
        const size_t s1 = (size_t)be1 * NT + lbase[be1] + ent[2], s2 = (size_t)be2 * NT + lbase[be2] + ent[3];
        p.slot[s1] = row * 2; p.slot[s2] = row * 2 + 1; p.slotw[s1] = __int_as_float(ent[4]); p.slotw[s2] = __int_as_float(ent[5]);
    }
    __syncthreads();
}

DI void ph_prepBLR_opt(const Ctx& cx, const Params& p, int j) {
    const int tid = cx.tid, wid = tid >> 6, lane = tid & 63;
    const float4 gq = *(const float4*)(p.b_q_norm + j * 256 + lane * 4); const float2 gk = *(const float2*)(p.b_kv_norm + j * 128 + lane * 2);
    constexpr int U = 8;
    for (int row0 = (cx.bid * 8 + wid) * U; row0 < NT; row0 += cx.nblk * 8 * U) {
        uint2 uq[U]; unsigned ukv[U];
#pragma unroll
        for (int u = 0; u < U; ++u) { const bf16_t* pr = p.P + (size_t)(row0 + u) * PLD + ACOLS; uq[u] = *(const uint2*)(pr + lane * 4); ukv[u] = *(const unsigned*)(pr + 256 + lane * 2); }
#pragma unroll
        for (int u = 0; u < U; ++u) {
            const float q0 = bflo(uq[u].x), q1 = bfhi(uq[u].x), q2 = bflo(uq[u].y), q3 = bfhi(uq[u].y), k0 = bflo(ukv[u]), k1 = bfhi(ukv[u]);
            const float sq = wave_sum(q0 * q0 + q1 * q1 + q2 * q2 + q3 * q3), sk = wave_sum(k0 * k0 + k1 * k1);
            const float rq = rsqrtf(sq * (1.f / 256.f) + 1e-6f), rk = rsqrtf(sk * (1.f / 128.f) + 1e-6f);
            uint2 o; o.x = att::pk(q0 * rq * gq.x, q1 * rq * gq.y); o.y = att::pk(q2 * rq * gq.z, q3 * rq * gq.w);
            bf16_t* qn = p.QN + (size_t)(row0 + u) * 512;
            *(uint2*)(qn + lane * 4) = o; *(unsigned*)(qn + 256 + lane * 2) = att::pk(k0 * rk * gk.x, k1 * rk * gk.y); *(unsigned*)(qn + 384 + lane * 2) = 0u;
        }
    }
    const int gtid = cx.bid * NTHR + tid, gsz = cx.nblk * NTHR;
    for (int idx = gtid; idx < NT * 48; idx += gsz) {
        const int row = idx / 48, cg = idx % 48, col0 = cg * 8;
        const bool lat = row < NLAT; const int t = lat ? (row & 2047) : ((row - NLAT) & 255); const int T = lat ? 2048 : 256;
        float mu[8]; ld8f(p.a_mu + j * ACOLS + 1536 + col0, mu);
        float v[8]; shift8(p.P, row, t, T, 1536 + col0, mu, v);
        if (cg < 16) {
#pragma unroll
            for (int i = 0; i < 8; ++i) { const float e = __expf(2.f * v[i]); v[i] = 1.f - 2.f * __builtin_amdgcn_rcpf(e + 1.f); }
        } else if (cg >= 32) {
#pragma unroll
            for (int i = 0; i < 8; ++i) v[i] = __builtin_amdgcn_rcpf(1.f + __expf(-v[i]));
        }
        *(uint4*)(p.LR + (size_t)row * 384 + col0) = pack8u(v);
    }
}

template <bool FINAL>
DI void ph_normc(const Ctx& cx, const Params& p, int nrows, const bf16_t* xin_lat, bf16_t* xout_lat, const float* gain, const float* modl, const float* modprev) {
    const int tid = cx.tid, wid = tid >> 6, lane = tid & 63;
    for (int row = cx.bid * 8 + wid; row < nrows; row += cx.nblk * 8) {
        const bool lat = row < NLAT; const int jj = lat ? (row >> 11) : 16; const size_t rb = lat ? (size_t)row : (size_t)(row - NLAT);
        const bf16_t* xr = (lat ? xin_lat : p.cs) + rb * 1024;
        const float* g2 = modprev + (size_t)jj * 6144 + 5 * 1024;
        float4 xv[4];
#pragma unroll
        for (int i = 0; i < 4; ++i) {
            const int col = i * 256 + lane * 4;
            const uint2 ux = *(const uint2*)(xr + col);
            float s0 = 0.f, s1 = 0.f, s2 = 0.f, s3 = 0.f;
#pragma unroll
            for (int sl = 0; sl < 3; ++sl) { const uint2 u = *(const uint2*)(p.Y + ((size_t)sl * NT + row) * 1024 + col); s0 += bflo(u.x); s1 += bfhi(u.x); s2 += bflo(u.y); s3 += bfhi(u.y); }
            const float4 gv = *(const float4*)(g2 + col);
            xv[i].x = bflo(ux.x) + gv.x * s0; xv[i].y = bfhi(ux.x) + gv.y * s1; xv[i].z = bflo(ux.y) + gv.z * s2; xv[i].w = bfhi(ux.y) + gv.w * s3;
            if (FINAL) *(float4*)(p.out + (size_t)row * 1024 + col) = xv[i];
            else { uint2 o; o.x = att_pk(xv[i].x, xv[i].y); o.y = att_pk(xv[i].z, xv[i].w); *(uint2*)((lat ? xout_lat : p.cs) + rb * 1024 + col) = o; }
        }
        if (!FINAL) {
            float ss = 0.f;
#pragma unroll
            for (int i = 0; i < 4; ++i) ss += xv[i].x * xv[i].x + xv[i].y * xv[i].y + xv[i].z * xv[i].z + xv[i].w * xv[i].w;
            ss = wave_sum(ss);
            const float rstd = rsqrtf(ss * (1.f / 1024.f) + 1e-6f);
            const float* shp = modl + (size_t)jj * 6144; const float* scp = modl + (size_t)jj * 6144 + 1024;
#pragma unroll
            for (int i = 0; i < 4; ++i) {
                const int col = i * 256 + lane * 4;
                const float4 g = *(const float4*)(gain + col), sh = *(const float4*)(shp + col), sc = *(const float4*)(scp + col);
                uint2 u; u.x = att_pk(xv[i].x * rstd * g.x * (1.f + sc.x) + sh.x, xv[i].y * rstd * g.y * (1.f + sc.y) + sh.y);
                u.y = att_pk(xv[i].z * rstd * g.z * (1.f + sc.z) + sh.z, xv[i].w * rstd * g.w * (1.f + sc.w) + sh.w);
                *(uint2*)(p.H + (size_t)row * 1024 + col) = u;
            }
        }
    }
}

struct F1Sched {
    static constexpr bool GATHER = false, TABLE = false;
    const char* A; const char* Hb; int T2, nN, G, c;
    DI size_t hstep_a() const { return (size_t)mm::HALF * 1024 * 2; }
    DI unsigned boff(int Rb, int C, int Kk) const { return (unsigned)(Rb * T2 * Kk + C) * 2u; }
    DI size_t hstep_b(int Kk) const { return (size_t)Kk * 2; }
    DI bool next(int i, mm::Unit& u) const {
        const int L = i * G + c; if (L >= 8 * nN) return false;
        u.pm = L & 7; u.pn = L >> 3; u.e = 0; u.m = 0;
        const int b = (T2 == 16) ? (u.pn >> 3) : u.pn, t20 = (T2 == 16) ? 2 * (u.pn & 7) : 0;
        u.A = A + (size_t)u.pm * 256 * 1024 * 2; u.B = Hb + ((size_t)b * (128 * T2) + t20) * 1024 * 2; return true;
    }
    DI void aoff(const mm::Unit&, int R0, int C0, int R1, int C1, unsigned (&o)[2][2]) const {
        o[0][0] = (unsigned)(R0 * 1024 + C0) * 2u; o[0][1] = (unsigned)(R1 * 1024 + C1) * 2u; o[1][0] = o[0][0]; o[1][1] = o[0][1];
    }
};
struct EpiZT3 {
    static constexpr bool PERM = true;
    bf16_t* Z; int T2;
    DI void operator()(const mm::f32x4 (&acc)[2][2][4][2], const mm::Unit& u, int wr, int wc, int fr, int fq) const {
        const int b = (T2 == 16) ? (u.pn >> 3) : u.pn, t20 = (T2 == 16) ? 2 * (u.pn & 7) : 0;
        const int m0 = u.pm * 256 + wr * 64 + fr, t1 = wc * 32 + 8 * fq;
#pragma unroll
        for (int ai = 0; ai < 2; ++ai)
#pragma unroll
            for (int m = 0; m < 4; ++m) { const int mr = m0 + ai * 128 + m * 16, part = mr >> 10, ch = mr & 1023;
#pragma unroll
                for (int bj = 0; bj < 2; ++bj) { const mm::f32x4 v0 = acc[ai][bj][m][0], v1 = acc[ai][bj][m][1];
                    mm::u32x4 w; w.x = att_pk(v0[0], v0[1]); w.y = att_pk(v0[2], v0[3]); w.z = att_pk(v1[0], v1[1]); w.w = att_pk(v1[2], v1[3]);
                    *(mm::u32x4*)(Z + ((size_t)(b * 1024 + ch) * T2 + t20 + bj) * 256 + part * 128 + t1) = w; } }
    }
};
DI void ph_f1b(const Ctx& cx, const Params& p, float* lds, int j, bool with_ctx) {
    { F1Sched S{(const char*)(p.A1 + (size_t)j * 2048 * 1024), (const char*)p.H, 16, NLAT / 256, cx.nblk, cx.bid}; EpiZT3 E{p.ZT, 16}; mm::gemm_phase(GEMM_LDS(lds), 1024, S, E, cx.tid); }
    if (with_ctx) { F1Sched S{(const char*)(p.A1 + (size_t)j * 2048 * 1024), (const char*)(p.H + (size_t)NLAT * 1024), 2, NCTX / 256, cx.nblk, cx.bid}; EpiZT3 E{p.ZTC, 2}; mm::gemm_phase(GEMM_LDS(lds), 1024, S, E, cx.tid); }
}
DI void ph_fa(const Ctx& cx, const Params& p, float* lds, bool with_ctx) {
    int Kr = 256; asm volatile("" : "+s"(Kr));
    { mm::BatchSched S; S.init(p.M1, p.ZT, (size_t)16384 * 256 * 2, 16, 256, 16384, Kr, cx.nblk, cx.bid); mm::EpiBf16Store E{p.YF1, 16384, (size_t)256 * 16384}; mm::gemm_phase(GEMM_LDS(lds), Kr, S, E, cx.tid); }
    if (with_ctx) { mm::BatchSched S; S.init(p.M1, p.ZTC, (size_t)2048 * 256 * 2, 16, 256, 2048, Kr, cx.nblk, cx.bid); mm::EpiBf16Store E{p.YF1c, 2048, (size_t)256 * 2048}; mm::gemm_phase(GEMM_LDS(lds), Kr, S, E, cx.tid); }
}
template <int T2>
DI void fb_items(const Ctx& cx, const Params& p, const LAS float* tw, const bf16_t* Y, const bf16_t* xin, bf16_t* xout, const float* modl, bool ctx, float scale) {
    constexpr int T = 128 * T2; constexpr size_t NB = (size_t)1024 * T2;
    const int gtid = cx.bid * NTHR + cx.tid, gsz = cx.nblk * NTHR;
    for (int idx = gtid; idx < 16 * 128 * 512; idx += gsz) {
        const int cp = idx & 511, f1 = (idx >> 9) & 127, b = idx >> 16;
        float yr[2][T2], yi[2][T2];
        { const bf16_t* pr = Y + ((size_t)b * 256 + f1) * NB + (size_t)(2 * cp) * T2; const bf16_t* pi = pr + (size_t)128 * NB;
          if constexpr (T2 == 2) { const uint2 ur = *(const uint2*)pr, ui = *(const uint2*)pi;
              yr[0][0] = bflo(ur.x); yr[0][1] = bfhi(ur.x); yr[1][0] = bflo(ur.y); yr[1][1] = bfhi(ur.y); yi[0][0] = bflo(ui.x); yi[0][1] = bfhi(ui.x); yi[1][0] = bflo(ui.y); yi[1][1] = bfhi(ui.y); }
          else {
#pragma unroll
          for (int q = 0; q < (2 * T2) / 8; ++q) { float d[8]; unpack8u(*(const uint4*)(pr + q * 8), d);
#pragma unroll
              for (int e = 0; e < 8; ++e) yr[(q * 8 + e) / T2][(q * 8 + e) % T2] = d[e];
              unpack8u(*(const uint4*)(pi + q * 8), d);
#pragma unroll
              for (int e = 0; e < 8; ++e) yi[(q * 8 + e) / T2][(q * 8 + e) % T2] = d[e]; } } }
        const int jj = ctx ? 16 : b; const float2 g1 = *(const float2*)(modl + (size_t)jj * 6144 + 2 * 1024 + 2 * cp);
        constexpr int FG = (T2 >= 4) ? 4 : T2;
#pragma unroll 1
        for (int fg = 0; fg < T2; fg += FG) {
            unsigned xv[FG];
#pragma unroll
            for (int q = 0; q < FG; ++q) xv[q] = *(const unsigned*)(xin + ((size_t)b * T + f1 + 128 * (fg + q)) * 1024 + 2 * cp);
#pragma unroll
            for (int q = 0; q < FG; ++q) {
                const int f = f1 + 128 * (fg + q); float a0 = 0.f, a1 = 0.f;
#pragma unroll
                for (int t2 = 0; t2 < T2; ++t2) { const int mi = ((t2 * f) & (T - 1)) * (2048 / T); const float cs = tw[2 * mi], sn = tw[2 * mi + 1];
                    a0 += cs * yr[0][t2] + sn * yi[0][t2]; a1 += cs * yr[1][t2] + sn * yi[1][t2]; }
                *(unsigned*)(xout + ((size_t)b * T + f) * 1024 + 2 * cp) = att_pk(bflo(xv[q]) + g1.x * scale * a0, bfhi(xv[q]) + g1.y * scale * a1);
            }
        }
    }
}
DI void fb_mfma(const Ctx& cx, const Params& p, const LAS float* tw, const bf16_t* Y, const bf16_t* xin, bf16_t* xout, const float* modl) {
    typedef short bf16x8 __attribute__((ext_vector_type(8)));
    constexpr size_t NB = (size_t)1024 * 16;
    const int tid = cx.tid, wid = tid >> 6, lane = tid & 63, lq = lane >> 4, lr = lane & 15;
    const int part = lq >> 1, t20 = 8 * (lq & 1);
    for (int item = cx.bid * 8 + wid; item < 16 * 128 * 32; item += cx.nblk * 8) {
        const int cb = item & 31, f1 = (item >> 5) & 127, b = item >> 12, c0 = cb * 32;
        const bf16_t* yb = Y + ((size_t)b * 256 + part * 128 + f1) * NB + t20;
        const int chA = c0 + 8 * (lr >> 2) + (lr & 3);
        const bf16x8 a0 = *(const bf16x8*)(yb + (size_t)chA * 16), a1 = *(const bf16x8*)(yb + (size_t)(chA + 4) * 16);
        const int f = f1 + 128 * lr;
        mm::u32x4 bw;
        { float tv[8];
#pragma unroll
          for (int jj = 0; jj < 8; ++jj) { const int mi = ((t20 + jj) * f) & 2047; tv[jj] = tw[2 * mi + part]; }
          bw.x = att_pk(tv[0], tv[1]); bw.y = att_pk(tv[2], tv[3]); bw.z = att_pk(tv[4], tv[5]); bw.w = att_pk(tv[6], tv[7]); }
        const bf16x8 bf = __builtin_bit_cast(bf16x8, bw);
        mm::f32x4 d0 = {0.f, 0.f, 0.f, 0.f}, d1 = d0;
        d0 = __builtin_amdgcn_mfma_f32_16x16x32_bf16(a0, bf, d0, 0, 0, 0);
        d1 = __builtin_amdgcn_mfma_f32_16x16x32_bf16(a1, bf, d1, 0, 0, 0);
        const float* g1 = modl + (size_t)b * 6144 + 2 * 1024 + c0 + 8 * lq;
        const mm::f32x4 g0 = *(const mm::f32x4*)g1, g4 = *(const mm::f32x4*)(g1 + 4);
        const size_t off = ((size_t)b * 2048 + f) * 1024 + c0 + 8 * lq;
        const mm::u32x4 xv = *(const mm::u32x4*)(xin + off);
        const float sc = 1.f / 512.f;
        mm::u32x4 o;
        o.x = att_pk(bflo(xv.x) + g0[0] * sc * d0[0], bfhi(xv.x) + g0[1] * sc * d0[1]); o.y = att_pk(bflo(xv.y) + g0[2] * sc * d0[2], bfhi(xv.y) + g0[3] * sc * d0[3]);
        o.z = att_pk(bflo(xv.z) + g4[0] * sc * d1[0], bfhi(xv.z) + g4[1] * sc * d1[1]); o.w = att_pk(bflo(xv.w) + g4[2] * sc * d1[2], bfhi(xv.w) + g4[3] * sc * d1[3]);
        *(mm::u32x4*)(xout + off) = o;
    }
}
DI void ph_fb(const Ctx& cx, const Params& p, float* ldsg, bool with_ctx, const bf16_t* xin_lat, bf16_t* xout_lat, const float* modl) {
    LAS float* tw = (LAS float*)ldsg;
    for (int i = cx.tid; i < 2048; i += NTHR) { const float a = (float)i * (1.f / 1024.f); tw[2 * i] = cospif(a); tw[2 * i + 1] = sinpif(a); }
    __syncthreads();
    fb_mfma(cx, p, tw, p.YF1, xin_lat, xout_lat, modl);
    if (with_ctx) fb_items<2>(cx, p, tw, p.YF1c, p.cs, p.cs, modl, true, 0.0055242717280199f);
    __syncthreads();
}

template <int PH>
DI void run_phase(const Params& p, float* lds, int L, int wave_id) {
    const Ctx cx = make_ctx(wave_id);
    const int j = L >> 1;
    const float* modl = p.mod + (size_t)L * 17 * 6144;
    const float* modprev = p.mod + (size_t)(L > 0 ? L - 1 : 0) * 17 * 6144;
    const bool last = (L == 3);
    const int rows_layer = (L == 3) ? NLAT : NT;
    const int rows_out = (L >= 2) ? NLAT : NT;
    const float* xin_lat = (L == 0) ? p.x : p.out; const float* xin_ctx = (L == 0) ? p.ctx : p.ctxs;
    constexpr bool BFS = (OPT >= 11);
    const void* bin_lat = (L == 0) ? (const void*)p.x : (const void*)p.xs; const void* bin_ctx = (L == 0) ? (const void*)p.ctx : (const void*)p.cs;
    bf16_t* bout_lat = (L == 3) ? p.xs3 : p.xs;
    if constexpr (PH == 0) { if (OPT >= 7) { ph_mod_opt(cx, p, lds); for (int i = cx.bid * NTHR + cx.tid; i < 1024; i += cx.nblk * NTHR) p.H[(size_t)NT * 1024 + i] = 0; } else ph_prologue(cx, p, lds); ph_prep_weights(cx, p, lds); }
    if constexpr (PH == 1) {
        if (OPT >= 4) ph_prep_moe(cx, p, lds, L);
        if (BFS && L > 0) { ph_normc<false>(cx, p, rows_layer, p.xs, p.xs, p.norm1_g + L * 1024, modl, modprev); return; }
        if (L == 0) ph_norm<false, true, false>(cx, p, lds, rows_layer, xin_lat, xin_ctx, p.norm1_g + L * 1024, modl, 0, 1, modprev, L);
        else ph_norm<true, true, false>(cx, p, lds, rows_layer, xin_lat, xin_ctx, p.norm1_g + L * 1024, modl, 0, 1, modprev, L);
    }
    if constexpr (PH == 2) { if (OPT >= 1) ph_win_mm(cx, p, lds, j); else ph_win(cx, p, lds, j); }
    if constexpr (PH == 3) { if (OPT >= 10) ph_prepBLR_opt(cx, p, j); else ph_prepB(cx, p, j); }
    if constexpr (PH == 4) { if (OPT >= 2) ph_qkvup_mm(cx, p, lds, j, rows_out); else ph_qkvup(cx, p, lds, j, rows_out); }
    if constexpr (PH == 5) { if (OPT >= 7) ph_finalize_opt(cx, p, lds, j, rows_out); else ph_finalize(cx, p, j, rows_out); }
    if constexpr (PH == 6) { if (OPT >= 5) ph_attn_mm(cx, p, lds, rows_out == NT); else ph_attn(cx, p, rows_out == NT); }
    if constexpr (PH == 7) { if (OPT < 10) ph_prepLR(cx, p, j); }
    if constexpr (PH == 8) { if (OPT >= 2) ph_wag_mm(cx, p, lds, j); else ph_wag(cx, p, lds, j); }
    if constexpr (PH == 9) { if (OPT >= 9) ph_scan_chunk<0>(cx, p, lds, j); else if (OPT >= 6) ph_scan_opt<0>(cx, p, lds, j); else ph_scan(cx, p, lds, j); }
    if constexpr (PH == 19) ph_scan_chunk<PROBE_SCAN>(cx, p, lds, j);
    if constexpr (PH == 10) { if (OPT >= 7) ph_post_opt(cx, p, j, rows_out); else ph_post(cx, p, j, rows_out); }
    if constexpr (PH == 11) { if (BFS) ph_wout_mmB(cx, p, lds, p.H, p.WoutT + (size_t)j * 1024 * 1024, rows_out, bin_lat, bin_ctx, bout_lat, L == 0, modl); else if (OPT >= 1) ph_wout_mm(cx, p, lds, p.H, p.WoutT + (size_t)j * 1024 * 1024, rows_out, xin_lat, xin_ctx, modl); else ph_wout(cx, p, lds, p.H, p.w_out_even + (size_t)j * 1024 * 1024, rows_out, xin_lat, xin_ctx, modl); }
    if constexpr (PH == 12) { if (OPT >= 12) ph_f1b(cx, p, lds, j, !last); else if (OPT >= 3) ph_f1_mm(cx, p, lds, j, !last); else ph_chdft(cx, p, lds, rows_layer); }
    if constexpr (PH == 13) { if (OPT >= 12) ph_fa(cx, p, lds, !last); else if (BFS) ph_f2_mmB(cx, p, lds, !last, bin_lat, bin_ctx, bout_lat, modl); else if (OPT >= 3) ph_f2_mm(cx, p, lds, !last, xin_lat, xin_ctx, modl); else ph_posdft(cx, p, lds, !last); }
    if constexpr (PH == 14) { if (OPT >= 12) ph_fb(cx, p, lds, !last, p.xs, bout_lat, modl); }
    if constexpr (PH == 14) { if (OPT < 3) ph_wout(cx, p, lds, p.F, p.w_out_fourier + (size_t)j * 1024 * 1024, rows_out, xin_lat, xin_ctx, modl); }
    if constexpr (PH == 15) { if (OPT >= 8) ph_norm2_router(cx, p, lds, rows_out, p.norm2_g + L * 1024, modl, L, BFS ? bout_lat : (const bf16_t*)nullptr); else ph_norm<false, true, true>(cx, p, lds, rows_out, p.out, p.ctxs, p.norm2_g + L * 1024, modl, 3, 4, modprev, L); }
    if constexpr (PH == 16) { if (OPT >= 4) ph_moe_up_mm(cx, p, lds, L, rows_out); else ph_moe_up(cx, p, lds, L, rows_out); }
    if constexpr (PH == 17) { if (OPT >= 4) ph_moe_down_mm(cx, p, lds, L, rows_out); else ph_moe_down(cx, p, lds, L, rows_out); }
    if constexpr (PH == 18) { if (BFS) { ph_normc<true>(cx, p, NLAT, p.xs3, nullptr, p.norm1_g, p.mod + (size_t)3 * 17 * 6144, p.mod + (size_t)3 * 17 * 6144); return; } }
    if constexpr (PH == 18) ph_norm<true, false, false>(cx, p, lds, NLAT, p.out, p.ctxs, p.norm1_g, p.mod + (size_t)3 * 17 * 6144, 0, 1, p.mod + (size_t)3 * 17 * 6144, 3);
}

template <int PH>
__global__ void __launch_bounds__(NTHR, 2) k_phase(Params p, int L) {
    extern __shared__ __attribute__((aligned(16))) float shm[];
    run_phase<PH>(p, shm, L, (int)(threadIdx.x >> 6));
}

#if ONE_LAUNCH
constexpr int PARAM_WORDS = (int)(sizeof(Params) / 4);
DI Params load_params(const unsigned* lp) {
    Params q; unsigned* d = (unsigned*)&q;
#pragma unroll
    for (int i = 0; i < PARAM_WORDS; ++i) d[i] = (unsigned)__builtin_amdgcn_readfirstlane((int)lp[i]);
    void** pp = (void**)&q;
#pragma unroll
    for (int i = 0; i < PARAM_WORDS / 2; ++i) pp[i] = (void*)(__attribute__((address_space(1))) void*)pp[i];
    return q;
}
#ifndef PROBE_MASK
#define PROBE_MASK 0u
#endif

#define PHASE(PH, L) do { unsigned long long t0_ = 0; if (PROBE_MASK & (1u << (PH))) t0_ = wall_clock64(); \
    { run_phase<PH>(p, lds, (L), wave_id); } xcd_barrier(bar, wave_id == 0 && lane_id_asm() == 0); \
    if (PROBE_MASK & (1u << (PH))) tacc += wall_clock64() - t0_; } while (0)
__global__ void __launch_bounds__(NTHR, 2) k_mega(Params p) {
    extern __shared__ __attribute__((aligned(16))) float shm[];
    unsigned* lp = (unsigned*)(shm + 4);
    float* lds = shm + 4 + ((PARAM_WORDS + 3) & ~3);
    if (threadIdx.x == 0) { shm[0] = 0.f; shm[1] = 0.f; shm[2] = 0.f; shm[3] = 0.f; }
    if (threadIdx.x < PARAM_WORDS) lp[threadIdx.x] = ((const unsigned*)&p)[threadIdx.x];
    __syncthreads();
    XcdBarrier bar; { const Params q_ = load_params(lp); bar = xcd_barrier_post(q_.bar, (volatile LAS unsigned*)shm); }
    unsigned long long tacc = 0;
    const int wave_id = __builtin_amdgcn_readfirstlane((int)(threadIdx.x >> 6));
    PHASE(0, 0);
#define LAYER_EVEN(L) PHASE(1, L); PHASE(2, L); PHASE(3, L); PHASE(4, L); PHASE(5, L); PHASE(6, L); if (OPT < 10) { PHASE(7, L); } PHASE(8, L); PHASE(9, L); if (PROBE_SCAN) { PHASE(19, L); } PHASE(10, L); PHASE(11, L); PHASE(15, L); PHASE(16, L); PHASE(17, L)
#define LAYER_ODD(L) PHASE(1, L); PHASE(12, L); PHASE(13, L); if (OPT < 3 || OPT >= 12) { PHASE(14, L); } PHASE(15, L); PHASE(16, L); PHASE(17, L)
    LAYER_EVEN(0); LAYER_ODD(1); LAYER_EVEN(2); LAYER_ODD(3);
    { unsigned long long t0_ = 0; if (PROBE_MASK & (1u << 18)) t0_ = wall_clock64(); run_phase<18>(p, lds, 3, wave_id);
      if (PROBE_MASK & (1u << 18)) { xcd_barrier(bar, wave_id == 0 && lane_id_asm() == 0); tacc += wall_clock64() - t0_; } }
    if (PROBE_MASK != 0u && blockIdx.x == 0 && threadIdx.x == 0) {
        const unsigned long long t1 = wall_clock64(); while (wall_clock64() - t1 < 20ull * tacc) __builtin_amdgcn_s_sleep(8); }
}
#endif

static inline size_t al256(size_t v) { return (v + 255) & ~(size_t)255; }
constexpr size_t LDS_BYTES = 148 * 1024;

template <int PH> static void launch_phase(const Params& p, int L, int grid, hipStream_t s) {
    static bool attr = false;
    if (!attr) { hipFuncSetAttribute((const void*)k_phase<PH>, hipFuncAttributeMaxDynamicSharedMemorySize, (int)LDS_BYTES); attr = true; }
    hipLaunchKernelGGL(k_phase<PH>, dim3(grid), dim3(NTHR), LDS_BYTES, s, p, L);
}

extern "C" void kernel_launch(void* const* d_in, const int* in_sizes, int n_in, void* d_out, int out_size, void* d_ws, size_t ws_size, hipStream_t stream) {
    (void)in_sizes; (void)n_in; (void)out_size;
    Params p{};
    const float** ip = (const float**)&p.x;
    for (int i = 0; i < 36; ++i) ip[i] = (const float*)d_in[i];
    p.out = (float*)d_out;
    char* w = (char*)d_ws; size_t o = 0;
    auto take = [&](size_t bytes) { char* r = w + o; o += al256(bytes); return r; };
    p.bar = (unsigned*)take(XCD_BAR_WORDS * 4);
    p.cnt = (int*)take(64 * 64 * 4);
    const size_t zero_bytes = o;
    p.mod = (float*)take((size_t)4 * 17 * 6144 * 4);
    p.ctxs = (float*)take((size_t)NCTX * 1024 * 4);
    p.dftl = (bf16_t*)take((size_t)2048 * 4096 * 2);
    p.dftc = (bf16_t*)take((size_t)256 * 512 * 2);
    p.slot = (int*)take((size_t)16 * NT * 4);
    p.tokw = (float*)take((size_t)NT * 2 * 4);
    p.slotw = (float*)take((size_t)16 * NT * 4);
    p.H = (bf16_t*)take((size_t)(NT + 1) * 1024 * 2);
    char* big = w + o;
    p.P = (bf16_t*)take((size_t)NT * PLD * 2);
    char* r1 = w + o;
    p.WAG = (bf16_t*)take((size_t)NT * WLD * 2);
    p.YF = (bf16_t*)take((size_t)NT * 512 * 2);
    p.YB = (bf16_t*)take((size_t)NT * 512 * 2);
    p.LR = (bf16_t*)take((size_t)NT * 384 * 2);
    p.WinT = (bf16_t*)take((size_t)2 * 2560 * 1024 * 2); p.WqT = (bf16_t*)take((size_t)2 * 768 * 256 * 2); p.WkvT = (bf16_t*)take((size_t)2 * 1024 * 256 * 2);
    p.WlrT = (bf16_t*)take((size_t)2 * 2560 * 384 * 2); p.WoutT = (bf16_t*)take((size_t)2 * 1024 * 1024 * 2); p.A1 = (bf16_t*)take((size_t)2 * 2048 * 1024 * 2);
    p.A2 = (bf16_t*)take((size_t)2048 * 4096 * 2); p.A2c = (bf16_t*)take((size_t)256 * 512 * 2); p.M1 = (bf16_t*)take((size_t)256 * 256 * 2);
    p.WguT = (bf16_t*)take((size_t)17 * 1024 * 1024 * 2); p.WdT = (bf16_t*)take((size_t)17 * 1024 * 512 * 2);
    const size_t total = o;
    { size_t q = 0; auto t2 = [&](size_t bytes) { char* r = r1 + q; q += al256(bytes); return r; };
      p.QN = (bf16_t*)t2((size_t)NT * 512 * 2); p.Qraw = (bf16_t*)t2((size_t)NT * 768 * 2); p.KVraw = (bf16_t*)t2((size_t)NT * 1024 * 2);
      p.Kf = (bf16_t*)t2((size_t)NB * 8 * 2304 * 96 * 2); p.Vt = (bf16_t*)t2((size_t)NB * 8 * 64 * 2304 * 2); }
    { size_t q = 0; auto t3 = [&](size_t bytes) { char* r = big + q; q += al256(bytes); return r; };
      p.ACT = (bf16_t*)t3((size_t)3 * NT * 512 * 2); p.Y = (bf16_t*)t3((size_t)3 * NT * 1024 * 2); }
    { size_t q = 0; auto t4 = [&](size_t bytes) { char* r = big + q; q += al256(bytes); return r; };
      p.G = (float*)t4((size_t)NT * 2048 * 4); p.F = (bf16_t*)t4((size_t)NT * 1024 * 2); }
    { size_t q = 0; auto t5 = [&](size_t bytes) { char* r = big + q; q += al256(bytes); return r; };
      p.ZT = (bf16_t*)t5((size_t)16 * 1024 * 4096 * 2); p.ZTC = (bf16_t*)t5((size_t)16 * 1024 * 512 * 2);
      p.YF1 = (bf16_t*)t5((size_t)256 * 16 * 1024 * 16 * 2); p.YF1c = (bf16_t*)t5((size_t)256 * 16 * 1024 * 2 * 2); }
    p.xs = (bf16_t*)d_out; p.cs = (bf16_t*)p.ctxs; p.xs3 = (bf16_t*)(big + (size_t)344 * 1024 * 1024);
    if (total > ws_size) { fprintf(stderr, "workspace too small: need %zu have %zu\n", total, ws_size); return; }
    static int grid = 0;
    if (!grid) { int dev = 0, cus = 0; hipGetDevice(&dev); hipDeviceGetAttribute(&cus, hipDeviceAttributeMultiprocessorCount, dev); grid = cus > 0 ? cus : 256; if (grid > 256) grid = 256; }
    hipMemsetAsync(d_ws, 0, zero_bytes, stream);
#if ONE_LAUNCH
    static bool attr = false;
    if (!attr) { hipFuncSetAttribute((const void*)k_mega, hipFuncAttributeMaxDynamicSharedMemorySize, (int)LDS_BYTES); attr = true; }
    hipLaunchKernelGGL(k_mega, dim3(grid), dim3(NTHR), LDS_BYTES, stream, p);
#else
    launch_phase<0>(p, 0, grid, stream);
    for (int L = 0; L < 4; ++L) {
        launch_phase<1>(p, L, grid, stream);
        if ((L & 1) == 0) {
            launch_phase<2>(p, L, grid, stream); launch_phase<3>(p, L, grid, stream); launch_phase<4>(p, L, grid, stream); launch_phase<5>(p, L, grid, stream);
            launch_phase<6>(p, L, grid, stream); launch_phase<7>(p, L, grid, stream); launch_phase<8>(p, L, grid, stream); launch_phase<9>(p, L, grid, stream);
            launch_phase<10>(p, L, grid, stream); launch_phase<11>(p, L, grid, stream);
        } else {
            launch_phase<12>(p, L, grid, stream); launch_phase<13>(p, L, grid, stream); launch_phase<14>(p, L, grid, stream);
        }
        launch_phase<15>(p, L, grid, stream); launch_phase<16>(p, L, grid, stream); launch_phase<17>(p, L, grid, stream);
    }
    launch_phase<18>(p, 3, grid, stream);
#endif
}
```

```cpp
#include <hip/hip_runtime.h>
#include <cstdio>
#include <cstdint>

#ifndef ONE_LAUNCH
#define ONE_LAUNCH 1
#endif
#ifndef PROBE_SCAN
#define PROBE_SCAN 0
#endif
#ifndef PROBE_SPLIT1
#define PROBE_SPLIT1 0
#endif
#ifndef OPT
#define OPT 13
#endif

typedef unsigned short bf16_t;
#define DI __device__ __forceinline__
#define LAS __attribute__((address_space(3)))

constexpr int D = 1024, NB = 16, SEQ = 2048, CTXL = 256, NLAT = NB * SEQ, NCTX = NB * CTXL, NT = NLAT + NCTX;
constexpr int PLD = 2560;
constexpr int INC = 2336, ACOLS = 1920;
constexpr int WLD = 2560;
constexpr int NTHR = 512;

#define XB_TMO      128
#define XB_XCNT(j)  (256  + 64 * (j))
#define XB_XSUB(j)  (1280 + 64 * (j))
#define XB_XGEN(j)  (2304 + 64 * (j))
#define XB_TOP      3328
#define XB_TOPGEN   3392
#define XCD_BAR_WORDS 3456
#define XB_SPIN_CAP (1u << 24)
DI unsigned xb_ld(unsigned* p)              { return __hip_atomic_load(p, __ATOMIC_RELAXED, __HIP_MEMORY_SCOPE_AGENT); }
DI unsigned xb_add(unsigned* p, unsigned v) { return __hip_atomic_fetch_add(p, v, __ATOMIC_RELAXED, __HIP_MEMORY_SCOPE_AGENT); }
DI unsigned xb_xcc_id() { return (unsigned)__builtin_amdgcn_s_getreg((3 << 11) | 20) & 0xFu; }
#define XB_SPIN(cond, bar) do { unsigned _sp = 0; while (cond) { __builtin_amdgcn_s_sleep(1); \
    if ((++_sp & 255u) == 0u) { if (xb_ld(&(bar)[XB_TMO])) break; if (_sp > XB_SPIN_CAP) { atomicAdd(&(bar)[XB_TMO], 1u); break; } } } } while (0)
struct XcdBarrier { unsigned* bar; unsigned x; volatile LAS unsigned* st; };
DI XcdBarrier xcd_barrier_post(unsigned* bar, volatile LAS unsigned* st) {
    XcdBarrier b; b.bar = bar; b.x = xb_xcc_id(); b.st = st;
    if (threadIdx.x == 0) (void)xb_add(&bar[XB_XCNT(b.x)], 1u);
    return b;
}
DI void xcd_barrier_complete(unsigned* bar, unsigned x, unsigned& nloc, unsigned& nx) {
    const unsigned G = gridDim.x * gridDim.y * gridDim.z;
    unsigned sum, cnt, mine, sp = 0u;
    for (;;) {
        sum = 0u; cnt = 0u; mine = 0u;
#pragma unroll
        for (unsigned j = 0; j < 16; ++j) { const unsigned c = xb_ld(&bar[XB_XCNT(j)]); sum += c; cnt += (c > 0u) ? 1u : 0u; mine = (j == x) ? c : mine; }
        if (sum == G) break;
        __builtin_amdgcn_s_sleep(1);
        if ((++sp & 255u) == 0u) { if (xb_ld(&bar[XB_TMO])) break; if (sp > XB_SPIN_CAP) { atomicAdd(&bar[XB_TMO], 1u); break; } }
    }
    nloc = mine > 0u ? mine : 1u; nx = cnt > 0u ? cnt : 1u;
}
DI void xcd_barrier(const XcdBarrier& b, const bool t0) {
    asm volatile("s_waitcnt vmcnt(0)" ::: "memory");
    __syncthreads();
    if (t0) {
        unsigned* bar = b.bar;
        __builtin_amdgcn_s_waitcnt(0);
        unsigned nloc = b.st[0], nx = b.st[1];
        if (nloc == 0u) { xcd_barrier_complete(bar, b.x, nloc, nx); b.st[0] = nloc; b.st[1] = nx; }
        const unsigned old = xb_add(&bar[XB_XSUB(b.x)], 1u);
        const unsigned gen = old / nloc;
        if (old + 1u == (gen + 1u) * nloc) {
            __builtin_amdgcn_fence(__ATOMIC_RELEASE, "agent");
            asm volatile("s_waitcnt vmcnt(0)" ::: "memory");
            const unsigned og = xb_add(&bar[XB_TOP], 1u);
            const unsigned tg = og / nx;
            if (og + 1u == (tg + 1u) * nx) xb_add(&bar[XB_TOPGEN], 1u);
            else XB_SPIN(xb_ld(&bar[XB_TOPGEN]) == tg, bar);
            __builtin_amdgcn_fence(__ATOMIC_ACQUIRE, "agent");
            xb_add(&bar[XB_XGEN(b.x)], 1u);
            asm volatile("s_waitcnt vmcnt(0)" ::: "memory");
        } else {
            XB_SPIN(xb_ld(&bar[XB_XGEN(b.x)]) == gen, bar);
            __builtin_amdgcn_fence(__ATOMIC_ACQUIRE, "agent");
            asm volatile("s_waitcnt vmcnt(0)" ::: "memory");
        }
    }
    __syncthreads();
}

struct Params {
    const float *x, *c, *ctx, *c_ctx, *norm1_g, *norm2_g, *mod_w, *mod_b, *w_in, *a_mu, *a_w0, *a_w2, *a_a0, *a_a2, *a_g2,
                *a_k_k, *a_k_a, *a_r_k, *a_ln_w, *a_ln_b, *b_q_norm, *b_w_q_up, *b_kv_norm, *b_w_kv_up, *b_q_gain, *b_k_gain,
                *w_out_even, *w_out_fourier, *router_w, *router_b, *moe_w_gate, *moe_w_up, *moe_w_down, *sh_gate, *sh_up, *sh_down;
    float* out;
    unsigned* bar; int* cnt; float* mod; float* ctxs; bf16_t* dftl; bf16_t* dftc; int* slot; float* tokw; float* slotw;
    bf16_t *H, *P, *LR, *WAG, *YF, *YB, *QN, *Qraw, *KVraw, *Kf, *Vt, *ACT, *Y, *F; float* G;
    bf16_t *WinT, *WqT, *WkvT, *WlrT, *WoutT, *A1, *A2, *A2c, *WguT, *WdT, *ZT, *ZTC;
    bf16_t *M1, *YF1, *YF1c;
    bf16_t *xs, *cs, *xs3;
};

struct Ctx { int tid, bid, nblk; };
DI int lane_id_asm() { int l; asm volatile("v_mbcnt_lo_u32_b32 %0, -1, 0\n\tv_mbcnt_hi_u32_b32 %0, -1, %0" : "=v"(l)); return l; }
DI Ctx make_ctx(int wave_id) { Ctx c; c.tid = wave_id * 64 + lane_id_asm(); c.bid = blockIdx.x; c.nblk = gridDim.x; asm volatile("" : "+v"(c.tid), "+s"(c.bid), "+s"(c.nblk)); return c; }

DI bf16_t f2bf(float f) { unsigned u = __float_as_uint(f); u += 0x7fffu + ((u >> 16) & 1u); return (bf16_t)(u >> 16); }
DI float bf2f(bf16_t b) { return __uint_as_float(((unsigned)b) << 16); }
DI float bflo(unsigned u) { return __uint_as_float(u << 16); }
DI float bfhi(unsigned u) { return __uint_as_float(u & 0xffff0000u); }
DI unsigned pack2(float lo, float hi) { return (unsigned)f2bf(lo) | ((unsigned)f2bf(hi) << 16); }
typedef __bf16 g_bf16x2_t __attribute__((ext_vector_type(2)));
typedef float g_f32x2_t __attribute__((ext_vector_type(2)));
DI unsigned att_pk(float a, float b) { g_f32x2_t f = {a, b}; g_bf16x2_t h = __builtin_convertvector(f, g_bf16x2_t); return __builtin_bit_cast(unsigned, h); }
DI float siluf(float v) { return v / (1.f + expf(-v)); }
DI float sigm(float v) { return 1.f / (1.f + expf(-v)); }
template <int CTRL> DI float dpp_f(float v) { return __builtin_bit_cast(float, __builtin_amdgcn_update_dpp(0, __builtin_bit_cast(int, v), CTRL, 0xf, 0xf, true)); }
DI float wave_sum(float v) {
    v += dpp_f<0xB1>(v); v += dpp_f<0x4E>(v); v += dpp_f<0x141>(v); v += dpp_f<0x140>(v);
    const int x = __builtin_bit_cast(int, v);
    const float a = __builtin_bit_cast(float, __builtin_amdgcn_readlane(x, 0)), b = __builtin_bit_cast(float, __builtin_amdgcn_readlane(x, 16));
    const float c = __builtin_bit_cast(float, __builtin_amdgcn_readlane(x, 32)), d = __builtin_bit_cast(float, __builtin_amdgcn_readlane(x, 48));
    return (a + b) + (c + d);
}

template <bool DUAL, class AFn, class BFn, class BFn2, class Epi>
DI void ngemm(const Ctx& cx, float* lds, int nbz, int M, int N, int K, AFn afn, BFn bfn, BFn2 bfn2, Epi epi) {
    float* As = lds; float* Bs = lds + 16 * 132; float* B2s = Bs + 16 * 128;
    const int tid = cx.tid, ty = tid >> 5, tx = tid & 31;
    const int tm = (M + 127) / 128, tn = (N + 127) / 128, ntile = tm * tn * nbz;
    const int arow = tid >> 2, akc = (tid & 3) * 4, bk = tid >> 5, bnn = (tid & 31) * 4;
    for (int tile = cx.bid; tile < ntile; tile += cx.nblk) {
        const int bz = tile / (tm * tn), rem = tile % (tm * tn), bm = rem / tn, bn = rem % tn;
        float acc[8][4], acc2[8][4];
#pragma unroll
        for (int i = 0; i < 8; ++i)
#pragma unroll
            for (int j = 0; j < 4; ++j) { acc[i][j] = 0.f; acc2[i][j] = 0.f; }
        const int m_a = bm * 128 + arow;
        const bf16_t* aptr = (m_a < M) ? afn(bz, m_a) : nullptr;
        const int nB = bn * 128 + bnn;
        for (int k0 = 0; k0 < K; k0 += 16) {
            float av0 = 0.f, av1 = 0.f, av2 = 0.f, av3 = 0.f;
            if (aptr) { const uint2 u = *(const uint2*)(aptr + k0 + akc); av0 = bflo(u.x); av1 = bfhi(u.x); av2 = bflo(u.y); av3 = bfhi(u.y); }
            float4 bv = make_float4(0.f, 0.f, 0.f, 0.f), bv2 = make_float4(0.f, 0.f, 0.f, 0.f);
            if (nB < N) { bv = *(const float4*)(bfn(bz, k0 + bk) + nB); if (DUAL) bv2 = *(const float4*)(bfn2(bz, k0 + bk) + nB); }
            __syncthreads();
            As[(akc + 0) * 132 + arow] = av0; As[(akc + 1) * 132 + arow] = av1; As[(akc + 2) * 132 + arow] = av2; As[(akc + 3) * 132 + arow] = av3;
            *(float4*)&Bs[bk * 128 + bnn] = bv;
            if (DUAL) *(float4*)&B2s[bk * 128 + bnn] = bv2;
            __syncthreads();
#pragma unroll 4
            for (int kk = 0; kk < 16; ++kk) {
                const float4 a0 = *(const float4*)&As[kk * 132 + ty * 8], a1 = *(const float4*)&As[kk * 132 + ty * 8 + 4];
                const float4 b = *(const float4*)&Bs[kk * 128 + tx * 4];
                const float a[8] = {a0.x, a0.y, a0.z, a0.w, a1.x, a1.y, a1.z, a1.w};
                const float bb[4] = {b.x, b.y, b.z, b.w};
#pragma unroll
                for (int i = 0; i < 8; ++i)
#pragma unroll
                    for (int j = 0; j < 4; ++j) acc[i][j] += a[i] * bb[j];
                if (DUAL) {
                    const float4 b2 = *(const float4*)&B2s[kk * 128 + tx * 4];
                    const float cc[4] = {b2.x, b2.y, b2.z, b2.w};
#pragma unroll
                    for (int i = 0; i < 8; ++i)
#pragma unroll
                        for (int j = 0; j < 4; ++j) acc2[i][j] += a[i] * cc[j];
                }
            }
        }
#pragma unroll
        for (int i = 0; i < 8; ++i) {
            const int m = bm * 128 + ty * 8 + i;
            if (m < M) {
#pragma unroll
                for (int j = 0; j < 4; ++j) { const int n = bn * 128 + tx * 4 + j; if (n < N) epi(bz, m, n, acc[i][j], acc2[i][j]); }
            }
        }
    }
    __syncthreads();
}

DI void ph_prologue(const Ctx& cx, const Params& p, float* lds) {
    const int tid = cx.tid, gtid = cx.bid * NTHR + tid, gsz = cx.nblk * NTHR;
    for (int i = tid; i < 17 * 1024; i += NTHR) { const int j = i >> 10, k = i & 1023; const float v = (j < 16) ? p.c[j * 1024 + k] : p.c_ctx[k]; lds[i] = siluf(v); }
    __syncthreads();
    for (int idx = gtid; idx < 4 * 6144; idx += gsz) {
        const int l = idx / 6144, n = idx % 6144;
        const float* w = p.mod_w + (size_t)l * 1024 * 6144 + n;
        float acc[17]; const float b0 = p.mod_b[l * 6144 + n];
#pragma unroll
        for (int j = 0; j < 17; ++j) acc[j] = b0;
        for (int k = 0; k < 1024; ++k) {
            const float wv = w[(size_t)k * 6144];
#pragma unroll
            for (int j = 0; j < 17; ++j) acc[j] += lds[j * 1024 + k] * wv;
        }
#pragma unroll
        for (int j = 0; j < 17; ++j) p.mod[((size_t)l * 17 + j) * 6144 + n] = acc[j];
    }
    for (int i = gtid; i < 2048 * 4096; i += gsz) {
        const int f = i >> 12, k = i & 4095, t = k & 2047, m = (f * t) & 2047; const float a = (float)m * (1.f / 1024.f);
        p.dftl[i] = f2bf((k < 2048) ? cospif(a) : sinpif(a));
    }
    for (int i = gtid; i < 256 * 512; i += gsz) {
        const int f = i >> 9, k = i & 511, t = k & 255, m = (f * t) & 255; const float a = (float)m * (1.f / 128.f);
        p.dftc[i] = f2bf((k < 256) ? cospif(a) : sinpif(a));
    }
    for (int i = gtid; i < 1024; i += gsz) p.H[(size_t)NT * 1024 + i] = 0;
    __syncthreads();
}

DI float pick4(float a0, float a1, float a2, float a3, int i) { return i == 0 ? a0 : (i == 1 ? a1 : (i == 2 ? a2 : a3)); }
template <bool COMBINE, bool NORM, bool ROUTER>
DI void ph_norm(const Ctx& cx, const Params& p, float* lds, int nrows, const float* xin_lat, const float* xin_ctx, const float* gain, const float* modl, int sh_idx, int sc_idx,
                const float* modprev, int layer) {
    const int tid = cx.tid, wid = tid >> 6, lane = tid & 63;
    float* rw = lds;
    float* scr = lds + 16 * 1024;
    int* lcnt = (int*)(lds + 16 * 1024 + 256); int* lbase = lcnt + 16; int* rlist = lcnt + 32;
    int nlist = 0;
    if (ROUTER) {
        for (int i = tid; i < 16 * 1024; i += NTHR) { const int e = i >> 10, col = i & 1023; rw[i] = p.router_w[col * 16 + e]; }
        if (tid < 16) lcnt[tid] = 0;
        __syncthreads();
    }
    for (int row = cx.bid * 8 + wid; row < nrows; row += cx.nblk * 8) {
        const bool lat = row < NLAT; const int j = lat ? (row >> 11) : 16;
        const float* xr = lat ? xin_lat + (size_t)row * 1024 : xin_ctx + (size_t)(row - NLAT) * 1024;
        float4 xv[4];
#pragma unroll
        for (int i = 0; i < 4; ++i) xv[i] = *(const float4*)(xr + i * 256 + lane * 4);
        if (COMBINE) {
            const float* g2 = modprev + (size_t)j * 6144 + 5 * 1024;
            float* xo = lat ? p.out + (size_t)row * 1024 : p.ctxs + (size_t)(row - NLAT) * 1024;
#pragma unroll
            for (int i = 0; i < 4; ++i) {
                const int col = i * 256 + lane * 4;
                const float4 gv = *(const float4*)(g2 + col);
                float s0 = 0.f, s1 = 0.f, s2 = 0.f, s3 = 0.f;
#pragma unroll
                for (int s = 0; s < 3; ++s) { const uint2 u = *(const uint2*)(p.Y + ((size_t)s * NT + row) * 1024 + col); s0 += bflo(u.x); s1 += bfhi(u.x); s2 += bflo(u.y); s3 += bfhi(u.y); }
                xv[i].x += gv.x * s0; xv[i].y += gv.y * s1; xv[i].z += gv.z * s2; xv[i].w += gv.w * s3;
                *(float4*)(xo + col) = xv[i];
            }
        }
        if (NORM) {
            float ss = 0.f;
#pragma unroll
            for (int i = 0; i < 4; ++i) ss += xv[i].x * xv[i].x + xv[i].y * xv[i].y + xv[i].z * xv[i].z + xv[i].w * xv[i].w;
            ss = wave_sum(ss);
            const float rstd = rsqrtf(ss * (1.f / 1024.f) + 1e-6f);
            const float* shp = modl + (size_t)j * 6144 + sh_idx * 1024; const float* scp = modl + (size_t)j * 6144 + sc_idx * 1024;
            float4 hv[4];
#pragma unroll
            for (int i = 0; i < 4; ++i) {
                const int col = i * 256 + lane * 4;
                const float4 g = *(const float4*)(gain + col), sh = *(const float4*)(shp + col), sc = *(const float4*)(scp + col);
                hv[i].x = xv[i].x * rstd * g.x * (1.f + sc.x) + sh.x; hv[i].y = xv[i].y * rstd * g.y * (1.f + sc.y) + sh.y;
                hv[i].z = xv[i].z * rstd * g.z * (1.f + sc.z) + sh.z; hv[i].w = xv[i].w * rstd * g.w * (1.f + sc.w) + sh.w;
                uint2 u; u.x = pack2(hv[i].x, hv[i].y); u.y = pack2(hv[i].z, hv[i].w);
                *(uint2*)(p.H + (size_t)row * 1024 + col) = u;
            }
            if (ROUTER) {
                float part[16];
#pragma unroll
                for (int e = 0; e < 16; ++e) {
                    float a = 0.f;
#pragma unroll
                    for (int i = 0; i < 4; ++i) { const float4 w = *(const float4*)(rw + e * 1024 + i * 256 + lane * 4); a += hv[i].x * w.x + hv[i].y * w.y + hv[i].z * w.z + hv[i].w * w.w; }
                    part[e] = wave_sum(a);
                }
                float* my = scr + wid * 32;
#pragma unroll
                for (int e = 0; e < 16; ++e) if (lane == e) { const float sg = sigm(part[e]); my[e] = sg; my[16 + e] = sg + p.router_b[e]; }
                __builtin_amdgcn_wave_barrier();
                if (lane == 0) {
                    float best = -3.0e38f; int be1 = 0, be2 = 1;
                    for (int g = 0; g < 4; ++g) {
                        const float v0 = my[16 + 4 * g], v1 = my[16 + 4 * g + 1], v2 = my[16 + 4 * g + 2], v3 = my[16 + 4 * g + 3];
                        int i1 = 0; float m1 = v0;
                        if (v1 > m1) { m1 = v1; i1 = 1; } if (v2 > m1) { m1 = v2; i1 = 2; } if (v3 > m1) { m1 = v3; i1 = 3; }
                        int i2 = -1; float m2 = -3.0e38f;
                        if (i1 != 0 && v0 > m2) { m2 = v0; i2 = 0; } if (i1 != 1 && v1 > m2) { m2 = v1; i2 = 1; }
                        if (i1 != 2 && v2 > m2) { m2 = v2; i2 = 2; } if (i1 != 3 && v3 > m2) { m2 = v3; i2 = 3; }
                        const float gs = m1 + m2;
                        if (gs > best) { best = gs; be1 = 4 * g + i1; be2 = 4 * g + i2; }
                    }
                    const float bs1 = my[be1], bs2 = my[be2];
                    const float inv = 1.f / (bs1 + bs2);
                    const int p1 = atomicAdd(&lcnt[be1], 1), p2 = atomicAdd(&lcnt[be2], 1);
                    int* ent = rlist + (wid * 24 + nlist) * 4;
                    ent[0] = row; ent[1] = be1 | (be2 << 8); ent[2] = p1; ent[3] = p2;
                    p.tokw[row * 2] = bs1 * inv; p.tokw[row * 2 + 1] = bs2 * inv;
                }
                ++nlist;
                __builtin_amdgcn_wave_barrier();
            }
        }
    }
    if (ROUTER) {
        __syncthreads();
        if (tid < 16) lbase[tid] = atomicAdd(p.cnt + (layer * 16 + tid) * 64, lcnt[tid]);
        __syncthreads();
        for (int k = lane; k < nlist; k += 64) {
            const int* ent = rlist + (wid * 24 + k) * 4; const int row = ent[0], be1 = ent[1] & 255, be2 = ent[1] >> 8;
            p.slot[(size_t)be1 * NT + lbase[be1] + ent[2]] = row * 2; p.slot[(size_t)be2 * NT + lbase[be2] + ent[3]] = row * 2 + 1;
        }
    }
    (void)scr;
    __syncthreads();
}

DI void ph_win(const Ctx& cx, const Params& p, float* lds, int j) {
    const float* W = p.w_in + (size_t)j * 1024 * INC;
    ngemm<false>(cx, lds, 1, NT, INC, 1024,
        [&](int, int m) { return p.H + (size_t)m * 1024; },
        [&](int, int k) { return W + (size_t)k * INC; }, [&](int, int) { return (const float*)nullptr; },
        [&](int, int m, int n, float v, float) { p.P[(size_t)m * PLD + n] = f2bf(v); });
}
DI void ph_prepB(const Ctx& cx, const Params& p, int j) {
    const int tid = cx.tid, wid = tid >> 6, lane = tid & 63;
    for (int row = cx.bid * 8 + wid; row < NT; row += cx.nblk * 8) {
        const bf16_t* pr = p.P + (size_t)row * PLD + ACOLS;
        const uint2 uq = *(const uint2*)(pr + lane * 4); const unsigned ukv = *(const unsigned*)(pr + 256 + lane * 2);
        const float q0 = bflo(uq.x), q1 = bfhi(uq.x), q2 = bflo(uq.y), q3 = bfhi(uq.y), k0 = bflo(ukv), k1 = bfhi(ukv);
        const float sq = wave_sum(q0 * q0 + q1 * q1 + q2 * q2 + q3 * q3), sk = wave_sum(k0 * k0 + k1 * k1);
        const float rq = rsqrtf(sq * (1.f / 256.f) + 1e-6f), rk = rsqrtf(sk * (1.f / 128.f) + 1e-6f);
        const float* gq = p.b_q_norm + j * 256 + lane * 4; const float* gk = p.b_kv_norm + j * 128 + lane * 2;
        uint2 o; o.x = pack2(q0 * rq * gq[0], q1 * rq * gq[1]); o.y = pack2(q2 * rq * gq[2], q3 * rq * gq[3]);
        bf16_t* qn = p.QN + (size_t)row * 512;
        *(uint2*)(qn + lane * 4) = o;
        *(unsigned*)(qn + 256 + lane * 2) = pack2(k0 * rk * gk[0], k1 * rk * gk[1]);
        *(unsigned*)(qn + 384 + lane * 2) = 0u;
    }
}
DI void ph_qkvup(const Ctx& cx, const Params& p, float* lds, int j, int mq) {
    const float* Wq = p.b_w_q_up + (size_t)j * 256 * 768; const float* Wkv = p.b_w_kv_up + (size_t)j * 128 * 1024;
    ngemm<false>(cx, lds, 1, mq, 768, 256,
        [&](int, int m) { return p.QN + (size_t)m * 512; },
        [&](int, int k) { return Wq + (size_t)k * 768; }, [&](int, int) { return (const float*)nullptr; },
        [&](int, int m, int n, float v, float) { p.Qraw[(size_t)m * 768 + n] = f2bf(v); });
    ngemm<false>(cx, lds, 1, NT, 1024, 128,
        [&](int, int m) { return p.QN + (size_t)m * 512 + 256; },
        [&](int, int k) { return Wkv + (size_t)k * 1024; }, [&](int, int) { return (const float*)nullptr; },
        [&](int, int m, int n, float v, float) { p.KVraw[(size_t)m * 1024 + n] = f2bf(v); });
}
DI void unpack8(const uint4 u, float* d) { d[0] = bflo(u.x); d[1] = bfhi(u.x); d[2] = bflo(u.y); d[3] = bfhi(u.y); d[4] = bflo(u.z); d[5] = bfhi(u.z); d[6] = bflo(u.w); d[7] = bfhi(u.w); }
DI uint4 pack8(const float* d, float scl) { uint4 u; u.x = pack2(d[0] * scl, d[1] * scl); u.y = pack2(d[2] * scl, d[3] * scl); u.z = pack2(d[4] * scl, d[5] * scl); u.w = pack2(d[6] * scl, d[7] * scl); return u; }
DI float ssq8(const uint4 u) { float d[8]; unpack8(u, d); float s = 0.f;
#pragma unroll
    for (int i = 0; i < 8; ++i) s += d[i] * d[i];
    return s; }
DI void norm_rope_store(const uint4 (&raw)[12], const float* gain, int t, bool lat, float scl, bf16_t* dst) {
    float ss = 0.f;
#pragma unroll
    for (int i = 0; i < 12; ++i) ss += ssq8(raw[i]);
    const float r = rsqrtf(ss * (1.f / 96.f) + 1e-6f);
#pragma unroll
    for (int i = 0; i < 8; ++i) { float d[8]; unpack8(raw[i], d);
#pragma unroll
        for (int c = 0; c < 8; ++c) d[c] = d[c] * r * gain[i * 8 + c];
        *(uint4*)(dst + i * 8) = pack8(d, scl); }
    const float invf[8] = {1.f, 0.316227766016838f, 0.1f, 0.0316227766016838f, 0.01f, 0.00316227766016838f, 0.001f, 0.000316227766016838f};
    const float ri = (float)(t >> 6), ci = (float)(t & 63);
#pragma unroll
    for (int half = 0; half < 2; ++half) {
        float x1[8], x2[8], o1[8], o2[8]; unpack8(raw[8 + half], x1); unpack8(raw[10 + half], x2);
#pragma unroll
        for (int c = 0; c < 8; ++c) {
            const float ang = (half == 0 ? ri : ci) * invf[c];
            const float cs = lat ? __cosf(ang) : 1.f, sn = lat ? __sinf(ang) : 0.f;
            const float a = x1[c] * r * gain[64 + half * 8 + c], b = x2[c] * r * gain[80 + half * 8 + c];
            o1[c] = a * cs - b * sn; o2[c] = b * cs + a * sn;
        }
        *(uint4*)(dst + 64 + half * 8) = pack8(o1, scl); *(uint4*)(dst + 80 + half * 8) = pack8(o2, scl);
    }
}
DI void ph_finalize(const Ctx& cx, const Params& p, int j, int mq) {
    const int gtid = cx.bid * NTHR + cx.tid, gsz = cx.nblk * NTHR;
    const float* qg = p.b_q_gain + j * 96; const float* kg = p.b_k_gain + j * 96;
    for (int idx = gtid; idx < 8 * mq; idx += gsz) {
        const int h = idx / mq, row = idx % mq;
        const bool lat = row < NLAT; const int t = lat ? (row & 2047) : ((row - NLAT) & 255);
        bf16_t* qp = p.Qraw + (size_t)row * 768 + h * 96;
        uint4 raw[12];
#pragma unroll
        for (int i = 0; i < 12; ++i) raw[i] = *(const uint4*)(qp + i * 8);
        norm_rope_store(raw, qg, t, lat, (OPT >= 5) ? 0.10206207261596577f * 1.4426950408889634f : 0.10206207261596577f, qp);
    }
    for (int idx = gtid; idx < 8 * NT; idx += gsz) {
        const int h = idx / NT, row = idx % NT;
        const bool lat = row < NLAT; const int b = lat ? (row >> 11) : ((row - NLAT) >> 8); const int t = lat ? (row & 2047) : ((row - NLAT) & 255);
        const int key = lat ? 256 + t : t;
        const bf16_t* kvp = p.KVraw + (size_t)row * 1024 + h * 128; const bf16_t* krp = p.P + (size_t)row * PLD + ACOLS + 384;
        uint4 raw[12];
#pragma unroll
        for (int i = 0; i < 8; ++i) raw[i] = *(const uint4*)(kvp + i * 8);
#pragma unroll
        for (int i = 0; i < 4; ++i) raw[8 + i] = *(const uint4*)(krp + i * 8);
        norm_rope_store(raw, kg, t, lat, 1.f, p.Kf + ((size_t)(b * 8 + h) * 2304 + key) * 96);
    }
    for (int idx = gtid; idx < 8 * NT; idx += gsz) {
        const int h = idx / NT, row = idx % NT;
        const bool lat = row < NLAT; const int b = lat ? (row >> 11) : ((row - NLAT) >> 8); const int t = lat ? (row & 2047) : ((row - NLAT) & 255);
        const int key = lat ? 256 + t : t;
        const bf16_t* vp = p.KVraw + (size_t)row * 1024 + h * 128 + 64;
        bf16_t* vo = p.Vt + (size_t)(b * 8 + h) * 64 * 2304 + key;
#pragma unroll 1
        for (int i = 0; i < 8; ++i) { const uint4 u = *(const uint4*)(vp + i * 8);
            vo[0] = (bf16_t)(u.x & 0xffff); vo[2304] = (bf16_t)(u.x >> 16); vo[2 * 2304] = (bf16_t)(u.y & 0xffff); vo[3 * 2304] = (bf16_t)(u.y >> 16);
            vo[4 * 2304] = (bf16_t)(u.z & 0xffff); vo[5 * 2304] = (bf16_t)(u.z >> 16); vo[6 * 2304] = (bf16_t)(u.w & 0xffff); vo[7 * 2304] = (bf16_t)(u.w >> 16);
            vo += 8 * 2304; }
    }
}
DI void ph_attn(const Ctx& cx, const Params& p, bool with_ctx) {
    const int gtid = cx.bid * NTHR + cx.tid, gsz = cx.nblk * NTHR;
    const int total = NLAT * 8 + (with_ctx ? NCTX * 8 : 0);
    for (int idx = gtid; idx < total; idx += gsz) {
        int b, h, row, nkeys;
        if (idx < NLAT * 8) { b = idx >> 14; h = (idx >> 11) & 7; row = b * 2048 + (idx & 2047); nkeys = 2304; }
        else { const int i2 = idx - NLAT * 8; b = i2 >> 11; h = (i2 >> 8) & 7; row = NLAT + b * 256 + (i2 & 255); nkeys = 256; }
        const bf16_t* qp = p.Qraw + (size_t)row * 768 + h * 96;
        const bf16_t* Kb = p.Kf + (size_t)(b * 8 + h) * 2304 * 96; const bf16_t* Vb = p.Vt + (size_t)(b * 8 + h) * 64 * 2304;
        float q[96];
#pragma unroll
        for (int i = 0; i < 12; ++i) { const uint4 u = *(const uint4*)(qp + i * 8); q[i * 8] = bflo(u.x); q[i * 8 + 1] = bfhi(u.x); q[i * 8 + 2] = bflo(u.y); q[i * 8 + 3] = bfhi(u.y);
            q[i * 8 + 4] = bflo(u.z); q[i * 8 + 5] = bfhi(u.z); q[i * 8 + 6] = bflo(u.w); q[i * 8 + 7] = bfhi(u.w); }
        float acc[64];
#pragma unroll
        for (int i = 0; i < 64; ++i) acc[i] = 0.f;
        float mx = -3.0e38f, l = 0.f;
        for (int key0 = 0; key0 < nkeys; key0 += 8) {
            float s[8];
#pragma unroll
            for (int kk = 0; kk < 8; ++kk) {
                const uint4* kp = (const uint4*)(Kb + (size_t)(key0 + kk) * 96); float a = 0.f;
#pragma unroll
                for (int i = 0; i < 12; ++i) { const uint4 u = kp[i]; a += q[i * 8] * bflo(u.x) + q[i * 8 + 1] * bfhi(u.x) + q[i * 8 + 2] * bflo(u.y) + q[i * 8 + 3] * bfhi(u.y)
                    + q[i * 8 + 4] * bflo(u.z) + q[i * 8 + 5] * bfhi(u.z) + q[i * 8 + 6] * bflo(u.w) + q[i * 8 + 7] * bfhi(u.w); }
                s[kk] = a;
            }
            float cm = s[0];
#pragma unroll
            for (int kk = 1; kk < 8; ++kk) cm = fmaxf(cm, s[kk]);
            const float mn = fmaxf(mx, cm), alpha = expf(mx - mn);
            float ps = 0.f;
#pragma unroll
            for (int kk = 0; kk < 8; ++kk) { s[kk] = expf(s[kk] - mn); ps += s[kk]; }
            l = l * alpha + ps; mx = mn;
#pragma unroll
            for (int dv = 0; dv < 64; ++dv) {
                const uint4 u = *(const uint4*)(Vb + (size_t)dv * 2304 + key0);
                acc[dv] = acc[dv] * alpha + s[0] * bflo(u.x) + s[1] * bfhi(u.x) + s[2] * bflo(u.y) + s[3] * bfhi(u.y) + s[4] * bflo(u.z) + s[5] * bfhi(u.z) + s[6] * bflo(u.w) + s[7] * bfhi(u.w);
            }
        }
        const float il = 1.f / l;
        bf16_t* o = p.H + (size_t)row * 1024 + 512 + h * 64;
#pragma unroll
        for (int i = 0; i < 8; ++i) { uint4 u; u.x = pack2(acc[i * 8] * il, acc[i * 8 + 1] * il); u.y = pack2(acc[i * 8 + 2] * il, acc[i * 8 + 3] * il);
            u.z = pack2(acc[i * 8 + 4] * il, acc[i * 8 + 5] * il); u.w = pack2(acc[i * 8 + 6] * il, acc[i * 8 + 7] * il); *(uint4*)(o + i * 8) = u; }
    }
}
DI float shiftp(const bf16_t* P, int row, int t, int T, int col, float mu) {
    const float c = bf2f(P[(size_t)row * PLD + col]);
    const float pv = (t > 0) ? bf2f(P[(size_t)(row - 1) * PLD + col]) : 0.f;
    const float nx = (t < T - 1) ? bf2f(P[(size_t)(row + 1) * PLD + col]) : 0.f;
    return c + mu * (0.5f * (pv + nx) - c);
}
DI void ph_prepLR(const Ctx& cx, const Params& p, int j) {
    const int gtid = cx.bid * NTHR + cx.tid, gsz = cx.nblk * NTHR;
    const float* mu = p.a_mu + j * ACOLS + 1536;
    for (int idx = gtid; idx < NT * 384; idx += gsz) {
        const int row = idx / 384, col = idx % 384;
        const bool lat = row < NLAT; const int t = lat ? (row & 2047) : ((row - NLAT) & 255); const int T = lat ? 2048 : 256;
        float v = shiftp(p.P, row, t, T, 1536 + col, mu[col]);
        if (col < 128) v = tanhf(v); else if (col >= 256) v = sigm(v);
        p.LR[(size_t)row * 384 + col] = f2bf(v);
    }
}
DI void ph_wag(const Ctx& cx, const Params& p, float* lds, int j) {
    for (int d = 0; d < 2; ++d) {
        const float* W2 = p.a_w2 + (size_t)(j * 2 + d) * 64 * 512; const float* w0 = p.a_w0 + (j * 2 + d) * 512;
        ngemm<false>(cx, lds, 1, NT, 512, 64,
            [&](int, int m) { return p.LR + (size_t)m * 384 + d * 64; },
            [&](int, int k) { return W2 + (size_t)k * 512; }, [&](int, int) { return (const float*)nullptr; },
            [&](int, int m, int n, float v, float) { const float z = -0.606531f * sigm(w0[n] + v); p.WAG[(size_t)m * WLD + d * 512 + n] = f2bf(-expm1f(z)); });
        const float* A2 = p.a_a2 + (size_t)(j * 2 + d) * 64 * 512; const float* a0 = p.a_a0 + (j * 2 + d) * 512;
        ngemm<false>(cx, lds, 1, NT, 512, 64,
            [&](int, int m) { return p.LR + (size_t)m * 384 + 128 + d * 64; },
            [&](int, int k) { return A2 + (size_t)k * 512; }, [&](int, int) { return (const float*)nullptr; },
            [&](int, int m, int n, float v, float) { p.WAG[(size_t)m * WLD + 1024 + d * 512 + n] = f2bf(sigm(a0[n] + v)); });
    }
    const float* G2 = p.a_g2 + (size_t)j * 128 * 512;
    ngemm<false>(cx, lds, 1, NT, 512, 128,
        [&](int, int m) { return p.LR + (size_t)m * 384 + 256; },
        [&](int, int k) { return G2 + (size_t)k * 512; }, [&](int, int) { return (const float*)nullptr; },
        [&](int, int m, int n, float v, float) { p.WAG[(size_t)m * WLD + 2048 + n] = f2bf(v); });
}
DI void ph_scan(const Ctx& cx, const Params& p, float* lds, int j) {
    const int tid = cx.tid, lane = tid & 63;
    if (tid < 64) {
        for (int item = cx.bid; item < 256; item += cx.nblk) {
            const int b = item >> 4, h = (item >> 1) & 7, dir = item & 1, hc = h * 64 + lane;
            float S[64];
#pragma unroll
            for (int k = 0; k < 64; ++k) S[k] = 0.f;
            const float kkc = p.a_k_k[j * 512 + hc], kac = p.a_k_a[j * 512 + hc];
            const float mur = p.a_mu[j * ACOLS + hc], muk = p.a_mu[j * ACOLS + 512 + hc], muv = p.a_mu[j * ACOLS + 1024 + hc];
            bf16_t* yout = dir ? p.YB : p.YF;
            for (int step = 0; step < 2304; ++step) {
                const bool cp = step < 256; const int tt = cp ? step : step - 256, T = cp ? 256 : 2048, t = dir ? (T - 1 - tt) : tt;
                const int row = cp ? NLAT + b * 256 + t : b * 2048 + t;
                const float R = shiftp(p.P, row, t, T, hc, mur), K = shiftp(p.P, row, t, T, 512 + hc, muk), V = shiftp(p.P, row, t, T, 1024 + hc, muv);
                const float w = 1.f - bf2f(p.WAG[(size_t)row * WLD + dir * 512 + hc]), a = bf2f(p.WAG[(size_t)row * WLD + 1024 + dir * 512 + hc]);
                const float kkv = K * kkc, ssq = wave_sum(kkv * kkv), kk = kkv * rsqrtf(ssq + 1e-12f);
                const float kd = K * (1.f + (a - 1.f) * kac), bd = kk * a;
                lds[lane] = -kk; lds[64 + lane] = w; lds[128 + lane] = bd; lds[192 + lane] = kd; lds[256 + lane] = R;
                __builtin_amdgcn_wave_barrier();
                float sa = 0.f;
#pragma unroll
                for (int k4 = 0; k4 < 16; ++k4) { const float4 v = *(const float4*)(lds + k4 * 4); sa += S[k4 * 4] * v.x + S[k4 * 4 + 1] * v.y + S[k4 * 4 + 2] * v.z + S[k4 * 4 + 3] * v.w; }
                float y = 0.f;
#pragma unroll
                for (int k4 = 0; k4 < 16; ++k4) {
                    const float4 wv = *(const float4*)(lds + 64 + k4 * 4), bv = *(const float4*)(lds + 128 + k4 * 4), kv = *(const float4*)(lds + 192 + k4 * 4), rv = *(const float4*)(lds + 256 + k4 * 4);
                    S[k4 * 4] = S[k4 * 4] * wv.x + sa * bv.x + V * kv.x; S[k4 * 4 + 1] = S[k4 * 4 + 1] * wv.y + sa * bv.y + V * kv.y;
                    S[k4 * 4 + 2] = S[k4 * 4 + 2] * wv.z + sa * bv.z + V * kv.z; S[k4 * 4 + 3] = S[k4 * 4 + 3] * wv.w + sa * bv.w + V * kv.w;
                    y += S[k4 * 4] * rv.x + S[k4 * 4 + 1] * rv.y + S[k4 * 4 + 2] * rv.z + S[k4 * 4 + 3] * rv.w;
                }
                __builtin_amdgcn_wave_barrier();
                yout[(size_t)row * 512 + hc] = f2bf(y);
            }
        }
    }
    __syncthreads();
}
DI void ph_post(const Ctx& cx, const Params& p, int j, int nrows) {
    const int gtid = cx.bid * NTHR + cx.tid, gsz = cx.nblk * NTHR;
    for (int idx = gtid; idx < 8 * nrows; idx += gsz) {
        const int h = idx / nrows, row = idx % nrows;
        const bool lat = row < NLAT; const int t = lat ? (row & 2047) : ((row - NLAT) & 255); const int T = lat ? 2048 : 256;
        float sum = 0.f, sb = 0.f;
#pragma unroll 8
        for (int n = 0; n < 64; ++n) {
            const int hc = h * 64 + n;
            const float yy = bf2f(p.YF[(size_t)row * 512 + hc]) + bf2f(p.YB[(size_t)row * 512 + hc]);
            sum += yy;
            const float R = shiftp(p.P, row, t, T, hc, p.a_mu[j * ACOLS + hc]), K = shiftp(p.P, row, t, T, 512 + hc, p.a_mu[j * ACOLS + 512 + hc]);
            const float af = bf2f(p.WAG[(size_t)row * WLD + 1024 + hc]), ab = bf2f(p.WAG[(size_t)row * WLD + 1536 + hc]);
            const float ka = p.a_k_a[j * 512 + hc], rk = p.a_r_k[j * 512 + hc];
            sb += R * rk * (K * (1.f + (af - 1.f) * ka) + K * (1.f + (ab - 1.f) * ka));
        }
        const float mean = sum * (1.f / 64.f); float var = 0.f;
#pragma unroll 8
        for (int n = 0; n < 64; ++n) { const int hc = h * 64 + n; const float yy = bf2f(p.YF[(size_t)row * 512 + hc]) + bf2f(p.YB[(size_t)row * 512 + hc]); var += (yy - mean) * (yy - mean); }
        const float rstd = rsqrtf(var * (1.f / 64.f) + 64e-5f);
#pragma unroll 8
        for (int n = 0; n < 64; ++n) {
            const int hc = h * 64 + n;
            const float yy = bf2f(p.YF[(size_t)row * 512 + hc]) + bf2f(p.YB[(size_t)row * 512 + hc]);
            const float V = shiftp(p.P, row, t, T, 1024 + hc, p.a_mu[j * ACOLS + 1024 + hc]);
            const float g = bf2f(p.WAG[(size_t)row * WLD + 2048 + hc]);
            const float o = ((yy - mean) * rstd * p.a_ln_w[j * 512 + hc] + p.a_ln_b[j * 512 + hc] + sb * V) * g;
            p.H[(size_t)row * 1024 + hc] = f2bf(o);
        }
    }
}
DI void ph_wout(const Ctx& cx, const Params& p, float* lds, const bf16_t* A, const float* W, int nrows, const float* xin_lat, const float* xin_ctx, const float* modl) {
    ngemm<false>(cx, lds, 1, nrows, 1024, 1024,
        [&](int, int m) { return A + (size_t)m * 1024; },
        [&](int, int k) { return W + (size_t)k * 1024; }, [&](int, int) { return (const float*)nullptr; },
        [&](int, int m, int n, float v, float) {
            const bool lat = m < NLAT; const int jj = lat ? (m >> 11) : 16; const float g1 = modl[(size_t)jj * 6144 + 2 * 1024 + n];
            if (lat) p.out[(size_t)m * 1024 + n] = xin_lat[(size_t)m * 1024 + n] + g1 * v;
            else p.ctxs[(size_t)(m - NLAT) * 1024 + n] = xin_ctx[(size_t)(m - NLAT) * 1024 + n] + g1 * v; });
}

DI void ph_chdft(const Ctx& cx, const Params& p, float* lds, int nrows) {
    const int tid = cx.tid, gtid = cx.bid * NTHR + tid, gsz = cx.nblk * NTHR;
    for (int i = tid; i < 128; i += NTHR) { lds[i] = cospif((float)i * (1.f / 64.f)); lds[128 + i] = sinpif((float)i * (1.f / 64.f)); }
    __syncthreads();
    for (int idx = gtid; idx < nrows * 1024; idx += gsz) {
        const int row = idx >> 10, col = idx & 1023, grp = col >> 7, g = col & 127;
        const bf16_t* hp = p.H + (size_t)row * 1024 + grp * 128;
        float gr = 0.f, gi = 0.f;
        for (int c = 0; c < 128; ++c) { const float xv = bf2f(hp[c]); const int m = (c * g) & 127; gr += xv * lds[m]; gi -= xv * lds[128 + m]; }
        p.G[(size_t)row * 2048 + col] = gr; p.G[(size_t)row * 2048 + 1024 + col] = gi;
    }
    __syncthreads();
}
DI void ph_posdft(const Ctx& cx, const Params& p, float* lds, bool with_ctx) {
    ngemm<false>(cx, lds, 16, 2048, 1024, 4096,
        [&](int, int m) { return p.dftl + (size_t)m * 4096; },
        [&](int bz, int k) { return (k < 2048) ? p.G + (size_t)(bz * 2048 + k) * 2048 : p.G + (size_t)(bz * 2048 + k - 2048) * 2048 + 1024; }, [&](int, int) { return (const float*)nullptr; },
        [&](int bz, int m, int n, float v, float) { p.F[(size_t)(bz * 2048 + m) * 1024 + n] = f2bf(v * (1.f / 512.f)); });
    if (with_ctx)
        ngemm<false>(cx, lds, 16, 256, 1024, 512,
            [&](int, int m) { return p.dftc + (size_t)m * 512; },
            [&](int bz, int k) { return (k < 256) ? p.G + (size_t)(NLAT + bz * 256 + k) * 2048 : p.G + (size_t)(NLAT + bz * 256 + k - 256) * 2048 + 1024; }, [&](int, int) { return (const float*)nullptr; },
            [&](int bz, int m, int n, float v, float) { p.F[(size_t)(NLAT + bz * 256 + m) * 1024 + n] = f2bf(v * 0.0055242717280199f); });
}

DI void ph_moe_up(const Ctx& cx, const Params& p, float* lds, int layer, int nrows) {
    for (int e = 0; e < 17; ++e) {
        const int M = (e < 16) ? __builtin_amdgcn_readfirstlane(p.cnt[(layer * 16 + e) * 64]) : nrows;
        const float* Wg = (e < 16) ? p.moe_w_gate + ((size_t)layer * 16 + e) * 1024 * 512 : p.sh_gate + (size_t)layer * 1024 * 512;
        const float* Wu = (e < 16) ? p.moe_w_up + ((size_t)layer * 16 + e) * 1024 * 512 : p.sh_up + (size_t)layer * 1024 * 512;
        const int* sl = p.slot + (size_t)(e & 15) * NT;
        ngemm<true>(cx, lds, 1, M, 512, 1024,
            [&](int, int m) { const int tok = (e < 16) ? (sl[m] >> 1) : m; return p.H + (size_t)tok * 1024; },
            [&](int, int k) { return Wg + (size_t)k * 512; }, [&](int, int k) { return Wu + (size_t)k * 512; },
            [&](int, int m, int n, float g, float u) { const int s = (e < 16) ? sl[m] : 0; const int tok = (e < 16) ? (s >> 1) : m, slab = (e < 16) ? (s & 1) : 2;
                p.ACT[((size_t)slab * NT + tok) * 512 + n] = f2bf(siluf(g) * u); });
    }
}
DI void ph_moe_down(const Ctx& cx, const Params& p, float* lds, int layer, int nrows) {
    for (int e = 0; e < 17; ++e) {
        const int M = (e < 16) ? __builtin_amdgcn_readfirstlane(p.cnt[(layer * 16 + e) * 64]) : nrows;
        const float* Wd = (e < 16) ? p.moe_w_down + ((size_t)layer * 16 + e) * 512 * 1024 : p.sh_down + (size_t)layer * 512 * 1024;
        const int* sl = p.slot + (size_t)(e & 15) * NT;
        ngemm<false>(cx, lds, 1, M, 1024, 512,
            [&](int, int m) { const int s = (e < 16) ? sl[m] : 0; const int tok = (e < 16) ? (s >> 1) : m, slab = (e < 16) ? (s & 1) : 2; return p.ACT + ((size_t)slab * NT + tok) * 512; },
            [&](int, int k) { return Wd + (size_t)k * 1024; }, [&](int, int) { return (const float*)nullptr; },
            [&](int, int m, int n, float v, float) { const int s = (e < 16) ? sl[m] : 0; const int tok = (e < 16) ? (s >> 1) : m, slab = (e < 16) ? (s & 1) : 2;
                const float w = (e < 16) ? p.tokw[s] : 1.f; p.Y[((size_t)slab * NT + tok) * 1024 + n] = f2bf(w * v); });
    }
}

namespace mm {
typedef short bf16x8 __attribute__((ext_vector_type(8)));
typedef float f32x4 __attribute__((ext_vector_type(4)));
typedef unsigned u32x4 __attribute__((ext_vector_type(4)));
constexpr int BM = 256, BK = 64, HALF = 128, HTB = HALF * BK * 2, STAGE_BYTES = 8 * HTB;
DI int lds_byte(int r, int c) { const int st = (r >> 4) * 2 + (c >> 5), rr = r & 15, cc = c & 31, ob = rr * 64 + cc * 2; return st * 1024 + (ob ^ (((ob >> 9) & 1) << 5)); }
DI void stage_rc(int b, int& R, int& C) { const int st = b / 1024, sb = b % 1024, swz = sb ^ (((sb >> 9) & 1) << 5); R = (st >> 1) * 16 + swz / 64; C = (st & 1) * 32 + (swz % 64) / 2; }
DI int perm32(int rho) { const int n = rho >> 4, i = rho & 15; return 8 * (i >> 2) + 4 * n + (i & 3); }
DI unsigned cvt_pk_bf16(float lo, float hi) { unsigned r; asm volatile("v_cvt_pk_bf16_f32 %0, %1, %2" : "=v"(r) : "v"(lo), "v"(hi)); return r; }
struct Unit { const char* A; const char* B; int pm, pn, e, m, tb; };
template <class Sched, class Epi>
DI void gemm_phase(LAS unsigned char* lds, const int K, const Sched& S, const Epi& E, const int tid) {
    const int wid = __builtin_amdgcn_readfirstlane(tid >> 6), lane = tid & 63, wr = wid >> 2, wc = wid & 3, fr = lane & 15, fq = lane >> 4;
    const int nt = K / BK;
    int R0, C0, R1, C1; stage_rc(tid * 16, R0, C0); stage_rc(tid * 16 + 8192, R1, C1);
    unsigned voffB[2];
    { const int Rb0 = Epi::PERM ? ((R0 & ~31) + perm32(R0 & 31)) : R0, Rb1 = Epi::PERM ? ((R1 & ~31) + perm32(R1 & 31)) : R1;
      voffB[0] = S.boff(Rb0, C0, K); voffB[1] = S.boff(Rb1, C1, K); }
    const size_t kstep = (size_t)(BK * 2), hstepB = S.hstep_b(K), hstepA = S.hstep_a();
    const unsigned ldsw = (unsigned)wid * 1024u;
    const int aoff = lds_byte(wr * 64 + fr, fq * 8), boff = lds_byte(wc * 32 + fr, fq * 8);
#define MM_SA(b, h) (((b) * 2 + (h)) * HTB)
#define MM_SB(b, h) ((4 + (b) * 2 + (h)) * HTB)
#define MM_STAGE_A(bufoff, gbase, h, offs) do { _Pragma("unroll") for (int _i = 0; _i < 2; ++_i) { \
        if constexpr (Sched::GATHER) __builtin_amdgcn_global_load_lds((const unsigned*)((const char*)(gbase) + (offs)[h][_i]), (LAS unsigned*)(lds + (bufoff) + ldsw + _i * 8192), 16, 0, 0); \
        else __builtin_amdgcn_global_load_lds((const unsigned*)((const char*)(gbase) + (size_t)(h) * hstepA + (offs)[0][_i]), (LAS unsigned*)(lds + (bufoff) + ldsw + _i * 8192), 16, 0, 0); } } while (0)
#define MM_STAGE_B(bufoff, gbase) do { _Pragma("unroll") for (int _i = 0; _i < 2; ++_i) \
        __builtin_amdgcn_global_load_lds((const unsigned*)((const char*)(gbase) + voffB[_i]), (LAS unsigned*)(lds + (bufoff) + ldsw + _i * 8192), 16, 0, 0); } while (0)
#define MM_LDA(dst, b, h) do { _Pragma("unroll") for (int m = 0; m < 4; ++m) _Pragma("unroll") for (int k = 0; k < 2; ++k) dst[m][k] = *(const LAS bf16x8*)(lds + MM_SA(b, h) + aoff + m * 2048 + k * 1024); } while (0)
#define MM_LDB(dst, b, h) do { _Pragma("unroll") for (int n = 0; n < 2; ++n) _Pragma("unroll") for (int k = 0; k < 2; ++k) dst[n][k] = *(const LAS bf16x8*)(lds + MM_SB(b, h) + boff + n * 2048 + k * 1024); } while (0)
#define MM_MMA(ai, bj, At, Bt) do { __builtin_amdgcn_s_setprio(1); _Pragma("unroll") for (int m = 0; m < 4; ++m) _Pragma("unroll") for (int n = 0; n < 2; ++n) _Pragma("unroll") for (int k = 0; k < 2; ++k) \
        acc[ai][bj][m][n] = __builtin_amdgcn_mfma_f32_16x16x32_bf16(Bt[n][k], At[m][k], acc[ai][bj][m][n], 0, 0, 0); __builtin_amdgcn_s_setprio(0); } while (0)
#define MM_WAIT_V(n) asm volatile("s_waitcnt vmcnt(" #n ")" ::: "memory")
#define MM_WAIT_L(n) asm volatile("s_waitcnt lgkmcnt(" #n ")" ::: "memory")
#define MM_BAR __builtin_amdgcn_s_barrier()
#define MM_SCHED __builtin_amdgcn_sched_barrier(0)
    Unit cur, nxt; int ui = 0;
    if (!S.next(0, cur)) return;
    unsigned oa[2][2], on[2][2];
    S.aoff(cur, R0, C0, R1, C1, oa);
    on[0][0] = oa[0][0]; on[0][1] = oa[0][1]; on[1][0] = oa[1][0]; on[1][1] = oa[1][1];
    if constexpr (Sched::TABLE) S.tab_dma(cur, lds + STAGE_BYTES + 1024, tid);
    f32x4 acc[2][2][4][2];
#pragma unroll
    for (int a = 0; a < 2; ++a)
#pragma unroll
        for (int b = 0; b < 2; ++b)
#pragma unroll
            for (int m = 0; m < 4; ++m)
#pragma unroll
                for (int n = 0; n < 2; ++n) acc[a][b][m][n] = (f32x4){0.f, 0.f, 0.f, 0.f};
    bf16x8 At[4][2], B0[2][2], B1[2][2];
    const char* cA = cur.A; const char* cB = cur.B;
    MM_STAGE_B(MM_SB(0, 0), cB); MM_STAGE_A(MM_SA(0, 0), cA, 0, oa); MM_STAGE_B(MM_SB(0, 1), cB + hstepB); MM_STAGE_A(MM_SA(0, 1), cA, 1, oa);
    if (wr == 1) MM_BAR;
    MM_WAIT_V(4); MM_BAR;
    MM_STAGE_B(MM_SB(1, 0), cB + kstep); MM_STAGE_A(MM_SA(1, 0), cA + kstep, 0, oa); MM_STAGE_B(MM_SB(1, 1), cB + hstepB + kstep);
    MM_WAIT_V(6); MM_BAR;
    for (;;) {
        cur.tb = ui % 3;
        const bool has_next = S.next(ui + 1, nxt);
        if constexpr (Sched::TABLE) { if (has_next) S.tab_dma(nxt, lds + STAGE_BYTES + 1024 + ((ui + 1) % 3) * 2048, tid); }
        const char* nA = has_next ? nxt.A : cA; const char* nB = has_next ? nxt.B : cB;
        for (int t = 0; t < nt; t += 2) {
            const bool last = (t == nt - 2);
            if constexpr (Sched::GATHER) { if (last) { if (has_next) S.aoff_lds(nxt, (const LAS int*)(lds + STAGE_BYTES + 1024 + ((ui + 1) % 3) * 2048), R0, C0, R1, C1, on);
                else { on[0][0] = oa[0][0]; on[0][1] = oa[0][1]; on[1][0] = oa[1][0]; on[1][1] = oa[1][1]; } } }
            const char* a1 = cA + (size_t)(t + 1) * kstep;
            const char* a2 = last ? nA : cA + (size_t)(t + 2) * kstep; const char* b2 = last ? nB : cB + (size_t)(t + 2) * kstep;
            const char* a3 = a2 + kstep; const char* b3 = b2 + kstep;
            unsigned o2[2][2];
            if constexpr (Sched::GATHER) { o2[0][0] = last ? on[0][0] : oa[0][0]; o2[0][1] = last ? on[0][1] : oa[0][1]; o2[1][0] = last ? on[1][0] : oa[1][0]; o2[1][1] = last ? on[1][1] : oa[1][1]; }
            else { o2[0][0] = oa[0][0]; o2[0][1] = oa[0][1]; o2[1][0] = oa[1][0]; o2[1][1] = oa[1][1]; }
            MM_LDB(B0, 0, 0); MM_SCHED; MM_LDA(At, 0, 0); MM_STAGE_A(MM_SA(1, 1), a1, 1, oa);
            MM_WAIT_L(8); MM_BAR; MM_WAIT_L(0); MM_MMA(0, 0, At, B0); MM_BAR; MM_SCHED;
            MM_LDB(B1, 0, 1); MM_STAGE_B(MM_SB(0, 0), b2);
            MM_BAR; MM_WAIT_L(0); MM_MMA(0, 1, At, B1); MM_BAR;
            MM_LDA(At, 0, 1); MM_STAGE_A(MM_SA(0, 0), a2, 0, o2);
            MM_BAR; MM_WAIT_L(0); MM_MMA(1, 0, At, B0); MM_BAR; MM_SCHED;
            MM_STAGE_B(MM_SB(0, 1), b2 + hstepB);
            MM_WAIT_V(6); MM_BAR; MM_MMA(1, 1, At, B1); MM_BAR;
            MM_LDB(B0, 1, 0); MM_SCHED; MM_LDA(At, 1, 0); MM_STAGE_A(MM_SA(0, 1), a2, 1, o2);
            MM_WAIT_L(8); MM_BAR; MM_WAIT_L(0); MM_MMA(0, 0, At, B0); MM_BAR; MM_SCHED;
            MM_LDB(B1, 1, 1); MM_STAGE_B(MM_SB(1, 0), b3);
            MM_BAR; MM_WAIT_L(0); MM_MMA(0, 1, At, B1); MM_BAR;
            MM_LDA(At, 1, 1); MM_STAGE_A(MM_SA(1, 0), a3, 0, o2);
            MM_BAR; MM_WAIT_L(0); MM_MMA(1, 0, At, B0); MM_BAR; MM_SCHED;
            MM_STAGE_B(MM_SB(1, 1), b3 + hstepB);
            MM_WAIT_V(6); MM_BAR; MM_MMA(1, 1, At, B1); MM_BAR;
        }
        {
          int tz = tid; asm volatile("" : "+v"(tz)); const int wz = tz >> 6, lz = tz & 63;
          E(acc, cur, wz >> 2, wz & 3, lz & 15, lz >> 4); }
        if (!has_next) break;
#pragma unroll
        for (int a = 0; a < 2; ++a)
#pragma unroll
            for (int b = 0; b < 2; ++b)
#pragma unroll
                for (int m = 0; m < 4; ++m)
#pragma unroll
                    for (int n = 0; n < 2; ++n) acc[a][b][m][n] = (f32x4){0.f, 0.f, 0.f, 0.f};
        cur = nxt; cA = nA; cB = nB; ++ui;
        if constexpr (Sched::GATHER) { oa[0][0] = on[0][0]; oa[0][1] = on[0][1]; oa[1][0] = on[1][0]; oa[1][1] = on[1][1]; }
    }
    MM_WAIT_V(0);
    if (wr == 0) MM_BAR;
    MM_BAR;
#undef MM_SA
#undef MM_SB
#undef MM_STAGE_A
#undef MM_STAGE_B
#undef MM_LDA
#undef MM_LDB
#undef MM_MMA
#undef MM_WAIT_V
#undef MM_WAIT_L
#undef MM_BAR
#undef MM_SCHED
}
struct StaticSched {
    static constexpr bool GATHER = false, TABLE = false;
    const char* A; const char* Bt; int lda, K, nM, nN, nwg, G, c;
    DI size_t hstep_a() const { return (size_t)HALF * lda * 2; }
    DI unsigned boff(int Rb, int C, int Kk) const { return (unsigned)(Rb * Kk + C) * 2u; }
    DI size_t hstep_b(int Kk) const { return (size_t)HALF * Kk * 2; }
    DI void init(const void* A_, const void* Bt_, int M, int N, int K_, int lda_, int G_, int c_) { A = (const char*)A_; Bt = (const char*)Bt_; lda = lda_; K = K_; nM = M / BM; nN = N / BM; nwg = nM * nN; G = G_; c = c_; }
    DI bool next(int i, Unit& u) const {
        const int L = i * G + c; if (L >= nwg) return false;
        int wgid = L; { const int q = nwg / 8, r = nwg % 8, xcd = wgid % 8, off = wgid / 8; wgid = (xcd < r ? xcd * (q + 1) : r * (q + 1) + (xcd - r) * q) + off; }
        const int nig = 8 * nN, gid = wgid / nig, fm = gid * 8, gsz = (nM - fm) < 8 ? (nM - fm) : 8;
        u.pm = fm + ((wgid % nig) % gsz); u.pn = (wgid % nig) / gsz; u.e = 0; u.m = 0;
        u.A = A + (size_t)u.pm * BM * lda * 2; u.B = Bt + (size_t)u.pn * BM * K * 2; return true;
    }
    DI void aoff(const Unit&, int R0, int C0, int R1, int C1, unsigned (&o)[2][2]) const {
        o[0][0] = (unsigned)(R0 * lda + C0) * 2u; o[0][1] = (unsigned)(R1 * lda + C1) * 2u;
        o[1][0] = (unsigned)((HALF + R0) * lda + C0) * 2u; o[1][1] = (unsigned)((HALF + R1) * lda + C1) * 2u;
    }
};
struct BatchSched {
    static constexpr bool GATHER = false, TABLE = false;
    const char* A; const char* Bt; int K, nM, nN, nb, G, c; size_t bstride;
    DI size_t hstep_a() const { return (size_t)HALF * K * 2; }
    DI unsigned boff(int Rb, int C, int Kk) const { return (unsigned)(Rb * Kk + C) * 2u; }
    DI size_t hstep_b(int Kk) const { return (size_t)HALF * Kk * 2; }
    DI void init(const void* A_, const void* Bt_, size_t bstride_bytes, int nb_, int M, int N, int K_, int G_, int c_) { A = (const char*)A_; Bt = (const char*)Bt_; bstride = bstride_bytes; nb = nb_; K = K_; nM = M / BM; nN = N / BM; G = G_; c = c_; }
    DI bool next(int i, Unit& u) const {
        const int L = i * G + c; if (L >= nb * nM * nN) return false;
        const int b = L / (nM * nN), rem = L % (nM * nN); u.pm = rem / nN; u.pn = rem % nN; u.e = b; u.m = 0;
        u.A = A + (size_t)u.pm * BM * K * 2; u.B = Bt + (size_t)b * bstride + (size_t)u.pn * BM * K * 2; return true;
    }
    DI void aoff(const Unit&, int R0, int C0, int R1, int C1, unsigned (&o)[2][2]) const {
        o[0][0] = (unsigned)(R0 * K + C0) * 2u; o[0][1] = (unsigned)(R1 * K + C1) * 2u;
        o[1][0] = (unsigned)((HALF + R0) * K + C0) * 2u; o[1][1] = (unsigned)((HALF + R1) * K + C1) * 2u;
    }
};
struct EpiBf16Store {
    static constexpr bool PERM = true;
    bf16_t* O0; int ldc; size_t bstr = 0;
    DI void operator()(const f32x4 (&acc)[2][2][4][2], const Unit& u, int wr, int wc, int fr, int fq) const {
        bf16_t* O = O0 + (size_t)u.e * bstr;
        const int row0 = u.pm * BM + wr * 64 + fr, col0 = u.pn * BM + wc * 32 + 8 * fq;
#pragma unroll
        for (int ai = 0; ai < 2; ++ai)
#pragma unroll
            for (int m = 0; m < 4; ++m) { bf16_t* rowp = O + (size_t)(row0 + ai * HALF + m * 16) * ldc + col0;
#pragma unroll
                for (int bj = 0; bj < 2; ++bj) { const f32x4 v0 = acc[ai][bj][m][0], v1 = acc[ai][bj][m][1];
                    u32x4 w; w.x = cvt_pk_bf16(v0[0], v0[1]); w.y = cvt_pk_bf16(v0[2], v0[3]); w.z = cvt_pk_bf16(v1[0], v1[1]); w.w = cvt_pk_bf16(v1[2], v1[3]);
                    *(u32x4*)(rowp + bj * HALF) = w; } }
    }
};
struct EpiResid {
    static constexpr bool PERM = false;
    const float* xin_lat; const float* xin_ctx; float* out_lat; float* out_ctx; const float* modl; int batched_T;
    DI void operator()(const f32x4 (&acc)[2][2][4][2], const Unit& u, int wr, int wc, int fr, int fq) const {
        int grow0; if (batched_T == 0) grow0 = u.pm * BM; else if (batched_T > 0) grow0 = u.e * 2048 + u.pm * BM; else grow0 = NLAT + u.e * 256 + u.pm * BM;
        const bool lat = grow0 < NLAT; const int jj = lat ? (grow0 >> 11) : 16;
        const float* xi = lat ? xin_lat + (size_t)grow0 * 1024 : xin_ctx + (size_t)(grow0 - NLAT) * 1024;
        float* xo = lat ? out_lat + (size_t)grow0 * 1024 : out_ctx + (size_t)(grow0 - NLAT) * 1024;
        const float* g1 = modl + (size_t)jj * 6144 + 2 * 1024;
        const int r0 = wr * 64 + fr, col0 = u.pn * BM + wc * 32 + 4 * fq;
        f32x4 gv[2][2];
#pragma unroll
        for (int bj = 0; bj < 2; ++bj)
#pragma unroll
            for (int n = 0; n < 2; ++n) gv[bj][n] = *(const f32x4*)(g1 + col0 + bj * HALF + n * 16);
#pragma unroll
        for (int ai = 0; ai < 2; ++ai) {
            f32x4 xv[4][2][2];
#pragma unroll
            for (int m = 0; m < 4; ++m)
#pragma unroll
                for (int bj = 0; bj < 2; ++bj)
#pragma unroll
                    for (int n = 0; n < 2; ++n) xv[m][bj][n] = *(const f32x4*)(xi + (size_t)(r0 + ai * HALF + m * 16) * 1024 + col0 + bj * HALF + n * 16);
#pragma unroll
            for (int m = 0; m < 4; ++m)
#pragma unroll
                for (int bj = 0; bj < 2; ++bj)
#pragma unroll
                    for (int n = 0; n < 2; ++n) *(f32x4*)(xo + (size_t)(r0 + ai * HALF + m * 16) * 1024 + col0 + bj * HALF + n * 16) = xv[m][bj][n] + gv[bj][n] * acc[ai][bj][m][n];
            asm volatile("" ::: "memory");
        }
    }
};
struct EpiResidB {
    static constexpr bool PERM = true;
    const void* xin_lat; const void* xin_ctx; bf16_t* out_lat; bf16_t* out_ctx; const float* modl; int batched_T; int in_f32;
    DI void operator()(const f32x4 (&acc)[2][2][4][2], const Unit& u, int wr, int wc, int fr, int fq) const {
        int grow0; if (batched_T == 0) grow0 = u.pm * BM; else if (batched_T > 0) grow0 = u.e * 2048 + u.pm * BM; else grow0 = NLAT + u.e * 256 + u.pm * BM;
        const bool lat = grow0 < NLAT; const int jj = lat ? (grow0 >> 11) : 16; const size_t rb = lat ? (size_t)grow0 : (size_t)(grow0 - NLAT);
        const float* g1 = modl + (size_t)jj * 6144 + 2 * 1024;
        bf16_t* xo = (lat ? out_lat : out_ctx) + rb * 1024;
        const int r0 = wr * 64 + fr, col0 = u.pn * BM + wc * 32 + 8 * fq;
        f32x4 gv[2][2];
#pragma unroll
        for (int bj = 0; bj < 2; ++bj)
#pragma unroll
            for (int n = 0; n < 2; ++n) gv[bj][n] = *(const f32x4*)(g1 + col0 + bj * HALF + 4 * n);
        if (in_f32) {
            const float* xi = (const float*)(lat ? xin_lat : xin_ctx) + rb * 1024;
#pragma unroll
            for (int ai = 0; ai < 2; ++ai)
#pragma unroll
                for (int mp = 0; mp < 2; ++mp) {
                    f32x4 xv[2][2][2];
#pragma unroll
                    for (int mm_ = 0; mm_ < 2; ++mm_)
#pragma unroll
                        for (int bj = 0; bj < 2; ++bj)
#pragma unroll
                            for (int n = 0; n < 2; ++n) xv[mm_][bj][n] = *(const f32x4*)(xi + (size_t)(r0 + ai * HALF + (2 * mp + mm_) * 16) * 1024 + col0 + bj * HALF + 4 * n);
#pragma unroll
                    for (int mm_ = 0; mm_ < 2; ++mm_)
#pragma unroll
                        for (int bj = 0; bj < 2; ++bj) { const int m = 2 * mp + mm_; const f32x4 o0 = xv[mm_][bj][0] + gv[bj][0] * acc[ai][bj][m][0], o1 = xv[mm_][bj][1] + gv[bj][1] * acc[ai][bj][m][1];
                            u32x4 w; w.x = att_pk(o0[0], o0[1]); w.y = att_pk(o0[2], o0[3]); w.z = att_pk(o1[0], o1[1]); w.w = att_pk(o1[2], o1[3]);
                            *(u32x4*)(xo + (size_t)(r0 + ai * HALF + m * 16) * 1024 + col0 + bj * HALF) = w; }
                    asm volatile("" ::: "memory");
                }
        } else {
            const bf16_t* xi = (const bf16_t*)(lat ? xin_lat : xin_ctx) + rb * 1024;
#pragma unroll
            for (int ai = 0; ai < 2; ++ai) {
                u32x4 xv[4][2];
#pragma unroll
                for (int m = 0; m < 4; ++m)
#pragma unroll
                    for (int bj = 0; bj < 2; ++bj) xv[m][bj] = *(const u32x4*)(xi + (size_t)(r0 + ai * HALF + m * 16) * 1024 + col0 + bj * HALF);
#pragma unroll
                for (int m = 0; m < 4; ++m)
#pragma unroll
                    for (int bj = 0; bj < 2; ++bj) { const u32x4 x = xv[m][bj];
                        const f32x4 x0 = {__uint_as_float(x.x << 16), __uint_as_float(x.x & 0xffff0000u), __uint_as_float(x.y << 16), __uint_as_float(x.y & 0xffff0000u)};
                        const f32x4 x1 = {__uint_as_float(x.z << 16), __uint_as_float(x.z & 0xffff0000u), __uint_as_float(x.w << 16), __uint_as_float(x.w & 0xffff0000u)};
                        const f32x4 o0 = x0 + gv[bj][0] * acc[ai][bj][m][0], o1 = x1 + gv[bj][1] * acc[ai][bj][m][1];
                        u32x4 w; w.x = att_pk(o0[0], o0[1]); w.y = att_pk(o0[2], o0[3]); w.z = att_pk(o1[0], o1[1]); w.w = att_pk(o1[2], o1[3]);
                        *(u32x4*)(xo + (size_t)(r0 + ai * HALF + m * 16) * 1024 + col0 + bj * HALF) = w; }
                asm volatile("" ::: "memory");
            }
        }
    }
};
}

DI void tconv_tile(const Ctx& cx, float* T, const float* src, int ld_src, int k0, int n0, int kvalid, int nvalid, bf16_t* dst, int ldd, int drow0) {
    const int tid = cx.tid;
#pragma unroll
    for (int rr = 0; rr < 2; ++rr) {
        const int i = (tid >> 4) + 32 * rr, j = (tid & 15) * 4;
        float4 v = make_float4(0.f, 0.f, 0.f, 0.f);
        if (k0 + i < kvalid && n0 + j < nvalid) v = *(const float4*)(src + (size_t)(k0 + i) * ld_src + n0 + j);
        T[i * 65 + j] = v.x; T[i * 65 + j + 1] = v.y; T[i * 65 + j + 2] = v.z; T[i * 65 + j + 3] = v.w;
    }
    __syncthreads();
    { const int j = tid >> 3, ch = tid & 7; uint4 o;
      o.x = pack2(T[(ch * 8 + 0) * 65 + j], T[(ch * 8 + 1) * 65 + j]); o.y = pack2(T[(ch * 8 + 2) * 65 + j], T[(ch * 8 + 3) * 65 + j]);
      o.z = pack2(T[(ch * 8 + 4) * 65 + j], T[(ch * 8 + 5) * 65 + j]); o.w = pack2(T[(ch * 8 + 6) * 65 + j], T[(ch * 8 + 7) * 65 + j]);
      *(uint4*)(dst + (size_t)(drow0 + j) * ldd + k0 + ch * 8) = o; }
    __syncthreads();
}
DI void ph_prep_weights(const Ctx& cx, const Params& p, float* lds) {
    const int tid = cx.tid, gtid = cx.bid * NTHR + tid, gsz = cx.nblk * NTHR;
    for (int it = cx.bid; it < 2 * 1008; it += cx.nblk) {
        const int j = it / 1008; int r = it % 1008;
        if (r < 640) { const int kt = r / 40, ntl = r % 40; tconv_tile(cx, lds, p.w_in + (size_t)j * 1024 * INC, INC, kt * 64, ntl * 64, 1024, INC, p.WinT + (size_t)j * 2560 * 1024, 1024, ntl * 64); continue; } r -= 640;
        if (r < 48) { const int kt = r / 12, ntl = r % 12; tconv_tile(cx, lds, p.b_w_q_up + (size_t)j * 256 * 768, 768, kt * 64, ntl * 64, 256, 768, p.WqT + (size_t)j * 768 * 256, 256, ntl * 64); continue; } r -= 48;
        if (r < 64) { const int kt = r / 16, ntl = r % 16; tconv_tile(cx, lds, p.b_w_kv_up + (size_t)j * 128 * 1024, 1024, kt * 64, ntl * 64, 128, 1024, p.WkvT + (size_t)j * 1024 * 256, 256, ntl * 64); continue; } r -= 64;
        { const int kt = r / 16, ntl = r % 16; tconv_tile(cx, lds, p.w_out_even + (size_t)j * 1024 * 1024, 1024, kt * 64, ntl * 64, 1024, 1024, p.WoutT + (size_t)j * 1024 * 1024, 1024, ntl * 64); }
    }
    for (int idx = gtid; idx < 2 * 2560 * 384; idx += gsz) {
        const int j = idx / (2560 * 384), rem = idx % (2560 * 384), n = rem / 384, k = rem % 384; const int seg = n >> 9, nn = n & 511;
        float v = 0.f;
        if (seg < 2) { if ((k >> 6) == seg) v = p.a_w2[((size_t)(j * 2 + seg) * 64 + (k & 63)) * 512 + nn]; }
        else if (seg < 4) { if ((k >> 6) == seg) v = p.a_a2[((size_t)(j * 2 + seg - 2) * 64 + (k & 63)) * 512 + nn]; }
        else { if (k >= 256) v = p.a_g2[((size_t)j * 128 + (k - 256)) * 512 + nn]; }
        p.WlrT[idx] = f2bf(v);
    }
    {
        float* Tc = lds; float* Ts = lds + 64 * 65; float* tab = lds + 2 * 64 * 65;
        for (int i = tid; i < 128; i += NTHR) { tab[i] = cospif((float)i * (1.f / 64.f)); tab[128 + i] = sinpif((float)i * (1.f / 64.f)); }
        __syncthreads();
        for (int it = cx.bid; it < 2 * 256; it += cx.nblk) {
            const int j = it >> 8, ct = (it >> 4) & 15, et = it & 15; const float* Wf = p.w_out_fourier + (size_t)j * 1024 * 1024;
            const int el = tid & 63, e = et * 64 + el;
#pragma unroll 1
            for (int i = 0; i < 8; ++i) {
                const int chl = (tid >> 6) + 8 * i, ch = ct * 64 + chl, grp = ch >> 7, c = ch & 127;
                float sc = 0.f, ss = 0.f;
                for (int g = 0; g < 128; ++g) { const float w = Wf[(size_t)(grp * 128 + g) * 1024 + e]; const int m = (c * g) & 127; sc += tab[m] * w; ss += tab[128 + m] * w; }
                Tc[chl * 65 + el] = sc; Ts[chl * 65 + el] = ss;
            }
            __syncthreads();
            { const int el2 = tid >> 3, chunk = tid & 7; uint4 o, o2; const float* a = Tc + chunk * 8 * 65 + el2; const float* b = Ts + chunk * 8 * 65 + el2;
              o.x = pack2(a[0], a[65]); o.y = pack2(a[2 * 65], a[3 * 65]); o.z = pack2(a[4 * 65], a[5 * 65]); o.w = pack2(a[6 * 65], a[7 * 65]);
              o2.x = pack2(b[0], b[65]); o2.y = pack2(b[2 * 65], b[3 * 65]); o2.z = pack2(b[4 * 65], b[5 * 65]); o2.w = pack2(b[6 * 65], b[7 * 65]);
              bf16_t* d = p.A1 + (size_t)j * 2048 * 1024 + (size_t)(et * 64 + el2) * 1024 + ct * 64 + chunk * 8;
              *(uint4*)d = o; *(uint4*)(d + (size_t)1024 * 1024) = o2; }
            __syncthreads();
        }
    }
    for (int i = gtid; i < 256 * 256; i += gsz) {
        const int m = i >> 8, k = i & 255, f1 = m & 127, t1 = k & 127; const float a = (float)((f1 * t1) & 127) * (1.f / 64.f); const float cs = cospif(a), sn = sinpif(a);
        const float v = (m < 128) ? ((k < 128) ? cs : -sn) : ((k < 128) ? -sn : -cs);
        p.M1[i] = f2bf(v);
    }
    for (int i = gtid; i < 2048 * 4096; i += gsz) {
        const int f = i >> 12, k = i & 4095, t = k & 2047, m = (f * t) & 2047; const float a = (float)m * (1.f / 1024.f);
        p.A2[i] = f2bf(((k < 2048) ? cospif(a) : -sinpif(a)) * (1.f / 512.f));
    }
    for (int i = gtid; i < 256 * 512; i += gsz) {
        const int f = i >> 9, k = i & 511, t = k & 255, m = (f * t) & 255; const float a = (float)m * (1.f / 128.f);
        p.A2c[i] = f2bf(((k < 256) ? cospif(a) : -sinpif(a)) * 0.0055242717280199f);
    }
    __syncthreads();
}
DI void ph_prep_moe(const Ctx& cx, const Params& p, float* lds, int layer) {
    const int tid = cx.tid; constexpr int TP = 513;
    for (int s = cx.bid; s < 17 * 48; s += cx.nblk) {
        const int e = s / 48, r = s % 48;
        const float* src; int ld_src, kt, ldd; bf16_t* dst; int bj = 0, nh = 0; const bool gu = r < 32;
        if (gu) { bj = r >> 4; kt = r & 15; ld_src = 512; ldd = 1024;
            src = (bj ? ((e < 16) ? p.moe_w_up + ((size_t)layer * 16 + e) * 1024 * 512 : p.sh_up + (size_t)layer * 1024 * 512)
                      : ((e < 16) ? p.moe_w_gate + ((size_t)layer * 16 + e) * 1024 * 512 : p.sh_gate + (size_t)layer * 1024 * 512)) + (size_t)kt * 64 * 512;
            dst = p.WguT + (size_t)e * 1024 * 1024; }
        else { const int r2 = r - 32; kt = r2 >> 1; nh = r2 & 1; ld_src = 1024; ldd = 512;
            src = ((e < 16) ? p.moe_w_down + ((size_t)layer * 16 + e) * 512 * 1024 : p.sh_down + (size_t)layer * 512 * 1024) + (size_t)kt * 64 * 1024 + nh * 512;
            dst = p.WdT + (size_t)e * 1024 * 512; }
        float4 v[16];
#pragma unroll
        for (int i = 0; i < 16; ++i) v[i] = *(const float4*)(src + (size_t)((tid >> 7) + 4 * i) * ld_src + (tid & 127) * 4);
        __syncthreads();
#pragma unroll
        for (int i = 0; i < 16; ++i) { float* t = lds + ((tid >> 7) + 4 * i) * TP + (tid & 127) * 4; t[0] = v[i].x; t[1] = v[i].y; t[2] = v[i].z; t[3] = v[i].w; }
        __syncthreads();
#pragma unroll
        for (int it = 0; it < 8; ++it) {
            const int n = (tid >> 3) + 64 * it, ch = tid & 7; const float* t = lds + (ch * 8) * TP + n;
            uint4 o; o.x = att_pk(t[0], t[TP]); o.y = att_pk(t[2 * TP], t[3 * TP]); o.z = att_pk(t[4 * TP], t[5 * TP]); o.w = att_pk(t[6 * TP], t[7 * TP]);
            const int drow = gu ? ((n >> 7) * 256 + bj * 128 + (n & 127)) : (nh * 512 + n);
            *(uint4*)(dst + (size_t)drow * ldd + kt * 64 + ch * 8) = o;
        }
    }
    __syncthreads();
}

#define GEMM_LDS(lds) ((LAS unsigned char*)(lds))
DI void ph_win_mm(const Ctx& cx, const Params& p, float* lds, int j) {
    mm::StaticSched S; S.init(p.H, p.WinT + (size_t)j * 2560 * 1024, NT, 2560, 1024, 1024, cx.nblk, cx.bid);
    mm::EpiBf16Store E{p.P, PLD};
    mm::gemm_phase(GEMM_LDS(lds), 1024, S, E, cx.tid);
}
DI void ph_wout_mmB(const Ctx& cx, const Params& p, float* lds, const bf16_t* A, const bf16_t* Bt, int nrows, const void* xin_lat, const void* xin_ctx, bf16_t* xo_lat, int in_f32, const float* modl) {
    mm::StaticSched S; S.init(A, Bt, nrows, 1024, 1024, 1024, cx.nblk, cx.bid);
    mm::EpiResidB E{xin_lat, xin_ctx, xo_lat, p.cs, modl, 0, in_f32};
    mm::gemm_phase(GEMM_LDS(lds), 1024, S, E, cx.tid);
}
DI void ph_wout_mm(const Ctx& cx, const Params& p, float* lds, const bf16_t* A, const bf16_t* Bt, int nrows, const float* xin_lat, const float* xin_ctx, const float* modl) {
    mm::StaticSched S; S.init(A, Bt, nrows, 1024, 1024, 1024, cx.nblk, cx.bid);
    mm::EpiResid E{xin_lat, xin_ctx, p.out, p.ctxs, modl, 0};
    mm::gemm_phase(GEMM_LDS(lds), 1024, S, E, cx.tid);
}

DI void ph_qkvup_mm(const Ctx& cx, const Params& p, float* lds, int j, int mq) {
    { mm::StaticSched S; S.init(p.QN, p.WqT + (size_t)j * 768 * 256, mq, 768, 256, 512, cx.nblk, cx.bid); mm::EpiBf16Store E{p.Qraw, 768}; mm::gemm_phase(GEMM_LDS(lds), 256, S, E, cx.tid); }
    { mm::StaticSched S; S.init(p.QN + 256, p.WkvT + (size_t)j * 1024 * 256, NT, 1024, 256, 512, cx.nblk, cx.bid); mm::EpiBf16Store E{p.KVraw, 1024}; mm::gemm_phase(GEMM_LDS(lds), 256, S, E, cx.tid); }
}
struct EpiWag {
    static constexpr bool PERM = true;
    bf16_t* O; const LAS float* bias;
    DI void operator()(const mm::f32x4 (&acc)[2][2][4][2], const mm::Unit& u, int wr, int wc, int fr, int fq) const {
        const int row0 = u.pm * 256 + wr * 64 + fr, col0 = u.pn * 256 + wc * 32 + 8 * fq; const int seg = u.pn >> 2;
        const LAS float* bp = bias + col0;
#pragma unroll
        for (int bj = 0; bj < 2; ++bj) {
            mm::f32x4 b0 = (mm::f32x4){0.f, 0.f, 0.f, 0.f}, b1 = b0;
            if (seg < 2) { b0 = *(const LAS mm::f32x4*)(bp + bj * 128); b1 = *(const LAS mm::f32x4*)(bp + bj * 128 + 4); }
#pragma unroll
            for (int ai = 0; ai < 2; ++ai)
#pragma unroll
                for (int m = 0; m < 4; ++m) {
                    mm::f32x4 v0 = acc[ai][bj][m][0] + b0, v1 = acc[ai][bj][m][1] + b1;
                    if (seg == 0) {
#pragma unroll
                        for (int c = 0; c < 4; ++c) { v0[c] = 1.f - __expf(-0.606531f * __builtin_amdgcn_rcpf(1.f + __expf(-v0[c]))); v1[c] = 1.f - __expf(-0.606531f * __builtin_amdgcn_rcpf(1.f + __expf(-v1[c]))); }
                    } else if (seg == 1) {
#pragma unroll
                        for (int c = 0; c < 4; ++c) { v0[c] = __builtin_amdgcn_rcpf(1.f + __expf(-v0[c])); v1[c] = __builtin_amdgcn_rcpf(1.f + __expf(-v1[c])); }
                    }
                    mm::u32x4 w; w.x = mm::cvt_pk_bf16(v0[0], v0[1]); w.y = mm::cvt_pk_bf16(v0[2], v0[3]); w.z = mm::cvt_pk_bf16(v1[0], v1[1]); w.w = mm::cvt_pk_bf16(v1[2], v1[3]);
                    *(mm::u32x4*)(O + (size_t)(row0 + ai * 128 + m * 16) * WLD + col0 + bj * 128) = w;
                }
        }
    }
};
DI void ph_wag_mm(const Ctx& cx, const Params& p, float* lds, int j) {
    mm::StaticSched S; S.init(p.LR, p.WlrT + (size_t)j * 2560 * 384, NT, 2560, 384, 384, cx.nblk, cx.bid);
    LAS float* bl = (LAS float*)lds + 32768 + 256 + 1024;
    for (int i = cx.tid; i < 2048; i += NTHR) bl[i] = (i < 1024) ? p.a_w0[j * 1024 + i] : p.a_a0[j * 1024 + i - 1024];
    __syncthreads();
    EpiWag E{p.WAG, bl};
    mm::gemm_phase(GEMM_LDS(lds), 384, S, E, cx.tid);
}
struct EpiZT {
    static constexpr bool PERM = true;
    bf16_t* Z; int T;
    DI void operator()(const mm::f32x4 (&acc)[2][2][4][2], const mm::Unit& u, int wr, int wc, int fr, int fq) const {
        const int b = (T == 2048) ? (u.pn >> 3) : u.pn, t0 = (T == 2048) ? ((u.pn & 7) * 256) : 0;
        const int m0 = u.pm * 256 + wr * 64 + fr; const int c0 = t0 + wc * 32 + 8 * fq;
#pragma unroll
        for (int ai = 0; ai < 2; ++ai)
#pragma unroll
            for (int m = 0; m < 4; ++m) { const int mr = m0 + ai * 128 + m * 16, part = mr >> 10, ch = mr & 1023;
                bf16_t* rowp = Z + ((size_t)(b * 1024 + ch) * 2 + part) * T + c0;
#pragma unroll
                for (int bj = 0; bj < 2; ++bj) { const mm::f32x4 v0 = acc[ai][bj][m][0], v1 = acc[ai][bj][m][1];
                    mm::u32x4 w; w.x = mm::cvt_pk_bf16(v0[0], v0[1]); w.y = mm::cvt_pk_bf16(v0[2], v0[3]); w.z = mm::cvt_pk_bf16(v1[0], v1[1]); w.w = mm::cvt_pk_bf16(v1[2], v1[3]);
                    *(mm::u32x4*)(rowp + bj * 128) = w; } }
    }
};
DI void ph_f1_mm(const Ctx& cx, const Params& p, float* lds, int j, bool with_ctx) {
    { mm::StaticSched S; S.init(p.A1 + (size_t)j * 2048 * 1024, p.H, 2048, NLAT, 1024, 1024, cx.nblk, cx.bid); EpiZT E{p.ZT, 2048}; mm::gemm_phase(GEMM_LDS(lds), 1024, S, E, cx.tid); }
    if (with_ctx) { mm::StaticSched S; S.init(p.A1 + (size_t)j * 2048 * 1024, p.H + (size_t)NLAT * 1024, 2048, NCTX, 1024, 1024, cx.nblk, cx.bid); EpiZT E{p.ZTC, 256}; mm::gemm_phase(GEMM_LDS(lds), 1024, S, E, cx.tid); }
}
DI void ph_f2_mmB(const Ctx& cx, const Params& p, float* lds, bool with_ctx, const void* xin_lat, const void* xin_ctx, bf16_t* xo_lat, const float* modl) {
    { mm::BatchSched S; S.init(p.A2, p.ZT, (size_t)1024 * 4096 * 2, 16, 2048, 1024, 4096, cx.nblk, cx.bid); mm::EpiResidB E{xin_lat, xin_ctx, xo_lat, p.cs, modl, 1, 0}; mm::gemm_phase(GEMM_LDS(lds), 4096, S, E, cx.tid); }
    if (with_ctx) { mm::BatchSched S; S.init(p.A2c, p.ZTC, (size_t)1024 * 512 * 2, 16, 256, 1024, 512, cx.nblk, cx.bid); mm::EpiResidB E{xin_lat, xin_ctx, xo_lat, p.cs, modl, -1, 0}; mm::gemm_phase(GEMM_LDS(lds), 512, S, E, cx.tid); }
}
DI void ph_f2_mm(const Ctx& cx, const Params& p, float* lds, bool with_ctx, const float* xin_lat, const float* xin_ctx, const float* modl) {
    { mm::BatchSched S; S.init(p.A2, p.ZT, (size_t)1024 * 4096 * 2, 16, 2048, 1024, 4096, cx.nblk, cx.bid); mm::EpiResid E{xin_lat, xin_ctx, p.out, p.ctxs, modl, 1}; mm::gemm_phase(GEMM_LDS(lds), 4096, S, E, cx.tid); }
    if (with_ctx) { mm::BatchSched S; S.init(p.A2c, p.ZTC, (size_t)1024 * 512 * 2, 16, 256, 1024, 512, cx.nblk, cx.bid); mm::EpiResid E{xin_lat, xin_ctx, p.out, p.ctxs, modl, -1}; mm::gemm_phase(GEMM_LDS(lds), 512, S, E, cx.tid); }
}
struct MoeSched {
    static constexpr bool GATHER = true, TABLE = true;
    const char* A; const char* Bt; const int* slot; const float* slotw; const int* tab; int lda, K, G, c, down;
    DI void tab_dma(const mm::Unit& u, LAS unsigned char* dst, int tid) const {
        const int Me = __builtin_amdgcn_readfirstlane(tab[32 + u.e]); const int r = tid & 255; int idx = u.m * 256 + r; idx = idx < Me ? idx : 0;
        const size_t off = (u.e < 16) ? (size_t)u.e * NT + idx : 0;
        const unsigned* src = (tid < 256) ? (const unsigned*)(slot + off) : (const unsigned*)(slotw + off);
        __builtin_amdgcn_global_load_lds(src, (LAS unsigned*)(dst + (tid >> 6) * 256), 4, 0, 0);
    }
    DI size_t hstep_a() const { return 0; }
    DI unsigned boff(int Rb, int C, int Kk) const { return (unsigned)(Rb * Kk + C) * 2u; }
    DI size_t hstep_b(int Kk) const { return (size_t)mm::HALF * Kk * 2; }
    DI bool next(int i, mm::Unit& u) const {
        const int L = i * G + c; const int total = __builtin_amdgcn_readfirstlane(tab[17]);
        if (L >= total * 4) return false;
        const int rtg = L >> 2; int e = 0;
        for (int q = 1; q < 17; ++q) e += (__builtin_amdgcn_readfirstlane(tab[q]) <= rtg) ? 1 : 0;
        u.e = e; u.m = rtg - __builtin_amdgcn_readfirstlane(tab[e]); u.pm = u.m; u.pn = L & 3;
        u.A = A; u.B = Bt + ((size_t)e * 1024 + (size_t)u.pn * 256) * K * 2; return true;
    }
    DI unsigned rowoff(const mm::Unit& u, int Me, int idx, int C) const {
        int row;
        if (u.e < 16) { const int s = (idx < Me) ? slot[(size_t)u.e * NT + idx] : 0; row = down ? ((s & 1) * NT + (s >> 1)) : (s >> 1); }
        else row = down ? (2 * NT + idx) : idx;
        return (unsigned)(row * lda + C) * 2u;
    }
    DI unsigned rowoff_s(const mm::Unit& u, int s, int r, int C) const { int row; if (u.e < 16) row = down ? ((s & 1) * NT + (s >> 1)) : (s >> 1); else row = down ? (2 * NT + u.m * 256 + r) : (u.m * 256 + r); return (unsigned)(row * lda + C) * 2u; }
    DI void aoff_lds(const mm::Unit& u, const LAS int* et, int R0, int C0, int R1, int C1, unsigned (&o)[2][2]) const {
        o[0][0] = rowoff_s(u, et[R0], R0, C0); o[0][1] = rowoff_s(u, et[R1], R1, C1); o[1][0] = rowoff_s(u, et[128 + R0], 128 + R0, C0); o[1][1] = rowoff_s(u, et[128 + R1], 128 + R1, C1);
    }
    DI void aoff(const mm::Unit& u, int R0, int C0, int R1, int C1, unsigned (&o)[2][2]) const {
        const int Me = __builtin_amdgcn_readfirstlane(tab[32 + u.e]), base = u.m * 256;
        o[0][0] = rowoff(u, Me, base + R0, C0); o[0][1] = rowoff(u, Me, base + R1, C1);
        o[1][0] = rowoff(u, Me, base + 128 + R0, C0); o[1][1] = rowoff(u, Me, base + 128 + R1, C1);
    }
};
DI void moe_table(const Ctx& cx, const Params& p, int* tab, int layer, int nrows) {
    if (cx.tid == 0) { int acc = 0;
        for (int e = 0; e < 17; ++e) { const int M = (e < 16) ? p.cnt[(layer * 16 + e) * 64] : nrows; tab[e] = acc; tab[32 + e] = M; acc += (M + 255) >> 8; }
        tab[17] = acc; }
    __syncthreads();
}
DI void lds_read8(const LAS int* base, int r0, int (&o)[8]) {
    const unsigned a = (unsigned)(size_t)(base + r0);
    asm volatile("ds_read_b32 %0, %8\n\tds_read_b32 %1, %8 offset:64\n\tds_read_b32 %2, %8 offset:128\n\tds_read_b32 %3, %8 offset:192\n\t"
                 "ds_read_b32 %4, %8 offset:512\n\tds_read_b32 %5, %8 offset:576\n\tds_read_b32 %6, %8 offset:640\n\tds_read_b32 %7, %8 offset:704\n\ts_waitcnt lgkmcnt(0)"
                 : "=&v"(o[0]), "=&v"(o[1]), "=&v"(o[2]), "=&v"(o[3]), "=&v"(o[4]), "=&v"(o[5]), "=&v"(o[6]), "=&v"(o[7]) : "v"(a) : "memory");
}
struct EpiSwiglu {
    static constexpr bool PERM = true;
    bf16_t* ACT; const int* slot; const int* tab; const LAS int* etab;
    DI void operator()(const mm::f32x4 (&acc)[2][2][4][2], const mm::Unit& u, int wr, int wc, int fr, int fq) const {
        const int Me = __builtin_amdgcn_readfirstlane(tab[32 + u.e]); const int col = u.pn * 128 + wc * 32 + 8 * fq; const LAS int* et = etab + u.tb * 512;
        int sl8[8]; lds_read8(et, wr * 64 + fr, sl8);
#pragma unroll
        for (int ai = 0; ai < 2; ++ai)
#pragma unroll
            for (int m = 0; m < 4; ++m) {
                const int idx = u.m * 256 + ai * 128 + wr * 64 + m * 16 + fr;
                if (idx < Me) {
                    int drow; if (u.e < 16) { const int s = sl8[ai * 4 + m]; drow = (s & 1) * NT + (s >> 1); } else drow = 2 * NT + idx;
                    float o[8];
#pragma unroll
                    for (int n = 0; n < 2; ++n)
#pragma unroll
                        for (int c = 0; c < 4; ++c) { const float g = acc[ai][0][m][n][c], uu = acc[ai][1][m][n][c]; o[n * 4 + c] = g * __builtin_amdgcn_rcpf(1.f + __expf(-g)) * uu; }
                    mm::u32x4 w; w.x = mm::cvt_pk_bf16(o[0], o[1]); w.y = mm::cvt_pk_bf16(o[2], o[3]); w.z = mm::cvt_pk_bf16(o[4], o[5]); w.w = mm::cvt_pk_bf16(o[6], o[7]);
                    *(mm::u32x4*)(ACT + (size_t)drow * 512 + col) = w;
                }
            }
    }
};
struct EpiDown {
    static constexpr bool PERM = true;
    bf16_t* Y; const int* slot; const float* tokw; const int* tab; const LAS int* etab;
    DI void operator()(const mm::f32x4 (&acc)[2][2][4][2], const mm::Unit& u, int wr, int wc, int fr, int fq) const {
        const int Me = __builtin_amdgcn_readfirstlane(tab[32 + u.e]); const int col = u.pn * 256 + wc * 32 + 8 * fq; const LAS int* et = etab + u.tb * 512;
        int sl8[8], sw8[8]; lds_read8(et, wr * 64 + fr, sl8); lds_read8(et + 256, wr * 64 + fr, sw8);
#pragma unroll
        for (int ai = 0; ai < 2; ++ai)
#pragma unroll
            for (int m = 0; m < 4; ++m) {
                const int idx = u.m * 256 + ai * 128 + wr * 64 + m * 16 + fr;
                if (idx < Me) {
                    int drow; float w = 1.f;
                    if (u.e < 16) { const int s = sl8[ai * 4 + m]; drow = (s & 1) * NT + (s >> 1); w = __int_as_float(sw8[ai * 4 + m]); } else drow = 2 * NT + idx;
#pragma unroll
                    for (int bj = 0; bj < 2; ++bj) { const mm::f32x4 v0 = acc[ai][bj][m][0] * w, v1 = acc[ai][bj][m][1] * w;
                        mm::u32x4 o; o.x = mm::cvt_pk_bf16(v0[0], v0[1]); o.y = mm::cvt_pk_bf16(v0[2], v0[3]); o.z = mm::cvt_pk_bf16(v1[0], v1[1]); o.w = mm::cvt_pk_bf16(v1[2], v1[3]);
                        *(mm::u32x4*)(Y + (size_t)drow * 1024 + col + bj * 128) = o; }
                }
            }
    }
};
DI void ph_moe_up_mm(const Ctx& cx, const Params& p, float* lds, int layer, int nrows) {
    int* tab = (int*)(lds + 32768); moe_table(cx, p, tab, layer, nrows);
    MoeSched S{(const char*)p.H, (const char*)p.WguT, p.slot, p.slotw, tab, 1024, 1024, cx.nblk, cx.bid, 0};
    EpiSwiglu E{p.ACT, p.slot, tab, (const LAS int*)((LAS float*)lds + 32768 + 256)};
    mm::gemm_phase(GEMM_LDS(lds), 1024, S, E, cx.tid);
}
DI void ph_moe_down_mm(const Ctx& cx, const Params& p, float* lds, int layer, int nrows) {
    int* tab = (int*)(lds + 32768); moe_table(cx, p, tab, layer, nrows);
    MoeSched S{(const char*)p.ACT, (const char*)p.WdT, p.slot, p.slotw, tab, 512, 512, cx.nblk, cx.bid, 1};
    EpiDown E{p.Y, p.slot, p.tokw, tab, (const LAS int*)((LAS float*)lds + 32768 + 256)};
    mm::gemm_phase(GEMM_LDS(lds), 512, S, E, cx.tid);
}

namespace att {
typedef short bf16x8 __attribute__((ext_vector_type(8)));
typedef float f32x16 __attribute__((ext_vector_type(16)));
typedef unsigned u32x4 __attribute__((ext_vector_type(4)));
typedef unsigned u32x2 __attribute__((ext_vector_type(2)));
typedef __bf16 bf16x2_t __attribute__((ext_vector_type(2)));
typedef float f32x2_t __attribute__((ext_vector_type(2)));
constexpr int KP = 208, VP = 264, KT_BYTES = 128 * KP, VT_BYTES = 64 * VP, BUF = KT_BYTES + VT_BYTES;
DI unsigned pk(float a, float b) { f32x2_t f = {a, b}; bf16x2_t h = __builtin_convertvector(f, bf16x2_t); return __builtin_bit_cast(unsigned, h); }
DI float xhalf_max(float x) { const auto r = __builtin_amdgcn_permlane32_swap(__builtin_bit_cast(unsigned, x), __builtin_bit_cast(unsigned, x), false, false); return fmaxf(__builtin_bit_cast(float, r[0]), __builtin_bit_cast(float, r[1])); }
DI float xhalf_sum(float x) { const auto r = __builtin_amdgcn_permlane32_swap(__builtin_bit_cast(unsigned, x), __builtin_bit_cast(unsigned, x), false, false); return __builtin_bit_cast(float, r[0]) + __builtin_bit_cast(float, r[1]); }
#define ATT_MFMA(a, b, c) __builtin_amdgcn_mfma_f32_32x32x16_bf16((a), (b), (c), 0, 0, 0)
}
DI void ph_attn_mm(const Ctx& cx, const Params& p, float* ldsf, bool with_ctx) {
    using namespace att;
    LAS unsigned char* lds = (LAS unsigned char*)ldsf;
    const int tid = cx.tid, wid = __builtin_amdgcn_readfirstlane(tid >> 6), lane = tid & 63, r = lane & 31, hh = lane >> 5;
    const int nunits = 1024 + (with_ctx ? 128 : 0);
    int kg[3], kl[3], vg[2], vl[2];
#pragma unroll
    for (int i = 0; i < 3; ++i) { const int c = tid + 512 * i, row = c / 12, part = c % 12; kg[i] = row * 96 + part * 8; kl[i] = row * KP + part * 16; }
#pragma unroll
    for (int i = 0; i < 2; ++i) { const int c = tid + 512 * i, row = c >> 4, part = c & 15; vg[i] = row * 2304 + part * 8; vl[i] = KT_BYTES + row * VP + part * 16; }
    for (int u = cx.bid; u < nunits; u += cx.nblk) {
        int bh, qrow0, nkeys;
        if (u < 1024) { bh = u >> 3; qrow0 = (bh >> 3) * 2048 + (u & 7) * 256; nkeys = 2304; }
        else { bh = u - 1024; qrow0 = NLAT + (bh >> 3) * 256; nkeys = 256; }
        const int h = bh & 7;
        const bf16_t* Kb = p.Kf + (size_t)bh * 2304 * 96; const bf16_t* Vb = p.Vt + (size_t)bh * 64 * 2304;
        const bf16_t* qp = p.Qraw + (size_t)(qrow0 + wid * 32 + r) * 768 + h * 96 + 8 * hh;
        bf16x8 qf[6];
#pragma unroll
        for (int s = 0; s < 6; ++s) qf[s] = *(const bf16x8*)(qp + 16 * s);
        f32x16 ot0, ot1;
#pragma unroll
        for (int i = 0; i < 16; ++i) { ot0[i] = 0.f; ot1[i] = 0.f; }
        float mrun = -3.0e38f, lrun = 0.f;
        const int ntiles = nkeys >> 7;
        u32x4 kr[3], vr[2];
#pragma unroll
        for (int i = 0; i < 3; ++i) kr[i] = *(const u32x4*)(Kb + kg[i]);
#pragma unroll
        for (int i = 0; i < 2; ++i) vr[i] = *(const u32x4*)(Vb + vg[i]);
#pragma unroll
        for (int i = 0; i < 3; ++i) *(LAS u32x4*)(lds + kl[i]) = kr[i];
#pragma unroll
        for (int i = 0; i < 2; ++i) { *(LAS u32x2*)(lds + vl[i]) = (u32x2){vr[i].x, vr[i].y}; *(LAS u32x2*)(lds + vl[i] + 8) = (u32x2){vr[i].z, vr[i].w}; }
        __syncthreads();
        for (int it = 0; it < ntiles; ++it) {
            const int bo = (it & 1) * BUF, bn = ((it + 1) & 1) * BUF;
            const bool more = (it + 1 < ntiles);
            if (more) {
                const bf16_t* Kn = Kb + (size_t)(it + 1) * 128 * 96; const bf16_t* Vn = Vb + (it + 1) * 128;
#pragma unroll
                for (int i = 0; i < 3; ++i) kr[i] = *(const u32x4*)(Kn + kg[i]);
#pragma unroll
                for (int i = 0; i < 2; ++i) vr[i] = *(const u32x4*)(Vn + vg[i]);
            }
            f32x16 st[4];
#pragma unroll
            for (int kb = 0; kb < 4; ++kb) {
#pragma unroll
                for (int i = 0; i < 16; ++i) st[kb][i] = 0.f;
#pragma unroll
                for (int s = 0; s < 6; ++s) { const bf16x8 kf = *(const LAS bf16x8*)(lds + bo + (kb * 32 + r) * KP + 32 * s + 16 * hh); st[kb] = ATT_MFMA(kf, qf[s], st[kb]); }
            }
            float mq[4];
#pragma unroll
            for (int kb = 0; kb < 4; ++kb) { float a = fmaxf(st[kb][0], st[kb][1]), b = fmaxf(st[kb][2], st[kb][3]), c2 = fmaxf(st[kb][4], st[kb][5]), d = fmaxf(st[kb][6], st[kb][7]);
                a = fmaxf(a, fmaxf(st[kb][8], st[kb][9])); b = fmaxf(b, fmaxf(st[kb][10], st[kb][11])); c2 = fmaxf(c2, fmaxf(st[kb][12], st[kb][13])); d = fmaxf(d, fmaxf(st[kb][14], st[kb][15]));
                mq[kb] = fmaxf(fmaxf(a, b), fmaxf(c2, d)); }
            float mt = fmaxf(fmaxf(mq[0], mq[1]), fmaxf(mq[2], mq[3]));
            mt = xhalf_max(mt);
            const float mnew = fmaxf(mrun, mt), alpha = __builtin_amdgcn_exp2f(mrun - mnew);
            mrun = mnew;
            float pq[4];
#pragma unroll
            for (int kb = 0; kb < 4; ++kb) { float a = 0.f, b = 0.f;
#pragma unroll
                for (int i = 0; i < 16; i += 2) { st[kb][i] = __builtin_amdgcn_exp2f(st[kb][i] - mnew); st[kb][i + 1] = __builtin_amdgcn_exp2f(st[kb][i + 1] - mnew); a += st[kb][i]; b += st[kb][i + 1]; }
                pq[kb] = a + b; }
            lrun = lrun * alpha + ((pq[0] + pq[1]) + (pq[2] + pq[3]));
#pragma unroll
            for (int i = 0; i < 16; ++i) { ot0[i] *= alpha; ot1[i] *= alpha; }
#pragma unroll
            for (int kb = 0; kb < 4; ++kb)
#pragma unroll
                for (int s = 0; s < 2; ++s) {
                    u32x4 pw; pw.x = pk(st[kb][8 * s], st[kb][8 * s + 1]); pw.y = pk(st[kb][8 * s + 2], st[kb][8 * s + 3]); pw.z = pk(st[kb][8 * s + 4], st[kb][8 * s + 5]); pw.w = pk(st[kb][8 * s + 6], st[kb][8 * s + 7]);
                    const bf16x8 pb = __builtin_bit_cast(bf16x8, pw);
                    const int col = (kb * 32 + 16 * s + 4 * hh) * 2;
                    const u32x2 a0 = *(const LAS u32x2*)(lds + bo + KT_BYTES + r * VP + col), a1 = *(const LAS u32x2*)(lds + bo + KT_BYTES + r * VP + col + 16);
                    const u32x2 b0 = *(const LAS u32x2*)(lds + bo + KT_BYTES + (32 + r) * VP + col), b1 = *(const LAS u32x2*)(lds + bo + KT_BYTES + (32 + r) * VP + col + 16);
                    const u32x4 va = {a0.x, a0.y, a1.x, a1.y}, vb = {b0.x, b0.y, b1.x, b1.y};
                    ot0 = ATT_MFMA(__builtin_bit_cast(bf16x8, va), pb, ot0);
                    ot1 = ATT_MFMA(__builtin_bit_cast(bf16x8, vb), pb, ot1);
                }
            if (more) {
#pragma unroll
                for (int i = 0; i < 3; ++i) *(LAS u32x4*)(lds + bn + kl[i]) = kr[i];
#pragma unroll
                for (int i = 0; i < 2; ++i) { *(LAS u32x2*)(lds + bn + vl[i]) = (u32x2){vr[i].x, vr[i].y}; *(LAS u32x2*)(lds + bn + vl[i] + 8) = (u32x2){vr[i].z, vr[i].w}; }
            }
            __syncthreads();
        }
        const float il = 1.f / xhalf_sum(lrun);
        bf16_t* op = p.H + (size_t)(qrow0 + wid * 32 + r) * 1024 + 512 + h * 64 + 4 * hh;
#pragma unroll
        for (int g = 0; g < 4; ++g) {
            u32x2 w0 = {pk(ot0[4 * g] * il, ot0[4 * g + 1] * il), pk(ot0[4 * g + 2] * il, ot0[4 * g + 3] * il)};
            u32x2 w1 = {pk(ot1[4 * g] * il, ot1[4 * g + 1] * il), pk(ot1[4 * g + 2] * il, ot1[4 * g + 3] * il)};
            *(u32x2*)(op + 8 * g) = w0; *(u32x2*)(op + 32 + 8 * g) = w1;
        }
    }
}

DI void ph_attn_mm_stag(const Ctx& cx, const Params& p, float* ldsf, bool with_ctx) {
    using namespace att;
    LAS unsigned char* lds = (LAS unsigned char*)ldsf;
    const int tid = cx.tid, wid = __builtin_amdgcn_readfirstlane(tid >> 6), lane = tid & 63, r = lane & 31, hh = lane >> 5, G = wid >> 2;
    const int nunits = 1024 + (with_ctx ? 128 : 0);
    int kg[3], kl[3], vg[2], vl[2];
#pragma unroll
    for (int i = 0; i < 3; ++i) { const int c = tid + 512 * i, row = c / 12, part = c % 12; kg[i] = row * 96 + part * 8; kl[i] = row * KP + part * 16; }
#pragma unroll
    for (int i = 0; i < 2; ++i) { const int c = tid + 512 * i, row = c >> 4, part = c & 15; vg[i] = row * 2304 + part * 8; vl[i] = KT_BYTES + row * VP + part * 16; }
    for (int u = cx.bid; u < nunits; u += cx.nblk) {
        int bh, qrow0, nkeys;
        if (u < 1024) { bh = u >> 3; qrow0 = (bh >> 3) * 2048 + (u & 7) * 256; nkeys = 2304; }
        else { bh = u - 1024; qrow0 = NLAT + (bh >> 3) * 256; nkeys = 256; }
        const int h = bh & 7;
        const bf16_t* Kb = p.Kf + (size_t)bh * 2304 * 96; const bf16_t* Vb = p.Vt + (size_t)bh * 64 * 2304;
        const bf16_t* qp = p.Qraw + (size_t)(qrow0 + wid * 32 + r) * 768 + h * 96 + 8 * hh;
        bf16x8 qf[6];
#pragma unroll
        for (int s = 0; s < 6; ++s) qf[s] = *(const bf16x8*)(qp + 16 * s);
        f32x16 ot0, ot1;
#pragma unroll
        for (int i = 0; i < 16; ++i) { ot0[i] = 0.f; ot1[i] = 0.f; }
        float mrun = -3.0e38f, lrun = 0.f;
        const int ntiles = nkeys >> 7;
        u32x4 kr[3], vr[2];
#define ATT_LOAD(t) do { const bf16_t* Kn = Kb + (size_t)(t) * 128 * 96; const bf16_t* Vn = Vb + (t) * 128; \
            _Pragma("unroll") for (int i = 0; i < 3; ++i) kr[i] = *(const u32x4*)(Kn + kg[i]); _Pragma("unroll") for (int i = 0; i < 2; ++i) vr[i] = *(const u32x4*)(Vn + vg[i]); } while (0)
#define ATT_WRITE(bufo) do { _Pragma("unroll") for (int i = 0; i < 3; ++i) *(LAS u32x4*)(lds + (bufo) + kl[i]) = kr[i]; \
            _Pragma("unroll") for (int i = 0; i < 2; ++i) { *(LAS u32x2*)(lds + (bufo) + vl[i]) = (u32x2){vr[i].x, vr[i].y}; *(LAS u32x2*)(lds + (bufo) + vl[i] + 8) = (u32x2){vr[i].z, vr[i].w}; } } while (0)
        ATT_LOAD(0); ATT_WRITE(0);
        ATT_LOAD(1); ATT_WRITE(BUF);
        __syncthreads();
        f32x16 st[4];
        for (int ph = 0; ph <= 2 * ntiles; ++ph) {
            if (ph & 1) {
                const int tw = (ph + 1) >> 1;
                if (tw >= 2 && tw < ntiles) ATT_WRITE((tw & 1) * BUF);
                if (tw + 1 < ntiles) ATT_LOAD(tw + 1);
            }
            const int e = ph - G;
            if (e >= 0 && e < 2 * ntiles) {
                const int bo = ((e >> 1) & 1) * BUF;
                if ((e & 1) == 0) {
#pragma unroll
                    for (int kb = 0; kb < 4; ++kb) {
#pragma unroll
                        for (int i = 0; i < 16; ++i) st[kb][i] = 0.f;
#pragma unroll
                        for (int s = 0; s < 6; ++s) { const bf16x8 kf = *(const LAS bf16x8*)(lds + bo + (kb * 32 + r) * KP + 32 * s + 16 * hh); st[kb] = ATT_MFMA(kf, qf[s], st[kb]); }
                    }
                    float mq[4];
#pragma unroll
                    for (int kb = 0; kb < 4; ++kb) { float a = fmaxf(st[kb][0], st[kb][1]), b = fmaxf(st[kb][2], st[kb][3]), c2 = fmaxf(st[kb][4], st[kb][5]), d = fmaxf(st[kb][6], st[kb][7]);
                        a = fmaxf(a, fmaxf(st[kb][8], st[kb][9])); b = fmaxf(b, fmaxf(st[kb][10], st[kb][11])); c2 = fmaxf(c2, fmaxf(st[kb][12], st[kb][13])); d = fmaxf(d, fmaxf(st[kb][14], st[kb][15]));
                        mq[kb] = fmaxf(fmaxf(a, b), fmaxf(c2, d)); }
                    float mt = fmaxf(fmaxf(mq[0], mq[1]), fmaxf(mq[2], mq[3]));
                    mt = xhalf_max(mt);
                    const float mnew = fmaxf(mrun, mt), alpha = __builtin_amdgcn_exp2f(mrun - mnew);
                    mrun = mnew;
                    float pq[4];
#pragma unroll
                    for (int kb = 0; kb < 4; ++kb) { float a = 0.f, b = 0.f;
#pragma unroll
                        for (int i = 0; i < 16; i += 2) { st[kb][i] = __builtin_amdgcn_exp2f(st[kb][i] - mnew); st[kb][i + 1] = __builtin_amdgcn_exp2f(st[kb][i + 1] - mnew); a += st[kb][i]; b += st[kb][i + 1]; }
                        pq[kb] = a + b; }
                    lrun = lrun * alpha + ((pq[0] + pq[1]) + (pq[2] + pq[3]));
#pragma unroll
                    for (int i = 0; i < 16; ++i) { ot0[i] *= alpha; ot1[i] *= alpha; }
                } else {
#pragma unroll
                    for (int kb = 0; kb < 4; ++kb)
#pragma unroll
                        for (int s = 0; s < 2; ++s) {
                            u32x4 pw; pw.x = pk(st[kb][8 * s], st[kb][8 * s + 1]); pw.y = pk(st[kb][8 * s + 2], st[kb][8 * s + 3]); pw.z = pk(st[kb][8 * s + 4], st[kb][8 * s + 5]); pw.w = pk(st[kb][8 * s + 6], st[kb][8 * s + 7]);
                            const bf16x8 pb = __builtin_bit_cast(bf16x8, pw);
                            const int col = (kb * 32 + 16 * s + 4 * hh) * 2;
                            const u32x2 a0 = *(const LAS u32x2*)(lds + bo + KT_BYTES + r * VP + col), a1 = *(const LAS u32x2*)(lds + bo + KT_BYTES + r * VP + col + 16);
                            const u32x2 b0 = *(const LAS u32x2*)(lds + bo + KT_BYTES + (32 + r) * VP + col), b1 = *(const LAS u32x2*)(lds + bo + KT_BYTES + (32 + r) * VP + col + 16);
                            const u32x4 va = {a0.x, a0.y, a1.x, a1.y}, vb = {b0.x, b0.y, b1.x, b1.y};
                            ot0 = ATT_MFMA(__builtin_bit_cast(bf16x8, va), pb, ot0);
                            ot1 = ATT_MFMA(__builtin_bit_cast(bf16x8, vb), pb, ot1);
                        }
                }
            }
            __syncthreads();
        }
#undef ATT_LOAD
#undef ATT_WRITE
        const float il = 1.f / xhalf_sum(lrun);
        bf16_t* op = p.H + (size_t)(qrow0 + wid * 32 + r) * 1024 + 512 + h * 64 + 4 * hh;
#pragma unroll
        for (int g = 0; g < 4; ++g) {
            u32x2 w0 = {pk(ot0[4 * g] * il, ot0[4 * g + 1] * il), pk(ot0[4 * g + 2] * il, ot0[4 * g + 3] * il)};
            u32x2 w1 = {pk(ot1[4 * g] * il, ot1[4 * g + 1] * il), pk(ot1[4 * g + 2] * il, ot1[4 * g + 3] * il)};
            *(u32x2*)(op + 8 * g) = w0; *(u32x2*)(op + 32 + 8 * g) = w1;
        }
    }
}

namespace scan {
typedef float f32x2 __attribute__((ext_vector_type(2)));
constexpr int REC = 400, CH = 32, BUFF = CH * REC, YOFF = 2 * BUFF;
DI float dppf(float v, int ctrl_sel) {
    const int x = __builtin_bit_cast(int, v);
    int r;
    if (ctrl_sel == 0) r = __builtin_amdgcn_update_dpp(0, x, 0xB1, 0xf, 0xf, true);
    else if (ctrl_sel == 1) r = __builtin_amdgcn_update_dpp(0, x, 0x4E, 0xf, 0xf, true);
    else r = __builtin_amdgcn_update_dpp(0, x, 0x141, 0xf, 0xf, true);
    return __builtin_bit_cast(float, r);
}
DI float red8(float v) { v += dppf(v, 0); v += dppf(v, 1); v += dppf(v, 2); return v; }
}
template <int ABL>
DI void ph_scan_opt(const Ctx& cx, const Params& p, float* lds, int j) {
    using namespace scan;
    const int tid = cx.tid, wid = __builtin_amdgcn_readfirstlane(tid >> 6), lane = tid & 63;
    for (int item = cx.bid; item < 256; item += cx.nblk) {
        const int b = item >> 4, h = (item >> 1) & 7, dir = item & 1;
        bf16_t* yout = dir ? p.YB : p.YF;
        if (wid >= 4) {
            const int pw = wid - 4, hc = h * 64 + lane;
            const float kkc = p.a_k_k[j * 512 + hc], kac = p.a_k_a[j * 512 + hc];
            const float mur = p.a_mu[j * ACOLS + hc], muk = p.a_mu[j * ACOLS + 512 + hc], muv = p.a_mu[j * ACOLS + 1024 + hc];
            LAS float* L = (LAS float*)lds;
            bf16_t raw[8][11];
#define SCAN_ROW(stepv, row_, t_, T_) const bool cp_ = (stepv) < 256; const int tt_ = cp_ ? (stepv) : (stepv) - 256, T_ = cp_ ? 256 : 2048, t_ = dir ? (T_ - 1 - tt_) : tt_; const int row_ = cp_ ? NLAT + b * 256 + t_ : b * 2048 + t_
#define SCAN_LOAD(cc) do { _Pragma("unroll") for (int it = 0; it < 8; ++it) { const int step = (cc) * CH + pw + 4 * it; SCAN_ROW(step, row, t, T); \
                const int rp_ = (t > 0) ? row - 1 : row, rn_ = (t < T - 1) ? row + 1 : row; \
                const bf16_t* pc = p.P + (size_t)row * PLD + hc; const bf16_t* pp = p.P + (size_t)rp_ * PLD + hc; const bf16_t* pn = p.P + (size_t)rn_ * PLD + hc; \
                raw[it][0] = pc[0]; raw[it][1] = pp[0]; raw[it][2] = pn[0]; raw[it][3] = pc[512]; raw[it][4] = pp[512]; raw[it][5] = pn[512]; raw[it][6] = pc[1024]; raw[it][7] = pp[1024]; raw[it][8] = pn[1024]; \
                raw[it][9] = p.WAG[(size_t)row * WLD + dir * 512 + hc]; raw[it][10] = p.WAG[(size_t)row * WLD + 1024 + dir * 512 + hc]; } } while (0)
            if (ABL != 1) SCAN_LOAD(0);
            for (int c = 0; c <= 73; ++c) {
                if (c >= 2 && ABL == 0) {
                    const LAS float* yb = L + YOFF + ((c - 2) & 1) * (CH * 64);
#pragma unroll
                    for (int it = 0; it < 8; ++it) {
                        const int sl = pw + 4 * it, step = (c - 2) * CH + sl; SCAN_ROW(step, row, t, T);
                        yout[(size_t)row * 512 + hc] = f2bf(yb[sl * 64 + lane]);
                    }
                }
                if (c < 72 && ABL != 1) {
                    LAS float* buf = L + (c & 1) * BUFF;
#pragma unroll
                    for (int it = 0; it < 8; ++it) {
                        const int sl = pw + 4 * it, step = c * CH + sl; SCAN_ROW(step, row, t, T); (void)row;
                        const float mp = (t > 0) ? 0.5f : 0.f, mn = (t < T - 1) ? 0.5f : 0.f;
                        const float rc = bf2f(raw[it][0]), kc_ = bf2f(raw[it][3]), vc = bf2f(raw[it][6]);
                        const float R = rc + mur * (mp * bf2f(raw[it][1]) + mn * bf2f(raw[it][2]) - rc);
                        const float K = kc_ + muk * (mp * bf2f(raw[it][4]) + mn * bf2f(raw[it][5]) - kc_);
                        const float V = vc + muv * (mp * bf2f(raw[it][7]) + mn * bf2f(raw[it][8]) - vc);
                        const float w = 1.f - bf2f(raw[it][9]), a = bf2f(raw[it][10]);
                        const float kkv = K * kkc, ssq = wave_sum(kkv * kkv), kk = kkv * rsqrtf(ssq + 1e-12f);
                        const float kd = K * (1.f + (a - 1.f) * kac), bd = kk * a;
                        const float br = wave_sum(bd * R), kr = wave_sum(kd * R);
                        LAS float* rec = buf + sl * REC;
                        rec[lane] = w; rec[64 + lane] = -kk; rec[128 + lane] = bd; rec[192 + lane] = kd; rec[256 + lane] = w * R; rec[320 + lane] = V;
                        if (lane == 0) { rec[384] = br; rec[385] = kr; }
                    }
                    if (c + 1 < 72) SCAN_LOAD(c + 1);
                }
                __syncthreads();
            }
#undef SCAN_LOAD
#undef SCAN_ROW
        } else {
            const int ct = tid, rp = ct >> 3, k8 = ct & 7;
            float S0[8], S1[8];
#pragma unroll
            for (int q = 0; q < 8; ++q) { S0[q] = 0.f; S1[q] = 0.f; }
            __syncthreads();
            for (int c = 0; c < 72; ++c) {
                const LAS float* buf = (const LAS float*)lds + (c & 1) * BUFF; LAS float* yb = (LAS float*)lds + YOFF + (c & 1) * (CH * 64);
                mm::f32x4 cw0, cw1, cn0, cn1, cb0, cb1, cd0, cd1, cr0, cr1; scan::f32x2 cvv, csc;
#define SCAN_LD(recp, W0, W1, N0, N1, B0, B1, D0, D1, R0_, R1_, VV, SC) do { const LAS float* r_ = (recp); \
                    W0 = *(const LAS mm::f32x4*)(r_ + k8 * 8); W1 = *(const LAS mm::f32x4*)(r_ + k8 * 8 + 4); N0 = *(const LAS mm::f32x4*)(r_ + 64 + k8 * 8); N1 = *(const LAS mm::f32x4*)(r_ + 64 + k8 * 8 + 4); \
                    B0 = *(const LAS mm::f32x4*)(r_ + 128 + k8 * 8); B1 = *(const LAS mm::f32x4*)(r_ + 128 + k8 * 8 + 4); D0 = *(const LAS mm::f32x4*)(r_ + 192 + k8 * 8); D1 = *(const LAS mm::f32x4*)(r_ + 192 + k8 * 8 + 4); \
                    R0_ = *(const LAS mm::f32x4*)(r_ + 256 + k8 * 8); R1_ = *(const LAS mm::f32x4*)(r_ + 256 + k8 * 8 + 4); VV = *(const LAS scan::f32x2*)(r_ + 320 + 2 * rp); SC = *(const LAS scan::f32x2*)(r_ + 384); } while (0)
                SCAN_LD(buf, cw0, cw1, cn0, cn1, cb0, cb1, cd0, cd1, cr0, cr1, cvv, csc);
#pragma unroll 2
                for (int sl = 0; sl < (ABL == 2 ? 0 : CH); ++sl) {
                    mm::f32x4 nw0, nw1, nn0, nn1, nb0, nb1, nd0, nd1, nr0, nr1; scan::f32x2 nvv, nsc;
                    SCAN_LD(buf + (sl + 1 < CH ? sl + 1 : sl) * REC, nw0, nw1, nn0, nn1, nb0, nb1, nd0, nd1, nr0, nr1, nvv, nsc);
                    const float wv[8] = {cw0[0], cw0[1], cw0[2], cw0[3], cw1[0], cw1[1], cw1[2], cw1[3]}, nv[8] = {cn0[0], cn0[1], cn0[2], cn0[3], cn1[0], cn1[1], cn1[2], cn1[3]};
                    const float bv[8] = {cb0[0], cb0[1], cb0[2], cb0[3], cb1[0], cb1[1], cb1[2], cb1[3]}, dv[8] = {cd0[0], cd0[1], cd0[2], cd0[3], cd1[0], cd1[1], cd1[2], cd1[3]};
                    const float rv[8] = {cr0[0], cr0[1], cr0[2], cr0[3], cr1[0], cr1[1], cr1[2], cr1[3]};
                    float sa0 = 0.f, sa1 = 0.f, y0 = 0.f, y1 = 0.f;
#pragma unroll
                    for (int q = 0; q < 8; ++q) { sa0 += S0[q] * nv[q]; sa1 += S1[q] * nv[q]; y0 += S0[q] * rv[q]; y1 += S1[q] * rv[q]; }
                    sa0 = red8(sa0); sa1 = red8(sa1); y0 = red8(y0); y1 = red8(y1);
                    y0 += sa0 * csc[0] + cvv[0] * csc[1]; y1 += sa1 * csc[0] + cvv[1] * csc[1];
#pragma unroll
                    for (int q = 0; q < 8; ++q) { S0[q] = S0[q] * wv[q] + sa0 * bv[q] + cvv[0] * dv[q]; S1[q] = S1[q] * wv[q] + sa1 * bv[q] + cvv[1] * dv[q]; }
                    if (k8 == 0) *(LAS scan::f32x2*)(yb + sl * 64 + 2 * rp) = (scan::f32x2){y0, y1};
                    cw0 = nw0; cw1 = nw1; cn0 = nn0; cn1 = nn1; cb0 = nb0; cb1 = nb1; cd0 = nd0; cd1 = nd1; cr0 = nr0; cr1 = nr1; cvv = nvv; csc = nsc;
                }
#undef SCAN_LD
                __syncthreads();
            }
            __syncthreads();
        }
    }
}

namespace sc2 {
typedef short bf16x8 __attribute__((ext_vector_type(8)));
typedef float f32x4 __attribute__((ext_vector_type(4)));
typedef unsigned u32x4 __attribute__((ext_vector_type(4)));
typedef unsigned u32x2 __attribute__((ext_vector_type(2)));
constexpr int NP = 6;
constexpr int O_AH = 0, O_RH = 2048, O_BK = 4096, O_VM = 8192, O_GC = 10240, O_AAB = 10496, O_AAK = 11520, O_ARK = 12032, O_BH = 13056, O_KH = 15104, SLOT = 17152;
constexpr int O_S0 = NP * SLOT, O_RHS = O_S0 + 8192, O_ZU = O_RHS + 4096, O_FLAG = O_ZU + 2048, TOTAL = O_FLAG + 256;
#define SC_MFMA(a, b, c) __builtin_amdgcn_mfma_f32_16x16x32_bf16((a), (b), (c), 0, 0, 0)
DI unsigned pk2(float a, float b) { return att::pk(a, b); }
DI int ldv(volatile LAS int* p) { return *p; }
}
template <int ABL>
DI void ph_scan_chunk(const Ctx& cx, const Params& p, float* ldsg, int j) {
    using namespace sc2;
    static_assert(TOTAL <= 128 * 1024, "scan LDS map");
    LAS unsigned char* L = (LAS unsigned char*)ldsg;
    volatile LAS int* ready = (volatile LAS int*)(L + O_FLAG); volatile LAS int* done = ready + 8;
    const int tid = cx.tid, wid = __builtin_amdgcn_readfirstlane(tid >> 6), lane = tid & 63, lq = lane >> 4, lr = lane & 15;
    constexpr int NCH = 144;
    for (int item = cx.bid; item < 256; item += cx.nblk) {
        const int b = item >> 4, h = (item >> 1) & 7, dir = item & 1;
        bf16_t* yout = dir ? p.YB : p.YF;
        __syncthreads();
        if (tid < 32) ready[tid] = 0;
        __syncthreads();
#define SC_ROW(stepv, row_, t_, T_) const bool cp_ = (stepv) < 256; const int tt_ = cp_ ? (stepv) : (stepv) - 256, T_ = cp_ ? 256 : 2048, t_ = dir ? (T_ - 1 - tt_) : tt_; const int row_ = cp_ ? NLAT + b * 256 + t_ : b * 2048 + t_
        if (wid < 2) {
            __builtin_amdgcn_s_setprio(3);
            const int g = wid, vb0 = 2 * g;
            f32x4 S[4][2];
#pragma unroll
            for (int kb = 0; kb < 4; ++kb)
#pragma unroll
                for (int vb = 0; vb < 2; ++vb) S[kb][vb] = (f32x4){0.f, 0.f, 0.f, 0.f};
            for (int c = 0; c < NCH; ++c) {
                const int sl = c % NP; LAS unsigned char* SB = L + sl * SLOT;
                { unsigned spins = 0; while (ldv(ready + sl) != c + 1) { __builtin_amdgcn_s_sleep(1); if (++spins > (1u << 22)) break; } }
                asm volatile("" ::: "memory");
                if (ABL == 2) { if (lane == 0) done[g * 8 + sl] = c + 1; continue; }
                f32x4 cA[4][4];
#pragma unroll
                for (int j = 0; j <= 3; ++j)
#pragma unroll
                    for (int q = (j + 1) / 4; q < 4; ++q) cA[j][q - (j + 1) / 4] = *(const LAS f32x4*)(SB + O_AAB + j * 64 + q * 16);
#pragma unroll
                for (int kb = 0; kb < 4; ++kb)
#pragma unroll
                    for (int vq = 0; vq < 2; ++vq) { const f32x4 x = S[kb][vq]; *(LAS u32x2*)(L + O_S0 + (16 * (vb0 + vq) + lr) * 128 + (16 * kb + 4 * lq) * 2) = (u32x2){pk2(x[0], x[1]), pk2(x[2], x[3])}; }
                {
                    bf16x8 ah[2], ak, sf[2][2], vmf[2];
#pragma unroll
                    for (int ks = 0; ks < 2; ++ks) ah[ks] = *(const LAS bf16x8*)(SB + O_AH + lr * 128 + ks * 64 + lq * 16);
                    { u32x4 z = {0u, 0u, 0u, 0u}; if (lq < 2) z = *(const LAS u32x4*)(SB + O_AAK + lr * 32 + lq * 16); ak = __builtin_bit_cast(bf16x8, z); }
#pragma unroll
                    for (int vq = 0; vq < 2; ++vq) { const int vb = vb0 + vq;
#pragma unroll
                        for (int ks = 0; ks < 2; ++ks) sf[vq][ks] = *(const LAS bf16x8*)(L + O_S0 + (16 * vb + lr) * 128 + ks * 64 + lq * 16);
                        u32x4 z = {0u, 0u, 0u, 0u}; if (lq < 2) z = *(const LAS u32x4*)(SB + O_VM + (16 * vb + lr) * 32 + lq * 16); vmf[vq] = __builtin_bit_cast(bf16x8, z);
                    }
                    f32x4 acc[2];
#pragma unroll
                    for (int vq = 0; vq < 2; ++vq) { acc[vq] = (f32x4){0.f, 0.f, 0.f, 0.f}; acc[vq] = SC_MFMA(sf[vq][0], ah[0], acc[vq]); acc[vq] = SC_MFMA(sf[vq][1], ah[1], acc[vq]); acc[vq] = SC_MFMA(vmf[vq], ak, acc[vq]); }
#pragma unroll
                    for (int vq = 0; vq < 2; ++vq)
#pragma unroll
                        for (int q = 0; q < 4; ++q) *(LAS float*)(L + O_RHS + ((16 * (vb0 + vq) + 4 * lq + q) * 16 + lr) * 4) = acc[vq][q];
                }
                float u[16];
                const int vl = 32 * g + (lane & 31);
                { const LAS f32x4* rp = (const LAS f32x4*)(L + O_RHS + vl * 64);
#pragma unroll
                  for (int q = 0; q < 4; ++q) { const f32x4 x = rp[q]; u[4 * q] = x[0]; u[4 * q + 1] = x[1]; u[4 * q + 2] = x[2]; u[4 * q + 3] = x[3]; } }
#define SC_COL(j, CF) do { _Pragma("unroll") for (int q = ((j) + 1) / 4; q < 4; ++q) { const f32x4 cf = CF[q - ((j) + 1) / 4]; \
                        _Pragma("unroll") for (int e = 0; e < 4; ++e) { if (4 * q + e > (j)) u[4 * q + e] += cf[e] * u[j]; } } } while (0)
                f32x4 cB[4][3], cC[7][2];
#pragma unroll
                for (int j = 4; j <= 7; ++j)
#pragma unroll
                    for (int q = (j + 1) / 4; q < 4; ++q) cB[j - 4][q - (j + 1) / 4] = *(const LAS f32x4*)(SB + O_AAB + j * 64 + q * 16);
                asm volatile("" ::: "memory");
                if (ABL != 3) {
                SC_COL(0, cA[0]); SC_COL(1, cA[1]); SC_COL(2, cA[2]); SC_COL(3, cA[3]);
                }
                asm volatile("" ::: "memory");
#pragma unroll
                for (int j = 8; j <= 14; ++j)
#pragma unroll
                    for (int q = (j + 1) / 4; q < 4; ++q) cC[j - 8][q - (j + 1) / 4] = *(const LAS f32x4*)(SB + O_AAB + j * 64 + q * 16);
                asm volatile("" ::: "memory");
                if (ABL != 3) {
                SC_COL(4, cB[0]); SC_COL(5, cB[1]); SC_COL(6, cB[2]); SC_COL(7, cB[3]);
                SC_COL(8, cC[0]); SC_COL(9, cC[1]); SC_COL(10, cC[2]); SC_COL(11, cC[3]); SC_COL(12, cC[4]); SC_COL(13, cC[5]); SC_COL(14, cC[6]);
                }
#undef SC_COL
                { u32x4 w0 = {pk2(u[0], u[1]), pk2(u[2], u[3]), pk2(u[4], u[5]), pk2(u[6], u[7])}, w1 = {pk2(u[8], u[9]), pk2(u[10], u[11]), pk2(u[12], u[13]), pk2(u[14], u[15])};
                  if (lane < 32) { *(LAS u32x4*)(L + O_ZU + vl * 32) = w0; *(LAS u32x4*)(L + O_ZU + vl * 32 + 16) = w1; } }
                {
                    bf16x8 zf[2], sf[2][2], bkf[4]; f32x4 gc[4];
#pragma unroll
                    for (int vq = 0; vq < 2; ++vq) { const int vb = vb0 + vq;
                        zf[vq] = (lq < 2) ? *(const LAS bf16x8*)(L + O_ZU + (16 * vb + lr) * 32 + lq * 16) : *(const LAS bf16x8*)(SB + O_VM + (16 * vb + lr) * 32 + (lq - 2) * 16);
#pragma unroll
                        for (int ks = 0; ks < 2; ++ks) sf[vq][ks] = *(const LAS bf16x8*)(L + O_S0 + (16 * vb + lr) * 128 + ks * 64 + lq * 16);
                    }
                    const bf16x8 rk = *(const LAS bf16x8*)(SB + O_ARK + lr * 64 + lq * 16);
                    const bf16x8 rh0 = *(const LAS bf16x8*)(SB + O_RH + lr * 128 + lq * 16), rh1 = *(const LAS bf16x8*)(SB + O_RH + lr * 128 + 64 + lq * 16);
#pragma unroll
                    for (int kb = 0; kb < 4; ++kb) { gc[kb] = *(const LAS f32x4*)(SB + O_GC + (16 * kb + 4 * lq) * 4); bkf[kb] = *(const LAS bf16x8*)(SB + O_BK + (16 * kb + lr) * 64 + lq * 16); }
                    const int step = c * 16 + lr; SC_ROW(step, row, tq, Tq); (void)tq; (void)Tq;
#pragma unroll
                    for (int vq = 0; vq < 2; ++vq) { f32x4 y = {0.f, 0.f, 0.f, 0.f};
                        y = SC_MFMA(sf[vq][0], rh0, y); y = SC_MFMA(sf[vq][1], rh1, y); y = SC_MFMA(zf[vq], rk, y);
                        if (ABL == 0) *(u32x2*)(yout + (size_t)row * 512 + h * 64 + 16 * (vb0 + vq) + 4 * lq) = (u32x2){pk2(y[0], y[1]), pk2(y[2], y[3])}; else asm volatile("" :: "v"(y[0]), "v"(y[1]), "v"(y[2]), "v"(y[3])); }
#pragma unroll
                    for (int kb = 0; kb < 4; ++kb)
#pragma unroll
                        for (int vq = 0; vq < 2; ++vq) S[kb][vq] = SC_MFMA(bkf[kb], zf[vq], S[kb][vq] * gc[kb]);
                }
                asm volatile("s_waitcnt lgkmcnt(0)" ::: "memory");
                if (lane == 0) done[g * 8 + sl] = c + 1;
            }
            __builtin_amdgcn_s_setprio(0);
        } else {
            const int pw = wid - 2, hc = h * 64 + lane; LAS unsigned char* SB = L + pw * SLOT;
            const float kkc = p.a_k_k[j * 512 + hc], kac = p.a_k_a[j * 512 + hc];
            const float mur = p.a_mu[j * ACOLS + hc], muk = p.a_mu[j * ACOLS + 512 + hc], muv = p.a_mu[j * ACOLS + 1024 + hc];
            for (int c = pw; c < NCH; c += NP) {
                if (ABL == 1 || ABL == 3 || ABL == 4) { if (c >= NP) { unsigned spins = 0; while (ldv(done + pw) != c - NP + 1 || ldv(done + 8 + pw) != c - NP + 1) { __builtin_amdgcn_s_sleep(2); if (++spins > (1u << 22)) break; } } if (lane == 0) ready[pw] = c + 1; continue; }
                bf16_t raw[16][11];
#define SC_LOAD(t) do { const int step = c * 16 + (t); SC_ROW(step, row, tq, Tq); \
                    const int rp_ = (tq > 0) ? row - 1 : row, rn_ = (tq < Tq - 1) ? row + 1 : row; \
                    const bf16_t* pc = p.P + (size_t)row * PLD + hc; const bf16_t* pp = p.P + (size_t)rp_ * PLD + hc; const bf16_t* pn = p.P + (size_t)rn_ * PLD + hc; \
                    raw[t][0] = pc[0]; raw[t][1] = pp[0]; raw[t][2] = pn[0]; raw[t][3] = pc[512]; raw[t][4] = pp[512]; raw[t][5] = pn[512]; raw[t][6] = pc[1024]; raw[t][7] = pp[1024]; raw[t][8] = pn[1024]; \
                    raw[t][9] = p.WAG[(size_t)row * WLD + dir * 512 + hc]; raw[t][10] = p.WAG[(size_t)row * WLD + 1024 + dir * 512 + hc]; } while (0)
#define SC_STEP(t) do { const int step = c * 16 + (t); SC_ROW(step, row, tq, Tq); (void)row; \
                    const float mp = (tq > 0) ? 0.5f : 0.f, mn = (tq < Tq - 1) ? 0.5f : 0.f; \
                    const float rc = bf2f(raw[t][0]), kc_ = bf2f(raw[t][3]), vc = bf2f(raw[t][6]); \
                    const float R = rc + mur * (mp * bf2f(raw[t][1]) + mn * bf2f(raw[t][2]) - rc); \
                    const float K = kc_ + muk * (mp * bf2f(raw[t][4]) + mn * bf2f(raw[t][5]) - kc_); \
                    const float Vv = vc + muv * (mp * bf2f(raw[t][7]) + mn * bf2f(raw[t][8]) - vc); \
                    const float w = 1.f - bf2f(raw[t][9]), a = bf2f(raw[t][10]); \
                    const float kkv = K * kkc, ssq = wave_sum(kkv * kkv), kk = kkv * rsqrtf(ssq + 1e-12f); \
                    const float kd = K * (1.f + (a - 1.f) * kac), bd = kk * a; \
                    const float gprev = g; g *= w; const float ig = __builtin_amdgcn_rcpf(g); \
                    *(LAS bf16_t*)(SB + O_AH + (t) * 128 + lane * 2) = f2bf(-kk * gprev); \
                    *(LAS bf16_t*)(SB + O_RH + (t) * 128 + lane * 2) = f2bf(R * g); \
                    *(LAS bf16_t*)(SB + O_BH + (t) * 128 + lane * 2) = f2bf(bd * ig); \
                    *(LAS bf16_t*)(SB + O_KH + (t) * 128 + lane * 2) = f2bf(kd * ig); \
                    *(LAS bf16_t*)(SB + O_VM + lane * 32 + (t) * 2) = f2bf(Vv); } while (0)
                SC_LOAD(0); SC_LOAD(1); SC_LOAD(2); SC_LOAD(3); SC_LOAD(4); SC_LOAD(5); SC_LOAD(6); SC_LOAD(7);
                if (c >= NP) { unsigned spins = 0; while (ldv(done + pw) != c - NP + 1 || ldv(done + 8 + pw) != c - NP + 1) { __builtin_amdgcn_s_sleep(2); if (++spins > (1u << 22)) break; } }
                asm volatile("" ::: "memory");
                float g = 1.f;
                SC_STEP(0); SC_STEP(1); SC_STEP(2); SC_STEP(3);
                asm volatile("" ::: "memory");
                SC_LOAD(8); SC_LOAD(9); SC_LOAD(10); SC_LOAD(11);
                asm volatile("" ::: "memory");
                SC_STEP(4); SC_STEP(5); SC_STEP(6); SC_STEP(7);
                asm volatile("" ::: "memory");
                SC_LOAD(12); SC_LOAD(13); SC_LOAD(14); SC_LOAD(15);
                asm volatile("" ::: "memory");
                SC_STEP(8); SC_STEP(9); SC_STEP(10); SC_STEP(11); SC_STEP(12); SC_STEP(13); SC_STEP(14); SC_STEP(15);
#undef SC_LOAD
#undef SC_STEP
#pragma unroll
                for (int q = 0; q < 2; ++q) {
                    float bq[8], kq[8];
#pragma unroll
                    for (int e = 0; e < 8; ++e) { bq[e] = bf2f(*(const LAS bf16_t*)(SB + O_BH + (8 * q + e) * 128 + lane * 2)) * g; kq[e] = bf2f(*(const LAS bf16_t*)(SB + O_KH + (8 * q + e) * 128 + lane * 2)) * g; }
                    u32x4 wb = {pk2(bq[0], bq[1]), pk2(bq[2], bq[3]), pk2(bq[4], bq[5]), pk2(bq[6], bq[7])}, wk = {pk2(kq[0], kq[1]), pk2(kq[2], kq[3]), pk2(kq[4], kq[5]), pk2(kq[6], kq[7])};
                    *(LAS u32x4*)(SB + O_BK + lane * 64 + q * 16) = wb; *(LAS u32x4*)(SB + O_BK + lane * 64 + 32 + q * 16) = wk;
                }
                *(LAS float*)(SB + O_GC + lane * 4) = g;
                f32x4 sab = {0.f, 0.f, 0.f, 0.f}, sak = sab, srb = sab, srk = sab;
#pragma unroll
                for (int ks = 0; ks < 2; ++ks) {
                    const bf16x8 fa = *(const LAS bf16x8*)(SB + O_AH + lr * 128 + ks * 64 + lq * 16), fr = *(const LAS bf16x8*)(SB + O_RH + lr * 128 + ks * 64 + lq * 16);
                    const bf16x8 fb = *(const LAS bf16x8*)(SB + O_BH + lr * 128 + ks * 64 + lq * 16), fk = *(const LAS bf16x8*)(SB + O_KH + lr * 128 + ks * 64 + lq * 16);
                    sab = SC_MFMA(fa, fb, sab); sak = SC_MFMA(fa, fk, sak); srb = SC_MFMA(fr, fb, srb); srk = SC_MFMA(fr, fk, srk);
                }
#pragma unroll
                for (int q = 0; q < 4; ++q) { const int t = 4 * lq + q; const bool lo = lr < t, le = lr <= t;
                    *(LAS bf16_t*)(SB + O_AAK + (t * 16 + lr) * 2) = f2bf(lo ? sak[q] : 0.f);
                    *(LAS bf16_t*)(SB + O_ARK + (t * 32 + lr) * 2) = f2bf(le ? srb[q] : 0.f);
                    *(LAS bf16_t*)(SB + O_ARK + (t * 32 + 16 + lr) * 2) = f2bf(le ? srk[q] : 0.f); }
                { f32x4 tq;
#pragma unroll
                  for (int q = 0; q < 4; ++q) tq[q] = (lr < 4 * lq + q) ? sab[q] : 0.f;
                  *(LAS f32x4*)(SB + O_AAB + (lr * 16 + 4 * lq) * 4) = tq; }
                asm volatile("s_waitcnt lgkmcnt(0)" ::: "memory");
                if (lane == 0) ready[pw] = c + 1;
            }
        }
#undef SC_ROW
        __syncthreads();
    }
}

DI void unpack8u(const uint4 u, float (&d)[8]) { d[0] = bflo(u.x); d[1] = bfhi(u.x); d[2] = bflo(u.y); d[3] = bfhi(u.y); d[4] = bflo(u.z); d[5] = bfhi(u.z); d[6] = bflo(u.w); d[7] = bfhi(u.w); }
DI uint4 pack8u(const float (&d)[8]) { uint4 u; u.x = att::pk(d[0], d[1]); u.y = att::pk(d[2], d[3]); u.z = att::pk(d[4], d[5]); u.w = att::pk(d[6], d[7]); return u; }
DI void shift8(const bf16_t* P, int row, int t, int T, int col0, const float (&mu)[8], float (&o)[8]) {
    float c[8], pv[8], nx[8];
    unpack8u(*(const uint4*)(P + (size_t)row * PLD + col0), c);
    if (t > 0) unpack8u(*(const uint4*)(P + (size_t)(row - 1) * PLD + col0), pv); else {
#pragma unroll
        for (int i = 0; i < 8; ++i) pv[i] = 0.f; }
    if (t < T - 1) unpack8u(*(const uint4*)(P + (size_t)(row + 1) * PLD + col0), nx); else {
#pragma unroll
        for (int i = 0; i < 8; ++i) nx[i] = 0.f; }
#pragma unroll
    for (int i = 0; i < 8; ++i) o[i] = c[i] + mu[i] * (0.5f * (pv[i] + nx[i]) - c[i]);
}
DI void ld8f(const float* p, float (&d)[8]) { const float4 a = *(const float4*)p, b = *(const float4*)(p + 4); d[0] = a.x; d[1] = a.y; d[2] = a.z; d[3] = a.w; d[4] = b.x; d[5] = b.y; d[6] = b.z; d[7] = b.w; }
DI void ph_post_opt(const Ctx& cx, const Params& p, int j, int nrows) {
    const int tid = cx.tid, wid = tid >> 6, lane = tid & 63, c0 = lane * 8;
    float mur[8], muk[8], muv[8], ka[8], rk[8], lw[8], lb[8];
    ld8f(p.a_mu + j * ACOLS + c0, mur); ld8f(p.a_mu + j * ACOLS + 512 + c0, muk); ld8f(p.a_mu + j * ACOLS + 1024 + c0, muv);
    ld8f(p.a_k_a + j * 512 + c0, ka); ld8f(p.a_r_k + j * 512 + c0, rk); ld8f(p.a_ln_w + j * 512 + c0, lw); ld8f(p.a_ln_b + j * 512 + c0, lb);
    for (int row = cx.bid * 8 + wid; row < nrows; row += cx.nblk * 8) {
        const bool lat = row < NLAT; const int t = lat ? (row & 2047) : ((row - NLAT) & 255); const int T = lat ? 2048 : 256;
        float yf[8], yb[8], R[8], K[8], V[8], af[8], ab[8], g[8];
        unpack8u(*(const uint4*)(p.YF + (size_t)row * 512 + c0), yf); unpack8u(*(const uint4*)(p.YB + (size_t)row * 512 + c0), yb);
        shift8(p.P, row, t, T, c0, mur, R); shift8(p.P, row, t, T, 512 + c0, muk, K); shift8(p.P, row, t, T, 1024 + c0, muv, V);
        unpack8u(*(const uint4*)(p.WAG + (size_t)row * WLD + 1024 + c0), af); unpack8u(*(const uint4*)(p.WAG + (size_t)row * WLD + 1536 + c0), ab); unpack8u(*(const uint4*)(p.WAG + (size_t)row * WLD + 2048 + c0), g);
        float sum = 0.f, sb = 0.f;
#pragma unroll
        for (int i = 0; i < 8; ++i) { yf[i] += yb[i]; sum += yf[i]; sb += R[i] * rk[i] * K[i] * (2.f + (af[i] + ab[i] - 2.f) * ka[i]); }
        sum = scan::red8(sum); sb = scan::red8(sb);
        const float mean = sum * (1.f / 64.f); float var = 0.f;
#pragma unroll
        for (int i = 0; i < 8; ++i) { const float d = yf[i] - mean; var += d * d; }
        var = scan::red8(var);
        const float rstd = rsqrtf(var * (1.f / 64.f) + 64e-5f);
        float o[8];
#pragma unroll
        for (int i = 0; i < 8; ++i) o[i] = ((yf[i] - mean) * rstd * lw[i] + lb[i] + sb * V[i]) * g[i];
        *(uint4*)(p.H + (size_t)row * 1024 + c0) = pack8u(o);
    }
}
DI void fin_vec(float (&x)[8], int c, int t, bool lat, const float (&gn)[8], float scl, bf16_t* dst) {
    float ss = 0.f;
#pragma unroll
    for (int i = 0; i < 8; ++i) ss += x[i] * x[i];
    ss += dpp_f<0xB1>(ss); ss += dpp_f<0x4E>(ss); ss += dpp_f<0x141>(ss); ss += dpp_f<0x140>(ss);
    const float r = rsqrtf(ss * (1.f / 96.f) + 1e-6f);
#pragma unroll
    for (int i = 0; i < 8; ++i) x[i] = x[i] * r * gn[i];
    float y[8];
#pragma unroll
    for (int i = 0; i < 8; ++i) { const float up = dpp_f<0x102>(x[i]), dn = dpp_f<0x112>(x[i]); y[i] = (c < 10) ? up : dn; }
    if (lat && c >= 8 && c < 12) {
        const float invf[8] = {1.f, 0.316227766016838f, 0.1f, 0.0316227766016838f, 0.01f, 0.00316227766016838f, 0.001f, 0.000316227766016838f};
        const float pos = (c & 1) ? (float)(t & 63) : (float)(t >> 6);
#pragma unroll
        for (int i = 0; i < 8; ++i) { const float ang = pos * invf[i], cs = __cosf(ang), sn = __sinf(ang); x[i] = (c < 10) ? (x[i] * cs - y[i] * sn) : (x[i] * cs + y[i] * sn); }
    }
    if (c < 12) {
#pragma unroll
        for (int i = 0; i < 8; ++i) x[i] *= scl;
        *(uint4*)(dst + c * 8) = pack8u(x);
    }
}
DI void ph_finalize_opt(const Ctx& cx, const Params& p, float* ldsf, int j, int mq) {
    const int tid = cx.tid, wid = tid >> 6, lane = tid & 63, c = lane & 15, hq = lane >> 4;
    float qg[8], kg[8]; ld8f(p.b_q_gain + j * 96 + (c < 12 ? c : 0) * 8, qg); ld8f(p.b_k_gain + j * 96 + (c < 12 ? c : 0) * 8, kg);
    for (int row0 = (cx.bid * 8 + wid) * 2; row0 < NT; row0 += cx.nblk * 16) {
        float xq[4][8], xk[4][8];
#pragma unroll
        for (int u = 0; u < 4; ++u) {
            const int row = row0 + (u >> 1), h = (u & 1) * 4 + hq;
#pragma unroll
            for (int i = 0; i < 8; ++i) { xq[u][i] = 0.f; xk[u][i] = 0.f; }
            if (row < mq && c < 12) unpack8u(*(const uint4*)(p.Qraw + (size_t)row * 768 + h * 96 + c * 8), xq[u]);
            if (c < 8) unpack8u(*(const uint4*)(p.KVraw + (size_t)row * 1024 + h * 128 + c * 8), xk[u]);
            else if (c < 12) unpack8u(*(const uint4*)(p.P + (size_t)row * PLD + ACOLS + 384 + (c - 8) * 8), xk[u]);
        }
#pragma unroll
        for (int u = 0; u < 4; ++u) {
            const int row = row0 + (u >> 1), h = (u & 1) * 4 + hq;
            const bool lat = row < NLAT; const int b = lat ? (row >> 11) : ((row - NLAT) >> 8); const int t = lat ? (row & 2047) : ((row - NLAT) & 255);
            if (row < mq) fin_vec(xq[u], c, t, lat, qg, 0.10206207261596577f * 1.4426950408889634f, p.Qraw + (size_t)row * 768 + h * 96);
            const int key = lat ? 256 + t : t;
            fin_vec(xk[u], c, t, lat, kg, 1.f, p.Kf + ((size_t)(b * 8 + h) * 2304 + key) * 96);
        }
    }
    bf16_t* T = (bf16_t*)ldsf; constexpr int TP = 520;
    for (int tile = cx.bid; tile < NT / 64; tile += cx.nblk) {
        const int row0 = tile * 64; const bool lat = row0 < NLAT; const int b = lat ? (row0 >> 11) : ((row0 - NLAT) >> 8); const int t0 = lat ? (row0 & 2047) : ((row0 - NLAT) & 255);
        const int key0 = lat ? 256 + t0 : t0;
        __syncthreads();
#pragma unroll
        for (int i = 0; i < 8; ++i) { const int ch = tid + 512 * i, kr = ch >> 6, cc = ch & 63, h = cc >> 3, part = cc & 7;
            *(uint4*)(T + kr * TP + h * 64 + part * 8) = *(const uint4*)(p.KVraw + (size_t)(row0 + kr) * 1024 + h * 128 + 64 + part * 8); }
        __syncthreads();
#pragma unroll
        for (int i = 0; i < 8; ++i) { const int ch = tid + 512 * i, hd = ch >> 3, kc = ch & 7;
            float v[8];
#pragma unroll
            for (int q = 0; q < 8; ++q) v[q] = bf2f(T[(kc * 8 + q) * TP + hd]);
            uint4 o; o.x = (unsigned)T[(kc * 8 + 0) * TP + hd] | ((unsigned)T[(kc * 8 + 1) * TP + hd] << 16); o.y = (unsigned)T[(kc * 8 + 2) * TP + hd] | ((unsigned)T[(kc * 8 + 3) * TP + hd] << 16);
            o.z = (unsigned)T[(kc * 8 + 4) * TP + hd] | ((unsigned)T[(kc * 8 + 5) * TP + hd] << 16); o.w = (unsigned)T[(kc * 8 + 6) * TP + hd] | ((unsigned)T[(kc * 8 + 7) * TP + hd] << 16);
            (void)v;
            *(uint4*)(p.Vt + ((size_t)(b * 8 + (hd >> 6)) * 64 + (hd & 63)) * 2304 + key0 + kc * 8) = o; }
    }
    __syncthreads();
}
DI void ph_mod_opt(const Ctx& cx, const Params& p, float* lds) {
    const int tid = cx.tid, wid = tid >> 6, lane = tid & 63;
    float* part = lds + 17 * 1024;
    for (int i = tid; i < 17 * 1024; i += NTHR) { const int jj = i >> 10, k = i & 1023; const float v = (jj < 16) ? p.c[jj * 1024 + k] : p.c_ctx[k]; lds[i] = siluf(v); }
    __syncthreads();
    for (int item = cx.bid; item < 4 * 96; item += cx.nblk) {
        const int l = item / 96, n = (item % 96) * 64 + lane;
        const float* w = p.mod_w + (size_t)l * 1024 * 6144 + n;
        float acc[17];
#pragma unroll
        for (int jj = 0; jj < 17; ++jj) acc[jj] = 0.f;
        for (int k0 = wid * 128; k0 < wid * 128 + 128; k0 += 16) {
            float wv[16];
#pragma unroll
            for (int q = 0; q < 16; ++q) wv[q] = w[(size_t)(k0 + q) * 6144];
#pragma unroll
            for (int q = 0; q < 16; ++q)
#pragma unroll
                for (int jj = 0; jj < 17; ++jj) acc[jj] += lds[jj * 1024 + k0 + q] * wv[q];
        }
#pragma unroll
        for (int jj = 0; jj < 17; ++jj) part[(wid * 17 + jj) * 64 + lane] = acc[jj];
        __syncthreads();
        for (int o = tid; o < 17 * 64; o += NTHR) { const int jj = o >> 6, ln = o & 63; float sacc = p.mod_b[l * 6144 + (item % 96) * 64 + ln];
#pragma unroll
            for (int q = 0; q < 8; ++q) sacc += part[(q * 17 + jj) * 64 + ln];
            p.mod[((size_t)l * 17 + jj) * 6144 + (item % 96) * 64 + ln] = sacc; }
        __syncthreads();
    }
}

DI void ph_norm2_router(const Ctx& cx, const Params& p, float* ldsg, int nrows, const float* gain, const float* modl, int layer, const bf16_t* xb_lat) {
    LAS float* lds = (LAS float*)ldsg;
    const int tid = cx.tid, wid = tid >> 6, lane = tid & 63;
    LAS float* rw = lds; LAS float* red = lds + 16 * 1024 + wid * (32 * 64 + 64); LAS float* my = red + 32 * 64;
    LAS int* lcnt = (LAS int*)(lds + 16 * 1024 + 8 * (32 * 64 + 64)); LAS int* lbase = lcnt + 16; LAS int* rlist = lcnt + 32;
    for (int i = tid; i < 16 * 1024; i += NTHR) { const int e = i >> 10, col = i & 1023; rw[i] = p.router_w[col * 16 + e]; }
    if (tid < 16) lcnt[tid] = 0;
    __syncthreads();
    int nlist = 0;
    uint2 raw[2][4];
#define N2_LOAD(pi) do { _Pragma("unroll") for (int r = 0; r < 2; ++r) { const int row = 2 * (pi) + r; const bf16_t* xr = (row < NLAT) ? xb_lat + (size_t)row * 1024 : p.cs + (size_t)(row - NLAT) * 1024; \
            _Pragma("unroll") for (int i = 0; i < 4; ++i) raw[r][i] = *(const uint2*)(xr + i * 256 + lane * 4); } } while (0)
    { const int p0 = cx.bid * 8 + wid; if (xb_lat && p0 < (nrows >> 1)) N2_LOAD(p0); }
    for (int pidx = cx.bid * 8 + wid; pidx < (nrows >> 1); pidx += cx.nblk * 8) {
        float4 xv[2][4];
        if (xb_lat) {
#pragma unroll
            for (int r = 0; r < 2; ++r)
#pragma unroll
                for (int i = 0; i < 4; ++i) xv[r][i] = make_float4(bflo(raw[r][i].x), bfhi(raw[r][i].x), bflo(raw[r][i].y), bfhi(raw[r][i].y));
            const int pn = pidx + cx.nblk * 8; if (pn < (nrows >> 1)) N2_LOAD(pn);
        } else {
#pragma unroll
            for (int r = 0; r < 2; ++r) { const int row = 2 * pidx + r; const float* xr = (row < NLAT) ? p.out + (size_t)row * 1024 : p.ctxs + (size_t)(row - NLAT) * 1024;
#pragma unroll
                for (int i = 0; i < 4; ++i) xv[r][i] = *(const float4*)(xr + i * 256 + lane * 4); }
        }
        const int row0 = 2 * pidx; const int jj = (row0 < NLAT) ? (row0 >> 11) : 16;
        const float* shp = modl + (size_t)jj * 6144 + 3 * 1024; const float* scp = modl + (size_t)jj * 6144 + 4 * 1024;
        float4 hv[2][4];
#pragma unroll
        for (int r = 0; r < 2; ++r) {
            float ss = 0.f;
#pragma unroll
            for (int i = 0; i < 4; ++i) ss += xv[r][i].x * xv[r][i].x + xv[r][i].y * xv[r][i].y + xv[r][i].z * xv[r][i].z + xv[r][i].w * xv[r][i].w;
            ss = wave_sum(ss);
            const float rstd = rsqrtf(ss * (1.f / 1024.f) + 1e-6f);
#pragma unroll
            for (int i = 0; i < 4; ++i) {
                const int col = i * 256 + lane * 4;
                const float4 g = *(const float4*)(gain + col), sh = *(const float4*)(shp + col), sc = *(const float4*)(scp + col);
                hv[r][i].x = xv[r][i].x * rstd * g.x * (1.f + sc.x) + sh.x; hv[r][i].y = xv[r][i].y * rstd * g.y * (1.f + sc.y) + sh.y;
                hv[r][i].z = xv[r][i].z * rstd * g.z * (1.f + sc.z) + sh.z; hv[r][i].w = xv[r][i].w * rstd * g.w * (1.f + sc.w) + sh.w;
                uint2 u; u.x = att::pk(hv[r][i].x, hv[r][i].y); u.y = att::pk(hv[r][i].z, hv[r][i].w);
                *(uint2*)(p.H + (size_t)(row0 + r) * 1024 + col) = u;
            }
        }
#pragma unroll
        for (int e = 0; e < 16; ++e) {
            float a0 = 0.f, a1 = 0.f;
#pragma unroll
            for (int i = 0; i < 4; ++i) { const mm::f32x4 w = *(const LAS mm::f32x4*)(rw + e * 1024 + i * 256 + lane * 4);
                a0 += hv[0][i].x * w[0] + hv[0][i].y * w[1] + hv[0][i].z * w[2] + hv[0][i].w * w[3]; a1 += hv[1][i].x * w[0] + hv[1][i].y * w[1] + hv[1][i].z * w[2] + hv[1][i].w * w[3]; }
            red[e * 64 + lane] = a0; red[(16 + e) * 64 + lane] = a1;
        }
        __builtin_amdgcn_wave_barrier();
        {
            const int r = lane >> 5, e = (lane >> 1) & 15, half = lane & 1; const LAS float* src = red + (r * 16 + e) * 64 + half * 32;
            float sacc = 0.f;
#pragma unroll
            for (int q = 0; q < 8; ++q) { const mm::f32x4 v = *(const LAS mm::f32x4*)(src + q * 4); sacc += (v[0] + v[1]) + (v[2] + v[3]); }
            sacc += dpp_f<0xB1>(sacc);
            const float sg = 1.f / (1.f + __expf(-sacc));
            if (half == 0) { my[r * 32 + e] = sg; my[r * 32 + 16 + e] = sg + p.router_b[e]; }
        }
        __builtin_amdgcn_wave_barrier();
        if ((lane & 31) == 0) {
            const int r = lane >> 5; const LAS float* m = my + r * 32;
            float best = -3.0e38f; int be1 = 0, be2 = 1;
#pragma unroll
            for (int g = 0; g < 4; ++g) {
                const mm::f32x4 v = *(const LAS mm::f32x4*)(m + 16 + 4 * g);
                int i1 = 0; float m1 = v[0];
                if (v[1] > m1) { m1 = v[1]; i1 = 1; } if (v[2] > m1) { m1 = v[2]; i1 = 2; } if (v[3] > m1) { m1 = v[3]; i1 = 3; }
                int i2 = -1; float m2 = -3.0e38f;
                if (i1 != 0 && v[0] > m2) { m2 = v[0]; i2 = 0; } if (i1 != 1 && v[1] > m2) { m2 = v[1]; i2 = 1; }
                if (i1 != 2 && v[2] > m2) { m2 = v[2]; i2 = 2; } if (i1 != 3 && v[3] > m2) { m2 = v[3]; i2 = 3; }
                const float gs = m1 + m2;
                if (gs > best) { best = gs; be1 = 4 * g + i1; be2 = 4 * g + i2; }
            }
            const float bs1 = m[be1], bs2 = m[be2]; const float inv = 1.f / (bs1 + bs2);
            const int p1 = atomicAdd((int*)&lcnt[be1], 1), p2 = atomicAdd((int*)&lcnt[be2], 1);
            LAS int* ent = rlist + (wid * 24 + nlist * 2 + r) * 6;
            const int row = row0 + r;
            ent[0] = row; ent[1] = be1 | (be2 << 8); ent[2] = p1; ent[3] = p2; ent[4] = __float_as_int(bs1 * inv); ent[5] = __float_as_int(bs2 * inv);
        }
        ++nlist;
        __builtin_amdgcn_wave_barrier();
    }
#undef N2_LOAD
    __syncthreads();
    if (tid < 16) lbase[tid] = atomicAdd(p.cnt + (layer * 16 + tid) * 64, lcnt[tid]);
    __syncthreads();
    for (int k = lane; k < 2 * nlist; k += 64) {
        const LAS int* ent = rlist + (wid * 24 + k) * 6; const int row = ent[0], be1 = ent[1] & 255, be2 = ent[1] >> 8;
        const size_t s1 = (size_t)be1 * NT + lbase[be1] + ent[2], s2 = (size_t)be2 * NT + lbase[be2] + ent[3];
        p.slot[s1] = row * 2; p.slot[s2] = row * 2 + 1; p.slotw[s1] = __int_as_float(ent[4]); p.slotw[s2] = __int_as_float(ent[5]);
    }
    __syncthreads();
}

DI void ph_prepBLR_opt(const Ctx& cx, const Params& p, int j) {
    const int tid = cx.tid, wid = tid >> 6, lane = tid & 63;
    const float4 gq = *(const float4*)(p.b_q_norm + j * 256 + lane * 4); const float2 gk = *(const float2*)(p.b_kv_norm + j * 128 + lane * 2);
    constexpr int U = 8;
    for (int row0 = (cx.bid * 8 + wid) * U; row0 < NT; row0 += cx.nblk * 8 * U) {
        uint2 uq[U]; unsigned ukv[U];
#pragma unroll
        for (int u = 0; u < U; ++u) { const bf16_t* pr = p.P + (size_t)(row0 + u) * PLD + ACOLS; uq[u] = *(const uint2*)(pr + lane * 4); ukv[u] = *(const unsigned*)(pr + 256 + lane * 2); }
#pragma unroll
        for (int u = 0; u < U; ++u) {
            const float q0 = bflo(uq[u].x), q1 = bfhi(uq[u].x), q2 = bflo(uq[u].y), q3 = bfhi(uq[u].y), k0 = bflo(ukv[u]), k1 = bfhi(ukv[u]);
            const float sq = wave_sum(q0 * q0 + q1 * q1 + q2 * q2 + q3 * q3), sk = wave_sum(k0 * k0 + k1 * k1);
            const float rq = rsqrtf(sq * (1.f / 256.f) + 1e-6f), rk = rsqrtf(sk * (1.f / 128.f) + 1e-6f);
            uint2 o; o.x = att::pk(q0 * rq * gq.x, q1 * rq * gq.y); o.y = att::pk(q2 * rq * gq.z, q3 * rq * gq.w);
            bf16_t* qn = p.QN + (size_t)(row0 + u) * 512;
            *(uint2*)(qn + lane * 4) = o; *(unsigned*)(qn + 256 + lane * 2) = att::pk(k0 * rk * gk.x, k1 * rk * gk.y); *(unsigned*)(qn + 384 + lane * 2) = 0u;
        }
    }
    const int gtid = cx.bid * NTHR + tid, gsz = cx.nblk * NTHR;
    for (int idx = gtid; idx < NT * 48; idx += gsz) {
        const int row = idx / 48, cg = idx % 48, col0 = cg * 8;
        const bool lat = row < NLAT; const int t = lat ? (row & 2047) : ((row - NLAT) & 255); const int T = lat ? 2048 : 256;
        float mu[8]; ld8f(p.a_mu + j * ACOLS + 1536 + col0, mu);
        float v[8]; shift8(p.P, row, t, T, 1536 + col0, mu, v);
        if (cg < 16) {
#pragma unroll
            for (int i = 0; i < 8; ++i) { const float e = __expf(2.f * v[i]); v[i] = 1.f - 2.f * __builtin_amdgcn_rcpf(e + 1.f); }
        } else if (cg >= 32) {
#pragma unroll
            for (int i = 0; i < 8; ++i) v[i] = __builtin_amdgcn_rcpf(1.f + __expf(-v[i]));
        }
        *(uint4*)(p.LR + (size_t)row * 384 + col0) = pack8u(v);
    }
}

template <bool FINAL>
DI void ph_normc(const Ctx& cx, const Params& p, int nrows, const bf16_t* xin_lat, bf16_t* xout_lat, const float* gain, const float* modl, const float* modprev) {
    const int tid = cx.tid, wid = tid >> 6, lane = tid & 63;
    for (int row = cx.bid * 8 + wid; row < nrows; row += cx.nblk * 8) {
        const bool lat = row < NLAT; const int jj = lat ? (row >> 11) : 16; const size_t rb = lat ? (size_t)row : (size_t)(row - NLAT);
        const bf16_t* xr = (lat ? xin_lat : p.cs) + rb * 1024;
        const float* g2 = modprev + (size_t)jj * 6144 + 5 * 1024;
        float4 xv[4];
#pragma unroll
        for (int i = 0; i < 4; ++i) {
            const int col = i * 256 + lane * 4;
            const uint2 ux = *(const uint2*)(xr + col);
            float s0 = 0.f, s1 = 0.f, s2 = 0.f, s3 = 0.f;
#pragma unroll
            for (int sl = 0; sl < 3; ++sl) { const uint2 u = *(const uint2*)(p.Y + ((size_t)sl * NT + row) * 1024 + col); s0 += bflo(u.x); s1 += bfhi(u.x); s2 += bflo(u.y); s3 += bfhi(u.y); }
            const float4 gv = *(const float4*)(g2 + col);
            xv[i].x = bflo(ux.x) + gv.x * s0; xv[i].y = bfhi(ux.x) + gv.y * s1; xv[i].z = bflo(ux.y) + gv.z * s2; xv[i].w = bfhi(ux.y) + gv.w * s3;
            if (FINAL) *(float4*)(p.out + (size_t)row * 1024 + col) = xv[i];
            else { uint2 o; o.x = att_pk(xv[i].x, xv[i].y); o.y = att_pk(xv[i].z, xv[i].w); *(uint2*)((lat ? xout_lat : p.cs) + rb * 1024 + col) = o; }
        }
        if (!FINAL) {
            float ss = 0.f;
#pragma unroll
            for (int i = 0; i < 4; ++i) ss += xv[i].x * xv[i].x + xv[i].y * xv[i].y + xv[i].z * xv[i].z + xv[i].w * xv[i].w;
            ss = wave_sum(ss);
            const float rstd = rsqrtf(ss * (1.f / 1024.f) + 1e-6f);
            const float* shp = modl + (size_t)jj * 6144; const float* scp = modl + (size_t)jj * 6144 + 1024;
#pragma unroll
            for (int i = 0; i < 4; ++i) {
                const int col = i * 256 + lane * 4;
                const float4 g = *(const float4*)(gain + col), sh = *(const float4*)(shp + col), sc = *(const float4*)(scp + col);
                uint2 u; u.x = att_pk(xv[i].x * rstd * g.x * (1.f + sc.x) + sh.x, xv[i].y * rstd * g.y * (1.f + sc.y) + sh.y);
                u.y = att_pk(xv[i].z * rstd * g.z * (1.f + sc.z) + sh.z, xv[i].w * rstd * g.w * (1.f + sc.w) + sh.w);
                *(uint2*)(p.H + (size_t)row * 1024 + col) = u;
            }
        }
    }
}

struct F1Sched {
    static constexpr bool GATHER = false, TABLE = false;
    const char* A; const char* Hb; int T2, nN, G, c;
    DI size_t hstep_a() const { return (size_t)mm::HALF * 1024 * 2; }
    DI unsigned boff(int Rb, int C, int Kk) const { return (unsigned)(Rb * T2 * Kk + C) * 2u; }
    DI size_t hstep_b(int Kk) const { return (size_t)Kk * 2; }
    DI bool next(int i, mm::Unit& u) const {
        const int L = i * G + c; if (L >= 8 * nN) return false;
        u.pm = L & 7; u.pn = L >> 3; u.e = 0; u.m = 0;
        const int b = (T2 == 16) ? (u.pn >> 3) : u.pn, t20 = (T2 == 16) ? 2 * (u.pn & 7) : 0;
        u.A = A + (size_t)u.pm * 256 * 1024 * 2; u.B = Hb + ((size_t)b * (128 * T2) + t20) * 1024 * 2; return true;
    }
    DI void aoff(const mm::Unit&, int R0, int C0, int R1, int C1, unsigned (&o)[2][2]) const {
        o[0][0] = (unsigned)(R0 * 1024 + C0) * 2u; o[0][1] = (unsigned)(R1 * 1024 + C1) * 2u; o[1][0] = o[0][0]; o[1][1] = o[0][1];
    }
};
struct EpiZT3 {
    static constexpr bool PERM = true;
    bf16_t* Z; int T2;
    DI void operator()(const mm::f32x4 (&acc)[2][2][4][2], const mm::Unit& u, int wr, int wc, int fr, int fq) const {
        const int b = (T2 == 16) ? (u.pn >> 3) : u.pn, t20 = (T2 == 16) ? 2 * (u.pn & 7) : 0;
        const int m0 = u.pm * 256 + wr * 64 + fr, t1 = wc * 32 + 8 * fq;
#pragma unroll
        for (int ai = 0; ai < 2; ++ai)
#pragma unroll
            for (int m = 0; m < 4; ++m) { const int mr = m0 + ai * 128 + m * 16, part = mr >> 10, ch = mr & 1023;
#pragma unroll
                for (int bj = 0; bj < 2; ++bj) { const mm::f32x4 v0 = acc[ai][bj][m][0], v1 = acc[ai][bj][m][1];
                    mm::u32x4 w; w.x = att_pk(v0[0], v0[1]); w.y = att_pk(v0[2], v0[3]); w.z = att_pk(v1[0], v1[1]); w.w = att_pk(v1[2], v1[3]);
                    *(mm::u32x4*)(Z + ((size_t)(b * 1024 + ch) * T2 + t20 + bj) * 256 + part * 128 + t1) = w; } }
    }
};
DI void ph_f1b(const Ctx& cx, const Params& p, float* lds, int j, bool with_ctx) {
    { F1Sched S{(const char*)(p.A1 + (size_t)j * 2048 * 1024), (const char*)p.H, 16, NLAT / 256, cx.nblk, cx.bid}; EpiZT3 E{p.ZT, 16}; mm::gemm_phase(GEMM_LDS(lds), 1024, S, E, cx.tid); }
    if (with_ctx) { F1Sched S{(const char*)(p.A1 + (size_t)j * 2048 * 1024), (const char*)(p.H + (size_t)NLAT * 1024), 2, NCTX / 256, cx.nblk, cx.bid}; EpiZT3 E{p.ZTC, 2}; mm::gemm_phase(GEMM_LDS(lds), 1024, S, E, cx.tid); }
}
DI void ph_fa(const Ctx& cx, const Params& p, float* lds, bool with_ctx) {
    int Kr = 256; asm volatile("" : "+s"(Kr));
    { mm::BatchSched S; S.init(p.M1, p.ZT, (size_t)16384 * 256 * 2, 16, 256, 16384, Kr, cx.nblk, cx.bid); mm::EpiBf16Store E{p.YF1, 16384, (size_t)256 * 16384}; mm::gemm_phase(GEMM_LDS(lds), Kr, S, E, cx.tid); }
    if (with_ctx) { mm::BatchSched S; S.init(p.M1, p.ZTC, (size_t)2048 * 256 * 2, 16, 256, 2048, Kr, cx.nblk, cx.bid); mm::EpiBf16Store E{p.YF1c, 2048, (size_t)256 * 2048}; mm::gemm_phase(GEMM_LDS(lds), Kr, S, E, cx.tid); }
}
template <int T2>
DI void fb_items(const Ctx& cx, const Params& p, const LAS float* tw, const bf16_t* Y, const bf16_t* xin, bf16_t* xout, const float* modl, bool ctx, float scale) {
    constexpr int T = 128 * T2; constexpr size_t NB = (size_t)1024 * T2;
    const int gtid = cx.bid * NTHR + cx.tid, gsz = cx.nblk * NTHR;
    for (int idx = gtid; idx < 16 * 128 * 512; idx += gsz) {
        const int cp = idx & 511, f1 = (idx >> 9) & 127, b = idx >> 16;
        float yr[2][T2], yi[2][T2];
        { const bf16_t* pr = Y + ((size_t)b * 256 + f1) * NB + (size_t)(2 * cp) * T2; const bf16_t* pi = pr + (size_t)128 * NB;
          if constexpr (T2 == 2) { const uint2 ur = *(const uint2*)pr, ui = *(const uint2*)pi;
              yr[0][0] = bflo(ur.x); yr[0][1] = bfhi(ur.x); yr[1][0] = bflo(ur.y); yr[1][1] = bfhi(ur.y); yi[0][0] = bflo(ui.x); yi[0][1] = bfhi(ui.x); yi[1][0] = bflo(ui.y); yi[1][1] = bfhi(ui.y); }
          else {
#pragma unroll
          for (int q = 0; q < (2 * T2) / 8; ++q) { float d[8]; unpack8u(*(const uint4*)(pr + q * 8), d);
#pragma unroll
              for (int e = 0; e < 8; ++e) yr[(q * 8 + e) / T2][(q * 8 + e) % T2] = d[e];
              unpack8u(*(const uint4*)(pi + q * 8), d);
#pragma unroll
              for (int e = 0; e < 8; ++e) yi[(q * 8 + e) / T2][(q * 8 + e) % T2] = d[e]; } } }
        const int jj = ctx ? 16 : b; const float2 g1 = *(const float2*)(modl + (size_t)jj * 6144 + 2 * 1024 + 2 * cp);
        constexpr int FG = (T2 >= 4) ? 4 : T2;
#pragma unroll 1
        for (int fg = 0; fg < T2; fg += FG) {
            unsigned xv[FG];
#pragma unroll
            for (int q = 0; q < FG; ++q) xv[q] = *(const unsigned*)(xin + ((size_t)b * T + f1 + 128 * (fg + q)) * 1024 + 2 * cp);
#pragma unroll
            for (int q = 0; q < FG; ++q) {
                const int f = f1 + 128 * (fg + q); float a0 = 0.f, a1 = 0.f;
#pragma unroll
                for (int t2 = 0; t2 < T2; ++t2) { const int mi = ((t2 * f) & (T - 1)) * (2048 / T); const float cs = tw[2 * mi], sn = tw[2 * mi + 1];
                    a0 += cs * yr[0][t2] + sn * yi[0][t2]; a1 += cs * yr[1][t2] + sn * yi[1][t2]; }
                *(unsigned*)(xout + ((size_t)b * T + f) * 1024 + 2 * cp) = att_pk(bflo(xv[q]) + g1.x * scale * a0, bfhi(xv[q]) + g1.y * scale * a1);
            }
        }
    }
}
DI void fb_mfma(const Ctx& cx, const Params& p, const LAS float* tw, const bf16_t* Y, const bf16_t* xin, bf16_t* xout, const float* modl) {
    typedef short bf16x8 __attribute__((ext_vector_type(8)));
    constexpr size_t NB = (size_t)1024 * 16;
    const int tid = cx.tid, wid = tid >> 6, lane = tid & 63, lq = lane >> 4, lr = lane & 15;
    const int part = lq >> 1, t20 = 8 * (lq & 1);
    for (int item = cx.bid * 8 + wid; item < 16 * 128 * 32; item += cx.nblk * 8) {
        const int cb = item & 31, f1 = (item >> 5) & 127, b = item >> 12, c0 = cb * 32;
        const bf16_t* yb = Y + ((size_t)b * 256 + part * 128 + f1) * NB + t20;
        const int chA = c0 + 8 * (lr >> 2) + (lr & 3);
        const bf16x8 a0 = *(const bf16x8*)(yb + (size_t)chA * 16), a1 = *(const bf16x8*)(yb + (size_t)(chA + 4) * 16);
        const int f = f1 + 128 * lr;
        mm::u32x4 bw;
        { float tv[8];
#pragma unroll
          for (int jj = 0; jj < 8; ++jj) { const int mi = ((t20 + jj) * f) & 2047; tv[jj] = tw[2 * mi + part]; }
          bw.x = att_pk(tv[0], tv[1]); bw.y = att_pk(tv[2], tv[3]); bw.z = att_pk(tv[4], tv[5]); bw.w = att_pk(tv[6], tv[7]); }
        const bf16x8 bf = __builtin_bit_cast(bf16x8, bw);
        mm::f32x4 d0 = {0.f, 0.f, 0.f, 0.f}, d1 = d0;
        d0 = __builtin_amdgcn_mfma_f32_16x16x32_bf16(a0, bf, d0, 0, 0, 0);
        d1 = __builtin_amdgcn_mfma_f32_16x16x32_bf16(a1, bf, d1, 0, 0, 0);
        const float* g1 = modl + (size_t)b * 6144 + 2 * 1024 + c0 + 8 * lq;
        const mm::f32x4 g0 = *(const mm::f32x4*)g1, g4 = *(const mm::f32x4*)(g1 + 4);
        const size_t off = ((size_t)b * 2048 + f) * 1024 + c0 + 8 * lq;
        const mm::u32x4 xv = *(const mm::u32x4*)(xin + off);
        const float sc = 1.f / 512.f;
        mm::u32x4 o;
        o.x = att_pk(bflo(xv.x) + g0[0] * sc * d0[0], bfhi(xv.x) + g0[1] * sc * d0[1]); o.y = att_pk(bflo(xv.y) + g0[2] * sc * d0[2], bfhi(xv.y) + g0[3] * sc * d0[3]);
        o.z = att_pk(bflo(xv.z) + g4[0] * sc * d1[0], bfhi(xv.z) + g4[1] * sc * d1[1]); o.w = att_pk(bflo(xv.w) + g4[2] * sc * d1[2], bfhi(xv.w) + g4[3] * sc * d1[3]);
        *(mm::u32x4*)(xout + off) = o;
    }
}
DI void ph_fb(const Ctx& cx, const Params& p, float* ldsg, bool with_ctx, const bf16_t* xin_lat, bf16_t* xout_lat, const float* modl) {
    LAS float* tw = (LAS float*)ldsg;
    for (int i = cx.tid; i < 2048; i += NTHR) { const float a = (float)i * (1.f / 1024.f); tw[2 * i] = cospif(a); tw[2 * i + 1] = sinpif(a); }
    __syncthreads();
    fb_mfma(cx, p, tw, p.YF1, xin_lat, xout_lat, modl);
    if (with_ctx) fb_items<2>(cx, p, tw, p.YF1c, p.cs, p.cs, modl, true, 0.0055242717280199f);
    __syncthreads();
}

DI void ph_norm2_router_mfma(const Ctx& cx, const Params& p, float* ldsg, int nrows, const float* gain, const float* modl, int layer, const bf16_t* xb_lat) {
    LAS float* lds = (LAS float*)ldsg;
    const int tid = cx.tid, wid = tid >> 6, lane = tid & 63, lq = lane >> 4, lr = lane & 15;
    constexpr int HP = 1026;
    LAS float* wl = lds; LAS float* hb = lds + 16384; LAS float* red = hb + 16 * HP; LAS float* myall = red + 2048;
    LAS int* lcnt = (LAS int*)(myall + 512); LAS int* lbase = lcnt + 16; LAS int* rlist = lcnt + 32;
    for (int i = tid; i < 16384; i += NTHR) wl[i] = p.router_w[i];
    if (tid < 16) lcnt[tid] = 0;
    __syncthreads();
    int nlist = 0;
    for (int grp = cx.bid; grp < (nrows >> 4); grp += cx.nblk) {
        const int row0 = 16 * grp + 2 * wid; const int jj = (row0 < NLAT) ? (row0 >> 11) : 16;
        const float* shp = modl + (size_t)jj * 6144 + 3 * 1024; const float* scp = modl + (size_t)jj * 6144 + 4 * 1024;
        float4 xv[2][4];
#pragma unroll
        for (int r = 0; r < 2; ++r) { const int row = row0 + r; const bf16_t* xr = (row < NLAT) ? xb_lat + (size_t)row * 1024 : p.cs + (size_t)(row - NLAT) * 1024;
#pragma unroll
            for (int i = 0; i < 4; ++i) { const uint2 u = *(const uint2*)(xr + i * 256 + lane * 4); xv[r][i] = make_float4(bflo(u.x), bfhi(u.x), bflo(u.y), bfhi(u.y)); } }
#pragma unroll
        for (int r = 0; r < 2; ++r) {
            float ss = 0.f;
#pragma unroll
            for (int i = 0; i < 4; ++i) ss += xv[r][i].x * xv[r][i].x + xv[r][i].y * xv[r][i].y + xv[r][i].z * xv[r][i].z + xv[r][i].w * xv[r][i].w;
            ss = wave_sum(ss);
            const float rstd = rsqrtf(ss * (1.f / 1024.f) + 1e-6f);
#pragma unroll
            for (int i = 0; i < 4; ++i) {
                const int col = i * 256 + lane * 4;
                const float4 g = *(const float4*)(gain + col), sh = *(const float4*)(shp + col), sc = *(const float4*)(scp + col);
                const float h0 = xv[r][i].x * rstd * g.x * (1.f + sc.x) + sh.x, h1 = xv[r][i].y * rstd * g.y * (1.f + sc.y) + sh.y;
                const float h2 = xv[r][i].z * rstd * g.z * (1.f + sc.z) + sh.z, h3 = xv[r][i].w * rstd * g.w * (1.f + sc.w) + sh.w;
                uint2 u; u.x = att_pk(h0, h1); u.y = att_pk(h2, h3);
                *(uint2*)(p.H + (size_t)(row0 + r) * 1024 + col) = u;
                LAS float* hp = hb + (2 * wid + r) * HP + col;
                *(LAS scan::f32x2*)hp = (scan::f32x2){h0, h1}; *(LAS scan::f32x2*)(hp + 2) = (scan::f32x2){h2, h3};
            }
        }
        __syncthreads();
        {
            mm::f32x4 acc = {0.f, 0.f, 0.f, 0.f};
            const LAS float* ap = hb + lr * HP + 128 * wid + lq; const LAS float* bp = wl + (128 * wid + lq) * 16 + lr;
#pragma unroll 8
            for (int s = 0; s < 32; ++s) acc = __builtin_amdgcn_mfma_f32_16x16x4f32(ap[4 * s], bp[64 * s], acc, 0, 0, 0);
#pragma unroll
            for (int q = 0; q < 4; ++q) red[wid * 256 + (4 * lq + q) * 16 + lr] = acc[q];
        }
        __syncthreads();
        if (tid < 256) { const int row = tid >> 4, e = tid & 15; float sacc = 0.f;
#pragma unroll
            for (int w = 0; w < 8; ++w) sacc += red[w * 256 + row * 16 + e];
            const float sg = 1.f / (1.f + __expf(-sacc));
            myall[row * 32 + e] = sg; myall[row * 32 + 16 + e] = sg + p.router_b[e]; }
        __syncthreads();
        if ((lane & 31) == 0) {
            const int r = lane >> 5; const LAS float* m = myall + (2 * wid + r) * 32;
            float best = -3.0e38f; int be1 = 0, be2 = 1;
#pragma unroll
            for (int g = 0; g < 4; ++g) {
                const mm::f32x4 v = *(const LAS mm::f32x4*)(m + 16 + 4 * g);
                int i1 = 0; float m1 = v[0];
                if (v[1] > m1) { m1 = v[1]; i1 = 1; } if (v[2] > m1) { m1 = v[2]; i1 = 2; } if (v[3] > m1) { m1 = v[3]; i1 = 3; }
                int i2 = -1; float m2 = -3.0e38f;
                if (i1 != 0 && v[0] > m2) { m2 = v[0]; i2 = 0; } if (i1 != 1 && v[1] > m2) { m2 = v[1]; i2 = 1; }
                if (i1 != 2 && v[2] > m2) { m2 = v[2]; i2 = 2; } if (i1 != 3 && v[3] > m2) { m2 = v[3]; i2 = 3; }
                const float gs = m1 + m2;
                if (gs > best) { best = gs; be1 = 4 * g + i1; be2 = 4 * g + i2; }
            }
            const float bs1 = m[be1], bs2 = m[be2]; const float inv = 1.f / (bs1 + bs2);
            const int p1 = atomicAdd((int*)&lcnt[be1], 1), p2 = atomicAdd((int*)&lcnt[be2], 1);
            LAS int* ent = rlist + (wid * 24 + nlist * 2 + r) * 6;
            ent[0] = row0 + r; ent[1] = be1 | (be2 << 8); ent[2] = p1; ent[3] = p2; ent[4] = __float_as_int(bs1 * inv); ent[5] = __float_as_int(bs2 * inv);
        }
        ++nlist;
    }
    __syncthreads();
    if (tid < 16) lbase[tid] = atomicAdd(p.cnt + (layer * 16 + tid) * 64, lcnt[tid]);
    __syncthreads();
    for (int k = lane; k < 2 * nlist; k += 64) {
        const LAS int* ent = rlist + (wid * 24 + k) * 6; const int row = ent[0], be1 = ent[1] & 255, be2 = ent[1] >> 8;
        const size_t s1 = (size_t)be1 * NT + lbase[be1] + ent[2], s2 = (size_t)be2 * NT + lbase[be2] + ent[3];
        p.slot[s1] = row * 2; p.slot[s2] = row * 2 + 1; p.slotw[s1] = __int_as_float(ent[4]); p.slotw[s2] = __int_as_float(ent[5]);
    }
    __syncthreads();
}

template <int PH>
DI void run_phase(const Params& p, float* lds, int L, int wave_id) {
    const Ctx cx = make_ctx(wave_id);
    const int j = L >> 1;
    const float* modl = p.mod + (size_t)L * 17 * 6144;
    const float* modprev = p.mod + (size_t)(L > 0 ? L - 1 : 0) * 17 * 6144;
    const bool last = (L == 3);
    const int rows_layer = (L == 3) ? NLAT : NT;
    const int rows_out = (L >= 2) ? NLAT : NT;
    const float* xin_lat = (L == 0) ? p.x : p.out; const float* xin_ctx = (L == 0) ? p.ctx : p.ctxs;
    constexpr bool BFS = (OPT >= 11);
    const void* bin_lat = (L == 0) ? (const void*)p.x : (const void*)p.xs; const void* bin_ctx = (L == 0) ? (const void*)p.ctx : (const void*)p.cs;
    bf16_t* bout_lat = (L == 3) ? p.xs3 : p.xs;
    if constexpr (PH == 0) { if (OPT >= 7) { ph_mod_opt(cx, p, lds); for (int i = cx.bid * NTHR + cx.tid; i < 1024; i += cx.nblk * NTHR) p.H[(size_t)NT * 1024 + i] = 0; } else ph_prologue(cx, p, lds); ph_prep_weights(cx, p, lds); }
    if constexpr (PH == 1) {
        if (OPT >= 4 && !PROBE_SPLIT1) ph_prep_moe(cx, p, lds, L);
        if (BFS && L > 0) { ph_normc<false>(cx, p, rows_layer, p.xs, p.xs, p.norm1_g + L * 1024, modl, modprev); return; }
        if (L == 0) ph_norm<false, true, false>(cx, p, lds, rows_layer, xin_lat, xin_ctx, p.norm1_g + L * 1024, modl, 0, 1, modprev, L);
        else ph_norm<true, true, false>(cx, p, lds, rows_layer, xin_lat, xin_ctx, p.norm1_g + L * 1024, modl, 0, 1, modprev, L);
    }
    if constexpr (PH == 2) { if (OPT >= 1) ph_win_mm(cx, p, lds, j); else ph_win(cx, p, lds, j); }
    if constexpr (PH == 3) { if (OPT >= 10) ph_prepBLR_opt(cx, p, j); else ph_prepB(cx, p, j); }
    if constexpr (PH == 4) { if (OPT >= 2) ph_qkvup_mm(cx, p, lds, j, rows_out); else ph_qkvup(cx, p, lds, j, rows_out); }
    if constexpr (PH == 5) { if (OPT >= 7) ph_finalize_opt(cx, p, lds, j, rows_out); else ph_finalize(cx, p, j, rows_out); }
    if constexpr (PH == 6) { if (OPT >= 5) ph_attn_mm(cx, p, lds, rows_out == NT); else ph_attn(cx, p, rows_out == NT); }
    if constexpr (PH == 7) { if (OPT < 10) ph_prepLR(cx, p, j); }
    if constexpr (PH == 8) { if (OPT >= 2) ph_wag_mm(cx, p, lds, j); else ph_wag(cx, p, lds, j); }
    if constexpr (PH == 9) { if (OPT >= 9) ph_scan_chunk<0>(cx, p, lds, j); else if (OPT >= 6) ph_scan_opt<0>(cx, p, lds, j); else ph_scan(cx, p, lds, j); }
    if constexpr (PH == 19) ph_scan_chunk<PROBE_SCAN>(cx, p, lds, j);
    if constexpr (PH == 20) ph_prep_moe(cx, p, lds, L);
    if constexpr (PH == 10) { if (OPT >= 7) ph_post_opt(cx, p, j, rows_out); else ph_post(cx, p, j, rows_out); }
    if constexpr (PH == 11) { if (BFS) ph_wout_mmB(cx, p, lds, p.H, p.WoutT + (size_t)j * 1024 * 1024, rows_out, bin_lat, bin_ctx, bout_lat, L == 0, modl); else if (OPT >= 1) ph_wout_mm(cx, p, lds, p.H, p.WoutT + (size_t)j * 1024 * 1024, rows_out, xin_lat, xin_ctx, modl); else ph_wout(cx, p, lds, p.H, p.w_out_even + (size_t)j * 1024 * 1024, rows_out, xin_lat, xin_ctx, modl); }
    if constexpr (PH == 12) { if (OPT >= 12) ph_f1b(cx, p, lds, j, !last); else if (OPT >= 3) ph_f1_mm(cx, p, lds, j, !last); else ph_chdft(cx, p, lds, rows_layer); }
    if constexpr (PH == 13) { if (OPT >= 12) ph_fa(cx, p, lds, !last); else if (BFS) ph_f2_mmB(cx, p, lds, !last, bin_lat, bin_ctx, bout_lat, modl); else if (OPT >= 3) ph_f2_mm(cx, p, lds, !last, xin_lat, xin_ctx, modl); else ph_posdft(cx, p, lds, !last); }
    if constexpr (PH == 14) { if (OPT >= 12) ph_fb(cx, p, lds, !last, p.xs, bout_lat, modl); }
    if constexpr (PH == 14) { if (OPT < 3) ph_wout(cx, p, lds, p.F, p.w_out_fourier + (size_t)j * 1024 * 1024, rows_out, xin_lat, xin_ctx, modl); }
    if constexpr (PH == 15) { if (OPT >= 13) ph_norm2_router_mfma(cx, p, lds, rows_out, p.norm2_g + L * 1024, modl, L, bout_lat); else if (OPT >= 8) ph_norm2_router(cx, p, lds, rows_out, p.norm2_g + L * 1024, modl, L, BFS ? bout_lat : (const bf16_t*)nullptr); else ph_norm<false, true, true>(cx, p, lds, rows_out, p.out, p.ctxs, p.norm2_g + L * 1024, modl, 3, 4, modprev, L); }
    if constexpr (PH == 16) { if (OPT >= 4) ph_moe_up_mm(cx, p, lds, L, rows_out); else ph_moe_up(cx, p, lds, L, rows_out); }
    if constexpr (PH == 17) { if (OPT >= 4) ph_moe_down_mm(cx, p, lds, L, rows_out); else ph_moe_down(cx, p, lds, L, rows_out); }
    if constexpr (PH == 18) { if (BFS) { ph_normc<true>(cx, p, NLAT, p.xs3, nullptr, p.norm1_g, p.mod + (size_t)3 * 17 * 6144, p.mod + (size_t)3 * 17 * 6144); return; } }
    if constexpr (PH == 18) ph_norm<true, false, false>(cx, p, lds, NLAT, p.out, p.ctxs, p.norm1_g, p.mod + (size_t)3 * 17 * 6144, 0, 1, p.mod + (size_t)3 * 17 * 6144, 3);
}

template <int PH>
__global__ void __launch_bounds__(NTHR, 2) k_phase(Params p, int L) {
    extern __shared__ __attribute__((aligned(16))) float shm[];
    run_phase<PH>(p, shm, L, (int)(threadIdx.x >> 6));
}

#if ONE_LAUNCH
constexpr int PARAM_WORDS = (int)(sizeof(Params) / 4);
DI Params load_params(const unsigned* lp) {
    Params q; unsigned* d = (unsigned*)&q;
#pragma unroll
    for (int i = 0; i < PARAM_WORDS; ++i) d[i] = (unsigned)__builtin_amdgcn_readfirstlane((int)lp[i]);
    void** pp = (void**)&q;
#pragma unroll
    for (int i = 0; i < PARAM_WORDS / 2; ++i) pp[i] = (void*)(__attribute__((address_space(1))) void*)pp[i];
    return q;
}
#ifndef PROBE_MASK
#define PROBE_MASK 0u
#endif

#define PHASE(PH, L) do { unsigned long long t0_ = 0; if (PROBE_MASK & (1u << (PH))) t0_ = wall_clock64(); \
    { run_phase<PH>(p, lds, (L), wave_id); } xcd_barrier(bar, wave_id == 0 && lane_id_asm() == 0); \
    if (PROBE_MASK & (1u << (PH))) tacc += wall_clock64() - t0_; } while (0)
__global__ void __launch_bounds__(NTHR, 2) k_mega(Params p) {
    extern __shared__ __attribute__((aligned(16))) float shm[];
    unsigned* lp = (unsigned*)(shm + 4);
    float* lds = shm + 4 + ((PARAM_WORDS + 3) & ~3);
    if (threadIdx.x == 0) { shm[0] = 0.f; shm[1] = 0.f; shm[2] = 0.f; shm[3] = 0.f; }
    if (threadIdx.x < PARAM_WORDS) lp[threadIdx.x] = ((const unsigned*)&p)[threadIdx.x];
    __syncthreads();
    XcdBarrier bar; { const Params q_ = load_params(lp); bar = xcd_barrier_post(q_.bar, (volatile LAS unsigned*)shm); }
    unsigned long long tacc = 0;
    const int wave_id = __builtin_amdgcn_readfirstlane((int)(threadIdx.x >> 6));
    PHASE(0, 0);
#define LAYER_EVEN(L) if (PROBE_SPLIT1) { PHASE(20, L); } PHASE(1, L); PHASE(2, L); PHASE(3, L); PHASE(4, L); PHASE(5, L); PHASE(6, L); if (OPT < 10) { PHASE(7, L); } PHASE(8, L); PHASE(9, L); if (PROBE_SCAN) { PHASE(19, L); } PHASE(10, L); PHASE(11, L); PHASE(15, L); PHASE(16, L); PHASE(17, L)
#define LAYER_ODD(L) if (PROBE_SPLIT1) { PHASE(20, L); } PHASE(1, L); PHASE(12, L); PHASE(13, L); if (OPT < 3 || OPT >= 12) { PHASE(14, L); } PHASE(15, L); PHASE(16, L); PHASE(17, L)
    LAYER_EVEN(0); LAYER_ODD(1); LAYER_EVEN(2); LAYER_ODD(3);
    { unsigned long long t0_ = 0; if (PROBE_MASK & (1u << 18)) t0_ = wall_clock64(); run_phase<18>(p, lds, 3, wave_id);
      if (PROBE_MASK & (1u << 18)) { xcd_barrier(bar, wave_id == 0 && lane_id_asm() == 0); tacc += wall_clock64() - t0_; } }
    if (PROBE_MASK != 0u && blockIdx.x == 0 && threadIdx.x == 0) {
        const unsigned long long t1 = wall_clock64(); while (wall_clock64() - t1 < 20ull * tacc) __builtin_amdgcn_s_sleep(8); }
}
#endif

static inline size_t al256(size_t v) { return (v + 255) & ~(size_t)255; }
constexpr size_t LDS_BYTES = 148 * 1024;

template <int PH> static void launch_phase(const Params& p, int L, int grid, hipStream_t s) {
    static bool attr = false;
    if (!attr) { hipFuncSetAttribute((const void*)k_phase<PH>, hipFuncAttributeMaxDynamicSharedMemorySize, (int)LDS_BYTES); attr = true; }
    hipLaunchKernelGGL(k_phase<PH>, dim3(grid), dim3(NTHR), LDS_BYTES, s, p, L);
}

extern "C" void kernel_launch(void* const* d_in, const int* in_sizes, int n_in, void* d_out, int out_size, void* d_ws, size_t ws_size, hipStream_t stream) {
    (void)in_sizes; (void)n_in; (void)out_size;
    Params p{};
    const float** ip = (const float**)&p.x;
    for (int i = 0; i < 36; ++i) ip[i] = (const float*)d_in[i];
    p.out = (float*)d_out;
    char* w = (char*)d_ws; size_t o = 0;
    auto take = [&](size_t bytes) { char* r = w + o; o += al256(bytes); return r; };
    p.bar = (unsigned*)take(XCD_BAR_WORDS * 4);
    p.cnt = (int*)take(64 * 64 * 4);
    const size_t zero_bytes = o;
    p.mod = (float*)take((size_t)4 * 17 * 6144 * 4);
    p.ctxs = (float*)take((size_t)NCTX * 1024 * 4);
    p.dftl = (bf16_t*)take((size_t)2048 * 4096 * 2);
    p.dftc = (bf16_t*)take((size_t)256 * 512 * 2);
    p.slot = (int*)take((size_t)16 * NT * 4);
    p.tokw = (float*)take((size_t)NT * 2 * 4);
    p.slotw = (float*)take((size_t)16 * NT * 4);
    p.H = (bf16_t*)take((size_t)(NT + 1) * 1024 * 2);
    char* big = w + o;
    p.P = (bf16_t*)take((size_t)NT * PLD * 2);
    char* r1 = w + o;
    p.WAG = (bf16_t*)take((size_t)NT * WLD * 2);
    p.YF = (bf16_t*)take((size_t)NT * 512 * 2);
    p.YB = (bf16_t*)take((size_t)NT * 512 * 2);
    p.LR = (bf16_t*)take((size_t)NT * 384 * 2);
    p.WinT = (bf16_t*)take((size_t)2 * 2560 * 1024 * 2); p.WqT = (bf16_t*)take((size_t)2 * 768 * 256 * 2); p.WkvT = (bf16_t*)take((size_t)2 * 1024 * 256 * 2);
    p.WlrT = (bf16_t*)take((size_t)2 * 2560 * 384 * 2); p.WoutT = (bf16_t*)take((size_t)2 * 1024 * 1024 * 2); p.A1 = (bf16_t*)take((size_t)2 * 2048 * 1024 * 2);
    p.A2 = (bf16_t*)take((size_t)2048 * 4096 * 2); p.A2c = (bf16_t*)take((size_t)256 * 512 * 2); p.M1 = (bf16_t*)take((size_t)256 * 256 * 2);
    p.WguT = (bf16_t*)take((size_t)17 * 1024 * 1024 * 2); p.WdT = (bf16_t*)take((size_t)17 * 1024 * 512 * 2);
    const size_t total = o;
    { size_t q = 0; auto t2 = [&](size_t bytes) { char* r = r1 + q; q += al256(bytes); return r; };
      p.QN = (bf16_t*)t2((size_t)NT * 512 * 2); p.Qraw = (bf16_t*)t2((size_t)NT * 768 * 2); p.KVraw = (bf16_t*)t2((size_t)NT * 1024 * 2);
      p.Kf = (bf16_t*)t2((size_t)NB * 8 * 2304 * 96 * 2); p.Vt = (bf16_t*)t2((size_t)NB * 8 * 64 * 2304 * 2); }
    { size_t q = 0; auto t3 = [&](size_t bytes) { char* r = big + q; q += al256(bytes); return r; };
      p.ACT = (bf16_t*)t3((size_t)3 * NT * 512 * 2); p.Y = (bf16_t*)t3((size_t)3 * NT * 1024 * 2); }
    { size_t q = 0; auto t4 = [&](size_t bytes) { char* r = big + q; q += al256(bytes); return r; };
      p.G = (float*)t4((size_t)NT * 2048 * 4); p.F = (bf16_t*)t4((size_t)NT * 1024 * 2); }
    { size_t q = 0; auto t5 = [&](size_t bytes) { char* r = big + q; q += al256(bytes); return r; };
      p.ZT = (bf16_t*)t5((size_t)16 * 1024 * 4096 * 2); p.ZTC = (bf16_t*)t5((size_t)16 * 1024 * 512 * 2);
      p.YF1 = (bf16_t*)t5((size_t)256 * 16 * 1024 * 16 * 2); p.YF1c = (bf16_t*)t5((size_t)256 * 16 * 1024 * 2 * 2); }
    p.xs = (bf16_t*)d_out; p.cs = (bf16_t*)p.ctxs; p.xs3 = (bf16_t*)(big + (size_t)344 * 1024 * 1024);
    if (total > ws_size) { fprintf(stderr, "workspace too small: need %zu have %zu\n", total, ws_size); return; }
    static int grid = 0;
    if (!grid) { int dev = 0, cus = 0; hipGetDevice(&dev); hipDeviceGetAttribute(&cus, hipDeviceAttributeMultiprocessorCount, dev); grid = cus > 0 ? cus : 256; if (grid > 256) grid = 256; }
    hipMemsetAsync(d_ws, 0, zero_bytes, stream);
#if ONE_LAUNCH
    static bool attr = false;
    if (!attr) { hipFuncSetAttribute((const void*)k_mega, hipFuncAttributeMaxDynamicSharedMemorySize, (int)LDS_BYTES); attr = true; }
    hipLaunchKernelGGL(k_mega, dim3(grid), dim3(NTHR), LDS_BYTES, stream, p);
#else
    launch_phase<0>(p, 0, grid, stream);
    for (int L = 0; L < 4; ++L) {
        launch_phase<1>(p, L, grid, stream);
        if ((L & 1) == 0) {
            launch_phase<2>(p, L, grid, stream); launch_phase<3>(p, L, grid, stream); launch_phase<4>(p, L, grid, stream); launch_phase<5>(p, L, grid, stream);
            launch_phase<6>(p, L, grid, stream); launch_phase<7>(p, L, grid, stream); launch_phase<8>(p, L, grid, stream); launch_phase<9>(p, L, grid, stream);
            launch_phase<10>(p, L, grid, stream); launch_phase<11>(p, L, grid, stream);
        } else {
            launch_phase<12>(p, L, grid, stream); launch_phase<13>(p, L, grid, stream); launch_phase<14>(p, L, grid, stream);
        }
        launch_phase<15>(p, L, grid, stream); launch_phase<16>(p, L, grid, stream); launch_phase<17>(p, L, grid, stream);
    }
    launch_phase<18>(p, 3, grid, stream);
#endif
}
```

```cpp
#include <hip/hip_runtime.h>
#include <cstdio>
#include <cstdint>

#ifndef ONE_LAUNCH
#define ONE_LAUNCH 1
#endif
#ifndef PROBE_SCAN
#define PROBE_SCAN 0
#endif
#ifndef PROBE_SPLIT1
#define PROBE_SPLIT1 0
#endif
#ifndef PROBE_GEMM
#define PROBE_GEMM 0
#endif
#ifndef OPT
#define OPT 13
#endif

typedef unsigned short bf16_t;
#define DI __device__ __forceinline__
#define LAS __attribute__((address_space(3)))

constexpr int D = 1024, NB = 16, SEQ = 2048, CTXL = 256, NLAT = NB * SEQ, NCTX = NB * CTXL, NT = NLAT + NCTX;
constexpr int PLD = 2560;
constexpr int INC = 2336, ACOLS = 1920;
constexpr int WLD = 2560;
constexpr int NTHR = 512;

#define XB_TMO      128
#define XB_XCNT(j)  (256  + 64 * (j))
#define XB_XSUB(j)  (1280 + 64 * (j))
#define XB_XGEN(j)  (2304 + 64 * (j))
#define XB_TOP      3328
#define XB_TOPGEN   3392
#define XCD_BAR_WORDS 3456
#define XB_SPIN_CAP (1u << 24)
DI unsigned xb_ld(unsigned* p)              { return __hip_atomic_load(p, __ATOMIC_RELAXED, __HIP_MEMORY_SCOPE_AGENT); }
DI unsigned xb_add(unsigned* p, unsigned v) { return __hip_atomic_fetch_add(p, v, __ATOMIC_RELAXED, __HIP_MEMORY_SCOPE_AGENT); }
DI unsigned xb_xcc_id() { return (unsigned)__builtin_amdgcn_s_getreg((3 << 11) | 20) & 0xFu; }
#define XB_SPIN(cond, bar) do { unsigned _sp = 0; while (cond) { __builtin_amdgcn_s_sleep(1); \
    if ((++_sp & 255u) == 0u) { if (xb_ld(&(bar)[XB_TMO])) break; if (_sp > XB_SPIN_CAP) { atomicAdd(&(bar)[XB_TMO], 1u); break; } } } } while (0)
struct XcdBarrier { unsigned* bar; unsigned x; volatile LAS unsigned* st; };
DI XcdBarrier xcd_barrier_post(unsigned* bar, volatile LAS unsigned* st) {
    XcdBarrier b; b.bar = bar; b.x = xb_xcc_id(); b.st = st;
    if (threadIdx.x == 0) (void)xb_add(&bar[XB_XCNT(b.x)], 1u);
    return b;
}
DI void xcd_barrier_complete(unsigned* bar, unsigned x, unsigned& nloc, unsigned& nx) {
    const unsigned G = gridDim.x * gridDim.y * gridDim.z;
    unsigned sum, cnt, mine, sp = 0u;
    for (;;) {
        sum = 0u; cnt = 0u; mine = 0u;
#pragma unroll
        for (unsigned j = 0; j < 16; ++j) { const unsigned c = xb_ld(&bar[XB_XCNT(j)]); sum += c; cnt += (c > 0u) ? 1u : 0u; mine = (j == x) ? c : mine; }
        if (sum == G) break;
        __builtin_amdgcn_s_sleep(1);
        if ((++sp & 255u) == 0u) { if (xb_ld(&bar[XB_TMO])) break; if (sp > XB_SPIN_CAP) { atomicAdd(&bar[XB_TMO], 1u); break; } }
    }
    nloc = mine > 0u ? mine : 1u; nx = cnt > 0u ? cnt : 1u;
}
DI void xcd_barrier(const XcdBarrier& b, const bool t0) {
    asm volatile("s_waitcnt vmcnt(0)" ::: "memory");
    __syncthreads();
    if (t0) {
        unsigned* bar = b.bar;
        __builtin_amdgcn_s_waitcnt(0);
        unsigned nloc = b.st[0], nx = b.st[1];
        if (nloc == 0u) { xcd_barrier_complete(bar, b.x, nloc, nx); b.st[0] = nloc; b.st[1] = nx; }
        const unsigned old = xb_add(&bar[XB_XSUB(b.x)], 1u);
        const unsigned gen = old / nloc;
        if (old + 1u == (gen + 1u) * nloc) {
            __builtin_amdgcn_fence(__ATOMIC_RELEASE, "agent");
            asm volatile("s_waitcnt vmcnt(0)" ::: "memory");
            const unsigned og = xb_add(&bar[XB_TOP], 1u);
            const unsigned tg = og / nx;
            if (og + 1u == (tg + 1u) * nx) xb_add(&bar[XB_TOPGEN], 1u);
            else XB_SPIN(xb_ld(&bar[XB_TOPGEN]) == tg, bar);
            __builtin_amdgcn_fence(__ATOMIC_ACQUIRE, "agent");
            xb_add(&bar[XB_XGEN(b.x)], 1u);
            asm volatile("s_waitcnt vmcnt(0)" ::: "memory");
        } else {
            XB_SPIN(xb_ld(&bar[XB_XGEN(b.x)]) == gen, bar);
            __builtin_amdgcn_fence(__ATOMIC_ACQUIRE, "agent");
            asm volatile("s_waitcnt vmcnt(0)" ::: "memory");
        }
    }
    __syncthreads();
}

struct Params {
    const float *x, *c, *ctx, *c_ctx, *norm1_g, *norm2_g, *mod_w, *mod_b, *w_in, *a_mu, *a_w0, *a_w2, *a_a0, *a_a2, *a_g2,
                *a_k_k, *a_k_a, *a_r_k, *a_ln_w, *a_ln_b, *b_q_norm, *b_w_q_up, *b_kv_norm, *b_w_kv_up, *b_q_gain, *b_k_gain,
                *w_out_even, *w_out_fourier, *router_w, *router_b, *moe_w_gate, *moe_w_up, *moe_w_down, *sh_gate, *sh_up, *sh_down;
    float* out;
    unsigned* bar; int* cnt; float* mod; float* ctxs; bf16_t* dftl; bf16_t* dftc; int* slot; float* tokw; float* slotw;
    bf16_t *H, *P, *LR, *WAG, *YF, *YB, *QN, *Qraw, *KVraw, *Kf, *Vt, *ACT, *Y, *F; float* G;
    bf16_t *WinT, *WqT, *WkvT, *WlrT, *WoutT, *A1, *A2, *A2c, *WguT, *WdT, *ZT, *ZTC;
    bf16_t *M1, *YF1, *YF1c;
    bf16_t *xs, *cs, *xs3;
};

struct Ctx { int tid, bid, nblk; };
DI int lane_id_asm() { int l; asm volatile("v_mbcnt_lo_u32_b32 %0, -1, 0\n\tv_mbcnt_hi_u32_b32 %0, -1, %0" : "=v"(l)); return l; }
DI Ctx make_ctx(int wave_id) { Ctx c; c.tid = wave_id * 64 + lane_id_asm(); c.bid = blockIdx.x; c.nblk = gridDim.x; asm volatile("" : "+v"(c.tid), "+s"(c.bid), "+s"(c.nblk)); return c; }

DI bf16_t f2bf(float f) { unsigned u = __float_as_uint(f); u += 0x7fffu + ((u >> 16) & 1u); return (bf16_t)(u >> 16); }
DI float bf2f(bf16_t b) { return __uint_as_float(((unsigned)b) << 16); }
DI float bflo(unsigned u) { return __uint_as_float(u << 16); }
DI float bfhi(unsigned u) { return __uint_as_float(u & 0xffff0000u); }
DI unsigned pack2(float lo, float hi) { return (unsigned)f2bf(lo) | ((unsigned)f2bf(hi) << 16); }
typedef __bf16 g_bf16x2_t __attribute__((ext_vector_type(2)));
typedef float g_f32x2_t __attribute__((ext_vector_type(2)));
DI unsigned att_pk(float a, float b) { g_f32x2_t f = {a, b}; g_bf16x2_t h = __builtin_convertvector(f, g_bf16x2_t); return __builtin_bit_cast(unsigned, h); }
DI float siluf(float v) { return v / (1.f + expf(-v)); }
DI float sigm(float v) { return 1.f / (1.f + expf(-v)); }
template <int CTRL> DI float dpp_f(float v) { return __builtin_bit_cast(float, __builtin_amdgcn_update_dpp(0, __builtin_bit_cast(int, v), CTRL, 0xf, 0xf, true)); }
DI float wave_sum(float v) {
    v += dpp_f<0xB1>(v); v += dpp_f<0x4E>(v); v += dpp_f<0x141>(v); v += dpp_f<0x140>(v);
    const int x = __builtin_bit_cast(int, v);
    const float a = __builtin_bit_cast(float, __builtin_amdgcn_readlane(x, 0)), b = __builtin_bit_cast(float, __builtin_amdgcn_readlane(x, 16));
    const float c = __builtin_bit_cast(float, __builtin_amdgcn_readlane(x, 32)), d = __builtin_bit_cast(float, __builtin_amdgcn_readlane(x, 48));
    return (a + b) + (c + d);
}

template <bool DUAL, class AFn, class BFn, class BFn2, class Epi>
DI void ngemm(const Ctx& cx, float* lds, int nbz, int M, int N, int K, AFn afn, BFn bfn, BFn2 bfn2, Epi epi) {
    float* As = lds; float* Bs = lds + 16 * 132; float* B2s = Bs + 16 * 128;
    const int tid = cx.tid, ty = tid >> 5, tx = tid & 31;
    const int tm = (M + 127) / 128, tn = (N + 127) / 128, ntile = tm * tn * nbz;
    const int arow = tid >> 2, akc = (tid & 3) * 4, bk = tid >> 5, bnn = (tid & 31) * 4;
    for (int tile = cx.bid; tile < ntile; tile += cx.nblk) {
        const int bz = tile / (tm * tn), rem = tile % (tm * tn), bm = rem / tn, bn = rem % tn;
        float acc[8][4], acc2[8][4];
#pragma unroll
        for (int i = 0; i < 8; ++i)
#pragma unroll
            for (int j = 0; j < 4; ++j) { acc[i][j] = 0.f; acc2[i][j] = 0.f; }
        const int m_a = bm * 128 + arow;
        const bf16_t* aptr = (m_a < M) ? afn(bz, m_a) : nullptr;
        const int nB = bn * 128 + bnn;
        for (int k0 = 0; k0 < K; k0 += 16) {
            float av0 = 0.f, av1 = 0.f, av2 = 0.f, av3 = 0.f;
            if (aptr) { const uint2 u = *(const uint2*)(aptr + k0 + akc); av0 = bflo(u.x); av1 = bfhi(u.x); av2 = bflo(u.y); av3 = bfhi(u.y); }
            float4 bv = make_float4(0.f, 0.f, 0.f, 0.f), bv2 = make_float4(0.f, 0.f, 0.f, 0.f);
            if (nB < N) { bv = *(const float4*)(bfn(bz, k0 + bk) + nB); if (DUAL) bv2 = *(const float4*)(bfn2(bz, k0 + bk) + nB); }
            __syncthreads();
            As[(akc + 0) * 132 + arow] = av0; As[(akc + 1) * 132 + arow] = av1; As[(akc + 2) * 132 + arow] = av2; As[(akc + 3) * 132 + arow] = av3;
            *(float4*)&Bs[bk * 128 + bnn] = bv;
            if (DUAL) *(float4*)&B2s[bk * 128 + bnn] = bv2;
            __syncthreads();
#pragma unroll 4
            for (int kk = 0; kk < 16; ++kk) {
                const float4 a0 = *(const float4*)&As[kk * 132 + ty * 8], a1 = *(const float4*)&As[kk * 132 + ty * 8 + 4];
                const float4 b = *(const float4*)&Bs[kk * 128 + tx * 4];
                const float a[8] = {a0.x, a0.y, a0.z, a0.w, a1.x, a1.y, a1.z, a1.w};
                const float bb[4] = {b.x, b.y, b.z, b.w};
#pragma unroll
                for (int i = 0; i < 8; ++i)
#pragma unroll
                    for (int j = 0; j < 4; ++j) acc[i][j] += a[i] * bb[j];
                if (DUAL) {
                    const float4 b2 = *(const float4*)&B2s[kk * 128 + tx * 4];
                    const float cc[4] = {b2.x, b2.y, b2.z, b2.w};
#pragma unroll
                    for (int i = 0; i < 8; ++i)
#pragma unroll
                        for (int j = 0; j < 4; ++j) acc2[i][j] += a[i] * cc[j];
                }
            }
        }
#pragma unroll
        for (int i = 0; i < 8; ++i) {
            const int m = bm * 128 + ty * 8 + i;
            if (m < M) {
#pragma unroll
                for (int j = 0; j < 4; ++j) { const int n = bn * 128 + tx * 4 + j; if (n < N) epi(bz, m, n, acc[i][j], acc2[i][j]); }
            }
        }
    }
    __syncthreads();
}

DI void ph_prologue(const Ctx& cx, const Params& p, float* lds) {
    const int tid = cx.tid, gtid = cx.bid * NTHR + tid, gsz = cx.nblk * NTHR;
    for (int i = tid; i < 17 * 1024; i += NTHR) { const int j = i >> 10, k = i & 1023; const float v = (j < 16) ? p.c[j * 1024 + k] : p.c_ctx[k]; lds[i] = siluf(v); }
    __syncthreads();
    for (int idx = gtid; idx < 4 * 6144; idx += gsz) {
        const int l = idx / 6144, n = idx % 6144;
        const float* w = p.mod_w + (size_t)l * 1024 * 6144 + n;
        float acc[17]; const float b0 = p.mod_b[l * 6144 + n];
#pragma unroll
        for (int j = 0; j < 17; ++j) acc[j] = b0;
        for (int k = 0; k < 1024; ++k) {
            const float wv = w[(size_t)k * 6144];
#pragma unroll
            for (int j = 0; j < 17; ++j) acc[j] += lds[j * 1024 + k] * wv;
        }
#pragma unroll
        for (int j = 0; j < 17; ++j) p.mod[((size_t)l * 17 + j) * 6144 + n] = acc[j];
    }
    for (int i = gtid; i < 2048 * 4096; i += gsz) {
        const int f = i >> 12, k = i & 4095, t = k & 2047, m = (f * t) & 2047; const float a = (float)m * (1.f / 1024.f);
        p.dftl[i] = f2bf((k < 2048) ? cospif(a) : sinpif(a));
    }
    for (int i = gtid; i < 256 * 512; i += gsz) {
        const int f = i >> 9, k = i & 511, t = k & 255, m = (f * t) & 255; const float a = (float)m * (1.f / 128.f);
        p.dftc[i] = f2bf((k < 256) ? cospif(a) : sinpif(a));
    }
    for (int i = gtid; i < 1024; i += gsz) p.H[(size_t)NT * 1024 + i] = 0;
    __syncthreads();
}

DI float pick4(float a0, float a1, float a2, float a3, int i) { return i == 0 ? a0 : (i == 1 ? a1 : (i == 2 ? a2 : a3)); }
template <bool COMBINE, bool NORM, bool ROUTER>
DI void ph_norm(const Ctx& cx, const Params& p, float* lds, int nrows, const float* xin_lat, const float* xin_ctx, const float* gain, const float* modl, int sh_idx, int sc_idx,
                const float* modprev, int layer) {
    const int tid = cx.tid, wid = tid >> 6, lane = tid & 63;
    float* rw = lds;
    float* scr = lds + 16 * 1024;
    int* lcnt = (int*)(lds + 16 * 1024 + 256); int* lbase = lcnt + 16; int* rlist = lcnt + 32;
    int nlist = 0;
    if (ROUTER) {
        for (int i = tid; i < 16 * 1024; i += NTHR) { const int e = i >> 10, col = i & 1023; rw[i] = p.router_w[col * 16 + e]; }
        if (tid < 16) lcnt[tid] = 0;
        __syncthreads();
    }
    for (int row = cx.bid * 8 + wid; row < nrows; row += cx.nblk * 8) {
        const bool lat = row < NLAT; const int j = lat ? (row >> 11) : 16;
        const float* xr = lat ? xin_lat + (size_t)row * 1024 : xin_ctx + (size_t)(row - NLAT) * 1024;
        float4 xv[4];
#pragma unroll
        for (int i = 0; i < 4; ++i) xv[i] = *(const float4*)(xr + i * 256 + lane * 4);
        if (COMBINE) {
            const float* g2 = modprev + (size_t)j * 6144 + 5 * 1024;
            float* xo = lat ? p.out + (size_t)row * 1024 : p.ctxs + (size_t)(row - NLAT) * 1024;
#pragma unroll
            for (int i = 0; i < 4; ++i) {
                const int col = i * 256 + lane * 4;
                const float4 gv = *(const float4*)(g2 + col);
                float s0 = 0.f, s1 = 0.f, s2 = 0.f, s3 = 0.f;
#pragma unroll
                for (int s = 0; s < 3; ++s) { const uint2 u = *(const uint2*)(p.Y + ((size_t)s * NT + row) * 1024 + col); s0 += bflo(u.x); s1 += bfhi(u.x); s2 += bflo(u.y); s3 += bfhi(u.y); }
                xv[i].x += gv.x * s0; xv[i].y += gv.y * s1; xv[i].z += gv.z * s2; xv[i].w += gv.w * s3;
                *(float4*)(xo + col) = xv[i];
            }
        }
        if (NORM) {
            float ss = 0.f;
#pragma unroll
            for (int i = 0; i < 4; ++i) ss += xv[i].x * xv[i].x + xv[i].y * xv[i].y + xv[i].z * xv[i].z + xv[i].w * xv[i].w;
            ss = wave_sum(ss);
            const float rstd = rsqrtf(ss * (1.f / 1024.f) + 1e-6f);
            const float* shp = modl + (size_t)j * 6144 + sh_idx * 1024; const float* scp = modl + (size_t)j * 6144 + sc_idx * 1024;
            float4 hv[4];
#pragma unroll
            for (int i = 0; i < 4; ++i) {
                const int col = i * 256 + lane * 4;
                const float4 g = *(const float4*)(gain + col), sh = *(const float4*)(shp + col), sc = *(const float4*)(scp + col);
                hv[i].x = xv[i].x * rstd * g.x * (1.f + sc.x) + sh.x; hv[i].y = xv[i].y * rstd * g.y * (1.f + sc.y) + sh.y;
                hv[i].z = xv[i].z * rstd * g.z * (1.f + sc.z) + sh.z; hv[i].w = xv[i].w * rstd * g.w * (1.f + sc.w) + sh.w;
                uint2 u; u.x = pack2(hv[i].x, hv[i].y); u.y = pack2(hv[i].z, hv[i].w);
                *(uint2*)(p.H + (size_t)row * 1024 + col) = u;
            }
            if (ROUTER) {
                float part[16];
#pragma unroll
                for (int e = 0; e < 16; ++e) {
                    float a = 0.f;
#pragma unroll
                    for (int i = 0; i < 4; ++i) { const float4 w = *(const float4*)(rw + e * 1024 + i * 256 + lane * 4); a += hv[i].x * w.x + hv[i].y * w.y + hv[i].z * w.z + hv[i].w * w.w; }
                    part[e] = wave_sum(a);
                }
                float* my = scr + wid * 32;
#pragma unroll
                for (int e = 0; e < 16; ++e) if (lane == e) { const float sg = sigm(part[e]); my[e] = sg; my[16 + e] = sg + p.router_b[e]; }
                __builtin_amdgcn_wave_barrier();
                if (lane == 0) {
                    float best = -3.0e38f; int be1 = 0, be2 = 1;
                    for (int g = 0; g < 4; ++g) {
                        const float v0 = my[16 + 4 * g], v1 = my[16 + 4 * g + 1], v2 = my[16 + 4 * g + 2], v3 = my[16 + 4 * g + 3];
                        int i1 = 0; float m1 = v0;
                        if (v1 > m1) { m1 = v1; i1 = 1; } if (v2 > m1) { m1 = v2; i1 = 2; } if (v3 > m1) { m1 = v3; i1 = 3; }
                        int i2 = -1; float m2 = -3.0e38f;
                        if (i1 != 0 && v0 > m2) { m2 = v0; i2 = 0; } if (i1 != 1 && v1 > m2) { m2 = v1; i2 = 1; }
                        if (i1 != 2 && v2 > m2) { m2 = v2; i2 = 2; } if (i1 != 3 && v3 > m2) { m2 = v3; i2 = 3; }
                        const float gs = m1 + m2;
                        if (gs > best) { best = gs; be1 = 4 * g + i1; be2 = 4 * g + i2; }
                    }
                    const float bs1 = my[be1], bs2 = my[be2];
                    const float inv = 1.f / (bs1 + bs2);
                    const int p1 = atomicAdd(&lcnt[be1], 1), p2 = atomicAdd(&lcnt[be2], 1);
                    int* ent = rlist + (wid * 24 + nlist) * 4;
                    ent[0] = row; ent[1] = be1 | (be2 << 8); ent[2] = p1; ent[3] = p2;
                    p.tokw[row * 2] = bs1 * inv; p.tokw[row * 2 + 1] = bs2 * inv;
                }
                ++nlist;
                __builtin_amdgcn_wave_barrier();
            }
        }
    }
    if (ROUTER) {
        __syncthreads();
        if (tid < 16) lbase[tid] = atomicAdd(p.cnt + (layer * 16 + tid) * 64, lcnt[tid]);
        __syncthreads();
        for (int k = lane; k < nlist; k += 64) {
            const int* ent = rlist + (wid * 24 + k) * 4; const int row = ent[0], be1 = ent[1] & 255, be2 = ent[1] >> 8;
            p.slot[(size_t)be1 * NT + lbase[be1] + ent[2]] = row * 2; p.slot[(size_t)be2 * NT + lbase[be2] + ent[3]] = row * 2 + 1;
        }
    }
    (void)scr;
    __syncthreads();
}

DI void ph_win(const Ctx& cx, const Params& p, float* lds, int j) {
    const float* W = p.w_in + (size_t)j * 1024 * INC;
    ngemm<false>(cx, lds, 1, NT, INC, 1024,
        [&](int, int m) { return p.H + (size_t)m * 1024; },
        [&](int, int k) { return W + (size_t)k * INC; }, [&](int, int) { return (const float*)nullptr; },
        [&](int, int m, int n, float v, float) { p.P[(size_t)m * PLD + n] = f2bf(v); });
}
DI void ph_prepB(const Ctx& cx, const Params& p, int j) {
    const int tid = cx.tid, wid = tid >> 6, lane = tid & 63;
    for (int row = cx.bid * 8 + wid; row < NT; row += cx.nblk * 8) {
        const bf16_t* pr = p.P + (size_t)row * PLD + ACOLS;
        const uint2 uq = *(const uint2*)(pr + lane * 4); const unsigned ukv = *(const unsigned*)(pr + 256 + lane * 2);
        const float q0 = bflo(uq.x), q1 = bfhi(uq.x), q2 = bflo(uq.y), q3 = bfhi(uq.y), k0 = bflo(ukv), k1 = bfhi(ukv);
        const float sq = wave_sum(q0 * q0 + q1 * q1 + q2 * q2 + q3 * q3), sk = wave_sum(k0 * k0 + k1 * k1);
        const float rq = rsqrtf(sq * (1.f / 256.f) + 1e-6f), rk = rsqrtf(sk * (1.f / 128.f) + 1e-6f);
        const float* gq = p.b_q_norm + j * 256 + lane * 4; const float* gk = p.b_kv_norm + j * 128 + lane * 2;
        uint2 o; o.x = pack2(q0 * rq * gq[0], q1 * rq * gq[1]); o.y = pack2(q2 * rq * gq[2], q3 * rq * gq[3]);
        bf16_t* qn = p.QN + (size_t)row * 512;
        *(uint2*)(qn + lane * 4) = o;
        *(unsigned*)(qn + 256 + lane * 2) = pack2(k0 * rk * gk[0], k1 * rk * gk[1]);
        *(unsigned*)(qn + 384 + lane * 2) = 0u;
    }
}
DI void ph_qkvup(const Ctx& cx, const Params& p, float* lds, int j, int mq) {
    const float* Wq = p.b_w_q_up + (size_t)j * 256 * 768; const float* Wkv = p.b_w_kv_up + (size_t)j * 128 * 1024;
    ngemm<false>(cx, lds, 1, mq, 768, 256,
        [&](int, int m) { return p.QN + (size_t)m * 512; },
        [&](int, int k) { return Wq + (size_t)k * 768; }, [&](int, int) { return (const float*)nullptr; },
        [&](int, int m, int n, float v, float) { p.Qraw[(size_t)m * 768 + n] = f2bf(v); });
    ngemm<false>(cx, lds, 1, NT, 1024, 128,
        [&](int, int m) { return p.QN + (size_t)m * 512 + 256; },
        [&](int, int k) { return Wkv + (size_t)k * 1024; }, [&](int, int) { return (const float*)nullptr; },
        [&](int, int m, int n, float v, float) { p.KVraw[(size_t)m * 1024 + n] = f2bf(v); });
}
DI void unpack8(const uint4 u, float* d) { d[0] = bflo(u.x); d[1] = bfhi(u.x); d[2] = bflo(u.y); d[3] = bfhi(u.y); d[4] = bflo(u.z); d[5] = bfhi(u.z); d[6] = bflo(u.w); d[7] = bfhi(u.w); }
DI uint4 pack8(const float* d, float scl) { uint4 u; u.x = pack2(d[0] * scl, d[1] * scl); u.y = pack2(d[2] * scl, d[3] * scl); u.z = pack2(d[4] * scl, d[5] * scl); u.w = pack2(d[6] * scl, d[7] * scl); return u; }
DI float ssq8(const uint4 u) { float d[8]; unpack8(u, d); float s = 0.f;
#pragma unroll
    for (int i = 0; i < 8; ++i) s += d[i] * d[i];
    return s; }
DI void norm_rope_store(const uint4 (&raw)[12], const float* gain, int t, bool lat, float scl, bf16_t* dst) {
    float ss = 0.f;
#pragma unroll
    for (int i = 0; i < 12; ++i) ss += ssq8(raw[i]);
    const float r = rsqrtf(ss * (1.f / 96.f) + 1e-6f);
#pragma unroll
    for (int i = 0; i < 8; ++i) { float d[8]; unpack8(raw[i], d);
#pragma unroll
        for (int c = 0; c < 8; ++c) d[c] = d[c] * r * gain[i * 8 + c];
        *(uint4*)(dst + i * 8) = pack8(d, scl); }
    const float invf[8] = {1.f, 0.316227766016838f, 0.1f, 0.0316227766016838f, 0.01f, 0.00316227766016838f, 0.001f, 0.000316227766016838f};
    const float ri = (float)(t >> 6), ci = (float)(t & 63);
#pragma unroll
    for (int half = 0; half < 2; ++half) {
        float x1[8], x2[8], o1[8], o2[8]; unpack8(raw[8 + half], x1); unpack8(raw[10 + half], x2);
#pragma unroll
        for (int c = 0; c < 8; ++c) {
            const float ang = (half == 0 ? ri : ci) * invf[c];
            const float cs = lat ? __cosf(ang) : 1.f, sn = lat ? __sinf(ang) : 0.f;
            const float a = x1[c] * r * gain[64 + half * 8 + c], b = x2[c] * r * gain[80 + half * 8 + c];
            o1[c] = a * cs - b * sn; o2[c] = b * cs + a * sn;
        }
        *(uint4*)(dst + 64 + half * 8) = pack8(o1, scl); *(uint4*)(dst + 80 + half * 8) = pack8(o2, scl);
    }
}
DI void ph_finalize(const Ctx& cx, const Params& p, int j, int mq) {
    const int gtid = cx.bid * NTHR + cx.tid, gsz = cx.nblk * NTHR;
    const float* qg = p.b_q_gain + j * 96; const float* kg = p.b_k_gain + j * 96;
    for (int idx = gtid; idx < 8 * mq; idx += gsz) {
        const int h = idx / mq, row = idx % mq;
        const bool lat = row < NLAT; const int t = lat ? (row & 2047) : ((row - NLAT) & 255);
        bf16_t* qp = p.Qraw + (size_t)row * 768 + h * 96;
        uint4 raw[12];
#pragma unroll
        for (int i = 0; i < 12; ++i) raw[i] = *(const uint4*)(qp + i * 8);
        norm_rope_store(raw, qg, t, lat, (OPT >= 5) ? 0.10206207261596577f * 1.4426950408889634f : 0.10206207261596577f, qp);
    }
    for (int idx = gtid; idx < 8 * NT; idx += gsz) {
        const int h = idx / NT, row = idx % NT;
        const bool lat = row < NLAT; const int b = lat ? (row >> 11) : ((row - NLAT) >> 8); const int t = lat ? (row & 2047) : ((row - NLAT) & 255);
        const int key = lat ? 256 + t : t;
        const bf16_t* kvp = p.KVraw + (size_t)row * 1024 + h * 128; const bf16_t* krp = p.P + (size_t)row * PLD + ACOLS + 384;
        uint4 raw[12];
#pragma unroll
        for (int i = 0; i < 8; ++i) raw[i] = *(const uint4*)(kvp + i * 8);
#pragma unroll
        for (int i = 0; i < 4; ++i) raw[8 + i] = *(const uint4*)(krp + i * 8);
        norm_rope_store(raw, kg, t, lat, 1.f, p.Kf + ((size_t)(b * 8 + h) * 2304 + key) * 96);
    }
    for (int idx = gtid; idx < 8 * NT; idx += gsz) {
        const int h = idx / NT, row = idx % NT;
        const bool lat = row < NLAT; const int b = lat ? (row >> 11) : ((row - NLAT) >> 8); const int t = lat ? (row & 2047) : ((row - NLAT) & 255);
        const int key = lat ? 256 + t : t;
        const bf16_t* vp = p.KVraw + (size_t)row * 1024 + h * 128 + 64;
        bf16_t* vo = p.Vt + (size_t)(b * 8 + h) * 64 * 2304 + key;
#pragma unroll 1
        for (int i = 0; i < 8; ++i) { const uint4 u = *(const uint4*)(vp + i * 8);
            vo[0] = (bf16_t)(u.x & 0xffff); vo[2304] = (bf16_t)(u.x >> 16); vo[2 * 2304] = (bf16_t)(u.y & 0xffff); vo[3 * 2304] = (bf16_t)(u.y >> 16);
            vo[4 * 2304] = (bf16_t)(u.z & 0xffff); vo[5 * 2304] = (bf16_t)(u.z >> 16); vo[6 * 2304] = (bf16_t)(u.w & 0xffff); vo[7 * 2304] = (bf16_t)(u.w >> 16);
            vo += 8 * 2304; }
    }
}
DI void ph_attn(const Ctx& cx, const Params& p, bool with_ctx) {
    const int gtid = cx.bid * NTHR + cx.tid, gsz = cx.nblk * NTHR;
    const int total = NLAT * 8 + (with_ctx ? NCTX * 8 : 0);
    for (int idx = gtid; idx < total; idx += gsz) {
        int b, h, row, nkeys;
        if (idx < NLAT * 8) { b = idx >> 14; h = (idx >> 11) & 7; row = b * 2048 + (idx & 2047); nkeys = 2304; }
        else { const int i2 = idx - NLAT * 8; b = i2 >> 11; h = (i2 >> 8) & 7; row = NLAT + b * 256 + (i2 & 255); nkeys = 256; }
        const bf16_t* qp = p.Qraw + (size_t)row * 768 + h * 96;
        const bf16_t* Kb = p.Kf + (size_t)(b * 8 + h) * 2304 * 96; const bf16_t* Vb = p.Vt + (size_t)(b * 8 + h) * 64 * 2304;
        float q[96];
#pragma unroll
        for (int i = 0; i < 12; ++i) { const uint4 u = *(const uint4*)(qp + i * 8); q[i * 8] = bflo(u.x); q[i * 8 + 1] = bfhi(u.x); q[i * 8 + 2] = bflo(u.y); q[i * 8 + 3] = bfhi(u.y);
            q[i * 8 + 4] = bflo(u.z); q[i * 8 + 5] = bfhi(u.z); q[i * 8 + 6] = bflo(u.w); q[i * 8 + 7] = bfhi(u.w); }
        float acc[64];
#pragma unroll
        for (int i = 0; i < 64; ++i) acc[i] = 0.f;
        float mx = -3.0e38f, l = 0.f;
        for (int key0 = 0; key0 < nkeys; key0 += 8) {
            float s[8];
#pragma unroll
            for (int kk = 0; kk < 8; ++kk) {
                const uint4* kp = (const uint4*)(Kb + (size_t)(key0 + kk) * 96); float a = 0.f;
#pragma unroll
                for (int i = 0; i < 12; ++i) { const uint4 u = kp[i]; a += q[i * 8] * bflo(u.x) + q[i * 8 + 1] * bfhi(u.x) + q[i * 8 + 2] * bflo(u.y) + q[i * 8 + 3] * bfhi(u.y)
                    + q[i * 8 + 4] * bflo(u.z) + q[i * 8 + 5] * bfhi(u.z) + q[i * 8 + 6] * bflo(u.w) + q[i * 8 + 7] * bfhi(u.w); }
                s[kk] = a;
            }
            float cm = s[0];
#pragma unroll
            for (int kk = 1; kk < 8; ++kk) cm = fmaxf(cm, s[kk]);
            const float mn = fmaxf(mx, cm), alpha = expf(mx - mn);
            float ps = 0.f;
#pragma unroll
            for (int kk = 0; kk < 8; ++kk) { s[kk] = expf(s[kk] - mn); ps += s[kk]; }
            l = l * alpha + ps; mx = mn;
#pragma unroll
            for (int dv = 0; dv < 64; ++dv) {
                const uint4 u = *(const uint4*)(Vb + (size_t)dv * 2304 + key0);
                acc[dv] = acc[dv] * alpha + s[0] * bflo(u.x) + s[1] * bfhi(u.x) + s[2] * bflo(u.y) + s[3] * bfhi(u.y) + s[4] * bflo(u.z) + s[5] * bfhi(u.z) + s[6] * bflo(u.w) + s[7] * bfhi(u.w);
            }
        }
        const float il = 1.f / l;
        bf16_t* o = p.H + (size_t)row * 1024 + 512 + h * 64;
#pragma unroll
        for (int i = 0; i < 8; ++i) { uint4 u; u.x = pack2(acc[i * 8] * il, acc[i * 8 + 1] * il); u.y = pack2(acc[i * 8 + 2] * il, acc[i * 8 + 3] * il);
            u.z = pack2(acc[i * 8 + 4] * il, acc[i * 8 + 5] * il); u.w = pack2(acc[i * 8 + 6] * il, acc[i * 8 + 7] * il); *(uint4*)(o + i * 8) = u; }
    }
}
DI float shiftp(const bf16_t* P, int row, int t, int T, int col, float mu) {
    const float c = bf2f(P[(size_t)row * PLD + col]);
    const float pv = (t > 0) ? bf2f(P[(size_t)(row - 1) * PLD + col]) : 0.f;
    const float nx = (t < T - 1) ? bf2f(P[(size_t)(row + 1) * PLD + col]) : 0.f;
    return c + mu * (0.5f * (pv + nx) - c);
}
DI void ph_prepLR(const Ctx& cx, const Params& p, int j) {
    const int gtid = cx.bid * NTHR + cx.tid, gsz = cx.nblk * NTHR;
    const float* mu = p.a_mu + j * ACOLS + 1536;
    for (int idx = gtid; idx < NT * 384; idx += gsz) {
        const int row = idx / 384, col = idx % 384;
        const bool lat = row < NLAT; const int t = lat ? (row & 2047) : ((row - NLAT) & 255); const int T = lat ? 2048 : 256;
        float v = shiftp(p.P, row, t, T, 1536 + col, mu[col]);
        if (col < 128) v = tanhf(v); else if (col >= 256) v = sigm(v);
        p.LR[(size_t)row * 384 + col] = f2bf(v);
    }
}
DI void ph_wag(const Ctx& cx, const Params& p, float* lds, int j) {
    for (int d = 0; d < 2; ++d) {
        const float* W2 = p.a_w2 + (size_t)(j * 2 + d) * 64 * 512; const float* w0 = p.a_w0 + (j * 2 + d) * 512;
        ngemm<false>(cx, lds, 1, NT, 512, 64,
            [&](int, int m) { return p.LR + (size_t)m * 384 + d * 64; },
            [&](int, int k) { return W2 + (size_t)k * 512; }, [&](int, int) { return (const float*)nullptr; },
            [&](int, int m, int n, float v, float) { const float z = -0.606531f * sigm(w0[n] + v); p.WAG[(size_t)m * WLD + d * 512 + n] = f2bf(-expm1f(z)); });
        const float* A2 = p.a_a2 + (size_t)(j * 2 + d) * 64 * 512; const float* a0 = p.a_a0 + (j * 2 + d) * 512;
        ngemm<false>(cx, lds, 1, NT, 512, 64,
            [&](int, int m) { return p.LR + (size_t)m * 384 + 128 + d * 64; },
            [&](int, int k) { return A2 + (size_t)k * 512; }, [&](int, int) { return (const float*)nullptr; },
            [&](int, int m, int n, float v, float) { p.WAG[(size_t)m * WLD + 1024 + d * 512 + n] = f2bf(sigm(a0[n] + v)); });
    }
    const float* G2 = p.a_g2 + (size_t)j * 128 * 512;
    ngemm<false>(cx, lds, 1, NT, 512, 128,
        [&](int, int m) { return p.LR + (size_t)m * 384 + 256; },
        [&](int, int k) { return G2 + (size_t)k * 512; }, [&](int, int) { return (const float*)nullptr; },
        [&](int, int m, int n, float v, float) { p.WAG[(size_t)m * WLD + 2048 + n] = f2bf(v); });
}
DI void ph_scan(const Ctx& cx, const Params& p, float* lds, int j) {
    const int tid = cx.tid, lane = tid & 63;
    if (tid < 64) {
        for (int item = cx.bid; item < 256; item += cx.nblk) {
            const int b = item >> 4, h = (item >> 1) & 7, dir = item & 1, hc = h * 64 + lane;
            float S[64];
#pragma unroll
            for (int k = 0; k < 64; ++k) S[k] = 0.f;
            const float kkc = p.a_k_k[j * 512 + hc], kac = p.a_k_a[j * 512 + hc];
            const float mur = p.a_mu[j * ACOLS + hc], muk = p.a_mu[j * ACOLS + 512 + hc], muv = p.a_mu[j * ACOLS + 1024 + hc];
            bf16_t* yout = dir ? p.YB : p.YF;
            for (int step = 0; step < 2304; ++step) {
                const bool cp = step < 256; const int tt = cp ? step : step - 256, T = cp ? 256 : 2048, t = dir ? (T - 1 - tt) : tt;
                const int row = cp ? NLAT + b * 256 + t : b * 2048 + t;
                const float R = shiftp(p.P, row, t, T, hc, mur), K = shiftp(p.P, row, t, T, 512 + hc, muk), V = shiftp(p.P, row, t, T, 1024 + hc, muv);
                const float w = 1.f - bf2f(p.WAG[(size_t)row * WLD + dir * 512 + hc]), a = bf2f(p.WAG[(size_t)row * WLD + 1024 + dir * 512 + hc]);
                const float kkv = K * kkc, ssq = wave_sum(kkv * kkv), kk = kkv * rsqrtf(ssq + 1e-12f);
                const float kd = K * (1.f + (a - 1.f) * kac), bd = kk * a;
                lds[lane] = -kk; lds[64 + lane] = w; lds[128 + lane] = bd; lds[192 + lane] = kd; lds[256 + lane] = R;
                __builtin_amdgcn_wave_barrier();
                float sa = 0.f;
#pragma unroll
                for (int k4 = 0; k4 < 16; ++k4) { const float4 v = *(const float4*)(lds + k4 * 4); sa += S[k4 * 4] * v.x + S[k4 * 4 + 1] * v.y + S[k4 * 4 + 2] * v.z + S[k4 * 4 + 3] * v.w; }
                float y = 0.f;
#pragma unroll
                for (int k4 = 0; k4 < 16; ++k4) {
                    const float4 wv = *(const float4*)(lds + 64 + k4 * 4), bv = *(const float4*)(lds + 128 + k4 * 4), kv = *(const float4*)(lds + 192 + k4 * 4), rv = *(const float4*)(lds + 256 + k4 * 4);
                    S[k4 * 4] = S[k4 * 4] * wv.x + sa * bv.x + V * kv.x; S[k4 * 4 + 1] = S[k4 * 4 + 1] * wv.y + sa * bv.y + V * kv.y;
                    S[k4 * 4 + 2] = S[k4 * 4 + 2] * wv.z + sa * bv.z + V * kv.z; S[k4 * 4 + 3] = S[k4 * 4 + 3] * wv.w + sa * bv.w + V * kv.w;
                    y += S[k4 * 4] * rv.x + S[k4 * 4 + 1] * rv.y + S[k4 * 4 + 2] * rv.z + S[k4 * 4 + 3] * rv.w;
                }
                __builtin_amdgcn_wave_barrier();
                yout[(size_t)row * 512 + hc] = f2bf(y);
            }
        }
    }
    __syncthreads();
}
DI void ph_post(const Ctx& cx, const Params& p, int j, int nrows) {
    const int gtid = cx.bid * NTHR + cx.tid, gsz = cx.nblk * NTHR;
    for (int idx = gtid; idx < 8 * nrows; idx += gsz) {
        const int h = idx / nrows, row = idx % nrows;
        const bool lat = row < NLAT; const int t = lat ? (row & 2047) : ((row - NLAT) & 255); const int T = lat ? 2048 : 256;
        float sum = 0.f, sb = 0.f;
#pragma unroll 8
        for (int n = 0; n < 64; ++n) {
            const int hc = h * 64 + n;
            const float yy = bf2f(p.YF[(size_t)row * 512 + hc]) + bf2f(p.YB[(size_t)row * 512 + hc]);
            sum += yy;
            const float R = shiftp(p.P, row, t, T, hc, p.a_mu[j * ACOLS + hc]), K = shiftp(p.P, row, t, T, 512 + hc, p.a_mu[j * ACOLS + 512 + hc]);
            const float af = bf2f(p.WAG[(size_t)row * WLD + 1024 + hc]), ab = bf2f(p.WAG[(size_t)row * WLD + 1536 + hc]);
            const float ka = p.a_k_a[j * 512 + hc], rk = p.a_r_k[j * 512 + hc];
            sb += R * rk * (K * (1.f + (af - 1.f) * ka) + K * (1.f + (ab - 1.f) * ka));
        }
        const float mean = sum * (1.f / 64.f); float var = 0.f;
#pragma unroll 8
        for (int n = 0; n < 64; ++n) { const int hc = h * 64 + n; const float yy = bf2f(p.YF[(size_t)row * 512 + hc]) + bf2f(p.YB[(size_t)row * 512 + hc]); var += (yy - mean) * (yy - mean); }
        const float rstd = rsqrtf(var * (1.f / 64.f) + 64e-5f);
#pragma unroll 8
        for (int n = 0; n < 64; ++n) {
            const int hc = h * 64 + n;
            const float yy = bf2f(p.YF[(size_t)row * 512 + hc]) + bf2f(p.YB[(size_t)row * 512 + hc]);
            const float V = shiftp(p.P, row, t, T, 1024 + hc, p.a_mu[j * ACOLS + 1024 + hc]);
            const float g = bf2f(p.WAG[(size_t)row * WLD + 2048 + hc]);
            const float o = ((yy - mean) * rstd * p.a_ln_w[j * 512 + hc] + p.a_ln_b[j * 512 + hc] + sb * V) * g;
            p.H[(size_t)row * 1024 + hc] = f2bf(o);
        }
    }
}
DI void ph_wout(const Ctx& cx, const Params& p, float* lds, const bf16_t* A, const float* W, int nrows, const float* xin_lat, const float* xin_ctx, const float* modl) {
    ngemm<false>(cx, lds, 1, nrows, 1024, 1024,
        [&](int, int m) { return A + (size_t)m * 1024; },
        [&](int, int k) { return W + (size_t)k * 1024; }, [&](int, int) { return (const float*)nullptr; },
        [&](int, int m, int n, float v, float) {
            const bool lat = m < NLAT; const int jj = lat ? (m >> 11) : 16; const float g1 = modl[(size_t)jj * 6144 + 2 * 1024 + n];
            if (lat) p.out[(size_t)m * 1024 + n] = xin_lat[(size_t)m * 1024 + n] + g1 * v;
            else p.ctxs[(size_t)(m - NLAT) * 1024 + n] = xin_ctx[(size_t)(m - NLAT) * 1024 + n] + g1 * v; });
}

DI void ph_chdft(const Ctx& cx, const Params& p, float* lds, int nrows) {
    const int tid = cx.tid, gtid = cx.bid * NTHR + tid, gsz = cx.nblk * NTHR;
    for (int i = tid; i < 128; i += NTHR) { lds[i] = cospif((float)i * (1.f / 64.f)); lds[128 + i] = sinpif((float)i * (1.f / 64.f)); }
    __syncthreads();
    for (int idx = gtid; idx < nrows * 1024; idx += gsz) {
        const int row = idx >> 10, col = idx & 1023, grp = col >> 7, g = col & 127;
        const bf16_t* hp = p.H + (size_t)row * 1024 + grp * 128;
        float gr = 0.f, gi = 0.f;
        for (int c = 0; c < 128; ++c) { const float xv = bf2f(hp[c]); const int m = (c * g) & 127; gr += xv * lds[m]; gi -= xv * lds[128 + m]; }
        p.G[(size_t)row * 2048 + col] = gr; p.G[(size_t)row * 2048 + 1024 + col] = gi;
    }
    __syncthreads();
}
DI void ph_posdft(const Ctx& cx, const Params& p, float* lds, bool with_ctx) {
    ngemm<false>(cx, lds, 16, 2048, 1024, 4096,
        [&](int, int m) { return p.dftl + (size_t)m * 4096; },
        [&](int bz, int k) { return (k < 2048) ? p.G + (size_t)(bz * 2048 + k) * 2048 : p.G + (size_t)(bz * 2048 + k - 2048) * 2048 + 1024; }, [&](int, int) { return (const float*)nullptr; },
        [&](int bz, int m, int n, float v, float) { p.F[(size_t)(bz * 2048 + m) * 1024 + n] = f2bf(v * (1.f / 512.f)); });
    if (with_ctx)
        ngemm<false>(cx, lds, 16, 256, 1024, 512,
            [&](int, int m) { return p.dftc + (size_t)m * 512; },
            [&](int bz, int k) { return (k < 256) ? p.G + (size_t)(NLAT + bz * 256 + k) * 2048 : p.G + (size_t)(NLAT + bz * 256 + k - 256) * 2048 + 1024; }, [&](int, int) { return (const float*)nullptr; },
            [&](int bz, int m, int n, float v, float) { p.F[(size_t)(NLAT + bz * 256 + m) * 1024 + n] = f2bf(v * 0.0055242717280199f); });
}

DI void ph_moe_up(const Ctx& cx, const Params& p, float* lds, int layer, int nrows) {
    for (int e = 0; e < 17; ++e) {
        const int M = (e < 16) ? __builtin_amdgcn_readfirstlane(p.cnt[(layer * 16 + e) * 64]) : nrows;
        const float* Wg = (e < 16) ? p.moe_w_gate + ((size_t)layer * 16 + e) * 1024 * 512 : p.sh_gate + (size_t)layer * 1024 * 512;
        const float* Wu = (e < 16) ? p.moe_w_up + ((size_t)layer * 16 + e) * 1024 * 512 : p.sh_up + (size_t)layer * 1024 * 512;
        const int* sl = p.slot + (size_t)(e & 15) * NT;
        ngemm<true>(cx, lds, 1, M, 512, 1024,
            [&](int, int m) { const int tok = (e < 16) ? (sl[m] >> 1) : m; return p.H + (size_t)tok * 1024; },
            [&](int, int k) { return Wg + (size_t)k * 512; }, [&](int, int k) { return Wu + (size_t)k * 512; },
            [&](int, int m, int n, float g, float u) { const int s = (e < 16) ? sl[m] : 0; const int tok = (e < 16) ? (s >> 1) : m, slab = (e < 16) ? (s & 1) : 2;
                p.ACT[((size_t)slab * NT + tok) * 512 + n] = f2bf(siluf(g) * u); });
    }
}
DI void ph_moe_down(const Ctx& cx, const Params& p, float* lds, int layer, int nrows) {
    for (int e = 0; e < 17; ++e) {
        const int M = (e < 16) ? __builtin_amdgcn_readfirstlane(p.cnt[(layer * 16 + e) * 64]) : nrows;
        const float* Wd = (e < 16) ? p.moe_w_down + ((size_t)layer * 16 + e) * 512 * 1024 : p.sh_down + (size_t)layer * 512 * 1024;
        const int* sl = p.slot + (size_t)(e & 15) * NT;
        ngemm<false>(cx, lds, 1, M, 1024, 512,
            [&](int, int m) { const int s = (e < 16) ? sl[m] : 0; const int tok = (e < 16) ? (s >> 1) : m, slab = (e < 16) ? (s & 1) : 2; return p.ACT + ((size_t)slab * NT + tok) * 512; },
            [&](int, int k) { return Wd + (size_t)k * 1024; }, [&](int, int) { return (const float*)nullptr; },
            [&](int, int m, int n, float v, float) { const int s = (e < 16) ? sl[m] : 0; const int tok = (e < 16) ? (s >> 1) : m, slab = (e < 16) ? (s & 1) : 2;
                const float w = (e < 16) ? p.tokw[s] : 1.f; p.Y[((size_t)slab * NT + tok) * 1024 + n] = f2bf(w * v); });
    }
}

namespace mm {
typedef short bf16x8 __attribute__((ext_vector_type(8)));
typedef float f32x4 __attribute__((ext_vector_type(4)));
typedef unsigned u32x4 __attribute__((ext_vector_type(4)));
constexpr int BM = 256, BK = 64, HALF = 128, HTB = HALF * BK * 2, STAGE_BYTES = 8 * HTB;
DI int lds_byte(int r, int c) { const int st = (r >> 4) * 2 + (c >> 5), rr = r & 15, cc = c & 31, ob = rr * 64 + cc * 2; return st * 1024 + (ob ^ (((ob >> 9) & 1) << 5)); }
DI void stage_rc(int b, int& R, int& C) { const int st = b / 1024, sb = b % 1024, swz = sb ^ (((sb >> 9) & 1) << 5); R = (st >> 1) * 16 + swz / 64; C = (st & 1) * 32 + (swz % 64) / 2; }
DI int perm32(int rho) { const int n = rho >> 4, i = rho & 15; return 8 * (i >> 2) + 4 * n + (i & 3); }
DI unsigned cvt_pk_bf16(float lo, float hi) { unsigned r; asm volatile("v_cvt_pk_bf16_f32 %0, %1, %2" : "=v"(r) : "v"(lo), "v"(hi)); return r; }
struct Unit { const char* A; const char* B; int pm, pn, e, m, tb; };
template <class Sched, class Epi>
DI void gemm_phase(LAS unsigned char* lds, const int K, const Sched& S, const Epi& E, const int tid) {
    const int wid = __builtin_amdgcn_readfirstlane(tid >> 6), lane = tid & 63, wr = wid >> 2, wc = wid & 3, fr = lane & 15, fq = lane >> 4;
    const int nt = K / BK;
    int R0, C0, R1, C1; stage_rc(tid * 16, R0, C0); stage_rc(tid * 16 + 8192, R1, C1);
    unsigned voffB[2];
    { const int Rb0 = Epi::PERM ? ((R0 & ~31) + perm32(R0 & 31)) : R0, Rb1 = Epi::PERM ? ((R1 & ~31) + perm32(R1 & 31)) : R1;
      voffB[0] = S.boff(Rb0, C0, K); voffB[1] = S.boff(Rb1, C1, K); }
    const size_t kstep = (size_t)(BK * 2), hstepB = S.hstep_b(K), hstepA = S.hstep_a();
    const unsigned ldsw = (unsigned)wid * 1024u;
    const int aoff = lds_byte(wr * 64 + fr, fq * 8), boff = lds_byte(wc * 32 + fr, fq * 8);
#define MM_SA(b, h) (((b) * 2 + (h)) * HTB)
#define MM_SB(b, h) ((4 + (b) * 2 + (h)) * HTB)
#define MM_STAGE_A(bufoff, gbase, h, offs) do { _Pragma("unroll") for (int _i = 0; _i < 2; ++_i) { \
        if constexpr (Sched::GATHER) __builtin_amdgcn_global_load_lds((const unsigned*)((const char*)(gbase) + (offs)[h][_i]), (LAS unsigned*)(lds + (bufoff) + ldsw + _i * 8192), 16, 0, 0); \
        else __builtin_amdgcn_global_load_lds((const unsigned*)((const char*)(gbase) + (size_t)(h) * hstepA + (offs)[0][_i]), (LAS unsigned*)(lds + (bufoff) + ldsw + _i * 8192), 16, 0, 0); } } while (0)
#define MM_STAGE_B(bufoff, gbase) do { _Pragma("unroll") for (int _i = 0; _i < 2; ++_i) \
        __builtin_amdgcn_global_load_lds((const unsigned*)((const char*)(gbase) + voffB[_i]), (LAS unsigned*)(lds + (bufoff) + ldsw + _i * 8192), 16, 0, 0); } while (0)
#define MM_LDA(dst, b, h) do { _Pragma("unroll") for (int m = 0; m < 4; ++m) _Pragma("unroll") for (int k = 0; k < 2; ++k) dst[m][k] = *(const LAS bf16x8*)(lds + MM_SA(b, h) + aoff + m * 2048 + k * 1024); } while (0)
#define MM_LDB(dst, b, h) do { _Pragma("unroll") for (int n = 0; n < 2; ++n) _Pragma("unroll") for (int k = 0; k < 2; ++k) dst[n][k] = *(const LAS bf16x8*)(lds + MM_SB(b, h) + boff + n * 2048 + k * 1024); } while (0)
#define MM_MMA(ai, bj, At, Bt) do { __builtin_amdgcn_s_setprio(1); _Pragma("unroll") for (int m = 0; m < 4; ++m) _Pragma("unroll") for (int n = 0; n < 2; ++n) _Pragma("unroll") for (int k = 0; k < 2; ++k) \
        acc[ai][bj][m][n] = __builtin_amdgcn_mfma_f32_16x16x32_bf16(Bt[n][k], At[m][k], acc[ai][bj][m][n], 0, 0, 0); __builtin_amdgcn_s_setprio(0); } while (0)
#define MM_WAIT_V(n) asm volatile("s_waitcnt vmcnt(" #n ")" ::: "memory")
#define MM_WAIT_L(n) asm volatile("s_waitcnt lgkmcnt(" #n ")" ::: "memory")
#define MM_BAR __builtin_amdgcn_s_barrier()
#define MM_SCHED __builtin_amdgcn_sched_barrier(0)
    Unit cur, nxt; int ui = 0;
    if (!S.next(0, cur)) return;
    unsigned oa[2][2], on[2][2];
    S.aoff(cur, R0, C0, R1, C1, oa);
    on[0][0] = oa[0][0]; on[0][1] = oa[0][1]; on[1][0] = oa[1][0]; on[1][1] = oa[1][1];
    if constexpr (Sched::TABLE) S.tab_dma(cur, lds + STAGE_BYTES + 1024, tid);
    f32x4 acc[2][2][4][2];
#pragma unroll
    for (int a = 0; a < 2; ++a)
#pragma unroll
        for (int b = 0; b < 2; ++b)
#pragma unroll
            for (int m = 0; m < 4; ++m)
#pragma unroll
                for (int n = 0; n < 2; ++n) acc[a][b][m][n] = (f32x4){0.f, 0.f, 0.f, 0.f};
    bf16x8 At[4][2], B0[2][2], B1[2][2];
    const char* cA = cur.A; const char* cB = cur.B;
    MM_STAGE_B(MM_SB(0, 0), cB); MM_STAGE_A(MM_SA(0, 0), cA, 0, oa); MM_STAGE_B(MM_SB(0, 1), cB + hstepB); MM_STAGE_A(MM_SA(0, 1), cA, 1, oa);
    if (wr == 1) MM_BAR;
    MM_WAIT_V(4); MM_BAR;
    MM_STAGE_B(MM_SB(1, 0), cB + kstep); MM_STAGE_A(MM_SA(1, 0), cA + kstep, 0, oa); MM_STAGE_B(MM_SB(1, 1), cB + hstepB + kstep);
    MM_WAIT_V(6); MM_BAR;
    for (;;) {
        cur.tb = ui % 3;
        const bool has_next = S.next(ui + 1, nxt);
        if constexpr (Sched::TABLE) { if (has_next) S.tab_dma(nxt, lds + STAGE_BYTES + 1024 + ((ui + 1) % 3) * 2048, tid); }
        const char* nA = has_next ? nxt.A : cA; const char* nB = has_next ? nxt.B : cB;
        for (int t = 0; t < nt; t += 2) {
            const bool last = (t == nt - 2);
            if constexpr (Sched::GATHER) { if (last) { if (has_next) S.aoff_lds(nxt, (const LAS int*)(lds + STAGE_BYTES + 1024 + ((ui + 1) % 3) * 2048), R0, C0, R1, C1, on);
                else { on[0][0] = oa[0][0]; on[0][1] = oa[0][1]; on[1][0] = oa[1][0]; on[1][1] = oa[1][1]; } } }
            const char* a1 = cA + (size_t)(t + 1) * kstep;
            const char* a2 = last ? nA : cA + (size_t)(t + 2) * kstep; const char* b2 = last ? nB : cB + (size_t)(t + 2) * kstep;
            const char* a3 = a2 + kstep; const char* b3 = b2 + kstep;
            unsigned o2[2][2];
            if constexpr (Sched::GATHER) { o2[0][0] = last ? on[0][0] : oa[0][0]; o2[0][1] = last ? on[0][1] : oa[0][1]; o2[1][0] = last ? on[1][0] : oa[1][0]; o2[1][1] = last ? on[1][1] : oa[1][1]; }
            else { o2[0][0] = oa[0][0]; o2[0][1] = oa[0][1]; o2[1][0] = oa[1][0]; o2[1][1] = oa[1][1]; }
            MM_LDB(B0, 0, 0); MM_SCHED; MM_LDA(At, 0, 0); MM_STAGE_A(MM_SA(1, 1), a1, 1, oa);
            MM_WAIT_L(8); MM_BAR; MM_WAIT_L(0); MM_MMA(0, 0, At, B0); MM_BAR; MM_SCHED;
            MM_LDB(B1, 0, 1); MM_STAGE_B(MM_SB(0, 0), b2);
            MM_BAR; MM_WAIT_L(0); MM_MMA(0, 1, At, B1); MM_BAR;
            MM_LDA(At, 0, 1); MM_STAGE_A(MM_SA(0, 0), a2, 0, o2);
            MM_BAR; MM_WAIT_L(0); MM_MMA(1, 0, At, B0); MM_BAR; MM_SCHED;
            MM_STAGE_B(MM_SB(0, 1), b2 + hstepB);
            MM_WAIT_V(6); MM_BAR; MM_MMA(1, 1, At, B1); MM_BAR;
            MM_LDB(B0, 1, 0); MM_SCHED; MM_LDA(At, 1, 0); MM_STAGE_A(MM_SA(0, 1), a2, 1, o2);
            MM_WAIT_L(8); MM_BAR; MM_WAIT_L(0); MM_MMA(0, 0, At, B0); MM_BAR; MM_SCHED;
            MM_LDB(B1, 1, 1); MM_STAGE_B(MM_SB(1, 0), b3);
            MM_BAR; MM_WAIT_L(0); MM_MMA(0, 1, At, B1); MM_BAR;
            MM_LDA(At, 1, 1); MM_STAGE_A(MM_SA(1, 0), a3, 0, o2);
            MM_BAR; MM_WAIT_L(0); MM_MMA(1, 0, At, B0); MM_BAR; MM_SCHED;
            MM_STAGE_B(MM_SB(1, 1), b3 + hstepB);
            MM_WAIT_V(6); MM_BAR; MM_MMA(1, 1, At, B1); MM_BAR;
        }
        {
          int tz = tid; asm volatile("" : "+v"(tz)); const int wz = tz >> 6, lz = tz & 63;
          E(acc, cur, wz >> 2, wz & 3, lz & 15, lz >> 4); }
        if (!has_next) break;
#pragma unroll
        for (int a = 0; a < 2; ++a)
#pragma unroll
            for (int b = 0; b < 2; ++b)
#pragma unroll
                for (int m = 0; m < 4; ++m)
#pragma unroll
                    for (int n = 0; n < 2; ++n) acc[a][b][m][n] = (f32x4){0.f, 0.f, 0.f, 0.f};
        cur = nxt; cA = nA; cB = nB; ++ui;
        if constexpr (Sched::GATHER) { oa[0][0] = on[0][0]; oa[0][1] = on[0][1]; oa[1][0] = on[1][0]; oa[1][1] = on[1][1]; }
    }
    MM_WAIT_V(0);
    if (wr == 0) MM_BAR;
    MM_BAR;
#undef MM_SA
#undef MM_SB
#undef MM_STAGE_A
#undef MM_STAGE_B
#undef MM_LDA
#undef MM_LDB
#undef MM_MMA
#undef MM_WAIT_V
#undef MM_WAIT_L
#undef MM_BAR
#undef MM_SCHED
}
struct StaticSched {
    static constexpr bool GATHER = false, TABLE = false;
    const char* A; const char* Bt; int lda, K, nM, nN, nwg, G, c;
    DI size_t hstep_a() const { return (size_t)HALF * lda * 2; }
    DI unsigned boff(int Rb, int C, int Kk) const { return (unsigned)(Rb * Kk + C) * 2u; }
    DI size_t hstep_b(int Kk) const { return (size_t)HALF * Kk * 2; }
    DI void init(const void* A_, const void* Bt_, int M, int N, int K_, int lda_, int G_, int c_) { A = (const char*)A_; Bt = (const char*)Bt_; lda = lda_; K = K_; nM = M / BM; nN = N / BM; nwg = nM * nN; G = G_; c = c_; }
    DI bool next(int i, Unit& u) const {
        const int L = i * G + c; if (L >= nwg) return false;
        int wgid = L; { const int q = nwg / 8, r = nwg % 8, xcd = wgid % 8, off = wgid / 8; wgid = (xcd < r ? xcd * (q + 1) : r * (q + 1) + (xcd - r) * q) + off; }
        const int nig = 8 * nN, gid = wgid / nig, fm = gid * 8, gsz = (nM - fm) < 8 ? (nM - fm) : 8;
        u.pm = fm + ((wgid % nig) % gsz); u.pn = (wgid % nig) / gsz; u.e = 0; u.m = 0;
        u.A = A + (size_t)u.pm * BM * lda * 2; u.B = Bt + (size_t)u.pn * BM * K * 2; return true;
    }
    DI void aoff(const Unit&, int R0, int C0, int R1, int C1, unsigned (&o)[2][2]) const {
        o[0][0] = (unsigned)(R0 * lda + C0) * 2u; o[0][1] = (unsigned)(R1 * lda + C1) * 2u;
        o[1][0] = (unsigned)((HALF + R0) * lda + C0) * 2u; o[1][1] = (unsigned)((HALF + R1) * lda + C1) * 2u;
    }
};
struct BatchSched {
    static constexpr bool GATHER = false, TABLE = false;
    const char* A; const char* Bt; int K, nM, nN, nb, G, c; size_t bstride;
    DI size_t hstep_a() const { return (size_t)HALF * K * 2; }
    DI unsigned boff(int Rb, int C, int Kk) const { return (unsigned)(Rb * Kk + C) * 2u; }
    DI size_t hstep_b(int Kk) const { return (size_t)HALF * Kk * 2; }
    DI void init(const void* A_, const void* Bt_, size_t bstride_bytes, int nb_, int M, int N, int K_, int G_, int c_) { A = (const char*)A_; Bt = (const char*)Bt_; bstride = bstride_bytes; nb = nb_; K = K_; nM = M / BM; nN = N / BM; G = G_; c = c_; }
    DI bool next(int i, Unit& u) const {
        const int L = i * G + c; if (L >= nb * nM * nN) return false;
        const int b = L / (nM * nN), rem = L % (nM * nN); u.pm = rem / nN; u.pn = rem % nN; u.e = b; u.m = 0;
        u.A = A + (size_t)u.pm * BM * K * 2; u.B = Bt + (size_t)b * bstride + (size_t)u.pn * BM * K * 2; return true;
    }
    DI void aoff(const Unit&, int R0, int C0, int R1, int C1, unsigned (&o)[2][2]) const {
        o[0][0] = (unsigned)(R0 * K + C0) * 2u; o[0][1] = (unsigned)(R1 * K + C1) * 2u;
        o[1][0] = (unsigned)((HALF + R0) * K + C0) * 2u; o[1][1] = (unsigned)((HALF + R1) * K + C1) * 2u;
    }
};
struct EpiBf16Store {
    static constexpr bool PERM = true;
    bf16_t* O0; int ldc; size_t bstr = 0;
    DI void operator()(const f32x4 (&acc)[2][2][4][2], const Unit& u, int wr, int wc, int fr, int fq) const {
        bf16_t* O = O0 + (size_t)u.e * bstr;
        const int row0 = u.pm * BM + wr * 64 + fr, col0 = u.pn * BM + wc * 32 + 8 * fq;
#pragma unroll
        for (int ai = 0; ai < 2; ++ai)
#pragma unroll
            for (int m = 0; m < 4; ++m) { bf16_t* rowp = O + (size_t)(row0 + ai * HALF + m * 16) * ldc + col0;
#pragma unroll
                for (int bj = 0; bj < 2; ++bj) { const f32x4 v0 = acc[ai][bj][m][0], v1 = acc[ai][bj][m][1];
                    u32x4 w; w.x = cvt_pk_bf16(v0[0], v0[1]); w.y = cvt_pk_bf16(v0[2], v0[3]); w.z = cvt_pk_bf16(v1[0], v1[1]); w.w = cvt_pk_bf16(v1[2], v1[3]);
                    *(u32x4*)(rowp + bj * HALF) = w; } }
    }
};
struct EpiResid {
    static constexpr bool PERM = false;
    const float* xin_lat; const float* xin_ctx; float* out_lat; float* out_ctx; const float* modl; int batched_T;
    DI void operator()(const f32x4 (&acc)[2][2][4][2], const Unit& u, int wr, int wc, int fr, int fq) const {
        int grow0; if (batched_T == 0) grow0 = u.pm * BM; else if (batched_T > 0) grow0 = u.e * 2048 + u.pm * BM; else grow0 = NLAT + u.e * 256 + u.pm * BM;
        const bool lat = grow0 < NLAT; const int jj = lat ? (grow0 >> 11) : 16;
        const float* xi = lat ? xin_lat + (size_t)grow0 * 1024 : xin_ctx + (size_t)(grow0 - NLAT) * 1024;
        float* xo = lat ? out_lat + (size_t)grow0 * 1024 : out_ctx + (size_t)(grow0 - NLAT) * 1024;
        const float* g1 = modl + (size_t)jj * 6144 + 2 * 1024;
        const int r0 = wr * 64 + fr, col0 = u.pn * BM + wc * 32 + 4 * fq;
        f32x4 gv[2][2];
#pragma unroll
        for (int bj = 0; bj < 2; ++bj)
#pragma unroll
            for (int n = 0; n < 2; ++n) gv[bj][n] = *(const f32x4*)(g1 + col0 + bj * HALF + n * 16);
#pragma unroll
        for (int ai = 0; ai < 2; ++ai) {
            f32x4 xv[4][2][2];
#pragma unroll
            for (int m = 0; m < 4; ++m)
#pragma unroll
                for (int bj = 0; bj < 2; ++bj)
#pragma unroll
                    for (int n = 0; n < 2; ++n) xv[m][bj][n] = *(const f32x4*)(xi + (size_t)(r0 + ai * HALF + m * 16) * 1024 + col0 + bj * HALF + n * 16);
#pragma unroll
            for (int m = 0; m < 4; ++m)
#pragma unroll
                for (int bj = 0; bj < 2; ++bj)
#pragma unroll
                    for (int n = 0; n < 2; ++n) *(f32x4*)(xo + (size_t)(r0 + ai * HALF + m * 16) * 1024 + col0 + bj * HALF + n * 16) = xv[m][bj][n] + gv[bj][n] * acc[ai][bj][m][n];
            asm volatile("" ::: "memory");
        }
    }
};
struct EpiResidB {
    static constexpr bool PERM = true;
    const void* xin_lat; const void* xin_ctx; bf16_t* out_lat; bf16_t* out_ctx; const float* modl; int batched_T; int in_f32;
    DI void operator()(const f32x4 (&acc)[2][2][4][2], const Unit& u, int wr, int wc, int fr, int fq) const {
        int grow0; if (batched_T == 0) grow0 = u.pm * BM; else if (batched_T > 0) grow0 = u.e * 2048 + u.pm * BM; else grow0 = NLAT + u.e * 256 + u.pm * BM;
        const bool lat = grow0 < NLAT; const int jj = lat ? (grow0 >> 11) : 16; const size_t rb = lat ? (size_t)grow0 : (size_t)(grow0 - NLAT);
        const float* g1 = modl + (size_t)jj * 6144 + 2 * 1024;
        bf16_t* xo = (lat ? out_lat : out_ctx) + rb * 1024;
        const int r0 = wr * 64 + fr, col0 = u.pn * BM + wc * 32 + 8 * fq;
        f32x4 gv[2][2];
#pragma unroll
        for (int bj = 0; bj < 2; ++bj)
#pragma unroll
            for (int n = 0; n < 2; ++n) gv[bj][n] = *(const f32x4*)(g1 + col0 + bj * HALF + 4 * n);
        if (in_f32) {
            const float* xi = (const float*)(lat ? xin_lat : xin_ctx) + rb * 1024;
#pragma unroll
            for (int ai = 0; ai < 2; ++ai)
#pragma unroll
                for (int mp = 0; mp < 2; ++mp) {
                    f32x4 xv[2][2][2];
#pragma unroll
                    for (int mm_ = 0; mm_ < 2; ++mm_)
#pragma unroll
                        for (int bj = 0; bj < 2; ++bj)
#pragma unroll
                            for (int n = 0; n < 2; ++n) xv[mm_][bj][n] = *(const f32x4*)(xi + (size_t)(r0 + ai * HALF + (2 * mp + mm_) * 16) * 1024 + col0 + bj * HALF + 4 * n);
#pragma unroll
                    for (int mm_ = 0; mm_ < 2; ++mm_)
#pragma unroll
                        for (int bj = 0; bj < 2; ++bj) { const int m = 2 * mp + mm_; const f32x4 o0 = xv[mm_][bj][0] + gv[bj][0] * acc[ai][bj][m][0], o1 = xv[mm_][bj][1] + gv[bj][1] * acc[ai][bj][m][1];
                            u32x4 w; w.x = att_pk(o0[0], o0[1]); w.y = att_pk(o0[2], o0[3]); w.z = att_pk(o1[0], o1[1]); w.w = att_pk(o1[2], o1[3]);
                            *(u32x4*)(xo + (size_t)(r0 + ai * HALF + m * 16) * 1024 + col0 + bj * HALF) = w; }
                    asm volatile("" ::: "memory");
                }
        } else {
            const bf16_t* xi = (const bf16_t*)(lat ? xin_lat : xin_ctx) + rb * 1024;
#pragma unroll
            for (int ai = 0; ai < 2; ++ai) {
                u32x4 xv[4][2];
#pragma unroll
                for (int m = 0; m < 4; ++m)
#pragma unroll
                    for (int bj = 0; bj < 2; ++bj) xv[m][bj] = *(const u32x4*)(xi + (size_t)(r0 + ai * HALF + m * 16) * 1024 + col0 + bj * HALF);
#pragma unroll
                for (int m = 0; m < 4; ++m)
#pragma unroll
                    for (int bj = 0; bj < 2; ++bj) { const u32x4 x = xv[m][bj];
                        const f32x4 x0 = {__uint_as_float(x.x << 16), __uint_as_float(x.x & 0xffff0000u), __uint_as_float(x.y << 16), __uint_as_float(x.y & 0xffff0000u)};
                        const f32x4 x1 = {__uint_as_float(x.z << 16), __uint_as_float(x.z & 0xffff0000u), __uint_as_float(x.w << 16), __uint_as_float(x.w & 0xffff0000u)};
                        const f32x4 o0 = x0 + gv[bj][0] * acc[ai][bj][m][0], o1 = x1 + gv[bj][1] * acc[ai][bj][m][1];
                        u32x4 w; w.x = att_pk(o0[0], o0[1]); w.y = att_pk(o0[2], o0[3]); w.z = att_pk(o1[0], o1[1]); w.w = att_pk(o1[2], o1[3]);
                        *(u32x4*)(xo + (size_t)(r0 + ai * HALF + m * 16) * 1024 + col0 + bj * HALF) = w; }
                asm volatile("" ::: "memory");
            }
        }
    }
};
}

DI void tconv_tile(const Ctx& cx, float* T, const float* src, int ld_src, int k0, int n0, int kvalid, int nvalid, bf16_t* dst, int ldd, int drow0) {
    const int tid = cx.tid;
#pragma unroll
    for (int rr = 0; rr < 2; ++rr) {
        const int i = (tid >> 4) + 32 * rr, j = (tid & 15) * 4;
        float4 v = make_float4(0.f, 0.f, 0.f, 0.f);
        if (k0 + i < kvalid && n0 + j < nvalid) v = *(const float4*)(src + (size_t)(k0 + i) * ld_src + n0 + j);
        T[i * 65 + j] = v.x; T[i * 65 + j + 1] = v.y; T[i * 65 + j + 2] = v.z; T[i * 65 + j + 3] = v.w;
    }
    __syncthreads();
    { const int j = tid >> 3, ch = tid & 7; uint4 o;
      o.x = pack2(T[(ch * 8 + 0) * 65 + j], T[(ch * 8 + 1) * 65 + j]); o.y = pack2(T[(ch * 8 + 2) * 65 + j], T[(ch * 8 + 3) * 65 + j]);
      o.z = pack2(T[(ch * 8 + 4) * 65 + j], T[(ch * 8 + 5) * 65 + j]); o.w = pack2(T[(ch * 8 + 6) * 65 + j], T[(ch * 8 + 7) * 65 + j]);
      *(uint4*)(dst + (size_t)(drow0 + j) * ldd + k0 + ch * 8) = o; }
    __syncthreads();
}
DI void ph_prep_weights(const Ctx& cx, const Params& p, float* lds) {
    const int tid = cx.tid, gtid = cx.bid * NTHR + tid, gsz = cx.nblk * NTHR;
    const int tb0 = (cx.nblk >= 256) ? cx.bid - 128 : cx.bid, tbs = (cx.nblk >= 256) ? 128 : cx.nblk;
    for (int it = tb0; it < 2 * 1008 && tb0 >= 0; it += tbs) {
        const int j = it / 1008; int r = it % 1008;
        if (r < 640) { const int kt = r / 40, ntl = r % 40; tconv_tile(cx, lds, p.w_in + (size_t)j * 1024 * INC, INC, kt * 64, ntl * 64, 1024, INC, p.WinT + (size_t)j * 2560 * 1024, 1024, ntl * 64); continue; } r -= 640;
        if (r < 48) { const int kt = r / 12, ntl = r % 12; tconv_tile(cx, lds, p.b_w_q_up + (size_t)j * 256 * 768, 768, kt * 64, ntl * 64, 256, 768, p.WqT + (size_t)j * 768 * 256, 256, ntl * 64); continue; } r -= 48;
        if (r < 64) { const int kt = r / 16, ntl = r % 16; tconv_tile(cx, lds, p.b_w_kv_up + (size_t)j * 128 * 1024, 1024, kt * 64, ntl * 64, 128, 1024, p.WkvT + (size_t)j * 1024 * 256, 256, ntl * 64); continue; } r -= 64;
        { const int kt = r / 16, ntl = r % 16; tconv_tile(cx, lds, p.w_out_even + (size_t)j * 1024 * 1024, 1024, kt * 64, ntl * 64, 1024, 1024, p.WoutT + (size_t)j * 1024 * 1024, 1024, ntl * 64); }
    }
    for (int idx = gtid; idx < 2 * 2560 * 384; idx += gsz) {
        const int j = idx / (2560 * 384), rem = idx % (2560 * 384), n = rem / 384, k = rem % 384; const int seg = n >> 9, nn = n & 511;
        float v = 0.f;
        if (seg < 2) { if ((k >> 6) == seg) v = p.a_w2[((size_t)(j * 2 + seg) * 64 + (k & 63)) * 512 + nn]; }
        else if (seg < 4) { if ((k >> 6) == seg) v = p.a_a2[((size_t)(j * 2 + seg - 2) * 64 + (k & 63)) * 512 + nn]; }
        else { if (k >= 256) v = p.a_g2[((size_t)j * 128 + (k - 256)) * 512 + nn]; }
        p.WlrT[idx] = f2bf(v);
    }
    {
        float* Tc = lds; float* Ts = lds + 64 * 65; float* tab = lds + 2 * 64 * 65;
        for (int i = tid; i < 128; i += NTHR) { tab[i] = cospif((float)i * (1.f / 64.f)); tab[128 + i] = sinpif((float)i * (1.f / 64.f)); }
        __syncthreads();
        for (int it = cx.bid; it < 2 * 256; it += cx.nblk) {
            const int j = it >> 8, ct = (it >> 4) & 15, et = it & 15; const float* Wf = p.w_out_fourier + (size_t)j * 1024 * 1024;
            const int el = tid & 63, e = et * 64 + el;
#pragma unroll 1
            for (int i = 0; i < 8; ++i) {
                const int chl = (tid >> 6) + 8 * i, ch = ct * 64 + chl, grp = ch >> 7, c = ch & 127;
                float sc = 0.f, ss = 0.f;
                for (int g0 = 0; g0 < 128; g0 += 16) {
                    float wv[16];
#pragma unroll
                    for (int q = 0; q < 16; ++q) wv[q] = Wf[(size_t)(grp * 128 + g0 + q) * 1024 + e];
#pragma unroll
                    for (int q = 0; q < 16; ++q) { const int m = (c * (g0 + q)) & 127; sc += tab[m] * wv[q]; ss += tab[128 + m] * wv[q]; }
                }
                Tc[chl * 65 + el] = sc; Ts[chl * 65 + el] = ss;
            }
            __syncthreads();
            { const int el2 = tid >> 3, chunk = tid & 7; uint4 o, o2; const float* a = Tc + chunk * 8 * 65 + el2; const float* b = Ts + chunk * 8 * 65 + el2;
              o.x = pack2(a[0], a[65]); o.y = pack2(a[2 * 65], a[3 * 65]); o.z = pack2(a[4 * 65], a[5 * 65]); o.w = pack2(a[6 * 65], a[7 * 65]);
              o2.x = pack2(b[0], b[65]); o2.y = pack2(b[2 * 65], b[3 * 65]); o2.z = pack2(b[4 * 65], b[5 * 65]); o2.w = pack2(b[6 * 65], b[7 * 65]);
              bf16_t* d = p.A1 + (size_t)j * 2048 * 1024 + (size_t)(et * 64 + el2) * 1024 + ct * 64 + chunk * 8;
              *(uint4*)d = o; *(uint4*)(d + (size_t)1024 * 1024) = o2; }
            __syncthreads();
        }
    }
    for (int i = gtid; i < 256 * 256; i += gsz) {
        const int m = i >> 8, k = i & 255, f1 = m & 127, t1 = k & 127; const float a = (float)((f1 * t1) & 127) * (1.f / 64.f); const float cs = cospif(a), sn = sinpif(a);
        const float v = (m < 128) ? ((k < 128) ? cs : -sn) : ((k < 128) ? -sn : -cs);
        p.M1[i] = f2bf(v);
    }
    if (OPT < 12) for (int i = gtid; i < 2048 * 4096; i += gsz) {
        const int f = i >> 12, k = i & 4095, t = k & 2047, m = (f * t) & 2047; const float a = (float)m * (1.f / 1024.f);
        p.A2[i] = f2bf(((k < 2048) ? cospif(a) : -sinpif(a)) * (1.f / 512.f));
    }
    if (OPT < 12) for (int i = gtid; i < 256 * 512; i += gsz) {
        const int f = i >> 9, k = i & 511, t = k & 255, m = (f * t) & 255; const float a = (float)m * (1.f / 128.f);
        p.A2c[i] = f2bf(((k < 256) ? cospif(a) : -sinpif(a)) * 0.0055242717280199f);
    }
    __syncthreads();
}
DI void ph_prep_moe(const Ctx& cx, const Params& p, float* lds, int layer) {
    const int tid = cx.tid; constexpr int TP = 513;
    for (int s = cx.bid; s < 17 * 48; s += cx.nblk) {
        const int e = s / 48, r = s % 48;
        const float* src; int ld_src, kt, ldd; bf16_t* dst; int bj = 0, nh = 0; const bool gu = r < 32;
        if (gu) { bj = r >> 4; kt = r & 15; ld_src = 512; ldd = 1024;
            src = (bj ? ((e < 16) ? p.moe_w_up + ((size_t)layer * 16 + e) * 1024 * 512 : p.sh_up + (size_t)layer * 1024 * 512)
                      : ((e < 16) ? p.moe_w_gate + ((size_t)layer * 16 + e) * 1024 * 512 : p.sh_gate + (size_t)layer * 1024 * 512)) + (size_t)kt * 64 * 512;
            dst = p.WguT + (size_t)e * 1024 * 1024; }
        else { const int r2 = r - 32; kt = r2 >> 1; nh = r2 & 1; ld_src = 1024; ldd = 512;
            src = ((e < 16) ? p.moe_w_down + ((size_t)layer * 16 + e) * 512 * 1024 : p.sh_down + (size_t)layer * 512 * 1024) + (size_t)kt * 64 * 1024 + nh * 512;
            dst = p.WdT + (size_t)e * 1024 * 512; }
        float4 v[16];
#pragma unroll
        for (int i = 0; i < 16; ++i) v[i] = *(const float4*)(src + (size_t)((tid >> 7) + 4 * i) * ld_src + (tid & 127) * 4);
        __syncthreads();
#pragma unroll
        for (int i = 0; i < 16; ++i) { float* t = lds + ((tid >> 7) + 4 * i) * TP + (tid & 127) * 4; t[0] = v[i].x; t[1] = v[i].y; t[2] = v[i].z; t[3] = v[i].w; }
        __syncthreads();
#pragma unroll
        for (int it = 0; it < 8; ++it) {
            const int n = (tid >> 3) + 64 * it, ch = tid & 7; const float* t = lds + (ch * 8) * TP + n;
            uint4 o; o.x = att_pk(t[0], t[TP]); o.y = att_pk(t[2 * TP], t[3 * TP]); o.z = att_pk(t[4 * TP], t[5 * TP]); o.w = att_pk(t[6 * TP], t[7 * TP]);
            const int drow = gu ? ((n >> 7) * 256 + bj * 128 + (n & 127)) : (nh * 512 + n);
            *(uint4*)(dst + (size_t)drow * ldd + kt * 64 + ch * 8) = o;
        }
    }
    __syncthreads();
}

#define GEMM_LDS(lds) ((LAS unsigned char*)(lds))
DI void ph_win_mm(const Ctx& cx, const Params& p, float* lds, int j) {
    mm::StaticSched S; S.init(p.H, p.WinT + (size_t)j * 2560 * 1024, NT, 2560, 1024, 1024, cx.nblk, cx.bid);
    mm::EpiBf16Store E{p.P, PLD};
    mm::gemm_phase(GEMM_LDS(lds), 1024, S, E, cx.tid);
}
struct EpiNone { static constexpr bool PERM = true; DI void operator()(const mm::f32x4 (&acc)[2][2][4][2], const mm::Unit&, int, int, int, int) const {
#pragma unroll
    for (int ai = 0; ai < 2; ++ai)
#pragma unroll
        for (int bj = 0; bj < 2; ++bj)
#pragma unroll
            for (int m = 0; m < 4; ++m) asm volatile("" :: "v"(acc[ai][bj][m][0]), "v"(acc[ai][bj][m][1]));
} };
DI void ph_win_probe(const Ctx& cx, const Params& p, float* lds, int j) {
    mm::StaticSched S; S.init(p.H, p.WinT + (size_t)j * 2560 * 1024, NT, 2560, 1024, 1024, cx.nblk, cx.bid);
    if (PROBE_GEMM == 1) { mm::EpiBf16Store E{p.WAG, PLD}; mm::gemm_phase(GEMM_LDS(lds), 1024, S, E, cx.tid); }
    else { EpiNone E; mm::gemm_phase(GEMM_LDS(lds), 1024, S, E, cx.tid); }
}
DI void ph_wout_mmB(const Ctx& cx, const Params& p, float* lds, const bf16_t* A, const bf16_t* Bt, int nrows, const void* xin_lat, const void* xin_ctx, bf16_t* xo_lat, int in_f32, const float* modl) {
    mm::StaticSched S; S.init(A, Bt, nrows, 1024, 1024, 1024, cx.nblk, cx.bid);
    mm::EpiResidB E{xin_lat, xin_ctx, xo_lat, p.cs, modl, 0, in_f32};
    mm::gemm_phase(GEMM_LDS(lds), 1024, S, E, cx.tid);
}
DI void ph_wout_mm(const Ctx& cx, const Params& p, float* lds, const bf16_t* A, const bf16_t* Bt, int nrows, const float* xin_lat, const float* xin_ctx, const float* modl) {
    mm::StaticSched S; S.init(A, Bt, nrows, 1024, 1024, 1024, cx.nblk, cx.bid);
    mm::EpiResid E{xin_lat, xin_ctx, p.out, p.ctxs, modl, 0};
    mm::gemm_phase(GEMM_LDS(lds), 1024, S, E, cx.tid);
}

DI void ph_qkvup_mm(const Ctx& cx, const Params& p, float* lds, int j, int mq) {
    { mm::StaticSched S; S.init(p.QN, p.WqT + (size_t)j * 768 * 256, mq, 768, 256, 512, cx.nblk, cx.bid); mm::EpiBf16Store E{p.Qraw, 768}; mm::gemm_phase(GEMM_LDS(lds), 256, S, E, cx.tid); }
    { mm::StaticSched S; S.init(p.QN + 256, p.WkvT + (size_t)j * 1024 * 256, NT, 1024, 256, 512, cx.nblk, cx.bid); mm::EpiBf16Store E{p.KVraw, 1024}; mm::gemm_phase(GEMM_LDS(lds), 256, S, E, cx.tid); }
}
struct EpiWag {
    static constexpr bool PERM = true;
    bf16_t* O; const LAS float* bias;
    DI void operator()(const mm::f32x4 (&acc)[2][2][4][2], const mm::Unit& u, int wr, int wc, int fr, int fq) const {
        const int row0 = u.pm * 256 + wr * 64 + fr, col0 = u.pn * 256 + wc * 32 + 8 * fq; const int seg = u.pn >> 2;
        const LAS float* bp = bias + col0;
#pragma unroll
        for (int bj = 0; bj < 2; ++bj) {
            mm::f32x4 b0 = (mm::f32x4){0.f, 0.f, 0.f, 0.f}, b1 = b0;
            if (seg < 2) { b0 = *(const LAS mm::f32x4*)(bp + bj * 128); b1 = *(const LAS mm::f32x4*)(bp + bj * 128 + 4); }
#pragma unroll
            for (int ai = 0; ai < 2; ++ai)
#pragma unroll
                for (int m = 0; m < 4; ++m) {
                    mm::f32x4 v0 = acc[ai][bj][m][0] + b0, v1 = acc[ai][bj][m][1] + b1;
                    if (seg == 0) {
#pragma unroll
                        for (int c = 0; c < 4; ++c) { v0[c] = 1.f - __expf(-0.606531f * __builtin_amdgcn_rcpf(1.f + __expf(-v0[c]))); v1[c] = 1.f - __expf(-0.606531f * __builtin_amdgcn_rcpf(1.f + __expf(-v1[c]))); }
                    } else if (seg == 1) {
#pragma unroll
                        for (int c = 0; c < 4; ++c) { v0[c] = __builtin_amdgcn_rcpf(1.f + __expf(-v0[c])); v1[c] = __builtin_amdgcn_rcpf(1.f + __expf(-v1[c])); }
                    }
                    mm::u32x4 w; w.x = mm::cvt_pk_bf16(v0[0], v0[1]); w.y = mm::cvt_pk_bf16(v0[2], v0[3]); w.z = mm::cvt_pk_bf16(v1[0], v1[1]); w.w = mm::cvt_pk_bf16(v1[2], v1[3]);
                    *(mm::u32x4*)(O + (size_t)(row0 + ai * 128 + m * 16) * WLD + col0 + bj * 128) = w;
                }
        }
    }
};
DI void ph_wag_mm(const Ctx& cx, const Params& p, float* lds, int j) {
    mm::StaticSched S; S.init(p.LR, p.WlrT + (size_t)j * 2560 * 384, NT, 2560, 384, 384, cx.nblk, cx.bid);
    LAS float* bl = (LAS float*)lds + 32768 + 256 + 1024;
    for (int i = cx.tid; i < 2048; i += NTHR) bl[i] = (i < 1024) ? p.a_w0[j * 1024 + i] : p.a_a0[j * 1024 + i - 1024];
    __syncthreads();
    EpiWag E{p.WAG, bl};
    mm::gemm_phase(GEMM_LDS(lds), 384, S, E, cx.tid);
}
struct EpiZT {
    static constexpr bool PERM = true;
    bf16_t* Z; int T;
    DI void operator()(const mm::f32x4 (&acc)[2][2][4][2], const mm::Unit& u, int wr, int wc, int fr, int fq) const {
        const int b = (T == 2048) ? (u.pn >> 3) : u.pn, t0 = (T == 2048) ? ((u.pn & 7) * 256) : 0;
        const int m0 = u.pm * 256 + wr * 64 + fr; const int c0 = t0 + wc * 32 + 8 * fq;
#pragma unroll
        for (int ai = 0; ai < 2; ++ai)
#pragma unroll
            for (int m = 0; m < 4; ++m) { const int mr = m0 + ai * 128 + m * 16, part = mr >> 10, ch = mr & 1023;
                bf16_t* rowp = Z + ((size_t)(b * 1024 + ch) * 2 + part) * T + c0;
#pragma unroll
                for (int bj = 0; bj < 2; ++bj) { const mm::f32x4 v0 = acc[ai][bj][m][0], v1 = acc[ai][bj][m][1];
                    mm::u32x4 w; w.x = mm::cvt_pk_bf16(v0[0], v0[1]); w.y = mm::cvt_pk_bf16(v0[2], v0[3]); w.z = mm::cvt_pk_bf16(v1[0], v1[1]); w.w = mm::cvt_pk_bf16(v1[2], v1[3]);
                    *(mm::u32x4*)(rowp + bj * 128) = w; } }
    }
};
DI void ph_f1_mm(const Ctx& cx, const Params& p, float* lds, int j, bool with_ctx) {
    { mm::StaticSched S; S.init(p.A1 + (size_t)j * 2048 * 1024, p.H, 2048, NLAT, 1024, 1024, cx.nblk, cx.bid); EpiZT E{p.ZT, 2048}; mm::gemm_phase(GEMM_LDS(lds), 1024, S, E, cx.tid); }
    if (with_ctx) { mm::StaticSched S; S.init(p.A1 + (size_t)j * 2048 * 1024, p.H + (size_t)NLAT * 1024, 2048, NCTX, 1024, 1024, cx.nblk, cx.bid); EpiZT E{p.ZTC, 256}; mm::gemm_phase(GEMM_LDS(lds), 1024, S, E, cx.tid); }
}
DI void ph_f2_mmB(const Ctx& cx, const Params& p, float* lds, bool with_ctx, const void* xin_lat, const void* xin_ctx, bf16_t* xo_lat, const float* modl) {
    { mm::BatchSched S; S.init(p.A2, p.ZT, (size_t)1024 * 4096 * 2, 16, 2048, 1024, 4096, cx.nblk, cx.bid); mm::EpiResidB E{xin_lat, xin_ctx, xo_lat, p.cs, modl, 1, 0}; mm::gemm_phase(GEMM_LDS(lds), 4096, S, E, cx.tid); }
    if (with_ctx) { mm::BatchSched S; S.init(p.A2c, p.ZTC, (size_t)1024 * 512 * 2, 16, 256, 1024, 512, cx.nblk, cx.bid); mm::EpiResidB E{xin_lat, xin_ctx, xo_lat, p.cs, modl, -1, 0}; mm::gemm_phase(GEMM_LDS(lds), 512, S, E, cx.tid); }
}
DI void ph_f2_mm(const Ctx& cx, const Params& p, float* lds, bool with_ctx, const float* xin_lat, const float* xin_ctx, const float* modl) {
    { mm::BatchSched S; S.init(p.A2, p.ZT, (size_t)1024 * 4096 * 2, 16, 2048, 1024, 4096, cx.nblk, cx.bid); mm::EpiResid E{xin_lat, xin_ctx, p.out, p.ctxs, modl, 1}; mm::gemm_phase(GEMM_LDS(lds), 4096, S, E, cx.tid); }
    if (with_ctx) { mm::BatchSched S; S.init(p.A2c, p.ZTC, (size_t)1024 * 512 * 2, 16, 256, 1024, 512, cx.nblk, cx.bid); mm::EpiResid E{xin_lat, xin_ctx, p.out, p.ctxs, modl, -1}; mm::gemm_phase(GEMM_LDS(lds), 512, S, E, cx.tid); }
}
struct MoeSched {
    static constexpr bool GATHER = true, TABLE = true;
    const char* A; const char* Bt; const int* slot; const float* slotw; const int* tab; int lda, K, G, c, down;
    DI void tab_dma(const mm::Unit& u, LAS unsigned char* dst, int tid) const {
        const int Me = __builtin_amdgcn_readfirstlane(tab[32 + u.e]); const int r = tid & 255; int idx = u.m * 256 + r; idx = idx < Me ? idx : 0;
        const size_t off = (u.e < 16) ? (size_t)u.e * NT + idx : 0;
        const unsigned* src = (tid < 256) ? (const unsigned*)(slot + off) : (const unsigned*)(slotw + off);
        __builtin_amdgcn_global_load_lds(src, (LAS unsigned*)(dst + (tid >> 6) * 256), 4, 0, 0);
    }
    DI size_t hstep_a() const { return 0; }
    DI unsigned boff(int Rb, int C, int Kk) const { return (unsigned)(Rb * Kk + C) * 2u; }
    DI size_t hstep_b(int Kk) const { return (size_t)mm::HALF * Kk * 2; }
    DI bool next(int i, mm::Unit& u) const {
        const int L = i * G + c; const int total = __builtin_amdgcn_readfirstlane(tab[17]);
        if (L >= total * 4) return false;
        const int rtg = L >> 2; int e = 0;
        for (int q = 1; q < 17; ++q) e += (__builtin_amdgcn_readfirstlane(tab[q]) <= rtg) ? 1 : 0;
        u.e = e; u.m = rtg - __builtin_amdgcn_readfirstlane(tab[e]); u.pm = u.m; u.pn = L & 3;
        u.A = A; u.B = Bt + ((size_t)e * 1024 + (size_t)u.pn * 256) * K * 2; return true;
    }
    DI unsigned rowoff(const mm::Unit& u, int Me, int idx, int C) const {
        int row;
        if (u.e < 16) { const int s = (idx < Me) ? slot[(size_t)u.e * NT + idx] : 0; row = down ? ((s & 1) * NT + (s >> 1)) : (s >> 1); }
        else row = down ? (2 * NT + idx) : idx;
        return (unsigned)(row * lda + C) * 2u;
    }
    DI unsigned rowoff_s(const mm::Unit& u, int s, int r, int C) const { int row; if (u.e < 16) row = down ? ((s & 1) * NT + (s >> 1)) : (s >> 1); else row = down ? (2 * NT + u.m * 256 + r) : (u.m * 256 + r); return (unsigned)(row * lda + C) * 2u; }
    DI void aoff_lds(const mm::Unit& u, const LAS int* et, int R0, int C0, int R1, int C1, unsigned (&o)[2][2]) const {
        o[0][0] = rowoff_s(u, et[R0], R0, C0); o[0][1] = rowoff_s(u, et[R1], R1, C1); o[1][0] = rowoff_s(u, et[128 + R0], 128 + R0, C0); o[1][1] = rowoff_s(u, et[128 + R1], 128 + R1, C1);
    }
    DI void aoff(const mm::Unit& u, int R0, int C0, int R1, int C1, unsigned (&o)[2][2]) const {
        const int Me = __builtin_amdgcn_readfirstlane(tab[32 + u.e]), base = u.m * 256;
        o[0][0] = rowoff(u, Me, base + R0, C0); o[0][1] = rowoff(u, Me, base + R1, C1);
        o[1][0] = rowoff(u, Me, base + 128 + R0, C0); o[1][1] = rowoff(u, Me, base + 128 + R1, C1);
    }
};
DI void moe_table(const Ctx& cx, const Params& p, int* tab, int layer, int nrows) {
    if (cx.tid == 0) { int acc = 0;
        for (int e = 0; e < 17; ++e) { const int M = (e < 16) ? p.cnt[(layer * 16 + e) * 64] : nrows; tab[e] = acc; tab[32 + e] = M; acc += (M + 255) >> 8; }
        tab[17] = acc; }
    __syncthreads();
}
DI void lds_read8(const LAS int* base, int r0, int (&o)[8]) {
    const unsigned a = (unsigned)(size_t)(base + r0);
    asm volatile("ds_read_b32 %0, %8\n\tds_read_b32 %1, %8 offset:64\n\tds_read_b32 %2, %8 offset:128\n\tds_read_b32 %3, %8 offset:192\n\t"
                 "ds_read_b32 %4, %8 offset:512\n\tds_read_b32 %5, %8 offset:576\n\tds_read_b32 %6, %8 offset:640\n\tds_read_b32 %7, %8 offset:704\n\ts_waitcnt lgkmcnt(0)"
                 : "=&v"(o[0]), "=&v"(o[1]), "=&v"(o[2]), "=&v"(o[3]), "=&v"(o[4]), "=&v"(o[5]), "=&v"(o[6]), "=&v"(o[7]) : "v"(a) : "memory");
}
struct EpiSwiglu {
    static constexpr bool PERM = true;
    bf16_t* ACT; const int* slot; const int* tab; const LAS int* etab;
    DI void operator()(const mm::f32x4 (&acc)[2][2][4][2], const mm::Unit& u, int wr, int wc, int fr, int fq) const {
        const int Me = __builtin_amdgcn_readfirstlane(tab[32 + u.e]); const int col = u.pn * 128 + wc * 32 + 8 * fq; const LAS int* et = etab + u.tb * 512;
        int sl8[8]; lds_read8(et, wr * 64 + fr, sl8);
#pragma unroll
        for (int ai = 0; ai < 2; ++ai)
#pragma unroll
            for (int m = 0; m < 4; ++m) {
                const int idx = u.m * 256 + ai * 128 + wr * 64 + m * 16 + fr;
                if (idx < Me) {
                    int drow; if (u.e < 16) { const int s = sl8[ai * 4 + m]; drow = (s & 1) * NT + (s >> 1); } else drow = 2 * NT + idx;
                    float o[8];
#pragma unroll
                    for (int n = 0; n < 2; ++n)
#pragma unroll
                        for (int c = 0; c < 4; ++c) { const float g = acc[ai][0][m][n][c], uu = acc[ai][1][m][n][c]; o[n * 4 + c] = g * __builtin_amdgcn_rcpf(1.f + __expf(-g)) * uu; }
                    mm::u32x4 w; w.x = mm::cvt_pk_bf16(o[0], o[1]); w.y = mm::cvt_pk_bf16(o[2], o[3]); w.z = mm::cvt_pk_bf16(o[4], o[5]); w.w = mm::cvt_pk_bf16(o[6], o[7]);
                    *(mm::u32x4*)(ACT + (size_t)drow * 512 + col) = w;
                }
            }
    }
};
struct EpiDown {
    static constexpr bool PERM = true;
    bf16_t* Y; const int* slot; const float* tokw; const int* tab; const LAS int* etab;
    DI void operator()(const mm::f32x4 (&acc)[2][2][4][2], const mm::Unit& u, int wr, int wc, int fr, int fq) const {
        const int Me = __builtin_amdgcn_readfirstlane(tab[32 + u.e]); const int col = u.pn * 256 + wc * 32 + 8 * fq; const LAS int* et = etab + u.tb * 512;
        int sl8[8], sw8[8]; lds_read8(et, wr * 64 + fr, sl8); lds_read8(et + 256, wr * 64 + fr, sw8);
#pragma unroll
        for (int ai = 0; ai < 2; ++ai)
#pragma unroll
            for (int m = 0; m < 4; ++m) {
                const int idx = u.m * 256 + ai * 128 + wr * 64 + m * 16 + fr;
                if (idx < Me) {
                    int drow; float w = 1.f;
                    if (u.e < 16) { const int s = sl8[ai * 4 + m]; drow = (s & 1) * NT + (s >> 1); w = __int_as_float(sw8[ai * 4 + m]); } else drow = 2 * NT + idx;
#pragma unroll
                    for (int bj = 0; bj < 2; ++bj) { const mm::f32x4 v0 = acc[ai][bj][m][0] * w, v1 = acc[ai][bj][m][1] * w;
                        mm::u32x4 o; o.x = mm::cvt_pk_bf16(v0[0], v0[1]); o.y = mm::cvt_pk_bf16(v0[2], v0[3]); o.z = mm::cvt_pk_bf16(v1[0], v1[1]); o.w = mm::cvt_pk_bf16(v1[2], v1[3]);
                        *(mm::u32x4*)(Y + (size_t)drow * 1024 + col + bj * 128) = o; }
                }
            }
    }
};
DI void ph_moe_up_mm(const Ctx& cx, const Params& p, float* lds, int layer, int nrows) {
    int* tab = (int*)(lds + 32768); moe_table(cx, p, tab, layer, nrows);
    MoeSched S{(const char*)p.H, (const char*)p.WguT, p.slot, p.slotw, tab, 1024, 1024, cx.nblk, cx.bid, 0};
    EpiSwiglu E{p.ACT, p.slot, tab, (const LAS int*)((LAS float*)lds + 32768 + 256)};
    mm::gemm_phase(GEMM_LDS(lds), 1024, S, E, cx.tid);
}
DI void ph_moe_down_mm(const Ctx& cx, const Params& p, float* lds, int layer, int nrows) {
    int* tab = (int*)(lds + 32768); moe_table(cx, p, tab, layer, nrows);
    MoeSched S{(const char*)p.ACT, (const char*)p.WdT, p.slot, p.slotw, tab, 512, 512, cx.nblk, cx.bid, 1};
    EpiDown E{p.Y, p.slot, p.tokw, tab, (const LAS int*)((LAS float*)lds + 32768 + 256)};
    mm::gemm_phase(GEMM_LDS(lds), 512, S, E, cx.tid);
}

namespace att {
typedef short bf16x8 __attribute__((ext_vector_type(8)));
typedef float f32x16 __attribute__((ext_vector_type(16)));
typedef unsigned u32x4 __attribute__((ext_vector_type(4)));
typedef unsigned u32x2 __attribute__((ext_vector_type(2)));
typedef __bf16 bf16x2_t __attribute__((ext_vector_type(2)));
typedef float f32x2_t __attribute__((ext_vector_type(2)));
constexpr int KP = 208, VP = 264, KT_BYTES = 128 * KP, VT_BYTES = 64 * VP, BUF = KT_BYTES + VT_BYTES;
DI unsigned pk(float a, float b) { f32x2_t f = {a, b}; bf16x2_t h = __builtin_convertvector(f, bf16x2_t); return __builtin_bit_cast(unsigned, h); }
DI float xhalf_max(float x) { const auto r = __builtin_amdgcn_permlane32_swap(__builtin_bit_cast(unsigned, x), __builtin_bit_cast(unsigned, x), false, false); return fmaxf(__builtin_bit_cast(float, r[0]), __builtin_bit_cast(float, r[1])); }
DI float xhalf_sum(float x) { const auto r = __builtin_amdgcn_permlane32_swap(__builtin_bit_cast(unsigned, x), __builtin_bit_cast(unsigned, x), false, false); return __builtin_bit_cast(float, r[0]) + __builtin_bit_cast(float, r[1]); }
#define ATT_MFMA(a, b, c) __builtin_amdgcn_mfma_f32_32x32x16_bf16((a), (b), (c), 0, 0, 0)
}
DI void ph_attn_mm(const Ctx& cx, const Params& p, float* ldsf, bool with_ctx) {
    using namespace att;
    LAS unsigned char* lds = (LAS unsigned char*)ldsf;
    const int tid = cx.tid, wid = __builtin_amdgcn_readfirstlane(tid >> 6), lane = tid & 63, r = lane & 31, hh = lane >> 5;
    const int nunits = 1024 + (with_ctx ? 128 : 0);
    for (int u = cx.bid; u < nunits; u += cx.nblk) {
        int tz = tid; asm volatile("" : "+v"(tz));
        int kg[3], kl[3], vg[2], vl[2];
#pragma unroll
        for (int i = 0; i < 3; ++i) { const int c = tz + 512 * i, row = c / 12, part = c % 12; kg[i] = row * 96 + part * 8; kl[i] = row * KP + part * 16; }
#pragma unroll
        for (int i = 0; i < 2; ++i) { const int c = tz + 512 * i, row = c >> 4, part = c & 15; vg[i] = row * 2304 + part * 8; vl[i] = KT_BYTES + row * VP + part * 16; }
        int bh, qrow0, nkeys;
        if (u < 1024) { bh = u >> 3; qrow0 = (bh >> 3) * 2048 + (u & 7) * 256; nkeys = 2304; }
        else { bh = u - 1024; qrow0 = NLAT + (bh >> 3) * 256; nkeys = 256; }
        const int h = bh & 7;
        const bf16_t* Kb = p.Kf + (size_t)bh * 2304 * 96; const bf16_t* Vb = p.Vt + (size_t)bh * 64 * 2304;
        const bf16_t* qp = p.Qraw + (size_t)(qrow0 + (tz >> 6) * 32 + (tz & 31)) * 768 + h * 96 + 8 * ((tz >> 5) & 1);
        bf16x8 qf[6];
#pragma unroll
        for (int s = 0; s < 6; ++s) qf[s] = *(const bf16x8*)(qp + 16 * s);
        f32x16 ot0, ot1;
#pragma unroll
        for (int i = 0; i < 16; ++i) { ot0[i] = 0.f; ot1[i] = 0.f; }
        float lrun = 0.f;
        const int ntiles = nkeys >> 7;
        u32x4 kr[3], vr[2];
#pragma unroll
        for (int i = 0; i < 3; ++i) kr[i] = *(const u32x4*)(Kb + kg[i]);
#pragma unroll
        for (int i = 0; i < 2; ++i) vr[i] = *(const u32x4*)(Vb + vg[i]);
#pragma unroll
        for (int i = 0; i < 3; ++i) *(LAS u32x4*)(lds + kl[i]) = kr[i];
#pragma unroll
        for (int i = 0; i < 2; ++i) { *(LAS u32x2*)(lds + vl[i]) = (u32x2){vr[i].x, vr[i].y}; *(LAS u32x2*)(lds + vl[i] + 8) = (u32x2){vr[i].z, vr[i].w}; }
        __syncthreads();
        for (int it = 0; it < ntiles; ++it) {
            const int bo = (it & 1) * BUF, bn = ((it + 1) & 1) * BUF;
            const bool more = (it + 1 < ntiles);
            if (more) {
                const bf16_t* Kn = Kb + (size_t)(it + 1) * 128 * 96; const bf16_t* Vn = Vb + (it + 1) * 128;
#pragma unroll
                for (int i = 0; i < 3; ++i) kr[i] = *(const u32x4*)(Kn + kg[i]);
#pragma unroll
                for (int i = 0; i < 2; ++i) vr[i] = *(const u32x4*)(Vn + vg[i]);
            }
            f32x16 st[4];
#pragma unroll
            for (int kb = 0; kb < 4; ++kb) {
#pragma unroll
                for (int i = 0; i < 16; ++i) st[kb][i] = 0.f;
#pragma unroll
                for (int s = 0; s < 6; ++s) { const bf16x8 kf = *(const LAS bf16x8*)(lds + bo + (kb * 32 + r) * KP + 32 * s + 16 * hh); st[kb] = ATT_MFMA(kf, qf[s], st[kb]); }
                asm volatile("" ::: "memory");
            }
            float pq[4];
#pragma unroll
            for (int kb = 0; kb < 4; ++kb) { float a = 0.f, b = 0.f;
#pragma unroll
                for (int i = 0; i < 16; i += 2) { st[kb][i] = __builtin_amdgcn_exp2f(st[kb][i]); st[kb][i + 1] = __builtin_amdgcn_exp2f(st[kb][i + 1]); a += st[kb][i]; b += st[kb][i + 1]; }
                pq[kb] = a + b; }
            lrun += (pq[0] + pq[1]) + (pq[2] + pq[3]);
#pragma unroll
            for (int kb = 0; kb < 4; ++kb)
#pragma unroll
                for (int s = 0; s < 2; ++s) {
                    u32x4 pw; pw.x = pk(st[kb][8 * s], st[kb][8 * s + 1]); pw.y = pk(st[kb][8 * s + 2], st[kb][8 * s + 3]); pw.z = pk(st[kb][8 * s + 4], st[kb][8 * s + 5]); pw.w = pk(st[kb][8 * s + 6], st[kb][8 * s + 7]);
                    const bf16x8 pb = __builtin_bit_cast(bf16x8, pw);
                    const int col = (kb * 32 + 16 * s + 4 * hh) * 2;
                    const u32x2 a0 = *(const LAS u32x2*)(lds + bo + KT_BYTES + r * VP + col), a1 = *(const LAS u32x2*)(lds + bo + KT_BYTES + r * VP + col + 16);
                    const u32x2 b0 = *(const LAS u32x2*)(lds + bo + KT_BYTES + (32 + r) * VP + col), b1 = *(const LAS u32x2*)(lds + bo + KT_BYTES + (32 + r) * VP + col + 16);
                    const u32x4 va = {a0.x, a0.y, a1.x, a1.y}, vb = {b0.x, b0.y, b1.x, b1.y};
                    ot0 = ATT_MFMA(__builtin_bit_cast(bf16x8, va), pb, ot0);
                    ot1 = ATT_MFMA(__builtin_bit_cast(bf16x8, vb), pb, ot1);
                }
            if (more) {
#pragma unroll
                for (int i = 0; i < 3; ++i) *(LAS u32x4*)(lds + bn + kl[i]) = kr[i];
#pragma unroll
                for (int i = 0; i < 2; ++i) { *(LAS u32x2*)(lds + bn + vl[i]) = (u32x2){vr[i].x, vr[i].y}; *(LAS u32x2*)(lds + bn + vl[i] + 8) = (u32x2){vr[i].z, vr[i].w}; }
            }
            __syncthreads();
        }
        const float il = 1.f / xhalf_sum(lrun);
        int t2 = tid; asm volatile("" : "+v"(t2));
        bf16_t* op = p.H + (size_t)(qrow0 + (t2 >> 6) * 32 + (t2 & 31)) * 1024 + 512 + h * 64 + 4 * ((t2 >> 5) & 1);
#pragma unroll
        for (int g = 0; g < 4; ++g) {
            u32x2 w0 = {pk(ot0[4 * g] * il, ot0[4 * g + 1] * il), pk(ot0[4 * g + 2] * il, ot0[4 * g + 3] * il)};
            u32x2 w1 = {pk(ot1[4 * g] * il, ot1[4 * g + 1] * il), pk(ot1[4 * g + 2] * il, ot1[4 * g + 3] * il)};
            *(u32x2*)(op + 8 * g) = w0; *(u32x2*)(op + 32 + 8 * g) = w1;
        }
    }
}

DI void ph_attn_mm_stag(const Ctx& cx, const Params& p, float* ldsf, bool with_ctx) {
    using namespace att;
    LAS unsigned char* lds = (LAS unsigned char*)ldsf;
    const int tid = cx.tid, wid = __builtin_amdgcn_readfirstlane(tid >> 6), lane = tid & 63, r = lane & 31, hh = lane >> 5, G = wid >> 2;
    const int nunits = 1024 + (with_ctx ? 128 : 0);
    int kg[3], kl[3], vg[2], vl[2];
#pragma unroll
    for (int i = 0; i < 3; ++i) { const int c = tid + 512 * i, row = c / 12, part = c % 12; kg[i] = row * 96 + part * 8; kl[i] = row * KP + part * 16; }
#pragma unroll
    for (int i = 0; i < 2; ++i) { const int c = tid + 512 * i, row = c >> 4, part = c & 15; vg[i] = row * 2304 + part * 8; vl[i] = KT_BYTES + row * VP + part * 16; }
    for (int u = cx.bid; u < nunits; u += cx.nblk) {
        int bh, qrow0, nkeys;
        if (u < 1024) { bh = u >> 3; qrow0 = (bh >> 3) * 2048 + (u & 7) * 256; nkeys = 2304; }
        else { bh = u - 1024; qrow0 = NLAT + (bh >> 3) * 256; nkeys = 256; }
        const int h = bh & 7;
        const bf16_t* Kb = p.Kf + (size_t)bh * 2304 * 96; const bf16_t* Vb = p.Vt + (size_t)bh * 64 * 2304;
        const bf16_t* qp = p.Qraw + (size_t)(qrow0 + wid * 32 + r) * 768 + h * 96 + 8 * hh;
        bf16x8 qf[6];
#pragma unroll
        for (int s = 0; s < 6; ++s) qf[s] = *(const bf16x8*)(qp + 16 * s);
        f32x16 ot0, ot1;
#pragma unroll
        for (int i = 0; i < 16; ++i) { ot0[i] = 0.f; ot1[i] = 0.f; }
        float mrun = -3.0e38f, lrun = 0.f;
        const int ntiles = nkeys >> 7;
        u32x4 kr[3], vr[2];
#define ATT_LOAD(t) do { const bf16_t* Kn = Kb + (size_t)(t) * 128 * 96; const bf16_t* Vn = Vb + (t) * 128; \
            _Pragma("unroll") for (int i = 0; i < 3; ++i) kr[i] = *(const u32x4*)(Kn + kg[i]); _Pragma("unroll") for (int i = 0; i < 2; ++i) vr[i] = *(const u32x4*)(Vn + vg[i]); } while (0)
#define ATT_WRITE(bufo) do { _Pragma("unroll") for (int i = 0; i < 3; ++i) *(LAS u32x4*)(lds + (bufo) + kl[i]) = kr[i]; \
            _Pragma("unroll") for (int i = 0; i < 2; ++i) { *(LAS u32x2*)(lds + (bufo) + vl[i]) = (u32x2){vr[i].x, vr[i].y}; *(LAS u32x2*)(lds + (bufo) + vl[i] + 8) = (u32x2){vr[i].z, vr[i].w}; } } while (0)
        ATT_LOAD(0); ATT_WRITE(0);
        ATT_LOAD(1); ATT_WRITE(BUF);
        __syncthreads();
        f32x16 st[4];
        for (int ph = 0; ph <= 2 * ntiles; ++ph) {
            if (ph & 1) {
                const int tw = (ph + 1) >> 1;
                if (tw >= 2 && tw < ntiles) ATT_WRITE((tw & 1) * BUF);
                if (tw + 1 < ntiles) ATT_LOAD(tw + 1);
            }
            const int e = ph - G;
            if (e >= 0 && e < 2 * ntiles) {
                const int bo = ((e >> 1) & 1) * BUF;
                if ((e & 1) == 0) {
#pragma unroll
                    for (int kb = 0; kb < 4; ++kb) {
#pragma unroll
                        for (int i = 0; i < 16; ++i) st[kb][i] = 0.f;
#pragma unroll
                        for (int s = 0; s < 6; ++s) { const bf16x8 kf = *(const LAS bf16x8*)(lds + bo + (kb * 32 + r) * KP + 32 * s + 16 * hh); st[kb] = ATT_MFMA(kf, qf[s], st[kb]); }
                    }
                    float mq[4];
#pragma unroll
                    for (int kb = 0; kb < 4; ++kb) { float a = fmaxf(st[kb][0], st[kb][1]), b = fmaxf(st[kb][2], st[kb][3]), c2 = fmaxf(st[kb][4], st[kb][5]), d = fmaxf(st[kb][6], st[kb][7]);
                        a = fmaxf(a, fmaxf(st[kb][8], st[kb][9])); b = fmaxf(b, fmaxf(st[kb][10], st[kb][11])); c2 = fmaxf(c2, fmaxf(st[kb][12], st[kb][13])); d = fmaxf(d, fmaxf(st[kb][14], st[kb][15]));
                        mq[kb] = fmaxf(fmaxf(a, b), fmaxf(c2, d)); }
                    float mt = fmaxf(fmaxf(mq[0], mq[1]), fmaxf(mq[2], mq[3]));
                    mt = xhalf_max(mt);
                    const float mnew = fmaxf(mrun, mt), alpha = __builtin_amdgcn_exp2f(mrun - mnew);
                    mrun = mnew;
                    float pq[4];
#pragma unroll
                    for (int kb = 0; kb < 4; ++kb) { float a = 0.f, b = 0.f;
#pragma unroll
                        for (int i = 0; i < 16; i += 2) { st[kb][i] = __builtin_amdgcn_exp2f(st[kb][i] - mnew); st[kb][i + 1] = __builtin_amdgcn_exp2f(st[kb][i + 1] - mnew); a += st[kb][i]; b += st[kb][i + 1]; }
                        pq[kb] = a + b; }
                    lrun = lrun * alpha + ((pq[0] + pq[1]) + (pq[2] + pq[3]));
#pragma unroll
                    for (int i = 0; i < 16; ++i) { ot0[i] *= alpha; ot1[i] *= alpha; }
                } else {
#pragma unroll
                    for (int kb = 0; kb < 4; ++kb)
#pragma unroll
                        for (int s = 0; s < 2; ++s) {
                            u32x4 pw; pw.x = pk(st[kb][8 * s], st[kb][8 * s + 1]); pw.y = pk(st[kb][8 * s + 2], st[kb][8 * s + 3]); pw.z = pk(st[kb][8 * s + 4], st[kb][8 * s + 5]); pw.w = pk(st[kb][8 * s + 6], st[kb][8 * s + 7]);
                            const bf16x8 pb = __builtin_bit_cast(bf16x8, pw);
                            const int col = (kb * 32 + 16 * s + 4 * hh) * 2;
                            const u32x2 a0 = *(const LAS u32x2*)(lds + bo + KT_BYTES + r * VP + col), a1 = *(const LAS u32x2*)(lds + bo + KT_BYTES + r * VP + col + 16);
                            const u32x2 b0 = *(const LAS u32x2*)(lds + bo + KT_BYTES + (32 + r) * VP + col), b1 = *(const LAS u32x2*)(lds + bo + KT_BYTES + (32 + r) * VP + col + 16);
                            const u32x4 va = {a0.x, a0.y, a1.x, a1.y}, vb = {b0.x, b0.y, b1.x, b1.y};
                            ot0 = ATT_MFMA(__builtin_bit_cast(bf16x8, va), pb, ot0);
                            ot1 = ATT_MFMA(__builtin_bit_cast(bf16x8, vb), pb, ot1);
                        }
                }
            }
            __syncthreads();
        }
#undef ATT_LOAD
#undef ATT_WRITE
        const float il = 1.f / xhalf_sum(lrun);
        bf16_t* op = p.H + (size_t)(qrow0 + wid * 32 + r) * 1024 + 512 + h * 64 + 4 * hh;
#pragma unroll
        for (int g = 0; g < 4; ++g) {
            u32x2 w0 = {pk(ot0[4 * g] * il, ot0[4 * g + 1] * il), pk(ot0[4 * g + 2] * il, ot0[4 * g + 3] * il)};
            u32x2 w1 = {pk(ot1[4 * g] * il, ot1[4 * g + 1] * il), pk(ot1[4 * g + 2] * il, ot1[4 * g + 3] * il)};
            *(u32x2*)(op + 8 * g) = w0; *(u32x2*)(op + 32 + 8 * g) = w1;
        }
    }
}

namespace scan {
typedef float f32x2 __attribute__((ext_vector_type(2)));
constexpr int REC = 400, CH = 32, BUFF = CH * REC, YOFF = 2 * BUFF;
DI float dppf(float v, int ctrl_sel) {
    const int x = __builtin_bit_cast(int, v);
    int r;
    if (ctrl_sel == 0) r = __builtin_amdgcn_update_dpp(0, x, 0xB1, 0xf, 0xf, true);
    else if (ctrl_sel == 1) r = __builtin_amdgcn_update_dpp(0, x, 0x4E, 0xf, 0xf, true);
    else r = __builtin_amdgcn_update_dpp(0, x, 0x141, 0xf, 0xf, true);
    return __builtin_bit_cast(float, r);
}
DI float red8(float v) { v += dppf(v, 0); v += dppf(v, 1); v += dppf(v, 2); return v; }
}
template <int ABL>
DI void ph_scan_opt(const Ctx& cx, const Params& p, float* lds, int j) {
    using namespace scan;
    const int tid = cx.tid, wid = __builtin_amdgcn_readfirstlane(tid >> 6), lane = tid & 63;
    for (int item = cx.bid; item < 256; item += cx.nblk) {
        const int b = item >> 4, h = (item >> 1) & 7, dir = item & 1;
        bf16_t* yout = dir ? p.YB : p.YF;
        if (wid >= 4) {
            const int pw = wid - 4, hc = h * 64 + lane;
            const float kkc = p.a_k_k[j * 512 + hc], kac = p.a_k_a[j * 512 + hc];
            const float mur = p.a_mu[j * ACOLS + hc], muk = p.a_mu[j * ACOLS + 512 + hc], muv = p.a_mu[j * ACOLS + 1024 + hc];
            LAS float* L = (LAS float*)lds;
            bf16_t raw[8][11];
#define SCAN_ROW(stepv, row_, t_, T_) const bool cp_ = (stepv) < 256; const int tt_ = cp_ ? (stepv) : (stepv) - 256, T_ = cp_ ? 256 : 2048, t_ = dir ? (T_ - 1 - tt_) : tt_; const int row_ = cp_ ? NLAT + b * 256 + t_ : b * 2048 + t_
#define SCAN_LOAD(cc) do { _Pragma("unroll") for (int it = 0; it < 8; ++it) { const int step = (cc) * CH + pw + 4 * it; SCAN_ROW(step, row, t, T); \
                const int rp_ = (t > 0) ? row - 1 : row, rn_ = (t < T - 1) ? row + 1 : row; \
                const bf16_t* pc = p.P + (size_t)row * PLD + hc; const bf16_t* pp = p.P + (size_t)rp_ * PLD + hc; const bf16_t* pn = p.P + (size_t)rn_ * PLD + hc; \
                raw[it][0] = pc[0]; raw[it][1] = pp[0]; raw[it][2] = pn[0]; raw[it][3] = pc[512]; raw[it][4] = pp[512]; raw[it][5] = pn[512]; raw[it][6] = pc[1024]; raw[it][7] = pp[1024]; raw[it][8] = pn[1024]; \
                raw[it][9] = p.WAG[(size_t)row * WLD + dir * 512 + hc]; raw[it][10] = p.WAG[(size_t)row * WLD + 1024 + dir * 512 + hc]; } } while (0)
            if (ABL != 1) SCAN_LOAD(0);
            for (int c = 0; c <= 73; ++c) {
                if (c >= 2 && ABL == 0) {
                    const LAS float* yb = L + YOFF + ((c - 2) & 1) * (CH * 64);
#pragma unroll
                    for (int it = 0; it < 8; ++it) {
                        const int sl = pw + 4 * it, step = (c - 2) * CH + sl; SCAN_ROW(step, row, t, T);
                        yout[(size_t)row * 512 + hc] = f2bf(yb[sl * 64 + lane]);
                    }
                }
                if (c < 72 && ABL != 1) {
                    LAS float* buf = L + (c & 1) * BUFF;
#pragma unroll
                    for (int it = 0; it < 8; ++it) {
                        const int sl = pw + 4 * it, step = c * CH + sl; SCAN_ROW(step, row, t, T); (void)row;
                        const float mp = (t > 0) ? 0.5f : 0.f, mn = (t < T - 1) ? 0.5f : 0.f;
                        const float rc = bf2f(raw[it][0]), kc_ = bf2f(raw[it][3]), vc = bf2f(raw[it][6]);
                        const float R = rc + mur * (mp * bf2f(raw[it][1]) + mn * bf2f(raw[it][2]) - rc);
                        const float K = kc_ + muk * (mp * bf2f(raw[it][4]) + mn * bf2f(raw[it][5]) - kc_);
                        const float V = vc + muv * (mp * bf2f(raw[it][7]) + mn * bf2f(raw[it][8]) - vc);
                        const float w = 1.f - bf2f(raw[it][9]), a = bf2f(raw[it][10]);
                        const float kkv = K * kkc, ssq = wave_sum(kkv * kkv), kk = kkv * rsqrtf(ssq + 1e-12f);
                        const float kd = K * (1.f + (a - 1.f) * kac), bd = kk * a;
                        const float br = wave_sum(bd * R), kr = wave_sum(kd * R);
                        LAS float* rec = buf + sl * REC;
                        rec[lane] = w; rec[64 + lane] = -kk; rec[128 + lane] = bd; rec[192 + lane] = kd; rec[256 + lane] = w * R; rec[320 + lane] = V;
                        if (lane == 0) { rec[384] = br; rec[385] = kr; }
                    }
                    if (c + 1 < 72) SCAN_LOAD(c + 1);
                }
                __syncthreads();
            }
#undef SCAN_LOAD
#undef SCAN_ROW
        } else {
            const int ct = tid, rp = ct >> 3, k8 = ct & 7;
            float S0[8], S1[8];
#pragma unroll
            for (int q = 0; q < 8; ++q) { S0[q] = 0.f; S1[q] = 0.f; }
            __syncthreads();
            for (int c = 0; c < 72; ++c) {
                const LAS float* buf = (const LAS float*)lds + (c & 1) * BUFF; LAS float* yb = (LAS float*)lds + YOFF + (c & 1) * (CH * 64);
                mm::f32x4 cw0, cw1, cn0, cn1, cb0, cb1, cd0, cd1, cr0, cr1; scan::f32x2 cvv, csc;
#define SCAN_LD(recp, W0, W1, N0, N1, B0, B1, D0, D1, R0_, R1_, VV, SC) do { const LAS float* r_ = (recp); \
                    W0 = *(const LAS mm::f32x4*)(r_ + k8 * 8); W1 = *(const LAS mm::f32x4*)(r_ + k8 * 8 + 4); N0 = *(const LAS mm::f32x4*)(r_ + 64 + k8 * 8); N1 = *(const LAS mm::f32x4*)(r_ + 64 + k8 * 8 + 4); \
                    B0 = *(const LAS mm::f32x4*)(r_ + 128 + k8 * 8); B1 = *(const LAS mm::f32x4*)(r_ + 128 + k8 * 8 + 4); D0 = *(const LAS mm::f32x4*)(r_ + 192 + k8 * 8); D1 = *(const LAS mm::f32x4*)(r_ + 192 + k8 * 8 + 4); \
                    R0_ = *(const LAS mm::f32x4*)(r_ + 256 + k8 * 8); R1_ = *(const LAS mm::f32x4*)(r_ + 256 + k8 * 8 + 4); VV = *(const LAS scan::f32x2*)(r_ + 320 + 2 * rp); SC = *(const LAS scan::f32x2*)(r_ + 384); } while (0)
                SCAN_LD(buf, cw0, cw1, cn0, cn1, cb0, cb1, cd0, cd1, cr0, cr1, cvv, csc);
#pragma unroll 2
                for (int sl = 0; sl < (ABL == 2 ? 0 : CH); ++sl) {
                    mm::f32x4 nw0, nw1, nn0, nn1, nb0, nb1, nd0, nd1, nr0, nr1; scan::f32x2 nvv, nsc;
                    SCAN_LD(buf + (sl + 1 < CH ? sl + 1 : sl) * REC, nw0, nw1, nn0, nn1, nb0, nb1, nd0, nd1, nr0, nr1, nvv, nsc);
                    const float wv[8] = {cw0[0], cw0[1], cw0[2], cw0[3], cw1[0], cw1[1], cw1[2], cw1[3]}, nv[8] = {cn0[0], cn0[1], cn0[2], cn0[3], cn1[0], cn1[1], cn1[2], cn1[3]};
                    const float bv[8] = {cb0[0], cb0[1], cb0[2], cb0[3], cb1[0], cb1[1], cb1[2], cb1[3]}, dv[8] = {cd0[0], cd0[1], cd0[2], cd0[3], cd1[0], cd1[1], cd1[2], cd1[3]};
                    const float rv[8] = {cr0[0], cr0[1], cr0[2], cr0[3], cr1[0], cr1[1], cr1[2], cr1[3]};
                    float sa0 = 0.f, sa1 = 0.f, y0 = 0.f, y1 = 0.f;
#pragma unroll
                    for (int q = 0; q < 8; ++q) { sa0 += S0[q] * nv[q]; sa1 += S1[q] * nv[q]; y0 += S0[q] * rv[q]; y1 += S1[q] * rv[q]; }
                    sa0 = red8(sa0); sa1 = red8(sa1); y0 = red8(y0); y1 = red8(y1);
                    y0 += sa0 * csc[0] + cvv[0] * csc[1]; y1 += sa1 * csc[0] + cvv[1] * csc[1];
#pragma unroll
                    for (int q = 0; q < 8; ++q) { S0[q] = S0[q] * wv[q] + sa0 * bv[q] + cvv[0] * dv[q]; S1[q] = S1[q] * wv[q] + sa1 * bv[q] + cvv[1] * dv[q]; }
                    if (k8 == 0) *(LAS scan::f32x2*)(yb + sl * 64 + 2 * rp) = (scan::f32x2){y0, y1};
                    cw0 = nw0; cw1 = nw1; cn0 = nn0; cn1 = nn1; cb0 = nb0; cb1 = nb1; cd0 = nd0; cd1 = nd1; cr0 = nr0; cr1 = nr1; cvv = nvv; csc = nsc;
                }
#undef SCAN_LD
                __syncthreads();
            }
            __syncthreads();
        }
    }
}

namespace sc2 {
typedef short bf16x8 __attribute__((ext_vector_type(8)));
typedef float f32x4 __attribute__((ext_vector_type(4)));
typedef unsigned u32x4 __attribute__((ext_vector_type(4)));
typedef unsigned u32x2 __attribute__((ext_vector_type(2)));
constexpr int NP = 6;
constexpr int O_AH = 0, O_RH = 2048, O_BK = 4096, O_VM = 8192, O_GC = 10240, O_AAB = 10496, O_AAK = 11520, O_ARK = 12032, O_BH = 13056, O_KH = 15104, SLOT = 17152;
constexpr int O_S0 = NP * SLOT, O_RHS = O_S0 + 8192, O_ZU = O_RHS + 4096, O_FLAG = O_ZU + 2048, TOTAL = O_FLAG + 256;
#define SC_MFMA(a, b, c) __builtin_amdgcn_mfma_f32_16x16x32_bf16((a), (b), (c), 0, 0, 0)
DI unsigned pk2(float a, float b) { return att::pk(a, b); }
DI int ldv(volatile LAS int* p) { return *p; }
}
template <int ABL>
DI void ph_scan_chunk(const Ctx& cx, const Params& p, float* ldsg, int j) {
    using namespace sc2;
    static_assert(TOTAL <= 128 * 1024, "scan LDS map");
    LAS unsigned char* L = (LAS unsigned char*)ldsg;
    volatile LAS int* ready = (volatile LAS int*)(L + O_FLAG); volatile LAS int* done = ready + 8;
    const int tid = cx.tid, wid = __builtin_amdgcn_readfirstlane(tid >> 6), lane = tid & 63, lq = lane >> 4, lr = lane & 15;
    constexpr int NCH = 144;
    for (int item = cx.bid; item < 256; item += cx.nblk) {
        const int b = item >> 4, h = (item >> 1) & 7, dir = item & 1;
        bf16_t* yout = dir ? p.YB : p.YF;
        __syncthreads();
        if (tid < 32) ready[tid] = 0;
        __syncthreads();
#define SC_ROW(stepv, row_, t_, T_) const bool cp_ = (stepv) < 256; const int tt_ = cp_ ? (stepv) : (stepv) - 256, T_ = cp_ ? 256 : 2048, t_ = dir ? (T_ - 1 - tt_) : tt_; const int row_ = cp_ ? NLAT + b * 256 + t_ : b * 2048 + t_
        if (wid < 2) {
            __builtin_amdgcn_s_setprio(3);
            const int g = wid, vb0 = 2 * g;
            f32x4 S[4][2];
#pragma unroll
            for (int kb = 0; kb < 4; ++kb)
#pragma unroll
                for (int vb = 0; vb < 2; ++vb) S[kb][vb] = (f32x4){0.f, 0.f, 0.f, 0.f};
            for (int c = 0; c < NCH; ++c) {
                const int sl = c % NP; LAS unsigned char* SB = L + sl * SLOT;
                { unsigned spins = 0; while (ldv(ready + sl) != c + 1) { __builtin_amdgcn_s_sleep(1); if (++spins > (1u << 22)) break; } }
                asm volatile("" ::: "memory");
                if (ABL == 2) { if (lane == 0) done[g * 8 + sl] = c + 1; continue; }
                f32x4 cA[4][4];
#pragma unroll
                for (int j = 0; j <= 3; ++j)
#pragma unroll
                    for (int q = (j + 1) / 4; q < 4; ++q) cA[j][q - (j + 1) / 4] = *(const LAS f32x4*)(SB + O_AAB + j * 64 + q * 16);
#pragma unroll
                for (int kb = 0; kb < 4; ++kb)
#pragma unroll
                    for (int vq = 0; vq < 2; ++vq) { const f32x4 x = S[kb][vq]; *(LAS u32x2*)(L + O_S0 + (16 * (vb0 + vq) + lr) * 128 + (16 * kb + 4 * lq) * 2) = (u32x2){pk2(x[0], x[1]), pk2(x[2], x[3])}; }
                {
                    bf16x8 ah[2], ak, sf[2][2], vmf[2];
#pragma unroll
                    for (int ks = 0; ks < 2; ++ks) ah[ks] = *(const LAS bf16x8*)(SB + O_AH + lr * 128 + ks * 64 + lq * 16);
                    { u32x4 z = {0u, 0u, 0u, 0u}; if (lq < 2) z = *(const LAS u32x4*)(SB + O_AAK + lr * 32 + lq * 16); ak = __builtin_bit_cast(bf16x8, z); }
#pragma unroll
                    for (int vq = 0; vq < 2; ++vq) { const int vb = vb0 + vq;
#pragma unroll
                        for (int ks = 0; ks < 2; ++ks) sf[vq][ks] = *(const LAS bf16x8*)(L + O_S0 + (16 * vb + lr) * 128 + ks * 64 + lq * 16);
                        u32x4 z = {0u, 0u, 0u, 0u}; if (lq < 2) z = *(const LAS u32x4*)(SB + O_VM + (16 * vb + lr) * 32 + lq * 16); vmf[vq] = __builtin_bit_cast(bf16x8, z);
                    }
                    f32x4 acc[2];
#pragma unroll
                    for (int vq = 0; vq < 2; ++vq) { acc[vq] = (f32x4){0.f, 0.f, 0.f, 0.f}; acc[vq] = SC_MFMA(sf[vq][0], ah[0], acc[vq]); acc[vq] = SC_MFMA(sf[vq][1], ah[1], acc[vq]); acc[vq] = SC_MFMA(vmf[vq], ak, acc[vq]); }
#pragma unroll
                    for (int vq = 0; vq < 2; ++vq)
#pragma unroll
                        for (int q = 0; q < 4; ++q) *(LAS float*)(L + O_RHS + ((16 * (vb0 + vq) + 4 * lq + q) * 16 + lr) * 4) = acc[vq][q];
                }
                float u[16];
                const int vl = 32 * g + (lane & 31);
                { const LAS f32x4* rp = (const LAS f32x4*)(L + O_RHS + vl * 64);
#pragma unroll
                  for (int q = 0; q < 4; ++q) { const f32x4 x = rp[q]; u[4 * q] = x[0]; u[4 * q + 1] = x[1]; u[4 * q + 2] = x[2]; u[4 * q + 3] = x[3]; } }
#define SC_COL(j, CF) do { _Pragma("unroll") for (int q = ((j) + 1) / 4; q < 4; ++q) { const f32x4 cf = CF[q - ((j) + 1) / 4]; \
                        _Pragma("unroll") for (int e = 0; e < 4; ++e) { if (4 * q + e > (j)) u[4 * q + e] += cf[e] * u[j]; } } } while (0)
                f32x4 cB[4][3], cC[7][2];
#pragma unroll
                for (int j = 4; j <= 7; ++j)
#pragma unroll
                    for (int q = (j + 1) / 4; q < 4; ++q) cB[j - 4][q - (j + 1) / 4] = *(const LAS f32x4*)(SB + O_AAB + j * 64 + q * 16);
                asm volatile("" ::: "memory");
                if (ABL != 3) {
                SC_COL(0, cA[0]); SC_COL(1, cA[1]); SC_COL(2, cA[2]); SC_COL(3, cA[3]);
                }
                asm volatile("" ::: "memory");
#pragma unroll
                for (int j = 8; j <= 14; ++j)
#pragma unroll
                    for (int q = (j + 1) / 4; q < 4; ++q) cC[j - 8][q - (j + 1) / 4] = *(const LAS f32x4*)(SB + O_AAB + j * 64 + q * 16);
                asm volatile("" ::: "memory");
                if (ABL != 3) {
                SC_COL(4, cB[0]); SC_COL(5, cB[1]); SC_COL(6, cB[2]); SC_COL(7, cB[3]);
                SC_COL(8, cC[0]); SC_COL(9, cC[1]); SC_COL(10, cC[2]); SC_COL(11, cC[3]); SC_COL(12, cC[4]); SC_COL(13, cC[5]); SC_COL(14, cC[6]);
                }
#undef SC_COL
                { u32x4 w0 = {pk2(u[0], u[1]), pk2(u[2], u[3]), pk2(u[4], u[5]), pk2(u[6], u[7])}, w1 = {pk2(u[8], u[9]), pk2(u[10], u[11]), pk2(u[12], u[13]), pk2(u[14], u[15])};
                  if (lane < 32) { *(LAS u32x4*)(L + O_ZU + vl * 32) = w0; *(LAS u32x4*)(L + O_ZU + vl * 32 + 16) = w1; } }
                {
                    bf16x8 zf[2], sf[2][2], bkf[4]; f32x4 gc[4];
#pragma unroll
                    for (int vq = 0; vq < 2; ++vq) { const int vb = vb0 + vq;
                        zf[vq] = (lq < 2) ? *(const LAS bf16x8*)(L + O_ZU + (16 * vb + lr) * 32 + lq * 16) : *(const LAS bf16x8*)(SB + O_VM + (16 * vb + lr) * 32 + (lq - 2) * 16);
#pragma unroll
                        for (int ks = 0; ks < 2; ++ks) sf[vq][ks] = *(const LAS bf16x8*)(L + O_S0 + (16 * vb + lr) * 128 + ks * 64 + lq * 16);
                    }
                    const bf16x8 rk = *(const LAS bf16x8*)(SB + O_ARK + lr * 64 + lq * 16);
                    const bf16x8 rh0 = *(const LAS bf16x8*)(SB + O_RH + lr * 128 + lq * 16), rh1 = *(const LAS bf16x8*)(SB + O_RH + lr * 128 + 64 + lq * 16);
#pragma unroll
                    for (int kb = 0; kb < 4; ++kb) { gc[kb] = *(const LAS f32x4*)(SB + O_GC + (16 * kb + 4 * lq) * 4); bkf[kb] = *(const LAS bf16x8*)(SB + O_BK + (16 * kb + lr) * 64 + lq * 16); }
                    const int step = c * 16 + lr; SC_ROW(step, row, tq, Tq); (void)tq; (void)Tq;
#pragma unroll
                    for (int vq = 0; vq < 2; ++vq) { f32x4 y = {0.f, 0.f, 0.f, 0.f};
                        y = SC_MFMA(sf[vq][0], rh0, y); y = SC_MFMA(sf[vq][1], rh1, y); y = SC_MFMA(zf[vq], rk, y);
                        if (ABL == 0) *(u32x2*)(yout + (size_t)row * 512 + h * 64 + 16 * (vb0 + vq) + 4 * lq) = (u32x2){pk2(y[0], y[1]), pk2(y[2], y[3])}; else asm volatile("" :: "v"(y[0]), "v"(y[1]), "v"(y[2]), "v"(y[3])); }
#pragma unroll
                    for (int kb = 0; kb < 4; ++kb)
#pragma unroll
                        for (int vq = 0; vq < 2; ++vq) S[kb][vq] = SC_MFMA(bkf[kb], zf[vq], S[kb][vq] * gc[kb]);
                }
                asm volatile("s_waitcnt lgkmcnt(0)" ::: "memory");
                if (lane == 0) done[g * 8 + sl] = c + 1;
            }
            __builtin_amdgcn_s_setprio(0);
        } else {
            const int pw = wid - 2, hc = h * 64 + lane; LAS unsigned char* SB = L + pw * SLOT;
            const float kkc = p.a_k_k[j * 512 + hc], kac = p.a_k_a[j * 512 + hc];
            const float mur = p.a_mu[j * ACOLS + hc], muk = p.a_mu[j * ACOLS + 512 + hc], muv = p.a_mu[j * ACOLS + 1024 + hc];
            for (int c = pw; c < NCH; c += NP) {
                if (ABL == 1 || ABL == 3 || ABL == 4) { if (c >= NP) { unsigned spins = 0; while (ldv(done + pw) != c - NP + 1 || ldv(done + 8 + pw) != c - NP + 1) { __builtin_amdgcn_s_sleep(2); if (++spins > (1u << 22)) break; } } if (lane == 0) ready[pw] = c + 1; continue; }
                bf16_t raw[16][11];
#define SC_LOAD(t) do { const int step = c * 16 + (t); SC_ROW(step, row, tq, Tq); \
                    const int rp_ = (tq > 0) ? row - 1 : row, rn_ = (tq < Tq - 1) ? row + 1 : row; \
                    const bf16_t* pc = p.P + (size_t)row * PLD + hc; const bf16_t* pp = p.P + (size_t)rp_ * PLD + hc; const bf16_t* pn = p.P + (size_t)rn_ * PLD + hc; \
                    raw[t][0] = pc[0]; raw[t][1] = pp[0]; raw[t][2] = pn[0]; raw[t][3] = pc[512]; raw[t][4] = pp[512]; raw[t][5] = pn[512]; raw[t][6] = pc[1024]; raw[t][7] = pp[1024]; raw[t][8] = pn[1024]; \
                    raw[t][9] = p.WAG[(size_t)row * WLD + dir * 512 + hc]; raw[t][10] = p.WAG[(size_t)row * WLD + 1024 + dir * 512 + hc]; } while (0)
#define SC_STEP(t) do { const int step = c * 16 + (t); SC_ROW(step, row, tq, Tq); (void)row; \
                    const float mp = (tq > 0) ? 0.5f : 0.f, mn = (tq < Tq - 1) ? 0.5f : 0.f; \
                    const float rc = bf2f(raw[t][0]), kc_ = bf2f(raw[t][3]), vc = bf2f(raw[t][6]); \
                    const float R = rc + mur * (mp * bf2f(raw[t][1]) + mn * bf2f(raw[t][2]) - rc); \
                    const float K = kc_ + muk * (mp * bf2f(raw[t][4]) + mn * bf2f(raw[t][5]) - kc_); \
                    const float Vv = vc + muv * (mp * bf2f(raw[t][7]) + mn * bf2f(raw[t][8]) - vc); \
                    const float w = 1.f - bf2f(raw[t][9]), a = bf2f(raw[t][10]); \
                    const float kkv = K * kkc, ssq = wave_sum(kkv * kkv), kk = kkv * rsqrtf(ssq + 1e-12f); \
                    const float kd = K * (1.f + (a - 1.f) * kac), bd = kk * a; \
                    const float gprev = g; g *= w; const float ig = __builtin_amdgcn_rcpf(g); \
                    *(LAS bf16_t*)(SB + O_AH + (t) * 128 + lane * 2) = f2bf(-kk * gprev); \
                    *(LAS bf16_t*)(SB + O_RH + (t) * 128 + lane * 2) = f2bf(R * g); \
                    *(LAS bf16_t*)(SB + O_BH + (t) * 128 + lane * 2) = f2bf(bd * ig); \
                    *(LAS bf16_t*)(SB + O_KH + (t) * 128 + lane * 2) = f2bf(kd * ig); \
                    *(LAS bf16_t*)(SB + O_VM + lane * 32 + (t) * 2) = f2bf(Vv); } while (0)
                SC_LOAD(0); SC_LOAD(1); SC_LOAD(2); SC_LOAD(3); SC_LOAD(4); SC_LOAD(5); SC_LOAD(6); SC_LOAD(7);
                if (c >= NP) { unsigned spins = 0; while (ldv(done + pw) != c - NP + 1 || ldv(done + 8 + pw) != c - NP + 1) { __builtin_amdgcn_s_sleep(2); if (++spins > (1u << 22)) break; } }
                asm volatile("" ::: "memory");
                float g = 1.f;
                SC_STEP(0); SC_STEP(1); SC_STEP(2); SC_STEP(3);
                asm volatile("" ::: "memory");
                SC_LOAD(8); SC_LOAD(9); SC_LOAD(10); SC_LOAD(11);
                asm volatile("" ::: "memory");
                SC_STEP(4); SC_STEP(5); SC_STEP(6); SC_STEP(7);
                asm volatile("" ::: "memory");
                SC_LOAD(12); SC_LOAD(13); SC_LOAD(14); SC_LOAD(15);
                asm volatile("" ::: "memory");
                SC_STEP(8); SC_STEP(9); SC_STEP(10); SC_STEP(11); SC_STEP(12); SC_STEP(13); SC_STEP(14); SC_STEP(15);
#undef SC_LOAD
#undef SC_STEP
#pragma unroll
                for (int q = 0; q < 2; ++q) {
                    float bq[8], kq[8];
#pragma unroll
                    for (int e = 0; e < 8; ++e) { bq[e] = bf2f(*(const LAS bf16_t*)(SB + O_BH + (8 * q + e) * 128 + lane * 2)) * g; kq[e] = bf2f(*(const LAS bf16_t*)(SB + O_KH + (8 * q + e) * 128 + lane * 2)) * g; }
                    u32x4 wb = {pk2(bq[0], bq[1]), pk2(bq[2], bq[3]), pk2(bq[4], bq[5]), pk2(bq[6], bq[7])}, wk = {pk2(kq[0], kq[1]), pk2(kq[2], kq[3]), pk2(kq[4], kq[5]), pk2(kq[6], kq[7])};
                    *(LAS u32x4*)(SB + O_BK + lane * 64 + q * 16) = wb; *(LAS u32x4*)(SB + O_BK + lane * 64 + 32 + q * 16) = wk;
                }
                *(LAS float*)(SB + O_GC + lane * 4) = g;
                f32x4 sab = {0.f, 0.f, 0.f, 0.f}, sak = sab, srb = sab, srk = sab;
#pragma unroll
                for (int ks = 0; ks < 2; ++ks) {
                    const bf16x8 fa = *(const LAS bf16x8*)(SB + O_AH + lr * 128 + ks * 64 + lq * 16), fr = *(const LAS bf16x8*)(SB + O_RH + lr * 128 + ks * 64 + lq * 16);
                    const bf16x8 fb = *(const LAS bf16x8*)(SB + O_BH + lr * 128 + ks * 64 + lq * 16), fk = *(const LAS bf16x8*)(SB + O_KH + lr * 128 + ks * 64 + lq * 16);
                    sab = SC_MFMA(fa, fb, sab); sak = SC_MFMA(fa, fk, sak); srb = SC_MFMA(fr, fb, srb); srk = SC_MFMA(fr, fk, srk);
                }
#pragma unroll
                for (int q = 0; q < 4; ++q) { const int t = 4 * lq + q; const bool lo = lr < t, le = lr <= t;
                    *(LAS bf16_t*)(SB + O_AAK + (t * 16 + lr) * 2) = f2bf(lo ? sak[q] : 0.f);
                    *(LAS bf16_t*)(SB + O_ARK + (t * 32 + lr) * 2) = f2bf(le ? srb[q] : 0.f);
                    *(LAS bf16_t*)(SB + O_ARK + (t * 32 + 16 + lr) * 2) = f2bf(le ? srk[q] : 0.f); }
                { f32x4 tq;
#pragma unroll
                  for (int q = 0; q < 4; ++q) tq[q] = (lr < 4 * lq + q) ? sab[q] : 0.f;
                  *(LAS f32x4*)(SB + O_AAB + (lr * 16 + 4 * lq) * 4) = tq; }
                asm volatile("s_waitcnt lgkmcnt(0)" ::: "memory");
                if (lane == 0) ready[pw] = c + 1;
            }
        }
#undef SC_ROW
        __syncthreads();
    }
}

DI void unpack8u(const uint4 u, float (&d)[8]) { d[0] = bflo(u.x); d[1] = bfhi(u.x); d[2] = bflo(u.y); d[3] = bfhi(u.y); d[4] = bflo(u.z); d[5] = bfhi(u.z); d[6] = bflo(u.w); d[7] = bfhi(u.w); }
DI uint4 pack8u(const float (&d)[8]) { uint4 u; u.x = att::pk(d[0], d[1]); u.y = att::pk(d[2], d[3]); u.z = att::pk(d[4], d[5]); u.w = att::pk(d[6], d[7]); return u; }
DI void shift8(const bf16_t* P, int row, int t, int T, int col0, const float (&mu)[8], float (&o)[8]) {
    float c[8], pv[8], nx[8];
    unpack8u(*(const uint4*)(P + (size_t)row * PLD + col0), c);
    if (t > 0) unpack8u(*(const uint4*)(P + (size_t)(row - 1) * PLD + col0), pv); else {
#pragma unroll
        for (int i = 0; i < 8; ++i) pv[i] = 0.f; }
    if (t < T - 1) unpack8u(*(const uint4*)(P + (size_t)(row + 1) * PLD + col0), nx); else {
#pragma unroll
        for (int i = 0; i < 8; ++i) nx[i] = 0.f; }
#pragma unroll
    for (int i = 0; i < 8; ++i) o[i] = c[i] + mu[i] * (0.5f * (pv[i] + nx[i]) - c[i]);
}
DI void ld8f(const float* p, float (&d)[8]) { const float4 a = *(const float4*)p, b = *(const float4*)(p + 4); d[0] = a.x; d[1] = a.y; d[2] = a.z; d[3] = a.w; d[4] = b.x; d[5] = b.y; d[6] = b.z; d[7] = b.w; }
DI void ph_post_opt(const Ctx& cx, const Params& p, int j, int nrows) {
    const int tid = cx.tid, wid = tid >> 6, lane = tid & 63, c0 = lane * 8;
    float mur[8], muk[8], muv[8], ka[8], rk[8], lw[8], lb[8];
    ld8f(p.a_mu + j * ACOLS + c0, mur); ld8f(p.a_mu + j * ACOLS + 512 + c0, muk); ld8f(p.a_mu + j * ACOLS + 1024 + c0, muv);
    ld8f(p.a_k_a + j * 512 + c0, ka); ld8f(p.a_r_k + j * 512 + c0, rk); ld8f(p.a_ln_w + j * 512 + c0, lw); ld8f(p.a_ln_b + j * 512 + c0, lb);
    for (int row = cx.bid * 8 + wid; row < nrows; row += cx.nblk * 8) {
        const bool lat = row < NLAT; const int t = lat ? (row & 2047) : ((row - NLAT) & 255); const int T = lat ? 2048 : 256;
        float yf[8], yb[8], R[8], K[8], V[8], af[8], ab[8], g[8];
        unpack8u(*(const uint4*)(p.YF + (size_t)row * 512 + c0), yf); unpack8u(*(const uint4*)(p.YB + (size_t)row * 512 + c0), yb);
        shift8(p.P, row, t, T, c0, mur, R); shift8(p.P, row, t, T, 512 + c0, muk, K); shift8(p.P, row, t, T, 1024 + c0, muv, V);
        unpack8u(*(const uint4*)(p.WAG + (size_t)row * WLD + 1024 + c0), af); unpack8u(*(const uint4*)(p.WAG + (size_t)row * WLD + 1536 + c0), ab); unpack8u(*(const uint4*)(p.WAG + (size_t)row * WLD + 2048 + c0), g);
        float sum = 0.f, sb = 0.f;
#pragma unroll
        for (int i = 0; i < 8; ++i) { yf[i] += yb[i]; sum += yf[i]; sb += R[i] * rk[i] * K[i] * (2.f + (af[i] + ab[i] - 2.f) * ka[i]); }
        sum = scan::red8(sum); sb = scan::red8(sb);
        const float mean = sum * (1.f / 64.f); float var = 0.f;
#pragma unroll
        for (int i = 0; i < 8; ++i) { const float d = yf[i] - mean; var += d * d; }
        var = scan::red8(var);
        const float rstd = rsqrtf(var * (1.f / 64.f) + 64e-5f);
        float o[8];
#pragma unroll
        for (int i = 0; i < 8; ++i) o[i] = ((yf[i] - mean) * rstd * lw[i] + lb[i] + sb * V[i]) * g[i];
        *(uint4*)(p.H + (size_t)row * 1024 + c0) = pack8u(o);
    }
}
DI void fin_vec(float (&x)[8], int c, int t, bool lat, const float (&gn)[8], float scl, bf16_t* dst) {
    float ss = 0.f;
#pragma unroll
    for (int i = 0; i < 8; ++i) ss += x[i] * x[i];
    ss += dpp_f<0xB1>(ss); ss += dpp_f<0x4E>(ss); ss += dpp_f<0x141>(ss); ss += dpp_f<0x140>(ss);
    const float r = rsqrtf(ss * (1.f / 96.f) + 1e-6f);
#pragma unroll
    for (int i = 0; i < 8; ++i) x[i] = x[i] * r * gn[i];
    float y[8];
#pragma unroll
    for (int i = 0; i < 8; ++i) { const float up = dpp_f<0x102>(x[i]), dn = dpp_f<0x112>(x[i]); y[i] = (c < 10) ? up : dn; }
    if (lat && c >= 8 && c < 12) {
        const float invf[8] = {1.f, 0.316227766016838f, 0.1f, 0.0316227766016838f, 0.01f, 0.00316227766016838f, 0.001f, 0.000316227766016838f};
        const float pos = (c & 1) ? (float)(t & 63) : (float)(t >> 6);
#pragma unroll
        for (int i = 0; i < 8; ++i) { const float ang = pos * invf[i], cs = __cosf(ang), sn = __sinf(ang); x[i] = (c < 10) ? (x[i] * cs - y[i] * sn) : (x[i] * cs + y[i] * sn); }
    }
    if (c < 12) {
#pragma unroll
        for (int i = 0; i < 8; ++i) x[i] *= scl;
        *(uint4*)(dst + c * 8) = pack8u(x);
    }
}
DI void ph_finalize_opt(const Ctx& cx, const Params& p, float* ldsf, int j, int mq) {
    const int tid = cx.tid, wid = tid >> 6, lane = tid & 63, c = lane & 15, hq = lane >> 4;
    float qg[8], kg[8]; ld8f(p.b_q_gain + j * 96 + (c < 12 ? c : 0) * 8, qg); ld8f(p.b_k_gain + j * 96 + (c < 12 ? c : 0) * 8, kg);
    for (int row0 = (cx.bid * 8 + wid) * 2; row0 < NT; row0 += cx.nblk * 16) {
        float xq[4][8], xk[4][8];
#pragma unroll
        for (int u = 0; u < 4; ++u) {
            const int row = row0 + (u >> 1), h = (u & 1) * 4 + hq;
#pragma unroll
            for (int i = 0; i < 8; ++i) { xq[u][i] = 0.f; xk[u][i] = 0.f; }
            if (row < mq && c < 12) unpack8u(*(const uint4*)(p.Qraw + (size_t)row * 768 + h * 96 + c * 8), xq[u]);
            if (c < 8) unpack8u(*(const uint4*)(p.KVraw + (size_t)row * 1024 + h * 128 + c * 8), xk[u]);
            else if (c < 12) unpack8u(*(const uint4*)(p.P + (size_t)row * PLD + ACOLS + 384 + (c - 8) * 8), xk[u]);
        }
#pragma unroll
        for (int u = 0; u < 4; ++u) {
            const int row = row0 + (u >> 1), h = (u & 1) * 4 + hq;
            const bool lat = row < NLAT; const int b = lat ? (row >> 11) : ((row - NLAT) >> 8); const int t = lat ? (row & 2047) : ((row - NLAT) & 255);
            if (row < mq) fin_vec(xq[u], c, t, lat, qg, 0.10206207261596577f * 1.4426950408889634f, p.Qraw + (size_t)row * 768 + h * 96);
            const int key = lat ? 256 + t : t;
            fin_vec(xk[u], c, t, lat, kg, 1.f, p.Kf + ((size_t)(b * 8 + h) * 2304 + key) * 96);
        }
    }
    bf16_t* T = (bf16_t*)ldsf; constexpr int TP = 520;
    for (int tile = cx.bid; tile < NT / 64; tile += cx.nblk) {
        const int row0 = tile * 64; const bool lat = row0 < NLAT; const int b = lat ? (row0 >> 11) : ((row0 - NLAT) >> 8); const int t0 = lat ? (row0 & 2047) : ((row0 - NLAT) & 255);
        const int key0 = lat ? 256 + t0 : t0;
        __syncthreads();
#pragma unroll
        for (int i = 0; i < 8; ++i) { const int ch = tid + 512 * i, kr = ch >> 6, cc = ch & 63, h = cc >> 3, part = cc & 7;
            *(uint4*)(T + kr * TP + h * 64 + part * 8) = *(const uint4*)(p.KVraw + (size_t)(row0 + kr) * 1024 + h * 128 + 64 + part * 8); }
        __syncthreads();
#pragma unroll
        for (int i = 0; i < 8; ++i) { const int ch = tid + 512 * i, hd = ch >> 3, kc = ch & 7;
            float v[8];
#pragma unroll
            for (int q = 0; q < 8; ++q) v[q] = bf2f(T[(kc * 8 + q) * TP + hd]);
            uint4 o; o.x = (unsigned)T[(kc * 8 + 0) * TP + hd] | ((unsigned)T[(kc * 8 + 1) * TP + hd] << 16); o.y = (unsigned)T[(kc * 8 + 2) * TP + hd] | ((unsigned)T[(kc * 8 + 3) * TP + hd] << 16);
            o.z = (unsigned)T[(kc * 8 + 4) * TP + hd] | ((unsigned)T[(kc * 8 + 5) * TP + hd] << 16); o.w = (unsigned)T[(kc * 8 + 6) * TP + hd] | ((unsigned)T[(kc * 8 + 7) * TP + hd] << 16);
            (void)v;
            *(uint4*)(p.Vt + ((size_t)(b * 8 + (hd >> 6)) * 64 + (hd & 63)) * 2304 + key0 + kc * 8) = o; }
    }
    __syncthreads();
}
DI void ph_mod_opt(const Ctx& cx, const Params& p, float* lds) {
    const int tid = cx.tid, wid = tid >> 6, lane = tid & 63;
    float* part = lds + 17 * 1024;
    for (int i = tid; i < 17 * 1024; i += NTHR) { const int jj = i >> 10, k = i & 1023; const float v = (jj < 16) ? p.c[jj * 1024 + k] : p.c_ctx[k]; lds[i] = siluf(v); }
    __syncthreads();
    for (int item = cx.bid; item < 4 * 96; item += cx.nblk) {
        const int l = item / 96, n = (item % 96) * 64 + lane;
        const float* w = p.mod_w + (size_t)l * 1024 * 6144 + n;
        float acc[17];
#pragma unroll
        for (int jj = 0; jj < 17; ++jj) acc[jj] = 0.f;
        for (int k0 = wid * 128; k0 < wid * 128 + 128; k0 += 16) {
            float wv[16];
#pragma unroll
            for (int q = 0; q < 16; ++q) wv[q] = w[(size_t)(k0 + q) * 6144];
#pragma unroll
            for (int q = 0; q < 16; ++q)
#pragma unroll
                for (int jj = 0; jj < 17; ++jj) acc[jj] += lds[jj * 1024 + k0 + q] * wv[q];
        }
#pragma unroll
        for (int jj = 0; jj < 17; ++jj) part[(wid * 17 + jj) * 64 + lane] = acc[jj];
        __syncthreads();
        for (int o = tid; o < 17 * 64; o += NTHR) { const int jj = o >> 6, ln = o & 63; float sacc = p.mod_b[l * 6144 + (item % 96) * 64 + ln];
#pragma unroll
            for (int q = 0; q < 8; ++q) sacc += part[(q * 17 + jj) * 64 + ln];
            p.mod[((size_t)l * 17 + jj) * 6144 + (item % 96) * 64 + ln] = sacc; }
        __syncthreads();
    }
}

DI void ph_norm2_router(const Ctx& cx, const Params& p, float* ldsg, int nrows, const float* gain, const float* modl, int layer, const bf16_t* xb_lat) {
    LAS float* lds = (LAS float*)ldsg;
    const int tid = cx.tid, wid = tid >> 6, lane = tid & 63;
    LAS float* rw = lds; LAS float* red = lds + 16 * 1024 + wid * (32 * 64 + 64); LAS float* my = red + 32 * 64;
    LAS int* lcnt = (LAS int*)(lds + 16 * 1024 + 8 * (32 * 64 + 64)); LAS int* lbase = lcnt + 16; LAS int* rlist = lcnt + 32;
    for (int i = tid; i < 16 * 1024; i += NTHR) { const int e = i >> 10, col = i & 1023; rw[i] = p.router_w[col * 16 + e]; }
    if (tid < 16) lcnt[tid] = 0;
    __syncthreads();
    int nlist = 0;
    uint2 raw[2][4];
#define N2_LOAD(pi) do { _Pragma("unroll") for (int r = 0; r < 2; ++r) { const int row = 2 * (pi) + r; const bf16_t* xr = (row < NLAT) ? xb_lat + (size_t)row * 1024 : p.cs + (size_t)(row - NLAT) * 1024; \
            _Pragma("unroll") for (int i = 0; i < 4; ++i) raw[r][i] = *(const uint2*)(xr + i * 256 + lane * 4); } } while (0)
    { const int p0 = cx.bid * 8 + wid; if (xb_lat && p0 < (nrows >> 1)) N2_LOAD(p0); }
    for (int pidx = cx.bid * 8 + wid; pidx < (nrows >> 1); pidx += cx.nblk * 8) {
        float4 xv[2][4];
        if (xb_lat) {
#pragma unroll
            for (int r = 0; r < 2; ++r)
#pragma unroll
                for (int i = 0; i < 4; ++i) xv[r][i] = make_float4(bflo(raw[r][i].x), bfhi(raw[r][i].x), bflo(raw[r][i].y), bfhi(raw[r][i].y));
            const int pn = pidx + cx.nblk * 8; if (pn < (nrows >> 1)) N2_LOAD(pn);
        } else {
#pragma unroll
            for (int r = 0; r < 2; ++r) { const int row = 2 * pidx + r; const float* xr = (row < NLAT) ? p.out + (size_t)row * 1024 : p.ctxs + (size_t)(row - NLAT) * 1024;
#pragma unroll
                for (int i = 0; i < 4; ++i) xv[r][i] = *(const float4*)(xr + i * 256 + lane * 4); }
        }
        const int row0 = 2 * pidx; const int jj = (row0 < NLAT) ? (row0 >> 11) : 16;
        const float* shp = modl + (size_t)jj * 6144 + 3 * 1024; const float* scp = modl + (size_t)jj * 6144 + 4 * 1024;
        float4 hv[2][4];
#pragma unroll
        for (int r = 0; r < 2; ++r) {
            float ss = 0.f;
#pragma unroll
            for (int i = 0; i < 4; ++i) ss += xv[r][i].x * xv[r][i].x + xv[r][i].y * xv[r][i].y + xv[r][i].z * xv[r][i].z + xv[r][i].w * xv[r][i].w;
            ss = wave_sum(ss);
            const float rstd = rsqrtf(ss * (1.f / 1024.f) + 1e-6f);
#pragma unroll
            for (int i = 0; i < 4; ++i) {
                const int col = i * 256 + lane * 4;
                const float4 g = *(const float4*)(gain + col), sh = *(const float4*)(shp + col), sc = *(const float4*)(scp + col);
                hv[r][i].x = xv[r][i].x * rstd * g.x * (1.f + sc.x) + sh.x; hv[r][i].y = xv[r][i].y * rstd * g.y * (1.f + sc.y) + sh.y;
                hv[r][i].z = xv[r][i].z * rstd * g.z * (1.f + sc.z) + sh.z; hv[r][i].w = xv[r][i].w * rstd * g.w * (1.f + sc.w) + sh.w;
                uint2 u; u.x = att::pk(hv[r][i].x, hv[r][i].y); u.y = att::pk(hv[r][i].z, hv[r][i].w);
                *(uint2*)(p.H + (size_t)(row0 + r) * 1024 + col) = u;
            }
        }
#pragma unroll
        for (int e = 0; e < 16; ++e) {
            float a0 = 0.f, a1 = 0.f;
#pragma unroll
            for (int i = 0; i < 4; ++i) { const mm::f32x4 w = *(const LAS mm::f32x4*)(rw + e * 1024 + i * 256 + lane * 4);
                a0 += hv[0][i].x * w[0] + hv[0][i].y * w[1] + hv[0][i].z * w[2] + hv[0][i].w * w[3]; a1 += hv[1][i].x * w[0] + hv[1][i].y * w[1] + hv[1][i].z * w[2] + hv[1][i].w * w[3]; }
            red[e * 64 + lane] = a0; red[(16 + e) * 64 + lane] = a1;
        }
        __builtin_amdgcn_wave_barrier();
        {
            const int r = lane >> 5, e = (lane >> 1) & 15, half = lane & 1; const LAS float* src = red + (r * 16 + e) * 64 + half * 32;
            float sacc = 0.f;
#pragma unroll
            for (int q = 0; q < 8; ++q) { const mm::f32x4 v = *(const LAS mm::f32x4*)(src + q * 4); sacc += (v[0] + v[1]) + (v[2] + v[3]); }
            sacc += dpp_f<0xB1>(sacc);
            const float sg = 1.f / (1.f + __expf(-sacc));
            if (half == 0) { my[r * 32 + e] = sg; my[r * 32 + 16 + e] = sg + p.router_b[e]; }
        }
        __builtin_amdgcn_wave_barrier();
        if ((lane & 31) == 0) {
            const int r = lane >> 5; const LAS float* m = my + r * 32;
            float best = -3.0e38f; int be1 = 0, be2 = 1;
#pragma unroll
            for (int g = 0; g < 4; ++g) {
                const mm::f32x4 v = *(const LAS mm::f32x4*)(m + 16 + 4 * g);
                int i1 = 0; float m1 = v[0];
                if (v[1] > m1) { m1 = v[1]; i1 = 1; } if (v[2] > m1) { m1 = v[2]; i1 = 2; } if (v[3] > m1) { m1 = v[3]; i1 = 3; }
                int i2 = -1; float m2 = -3.0e38f;
                if (i1 != 0 && v[0] > m2) { m2 = v[0]; i2 = 0; } if (i1 != 1 && v[1] > m2) { m2 = v[1]; i2 = 1; }
                if (i1 != 2 && v[2] > m2) { m2 = v[2]; i2 = 2; } if (i1 != 3 && v[3] > m2) { m2 = v[3]; i2 = 3; }
                const float gs = m1 + m2;
                if (gs > best) { best = gs; be1 = 4 * g + i1; be2 = 4 * g + i2; }
            }
            const float bs1 = m[be1], bs2 = m[be2]; const float inv = 1.f / (bs1 + bs2);
            const int p1 = atomicAdd((int*)&lcnt[be1], 1), p2 = atomicAdd((int*)&lcnt[be2], 1);
            LAS int* ent = rlist + (wid * 24 + nlist * 2 + r) * 6;
            const int row = row0 + r;
            ent[0] = row; ent[1] = be1 | (be2 << 8); ent[2] = p1; ent[3] = p2; ent[4] = __float_as_int(bs1 * inv); ent[5] = __float_as_int(bs2 * inv);
        }
        ++nlist;
        __builtin_amdgcn_wave_barrier();
    }
#undef N2_LOAD
    __syncthreads();
    if (tid < 16) lbase[tid] = atomicAdd(p.cnt + (layer * 16 + tid) * 64, lcnt[tid]);
    __syncthreads();
    for (int k = lane; k < 2 * nlist; k += 64) {
        const LAS int* ent = rlist + (wid * 24 + k) * 6; const int row = ent[0], be1 = ent[1] & 255, be2 = ent[1] >> 8;
        const size_t s1 = (size_t)be1 * NT + lbase[be1] + ent[2], s2 = (size_t)be2 * NT + lbase[be2] + ent[3];
        p.slot[s1] = row * 2; p.slot[s2] = row * 2 + 1; p.slotw[s1] = __int_as_float(ent[4]); p.slotw[s2] = __int_as_float(ent[5]);
    }
    __syncthreads();
}

DI void ph_prepBLR_opt(const Ctx& cx, const Params& p, int j) {
    const int tid = cx.tid, wid = tid >> 6, lane = tid & 63;
    const float4 gq = *(const float4*)(p.b_q_norm + j * 256 + lane * 4); const float2 gk = *(const float2*)(p.b_kv_norm + j * 128 + lane * 2);
    constexpr int U = 8;
    for (int row0 = (cx.bid * 8 + wid) * U; row0 < NT; row0 += cx.nblk * 8 * U) {
        uint2 uq[U]; unsigned ukv[U];
#pragma unroll
        for (int u = 0; u < U; ++u) { const bf16_t* pr = p.P + (size_t)(row0 + u) * PLD + ACOLS; uq[u] = *(const uint2*)(pr + lane * 4); ukv[u] = *(const unsigned*)(pr + 256 + lane * 2); }
#pragma unroll
        for (int u = 0; u < U; ++u) {
            const float q0 = bflo(uq[u].x), q1 = bfhi(uq[u].x), q2 = bflo(uq[u].y), q3 = bfhi(uq[u].y), k0 = bflo(ukv[u]), k1 = bfhi(ukv[u]);
            const float sq = wave_sum(q0 * q0 + q1 * q1 + q2 * q2 + q3 * q3), sk = wave_sum(k0 * k0 + k1 * k1);
            const float rq = rsqrtf(sq * (1.f / 256.f) + 1e-6f), rk = rsqrtf(sk * (1.f / 128.f) + 1e-6f);
            uint2 o; o.x = att::pk(q0 * rq * gq.x, q1 * rq * gq.y); o.y = att::pk(q2 * rq * gq.z, q3 * rq * gq.w);
            bf16_t* qn = p.QN + (size_t)(row0 + u) * 512;
            *(uint2*)(qn + lane * 4) = o; *(unsigned*)(qn + 256 + lane * 2) = att::pk(k0 * rk * gk.x, k1 * rk * gk.y); *(unsigned*)(qn + 384 + lane * 2) = 0u;
        }
    }
    const int gtid = cx.bid * NTHR + tid, gsz = cx.nblk * NTHR;
    for (int idx = gtid; idx < NT * 48; idx += gsz) {
        const int row = idx / 48, cg = idx % 48, col0 = cg * 8;
        const bool lat = row < NLAT; const int t = lat ? (row & 2047) : ((row - NLAT) & 255); const int T = lat ? 2048 : 256;
        float mu[8]; ld8f(p.a_mu + j * ACOLS + 1536 + col0, mu);
        float v[8]; shift8(p.P, row, t, T, 1536 + col0, mu, v);
        if (cg < 16) {
#pragma unroll
            for (int i = 0; i < 8; ++i) { const float e = __expf(2.f * v[i]); v[i] = 1.f - 2.f * __builtin_amdgcn_rcpf(e + 1.f); }
        } else if (cg >= 32) {
#pragma unroll
            for (int i = 0; i < 8; ++i) v[i] = __builtin_amdgcn_rcpf(1.f + __expf(-v[i]));
        }
        *(uint4*)(p.LR + (size_t)row * 384 + col0) = pack8u(v);
    }
}

template <bool FINAL>
DI void ph_normc(const Ctx& cx, const Params& p, int nrows, const bf16_t* xin_lat, bf16_t* xout_lat, const float* gain, const float* modl, const float* modprev) {
    const int tid = cx.tid, wid = tid >> 6, lane = tid & 63;
    for (int row = cx.bid * 8 + wid; row < nrows; row += cx.nblk * 8) {
        const bool lat = row < NLAT; const int jj = lat ? (row >> 11) : 16; const size_t rb = lat ? (size_t)row : (size_t)(row - NLAT);
        const bf16_t* xr = (lat ? xin_lat : p.cs) + rb * 1024;
        const float* g2 = modprev + (size_t)jj * 6144 + 5 * 1024;
        float4 xv[4];
#pragma unroll
        for (int i = 0; i < 4; ++i) {
            const int col = i * 256 + lane * 4;
            const uint2 ux = *(const uint2*)(xr + col);
            float s0 = 0.f, s1 = 0.f, s2 = 0.f, s3 = 0.f;
#pragma unroll
            for (int sl = 0; sl < 3; ++sl) { const uint2 u = *(const uint2*)(p.Y + ((size_t)sl * NT + row) * 1024 + col); s0 += bflo(u.x); s1 += bfhi(u.x); s2 += bflo(u.y); s3 += bfhi(u.y); }
            const float4 gv = *(const float4*)(g2 + col);
            xv[i].x = bflo(ux.x) + gv.x * s0; xv[i].y = bfhi(ux.x) + gv.y * s1; xv[i].z = bflo(ux.y) + gv.z * s2; xv[i].w = bfhi(ux.y) + gv.w * s3;
            if (FINAL) *(float4*)(p.out + (size_t)row * 1024 + col) = xv[i];
            else { uint2 o; o.x = att_pk(xv[i].x, xv[i].y); o.y = att_pk(xv[i].z, xv[i].w); *(uint2*)((lat ? xout_lat : p.cs) + rb * 1024 + col) = o; }
        }
        if (!FINAL) {
            float ss = 0.f;
#pragma unroll
            for (int i = 0; i < 4; ++i) ss += xv[i].x * xv[i].x + xv[i].y * xv[i].y + xv[i].z * xv[i].z + xv[i].w * xv[i].w;
            ss = wave_sum(ss);
            const float rstd = rsqrtf(ss * (1.f / 1024.f) + 1e-6f);
            const float* shp = modl + (size_t)jj * 6144; const float* scp = modl + (size_t)jj * 6144 + 1024;
#pragma unroll
            for (int i = 0; i < 4; ++i) {
                const int col = i * 256 + lane * 4;
                const float4 g = *(const float4*)(gain + col), sh = *(const float4*)(shp + col), sc = *(const float4*)(scp + col);
                uint2 u; u.x = att_pk(xv[i].x * rstd * g.x * (1.f + sc.x) + sh.x, xv[i].y * rstd * g.y * (1.f + sc.y) + sh.y);
                u.y = att_pk(xv[i].z * rstd * g.z * (1.f + sc.z) + sh.z, xv[i].w * rstd * g.w * (1.f + sc.w) + sh.w);
                *(uint2*)(p.H + (size_t)row * 1024 + col) = u;
            }
        }
    }
}

struct F1Sched {
    static constexpr bool GATHER = false, TABLE = false;
    const char* A; const char* Hb; int T2, nN, G, c;
    DI size_t hstep_a() const { return (size_t)mm::HALF * 1024 * 2; }
    DI unsigned boff(int Rb, int C, int Kk) const { return (unsigned)(Rb * T2 * Kk + C) * 2u; }
    DI size_t hstep_b(int Kk) const { return (size_t)Kk * 2; }
    DI bool next(int i, mm::Unit& u) const {
        const int L = i * G + c; if (L >= 8 * nN) return false;
        u.pm = L & 7; u.pn = L >> 3; u.e = 0; u.m = 0;
        const int b = (T2 == 16) ? (u.pn >> 3) : u.pn, t20 = (T2 == 16) ? 2 * (u.pn & 7) : 0;
        u.A = A + (size_t)u.pm * 256 * 1024 * 2; u.B = Hb + ((size_t)b * (128 * T2) + t20) * 1024 * 2; return true;
    }
    DI void aoff(const mm::Unit&, int R0, int C0, int R1, int C1, unsigned (&o)[2][2]) const {
        o[0][0] = (unsigned)(R0 * 1024 + C0) * 2u; o[0][1] = (unsigned)(R1 * 1024 + C1) * 2u; o[1][0] = o[0][0]; o[1][1] = o[0][1];
    }
};
struct EpiZT3 {
    static constexpr bool PERM = true;
    bf16_t* Z; int T2;
    DI void operator()(const mm::f32x4 (&acc)[2][2][4][2], const mm::Unit& u, int wr, int wc, int fr, int fq) const {
        const int b = (T2 == 16) ? (u.pn >> 3) : u.pn, t20 = (T2 == 16) ? 2 * (u.pn & 7) : 0;
        const int m0 = u.pm * 256 + wr * 64 + fr, t1 = wc * 32 + 8 * fq;
#pragma unroll
        for (int ai = 0; ai < 2; ++ai)
#pragma unroll
            for (int m = 0; m < 4; ++m) { const int mr = m0 + ai * 128 + m * 16, part = mr >> 10, ch = mr & 1023;
#pragma unroll
                for (int bj = 0; bj < 2; ++bj) { const mm::f32x4 v0 = acc[ai][bj][m][0], v1 = acc[ai][bj][m][1];
                    mm::u32x4 w; w.x = att_pk(v0[0], v0[1]); w.y = att_pk(v0[2], v0[3]); w.z = att_pk(v1[0], v1[1]); w.w = att_pk(v1[2], v1[3]);
                    *(mm::u32x4*)(Z + ((size_t)(b * 1024 + ch) * T2 + t20 + bj) * 256 + part * 128 + t1) = w; } }
    }
};
DI void ph_f1b(const Ctx& cx, const Params& p, float* lds, int j, bool with_ctx) {
    { F1Sched S{(const char*)(p.A1 + (size_t)j * 2048 * 1024), (const char*)p.H, 16, NLAT / 256, cx.nblk, cx.bid}; EpiZT3 E{p.ZT, 16}; mm::gemm_phase(GEMM_LDS(lds), 1024, S, E, cx.tid); }
    if (with_ctx) { F1Sched S{(const char*)(p.A1 + (size_t)j * 2048 * 1024), (const char*)(p.H + (size_t)NLAT * 1024), 2, NCTX / 256, cx.nblk, cx.bid}; EpiZT3 E{p.ZTC, 2}; mm::gemm_phase(GEMM_LDS(lds), 1024, S, E, cx.tid); }
}
DI void ph_fa(const Ctx& cx, const Params& p, float* lds, bool with_ctx) {
    int Kr = 256; asm volatile("" : "+s"(Kr));
    { mm::BatchSched S; S.init(p.M1, p.ZT, (size_t)16384 * 256 * 2, 16, 256, 16384, Kr, cx.nblk, cx.bid); mm::EpiBf16Store E{p.YF1, 16384, (size_t)256 * 16384}; mm::gemm_phase(GEMM_LDS(lds), Kr, S, E, cx.tid); }
    if (with_ctx) { mm::BatchSched S; S.init(p.M1, p.ZTC, (size_t)2048 * 256 * 2, 16, 256, 2048, Kr, cx.nblk, cx.bid); mm::EpiBf16Store E{p.YF1c, 2048, (size_t)256 * 2048}; mm::gemm_phase(GEMM_LDS(lds), Kr, S, E, cx.tid); }
}
template <int T2>
DI void fb_items(const Ctx& cx, const Params& p, const LAS float* tw, const bf16_t* Y, const bf16_t* xin, bf16_t* xout, const float* modl, bool ctx, float scale) {
    constexpr int T = 128 * T2; constexpr size_t NB = (size_t)1024 * T2;
    const int gtid = cx.bid * NTHR + cx.tid, gsz = cx.nblk * NTHR;
    for (int idx = gtid; idx < 16 * 128 * 512; idx += gsz) {
        const int cp = idx & 511, f1 = (idx >> 9) & 127, b = idx >> 16;
        float yr[2][T2], yi[2][T2];
        { const bf16_t* pr = Y + ((size_t)b * 256 + f1) * NB + (size_t)(2 * cp) * T2; const bf16_t* pi = pr + (size_t)128 * NB;
          if constexpr (T2 == 2) { const uint2 ur = *(const uint2*)pr, ui = *(const uint2*)pi;
              yr[0][0] = bflo(ur.x); yr[0][1] = bfhi(ur.x); yr[1][0] = bflo(ur.y); yr[1][1] = bfhi(ur.y); yi[0][0] = bflo(ui.x); yi[0][1] = bfhi(ui.x); yi[1][0] = bflo(ui.y); yi[1][1] = bfhi(ui.y); }
          else {
#pragma unroll
          for (int q = 0; q < (2 * T2) / 8; ++q) { float d[8]; unpack8u(*(const uint4*)(pr + q * 8), d);
#pragma unroll
              for (int e = 0; e < 8; ++e) yr[(q * 8 + e) / T2][(q * 8 + e) % T2] = d[e];
              unpack8u(*(const uint4*)(pi + q * 8), d);
#pragma unroll
              for (int e = 0; e < 8; ++e) yi[(q * 8 + e) / T2][(q * 8 + e) % T2] = d[e]; } } }
        const int jj = ctx ? 16 : b; const float2 g1 = *(const float2*)(modl + (size_t)jj * 6144 + 2 * 1024 + 2 * cp);
        constexpr int FG = (T2 >= 4) ? 4 : T2;
#pragma unroll 1
        for (int fg = 0; fg < T2; fg += FG) {
            unsigned xv[FG];
#pragma unroll
            for (int q = 0; q < FG; ++q) xv[q] = *(const unsigned*)(xin + ((size_t)b * T + f1 + 128 * (fg + q)) * 1024 + 2 * cp);
#pragma unroll
            for (int q = 0; q < FG; ++q) {
                const int f = f1 + 128 * (fg + q); float a0 = 0.f, a1 = 0.f;
#pragma unroll
                for (int t2 = 0; t2 < T2; ++t2) { const int mi = ((t2 * f) & (T - 1)) * (2048 / T); const float cs = tw[2 * mi], sn = tw[2 * mi + 1];
                    a0 += cs * yr[0][t2] + sn * yi[0][t2]; a1 += cs * yr[1][t2] + sn * yi[1][t2]; }
                *(unsigned*)(xout + ((size_t)b * T + f) * 1024 + 2 * cp) = att_pk(bflo(xv[q]) + g1.x * scale * a0, bfhi(xv[q]) + g1.y * scale * a1);
            }
        }
    }
}
DI void fb_mfma(const Ctx& cx, const Params& p, const LAS float* tw, const bf16_t* Y, const bf16_t* xin, bf16_t* xout, const float* modl) {
    typedef short bf16x8 __attribute__((ext_vector_type(8)));
    constexpr size_t NB = (size_t)1024 * 16;
    const int tid = cx.tid, wid = tid >> 6, lane = tid & 63, lq = lane >> 4, lr = lane & 15;
    const int part = lq >> 1, t20 = 8 * (lq & 1);
    for (int item = cx.bid * 8 + wid; item < 16 * 128 * 32; item += cx.nblk * 8) {
        const int cb = item & 31, f1 = (item >> 5) & 127, b = item >> 12, c0 = cb * 32;
        const bf16_t* yb = Y + ((size_t)b * 256 + part * 128 + f1) * NB + t20;
        const int chA = c0 + 8 * (lr >> 2) + (lr & 3);
        const bf16x8 a0 = *(const bf16x8*)(yb + (size_t)chA * 16), a1 = *(const bf16x8*)(yb + (size_t)(chA + 4) * 16);
        const int f = f1 + 128 * lr;
        mm::u32x4 bw;
        { float tv[8];
#pragma unroll
          for (int jj = 0; jj < 8; ++jj) { const int mi = ((t20 + jj) * f) & 2047; tv[jj] = tw[2 * mi + part]; }
          bw.x = att_pk(tv[0], tv[1]); bw.y = att_pk(tv[2], tv[3]); bw.z = att_pk(tv[4], tv[5]); bw.w = att_pk(tv[6], tv[7]); }
        const bf16x8 bf = __builtin_bit_cast(bf16x8, bw);
        mm::f32x4 d0 = {0.f, 0.f, 0.f, 0.f}, d1 = d0;
        d0 = __builtin_amdgcn_mfma_f32_16x16x32_bf16(a0, bf, d0, 0, 0, 0);
        d1 = __builtin_amdgcn_mfma_f32_16x16x32_bf16(a1, bf, d1, 0, 0, 0);
        const float* g1 = modl + (size_t)b * 6144 + 2 * 1024 + c0 + 8 * lq;
        const mm::f32x4 g0 = *(const mm::f32x4*)g1, g4 = *(const mm::f32x4*)(g1 + 4);
        const size_t off = ((size_t)b * 2048 + f) * 1024 + c0 + 8 * lq;
        const mm::u32x4 xv = *(const mm::u32x4*)(xin + off);
        const float sc = 1.f / 512.f;
        mm::u32x4 o;
        o.x = att_pk(bflo(xv.x) + g0[0] * sc * d0[0], bfhi(xv.x) + g0[1] * sc * d0[1]); o.y = att_pk(bflo(xv.y) + g0[2] * sc * d0[2], bfhi(xv.y) + g0[3] * sc * d0[3]);
        o.z = att_pk(bflo(xv.z) + g4[0] * sc * d1[0], bfhi(xv.z) + g4[1] * sc * d1[1]); o.w = att_pk(bflo(xv.w) + g4[2] * sc * d1[2], bfhi(xv.w) + g4[3] * sc * d1[3]);
        *(mm::u32x4*)(xout + off) = o;
    }
}
DI void ph_fb(const Ctx& cx, const Params& p, float* ldsg, bool with_ctx, const bf16_t* xin_lat, bf16_t* xout_lat, const float* modl) {
    LAS float* tw = (LAS float*)ldsg;
    for (int i = cx.tid; i < 2048; i += NTHR) { const float a = (float)i * (1.f / 1024.f); tw[2 * i] = cospif(a); tw[2 * i + 1] = sinpif(a); }
    __syncthreads();
    fb_mfma(cx, p, tw, p.YF1, xin_lat, xout_lat, modl);
    if (with_ctx) fb_items<2>(cx, p, tw, p.YF1c, p.cs, p.cs, modl, true, 0.0055242717280199f);
    __syncthreads();
}

DI void ph_norm2_router_mfma(const Ctx& cx, const Params& p, float* ldsg, int nrows, const float* gain, const float* modl, int layer, const bf16_t* xb_lat) {
    LAS float* lds = (LAS float*)ldsg;
    const int tid = cx.tid, wid = tid >> 6, lane = tid & 63, lq = lane >> 4, lr = lane & 15;
    constexpr int HP = 1026;
    LAS float* wl = lds; LAS float* hb = lds + 16384; LAS float* red = hb + 16 * HP; LAS float* myall = red + 2048;
    LAS int* lcnt = (LAS int*)(myall + 512); LAS int* lbase = lcnt + 16; LAS int* rlist = lcnt + 32;
    for (int i = tid; i < 16384; i += NTHR) wl[i] = p.router_w[i];
    if (tid < 16) lcnt[tid] = 0;
    __syncthreads();
    int nlist = 0;
    for (int grp = cx.bid; grp < (nrows >> 4); grp += cx.nblk) {
        const int row0 = 16 * grp + 2 * wid; const int jj = (row0 < NLAT) ? (row0 >> 11) : 16;
        const float* shp = modl + (size_t)jj * 6144 + 3 * 1024; const float* scp = modl + (size_t)jj * 6144 + 4 * 1024;
        float4 xv[2][4];
#pragma unroll
        for (int r = 0; r < 2; ++r) { const int row = row0 + r; const bf16_t* xr = (row < NLAT) ? xb_lat + (size_t)row * 1024 : p.cs + (size_t)(row - NLAT) * 1024;
#pragma unroll
            for (int i = 0; i < 4; ++i) { const uint2 u = *(const uint2*)(xr + i * 256 + lane * 4); xv[r][i] = make_float4(bflo(u.x), bfhi(u.x), bflo(u.y), bfhi(u.y)); } }
#pragma unroll
        for (int r = 0; r < 2; ++r) {
            float ss = 0.f;
#pragma unroll
            for (int i = 0; i < 4; ++i) ss += xv[r][i].x * xv[r][i].x + xv[r][i].y * xv[r][i].y + xv[r][i].z * xv[r][i].z + xv[r][i].w * xv[r][i].w;
            ss = wave_sum(ss);
            const float rstd = rsqrtf(ss * (1.f / 1024.f) + 1e-6f);
#pragma unroll
            for (int i = 0; i < 4; ++i) {
                const int col = i * 256 + lane * 4;
                const float4 g = *(const float4*)(gain + col), sh = *(const float4*)(shp + col), sc = *(const float4*)(scp + col);
                const float h0 = xv[r][i].x * rstd * g.x * (1.f + sc.x) + sh.x, h1 = xv[r][i].y * rstd * g.y * (1.f + sc.y) + sh.y;
                const float h2 = xv[r][i].z * rstd * g.z * (1.f + sc.z) + sh.z, h3 = xv[r][i].w * rstd * g.w * (1.f + sc.w) + sh.w;
                uint2 u; u.x = att_pk(h0, h1); u.y = att_pk(h2, h3);
                *(uint2*)(p.H + (size_t)(row0 + r) * 1024 + col) = u;
                LAS float* hp = hb + (2 * wid + r) * HP + col;
                *(LAS scan::f32x2*)hp = (scan::f32x2){h0, h1}; *(LAS scan::f32x2*)(hp + 2) = (scan::f32x2){h2, h3};
            }
        }
        __syncthreads();
        {
            mm::f32x4 acc = {0.f, 0.f, 0.f, 0.f};
            const LAS float* ap = hb + lr * HP + 128 * wid + lq; const LAS float* bp = wl + (128 * wid + lq) * 16 + lr;
#pragma unroll 8
            for (int s = 0; s < 32; ++s) acc = __builtin_amdgcn_mfma_f32_16x16x4f32(ap[4 * s], bp[64 * s], acc, 0, 0, 0);
#pragma unroll
            for (int q = 0; q < 4; ++q) red[wid * 256 + (4 * lq + q) * 16 + lr] = acc[q];
        }
        __syncthreads();
        if (tid < 256) { const int row = tid >> 4, e = tid & 15; float sacc = 0.f;
#pragma unroll
            for (int w = 0; w < 8; ++w) sacc += red[w * 256 + row * 16 + e];
            const float sg = 1.f / (1.f + __expf(-sacc));
            myall[row * 32 + e] = sg; myall[row * 32 + 16 + e] = sg + p.router_b[e]; }
        __syncthreads();
        if ((lane & 31) == 0) {
            const int r = lane >> 5; const LAS float* m = myall + (2 * wid + r) * 32;
            float best = -3.0e38f; int be1 = 0, be2 = 1;
#pragma unroll
            for (int g = 0; g < 4; ++g) {
                const mm::f32x4 v = *(const LAS mm::f32x4*)(m + 16 + 4 * g);
                int i1 = 0; float m1 = v[0];
                if (v[1] > m1) { m1 = v[1]; i1 = 1; } if (v[2] > m1) { m1 = v[2]; i1 = 2; } if (v[3] > m1) { m1 = v[3]; i1 = 3; }
                int i2 = -1; float m2 = -3.0e38f;
                if (i1 != 0 && v[0] > m2) { m2 = v[0]; i2 = 0; } if (i1 != 1 && v[1] > m2) { m2 = v[1]; i2 = 1; }
                if (i1 != 2 && v[2] > m2) { m2 = v[2]; i2 = 2; } if (i1 != 3 && v[3] > m2) { m2 = v[3]; i2 = 3; }
                const float gs = m1 + m2;
                if (gs > best) { best = gs; be1 = 4 * g + i1; be2 = 4 * g + i2; }
            }
            const float bs1 = m[be1], bs2 = m[be2]; const float inv = 1.f / (bs1 + bs2);
            const int p1 = atomicAdd((int*)&lcnt[be1], 1), p2 = atomicAdd((int*)&lcnt[be2], 1);
            LAS int* ent = rlist + (wid * 24 + nlist * 2 + r) * 6;
            ent[0] = row0 + r; ent[1] = be1 | (be2 << 8); ent[2] = p1; ent[3] = p2; ent[4] = __float_as_int(bs1 * inv); ent[5] = __float_as_int(bs2 * inv);
        }
        ++nlist;
    }
    __syncthreads();
    if (tid < 16) lbase[tid] = atomicAdd(p.cnt + (layer * 16 + tid) * 64, lcnt[tid]);
    __syncthreads();
    for (int k = lane; k < 2 * nlist; k += 64) {
        const LAS int* ent = rlist + (wid * 24 + k) * 6; const int row = ent[0], be1 = ent[1] & 255, be2 = ent[1] >> 8;
        const size_t s1 = (size_t)be1 * NT + lbase[be1] + ent[2], s2 = (size_t)be2 * NT + lbase[be2] + ent[3];
        p.slot[s1] = row * 2; p.slot[s2] = row * 2 + 1; p.slotw[s1] = __int_as_float(ent[4]); p.slotw[s2] = __int_as_float(ent[5]);
    }
    __syncthreads();
}

template <int PH>
DI void run_phase(const Params& p, float* lds, int L, int wave_id) {
    const Ctx cx = make_ctx(wave_id);
    const int j = L >> 1;
    const float* modl = p.mod + (size_t)L * 17 * 6144;
    const float* modprev = p.mod + (size_t)(L > 0 ? L - 1 : 0) * 17 * 6144;
    const bool last = (L == 3);
    const int rows_layer = (L == 3) ? NLAT : NT;
    const int rows_out = (L >= 2) ? NLAT : NT;
    const float* xin_lat = (L == 0) ? p.x : p.out; const float* xin_ctx = (L == 0) ? p.ctx : p.ctxs;
    constexpr bool BFS = (OPT >= 11);
    const void* bin_lat = (L == 0) ? (const void*)p.x : (const void*)p.xs; const void* bin_ctx = (L == 0) ? (const void*)p.ctx : (const void*)p.cs;
    bf16_t* bout_lat = (L == 3) ? p.xs3 : p.xs;
    if constexpr (PH == 0) { if (OPT >= 7) { ph_mod_opt(cx, p, lds); for (int i = cx.bid * NTHR + cx.tid; i < 1024; i += cx.nblk * NTHR) p.H[(size_t)NT * 1024 + i] = 0; } else ph_prologue(cx, p, lds); ph_prep_weights(cx, p, lds); }
    if constexpr (PH == 1) {
        if (OPT >= 4 && !PROBE_SPLIT1) ph_prep_moe(cx, p, lds, L);
        if (BFS && L > 0) { ph_normc<false>(cx, p, rows_layer, p.xs, p.xs, p.norm1_g + L * 1024, modl, modprev); return; }
        if (L == 0) ph_norm<false, true, false>(cx, p, lds, rows_layer, xin_lat, xin_ctx, p.norm1_g + L * 1024, modl, 0, 1, modprev, L);
        else ph_norm<true, true, false>(cx, p, lds, rows_layer, xin_lat, xin_ctx, p.norm1_g + L * 1024, modl, 0, 1, modprev, L);
    }
    if constexpr (PH == 2) { if (OPT >= 1) ph_win_mm(cx, p, lds, j); else ph_win(cx, p, lds, j); }
    if constexpr (PH == 3) { if (OPT >= 10) ph_prepBLR_opt(cx, p, j); else ph_prepB(cx, p, j); }
    if constexpr (PH == 4) { if (OPT >= 2) ph_qkvup_mm(cx, p, lds, j, rows_out); else ph_qkvup(cx, p, lds, j, rows_out); }
    if constexpr (PH == 5) { if (OPT >= 7) ph_finalize_opt(cx, p, lds, j, rows_out); else ph_finalize(cx, p, j, rows_out); }
    if constexpr (PH == 6) { if (OPT >= 5) ph_attn_mm(cx, p, lds, rows_out == NT); else ph_attn(cx, p, rows_out == NT); }
    if constexpr (PH == 7) { if (OPT < 10) ph_prepLR(cx, p, j); }
    if constexpr (PH == 8) { if (OPT >= 2) ph_wag_mm(cx, p, lds, j); else ph_wag(cx, p, lds, j); }
    if constexpr (PH == 9) { if (OPT >= 9) ph_scan_chunk<0>(cx, p, lds, j); else if (OPT >= 6) ph_scan_opt<0>(cx, p, lds, j); else ph_scan(cx, p, lds, j); }
    if constexpr (PH == 19) ph_scan_chunk<PROBE_SCAN>(cx, p, lds, j);
    if constexpr (PH == 20) ph_prep_moe(cx, p, lds, L);
    if constexpr (PH == 21) ph_win_probe(cx, p, lds, j);
    if constexpr (PH == 10) { if (OPT >= 7) ph_post_opt(cx, p, j, rows_out); else ph_post(cx, p, j, rows_out); }
    if constexpr (PH == 11) { if (BFS) ph_wout_mmB(cx, p, lds, p.H, p.WoutT + (size_t)j * 1024 * 1024, rows_out, bin_lat, bin_ctx, bout_lat, L == 0, modl); else if (OPT >= 1) ph_wout_mm(cx, p, lds, p.H, p.WoutT + (size_t)j * 1024 * 1024, rows_out, xin_lat, xin_ctx, modl); else ph_wout(cx, p, lds, p.H, p.w_out_even + (size_t)j * 1024 * 1024, rows_out, xin_lat, xin_ctx, modl); }
    if constexpr (PH == 12) { if (OPT >= 12) ph_f1b(cx, p, lds, j, !last); else if (OPT >= 3) ph_f1_mm(cx, p, lds, j, !last); else ph_chdft(cx, p, lds, rows_layer); }
    if constexpr (PH == 13) { if (OPT >= 12) ph_fa(cx, p, lds, !last); else if (BFS) ph_f2_mmB(cx, p, lds, !last, bin_lat, bin_ctx, bout_lat, modl); else if (OPT >= 3) ph_f2_mm(cx, p, lds, !last, xin_lat, xin_ctx, modl); else ph_posdft(cx, p, lds, !last); }
    if constexpr (PH == 14) { if (OPT >= 12) ph_fb(cx, p, lds, !last, p.xs, bout_lat, modl); }
    if constexpr (PH == 14) { if (OPT < 3) ph_wout(cx, p, lds, p.F, p.w_out_fourier + (size_t)j * 1024 * 1024, rows_out, xin_lat, xin_ctx, modl); }
    if constexpr (PH == 15) { if (OPT >= 13) ph_norm2_router_mfma(cx, p, lds, rows_out, p.norm2_g + L * 1024, modl, L, bout_lat); else if (OPT >= 8) ph_norm2_router(cx, p, lds, rows_out, p.norm2_g + L * 1024, modl, L, BFS ? bout_lat : (const bf16_t*)nullptr); else ph_norm<false, true, true>(cx, p, lds, rows_out, p.out, p.ctxs, p.norm2_g + L * 1024, modl, 3, 4, modprev, L); }
    if constexpr (PH == 16) { if (OPT >= 4) ph_moe_up_mm(cx, p, lds, L, rows_out); else ph_moe_up(cx, p, lds, L, rows_out); }
    if constexpr (PH == 17) { if (OPT >= 4) ph_moe_down_mm(cx, p, lds, L, rows_out); else ph_moe_down(cx, p, lds, L, rows_out); }
    if constexpr (PH == 18) { if (BFS) { ph_normc<true>(cx, p, NLAT, p.xs3, nullptr, p.norm1_g, p.mod + (size_t)3 * 17 * 6144, p.mod + (size_t)3 * 17 * 6144); return; } }
    if constexpr (PH == 18) ph_norm<true, false, false>(cx, p, lds, NLAT, p.out, p.ctxs, p.norm1_g, p.mod + (size_t)3 * 17 * 6144, 0, 1, p.mod + (size_t)3 * 17 * 6144, 3);
}

template <int PH>
__global__ void __launch_bounds__(NTHR, 2) k_phase(Params p, int L) {
    extern __shared__ __attribute__((aligned(16))) float shm[];
    run_phase<PH>(p, shm, L, (int)(threadIdx.x >> 6));
}

#if ONE_LAUNCH
constexpr int PARAM_WORDS = (int)(sizeof(Params) / 4);
DI Params load_params(const unsigned* lp) {
    Params q; unsigned* d = (unsigned*)&q;
#pragma unroll
    for (int i = 0; i < PARAM_WORDS; ++i) d[i] = (unsigned)__builtin_amdgcn_readfirstlane((int)lp[i]);
    void** pp = (void**)&q;
#pragma unroll
    for (int i = 0; i < PARAM_WORDS / 2; ++i) pp[i] = (void*)(__attribute__((address_space(1))) void*)pp[i];
    return q;
}
#ifndef PROBE_MASK
#define PROBE_MASK 0u
#endif

#define PHASE(PH, L) do { unsigned long long t0_ = 0; if (PROBE_MASK & (1u << (PH))) t0_ = wall_clock64(); \
    { run_phase<PH>(p, lds, (L), wave_id); } xcd_barrier(bar, wave_id == 0 && lane_id_asm() == 0); \
    if (PROBE_MASK & (1u << (PH))) tacc += wall_clock64() - t0_; } while (0)
__global__ void __launch_bounds__(NTHR, 2) k_mega(Params p) {
    extern __shared__ __attribute__((aligned(16))) float shm[];
    unsigned* lp = (unsigned*)(shm + 4);
    float* lds = shm + 4 + ((PARAM_WORDS + 3) & ~3);
    if (threadIdx.x == 0) { shm[0] = 0.f; shm[1] = 0.f; shm[2] = 0.f; shm[3] = 0.f; }
    if (threadIdx.x < PARAM_WORDS) lp[threadIdx.x] = ((const unsigned*)&p)[threadIdx.x];
    __syncthreads();
    XcdBarrier bar; { const Params q_ = load_params(lp); bar = xcd_barrier_post(q_.bar, (volatile LAS unsigned*)shm); }
    unsigned long long tacc = 0;
    const int wave_id = __builtin_amdgcn_readfirstlane((int)(threadIdx.x >> 6));
    PHASE(0, 0);
#define LAYER_EVEN(L) if (PROBE_SPLIT1) { PHASE(20, L); } PHASE(1, L); PHASE(2, L); if (PROBE_GEMM) { PHASE(21, L); } PHASE(3, L); PHASE(4, L); PHASE(5, L); PHASE(6, L); if (OPT < 10) { PHASE(7, L); } PHASE(8, L); PHASE(9, L); if (PROBE_SCAN) { PHASE(19, L); } PHASE(10, L); PHASE(11, L); PHASE(15, L); PHASE(16, L); PHASE(17, L)
#define LAYER_ODD(L) if (PROBE_SPLIT1) { PHASE(20, L); } PHASE(1, L); PHASE(12, L); PHASE(13, L); if (OPT < 3 || OPT >= 12) { PHASE(14, L); } PHASE(15, L); PHASE(16, L); PHASE(17, L)
    LAYER_EVEN(0); LAYER_ODD(1); LAYER_EVEN(2); LAYER_ODD(3);
    { unsigned long long t0_ = 0; if (PROBE_MASK & (1u << 18)) t0_ = wall_clock64(); run_phase<18>(p, lds, 3, wave_id);
      if (PROBE_MASK & (1u << 18)) { xcd_barrier(bar, wave_id == 0 && lane_id_asm() == 0); tacc += wall_clock64() - t0_; } }
    if (PROBE_MASK != 0u && blockIdx.x == 0 && threadIdx.x == 0) {
        const unsigned long long t1 = wall_clock64(); while (wall_clock64() - t1 < 20ull * tacc) __builtin_amdgcn_s_sleep(8); }
}
#endif

static inline size_t al256(size_t v) { return (v + 255) & ~(size_t)255; }
constexpr size_t LDS_BYTES = 148 * 1024;

template <int PH> static void launch_phase(const Params& p, int L, int grid, hipStream_t s) {
    static bool attr = false;
    if (!attr) { hipFuncSetAttribute((const void*)k_phase<PH>, hipFuncAttributeMaxDynamicSharedMemorySize, (int)LDS_BYTES); attr = true; }
    hipLaunchKernelGGL(k_phase<PH>, dim3(grid), dim3(NTHR), LDS_BYTES, s, p, L);
}

extern "C" void kernel_launch(void* const* d_in, const int* in_sizes, int n_in, void* d_out, int out_size, void* d_ws, size_t ws_size, hipStream_t stream) {
    (void)in_sizes; (void)n_in; (void)out_size;
    Params p{};
    const float** ip = (const float**)&p.x;
    for (int i = 0; i < 36; ++i) ip[i] = (const float*)d_in[i];
    p.out = (float*)d_out;
    char* w = (char*)d_ws; size_t o = 0;
    auto take = [&](size_t bytes) { char* r = w + o; o += al256(bytes); return r; };
    p.bar = (unsigned*)take(XCD_BAR_WORDS * 4);
    p.cnt = (int*)take(64 * 64 * 4);
    const size_t zero_bytes = o;
    p.mod = (float*)take((size_t)4 * 17 * 6144 * 4);
    p.ctxs = (float*)take((size_t)NCTX * 1024 * 4);
    p.dftl = (bf16_t*)take((size_t)2048 * 4096 * 2);
    p.dftc = (bf16_t*)take((size_t)256 * 512 * 2);
    p.slot = (int*)take((size_t)16 * NT * 4);
    p.tokw = (float*)take((size_t)NT * 2 * 4);
    p.slotw = (float*)take((size_t)16 * NT * 4);
    p.H = (bf16_t*)take((size_t)(NT + 1) * 1024 * 2);
    char* big = w + o;
    p.P = (bf16_t*)take((size_t)NT * PLD * 2);
    char* r1 = w + o;
    p.WAG = (bf16_t*)take((size_t)NT * WLD * 2);
    p.YF = (bf16_t*)take((size_t)NT * 512 * 2);
    p.YB = (bf16_t*)take((size_t)NT * 512 * 2);
    p.LR = (bf16_t*)take((size_t)NT * 384 * 2);
    p.WinT = (bf16_t*)take((size_t)2 * 2560 * 1024 * 2); p.WqT = (bf16_t*)take((size_t)2 * 768 * 256 * 2); p.WkvT = (bf16_t*)take((size_t)2 * 1024 * 256 * 2);
    p.WlrT = (bf16_t*)take((size_t)2 * 2560 * 384 * 2); p.WoutT = (bf16_t*)take((size_t)2 * 1024 * 1024 * 2); p.A1 = (bf16_t*)take((size_t)2 * 2048 * 1024 * 2);
    p.A2 = (bf16_t*)take((size_t)2048 * 4096 * 2); p.A2c = (bf16_t*)take((size_t)256 * 512 * 2); p.M1 = (bf16_t*)take((size_t)256 * 256 * 2);
    p.WguT = (bf16_t*)take((size_t)17 * 1024 * 1024 * 2); p.WdT = (bf16_t*)take((size_t)17 * 1024 * 512 * 2);
    const size_t total = o;
    { size_t q = 0; auto t2 = [&](size_t bytes) { char* r = r1 + q; q += al256(bytes); return r; };
      p.QN = (bf16_t*)t2((size_t)NT * 512 * 2); p.Qraw = (bf16_t*)t2((size_t)NT * 768 * 2); p.KVraw = (bf16_t*)t2((size_t)NT * 1024 * 2);
      p.Kf = (bf16_t*)t2((size_t)NB * 8 * 2304 * 96 * 2); p.Vt = (bf16_t*)t2((size_t)NB * 8 * 64 * 2304 * 2); }
    { size_t q = 0; auto t3 = [&](size_t bytes) { char* r = big + q; q += al256(bytes); return r; };
      p.ACT = (bf16_t*)t3((size_t)3 * NT * 512 * 2); p.Y = (bf16_t*)t3((size_t)3 * NT * 1024 * 2); }
    { size_t q = 0; auto t4 = [&](size_t bytes) { char* r = big + q; q += al256(bytes); return r; };
      p.G = (float*)t4((size_t)NT * 2048 * 4); p.F = (bf16_t*)t4((size_t)NT * 1024 * 2); }
    { size_t q = 0; auto t5 = [&](size_t bytes) { char* r = big + q; q += al256(bytes); return r; };
      p.ZT = (bf16_t*)t5((size_t)16 * 1024 * 4096 * 2); p.ZTC = (bf16_t*)t5((size_t)16 * 1024 * 512 * 2);
      p.YF1 = (bf16_t*)t5((size_t)256 * 16 * 1024 * 16 * 2); p.YF1c = (bf16_t*)t5((size_t)256 * 16 * 1024 * 2 * 2); }
    p.xs = (bf16_t*)d_out; p.cs = (bf16_t*)p.ctxs; p.xs3 = (bf16_t*)(big + (size_t)344 * 1024 * 1024);
    if (total > ws_size) { fprintf(stderr, "workspace too small: need %zu have %zu\n", total, ws_size); return; }
    static int grid = 0;
    if (!grid) { int dev = 0, cus = 0; hipGetDevice(&dev); hipDeviceGetAttribute(&cus, hipDeviceAttributeMultiprocessorCount, dev); grid = cus > 0 ? cus : 256; if (grid > 256) grid = 256; }
    hipMemsetAsync(d_ws, 0, zero_bytes, stream);
#if ONE_LAUNCH
    static bool attr = false;
    if (!attr) { hipFuncSetAttribute((const void*)k_mega, hipFuncAttributeMaxDynamicSharedMemorySize, (int)LDS_BYTES); attr = true; }
    hipLaunchKernelGGL(k_mega, dim3(grid), dim3(NTHR), LDS_BYTES, stream, p);
#else
    launch_phase<0>(p, 0, grid, stream);
    for (int L = 0; L < 4; ++L) {
        launch_phase<1>(p, L, grid, stream);
        if ((L & 1) == 0) {
            launch_phase<2>(p, L, grid, stream); launch_phase<3>(p, L, grid, stream); launch_phase<4>(p, L, grid, stream); launch_phase<5>(p, L, grid, stream);
            launch_phase<6>(p, L, grid, stream); launch_phase<7>(p, L, grid, stream); launch_phase<8>(p, L, grid, stream); launch_phase<9>(p, L, grid, stream);
            launch_phase<10>(p, L, grid, stream); launch_phase<11>(p, L, grid, stream);
        } else {
            launch_phase<12>(p, L, grid, stream); launch_phase<13>(p, L, grid, stream); launch_phase<14>(p, L, grid, stream);
        }
        launch_phase<15>(p, L, grid, stream); launch_phase<16>(p, L, grid, stream); launch_phase<17>(p, L, grid, stream);
    }
    launch_phase<18>(p, 3, grid, stream);
#endif
}
```

```cpp
#include <hip/hip_runtime.h>
#include <cstdio>
#include <cstdint>

#ifndef ONE_LAUNCH
#define ONE_LAUNCH 1
#endif
#ifndef PROBE_SCAN
#define PROBE_SCAN 0
#endif
#ifndef PROBE_SPLIT1
#define PROBE_SPLIT1 0
#endif
#ifndef PROBE_GEMM
#define PROBE_GEMM 0
#endif
#ifndef OPT
#define OPT 13
#endif

typedef unsigned short bf16_t;
#define DI __device__ __forceinline__
#define LAS __attribute__((address_space(3)))

constexpr int D = 1024, NB = 16, SEQ = 2048, CTXL = 256, NLAT = NB * SEQ, NCTX = NB * CTXL, NT = NLAT + NCTX;
constexpr int PLD = 2560;
constexpr int INC = 2336, ACOLS = 1920;
constexpr int WLD = 2560;
constexpr int NTHR = 512;

#define XB_TMO      128
#define XB_XCNT(j)  (256  + 64 * (j))
#define XB_XSUB(j)  (1280 + 64 * (j))
#define XB_XGEN(j)  (2304 + 64 * (j))
#define XB_TOP      3328
#define XB_TOPGEN   3392
#define XCD_BAR_WORDS 3456
#define XB_SPIN_CAP (1u << 24)
DI unsigned xb_ld(unsigned* p)              { return __hip_atomic_load(p, __ATOMIC_RELAXED, __HIP_MEMORY_SCOPE_AGENT); }
DI unsigned xb_add(unsigned* p, unsigned v) { return __hip_atomic_fetch_add(p, v, __ATOMIC_RELAXED, __HIP_MEMORY_SCOPE_AGENT); }
DI unsigned xb_xcc_id() { return (unsigned)__builtin_amdgcn_s_getreg((3 << 11) | 20) & 0xFu; }
#define XB_SPIN(cond, bar) do { unsigned _sp = 0; while (cond) { __builtin_amdgcn_s_sleep(1); \
    if ((++_sp & 255u) == 0u) { if (xb_ld(&(bar)[XB_TMO])) break; if (_sp > XB_SPIN_CAP) { atomicAdd(&(bar)[XB_TMO], 1u); break; } } } } while (0)
struct XcdBarrier { unsigned* bar; unsigned x; volatile LAS unsigned* st; };
DI XcdBarrier xcd_barrier_post(unsigned* bar, volatile LAS unsigned* st) {
    XcdBarrier b; b.bar = bar; b.x = xb_xcc_id(); b.st = st;
    if (threadIdx.x == 0) (void)xb_add(&bar[XB_XCNT(b.x)], 1u);
    return b;
}
DI void xcd_barrier_complete(unsigned* bar, unsigned x, unsigned& nloc, unsigned& nx) {
    const unsigned G = gridDim.x * gridDim.y * gridDim.z;
    unsigned sum, cnt, mine, sp = 0u;
    for (;;) {
        sum = 0u; cnt = 0u; mine = 0u;
#pragma unroll
        for (unsigned j = 0; j < 16; ++j) { const unsigned c = xb_ld(&bar[XB_XCNT(j)]); sum += c; cnt += (c > 0u) ? 1u : 0u; mine = (j == x) ? c : mine; }
        if (sum == G) break;
        __builtin_amdgcn_s_sleep(1);
        if ((++sp & 255u) == 0u) { if (xb_ld(&bar[XB_TMO])) break; if (sp > XB_SPIN_CAP) { atomicAdd(&bar[XB_TMO], 1u); break; } }
    }
    nloc = mine > 0u ? mine : 1u; nx = cnt > 0u ? cnt : 1u;
}
DI void xcd_barrier(const XcdBarrier& b, const bool t0) {
    asm volatile("s_waitcnt vmcnt(0)" ::: "memory");
    __syncthreads();
    if (t0) {
        unsigned* bar = b.bar;
        __builtin_amdgcn_s_waitcnt(0);
        unsigned nloc = b.st[0], nx = b.st[1];
        if (nloc == 0u) { xcd_barrier_complete(bar, b.x, nloc, nx); b.st[0] = nloc; b.st[1] = nx; }
        const unsigned old = xb_add(&bar[XB_XSUB(b.x)], 1u);
        const unsigned gen = old / nloc;
        if (old + 1u == (gen + 1u) * nloc) {
            __builtin_amdgcn_fence(__ATOMIC_RELEASE, "agent");
            asm volatile("s_waitcnt vmcnt(0)" ::: "memory");
            const unsigned og = xb_add(&bar[XB_TOP], 1u);
            const unsigned tg = og / nx;
            if (og + 1u == (tg + 1u) * nx) xb_add(&bar[XB_TOPGEN], 1u);
            else XB_SPIN(xb_ld(&bar[XB_TOPGEN]) == tg, bar);
            __builtin_amdgcn_fence(__ATOMIC_ACQUIRE, "agent");
            xb_add(&bar[XB_XGEN(b.x)], 1u);
            asm volatile("s_waitcnt vmcnt(0)" ::: "memory");
        } else {
            XB_SPIN(xb_ld(&bar[XB_XGEN(b.x)]) == gen, bar);
            __builtin_amdgcn_fence(__ATOMIC_ACQUIRE, "agent");
            asm volatile("s_waitcnt vmcnt(0)" ::: "memory");
        }
    }
    __syncthreads();
}

struct Params {
    const float *x, *c, *ctx, *c_ctx, *norm1_g, *norm2_g, *mod_w, *mod_b, *w_in, *a_mu, *a_w0, *a_w2, *a_a0, *a_a2, *a_g2,
                *a_k_k, *a_k_a, *a_r_k, *a_ln_w, *a_ln_b, *b_q_norm, *b_w_q_up, *b_kv_norm, *b_w_kv_up, *b_q_gain, *b_k_gain,
                *w_out_even, *w_out_fourier, *router_w, *router_b, *moe_w_gate, *moe_w_up, *moe_w_down, *sh_gate, *sh_up, *sh_down;
    float* out;
    unsigned* bar; int* cnt; float* mod; float* ctxs; bf16_t* dftl; bf16_t* dftc; int* slot; float* tokw; float* slotw;
    bf16_t *H, *P, *LR, *WAG, *YF, *YB, *QN, *Qraw, *KVraw, *Kf, *Vt, *ACT, *Y, *F; float* G;
    bf16_t *WinT, *WqT, *WkvT, *WlrT, *WoutT, *A1, *A2, *A2c, *WguT, *WdT, *ZT, *ZTC;
    bf16_t *M1, *YF1, *YF1c;
    bf16_t *xs, *cs, *xs3;
};

struct Ctx { int tid, bid, nblk; };
DI int lane_id_asm() { int l; asm volatile("v_mbcnt_lo_u32_b32 %0, -1, 0\n\tv_mbcnt_hi_u32_b32 %0, -1, %0" : "=v"(l)); return l; }
DI Ctx make_ctx(int wave_id) { Ctx c; c.tid = wave_id * 64 + lane_id_asm(); c.bid = blockIdx.x; c.nblk = gridDim.x; asm volatile("" : "+v"(c.tid), "+s"(c.bid), "+s"(c.nblk)); return c; }

DI bf16_t f2bf(float f) { unsigned u = __float_as_uint(f); u += 0x7fffu + ((u >> 16) & 1u); return (bf16_t)(u >> 16); }
DI float bf2f(bf16_t b) { return __uint_as_float(((unsigned)b) << 16); }
DI float bflo(unsigned u) { return __uint_as_float(u << 16); }
DI float bfhi(unsigned u) { return __uint_as_float(u & 0xffff0000u); }
DI unsigned pack2(float lo, float hi) { return (unsigned)f2bf(lo) | ((unsigned)f2bf(hi) << 16); }
typedef __bf16 g_bf16x2_t __attribute__((ext_vector_type(2)));
typedef float g_f32x2_t __attribute__((ext_vector_type(2)));
DI unsigned att_pk(float a, float b) { g_f32x2_t f = {a, b}; g_bf16x2_t h = __builtin_convertvector(f, g_bf16x2_t); return __builtin_bit_cast(unsigned, h); }
DI float siluf(float v) { return v / (1.f + expf(-v)); }
DI float sigm(float v) { return 1.f / (1.f + expf(-v)); }
template <int CTRL> DI float dpp_f(float v) { return __builtin_bit_cast(float, __builtin_amdgcn_update_dpp(0, __builtin_bit_cast(int, v), CTRL, 0xf, 0xf, true)); }
DI float wave_sum(float v) {
    v += dpp_f<0xB1>(v); v += dpp_f<0x4E>(v); v += dpp_f<0x141>(v); v += dpp_f<0x140>(v);
    const int x = __builtin_bit_cast(int, v);
    const float a = __builtin_bit_cast(float, __builtin_amdgcn_readlane(x, 0)), b = __builtin_bit_cast(float, __builtin_amdgcn_readlane(x, 16));
    const float c = __builtin_bit_cast(float, __builtin_amdgcn_readlane(x, 32)), d = __builtin_bit_cast(float, __builtin_amdgcn_readlane(x, 48));
    return (a + b) + (c + d);
}

template <bool DUAL, class AFn, class BFn, class BFn2, class Epi>
DI void ngemm(const Ctx& cx, float* lds, int nbz, int M, int N, int K, AFn afn, BFn bfn, BFn2 bfn2, Epi epi) {
    float* As = lds; float* Bs = lds + 16 * 132; float* B2s = Bs + 16 * 128;
    const int tid = cx.tid, ty = tid >> 5, tx = tid & 31;
    const int tm = (M + 127) / 128, tn = (N + 127) / 128, ntile = tm * tn * nbz;
    const int arow = tid >> 2, akc = (tid & 3) * 4, bk = tid >> 5, bnn = (tid & 31) * 4;
    for (int tile = cx.bid; tile < ntile; tile += cx.nblk) {
        const int bz = tile / (tm * tn), rem = tile % (tm * tn), bm = rem / tn, bn = rem % tn;
        float acc[8][4], acc2[8][4];
#pragma unroll
        for (int i = 0; i < 8; ++i)
#pragma unroll
            for (int j = 0; j < 4; ++j) { acc[i][j] = 0.f; acc2[i][j] = 0.f; }
        const int m_a = bm * 128 + arow;
        const bf16_t* aptr = (m_a < M) ? afn(bz, m_a) : nullptr;
        const int nB = bn * 128 + bnn;
        for (int k0 = 0; k0 < K; k0 += 16) {
            float av0 = 0.f, av1 = 0.f, av2 = 0.f, av3 = 0.f;
            if (aptr) { const uint2 u = *(const uint2*)(aptr + k0 + akc); av0 = bflo(u.x); av1 = bfhi(u.x); av2 = bflo(u.y); av3 = bfhi(u.y); }
            float4 bv = make_float4(0.f, 0.f, 0.f, 0.f), bv2 = make_float4(0.f, 0.f, 0.f, 0.f);
            if (nB < N) { bv = *(const float4*)(bfn(bz, k0 + bk) + nB); if (DUAL) bv2 = *(const float4*)(bfn2(bz, k0 + bk) + nB); }
            __syncthreads();
            As[(akc + 0) * 132 + arow] = av0; As[(akc + 1) * 132 + arow] = av1; As[(akc + 2) * 132 + arow] = av2; As[(akc + 3) * 132 + arow] = av3;
            *(float4*)&Bs[bk * 128 + bnn] = bv;
            if (DUAL) *(float4*)&B2s[bk * 128 + bnn] = bv2;
            __syncthreads();
#pragma unroll 4
            for (int kk = 0; kk < 16; ++kk) {
                const float4 a0 = *(const float4*)&As[kk * 132 + ty * 8], a1 = *(const float4*)&As[kk * 132 + ty * 8 + 4];
                const float4 b = *(const float4*)&Bs[kk * 128 + tx * 4];
                const float a[8] = {a0.x, a0.y, a0.z, a0.w, a1.x, a1.y, a1.z, a1.w};
                const float bb[4] = {b.x, b.y, b.z, b.w};
#pragma unroll
                for (int i = 0; i < 8; ++i)
#pragma unroll
                    for (int j = 0; j < 4; ++j) acc[i][j] += a[i] * bb[j];
                if (DUAL) {
                    const float4 b2 = *(const float4*)&B2s[kk * 128 + tx * 4];
                    const float cc[4] = {b2.x, b2.y, b2.z, b2.w};
#pragma unroll
                    for (int i = 0; i < 8; ++i)
#pragma unroll
                        for (int j = 0; j < 4; ++j) acc2[i][j] += a[i] * cc[j];
                }
            }
        }
#pragma unroll
        for (int i = 0; i < 8; ++i) {
            const int m = bm * 128 + ty * 8 + i;
            if (m < M) {
#pragma unroll
                for (int j = 0; j < 4; ++j) { const int n = bn * 128 + tx * 4 + j; if (n < N) epi(bz, m, n, acc[i][j], acc2[i][j]); }
            }
        }
    }
    __syncthreads();
}

DI void ph_prologue(const Ctx& cx, const Params& p, float* lds) {
    const int tid = cx.tid, gtid = cx.bid * NTHR + tid, gsz = cx.nblk * NTHR;
    for (int i = tid; i < 17 * 1024; i += NTHR) { const int j = i >> 10, k = i & 1023; const float v = (j < 16) ? p.c[j * 1024 + k] : p.c_ctx[k]; lds[i] = siluf(v); }
    __syncthreads();
    for (int idx = gtid; idx < 4 * 6144; idx += gsz) {
        const int l = idx / 6144, n = idx % 6144;
        const float* w = p.mod_w + (size_t)l * 1024 * 6144 + n;
        float acc[17]; const float b0 = p.mod_b[l * 6144 + n];
#pragma unroll
        for (int j = 0; j < 17; ++j) acc[j] = b0;
        for (int k = 0; k < 1024; ++k) {
            const float wv = w[(size_t)k * 6144];
#pragma unroll
            for (int j = 0; j < 17; ++j) acc[j] += lds[j * 1024 + k] * wv;
        }
#pragma unroll
        for (int j = 0; j < 17; ++j) p.mod[((size_t)l * 17 + j) * 6144 + n] = acc[j];
    }
    for (int i = gtid; i < 2048 * 4096; i += gsz) {
        const int f = i >> 12, k = i & 4095, t = k & 2047, m = (f * t) & 2047; const float a = (float)m * (1.f / 1024.f);
        p.dftl[i] = f2bf((k < 2048) ? cospif(a) : sinpif(a));
    }
    for (int i = gtid; i < 256 * 512; i += gsz) {
        const int f = i >> 9, k = i & 511, t = k & 255, m = (f * t) & 255; const float a = (float)m * (1.f / 128.f);
        p.dftc[i] = f2bf((k < 256) ? cospif(a) : sinpif(a));
    }
    for (int i = gtid; i < 1024; i += gsz) p.H[(size_t)NT * 1024 + i] = 0;
    __syncthreads();
}

DI float pick4(float a0, float a1, float a2, float a3, int i) { return i == 0 ? a0 : (i == 1 ? a1 : (i == 2 ? a2 : a3)); }
template <bool COMBINE, bool NORM, bool ROUTER>
DI void ph_norm(const Ctx& cx, const Params& p, float* lds, int nrows, const float* xin_lat, const float* xin_ctx, const float* gain, const float* modl, int sh_idx, int sc_idx,
                const float* modprev, int layer) {
    const int tid = cx.tid, wid = tid >> 6, lane = tid & 63;
    float* rw = lds;
    float* scr = lds + 16 * 1024;
    int* lcnt = (int*)(lds + 16 * 1024 + 256); int* lbase = lcnt + 16; int* rlist = lcnt + 32;
    int nlist = 0;
    if (ROUTER) {
        for (int i = tid; i < 16 * 1024; i += NTHR) { const int e = i >> 10, col = i & 1023; rw[i] = p.router_w[col * 16 + e]; }
        if (tid < 16) lcnt[tid] = 0;
        __syncthreads();
    }
    for (int row = cx.bid * 8 + wid; row < nrows; row += cx.nblk * 8) {
        const bool lat = row < NLAT; const int j = lat ? (row >> 11) : 16;
        const float* xr = lat ? xin_lat + (size_t)row * 1024 : xin_ctx + (size_t)(row - NLAT) * 1024;
        float4 xv[4];
#pragma unroll
        for (int i = 0; i < 4; ++i) xv[i] = *(const float4*)(xr + i * 256 + lane * 4);
        if (COMBINE) {
            const float* g2 = modprev + (size_t)j * 6144 + 5 * 1024;
            float* xo = lat ? p.out + (size_t)row * 1024 : p.ctxs + (size_t)(row - NLAT) * 1024;
#pragma unroll
            for (int i = 0; i < 4; ++i) {
                const int col = i * 256 + lane * 4;
                const float4 gv = *(const float4*)(g2 + col);
                float s0 = 0.f, s1 = 0.f, s2 = 0.f, s3 = 0.f;
#pragma unroll
                for (int s = 0; s < 3; ++s) { const uint2 u = *(const uint2*)(p.Y + ((size_t)s * NT + row) * 1024 + col); s0 += bflo(u.x); s1 += bfhi(u.x); s2 += bflo(u.y); s3 += bfhi(u.y); }
                xv[i].x += gv.x * s0; xv[i].y += gv.y * s1; xv[i].z += gv.z * s2; xv[i].w += gv.w * s3;
                *(float4*)(xo + col) = xv[i];
            }
        }
        if (NORM) {
            float ss = 0.f;
#pragma unroll
            for (int i = 0; i < 4; ++i) ss += xv[i].x * xv[i].x + xv[i].y * xv[i].y + xv[i].z * xv[i].z + xv[i].w * xv[i].w;
            ss = wave_sum(ss);
            const float rstd = rsqrtf(ss * (1.f / 1024.f) + 1e-6f);
            const float* shp = modl + (size_t)j * 6144 + sh_idx * 1024; const float* scp = modl + (size_t)j * 6144 + sc_idx * 1024;
            float4 hv[4];
#pragma unroll
            for (int i = 0; i < 4; ++i) {
                const int col = i * 256 + lane * 4;
                const float4 g = *(const float4*)(gain + col), sh = *(const float4*)(shp + col), sc = *(const float4*)(scp + col);
                hv[i].x = xv[i].x * rstd * g.x * (1.f + sc.x) + sh.x; hv[i].y = xv[i].y * rstd * g.y * (1.f + sc.y) + sh.y;
                hv[i].z = xv[i].z * rstd * g.z * (1.f + sc.z) + sh.z; hv[i].w = xv[i].w * rstd * g.w * (1.f + sc.w) + sh.w;
                uint2 u; u.x = pack2(hv[i].x, hv[i].y); u.y = pack2(hv[i].z, hv[i].w);
                *(uint2*)(p.H + (size_t)row * 1024 + col) = u;
            }
            if (ROUTER) {
                float part[16];
#pragma unroll
                for (int e = 0; e < 16; ++e) {
                    float a = 0.f;
#pragma unroll
                    for (int i = 0; i < 4; ++i) { const float4 w = *(const float4*)(rw + e * 1024 + i * 256 + lane * 4); a += hv[i].x * w.x + hv[i].y * w.y + hv[i].z * w.z + hv[i].w * w.w; }
                    part[e] = wave_sum(a);
                }
                float* my = scr + wid * 32;
#pragma unroll
                for (int e = 0; e < 16; ++e) if (lane == e) { const float sg = sigm(part[e]); my[e] = sg; my[16 + e] = sg + p.router_b[e]; }
                __builtin_amdgcn_wave_barrier();
                if (lane == 0) {
                    float best = -3.0e38f; int be1 = 0, be2 = 1;
                    for (int g = 0; g < 4; ++g) {
                        const float v0 = my[16 + 4 * g], v1 = my[16 + 4 * g + 1], v2 = my[16 + 4 * g + 2], v3 = my[16 + 4 * g + 3];
                        int i1 = 0; float m1 = v0;
                        if (v1 > m1) { m1 = v1; i1 = 1; } if (v2 > m1) { m1 = v2; i1 = 2; } if (v3 > m1) { m1 = v3; i1 = 3; }
                        int i2 = -1; float m2 = -3.0e38f;
                        if (i1 != 0 && v0 > m2) { m2 = v0; i2 = 0; } if (i1 != 1 && v1 > m2) { m2 = v1; i2 = 1; }
                        if (i1 != 2 && v2 > m2) { m2 = v2; i2 = 2; } if (i1 != 3 && v3 > m2) { m2 = v3; i2 = 3; }
                        const float gs = m1 + m2;
                        if (gs > best) { best = gs; be1 = 4 * g + i1; be2 = 4 * g + i2; }
                    }
                    const float bs1 = my[be1], bs2 = my[be2];
                    const float inv = 1.f / (bs1 + bs2);
                    const int p1 = atomicAdd(&lcnt[be1], 1), p2 = atomicAdd(&lcnt[be2], 1);
                    int* ent = rlist + (wid * 24 + nlist) * 4;
                    ent[0] = row; ent[1] = be1 | (be2 << 8); ent[2] = p1; ent[3] = p2;
                    p.tokw[row * 2] = bs1 * inv; p.tokw[row * 2 + 1] = bs2 * inv;
                }
                ++nlist;
                __builtin_amdgcn_wave_barrier();
            }
        }
    }
    if (ROUTER) {
        __syncthreads();
        if (tid < 16) lbase[tid] = atomicAdd(p.cnt + (layer * 16 + tid) * 64, lcnt[tid]);
        __syncthreads();
        for (int k = lane; k < nlist; k += 64) {
            const int* ent = rlist + (wid * 24 + k) * 4; const int row = ent[0], be1 = ent[1] & 255, be2 = ent[1] >> 8;
            p.slot[(size_t)be1 * NT + lbase[be1] + ent[2]] = row * 2; p.slot[(size_t)be2 * NT + lbase[be2] + ent[3]] = row * 2 + 1;
        }
    }
    (void)scr;
    __syncthreads();
}

DI void ph_win(const Ctx& cx, const Params& p, float* lds, int j) {
    const float* W = p.w_in + (size_t)j * 1024 * INC;
    ngemm<false>(cx, lds, 1, NT, INC, 1024,
        [&](int, int m) { return p.H + (size_t)m * 1024; },
        [&](int, int k) { return W + (size_t)k * INC; }, [&](int, int) { return (const float*)nullptr; },
        [&](int, int m, int n, float v, float) { p.P[(size_t)m * PLD + n] = f2bf(v); });
}
DI void ph_prepB(const Ctx& cx, const Params& p, int j) {
    const int tid = cx.tid, wid = tid >> 6, lane = tid & 63;
    for (int row = cx.bid * 8 + wid; row < NT; row += cx.nblk * 8) {
        const bf16_t* pr = p.P + (size_t)row * PLD + ACOLS;
        const uint2 uq = *(const uint2*)(pr + lane * 4); const unsigned ukv = *(const unsigned*)(pr + 256 + lane * 2);
        const float q0 = bflo(uq.x), q1 = bfhi(uq.x), q2 = bflo(uq.y), q3 = bfhi(uq.y), k0 = bflo(ukv), k1 = bfhi(ukv);
        const float sq = wave_sum(q0 * q0 + q1 * q1 + q2 * q2 + q3 * q3), sk = wave_sum(k0 * k0 + k1 * k1);
        const float rq = rsqrtf(sq * (1.f / 256.f) + 1e-6f), rk = rsqrtf(sk * (1.f / 128.f) + 1e-6f);
        const float* gq = p.b_q_norm + j * 256 + lane * 4; const float* gk = p.b_kv_norm + j * 128 + lane * 2;
        uint2 o; o.x = pack2(q0 * rq * gq[0], q1 * rq * gq[1]); o.y = pack2(q2 * rq * gq[2], q3 * rq * gq[3]);
        bf16_t* qn = p.QN + (size_t)row * 512;
        *(uint2*)(qn + lane * 4) = o;
        *(unsigned*)(qn + 256 + lane * 2) = pack2(k0 * rk * gk[0], k1 * rk * gk[1]);
        *(unsigned*)(qn + 384 + lane * 2) = 0u;
    }
}
DI void ph_qkvup(const Ctx& cx, const Params& p, float* lds, int j, int mq) {
    const float* Wq = p.b_w_q_up + (size_t)j * 256 * 768; const float* Wkv = p.b_w_kv_up + (size_t)j * 128 * 1024;
    ngemm<false>(cx, lds, 1, mq, 768, 256,
        [&](int, int m) { return p.QN + (size_t)m * 512; },
        [&](int, int k) { return Wq + (size_t)k * 768; }, [&](int, int) { return (const float*)nullptr; },
        [&](int, int m, int n, float v, float) { p.Qraw[(size_t)m * 768 + n] = f2bf(v); });
    ngemm<false>(cx, lds, 1, NT, 1024, 128,
        [&](int, int m) { return p.QN + (size_t)m * 512 + 256; },
        [&](int, int k) { return Wkv + (size_t)k * 1024; }, [&](int, int) { return (const float*)nullptr; },
        [&](int, int m, int n, float v, float) { p.KVraw[(size_t)m * 1024 + n] = f2bf(v); });
}
DI void unpack8(const uint4 u, float* d) { d[0] = bflo(u.x); d[1] = bfhi(u.x); d[2] = bflo(u.y); d[3] = bfhi(u.y); d[4] = bflo(u.z); d[5] = bfhi(u.z); d[6] = bflo(u.w); d[7] = bfhi(u.w); }
DI uint4 pack8(const float* d, float scl) { uint4 u; u.x = pack2(d[0] * scl, d[1] * scl); u.y = pack2(d[2] * scl, d[3] * scl); u.z = pack2(d[4] * scl, d[5] * scl); u.w = pack2(d[6] * scl, d[7] * scl); return u; }
DI float ssq8(const uint4 u) { float d[8]; unpack8(u, d); float s = 0.f;
#pragma unroll
    for (int i = 0; i < 8; ++i) s += d[i] * d[i];
    return s; }
DI void norm_rope_store(const uint4 (&raw)[12], const float* gain, int t, bool lat, float scl, bf16_t* dst) {
    float ss = 0.f;
#pragma unroll
    for (int i = 0; i < 12; ++i) ss += ssq8(raw[i]);
    const float r = rsqrtf(ss * (1.f / 96.f) + 1e-6f);
#pragma unroll
    for (int i = 0; i < 8; ++i) { float d[8]; unpack8(raw[i], d);
#pragma unroll
        for (int c = 0; c < 8; ++c) d[c] = d[c] * r * gain[i * 8 + c];
        *(uint4*)(dst + i * 8) = pack8(d, scl); }
    const float invf[8] = {1.f, 0.316227766016838f, 0.1f, 0.0316227766016838f, 0.01f, 0.00316227766016838f, 0.001f, 0.000316227766016838f};
    const float ri = (float)(t >> 6), ci = (float)(t & 63);
#pragma unroll
    for (int half = 0; half < 2; ++half) {
        float x1[8], x2[8], o1[8], o2[8]; unpack8(raw[8 + half], x1); unpack8(raw[10 + half], x2);
#pragma unroll
        for (int c = 0; c < 8; ++c) {
            const float ang = (half == 0 ? ri : ci) * invf[c];
            const float cs = lat ? __cosf(ang) : 1.f, sn = lat ? __sinf(ang) : 0.f;
            const float a = x1[c] * r * gain[64 + half * 8 + c], b = x2[c] * r * gain[80 + half * 8 + c];
            o1[c] = a * cs - b * sn; o2[c] = b * cs + a * sn;
        }
        *(uint4*)(dst + 64 + half * 8) = pack8(o1, scl); *(uint4*)(dst + 80 + half * 8) = pack8(o2, scl);
    }
}
DI void ph_finalize(const Ctx& cx, const Params& p, int j, int mq) {
    const int gtid = cx.bid * NTHR + cx.tid, gsz = cx.nblk * NTHR;
    const float* qg = p.b_q_gain + j * 96; const float* kg = p.b_k_gain + j * 96;
    for (int idx = gtid; idx < 8 * mq; idx += gsz) {
        const int h = idx / mq, row = idx % mq;
        const bool lat = row < NLAT; const int t = lat ? (row & 2047) : ((row - NLAT) & 255);
        bf16_t* qp = p.Qraw + (size_t)row * 768 + h * 96;
        uint4 raw[12];
#pragma unroll
        for (int i = 0; i < 12; ++i) raw[i] = *(const uint4*)(qp + i * 8);
        norm_rope_store(raw, qg, t, lat, (OPT >= 5) ? 0.10206207261596577f * 1.4426950408889634f : 0.10206207261596577f, qp);
    }
    for (int idx = gtid; idx < 8 * NT; idx += gsz) {
        const int h = idx / NT, row = idx % NT;
        const bool lat = row < NLAT; const int b = lat ? (row >> 11) : ((row - NLAT) >> 8); const int t = lat ? (row & 2047) : ((row - NLAT) & 255);
        const int key = lat ? 256 + t : t;
        const bf16_t* kvp = p.KVraw + (size_t)row * 1024 + h * 128; const bf16_t* krp = p.P + (size_t)row * PLD + ACOLS + 384;
        uint4 raw[12];
#pragma unroll
        for (int i = 0; i < 8; ++i) raw[i] = *(const uint4*)(kvp + i * 8);
#pragma unroll
        for (int i = 0; i < 4; ++i) raw[8 + i] = *(const uint4*)(krp + i * 8);
        norm_rope_store(raw, kg, t, lat, 1.f, p.Kf + ((size_t)(b * 8 + h) * 2304 + key) * 96);
    }
    for (int idx = gtid; idx < 8 * NT; idx += gsz) {
        const int h = idx / NT, row = idx % NT;
        const bool lat = row < NLAT; const int b = lat ? (row >> 11) : ((row - NLAT) >> 8); const int t = lat ? (row & 2047) : ((row - NLAT) & 255);
        const int key = lat ? 256 + t : t;
        const bf16_t* vp = p.KVraw + (size_t)row * 1024 + h * 128 + 64;
        bf16_t* vo = p.Vt + (size_t)(b * 8 + h) * 64 * 2304 + key;
#pragma unroll 1
        for (int i = 0; i < 8; ++i) { const uint4 u = *(const uint4*)(vp + i * 8);
            vo[0] = (bf16_t)(u.x & 0xffff); vo[2304] = (bf16_t)(u.x >> 16); vo[2 * 2304] = (bf16_t)(u.y & 0xffff); vo[3 * 2304] = (bf16_t)(u.y >> 16);
            vo[4 * 2304] = (bf16_t)(u.z & 0xffff); vo[5 * 2304] = (bf16_t)(u.z >> 16); vo[6 * 2304] = (bf16_t)(u.w & 0xffff); vo[7 * 2304] = (bf16_t)(u.w >> 16);
            vo += 8 * 2304; }
    }
}
DI void ph_attn(const Ctx& cx, const Params& p, bool with_ctx) {
    const int gtid = cx.bid * NTHR + cx.tid, gsz = cx.nblk * NTHR;
    const int total = NLAT * 8 + (with_ctx ? NCTX * 8 : 0);
    for (int idx = gtid; idx < total; idx += gsz) {
        int b, h, row, nkeys;
        if (idx < NLAT * 8) { b = idx >> 14; h = (idx >> 11) & 7; row = b * 2048 + (idx & 2047); nkeys = 2304; }
        else { const int i2 = idx - NLAT * 8; b = i2 >> 11; h = (i2 >> 8) & 7; row = NLAT + b * 256 + (i2 & 255); nkeys = 256; }
        const bf16_t* qp = p.Qraw + (size_t)row * 768 + h * 96;
        const bf16_t* Kb = p.Kf + (size_t)(b * 8 + h) * 2304 * 96; const bf16_t* Vb = p.Vt + (size_t)(b * 8 + h) * 64 * 2304;
        float q[96];
#pragma unroll
        for (int i = 0; i < 12; ++i) { const uint4 u = *(const uint4*)(qp + i * 8); q[i * 8] = bflo(u.x); q[i * 8 + 1] = bfhi(u.x); q[i * 8 + 2] = bflo(u.y); q[i * 8 + 3] = bfhi(u.y);
            q[i * 8 + 4] = bflo(u.z); q[i * 8 + 5] = bfhi(u.z); q[i * 8 + 6] = bflo(u.w); q[i * 8 + 7] = bfhi(u.w); }
        float acc[64];
#pragma unroll
        for (int i = 0; i < 64; ++i) acc[i] = 0.f;
        float mx = -3.0e38f, l = 0.f;
        for (int key0 = 0; key0 < nkeys; key0 += 8) {
            float s[8];
#pragma unroll
            for (int kk = 0; kk < 8; ++kk) {
                const uint4* kp = (const uint4*)(Kb + (size_t)(key0 + kk) * 96); float a = 0.f;
#pragma unroll
                for (int i = 0; i < 12; ++i) { const uint4 u = kp[i]; a += q[i * 8] * bflo(u.x) + q[i * 8 + 1] * bfhi(u.x) + q[i * 8 + 2] * bflo(u.y) + q[i * 8 + 3] * bfhi(u.y)
                    + q[i * 8 + 4] * bflo(u.z) + q[i * 8 + 5] * bfhi(u.z) + q[i * 8 + 6] * bflo(u.w) + q[i * 8 + 7] * bfhi(u.w); }
                s[kk] = a;
            }
            float cm = s[0];
#pragma unroll
            for (int kk = 1; kk < 8; ++kk) cm = fmaxf(cm, s[kk]);
            const float mn = fmaxf(mx, cm), alpha = expf(mx - mn);
            float ps = 0.f;
#pragma unroll
            for (int kk = 0; kk < 8; ++kk) { s[kk] = expf(s[kk] - mn); ps += s[kk]; }
            l = l * alpha + ps; mx = mn;
#pragma unroll
            for (int dv = 0; dv < 64; ++dv) {
                const uint4 u = *(const uint4*)(Vb + (size_t)dv * 2304 + key0);
                acc[dv] = acc[dv] * alpha + s[0] * bflo(u.x) + s[1] * bfhi(u.x) + s[2] * bflo(u.y) + s[3] * bfhi(u.y) + s[4] * bflo(u.z) + s[5] * bfhi(u.z) + s[6] * bflo(u.w) + s[7] * bfhi(u.w);
            }
        }
        const float il = 1.f / l;
        bf16_t* o = p.H + (size_t)row * 1024 + 512 + h * 64;
#pragma unroll
        for (int i = 0; i < 8; ++i) { uint4 u; u.x = pack2(acc[i * 8] * il, acc[i * 8 + 1] * il); u.y = pack2(acc[i * 8 + 2] * il, acc[i * 8 + 3] * il);
            u.z = pack2(acc[i * 8 + 4] * il, acc[i * 8 + 5] * il); u.w = pack2(acc[i * 8 + 6] * il, acc[i * 8 + 7] * il); *(uint4*)(o + i * 8) = u; }
    }
}
DI float shiftp(const bf16_t* P, int row, int t, int T, int col, float mu) {
    const float c = bf2f(P[(size_t)row * PLD + col]);
    const float pv = (t > 0) ? bf2f(P[(size_t)(row - 1) * PLD + col]) : 0.f;
    const float nx = (t < T - 1) ? bf2f(P[(size_t)(row + 1) * PLD + col]) : 0.f;
    return c + mu * (0.5f * (pv + nx) - c);
}
DI void ph_prepLR(const Ctx& cx, const Params& p, int j) {
    const int gtid = cx.bid * NTHR + cx.tid, gsz = cx.nblk * NTHR;
    const float* mu = p.a_mu + j * ACOLS + 1536;
    for (int idx = gtid; idx < NT * 384; idx += gsz) {
        const int row = idx / 384, col = idx % 384;
        const bool lat = row < NLAT; const int t = lat ? (row & 2047) : ((row - NLAT) & 255); const int T = lat ? 2048 : 256;
        float v = shiftp(p.P, row, t, T, 1536 + col, mu[col]);
        if (col < 128) v = tanhf(v); else if (col >= 256) v = sigm(v);
        p.LR[(size_t)row * 384 + col] = f2bf(v);
    }
}
DI void ph_wag(const Ctx& cx, const Params& p, float* lds, int j) {
    for (int d = 0; d < 2; ++d) {
        const float* W2 = p.a_w2 + (size_t)(j * 2 + d) * 64 * 512; const float* w0 = p.a_w0 + (j * 2 + d) * 512;
        ngemm<false>(cx, lds, 1, NT, 512, 64,
            [&](int, int m) { return p.LR + (size_t)m * 384 + d * 64; },
            [&](int, int k) { return W2 + (size_t)k * 512; }, [&](int, int) { return (const float*)nullptr; },
            [&](int, int m, int n, float v, float) { const float z = -0.606531f * sigm(w0[n] + v); p.WAG[(size_t)m * WLD + d * 512 + n] = f2bf(-expm1f(z)); });
        const float* A2 = p.a_a2 + (size_t)(j * 2 + d) * 64 * 512; const float* a0 = p.a_a0 + (j * 2 + d) * 512;
        ngemm<false>(cx, lds, 1, NT, 512, 64,
            [&](int, int m) { return p.LR + (size_t)m * 384 + 128 + d * 64; },
            [&](int, int k) { return A2 + (size_t)k * 512; }, [&](int, int) { return (const float*)nullptr; },
            [&](int, int m, int n, float v, float) { p.WAG[(size_t)m * WLD + 1024 + d * 512 + n] = f2bf(sigm(a0[n] + v)); });
    }
    const float* G2 = p.a_g2 + (size_t)j * 128 * 512;
    ngemm<false>(cx, lds, 1, NT, 512, 128,
        [&](int, int m) { return p.LR + (size_t)m * 384 + 256; },
        [&](int, int k) { return G2 + (size_t)k * 512; }, [&](int, int) { return (const float*)nullptr; },
        [&](int, int m, int n, float v, float) { p.WAG[(size_t)m * WLD + 2048 + n] = f2bf(v); });
}
DI void ph_scan(const Ctx& cx, const Params& p, float* lds, int j) {
    const int tid = cx.tid, lane = tid & 63;
    if (tid < 64) {
        for (int item = cx.bid; item < 256; item += cx.nblk) {
            const int b = item >> 4, h = (item >> 1) & 7, dir = item & 1, hc = h * 64 + lane;
            float S[64];
#pragma unroll
            for (int k = 0; k < 64; ++k) S[k] = 0.f;
            const float kkc = p.a_k_k[j * 512 + hc], kac = p.a_k_a[j * 512 + hc];
            const float mur = p.a_mu[j * ACOLS + hc], muk = p.a_mu[j * ACOLS + 512 + hc], muv = p.a_mu[j * ACOLS + 1024 + hc];
            bf16_t* yout = dir ? p.YB : p.YF;
            for (int step = 0; step < 2304; ++step) {
                const bool cp = step < 256; const int tt = cp ? step : step - 256, T = cp ? 256 : 2048, t = dir ? (T - 1 - tt) : tt;
                const int row = cp ? NLAT + b * 256 + t : b * 2048 + t;
                const float R = shiftp(p.P, row, t, T, hc, mur), K = shiftp(p.P, row, t, T, 512 + hc, muk), V = shiftp(p.P, row, t, T, 1024 + hc, muv);
                const float w = 1.f - bf2f(p.WAG[(size_t)row * WLD + dir * 512 + hc]), a = bf2f(p.WAG[(size_t)row * WLD + 1024 + dir * 512 + hc]);
                const float kkv = K * kkc, ssq = wave_sum(kkv * kkv), kk = kkv * rsqrtf(ssq + 1e-12f);
                const float kd = K * (1.f + (a - 1.f) * kac), bd = kk * a;
                lds[lane] = -kk; lds[64 + lane] = w; lds[128 + lane] = bd; lds[192 + lane] = kd; lds[256 + lane] = R;
                __builtin_amdgcn_wave_barrier();
                float sa = 0.f;
#pragma unroll
                for (int k4 = 0; k4 < 16; ++k4) { const float4 v = *(const float4*)(lds + k4 * 4); sa += S[k4 * 4] * v.x + S[k4 * 4 + 1] * v.y + S[k4 * 4 + 2] * v.z + S[k4 * 4 + 3] * v.w; }
                float y = 0.f;
#pragma unroll
                for (int k4 = 0; k4 < 16; ++k4) {
                    const float4 wv = *(const float4*)(lds + 64 + k4 * 4), bv = *(const float4*)(lds + 128 + k4 * 4), kv = *(const float4*)(lds + 192 + k4 * 4), rv = *(const float4*)(lds + 256 + k4 * 4);
                    S[k4 * 4] = S[k4 * 4] * wv.x + sa * bv.x + V * kv.x; S[k4 * 4 + 1] = S[k4 * 4 + 1] * wv.y + sa * bv.y + V * kv.y;
                    S[k4 * 4 + 2] = S[k4 * 4 + 2] * wv.z + sa * bv.z + V * kv.z; S[k4 * 4 + 3] = S[k4 * 4 + 3] * wv.w + sa * bv.w + V * kv.w;
                    y += S[k4 * 4] * rv.x + S[k4 * 4 + 1] * rv.y + S[k4 * 4 + 2] * rv.z + S[k4 * 4 + 3] * rv.w;
                }
                __builtin_amdgcn_wave_barrier();
                yout[(size_t)row * 512 + hc] = f2bf(y);
            }
        }
    }
    __syncthreads();
}
DI void ph_post(const Ctx& cx, const Params& p, int j, int nrows) {
    const int gtid = cx.bid * NTHR + cx.tid, gsz = cx.nblk * NTHR;
    for (int idx = gtid; idx < 8 * nrows; idx += gsz) {
        const int h = idx / nrows, row = idx % nrows;
        const bool lat = row < NLAT; const int t = lat ? (row & 2047) : ((row - NLAT) & 255); const int T = lat ? 2048 : 256;
        float sum = 0.f, sb = 0.f;
#pragma unroll 8
        for (int n = 0; n < 64; ++n) {
            const int hc = h * 64 + n;
            const float yy = bf2f(p.YF[(size_t)row * 512 + hc]) + bf2f(p.YB[(size_t)row * 512 + hc]);
            sum += yy;
            const float R = shiftp(p.P, row, t, T, hc, p.a_mu[j * ACOLS + hc]), K = shiftp(p.P, row, t, T, 512 + hc, p.a_mu[j * ACOLS + 512 + hc]);
            const float af = bf2f(p.WAG[(size_t)row * WLD + 1024 + hc]), ab = bf2f(p.WAG[(size_t)row * WLD + 1536 + hc]);
            const float ka = p.a_k_a[j * 512 + hc], rk = p.a_r_k[j * 512 + hc];
            sb += R * rk * (K * (1.f + (af - 1.f) * ka) + K * (1.f + (ab - 1.f) * ka));
        }
        const float mean = sum * (1.f / 64.f); float var = 0.f;
#pragma unroll 8
        for (int n = 0; n < 64; ++n) { const int hc = h * 64 + n; const float yy = bf2f(p.YF[(size_t)row * 512 + hc]) + bf2f(p.YB[(size_t)row * 512 + hc]); var += (yy - mean) * (yy - mean); }
        const float rstd = rsqrtf(var * (1.f / 64.f) + 64e-5f);
#pragma unroll 8
        for (int n = 0; n < 64; ++n) {
            const int hc = h * 64 + n;
            const float yy = bf2f(p.YF[(size_t)row * 512 + hc]) + bf2f(p.YB[(size_t)row * 512 + hc]);
            const float V = shiftp(p.P, row, t, T, 1024 + hc, p.a_mu[j * ACOLS + 1024 + hc]);
            const float g = bf2f(p.WAG[(size_t)row * WLD + 2048 + hc]);
            const float o = ((yy - mean) * rstd * p.a_ln_w[j * 512 + hc] + p.a_ln_b[j * 512 + hc] + sb * V) * g;
            p.H[(size_t)row * 1024 + hc] = f2bf(o);
        }
    }
}
DI void ph_wout(const Ctx& cx, const Params& p, float* lds, const bf16_t* A, const float* W, int nrows, const float* xin_lat, const float* xin_ctx, const float* modl) {
    ngemm<false>(cx, lds, 1, nrows, 1024, 1024,
        [&](int, int m) { return A + (size_t)m * 1024; },
        [&](int, int k) { return W + (size_t)k * 1024; }, [&](int, int) { return (const float*)nullptr; },
        [&](int, int m, int n, float v, float) {
            const bool lat = m < NLAT; const int jj = lat ? (m >> 11) : 16; const float g1 = modl[(size_t)jj * 6144 + 2 * 1024 + n];
            if (lat) p.out[(size_t)m * 1024 + n] = xin_lat[(size_t)m * 1024 + n] + g1 * v;
            else p.ctxs[(size_t)(m - NLAT) * 1024 + n] = xin_ctx[(size_t)(m - NLAT) * 1024 + n] + g1 * v; });
}

DI void ph_chdft(const Ctx& cx, const Params& p, float* lds, int nrows) {
    const int tid = cx.tid, gtid = cx.bid * NTHR + tid, gsz = cx.nblk * NTHR;
    for (int i = tid; i < 128; i += NTHR) { lds[i] = cospif((float)i * (1.f / 64.f)); lds[128 + i] = sinpif((float)i * (1.f / 64.f)); }
    __syncthreads();
    for (int idx = gtid; idx < nrows * 1024; idx += gsz) {
        const int row = idx >> 10, col = idx & 1023, grp = col >> 7, g = col & 127;
        const bf16_t* hp = p.H + (size_t)row * 1024 + grp * 128;
        float gr = 0.f, gi = 0.f;
        for (int c = 0; c < 128; ++c) { const float xv = bf2f(hp[c]); const int m = (c * g) & 127; gr += xv * lds[m]; gi -= xv * lds[128 + m]; }
        p.G[(size_t)row * 2048 + col] = gr; p.G[(size_t)row * 2048 + 1024 + col] = gi;
    }
    __syncthreads();
}
DI void ph_posdft(const Ctx& cx, const Params& p, float* lds, bool with_ctx) {
    ngemm<false>(cx, lds, 16, 2048, 1024, 4096,
        [&](int, int m) { return p.dftl + (size_t)m * 4096; },
        [&](int bz, int k) { return (k < 2048) ? p.G + (size_t)(bz * 2048 + k) * 2048 : p.G + (size_t)(bz * 2048 + k - 2048) * 2048 + 1024; }, [&](int, int) { return (const float*)nullptr; },
        [&](int bz, int m, int n, float v, float) { p.F[(size_t)(bz * 2048 + m) * 1024 + n] = f2bf(v * (1.f / 512.f)); });
    if (with_ctx)
        ngemm<false>(cx, lds, 16, 256, 1024, 512,
            [&](int, int m) { return p.dftc + (size_t)m * 512; },
            [&](int bz, int k) { return (k < 256) ? p.G + (size_t)(NLAT + bz * 256 + k) * 2048 : p.G + (size_t)(NLAT + bz * 256 + k - 256) * 2048 + 1024; }, [&](int, int) { return (const float*)nullptr; },
            [&](int bz, int m, int n, float v, float) { p.F[(size_t)(NLAT + bz * 256 + m) * 1024 + n] = f2bf(v * 0.0055242717280199f); });
}

DI void ph_moe_up(const Ctx& cx, const Params& p, float* lds, int layer, int nrows) {
    for (int e = 0; e < 17; ++e) {
        const int M = (e < 16) ? __builtin_amdgcn_readfirstlane(p.cnt[(layer * 16 + e) * 64]) : nrows;
        const float* Wg = (e < 16) ? p.moe_w_gate + ((size_t)layer * 16 + e) * 1024 * 512 : p.sh_gate + (size_t)layer * 1024 * 512;
        const float* Wu = (e < 16) ? p.moe_w_up + ((size_t)layer * 16 + e) * 1024 * 512 : p.sh_up + (size_t)layer * 1024 * 512;
        const int* sl = p.slot + (size_t)(e & 15) * NT;
        ngemm<true>(cx, lds, 1, M, 512, 1024,
            [&](int, int m) { const int tok = (e < 16) ? (sl[m] >> 1) : m; return p.H + (size_t)tok * 1024; },
            [&](int, int k) { return Wg + (size_t)k * 512; }, [&](int, int k) { return Wu + (size_t)k * 512; },
            [&](int, int m, int n, float g, float u) { const int s = (e < 16) ? sl[m] : 0; const int tok = (e < 16) ? (s >> 1) : m, slab = (e < 16) ? (s & 1) : 2;
                p.ACT[((size_t)slab * NT + tok) * 512 + n] = f2bf(siluf(g) * u); });
    }
}
DI void ph_moe_down(const Ctx& cx, const Params& p, float* lds, int layer, int nrows) {
    for (int e = 0; e < 17; ++e) {
        const int M = (e < 16) ? __builtin_amdgcn_readfirstlane(p.cnt[(layer * 16 + e) * 64]) : nrows;
        const float* Wd = (e < 16) ? p.moe_w_down + ((size_t)layer * 16 + e) * 512 * 1024 : p.sh_down + (size_t)layer * 512 * 1024;
        const int* sl = p.slot + (size_t)(e & 15) * NT;
        ngemm<false>(cx, lds, 1, M, 1024, 512,
            [&](int, int m) { const int s = (e < 16) ? sl[m] : 0; const int tok = (e < 16) ? (s >> 1) : m, slab = (e < 16) ? (s & 1) : 2; return p.ACT + ((size_t)slab * NT + tok) * 512; },
            [&](int, int k) { return Wd + (size_t)k * 1024; }, [&](int, int) { return (const float*)nullptr; },
            [&](int, int m, int n, float v, float) { const int s = (e < 16) ? sl[m] : 0; const int tok = (e < 16) ? (s >> 1) : m, slab = (e < 16) ? (s & 1) : 2;
                const float w = (e < 16) ? p.tokw[s] : 1.f; p.Y[((size_t)slab * NT + tok) * 1024 + n] = f2bf(w * v); });
    }
}

namespace mm {
typedef short bf16x8 __attribute__((ext_vector_type(8)));
typedef float f32x4 __attribute__((ext_vector_type(4)));
typedef unsigned u32x4 __attribute__((ext_vector_type(4)));
constexpr int BM = 256, BK = 64, HALF = 128, HTB = HALF * BK * 2, STAGE_BYTES = 8 * HTB;
DI int lds_byte(int r, int c) { const int st = (r >> 4) * 2 + (c >> 5), rr = r & 15, cc = c & 31, ob = rr * 64 + cc * 2; return st * 1024 + (ob ^ (((ob >> 9) & 1) << 5)); }
DI void stage_rc(int b, int& R, int& C) { const int st = b / 1024, sb = b % 1024, swz = sb ^ (((sb >> 9) & 1) << 5); R = (st >> 1) * 16 + swz / 64; C = (st & 1) * 32 + (swz % 64) / 2; }
DI int perm32(int rho) { const int n = rho >> 4, i = rho & 15; return 8 * (i >> 2) + 4 * n + (i & 3); }
DI unsigned cvt_pk_bf16(float lo, float hi) { unsigned r; asm volatile("v_cvt_pk_bf16_f32 %0, %1, %2" : "=v"(r) : "v"(lo), "v"(hi)); return r; }
struct Unit { const char* A; const char* B; int pm, pn, e, m, tb; };
template <class Sched, class Epi>
DI void gemm_phase(LAS unsigned char* lds, const int K, const Sched& S, const Epi& E, const int tid) {
    const int wid = __builtin_amdgcn_readfirstlane(tid >> 6), lane = tid & 63, wr = wid >> 2, wc = wid & 3, fr = lane & 15, fq = lane >> 4;
    const int nt = K / BK;
    int R0, C0, R1, C1; stage_rc(tid * 16, R0, C0); stage_rc(tid * 16 + 8192, R1, C1);
    unsigned voffB[2];
    { const int Rb0 = Epi::PERM ? ((R0 & ~31) + perm32(R0 & 31)) : R0, Rb1 = Epi::PERM ? ((R1 & ~31) + perm32(R1 & 31)) : R1;
      voffB[0] = S.boff(Rb0, C0, K); voffB[1] = S.boff(Rb1, C1, K); }
    const size_t kstep = (size_t)(BK * 2), hstepB = S.hstep_b(K), hstepA = S.hstep_a();
    const unsigned ldsw = (unsigned)wid * 1024u;
    const int aoff = lds_byte(wr * 64 + fr, fq * 8), boff = lds_byte(wc * 32 + fr, fq * 8);
#define MM_SA(b, h) (((b) * 2 + (h)) * HTB)
#define MM_SB(b, h) ((4 + (b) * 2 + (h)) * HTB)
#define MM_STAGE_A(bufoff, gbase, h, offs) do { _Pragma("unroll") for (int _i = 0; _i < 2; ++_i) { \
        if constexpr (Sched::GATHER) __builtin_amdgcn_global_load_lds((const unsigned*)((const char*)(gbase) + (offs)[h][_i]), (LAS unsigned*)(lds + (bufoff) + ldsw + _i * 8192), 16, 0, 0); \
        else __builtin_amdgcn_global_load_lds((const unsigned*)((const char*)(gbase) + (size_t)(h) * hstepA + (offs)[0][_i]), (LAS unsigned*)(lds + (bufoff) + ldsw + _i * 8192), 16, 0, 0); } } while (0)
#define MM_STAGE_B(bufoff, gbase) do { _Pragma("unroll") for (int _i = 0; _i < 2; ++_i) \
        __builtin_amdgcn_global_load_lds((const unsigned*)((const char*)(gbase) + voffB[_i]), (LAS unsigned*)(lds + (bufoff) + ldsw + _i * 8192), 16, 0, 0); } while (0)
#define MM_LDA(dst, b, h) do { _Pragma("unroll") for (int m = 0; m < 4; ++m) _Pragma("unroll") for (int k = 0; k < 2; ++k) dst[m][k] = *(const LAS bf16x8*)(lds + MM_SA(b, h) + aoff + m * 2048 + k * 1024); } while (0)
#define MM_LDB(dst, b, h) do { _Pragma("unroll") for (int n = 0; n < 2; ++n) _Pragma("unroll") for (int k = 0; k < 2; ++k) dst[n][k] = *(const LAS bf16x8*)(lds + MM_SB(b, h) + boff + n * 2048 + k * 1024); } while (0)
#define MM_MMA(ai, bj, At, Bt) do { __builtin_amdgcn_s_setprio(1); _Pragma("unroll") for (int m = 0; m < 4; ++m) _Pragma("unroll") for (int n = 0; n < 2; ++n) _Pragma("unroll") for (int k = 0; k < 2; ++k) \
        acc[ai][bj][m][n] = __builtin_amdgcn_mfma_f32_16x16x32_bf16(Bt[n][k], At[m][k], acc[ai][bj][m][n], 0, 0, 0); __builtin_amdgcn_s_setprio(0); } while (0)
#define MM_WAIT_V(n) asm volatile("s_waitcnt vmcnt(" #n ")" ::: "memory")
#define MM_WAIT_L(n) asm volatile("s_waitcnt lgkmcnt(" #n ")" ::: "memory")
#define MM_BAR __builtin_amdgcn_s_barrier()
#define MM_SCHED __builtin_amdgcn_sched_barrier(0)
    Unit cur, nxt; int ui = 0;
    if (!S.next(0, cur)) return;
    unsigned oa[2][2], on[2][2];
    S.aoff(cur, R0, C0, R1, C1, oa);
    on[0][0] = oa[0][0]; on[0][1] = oa[0][1]; on[1][0] = oa[1][0]; on[1][1] = oa[1][1];
    if constexpr (Sched::TABLE) S.tab_dma(cur, lds + STAGE_BYTES + 1024, tid);
    f32x4 acc[2][2][4][2];
#pragma unroll
    for (int a = 0; a < 2; ++a)
#pragma unroll
        for (int b = 0; b < 2; ++b)
#pragma unroll
            for (int m = 0; m < 4; ++m)
#pragma unroll
                for (int n = 0; n < 2; ++n) acc[a][b][m][n] = (f32x4){0.f, 0.f, 0.f, 0.f};
    bf16x8 At[4][2], B0[2][2], B1[2][2];
    const char* cA = cur.A; const char* cB = cur.B;
    MM_STAGE_B(MM_SB(0, 0), cB); MM_STAGE_A(MM_SA(0, 0), cA, 0, oa); MM_STAGE_B(MM_SB(0, 1), cB + hstepB); MM_STAGE_A(MM_SA(0, 1), cA, 1, oa);
    if (wr == 1) MM_BAR;
    MM_WAIT_V(4); MM_BAR;
    MM_STAGE_B(MM_SB(1, 0), cB + kstep); MM_STAGE_A(MM_SA(1, 0), cA + kstep, 0, oa); MM_STAGE_B(MM_SB(1, 1), cB + hstepB + kstep);
    MM_WAIT_V(6); MM_BAR;
    for (;;) {
        cur.tb = ui % 3;
        const bool has_next = S.next(ui + 1, nxt);
        if constexpr (Sched::TABLE) { if (has_next) S.tab_dma(nxt, lds + STAGE_BYTES + 1024 + ((ui + 1) % 3) * 2048, tid); }
        const char* nA = has_next ? nxt.A : cA; const char* nB = has_next ? nxt.B : cB;
        for (int t = 0; t < nt; t += 2) {
            const bool last = (t == nt - 2);
            if constexpr (Sched::GATHER) { if (last) { if (has_next) S.aoff_lds(nxt, (const LAS int*)(lds + STAGE_BYTES + 1024 + ((ui + 1) % 3) * 2048), R0, C0, R1, C1, on);
                else { on[0][0] = oa[0][0]; on[0][1] = oa[0][1]; on[1][0] = oa[1][0]; on[1][1] = oa[1][1]; } } }
            const char* a1 = cA + (size_t)(t + 1) * kstep;
            const char* a2 = last ? nA : cA + (size_t)(t + 2) * kstep; const char* b2 = last ? nB : cB + (size_t)(t + 2) * kstep;
            const char* a3 = a2 + kstep; const char* b3 = b2 + kstep;
            unsigned o2[2][2];
            if constexpr (Sched::GATHER) { o2[0][0] = last ? on[0][0] : oa[0][0]; o2[0][1] = last ? on[0][1] : oa[0][1]; o2[1][0] = last ? on[1][0] : oa[1][0]; o2[1][1] = last ? on[1][1] : oa[1][1]; }
            else { o2[0][0] = oa[0][0]; o2[0][1] = oa[0][1]; o2[1][0] = oa[1][0]; o2[1][1] = oa[1][1]; }
            MM_LDB(B0, 0, 0); MM_SCHED; MM_LDA(At, 0, 0); MM_STAGE_A(MM_SA(1, 1), a1, 1, oa);
            MM_WAIT_L(8); MM_BAR; MM_WAIT_L(0); MM_MMA(0, 0, At, B0); MM_BAR; MM_SCHED;
            MM_LDB(B1, 0, 1); MM_STAGE_B(MM_SB(0, 0), b2);
            MM_BAR; MM_WAIT_L(0); MM_MMA(0, 1, At, B1); MM_BAR;
            MM_LDA(At, 0, 1); MM_STAGE_A(MM_SA(0, 0), a2, 0, o2);
            MM_BAR; MM_WAIT_L(0); MM_MMA(1, 0, At, B0); MM_BAR; MM_SCHED;
            MM_STAGE_B(MM_SB(0, 1), b2 + hstepB);
            MM_WAIT_V(6); MM_BAR; MM_MMA(1, 1, At, B1); MM_BAR;
            MM_LDB(B0, 1, 0); MM_SCHED; MM_LDA(At, 1, 0); MM_STAGE_A(MM_SA(0, 1), a2, 1, o2);
            MM_WAIT_L(8); MM_BAR; MM_WAIT_L(0); MM_MMA(0, 0, At, B0); MM_BAR; MM_SCHED;
            MM_LDB(B1, 1, 1); MM_STAGE_B(MM_SB(1, 0), b3);
            MM_BAR; MM_WAIT_L(0); MM_MMA(0, 1, At, B1); MM_BAR;
            MM_LDA(At, 1, 1); MM_STAGE_A(MM_SA(1, 0), a3, 0, o2);
            MM_BAR; MM_WAIT_L(0); MM_MMA(1, 0, At, B0); MM_BAR; MM_SCHED;
            MM_STAGE_B(MM_SB(1, 1), b3 + hstepB);
            MM_WAIT_V(6); MM_BAR; MM_MMA(1, 1, At, B1); MM_BAR;
        }
        {
          int tz = tid; asm volatile("" : "+v"(tz)); const int wz = tz >> 6, lz = tz & 63;
          E(acc, cur, wz >> 2, wz & 3, lz & 15, lz >> 4); }
        if (!has_next) break;
#pragma unroll
        for (int a = 0; a < 2; ++a)
#pragma unroll
            for (int b = 0; b < 2; ++b)
#pragma unroll
                for (int m = 0; m < 4; ++m)
#pragma unroll
                    for (int n = 0; n < 2; ++n) acc[a][b][m][n] = (f32x4){0.f, 0.f, 0.f, 0.f};
        cur = nxt; cA = nA; cB = nB; ++ui;
        if constexpr (Sched::GATHER) { oa[0][0] = on[0][0]; oa[0][1] = on[0][1]; oa[1][0] = on[1][0]; oa[1][1] = on[1][1]; }
    }
    MM_WAIT_V(0);
    if (wr == 0) MM_BAR;
    MM_BAR;
#undef MM_SA
#undef MM_SB
#undef MM_STAGE_A
#undef MM_STAGE_B
#undef MM_LDA
#undef MM_LDB
#undef MM_MMA
#undef MM_WAIT_V
#undef MM_WAIT_L
#undef MM_BAR
#undef MM_SCHED
}
struct StaticSched {
    static constexpr bool GATHER = false, TABLE = false;
    const char* A; const char* Bt; int lda, K, nM, nN, nwg, G, c;
    DI size_t hstep_a() const { return (size_t)HALF * lda * 2; }
    DI unsigned boff(int Rb, int C, int Kk) const { return (unsigned)(Rb * Kk + C) * 2u; }
    DI size_t hstep_b(int Kk) const { return (size_t)HALF * Kk * 2; }
    DI void init(const void* A_, const void* Bt_, int M, int N, int K_, int lda_, int G_, int c_) { A = (const char*)A_; Bt = (const char*)Bt_; lda = lda_; K = K_; nM = M / BM; nN = N / BM; nwg = nM * nN; G = G_; c = c_; }
    DI bool next(int i, Unit& u) const {
        const int L = i * G + c; if (L >= nwg) return false;
        int wgid = L; { const int q = nwg / 8, r = nwg % 8, xcd = wgid % 8, off = wgid / 8; wgid = (xcd < r ? xcd * (q + 1) : r * (q + 1) + (xcd - r) * q) + off; }
        const int nig = 8 * nN, gid = wgid / nig, fm = gid * 8, gsz = (nM - fm) < 8 ? (nM - fm) : 8;
        u.pm = fm + ((wgid % nig) % gsz); u.pn = (wgid % nig) / gsz; u.e = 0; u.m = 0;
        u.A = A + (size_t)u.pm * BM * lda * 2; u.B = Bt + (size_t)u.pn * BM * K * 2; return true;
    }
    DI void aoff(const Unit&, int R0, int C0, int R1, int C1, unsigned (&o)[2][2]) const {
        o[0][0] = (unsigned)(R0 * lda + C0) * 2u; o[0][1] = (unsigned)(R1 * lda + C1) * 2u;
        o[1][0] = (unsigned)((HALF + R0) * lda + C0) * 2u; o[1][1] = (unsigned)((HALF + R1) * lda + C1) * 2u;
    }
};
struct BatchSched {
    static constexpr bool GATHER = false, TABLE = false;
    const char* A; const char* Bt; int K, nM, nN, nb, G, c; size_t bstride;
    DI size_t hstep_a() const { return (size_t)HALF * K * 2; }
    DI unsigned boff(int Rb, int C, int Kk) const { return (unsigned)(Rb * Kk + C) * 2u; }
    DI size_t hstep_b(int Kk) const { return (size_t)HALF * Kk * 2; }
    DI void init(const void* A_, const void* Bt_, size_t bstride_bytes, int nb_, int M, int N, int K_, int G_, int c_) { A = (const char*)A_; Bt = (const char*)Bt_; bstride = bstride_bytes; nb = nb_; K = K_; nM = M / BM; nN = N / BM; G = G_; c = c_; }
    DI bool next(int i, Unit& u) const {
        const int L = i * G + c; if (L >= nb * nM * nN) return false;
        const int b = L / (nM * nN), rem = L % (nM * nN); u.pm = rem / nN; u.pn = rem % nN; u.e = b; u.m = 0;
        u.A = A + (size_t)u.pm * BM * K * 2; u.B = Bt + (size_t)b * bstride + (size_t)u.pn * BM * K * 2; return true;
    }
    DI void aoff(const Unit&, int R0, int C0, int R1, int C1, unsigned (&o)[2][2]) const {
        o[0][0] = (unsigned)(R0 * K + C0) * 2u; o[0][1] = (unsigned)(R1 * K + C1) * 2u;
        o[1][0] = (unsigned)((HALF + R0) * K + C0) * 2u; o[1][1] = (unsigned)((HALF + R1) * K + C1) * 2u;
    }
};
struct EpiBf16Store {
    static constexpr bool PERM = true;
    bf16_t* O0; int ldc; size_t bstr = 0;
    DI void operator()(const f32x4 (&acc)[2][2][4][2], const Unit& u, int wr, int wc, int fr, int fq) const {
        bf16_t* O = O0 + (size_t)u.e * bstr;
        const int row0 = u.pm * BM + wr * 64 + fr, col0 = u.pn * BM + wc * 32 + 8 * fq;
#pragma unroll
        for (int ai = 0; ai < 2; ++ai)
#pragma unroll
            for (int m = 0; m < 4; ++m) { bf16_t* rowp = O + (size_t)(row0 + ai * HALF + m * 16) * ldc + col0;
#pragma unroll
                for (int bj = 0; bj < 2; ++bj) { const f32x4 v0 = acc[ai][bj][m][0], v1 = acc[ai][bj][m][1];
                    u32x4 w; w.x = cvt_pk_bf16(v0[0], v0[1]); w.y = cvt_pk_bf16(v0[2], v0[3]); w.z = cvt_pk_bf16(v1[0], v1[1]); w.w = cvt_pk_bf16(v1[2], v1[3]);
                    *(u32x4*)(rowp + bj * HALF) = w; } }
    }
};
struct EpiResid {
    static constexpr bool PERM = false;
    const float* xin_lat; const float* xin_ctx; float* out_lat; float* out_ctx; const float* modl; int batched_T;
    DI void operator()(const f32x4 (&acc)[2][2][4][2], const Unit& u, int wr, int wc, int fr, int fq) const {
        int grow0; if (batched_T == 0) grow0 = u.pm * BM; else if (batched_T > 0) grow0 = u.e * 2048 + u.pm * BM; else grow0 = NLAT + u.e * 256 + u.pm * BM;
        const bool lat = grow0 < NLAT; const int jj = lat ? (grow0 >> 11) : 16;
        const float* xi = lat ? xin_lat + (size_t)grow0 * 1024 : xin_ctx + (size_t)(grow0 - NLAT) * 1024;
        float* xo = lat ? out_lat + (size_t)grow0 * 1024 : out_ctx + (size_t)(grow0 - NLAT) * 1024;
        const float* g1 = modl + (size_t)jj * 6144 + 2 * 1024;
        const int r0 = wr * 64 + fr, col0 = u.pn * BM + wc * 32 + 4 * fq;
        f32x4 gv[2][2];
#pragma unroll
        for (int bj = 0; bj < 2; ++bj)
#pragma unroll
            for (int n = 0; n < 2; ++n) gv[bj][n] = *(const f32x4*)(g1 + col0 + bj * HALF + n * 16);
#pragma unroll
        for (int ai = 0; ai < 2; ++ai) {
            f32x4 xv[4][2][2];
#pragma unroll
            for (int m = 0; m < 4; ++m)
#pragma unroll
                for (int bj = 0; bj < 2; ++bj)
#pragma unroll
                    for (int n = 0; n < 2; ++n) xv[m][bj][n] = *(const f32x4*)(xi + (size_t)(r0 + ai * HALF + m * 16) * 1024 + col0 + bj * HALF + n * 16);
#pragma unroll
            for (int m = 0; m < 4; ++m)
#pragma unroll
                for (int bj = 0; bj < 2; ++bj)
#pragma unroll
                    for (int n = 0; n < 2; ++n) *(f32x4*)(xo + (size_t)(r0 + ai * HALF + m * 16) * 1024 + col0 + bj * HALF + n * 16) = xv[m][bj][n] + gv[bj][n] * acc[ai][bj][m][n];
            asm volatile("" ::: "memory");
        }
    }
};
struct EpiResidB {
    static constexpr bool PERM = true;
    const void* xin_lat; const void* xin_ctx; bf16_t* out_lat; bf16_t* out_ctx; const float* modl; int batched_T; int in_f32;
    DI void operator()(const f32x4 (&acc)[2][2][4][2], const Unit& u, int wr, int wc, int fr, int fq) const {
        int grow0; if (batched_T == 0) grow0 = u.pm * BM; else if (batched_T > 0) grow0 = u.e * 2048 + u.pm * BM; else grow0 = NLAT + u.e * 256 + u.pm * BM;
        const bool lat = grow0 < NLAT; const int jj = lat ? (grow0 >> 11) : 16; const size_t rb = lat ? (size_t)grow0 : (size_t)(grow0 - NLAT);
        const float* g1 = modl + (size_t)jj * 6144 + 2 * 1024;
        bf16_t* xo = (lat ? out_lat : out_ctx) + rb * 1024;
        const int r0 = wr * 64 + fr, col0 = u.pn * BM + wc * 32 + 8 * fq;
        f32x4 gv[2][2];
#pragma unroll
        for (int bj = 0; bj < 2; ++bj)
#pragma unroll
            for (int n = 0; n < 2; ++n) gv[bj][n] = *(const f32x4*)(g1 + col0 + bj * HALF + 4 * n);
        if (in_f32) {
            const float* xi = (const float*)(lat ? xin_lat : xin_ctx) + rb * 1024;
#pragma unroll
            for (int ai = 0; ai < 2; ++ai)
#pragma unroll
                for (int mp = 0; mp < 2; ++mp) {
                    f32x4 xv[2][2][2];
#pragma unroll
                    for (int mm_ = 0; mm_ < 2; ++mm_)
#pragma unroll
                        for (int bj = 0; bj < 2; ++bj)
#pragma unroll
                            for (int n = 0; n < 2; ++n) xv[mm_][bj][n] = *(const f32x4*)(xi + (size_t)(r0 + ai * HALF + (2 * mp + mm_) * 16) * 1024 + col0 + bj * HALF + 4 * n);
#pragma unroll
                    for (int mm_ = 0; mm_ < 2; ++mm_)
#pragma unroll
                        for (int bj = 0; bj < 2; ++bj) { const int m = 2 * mp + mm_; const f32x4 o0 = xv[mm_][bj][0] + gv[bj][0] * acc[ai][bj][m][0], o1 = xv[mm_][bj][1] + gv[bj][1] * acc[ai][bj][m][1];
                            u32x4 w; w.x = att_pk(o0[0], o0[1]); w.y = att_pk(o0[2], o0[3]); w.z = att_pk(o1[0], o1[1]); w.w = att_pk(o1[2], o1[3]);
                            *(u32x4*)(xo + (size_t)(r0 + ai * HALF + m * 16) * 1024 + col0 + bj * HALF) = w; }
                    asm volatile("" ::: "memory");
                }
        } else {
            const bf16_t* xi = (const bf16_t*)(lat ? xin_lat : xin_ctx) + rb * 1024;
#pragma unroll
            for (int ai = 0; ai < 2; ++ai) {
                u32x4 xv[4][2];
#pragma unroll
                for (int m = 0; m < 4; ++m)
#pragma unroll
                    for (int bj = 0; bj < 2; ++bj) xv[m][bj] = *(const u32x4*)(xi + (size_t)(r0 + ai * HALF + m * 16) * 1024 + col0 + bj * HALF);
#pragma unroll
                for (int m = 0; m < 4; ++m)
#pragma unroll
                    for (int bj = 0; bj < 2; ++bj) { const u32x4 x = xv[m][bj];
                        const f32x4 x0 = {__uint_as_float(x.x << 16), __uint_as_float(x.x & 0xffff0000u), __uint_as_float(x.y << 16), __uint_as_float(x.y & 0xffff0000u)};
                        const f32x4 x1 = {__uint_as_float(x.z << 16), __uint_as_float(x.z & 0xffff0000u), __uint_as_float(x.w << 16), __uint_as_float(x.w & 0xffff0000u)};
                        const f32x4 o0 = x0 + gv[bj][0] * acc[ai][bj][m][0], o1 = x1 + gv[bj][1] * acc[ai][bj][m][1];
                        u32x4 w; w.x = att_pk(o0[0], o0[1]); w.y = att_pk(o0[2], o0[3]); w.z = att_pk(o1[0], o1[1]); w.w = att_pk(o1[2], o1[3]);
                        *(u32x4*)(xo + (size_t)(r0 + ai * HALF + m * 16) * 1024 + col0 + bj * HALF) = w; }
                asm volatile("" ::: "memory");
            }
        }
    }
};
}

DI void tconv_tile(const Ctx& cx, float* T, const float* src, int ld_src, int k0, int n0, int kvalid, int nvalid, bf16_t* dst, int ldd, int drow0) {
    const int tid = cx.tid;
#pragma unroll
    for (int rr = 0; rr < 2; ++rr) {
        const int i = (tid >> 4) + 32 * rr, j = (tid & 15) * 4;
        float4 v = make_float4(0.f, 0.f, 0.f, 0.f);
        if (k0 + i < kvalid && n0 + j < nvalid) v = *(const float4*)(src + (size_t)(k0 + i) * ld_src + n0 + j);
        T[i * 65 + j] = v.x; T[i * 65 + j + 1] = v.y; T[i * 65 + j + 2] = v.z; T[i * 65 + j + 3] = v.w;
    }
    __syncthreads();
    { const int j = tid >> 3, ch = tid & 7; uint4 o;
      o.x = pack2(T[(ch * 8 + 0) * 65 + j], T[(ch * 8 + 1) * 65 + j]); o.y = pack2(T[(ch * 8 + 2) * 65 + j], T[(ch * 8 + 3) * 65 + j]);
      o.z = pack2(T[(ch * 8 + 4) * 65 + j], T[(ch * 8 + 5) * 65 + j]); o.w = pack2(T[(ch * 8 + 6) * 65 + j], T[(ch * 8 + 7) * 65 + j]);
      *(uint4*)(dst + (size_t)(drow0 + j) * ldd + k0 + ch * 8) = o; }
    __syncthreads();
}
DI void ph_prep_weights(const Ctx& cx, const Params& p, float* lds) {
    const int tid = cx.tid, gtid = cx.bid * NTHR + tid, gsz = cx.nblk * NTHR;
    const int tb0 = (cx.nblk >= 256) ? cx.bid - 128 : cx.bid, tbs = (cx.nblk >= 256) ? 128 : cx.nblk;
    for (int it = tb0; it < 2 * 1008 && tb0 >= 0; it += tbs) {
        const int j = it / 1008; int r = it % 1008;
        if (r < 640) { const int kt = r / 40, ntl = r % 40; tconv_tile(cx, lds, p.w_in + (size_t)j * 1024 * INC, INC, kt * 64, ntl * 64, 1024, INC, p.WinT + (size_t)j * 2560 * 1024, 1024, ntl * 64); continue; } r -= 640;
        if (r < 48) { const int kt = r / 12, ntl = r % 12; tconv_tile(cx, lds, p.b_w_q_up + (size_t)j * 256 * 768, 768, kt * 64, ntl * 64, 256, 768, p.WqT + (size_t)j * 768 * 256, 256, ntl * 64); continue; } r -= 48;
        if (r < 64) { const int kt = r / 16, ntl = r % 16; tconv_tile(cx, lds, p.b_w_kv_up + (size_t)j * 128 * 1024, 1024, kt * 64, ntl * 64, 128, 1024, p.WkvT + (size_t)j * 1024 * 256, 256, ntl * 64); continue; } r -= 64;
        { const int kt = r / 16, ntl = r % 16; tconv_tile(cx, lds, p.w_out_even + (size_t)j * 1024 * 1024, 1024, kt * 64, ntl * 64, 1024, 1024, p.WoutT + (size_t)j * 1024 * 1024, 1024, ntl * 64); }
    }
    for (int idx = gtid; idx < 2 * 2560 * 384; idx += gsz) {
        const int j = idx / (2560 * 384), rem = idx % (2560 * 384), n = rem / 384, k = rem % 384; const int seg = n >> 9, nn = n & 511;
        float v = 0.f;
        if (seg < 2) { if ((k >> 6) == seg) v = p.a_w2[((size_t)(j * 2 + seg) * 64 + (k & 63)) * 512 + nn]; }
        else if (seg < 4) { if ((k >> 6) == seg) v = p.a_a2[((size_t)(j * 2 + seg - 2) * 64 + (k & 63)) * 512 + nn]; }
        else { if (k >= 256) v = p.a_g2[((size_t)j * 128 + (k - 256)) * 512 + nn]; }
        p.WlrT[idx] = f2bf(v);
    }
    {
        float* Tc = lds; float* Ts = lds + 64 * 65; float* tab = lds + 2 * 64 * 65;
        for (int i = tid; i < 128; i += NTHR) { tab[i] = cospif((float)i * (1.f / 64.f)); tab[128 + i] = sinpif((float)i * (1.f / 64.f)); }
        __syncthreads();
        for (int it = cx.bid; it < 2 * 256; it += cx.nblk) {
            const int j = it >> 8, ct = (it >> 4) & 15, et = it & 15; const float* Wf = p.w_out_fourier + (size_t)j * 1024 * 1024;
            const int el = tid & 63, e = et * 64 + el;
#pragma unroll 1
            for (int i = 0; i < 8; ++i) {
                const int chl = (tid >> 6) + 8 * i, ch = ct * 64 + chl, grp = ch >> 7, c = ch & 127;
                float sc = 0.f, ss = 0.f;
                for (int g0 = 0; g0 < 128; g0 += 16) {
                    float wv[16];
#pragma unroll
                    for (int q = 0; q < 16; ++q) wv[q] = Wf[(size_t)(grp * 128 + g0 + q) * 1024 + e];
#pragma unroll
                    for (int q = 0; q < 16; ++q) { const int m = (c * (g0 + q)) & 127; sc += tab[m] * wv[q]; ss += tab[128 + m] * wv[q]; }
                }
                Tc[chl * 65 + el] = sc; Ts[chl * 65 + el] = ss;
            }
            __syncthreads();
            { const int el2 = tid >> 3, chunk = tid & 7; uint4 o, o2; const float* a = Tc + chunk * 8 * 65 + el2; const float* b = Ts + chunk * 8 * 65 + el2;
              o.x = pack2(a[0], a[65]); o.y = pack2(a[2 * 65], a[3 * 65]); o.z = pack2(a[4 * 65], a[5 * 65]); o.w = pack2(a[6 * 65], a[7 * 65]);
              o2.x = pack2(b[0], b[65]); o2.y = pack2(b[2 * 65], b[3 * 65]); o2.z = pack2(b[4 * 65], b[5 * 65]); o2.w = pack2(b[6 * 65], b[7 * 65]);
              bf16_t* d = p.A1 + (size_t)j * 2048 * 1024 + (size_t)(et * 64 + el2) * 1024 + ct * 64 + chunk * 8;
              *(uint4*)d = o; *(uint4*)(d + (size_t)1024 * 1024) = o2; }
            __syncthreads();
        }
    }
    for (int i = gtid; i < 256 * 256; i += gsz) {
        const int m = i >> 8, k = i & 255, f1 = m & 127, t1 = k & 127; const float a = (float)((f1 * t1) & 127) * (1.f / 64.f); const float cs = cospif(a), sn = sinpif(a);
        const float v = (m < 128) ? ((k < 128) ? cs : -sn) : ((k < 128) ? -sn : -cs);
        p.M1[i] = f2bf(v);
    }
    if (OPT < 12) for (int i = gtid; i < 2048 * 4096; i += gsz) {
        const int f = i >> 12, k = i & 4095, t = k & 2047, m = (f * t) & 2047; const float a = (float)m * (1.f / 1024.f);
        p.A2[i] = f2bf(((k < 2048) ? cospif(a) : -sinpif(a)) * (1.f / 512.f));
    }
    if (OPT < 12) for (int i = gtid; i < 256 * 512; i += gsz) {
        const int f = i >> 9, k = i & 511, t = k & 255, m = (f * t) & 255; const float a = (float)m * (1.f / 128.f);
        p.A2c[i] = f2bf(((k < 256) ? cospif(a) : -sinpif(a)) * 0.0055242717280199f);
    }
    __syncthreads();
}
DI void ph_prep_moe(const Ctx& cx, const Params& p, float* lds, int layer) {
    const int tid = cx.tid; constexpr int TP = 513;
    for (int s = cx.bid; s < 17 * 48; s += cx.nblk) {
        const int e = s / 48, r = s % 48;
        const float* src; int ld_src, kt, ldd; bf16_t* dst; int bj = 0, nh = 0; const bool gu = r < 32;
        if (gu) { bj = r >> 4; kt = r & 15; ld_src = 512; ldd = 1024;
            src = (bj ? ((e < 16) ? p.moe_w_up + ((size_t)layer * 16 + e) * 1024 * 512 : p.sh_up + (size_t)layer * 1024 * 512)
                      : ((e < 16) ? p.moe_w_gate + ((size_t)layer * 16 + e) * 1024 * 512 : p.sh_gate + (size_t)layer * 1024 * 512)) + (size_t)kt * 64 * 512;
            dst = p.WguT + (size_t)e * 1024 * 1024; }
        else { const int r2 = r - 32; kt = r2 >> 1; nh = r2 & 1; ld_src = 1024; ldd = 512;
            src = ((e < 16) ? p.moe_w_down + ((size_t)layer * 16 + e) * 512 * 1024 : p.sh_down + (size_t)layer * 512 * 1024) + (size_t)kt * 64 * 1024 + nh * 512;
            dst = p.WdT + (size_t)e * 1024 * 512; }
        float4 v[16];
#pragma unroll
        for (int i = 0; i < 16; ++i) v[i] = *(const float4*)(src + (size_t)((tid >> 7) + 4 * i) * ld_src + (tid & 127) * 4);
        __syncthreads();
#pragma unroll
        for (int i = 0; i < 16; ++i) { float* t = lds + ((tid >> 7) + 4 * i) * TP + (tid & 127) * 4; t[0] = v[i].x; t[1] = v[i].y; t[2] = v[i].z; t[3] = v[i].w; }
        __syncthreads();
#pragma unroll
        for (int it = 0; it < 8; ++it) {
            const int n = (tid >> 3) + 64 * it, ch = tid & 7; const float* t = lds + (ch * 8) * TP + n;
            uint4 o; o.x = att_pk(t[0], t[TP]); o.y = att_pk(t[2 * TP], t[3 * TP]); o.z = att_pk(t[4 * TP], t[5 * TP]); o.w = att_pk(t[6 * TP], t[7 * TP]);
            const int drow = gu ? ((n >> 7) * 256 + bj * 128 + (n & 127)) : (nh * 512 + n);
            *(uint4*)(dst + (size_t)drow * ldd + kt * 64 + ch * 8) = o;
        }
    }
    __syncthreads();
}

#define GEMM_LDS(lds) ((LAS unsigned char*)(lds))
DI void ph_win_mm(const Ctx& cx, const Params& p, float* lds, int j) {
    mm::StaticSched S; S.init(p.H, p.WinT + (size_t)j * 2560 * 1024, NT, 2560, 1024, 1024, cx.nblk, cx.bid);
    mm::EpiBf16Store E{p.P, PLD};
    mm::gemm_phase(GEMM_LDS(lds), 1024, S, E, cx.tid);
}
struct EpiNone { static constexpr bool PERM = true; DI void operator()(const mm::f32x4 (&acc)[2][2][4][2], const mm::Unit&, int, int, int, int) const {
#pragma unroll
    for (int ai = 0; ai < 2; ++ai)
#pragma unroll
        for (int bj = 0; bj < 2; ++bj)
#pragma unroll
            for (int m = 0; m < 4; ++m) asm volatile("" :: "v"(acc[ai][bj][m][0]), "v"(acc[ai][bj][m][1]));
} };
DI void ph_win_probe(const Ctx& cx, const Params& p, float* lds, int j) {
    mm::StaticSched S; S.init(p.H, p.WinT + (size_t)j * 2560 * 1024, NT, 2560, 1024, 1024, cx.nblk, cx.bid);
    if (PROBE_GEMM == 1) { mm::EpiBf16Store E{p.WAG, PLD}; mm::gemm_phase(GEMM_LDS(lds), 1024, S, E, cx.tid); }
    else { EpiNone E; mm::gemm_phase(GEMM_LDS(lds), 1024, S, E, cx.tid); }
}
DI void ph_wout_mmB(const Ctx& cx, const Params& p, float* lds, const bf16_t* A, const bf16_t* Bt, int nrows, const void* xin_lat, const void* xin_ctx, bf16_t* xo_lat, int in_f32, const float* modl) {
    mm::StaticSched S; S.init(A, Bt, nrows, 1024, 1024, 1024, cx.nblk, cx.bid);
    mm::EpiResidB E{xin_lat, xin_ctx, xo_lat, p.cs, modl, 0, in_f32};
    mm::gemm_phase(GEMM_LDS(lds), 1024, S, E, cx.tid);
}
DI void ph_wout_mm(const Ctx& cx, const Params& p, float* lds, const bf16_t* A, const bf16_t* Bt, int nrows, const float* xin_lat, const float* xin_ctx, const float* modl) {
    mm::StaticSched S; S.init(A, Bt, nrows, 1024, 1024, 1024, cx.nblk, cx.bid);
    mm::EpiResid E{xin_lat, xin_ctx, p.out, p.ctxs, modl, 0};
    mm::gemm_phase(GEMM_LDS(lds), 1024, S, E, cx.tid);
}

DI void ph_qkvup_mm(const Ctx& cx, const Params& p, float* lds, int j, int mq) {
    { mm::StaticSched S; S.init(p.QN, p.WqT + (size_t)j * 768 * 256, mq, 768, 256, 512, cx.nblk, cx.bid); mm::EpiBf16Store E{p.Qraw, 768}; mm::gemm_phase(GEMM_LDS(lds), 256, S, E, cx.tid); }
    { mm::StaticSched S; S.init(p.QN + 256, p.WkvT + (size_t)j * 1024 * 256, NT, 1024, 256, 512, cx.nblk, cx.bid); mm::EpiBf16Store E{p.KVraw, 1024}; mm::gemm_phase(GEMM_LDS(lds), 256, S, E, cx.tid); }
}
struct EpiWag {
    static constexpr bool PERM = true;
    bf16_t* O; const LAS float* bias;
    DI void operator()(const mm::f32x4 (&acc)[2][2][4][2], const mm::Unit& u, int wr, int wc, int fr, int fq) const {
        const int row0 = u.pm * 256 + wr * 64 + fr, col0 = u.pn * 256 + wc * 32 + 8 * fq; const int seg = u.pn >> 2;
        const LAS float* bp = bias + col0;
#pragma unroll
        for (int bj = 0; bj < 2; ++bj) {
            mm::f32x4 b0 = (mm::f32x4){0.f, 0.f, 0.f, 0.f}, b1 = b0;
            if (seg < 2) { b0 = *(const LAS mm::f32x4*)(bp + bj * 128); b1 = *(const LAS mm::f32x4*)(bp + bj * 128 + 4); }
#pragma unroll
            for (int ai = 0; ai < 2; ++ai)
#pragma unroll
                for (int m = 0; m < 4; ++m) {
                    mm::f32x4 v0 = acc[ai][bj][m][0] + b0, v1 = acc[ai][bj][m][1] + b1;
                    if (seg == 0) {
#pragma unroll
                        for (int c = 0; c < 4; ++c) { v0[c] = 1.f - __expf(-0.606531f * __builtin_amdgcn_rcpf(1.f + __expf(-v0[c]))); v1[c] = 1.f - __expf(-0.606531f * __builtin_amdgcn_rcpf(1.f + __expf(-v1[c]))); }
                    } else if (seg == 1) {
#pragma unroll
                        for (int c = 0; c < 4; ++c) { v0[c] = __builtin_amdgcn_rcpf(1.f + __expf(-v0[c])); v1[c] = __builtin_amdgcn_rcpf(1.f + __expf(-v1[c])); }
                    }
                    mm::u32x4 w; w.x = mm::cvt_pk_bf16(v0[0], v0[1]); w.y = mm::cvt_pk_bf16(v0[2], v0[3]); w.z = mm::cvt_pk_bf16(v1[0], v1[1]); w.w = mm::cvt_pk_bf16(v1[2], v1[3]);
                    *(mm::u32x4*)(O + (size_t)(row0 + ai * 128 + m * 16) * WLD + col0 + bj * 128) = w;
                }
        }
    }
};
DI void ph_wag_mm(const Ctx& cx, const Params& p, float* lds, int j) {
    mm::StaticSched S; S.init(p.LR, p.WlrT + (size_t)j * 2560 * 384, NT, 2560, 384, 384, cx.nblk, cx.bid);
    LAS float* bl = (LAS float*)lds + 32768 + 256 + 1024;
    for (int i = cx.tid; i < 2048; i += NTHR) bl[i] = (i < 1024) ? p.a_w0[j * 1024 + i] : p.a_a0[j * 1024 + i - 1024];
    __syncthreads();
    EpiWag E{p.WAG, bl};
    mm::gemm_phase(GEMM_LDS(lds), 384, S, E, cx.tid);
}
struct EpiZT {
    static constexpr bool PERM = true;
    bf16_t* Z; int T;
    DI void operator()(const mm::f32x4 (&acc)[2][2][4][2], const mm::Unit& u, int wr, int wc, int fr, int fq) const {
        const int b = (T == 2048) ? (u.pn >> 3) : u.pn, t0 = (T == 2048) ? ((u.pn & 7) * 256) : 0;
        const int m0 = u.pm * 256 + wr * 64 + fr; const int c0 = t0 + wc * 32 + 8 * fq;
#pragma unroll
        for (int ai = 0; ai < 2; ++ai)
#pragma unroll
            for (int m = 0; m < 4; ++m) { const int mr = m0 + ai * 128 + m * 16, part = mr >> 10, ch = mr & 1023;
                bf16_t* rowp = Z + ((size_t)(b * 1024 + ch) * 2 + part) * T + c0;
#pragma unroll
                for (int bj = 0; bj < 2; ++bj) { const mm::f32x4 v0 = acc[ai][bj][m][0], v1 = acc[ai][bj][m][1];
                    mm::u32x4 w; w.x = mm::cvt_pk_bf16(v0[0], v0[1]); w.y = mm::cvt_pk_bf16(v0[2], v0[3]); w.z = mm::cvt_pk_bf16(v1[0], v1[1]); w.w = mm::cvt_pk_bf16(v1[2], v1[3]);
                    *(mm::u32x4*)(rowp + bj * 128) = w; } }
    }
};
DI void ph_f1_mm(const Ctx& cx, const Params& p, float* lds, int j, bool with_ctx) {
    { mm::StaticSched S; S.init(p.A1 + (size_t)j * 2048 * 1024, p.H, 2048, NLAT, 1024, 1024, cx.nblk, cx.bid); EpiZT E{p.ZT, 2048}; mm::gemm_phase(GEMM_LDS(lds), 1024, S, E, cx.tid); }
    if (with_ctx) { mm::StaticSched S; S.init(p.A1 + (size_t)j * 2048 * 1024, p.H + (size_t)NLAT * 1024, 2048, NCTX, 1024, 1024, cx.nblk, cx.bid); EpiZT E{p.ZTC, 256}; mm::gemm_phase(GEMM_LDS(lds), 1024, S, E, cx.tid); }
}
DI void ph_f2_mmB(const Ctx& cx, const Params& p, float* lds, bool with_ctx, const void* xin_lat, const void* xin_ctx, bf16_t* xo_lat, const float* modl) {
    { mm::BatchSched S; S.init(p.A2, p.ZT, (size_t)1024 * 4096 * 2, 16, 2048, 1024, 4096, cx.nblk, cx.bid); mm::EpiResidB E{xin_lat, xin_ctx, xo_lat, p.cs, modl, 1, 0}; mm::gemm_phase(GEMM_LDS(lds), 4096, S, E, cx.tid); }
    if (with_ctx) { mm::BatchSched S; S.init(p.A2c, p.ZTC, (size_t)1024 * 512 * 2, 16, 256, 1024, 512, cx.nblk, cx.bid); mm::EpiResidB E{xin_lat, xin_ctx, xo_lat, p.cs, modl, -1, 0}; mm::gemm_phase(GEMM_LDS(lds), 512, S, E, cx.tid); }
}
DI void ph_f2_mm(const Ctx& cx, const Params& p, float* lds, bool with_ctx, const float* xin_lat, const float* xin_ctx, const float* modl) {
    { mm::BatchSched S; S.init(p.A2, p.ZT, (size_t)1024 * 4096 * 2, 16, 2048, 1024, 4096, cx.nblk, cx.bid); mm::EpiResid E{xin_lat, xin_ctx, p.out, p.ctxs, modl, 1}; mm::gemm_phase(GEMM_LDS(lds), 4096, S, E, cx.tid); }
    if (with_ctx) { mm::BatchSched S; S.init(p.A2c, p.ZTC, (size_t)1024 * 512 * 2, 16, 256, 1024, 512, cx.nblk, cx.bid); mm::EpiResid E{xin_lat, xin_ctx, p.out, p.ctxs, modl, -1}; mm::gemm_phase(GEMM_LDS(lds), 512, S, E, cx.tid); }
}
struct MoeSched {
    static constexpr bool GATHER = true, TABLE = true;
    const char* A; const char* Bt; const int* slot; const float* slotw; const int* tab; int lda, K, G, c, down;
    DI void tab_dma(const mm::Unit& u, LAS unsigned char* dst, int tid) const {
        const int Me = __builtin_amdgcn_readfirstlane(tab[32 + u.e]); const int r = tid & 255; int idx = u.m * 256 + r; idx = idx < Me ? idx : 0;
        const size_t off = (u.e < 16) ? (size_t)u.e * NT + idx : 0;
        const unsigned* src = (tid < 256) ? (const unsigned*)(slot + off) : (const unsigned*)(slotw + off);
        __builtin_amdgcn_global_load_lds(src, (LAS unsigned*)(dst + (tid >> 6) * 256), 4, 0, 0);
    }
    DI size_t hstep_a() const { return 0; }
    DI unsigned boff(int Rb, int C, int Kk) const { return (unsigned)(Rb * Kk + C) * 2u; }
    DI size_t hstep_b(int Kk) const { return (size_t)mm::HALF * Kk * 2; }
    DI bool next(int i, mm::Unit& u) const {
        const int L = i * G + c; const int total = __builtin_amdgcn_readfirstlane(tab[17]);
        if (L >= total * 4) return false;
        const int rtg = L >> 2; int e = 0;
        for (int q = 1; q < 17; ++q) e += (__builtin_amdgcn_readfirstlane(tab[q]) <= rtg) ? 1 : 0;
        u.e = e; u.m = rtg - __builtin_amdgcn_readfirstlane(tab[e]); u.pm = u.m; u.pn = L & 3;
        u.A = A; u.B = Bt + ((size_t)e * 1024 + (size_t)u.pn * 256) * K * 2; return true;
    }
    DI unsigned rowoff(const mm::Unit& u, int Me, int idx, int C) const {
        int row;
        if (u.e < 16) { const int s = (idx < Me) ? slot[(size_t)u.e * NT + idx] : 0; row = down ? ((s & 1) * NT + (s >> 1)) : (s >> 1); }
        else row = down ? (2 * NT + idx) : idx;
        return (unsigned)(row * lda + C) * 2u;
    }
    DI unsigned rowoff_s(const mm::Unit& u, int s, int r, int C) const { int row; if (u.e < 16) row = down ? ((s & 1) * NT + (s >> 1)) : (s >> 1); else row = down ? (2 * NT + u.m * 256 + r) : (u.m * 256 + r); return (unsigned)(row * lda + C) * 2u; }
    DI void aoff_lds(const mm::Unit& u, const LAS int* et, int R0, int C0, int R1, int C1, unsigned (&o)[2][2]) const {
        o[0][0] = rowoff_s(u, et[R0], R0, C0); o[0][1] = rowoff_s(u, et[R1], R1, C1); o[1][0] = rowoff_s(u, et[128 + R0], 128 + R0, C0); o[1][1] = rowoff_s(u, et[128 + R1], 128 + R1, C1);
    }
    DI void aoff(const mm::Unit& u, int R0, int C0, int R1, int C1, unsigned (&o)[2][2]) const {
        const int Me = __builtin_amdgcn_readfirstlane(tab[32 + u.e]), base = u.m * 256;
        o[0][0] = rowoff(u, Me, base + R0, C0); o[0][1] = rowoff(u, Me, base + R1, C1);
        o[1][0] = rowoff(u, Me, base + 128 + R0, C0); o[1][1] = rowoff(u, Me, base + 128 + R1, C1);
    }
};
DI void moe_table(const Ctx& cx, const Params& p, int* tab, int layer, int nrows) {
    if (cx.tid == 0) { int acc = 0;
        for (int e = 0; e < 17; ++e) { const int M = (e < 16) ? p.cnt[(layer * 16 + e) * 64] : nrows; tab[e] = acc; tab[32 + e] = M; acc += (M + 255) >> 8; }
        tab[17] = acc; }
    __syncthreads();
}
DI void lds_read8(const LAS int* base, int r0, int (&o)[8]) {
    const unsigned a = (unsigned)(size_t)(base + r0);
    asm volatile("ds_read_b32 %0, %8\n\tds_read_b32 %1, %8 offset:64\n\tds_read_b32 %2, %8 offset:128\n\tds_read_b32 %3, %8 offset:192\n\t"
                 "ds_read_b32 %4, %8 offset:512\n\tds_read_b32 %5, %8 offset:576\n\tds_read_b32 %6, %8 offset:640\n\tds_read_b32 %7, %8 offset:704\n\ts_waitcnt lgkmcnt(0)"
                 : "=&v"(o[0]), "=&v"(o[1]), "=&v"(o[2]), "=&v"(o[3]), "=&v"(o[4]), "=&v"(o[5]), "=&v"(o[6]), "=&v"(o[7]) : "v"(a) : "memory");
}
struct EpiSwiglu {
    static constexpr bool PERM = true;
    bf16_t* ACT; const int* slot; const int* tab; const LAS int* etab;
    DI void operator()(const mm::f32x4 (&acc)[2][2][4][2], const mm::Unit& u, int wr, int wc, int fr, int fq) const {
        const int Me = __builtin_amdgcn_readfirstlane(tab[32 + u.e]); const int col = u.pn * 128 + wc * 32 + 8 * fq; const LAS int* et = etab + u.tb * 512;
        int sl8[8]; lds_read8(et, wr * 64 + fr, sl8);
#pragma unroll
        for (int ai = 0; ai < 2; ++ai)
#pragma unroll
            for (int m = 0; m < 4; ++m) {
                const int idx = u.m * 256 + ai * 128 + wr * 64 + m * 16 + fr;
                if (idx < Me) {
                    int drow; if (u.e < 16) { const int s = sl8[ai * 4 + m]; drow = (s & 1) * NT + (s >> 1); } else drow = 2 * NT + idx;
                    float o[8];
#pragma unroll
                    for (int n = 0; n < 2; ++n)
#pragma unroll
                        for (int c = 0; c < 4; ++c) { const float g = acc[ai][0][m][n][c], uu = acc[ai][1][m][n][c]; o[n * 4 + c] = g * __builtin_amdgcn_rcpf(1.f + __expf(-g)) * uu; }
                    mm::u32x4 w; w.x = mm::cvt_pk_bf16(o[0], o[1]); w.y = mm::cvt_pk_bf16(o[2], o[3]); w.z = mm::cvt_pk_bf16(o[4], o[5]); w.w = mm::cvt_pk_bf16(o[6], o[7]);
                    *(mm::u32x4*)(ACT + (size_t)drow * 512 + col) = w;
                }
            }
    }
};
struct EpiDown {
    static constexpr bool PERM = true;
    bf16_t* Y; const int* slot; const float* tokw; const int* tab; const LAS int* etab;
    DI void operator()(const mm::f32x4 (&acc)[2][2][4][2], const mm::Unit& u, int wr, int wc, int fr, int fq) const {
        const int Me = __builtin_amdgcn_readfirstlane(tab[32 + u.e]); const int col = u.pn * 256 + wc * 32 + 8 * fq; const LAS int* et = etab + u.tb * 512;
        int sl8[8], sw8[8]; lds_read8(et, wr * 64 + fr, sl8); lds_read8(et + 256, wr * 64 + fr, sw8);
#pragma unroll
        for (int ai = 0; ai < 2; ++ai)
#pragma unroll
            for (int m = 0; m < 4; ++m) {
                const int idx = u.m * 256 + ai * 128 + wr * 64 + m * 16 + fr;
                if (idx < Me) {
                    int drow; float w = 1.f;
                    if (u.e < 16) { const int s = sl8[ai * 4 + m]; drow = (s & 1) * NT + (s >> 1); w = __int_as_float(sw8[ai * 4 + m]); } else drow = 2 * NT + idx;
#pragma unroll
                    for (int bj = 0; bj < 2; ++bj) { const mm::f32x4 v0 = acc[ai][bj][m][0] * w, v1 = acc[ai][bj][m][1] * w;
                        mm::u32x4 o; o.x = mm::cvt_pk_bf16(v0[0], v0[1]); o.y = mm::cvt_pk_bf16(v0[2], v0[3]); o.z = mm::cvt_pk_bf16(v1[0], v1[1]); o.w = mm::cvt_pk_bf16(v1[2], v1[3]);
                        *(mm::u32x4*)(Y + (size_t)drow * 1024 + col + bj * 128) = o; }
                }
            }
    }
};
DI void ph_moe_up_mm(const Ctx& cx, const Params& p, float* lds, int layer, int nrows) {
    int* tab = (int*)(lds + 32768); moe_table(cx, p, tab, layer, nrows);
    MoeSched S{(const char*)p.H, (const char*)p.WguT, p.slot, p.slotw, tab, 1024, 1024, cx.nblk, cx.bid, 0};
    EpiSwiglu E{p.ACT, p.slot, tab, (const LAS int*)((LAS float*)lds + 32768 + 256)};
    mm::gemm_phase(GEMM_LDS(lds), 1024, S, E, cx.tid);
}
DI void ph_moe_down_mm(const Ctx& cx, const Params& p, float* lds, int layer, int nrows) {
    int* tab = (int*)(lds + 32768); moe_table(cx, p, tab, layer, nrows);
    MoeSched S{(const char*)p.ACT, (const char*)p.WdT, p.slot, p.slotw, tab, 512, 512, cx.nblk, cx.bid, 1};
    EpiDown E{p.Y, p.slot, p.tokw, tab, (const LAS int*)((LAS float*)lds + 32768 + 256)};
    mm::gemm_phase(GEMM_LDS(lds), 512, S, E, cx.tid);
}

namespace att {
typedef short bf16x8 __attribute__((ext_vector_type(8)));
typedef float f32x16 __attribute__((ext_vector_type(16)));
typedef unsigned u32x4 __attribute__((ext_vector_type(4)));
typedef unsigned u32x2 __attribute__((ext_vector_type(2)));
typedef __bf16 bf16x2_t __attribute__((ext_vector_type(2)));
typedef float f32x2_t __attribute__((ext_vector_type(2)));
constexpr int KP = 208, VP = 264, KT_BYTES = 128 * KP, VT_BYTES = 64 * VP, BUF = KT_BYTES + VT_BYTES;
DI unsigned pk(float a, float b) { f32x2_t f = {a, b}; bf16x2_t h = __builtin_convertvector(f, bf16x2_t); return __builtin_bit_cast(unsigned, h); }
DI float xhalf_max(float x) { const auto r = __builtin_amdgcn_permlane32_swap(__builtin_bit_cast(unsigned, x), __builtin_bit_cast(unsigned, x), false, false); return fmaxf(__builtin_bit_cast(float, r[0]), __builtin_bit_cast(float, r[1])); }
DI float xhalf_sum(float x) { const auto r = __builtin_amdgcn_permlane32_swap(__builtin_bit_cast(unsigned, x), __builtin_bit_cast(unsigned, x), false, false); return __builtin_bit_cast(float, r[0]) + __builtin_bit_cast(float, r[1]); }
#define ATT_MFMA(a, b, c) __builtin_amdgcn_mfma_f32_32x32x16_bf16((a), (b), (c), 0, 0, 0)
}
DI void ph_attn_mm(const Ctx& cx, const Params& p, float* ldsf, bool with_ctx) {
    using namespace att;
    LAS unsigned char* lds = (LAS unsigned char*)ldsf;
    const int tid = cx.tid, wid = __builtin_amdgcn_readfirstlane(tid >> 6), lane = tid & 63, r = lane & 31, hh = lane >> 5;
    const int nunits = 1024 + (with_ctx ? 128 : 0);
    for (int u = cx.bid; u < nunits; u += cx.nblk) {
        int tz = tid; asm volatile("" : "+v"(tz));
        int kg[3], kl[3], vg[2], vl[2];
#pragma unroll
        for (int i = 0; i < 3; ++i) { const int c = tz + 512 * i, row = c / 12, part = c % 12; kg[i] = row * 96 + part * 8; kl[i] = row * KP + part * 16; }
#pragma unroll
        for (int i = 0; i < 2; ++i) { const int c = tz + 512 * i, row = c >> 4, part = c & 15; vg[i] = row * 2304 + part * 8; vl[i] = KT_BYTES + row * VP + part * 16; }
        int bh, qrow0, nkeys;
        if (u < 1024) { bh = u >> 3; qrow0 = (bh >> 3) * 2048 + (u & 7) * 256; nkeys = 2304; }
        else { bh = u - 1024; qrow0 = NLAT + (bh >> 3) * 256; nkeys = 256; }
        const int h = bh & 7;
        const bf16_t* Kb = p.Kf + (size_t)bh * 2304 * 96; const bf16_t* Vb = p.Vt + (size_t)bh * 64 * 2304;
        const bf16_t* qp = p.Qraw + (size_t)(qrow0 + (tz >> 6) * 32 + (tz & 31)) * 768 + h * 96 + 8 * ((tz >> 5) & 1);
        bf16x8 qf[6];
#pragma unroll
        for (int s = 0; s < 6; ++s) qf[s] = *(const bf16x8*)(qp + 16 * s);
        f32x16 ot0, ot1;
#pragma unroll
        for (int i = 0; i < 16; ++i) { ot0[i] = 0.f; ot1[i] = 0.f; }
        float lrun = 0.f;
        const int ntiles = nkeys >> 7;
        u32x4 kr[3], vr[2];
#pragma unroll
        for (int i = 0; i < 3; ++i) kr[i] = *(const u32x4*)(Kb + kg[i]);
#pragma unroll
        for (int i = 0; i < 2; ++i) vr[i] = *(const u32x4*)(Vb + vg[i]);
#pragma unroll
        for (int i = 0; i < 3; ++i) *(LAS u32x4*)(lds + kl[i]) = kr[i];
#pragma unroll
        for (int i = 0; i < 2; ++i) { *(LAS u32x2*)(lds + vl[i]) = (u32x2){vr[i].x, vr[i].y}; *(LAS u32x2*)(lds + vl[i] + 8) = (u32x2){vr[i].z, vr[i].w}; }
        __syncthreads();
        for (int it = 0; it < ntiles; ++it) {
            const int bo = (it & 1) * BUF, bn = ((it + 1) & 1) * BUF;
            const bool more = (it + 1 < ntiles);
            if (more) {
                const bf16_t* Kn = Kb + (size_t)(it + 1) * 128 * 96; const bf16_t* Vn = Vb + (it + 1) * 128;
#pragma unroll
                for (int i = 0; i < 3; ++i) kr[i] = *(const u32x4*)(Kn + kg[i]);
#pragma unroll
                for (int i = 0; i < 2; ++i) vr[i] = *(const u32x4*)(Vn + vg[i]);
            }
            f32x16 st[4];
#pragma unroll
            for (int kb = 0; kb < 4; ++kb) {
#pragma unroll
                for (int i = 0; i < 16; ++i) st[kb][i] = 0.f;
#pragma unroll
                for (int s = 0; s < 6; ++s) { const bf16x8 kf = *(const LAS bf16x8*)(lds + bo + (kb * 32 + r) * KP + 32 * s + 16 * hh); st[kb] = ATT_MFMA(kf, qf[s], st[kb]); }
                asm volatile("" ::: "memory");
            }
            float pq[4];
#pragma unroll
            for (int kb = 0; kb < 4; ++kb) { float a = 0.f, b = 0.f;
#pragma unroll
                for (int i = 0; i < 16; i += 2) { st[kb][i] = __builtin_amdgcn_exp2f(st[kb][i]); st[kb][i + 1] = __builtin_amdgcn_exp2f(st[kb][i + 1]); a += st[kb][i]; b += st[kb][i + 1]; }
                pq[kb] = a + b; }
            lrun += (pq[0] + pq[1]) + (pq[2] + pq[3]);
#pragma unroll
            for (int kb = 0; kb < 4; ++kb)
#pragma unroll
                for (int s = 0; s < 2; ++s) {
                    u32x4 pw; pw.x = pk(st[kb][8 * s], st[kb][8 * s + 1]); pw.y = pk(st[kb][8 * s + 2], st[kb][8 * s + 3]); pw.z = pk(st[kb][8 * s + 4], st[kb][8 * s + 5]); pw.w = pk(st[kb][8 * s + 6], st[kb][8 * s + 7]);
                    const bf16x8 pb = __builtin_bit_cast(bf16x8, pw);
                    const int col = (kb * 32 + 16 * s + 4 * hh) * 2;
                    const u32x2 a0 = *(const LAS u32x2*)(lds + bo + KT_BYTES + r * VP + col), a1 = *(const LAS u32x2*)(lds + bo + KT_BYTES + r * VP + col + 16);
                    const u32x2 b0 = *(const LAS u32x2*)(lds + bo + KT_BYTES + (32 + r) * VP + col), b1 = *(const LAS u32x2*)(lds + bo + KT_BYTES + (32 + r) * VP + col + 16);
                    const u32x4 va = {a0.x, a0.y, a1.x, a1.y}, vb = {b0.x, b0.y, b1.x, b1.y};
                    ot0 = ATT_MFMA(__builtin_bit_cast(bf16x8, va), pb, ot0);
                    ot1 = ATT_MFMA(__builtin_bit_cast(bf16x8, vb), pb, ot1);
                }
            if (more) {
#pragma unroll
                for (int i = 0; i < 3; ++i) *(LAS u32x4*)(lds + bn + kl[i]) = kr[i];
#pragma unroll
                for (int i = 0; i < 2; ++i) { *(LAS u32x2*)(lds + bn + vl[i]) = (u32x2){vr[i].x, vr[i].y}; *(LAS u32x2*)(lds + bn + vl[i] + 8) = (u32x2){vr[i].z, vr[i].w}; }
            }
            __syncthreads();
        }
        const float il = 1.f / xhalf_sum(lrun);
        int t2 = tid; asm volatile("" : "+v"(t2));
        bf16_t* op = p.H + (size_t)(qrow0 + (t2 >> 6) * 32 + (t2 & 31)) * 1024 + 512 + h * 64 + 4 * ((t2 >> 5) & 1);
#pragma unroll
        for (int g = 0; g < 4; ++g) {
            u32x2 w0 = {pk(ot0[4 * g] * il, ot0[4 * g + 1] * il), pk(ot0[4 * g + 2] * il, ot0[4 * g + 3] * il)};
            u32x2 w1 = {pk(ot1[4 * g] * il, ot1[4 * g + 1] * il), pk(ot1[4 * g + 2] * il, ot1[4 * g + 3] * il)};
            *(u32x2*)(op + 8 * g) = w0; *(u32x2*)(op + 32 + 8 * g) = w1;
        }
    }
}

DI void ph_attn_mm_stag(const Ctx& cx, const Params& p, float* ldsf, bool with_ctx) {
    using namespace att;
    LAS unsigned char* lds = (LAS unsigned char*)ldsf;
    const int tid = cx.tid, wid = __builtin_amdgcn_readfirstlane(tid >> 6), lane = tid & 63, r = lane & 31, hh = lane >> 5, G = wid >> 2;
    const int nunits = 1024 + (with_ctx ? 128 : 0);
    int kg[3], kl[3], vg[2], vl[2];
#pragma unroll
    for (int i = 0; i < 3; ++i) { const int c = tid + 512 * i, row = c / 12, part = c % 12; kg[i] = row * 96 + part * 8; kl[i] = row * KP + part * 16; }
#pragma unroll
    for (int i = 0; i < 2; ++i) { const int c = tid + 512 * i, row = c >> 4, part = c & 15; vg[i] = row * 2304 + part * 8; vl[i] = KT_BYTES + row * VP + part * 16; }
    for (int u = cx.bid; u < nunits; u += cx.nblk) {
        int bh, qrow0, nkeys;
        if (u < 1024) { bh = u >> 3; qrow0 = (bh >> 3) * 2048 + (u & 7) * 256; nkeys = 2304; }
        else { bh = u - 1024; qrow0 = NLAT + (bh >> 3) * 256; nkeys = 256; }
        const int h = bh & 7;
        const bf16_t* Kb = p.Kf + (size_t)bh * 2304 * 96; const bf16_t* Vb = p.Vt + (size_t)bh * 64 * 2304;
        const bf16_t* qp = p.Qraw + (size_t)(qrow0 + wid * 32 + r) * 768 + h * 96 + 8 * hh;
        bf16x8 qf[6];
#pragma unroll
        for (int s = 0; s < 6; ++s) qf[s] = *(const bf16x8*)(qp + 16 * s);
        f32x16 ot0, ot1;
#pragma unroll
        for (int i = 0; i < 16; ++i) { ot0[i] = 0.f; ot1[i] = 0.f; }
        float mrun = -3.0e38f, lrun = 0.f;
        const int ntiles = nkeys >> 7;
        u32x4 kr[3], vr[2];
#define ATT_LOAD(t) do { const bf16_t* Kn = Kb + (size_t)(t) * 128 * 96; const bf16_t* Vn = Vb + (t) * 128; \
            _Pragma("unroll") for (int i = 0; i < 3; ++i) kr[i] = *(const u32x4*)(Kn + kg[i]); _Pragma("unroll") for (int i = 0; i < 2; ++i) vr[i] = *(const u32x4*)(Vn + vg[i]); } while (0)
#define ATT_WRITE(bufo) do { _Pragma("unroll") for (int i = 0; i < 3; ++i) *(LAS u32x4*)(lds + (bufo) + kl[i]) = kr[i]; \
            _Pragma("unroll") for (int i = 0; i < 2; ++i) { *(LAS u32x2*)(lds + (bufo) + vl[i]) = (u32x2){vr[i].x, vr[i].y}; *(LAS u32x2*)(lds + (bufo) + vl[i] + 8) = (u32x2){vr[i].z, vr[i].w}; } } while (0)
        ATT_LOAD(0); ATT_WRITE(0);
        ATT_LOAD(1); ATT_WRITE(BUF);
        __syncthreads();
        f32x16 st[4];
        for (int ph = 0; ph <= 2 * ntiles; ++ph) {
            if (ph & 1) {
                const int tw = (ph + 1) >> 1;
                if (tw >= 2 && tw < ntiles) ATT_WRITE((tw & 1) * BUF);
                if (tw + 1 < ntiles) ATT_LOAD(tw + 1);
            }
            const int e = ph - G;
            if (e >= 0 && e < 2 * ntiles) {
                const int bo = ((e >> 1) & 1) * BUF;
                if ((e & 1) == 0) {
#pragma unroll
                    for (int kb = 0; kb < 4; ++kb) {
#pragma unroll
                        for (int i = 0; i < 16; ++i) st[kb][i] = 0.f;
#pragma unroll
                        for (int s = 0; s < 6; ++s) { const bf16x8 kf = *(const LAS bf16x8*)(lds + bo + (kb * 32 + r) * KP + 32 * s + 16 * hh); st[kb] = ATT_MFMA(kf, qf[s], st[kb]); }
                    }
                    float mq[4];
#pragma unroll
                    for (int kb = 0; kb < 4; ++kb) { float a = fmaxf(st[kb][0], st[kb][1]), b = fmaxf(st[kb][2], st[kb][3]), c2 = fmaxf(st[kb][4], st[kb][5]), d = fmaxf(st[kb][6], st[kb][7]);
                        a = fmaxf(a, fmaxf(st[kb][8], st[kb][9])); b = fmaxf(b, fmaxf(st[kb][10], st[kb][11])); c2 = fmaxf(c2, fmaxf(st[kb][12], st[kb][13])); d = fmaxf(d, fmaxf(st[kb][14], st[kb][15]));
                        mq[kb] = fmaxf(fmaxf(a, b), fmaxf(c2, d)); }
                    float mt = fmaxf(fmaxf(mq[0], mq[1]), fmaxf(mq[2], mq[3]));
                    mt = xhalf_max(mt);
                    const float mnew = fmaxf(mrun, mt), alpha = __builtin_amdgcn_exp2f(mrun - mnew);
                    mrun = mnew;
                    float pq[4];
#pragma unroll
                    for (int kb = 0; kb < 4; ++kb) { float a = 0.f, b = 0.f;
#pragma unroll
                        for (int i = 0; i < 16; i += 2) { st[kb][i] = __builtin_amdgcn_exp2f(st[kb][i] - mnew); st[kb][i + 1] = __builtin_amdgcn_exp2f(st[kb][i + 1] - mnew); a += st[kb][i]; b += st[kb][i + 1]; }
                        pq[kb] = a + b; }
                    lrun = lrun * alpha + ((pq[0] + pq[1]) + (pq[2] + pq[3]));
#pragma unroll
                    for (int i = 0; i < 16; ++i) { ot0[i] *= alpha; ot1[i] *= alpha; }
                } else {
#pragma unroll
                    for (int kb = 0; kb < 4; ++kb)
#pragma unroll
                        for (int s = 0; s < 2; ++s) {
                            u32x4 pw; pw.x = pk(st[kb][8 * s], st[kb][8 * s + 1]); pw.y = pk(st[kb][8 * s + 2], st[kb][8 * s + 3]); pw.z = pk(st[kb][8 * s + 4], st[kb][8 * s + 5]); pw.w = pk(st[kb][8 * s + 6], st[kb][8 * s + 7]);
                            const bf16x8 pb = __builtin_bit_cast(bf16x8, pw);
                            const int col = (kb * 32 + 16 * s + 4 * hh) * 2;
                            const u32x2 a0 = *(const LAS u32x2*)(lds + bo + KT_BYTES + r * VP + col), a1 = *(const LAS u32x2*)(lds + bo + KT_BYTES + r * VP + col + 16);
                            const u32x2 b0 = *(const LAS u32x2*)(lds + bo + KT_BYTES + (32 + r) * VP + col), b1 = *(const LAS u32x2*)(lds + bo + KT_BYTES + (32 + r) * VP + col + 16);
                            const u32x4 va = {a0.x, a0.y, a1.x, a1.y}, vb = {b0.x, b0.y, b1.x, b1.y};
                            ot0 = ATT_MFMA(__builtin_bit_cast(bf16x8, va), pb, ot0);
                            ot1 = ATT_MFMA(__builtin_bit_cast(bf16x8, vb), pb, ot1);
                        }
                }
            }
            __syncthreads();
        }
#undef ATT_LOAD
#undef ATT_WRITE
        const float il = 1.f / xhalf_sum(lrun);
        bf16_t* op = p.H + (size_t)(qrow0 + wid * 32 + r) * 1024 + 512 + h * 64 + 4 * hh;
#pragma unroll
        for (int g = 0; g < 4; ++g) {
            u32x2 w0 = {pk(ot0[4 * g] * il, ot0[4 * g + 1] * il), pk(ot0[4 * g + 2] * il, ot0[4 * g + 3] * il)};
            u32x2 w1 = {pk(ot1[4 * g] * il, ot1[4 * g + 1] * il), pk(ot1[4 * g + 2] * il, ot1[4 * g + 3] * il)};
            *(u32x2*)(op + 8 * g) = w0; *(u32x2*)(op + 32 + 8 * g) = w1;
        }
    }
}

namespace scan {
typedef float f32x2 __attribute__((ext_vector_type(2)));
constexpr int REC = 400, CH = 32, BUFF = CH * REC, YOFF = 2 * BUFF;
DI float dppf(float v, int ctrl_sel) {
    const int x = __builtin_bit_cast(int, v);
    int r;
    if (ctrl_sel == 0) r = __builtin_amdgcn_update_dpp(0, x, 0xB1, 0xf, 0xf, true);
    else if (ctrl_sel == 1) r = __builtin_amdgcn_update_dpp(0, x, 0x4E, 0xf, 0xf, true);
    else r = __builtin_amdgcn_update_dpp(0, x, 0x141, 0xf, 0xf, true);
    return __builtin_bit_cast(float, r);
}
DI float red8(float v) { v += dppf(v, 0); v += dppf(v, 1); v += dppf(v, 2); return v; }
}
template <int ABL>
DI void ph_scan_opt(const Ctx& cx, const Params& p, float* lds, int j) {
    using namespace scan;
    const int tid = cx.tid, wid = __builtin_amdgcn_readfirstlane(tid >> 6), lane = tid & 63;
    for (int item = cx.bid; item < 256; item += cx.nblk) {
        const int b = item >> 4, h = (item >> 1) & 7, dir = item & 1;
        bf16_t* yout = dir ? p.YB : p.YF;
        if (wid >= 4) {
            const int pw = wid - 4, hc = h * 64 + lane;
            const float kkc = p.a_k_k[j * 512 + hc], kac = p.a_k_a[j * 512 + hc];
            const float mur = p.a_mu[j * ACOLS + hc], muk = p.a_mu[j * ACOLS + 512 + hc], muv = p.a_mu[j * ACOLS + 1024 + hc];
            LAS float* L = (LAS float*)lds;
            bf16_t raw[8][11];
#define SCAN_ROW(stepv, row_, t_, T_) const bool cp_ = (stepv) < 256; const int tt_ = cp_ ? (stepv) : (stepv) - 256, T_ = cp_ ? 256 : 2048, t_ = dir ? (T_ - 1 - tt_) : tt_; const int row_ = cp_ ? NLAT + b * 256 + t_ : b * 2048 + t_
#define SCAN_LOAD(cc) do { _Pragma("unroll") for (int it = 0; it < 8; ++it) { const int step = (cc) * CH + pw + 4 * it; SCAN_ROW(step, row, t, T); \
                const int rp_ = (t > 0) ? row - 1 : row, rn_ = (t < T - 1) ? row + 1 : row; \
                const bf16_t* pc = p.P + (size_t)row * PLD + hc; const bf16_t* pp = p.P + (size_t)rp_ * PLD + hc; const bf16_t* pn = p.P + (size_t)rn_ * PLD + hc; \
                raw[it][0] = pc[0]; raw[it][1] = pp[0]; raw[it][2] = pn[0]; raw[it][3] = pc[512]; raw[it][4] = pp[512]; raw[it][5] = pn[512]; raw[it][6] = pc[1024]; raw[it][7] = pp[1024]; raw[it][8] = pn[1024]; \
                raw[it][9] = p.WAG[(size_t)row * WLD + dir * 512 + hc]; raw[it][10] = p.WAG[(size_t)row * WLD + 1024 + dir * 512 + hc]; } } while (0)
            if (ABL != 1) SCAN_LOAD(0);
            for (int c = 0; c <= 73; ++c) {
                if (c >= 2 && ABL == 0) {
                    const LAS float* yb = L + YOFF + ((c - 2) & 1) * (CH * 64);
#pragma unroll
                    for (int it = 0; it < 8; ++it) {
                        const int sl = pw + 4 * it, step = (c - 2) * CH + sl; SCAN_ROW(step, row, t, T);
                        yout[(size_t)row * 512 + hc] = f2bf(yb[sl * 64 + lane]);
                    }
                }
                if (c < 72 && ABL != 1) {
                    LAS float* buf = L + (c & 1) * BUFF;
#pragma unroll
                    for (int it = 0; it < 8; ++it) {
                        const int sl = pw + 4 * it, step = c * CH + sl; SCAN_ROW(step, row, t, T); (void)row;
                        const float mp = (t > 0) ? 0.5f : 0.f, mn = (t < T - 1) ? 0.5f : 0.f;
                        const float rc = bf2f(raw[it][0]), kc_ = bf2f(raw[it][3]), vc = bf2f(raw[it][6]);
                        const float R = rc + mur * (mp * bf2f(raw[it][1]) + mn * bf2f(raw[it][2]) - rc);
                        const float K = kc_ + muk * (mp * bf2f(raw[it][4]) + mn * bf2f(raw[it][5]) - kc_);
                        const float V = vc + muv * (mp * bf2f(raw[it][7]) + mn * bf2f(raw[it][8]) - vc);
                        const float w = 1.f - bf2f(raw[it][9]), a = bf2f(raw[it][10]);
                        const float kkv = K * kkc, ssq = wave_sum(kkv * kkv), kk = kkv * rsqrtf(ssq + 1e-12f);
                        const float kd = K * (1.f + (a - 1.f) * kac), bd = kk * a;
                        const float br = wave_sum(bd * R), kr = wave_sum(kd * R);
                        LAS float* rec = buf + sl * REC;
                        rec[lane] = w; rec[64 + lane] = -kk; rec[128 + lane] = bd; rec[192 + lane] = kd; rec[256 + lane] = w * R; rec[320 + lane] = V;
                        if (lane == 0) { rec[384] = br; rec[385] = kr; }
                    }
                    if (c + 1 < 72) SCAN_LOAD(c + 1);
                }
                __syncthreads();
            }
#undef SCAN_LOAD
#undef SCAN_ROW
        } else {
            const int ct = tid, rp = ct >> 3, k8 = ct & 7;
            float S0[8], S1[8];
#pragma unroll
            for (int q = 0; q < 8; ++q) { S0[q] = 0.f; S1[q] = 0.f; }
            __syncthreads();
            for (int c = 0; c < 72; ++c) {
                const LAS float* buf = (const LAS float*)lds + (c & 1) * BUFF; LAS float* yb = (LAS float*)lds + YOFF + (c & 1) * (CH * 64);
                mm::f32x4 cw0, cw1, cn0, cn1, cb0, cb1, cd0, cd1, cr0, cr1; scan::f32x2 cvv, csc;
#define SCAN_LD(recp, W0, W1, N0, N1, B0, B1, D0, D1, R0_, R1_, VV, SC) do { const LAS float* r_ = (recp); \
                    W0 = *(const LAS mm::f32x4*)(r_ + k8 * 8); W1 = *(const LAS mm::f32x4*)(r_ + k8 * 8 + 4); N0 = *(const LAS mm::f32x4*)(r_ + 64 + k8 * 8); N1 = *(const LAS mm::f32x4*)(r_ + 64 + k8 * 8 + 4); \
                    B0 = *(const LAS mm::f32x4*)(r_ + 128 + k8 * 8); B1 = *(const LAS mm::f32x4*)(r_ + 128 + k8 * 8 + 4); D0 = *(const LAS mm::f32x4*)(r_ + 192 + k8 * 8); D1 = *(const LAS mm::f32x4*)(r_ + 192 + k8 * 8 + 4); \
                    R0_ = *(const LAS mm::f32x4*)(r_ + 256 + k8 * 8); R1_ = *(const LAS mm::f32x4*)(r_ + 256 + k8 * 8 + 4); VV = *(const LAS scan::f32x2*)(r_ + 320 + 2 * rp); SC = *(const LAS scan::f32x2*)(r_ + 384); } while (0)
                SCAN_LD(buf, cw0, cw1, cn0, cn1, cb0, cb1, cd0, cd1, cr0, cr1, cvv, csc);
#pragma unroll 2
                for (int sl = 0; sl < (ABL == 2 ? 0 : CH); ++sl) {
                    mm::f32x4 nw0, nw1, nn0, nn1, nb0, nb1, nd0, nd1, nr0, nr1; scan::f32x2 nvv, nsc;
                    SCAN_LD(buf + (sl + 1 < CH ? sl + 1 : sl) * REC, nw0, nw1, nn0, nn1, nb0, nb1, nd0, nd1, nr0, nr1, nvv, nsc);
                    const float wv[8] = {cw0[0], cw0[1], cw0[2], cw0[3], cw1[0], cw1[1], cw1[2], cw1[3]}, nv[8] = {cn0[0], cn0[1], cn0[2], cn0[3], cn1[0], cn1[1], cn1[2], cn1[3]};
                    const float bv[8] = {cb0[0], cb0[1], cb0[2], cb0[3], cb1[0], cb1[1], cb1[2], cb1[3]}, dv[8] = {cd0[0], cd0[1], cd0[2], cd0[3], cd1[0], cd1[1], cd1[2], cd1[3]};
                    const float rv[8] = {cr0[0], cr0[1], cr0[2], cr0[3], cr1[0], cr1[1], cr1[2], cr1[3]};
                    float sa0 = 0.f, sa1 = 0.f, y0 = 0.f, y1 = 0.f;
#pragma unroll
                    for (int q = 0; q < 8; ++q) { sa0 += S0[q] * nv[q]; sa1 += S1[q] * nv[q]; y0 += S0[q] * rv[q]; y1 += S1[q] * rv[q]; }
                    sa0 = red8(sa0); sa1 = red8(sa1); y0 = red8(y0); y1 = red8(y1);
                    y0 += sa0 * csc[0] + cvv[0] * csc[1]; y1 += sa1 * csc[0] + cvv[1] * csc[1];
#pragma unroll
                    for (int q = 0; q < 8; ++q) { S0[q] = S0[q] * wv[q] + sa0 * bv[q] + cvv[0] * dv[q]; S1[q] = S1[q] * wv[q] + sa1 * bv[q] + cvv[1] * dv[q]; }
                    if (k8 == 0) *(LAS scan::f32x2*)(yb + sl * 64 + 2 * rp) = (scan::f32x2){y0, y1};
                    cw0 = nw0; cw1 = nw1; cn0 = nn0; cn1 = nn1; cb0 = nb0; cb1 = nb1; cd0 = nd0; cd1 = nd1; cr0 = nr0; cr1 = nr1; cvv = nvv; csc = nsc;
                }
#undef SCAN_LD
                __syncthreads();
            }
            __syncthreads();
        }
    }
}

namespace sc2 {
typedef short bf16x8 __attribute__((ext_vector_type(8)));
typedef float f32x4 __attribute__((ext_vector_type(4)));
typedef unsigned u32x4 __attribute__((ext_vector_type(4)));
typedef unsigned u32x2 __attribute__((ext_vector_type(2)));
constexpr int NP = 6;
constexpr int O_AH = 0, O_RH = 2048, O_BK = 4096, O_VM = 8192, O_GC = 10240, O_AAB = 10496, O_AAK = 11520, O_ARK = 12032, O_BH = 13056, O_KH = 15104, SLOT = 17152;
constexpr int O_S0 = NP * SLOT, O_RHS = O_S0 + 8192, O_ZU = O_RHS + 4096, O_FLAG = O_ZU + 2048, TOTAL = O_FLAG + 256;
#define SC_MFMA(a, b, c) __builtin_amdgcn_mfma_f32_16x16x32_bf16((a), (b), (c), 0, 0, 0)
DI unsigned pk2(float a, float b) { return att::pk(a, b); }
DI int ldv(volatile LAS int* p) { return *p; }
}
template <int ABL>
DI void ph_scan_chunk(const Ctx& cx, const Params& p, float* ldsg, int j) {
    using namespace sc2;
    static_assert(TOTAL <= 128 * 1024, "scan LDS map");
    LAS unsigned char* L = (LAS unsigned char*)ldsg;
    volatile LAS int* ready = (volatile LAS int*)(L + O_FLAG); volatile LAS int* done = ready + 8;
    const int tid = cx.tid, wid = __builtin_amdgcn_readfirstlane(tid >> 6), lane = tid & 63, lq = lane >> 4, lr = lane & 15;
    constexpr int NCH = 144;
    for (int item = cx.bid; item < 256; item += cx.nblk) {
        const int b = item >> 4, h = (item >> 1) & 7, dir = item & 1;
        bf16_t* yout = dir ? p.YB : p.YF;
        __syncthreads();
        if (tid < 32) ready[tid] = 0;
        __syncthreads();
#define SC_ROW(stepv, row_, t_, T_) const bool cp_ = (stepv) < 256; const int tt_ = cp_ ? (stepv) : (stepv) - 256, T_ = cp_ ? 256 : 2048, t_ = dir ? (T_ - 1 - tt_) : tt_; const int row_ = cp_ ? NLAT + b * 256 + t_ : b * 2048 + t_
        if (wid < 2) {
            __builtin_amdgcn_s_setprio(3);
            const int g = wid, vb0 = 2 * g;
            f32x4 S[4][2];
#pragma unroll
            for (int kb = 0; kb < 4; ++kb)
#pragma unroll
                for (int vb = 0; vb < 2; ++vb) S[kb][vb] = (f32x4){0.f, 0.f, 0.f, 0.f};
            for (int c = 0; c < NCH; ++c) {
                const int sl = c % NP; LAS unsigned char* SB = L + sl * SLOT;
                { unsigned spins = 0; while (ldv(ready + sl) != c + 1) { __builtin_amdgcn_s_sleep(1); if (++spins > (1u << 22)) break; } }
                asm volatile("" ::: "memory");
                if (ABL == 2) { if (lane == 0) done[g * 8 + sl] = c + 1; continue; }
                f32x4 cA[4][4];
#pragma unroll
                for (int j = 0; j <= 3; ++j)
#pragma unroll
                    for (int q = (j + 1) / 4; q < 4; ++q) cA[j][q - (j + 1) / 4] = *(const LAS f32x4*)(SB + O_AAB + j * 64 + q * 16);
#pragma unroll
                for (int kb = 0; kb < 4; ++kb)
#pragma unroll
                    for (int vq = 0; vq < 2; ++vq) { const f32x4 x = S[kb][vq]; *(LAS u32x2*)(L + O_S0 + (16 * (vb0 + vq) + lr) * 128 + (16 * kb + 4 * lq) * 2) = (u32x2){pk2(x[0], x[1]), pk2(x[2], x[3])}; }
                {
                    bf16x8 ah[2], ak, sf[2][2], vmf[2];
#pragma unroll
                    for (int ks = 0; ks < 2; ++ks) ah[ks] = *(const LAS bf16x8*)(SB + O_AH + lr * 128 + ks * 64 + lq * 16);
                    { u32x4 z = {0u, 0u, 0u, 0u}; if (lq < 2) z = *(const LAS u32x4*)(SB + O_AAK + lr * 32 + lq * 16); ak = __builtin_bit_cast(bf16x8, z); }
#pragma unroll
                    for (int vq = 0; vq < 2; ++vq) { const int vb = vb0 + vq;
#pragma unroll
                        for (int ks = 0; ks < 2; ++ks) sf[vq][ks] = *(const LAS bf16x8*)(L + O_S0 + (16 * vb + lr) * 128 + ks * 64 + lq * 16);
                        u32x4 z = {0u, 0u, 0u, 0u}; if (lq < 2) z = *(const LAS u32x4*)(SB + O_VM + (16 * vb + lr) * 32 + lq * 16); vmf[vq] = __builtin_bit_cast(bf16x8, z);
                    }
                    f32x4 acc[2];
#pragma unroll
                    for (int vq = 0; vq < 2; ++vq) { acc[vq] = (f32x4){0.f, 0.f, 0.f, 0.f}; acc[vq] = SC_MFMA(sf[vq][0], ah[0], acc[vq]); acc[vq] = SC_MFMA(sf[vq][1], ah[1], acc[vq]); acc[vq] = SC_MFMA(vmf[vq], ak, acc[vq]); }
#pragma unroll
                    for (int vq = 0; vq < 2; ++vq)
#pragma unroll
                        for (int q = 0; q < 4; ++q) *(LAS float*)(L + O_RHS + ((16 * (vb0 + vq) + 4 * lq + q) * 16 + lr) * 4) = acc[vq][q];
                }
                float u[16];
                const int vl = 32 * g + (lane & 31);
                { const LAS f32x4* rp = (const LAS f32x4*)(L + O_RHS + vl * 64);
#pragma unroll
                  for (int q = 0; q < 4; ++q) { const f32x4 x = rp[q]; u[4 * q] = x[0]; u[4 * q + 1] = x[1]; u[4 * q + 2] = x[2]; u[4 * q + 3] = x[3]; } }
#define SC_COL(j, CF) do { _Pragma("unroll") for (int q = ((j) + 1) / 4; q < 4; ++q) { const f32x4 cf = CF[q - ((j) + 1) / 4]; \
                        _Pragma("unroll") for (int e = 0; e < 4; ++e) { if (4 * q + e > (j)) u[4 * q + e] += cf[e] * u[j]; } } } while (0)
                f32x4 cB[4][3], cC[7][2];
#pragma unroll
                for (int j = 4; j <= 7; ++j)
#pragma unroll
                    for (int q = (j + 1) / 4; q < 4; ++q) cB[j - 4][q - (j + 1) / 4] = *(const LAS f32x4*)(SB + O_AAB + j * 64 + q * 16);
                asm volatile("" ::: "memory");
                if (ABL != 3) {
                SC_COL(0, cA[0]); SC_COL(1, cA[1]); SC_COL(2, cA[2]); SC_COL(3, cA[3]);
                }
                asm volatile("" ::: "memory");
#pragma unroll
                for (int j = 8; j <= 14; ++j)
#pragma unroll
                    for (int q = (j + 1) / 4; q < 4; ++q) cC[j - 8][q - (j + 1) / 4] = *(const LAS f32x4*)(SB + O_AAB + j * 64 + q * 16);
                asm volatile("" ::: "memory");
                if (ABL != 3) {
                SC_COL(4, cB[0]); SC_COL(5, cB[1]); SC_COL(6, cB[2]); SC_COL(7, cB[3]);
                SC_COL(8, cC[0]); SC_COL(9, cC[1]); SC_COL(10, cC[2]); SC_COL(11, cC[3]); SC_COL(12, cC[4]); SC_COL(13, cC[5]); SC_COL(14, cC[6]);
                }
#undef SC_COL
                { u32x4 w0 = {pk2(u[0], u[1]), pk2(u[2], u[3]), pk2(u[4], u[5]), pk2(u[6], u[7])}, w1 = {pk2(u[8], u[9]), pk2(u[10], u[11]), pk2(u[12], u[13]), pk2(u[14], u[15])};
                  if (lane < 32) { *(LAS u32x4*)(L + O_ZU + vl * 32) = w0; *(LAS u32x4*)(L + O_ZU + vl * 32 + 16) = w1; } }
                {
                    bf16x8 zf[2], sf[2][2], bkf[4]; f32x4 gc[4];
#pragma unroll
                    for (int vq = 0; vq < 2; ++vq) { const int vb = vb0 + vq;
                        zf[vq] = (lq < 2) ? *(const LAS bf16x8*)(L + O_ZU + (16 * vb + lr) * 32 + lq * 16) : *(const LAS bf16x8*)(SB + O_VM + (16 * vb + lr) * 32 + (lq - 2) * 16);
#pragma unroll
                        for (int ks = 0; ks < 2; ++ks) sf[vq][ks] = *(const LAS bf16x8*)(L + O_S0 + (16 * vb + lr) * 128 + ks * 64 + lq * 16);
                    }
                    const bf16x8 rk = *(const LAS bf16x8*)(SB + O_ARK + lr * 64 + lq * 16);
                    const bf16x8 rh0 = *(const LAS bf16x8*)(SB + O_RH + lr * 128 + lq * 16), rh1 = *(const LAS bf16x8*)(SB + O_RH + lr * 128 + 64 + lq * 16);
#pragma unroll
                    for (int kb = 0; kb < 4; ++kb) { gc[kb] = *(const LAS f32x4*)(SB + O_GC + (16 * kb + 4 * lq) * 4); bkf[kb] = *(const LAS bf16x8*)(SB + O_BK + (16 * kb + lr) * 64 + lq * 16); }
                    const int step = c * 16 + lr; SC_ROW(step, row, tq, Tq); (void)tq; (void)Tq;
#pragma unroll
                    for (int vq = 0; vq < 2; ++vq) { f32x4 y = {0.f, 0.f, 0.f, 0.f};
                        y = SC_MFMA(sf[vq][0], rh0, y); y = SC_MFMA(sf[vq][1], rh1, y); y = SC_MFMA(zf[vq], rk, y);
                        if (ABL == 0) *(u32x2*)(yout + (size_t)row * 512 + h * 64 + 16 * (vb0 + vq) + 4 * lq) = (u32x2){pk2(y[0], y[1]), pk2(y[2], y[3])}; else asm volatile("" :: "v"(y[0]), "v"(y[1]), "v"(y[2]), "v"(y[3])); }
#pragma unroll
                    for (int kb = 0; kb < 4; ++kb)
#pragma unroll
                        for (int vq = 0; vq < 2; ++vq) S[kb][vq] = SC_MFMA(bkf[kb], zf[vq], S[kb][vq] * gc[kb]);
                }
                asm volatile("s_waitcnt lgkmcnt(0)" ::: "memory");
                if (lane == 0) done[g * 8 + sl] = c + 1;
            }
            __builtin_amdgcn_s_setprio(0);
        } else {
            const int pw = wid - 2, hc = h * 64 + lane; LAS unsigned char* SB = L + pw * SLOT;
            const float kkc = p.a_k_k[j * 512 + hc], kac = p.a_k_a[j * 512 + hc];
            const float mur = p.a_mu[j * ACOLS + hc], muk = p.a_mu[j * ACOLS + 512 + hc], muv = p.a_mu[j * ACOLS + 1024 + hc];
            for (int c = pw; c < NCH; c += NP) {
                if (ABL == 1 || ABL == 3 || ABL == 4) { if (c >= NP) { unsigned spins = 0; while (ldv(done + pw) != c - NP + 1 || ldv(done + 8 + pw) != c - NP + 1) { __builtin_amdgcn_s_sleep(2); if (++spins > (1u << 22)) break; } } if (lane == 0) ready[pw] = c + 1; continue; }
                bf16_t raw[16][11];
#define SC_LOAD(t) do { const int step = c * 16 + (t); SC_ROW(step, row, tq, Tq); \
                    const int rp_ = (tq > 0) ? row - 1 : row, rn_ = (tq < Tq - 1) ? row + 1 : row; \
                    const bf16_t* pc = p.P + (size_t)row * PLD + hc; const bf16_t* pp = p.P + (size_t)rp_ * PLD + hc; const bf16_t* pn = p.P + (size_t)rn_ * PLD + hc; \
                    raw[t][0] = pc[0]; raw[t][1] = pp[0]; raw[t][2] = pn[0]; raw[t][3] = pc[512]; raw[t][4] = pp[512]; raw[t][5] = pn[512]; raw[t][6] = pc[1024]; raw[t][7] = pp[1024]; raw[t][8] = pn[1024]; \
                    raw[t][9] = p.WAG[(size_t)row * WLD + dir * 512 + hc]; raw[t][10] = p.WAG[(size_t)row * WLD + 1024 + dir * 512 + hc]; } while (0)
#define SC_STEP(t) do { const int step = c * 16 + (t); SC_ROW(step, row, tq, Tq); (void)row; \
                    const float mp = (tq > 0) ? 0.5f : 0.f, mn = (tq < Tq - 1) ? 0.5f : 0.f; \
                    const float rc = bf2f(raw[t][0]), kc_ = bf2f(raw[t][3]), vc = bf2f(raw[t][6]); \
                    const float R = rc + mur * (mp * bf2f(raw[t][1]) + mn * bf2f(raw[t][2]) - rc); \
                    const float K = kc_ + muk * (mp * bf2f(raw[t][4]) + mn * bf2f(raw[t][5]) - kc_); \
                    const float Vv = vc + muv * (mp * bf2f(raw[t][7]) + mn * bf2f(raw[t][8]) - vc); \
                    const float w = 1.f - bf2f(raw[t][9]), a = bf2f(raw[t][10]); \
                    const float kkv = K * kkc, ssq = wave_sum(kkv * kkv), kk = kkv * rsqrtf(ssq + 1e-12f); \
                    const float kd = K * (1.f + (a - 1.f) * kac), bd = kk * a; \
                    const float gprev = g; g *= w; const float ig = __builtin_amdgcn_rcpf(g); \
                    *(LAS bf16_t*)(SB + O_AH + (t) * 128 + lane * 2) = f2bf(-kk * gprev); \
                    *(LAS bf16_t*)(SB + O_RH + (t) * 128 + lane * 2) = f2bf(R * g); \
                    *(LAS bf16_t*)(SB + O_BH + (t) * 128 + lane * 2) = f2bf(bd * ig); \
                    *(LAS bf16_t*)(SB + O_KH + (t) * 128 + lane * 2) = f2bf(kd * ig); \
                    *(LAS bf16_t*)(SB + O_VM + lane * 32 + (t) * 2) = f2bf(Vv); } while (0)
                SC_LOAD(0); SC_LOAD(1); SC_LOAD(2); SC_LOAD(3); SC_LOAD(4); SC_LOAD(5); SC_LOAD(6); SC_LOAD(7);
                if (c >= NP) { unsigned spins = 0; while (ldv(done + pw) != c - NP + 1 || ldv(done + 8 + pw) != c - NP + 1) { __builtin_amdgcn_s_sleep(2); if (++spins > (1u << 22)) break; } }
                asm volatile("" ::: "memory");
                float g = 1.f;
                SC_STEP(0); SC_STEP(1); SC_STEP(2); SC_STEP(3);
                asm volatile("" ::: "memory");
                SC_LOAD(8); SC_LOAD(9); SC_LOAD(10); SC_LOAD(11);
                asm volatile("" ::: "memory");
                SC_STEP(4); SC_STEP(5); SC_STEP(6); SC_STEP(7);
                asm volatile("" ::: "memory");
                SC_LOAD(12); SC_LOAD(13); SC_LOAD(14); SC_LOAD(15);
                asm volatile("" ::: "memory");
                SC_STEP(8); SC_STEP(9); SC_STEP(10); SC_STEP(11); SC_STEP(12); SC_STEP(13); SC_STEP(14); SC_STEP(15);
#undef SC_LOAD
#undef SC_STEP
#pragma unroll
                for (int q = 0; q < 2; ++q) {
                    float bq[8], kq[8];
#pragma unroll
                    for (int e = 0; e < 8; ++e) { bq[e] = bf2f(*(const LAS bf16_t*)(SB + O_BH + (8 * q + e) * 128 + lane * 2)) * g; kq[e] = bf2f(*(const LAS bf16_t*)(SB + O_KH + (8 * q + e) * 128 + lane * 2)) * g; }
                    u32x4 wb = {pk2(bq[0], bq[1]), pk2(bq[2], bq[3]), pk2(bq[4], bq[5]), pk2(bq[6], bq[7])}, wk = {pk2(kq[0], kq[1]), pk2(kq[2], kq[3]), pk2(kq[4], kq[5]), pk2(kq[6], kq[7])};
                    *(LAS u32x4*)(SB + O_BK + lane * 64 + q * 16) = wb; *(LAS u32x4*)(SB + O_BK + lane * 64 + 32 + q * 16) = wk;
                }
                *(LAS float*)(SB + O_GC + lane * 4) = g;
                f32x4 sab = {0.f, 0.f, 0.f, 0.f}, sak = sab, srb = sab, srk = sab;
#pragma unroll
                for (int ks = 0; ks < 2; ++ks) {
                    const bf16x8 fa = *(const LAS bf16x8*)(SB + O_AH + lr * 128 + ks * 64 + lq * 16), fr = *(const LAS bf16x8*)(SB + O_RH + lr * 128 + ks * 64 + lq * 16);
                    const bf16x8 fb = *(const LAS bf16x8*)(SB + O_BH + lr * 128 + ks * 64 + lq * 16), fk = *(const LAS bf16x8*)(SB + O_KH + lr * 128 + ks * 64 + lq * 16);
                    sab = SC_MFMA(fa, fb, sab); sak = SC_MFMA(fa, fk, sak); srb = SC_MFMA(fr, fb, srb); srk = SC_MFMA(fr, fk, srk);
                }
#pragma unroll
                for (int q = 0; q < 4; ++q) { const int t = 4 * lq + q; const bool lo = lr < t, le = lr <= t;
                    *(LAS bf16_t*)(SB + O_AAK + (t * 16 + lr) * 2) = f2bf(lo ? sak[q] : 0.f);
                    *(LAS bf16_t*)(SB + O_ARK + (t * 32 + lr) * 2) = f2bf(le ? srb[q] : 0.f);
                    *(LAS bf16_t*)(SB + O_ARK + (t * 32 + 16 + lr) * 2) = f2bf(le ? srk[q] : 0.f); }
                { f32x4 tq;
#pragma unroll
                  for (int q = 0; q < 4; ++q) tq[q] = (lr < 4 * lq + q) ? sab[q] : 0.f;
                  *(LAS f32x4*)(SB + O_AAB + (lr * 16 + 4 * lq) * 4) = tq; }
                asm volatile("s_waitcnt lgkmcnt(0)" ::: "memory");
                if (lane == 0) ready[pw] = c + 1;
            }
        }
#undef SC_ROW
        __syncthreads();
    }
}

DI void unpack8u(const uint4 u, float (&d)[8]) { d[0] = bflo(u.x); d[1] = bfhi(u.x); d[2] = bflo(u.y); d[3] = bfhi(u.y); d[4] = bflo(u.z); d[5] = bfhi(u.z); d[6] = bflo(u.w); d[7] = bfhi(u.w); }
DI uint4 pack8u(const float (&d)[8]) { uint4 u; u.x = att::pk(d[0], d[1]); u.y = att::pk(d[2], d[3]); u.z = att::pk(d[4], d[5]); u.w = att::pk(d[6], d[7]); return u; }
DI void shift8(const bf16_t* P, int row, int t, int T, int col0, const float (&mu)[8], float (&o)[8]) {
    float c[8], pv[8], nx[8];
    unpack8u(*(const uint4*)(P + (size_t)row * PLD + col0), c);
    if (t > 0) unpack8u(*(const uint4*)(P + (size_t)(row - 1) * PLD + col0), pv); else {
#pragma unroll
        for (int i = 0; i < 8; ++i) pv[i] = 0.f; }
    if (t < T - 1) unpack8u(*(const uint4*)(P + (size_t)(row + 1) * PLD + col0), nx); else {
#pragma unroll
        for (int i = 0; i < 8; ++i) nx[i] = 0.f; }
#pragma unroll
    for (int i = 0; i < 8; ++i) o[i] = c[i] + mu[i] * (0.5f * (pv[i] + nx[i]) - c[i]);
}
DI void ld8f(const float* p, float (&d)[8]) { const float4 a = *(const float4*)p, b = *(const float4*)(p + 4); d[0] = a.x; d[1] = a.y; d[2] = a.z; d[3] = a.w; d[4] = b.x; d[5] = b.y; d[6] = b.z; d[7] = b.w; }
DI void ph_post_opt(const Ctx& cx, const Params& p, int j, int nrows) {
    const int tid = cx.tid, wid = tid >> 6, lane = tid & 63, c0 = lane * 8;
    float mur[8], muk[8], muv[8], ka[8], rk[8], lw[8], lb[8];
    ld8f(p.a_mu + j * ACOLS + c0, mur); ld8f(p.a_mu + j * ACOLS + 512 + c0, muk); ld8f(p.a_mu + j * ACOLS + 1024 + c0, muv);
    ld8f(p.a_k_a + j * 512 + c0, ka); ld8f(p.a_r_k + j * 512 + c0, rk); ld8f(p.a_ln_w + j * 512 + c0, lw); ld8f(p.a_ln_b + j * 512 + c0, lb);
    for (int row = cx.bid * 8 + wid; row < nrows; row += cx.nblk * 8) {
        const bool lat = row < NLAT; const int t = lat ? (row & 2047) : ((row - NLAT) & 255); const int T = lat ? 2048 : 256;
        float yf[8], yb[8], R[8], K[8], V[8], af[8], ab[8], g[8];
        unpack8u(*(const uint4*)(p.YF + (size_t)row * 512 + c0), yf); unpack8u(*(const uint4*)(p.YB + (size_t)row * 512 + c0), yb);
        shift8(p.P, row, t, T, c0, mur, R); shift8(p.P, row, t, T, 512 + c0, muk, K); shift8(p.P, row, t, T, 1024 + c0, muv, V);
        unpack8u(*(const uint4*)(p.WAG + (size_t)row * WLD + 1024 + c0), af); unpack8u(*(const uint4*)(p.WAG + (size_t)row * WLD + 1536 + c0), ab); unpack8u(*(const uint4*)(p.WAG + (size_t)row * WLD + 2048 + c0), g);
        float sum = 0.f, sb = 0.f;
#pragma unroll
        for (int i = 0; i < 8; ++i) { yf[i] += yb[i]; sum += yf[i]; sb += R[i] * rk[i] * K[i] * (2.f + (af[i] + ab[i] - 2.f) * ka[i]); }
        sum = scan::red8(sum); sb = scan::red8(sb);
        const float mean = sum * (1.f / 64.f); float var = 0.f;
#pragma unroll
        for (int i = 0; i < 8; ++i) { const float d = yf[i] - mean; var += d * d; }
        var = scan::red8(var);
        const float rstd = rsqrtf(var * (1.f / 64.f) + 64e-5f);
        float o[8];
#pragma unroll
        for (int i = 0; i < 8; ++i) o[i] = ((yf[i] - mean) * rstd * lw[i] + lb[i] + sb * V[i]) * g[i];
        *(uint4*)(p.H + (size_t)row * 1024 + c0) = pack8u(o);
    }
}
DI void rope_cs(int c, int t, bool lat, float (&cs)[8], float (&sn)[8]) {
    const float invf[8] = {1.f, 0.316227766016838f, 0.1f, 0.0316227766016838f, 0.01f, 0.00316227766016838f, 0.001f, 0.000316227766016838f};
    const float pos = (c & 1) ? (float)(t & 63) : (float)(t >> 6);
#pragma unroll
    for (int i = 0; i < 8; ++i) { const float ang = pos * invf[i]; cs[i] = lat ? __cosf(ang) : 1.f; sn[i] = lat ? __sinf(ang) : 0.f; }
}
DI void fin_vec(float (&x)[8], int c, const float (&cs)[8], const float (&sn)[8], const float (&gn)[8], float scl, bf16_t* dst) {
    float ss = 0.f;
#pragma unroll
    for (int i = 0; i < 8; ++i) ss += x[i] * x[i];
    ss += dpp_f<0xB1>(ss); ss += dpp_f<0x4E>(ss); ss += dpp_f<0x141>(ss); ss += dpp_f<0x140>(ss);
    const float r = rsqrtf(ss * (1.f / 96.f) + 1e-6f);
#pragma unroll
    for (int i = 0; i < 8; ++i) x[i] = x[i] * r * gn[i];
    float y[8];
#pragma unroll
    for (int i = 0; i < 8; ++i) { const float up = dpp_f<0x102>(x[i]), dn = dpp_f<0x112>(x[i]); y[i] = (c < 10) ? up : dn; }
    if (c >= 8 && c < 12) {
#pragma unroll
        for (int i = 0; i < 8; ++i) x[i] = (c < 10) ? (x[i] * cs[i] - y[i] * sn[i]) : (x[i] * cs[i] + y[i] * sn[i]);
    }
    if (c < 12) {
#pragma unroll
        for (int i = 0; i < 8; ++i) x[i] *= scl;
        *(uint4*)(dst + c * 8) = pack8u(x);
    }
}
DI void ph_finalize_opt(const Ctx& cx, const Params& p, float* ldsf, int j, int mq) {
    const int tid = cx.tid, wid = tid >> 6, lane = tid & 63, c = lane & 15, hq = lane >> 4;
    float qg[8], kg[8]; ld8f(p.b_q_gain + j * 96 + (c < 12 ? c : 0) * 8, qg); ld8f(p.b_k_gain + j * 96 + (c < 12 ? c : 0) * 8, kg);
    for (int row0 = (cx.bid * 8 + wid) * 2; row0 < NT; row0 += cx.nblk * 16) {
        float xq[4][8], xk[4][8];
#pragma unroll
        for (int u = 0; u < 4; ++u) {
            const int row = row0 + (u >> 1), h = (u & 1) * 4 + hq;
#pragma unroll
            for (int i = 0; i < 8; ++i) { xq[u][i] = 0.f; xk[u][i] = 0.f; }
            if (row < mq && c < 12) unpack8u(*(const uint4*)(p.Qraw + (size_t)row * 768 + h * 96 + c * 8), xq[u]);
            if (c < 8) unpack8u(*(const uint4*)(p.KVraw + (size_t)row * 1024 + h * 128 + c * 8), xk[u]);
            else if (c < 12) unpack8u(*(const uint4*)(p.P + (size_t)row * PLD + ACOLS + 384 + (c - 8) * 8), xk[u]);
        }
#pragma unroll
        for (int rr = 0; rr < 2; ++rr) {
            const int row = row0 + rr;
            const bool lat = row < NLAT; const int b = lat ? (row >> 11) : ((row - NLAT) >> 8); const int t = lat ? (row & 2047) : ((row - NLAT) & 255);
            float cs[8], sn[8]; rope_cs(c, t, lat, cs, sn);
            const int key = lat ? 256 + t : t;
#pragma unroll
            for (int hf = 0; hf < 2; ++hf) { const int u = rr * 2 + hf, h = hf * 4 + hq;
                if (row < mq) fin_vec(xq[u], c, cs, sn, qg, 0.10206207261596577f * 1.4426950408889634f, p.Qraw + (size_t)row * 768 + h * 96);
                fin_vec(xk[u], c, cs, sn, kg, 1.f, p.Kf + ((size_t)(b * 8 + h) * 2304 + key) * 96); }
        }
    }
    bf16_t* T = (bf16_t*)ldsf; constexpr int TP = 520;
    for (int tile = cx.bid; tile < NT / 64; tile += cx.nblk) {
        const int row0 = tile * 64; const bool lat = row0 < NLAT; const int b = lat ? (row0 >> 11) : ((row0 - NLAT) >> 8); const int t0 = lat ? (row0 & 2047) : ((row0 - NLAT) & 255);
        const int key0 = lat ? 256 + t0 : t0;
        __syncthreads();
#pragma unroll
        for (int i = 0; i < 8; ++i) { const int ch = tid + 512 * i, kr = ch >> 6, cc = ch & 63, h = cc >> 3, part = cc & 7;
            *(uint4*)(T + kr * TP + h * 64 + part * 8) = *(const uint4*)(p.KVraw + (size_t)(row0 + kr) * 1024 + h * 128 + 64 + part * 8); }
        __syncthreads();
#pragma unroll
        for (int i = 0; i < 8; ++i) { const int ch = tid + 512 * i, hd = ch >> 3, kc = ch & 7;
            float v[8];
#pragma unroll
            for (int q = 0; q < 8; ++q) v[q] = bf2f(T[(kc * 8 + q) * TP + hd]);
            uint4 o; o.x = (unsigned)T[(kc * 8 + 0) * TP + hd] | ((unsigned)T[(kc * 8 + 1) * TP + hd] << 16); o.y = (unsigned)T[(kc * 8 + 2) * TP + hd] | ((unsigned)T[(kc * 8 + 3) * TP + hd] << 16);
            o.z = (unsigned)T[(kc * 8 + 4) * TP + hd] | ((unsigned)T[(kc * 8 + 5) * TP + hd] << 16); o.w = (unsigned)T[(kc * 8 + 6) * TP + hd] | ((unsigned)T[(kc * 8 + 7) * TP + hd] << 16);
            (void)v;
            *(uint4*)(p.Vt + ((size_t)(b * 8 + (hd >> 6)) * 64 + (hd & 63)) * 2304 + key0 + kc * 8) = o; }
    }
    __syncthreads();
}
DI void ph_mod_opt(const Ctx& cx, const Params& p, float* lds) {
    const int tid = cx.tid, wid = tid >> 6, lane = tid & 63;
    float* part = lds + 17 * 1024;
    for (int i = tid; i < 17 * 1024; i += NTHR) { const int jj = i >> 10, k = i & 1023; const float v = (jj < 16) ? p.c[jj * 1024 + k] : p.c_ctx[k]; lds[i] = siluf(v); }
    __syncthreads();
    for (int item = cx.bid; item < 4 * 96; item += cx.nblk) {
        const int l = item / 96, n = (item % 96) * 64 + lane;
        const float* w = p.mod_w + (size_t)l * 1024 * 6144 + n;
        float acc[17];
#pragma unroll
        for (int jj = 0; jj < 17; ++jj) acc[jj] = 0.f;
        for (int k0 = wid * 128; k0 < wid * 128 + 128; k0 += 16) {
            float wv[16];
#pragma unroll
            for (int q = 0; q < 16; ++q) wv[q] = w[(size_t)(k0 + q) * 6144];
#pragma unroll
            for (int q = 0; q < 16; ++q)
#pragma unroll
                for (int jj = 0; jj < 17; ++jj) acc[jj] += lds[jj * 1024 + k0 + q] * wv[q];
        }
#pragma unroll
        for (int jj = 0; jj < 17; ++jj) part[(wid * 17 + jj) * 64 + lane] = acc[jj];
        __syncthreads();
        for (int o = tid; o < 17 * 64; o += NTHR) { const int jj = o >> 6, ln = o & 63; float sacc = p.mod_b[l * 6144 + (item % 96) * 64 + ln];
#pragma unroll
            for (int q = 0; q < 8; ++q) sacc += part[(q * 17 + jj) * 64 + ln];
            p.mod[((size_t)l * 17 + jj) * 6144 + (item % 96) * 64 + ln] = sacc; }
        __syncthreads();
    }
}

DI void ph_norm2_router(const Ctx& cx, const Params& p, float* ldsg, int nrows, const float* gain, const float* modl, int layer, const bf16_t* xb_lat) {
    LAS float* lds = (LAS float*)ldsg;
    const int tid = cx.tid, wid = tid >> 6, lane = tid & 63;
    LAS float* rw = lds; LAS float* red = lds + 16 * 1024 + wid * (32 * 64 + 64); LAS float* my = red + 32 * 64;
    LAS int* lcnt = (LAS int*)(lds + 16 * 1024 + 8 * (32 * 64 + 64)); LAS int* lbase = lcnt + 16; LAS int* rlist = lcnt + 32;
    for (int i = tid; i < 16 * 1024; i += NTHR) { const int e = i >> 10, col = i & 1023; rw[i] = p.router_w[col * 16 + e]; }
    if (tid < 16) lcnt[tid] = 0;
    __syncthreads();
    int nlist = 0;
    uint2 raw[2][4];
#define N2_LOAD(pi) do { _Pragma("unroll") for (int r = 0; r < 2; ++r) { const int row = 2 * (pi) + r; const bf16_t* xr = (row < NLAT) ? xb_lat + (size_t)row * 1024 : p.cs + (size_t)(row - NLAT) * 1024; \
            _Pragma("unroll") for (int i = 0; i < 4; ++i) raw[r][i] = *(const uint2*)(xr + i * 256 + lane * 4); } } while (0)
    { const int p0 = cx.bid * 8 + wid; if (xb_lat && p0 < (nrows >> 1)) N2_LOAD(p0); }
    for (int pidx = cx.bid * 8 + wid; pidx < (nrows >> 1); pidx += cx.nblk * 8) {
        float4 xv[2][4];
        if (xb_lat) {
#pragma unroll
            for (int r = 0; r < 2; ++r)
#pragma unroll
                for (int i = 0; i < 4; ++i) xv[r][i] = make_float4(bflo(raw[r][i].x), bfhi(raw[r][i].x), bflo(raw[r][i].y), bfhi(raw[r][i].y));
            const int pn = pidx + cx.nblk * 8; if (pn < (nrows >> 1)) N2_LOAD(pn);
        } else {
#pragma unroll
            for (int r = 0; r < 2; ++r) { const int row = 2 * pidx + r; const float* xr = (row < NLAT) ? p.out + (size_t)row * 1024 : p.ctxs + (size_t)(row - NLAT) * 1024;
#pragma unroll
                for (int i = 0; i < 4; ++i) xv[r][i] = *(const float4*)(xr + i * 256 + lane * 4); }
        }
        const int row0 = 2 * pidx; const int jj = (row0 < NLAT) ? (row0 >> 11) : 16;
        const float* shp = modl + (size_t)jj * 6144 + 3 * 1024; const float* scp = modl + (size_t)jj * 6144 + 4 * 1024;
        float4 hv[2][4];
#pragma unroll
        for (int r = 0; r < 2; ++r) {
            float ss = 0.f;
#pragma unroll
            for (int i = 0; i < 4; ++i) ss += xv[r][i].x * xv[r][i].x + xv[r][i].y * xv[r][i].y + xv[r][i].z * xv[r][i].z + xv[r][i].w * xv[r][i].w;
            ss = wave_sum(ss);
            const float rstd = rsqrtf(ss * (1.f / 1024.f) + 1e-6f);
#pragma unroll
            for (int i = 0; i < 4; ++i) {
                const int col = i * 256 + lane * 4;
                const float4 g = *(const float4*)(gain + col), sh = *(const float4*)(shp + col), sc = *(const float4*)(scp + col);
                hv[r][i].x = xv[r][i].x * rstd * g.x * (1.f + sc.x) + sh.x; hv[r][i].y = xv[r][i].y * rstd * g.y * (1.f + sc.y) + sh.y;
                hv[r][i].z = xv[r][i].z * rstd * g.z * (1.f + sc.z) + sh.z; hv[r][i].w = xv[r][i].w * rstd * g.w * (1.f + sc.w) + sh.w;
                uint2 u; u.x = att::pk(hv[r][i].x, hv[r][i].y); u.y = att::pk(hv[r][i].z, hv[r][i].w);
                *(uint2*)(p.H + (size_t)(row0 + r) * 1024 + col) = u;
            }
        }
#pragma unroll
        for (int e = 0; e < 16; ++e) {
            float a0 = 0.f, a1 = 0.f;
#pragma unroll
            for (int i = 0; i < 4; ++i) { const mm::f32x4 w = *(const LAS mm::f32x4*)(rw + e * 1024 + i * 256 + lane * 4);
                a0 += hv[0][i].x * w[0] + hv[0][i].y * w[1] + hv[0][i].z * w[2] + hv[0][i].w * w[3]; a1 += hv[1][i].x * w[0] + hv[1][i].y * w[1] + hv[1][i].z * w[2] + hv[1][i].w * w[3]; }
            red[e * 64 + lane] = a0; red[(16 + e) * 64 + lane] = a1;
        }
        __builtin_amdgcn_wave_barrier();
        {
            const int r = lane >> 5, e = (lane >> 1) & 15, half = lane & 1; const LAS float* src = red + (r * 16 + e) * 64 + half * 32;
            float sacc = 0.f;
#pragma unroll
            for (int q = 0; q < 8; ++q) { const mm::f32x4 v = *(const LAS mm::f32x4*)(src + q * 4); sacc += (v[0] + v[1]) + (v[2] + v[3]); }
            sacc += dpp_f<0xB1>(sacc);
            const float sg = 1.f / (1.f + __expf(-sacc));
            if (half == 0) { my[r * 32 + e] = sg; my[r * 32 + 16 + e] = sg + p.router_b[e]; }
        }
        __builtin_amdgcn_wave_barrier();
        if ((lane & 31) == 0) {
            const int r = lane >> 5; const LAS float* m = my + r * 32;
            float best = -3.0e38f; int be1 = 0, be2 = 1;
#pragma unroll
            for (int g = 0; g < 4; ++g) {
                const mm::f32x4 v = *(const LAS mm::f32x4*)(m + 16 + 4 * g);
                int i1 = 0; float m1 = v[0];
                if (v[1] > m1) { m1 = v[1]; i1 = 1; } if (v[2] > m1) { m1 = v[2]; i1 = 2; } if (v[3] > m1) { m1 = v[3]; i1 = 3; }
                int i2 = -1; float m2 = -3.0e38f;
                if (i1 != 0 && v[0] > m2) { m2 = v[0]; i2 = 0; } if (i1 != 1 && v[1] > m2) { m2 = v[1]; i2 = 1; }
                if (i1 != 2 && v[2] > m2) { m2 = v[2]; i2 = 2; } if (i1 != 3 && v[3] > m2) { m2 = v[3]; i2 = 3; }
                const float gs = m1 + m2;
                if (gs > best) { best = gs; be1 = 4 * g + i1; be2 = 4 * g + i2; }
            }
            const float bs1 = m[be1], bs2 = m[be2]; const float inv = 1.f / (bs1 + bs2);
            const int p1 = atomicAdd((int*)&lcnt[be1], 1), p2 = atomicAdd((int*)&lcnt[be2], 1);
            LAS int* ent = rlist + (wid * 24 + nlist * 2 + r) * 6;
            const int row = row0 + r;
            ent[0] = row; ent[1] = be1 | (be2 << 8); ent[2] = p1; ent[3] = p2; ent[4] = __float_as_int(bs1 * inv); ent[5] = __float_as_int(bs2 * inv);
        }
        ++nlist;
        __builtin_amdgcn_wave_barrier();
    }
#undef N2_LOAD
    __syncthreads();
    if (tid < 16) lbase[tid] = atomicAdd(p.cnt + (layer * 16 + tid) * 64, lcnt[tid]);
    __syncthreads();
    for (int k = lane; k < 2 * nlist; k += 64) {
        const LAS int* ent = rlist + (wid * 24 + k) * 6; const int row = ent[0], be1 = ent[1] & 255, be2 = ent[1] >> 8;
        const size_t s1 = (size_t)be1 * NT + lbase[be1] + ent[2], s2 = (size_t)be2 * NT + lbase[be2] + ent[3];
        p.slot[s1] = row * 2; p.slot[s2] = row * 2 + 1; p.slotw[s1] = __int_as_float(ent[4]); p.slotw[s2] = __int_as_float(ent[5]);
    }
    __syncthreads();
}

DI void ph_prepBLR_opt(const Ctx& cx, const Params& p, int j) {
    const int tid = cx.tid, wid = tid >> 6, lane = tid & 63;
    const float4 gq = *(const float4*)(p.b_q_norm + j * 256 + lane * 4); const float2 gk = *(const float2*)(p.b_kv_norm + j * 128 + lane * 2);
    constexpr int U = 8;
    for (int row0 = (cx.bid * 8 + wid) * U; row0 < NT; row0 += cx.nblk * 8 * U) {
        uint2 uq[U]; unsigned ukv[U];
#pragma unroll
        for (int u = 0; u < U; ++u) { const bf16_t* pr = p.P + (size_t)(row0 + u) * PLD + ACOLS; uq[u] = *(const uint2*)(pr + lane * 4); ukv[u] = *(const unsigned*)(pr + 256 + lane * 2); }
#pragma unroll
        for (int u = 0; u < U; ++u) {
            const float q0 = bflo(uq[u].x), q1 = bfhi(uq[u].x), q2 = bflo(uq[u].y), q3 = bfhi(uq[u].y), k0 = bflo(ukv[u]), k1 = bfhi(ukv[u]);
            const float sq = wave_sum(q0 * q0 + q1 * q1 + q2 * q2 + q3 * q3), sk = wave_sum(k0 * k0 + k1 * k1);
            const float rq = rsqrtf(sq * (1.f / 256.f) + 1e-6f), rk = rsqrtf(sk * (1.f / 128.f) + 1e-6f);
            uint2 o; o.x = att::pk(q0 * rq * gq.x, q1 * rq * gq.y); o.y = att::pk(q2 * rq * gq.z, q3 * rq * gq.w);
            bf16_t* qn = p.QN + (size_t)(row0 + u) * 512;
            *(uint2*)(qn + lane * 4) = o; *(unsigned*)(qn + 256 + lane * 2) = att::pk(k0 * rk * gk.x, k1 * rk * gk.y); *(unsigned*)(qn + 384 + lane * 2) = 0u;
        }
    }
    const int gtid = cx.bid * NTHR + tid, gsz = cx.nblk * NTHR;
    for (int idx = gtid; idx < NT * 48; idx += gsz) {
        const int row = idx / 48, cg = idx % 48, col0 = cg * 8;
        const bool lat = row < NLAT; const int t = lat ? (row & 2047) : ((row - NLAT) & 255); const int T = lat ? 2048 : 256;
        float mu[8]; ld8f(p.a_mu + j * ACOLS + 1536 + col0, mu);
        float v[8]; shift8(p.P, row, t, T, 1536 + col0, mu, v);
        if (cg < 16) {
#pragma unroll
            for (int i = 0; i < 8; ++i) { const float e = __expf(2.f * v[i]); v[i] = 1.f - 2.f * __builtin_amdgcn_rcpf(e + 1.f); }
        } else if (cg >= 32) {
#pragma unroll
            for (int i = 0; i < 8; ++i) v[i] = __builtin_amdgcn_rcpf(1.f + __expf(-v[i]));
        }
        *(uint4*)(p.LR + (size_t)row * 384 + col0) = pack8u(v);
    }
}

template <bool FINAL>
DI void ph_normc(const Ctx& cx, const Params& p, int nrows, const bf16_t* xin_lat, bf16_t* xout_lat, const float* gain, const float* modl, const float* modprev) {
    const int tid = cx.tid, wid = tid >> 6, lane = tid & 63;
    for (int row = cx.bid * 8 + wid; row < nrows; row += cx.nblk * 8) {
        const bool lat = row < NLAT; const int jj = lat ? (row >> 11) : 16; const size_t rb = lat ? (size_t)row : (size_t)(row - NLAT);
        const bf16_t* xr = (lat ? xin_lat : p.cs) + rb * 1024;
        const float* g2 = modprev + (size_t)jj * 6144 + 5 * 1024;
        float4 xv[4];
#pragma unroll
        for (int i = 0; i < 4; ++i) {
            const int col = i * 256 + lane * 4;
            const uint2 ux = *(const uint2*)(xr + col);
            float s0 = 0.f, s1 = 0.f, s2 = 0.f, s3 = 0.f;
#pragma unroll
            for (int sl = 0; sl < 3; ++sl) { const uint2 u = *(const uint2*)(p.Y + ((size_t)sl * NT + row) * 1024 + col); s0 += bflo(u.x); s1 += bfhi(u.x); s2 += bflo(u.y); s3 += bfhi(u.y); }
            const float4 gv = *(const float4*)(g2 + col);
            xv[i].x = bflo(ux.x) + gv.x * s0; xv[i].y = bfhi(ux.x) + gv.y * s1; xv[i].z = bflo(ux.y) + gv.z * s2; xv[i].w = bfhi(ux.y) + gv.w * s3;
            if (FINAL) *(float4*)(p.out + (size_t)row * 1024 + col) = xv[i];
            else { uint2 o; o.x = att_pk(xv[i].x, xv[i].y); o.y = att_pk(xv[i].z, xv[i].w); *(uint2*)((lat ? xout_lat : p.cs) + rb * 1024 + col) = o; }
        }
        if (!FINAL) {
            float ss = 0.f;
#pragma unroll
            for (int i = 0; i < 4; ++i) ss += xv[i].x * xv[i].x + xv[i].y * xv[i].y + xv[i].z * xv[i].z + xv[i].w * xv[i].w;
            ss = wave_sum(ss);
            const float rstd = rsqrtf(ss * (1.f / 1024.f) + 1e-6f);
            const float* shp = modl + (size_t)jj * 6144; const float* scp = modl + (size_t)jj * 6144 + 1024;
#pragma unroll
            for (int i = 0; i < 4; ++i) {
                const int col = i * 256 + lane * 4;
                const float4 g = *(const float4*)(gain + col), sh = *(const float4*)(shp + col), sc = *(const float4*)(scp + col);
                uint2 u; u.x = att_pk(xv[i].x * rstd * g.x * (1.f + sc.x) + sh.x, xv[i].y * rstd * g.y * (1.f + sc.y) + sh.y);
                u.y = att_pk(xv[i].z * rstd * g.z * (1.f + sc.z) + sh.z, xv[i].w * rstd * g.w * (1.f + sc.w) + sh.w);
                *(uint2*)(p.H + (size_t)row * 1024 + col) = u;
            }
        }
    }
}

struct F1Sched {
    static constexpr bool GATHER = false, TABLE = false;
    const char* A; const char* Hb; int T2, nN, G, c;
    DI size_t hstep_a() const { return (size_t)mm::HALF * 1024 * 2; }
    DI unsigned boff(int Rb, int C, int Kk) const { return (unsigned)(Rb * T2 * Kk + C) * 2u; }
    DI size_t hstep_b(int Kk) const { return (size_t)Kk * 2; }
    DI bool next(int i, mm::Unit& u) const {
        const int L = i * G + c; if (L >= 8 * nN) return false;
        u.pm = L & 7; u.pn = L >> 3; u.e = 0; u.m = 0;
        const int b = (T2 == 16) ? (u.pn >> 3) : u.pn, t20 = (T2 == 16) ? 2 * (u.pn & 7) : 0;
        u.A = A + (size_t)u.pm * 256 * 1024 * 2; u.B = Hb + ((size_t)b * (128 * T2) + t20) * 1024 * 2; return true;
    }
    DI void aoff(const mm::Unit&, int R0, int C0, int R1, int C1, unsigned (&o)[2][2]) const {
        o[0][0] = (unsigned)(R0 * 1024 + C0) * 2u; o[0][1] = (unsigned)(R1 * 1024 + C1) * 2u; o[1][0] = o[0][0]; o[1][1] = o[0][1];
    }
};
struct EpiZT3 {
    static constexpr bool PERM = true;
    bf16_t* Z; int T2;
    DI void operator()(const mm::f32x4 (&acc)[2][2][4][2], const mm::Unit& u, int wr, int wc, int fr, int fq) const {
        const int b = (T2 == 16) ? (u.pn >> 3) : u.pn, t20 = (T2 == 16) ? 2 * (u.pn & 7) : 0;
        const int m0 = u.pm * 256 + wr * 64 + fr, t1 = wc * 32 + 8 * fq;
#pragma unroll
        for (int ai = 0; ai < 2; ++ai)
#pragma unroll
            for (int m = 0; m < 4; ++m) { const int mr = m0 + ai * 128 + m * 16, part = mr >> 10, ch = mr & 1023;
#pragma unroll
                for (int bj = 0; bj < 2; ++bj) { const mm::f32x4 v0 = acc[ai][bj][m][0], v1 = acc[ai][bj][m][1];
                    mm::u32x4 w; w.x = att_pk(v0[0], v0[1]); w.y = att_pk(v0[2], v0[3]); w.z = att_pk(v1[0], v1[1]); w.w = att_pk(v1[2], v1[3]);
                    *(mm::u32x4*)(Z + ((size_t)(b * 1024 + ch) * T2 + t20 + bj) * 256 + part * 128 + t1) = w; } }
    }
};
DI void ph_f1b(const Ctx& cx, const Params& p, float* lds, int j, bool with_ctx) {
    { F1Sched S{(const char*)(p.A1 + (size_t)j * 2048 * 1024), (const char*)p.H, 16, NLAT / 256, cx.nblk, cx.bid}; EpiZT3 E{p.ZT, 16}; mm::gemm_phase(GEMM_LDS(lds), 1024, S, E, cx.tid); }
    if (with_ctx) { F1Sched S{(const char*)(p.A1 + (size_t)j * 2048 * 1024), (const char*)(p.H + (size_t)NLAT * 1024), 2, NCTX / 256, cx.nblk, cx.bid}; EpiZT3 E{p.ZTC, 2}; mm::gemm_phase(GEMM_LDS(lds), 1024, S, E, cx.tid); }
}
DI void ph_fa(const Ctx& cx, const Params& p, float* lds, bool with_ctx) {
    int Kr = 256; asm volatile("" : "+s"(Kr));
    { mm::BatchSched S; S.init(p.M1, p.ZT, (size_t)16384 * 256 * 2, 16, 256, 16384, Kr, cx.nblk, cx.bid); mm::EpiBf16Store E{p.YF1, 16384, (size_t)256 * 16384}; mm::gemm_phase(GEMM_LDS(lds), Kr, S, E, cx.tid); }
    if (with_ctx) { mm::BatchSched S; S.init(p.M1, p.ZTC, (size_t)2048 * 256 * 2, 16, 256, 2048, Kr, cx.nblk, cx.bid); mm::EpiBf16Store E{p.YF1c, 2048, (size_t)256 * 2048}; mm::gemm_phase(GEMM_LDS(lds), Kr, S, E, cx.tid); }
}
template <int T2>
DI void fb_items(const Ctx& cx, const Params& p, const LAS float* tw, const bf16_t* Y, const bf16_t* xin, bf16_t* xout, const float* modl, bool ctx, float scale) {
    constexpr int T = 128 * T2; constexpr size_t NB = (size_t)1024 * T2;
    const int gtid = cx.bid * NTHR + cx.tid, gsz = cx.nblk * NTHR;
    for (int idx = gtid; idx < 16 * 128 * 512; idx += gsz) {
        const int cp = idx & 511, f1 = (idx >> 9) & 127, b = idx >> 16;
        float yr[2][T2], yi[2][T2];
        { const bf16_t* pr = Y + ((size_t)b * 256 + f1) * NB + (size_t)(2 * cp) * T2; const bf16_t* pi = pr + (size_t)128 * NB;
          if constexpr (T2 == 2) { const uint2 ur = *(const uint2*)pr, ui = *(const uint2*)pi;
              yr[0][0] = bflo(ur.x); yr[0][1] = bfhi(ur.x); yr[1][0] = bflo(ur.y); yr[1][1] = bfhi(ur.y); yi[0][0] = bflo(ui.x); yi[0][1] = bfhi(ui.x); yi[1][0] = bflo(ui.y); yi[1][1] = bfhi(ui.y); }
          else {
#pragma unroll
          for (int q = 0; q < (2 * T2) / 8; ++q) { float d[8]; unpack8u(*(const uint4*)(pr + q * 8), d);
#pragma unroll
              for (int e = 0; e < 8; ++e) yr[(q * 8 + e) / T2][(q * 8 + e) % T2] = d[e];
              unpack8u(*(const uint4*)(pi + q * 8), d);
#pragma unroll
              for (int e = 0; e < 8; ++e) yi[(q * 8 + e) / T2][(q * 8 + e) % T2] = d[e]; } } }
        const int jj = ctx ? 16 : b; const float2 g1 = *(const float2*)(modl + (size_t)jj * 6144 + 2 * 1024 + 2 * cp);
        constexpr int FG = (T2 >= 4) ? 4 : T2;
#pragma unroll 1
        for (int fg = 0; fg < T2; fg += FG) {
            unsigned xv[FG];
#pragma unroll
            for (int q = 0; q < FG; ++q) xv[q] = *(const unsigned*)(xin + ((size_t)b * T + f1 + 128 * (fg + q)) * 1024 + 2 * cp);
#pragma unroll
            for (int q = 0; q < FG; ++q) {
                const int f = f1 + 128 * (fg + q); float a0 = 0.f, a1 = 0.f;
#pragma unroll
                for (int t2 = 0; t2 < T2; ++t2) { const int mi = ((t2 * f) & (T - 1)) * (2048 / T); const float cs = tw[2 * mi], sn = tw[2 * mi + 1];
                    a0 += cs * yr[0][t2] + sn * yi[0][t2]; a1 += cs * yr[1][t2] + sn * yi[1][t2]; }
                *(unsigned*)(xout + ((size_t)b * T + f) * 1024 + 2 * cp) = att_pk(bflo(xv[q]) + g1.x * scale * a0, bfhi(xv[q]) + g1.y * scale * a1);
            }
        }
    }
}
DI void fb_mfma(const Ctx& cx, const Params& p, const LAS float* tw, const bf16_t* Y, const bf16_t* xin, bf16_t* xout, const float* modl) {
    typedef short bf16x8 __attribute__((ext_vector_type(8)));
    constexpr size_t NB = (size_t)1024 * 16;
    const int tid = cx.tid, wid = tid >> 6, lane = tid & 63, lq = lane >> 4, lr = lane & 15;
    const int part = lq >> 1, t20 = 8 * (lq & 1);
    for (int item = cx.bid * 8 + wid; item < 16 * 128 * 32; item += cx.nblk * 8) {
        const int cb = item & 31, f1 = (item >> 5) & 127, b = item >> 12, c0 = cb * 32;
        const bf16_t* yb = Y + ((size_t)b * 256 + part * 128 + f1) * NB + t20;
        const int chA = c0 + 8 * (lr >> 2) + (lr & 3);
        const bf16x8 a0 = *(const bf16x8*)(yb + (size_t)chA * 16), a1 = *(const bf16x8*)(yb + (size_t)(chA + 4) * 16);
        const int f = f1 + 128 * lr;
        mm::u32x4 bw;
        { float tv[8];
#pragma unroll
          for (int jj = 0; jj < 8; ++jj) { const int mi = ((t20 + jj) * f) & 2047; tv[jj] = tw[2 * mi + part]; }
          bw.x = att_pk(tv[0], tv[1]); bw.y = att_pk(tv[2], tv[3]); bw.z = att_pk(tv[4], tv[5]); bw.w = att_pk(tv[6], tv[7]); }
        const bf16x8 bf = __builtin_bit_cast(bf16x8, bw);
        mm::f32x4 d0 = {0.f, 0.f, 0.f, 0.f}, d1 = d0;
        d0 = __builtin_amdgcn_mfma_f32_16x16x32_bf16(a0, bf, d0, 0, 0, 0);
        d1 = __builtin_amdgcn_mfma_f32_16x16x32_bf16(a1, bf, d1, 0, 0, 0);
        const float* g1 = modl + (size_t)b * 6144 + 2 * 1024 + c0 + 8 * lq;
        const mm::f32x4 g0 = *(const mm::f32x4*)g1, g4 = *(const mm::f32x4*)(g1 + 4);
        const size_t off = ((size_t)b * 2048 + f) * 1024 + c0 + 8 * lq;
        const mm::u32x4 xv = *(const mm::u32x4*)(xin + off);
        const float sc = 1.f / 512.f;
        mm::u32x4 o;
        o.x = att_pk(bflo(xv.x) + g0[0] * sc * d0[0], bfhi(xv.x) + g0[1] * sc * d0[1]); o.y = att_pk(bflo(xv.y) + g0[2] * sc * d0[2], bfhi(xv.y) + g0[3] * sc * d0[3]);
        o.z = att_pk(bflo(xv.z) + g4[0] * sc * d1[0], bfhi(xv.z) + g4[1] * sc * d1[1]); o.w = att_pk(bflo(xv.w) + g4[2] * sc * d1[2], bfhi(xv.w) + g4[3] * sc * d1[3]);
        *(mm::u32x4*)(xout + off) = o;
    }
}
DI void ph_fb(const Ctx& cx, const Params& p, float* ldsg, bool with_ctx, const bf16_t* xin_lat, bf16_t* xout_lat, const float* modl) {
    LAS float* tw = (LAS float*)ldsg;
    for (int i = cx.tid; i < 2048; i += NTHR) { const float a = (float)i * (1.f / 1024.f); tw[2 * i] = cospif(a); tw[2 * i + 1] = sinpif(a); }
    __syncthreads();
    fb_mfma(cx, p, tw, p.YF1, xin_lat, xout_lat, modl);
    if (with_ctx) fb_items<2>(cx, p, tw, p.YF1c, p.cs, p.cs, modl, true, 0.0055242717280199f);
    __syncthreads();
}

DI void ph_norm2_router_mfma(const Ctx& cx, const Params& p, float* ldsg, int nrows, const float* gain, const float* modl, int layer, const bf16_t* xb_lat) {
    LAS float* lds = (LAS float*)ldsg;
    const int tid = cx.tid, wid = tid >> 6, lane = tid & 63, lq = lane >> 4, lr = lane & 15;
    constexpr int HP = 1026;
    LAS float* wl = lds; LAS float* hb = lds + 16384; LAS float* red = hb + 16 * HP; LAS float* myall = red + 2048;
    LAS int* lcnt = (LAS int*)(myall + 512); LAS int* lbase = lcnt + 16; LAS int* rlist = lcnt + 32;
    for (int i = tid; i < 16384; i += NTHR) wl[i] = p.router_w[i];
    if (tid < 16) lcnt[tid] = 0;
    __syncthreads();
    int nlist = 0;
    for (int grp = cx.bid; grp < (nrows >> 4); grp += cx.nblk) {
        const int row0 = 16 * grp + 2 * wid; const int jj = (row0 < NLAT) ? (row0 >> 11) : 16;
        const float* shp = modl + (size_t)jj * 6144 + 3 * 1024; const float* scp = modl + (size_t)jj * 6144 + 4 * 1024;
        float4 xv[2][4];
#pragma unroll
        for (int r = 0; r < 2; ++r) { const int row = row0 + r; const bf16_t* xr = (row < NLAT) ? xb_lat + (size_t)row * 1024 : p.cs + (size_t)(row - NLAT) * 1024;
#pragma unroll
            for (int i = 0; i < 4; ++i) { const uint2 u = *(const uint2*)(xr + i * 256 + lane * 4); xv[r][i] = make_float4(bflo(u.x), bfhi(u.x), bflo(u.y), bfhi(u.y)); } }
#pragma unroll
        for (int r = 0; r < 2; ++r) {
            float ss = 0.f;
#pragma unroll
            for (int i = 0; i < 4; ++i) ss += xv[r][i].x * xv[r][i].x + xv[r][i].y * xv[r][i].y + xv[r][i].z * xv[r][i].z + xv[r][i].w * xv[r][i].w;
            ss = wave_sum(ss);
            const float rstd = rsqrtf(ss * (1.f / 1024.f) + 1e-6f);
#pragma unroll
            for (int i = 0; i < 4; ++i) {
                const int col = i * 256 + lane * 4;
                const float4 g = *(const float4*)(gain + col), sh = *(const float4*)(shp + col), sc = *(const float4*)(scp + col);
                const float h0 = xv[r][i].x * rstd * g.x * (1.f + sc.x) + sh.x, h1 = xv[r][i].y * rstd * g.y * (1.f + sc.y) + sh.y;
                const float h2 = xv[r][i].z * rstd * g.z * (1.f + sc.z) + sh.z, h3 = xv[r][i].w * rstd * g.w * (1.f + sc.w) + sh.w;
                uint2 u; u.x = att_pk(h0, h1); u.y = att_pk(h2, h3);
                *(uint2*)(p.H + (size_t)(row0 + r) * 1024 + col) = u;
                LAS float* hp = hb + (2 * wid + r) * HP + col;
                *(LAS scan::f32x2*)hp = (scan::f32x2){h0, h1}; *(LAS scan::f32x2*)(hp + 2) = (scan::f32x2){h2, h3};
            }
        }
        __syncthreads();
        {
            mm::f32x4 acc = {0.f, 0.f, 0.f, 0.f};
            const LAS float* ap = hb + lr * HP + 128 * wid + lq; const LAS float* bp = wl + (128 * wid + lq) * 16 + lr;
#pragma unroll 8
            for (int s = 0; s < 32; ++s) acc = __builtin_amdgcn_mfma_f32_16x16x4f32(ap[4 * s], bp[64 * s], acc, 0, 0, 0);
#pragma unroll
            for (int q = 0; q < 4; ++q) red[wid * 256 + (4 * lq + q) * 16 + lr] = acc[q];
        }
        __syncthreads();
        if (tid < 256) { const int row = tid >> 4, e = tid & 15; float sacc = 0.f;
#pragma unroll
            for (int w = 0; w < 8; ++w) sacc += red[w * 256 + row * 16 + e];
            const float sg = 1.f / (1.f + __expf(-sacc));
            myall[row * 32 + e] = sg; myall[row * 32 + 16 + e] = sg + p.router_b[e]; }
        __syncthreads();
        if ((lane & 31) == 0) {
            const int r = lane >> 5; const LAS float* m = myall + (2 * wid + r) * 32;
            float best = -3.0e38f; int be1 = 0, be2 = 1;
#pragma unroll
            for (int g = 0; g < 4; ++g) {
                const mm::f32x4 v = *(const LAS mm::f32x4*)(m + 16 + 4 * g);
                int i1 = 0; float m1 = v[0];
                if (v[1] > m1) { m1 = v[1]; i1 = 1; } if (v[2] > m1) { m1 = v[2]; i1 = 2; } if (v[3] > m1) { m1 = v[3]; i1 = 3; }
                int i2 = -1; float m2 = -3.0e38f;
                if (i1 != 0 && v[0] > m2) { m2 = v[0]; i2 = 0; } if (i1 != 1 && v[1] > m2) { m2 = v[1]; i2 = 1; }
                if (i1 != 2 && v[2] > m2) { m2 = v[2]; i2 = 2; } if (i1 != 3 && v[3] > m2) { m2 = v[3]; i2 = 3; }
                const float gs = m1 + m2;
                if (gs > best) { best = gs; be1 = 4 * g + i1; be2 = 4 * g + i2; }
            }
            const float bs1 = m[be1], bs2 = m[be2]; const float inv = 1.f / (bs1 + bs2);
            const int p1 = atomicAdd((int*)&lcnt[be1], 1), p2 = atomicAdd((int*)&lcnt[be2], 1);
            LAS int* ent = rlist + (wid * 24 + nlist * 2 + r) * 6;
            ent[0] = row0 + r; ent[1] = be1 | (be2 << 8); ent[2] = p1; ent[3] = p2; ent[4] = __float_as_int(bs1 * inv); ent[5] = __float_as_int(bs2 * inv);
        }
        ++nlist;
    }
    __syncthreads();
    if (tid < 16) lbase[tid] = atomicAdd(p.cnt + (layer * 16 + tid) * 64, lcnt[tid]);
    __syncthreads();
    for (int k = lane; k < 2 * nlist; k += 64) {
        const LAS int* ent = rlist + (wid * 24 + k) * 6; const int row = ent[0], be1 = ent[1] & 255, be2 = ent[1] >> 8;
        const size_t s1 = (size_t)be1 * NT + lbase[be1] + ent[2], s2 = (size_t)be2 * NT + lbase[be2] + ent[3];
        p.slot[s1] = row * 2; p.slot[s2] = row * 2 + 1; p.slotw[s1] = __int_as_float(ent[4]); p.slotw[s2] = __int_as_float(ent[5]);
    }
    __syncthreads();
}

template <int PH>
DI void run_phase(const Params& p, float* lds, int L, int wave_id) {
    const Ctx cx = make_ctx(wave_id);
    const int j = L >> 1;
    const float* modl = p.mod + (size_t)L * 17 * 6144;
    const float* modprev = p.mod + (size_t)(L > 0 ? L - 1 : 0) * 17 * 6144;
    const bool last = (L == 3);
    const int rows_layer = (L == 3) ? NLAT : NT;
    const int rows_out = (L >= 2) ? NLAT : NT;
    const float* xin_lat = (L == 0) ? p.x : p.out; const float* xin_ctx = (L == 0) ? p.ctx : p.ctxs;
    constexpr bool BFS = (OPT >= 11);
    const void* bin_lat = (L == 0) ? (const void*)p.x : (const void*)p.xs; const void* bin_ctx = (L == 0) ? (const void*)p.ctx : (const void*)p.cs;
    bf16_t* bout_lat = (L == 3) ? p.xs3 : p.xs;
    if constexpr (PH == 0) { if (OPT >= 7) { ph_mod_opt(cx, p, lds); for (int i = cx.bid * NTHR + cx.tid; i < 1024; i += cx.nblk * NTHR) p.H[(size_t)NT * 1024 + i] = 0; } else ph_prologue(cx, p, lds); ph_prep_weights(cx, p, lds); }
    if constexpr (PH == 1) {
        if (OPT >= 4 && !PROBE_SPLIT1) ph_prep_moe(cx, p, lds, L);
        if (BFS && L > 0) { ph_normc<false>(cx, p, rows_layer, p.xs, p.xs, p.norm1_g + L * 1024, modl, modprev); return; }
        if (L == 0) ph_norm<false, true, false>(cx, p, lds, rows_layer, xin_lat, xin_ctx, p.norm1_g + L * 1024, modl, 0, 1, modprev, L);
        else ph_norm<true, true, false>(cx, p, lds, rows_layer, xin_lat, xin_ctx, p.norm1_g + L * 1024, modl, 0, 1, modprev, L);
    }
    if constexpr (PH == 2) { if (OPT >= 1) ph_win_mm(cx, p, lds, j); else ph_win(cx, p, lds, j); }
    if constexpr (PH == 3) { if (OPT >= 10) ph_prepBLR_opt(cx, p, j); else ph_prepB(cx, p, j); }
    if constexpr (PH == 4) { if (OPT >= 2) ph_qkvup_mm(cx, p, lds, j, rows_out); else ph_qkvup(cx, p, lds, j, rows_out); }
    if constexpr (PH == 5) { if (OPT >= 7) ph_finalize_opt(cx, p, lds, j, rows_out); else ph_finalize(cx, p, j, rows_out); }
    if constexpr (PH == 6) { if (OPT >= 5) ph_attn_mm(cx, p, lds, rows_out == NT); else ph_attn(cx, p, rows_out == NT); }
    if constexpr (PH == 7) { if (OPT < 10) ph_prepLR(cx, p, j); }
    if constexpr (PH == 8) { if (OPT >= 2) ph_wag_mm(cx, p, lds, j); else ph_wag(cx, p, lds, j); }
    if constexpr (PH == 9) { if (OPT >= 9) ph_scan_chunk<0>(cx, p, lds, j); else if (OPT >= 6) ph_scan_opt<0>(cx, p, lds, j); else ph_scan(cx, p, lds, j); }
    if constexpr (PH == 19) ph_scan_chunk<PROBE_SCAN>(cx, p, lds, j);
    if constexpr (PH == 20) ph_prep_moe(cx, p, lds, L);
    if constexpr (PH == 21) ph_win_probe(cx, p, lds, j);
    if constexpr (PH == 10) { if (OPT >= 7) ph_post_opt(cx, p, j, rows_out); else ph_post(cx, p, j, rows_out); }
    if constexpr (PH == 11) { if (BFS) ph_wout_mmB(cx, p, lds, p.H, p.WoutT + (size_t)j * 1024 * 1024, rows_out, bin_lat, bin_ctx, bout_lat, L == 0, modl); else if (OPT >= 1) ph_wout_mm(cx, p, lds, p.H, p.WoutT + (size_t)j * 1024 * 1024, rows_out, xin_lat, xin_ctx, modl); else ph_wout(cx, p, lds, p.H, p.w_out_even + (size_t)j * 1024 * 1024, rows_out, xin_lat, xin_ctx, modl); }
    if constexpr (PH == 12) { if (OPT >= 12) ph_f1b(cx, p, lds, j, !last); else if (OPT >= 3) ph_f1_mm(cx, p, lds, j, !last); else ph_chdft(cx, p, lds, rows_layer); }
    if constexpr (PH == 13) { if (OPT >= 12) ph_fa(cx, p, lds, !last); else if (BFS) ph_f2_mmB(cx, p, lds, !last, bin_lat, bin_ctx, bout_lat, modl); else if (OPT >= 3) ph_f2_mm(cx, p, lds, !last, xin_lat, xin_ctx, modl); else ph_posdft(cx, p, lds, !last); }
    if constexpr (PH == 14) { if (OPT >= 12) ph_fb(cx, p, lds, !last, p.xs, bout_lat, modl); }
    if constexpr (PH == 14) { if (OPT < 3) ph_wout(cx, p, lds, p.F, p.w_out_fourier + (size_t)j * 1024 * 1024, rows_out, xin_lat, xin_ctx, modl); }
    if constexpr (PH == 15) { if (OPT >= 13) ph_norm2_router_mfma(cx, p, lds, rows_out, p.norm2_g + L * 1024, modl, L, bout_lat); else if (OPT >= 8) ph_norm2_router(cx, p, lds, rows_out, p.norm2_g + L * 1024, modl, L, BFS ? bout_lat : (const bf16_t*)nullptr); else ph_norm<false, true, true>(cx, p, lds, rows_out, p.out, p.ctxs, p.norm2_g + L * 1024, modl, 3, 4, modprev, L); }
    if constexpr (PH == 16) { if (OPT >= 4) ph_moe_up_mm(cx, p, lds, L, rows_out); else ph_moe_up(cx, p, lds, L, rows_out); }
    if constexpr (PH == 17) { if (OPT >= 4) ph_moe_down_mm(cx, p, lds, L, rows_out); else ph_moe_down(cx, p, lds, L, rows_out); }
    if constexpr (PH == 18) { if (BFS) { ph_normc<true>(cx, p, NLAT, p.xs3, nullptr, p.norm1_g, p.mod + (size_t)3 * 17 * 6144, p.mod + (size_t)3 * 17 * 6144); return; } }
    if constexpr (PH == 18) ph_norm<true, false, false>(cx, p, lds, NLAT, p.out, p.ctxs, p.norm1_g, p.mod + (size_t)3 * 17 * 6144, 0, 1, p.mod + (size_t)3 * 17 * 6144, 3);
}

template <int PH>
__global__ void __launch_bounds__(NTHR, 2) k_phase(Params p, int L) {
    extern __shared__ __attribute__((aligned(16))) float shm[];
    run_phase<PH>(p, shm, L, (int)(threadIdx.x >> 6));
}

#if ONE_LAUNCH
constexpr int PARAM_WORDS = (int)(sizeof(Params) / 4);
DI Params load_params(const unsigned* lp) {
    Params q; unsigned* d = (unsigned*)&q;
#pragma unroll
    for (int i = 0; i < PARAM_WORDS; ++i) d[i] = (unsigned)__builtin_amdgcn_readfirstlane((int)lp[i]);
    void** pp = (void**)&q;
#pragma unroll
    for (int i = 0; i < PARAM_WORDS / 2; ++i) pp[i] = (void*)(__attribute__((address_space(1))) void*)pp[i];
    return q;
}
#ifndef PROBE_MASK
#define PROBE_MASK 0u
#endif

#define PHASE(PH, L) do { unsigned long long t0_ = 0; if (PROBE_MASK & (1u << (PH))) t0_ = wall_clock64(); \
    { run_phase<PH>(p, lds, (L), wave_id); } xcd_barrier(bar, wave_id == 0 && lane_id_asm() == 0); \
    if (PROBE_MASK & (1u << (PH))) tacc += wall_clock64() - t0_; } while (0)
__global__ void __launch_bounds__(NTHR, 2) k_mega(Params p) {
    extern __shared__ __attribute__((aligned(16))) float shm[];
    unsigned* lp = (unsigned*)(shm + 4);
    float* lds = shm + 4 + ((PARAM_WORDS + 3) & ~3);
    if (threadIdx.x == 0) { shm[0] = 0.f; shm[1] = 0.f; shm[2] = 0.f; shm[3] = 0.f; }
    if (threadIdx.x < PARAM_WORDS) lp[threadIdx.x] = ((const unsigned*)&p)[threadIdx.x];
    __syncthreads();
    XcdBarrier bar; { const Params q_ = load_params(lp); bar = xcd_barrier_post(q_.bar, (volatile LAS unsigned*)shm); }
    unsigned long long tacc = 0;
    const int wave_id = __builtin_amdgcn_readfirstlane((int)(threadIdx.x >> 6));
    PHASE(0, 0);
#define LAYER_EVEN(L) if (PROBE_SPLIT1) { PHASE(20, L); } PHASE(1, L); PHASE(2, L); if (PROBE_GEMM) { PHASE(21, L); } PHASE(3, L); PHASE(4, L); PHASE(5, L); PHASE(6, L); if (OPT < 10) { PHASE(7, L); } PHASE(8, L); PHASE(9, L); if (PROBE_SCAN) { PHASE(19, L); } PHASE(10, L); PHASE(11, L); PHASE(15, L); PHASE(16, L); PHASE(17, L)
#define LAYER_ODD(L) if (PROBE_SPLIT1) { PHASE(20, L); } PHASE(1, L); PHASE(12, L); PHASE(13, L); if (OPT < 3 || OPT >= 12) { PHASE(14, L); } PHASE(15, L); PHASE(16, L); PHASE(17, L)
    LAYER_EVEN(0); LAYER_ODD(1); LAYER_EVEN(2); LAYER_ODD(3);
    { unsigned long long t0_ = 0; if (PROBE_MASK & (1u << 18)) t0_ = wall_clock64(); run_phase<18>(p, lds, 3, wave_id);
      if (PROBE_MASK & (1u << 18)) { xcd_barrier(bar, wave_id == 0 && lane_id_asm() == 0); tacc += wall_clock64() - t0_; } }
    if (PROBE_MASK != 0u && blockIdx.x == 0 && threadIdx.x == 0) {
        const unsigned long long t1 = wall_clock64(); while (wall_clock64() - t1 < 20ull * tacc) __builtin_amdgcn_s_sleep(8); }
}
#endif

static inline size_t al256(size_t v) { return (v + 255) & ~(size_t)255; }
constexpr size_t LDS_BYTES = 148 * 1024;

template <int PH> static void launch_phase(const Params& p, int L, int grid, hipStream_t s) {
    static bool attr = false;
    if (!attr) { hipFuncSetAttribute((const void*)k_phase<PH>, hipFuncAttributeMaxDynamicSharedMemorySize, (int)LDS_BYTES); attr = true; }
    hipLaunchKernelGGL(k_phase<PH>, dim3(grid), dim3(NTHR), LDS_BYTES, s, p, L);
}

extern "C" void kernel_launch(void* const* d_in, const int* in_sizes, int n_in, void* d_out, int out_size, void* d_ws, size_t ws_size, hipStream_t stream) {
    (void)in_sizes; (void)n_in; (void)out_size;
    Params p{};
    const float** ip = (const float**)&p.x;
    for (int i = 0; i < 36; ++i) ip[i] = (const float*)d_in[i];
    p.out = (float*)d_out;
    char* w = (char*)d_ws; size_t o = 0;
    auto take = [&](size_t bytes) { char* r = w + o; o += al256(bytes); return r; };
    p.bar = (unsigned*)take(XCD_BAR_WORDS * 4);
    p.cnt = (int*)take(64 * 64 * 4);
    const size_t zero_bytes = o;
    p.mod = (float*)take((size_t)4 * 17 * 6144 * 4);
    p.ctxs = (float*)take((size_t)NCTX * 1024 * 4);
    p.dftl = (bf16_t*)take((size_t)2048 * 4096 * 2);
    p.dftc = (bf16_t*)take((size_t)256 * 512 * 2);
    p.slot = (int*)take((size_t)16 * NT * 4);
    p.tokw = (float*)take((size_t)NT * 2 * 4);
    p.slotw = (float*)take((size_t)16 * NT * 4);
    p.H = (bf16_t*)take((size_t)(NT + 1) * 1024 * 2);
    char* big = w + o;
    p.P = (bf16_t*)take((size_t)NT * PLD * 2);
    char* r1 = w + o;
    p.WAG = (bf16_t*)take((size_t)NT * WLD * 2);
    p.YF = (bf16_t*)take((size_t)NT * 512 * 2);
    p.YB = (bf16_t*)take((size_t)NT * 512 * 2);
    p.LR = (bf16_t*)take((size_t)NT * 384 * 2);
    p.WinT = (bf16_t*)take((size_t)2 * 2560 * 1024 * 2); p.WqT = (bf16_t*)take((size_t)2 * 768 * 256 * 2); p.WkvT = (bf16_t*)take((size_t)2 * 1024 * 256 * 2);
    p.WlrT = (bf16_t*)take((size_t)2 * 2560 * 384 * 2); p.WoutT = (bf16_t*)take((size_t)2 * 1024 * 1024 * 2); p.A1 = (bf16_t*)take((size_t)2 * 2048 * 1024 * 2);
    p.A2 = (bf16_t*)take((size_t)2048 * 4096 * 2); p.A2c = (bf16_t*)take((size_t)256 * 512 * 2); p.M1 = (bf16_t*)take((size_t)256 * 256 * 2);
    p.WguT = (bf16_t*)take((size_t)17 * 1024 * 1024 * 2); p.WdT = (bf16_t*)take((size_t)17 * 1024 * 512 * 2);
    const size_t total = o;
    { size_t q = 0; auto t2 = [&](size_t bytes) { char* r = r1 + q; q += al256(bytes); return r; };
      p.QN = (bf16_t*)t2((size_t)NT * 512 * 2); p.Qraw = (bf16_t*)t2((size_t)NT * 768 * 2); p.KVraw = (bf16_t*)t2((size_t)NT * 1024 * 2);
      p.Kf = (bf16_t*)t2((size_t)NB * 8 * 2304 * 96 * 2); p.Vt = (bf16_t*)t2((size_t)NB * 8 * 64 * 2304 * 2); }
    { size_t q = 0; auto t3 = [&](size_t bytes) { char* r = big + q; q += al256(bytes); return r; };
      p.ACT = (bf16_t*)t3((size_t)3 * NT * 512 * 2); p.Y = (bf16_t*)t3((size_t)3 * NT * 1024 * 2); }
    { size_t q = 0; auto t4 = [&](size_t bytes) { char* r = big + q; q += al256(bytes); return r; };
      p.G = (float*)t4((size_t)NT * 2048 * 4); p.F = (bf16_t*)t4((size_t)NT * 1024 * 2); }
    { size_t q = 0; auto t5 = [&](size_t bytes) { char* r = big + q; q += al256(bytes); return r; };
      p.ZT = (bf16_t*)t5((size_t)16 * 1024 * 4096 * 2); p.ZTC = (bf16_t*)t5((size_t)16 * 1024 * 512 * 2);
      p.YF1 = (bf16_t*)t5((size_t)256 * 16 * 1024 * 16 * 2); p.YF1c = (bf16_t*)t5((size_t)256 * 16 * 1024 * 2 * 2); }
    p.xs = (bf16_t*)d_out; p.cs = (bf16_t*)p.ctxs; p.xs3 = (bf16_t*)(big + (size_t)344 * 1024 * 1024);
    if (total > ws_size) { fprintf(stderr, "workspace too small: need %zu have %zu\n", total, ws_size); return; }
    static int grid = 0;
    if (!grid) { int dev = 0, cus = 0; hipGetDevice(&dev); hipDeviceGetAttribute(&cus, hipDeviceAttributeMultiprocessorCount, dev); grid = cus > 0 ? cus : 256; if (grid > 256) grid = 256; }
    hipMemsetAsync(d_ws, 0, zero_bytes, stream);
#if ONE_LAUNCH
    static bool attr = false;
    if (!attr) { hipFuncSetAttribute((const void*)k_mega, hipFuncAttributeMaxDynamicSharedMemorySize, (int)LDS_BYTES); attr = true; }
    hipLaunchKernelGGL(k_mega, dim3(grid), dim3(NTHR), LDS_BYTES, stream, p);
#else
    launch_phase<0>(p, 0, grid, stream);
    for (int L = 0; L < 4; ++L) {
        launch_phase<1>(p, L, grid, stream);
        if ((L & 1) == 0) {
            launch_phase<2>(p, L, grid, stream); launch_phase<3>(p, L, grid, stream); launch_phase<4>(p, L, grid, stream); launch_phase<5>(p, L, grid, stream);
            launch_phase<6>(p, L, grid, stream); launch_phase<7>(p, L, grid, stream); launch_phase<8>(p, L, grid, stream); launch_phase<9>(p, L, grid, stream);
            launch_phase<10>(p, L, grid, stream); launch_phase<11>(p, L, grid, stream);
        } else {
            launch_phase<12>(p, L, grid, stream); launch_phase<13>(p, L, grid, stream); launch_phase<14>(p, L, grid, stream);
        }
        launch_phase<15>(p, L, grid, stream); launch_phase<16>(p, L, grid, stream); launch_phase<17>(p, L, grid, stream);
    }
    launch_phase<18>(p, 3, grid, stream);
#endif
}
```

```cpp
#include <hip/hip_runtime.h>
#include <cstdio>
#include <cstdint>

#ifndef ONE_LAUNCH
#define ONE_LAUNCH 1
#endif
#ifndef PROBE_SCAN
#define PROBE_SCAN 0
#endif
#ifndef PROBE_SPLIT1
#define PROBE_SPLIT1 0
#endif
#ifndef PROBE_GEMM
#define PROBE_GEMM 0
#endif
#ifndef OPT
#define OPT 13
#endif

typedef unsigned short bf16_t;
#define DI __device__ __forceinline__
#define LAS __attribute__((address_space(3)))

constexpr int D = 1024, NB = 16, SEQ = 2048, CTXL = 256, NLAT = NB * SEQ, NCTX = NB * CTXL, NT = NLAT + NCTX;
constexpr int PLD = 2560;
constexpr int INC = 2336, ACOLS = 1920;
constexpr int WLD = 2560;
constexpr int NTHR = 512;

#define XB_TMO      128
#define XB_XCNT(j)  (256  + 64 * (j))
#define XB_XSUB(j)  (1280 + 64 * (j))
#define XB_XGEN(j)  (2304 + 64 * (j))
#define XB_TOP      3328
#define XB_TOPGEN   3392
#define XCD_BAR_WORDS 3456
#define XB_SPIN_CAP (1u << 24)
DI unsigned xb_ld(unsigned* p)              { return __hip_atomic_load(p, __ATOMIC_RELAXED, __HIP_MEMORY_SCOPE_AGENT); }
DI unsigned xb_add(unsigned* p, unsigned v) { return __hip_atomic_fetch_add(p, v, __ATOMIC_RELAXED, __HIP_MEMORY_SCOPE_AGENT); }
DI unsigned xb_xcc_id() { return (unsigned)__builtin_amdgcn_s_getreg((3 << 11) | 20) & 0xFu; }
#define XB_SPIN(cond, bar) do { unsigned _sp = 0; while (cond) { __builtin_amdgcn_s_sleep(1); \
    if ((++_sp & 255u) == 0u) { if (xb_ld(&(bar)[XB_TMO])) break; if (_sp > XB_SPIN_CAP) { atomicAdd(&(bar)[XB_TMO], 1u); break; } } } } while (0)
struct XcdBarrier { unsigned* bar; unsigned x; volatile LAS unsigned* st; };
DI XcdBarrier xcd_barrier_post(unsigned* bar, volatile LAS unsigned* st) {
    XcdBarrier b; b.bar = bar; b.x = xb_xcc_id(); b.st = st;
    if (threadIdx.x == 0) (void)xb_add(&bar[XB_XCNT(b.x)], 1u);
    return b;
}
DI void xcd_barrier_complete(unsigned* bar, unsigned x, unsigned& nloc, unsigned& nx) {
    const unsigned G = gridDim.x * gridDim.y * gridDim.z;
    unsigned sum, cnt, mine, sp = 0u;
    for (;;) {
        sum = 0u; cnt = 0u; mine = 0u;
#pragma unroll
        for (unsigned j = 0; j < 16; ++j) { const unsigned c = xb_ld(&bar[XB_XCNT(j)]); sum += c; cnt += (c > 0u) ? 1u : 0u; mine = (j == x) ? c : mine; }
        if (sum == G) break;
        __builtin_amdgcn_s_sleep(1);
        if ((++sp & 255u) == 0u) { if (xb_ld(&bar[XB_TMO])) break; if (sp > XB_SPIN_CAP) { atomicAdd(&bar[XB_TMO], 1u); break; } }
    }
    nloc = mine > 0u ? mine : 1u; nx = cnt > 0u ? cnt : 1u;
}
DI void xcd_barrier(const XcdBarrier& b, const bool t0) {
    asm volatile("s_waitcnt vmcnt(0)" ::: "memory");
    __syncthreads();
    if (t0) {
        unsigned* bar = b.bar;
        __builtin_amdgcn_s_waitcnt(0);
        unsigned nloc = b.st[0], nx = b.st[1];
        if (nloc == 0u) { xcd_barrier_complete(bar, b.x, nloc, nx); b.st[0] = nloc; b.st[1] = nx; }
        const unsigned old = xb_add(&bar[XB_XSUB(b.x)], 1u);
        const unsigned gen = old / nloc;
        if (old + 1u == (gen + 1u) * nloc) {
            __builtin_amdgcn_fence(__ATOMIC_RELEASE, "agent");
            asm volatile("s_waitcnt vmcnt(0)" ::: "memory");
            const unsigned og = xb_add(&bar[XB_TOP], 1u);
            const unsigned tg = og / nx;
            if (og + 1u == (tg + 1u) * nx) xb_add(&bar[XB_TOPGEN], 1u);
            else XB_SPIN(xb_ld(&bar[XB_TOPGEN]) == tg, bar);
            __builtin_amdgcn_fence(__ATOMIC_ACQUIRE, "agent");
            xb_add(&bar[XB_XGEN(b.x)], 1u);
            asm volatile("s_waitcnt vmcnt(0)" ::: "memory");
        } else {
            XB_SPIN(xb_ld(&bar[XB_XGEN(b.x)]) == gen, bar);
            __builtin_amdgcn_fence(__ATOMIC_ACQUIRE, "agent");
            asm volatile("s_waitcnt vmcnt(0)" ::: "memory");
        }
    }
    __syncthreads();
}

struct Params {
    const float *x, *c, *ctx, *c_ctx, *norm1_g, *norm2_g, *mod_w, *mod_b, *w_in, *a_mu, *a_w0, *a_w2, *a_a0, *a_a2, *a_g2,
                *a_k_k, *a_k_a, *a_r_k, *a_ln_w, *a_ln_b, *b_q_norm, *b_w_q_up, *b_kv_norm, *b_w_kv_up, *b_q_gain, *b_k_gain,
                *w_out_even, *w_out_fourier, *router_w, *router_b, *moe_w_gate, *moe_w_up, *moe_w_down, *sh_gate, *sh_up, *sh_down;
    float* out;
    unsigned* bar; int* cnt; float* mod; float* ctxs; bf16_t* dftl; bf16_t* dftc; int* slot; float* tokw; float* slotw;
    bf16_t *H, *P, *LR, *WAG, *YF, *YB, *QN, *Qraw, *KVraw, *Kf, *Vt, *ACT, *Y, *F; float* G;
    bf16_t *WinT, *WqT, *WkvT, *WlrT, *WoutT, *A1, *A2, *A2c, *WguT, *WdT, *ZT, *ZTC;
    bf16_t *M1, *YF1, *YF1c;
    bf16_t *xs, *cs, *xs3;
};

struct Ctx { int tid, bid, nblk; };
DI int lane_id_asm() { int l; asm volatile("v_mbcnt_lo_u32_b32 %0, -1, 0\n\tv_mbcnt_hi_u32_b32 %0, -1, %0" : "=v"(l)); return l; }
DI Ctx make_ctx(int wave_id) { Ctx c; c.tid = wave_id * 64 + lane_id_asm(); c.bid = blockIdx.x; c.nblk = gridDim.x; asm volatile("" : "+v"(c.tid), "+s"(c.bid), "+s"(c.nblk)); return c; }

DI bf16_t f2bf(float f) { unsigned u = __float_as_uint(f); u += 0x7fffu + ((u >> 16) & 1u); return (bf16_t)(u >> 16); }
DI float bf2f(bf16_t b) { return __uint_as_float(((unsigned)b) << 16); }
DI float bflo(unsigned u) { return __uint_as_float(u << 16); }
DI float bfhi(unsigned u) { return __uint_as_float(u & 0xffff0000u); }
DI unsigned pack2(float lo, float hi) { return (unsigned)f2bf(lo) | ((unsigned)f2bf(hi) << 16); }
typedef __bf16 g_bf16x2_t __attribute__((ext_vector_type(2)));
typedef float g_f32x2_t __attribute__((ext_vector_type(2)));
DI unsigned att_pk(float a, float b) { g_f32x2_t f = {a, b}; g_bf16x2_t h = __builtin_convertvector(f, g_bf16x2_t); return __builtin_bit_cast(unsigned, h); }
DI float siluf(float v) { return v / (1.f + expf(-v)); }
DI float sigm(float v) { return 1.f / (1.f + expf(-v)); }
template <int CTRL> DI float dpp_f(float v) { return __builtin_bit_cast(float, __builtin_amdgcn_update_dpp(0, __builtin_bit_cast(int, v), CTRL, 0xf, 0xf, true)); }
DI float wave_sum(float v) {
    v += dpp_f<0xB1>(v); v += dpp_f<0x4E>(v); v += dpp_f<0x141>(v); v += dpp_f<0x140>(v);
    const int x = __builtin_bit_cast(int, v);
    const float a = __builtin_bit_cast(float, __builtin_amdgcn_readlane(x, 0)), b = __builtin_bit_cast(float, __builtin_amdgcn_readlane(x, 16));
    const float c = __builtin_bit_cast(float, __builtin_amdgcn_readlane(x, 32)), d = __builtin_bit_cast(float, __builtin_amdgcn_readlane(x, 48));
    return (a + b) + (c + d);
}

template <bool DUAL, class AFn, class BFn, class BFn2, class Epi>
DI void ngemm(const Ctx& cx, float* lds, int nbz, int M, int N, int K, AFn afn, BFn bfn, BFn2 bfn2, Epi epi) {
    float* As = lds; float* Bs = lds + 16 * 132; float* B2s = Bs + 16 * 128;
    const int tid = cx.tid, ty = tid >> 5, tx = tid & 31;
    const int tm = (M + 127) / 128, tn = (N + 127) / 128, ntile = tm * tn * nbz;
    const int arow = tid >> 2, akc = (tid & 3) * 4, bk = tid >> 5, bnn = (tid & 31) * 4;
    for (int tile = cx.bid; tile < ntile; tile += cx.nblk) {
        const int bz = tile / (tm * tn), rem = tile % (tm * tn), bm = rem / tn, bn = rem % tn;
        float acc[8][4], acc2[8][4];
#pragma unroll
        for (int i = 0; i < 8; ++i)
#pragma unroll
            for (int j = 0; j < 4; ++j) { acc[i][j] = 0.f; acc2[i][j] = 0.f; }
        const int m_a = bm * 128 + arow;
        const bf16_t* aptr = (m_a < M) ? afn(bz, m_a) : nullptr;
        const int nB = bn * 128 + bnn;
        for (int k0 = 0; k0 < K; k0 += 16) {
            float av0 = 0.f, av1 = 0.f, av2 = 0.f, av3 = 0.f;
            if (aptr) { const uint2 u = *(const uint2*)(aptr + k0 + akc); av0 = bflo(u.x); av1 = bfhi(u.x); av2 = bflo(u.y); av3 = bfhi(u.y); }
            float4 bv = make_float4(0.f, 0.f, 0.f, 0.f), bv2 = make_float4(0.f, 0.f, 0.f, 0.f);
            if (nB < N) { bv = *(const float4*)(bfn(bz, k0 + bk) + nB); if (DUAL) bv2 = *(const float4*)(bfn2(bz, k0 + bk) + nB); }
            __syncthreads();
            As[(akc + 0) * 132 + arow] = av0; As[(akc + 1) * 132 + arow] = av1; As[(akc + 2) * 132 + arow] = av2; As[(akc + 3) * 132 + arow] = av3;
            *(float4*)&Bs[bk * 128 + bnn] = bv;
            if (DUAL) *(float4*)&B2s[bk * 128 + bnn] = bv2;
            __syncthreads();
#pragma unroll 4
            for (int kk = 0; kk < 16; ++kk) {
                const float4 a0 = *(const float4*)&As[kk * 132 + ty * 8], a1 = *(const float4*)&As[kk * 132 + ty * 8 + 4];
                const float4 b = *(const float4*)&Bs[kk * 128 + tx * 4];
                const float a[8] = {a0.x, a0.y, a0.z, a0.w, a1.x, a1.y, a1.z, a1.w};
                const float bb[4] = {b.x, b.y, b.z, b.w};
#pragma unroll
                for (int i = 0; i < 8; ++i)
#pragma unroll
                    for (int j = 0; j < 4; ++j) acc[i][j] += a[i] * bb[j];
                if (DUAL) {
                    const float4 b2 = *(const float4*)&B2s[kk * 128 + tx * 4];
                    const float cc[4] = {b2.x, b2.y, b2.z, b2.w};
#pragma unroll
                    for (int i = 0; i < 8; ++i)
#pragma unroll
                        for (int j = 0; j < 4; ++j) acc2[i][j] += a[i] * cc[j];
                }
            }
        }
#pragma unroll
        for (int i = 0; i < 8; ++i) {
            const int m = bm * 128 + ty * 8 + i;
            if (m < M) {
#pragma unroll
                for (int j = 0; j < 4; ++j) { const int n = bn * 128 + tx * 4 + j; if (n < N) epi(bz, m, n, acc[i][j], acc2[i][j]); }
            }
        }
    }
    __syncthreads();
}

DI void ph_prologue(const Ctx& cx, const Params& p, float* lds) {
    const int tid = cx.tid, gtid = cx.bid * NTHR + tid, gsz = cx.nblk * NTHR;
    for (int i = tid; i < 17 * 1024; i += NTHR) { const int j = i >> 10, k = i & 1023; const float v = (j < 16) ? p.c[j * 1024 + k] : p.c_ctx[k]; lds[i] = siluf(v); }
    __syncthreads();
    for (int idx = gtid; idx < 4 * 6144; idx += gsz) {
        const int l = idx / 6144, n = idx % 6144;
        const float* w = p.mod_w + (size_t)l * 1024 * 6144 + n;
        float acc[17]; const float b0 = p.mod_b[l * 6144 + n];
#pragma unroll
        for (int j = 0; j < 17; ++j) acc[j] = b0;
        for (int k = 0; k < 1024; ++k) {
            const float wv = w[(size_t)k * 6144];
#pragma unroll
            for (int j = 0; j < 17; ++j) acc[j] += lds[j * 1024 + k] * wv;
        }
#pragma unroll
        for (int j = 0; j < 17; ++j) p.mod[((size_t)l * 17 + j) * 6144 + n] = acc[j];
    }
    for (int i = gtid; i < 2048 * 4096; i += gsz) {
        const int f = i >> 12, k = i & 4095, t = k & 2047, m = (f * t) & 2047; const float a = (float)m * (1.f / 1024.f);
        p.dftl[i] = f2bf((k < 2048) ? cospif(a) : sinpif(a));
    }
    for (int i = gtid; i < 256 * 512; i += gsz) {
        const int f = i >> 9, k = i & 511, t = k & 255, m = (f * t) & 255; const float a = (float)m * (1.f / 128.f);
        p.dftc[i] = f2bf((k < 256) ? cospif(a) : sinpif(a));
    }
    for (int i = gtid; i < 1024; i += gsz) p.H[(size_t)NT * 1024 + i] = 0;
    __syncthreads();
}

DI float pick4(float a0, float a1, float a2, float a3, int i) { return i == 0 ? a0 : (i == 1 ? a1 : (i == 2 ? a2 : a3)); }
template <bool COMBINE, bool NORM, bool ROUTER>
DI void ph_norm(const Ctx& cx, const Params& p, float* lds, int nrows, const float* xin_lat, const float* xin_ctx, const float* gain, const float* modl, int sh_idx, int sc_idx,
                const float* modprev, int layer) {
    const int tid = cx.tid, wid = tid >> 6, lane = tid & 63;
    float* rw = lds;
    float* scr = lds + 16 * 1024;
    int* lcnt = (int*)(lds + 16 * 1024 + 256); int* lbase = lcnt + 16; int* rlist = lcnt + 32;
    int nlist = 0;
    if (ROUTER) {
        for (int i = tid; i < 16 * 1024; i += NTHR) { const int e = i >> 10, col = i & 1023; rw[i] = p.router_w[col * 16 + e]; }
        if (tid < 16) lcnt[tid] = 0;
        __syncthreads();
    }
    for (int row = cx.bid * 8 + wid; row < nrows; row += cx.nblk * 8) {
        const bool lat = row < NLAT; const int j = lat ? (row >> 11) : 16;
        const float* xr = lat ? xin_lat + (size_t)row * 1024 : xin_ctx + (size_t)(row - NLAT) * 1024;
        float4 xv[4];
#pragma unroll
        for (int i = 0; i < 4; ++i) xv[i] = *(const float4*)(xr + i * 256 + lane * 4);
        if (COMBINE) {
            const float* g2 = modprev + (size_t)j * 6144 + 5 * 1024;
            float* xo = lat ? p.out + (size_t)row * 1024 : p.ctxs + (size_t)(row - NLAT) * 1024;
#pragma unroll
            for (int i = 0; i < 4; ++i) {
                const int col = i * 256 + lane * 4;
                const float4 gv = *(const float4*)(g2 + col);
                float s0 = 0.f, s1 = 0.f, s2 = 0.f, s3 = 0.f;
#pragma unroll
                for (int s = 0; s < 3; ++s) { const uint2 u = *(const uint2*)(p.Y + ((size_t)s * NT + row) * 1024 + col); s0 += bflo(u.x); s1 += bfhi(u.x); s2 += bflo(u.y); s3 += bfhi(u.y); }
                xv[i].x += gv.x * s0; xv[i].y += gv.y * s1; xv[i].z += gv.z * s2; xv[i].w += gv.w * s3;
                *(float4*)(xo + col) = xv[i];
            }
        }
        if (NORM) {
            float ss = 0.f;
#pragma unroll
            for (int i = 0; i < 4; ++i) ss += xv[i].x * xv[i].x + xv[i].y * xv[i].y + xv[i].z * xv[i].z + xv[i].w * xv[i].w;
            ss = wave_sum(ss);
            const float rstd = rsqrtf(ss * (1.f / 1024.f) + 1e-6f);
            const float* shp = modl + (size_t)j * 6144 + sh_idx * 1024; const float* scp = modl + (size_t)j * 6144 + sc_idx * 1024;
            float4 hv[4];
#pragma unroll
            for (int i = 0; i < 4; ++i) {
                const int col = i * 256 + lane * 4;
                const float4 g = *(const float4*)(gain + col), sh = *(const float4*)(shp + col), sc = *(const float4*)(scp + col);
                hv[i].x = xv[i].x * rstd * g.x * (1.f + sc.x) + sh.x; hv[i].y = xv[i].y * rstd * g.y * (1.f + sc.y) + sh.y;
                hv[i].z = xv[i].z * rstd * g.z * (1.f + sc.z) + sh.z; hv[i].w = xv[i].w * rstd * g.w * (1.f + sc.w) + sh.w;
                uint2 u; u.x = pack2(hv[i].x, hv[i].y); u.y = pack2(hv[i].z, hv[i].w);
                *(uint2*)(p.H + (size_t)row * 1024 + col) = u;
            }
            if (ROUTER) {
                float part[16];
#pragma unroll
                for (int e = 0; e < 16; ++e) {
                    float a = 0.f;
#pragma unroll
                    for (int i = 0; i < 4; ++i) { const float4 w = *(const float4*)(rw + e * 1024 + i * 256 + lane * 4); a += hv[i].x * w.x + hv[i].y * w.y + hv[i].z * w.z + hv[i].w * w.w; }
                    part[e] = wave_sum(a);
                }
                float* my = scr + wid * 32;
#pragma unroll
                for (int e = 0; e < 16; ++e) if (lane == e) { const float sg = sigm(part[e]); my[e] = sg; my[16 + e] = sg + p.router_b[e]; }
                __builtin_amdgcn_wave_barrier();
                if (lane == 0) {
                    float best = -3.0e38f; int be1 = 0, be2 = 1;
                    for (int g = 0; g < 4; ++g) {
                        const float v0 = my[16 + 4 * g], v1 = my[16 + 4 * g + 1], v2 = my[16 + 4 * g + 2], v3 = my[16 + 4 * g + 3];
                        int i1 = 0; float m1 = v0;
                        if (v1 > m1) { m1 = v1; i1 = 1; } if (v2 > m1) { m1 = v2; i1 = 2; } if (v3 > m1) { m1 = v3; i1 = 3; }
                        int i2 = -1; float m2 = -3.0e38f;
                        if (i1 != 0 && v0 > m2) { m2 = v0; i2 = 0; } if (i1 != 1 && v1 > m2) { m2 = v1; i2 = 1; }
                        if (i1 != 2 && v2 > m2) { m2 = v2; i2 = 2; } if (i1 != 3 && v3 > m2) { m2 = v3; i2 = 3; }
                        const float gs = m1 + m2;
                        if (gs > best) { best = gs; be1 = 4 * g + i1; be2 = 4 * g + i2; }
                    }
                    const float bs1 = my[be1], bs2 = my[be2];
                    const float inv = 1.f / (bs1 + bs2);
                    const int p1 = atomicAdd(&lcnt[be1], 1), p2 = atomicAdd(&lcnt[be2], 1);
                    int* ent = rlist + (wid * 24 + nlist) * 4;
                    ent[0] = row; ent[1] = be1 | (be2 << 8); ent[2] = p1; ent[3] = p2;
                    p.tokw[row * 2] = bs1 * inv; p.tokw[row * 2 + 1] = bs2 * inv;
                }
                ++nlist;
                __builtin_amdgcn_wave_barrier();
            }
        }
    }
    if (ROUTER) {
        __syncthreads();
        if (tid < 16) lbase[tid] = atomicAdd(p.cnt + (layer * 16 + tid) * 64, lcnt[tid]);
        __syncthreads();
        for (int k = lane; k < nlist; k += 64) {
            const int* ent = rlist + (wid * 24 + k) * 4; const int row = ent[0], be1 = ent[1] & 255, be2 = ent[1] >> 8;
            p.slot[(size_t)be1 * NT + lbase[be1] + ent[2]] = row * 2; p.slot[(size_t)be2 * NT + lbase[be2] + ent[3]] = row * 2 + 1;
        }
    }
    (void)scr;
    __syncthreads();
}

DI void ph_win(const Ctx& cx, const Params& p, float* lds, int j) {
    const float* W = p.w_in + (size_t)j * 1024 * INC;
    ngemm<false>(cx, lds, 1, NT, INC, 1024,
        [&](int, int m) { return p.H + (size_t)m * 1024; },
        [&](int, int k) { return W + (size_t)k * INC; }, [&](int, int) { return (const float*)nullptr; },
        [&](int, int m, int n, float v, float) { p.P[(size_t)m * PLD + n] = f2bf(v); });
}
DI void ph_prepB(const Ctx& cx, const Params& p, int j) {
    const int tid = cx.tid, wid = tid >> 6, lane = tid & 63;
    for (int row = cx.bid * 8 + wid; row < NT; row += cx.nblk * 8) {
        const bf16_t* pr = p.P + (size_t)row * PLD + ACOLS;
        const uint2 uq = *(const uint2*)(pr + lane * 4); const unsigned ukv = *(const unsigned*)(pr + 256 + lane * 2);
        const float q0 = bflo(uq.x), q1 = bfhi(uq.x), q2 = bflo(uq.y), q3 = bfhi(uq.y), k0 = bflo(ukv), k1 = bfhi(ukv);
        const float sq = wave_sum(q0 * q0 + q1 * q1 + q2 * q2 + q3 * q3), sk = wave_sum(k0 * k0 + k1 * k1);
        const float rq = rsqrtf(sq * (1.f / 256.f) + 1e-6f), rk = rsqrtf(sk * (1.f / 128.f) + 1e-6f);
        const float* gq = p.b_q_norm + j * 256 + lane * 4; const float* gk = p.b_kv_norm + j * 128 + lane * 2;
        uint2 o; o.x = pack2(q0 * rq * gq[0], q1 * rq * gq[1]); o.y = pack2(q2 * rq * gq[2], q3 * rq * gq[3]);
        bf16_t* qn = p.QN + (size_t)row * 512;
        *(uint2*)(qn + lane * 4) = o;
        *(unsigned*)(qn + 256 + lane * 2) = pack2(k0 * rk * gk[0], k1 * rk * gk[1]);
        *(unsigned*)(qn + 384 + lane * 2) = 0u;
    }
}
DI void ph_qkvup(const Ctx& cx, const Params& p, float* lds, int j, int mq) {
    const float* Wq = p.b_w_q_up + (size_t)j * 256 * 768; const float* Wkv = p.b_w_kv_up + (size_t)j * 128 * 1024;
    ngemm<false>(cx, lds, 1, mq, 768, 256,
        [&](int, int m) { return p.QN + (size_t)m * 512; },
        [&](int, int k) { return Wq + (size_t)k * 768; }, [&](int, int) { return (const float*)nullptr; },
        [&](int, int m, int n, float v, float) { p.Qraw[(size_t)m * 768 + n] = f2bf(v); });
    ngemm<false>(cx, lds, 1, NT, 1024, 128,
        [&](int, int m) { return p.QN + (size_t)m * 512 + 256; },
        [&](int, int k) { return Wkv + (size_t)k * 1024; }, [&](int, int) { return (const float*)nullptr; },
        [&](int, int m, int n, float v, float) { p.KVraw[(size_t)m * 1024 + n] = f2bf(v); });
}
DI void unpack8(const uint4 u, float* d) { d[0] = bflo(u.x); d[1] = bfhi(u.x); d[2] = bflo(u.y); d[3] = bfhi(u.y); d[4] = bflo(u.z); d[5] = bfhi(u.z); d[6] = bflo(u.w); d[7] = bfhi(u.w); }
DI uint4 pack8(const float* d, float scl) { uint4 u; u.x = pack2(d[0] * scl, d[1] * scl); u.y = pack2(d[2] * scl, d[3] * scl); u.z = pack2(d[4] * scl, d[5] * scl); u.w = pack2(d[6] * scl, d[7] * scl); return u; }
DI float ssq8(const uint4 u) { float d[8]; unpack8(u, d); float s = 0.f;
#pragma unroll
    for (int i = 0; i < 8; ++i) s += d[i] * d[i];
    return s; }
DI void norm_rope_store(const uint4 (&raw)[12], const float* gain, int t, bool lat, float scl, bf16_t* dst) {
    float ss = 0.f;
#pragma unroll
    for (int i = 0; i < 12; ++i) ss += ssq8(raw[i]);
    const float r = rsqrtf(ss * (1.f / 96.f) + 1e-6f);
#pragma unroll
    for (int i = 0; i < 8; ++i) { float d[8]; unpack8(raw[i], d);
#pragma unroll
        for (int c = 0; c < 8; ++c) d[c] = d[c] * r * gain[i * 8 + c];
        *(uint4*)(dst + i * 8) = pack8(d, scl); }
    const float invf[8] = {1.f, 0.316227766016838f, 0.1f, 0.0316227766016838f, 0.01f, 0.00316227766016838f, 0.001f, 0.000316227766016838f};
    const float ri = (float)(t >> 6), ci = (float)(t & 63);
#pragma unroll
    for (int half = 0; half < 2; ++half) {
        float x1[8], x2[8], o1[8], o2[8]; unpack8(raw[8 + half], x1); unpack8(raw[10 + half], x2);
#pragma unroll
        for (int c = 0; c < 8; ++c) {
            const float ang = (half == 0 ? ri : ci) * invf[c];
            const float cs = lat ? __cosf(ang) : 1.f, sn = lat ? __sinf(ang) : 0.f;
            const float a = x1[c] * r * gain[64 + half * 8 + c], b = x2[c] * r * gain[80 + half * 8 + c];
            o1[c] = a * cs - b * sn; o2[c] = b * cs + a * sn;
        }
        *(uint4*)(dst + 64 + half * 8) = pack8(o1, scl); *(uint4*)(dst + 80 + half * 8) = pack8(o2, scl);
    }
}
DI void ph_finalize(const Ctx& cx, const Params& p, int j, int mq) {
    const int gtid = cx.bid * NTHR + cx.tid, gsz = cx.nblk * NTHR;
    const float* qg = p.b_q_gain + j * 96; const float* kg = p.b_k_gain + j * 96;
    for (int idx = gtid; idx < 8 * mq; idx += gsz) {
        const int h = idx / mq, row = idx % mq;
        const bool lat = row < NLAT; const int t = lat ? (row & 2047) : ((row - NLAT) & 255);
        bf16_t* qp = p.Qraw + (size_t)row * 768 + h * 96;
        uint4 raw[12];
#pragma unroll
        for (int i = 0; i < 12; ++i) raw[i] = *(const uint4*)(qp + i * 8);
        norm_rope_store(raw, qg, t, lat, (OPT >= 5) ? 0.10206207261596577f * 1.4426950408889634f : 0.10206207261596577f, qp);
    }
    for (int idx = gtid; idx < 8 * NT; idx += gsz) {
        const int h = idx / NT, row = idx % NT;
        const bool lat = row < NLAT; const int b = lat ? (row >> 11) : ((row - NLAT) >> 8); const int t = lat ? (row & 2047) : ((row - NLAT) & 255);
        const int key = lat ? 256 + t : t;
        const bf16_t* kvp = p.KVraw + (size_t)row * 1024 + h * 128; const bf16_t* krp = p.P + (size_t)row * PLD + ACOLS + 384;
        uint4 raw[12];
#pragma unroll
        for (int i = 0; i < 8; ++i) raw[i] = *(const uint4*)(kvp + i * 8);
#pragma unroll
        for (int i = 0; i < 4; ++i) raw[8 + i] = *(const uint4*)(krp + i * 8);
        norm_rope_store(raw, kg, t, lat, 1.f, p.Kf + ((size_t)(b * 8 + h) * 2304 + key) * 96);
    }
    for (int idx = gtid; idx < 8 * NT; idx += gsz) {
        const int h = idx / NT, row = idx % NT;
        const bool lat = row < NLAT; const int b = lat ? (row >> 11) : ((row - NLAT) >> 8); const int t = lat ? (row & 2047) : ((row - NLAT) & 255);
        const int key = lat ? 256 + t : t;
        const bf16_t* vp = p.KVraw + (size_t)row * 1024 + h * 128 + 64;
        bf16_t* vo = p.Vt + (size_t)(b * 8 + h) * 64 * 2304 + key;
#pragma unroll 1
        for (int i = 0; i < 8; ++i) { const uint4 u = *(const uint4*)(vp + i * 8);
            vo[0] = (bf16_t)(u.x & 0xffff); vo[2304] = (bf16_t)(u.x >> 16); vo[2 * 2304] = (bf16_t)(u.y & 0xffff); vo[3 * 2304] = (bf16_t)(u.y >> 16);
            vo[4 * 2304] = (bf16_t)(u.z & 0xffff); vo[5 * 2304] = (bf16_t)(u.z >> 16); vo[6 * 2304] = (bf16_t)(u.w & 0xffff); vo[7 * 2304] = (bf16_t)(u.w >> 16);
            vo += 8 * 2304; }
    }
}
DI void ph_attn(const Ctx& cx, const Params& p, bool with_ctx) {
    const int gtid = cx.bid * NTHR + cx.tid, gsz = cx.nblk * NTHR;
    const int total = NLAT * 8 + (with_ctx ? NCTX * 8 : 0);
    for (int idx = gtid; idx < total; idx += gsz) {
        int b, h, row, nkeys;
        if (idx < NLAT * 8) { b = idx >> 14; h = (idx >> 11) & 7; row = b * 2048 + (idx & 2047); nkeys = 2304; }
        else { const int i2 = idx - NLAT * 8; b = i2 >> 11; h = (i2 >> 8) & 7; row = NLAT + b * 256 + (i2 & 255); nkeys = 256; }
        const bf16_t* qp = p.Qraw + (size_t)row * 768 + h * 96;
        const bf16_t* Kb = p.Kf + (size_t)(b * 8 + h) * 2304 * 96; const bf16_t* Vb = p.Vt + (size_t)(b * 8 + h) * 64 * 2304;
        float q[96];
#pragma unroll
        for (int i = 0; i < 12; ++i) { const uint4 u = *(const uint4*)(qp + i * 8); q[i * 8] = bflo(u.x); q[i * 8 + 1] = bfhi(u.x); q[i * 8 + 2] = bflo(u.y); q[i * 8 + 3] = bfhi(u.y);
            q[i * 8 + 4] = bflo(u.z); q[i * 8 + 5] = bfhi(u.z); q[i * 8 + 6] = bflo(u.w); q[i * 8 + 7] = bfhi(u.w); }
        float acc[64];
#pragma unroll
        for (int i = 0; i < 64; ++i) acc[i] = 0.f;
        float mx = -3.0e38f, l = 0.f;
        for (int key0 = 0; key0 < nkeys; key0 += 8) {
            float s[8];
#pragma unroll
            for (int kk = 0; kk < 8; ++kk) {
                const uint4* kp = (const uint4*)(Kb + (size_t)(key0 + kk) * 96); float a = 0.f;
#pragma unroll
                for (int i = 0; i < 12; ++i) { const uint4 u = kp[i]; a += q[i * 8] * bflo(u.x) + q[i * 8 + 1] * bfhi(u.x) + q[i * 8 + 2] * bflo(u.y) + q[i * 8 + 3] * bfhi(u.y)
                    + q[i * 8 + 4] * bflo(u.z) + q[i * 8 + 5] * bfhi(u.z) + q[i * 8 + 6] * bflo(u.w) + q[i * 8 + 7] * bfhi(u.w); }
                s[kk] = a;
            }
            float cm = s[0];
#pragma unroll
            for (int kk = 1; kk < 8; ++kk) cm = fmaxf(cm, s[kk]);
            const float mn = fmaxf(mx, cm), alpha = expf(mx - mn);
            float ps = 0.f;
#pragma unroll
            for (int kk = 0; kk < 8; ++kk) { s[kk] = expf(s[kk] - mn); ps += s[kk]; }
            l = l * alpha + ps; mx = mn;
#pragma unroll
            for (int dv = 0; dv < 64; ++dv) {
                const uint4 u = *(const uint4*)(Vb + (size_t)dv * 2304 + key0);
                acc[dv] = acc[dv] * alpha + s[0] * bflo(u.x) + s[1] * bfhi(u.x) + s[2] * bflo(u.y) + s[3] * bfhi(u.y) + s[4] * bflo(u.z) + s[5] * bfhi(u.z) + s[6] * bflo(u.w) + s[7] * bfhi(u.w);
            }
        }
        const float il = 1.f / l;
        bf16_t* o = p.H + (size_t)row * 1024 + 512 + h * 64;
#pragma unroll
        for (int i = 0; i < 8; ++i) { uint4 u; u.x = pack2(acc[i * 8] * il, acc[i * 8 + 1] * il); u.y = pack2(acc[i * 8 + 2] * il, acc[i * 8 + 3] * il);
            u.z = pack2(acc[i * 8 + 4] * il, acc[i * 8 + 5] * il); u.w = pack2(acc[i * 8 + 6] * il, acc[i * 8 + 7] * il); *(uint4*)(o + i * 8) = u; }
    }
}
DI float shiftp(const bf16_t* P, int row, int t, int T, int col, float mu) {
    const float c = bf2f(P[(size_t)row * PLD + col]);
    const float pv = (t > 0) ? bf2f(P[(size_t)(row - 1) * PLD + col]) : 0.f;
    const float nx = (t < T - 1) ? bf2f(P[(size_t)(row + 1) * PLD + col]) : 0.f;
    return c + mu * (0.5f * (pv + nx) - c);
}
DI void ph_prepLR(const Ctx& cx, const Params& p, int j) {
    const int gtid = cx.bid * NTHR + cx.tid, gsz = cx.nblk * NTHR;
    const float* mu = p.a_mu + j * ACOLS + 1536;
    for (int idx = gtid; idx < NT * 384; idx += gsz) {
        const int row = idx / 384, col = idx % 384;
        const bool lat = row < NLAT; const int t = lat ? (row & 2047) : ((row - NLAT) & 255); const int T = lat ? 2048 : 256;
        float v = shiftp(p.P, row, t, T, 1536 + col, mu[col]);
        if (col < 128) v = tanhf(v); else if (col >= 256) v = sigm(v);
        p.LR[(size_t)row * 384 + col] = f2bf(v);
    }
}
DI void ph_wag(const Ctx& cx, const Params& p, float* lds, int j) {
    for (int d = 0; d < 2; ++d) {
        const float* W2 = p.a_w2 + (size_t)(j * 2 + d) * 64 * 512; const float* w0 = p.a_w0 + (j * 2 + d) * 512;
        ngemm<false>(cx, lds, 1, NT, 512, 64,
            [&](int, int m) { return p.LR + (size_t)m * 384 + d * 64; },
            [&](int, int k) { return W2 + (size_t)k * 512; }, [&](int, int) { return (const float*)nullptr; },
            [&](int, int m, int n, float v, float) { const float z = -0.606531f * sigm(w0[n] + v); p.WAG[(size_t)m * WLD + d * 512 + n] = f2bf(-expm1f(z)); });
        const float* A2 = p.a_a2 + (size_t)(j * 2 + d) * 64 * 512; const float* a0 = p.a_a0 + (j * 2 + d) * 512;
        ngemm<false>(cx, lds, 1, NT, 512, 64,
            [&](int, int m) { return p.LR + (size_t)m * 384 + 128 + d * 64; },
            [&](int, int k) { return A2 + (size_t)k * 512; }, [&](int, int) { return (const float*)nullptr; },
            [&](int, int m, int n, float v, float) { p.WAG[(size_t)m * WLD + 1024 + d * 512 + n] = f2bf(sigm(a0[n] + v)); });
    }
    const float* G2 = p.a_g2 + (size_t)j * 128 * 512;
    ngemm<false>(cx, lds, 1, NT, 512, 128,
        [&](int, int m) { return p.LR + (size_t)m * 384 + 256; },
        [&](int, int k) { return G2 + (size_t)k * 512; }, [&](int, int) { return (const float*)nullptr; },
        [&](int, int m, int n, float v, float) { p.WAG[(size_t)m * WLD + 2048 + n] = f2bf(v); });
}
DI void ph_scan(const Ctx& cx, const Params& p, float* lds, int j) {
    const int tid = cx.tid, lane = tid & 63;
    if (tid < 64) {
        for (int item = cx.bid; item < 256; item += cx.nblk) {
            const int b = item >> 4, h = (item >> 1) & 7, dir = item & 1, hc = h * 64 + lane;
            float S[64];
#pragma unroll
            for (int k = 0; k < 64; ++k) S[k] = 0.f;
            const float kkc = p.a_k_k[j * 512 + hc], kac = p.a_k_a[j * 512 + hc];
            const float mur = p.a_mu[j * ACOLS + hc], muk = p.a_mu[j * ACOLS + 512 + hc], muv = p.a_mu[j * ACOLS + 1024 + hc];
            bf16_t* yout = dir ? p.YB : p.YF;
            for (int step = 0; step < 2304; ++step) {
                const bool cp = step < 256; const int tt = cp ? step : step - 256, T = cp ? 256 : 2048, t = dir ? (T - 1 - tt) : tt;
                const int row = cp ? NLAT + b * 256 + t : b * 2048 + t;
                const float R = shiftp(p.P, row, t, T, hc, mur), K = shiftp(p.P, row, t, T, 512 + hc, muk), V = shiftp(p.P, row, t, T, 1024 + hc, muv);
                const float w = 1.f - bf2f(p.WAG[(size_t)row * WLD + dir * 512 + hc]), a = bf2f(p.WAG[(size_t)row * WLD + 1024 + dir * 512 + hc]);
                const float kkv = K * kkc, ssq = wave_sum(kkv * kkv), kk = kkv * rsqrtf(ssq + 1e-12f);
                const float kd = K * (1.f + (a - 1.f) * kac), bd = kk * a;
                lds[lane] = -kk; lds[64 + lane] = w; lds[128 + lane] = bd; lds[192 + lane] = kd; lds[256 + lane] = R;
                __builtin_amdgcn_wave_barrier();
                float sa = 0.f;
#pragma unroll
                for (int k4 = 0; k4 < 16; ++k4) { const float4 v = *(const float4*)(lds + k4 * 4); sa += S[k4 * 4] * v.x + S[k4 * 4 + 1] * v.y + S[k4 * 4 + 2] * v.z + S[k4 * 4 + 3] * v.w; }
                float y = 0.f;
#pragma unroll
                for (int k4 = 0; k4 < 16; ++k4) {
                    const float4 wv = *(const float4*)(lds + 64 + k4 * 4), bv = *(const float4*)(lds + 128 + k4 * 4), kv = *(const float4*)(lds + 192 + k4 * 4), rv = *(const float4*)(lds + 256 + k4 * 4);
                    S[k4 * 4] = S[k4 * 4] * wv.x + sa * bv.x + V * kv.x; S[k4 * 4 + 1] = S[k4 * 4 + 1] * wv.y + sa * bv.y + V * kv.y;
                    S[k4 * 4 + 2] = S[k4 * 4 + 2] * wv.z + sa * bv.z + V * kv.z; S[k4 * 4 + 3] = S[k4 * 4 + 3] * wv.w + sa * bv.w + V * kv.w;
                    y += S[k4 * 4] * rv.x + S[k4 * 4 + 1] * rv.y + S[k4 * 4 + 2] * rv.z + S[k4 * 4 + 3] * rv.w;
                }
                __builtin_amdgcn_wave_barrier();
                yout[(size_t)row * 512 + hc] = f2bf(y);
            }
        }
    }
    __syncthreads();
}
DI void ph_post(const Ctx& cx, const Params& p, int j, int nrows) {
    const int gtid = cx.bid * NTHR + cx.tid, gsz = cx.nblk * NTHR;
    for (int idx = gtid; idx < 8 * nrows; idx += gsz) {
        const int h = idx / nrows, row = idx % nrows;
        const bool lat = row < NLAT; const int t = lat ? (row & 2047) : ((row - NLAT) & 255); const int T = lat ? 2048 : 256;
        float sum = 0.f, sb = 0.f;
#pragma unroll 8
        for (int n = 0; n < 64; ++n) {
            const int hc = h * 64 + n;
            const float yy = bf2f(p.YF[(size_t)row * 512 + hc]) + bf2f(p.YB[(size_t)row * 512 + hc]);
            sum += yy;
            const float R = shiftp(p.P, row, t, T, hc, p.a_mu[j * ACOLS + hc]), K = shiftp(p.P, row, t, T, 512 + hc, p.a_mu[j * ACOLS + 512 + hc]);
            const float af = bf2f(p.WAG[(size_t)row * WLD + 1024 + hc]), ab = bf2f(p.WAG[(size_t)row * WLD + 1536 + hc]);
            const float ka = p.a_k_a[j * 512 + hc], rk = p.a_r_k[j * 512 + hc];
            sb += R * rk * (K * (1.f + (af - 1.f) * ka) + K * (1.f + (ab - 1.f) * ka));
        }
        const float mean = sum * (1.f / 64.f); float var = 0.f;
#pragma unroll 8
        for (int n = 0; n < 64; ++n) { const int hc = h * 64 + n; const float yy = bf2f(p.YF[(size_t)row * 512 + hc]) + bf2f(p.YB[(size_t)row * 512 + hc]); var += (yy - mean) * (yy - mean); }
        const float rstd = rsqrtf(var * (1.f / 64.f) + 64e-5f);
#pragma unroll 8
        for (int n = 0; n < 64; ++n) {
            const int hc = h * 64 + n;
            const float yy = bf2f(p.YF[(size_t)row * 512 + hc]) + bf2f(p.YB[(size_t)row * 512 + hc]);
            const float V = shiftp(p.P, row, t, T, 1024 + hc, p.a_mu[j * ACOLS + 1024 + hc]);
            const float g = bf2f(p.WAG[(size_t)row * WLD + 2048 + hc]);
            const float o = ((yy - mean) * rstd * p.a_ln_w[j * 512 + hc] + p.a_ln_b[j * 512 + hc] + sb * V) * g;
            p.H[(size_t)row * 1024 + hc] = f2bf(o);
        }
    }
}
DI void ph_wout(const Ctx& cx, const Params& p, float* lds, const bf16_t* A, const float* W, int nrows, const float* xin_lat, const float* xin_ctx, const float* modl) {
    ngemm<false>(cx, lds, 1, nrows, 1024, 1024,
        [&](int, int m) { return A + (size_t)m * 1024; },
        [&](int, int k) { return W + (size_t)k * 1024; }, [&](int, int) { return (const float*)nullptr; },
        [&](int, int m, int n, float v, float) {
            const bool lat = m < NLAT; const int jj = lat ? (m >> 11) : 16; const float g1 = modl[(size_t)jj * 6144 + 2 * 1024 + n];
            if (lat) p.out[(size_t)m * 1024 + n] = xin_lat[(size_t)m * 1024 + n] + g1 * v;
            else p.ctxs[(size_t)(m - NLAT) * 1024 + n] = xin_ctx[(size_t)(m - NLAT) * 1024 + n] + g1 * v; });
}

DI void ph_chdft(const Ctx& cx, const Params& p, float* lds, int nrows) {
    const int tid = cx.tid, gtid = cx.bid * NTHR + tid, gsz = cx.nblk * NTHR;
    for (int i = tid; i < 128; i += NTHR) { lds[i] = cospif((float)i * (1.f / 64.f)); lds[128 + i] = sinpif((float)i * (1.f / 64.f)); }
    __syncthreads();
    for (int idx = gtid; idx < nrows * 1024; idx += gsz) {
        const int row = idx >> 10, col = idx & 1023, grp = col >> 7, g = col & 127;
        const bf16_t* hp = p.H + (size_t)row * 1024 + grp * 128;
        float gr = 0.f, gi = 0.f;
        for (int c = 0; c < 128; ++c) { const float xv = bf2f(hp[c]); const int m = (c * g) & 127; gr += xv * lds[m]; gi -= xv * lds[128 + m]; }
        p.G[(size_t)row * 2048 + col] = gr; p.G[(size_t)row * 2048 + 1024 + col] = gi;
    }
    __syncthreads();
}
DI void ph_posdft(const Ctx& cx, const Params& p, float* lds, bool with_ctx) {
    ngemm<false>(cx, lds, 16, 2048, 1024, 4096,
        [&](int, int m) { return p.dftl + (size_t)m * 4096; },
        [&](int bz, int k) { return (k < 2048) ? p.G + (size_t)(bz * 2048 + k) * 2048 : p.G + (size_t)(bz * 2048 + k - 2048) * 2048 + 1024; }, [&](int, int) { return (const float*)nullptr; },
        [&](int bz, int m, int n, float v, float) { p.F[(size_t)(bz * 2048 + m) * 1024 + n] = f2bf(v * (1.f / 512.f)); });
    if (with_ctx)
        ngemm<false>(cx, lds, 16, 256, 1024, 512,
            [&](int, int m) { return p.dftc + (size_t)m * 512; },
            [&](int bz, int k) { return (k < 256) ? p.G + (size_t)(NLAT + bz * 256 + k) * 2048 : p.G + (size_t)(NLAT + bz * 256 + k - 256) * 2048 + 1024; }, [&](int, int) { return (const float*)nullptr; },
            [&](int bz, int m, int n, float v, float) { p.F[(size_t)(NLAT + bz * 256 + m) * 1024 + n] = f2bf(v * 0.0055242717280199f); });
}

DI void ph_moe_up(const Ctx& cx, const Params& p, float* lds, int layer, int nrows) {
    for (int e = 0; e < 17; ++e) {
        const int M = (e < 16) ? __builtin_amdgcn_readfirstlane(p.cnt[(layer * 16 + e) * 64]) : nrows;
        const float* Wg = (e < 16) ? p.moe_w_gate + ((size_t)layer * 16 + e) * 1024 * 512 : p.sh_gate + (size_t)layer * 1024 * 512;
        const float* Wu = (e < 16) ? p.moe_w_up + ((size_t)layer * 16 + e) * 1024 * 512 : p.sh_up + (size_t)layer * 1024 * 512;
        const int* sl = p.slot + (size_t)(e & 15) * NT;
        ngemm<true>(cx, lds, 1, M, 512, 1024,
            [&](int, int m) { const int tok = (e < 16) ? (sl[m] >> 1) : m; return p.H + (size_t)tok * 1024; },
            [&](int, int k) { return Wg + (size_t)k * 512; }, [&](int, int k) { return Wu + (size_t)k * 512; },
            [&](int, int m, int n, float g, float u) { const int s = (e < 16) ? sl[m] : 0; const int tok = (e < 16) ? (s >> 1) : m, slab = (e < 16) ? (s & 1) : 2;
                p.ACT[((size_t)slab * NT + tok) * 512 + n] = f2bf(siluf(g) * u); });
    }
}
DI void ph_moe_down(const Ctx& cx, const Params& p, float* lds, int layer, int nrows) {
    for (int e = 0; e < 17; ++e) {
        const int M = (e < 16) ? __builtin_amdgcn_readfirstlane(p.cnt[(layer * 16 + e) * 64]) : nrows;
        const float* Wd = (e < 16) ? p.moe_w_down + ((size_t)layer * 16 + e) * 512 * 1024 : p.sh_down + (size_t)layer * 512 * 1024;
        const int* sl = p.slot + (size_t)(e & 15) * NT;
        ngemm<false>(cx, lds, 1, M, 1024, 512,
            [&](int, int m) { const int s = (e < 16) ? sl[m] : 0; const int tok = (e < 16) ? (s >> 1) : m, slab = (e < 16) ? (s & 1) : 2; return p.ACT + ((size_t)slab * NT + tok) * 512; },
            [&](int, int k) { return Wd + (size_t)k * 1024; }, [&](int, int) { return (const float*)nullptr; },
            [&](int, int m, int n, float v, float) { const int s = (e < 16) ? sl[m] : 0; const int tok = (e < 16) ? (s >> 1) : m, slab = (e < 16) ? (s & 1) : 2;
                const float w = (e < 16) ? p.tokw[s] : 1.f; p.Y[((size_t)slab * NT + tok) * 1024 + n] = f2bf(w * v); });
    }
}

namespace mm {
typedef short bf16x8 __attribute__((ext_vector_type(8)));
typedef float f32x4 __attribute__((ext_vector_type(4)));
typedef unsigned u32x4 __attribute__((ext_vector_type(4)));
constexpr int BM = 256, BK = 64, HALF = 128, HTB = HALF * BK * 2, STAGE_BYTES = 8 * HTB;
DI int lds_byte(int r, int c) { const int st = (r >> 4) * 2 + (c >> 5), rr = r & 15, cc = c & 31, ob = rr * 64 + cc * 2; return st * 1024 + (ob ^ (((ob >> 9) & 1) << 5)); }
DI void stage_rc(int b, int& R, int& C) { const int st = b / 1024, sb = b % 1024, swz = sb ^ (((sb >> 9) & 1) << 5); R = (st >> 1) * 16 + swz / 64; C = (st & 1) * 32 + (swz % 64) / 2; }
DI int perm32(int rho) { const int n = rho >> 4, i = rho & 15; return 8 * (i >> 2) + 4 * n + (i & 3); }
DI unsigned cvt_pk_bf16(float lo, float hi) { unsigned r; asm volatile("v_cvt_pk_bf16_f32 %0, %1, %2" : "=v"(r) : "v"(lo), "v"(hi)); return r; }
struct Unit { const char* A; const char* B; int pm, pn, e, m, tb; };
template <class Sched, class Epi>
DI void gemm_phase(LAS unsigned char* lds, const int K, const Sched& S, const Epi& E, const int tid) {
    const int wid = __builtin_amdgcn_readfirstlane(tid >> 6), lane = tid & 63, wr = wid >> 2, wc = wid & 3, fr = lane & 15, fq = lane >> 4;
    const int nt = K / BK;
    int R0, C0, R1, C1; stage_rc(tid * 16, R0, C0); stage_rc(tid * 16 + 8192, R1, C1);
    unsigned voffB[2];
    { const int Rb0 = Epi::PERM ? ((R0 & ~31) + perm32(R0 & 31)) : R0, Rb1 = Epi::PERM ? ((R1 & ~31) + perm32(R1 & 31)) : R1;
      voffB[0] = S.boff(Rb0, C0, K); voffB[1] = S.boff(Rb1, C1, K); }
    const size_t kstep = (size_t)(BK * 2), hstepB = S.hstep_b(K), hstepA = S.hstep_a();
    const unsigned ldsw = (unsigned)wid * 1024u;
    const int aoff = lds_byte(wr * 64 + fr, fq * 8), boff = lds_byte(wc * 32 + fr, fq * 8);
#define MM_SA(b, h) (((b) * 2 + (h)) * HTB)
#define MM_SB(b, h) ((4 + (b) * 2 + (h)) * HTB)
#define MM_STAGE_A(bufoff, gbase, h, offs) do { _Pragma("unroll") for (int _i = 0; _i < 2; ++_i) { \
        if constexpr (Sched::GATHER) __builtin_amdgcn_global_load_lds((const unsigned*)((const char*)(gbase) + (offs)[h][_i]), (LAS unsigned*)(lds + (bufoff) + ldsw + _i * 8192), 16, 0, 0); \
        else __builtin_amdgcn_global_load_lds((const unsigned*)((const char*)(gbase) + (size_t)(h) * hstepA + (offs)[0][_i]), (LAS unsigned*)(lds + (bufoff) + ldsw + _i * 8192), 16, 0, 0); } } while (0)
#define MM_STAGE_B(bufoff, gbase) do { _Pragma("unroll") for (int _i = 0; _i < 2; ++_i) \
        __builtin_amdgcn_global_load_lds((const unsigned*)((const char*)(gbase) + voffB[_i]), (LAS unsigned*)(lds + (bufoff) + ldsw + _i * 8192), 16, 0, 0); } while (0)
#define MM_LDA(dst, b, h) do { _Pragma("unroll") for (int m = 0; m < 4; ++m) _Pragma("unroll") for (int k = 0; k < 2; ++k) dst[m][k] = *(const LAS bf16x8*)(lds + MM_SA(b, h) + aoff + m * 2048 + k * 1024); } while (0)
#define MM_LDB(dst, b, h) do { _Pragma("unroll") for (int n = 0; n < 2; ++n) _Pragma("unroll") for (int k = 0; k < 2; ++k) dst[n][k] = *(const LAS bf16x8*)(lds + MM_SB(b, h) + boff + n * 2048 + k * 1024); } while (0)
#define MM_MMA(ai, bj, At, Bt) do { __builtin_amdgcn_s_setprio(1); _Pragma("unroll") for (int m = 0; m < 4; ++m) _Pragma("unroll") for (int n = 0; n < 2; ++n) _Pragma("unroll") for (int k = 0; k < 2; ++k) \
        acc[ai][bj][m][n] = __builtin_amdgcn_mfma_f32_16x16x32_bf16(Bt[n][k], At[m][k], acc[ai][bj][m][n], 0, 0, 0); __builtin_amdgcn_s_setprio(0); } while (0)
#define MM_WAIT_V(n) asm volatile("s_waitcnt vmcnt(" #n ")" ::: "memory")
#define MM_WAIT_L(n) asm volatile("s_waitcnt lgkmcnt(" #n ")" ::: "memory")
#define MM_BAR __builtin_amdgcn_s_barrier()
#define MM_SCHED __builtin_amdgcn_sched_barrier(0)
    Unit cur, nxt; int ui = 0;
    if (!S.next(0, cur)) return;
    unsigned oa[2][2], on[2][2];
    S.aoff(cur, R0, C0, R1, C1, oa);
    on[0][0] = oa[0][0]; on[0][1] = oa[0][1]; on[1][0] = oa[1][0]; on[1][1] = oa[1][1];
    if constexpr (Sched::TABLE) S.tab_dma(cur, lds + STAGE_BYTES + 1024, tid);
    f32x4 acc[2][2][4][2];
#pragma unroll
    for (int a = 0; a < 2; ++a)
#pragma unroll
        for (int b = 0; b < 2; ++b)
#pragma unroll
            for (int m = 0; m < 4; ++m)
#pragma unroll
                for (int n = 0; n < 2; ++n) acc[a][b][m][n] = (f32x4){0.f, 0.f, 0.f, 0.f};
    bf16x8 At[4][2], B0[2][2], B1[2][2];
    const char* cA = cur.A; const char* cB = cur.B;
    MM_STAGE_B(MM_SB(0, 0), cB); MM_STAGE_A(MM_SA(0, 0), cA, 0, oa); MM_STAGE_B(MM_SB(0, 1), cB + hstepB); MM_STAGE_A(MM_SA(0, 1), cA, 1, oa);
    if (wr == 1) MM_BAR;
    MM_WAIT_V(4); MM_BAR;
    MM_STAGE_B(MM_SB(1, 0), cB + kstep); MM_STAGE_A(MM_SA(1, 0), cA + kstep, 0, oa); MM_STAGE_B(MM_SB(1, 1), cB + hstepB + kstep);
    MM_WAIT_V(6); MM_BAR;
    for (;;) {
        cur.tb = ui % 3;
        const bool has_next = S.next(ui + 1, nxt);
        if constexpr (Sched::TABLE) { if (has_next) S.tab_dma(nxt, lds + STAGE_BYTES + 1024 + ((ui + 1) % 3) * 2048, tid); }
        const char* nA = has_next ? nxt.A : cA; const char* nB = has_next ? nxt.B : cB;
        for (int t = 0; t < nt; t += 2) {
            const bool last = (t == nt - 2);
            if constexpr (Sched::GATHER) { if (last) { if (has_next) S.aoff_lds(nxt, (const LAS int*)(lds + STAGE_BYTES + 1024 + ((ui + 1) % 3) * 2048), R0, C0, R1, C1, on);
                else { on[0][0] = oa[0][0]; on[0][1] = oa[0][1]; on[1][0] = oa[1][0]; on[1][1] = oa[1][1]; } } }
            const char* a1 = cA + (size_t)(t + 1) * kstep;
            const char* a2 = last ? nA : cA + (size_t)(t + 2) * kstep; const char* b2 = last ? nB : cB + (size_t)(t + 2) * kstep;
            const char* a3 = a2 + kstep; const char* b3 = b2 + kstep;
            unsigned o2[2][2];
            if constexpr (Sched::GATHER) { o2[0][0] = last ? on[0][0] : oa[0][0]; o2[0][1] = last ? on[0][1] : oa[0][1]; o2[1][0] = last ? on[1][0] : oa[1][0]; o2[1][1] = last ? on[1][1] : oa[1][1]; }
            else { o2[0][0] = oa[0][0]; o2[0][1] = oa[0][1]; o2[1][0] = oa[1][0]; o2[1][1] = oa[1][1]; }
            MM_LDB(B0, 0, 0); MM_SCHED; MM_LDA(At, 0, 0); MM_STAGE_A(MM_SA(1, 1), a1, 1, oa);
            MM_WAIT_L(8); MM_BAR; MM_WAIT_L(0); MM_MMA(0, 0, At, B0); MM_BAR; MM_SCHED;
            MM_LDB(B1, 0, 1); MM_STAGE_B(MM_SB(0, 0), b2);
            MM_BAR; MM_WAIT_L(0); MM_MMA(0, 1, At, B1); MM_BAR;
            MM_LDA(At, 0, 1); MM_STAGE_A(MM_SA(0, 0), a2, 0, o2);
            MM_BAR; MM_WAIT_L(0); MM_MMA(1, 0, At, B0); MM_BAR; MM_SCHED;
            MM_STAGE_B(MM_SB(0, 1), b2 + hstepB);
            MM_WAIT_V(6); MM_BAR; MM_MMA(1, 1, At, B1); MM_BAR;
            MM_LDB(B0, 1, 0); MM_SCHED; MM_LDA(At, 1, 0); MM_STAGE_A(MM_SA(0, 1), a2, 1, o2);
            MM_WAIT_L(8); MM_BAR; MM_WAIT_L(0); MM_MMA(0, 0, At, B0); MM_BAR; MM_SCHED;
            MM_LDB(B1, 1, 1); MM_STAGE_B(MM_SB(1, 0), b3);
            MM_BAR; MM_WAIT_L(0); MM_MMA(0, 1, At, B1); MM_BAR;
            MM_LDA(At, 1, 1); MM_STAGE_A(MM_SA(1, 0), a3, 0, o2);
            MM_BAR; MM_WAIT_L(0); MM_MMA(1, 0, At, B0); MM_BAR; MM_SCHED;
            MM_STAGE_B(MM_SB(1, 1), b3 + hstepB);
            MM_WAIT_V(6); MM_BAR; MM_MMA(1, 1, At, B1); MM_BAR;
        }
        {
          int tz = tid; asm volatile("" : "+v"(tz)); const int wz = tz >> 6, lz = tz & 63;
          E(acc, cur, wz >> 2, wz & 3, lz & 15, lz >> 4); }
        if (!has_next) break;
#pragma unroll
        for (int a = 0; a < 2; ++a)
#pragma unroll
            for (int b = 0; b < 2; ++b)
#pragma unroll
                for (int m = 0; m < 4; ++m)
#pragma unroll
                    for (int n = 0; n < 2; ++n) acc[a][b][m][n] = (f32x4){0.f, 0.f, 0.f, 0.f};
        cur = nxt; cA = nA; cB = nB; ++ui;
        if constexpr (Sched::GATHER) { oa[0][0] = on[0][0]; oa[0][1] = on[0][1]; oa[1][0] = on[1][0]; oa[1][1] = on[1][1]; }
    }
    MM_WAIT_V(0);
    if (wr == 0) MM_BAR;
    MM_BAR;
#undef MM_SA
#undef MM_SB
#undef MM_STAGE_A
#undef MM_STAGE_B
#undef MM_LDA
#undef MM_LDB
#undef MM_MMA
#undef MM_WAIT_V
#undef MM_WAIT_L
#undef MM_BAR
#undef MM_SCHED
}
struct StaticSched {
    static constexpr bool GATHER = false, TABLE = false;
    const char* A; const char* Bt; int lda, K, nM, nN, nwg, G, c;
    DI size_t hstep_a() const { return (size_t)HALF * lda * 2; }
    DI unsigned boff(int Rb, int C, int Kk) const { return (unsigned)(Rb * Kk + C) * 2u; }
    DI size_t hstep_b(int Kk) const { return (size_t)HALF * Kk * 2; }
    DI void init(const void* A_, const void* Bt_, int M, int N, int K_, int lda_, int G_, int c_) { A = (const char*)A_; Bt = (const char*)Bt_; lda = lda_; K = K_; nM = M / BM; nN = N / BM; nwg = nM * nN; G = G_; c = c_; }
    DI bool next(int i, Unit& u) const {
        const int L = i * G + c; if (L >= nwg) return false;
        int wgid = L; { const int q = nwg / 8, r = nwg % 8, xcd = wgid % 8, off = wgid / 8; wgid = (xcd < r ? xcd * (q + 1) : r * (q + 1) + (xcd - r) * q) + off; }
        const int nig = 8 * nN, gid = wgid / nig, fm = gid * 8, gsz = (nM - fm) < 8 ? (nM - fm) : 8;
        u.pm = fm + ((wgid % nig) % gsz); u.pn = (wgid % nig) / gsz; u.e = 0; u.m = 0;
        u.A = A + (size_t)u.pm * BM * lda * 2; u.B = Bt + (size_t)u.pn * BM * K * 2; return true;
    }
    DI void aoff(const Unit&, int R0, int C0, int R1, int C1, unsigned (&o)[2][2]) const {
        o[0][0] = (unsigned)(R0 * lda + C0) * 2u; o[0][1] = (unsigned)(R1 * lda + C1) * 2u;
        o[1][0] = (unsigned)((HALF + R0) * lda + C0) * 2u; o[1][1] = (unsigned)((HALF + R1) * lda + C1) * 2u;
    }
};
struct BatchSched {
    static constexpr bool GATHER = false, TABLE = false;
    const char* A; const char* Bt; int K, nM, nN, nb, G, c; size_t bstride;
    DI size_t hstep_a() const { return (size_t)HALF * K * 2; }
    DI unsigned boff(int Rb, int C, int Kk) const { return (unsigned)(Rb * Kk + C) * 2u; }
    DI size_t hstep_b(int Kk) const { return (size_t)HALF * Kk * 2; }
    DI void init(const void* A_, const void* Bt_, size_t bstride_bytes, int nb_, int M, int N, int K_, int G_, int c_) { A = (const char*)A_; Bt = (const char*)Bt_; bstride = bstride_bytes; nb = nb_; K = K_; nM = M / BM; nN = N / BM; G = G_; c = c_; }
    DI bool next(int i, Unit& u) const {
        const int L = i * G + c; if (L >= nb * nM * nN) return false;
        const int b = L / (nM * nN), rem = L % (nM * nN); u.pm = rem / nN; u.pn = rem % nN; u.e = b; u.m = 0;
        u.A = A + (size_t)u.pm * BM * K * 2; u.B = Bt + (size_t)b * bstride + (size_t)u.pn * BM * K * 2; return true;
    }
    DI void aoff(const Unit&, int R0, int C0, int R1, int C1, unsigned (&o)[2][2]) const {
        o[0][0] = (unsigned)(R0 * K + C0) * 2u; o[0][1] = (unsigned)(R1 * K + C1) * 2u;
        o[1][0] = (unsigned)((HALF + R0) * K + C0) * 2u; o[1][1] = (unsigned)((HALF + R1) * K + C1) * 2u;
    }
};
struct EpiBf16Store {
    static constexpr bool PERM = true;
    bf16_t* O0; int ldc; size_t bstr = 0;
    DI void operator()(const f32x4 (&acc)[2][2][4][2], const Unit& u, int wr, int wc, int fr, int fq) const {
        bf16_t* O = O0 + (size_t)u.e * bstr;
        const int row0 = u.pm * BM + wr * 64 + fr, col0 = u.pn * BM + wc * 32 + 8 * fq;
#pragma unroll
        for (int ai = 0; ai < 2; ++ai)
#pragma unroll
            for (int m = 0; m < 4; ++m) { bf16_t* rowp = O + (size_t)(row0 + ai * HALF + m * 16) * ldc + col0;
#pragma unroll
                for (int bj = 0; bj < 2; ++bj) { const f32x4 v0 = acc[ai][bj][m][0], v1 = acc[ai][bj][m][1];
                    u32x4 w; w.x = cvt_pk_bf16(v0[0], v0[1]); w.y = cvt_pk_bf16(v0[2], v0[3]); w.z = cvt_pk_bf16(v1[0], v1[1]); w.w = cvt_pk_bf16(v1[2], v1[3]);
                    *(u32x4*)(rowp + bj * HALF) = w; } }
    }
};
struct EpiResid {
    static constexpr bool PERM = false;
    const float* xin_lat; const float* xin_ctx; float* out_lat; float* out_ctx; const float* modl; int batched_T;
    DI void operator()(const f32x4 (&acc)[2][2][4][2], const Unit& u, int wr, int wc, int fr, int fq) const {
        int grow0; if (batched_T == 0) grow0 = u.pm * BM; else if (batched_T > 0) grow0 = u.e * 2048 + u.pm * BM; else grow0 = NLAT + u.e * 256 + u.pm * BM;
        const bool lat = grow0 < NLAT; const int jj = lat ? (grow0 >> 11) : 16;
        const float* xi = lat ? xin_lat + (size_t)grow0 * 1024 : xin_ctx + (size_t)(grow0 - NLAT) * 1024;
        float* xo = lat ? out_lat + (size_t)grow0 * 1024 : out_ctx + (size_t)(grow0 - NLAT) * 1024;
        const float* g1 = modl + (size_t)jj * 6144 + 2 * 1024;
        const int r0 = wr * 64 + fr, col0 = u.pn * BM + wc * 32 + 4 * fq;
        f32x4 gv[2][2];
#pragma unroll
        for (int bj = 0; bj < 2; ++bj)
#pragma unroll
            for (int n = 0; n < 2; ++n) gv[bj][n] = *(const f32x4*)(g1 + col0 + bj * HALF + n * 16);
#pragma unroll
        for (int ai = 0; ai < 2; ++ai) {
            f32x4 xv[4][2][2];
#pragma unroll
            for (int m = 0; m < 4; ++m)
#pragma unroll
                for (int bj = 0; bj < 2; ++bj)
#pragma unroll
                    for (int n = 0; n < 2; ++n) xv[m][bj][n] = *(const f32x4*)(xi + (size_t)(r0 + ai * HALF + m * 16) * 1024 + col0 + bj * HALF + n * 16);
#pragma unroll
            for (int m = 0; m < 4; ++m)
#pragma unroll
                for (int bj = 0; bj < 2; ++bj)
#pragma unroll
                    for (int n = 0; n < 2; ++n) *(f32x4*)(xo + (size_t)(r0 + ai * HALF + m * 16) * 1024 + col0 + bj * HALF + n * 16) = xv[m][bj][n] + gv[bj][n] * acc[ai][bj][m][n];
            asm volatile("" ::: "memory");
        }
    }
};
struct EpiResidB {
    static constexpr bool PERM = true;
    const void* xin_lat; const void* xin_ctx; bf16_t* out_lat; bf16_t* out_ctx; const float* modl; int batched_T; int in_f32;
    DI void operator()(const f32x4 (&acc)[2][2][4][2], const Unit& u, int wr, int wc, int fr, int fq) const {
        int grow0; if (batched_T == 0) grow0 = u.pm * BM; else if (batched_T > 0) grow0 = u.e * 2048 + u.pm * BM; else grow0 = NLAT + u.e * 256 + u.pm * BM;
        const bool lat = grow0 < NLAT; const int jj = lat ? (grow0 >> 11) : 16; const size_t rb = lat ? (size_t)grow0 : (size_t)(grow0 - NLAT);
        const float* g1 = modl + (size_t)jj * 6144 + 2 * 1024;
        bf16_t* xo = (lat ? out_lat : out_ctx) + rb * 1024;
        const int r0 = wr * 64 + fr, col0 = u.pn * BM + wc * 32 + 8 * fq;
        f32x4 gv[2][2];
#pragma unroll
        for (int bj = 0; bj < 2; ++bj)
#pragma unroll
            for (int n = 0; n < 2; ++n) gv[bj][n] = *(const f32x4*)(g1 + col0 + bj * HALF + 4 * n);
        if (in_f32) {
            const float* xi = (const float*)(lat ? xin_lat : xin_ctx) + rb * 1024;
#pragma unroll
            for (int ai = 0; ai < 2; ++ai)
#pragma unroll
                for (int mp = 0; mp < 2; ++mp) {
                    f32x4 xv[2][2][2];
#pragma unroll
                    for (int mm_ = 0; mm_ < 2; ++mm_)
#pragma unroll
                        for (int bj = 0; bj < 2; ++bj)
#pragma unroll
                            for (int n = 0; n < 2; ++n) xv[mm_][bj][n] = *(const f32x4*)(xi + (size_t)(r0 + ai * HALF + (2 * mp + mm_) * 16) * 1024 + col0 + bj * HALF + 4 * n);
#pragma unroll
                    for (int mm_ = 0; mm_ < 2; ++mm_)
#pragma unroll
                        for (int bj = 0; bj < 2; ++bj) { const int m = 2 * mp + mm_; const f32x4 o0 = xv[mm_][bj][0] + gv[bj][0] * acc[ai][bj][m][0], o1 = xv[mm_][bj][1] + gv[bj][1] * acc[ai][bj][m][1];
                            u32x4 w; w.x = att_pk(o0[0], o0[1]); w.y = att_pk(o0[2], o0[3]); w.z = att_pk(o1[0], o1[1]); w.w = att_pk(o1[2], o1[3]);
                            *(u32x4*)(xo + (size_t)(r0 + ai * HALF + m * 16) * 1024 + col0 + bj * HALF) = w; }
                    asm volatile("" ::: "memory");
                }
        } else {
            const bf16_t* xi = (const bf16_t*)(lat ? xin_lat : xin_ctx) + rb * 1024;
#pragma unroll
            for (int ai = 0; ai < 2; ++ai) {
                u32x4 xv[4][2];
#pragma unroll
                for (int m = 0; m < 4; ++m)
#pragma unroll
                    for (int bj = 0; bj < 2; ++bj) xv[m][bj] = *(const u32x4*)(xi + (size_t)(r0 + ai * HALF + m * 16) * 1024 + col0 + bj * HALF);
#pragma unroll
                for (int m = 0; m < 4; ++m)
#pragma unroll
                    for (int bj = 0; bj < 2; ++bj) { const u32x4 x = xv[m][bj];
                        const f32x4 x0 = {__uint_as_float(x.x << 16), __uint_as_float(x.x & 0xffff0000u), __uint_as_float(x.y << 16), __uint_as_float(x.y & 0xffff0000u)};
                        const f32x4 x1 = {__uint_as_float(x.z << 16), __uint_as_float(x.z & 0xffff0000u), __uint_as_float(x.w << 16), __uint_as_float(x.w & 0xffff0000u)};
                        const f32x4 o0 = x0 + gv[bj][0] * acc[ai][bj][m][0], o1 = x1 + gv[bj][1] * acc[ai][bj][m][1];
                        u32x4 w; w.x = att_pk(o0[0], o0[1]); w.y = att_pk(o0[2], o0[3]); w.z = att_pk(o1[0], o1[1]); w.w = att_pk(o1[2], o1[3]);
                        *(u32x4*)(xo + (size_t)(r0 + ai * HALF + m * 16) * 1024 + col0 + bj * HALF) = w; }
                asm volatile("" ::: "memory");
            }
        }
    }
};
}

DI void tconv_tile(const Ctx& cx, float* T, const float* src, int ld_src, int k0, int n0, int kvalid, int nvalid, bf16_t* dst, int ldd, int drow0) {
    const int tid = cx.tid;
#pragma unroll
    for (int rr = 0; rr < 2; ++rr) {
        const int i = (tid >> 4) + 32 * rr, j = (tid & 15) * 4;
        float4 v = make_float4(0.f, 0.f, 0.f, 0.f);
        if (k0 + i < kvalid && n0 + j < nvalid) v = *(const float4*)(src + (size_t)(k0 + i) * ld_src + n0 + j);
        T[i * 65 + j] = v.x; T[i * 65 + j + 1] = v.y; T[i * 65 + j + 2] = v.z; T[i * 65 + j + 3] = v.w;
    }
    __syncthreads();
    { const int j = tid >> 3, ch = tid & 7; uint4 o;
      o.x = pack2(T[(ch * 8 + 0) * 65 + j], T[(ch * 8 + 1) * 65 + j]); o.y = pack2(T[(ch * 8 + 2) * 65 + j], T[(ch * 8 + 3) * 65 + j]);
      o.z = pack2(T[(ch * 8 + 4) * 65 + j], T[(ch * 8 + 5) * 65 + j]); o.w = pack2(T[(ch * 8 + 6) * 65 + j], T[(ch * 8 + 7) * 65 + j]);
      *(uint4*)(dst + (size_t)(drow0 + j) * ldd + k0 + ch * 8) = o; }
    __syncthreads();
}
DI void ph_prep_weights(const Ctx& cx, const Params& p, float* lds) {
    const int tid = cx.tid, gtid = cx.bid * NTHR + tid, gsz = cx.nblk * NTHR;
    const int tb0 = (cx.nblk >= 256) ? cx.bid - 128 : cx.bid, tbs = (cx.nblk >= 256) ? 128 : cx.nblk;
    for (int it = tb0; it < 2 * 1008 && tb0 >= 0; it += tbs) {
        const int j = it / 1008; int r = it % 1008;
        if (r < 640) { const int kt = r / 40, ntl = r % 40; tconv_tile(cx, lds, p.w_in + (size_t)j * 1024 * INC, INC, kt * 64, ntl * 64, 1024, INC, p.WinT + (size_t)j * 2560 * 1024, 1024, ntl * 64); continue; } r -= 640;
        if (r < 48) { const int kt = r / 12, ntl = r % 12; tconv_tile(cx, lds, p.b_w_q_up + (size_t)j * 256 * 768, 768, kt * 64, ntl * 64, 256, 768, p.WqT + (size_t)j * 768 * 256, 256, ntl * 64); continue; } r -= 48;
        if (r < 64) { const int kt = r / 16, ntl = r % 16; tconv_tile(cx, lds, p.b_w_kv_up + (size_t)j * 128 * 1024, 1024, kt * 64, ntl * 64, 128, 1024, p.WkvT + (size_t)j * 1024 * 256, 256, ntl * 64); continue; } r -= 64;
        { const int kt = r / 16, ntl = r % 16; tconv_tile(cx, lds, p.w_out_even + (size_t)j * 1024 * 1024, 1024, kt * 64, ntl * 64, 1024, 1024, p.WoutT + (size_t)j * 1024 * 1024, 1024, ntl * 64); }
    }
    for (int idx = gtid; idx < 2 * 2560 * 384; idx += gsz) {
        const int j = idx / (2560 * 384), rem = idx % (2560 * 384), n = rem / 384, k = rem % 384; const int seg = n >> 9, nn = n & 511;
        float v = 0.f;
        if (seg < 2) { if ((k >> 6) == seg) v = p.a_w2[((size_t)(j * 2 + seg) * 64 + (k & 63)) * 512 + nn]; }
        else if (seg < 4) { if ((k >> 6) == seg) v = p.a_a2[((size_t)(j * 2 + seg - 2) * 64 + (k & 63)) * 512 + nn]; }
        else { if (k >= 256) v = p.a_g2[((size_t)j * 128 + (k - 256)) * 512 + nn]; }
        p.WlrT[idx] = f2bf(v);
    }
    {
        constexpr int WP = 80;
        LAS float* Wt = (LAS float*)lds; LAS float* tab = Wt + 128 * WP;
        for (int i = tid; i < 128; i += NTHR) { tab[i] = cospif((float)i * (1.f / 64.f)); tab[128 + i] = sinpif((float)i * (1.f / 64.f)); }
        const int wid = tid >> 6, lane = tid & 63, lr = lane & 15, lq = lane >> 4, cb = wid & 3, eh = wid >> 2;
        for (int it = cx.bid; it < 2 * 256; it += cx.nblk) {
            const int j = it >> 8, ct = (it >> 4) & 15, et = it & 15, grp = ct >> 1, c = (ct & 1) * 64 + cb * 16 + lr;
            const float* Wf = p.w_out_fourier + (size_t)j * 1024 * 1024 + (size_t)grp * 128 * 1024 + et * 64;
            __syncthreads();
#pragma unroll
            for (int q = 0; q < 4; ++q) { const int idx = tid + 512 * q, g = idx >> 4, c4 = (idx & 15) * 4;
                const float4 v = *(const float4*)(Wf + (size_t)g * 1024 + c4); *(LAS mm::f32x4*)(Wt + g * WP + c4) = (mm::f32x4){v.x, v.y, v.z, v.w}; }
            __syncthreads();
            mm::f32x4 ac0 = {0.f, 0.f, 0.f, 0.f}, ac1 = ac0, as0 = ac0, as1 = ac0;
#pragma unroll 4
            for (int ks = 0; ks < 32; ++ks) {
                const int g = 4 * ks + lq, m = (c * g) & 127;
                const float tc = tab[m], ts = tab[128 + m];
                const float b0 = Wt[g * WP + eh * 32 + lr], b1 = Wt[g * WP + eh * 32 + 16 + lr];
                ac0 = __builtin_amdgcn_mfma_f32_16x16x4f32(tc, b0, ac0, 0, 0, 0); ac1 = __builtin_amdgcn_mfma_f32_16x16x4f32(tc, b1, ac1, 0, 0, 0);
                as0 = __builtin_amdgcn_mfma_f32_16x16x4f32(ts, b0, as0, 0, 0, 0); as1 = __builtin_amdgcn_mfma_f32_16x16x4f32(ts, b1, as1, 0, 0, 0);
            }
            bf16_t* d0 = p.A1 + (size_t)j * 2048 * 1024 + (size_t)(et * 64 + eh * 32 + lr) * 1024 + ct * 64 + cb * 16 + 4 * lq;
            *(uint2*)d0 = make_uint2(pack2(ac0[0], ac0[1]), pack2(ac0[2], ac0[3]));
            *(uint2*)(d0 + (size_t)16 * 1024) = make_uint2(pack2(ac1[0], ac1[1]), pack2(ac1[2], ac1[3]));
            *(uint2*)(d0 + (size_t)1024 * 1024) = make_uint2(pack2(as0[0], as0[1]), pack2(as0[2], as0[3]));
            *(uint2*)(d0 + (size_t)(1024 + 16) * 1024) = make_uint2(pack2(as1[0], as1[1]), pack2(as1[2], as1[3]));
        }
        __syncthreads();
    }
    for (int i = gtid; i < 256 * 256; i += gsz) {
        const int m = i >> 8, k = i & 255, f1 = m & 127, t1 = k & 127; const float a = (float)((f1 * t1) & 127) * (1.f / 64.f); const float cs = cospif(a), sn = sinpif(a);
        const float v = (m < 128) ? ((k < 128) ? cs : -sn) : ((k < 128) ? -sn : -cs);
        p.M1[i] = f2bf(v);
    }
    if (OPT < 12) for (int i = gtid; i < 2048 * 4096; i += gsz) {
        const int f = i >> 12, k = i & 4095, t = k & 2047, m = (f * t) & 2047; const float a = (float)m * (1.f / 1024.f);
        p.A2[i] = f2bf(((k < 2048) ? cospif(a) : -sinpif(a)) * (1.f / 512.f));
    }
    if (OPT < 12) for (int i = gtid; i < 256 * 512; i += gsz) {
        const int f = i >> 9, k = i & 511, t = k & 255, m = (f * t) & 255; const float a = (float)m * (1.f / 128.f);
        p.A2c[i] = f2bf(((k < 256) ? cospif(a) : -sinpif(a)) * 0.0055242717280199f);
    }
    __syncthreads();
}
DI void ph_prep_moe(const Ctx& cx, const Params& p, float* lds, int layer) {
    const int tid = cx.tid; constexpr int TP = 513;
    for (int s = cx.bid; s < 17 * 48; s += cx.nblk) {
        const int e = s / 48, r = s % 48;
        const float* src; int ld_src, kt, ldd; bf16_t* dst; int bj = 0, nh = 0; const bool gu = r < 32;
        if (gu) { bj = r >> 4; kt = r & 15; ld_src = 512; ldd = 1024;
            src = (bj ? ((e < 16) ? p.moe_w_up + ((size_t)layer * 16 + e) * 1024 * 512 : p.sh_up + (size_t)layer * 1024 * 512)
                      : ((e < 16) ? p.moe_w_gate + ((size_t)layer * 16 + e) * 1024 * 512 : p.sh_gate + (size_t)layer * 1024 * 512)) + (size_t)kt * 64 * 512;
            dst = p.WguT + (size_t)e * 1024 * 1024; }
        else { const int r2 = r - 32; kt = r2 >> 1; nh = r2 & 1; ld_src = 1024; ldd = 512;
            src = ((e < 16) ? p.moe_w_down + ((size_t)layer * 16 + e) * 512 * 1024 : p.sh_down + (size_t)layer * 512 * 1024) + (size_t)kt * 64 * 1024 + nh * 512;
            dst = p.WdT + (size_t)e * 1024 * 512; }
        float4 v[16];
#pragma unroll
        for (int i = 0; i < 16; ++i) v[i] = *(const float4*)(src + (size_t)((tid >> 7) + 4 * i) * ld_src + (tid & 127) * 4);
        __syncthreads();
#pragma unroll
        for (int i = 0; i < 16; ++i) { float* t = lds + ((tid >> 7) + 4 * i) * TP + (tid & 127) * 4; t[0] = v[i].x; t[1] = v[i].y; t[2] = v[i].z; t[3] = v[i].w; }
        __syncthreads();
#pragma unroll
        for (int it = 0; it < 8; ++it) {
            const int n = (tid >> 3) + 64 * it, ch = tid & 7; const float* t = lds + (ch * 8) * TP + n;
            uint4 o; o.x = att_pk(t[0], t[TP]); o.y = att_pk(t[2 * TP], t[3 * TP]); o.z = att_pk(t[4 * TP], t[5 * TP]); o.w = att_pk(t[6 * TP], t[7 * TP]);
            const int drow = gu ? ((n >> 7) * 256 + bj * 128 + (n & 127)) : (nh * 512 + n);
            *(uint4*)(dst + (size_t)drow * ldd + kt * 64 + ch * 8) = o;
        }
    }
    __syncthreads();
}

#define GEMM_LDS(lds) ((LAS unsigned char*)(lds))
DI void ph_win_mm(const Ctx& cx, const Params& p, float* lds, int j) {
    mm::StaticSched S; S.init(p.H, p.WinT + (size_t)j * 2560 * 1024, NT, 2560, 1024, 1024, cx.nblk, cx.bid);
    mm::EpiBf16Store E{p.P, PLD};
    mm::gemm_phase(GEMM_LDS(lds), 1024, S, E, cx.tid);
}
struct EpiNone { static constexpr bool PERM = true; DI void operator()(const mm::f32x4 (&acc)[2][2][4][2], const mm::Unit&, int, int, int, int) const {
#pragma unroll
    for (int ai = 0; ai < 2; ++ai)
#pragma unroll
        for (int bj = 0; bj < 2; ++bj)
#pragma unroll
            for (int m = 0; m < 4; ++m) asm volatile("" :: "v"(acc[ai][bj][m][0]), "v"(acc[ai][bj][m][1]));
} };
DI void ph_win_probe(const Ctx& cx, const Params& p, float* lds, int j) {
    mm::StaticSched S; S.init(p.H, p.WinT + (size_t)j * 2560 * 1024, NT, 2560, 1024, 1024, cx.nblk, cx.bid);
    if (PROBE_GEMM == 1) { mm::EpiBf16Store E{p.WAG, PLD}; mm::gemm_phase(GEMM_LDS(lds), 1024, S, E, cx.tid); }
    else { EpiNone E; mm::gemm_phase(GEMM_LDS(lds), 1024, S, E, cx.tid); }
}
DI void ph_wout_mmB(const Ctx& cx, const Params& p, float* lds, const bf16_t* A, const bf16_t* Bt, int nrows, const void* xin_lat, const void* xin_ctx, bf16_t* xo_lat, int in_f32, const float* modl) {
    mm::StaticSched S; S.init(A, Bt, nrows, 1024, 1024, 1024, cx.nblk, cx.bid);
    mm::EpiResidB E{xin_lat, xin_ctx, xo_lat, p.cs, modl, 0, in_f32};
    mm::gemm_phase(GEMM_LDS(lds), 1024, S, E, cx.tid);
}
DI void ph_wout_mm(const Ctx& cx, const Params& p, float* lds, const bf16_t* A, const bf16_t* Bt, int nrows, const float* xin_lat, const float* xin_ctx, const float* modl) {
    mm::StaticSched S; S.init(A, Bt, nrows, 1024, 1024, 1024, cx.nblk, cx.bid);
    mm::EpiResid E{xin_lat, xin_ctx, p.out, p.ctxs, modl, 0};
    mm::gemm_phase(GEMM_LDS(lds), 1024, S, E, cx.tid);
}

DI void ph_qkvup_mm(const Ctx& cx, const Params& p, float* lds, int j, int mq) {
    { mm::StaticSched S; S.init(p.QN, p.WqT + (size_t)j * 768 * 256, mq, 768, 256, 512, cx.nblk, cx.bid); mm::EpiBf16Store E{p.Qraw, 768}; mm::gemm_phase(GEMM_LDS(lds), 256, S, E, cx.tid); }
    { mm::StaticSched S; S.init(p.QN + 256, p.WkvT + (size_t)j * 1024 * 256, NT, 1024, 256, 512, cx.nblk, cx.bid); mm::EpiBf16Store E{p.KVraw, 1024}; mm::gemm_phase(GEMM_LDS(lds), 256, S, E, cx.tid); }
}
struct EpiWag {
    static constexpr bool PERM = true;
    bf16_t* O; const LAS float* bias;
    DI void operator()(const mm::f32x4 (&acc)[2][2][4][2], const mm::Unit& u, int wr, int wc, int fr, int fq) const {
        const int row0 = u.pm * 256 + wr * 64 + fr, col0 = u.pn * 256 + wc * 32 + 8 * fq; const int seg = u.pn >> 2;
        const LAS float* bp = bias + col0;
#pragma unroll
        for (int bj = 0; bj < 2; ++bj) {
            mm::f32x4 b0 = (mm::f32x4){0.f, 0.f, 0.f, 0.f}, b1 = b0;
            if (seg < 2) { b0 = *(const LAS mm::f32x4*)(bp + bj * 128); b1 = *(const LAS mm::f32x4*)(bp + bj * 128 + 4); }
#pragma unroll
            for (int ai = 0; ai < 2; ++ai)
#pragma unroll
                for (int m = 0; m < 4; ++m) {
                    mm::f32x4 v0 = acc[ai][bj][m][0] + b0, v1 = acc[ai][bj][m][1] + b1;
                    if (seg == 0) {
#pragma unroll
                        for (int c = 0; c < 4; ++c) { v0[c] = 1.f - __expf(-0.606531f * __builtin_amdgcn_rcpf(1.f + __expf(-v0[c]))); v1[c] = 1.f - __expf(-0.606531f * __builtin_amdgcn_rcpf(1.f + __expf(-v1[c]))); }
                    } else if (seg == 1) {
#pragma unroll
                        for (int c = 0; c < 4; ++c) { v0[c] = __builtin_amdgcn_rcpf(1.f + __expf(-v0[c])); v1[c] = __builtin_amdgcn_rcpf(1.f + __expf(-v1[c])); }
                    }
                    mm::u32x4 w; w.x = mm::cvt_pk_bf16(v0[0], v0[1]); w.y = mm::cvt_pk_bf16(v0[2], v0[3]); w.z = mm::cvt_pk_bf16(v1[0], v1[1]); w.w = mm::cvt_pk_bf16(v1[2], v1[3]);
                    *(mm::u32x4*)(O + (size_t)(row0 + ai * 128 + m * 16) * WLD + col0 + bj * 128) = w;
                }
        }
    }
};
DI void ph_wag_mm(const Ctx& cx, const Params& p, float* lds, int j) {
    mm::StaticSched S; S.init(p.LR, p.WlrT + (size_t)j * 2560 * 384, NT, 2560, 384, 384, cx.nblk, cx.bid);
    LAS float* bl = (LAS float*)lds + 32768 + 256 + 1024;
    for (int i = cx.tid; i < 2048; i += NTHR) bl[i] = (i < 1024) ? p.a_w0[j * 1024 + i] : p.a_a0[j * 1024 + i - 1024];
    __syncthreads();
    EpiWag E{p.WAG, bl};
    mm::gemm_phase(GEMM_LDS(lds), 384, S, E, cx.tid);
}
struct EpiZT {
    static constexpr bool PERM = true;
    bf16_t* Z; int T;
    DI void operator()(const mm::f32x4 (&acc)[2][2][4][2], const mm::Unit& u, int wr, int wc, int fr, int fq) const {
        const int b = (T == 2048) ? (u.pn >> 3) : u.pn, t0 = (T == 2048) ? ((u.pn & 7) * 256) : 0;
        const int m0 = u.pm * 256 + wr * 64 + fr; const int c0 = t0 + wc * 32 + 8 * fq;
#pragma unroll
        for (int ai = 0; ai < 2; ++ai)
#pragma unroll
            for (int m = 0; m < 4; ++m) { const int mr = m0 + ai * 128 + m * 16, part = mr >> 10, ch = mr & 1023;
                bf16_t* rowp = Z + ((size_t)(b * 1024 + ch) * 2 + part) * T + c0;
#pragma unroll
                for (int bj = 0; bj < 2; ++bj) { const mm::f32x4 v0 = acc[ai][bj][m][0], v1 = acc[ai][bj][m][1];
                    mm::u32x4 w; w.x = mm::cvt_pk_bf16(v0[0], v0[1]); w.y = mm::cvt_pk_bf16(v0[2], v0[3]); w.z = mm::cvt_pk_bf16(v1[0], v1[1]); w.w = mm::cvt_pk_bf16(v1[2], v1[3]);
                    *(mm::u32x4*)(rowp + bj * 128) = w; } }
    }
};
DI void ph_f1_mm(const Ctx& cx, const Params& p, float* lds, int j, bool with_ctx) {
    { mm::StaticSched S; S.init(p.A1 + (size_t)j * 2048 * 1024, p.H, 2048, NLAT, 1024, 1024, cx.nblk, cx.bid); EpiZT E{p.ZT, 2048}; mm::gemm_phase(GEMM_LDS(lds), 1024, S, E, cx.tid); }
    if (with_ctx) { mm::StaticSched S; S.init(p.A1 + (size_t)j * 2048 * 1024, p.H + (size_t)NLAT * 1024, 2048, NCTX, 1024, 1024, cx.nblk, cx.bid); EpiZT E{p.ZTC, 256}; mm::gemm_phase(GEMM_LDS(lds), 1024, S, E, cx.tid); }
}
DI void ph_f2_mmB(const Ctx& cx, const Params& p, float* lds, bool with_ctx, const void* xin_lat, const void* xin_ctx, bf16_t* xo_lat, const float* modl) {
    { mm::BatchSched S; S.init(p.A2, p.ZT, (size_t)1024 * 4096 * 2, 16, 2048, 1024, 4096, cx.nblk, cx.bid); mm::EpiResidB E{xin_lat, xin_ctx, xo_lat, p.cs, modl, 1, 0}; mm::gemm_phase(GEMM_LDS(lds), 4096, S, E, cx.tid); }
    if (with_ctx) { mm::BatchSched S; S.init(p.A2c, p.ZTC, (size_t)1024 * 512 * 2, 16, 256, 1024, 512, cx.nblk, cx.bid); mm::EpiResidB E{xin_lat, xin_ctx, xo_lat, p.cs, modl, -1, 0}; mm::gemm_phase(GEMM_LDS(lds), 512, S, E, cx.tid); }
}
DI void ph_f2_mm(const Ctx& cx, const Params& p, float* lds, bool with_ctx, const float* xin_lat, const float* xin_ctx, const float* modl) {
    { mm::BatchSched S; S.init(p.A2, p.ZT, (size_t)1024 * 4096 * 2, 16, 2048, 1024, 4096, cx.nblk, cx.bid); mm::EpiResid E{xin_lat, xin_ctx, p.out, p.ctxs, modl, 1}; mm::gemm_phase(GEMM_LDS(lds), 4096, S, E, cx.tid); }
    if (with_ctx) { mm::BatchSched S; S.init(p.A2c, p.ZTC, (size_t)1024 * 512 * 2, 16, 256, 1024, 512, cx.nblk, cx.bid); mm::EpiResid E{xin_lat, xin_ctx, p.out, p.ctxs, modl, -1}; mm::gemm_phase(GEMM_LDS(lds), 512, S, E, cx.tid); }
}
struct MoeSched {
    static constexpr bool GATHER = true, TABLE = true;
    const char* A; const char* Bt; const int* slot; const float* slotw; const int* tab; int lda, K, G, c, down;
    DI void tab_dma(const mm::Unit& u, LAS unsigned char* dst, int tid) const {
        const int Me = __builtin_amdgcn_readfirstlane(tab[32 + u.e]); const int r = tid & 255; int idx = u.m * 256 + r; idx = idx < Me ? idx : 0;
        const size_t off = (u.e < 16) ? (size_t)u.e * NT + idx : 0;
        const unsigned* src = (tid < 256) ? (const unsigned*)(slot + off) : (const unsigned*)(slotw + off);
        __builtin_amdgcn_global_load_lds(src, (LAS unsigned*)(dst + (tid >> 6) * 256), 4, 0, 0);
    }
    DI size_t hstep_a() const { return 0; }
    DI unsigned boff(int Rb, int C, int Kk) const { return (unsigned)(Rb * Kk + C) * 2u; }
    DI size_t hstep_b(int Kk) const { return (size_t)mm::HALF * Kk * 2; }
    DI bool next(int i, mm::Unit& u) const {
        const int L = i * G + c; const int total = __builtin_amdgcn_readfirstlane(tab[17]);
        if (L >= total * 4) return false;
        const int rtg = L >> 2; int e = 0;
        for (int q = 1; q < 17; ++q) e += (__builtin_amdgcn_readfirstlane(tab[q]) <= rtg) ? 1 : 0;
        u.e = e; u.m = rtg - __builtin_amdgcn_readfirstlane(tab[e]); u.pm = u.m; u.pn = L & 3;
        u.A = A; u.B = Bt + ((size_t)e * 1024 + (size_t)u.pn * 256) * K * 2; return true;
    }
    DI unsigned rowoff(const mm::Unit& u, int Me, int idx, int C) const {
        int row;
        if (u.e < 16) { const int s = (idx < Me) ? slot[(size_t)u.e * NT + idx] : 0; row = down ? ((s & 1) * NT + (s >> 1)) : (s >> 1); }
        else row = down ? (2 * NT + idx) : idx;
        return (unsigned)(row * lda + C) * 2u;
    }
    DI unsigned rowoff_s(const mm::Unit& u, int s, int r, int C) const { int row; if (u.e < 16) row = down ? ((s & 1) * NT + (s >> 1)) : (s >> 1); else row = down ? (2 * NT + u.m * 256 + r) : (u.m * 256 + r); return (unsigned)(row * lda + C) * 2u; }
    DI void aoff_lds(const mm::Unit& u, const LAS int* et, int R0, int C0, int R1, int C1, unsigned (&o)[2][2]) const {
        o[0][0] = rowoff_s(u, et[R0], R0, C0); o[0][1] = rowoff_s(u, et[R1], R1, C1); o[1][0] = rowoff_s(u, et[128 + R0], 128 + R0, C0); o[1][1] = rowoff_s(u, et[128 + R1], 128 + R1, C1);
    }
    DI void aoff(const mm::Unit& u, int R0, int C0, int R1, int C1, unsigned (&o)[2][2]) const {
        const int Me = __builtin_amdgcn_readfirstlane(tab[32 + u.e]), base = u.m * 256;
        o[0][0] = rowoff(u, Me, base + R0, C0); o[0][1] = rowoff(u, Me, base + R1, C1);
        o[1][0] = rowoff(u, Me, base + 128 + R0, C0); o[1][1] = rowoff(u, Me, base + 128 + R1, C1);
    }
};
DI void moe_table(const Ctx& cx, const Params& p, int* tab, int layer, int nrows) {
    if (cx.tid == 0) { int acc = 0;
        for (int e = 0; e < 17; ++e) { const int M = (e < 16) ? p.cnt[(layer * 16 + e) * 64] : nrows; tab[e] = acc; tab[32 + e] = M; acc += (M + 255) >> 8; }
        tab[17] = acc; }
    __syncthreads();
}
DI void lds_read8(const LAS int* base, int r0, int (&o)[8]) {
    const unsigned a = (unsigned)(size_t)(base + r0);
    asm volatile("ds_read_b32 %0, %8\n\tds_read_b32 %1, %8 offset:64\n\tds_read_b32 %2, %8 offset:128\n\tds_read_b32 %3, %8 offset:192\n\t"
                 "ds_read_b32 %4, %8 offset:512\n\tds_read_b32 %5, %8 offset:576\n\tds_read_b32 %6, %8 offset:640\n\tds_read_b32 %7, %8 offset:704\n\ts_waitcnt lgkmcnt(0)"
                 : "=&v"(o[0]), "=&v"(o[1]), "=&v"(o[2]), "=&v"(o[3]), "=&v"(o[4]), "=&v"(o[5]), "=&v"(o[6]), "=&v"(o[7]) : "v"(a) : "memory");
}
struct EpiSwiglu {
    static constexpr bool PERM = true;
    bf16_t* ACT; const int* slot; const int* tab; const LAS int* etab;
    DI void operator()(const mm::f32x4 (&acc)[2][2][4][2], const mm::Unit& u, int wr, int wc, int fr, int fq) const {
        const int Me = __builtin_amdgcn_readfirstlane(tab[32 + u.e]); const int col = u.pn * 128 + wc * 32 + 8 * fq; const LAS int* et = etab + u.tb * 512;
        int sl8[8]; lds_read8(et, wr * 64 + fr, sl8);
#pragma unroll
        for (int ai = 0; ai < 2; ++ai)
#pragma unroll
            for (int m = 0; m < 4; ++m) {
                const int idx = u.m * 256 + ai * 128 + wr * 64 + m * 16 + fr;
                if (idx < Me) {
                    int drow; if (u.e < 16) { const int s = sl8[ai * 4 + m]; drow = (s & 1) * NT + (s >> 1); } else drow = 2 * NT + idx;
                    float o[8];
#pragma unroll
                    for (int n = 0; n < 2; ++n)
#pragma unroll
                        for (int c = 0; c < 4; ++c) { const float g = acc[ai][0][m][n][c], uu = acc[ai][1][m][n][c]; o[n * 4 + c] = g * __builtin_amdgcn_rcpf(1.f + __expf(-g)) * uu; }
                    mm::u32x4 w; w.x = mm::cvt_pk_bf16(o[0], o[1]); w.y = mm::cvt_pk_bf16(o[2], o[3]); w.z = mm::cvt_pk_bf16(o[4], o[5]); w.w = mm::cvt_pk_bf16(o[6], o[7]);
                    *(mm::u32x4*)(ACT + (size_t)drow * 512 + col) = w;
                }
            }
    }
};
struct EpiDown {
    static constexpr bool PERM = true;
    bf16_t* Y; const int* slot; const float* tokw; const int* tab; const LAS int* etab;
    DI void operator()(const mm::f32x4 (&acc)[2][2][4][2], const mm::Unit& u, int wr, int wc, int fr, int fq) const {
        const int Me = __builtin_amdgcn_readfirstlane(tab[32 + u.e]); const int col = u.pn * 256 + wc * 32 + 8 * fq; const LAS int* et = etab + u.tb * 512;
        int sl8[8], sw8[8]; lds_read8(et, wr * 64 + fr, sl8); lds_read8(et + 256, wr * 64 + fr, sw8);
#pragma unroll
        for (int ai = 0; ai < 2; ++ai)
#pragma unroll
            for (int m = 0; m < 4; ++m) {
                const int idx = u.m * 256 + ai * 128 + wr * 64 + m * 16 + fr;
                if (idx < Me) {
                    int drow; float w = 1.f;
                    if (u.e < 16) { const int s = sl8[ai * 4 + m]; drow = (s & 1) * NT + (s >> 1); w = __int_as_float(sw8[ai * 4 + m]); } else drow = 2 * NT + idx;
#pragma unroll
                    for (int bj = 0; bj < 2; ++bj) { const mm::f32x4 v0 = acc[ai][bj][m][0] * w, v1 = acc[ai][bj][m][1] * w;
                        mm::u32x4 o; o.x = mm::cvt_pk_bf16(v0[0], v0[1]); o.y = mm::cvt_pk_bf16(v0[2], v0[3]); o.z = mm::cvt_pk_bf16(v1[0], v1[1]); o.w = mm::cvt_pk_bf16(v1[2], v1[3]);
                        *(mm::u32x4*)(Y + (size_t)drow * 1024 + col + bj * 128) = o; }
                }
            }
    }
};
DI void ph_moe_up_mm(const Ctx& cx, const Params& p, float* lds, int layer, int nrows) {
    int* tab = (int*)(lds + 32768); moe_table(cx, p, tab, layer, nrows);
    MoeSched S{(const char*)p.H, (const char*)p.WguT, p.slot, p.slotw, tab, 1024, 1024, cx.nblk, cx.bid, 0};
    EpiSwiglu E{p.ACT, p.slot, tab, (const LAS int*)((LAS float*)lds + 32768 + 256)};
    mm::gemm_phase(GEMM_LDS(lds), 1024, S, E, cx.tid);
}
DI void ph_moe_down_mm(const Ctx& cx, const Params& p, float* lds, int layer, int nrows) {
    int* tab = (int*)(lds + 32768); moe_table(cx, p, tab, layer, nrows);
    MoeSched S{(const char*)p.ACT, (const char*)p.WdT, p.slot, p.slotw, tab, 512, 512, cx.nblk, cx.bid, 1};
    EpiDown E{p.Y, p.slot, p.tokw, tab, (const LAS int*)((LAS float*)lds + 32768 + 256)};
    mm::gemm_phase(GEMM_LDS(lds), 512, S, E, cx.tid);
}

namespace att {
typedef short bf16x8 __attribute__((ext_vector_type(8)));
typedef float f32x16 __attribute__((ext_vector_type(16)));
typedef unsigned u32x4 __attribute__((ext_vector_type(4)));
typedef unsigned u32x2 __attribute__((ext_vector_type(2)));
typedef __bf16 bf16x2_t __attribute__((ext_vector_type(2)));
typedef float f32x2_t __attribute__((ext_vector_type(2)));
constexpr int KP = 208, VP = 264, KT_BYTES = 128 * KP, VT_BYTES = 64 * VP, BUF = KT_BYTES + VT_BYTES;
DI unsigned pk(float a, float b) { f32x2_t f = {a, b}; bf16x2_t h = __builtin_convertvector(f, bf16x2_t); return __builtin_bit_cast(unsigned, h); }
DI float xhalf_max(float x) { const auto r = __builtin_amdgcn_permlane32_swap(__builtin_bit_cast(unsigned, x), __builtin_bit_cast(unsigned, x), false, false); return fmaxf(__builtin_bit_cast(float, r[0]), __builtin_bit_cast(float, r[1])); }
DI float xhalf_sum(float x) { const auto r = __builtin_amdgcn_permlane32_swap(__builtin_bit_cast(unsigned, x), __builtin_bit_cast(unsigned, x), false, false); return __builtin_bit_cast(float, r[0]) + __builtin_bit_cast(float, r[1]); }
#define ATT_MFMA(a, b, c) __builtin_amdgcn_mfma_f32_32x32x16_bf16((a), (b), (c), 0, 0, 0)
struct TileSt { f32x16 s[2]; u32x4 pk[2][2]; bf16x8 kf[6]; };
template<int J> DI void tile_iter(TileSt& T, const bf16x8 (&qf)[6], f32x16& ot0, f32x16& ot1, float& a, float& b, const LAS unsigned char* kbp, const LAS unsigned char* vbp) {
    constexpr bool HA = J < 3, HB = (J >= 0 && J <= 3), HC = J > 0, PF = J < 2;
    constexpr int C = J & 1, N = (J + 1) & 1, KPV = (J > 0) ? J - 1 : 0;
    u32x2 vf[4][2];
#pragma unroll
    for (int g = 0; g < 6; ++g) {
        if constexpr (HA) {
            if (g == 0) { f32x16 z;
#pragma unroll
                for (int i = 0; i < 16; ++i) z[i] = 0.f;
                T.s[N] = ATT_MFMA(T.kf[0], qf[0], z); }
            else T.s[N] = ATT_MFMA(T.kf[g], qf[g], T.s[N]);
        }
        if constexpr (HB) {
            const int i0 = g < 4 ? 3 * g : 12 + 2 * (g - 4), n = g < 4 ? 3 : 2;
#pragma unroll
            for (int i = i0; i < i0 + n; ++i) { const float e = __builtin_amdgcn_exp2f(T.s[C][i]); T.s[C][i] = e; if (i & 1) b += e; else a += e; }
        }
        if constexpr (HA && PF) T.kf[g] = *(const LAS bf16x8*)(kbp + (J + 2) * 32 * KP + 32 * g);
        if constexpr (HC) { if (g >= 2) { const int q = g - 2, sv = q >> 1, hf = q & 1;
            vf[q][0] = *(const LAS u32x2*)(vbp + hf * 32 * VP + KPV * 64 + 32 * sv); vf[q][1] = *(const LAS u32x2*)(vbp + hf * 32 * VP + KPV * 64 + 32 * sv + 16); } }
        __builtin_amdgcn_sched_barrier(0);
    }
#pragma unroll
    for (int g = 0; g < 4; ++g) {
        if constexpr (HC) { const u32x4 vv = {vf[g][0].x, vf[g][0].y, vf[g][1].x, vf[g][1].y}; const bf16x8 pb = __builtin_bit_cast(bf16x8, T.pk[C ^ 1][g >> 1]);
            if (g & 1) ot1 = ATT_MFMA(__builtin_bit_cast(bf16x8, vv), pb, ot1); else ot0 = ATT_MFMA(__builtin_bit_cast(bf16x8, vv), pb, ot0); }
        if constexpr (HB) { const int base = 8 * (g >> 1) + 4 * (g & 1); const unsigned w0 = pk(T.s[C][base], T.s[C][base + 1]), w1 = pk(T.s[C][base + 2], T.s[C][base + 3]);
            if (g & 1) { T.pk[C][g >> 1].z = w0; T.pk[C][g >> 1].w = w1; } else { T.pk[C][g >> 1].x = w0; T.pk[C][g >> 1].y = w1; } }
        __builtin_amdgcn_sched_barrier(0);
    }
}
}
DI void ph_attn_mm(const Ctx& cx, const Params& p, float* ldsf, bool with_ctx) {
    using namespace att;
    LAS unsigned char* lds = (LAS unsigned char*)ldsf;
    const int tid = cx.tid, wid = __builtin_amdgcn_readfirstlane(tid >> 6), lane = tid & 63, r = lane & 31, hh = lane >> 5;
    const int nunits = 1024 + (with_ctx ? 128 : 0);
    for (int u0 = cx.bid; u0 < nunits; u0 += cx.nblk) {
        int u = u0;
        if (u0 < 1024 && cx.nblk == 256) { const int k = u0 >> 8, x = u0 & 7, l = (u0 & 255) >> 3; u = (((k * 8 + x) * 4 + (l >> 3)) << 3) + (l & 7); }
        int tz = tid; asm volatile("" : "+v"(tz));
        int kg[3], kl[3], vg[2], vl[2];
#pragma unroll
        for (int i = 0; i < 3; ++i) { const int c = tz + 512 * i, row = c / 12, part = c % 12; kg[i] = row * 96 + part * 8; kl[i] = row * KP + part * 16; }
#pragma unroll
        for (int i = 0; i < 2; ++i) { const int c = tz + 512 * i, row = c >> 4, part = c & 15; vg[i] = row * 2304 + part * 8; vl[i] = KT_BYTES + row * VP + part * 16; }
        int bh, qrow0, nkeys;
        if (u < 1024) { bh = u >> 3; qrow0 = (bh >> 3) * 2048 + (u & 7) * 256; nkeys = 2304; }
        else { bh = u - 1024; qrow0 = NLAT + (bh >> 3) * 256; nkeys = 256; }
        const int h = bh & 7;
        const bf16_t* Kb = p.Kf + (size_t)bh * 2304 * 96; const bf16_t* Vb = p.Vt + (size_t)bh * 64 * 2304;
        const bf16_t* qp = p.Qraw + (size_t)(qrow0 + (tz >> 6) * 32 + (tz & 31)) * 768 + h * 96 + 8 * ((tz >> 5) & 1);
        bf16x8 qf[6];
#pragma unroll
        for (int s = 0; s < 6; ++s) qf[s] = *(const bf16x8*)(qp + 16 * s);
        f32x16 ot0, ot1;
#pragma unroll
        for (int i = 0; i < 16; ++i) { ot0[i] = 0.f; ot1[i] = 0.f; }
        float lrun = 0.f, lrun1 = 0.f;
        const int ntiles = nkeys >> 7;
        u32x4 kr[3], vr[2];
#pragma unroll
        for (int i = 0; i < 3; ++i) kr[i] = *(const u32x4*)(Kb + kg[i]);
#pragma unroll
        for (int i = 0; i < 2; ++i) vr[i] = *(const u32x4*)(Vb + vg[i]);
#pragma unroll
        for (int i = 0; i < 3; ++i) *(LAS u32x4*)(lds + kl[i]) = kr[i];
#pragma unroll
        for (int i = 0; i < 2; ++i) { *(LAS u32x2*)(lds + vl[i]) = (u32x2){vr[i].x, vr[i].y}; *(LAS u32x2*)(lds + vl[i] + 8) = (u32x2){vr[i].z, vr[i].w}; }
        __syncthreads();
        for (int it = 0; it < ntiles; ++it) {
            const int bo = (it & 1) * BUF, bn = ((it + 1) & 1) * BUF;
            const bool more = (it + 1 < ntiles);
            if (more) {
                const bf16_t* Kn = Kb + (size_t)(it + 1) * 128 * 96; const bf16_t* Vn = Vb + (it + 1) * 128;
#pragma unroll
                for (int i = 0; i < 3; ++i) kr[i] = *(const u32x4*)(Kn + kg[i]);
#pragma unroll
                for (int i = 0; i < 2; ++i) vr[i] = *(const u32x4*)(Vn + vg[i]);
            }
            { const LAS unsigned char* kbp = lds + bo + r * KP + 16 * hh; const LAS unsigned char* vbp = lds + bo + KT_BYTES + r * VP + 8 * hh;
                TileSt T;
#pragma unroll
                for (int s = 0; s < 6; ++s) T.kf[s] = *(const LAS bf16x8*)(kbp + 32 * s);
                tile_iter<-1>(T, qf, ot0, ot1, lrun, lrun1, kbp, vbp); tile_iter<0>(T, qf, ot0, ot1, lrun, lrun1, kbp, vbp); tile_iter<1>(T, qf, ot0, ot1, lrun, lrun1, kbp, vbp);
                tile_iter<2>(T, qf, ot0, ot1, lrun, lrun1, kbp, vbp); tile_iter<3>(T, qf, ot0, ot1, lrun, lrun1, kbp, vbp); tile_iter<4>(T, qf, ot0, ot1, lrun, lrun1, kbp, vbp); }
            if (more) {
#pragma unroll
                for (int i = 0; i < 3; ++i) *(LAS u32x4*)(lds + bn + kl[i]) = kr[i];
#pragma unroll
                for (int i = 0; i < 2; ++i) { *(LAS u32x2*)(lds + bn + vl[i]) = (u32x2){vr[i].x, vr[i].y}; *(LAS u32x2*)(lds + bn + vl[i] + 8) = (u32x2){vr[i].z, vr[i].w}; }
            }
            __syncthreads();
        }
        const float il = 1.f / xhalf_sum(lrun + lrun1);
        int t2 = tid; asm volatile("" : "+v"(t2));
        bf16_t* op = p.H + (size_t)(qrow0 + (t2 >> 6) * 32 + (t2 & 31)) * 1024 + 512 + h * 64 + 4 * ((t2 >> 5) & 1);
#pragma unroll
        for (int g = 0; g < 4; ++g) {
            u32x2 w0 = {pk(ot0[4 * g] * il, ot0[4 * g + 1] * il), pk(ot0[4 * g + 2] * il, ot0[4 * g + 3] * il)};
            u32x2 w1 = {pk(ot1[4 * g] * il, ot1[4 * g + 1] * il), pk(ot1[4 * g + 2] * il, ot1[4 * g + 3] * il)};
            *(u32x2*)(op + 8 * g) = w0; *(u32x2*)(op + 32 + 8 * g) = w1;
        }
    }
}

DI void ph_attn_mm_stag(const Ctx& cx, const Params& p, float* ldsf, bool with_ctx) {
    using namespace att;
    LAS unsigned char* lds = (LAS unsigned char*)ldsf;
    const int tid = cx.tid, wid = __builtin_amdgcn_readfirstlane(tid >> 6), lane = tid & 63, r = lane & 31, hh = lane >> 5, G = wid >> 2;
    const int nunits = 1024 + (with_ctx ? 128 : 0);
    int kg[3], kl[3], vg[2], vl[2];
#pragma unroll
    for (int i = 0; i < 3; ++i) { const int c = tid + 512 * i, row = c / 12, part = c % 12; kg[i] = row * 96 + part * 8; kl[i] = row * KP + part * 16; }
#pragma unroll
    for (int i = 0; i < 2; ++i) { const int c = tid + 512 * i, row = c >> 4, part = c & 15; vg[i] = row * 2304 + part * 8; vl[i] = KT_BYTES + row * VP + part * 16; }
    for (int u = cx.bid; u < nunits; u += cx.nblk) {
        int bh, qrow0, nkeys;
        if (u < 1024) { bh = u >> 3; qrow0 = (bh >> 3) * 2048 + (u & 7) * 256; nkeys = 2304; }
        else { bh = u - 1024; qrow0 = NLAT + (bh >> 3) * 256; nkeys = 256; }
        const int h = bh & 7;
        const bf16_t* Kb = p.Kf + (size_t)bh * 2304 * 96; const bf16_t* Vb = p.Vt + (size_t)bh * 64 * 2304;
        const bf16_t* qp = p.Qraw + (size_t)(qrow0 + wid * 32 + r) * 768 + h * 96 + 8 * hh;
        bf16x8 qf[6];
#pragma unroll
        for (int s = 0; s < 6; ++s) qf[s] = *(const bf16x8*)(qp + 16 * s);
        f32x16 ot0, ot1;
#pragma unroll
        for (int i = 0; i < 16; ++i) { ot0[i] = 0.f; ot1[i] = 0.f; }
        float mrun = -3.0e38f, lrun = 0.f;
        const int ntiles = nkeys >> 7;
        u32x4 kr[3], vr[2];
#define ATT_LOAD(t) do { const bf16_t* Kn = Kb + (size_t)(t) * 128 * 96; const bf16_t* Vn = Vb + (t) * 128; \
            _Pragma("unroll") for (int i = 0; i < 3; ++i) kr[i] = *(const u32x4*)(Kn + kg[i]); _Pragma("unroll") for (int i = 0; i < 2; ++i) vr[i] = *(const u32x4*)(Vn + vg[i]); } while (0)
#define ATT_WRITE(bufo) do { _Pragma("unroll") for (int i = 0; i < 3; ++i) *(LAS u32x4*)(lds + (bufo) + kl[i]) = kr[i]; \
            _Pragma("unroll") for (int i = 0; i < 2; ++i) { *(LAS u32x2*)(lds + (bufo) + vl[i]) = (u32x2){vr[i].x, vr[i].y}; *(LAS u32x2*)(lds + (bufo) + vl[i] + 8) = (u32x2){vr[i].z, vr[i].w}; } } while (0)
        ATT_LOAD(0); ATT_WRITE(0);
        ATT_LOAD(1); ATT_WRITE(BUF);
        __syncthreads();
        f32x16 st[4];
        for (int ph = 0; ph <= 2 * ntiles; ++ph) {
            if (ph & 1) {
                const int tw = (ph + 1) >> 1;
                if (tw >= 2 && tw < ntiles) ATT_WRITE((tw & 1) * BUF);
                if (tw + 1 < ntiles) ATT_LOAD(tw + 1);
            }
            const int e = ph - G;
            if (e >= 0 && e < 2 * ntiles) {
                const int bo = ((e >> 1) & 1) * BUF;
                if ((e & 1) == 0) {
#pragma unroll
                    for (int kb = 0; kb < 4; ++kb) {
#pragma unroll
                        for (int i = 0; i < 16; ++i) st[kb][i] = 0.f;
#pragma unroll
                        for (int s = 0; s < 6; ++s) { const bf16x8 kf = *(const LAS bf16x8*)(lds + bo + (kb * 32 + r) * KP + 32 * s + 16 * hh); st[kb] = ATT_MFMA(kf, qf[s], st[kb]); }
                    }
                    float mq[4];
#pragma unroll
                    for (int kb = 0; kb < 4; ++kb) { float a = fmaxf(st[kb][0], st[kb][1]), b = fmaxf(st[kb][2], st[kb][3]), c2 = fmaxf(st[kb][4], st[kb][5]), d = fmaxf(st[kb][6], st[kb][7]);
                        a = fmaxf(a, fmaxf(st[kb][8], st[kb][9])); b = fmaxf(b, fmaxf(st[kb][10], st[kb][11])); c2 = fmaxf(c2, fmaxf(st[kb][12], st[kb][13])); d = fmaxf(d, fmaxf(st[kb][14], st[kb][15]));
                        mq[kb] = fmaxf(fmaxf(a, b), fmaxf(c2, d)); }
                    float mt = fmaxf(fmaxf(mq[0], mq[1]), fmaxf(mq[2], mq[3]));
                    mt = xhalf_max(mt);
                    const float mnew = fmaxf(mrun, mt), alpha = __builtin_amdgcn_exp2f(mrun - mnew);
                    mrun = mnew;
                    float pq[4];
#pragma unroll
                    for (int kb = 0; kb < 4; ++kb) { float a = 0.f, b = 0.f;
#pragma unroll
                        for (int i = 0; i < 16; i += 2) { st[kb][i] = __builtin_amdgcn_exp2f(st[kb][i] - mnew); st[kb][i + 1] = __builtin_amdgcn_exp2f(st[kb][i + 1] - mnew); a += st[kb][i]; b += st[kb][i + 1]; }
                        pq[kb] = a + b; }
                    lrun = lrun * alpha + ((pq[0] + pq[1]) + (pq[2] + pq[3]));
#pragma unroll
                    for (int i = 0; i < 16; ++i) { ot0[i] *= alpha; ot1[i] *= alpha; }
                } else {
#pragma unroll
                    for (int kb = 0; kb < 4; ++kb)
#pragma unroll
                        for (int s = 0; s < 2; ++s) {
                            u32x4 pw; pw.x = pk(st[kb][8 * s], st[kb][8 * s + 1]); pw.y = pk(st[kb][8 * s + 2], st[kb][8 * s + 3]); pw.z = pk(st[kb][8 * s + 4], st[kb][8 * s + 5]); pw.w = pk(st[kb][8 * s + 6], st[kb][8 * s + 7]);
                            const bf16x8 pb = __builtin_bit_cast(bf16x8, pw);
                            const int col = (kb * 32 + 16 * s + 4 * hh) * 2;
                            const u32x2 a0 = *(const LAS u32x2*)(lds + bo + KT_BYTES + r * VP + col), a1 = *(const LAS u32x2*)(lds + bo + KT_BYTES + r * VP + col + 16);
                            const u32x2 b0 = *(const LAS u32x2*)(lds + bo + KT_BYTES + (32 + r) * VP + col), b1 = *(const LAS u32x2*)(lds + bo + KT_BYTES + (32 + r) * VP + col + 16);
                            const u32x4 va = {a0.x, a0.y, a1.x, a1.y}, vb = {b0.x, b0.y, b1.x, b1.y};
                            ot0 = ATT_MFMA(__builtin_bit_cast(bf16x8, va), pb, ot0);
                            ot1 = ATT_MFMA(__builtin_bit_cast(bf16x8, vb), pb, ot1);
                        }
                }
            }
            __syncthreads();
        }
#undef ATT_LOAD
#undef ATT_WRITE
        const float il = 1.f / xhalf_sum(lrun);
        bf16_t* op = p.H + (size_t)(qrow0 + wid * 32 + r) * 1024 + 512 + h * 64 + 4 * hh;
#pragma unroll
        for (int g = 0; g < 4; ++g) {
            u32x2 w0 = {pk(ot0[4 * g] * il, ot0[4 * g + 1] * il), pk(ot0[4 * g + 2] * il, ot0[4 * g + 3] * il)};
            u32x2 w1 = {pk(ot1[4 * g] * il, ot1[4 * g + 1] * il), pk(ot1[4 * g + 2] * il, ot1[4 * g + 3] * il)};
            *(u32x2*)(op + 8 * g) = w0; *(u32x2*)(op + 32 + 8 * g) = w1;
        }
    }
}

namespace scan {
typedef float f32x2 __attribute__((ext_vector_type(2)));
constexpr int REC = 400, CH = 32, BUFF = CH * REC, YOFF = 2 * BUFF;
DI float dppf(float v, int ctrl_sel) {
    const int x = __builtin_bit_cast(int, v);
    int r;
    if (ctrl_sel == 0) r = __builtin_amdgcn_update_dpp(0, x, 0xB1, 0xf, 0xf, true);
    else if (ctrl_sel == 1) r = __builtin_amdgcn_update_dpp(0, x, 0x4E, 0xf, 0xf, true);
    else r = __builtin_amdgcn_update_dpp(0, x, 0x141, 0xf, 0xf, true);
    return __builtin_bit_cast(float, r);
}
DI float red8(float v) { v += dppf(v, 0); v += dppf(v, 1); v += dppf(v, 2); return v; }
}
template <int ABL>
DI void ph_scan_opt(const Ctx& cx, const Params& p, float* lds, int j) {
    using namespace scan;
    const int tid = cx.tid, wid = __builtin_amdgcn_readfirstlane(tid >> 6), lane = tid & 63;
    for (int item = cx.bid; item < 256; item += cx.nblk) {
        const int b = item >> 4, h = (item >> 1) & 7, dir = item & 1;
        bf16_t* yout = dir ? p.YB : p.YF;
        if (wid >= 4) {
            const int pw = wid - 4, hc = h * 64 + lane;
            const float kkc = p.a_k_k[j * 512 + hc], kac = p.a_k_a[j * 512 + hc];
            const float mur = p.a_mu[j * ACOLS + hc], muk = p.a_mu[j * ACOLS + 512 + hc], muv = p.a_mu[j * ACOLS + 1024 + hc];
            LAS float* L = (LAS float*)lds;
            bf16_t raw[8][11];
#define SCAN_ROW(stepv, row_, t_, T_) const bool cp_ = (stepv) < 256; const int tt_ = cp_ ? (stepv) : (stepv) - 256, T_ = cp_ ? 256 : 2048, t_ = dir ? (T_ - 1 - tt_) : tt_; const int row_ = cp_ ? NLAT + b * 256 + t_ : b * 2048 + t_
#define SCAN_LOAD(cc) do { _Pragma("unroll") for (int it = 0; it < 8; ++it) { const int step = (cc) * CH + pw + 4 * it; SCAN_ROW(step, row, t, T); \
                const int rp_ = (t > 0) ? row - 1 : row, rn_ = (t < T - 1) ? row + 1 : row; \
                const bf16_t* pc = p.P + (size_t)row * PLD + hc; const bf16_t* pp = p.P + (size_t)rp_ * PLD + hc; const bf16_t* pn = p.P + (size_t)rn_ * PLD + hc; \
                raw[it][0] = pc[0]; raw[it][1] = pp[0]; raw[it][2] = pn[0]; raw[it][3] = pc[512]; raw[it][4] = pp[512]; raw[it][5] = pn[512]; raw[it][6] = pc[1024]; raw[it][7] = pp[1024]; raw[it][8] = pn[1024]; \
                raw[it][9] = p.WAG[(size_t)row * WLD + dir * 512 + hc]; raw[it][10] = p.WAG[(size_t)row * WLD + 1024 + dir * 512 + hc]; } } while (0)
            if (ABL != 1) SCAN_LOAD(0);
            for (int c = 0; c <= 73; ++c) {
                if (c >= 2 && ABL == 0) {
                    const LAS float* yb = L + YOFF + ((c - 2) & 1) * (CH * 64);
#pragma unroll
                    for (int it = 0; it < 8; ++it) {
                        const int sl = pw + 4 * it, step = (c - 2) * CH + sl; SCAN_ROW(step, row, t, T);
                        yout[(size_t)row * 512 + hc] = f2bf(yb[sl * 64 + lane]);
                    }
                }
                if (c < 72 && ABL != 1) {
                    LAS float* buf = L + (c & 1) * BUFF;
#pragma unroll
                    for (int it = 0; it < 8; ++it) {
                        const int sl = pw + 4 * it, step = c * CH + sl; SCAN_ROW(step, row, t, T); (void)row;
                        const float mp = (t > 0) ? 0.5f : 0.f, mn = (t < T - 1) ? 0.5f : 0.f;
                        const float rc = bf2f(raw[it][0]), kc_ = bf2f(raw[it][3]), vc = bf2f(raw[it][6]);
                        const float R = rc + mur * (mp * bf2f(raw[it][1]) + mn * bf2f(raw[it][2]) - rc);
                        const float K = kc_ + muk * (mp * bf2f(raw[it][4]) + mn * bf2f(raw[it][5]) - kc_);
                        const float V = vc + muv * (mp * bf2f(raw[it][7]) + mn * bf2f(raw[it][8]) - vc);
                        const float w = 1.f - bf2f(raw[it][9]), a = bf2f(raw[it][10]);
                        const float kkv = K * kkc, ssq = wave_sum(kkv * kkv), kk = kkv * rsqrtf(ssq + 1e-12f);
                        const float kd = K * (1.f + (a - 1.f) * kac), bd = kk * a;
                        const float br = wave_sum(bd * R), kr = wave_sum(kd * R);
                        LAS float* rec = buf + sl * REC;
                        rec[lane] = w; rec[64 + lane] = -kk; rec[128 + lane] = bd; rec[192 + lane] = kd; rec[256 + lane] = w * R; rec[320 + lane] = V;
                        if (lane == 0) { rec[384] = br; rec[385] = kr; }
                    }
                    if (c + 1 < 72) SCAN_LOAD(c + 1);
                }
                __syncthreads();
            }
#undef SCAN_LOAD
#undef SCAN_ROW
        } else {
            const int ct = tid, rp = ct >> 3, k8 = ct & 7;
            float S0[8], S1[8];
#pragma unroll
            for (int q = 0; q < 8; ++q) { S0[q] = 0.f; S1[q] = 0.f; }
            __syncthreads();
            for (int c = 0; c < 72; ++c) {
                const LAS float* buf = (const LAS float*)lds + (c & 1) * BUFF; LAS float* yb = (LAS float*)lds + YOFF + (c & 1) * (CH * 64);
                mm::f32x4 cw0, cw1, cn0, cn1, cb0, cb1, cd0, cd1, cr0, cr1; scan::f32x2 cvv, csc;
#define SCAN_LD(recp, W0, W1, N0, N1, B0, B1, D0, D1, R0_, R1_, VV, SC) do { const LAS float* r_ = (recp); \
                    W0 = *(const LAS mm::f32x4*)(r_ + k8 * 8); W1 = *(const LAS mm::f32x4*)(r_ + k8 * 8 + 4); N0 = *(const LAS mm::f32x4*)(r_ + 64 + k8 * 8); N1 = *(const LAS mm::f32x4*)(r_ + 64 + k8 * 8 + 4); \
                    B0 = *(const LAS mm::f32x4*)(r_ + 128 + k8 * 8); B1 = *(const LAS mm::f32x4*)(r_ + 128 + k8 * 8 + 4); D0 = *(const LAS mm::f32x4*)(r_ + 192 + k8 * 8); D1 = *(const LAS mm::f32x4*)(r_ + 192 + k8 * 8 + 4); \
                    R0_ = *(const LAS mm::f32x4*)(r_ + 256 + k8 * 8); R1_ = *(const LAS mm::f32x4*)(r_ + 256 + k8 * 8 + 4); VV = *(const LAS scan::f32x2*)(r_ + 320 + 2 * rp); SC = *(const LAS scan::f32x2*)(r_ + 384); } while (0)
                SCAN_LD(buf, cw0, cw1, cn0, cn1, cb0, cb1, cd0, cd1, cr0, cr1, cvv, csc);
#pragma unroll 2
                for (int sl = 0; sl < (ABL == 2 ? 0 : CH); ++sl) {
                    mm::f32x4 nw0, nw1, nn0, nn1, nb0, nb1, nd0, nd1, nr0, nr1; scan::f32x2 nvv, nsc;
                    SCAN_LD(buf + (sl + 1 < CH ? sl + 1 : sl) * REC, nw0, nw1, nn0, nn1, nb0, nb1, nd0, nd1, nr0, nr1, nvv, nsc);
                    const float wv[8] = {cw0[0], cw0[1], cw0[2], cw0[3], cw1[0], cw1[1], cw1[2], cw1[3]}, nv[8] = {cn0[0], cn0[1], cn0[2], cn0[3], cn1[0], cn1[1], cn1[2], cn1[3]};
                    const float bv[8] = {cb0[0], cb0[1], cb0[2], cb0[3], cb1[0], cb1[1], cb1[2], cb1[3]}, dv[8] = {cd0[0], cd0[1], cd0[2], cd0[3], cd1[0], cd1[1], cd1[2], cd1[3]};
                    const float rv[8] = {cr0[0], cr0[1], cr0[2], cr0[3], cr1[0], cr1[1], cr1[2], cr1[3]};
                    float sa0 = 0.f, sa1 = 0.f, y0 = 0.f, y1 = 0.f;
#pragma unroll
                    for (int q = 0; q < 8; ++q) { sa0 += S0[q] * nv[q]; sa1 += S1[q] * nv[q]; y0 += S0[q] * rv[q]; y1 += S1[q] * rv[q]; }
                    sa0 = red8(sa0); sa1 = red8(sa1); y0 = red8(y0); y1 = red8(y1);
                    y0 += sa0 * csc[0] + cvv[0] * csc[1]; y1 += sa1 * csc[0] + cvv[1] * csc[1];
#pragma unroll
                    for (int q = 0; q < 8; ++q) { S0[q] = S0[q] * wv[q] + sa0 * bv[q] + cvv[0] * dv[q]; S1[q] = S1[q] * wv[q] + sa1 * bv[q] + cvv[1] * dv[q]; }
                    if (k8 == 0) *(LAS scan::f32x2*)(yb + sl * 64 + 2 * rp) = (scan::f32x2){y0, y1};
                    cw0 = nw0; cw1 = nw1; cn0 = nn0; cn1 = nn1; cb0 = nb0; cb1 = nb1; cd0 = nd0; cd1 = nd1; cr0 = nr0; cr1 = nr1; cvv = nvv; csc = nsc;
                }
#undef SCAN_LD
                __syncthreads();
            }
            __syncthreads();
        }
    }
}

namespace sc2 {
typedef short bf16x8 __attribute__((ext_vector_type(8)));
typedef float f32x4 __attribute__((ext_vector_type(4)));
typedef unsigned u32x4 __attribute__((ext_vector_type(4)));
typedef unsigned u32x2 __attribute__((ext_vector_type(2)));
constexpr int NP = 6;
constexpr int O_AH = 0, O_RH = 2048, O_BK = 4096, O_VM = 8192, O_GC = 10240, O_AAB = 10496, O_AAK = 11520, O_ARK = 12032, O_BH = 13056, O_KH = 15104, SLOT = 17152;
constexpr int O_S0 = NP * SLOT, O_RHS = O_S0 + 8192, O_ZU = O_RHS + 4096, O_FLAG = O_ZU + 2048, TOTAL = O_FLAG + 256;
#define SC_MFMA(a, b, c) __builtin_amdgcn_mfma_f32_16x16x32_bf16((a), (b), (c), 0, 0, 0)
DI unsigned pk2(float a, float b) { return att::pk(a, b); }
DI int ldv(volatile LAS int* p) { return *p; }
}
template <int ABL>
DI void ph_scan_chunk(const Ctx& cx, const Params& p, float* ldsg, int j) {
    using namespace sc2;
    static_assert(TOTAL <= 128 * 1024, "scan LDS map");
    LAS unsigned char* L = (LAS unsigned char*)ldsg;
    volatile LAS int* ready = (volatile LAS int*)(L + O_FLAG); volatile LAS int* done = ready + 8;
    const int tid = cx.tid, wid = __builtin_amdgcn_readfirstlane(tid >> 6), lane = tid & 63, lq = lane >> 4, lr = lane & 15;
    constexpr int NCH = 144;
    for (int item = cx.bid; item < 256; item += cx.nblk) {
        const int b = item >> 4, h = (item >> 1) & 7, dir = item & 1;
        bf16_t* yout = dir ? p.YB : p.YF;
        __syncthreads();
        if (tid < 32) ready[tid] = 0;
        __syncthreads();
#define SC_ROW(stepv, row_, t_, T_) const bool cp_ = (stepv) < 256; const int tt_ = cp_ ? (stepv) : (stepv) - 256, T_ = cp_ ? 256 : 2048, t_ = dir ? (T_ - 1 - tt_) : tt_; const int row_ = cp_ ? NLAT + b * 256 + t_ : b * 2048 + t_
        if (wid < 2) {
            __builtin_amdgcn_s_setprio(3);
            const int g = wid, vb0 = 2 * g;
            f32x4 S[4][2];
#pragma unroll
            for (int kb = 0; kb < 4; ++kb)
#pragma unroll
                for (int vb = 0; vb < 2; ++vb) S[kb][vb] = (f32x4){0.f, 0.f, 0.f, 0.f};
            for (int c = 0; c < NCH; ++c) {
                const int sl = c % NP; LAS unsigned char* SB = L + sl * SLOT;
                { unsigned spins = 0; while (ldv(ready + sl) != c + 1) { __builtin_amdgcn_s_sleep(1); if (++spins > (1u << 22)) break; } }
                asm volatile("" ::: "memory");
                if (ABL == 2) { if (lane == 0) done[g * 8 + sl] = c + 1; continue; }
                f32x4 cA[4][4];
#pragma unroll
                for (int j = 0; j <= 3; ++j)
#pragma unroll
                    for (int q = (j + 1) / 4; q < 4; ++q) cA[j][q - (j + 1) / 4] = *(const LAS f32x4*)(SB + O_AAB + j * 64 + q * 16);
#pragma unroll
                for (int kb = 0; kb < 4; ++kb)
#pragma unroll
                    for (int vq = 0; vq < 2; ++vq) { const f32x4 x = S[kb][vq]; *(LAS u32x2*)(L + O_S0 + (16 * (vb0 + vq) + lr) * 128 + (16 * kb + 4 * lq) * 2) = (u32x2){pk2(x[0], x[1]), pk2(x[2], x[3])}; }
                {
                    bf16x8 ah[2], ak, sf[2][2], vmf[2];
#pragma unroll
                    for (int ks = 0; ks < 2; ++ks) ah[ks] = *(const LAS bf16x8*)(SB + O_AH + lr * 128 + ks * 64 + lq * 16);
                    { u32x4 z = {0u, 0u, 0u, 0u}; if (lq < 2) z = *(const LAS u32x4*)(SB + O_AAK + lr * 32 + lq * 16); ak = __builtin_bit_cast(bf16x8, z); }
#pragma unroll
                    for (int vq = 0; vq < 2; ++vq) { const int vb = vb0 + vq;
#pragma unroll
                        for (int ks = 0; ks < 2; ++ks) sf[vq][ks] = *(const LAS bf16x8*)(L + O_S0 + (16 * vb + lr) * 128 + ks * 64 + lq * 16);
                        u32x4 z = {0u, 0u, 0u, 0u}; if (lq < 2) z = *(const LAS u32x4*)(SB + O_VM + (16 * vb + lr) * 32 + lq * 16); vmf[vq] = __builtin_bit_cast(bf16x8, z);
                    }
                    f32x4 acc[2];
#pragma unroll
                    for (int vq = 0; vq < 2; ++vq) { acc[vq] = (f32x4){0.f, 0.f, 0.f, 0.f}; acc[vq] = SC_MFMA(sf[vq][0], ah[0], acc[vq]); acc[vq] = SC_MFMA(sf[vq][1], ah[1], acc[vq]); acc[vq] = SC_MFMA(vmf[vq], ak, acc[vq]); }
#pragma unroll
                    for (int vq = 0; vq < 2; ++vq)
#pragma unroll
                        for (int q = 0; q < 4; ++q) *(LAS float*)(L + O_RHS + ((16 * (vb0 + vq) + 4 * lq + q) * 16 + lr) * 4) = acc[vq][q];
                }
                float u[16];
                const int vl = 32 * g + (lane & 31);
                { const LAS f32x4* rp = (const LAS f32x4*)(L + O_RHS + vl * 64);
#pragma unroll
                  for (int q = 0; q < 4; ++q) { const f32x4 x = rp[q]; u[4 * q] = x[0]; u[4 * q + 1] = x[1]; u[4 * q + 2] = x[2]; u[4 * q + 3] = x[3]; } }
#define SC_COL(j, CF) do { _Pragma("unroll") for (int q = ((j) + 1) / 4; q < 4; ++q) { const f32x4 cf = CF[q - ((j) + 1) / 4]; \
                        _Pragma("unroll") for (int e = 0; e < 4; ++e) { if (4 * q + e > (j)) u[4 * q + e] += cf[e] * u[j]; } } } while (0)
                f32x4 cB[4][3], cC[7][2];
#pragma unroll
                for (int j = 4; j <= 7; ++j)
#pragma unroll
                    for (int q = (j + 1) / 4; q < 4; ++q) cB[j - 4][q - (j + 1) / 4] = *(const LAS f32x4*)(SB + O_AAB + j * 64 + q * 16);
                asm volatile("" ::: "memory");
                if (ABL != 3) {
                SC_COL(0, cA[0]); SC_COL(1, cA[1]); SC_COL(2, cA[2]); SC_COL(3, cA[3]);
                }
                asm volatile("" ::: "memory");
#pragma unroll
                for (int j = 8; j <= 14; ++j)
#pragma unroll
                    for (int q = (j + 1) / 4; q < 4; ++q) cC[j - 8][q - (j + 1) / 4] = *(const LAS f32x4*)(SB + O_AAB + j * 64 + q * 16);
                asm volatile("" ::: "memory");
                if (ABL != 3) {
                SC_COL(4, cB[0]); SC_COL(5, cB[1]); SC_COL(6, cB[2]); SC_COL(7, cB[3]);
                SC_COL(8, cC[0]); SC_COL(9, cC[1]); SC_COL(10, cC[2]); SC_COL(11, cC[3]); SC_COL(12, cC[4]); SC_COL(13, cC[5]); SC_COL(14, cC[6]);
                }
#undef SC_COL
                { u32x4 w0 = {pk2(u[0], u[1]), pk2(u[2], u[3]), pk2(u[4], u[5]), pk2(u[6], u[7])}, w1 = {pk2(u[8], u[9]), pk2(u[10], u[11]), pk2(u[12], u[13]), pk2(u[14], u[15])};
                  if (lane < 32) { *(LAS u32x4*)(L + O_ZU + vl * 32) = w0; *(LAS u32x4*)(L + O_ZU + vl * 32 + 16) = w1; } }
                {
                    bf16x8 zf[2], sf[2][2], bkf[4]; f32x4 gc[4];
#pragma unroll
                    for (int vq = 0; vq < 2; ++vq) { const int vb = vb0 + vq;
                        zf[vq] = (lq < 2) ? *(const LAS bf16x8*)(L + O_ZU + (16 * vb + lr) * 32 + lq * 16) : *(const LAS bf16x8*)(SB + O_VM + (16 * vb + lr) * 32 + (lq - 2) * 16);
#pragma unroll
                        for (int ks = 0; ks < 2; ++ks) sf[vq][ks] = *(const LAS bf16x8*)(L + O_S0 + (16 * vb + lr) * 128 + ks * 64 + lq * 16);
                    }
                    const bf16x8 rk = *(const LAS bf16x8*)(SB + O_ARK + lr * 64 + lq * 16);
                    const bf16x8 rh0 = *(const LAS bf16x8*)(SB + O_RH + lr * 128 + lq * 16), rh1 = *(const LAS bf16x8*)(SB + O_RH + lr * 128 + 64 + lq * 16);
#pragma unroll
                    for (int kb = 0; kb < 4; ++kb) { gc[kb] = *(const LAS f32x4*)(SB + O_GC + (16 * kb + 4 * lq) * 4); bkf[kb] = *(const LAS bf16x8*)(SB + O_BK + (16 * kb + lr) * 64 + lq * 16); }
                    const int step = c * 16 + lr; SC_ROW(step, row, tq, Tq); (void)tq; (void)Tq;
#pragma unroll
                    for (int vq = 0; vq < 2; ++vq) { f32x4 y = {0.f, 0.f, 0.f, 0.f};
                        y = SC_MFMA(sf[vq][0], rh0, y); y = SC_MFMA(sf[vq][1], rh1, y); y = SC_MFMA(zf[vq], rk, y);
                        if (ABL == 0) *(u32x2*)(yout + (size_t)row * 512 + h * 64 + 16 * (vb0 + vq) + 4 * lq) = (u32x2){pk2(y[0], y[1]), pk2(y[2], y[3])}; else asm volatile("" :: "v"(y[0]), "v"(y[1]), "v"(y[2]), "v"(y[3])); }
#pragma unroll
                    for (int kb = 0; kb < 4; ++kb)
#pragma unroll
                        for (int vq = 0; vq < 2; ++vq) S[kb][vq] = SC_MFMA(bkf[kb], zf[vq], S[kb][vq] * gc[kb]);
                }
                asm volatile("s_waitcnt lgkmcnt(0)" ::: "memory");
                if (lane == 0) done[g * 8 + sl] = c + 1;
            }
            __builtin_amdgcn_s_setprio(0);
        } else {
            const int pw = wid - 2, hc = h * 64 + lane; LAS unsigned char* SB = L + pw * SLOT;
            const float kkc = p.a_k_k[j * 512 + hc], kac = p.a_k_a[j * 512 + hc];
            const float mur = p.a_mu[j * ACOLS + hc], muk = p.a_mu[j * ACOLS + 512 + hc], muv = p.a_mu[j * ACOLS + 1024 + hc];
            for (int c = pw; c < NCH; c += NP) {
                if (ABL == 1 || ABL == 3 || ABL == 4) { if (c >= NP) { unsigned spins = 0; while (ldv(done + pw) != c - NP + 1 || ldv(done + 8 + pw) != c - NP + 1) { __builtin_amdgcn_s_sleep(2); if (++spins > (1u << 22)) break; } } if (lane == 0) ready[pw] = c + 1; continue; }
                bf16_t raw[16][11];
#define SC_LOAD(t) do { const int step = c * 16 + (t); SC_ROW(step, row, tq, Tq); \
                    const int rp_ = (tq > 0) ? row - 1 : row, rn_ = (tq < Tq - 1) ? row + 1 : row; \
                    const bf16_t* pc = p.P + (size_t)row * PLD + hc; const bf16_t* pp = p.P + (size_t)rp_ * PLD + hc; const bf16_t* pn = p.P + (size_t)rn_ * PLD + hc; \
                    raw[t][0] = pc[0]; raw[t][1] = pp[0]; raw[t][2] = pn[0]; raw[t][3] = pc[512]; raw[t][4] = pp[512]; raw[t][5] = pn[512]; raw[t][6] = pc[1024]; raw[t][7] = pp[1024]; raw[t][8] = pn[1024]; \
                    raw[t][9] = p.WAG[(size_t)row * WLD + dir * 512 + hc]; raw[t][10] = p.WAG[(size_t)row * WLD + 1024 + dir * 512 + hc]; } while (0)
#define SC_STEP(t) do { const int step = c * 16 + (t); SC_ROW(step, row, tq, Tq); (void)row; \
                    const float mp = (tq > 0) ? 0.5f : 0.f, mn = (tq < Tq - 1) ? 0.5f : 0.f; \
                    const float rc = bf2f(raw[t][0]), kc_ = bf2f(raw[t][3]), vc = bf2f(raw[t][6]); \
                    const float R = rc + mur * (mp * bf2f(raw[t][1]) + mn * bf2f(raw[t][2]) - rc); \
                    const float K = kc_ + muk * (mp * bf2f(raw[t][4]) + mn * bf2f(raw[t][5]) - kc_); \
                    const float Vv = vc + muv * (mp * bf2f(raw[t][7]) + mn * bf2f(raw[t][8]) - vc); \
                    const float w = 1.f - bf2f(raw[t][9]), a = bf2f(raw[t][10]); \
                    const float kkv = K * kkc, ssq = wave_sum(kkv * kkv), kk = kkv * rsqrtf(ssq + 1e-12f); \
                    const float kd = K * (1.f + (a - 1.f) * kac), bd = kk * a; \
                    const float gprev = g; g *= w; const float ig = __builtin_amdgcn_rcpf(g); \
                    *(LAS bf16_t*)(SB + O_AH + (t) * 128 + lane * 2) = f2bf(-kk * gprev); \
                    *(LAS bf16_t*)(SB + O_RH + (t) * 128 + lane * 2) = f2bf(R * g); \
                    *(LAS bf16_t*)(SB + O_BH + (t) * 128 + lane * 2) = f2bf(bd * ig); \
                    *(LAS bf16_t*)(SB + O_KH + (t) * 128 + lane * 2) = f2bf(kd * ig); \
                    *(LAS bf16_t*)(SB + O_VM + lane * 32 + (t) * 2) = f2bf(Vv); } while (0)
                SC_LOAD(0); SC_LOAD(1); SC_LOAD(2); SC_LOAD(3); SC_LOAD(4); SC_LOAD(5); SC_LOAD(6); SC_LOAD(7);
                if (c >= NP) { unsigned spins = 0; while (ldv(done + pw) != c - NP + 1 || ldv(done + 8 + pw) != c - NP + 1) { __builtin_amdgcn_s_sleep(2); if (++spins > (1u << 22)) break; } }
                asm volatile("" ::: "memory");
                float g = 1.f;
                SC_STEP(0); SC_STEP(1); SC_STEP(2); SC_STEP(3);
                asm volatile("" ::: "memory");
                SC_LOAD(8); SC_LOAD(9); SC_LOAD(10); SC_LOAD(11);
                asm volatile("" ::: "memory");
                SC_STEP(4); SC_STEP(5); SC_STEP(6); SC_STEP(7);
                asm volatile("" ::: "memory");
                SC_LOAD(12); SC_LOAD(13); SC_LOAD(14); SC_LOAD(15);
                asm volatile("" ::: "memory");
                SC_STEP(8); SC_STEP(9); SC_STEP(10); SC_STEP(11); SC_STEP(12); SC_STEP(13); SC_STEP(14); SC_STEP(15);
#undef SC_LOAD
#undef SC_STEP
#pragma unroll
                for (int q = 0; q < 2; ++q) {
                    float bq[8], kq[8];
#pragma unroll
                    for (int e = 0; e < 8; ++e) { bq[e] = bf2f(*(const LAS bf16_t*)(SB + O_BH + (8 * q + e) * 128 + lane * 2)) * g; kq[e] = bf2f(*(const LAS bf16_t*)(SB + O_KH + (8 * q + e) * 128 + lane * 2)) * g; }
                    u32x4 wb = {pk2(bq[0], bq[1]), pk2(bq[2], bq[3]), pk2(bq[4], bq[5]), pk2(bq[6], bq[7])}, wk = {pk2(kq[0], kq[1]), pk2(kq[2], kq[3]), pk2(kq[4], kq[5]), pk2(kq[6], kq[7])};
                    *(LAS u32x4*)(SB + O_BK + lane * 64 + q * 16) = wb; *(LAS u32x4*)(SB + O_BK + lane * 64 + 32 + q * 16) = wk;
                }
                *(LAS float*)(SB + O_GC + lane * 4) = g;
                f32x4 sab = {0.f, 0.f, 0.f, 0.f}, sak = sab, srb = sab, srk = sab;
#pragma unroll
                for (int ks = 0; ks < 2; ++ks) {
                    const bf16x8 fa = *(const LAS bf16x8*)(SB + O_AH + lr * 128 + ks * 64 + lq * 16), fr = *(const LAS bf16x8*)(SB + O_RH + lr * 128 + ks * 64 + lq * 16);
                    const bf16x8 fb = *(const LAS bf16x8*)(SB + O_BH + lr * 128 + ks * 64 + lq * 16), fk = *(const LAS bf16x8*)(SB + O_KH + lr * 128 + ks * 64 + lq * 16);
                    sab = SC_MFMA(fa, fb, sab); sak = SC_MFMA(fa, fk, sak); srb = SC_MFMA(fr, fb, srb); srk = SC_MFMA(fr, fk, srk);
                }
#pragma unroll
                for (int q = 0; q < 4; ++q) { const int t = 4 * lq + q; const bool lo = lr < t, le = lr <= t;
                    *(LAS bf16_t*)(SB + O_AAK + (t * 16 + lr) * 2) = f2bf(lo ? sak[q] : 0.f);
                    *(LAS bf16_t*)(SB + O_ARK + (t * 32 + lr) * 2) = f2bf(le ? srb[q] : 0.f);
                    *(LAS bf16_t*)(SB + O_ARK + (t * 32 + 16 + lr) * 2) = f2bf(le ? srk[q] : 0.f); }
                { f32x4 tq;
#pragma unroll
                  for (int q = 0; q < 4; ++q) tq[q] = (lr < 4 * lq + q) ? sab[q] : 0.f;
                  *(LAS f32x4*)(SB + O_AAB + (lr * 16 + 4 * lq) * 4) = tq; }
                asm volatile("s_waitcnt lgkmcnt(0)" ::: "memory");
                if (lane == 0) ready[pw] = c + 1;
            }
        }
#undef SC_ROW
        __syncthreads();
    }
}

DI void unpack8u(const uint4 u, float (&d)[8]) { d[0] = bflo(u.x); d[1] = bfhi(u.x); d[2] = bflo(u.y); d[3] = bfhi(u.y); d[4] = bflo(u.z); d[5] = bfhi(u.z); d[6] = bflo(u.w); d[7] = bfhi(u.w); }
DI uint4 pack8u(const float (&d)[8]) { uint4 u; u.x = att::pk(d[0], d[1]); u.y = att::pk(d[2], d[3]); u.z = att::pk(d[4], d[5]); u.w = att::pk(d[6], d[7]); return u; }
DI void shift8(const bf16_t* P, int row, int t, int T, int col0, const float (&mu)[8], float (&o)[8]) {
    float c[8], pv[8], nx[8];
    unpack8u(*(const uint4*)(P + (size_t)row * PLD + col0), c);
    if (t > 0) unpack8u(*(const uint4*)(P + (size_t)(row - 1) * PLD + col0), pv); else {
#pragma unroll
        for (int i = 0; i < 8; ++i) pv[i] = 0.f; }
    if (t < T - 1) unpack8u(*(const uint4*)(P + (size_t)(row + 1) * PLD + col0), nx); else {
#pragma unroll
        for (int i = 0; i < 8; ++i) nx[i] = 0.f; }
#pragma unroll
    for (int i = 0; i < 8; ++i) o[i] = c[i] + mu[i] * (0.5f * (pv[i] + nx[i]) - c[i]);
}
DI void ld8f(const float* p, float (&d)[8]) { const float4 a = *(const float4*)p, b = *(const float4*)(p + 4); d[0] = a.x; d[1] = a.y; d[2] = a.z; d[3] = a.w; d[4] = b.x; d[5] = b.y; d[6] = b.z; d[7] = b.w; }
DI void ph_post_opt(const Ctx& cx, const Params& p, int j, int nrows) {
    const int tid = cx.tid, wid = tid >> 6, lane = tid & 63, c0 = lane * 8;
    float mur[8], muk[8], muv[8], ka[8], rk[8], lw[8], lb[8];
    ld8f(p.a_mu + j * ACOLS + c0, mur); ld8f(p.a_mu + j * ACOLS + 512 + c0, muk); ld8f(p.a_mu + j * ACOLS + 1024 + c0, muv);
    ld8f(p.a_k_a + j * 512 + c0, ka); ld8f(p.a_r_k + j * 512 + c0, rk); ld8f(p.a_ln_w + j * 512 + c0, lw); ld8f(p.a_ln_b + j * 512 + c0, lb);
    for (int row = cx.bid * 8 + wid; row < nrows; row += cx.nblk * 8) {
        const bool lat = row < NLAT; const int t = lat ? (row & 2047) : ((row - NLAT) & 255); const int T = lat ? 2048 : 256;
        float yf[8], yb[8], R[8], K[8], V[8], af[8], ab[8], g[8];
        unpack8u(*(const uint4*)(p.YF + (size_t)row * 512 + c0), yf); unpack8u(*(const uint4*)(p.YB + (size_t)row * 512 + c0), yb);
        shift8(p.P, row, t, T, c0, mur, R); shift8(p.P, row, t, T, 512 + c0, muk, K); shift8(p.P, row, t, T, 1024 + c0, muv, V);
        unpack8u(*(const uint4*)(p.WAG + (size_t)row * WLD + 1024 + c0), af); unpack8u(*(const uint4*)(p.WAG + (size_t)row * WLD + 1536 + c0), ab); unpack8u(*(const uint4*)(p.WAG + (size_t)row * WLD + 2048 + c0), g);
        float sum = 0.f, sb = 0.f;
#pragma unroll
        for (int i = 0; i < 8; ++i) { yf[i] += yb[i]; sum += yf[i]; sb += R[i] * rk[i] * K[i] * (2.f + (af[i] + ab[i] - 2.f) * ka[i]); }
        sum = scan::red8(sum); sb = scan::red8(sb);
        const float mean = sum * (1.f / 64.f); float var = 0.f;
#pragma unroll
        for (int i = 0; i < 8; ++i) { const float d = yf[i] - mean; var += d * d; }
        var = scan::red8(var);
        const float rstd = rsqrtf(var * (1.f / 64.f) + 64e-5f);
        float o[8];
#pragma unroll
        for (int i = 0; i < 8; ++i) o[i] = ((yf[i] - mean) * rstd * lw[i] + lb[i] + sb * V[i]) * g[i];
        *(uint4*)(p.H + (size_t)row * 1024 + c0) = pack8u(o);
    }
}
DI void rope_cs(int c, int t, bool lat, float (&cs)[8], float (&sn)[8]) {
    const float invf[8] = {1.f, 0.316227766016838f, 0.1f, 0.0316227766016838f, 0.01f, 0.00316227766016838f, 0.001f, 0.000316227766016838f};
    const float pos = (c & 1) ? (float)(t & 63) : (float)(t >> 6);
#pragma unroll
    for (int i = 0; i < 8; ++i) { const float ang = pos * invf[i]; cs[i] = lat ? __cosf(ang) : 1.f; sn[i] = lat ? __sinf(ang) : 0.f; }
}
DI void fin_vec(float (&x)[8], int c, const float (&cs)[8], const float (&sn)[8], const float (&gn)[8], float scl, bf16_t* dst) {
    float ss = 0.f;
#pragma unroll
    for (int i = 0; i < 8; ++i) ss += x[i] * x[i];
    ss += dpp_f<0xB1>(ss); ss += dpp_f<0x4E>(ss); ss += dpp_f<0x141>(ss); ss += dpp_f<0x140>(ss);
    const float r = rsqrtf(ss * (1.f / 96.f) + 1e-6f);
#pragma unroll
    for (int i = 0; i < 8; ++i) x[i] = x[i] * r * gn[i];
    float y[8];
#pragma unroll
    for (int i = 0; i < 8; ++i) { const float up = dpp_f<0x102>(x[i]), dn = dpp_f<0x112>(x[i]); y[i] = (c < 10) ? up : dn; }
    if (c >= 8 && c < 12) {
#pragma unroll
        for (int i = 0; i < 8; ++i) x[i] = (c < 10) ? (x[i] * cs[i] - y[i] * sn[i]) : (x[i] * cs[i] + y[i] * sn[i]);
    }
    if (c < 12) {
#pragma unroll
        for (int i = 0; i < 8; ++i) x[i] *= scl;
        *(uint4*)(dst + c * 8) = pack8u(x);
    }
}
DI void ph_finalize_opt(const Ctx& cx, const Params& p, float* ldsf, int j, int mq) {
    const int tid = cx.tid, wid = tid >> 6, lane = tid & 63, c = lane & 15, hq = lane >> 4;
    float qg[8], kg[8]; ld8f(p.b_q_gain + j * 96 + (c < 12 ? c : 0) * 8, qg); ld8f(p.b_k_gain + j * 96 + (c < 12 ? c : 0) * 8, kg);
    for (int row0 = (cx.bid * 8 + wid) * 2; row0 < NT; row0 += cx.nblk * 16) {
        float xq[4][8], xk[4][8];
#pragma unroll
        for (int u = 0; u < 4; ++u) {
            const int row = row0 + (u >> 1), h = (u & 1) * 4 + hq;
#pragma unroll
            for (int i = 0; i < 8; ++i) { xq[u][i] = 0.f; xk[u][i] = 0.f; }
            if (row < mq && c < 12) unpack8u(*(const uint4*)(p.Qraw + (size_t)row * 768 + h * 96 + c * 8), xq[u]);
            if (c < 8) unpack8u(*(const uint4*)(p.KVraw + (size_t)row * 1024 + h * 128 + c * 8), xk[u]);
            else if (c < 12) unpack8u(*(const uint4*)(p.P + (size_t)row * PLD + ACOLS + 384 + (c - 8) * 8), xk[u]);
        }
#pragma unroll
        for (int rr = 0; rr < 2; ++rr) {
            const int row = row0 + rr;
            const bool lat = row < NLAT; const int b = lat ? (row >> 11) : ((row - NLAT) >> 8); const int t = lat ? (row & 2047) : ((row - NLAT) & 255);
            float cs[8], sn[8]; rope_cs(c, t, lat, cs, sn);
            const int key = lat ? 256 + t : t;
#pragma unroll
            for (int hf = 0; hf < 2; ++hf) { const int u = rr * 2 + hf, h = hf * 4 + hq;
                if (row < mq) fin_vec(xq[u], c, cs, sn, qg, 0.10206207261596577f * 1.4426950408889634f, p.Qraw + (size_t)row * 768 + h * 96);
                fin_vec(xk[u], c, cs, sn, kg, 1.f, p.Kf + ((size_t)(b * 8 + h) * 2304 + key) * 96); }
        }
    }
    bf16_t* T = (bf16_t*)ldsf; constexpr int TP = 520;
    for (int tile = cx.bid; tile < NT / 64; tile += cx.nblk) {
        const int row0 = tile * 64; const bool lat = row0 < NLAT; const int b = lat ? (row0 >> 11) : ((row0 - NLAT) >> 8); const int t0 = lat ? (row0 & 2047) : ((row0 - NLAT) & 255);
        const int key0 = lat ? 256 + t0 : t0;
        __syncthreads();
#pragma unroll
        for (int i = 0; i < 8; ++i) { const int ch = tid + 512 * i, kr = ch >> 6, cc = ch & 63, h = cc >> 3, part = cc & 7;
            *(uint4*)(T + kr * TP + h * 64 + part * 8) = *(const uint4*)(p.KVraw + (size_t)(row0 + kr) * 1024 + h * 128 + 64 + part * 8); }
        __syncthreads();
#pragma unroll
        for (int i = 0; i < 8; ++i) { const int ch = tid + 512 * i, hd = ch >> 3, kc = ch & 7;
            float v[8];
#pragma unroll
            for (int q = 0; q < 8; ++q) v[q] = bf2f(T[(kc * 8 + q) * TP + hd]);
            uint4 o; o.x = (unsigned)T[(kc * 8 + 0) * TP + hd] | ((unsigned)T[(kc * 8 + 1) * TP + hd] << 16); o.y = (unsigned)T[(kc * 8 + 2) * TP + hd] | ((unsigned)T[(kc * 8 + 3) * TP + hd] << 16);
            o.z = (unsigned)T[(kc * 8 + 4) * TP + hd] | ((unsigned)T[(kc * 8 + 5) * TP + hd] << 16); o.w = (unsigned)T[(kc * 8 + 6) * TP + hd] | ((unsigned)T[(kc * 8 + 7) * TP + hd] << 16);
            (void)v;
            *(uint4*)(p.Vt + ((size_t)(b * 8 + (hd >> 6)) * 64 + (hd & 63)) * 2304 + key0 + kc * 8) = o; }
    }
    __syncthreads();
}
DI void ph_mod_opt(const Ctx& cx, const Params& p, float* lds) {
    const int tid = cx.tid, wid = tid >> 6, lane = tid & 63;
    float* part = lds + 17 * 1024;
    for (int i = tid; i < 17 * 1024; i += NTHR) { const int jj = i >> 10, k = i & 1023; const float v = (jj < 16) ? p.c[jj * 1024 + k] : p.c_ctx[k]; lds[i] = siluf(v); }
    __syncthreads();
    for (int item = cx.bid; item < 4 * 96; item += cx.nblk) {
        const int l = item / 96, n = (item % 96) * 64 + lane;
        const float* w = p.mod_w + (size_t)l * 1024 * 6144 + n;
        float acc[17];
#pragma unroll
        for (int jj = 0; jj < 17; ++jj) acc[jj] = 0.f;
        for (int k0 = wid * 128; k0 < wid * 128 + 128; k0 += 16) {
            float wv[16];
#pragma unroll
            for (int q = 0; q < 16; ++q) wv[q] = w[(size_t)(k0 + q) * 6144];
#pragma unroll
            for (int q = 0; q < 16; ++q)
#pragma unroll
                for (int jj = 0; jj < 17; ++jj) acc[jj] += lds[jj * 1024 + k0 + q] * wv[q];
        }
#pragma unroll
        for (int jj = 0; jj < 17; ++jj) part[(wid * 17 + jj) * 64 + lane] = acc[jj];
        __syncthreads();
        for (int o = tid; o < 17 * 64; o += NTHR) { const int jj = o >> 6, ln = o & 63; float sacc = p.mod_b[l * 6144 + (item % 96) * 64 + ln];
#pragma unroll
            for (int q = 0; q < 8; ++q) sacc += part[(q * 17 + jj) * 64 + ln];
            p.mod[((size_t)l * 17 + jj) * 6144 + (item % 96) * 64 + ln] = sacc; }
        __syncthreads();
    }
}

DI void ph_norm2_router(const Ctx& cx, const Params& p, float* ldsg, int nrows, const float* gain, const float* modl, int layer, const bf16_t* xb_lat) {
    LAS float* lds = (LAS float*)ldsg;
    const int tid = cx.tid, wid = tid >> 6, lane = tid & 63;
    LAS float* rw = lds; LAS float* red = lds + 16 * 1024 + wid * (32 * 64 + 64); LAS float* my = red + 32 * 64;
    LAS int* lcnt = (LAS int*)(lds + 16 * 1024 + 8 * (32 * 64 + 64)); LAS int* lbase = lcnt + 16; LAS int* rlist = lcnt + 32;
    for (int i = tid; i < 16 * 1024; i += NTHR) { const int e = i >> 10, col = i & 1023; rw[i] = p.router_w[col * 16 + e]; }
    if (tid < 16) lcnt[tid] = 0;
    __syncthreads();
    int nlist = 0;
    uint2 raw[2][4];
#define N2_LOAD(pi) do { _Pragma("unroll") for (int r = 0; r < 2; ++r) { const int row = 2 * (pi) + r; const bf16_t* xr = (row < NLAT) ? xb_lat + (size_t)row * 1024 : p.cs + (size_t)(row - NLAT) * 1024; \
            _Pragma("unroll") for (int i = 0; i < 4; ++i) raw[r][i] = *(const uint2*)(xr + i * 256 + lane * 4); } } while (0)
    { const int p0 = cx.bid * 8 + wid; if (xb_lat && p0 < (nrows >> 1)) N2_LOAD(p0); }
    for (int pidx = cx.bid * 8 + wid; pidx < (nrows >> 1); pidx += cx.nblk * 8) {
        float4 xv[2][4];
        if (xb_lat) {
#pragma unroll
            for (int r = 0; r < 2; ++r)
#pragma unroll
                for (int i = 0; i < 4; ++i) xv[r][i] = make_float4(bflo(raw[r][i].x), bfhi(raw[r][i].x), bflo(raw[r][i].y), bfhi(raw[r][i].y));
            const int pn = pidx + cx.nblk * 8; if (pn < (nrows >> 1)) N2_LOAD(pn);
        } else {
#pragma unroll
            for (int r = 0; r < 2; ++r) { const int row = 2 * pidx + r; const float* xr = (row < NLAT) ? p.out + (size_t)row * 1024 : p.ctxs + (size_t)(row - NLAT) * 1024;
#pragma unroll
                for (int i = 0; i < 4; ++i) xv[r][i] = *(const float4*)(xr + i * 256 + lane * 4); }
        }
        const int row0 = 2 * pidx; const int jj = (row0 < NLAT) ? (row0 >> 11) : 16;
        const float* shp = modl + (size_t)jj * 6144 + 3 * 1024; const float* scp = modl + (size_t)jj * 6144 + 4 * 1024;
        float4 hv[2][4];
#pragma unroll
        for (int r = 0; r < 2; ++r) {
            float ss = 0.f;
#pragma unroll
            for (int i = 0; i < 4; ++i) ss += xv[r][i].x * xv[r][i].x + xv[r][i].y * xv[r][i].y + xv[r][i].z * xv[r][i].z + xv[r][i].w * xv[r][i].w;
            ss = wave_sum(ss);
            const float rstd = rsqrtf(ss * (1.f / 1024.f) + 1e-6f);
#pragma unroll
            for (int i = 0; i < 4; ++i) {
                const int col = i * 256 + lane * 4;
                const float4 g = *(const float4*)(gain + col), sh = *(const float4*)(shp + col), sc = *(const float4*)(scp + col);
                hv[r][i].x = xv[r][i].x * rstd * g.x * (1.f + sc.x) + sh.x; hv[r][i].y = xv[r][i].y * rstd * g.y * (1.f + sc.y) + sh.y;
                hv[r][i].z = xv[r][i].z * rstd * g.z * (1.f + sc.z) + sh.z; hv[r][i].w = xv[r][i].w * rstd * g.w * (1.f + sc.w) + sh.w;
                uint2 u; u.x = att::pk(hv[r][i].x, hv[r][i].y); u.y = att::pk(hv[r][i].z, hv[r][i].w);
                *(uint2*)(p.H + (size_t)(row0 + r) * 1024 + col) = u;
            }
        }
#pragma unroll
        for (int e = 0; e < 16; ++e) {
            float a0 = 0.f, a1 = 0.f;
#pragma unroll
            for (int i = 0; i < 4; ++i) { const mm::f32x4 w = *(const LAS mm::f32x4*)(rw + e * 1024 + i * 256 + lane * 4);
                a0 += hv[0][i].x * w[0] + hv[0][i].y * w[1] + hv[0][i].z * w[2] + hv[0][i].w * w[3]; a1 += hv[1][i].x * w[0] + hv[1][i].y * w[1] + hv[1][i].z * w[2] + hv[1][i].w * w[3]; }
            red[e * 64 + lane] = a0; red[(16 + e) * 64 + lane] = a1;
        }
        __builtin_amdgcn_wave_barrier();
        {
            const int r = lane >> 5, e = (lane >> 1) & 15, half = lane & 1; const LAS float* src = red + (r * 16 + e) * 64 + half * 32;
            float sacc = 0.f;
#pragma unroll
            for (int q = 0; q < 8; ++q) { const mm::f32x4 v = *(const LAS mm::f32x4*)(src + q * 4); sacc += (v[0] + v[1]) + (v[2] + v[3]); }
            sacc += dpp_f<0xB1>(sacc);
            const float sg = 1.f / (1.f + __expf(-sacc));
            if (half == 0) { my[r * 32 + e] = sg; my[r * 32 + 16 + e] = sg + p.router_b[e]; }
        }
        __builtin_amdgcn_wave_barrier();
        if ((lane & 31) == 0) {
            const int r = lane >> 5; const LAS float* m = my + r * 32;
            float best = -3.0e38f; int be1 = 0, be2 = 1;
#pragma unroll
            for (int g = 0; g < 4; ++g) {
                const mm::f32x4 v = *(const LAS mm::f32x4*)(m + 16 + 4 * g);
                int i1 = 0; float m1 = v[0];
                if (v[1] > m1) { m1 = v[1]; i1 = 1; } if (v[2] > m1) { m1 = v[2]; i1 = 2; } if (v[3] > m1) { m1 = v[3]; i1 = 3; }
                int i2 = -1; float m2 = -3.0e38f;
                if (i1 != 0 && v[0] > m2) { m2 = v[0]; i2 = 0; } if (i1 != 1 && v[1] > m2) { m2 = v[1]; i2 = 1; }
                if (i1 != 2 && v[2] > m2) { m2 = v[2]; i2 = 2; } if (i1 != 3 && v[3] > m2) { m2 = v[3]; i2 = 3; }
                const float gs = m1 + m2;
                if (gs > best) { best = gs; be1 = 4 * g + i1; be2 = 4 * g + i2; }
            }
            const float bs1 = m[be1], bs2 = m[be2]; const float inv = 1.f / (bs1 + bs2);
            const int p1 = atomicAdd((int*)&lcnt[be1], 1), p2 = atomicAdd((int*)&lcnt[be2], 1);
            LAS int* ent = rlist + (wid * 24 + nlist * 2 + r) * 6;
            const int row = row0 + r;
            ent[0] = row; ent[1] = be1 | (be2 << 8); ent[2] = p1; ent[3] = p2; ent[4] = __float_as_int(bs1 * inv); ent[5] = __float_as_int(bs2 * inv);
        }
        ++nlist;
        __builtin_amdgcn_wave_barrier();
    }
#undef N2_LOAD
    __syncthreads();
    if (tid < 16) lbase[tid] = atomicAdd(p.cnt + (layer * 16 + tid) * 64, lcnt[tid]);
    __syncthreads();
    for (int k = lane; k < 2 * nlist; k += 64) {
        const LAS int* ent = rlist + (wid * 24 + k) * 6; const int row = ent[0], be1 = ent[1] & 255, be2 = ent[1] >> 8;
        const size_t s1 = (size_t)be1 * NT + lbase[be1] + ent[2], s2 = (size_t)be2 * NT + lbase[be2] + ent[3];
        p.slot[s1] = row * 2; p.slot[s2] = row * 2 + 1; p.slotw[s1] = __int_as_float(ent[4]); p.slotw[s2] = __int_as_float(ent[5]);
    }
    __syncthreads();
}

DI void ph_prepBLR_opt(const Ctx& cx, const Params& p, int j) {
    const int tid = cx.tid, wid = tid >> 6, lane = tid & 63;
    const float4 gq = *(const float4*)(p.b_q_norm + j * 256 + lane * 4); const float2 gk = *(const float2*)(p.b_kv_norm + j * 128 + lane * 2);
    constexpr int U = 8;
    for (int row0 = (cx.bid * 8 + wid) * U; row0 < NT; row0 += cx.nblk * 8 * U) {
        uint2 uq[U]; unsigned ukv[U];
#pragma unroll
        for (int u = 0; u < U; ++u) { const bf16_t* pr = p.P + (size_t)(row0 + u) * PLD + ACOLS; uq[u] = *(const uint2*)(pr + lane * 4); ukv[u] = *(const unsigned*)(pr + 256 + lane * 2); }
#pragma unroll
        for (int u = 0; u < U; ++u) {
            const float q0 = bflo(uq[u].x), q1 = bfhi(uq[u].x), q2 = bflo(uq[u].y), q3 = bfhi(uq[u].y), k0 = bflo(ukv[u]), k1 = bfhi(ukv[u]);
            const float sq = wave_sum(q0 * q0 + q1 * q1 + q2 * q2 + q3 * q3), sk = wave_sum(k0 * k0 + k1 * k1);
            const float rq = rsqrtf(sq * (1.f / 256.f) + 1e-6f), rk = rsqrtf(sk * (1.f / 128.f) + 1e-6f);
            uint2 o; o.x = att::pk(q0 * rq * gq.x, q1 * rq * gq.y); o.y = att::pk(q2 * rq * gq.z, q3 * rq * gq.w);
            bf16_t* qn = p.QN + (size_t)(row0 + u) * 512;
            *(uint2*)(qn + lane * 4) = o; *(unsigned*)(qn + 256 + lane * 2) = att::pk(k0 * rk * gk.x, k1 * rk * gk.y); *(unsigned*)(qn + 384 + lane * 2) = 0u;
        }
    }
    const int gtid = cx.bid * NTHR + tid, gsz = cx.nblk * NTHR;
    for (int idx = gtid; idx < NT * 48; idx += gsz) {
        const int row = idx / 48, cg = idx % 48, col0 = cg * 8;
        const bool lat = row < NLAT; const int t = lat ? (row & 2047) : ((row - NLAT) & 255); const int T = lat ? 2048 : 256;
        float mu[8]; ld8f(p.a_mu + j * ACOLS + 1536 + col0, mu);
        float v[8]; shift8(p.P, row, t, T, 1536 + col0, mu, v);
        if (cg < 16) {
#pragma unroll
            for (int i = 0; i < 8; ++i) { const float e = __expf(2.f * v[i]); v[i] = 1.f - 2.f * __builtin_amdgcn_rcpf(e + 1.f); }
        } else if (cg >= 32) {
#pragma unroll
            for (int i = 0; i < 8; ++i) v[i] = __builtin_amdgcn_rcpf(1.f + __expf(-v[i]));
        }
        *(uint4*)(p.LR + (size_t)row * 384 + col0) = pack8u(v);
    }
}

template <bool FINAL>
DI void ph_normc(const Ctx& cx, const Params& p, int nrows, const bf16_t* xin_lat, bf16_t* xout_lat, const float* gain, const float* modl, const float* modprev) {
    const int tid = cx.tid, wid = tid >> 6, lane = tid & 63;
    for (int row = cx.bid * 8 + wid; row < nrows; row += cx.nblk * 8) {
        const bool lat = row < NLAT; const int jj = lat ? (row >> 11) : 16; const size_t rb = lat ? (size_t)row : (size_t)(row - NLAT);
        const bf16_t* xr = (lat ? xin_lat : p.cs) + rb * 1024;
        const float* g2 = modprev + (size_t)jj * 6144 + 5 * 1024;
        float4 xv[4];
#pragma unroll
        for (int i = 0; i < 4; ++i) {
            const int col = i * 256 + lane * 4;
            const uint2 ux = *(const uint2*)(xr + col);
            float s0 = 0.f, s1 = 0.f, s2 = 0.f, s3 = 0.f;
#pragma unroll
            for (int sl = 0; sl < 3; ++sl) { const uint2 u = *(const uint2*)(p.Y + ((size_t)sl * NT + row) * 1024 + col); s0 += bflo(u.x); s1 += bfhi(u.x); s2 += bflo(u.y); s3 += bfhi(u.y); }
            const float4 gv = *(const float4*)(g2 + col);
            xv[i].x = bflo(ux.x) + gv.x * s0; xv[i].y = bfhi(ux.x) + gv.y * s1; xv[i].z = bflo(ux.y) + gv.z * s2; xv[i].w = bfhi(ux.y) + gv.w * s3;
            if (FINAL) *(float4*)(p.out + (size_t)row * 1024 + col) = xv[i];
            else { uint2 o; o.x = att_pk(xv[i].x, xv[i].y); o.y = att_pk(xv[i].z, xv[i].w); *(uint2*)((lat ? xout_lat : p.cs) + rb * 1024 + col) = o; }
        }
        if (!FINAL) {
            float ss = 0.f;
#pragma unroll
            for (int i = 0; i < 4; ++i) ss += xv[i].x * xv[i].x + xv[i].y * xv[i].y + xv[i].z * xv[i].z + xv[i].w * xv[i].w;
            ss = wave_sum(ss);
            const float rstd = rsqrtf(ss * (1.f / 1024.f) + 1e-6f);
            const float* shp = modl + (size_t)jj * 6144; const float* scp = modl + (size_t)jj * 6144 + 1024;
#pragma unroll
            for (int i = 0; i < 4; ++i) {
                const int col = i * 256 + lane * 4;
                const float4 g = *(const float4*)(gain + col), sh = *(const float4*)(shp + col), sc = *(const float4*)(scp + col);
                uint2 u; u.x = att_pk(xv[i].x * rstd * g.x * (1.f + sc.x) + sh.x, xv[i].y * rstd * g.y * (1.f + sc.y) + sh.y);
                u.y = att_pk(xv[i].z * rstd * g.z * (1.f + sc.z) + sh.z, xv[i].w * rstd * g.w * (1.f + sc.w) + sh.w);
                *(uint2*)(p.H + (size_t)row * 1024 + col) = u;
            }
        }
    }
}

struct F1Sched {
    static constexpr bool GATHER = false, TABLE = false;
    const char* A; const char* Hb; int T2, nN, G, c;
    DI size_t hstep_a() const { return (size_t)mm::HALF * 1024 * 2; }
    DI unsigned boff(int Rb, int C, int Kk) const { return (unsigned)(Rb * T2 * Kk + C) * 2u; }
    DI size_t hstep_b(int Kk) const { return (size_t)Kk * 2; }
    DI bool next(int i, mm::Unit& u) const {
        const int L = i * G + c; if (L >= 8 * nN) return false;
        u.pm = L & 7; u.pn = L >> 3; u.e = 0; u.m = 0;
        const int b = (T2 == 16) ? (u.pn >> 3) : u.pn, t20 = (T2 == 16) ? 2 * (u.pn & 7) : 0;
        u.A = A + (size_t)u.pm * 256 * 1024 * 2; u.B = Hb + ((size_t)b * (128 * T2) + t20) * 1024 * 2; return true;
    }
    DI void aoff(const mm::Unit&, int R0, int C0, int R1, int C1, unsigned (&o)[2][2]) const {
        o[0][0] = (unsigned)(R0 * 1024 + C0) * 2u; o[0][1] = (unsigned)(R1 * 1024 + C1) * 2u; o[1][0] = o[0][0]; o[1][1] = o[0][1];
    }
};
struct EpiZT3 {
    static constexpr bool PERM = true;
    bf16_t* Z; int T2;
    DI void operator()(const mm::f32x4 (&acc)[2][2][4][2], const mm::Unit& u, int wr, int wc, int fr, int fq) const {
        const int b = (T2 == 16) ? (u.pn >> 3) : u.pn, t20 = (T2 == 16) ? 2 * (u.pn & 7) : 0;
        const int m0 = u.pm * 256 + wr * 64 + fr, t1 = wc * 32 + 8 * fq;
#pragma unroll
        for (int ai = 0; ai < 2; ++ai)
#pragma unroll
            for (int m = 0; m < 4; ++m) { const int mr = m0 + ai * 128 + m * 16, part = mr >> 10, ch = mr & 1023;
#pragma unroll
                for (int bj = 0; bj < 2; ++bj) { const mm::f32x4 v0 = acc[ai][bj][m][0], v1 = acc[ai][bj][m][1];
                    mm::u32x4 w; w.x = att_pk(v0[0], v0[1]); w.y = att_pk(v0[2], v0[3]); w.z = att_pk(v1[0], v1[1]); w.w = att_pk(v1[2], v1[3]);
                    *(mm::u32x4*)(Z + ((size_t)(b * 1024 + ch) * T2 + t20 + bj) * 256 + part * 128 + t1) = w; } }
    }
};
DI void ph_f1b(const Ctx& cx, const Params& p, float* lds, int j, bool with_ctx) {
    { F1Sched S{(const char*)(p.A1 + (size_t)j * 2048 * 1024), (const char*)p.H, 16, NLAT / 256, cx.nblk, cx.bid}; EpiZT3 E{p.ZT, 16}; mm::gemm_phase(GEMM_LDS(lds), 1024, S, E, cx.tid); }
    if (with_ctx) { F1Sched S{(const char*)(p.A1 + (size_t)j * 2048 * 1024), (const char*)(p.H + (size_t)NLAT * 1024), 2, NCTX / 256, cx.nblk, cx.bid}; EpiZT3 E{p.ZTC, 2}; mm::gemm_phase(GEMM_LDS(lds), 1024, S, E, cx.tid); }
}
DI void ph_fa(const Ctx& cx, const Params& p, float* lds, bool with_ctx) {
    int Kr = 256; asm volatile("" : "+s"(Kr));
    { mm::BatchSched S; S.init(p.M1, p.ZT, (size_t)16384 * 256 * 2, 16, 256, 16384, Kr, cx.nblk, cx.bid); mm::EpiBf16Store E{p.YF1, 16384, (size_t)256 * 16384}; mm::gemm_phase(GEMM_LDS(lds), Kr, S, E, cx.tid); }
    if (with_ctx) { mm::BatchSched S; S.init(p.M1, p.ZTC, (size_t)2048 * 256 * 2, 16, 256, 2048, Kr, cx.nblk, cx.bid); mm::EpiBf16Store E{p.YF1c, 2048, (size_t)256 * 2048}; mm::gemm_phase(GEMM_LDS(lds), Kr, S, E, cx.tid); }
}
template <int T2>
DI void fb_items(const Ctx& cx, const Params& p, const LAS float* tw, const bf16_t* Y, const bf16_t* xin, bf16_t* xout, const float* modl, bool ctx, float scale) {
    constexpr int T = 128 * T2; constexpr size_t NB = (size_t)1024 * T2;
    const int gtid = cx.bid * NTHR + cx.tid, gsz = cx.nblk * NTHR;
    for (int idx = gtid; idx < 16 * 128 * 512; idx += gsz) {
        const int cp = idx & 511, f1 = (idx >> 9) & 127, b = idx >> 16;
        float yr[2][T2], yi[2][T2];
        { const bf16_t* pr = Y + ((size_t)b * 256 + f1) * NB + (size_t)(2 * cp) * T2; const bf16_t* pi = pr + (size_t)128 * NB;
          if constexpr (T2 == 2) { const uint2 ur = *(const uint2*)pr, ui = *(const uint2*)pi;
              yr[0][0] = bflo(ur.x); yr[0][1] = bfhi(ur.x); yr[1][0] = bflo(ur.y); yr[1][1] = bfhi(ur.y); yi[0][0] = bflo(ui.x); yi[0][1] = bfhi(ui.x); yi[1][0] = bflo(ui.y); yi[1][1] = bfhi(ui.y); }
          else {
#pragma unroll
          for (int q = 0; q < (2 * T2) / 8; ++q) { float d[8]; unpack8u(*(const uint4*)(pr + q * 8), d);
#pragma unroll
              for (int e = 0; e < 8; ++e) yr[(q * 8 + e) / T2][(q * 8 + e) % T2] = d[e];
              unpack8u(*(const uint4*)(pi + q * 8), d);
#pragma unroll
              for (int e = 0; e < 8; ++e) yi[(q * 8 + e) / T2][(q * 8 + e) % T2] = d[e]; } } }
        const int jj = ctx ? 16 : b; const float2 g1 = *(const float2*)(modl + (size_t)jj * 6144 + 2 * 1024 + 2 * cp);
        constexpr int FG = (T2 >= 4) ? 4 : T2;
#pragma unroll 1
        for (int fg = 0; fg < T2; fg += FG) {
            unsigned xv[FG];
#pragma unroll
            for (int q = 0; q < FG; ++q) xv[q] = *(const unsigned*)(xin + ((size_t)b * T + f1 + 128 * (fg + q)) * 1024 + 2 * cp);
#pragma unroll
            for (int q = 0; q < FG; ++q) {
                const int f = f1 + 128 * (fg + q); float a0 = 0.f, a1 = 0.f;
#pragma unroll
                for (int t2 = 0; t2 < T2; ++t2) { const int mi = ((t2 * f) & (T - 1)) * (2048 / T); const float cs = tw[2 * mi], sn = tw[2 * mi + 1];
                    a0 += cs * yr[0][t2] + sn * yi[0][t2]; a1 += cs * yr[1][t2] + sn * yi[1][t2]; }
                *(unsigned*)(xout + ((size_t)b * T + f) * 1024 + 2 * cp) = att_pk(bflo(xv[q]) + g1.x * scale * a0, bfhi(xv[q]) + g1.y * scale * a1);
            }
        }
    }
}
DI void fb_mfma(const Ctx& cx, const Params& p, const LAS float* tw, const bf16_t* Y, const bf16_t* xin, bf16_t* xout, const float* modl) {
    typedef short bf16x8 __attribute__((ext_vector_type(8)));
    constexpr size_t NB = (size_t)1024 * 16;
    const int tid = cx.tid, wid = tid >> 6, lane = tid & 63, lq = lane >> 4, lr = lane & 15;
    const int part = lq >> 1, t20 = 8 * (lq & 1);
    for (int item = cx.bid * 8 + wid; item < 16 * 128 * 32; item += cx.nblk * 8) {
        const int cb = item & 31, f1 = (item >> 5) & 127, b = item >> 12, c0 = cb * 32;
        const bf16_t* yb = Y + ((size_t)b * 256 + part * 128 + f1) * NB + t20;
        const int chA = c0 + 8 * (lr >> 2) + (lr & 3);
        const bf16x8 a0 = *(const bf16x8*)(yb + (size_t)chA * 16), a1 = *(const bf16x8*)(yb + (size_t)(chA + 4) * 16);
        const int f = f1 + 128 * lr;
        mm::u32x4 bw;
        { float tv[8];
#pragma unroll
          for (int jj = 0; jj < 8; ++jj) { const int mi = ((t20 + jj) * f) & 2047; tv[jj] = tw[2 * mi + part]; }
          bw.x = att_pk(tv[0], tv[1]); bw.y = att_pk(tv[2], tv[3]); bw.z = att_pk(tv[4], tv[5]); bw.w = att_pk(tv[6], tv[7]); }
        const bf16x8 bf = __builtin_bit_cast(bf16x8, bw);
        mm::f32x4 d0 = {0.f, 0.f, 0.f, 0.f}, d1 = d0;
        d0 = __builtin_amdgcn_mfma_f32_16x16x32_bf16(a0, bf, d0, 0, 0, 0);
        d1 = __builtin_amdgcn_mfma_f32_16x16x32_bf16(a1, bf, d1, 0, 0, 0);
        const float* g1 = modl + (size_t)b * 6144 + 2 * 1024 + c0 + 8 * lq;
        const mm::f32x4 g0 = *(const mm::f32x4*)g1, g4 = *(const mm::f32x4*)(g1 + 4);
        const size_t off = ((size_t)b * 2048 + f) * 1024 + c0 + 8 * lq;
        const mm::u32x4 xv = *(const mm::u32x4*)(xin + off);
        const float sc = 1.f / 512.f;
        mm::u32x4 o;
        o.x = att_pk(bflo(xv.x) + g0[0] * sc * d0[0], bfhi(xv.x) + g0[1] * sc * d0[1]); o.y = att_pk(bflo(xv.y) + g0[2] * sc * d0[2], bfhi(xv.y) + g0[3] * sc * d0[3]);
        o.z = att_pk(bflo(xv.z) + g4[0] * sc * d1[0], bfhi(xv.z) + g4[1] * sc * d1[1]); o.w = att_pk(bflo(xv.w) + g4[2] * sc * d1[2], bfhi(xv.w) + g4[3] * sc * d1[3]);
        *(mm::u32x4*)(xout + off) = o;
    }
}
DI void ph_fb(const Ctx& cx, const Params& p, float* ldsg, bool with_ctx, const bf16_t* xin_lat, bf16_t* xout_lat, const float* modl) {
    LAS float* tw = (LAS float*)ldsg;
    for (int i = cx.tid; i < 2048; i += NTHR) { const float a = (float)i * (1.f / 1024.f); tw[2 * i] = cospif(a); tw[2 * i + 1] = sinpif(a); }
    __syncthreads();
    fb_mfma(cx, p, tw, p.YF1, xin_lat, xout_lat, modl);
    if (with_ctx) fb_items<2>(cx, p, tw, p.YF1c, p.cs, p.cs, modl, true, 0.0055242717280199f);
    __syncthreads();
}

DI void ph_norm2_router_mfma(const Ctx& cx, const Params& p, float* ldsg, int nrows, const float* gain, const float* modl, int layer, const bf16_t* xb_lat) {
    LAS float* lds = (LAS float*)ldsg;
    const int tid = cx.tid, wid = tid >> 6, lane = tid & 63, lq = lane >> 4, lr = lane & 15;
    constexpr int HP = 1026;
    LAS float* wl = lds; LAS float* hb = lds + 16384; LAS float* red = hb + 16 * HP; LAS float* myall = red + 2048;
    LAS int* lcnt = (LAS int*)(myall + 512); LAS int* lbase = lcnt + 16; LAS int* rlist = lcnt + 32;
    for (int i = tid; i < 16384; i += NTHR) wl[i] = p.router_w[i];
    if (tid < 16) lcnt[tid] = 0;
    __syncthreads();
    int nlist = 0;
    for (int grp = cx.bid; grp < (nrows >> 4); grp += cx.nblk) {
        const int row0 = 16 * grp + 2 * wid; const int jj = (row0 < NLAT) ? (row0 >> 11) : 16;
        const float* shp = modl + (size_t)jj * 6144 + 3 * 1024; const float* scp = modl + (size_t)jj * 6144 + 4 * 1024;
        float4 xv[2][4];
#pragma unroll
        for (int r = 0; r < 2; ++r) { const int row = row0 + r; const bf16_t* xr = (row < NLAT) ? xb_lat + (size_t)row * 1024 : p.cs + (size_t)(row - NLAT) * 1024;
#pragma unroll
            for (int i = 0; i < 4; ++i) { const uint2 u = *(const uint2*)(xr + i * 256 + lane * 4); xv[r][i] = make_float4(bflo(u.x), bfhi(u.x), bflo(u.y), bfhi(u.y)); } }
#pragma unroll
        for (int r = 0; r < 2; ++r) {
            float ss = 0.f;
#pragma unroll
            for (int i = 0; i < 4; ++i) ss += xv[r][i].x * xv[r][i].x + xv[r][i].y * xv[r][i].y + xv[r][i].z * xv[r][i].z + xv[r][i].w * xv[r][i].w;
            ss = wave_sum(ss);
            const float rstd = rsqrtf(ss * (1.f / 1024.f) + 1e-6f);
#pragma unroll
            for (int i = 0; i < 4; ++i) {
                const int col = i * 256 + lane * 4;
                const float4 g = *(const float4*)(gain + col), sh = *(const float4*)(shp + col), sc = *(const float4*)(scp + col);
                const float h0 = xv[r][i].x * rstd * g.x * (1.f + sc.x) + sh.x, h1 = xv[r][i].y * rstd * g.y * (1.f + sc.y) + sh.y;
                const float h2 = xv[r][i].z * rstd * g.z * (1.f + sc.z) + sh.z, h3 = xv[r][i].w * rstd * g.w * (1.f + sc.w) + sh.w;
                uint2 u; u.x = att_pk(h0, h1); u.y = att_pk(h2, h3);
                *(uint2*)(p.H + (size_t)(row0 + r) * 1024 + col) = u;
                LAS float* hp = hb + (2 * wid + r) * HP + col;
                *(LAS scan::f32x2*)hp = (scan::f32x2){h0, h1}; *(LAS scan::f32x2*)(hp + 2) = (scan::f32x2){h2, h3};
            }
        }
        __syncthreads();
        {
            mm::f32x4 acc = {0.f, 0.f, 0.f, 0.f};
            const LAS float* ap = hb + lr * HP + 128 * wid + lq; const LAS float* bp = wl + (128 * wid + lq) * 16 + lr;
#pragma unroll 8
            for (int s = 0; s < 32; ++s) acc = __builtin_amdgcn_mfma_f32_16x16x4f32(ap[4 * s], bp[64 * s], acc, 0, 0, 0);
#pragma unroll
            for (int q = 0; q < 4; ++q) red[wid * 256 + (4 * lq + q) * 16 + lr] = acc[q];
        }
        __syncthreads();
        if (tid < 256) { const int row = tid >> 4, e = tid & 15; float sacc = 0.f;
#pragma unroll
            for (int w = 0; w < 8; ++w) sacc += red[w * 256 + row * 16 + e];
            const float sg = 1.f / (1.f + __expf(-sacc));
            myall[row * 32 + e] = sg; myall[row * 32 + 16 + e] = sg + p.router_b[e]; }
        __syncthreads();
        if ((lane & 31) == 0) {
            const int r = lane >> 5; const LAS float* m = myall + (2 * wid + r) * 32;
            float best = -3.0e38f; int be1 = 0, be2 = 1;
#pragma unroll
            for (int g = 0; g < 4; ++g) {
                const mm::f32x4 v = *(const LAS mm::f32x4*)(m + 16 + 4 * g);
                int i1 = 0; float m1 = v[0];
                if (v[1] > m1) { m1 = v[1]; i1 = 1; } if (v[2] > m1) { m1 = v[2]; i1 = 2; } if (v[3] > m1) { m1 = v[3]; i1 = 3; }
                int i2 = -1; float m2 = -3.0e38f;
                if (i1 != 0 && v[0] > m2) { m2 = v[0]; i2 = 0; } if (i1 != 1 && v[1] > m2) { m2 = v[1]; i2 = 1; }
                if (i1 != 2 && v[2] > m2) { m2 = v[2]; i2 = 2; } if (i1 != 3 && v[3] > m2) { m2 = v[3]; i2 = 3; }
                const float gs = m1 + m2;
                if (gs > best) { best = gs; be1 = 4 * g + i1; be2 = 4 * g + i2; }
            }
            const float bs1 = m[be1], bs2 = m[be2]; const float inv = 1.f / (bs1 + bs2);
            const int p1 = atomicAdd((int*)&lcnt[be1], 1), p2 = atomicAdd((int*)&lcnt[be2], 1);
            LAS int* ent = rlist + (wid * 24 + nlist * 2 + r) * 6;
            ent[0] = row0 + r; ent[1] = be1 | (be2 << 8); ent[2] = p1; ent[3] = p2; ent[4] = __float_as_int(bs1 * inv); ent[5] = __float_as_int(bs2 * inv);
        }
        ++nlist;
    }
    __syncthreads();
    if (tid < 16) lbase[tid] = atomicAdd(p.cnt + (layer * 16 + tid) * 64, lcnt[tid]);
    __syncthreads();
    for (int k = lane; k < 2 * nlist; k += 64) {
        const LAS int* ent = rlist + (wid * 24 + k) * 6; const int row = ent[0], be1 = ent[1] & 255, be2 = ent[1] >> 8;
        const size_t s1 = (size_t)be1 * NT + lbase[be1] + ent[2], s2 = (size_t)be2 * NT + lbase[be2] + ent[3];
        p.slot[s1] = row * 2; p.slot[s2] = row * 2 + 1; p.slotw[s1] = __int_as_float(ent[4]); p.slotw[s2] = __int_as_float(ent[5]);
    }
    __syncthreads();
}

template <int PH>
DI void run_phase(const Params& p, float* lds, int L, int wave_id) {
    const Ctx cx = make_ctx(wave_id);
    const int j = L >> 1;
    const float* modl = p.mod + (size_t)L * 17 * 6144;
    const float* modprev = p.mod + (size_t)(L > 0 ? L - 1 : 0) * 17 * 6144;
    const bool last = (L == 3);
    const int rows_layer = (L == 3) ? NLAT : NT;
    const int rows_out = (L >= 2) ? NLAT : NT;
    const float* xin_lat = (L == 0) ? p.x : p.out; const float* xin_ctx = (L == 0) ? p.ctx : p.ctxs;
    constexpr bool BFS = (OPT >= 11);
    const void* bin_lat = (L == 0) ? (const void*)p.x : (const void*)p.xs; const void* bin_ctx = (L == 0) ? (const void*)p.ctx : (const void*)p.cs;
    bf16_t* bout_lat = (L == 3) ? p.xs3 : p.xs;
    if constexpr (PH == 0) { if (OPT >= 7) { ph_mod_opt(cx, p, lds); for (int i = cx.bid * NTHR + cx.tid; i < 1024; i += cx.nblk * NTHR) p.H[(size_t)NT * 1024 + i] = 0; } else ph_prologue(cx, p, lds); ph_prep_weights(cx, p, lds); }
    if constexpr (PH == 1) {
        if (OPT >= 4 && !PROBE_SPLIT1) ph_prep_moe(cx, p, lds, L);
        if (BFS && L > 0) { ph_normc<false>(cx, p, rows_layer, p.xs, p.xs, p.norm1_g + L * 1024, modl, modprev); return; }
        if (L == 0) ph_norm<false, true, false>(cx, p, lds, rows_layer, xin_lat, xin_ctx, p.norm1_g + L * 1024, modl, 0, 1, modprev, L);
        else ph_norm<true, true, false>(cx, p, lds, rows_layer, xin_lat, xin_ctx, p.norm1_g + L * 1024, modl, 0, 1, modprev, L);
    }
    if constexpr (PH == 2) { if (OPT >= 1) ph_win_mm(cx, p, lds, j); else ph_win(cx, p, lds, j); }
    if constexpr (PH == 3) { if (OPT >= 10) ph_prepBLR_opt(cx, p, j); else ph_prepB(cx, p, j); }
    if constexpr (PH == 4) { if (OPT >= 2) ph_qkvup_mm(cx, p, lds, j, rows_out); else ph_qkvup(cx, p, lds, j, rows_out); }
    if constexpr (PH == 5) { if (OPT >= 7) ph_finalize_opt(cx, p, lds, j, rows_out); else ph_finalize(cx, p, j, rows_out); }
    if constexpr (PH == 6) { if (OPT >= 5) ph_attn_mm(cx, p, lds, rows_out == NT); else ph_attn(cx, p, rows_out == NT); }
    if constexpr (PH == 7) { if (OPT < 10) ph_prepLR(cx, p, j); }
    if constexpr (PH == 8) { if (OPT >= 2) ph_wag_mm(cx, p, lds, j); else ph_wag(cx, p, lds, j); }
    if constexpr (PH == 9) { if (OPT >= 9) ph_scan_chunk<0>(cx, p, lds, j); else if (OPT >= 6) ph_scan_opt<0>(cx, p, lds, j); else ph_scan(cx, p, lds, j); }
    if constexpr (PH == 19) ph_scan_chunk<PROBE_SCAN>(cx, p, lds, j);
    if constexpr (PH == 20) ph_prep_moe(cx, p, lds, L);
    if constexpr (PH == 21) ph_win_probe(cx, p, lds, j);
    if constexpr (PH == 10) { if (OPT >= 7) ph_post_opt(cx, p, j, rows_out); else ph_post(cx, p, j, rows_out); }
    if constexpr (PH == 11) { if (BFS) ph_wout_mmB(cx, p, lds, p.H, p.WoutT + (size_t)j * 1024 * 1024, rows_out, bin_lat, bin_ctx, bout_lat, L == 0, modl); else if (OPT >= 1) ph_wout_mm(cx, p, lds, p.H, p.WoutT + (size_t)j * 1024 * 1024, rows_out, xin_lat, xin_ctx, modl); else ph_wout(cx, p, lds, p.H, p.w_out_even + (size_t)j * 1024 * 1024, rows_out, xin_lat, xin_ctx, modl); }
    if constexpr (PH == 12) { if (OPT >= 12) ph_f1b(cx, p, lds, j, !last); else if (OPT >= 3) ph_f1_mm(cx, p, lds, j, !last); else ph_chdft(cx, p, lds, rows_layer); }
    if constexpr (PH == 13) { if (OPT >= 12) ph_fa(cx, p, lds, !last); else if (BFS) ph_f2_mmB(cx, p, lds, !last, bin_lat, bin_ctx, bout_lat, modl); else if (OPT >= 3) ph_f2_mm(cx, p, lds, !last, xin_lat, xin_ctx, modl); else ph_posdft(cx, p, lds, !last); }
    if constexpr (PH == 14) { if (OPT >= 12) ph_fb(cx, p, lds, !last, p.xs, bout_lat, modl); }
    if constexpr (PH == 14) { if (OPT < 3) ph_wout(cx, p, lds, p.F, p.w_out_fourier + (size_t)j * 1024 * 1024, rows_out, xin_lat, xin_ctx, modl); }
    if constexpr (PH == 15) { if (OPT >= 13) ph_norm2_router_mfma(cx, p, lds, rows_out, p.norm2_g + L * 1024, modl, L, bout_lat); else if (OPT >= 8) ph_norm2_router(cx, p, lds, rows_out, p.norm2_g + L * 1024, modl, L, BFS ? bout_lat : (const bf16_t*)nullptr); else ph_norm<false, true, true>(cx, p, lds, rows_out, p.out, p.ctxs, p.norm2_g + L * 1024, modl, 3, 4, modprev, L); }
    if constexpr (PH == 16) { if (OPT >= 4) ph_moe_up_mm(cx, p, lds, L, rows_out); else ph_moe_up(cx, p, lds, L, rows_out); }
    if constexpr (PH == 17) { if (OPT >= 4) ph_moe_down_mm(cx, p, lds, L, rows_out); else ph_moe_down(cx, p, lds, L, rows_out); }
    if constexpr (PH == 18) { if (BFS) { ph_normc<true>(cx, p, NLAT, p.xs3, nullptr, p.norm1_g, p.mod + (size_t)3 * 17 * 6144, p.mod + (size_t)3 * 17 * 6144); return; } }
    if constexpr (PH == 18) ph_norm<true, false, false>(cx, p, lds, NLAT, p.out, p.ctxs, p.norm1_g, p.mod + (size_t)3 * 17 * 6144, 0, 1, p.mod + (size_t)3 * 17 * 6144, 3);
}

template <int PH>
__global__ void __launch_bounds__(NTHR, 2) k_phase(Params p, int L) {
    extern __shared__ __attribute__((aligned(16))) float shm[];
    run_phase<PH>(p, shm, L, (int)(threadIdx.x >> 6));
}

#if ONE_LAUNCH
constexpr int PARAM_WORDS = (int)(sizeof(Params) / 4);
DI Params load_params(const unsigned* lp) {
    Params q; unsigned* d = (unsigned*)&q;
#pragma unroll
    for (int i = 0; i < PARAM_WORDS; ++i) d[i] = (unsigned)__builtin_amdgcn_readfirstlane((int)lp[i]);
    void** pp = (void**)&q;
#pragma unroll
    for (int i = 0; i < PARAM_WORDS / 2; ++i) pp[i] = (void*)(__attribute__((address_space(1))) void*)pp[i];
    return q;
}
#ifndef PROBE_MASK
#define PROBE_MASK 0u
#endif

#define PHASE(PH, L) do { unsigned long long t0_ = 0; if (PROBE_MASK & (1u << (PH))) t0_ = wall_clock64(); \
    { run_phase<PH>(p, lds, (L), wave_id); } xcd_barrier(bar, wave_id == 0 && lane_id_asm() == 0); \
    if (PROBE_MASK & (1u << (PH))) tacc += wall_clock64() - t0_; } while (0)
__global__ void __launch_bounds__(NTHR, 2) k_mega(Params p) {
    extern __shared__ __attribute__((aligned(16))) float shm[];
    unsigned* lp = (unsigned*)(shm + 4);
    float* lds = shm + 4 + ((PARAM_WORDS + 3) & ~3);
    if (threadIdx.x == 0) { shm[0] = 0.f; shm[1] = 0.f; shm[2] = 0.f; shm[3] = 0.f; }
    if (threadIdx.x < PARAM_WORDS) lp[threadIdx.x] = ((const unsigned*)&p)[threadIdx.x];
    __syncthreads();
    XcdBarrier bar; { const Params q_ = load_params(lp); bar = xcd_barrier_post(q_.bar, (volatile LAS unsigned*)shm); }
    unsigned long long tacc = 0;
    const int wave_id = __builtin_amdgcn_readfirstlane((int)(threadIdx.x >> 6));
    PHASE(0, 0);
#define LAYER_EVEN(L) if (PROBE_SPLIT1) { PHASE(20, L); } PHASE(1, L); PHASE(2, L); if (PROBE_GEMM) { PHASE(21, L); } PHASE(3, L); PHASE(4, L); PHASE(5, L); PHASE(6, L); if (OPT < 10) { PHASE(7, L); } PHASE(8, L); PHASE(9, L); if (PROBE_SCAN) { PHASE(19, L); } PHASE(10, L); PHASE(11, L); PHASE(15, L); PHASE(16, L); PHASE(17, L)
#define LAYER_ODD(L) if (PROBE_SPLIT1) { PHASE(20, L); } PHASE(1, L); PHASE(12, L); PHASE(13, L); if (OPT < 3 || OPT >= 12) { PHASE(14, L); } PHASE(15, L); PHASE(16, L); PHASE(17, L)
    LAYER_EVEN(0); LAYER_ODD(1); LAYER_EVEN(2); LAYER_ODD(3);
    { unsigned long long t0_ = 0; if (PROBE_MASK & (1u << 18)) t0_ = wall_clock64(); run_phase<18>(p, lds, 3, wave_id);
      if (PROBE_MASK & (1u << 18)) { xcd_barrier(bar, wave_id == 0 && lane_id_asm() == 0); tacc += wall_clock64() - t0_; } }
    if (PROBE_MASK != 0u && blockIdx.x == 0 && threadIdx.x == 0) {
        const unsigned long long t1 = wall_clock64(); while (wall_clock64() - t1 < 20ull * tacc) __builtin_amdgcn_s_sleep(8); }
}
#endif

static inline size_t al256(size_t v) { return (v + 255) & ~(size_t)255; }
constexpr size_t LDS_BYTES = 148 * 1024;

template <int PH> static void launch_phase(const Params& p, int L, int grid, hipStream_t s) {
    static bool attr = false;
    if (!attr) { hipFuncSetAttribute((const void*)k_phase<PH>, hipFuncAttributeMaxDynamicSharedMemorySize, (int)LDS_BYTES); attr = true; }
    hipLaunchKernelGGL(k_phase<PH>, dim3(grid), dim3(NTHR), LDS_BYTES, s, p, L);
}

extern "C" void kernel_launch(void* const* d_in, const int* in_sizes, int n_in, void* d_out, int out_size, void* d_ws, size_t ws_size, hipStream_t stream) {
    (void)in_sizes; (void)n_in; (void)out_size;
    Params p{};
    const float** ip = (const float**)&p.x;
    for (int i = 0; i < 36; ++i) ip[i] = (const float*)d_in[i];
    p.out = (float*)d_out;
    char* w = (char*)d_ws; size_t o = 0;
    auto take = [&](size_t bytes) { char* r = w + o; o += al256(bytes); return r; };
    p.bar = (unsigned*)take(XCD_BAR_WORDS * 4);
    p.cnt = (int*)take(64 * 64 * 4);
    const size_t zero_bytes = o;
    p.mod = (float*)take((size_t)4 * 17 * 6144 * 4);
    p.ctxs = (float*)take((size_t)NCTX * 1024 * 4);
    p.dftl = (bf16_t*)take((size_t)2048 * 4096 * 2);
    p.dftc = (bf16_t*)take((size_t)256 * 512 * 2);
    p.slot = (int*)take((size_t)16 * NT * 4);
    p.tokw = (float*)take((size_t)NT * 2 * 4);
    p.slotw = (float*)take((size_t)16 * NT * 4);
    p.H = (bf16_t*)take((size_t)(NT + 1) * 1024 * 2);
    char* big = w + o;
    p.P = (bf16_t*)take((size_t)NT * PLD * 2);
    char* r1 = w + o;
    p.WAG = (bf16_t*)take((size_t)NT * WLD * 2);
    p.YF = (bf16_t*)take((size_t)NT * 512 * 2);
    p.YB = (bf16_t*)take((size_t)NT * 512 * 2);
    p.LR = (bf16_t*)take((size_t)NT * 384 * 2);
    p.WinT = (bf16_t*)take((size_t)2 * 2560 * 1024 * 2); p.WqT = (bf16_t*)take((size_t)2 * 768 * 256 * 2); p.WkvT = (bf16_t*)take((size_t)2 * 1024 * 256 * 2);
    p.WlrT = (bf16_t*)take((size_t)2 * 2560 * 384 * 2); p.WoutT = (bf16_t*)take((size_t)2 * 1024 * 1024 * 2); p.A1 = (bf16_t*)take((size_t)2 * 2048 * 1024 * 2);
    p.A2 = (bf16_t*)take((size_t)2048 * 4096 * 2); p.A2c = (bf16_t*)take((size_t)256 * 512 * 2); p.M1 = (bf16_t*)take((size_t)256 * 256 * 2);
    p.WguT = (bf16_t*)take((size_t)17 * 1024 * 1024 * 2); p.WdT = (bf16_t*)take((size_t)17 * 1024 * 512 * 2);
    const size_t total = o;
    { size_t q = 0; auto t2 = [&](size_t bytes) { char* r = r1 + q; q += al256(bytes); return r; };
      p.QN = (bf16_t*)t2((size_t)NT * 512 * 2); p.Qraw = (bf16_t*)t2((size_t)NT * 768 * 2); p.KVraw = (bf16_t*)t2((size_t)NT * 1024 * 2);
      p.Kf = (bf16_t*)t2((size_t)NB * 8 * 2304 * 96 * 2); p.Vt = (bf16_t*)t2((size_t)NB * 8 * 64 * 2304 * 2); }
    { size_t q = 0; auto t3 = [&](size_t bytes) { char* r = big + q; q += al256(bytes); return r; };
      p.ACT = (bf16_t*)t3((size_t)3 * NT * 512 * 2); p.Y = (bf16_t*)t3((size_t)3 * NT * 1024 * 2); }
    { size_t q = 0; auto t4 = [&](size_t bytes) { char* r = big + q; q += al256(bytes); return r; };
      p.G = (float*)t4((size_t)NT * 2048 * 4); p.F = (bf16_t*)t4((size_t)NT * 1024 * 2); }
    { size_t q = 0; auto t5 = [&](size_t bytes) { char* r = big + q; q += al256(bytes); return r; };
      p.ZT = (bf16_t*)t5((size_t)16 * 1024 * 4096 * 2); p.ZTC = (bf16_t*)t5((size_t)16 * 1024 * 512 * 2);
      p.YF1 = (bf16_t*)t5((size_t)256 * 16 * 1024 * 16 * 2); p.YF1c = (bf16_t*)t5((size_t)256 * 16 * 1024 * 2 * 2); }
    p.xs = (bf16_t*)d_out; p.cs = (bf16_t*)p.ctxs; p.xs3 = (bf16_t*)(big + (size_t)344 * 1024 * 1024);
    if (total > ws_size) { fprintf(stderr, "workspace too small: need %zu have %zu\n", total, ws_size); return; }
    static int grid = 0;
    if (!grid) { int dev = 0, cus = 0; hipGetDevice(&dev); hipDeviceGetAttribute(&cus, hipDeviceAttributeMultiprocessorCount, dev); grid = cus > 0 ? cus : 256; if (grid > 256) grid = 256; }
    hipMemsetAsync(d_ws, 0, zero_bytes, stream);
#if ONE_LAUNCH
    static bool attr = false;
    if (!attr) { hipFuncSetAttribute((const void*)k_mega, hipFuncAttributeMaxDynamicSharedMemorySize, (int)LDS_BYTES); attr = true; }
    hipLaunchKernelGGL(k_mega, dim3(grid), dim3(NTHR), LDS_BYTES, stream, p);
#else
    launch_phase<0>(p, 0, grid, stream);
    for (int L = 0; L < 4; ++L) {
        launch_phase<1>(p, L, grid, stream);
        if ((L & 1) == 0) {
            launch_phase<2>(p, L, grid, stream); launch_phase<3>(p, L, grid, stream); launch_phase<4>(p, L, grid, stream); launch_phase<5>(p, L, grid, stream);
            launch_phase<6>(p, L, grid, stream); launch_phase<7>(p, L, grid, stream); launch_phase<8>(p, L, grid, stream); launch_phase<9>(p, L, grid, stream);
            launch_phase<10>(p, L, grid, stream); launch_phase<11>(p, L, grid, stream);
        } else {
            launch_phase<12>(p, L, grid, stream); launch_phase<13>(p, L, grid, stream); launch_phase<14>(p, L, grid, stream);
        }
        launch_phase<15>(p, L, grid, stream); launch_phase<16>(p, L, grid, stream); launch_phase<17>(p, L, grid, stream);
    }
    launch_phase<18>(p, 3, grid, stream);
#endif
}
```

```cpp
#include <hip/hip_runtime.h>
#include <cstdio>
#include <cstdint>

#ifndef ONE_LAUNCH
#define ONE_LAUNCH 1
#endif
#ifndef PROBE_SCAN
#define PROBE_SCAN 0
#endif
#ifndef PROBE_SPLIT1
#define PROBE_SPLIT1 0
#endif
#ifndef PROBE_GEMM
#define PROBE_GEMM 0
#endif
#ifndef OPT
#define OPT 13
#endif

typedef unsigned short bf16_t;
#define DI __device__ __forceinline__
#define LAS __attribute__((address_space(3)))

constexpr int D = 1024, NB = 16, SEQ = 2048, CTXL = 256, NLAT = NB * SEQ, NCTX = NB * CTXL, NT = NLAT + NCTX;
constexpr int PLD = 2560;
constexpr int INC = 2336, ACOLS = 1920;
constexpr int WLD = 2560;
constexpr int NTHR = 512;

#define XB_TMO      128
#define XB_XCNT(j)  (256  + 64 * (j))
#define XB_XSUB(j)  (1280 + 64 * (j))
#define XB_XGEN(j)  (2304 + 64 * (j))
#define XB_TOP      3328
#define XB_TOPGEN   3392
#define XCD_BAR_WORDS 3456
#define XB_SPIN_CAP (1u << 24)
DI unsigned xb_ld(unsigned* p)              { return __hip_atomic_load(p, __ATOMIC_RELAXED, __HIP_MEMORY_SCOPE_AGENT); }
DI unsigned xb_add(unsigned* p, unsigned v) { return __hip_atomic_fetch_add(p, v, __ATOMIC_RELAXED, __HIP_MEMORY_SCOPE_AGENT); }
DI unsigned xb_xcc_id() { return (unsigned)__builtin_amdgcn_s_getreg((3 << 11) | 20) & 0xFu; }
#define XB_SPIN(cond, bar) do { unsigned _sp = 0; while (cond) { __builtin_amdgcn_s_sleep(1); \
    if ((++_sp & 255u) == 0u) { if (xb_ld(&(bar)[XB_TMO])) break; if (_sp > XB_SPIN_CAP) { atomicAdd(&(bar)[XB_TMO], 1u); break; } } } } while (0)
struct XcdBarrier { unsigned* bar; unsigned x; volatile LAS unsigned* st; };
DI XcdBarrier xcd_barrier_post(unsigned* bar, volatile LAS unsigned* st) {
    XcdBarrier b; b.bar = bar; b.x = xb_xcc_id(); b.st = st;
    if (threadIdx.x == 0) (void)xb_add(&bar[XB_XCNT(b.x)], 1u);
    return b;
}
DI void xcd_barrier_complete(unsigned* bar, unsigned x, unsigned& nloc, unsigned& nx) {
    const unsigned G = gridDim.x * gridDim.y * gridDim.z;
    unsigned sum, cnt, mine, sp = 0u;
    for (;;) {
        sum = 0u; cnt = 0u; mine = 0u;
#pragma unroll
        for (unsigned j = 0; j < 16; ++j) { const unsigned c = xb_ld(&bar[XB_XCNT(j)]); sum += c; cnt += (c > 0u) ? 1u : 0u; mine = (j == x) ? c : mine; }
        if (sum == G) break;
        __builtin_amdgcn_s_sleep(1);
        if ((++sp & 255u) == 0u) { if (xb_ld(&bar[XB_TMO])) break; if (sp > XB_SPIN_CAP) { atomicAdd(&bar[XB_TMO], 1u); break; } }
    }
    nloc = mine > 0u ? mine : 1u; nx = cnt > 0u ? cnt : 1u;
}
DI void xcd_barrier(const XcdBarrier& b, const bool t0) {
    asm volatile("s_waitcnt vmcnt(0)" ::: "memory");
    __syncthreads();
    if (t0) {
        unsigned* bar = b.bar;
        __builtin_amdgcn_s_waitcnt(0);
        unsigned nloc = b.st[0], nx = b.st[1];
        if (nloc == 0u) { xcd_barrier_complete(bar, b.x, nloc, nx); b.st[0] = nloc; b.st[1] = nx; }
        const unsigned old = xb_add(&bar[XB_XSUB(b.x)], 1u);
        const unsigned gen = old / nloc;
        if (old + 1u == (gen + 1u) * nloc) {
            __builtin_amdgcn_fence(__ATOMIC_RELEASE, "agent");
            asm volatile("s_waitcnt vmcnt(0)" ::: "memory");
            const unsigned og = xb_add(&bar[XB_TOP], 1u);
            const unsigned tg = og / nx;
            if (og + 1u == (tg + 1u) * nx) xb_add(&bar[XB_TOPGEN], 1u);
            else XB_SPIN(xb_ld(&bar[XB_TOPGEN]) == tg, bar);
            __builtin_amdgcn_fence(__ATOMIC_ACQUIRE, "agent");
            xb_add(&bar[XB_XGEN(b.x)], 1u);
            asm volatile("s_waitcnt vmcnt(0)" ::: "memory");
        } else {
            XB_SPIN(xb_ld(&bar[XB_XGEN(b.x)]) == gen, bar);
            __builtin_amdgcn_fence(__ATOMIC_ACQUIRE, "agent");
            asm volatile("s_waitcnt vmcnt(0)" ::: "memory");
        }
    }
    __syncthreads();
}

struct Params {
    const float *x, *c, *ctx, *c_ctx, *norm1_g, *norm2_g, *mod_w, *mod_b, *w_in, *a_mu, *a_w0, *a_w2, *a_a0, *a_a2, *a_g2,
                *a_k_k, *a_k_a, *a_r_k, *a_ln_w, *a_ln_b, *b_q_norm, *b_w_q_up, *b_kv_norm, *b_w_kv_up, *b_q_gain, *b_k_gain,
                *w_out_even, *w_out_fourier, *router_w, *router_b, *moe_w_gate, *moe_w_up, *moe_w_down, *sh_gate, *sh_up, *sh_down;
    float* out;
    unsigned* bar; int* cnt; float* mod; float* ctxs; bf16_t* dftl; bf16_t* dftc; int* slot; float* tokw; float* slotw;
    bf16_t *H, *P, *LR, *WAG, *YF, *YB, *QN, *Qraw, *KVraw, *Kf, *Vt, *ACT, *Y, *F; float* G;
    bf16_t *WinT, *WqT, *WkvT, *WlrT, *WoutT, *A1, *A2, *A2c, *WguT, *WdT, *ZT, *ZTC;
    bf16_t *M1, *YF1, *YF1c;
    bf16_t *xs, *cs, *xs3;
};

struct Ctx { int tid, bid, nblk; };
DI int lane_id_asm() { int l; asm volatile("v_mbcnt_lo_u32_b32 %0, -1, 0\n\tv_mbcnt_hi_u32_b32 %0, -1, %0" : "=v"(l)); return l; }
DI Ctx make_ctx(int wave_id) { Ctx c; c.tid = wave_id * 64 + lane_id_asm(); c.bid = blockIdx.x; c.nblk = gridDim.x; asm volatile("" : "+v"(c.tid), "+s"(c.bid), "+s"(c.nblk)); return c; }

DI bf16_t f2bf(float f) { unsigned u = __float_as_uint(f); u += 0x7fffu + ((u >> 16) & 1u); return (bf16_t)(u >> 16); }
DI float bf2f(bf16_t b) { return __uint_as_float(((unsigned)b) << 16); }
DI float bflo(unsigned u) { return __uint_as_float(u << 16); }
DI float bfhi(unsigned u) { return __uint_as_float(u & 0xffff0000u); }
DI unsigned pack2(float lo, float hi) { return (unsigned)f2bf(lo) | ((unsigned)f2bf(hi) << 16); }
typedef __bf16 g_bf16x2_t __attribute__((ext_vector_type(2)));
typedef float g_f32x2_t __attribute__((ext_vector_type(2)));
DI unsigned att_pk(float a, float b) { g_f32x2_t f = {a, b}; g_bf16x2_t h = __builtin_convertvector(f, g_bf16x2_t); return __builtin_bit_cast(unsigned, h); }
DI float siluf(float v) { return v / (1.f + expf(-v)); }
DI float sigm(float v) { return 1.f / (1.f + expf(-v)); }
template <int CTRL> DI float dpp_f(float v) { return __builtin_bit_cast(float, __builtin_amdgcn_update_dpp(0, __builtin_bit_cast(int, v), CTRL, 0xf, 0xf, true)); }
DI float wave_sum(float v) {
    v += dpp_f<0xB1>(v); v += dpp_f<0x4E>(v); v += dpp_f<0x141>(v); v += dpp_f<0x140>(v);
    const int x = __builtin_bit_cast(int, v);
    const float a = __builtin_bit_cast(float, __builtin_amdgcn_readlane(x, 0)), b = __builtin_bit_cast(float, __builtin_amdgcn_readlane(x, 16));
    const float c = __builtin_bit_cast(float, __builtin_amdgcn_readlane(x, 32)), d = __builtin_bit_cast(float, __builtin_amdgcn_readlane(x, 48));
    return (a + b) + (c + d);
}

template <bool DUAL, class AFn, class BFn, class BFn2, class Epi>
DI void ngemm(const Ctx& cx, float* lds, int nbz, int M, int N, int K, AFn afn, BFn bfn, BFn2 bfn2, Epi epi) {
    float* As = lds; float* Bs = lds + 16 * 132; float* B2s = Bs + 16 * 128;
    const int tid = cx.tid, ty = tid >> 5, tx = tid & 31;
    const int tm = (M + 127) / 128, tn = (N + 127) / 128, ntile = tm * tn * nbz;
    const int arow = tid >> 2, akc = (tid & 3) * 4, bk = tid >> 5, bnn = (tid & 31) * 4;
    for (int tile = cx.bid; tile < ntile; tile += cx.nblk) {
        const int bz = tile / (tm * tn), rem = tile % (tm * tn), bm = rem / tn, bn = rem % tn;
        float acc[8][4], acc2[8][4];
#pragma unroll
        for (int i = 0; i < 8; ++i)
#pragma unroll
            for (int j = 0; j < 4; ++j) { acc[i][j] = 0.f; acc2[i][j] = 0.f; }
        const int m_a = bm * 128 + arow;
        const bf16_t* aptr = (m_a < M) ? afn(bz, m_a) : nullptr;
        const int nB = bn * 128 + bnn;
        for (int k0 = 0; k0 < K; k0 += 16) {
            float av0 = 0.f, av1 = 0.f, av2 = 0.f, av3 = 0.f;
            if (aptr) { const uint2 u = *(const uint2*)(aptr + k0 + akc); av0 = bflo(u.x); av1 = bfhi(u.x); av2 = bflo(u.y); av3 = bfhi(u.y); }
            float4 bv = make_float4(0.f, 0.f, 0.f, 0.f), bv2 = make_float4(0.f, 0.f, 0.f, 0.f);
            if (nB < N) { bv = *(const float4*)(bfn(bz, k0 + bk) + nB); if (DUAL) bv2 = *(const float4*)(bfn2(bz, k0 + bk) + nB); }
            __syncthreads();
            As[(akc + 0) * 132 + arow] = av0; As[(akc + 1) * 132 + arow] = av1; As[(akc + 2) * 132 + arow] = av2; As[(akc + 3) * 132 + arow] = av3;
            *(float4*)&Bs[bk * 128 + bnn] = bv;
            if (DUAL) *(float4*)&B2s[bk * 128 + bnn] = bv2;
            __syncthreads();
#pragma unroll 4
            for (int kk = 0; kk < 16; ++kk) {
                const float4 a0 = *(const float4*)&As[kk * 132 + ty * 8], a1 = *(const float4*)&As[kk * 132 + ty * 8 + 4];
                const float4 b = *(const float4*)&Bs[kk * 128 + tx * 4];
                const float a[8] = {a0.x, a0.y, a0.z, a0.w, a1.x, a1.y, a1.z, a1.w};
                const float bb[4] = {b.x, b.y, b.z, b.w};
#pragma unroll
                for (int i = 0; i < 8; ++i)
#pragma unroll
                    for (int j = 0; j < 4; ++j) acc[i][j] += a[i] * bb[j];
                if (DUAL) {
                    const float4 b2 = *(const float4*)&B2s[kk * 128 + tx * 4];
                    const float cc[4] = {b2.x, b2.y, b2.z, b2.w};
#pragma unroll
                    for (int i = 0; i < 8; ++i)
#pragma unroll
                        for (int j = 0; j < 4; ++j) acc2[i][j] += a[i] * cc[j];
                }
            }
        }
#pragma unroll
        for (int i = 0; i < 8; ++i) {
            const int m = bm * 128 + ty * 8 + i;
            if (m < M) {
#pragma unroll
                for (int j = 0; j < 4; ++j) { const int n = bn * 128 + tx * 4 + j; if (n < N) epi(bz, m, n, acc[i][j], acc2[i][j]); }
            }
        }
    }
    __syncthreads();
}

DI void ph_prologue(const Ctx& cx, const Params& p, float* lds) {
    const int tid = cx.tid, gtid = cx.bid * NTHR + tid, gsz = cx.nblk * NTHR;
    for (int i = tid; i < 17 * 1024; i += NTHR) { const int j = i >> 10, k = i & 1023; const float v = (j < 16) ? p.c[j * 1024 + k] : p.c_ctx[k]; lds[i] = siluf(v); }
    __syncthreads();
    for (int idx = gtid; idx < 4 * 6144; idx += gsz) {
        const int l = idx / 6144, n = idx % 6144;
        const float* w = p.mod_w + (size_t)l * 1024 * 6144 + n;
        float acc[17]; const float b0 = p.mod_b[l * 6144 + n];
#pragma unroll
        for (int j = 0; j < 17; ++j) acc[j] = b0;
        for (int k = 0; k < 1024; ++k) {
            const float wv = w[(size_t)k * 6144];
#pragma unroll
            for (int j = 0; j < 17; ++j) acc[j] += lds[j * 1024 + k] * wv;
        }
#pragma unroll
        for (int j = 0; j < 17; ++j) p.mod[((size_t)l * 17 + j) * 6144 + n] = acc[j];
    }
    for (int i = gtid; i < 2048 * 4096; i += gsz) {
        const int f = i >> 12, k = i & 4095, t = k & 2047, m = (f * t) & 2047; const float a = (float)m * (1.f / 1024.f);
        p.dftl[i] = f2bf((k < 2048) ? cospif(a) : sinpif(a));
    }
    for (int i = gtid; i < 256 * 512; i += gsz) {
        const int f = i >> 9, k = i & 511, t = k & 255, m = (f * t) & 255; const float a = (float)m * (1.f / 128.f);
        p.dftc[i] = f2bf((k < 256) ? cospif(a) : sinpif(a));
    }
    for (int i = gtid; i < 1024; i += gsz) p.H[(size_t)NT * 1024 + i] = 0;
    __syncthreads();
}

DI float pick4(float a0, float a1, float a2, float a3, int i) { return i == 0 ? a0 : (i == 1 ? a1 : (i == 2 ? a2 : a3)); }
template <bool COMBINE, bool NORM, bool ROUTER>
DI void ph_norm(const Ctx& cx, const Params& p, float* lds, int nrows, const float* xin_lat, const float* xin_ctx, const float* gain, const float* modl, int sh_idx, int sc_idx,
                const float* modprev, int layer) {
    const int tid = cx.tid, wid = tid >> 6, lane = tid & 63;
    float* rw = lds;
    float* scr = lds + 16 * 1024;
    int* lcnt = (int*)(lds + 16 * 1024 + 256); int* lbase = lcnt + 16; int* rlist = lcnt + 32;
    int nlist = 0;
    if (ROUTER) {
        for (int i = tid; i < 16 * 1024; i += NTHR) { const int e = i >> 10, col = i & 1023; rw[i] = p.router_w[col * 16 + e]; }
        if (tid < 16) lcnt[tid] = 0;
        __syncthreads();
    }
    for (int row = cx.bid * 8 + wid; row < nrows; row += cx.nblk * 8) {
        const bool lat = row < NLAT; const int j = lat ? (row >> 11) : 16;
        const float* xr = lat ? xin_lat + (size_t)row * 1024 : xin_ctx + (size_t)(row - NLAT) * 1024;
        float4 xv[4];
#pragma unroll
        for (int i = 0; i < 4; ++i) xv[i] = *(const float4*)(xr + i * 256 + lane * 4);
        if (COMBINE) {
            const float* g2 = modprev + (size_t)j * 6144 + 5 * 1024;
            float* xo = lat ? p.out + (size_t)row * 1024 : p.ctxs + (size_t)(row - NLAT) * 1024;
#pragma unroll
            for (int i = 0; i < 4; ++i) {
                const int col = i * 256 + lane * 4;
                const float4 gv = *(const float4*)(g2 + col);
                float s0 = 0.f, s1 = 0.f, s2 = 0.f, s3 = 0.f;
#pragma unroll
                for (int s = 0; s < 3; ++s) { const uint2 u = *(const uint2*)(p.Y + ((size_t)s * NT + row) * 1024 + col); s0 += bflo(u.x); s1 += bfhi(u.x); s2 += bflo(u.y); s3 += bfhi(u.y); }
                xv[i].x += gv.x * s0; xv[i].y += gv.y * s1; xv[i].z += gv.z * s2; xv[i].w += gv.w * s3;
                *(float4*)(xo + col) = xv[i];
            }
        }
        if (NORM) {
            float ss = 0.f;
#pragma unroll
            for (int i = 0; i < 4; ++i) ss += xv[i].x * xv[i].x + xv[i].y * xv[i].y + xv[i].z * xv[i].z + xv[i].w * xv[i].w;
            ss = wave_sum(ss);
            const float rstd = rsqrtf(ss * (1.f / 1024.f) + 1e-6f);
            const float* shp = modl + (size_t)j * 6144 + sh_idx * 1024; const float* scp = modl + (size_t)j * 6144 + sc_idx * 1024;
            float4 hv[4];
#pragma unroll
            for (int i = 0; i < 4; ++i) {
                const int col = i * 256 + lane * 4;
                const float4 g = *(const float4*)(gain + col), sh = *(const float4*)(shp + col), sc = *(const float4*)(scp + col);
                hv[i].x = xv[i].x * rstd * g.x * (1.f + sc.x) + sh.x; hv[i].y = xv[i].y * rstd * g.y * (1.f + sc.y) + sh.y;
                hv[i].z = xv[i].z * rstd * g.z * (1.f + sc.z) + sh.z; hv[i].w = xv[i].w * rstd * g.w * (1.f + sc.w) + sh.w;
                uint2 u; u.x = pack2(hv[i].x, hv[i].y); u.y = pack2(hv[i].z, hv[i].w);
                *(uint2*)(p.H + (size_t)row * 1024 + col) = u;
            }
            if (ROUTER) {
                float part[16];
#pragma unroll
                for (int e = 0; e < 16; ++e) {
                    float a = 0.f;
#pragma unroll
                    for (int i = 0; i < 4; ++i) { const float4 w = *(const float4*)(rw + e * 1024 + i * 256 + lane * 4); a += hv[i].x * w.x + hv[i].y * w.y + hv[i].z * w.z + hv[i].w * w.w; }
                    part[e] = wave_sum(a);
                }
                float* my = scr + wid * 32;
#pragma unroll
                for (int e = 0; e < 16; ++e) if (lane == e) { const float sg = sigm(part[e]); my[e] = sg; my[16 + e] = sg + p.router_b[e]; }
                __builtin_amdgcn_wave_barrier();
                if (lane == 0) {
                    float best = -3.0e38f; int be1 = 0, be2 = 1;
                    for (int g = 0; g < 4; ++g) {
                        const float v0 = my[16 + 4 * g], v1 = my[16 + 4 * g + 1], v2 = my[16 + 4 * g + 2], v3 = my[16 + 4 * g + 3];
                        int i1 = 0; float m1 = v0;
                        if (v1 > m1) { m1 = v1; i1 = 1; } if (v2 > m1) { m1 = v2; i1 = 2; } if (v3 > m1) { m1 = v3; i1 = 3; }
                        int i2 = -1; float m2 = -3.0e38f;
                        if (i1 != 0 && v0 > m2) { m2 = v0; i2 = 0; } if (i1 != 1 && v1 > m2) { m2 = v1; i2 = 1; }
                        if (i1 != 2 && v2 > m2) { m2 = v2; i2 = 2; } if (i1 != 3 && v3 > m2) { m2 = v3; i2 = 3; }
                        const float gs = m1 + m2;
                        if (gs > best) { best = gs; be1 = 4 * g + i1; be2 = 4 * g + i2; }
                    }
                    const float bs1 = my[be1], bs2 = my[be2];
                    const float inv = 1.f / (bs1 + bs2);
                    const int p1 = atomicAdd(&lcnt[be1], 1), p2 = atomicAdd(&lcnt[be2], 1);
                    int* ent = rlist + (wid * 24 + nlist) * 4;
                    ent[0] = row; ent[1] = be1 | (be2 << 8); ent[2] = p1; ent[3] = p2;
                    p.tokw[row * 2] = bs1 * inv; p.tokw[row * 2 + 1] = bs2 * inv;
                }
                ++nlist;
                __builtin_amdgcn_wave_barrier();
            }
        }
    }
    if (ROUTER) {
        __syncthreads();
        if (tid < 16) lbase[tid] = atomicAdd(p.cnt + (layer * 16 + tid) * 64, lcnt[tid]);
        __syncthreads();
        for (int k = lane; k < nlist; k += 64) {
            const int* ent = rlist + (wid * 24 + k) * 4; const int row = ent[0], be1 = ent[1] & 255, be2 = ent[1] >> 8;
            p.slot[(size_t)be1 * NT + lbase[be1] + ent[2]] = row * 2; p.slot[(size_t)be2 * NT + lbase[be2] + ent[3]] = row * 2 + 1;
        }
    }
    (void)scr;
    __syncthreads();
}

DI void ph_win(const Ctx& cx, const Params& p, float* lds, int j) {
    const float* W = p.w_in + (size_t)j * 1024 * INC;
    ngemm<false>(cx, lds, 1, NT, INC, 1024,
        [&](int, int m) { return p.H + (size_t)m * 1024; },
        [&](int, int k) { return W + (size_t)k * INC; }, [&](int, int) { return (const float*)nullptr; },
        [&](int, int m, int n, float v, float) { p.P[(size_t)m * PLD + n] = f2bf(v); });
}
DI void ph_prepB(const Ctx& cx, const Params& p, int j) {
    const int tid = cx.tid, wid = tid >> 6, lane = tid & 63;
    for (int row = cx.bid * 8 + wid; row < NT; row += cx.nblk * 8) {
        const bf16_t* pr = p.P + (size_t)row * PLD + ACOLS;
        const uint2 uq = *(const uint2*)(pr + lane * 4); const unsigned ukv = *(const unsigned*)(pr + 256 + lane * 2);
        const float q0 = bflo(uq.x), q1 = bfhi(uq.x), q2 = bflo(uq.y), q3 = bfhi(uq.y), k0 = bflo(ukv), k1 = bfhi(ukv);
        const float sq = wave_sum(q0 * q0 + q1 * q1 + q2 * q2 + q3 * q3), sk = wave_sum(k0 * k0 + k1 * k1);
        const float rq = rsqrtf(sq * (1.f / 256.f) + 1e-6f), rk = rsqrtf(sk * (1.f / 128.f) + 1e-6f);
        const float* gq = p.b_q_norm + j * 256 + lane * 4; const float* gk = p.b_kv_norm + j * 128 + lane * 2;
        uint2 o; o.x = pack2(q0 * rq * gq[0], q1 * rq * gq[1]); o.y = pack2(q2 * rq * gq[2], q3 * rq * gq[3]);
        bf16_t* qn = p.QN + (size_t)row * 512;
        *(uint2*)(qn + lane * 4) = o;
        *(unsigned*)(qn + 256 + lane * 2) = pack2(k0 * rk * gk[0], k1 * rk * gk[1]);
        *(unsigned*)(qn + 384 + lane * 2) = 0u;
    }
}
DI void ph_qkvup(const Ctx& cx, const Params& p, float* lds, int j, int mq) {
    const float* Wq = p.b_w_q_up + (size_t)j * 256 * 768; const float* Wkv = p.b_w_kv_up + (size_t)j * 128 * 1024;
    ngemm<false>(cx, lds, 1, mq, 768, 256,
        [&](int, int m) { return p.QN + (size_t)m * 512; },
        [&](int, int k) { return Wq + (size_t)k * 768; }, [&](int, int) { return (const float*)nullptr; },
        [&](int, int m, int n, float v, float) { p.Qraw[(size_t)m * 768 + n] = f2bf(v); });
    ngemm<false>(cx, lds, 1, NT, 1024, 128,
        [&](int, int m) { return p.QN + (size_t)m * 512 + 256; },
        [&](int, int k) { return Wkv + (size_t)k * 1024; }, [&](int, int) { return (const float*)nullptr; },
        [&](int, int m, int n, float v, float) { p.KVraw[(size_t)m * 1024 + n] = f2bf(v); });
}
DI void unpack8(const uint4 u, float* d) { d[0] = bflo(u.x); d[1] = bfhi(u.x); d[2] = bflo(u.y); d[3] = bfhi(u.y); d[4] = bflo(u.z); d[5] = bfhi(u.z); d[6] = bflo(u.w); d[7] = bfhi(u.w); }
DI uint4 pack8(const float* d, float scl) { uint4 u; u.x = pack2(d[0] * scl, d[1] * scl); u.y = pack2(d[2] * scl, d[3] * scl); u.z = pack2(d[4] * scl, d[5] * scl); u.w = pack2(d[6] * scl, d[7] * scl); return u; }
DI float ssq8(const uint4 u) { float d[8]; unpack8(u, d); float s = 0.f;
#pragma unroll
    for (int i = 0; i < 8; ++i) s += d[i] * d[i];
    return s; }
DI void norm_rope_store(const uint4 (&raw)[12], const float* gain, int t, bool lat, float scl, bf16_t* dst) {
    float ss = 0.f;
#pragma unroll
    for (int i = 0; i < 12; ++i) ss += ssq8(raw[i]);
    const float r = rsqrtf(ss * (1.f / 96.f) + 1e-6f);
#pragma unroll
    for (int i = 0; i < 8; ++i) { float d[8]; unpack8(raw[i], d);
#pragma unroll
        for (int c = 0; c < 8; ++c) d[c] = d[c] * r * gain[i * 8 + c];
        *(uint4*)(dst + i * 8) = pack8(d, scl); }
    const float invf[8] = {1.f, 0.316227766016838f, 0.1f, 0.0316227766016838f, 0.01f, 0.00316227766016838f, 0.001f, 0.000316227766016838f};
    const float ri = (float)(t >> 6), ci = (float)(t & 63);
#pragma unroll
    for (int half = 0; half < 2; ++half) {
        float x1[8], x2[8], o1[8], o2[8]; unpack8(raw[8 + half], x1); unpack8(raw[10 + half], x2);
#pragma unroll
        for (int c = 0; c < 8; ++c) {
            const float ang = (half == 0 ? ri : ci) * invf[c];
            const float cs = lat ? __cosf(ang) : 1.f, sn = lat ? __sinf(ang) : 0.f;
            const float a = x1[c] * r * gain[64 + half * 8 + c], b = x2[c] * r * gain[80 + half * 8 + c];
            o1[c] = a * cs - b * sn; o2[c] = b * cs + a * sn;
        }
        *(uint4*)(dst + 64 + half * 8) = pack8(o1, scl); *(uint4*)(dst + 80 + half * 8) = pack8(o2, scl);
    }
}
DI void ph_finalize(const Ctx& cx, const Params& p, int j, int mq) {
    const int gtid = cx.bid * NTHR + cx.tid, gsz = cx.nblk * NTHR;
    const float* qg = p.b_q_gain + j * 96; const float* kg = p.b_k_gain + j * 96;
    for (int idx = gtid; idx < 8 * mq; idx += gsz) {
        const int h = idx / mq, row = idx % mq;
        const bool lat = row < NLAT; const int t = lat ? (row & 2047) : ((row - NLAT) & 255);
        bf16_t* qp = p.Qraw + (size_t)row * 768 + h * 96;
        uint4 raw[12];
#pragma unroll
        for (int i = 0; i < 12; ++i) raw[i] = *(const uint4*)(qp + i * 8);
        norm_rope_store(raw, qg, t, lat, (OPT >= 5) ? 0.10206207261596577f * 1.4426950408889634f : 0.10206207261596577f, qp);
    }
    for (int idx = gtid; idx < 8 * NT; idx += gsz) {
        const int h = idx / NT, row = idx % NT;
        const bool lat = row < NLAT; const int b = lat ? (row >> 11) : ((row - NLAT) >> 8); const int t = lat ? (row & 2047) : ((row - NLAT) & 255);
        const int key = lat ? 256 + t : t;
        const bf16_t* kvp = p.KVraw + (size_t)row * 1024 + h * 128; const bf16_t* krp = p.P + (size_t)row * PLD + ACOLS + 384;
        uint4 raw[12];
#pragma unroll
        for (int i = 0; i < 8; ++i) raw[i] = *(const uint4*)(kvp + i * 8);
#pragma unroll
        for (int i = 0; i < 4; ++i) raw[8 + i] = *(const uint4*)(krp + i * 8);
        norm_rope_store(raw, kg, t, lat, 1.f, p.Kf + ((size_t)(b * 8 + h) * 2304 + key) * 96);
    }
    for (int idx = gtid; idx < 8 * NT; idx += gsz) {
        const int h = idx / NT, row = idx % NT;
        const bool lat = row < NLAT; const int b = lat ? (row >> 11) : ((row - NLAT) >> 8); const int t = lat ? (row & 2047) : ((row - NLAT) & 255);
        const int key = lat ? 256 + t : t;
        const bf16_t* vp = p.KVraw + (size_t)row * 1024 + h * 128 + 64;
        bf16_t* vo = p.Vt + (size_t)(b * 8 + h) * 64 * 2304 + key;
#pragma unroll 1
        for (int i = 0; i < 8; ++i) { const uint4 u = *(const uint4*)(vp + i * 8);
            vo[0] = (bf16_t)(u.x & 0xffff); vo[2304] = (bf16_t)(u.x >> 16); vo[2 * 2304] = (bf16_t)(u.y & 0xffff); vo[3 * 2304] = (bf16_t)(u.y >> 16);
            vo[4 * 2304] = (bf16_t)(u.z & 0xffff); vo[5 * 2304] = (bf16_t)(u.z >> 16); vo[6 * 2304] = (bf16_t)(u.w & 0xffff); vo[7 * 2304] = (bf16_t)(u.w >> 16);
            vo += 8 * 2304; }
    }
}
DI void ph_attn(const Ctx& cx, const Params& p, bool with_ctx) {
    const int gtid = cx.bid * NTHR + cx.tid, gsz = cx.nblk * NTHR;
    const int total = NLAT * 8 + (with_ctx ? NCTX * 8 : 0);
    for (int idx = gtid; idx < total; idx += gsz) {
        int b, h, row, nkeys;
        if (idx < NLAT * 8) { b = idx >> 14; h = (idx >> 11) & 7; row = b * 2048 + (idx & 2047); nkeys = 2304; }
        else { const int i2 = idx - NLAT * 8; b = i2 >> 11; h = (i2 >> 8) & 7; row = NLAT + b * 256 + (i2 & 255); nkeys = 256; }
        const bf16_t* qp = p.Qraw + (size_t)row * 768 + h * 96;
        const bf16_t* Kb = p.Kf + (size_t)(b * 8 + h) * 2304 * 96; const bf16_t* Vb = p.Vt + (size_t)(b * 8 + h) * 64 * 2304;
        float q[96];
#pragma unroll
        for (int i = 0; i < 12; ++i) { const uint4 u = *(const uint4*)(qp + i * 8); q[i * 8] = bflo(u.x); q[i * 8 + 1] = bfhi(u.x); q[i * 8 + 2] = bflo(u.y); q[i * 8 + 3] = bfhi(u.y);
            q[i * 8 + 4] = bflo(u.z); q[i * 8 + 5] = bfhi(u.z); q[i * 8 + 6] = bflo(u.w); q[i * 8 + 7] = bfhi(u.w); }
        float acc[64];
#pragma unroll
        for (int i = 0; i < 64; ++i) acc[i] = 0.f;
        float mx = -3.0e38f, l = 0.f;
        for (int key0 = 0; key0 < nkeys; key0 += 8) {
            float s[8];
#pragma unroll
            for (int kk = 0; kk < 8; ++kk) {
                const uint4* kp = (const uint4*)(Kb + (size_t)(key0 + kk) * 96); float a = 0.f;
#pragma unroll
                for (int i = 0; i < 12; ++i) { const uint4 u = kp[i]; a += q[i * 8] * bflo(u.x) + q[i * 8 + 1] * bfhi(u.x) + q[i * 8 + 2] * bflo(u.y) + q[i * 8 + 3] * bfhi(u.y)
                    + q[i * 8 + 4] * bflo(u.z) + q[i * 8 + 5] * bfhi(u.z) + q[i * 8 + 6] * bflo(u.w) + q[i * 8 + 7] * bfhi(u.w); }
                s[kk] = a;
            }
            float cm = s[0];
#pragma unroll
            for (int kk = 1; kk < 8; ++kk) cm = fmaxf(cm, s[kk]);
            const float mn = fmaxf(mx, cm), alpha = expf(mx - mn);
            float ps = 0.f;
#pragma unroll
            for (int kk = 0; kk < 8; ++kk) { s[kk] = expf(s[kk] - mn); ps += s[kk]; }
            l = l * alpha + ps; mx = mn;
#pragma unroll
            for (int dv = 0; dv < 64; ++dv) {
                const uint4 u = *(const uint4*)(Vb + (size_t)dv * 2304 + key0);
                acc[dv] = acc[dv] * alpha + s[0] * bflo(u.x) + s[1] * bfhi(u.x) + s[2] * bflo(u.y) + s[3] * bfhi(u.y) + s[4] * bflo(u.z) + s[5] * bfhi(u.z) + s[6] * bflo(u.w) + s[7] * bfhi(u.w);
            }
        }
        const float il = 1.f / l;
        bf16_t* o = p.H + (size_t)row * 1024 + 512 + h * 64;
#pragma unroll
        for (int i = 0; i < 8; ++i) { uint4 u; u.x = pack2(acc[i * 8] * il, acc[i * 8 + 1] * il); u.y = pack2(acc[i * 8 + 2] * il, acc[i * 8 + 3] * il);
            u.z = pack2(acc[i * 8 + 4] * il, acc[i * 8 + 5] * il); u.w = pack2(acc[i * 8 + 6] * il, acc[i * 8 + 7] * il); *(uint4*)(o + i * 8) = u; }
    }
}
DI float shiftp(const bf16_t* P, int row, int t, int T, int col, float mu) {
    const float c = bf2f(P[(size_t)row * PLD + col]);
    const float pv = (t > 0) ? bf2f(P[(size_t)(row - 1) * PLD + col]) : 0.f;
    const float nx = (t < T - 1) ? bf2f(P[(size_t)(row + 1) * PLD + col]) : 0.f;
    return c + mu * (0.5f * (pv + nx) - c);
}
DI void ph_prepLR(const Ctx& cx, const Params& p, int j) {
    const int gtid = cx.bid * NTHR + cx.tid, gsz = cx.nblk * NTHR;
    const float* mu = p.a_mu + j * ACOLS + 1536;
    for (int idx = gtid; idx < NT * 384; idx += gsz) {
        const int row = idx / 384, col = idx % 384;
        const bool lat = row < NLAT; const int t = lat ? (row & 2047) : ((row - NLAT) & 255); const int T = lat ? 2048 : 256;
        float v = shiftp(p.P, row, t, T, 1536 + col, mu[col]);
        if (col < 128) v = tanhf(v); else if (col >= 256) v = sigm(v);
        p.LR[(size_t)row * 384 + col] = f2bf(v);
    }
}
DI void ph_wag(const Ctx& cx, const Params& p, float* lds, int j) {
    for (int d = 0; d < 2; ++d) {
        const float* W2 = p.a_w2 + (size_t)(j * 2 + d) * 64 * 512; const float* w0 = p.a_w0 + (j * 2 + d) * 512;
        ngemm<false>(cx, lds, 1, NT, 512, 64,
            [&](int, int m) { return p.LR + (size_t)m * 384 + d * 64; },
            [&](int, int k) { return W2 + (size_t)k * 512; }, [&](int, int) { return (const float*)nullptr; },
            [&](int, int m, int n, float v, float) { const float z = -0.606531f * sigm(w0[n] + v); p.WAG[(size_t)m * WLD + d * 512 + n] = f2bf(-expm1f(z)); });
        const float* A2 = p.a_a2 + (size_t)(j * 2 + d) * 64 * 512; const float* a0 = p.a_a0 + (j * 2 + d) * 512;
        ngemm<false>(cx, lds, 1, NT, 512, 64,
            [&](int, int m) { return p.LR + (size_t)m * 384 + 128 + d * 64; },
            [&](int, int k) { return A2 + (size_t)k * 512; }, [&](int, int) { return (const float*)nullptr; },
            [&](int, int m, int n, float v, float) { p.WAG[(size_t)m * WLD + 1024 + d * 512 + n] = f2bf(sigm(a0[n] + v)); });
    }
    const float* G2 = p.a_g2 + (size_t)j * 128 * 512;
    ngemm<false>(cx, lds, 1, NT, 512, 128,
        [&](int, int m) { return p.LR + (size_t)m * 384 + 256; },
        [&](int, int k) { return G2 + (size_t)k * 512; }, [&](int, int) { return (const float*)nullptr; },
        [&](int, int m, int n, float v, float) { p.WAG[(size_t)m * WLD + 2048 + n] = f2bf(v); });
}
DI void ph_scan(const Ctx& cx, const Params& p, float* lds, int j) {
    const int tid = cx.tid, lane = tid & 63;
    if (tid < 64) {
        for (int item = cx.bid; item < 256; item += cx.nblk) {
            const int b = item >> 4, h = (item >> 1) & 7, dir = item & 1, hc = h * 64 + lane;
            float S[64];
#pragma unroll
            for (int k = 0; k < 64; ++k) S[k] = 0.f;
            const float kkc = p.a_k_k[j * 512 + hc], kac = p.a_k_a[j * 512 + hc];
            const float mur = p.a_mu[j * ACOLS + hc], muk = p.a_mu[j * ACOLS + 512 + hc], muv = p.a_mu[j * ACOLS + 1024 + hc];
            bf16_t* yout = dir ? p.YB : p.YF;
            for (int step = 0; step < 2304; ++step) {
                const bool cp = step < 256; const int tt = cp ? step : step - 256, T = cp ? 256 : 2048, t = dir ? (T - 1 - tt) : tt;
                const int row = cp ? NLAT + b * 256 + t : b * 2048 + t;
                const float R = shiftp(p.P, row, t, T, hc, mur), K = shiftp(p.P, row, t, T, 512 + hc, muk), V = shiftp(p.P, row, t, T, 1024 + hc, muv);
                const float w = 1.f - bf2f(p.WAG[(size_t)row * WLD + dir * 512 + hc]), a = bf2f(p.WAG[(size_t)row * WLD + 1024 + dir * 512 + hc]);
                const float kkv = K * kkc, ssq = wave_sum(kkv * kkv), kk = kkv * rsqrtf(ssq + 1e-12f);
                const float kd = K * (1.f + (a - 1.f) * kac), bd = kk * a;
                lds[lane] = -kk; lds[64 + lane] = w; lds[128 + lane] = bd; lds[192 + lane] = kd; lds[256 + lane] = R;
                __builtin_amdgcn_wave_barrier();
                float sa = 0.f;
#pragma unroll
                for (int k4 = 0; k4 < 16; ++k4) { const float4 v = *(const float4*)(lds + k4 * 4); sa += S[k4 * 4] * v.x + S[k4 * 4 + 1] * v.y + S[k4 * 4 + 2] * v.z + S[k4 * 4 + 3] * v.w; }
                float y = 0.f;
#pragma unroll
                for (int k4 = 0; k4 < 16; ++k4) {
                    const float4 wv = *(const float4*)(lds + 64 + k4 * 4), bv = *(const float4*)(lds + 128 + k4 * 4), kv = *(const float4*)(lds + 192 + k4 * 4), rv = *(const float4*)(lds + 256 + k4 * 4);
                    S[k4 * 4] = S[k4 * 4] * wv.x + sa * bv.x + V * kv.x; S[k4 * 4 + 1] = S[k4 * 4 + 1] * wv.y + sa * bv.y + V * kv.y;
                    S[k4 * 4 + 2] = S[k4 * 4 + 2] * wv.z + sa * bv.z + V * kv.z; S[k4 * 4 + 3] = S[k4 * 4 + 3] * wv.w + sa * bv.w + V * kv.w;
                    y += S[k4 * 4] * rv.x + S[k4 * 4 + 1] * rv.y + S[k4 * 4 + 2] * rv.z + S[k4 * 4 + 3] * rv.w;
                }
                __builtin_amdgcn_wave_barrier();
                yout[(size_t)row * 512 + hc] = f2bf(y);
            }
        }
    }
    __syncthreads();
}
DI void ph_post(const Ctx& cx, const Params& p, int j, int nrows) {
    const int gtid = cx.bid * NTHR + cx.tid, gsz = cx.nblk * NTHR;
    for (int idx = gtid; idx < 8 * nrows; idx += gsz) {
        const int h = idx / nrows, row = idx % nrows;
        const bool lat = row < NLAT; const int t = lat ? (row & 2047) : ((row - NLAT) & 255); const int T = lat ? 2048 : 256;
        float sum = 0.f, sb = 0.f;
#pragma unroll 8
        for (int n = 0; n < 64; ++n) {
            const int hc = h * 64 + n;
            const float yy = bf2f(p.YF[(size_t)row * 512 + hc]) + bf2f(p.YB[(size_t)row * 512 + hc]);
            sum += yy;
            const float R = shiftp(p.P, row, t, T, hc, p.a_mu[j * ACOLS + hc]), K = shiftp(p.P, row, t, T, 512 + hc, p.a_mu[j * ACOLS + 512 + hc]);
            const float af = bf2f(p.WAG[(size_t)row * WLD + 1024 + hc]), ab = bf2f(p.WAG[(size_t)row * WLD + 1536 + hc]);
            const float ka = p.a_k_a[j * 512 + hc], rk = p.a_r_k[j * 512 + hc];
            sb += R * rk * (K * (1.f + (af - 1.f) * ka) + K * (1.f + (ab - 1.f) * ka));
        }
        const float mean = sum * (1.f / 64.f); float var = 0.f;
#pragma unroll 8
        for (int n = 0; n < 64; ++n) { const int hc = h * 64 + n; const float yy = bf2f(p.YF[(size_t)row * 512 + hc]) + bf2f(p.YB[(size_t)row * 512 + hc]); var += (yy - mean) * (yy - mean); }
        const float rstd = rsqrtf(var * (1.f / 64.f) + 64e-5f);
#pragma unroll 8
        for (int n = 0; n < 64; ++n) {
            const int hc = h * 64 + n;
            const float yy = bf2f(p.YF[(size_t)row * 512 + hc]) + bf2f(p.YB[(size_t)row * 512 + hc]);
            const float V = shiftp(p.P, row, t, T, 1024 + hc, p.a_mu[j * ACOLS + 1024 + hc]);
            const float g = bf2f(p.WAG[(size_t)row * WLD + 2048 + hc]);
            const float o = ((yy - mean) * rstd * p.a_ln_w[j * 512 + hc] + p.a_ln_b[j * 512 + hc] + sb * V) * g;
            p.H[(size_t)row * 1024 + hc] = f2bf(o);
        }
    }
}
DI void ph_wout(const Ctx& cx, const Params& p, float* lds, const bf16_t* A, const float* W, int nrows, const float* xin_lat, const float* xin_ctx, const float* modl) {
    ngemm<false>(cx, lds, 1, nrows, 1024, 1024,
        [&](int, int m) { return A + (size_t)m * 1024; },
        [&](int, int k) { return W + (size_t)k * 1024; }, [&](int, int) { return (const float*)nullptr; },
        [&](int, int m, int n, float v, float) {
            const bool lat = m < NLAT; const int jj = lat ? (m >> 11) : 16; const float g1 = modl[(size_t)jj * 6144 + 2 * 1024 + n];
            if (lat) p.out[(size_t)m * 1024 + n] = xin_lat[(size_t)m * 1024 + n] + g1 * v;
            else p.ctxs[(size_t)(m - NLAT) * 1024 + n] = xin_ctx[(size_t)(m - NLAT) * 1024 + n] + g1 * v; });
}

DI void ph_chdft(const Ctx& cx, const Params& p, float* lds, int nrows) {
    const int tid = cx.tid, gtid = cx.bid * NTHR + tid, gsz = cx.nblk * NTHR;
    for (int i = tid; i < 128; i += NTHR) { lds[i] = cospif((float)i * (1.f / 64.f)); lds[128 + i] = sinpif((float)i * (1.f / 64.f)); }
    __syncthreads();
    for (int idx = gtid; idx < nrows * 1024; idx += gsz) {
        const int row = idx >> 10, col = idx & 1023, grp = col >> 7, g = col & 127;
        const bf16_t* hp = p.H + (size_t)row * 1024 + grp * 128;
        float gr = 0.f, gi = 0.f;
        for (int c = 0; c < 128; ++c) { const float xv = bf2f(hp[c]); const int m = (c * g) & 127; gr += xv * lds[m]; gi -= xv * lds[128 + m]; }
        p.G[(size_t)row * 2048 + col] = gr; p.G[(size_t)row * 2048 + 1024 + col] = gi;
    }
    __syncthreads();
}
DI void ph_posdft(const Ctx& cx, const Params& p, float* lds, bool with_ctx) {
    ngemm<false>(cx, lds, 16, 2048, 1024, 4096,
        [&](int, int m) { return p.dftl + (size_t)m * 4096; },
        [&](int bz, int k) { return (k < 2048) ? p.G + (size_t)(bz * 2048 + k) * 2048 : p.G + (size_t)(bz * 2048 + k - 2048) * 2048 + 1024; }, [&](int, int) { return (const float*)nullptr; },
        [&](int bz, int m, int n, float v, float) { p.F[(size_t)(bz * 2048 + m) * 1024 + n] = f2bf(v * (1.f / 512.f)); });
    if (with_ctx)
        ngemm<false>(cx, lds, 16, 256, 1024, 512,
            [&](int, int m) { return p.dftc + (size_t)m * 512; },
            [&](int bz, int k) { return (k < 256) ? p.G + (size_t)(NLAT + bz * 256 + k) * 2048 : p.G + (size_t)(NLAT + bz * 256 + k - 256) * 2048 + 1024; }, [&](int, int) { return (const float*)nullptr; },
            [&](int bz, int m, int n, float v, float) { p.F[(size_t)(NLAT + bz * 256 + m) * 1024 + n] = f2bf(v * 0.0055242717280199f); });
}

DI void ph_moe_up(const Ctx& cx, const Params& p, float* lds, int layer, int nrows) {
    for (int e = 0; e < 17; ++e) {
        const int M = (e < 16) ? __builtin_amdgcn_readfirstlane(p.cnt[(layer * 16 + e) * 64]) : nrows;
        const float* Wg = (e < 16) ? p.moe_w_gate + ((size_t)layer * 16 + e) * 1024 * 512 : p.sh_gate + (size_t)layer * 1024 * 512;
        const float* Wu = (e < 16) ? p.moe_w_up + ((size_t)layer * 16 + e) * 1024 * 512 : p.sh_up + (size_t)layer * 1024 * 512;
        const int* sl = p.slot + (size_t)(e & 15) * NT;
        ngemm<true>(cx, lds, 1, M, 512, 1024,
            [&](int, int m) { const int tok = (e < 16) ? (sl[m] >> 1) : m; return p.H + (size_t)tok * 1024; },
            [&](int, int k) { return Wg + (size_t)k * 512; }, [&](int, int k) { return Wu + (size_t)k * 512; },
            [&](int, int m, int n, float g, float u) { const int s = (e < 16) ? sl[m] : 0; const int tok = (e < 16) ? (s >> 1) : m, slab = (e < 16) ? (s & 1) : 2;
                p.ACT[((size_t)slab * NT + tok) * 512 + n] = f2bf(siluf(g) * u); });
    }
}
DI void ph_moe_down(const Ctx& cx, const Params& p, float* lds, int layer, int nrows) {
    for (int e = 0; e < 17; ++e) {
        const int M = (e < 16) ? __builtin_amdgcn_readfirstlane(p.cnt[(layer * 16 + e) * 64]) : nrows;
        const float* Wd = (e < 16) ? p.moe_w_down + ((size_t)layer * 16 + e) * 512 * 1024 : p.sh_down + (size_t)layer * 512 * 1024;
        const int* sl = p.slot + (size_t)(e & 15) * NT;
        ngemm<false>(cx, lds, 1, M, 1024, 512,
            [&](int, int m) { const int s = (e < 16) ? sl[m] : 0; const int tok = (e < 16) ? (s >> 1) : m, slab = (e < 16) ? (s & 1) : 2; return p.ACT + ((size_t)slab * NT + tok) * 512; },
            [&](int, int k) { return Wd + (size_t)k * 1024; }, [&](int, int) { return (const float*)nullptr; },
            [&](int, int m, int n, float v, float) { const int s = (e < 16) ? sl[m] : 0; const int tok = (e < 16) ? (s >> 1) : m, slab = (e < 16) ? (s & 1) : 2;
                const float w = (e < 16) ? p.tokw[s] : 1.f; p.Y[((size_t)slab * NT + tok) * 1024 + n] = f2bf(w * v); });
    }
}

namespace mm {
typedef short bf16x8 __attribute__((ext_vector_type(8)));
typedef float f32x4 __attribute__((ext_vector_type(4)));
typedef unsigned u32x4 __attribute__((ext_vector_type(4)));
constexpr int BM = 256, BK = 64, HALF = 128, HTB = HALF * BK * 2, STAGE_BYTES = 8 * HTB;
DI int lds_byte(int r, int c) { const int st = (r >> 4) * 2 + (c >> 5), rr = r & 15, cc = c & 31, ob = rr * 64 + cc * 2; return st * 1024 + (ob ^ (((ob >> 9) & 1) << 5)); }
DI void stage_rc(int b, int& R, int& C) { const int st = b / 1024, sb = b % 1024, swz = sb ^ (((sb >> 9) & 1) << 5); R = (st >> 1) * 16 + swz / 64; C = (st & 1) * 32 + (swz % 64) / 2; }
DI int perm32(int rho) { const int n = rho >> 4, i = rho & 15; return 8 * (i >> 2) + 4 * n + (i & 3); }
DI unsigned cvt_pk_bf16(float lo, float hi) { unsigned r; asm volatile("v_cvt_pk_bf16_f32 %0, %1, %2" : "=v"(r) : "v"(lo), "v"(hi)); return r; }
struct Unit { const char* A; const char* B; int pm, pn, e, m, tb; };
template <class Sched, class Epi>
DI void gemm_phase(LAS unsigned char* lds, const int K, const Sched& S, const Epi& E, const int tid) {
    const int wid = __builtin_amdgcn_readfirstlane(tid >> 6), lane = tid & 63, wr = wid >> 2, wc = wid & 3, fr = lane & 15, fq = lane >> 4;
    const int nt = K / BK;
    int R0, C0, R1, C1; stage_rc(tid * 16, R0, C0); stage_rc(tid * 16 + 8192, R1, C1);
    unsigned voffB[2];
    { const int Rb0 = Epi::PERM ? ((R0 & ~31) + perm32(R0 & 31)) : R0, Rb1 = Epi::PERM ? ((R1 & ~31) + perm32(R1 & 31)) : R1;
      voffB[0] = S.boff(Rb0, C0, K); voffB[1] = S.boff(Rb1, C1, K); }
    const size_t kstep = (size_t)(BK * 2), hstepB = S.hstep_b(K), hstepA = S.hstep_a();
    const unsigned ldsw = (unsigned)wid * 1024u;
    const int aoff = lds_byte(wr * 64 + fr, fq * 8), boff = lds_byte(wc * 32 + fr, fq * 8);
#define MM_SA(b, h) (((b) * 2 + (h)) * HTB)
#define MM_SB(b, h) ((4 + (b) * 2 + (h)) * HTB)
#define MM_STAGE_A(bufoff, gbase, h, offs) do { _Pragma("unroll") for (int _i = 0; _i < 2; ++_i) { \
        if constexpr (Sched::GATHER) __builtin_amdgcn_global_load_lds((const unsigned*)((const char*)(gbase) + (offs)[h][_i]), (LAS unsigned*)(lds + (bufoff) + ldsw + _i * 8192), 16, 0, 0); \
        else __builtin_amdgcn_global_load_lds((const unsigned*)((const char*)(gbase) + (size_t)(h) * hstepA + (offs)[0][_i]), (LAS unsigned*)(lds + (bufoff) + ldsw + _i * 8192), 16, 0, 0); } } while (0)
#define MM_STAGE_B(bufoff, gbase) do { _Pragma("unroll") for (int _i = 0; _i < 2; ++_i) \
        __builtin_amdgcn_global_load_lds((const unsigned*)((const char*)(gbase) + voffB[_i]), (LAS unsigned*)(lds + (bufoff) + ldsw + _i * 8192), 16, 0, 0); } while (0)
#define MM_LDA(dst, b, h) do { _Pragma("unroll") for (int m = 0; m < 4; ++m) _Pragma("unroll") for (int k = 0; k < 2; ++k) dst[m][k] = *(const LAS bf16x8*)(lds + MM_SA(b, h) + aoff + m * 2048 + k * 1024); } while (0)
#define MM_LDB(dst, b, h) do { _Pragma("unroll") for (int n = 0; n < 2; ++n) _Pragma("unroll") for (int k = 0; k < 2; ++k) dst[n][k] = *(const LAS bf16x8*)(lds + MM_SB(b, h) + boff + n * 2048 + k * 1024); } while (0)
#define MM_MMA(ai, bj, At, Bt) do { __builtin_amdgcn_s_setprio(1); _Pragma("unroll") for (int m = 0; m < 4; ++m) _Pragma("unroll") for (int n = 0; n < 2; ++n) _Pragma("unroll") for (int k = 0; k < 2; ++k) \
        acc[ai][bj][m][n] = __builtin_amdgcn_mfma_f32_16x16x32_bf16(Bt[n][k], At[m][k], acc[ai][bj][m][n], 0, 0, 0); __builtin_amdgcn_s_setprio(0); } while (0)
#define MM_WAIT_V(n) asm volatile("s_waitcnt vmcnt(" #n ")" ::: "memory")
#define MM_WAIT_L(n) asm volatile("s_waitcnt lgkmcnt(" #n ")" ::: "memory")
#define MM_BAR __builtin_amdgcn_s_barrier()
#define MM_SCHED __builtin_amdgcn_sched_barrier(0)
    Unit cur, nxt; int ui = 0;
    if (!S.next(0, cur)) return;
    unsigned oa[2][2], on[2][2];
    S.aoff(cur, R0, C0, R1, C1, oa);
    on[0][0] = oa[0][0]; on[0][1] = oa[0][1]; on[1][0] = oa[1][0]; on[1][1] = oa[1][1];
    if constexpr (Sched::TABLE) S.tab_dma(cur, lds + STAGE_BYTES + 1024, tid);
    f32x4 acc[2][2][4][2];
#pragma unroll
    for (int a = 0; a < 2; ++a)
#pragma unroll
        for (int b = 0; b < 2; ++b)
#pragma unroll
            for (int m = 0; m < 4; ++m)
#pragma unroll
                for (int n = 0; n < 2; ++n) acc[a][b][m][n] = (f32x4){0.f, 0.f, 0.f, 0.f};
    bf16x8 At[4][2], B0[2][2], B1[2][2];
    const char* cA = cur.A; const char* cB = cur.B;
    MM_STAGE_B(MM_SB(0, 0), cB); MM_STAGE_A(MM_SA(0, 0), cA, 0, oa); MM_STAGE_B(MM_SB(0, 1), cB + hstepB); MM_STAGE_A(MM_SA(0, 1), cA, 1, oa);
    if (wr == 1) MM_BAR;
    MM_WAIT_V(4); MM_BAR;
    MM_STAGE_B(MM_SB(1, 0), cB + kstep); MM_STAGE_A(MM_SA(1, 0), cA + kstep, 0, oa); MM_STAGE_B(MM_SB(1, 1), cB + hstepB + kstep);
    MM_WAIT_V(6); MM_BAR;
    for (;;) {
        cur.tb = ui % 3;
        const bool has_next = S.next(ui + 1, nxt);
        if constexpr (Sched::TABLE) { if (has_next) S.tab_dma(nxt, lds + STAGE_BYTES + 1024 + ((ui + 1) % 3) * 2048, tid); }
        const char* nA = has_next ? nxt.A : cA; const char* nB = has_next ? nxt.B : cB;
        for (int t = 0; t < nt; t += 2) {
            const bool last = (t == nt - 2);
            if constexpr (Sched::GATHER) { if (last) { if (has_next) S.aoff_lds(nxt, (const LAS int*)(lds + STAGE_BYTES + 1024 + ((ui + 1) % 3) * 2048), R0, C0, R1, C1, on);
                else { on[0][0] = oa[0][0]; on[0][1] = oa[0][1]; on[1][0] = oa[1][0]; on[1][1] = oa[1][1]; } } }
            const char* a1 = cA + (size_t)(t + 1) * kstep;
            const char* a2 = last ? nA : cA + (size_t)(t + 2) * kstep; const char* b2 = last ? nB : cB + (size_t)(t + 2) * kstep;
            const char* a3 = a2 + kstep; const char* b3 = b2 + kstep;
            unsigned o2[2][2];
            if constexpr (Sched::GATHER) { o2[0][0] = last ? on[0][0] : oa[0][0]; o2[0][1] = last ? on[0][1] : oa[0][1]; o2[1][0] = last ? on[1][0] : oa[1][0]; o2[1][1] = last ? on[1][1] : oa[1][1]; }
            else { o2[0][0] = oa[0][0]; o2[0][1] = oa[0][1]; o2[1][0] = oa[1][0]; o2[1][1] = oa[1][1]; }
            MM_LDB(B0, 0, 0); MM_SCHED; MM_LDA(At, 0, 0); MM_STAGE_A(MM_SA(1, 1), a1, 1, oa);
            MM_WAIT_L(8); MM_BAR; MM_WAIT_L(0); MM_MMA(0, 0, At, B0); MM_BAR; MM_SCHED;
            MM_LDB(B1, 0, 1); MM_STAGE_B(MM_SB(0, 0), b2);
            MM_BAR; MM_WAIT_L(0); MM_MMA(0, 1, At, B1); MM_BAR;
            MM_LDA(At, 0, 1); MM_STAGE_A(MM_SA(0, 0), a2, 0, o2);
            MM_BAR; MM_WAIT_L(0); MM_MMA(1, 0, At, B0); MM_BAR; MM_SCHED;
            MM_STAGE_B(MM_SB(0, 1), b2 + hstepB);
            MM_WAIT_V(6); MM_BAR; MM_MMA(1, 1, At, B1); MM_BAR;
            MM_LDB(B0, 1, 0); MM_SCHED; MM_LDA(At, 1, 0); MM_STAGE_A(MM_SA(0, 1), a2, 1, o2);
            MM_WAIT_L(8); MM_BAR; MM_WAIT_L(0); MM_MMA(0, 0, At, B0); MM_BAR; MM_SCHED;
            MM_LDB(B1, 1, 1); MM_STAGE_B(MM_SB(1, 0), b3);
            MM_BAR; MM_WAIT_L(0); MM_MMA(0, 1, At, B1); MM_BAR;
            MM_LDA(At, 1, 1); MM_STAGE_A(MM_SA(1, 0), a3, 0, o2);
            MM_BAR; MM_WAIT_L(0); MM_MMA(1, 0, At, B0); MM_BAR; MM_SCHED;
            MM_STAGE_B(MM_SB(1, 1), b3 + hstepB);
            MM_WAIT_V(6); MM_BAR; MM_MMA(1, 1, At, B1); MM_BAR;
        }
        {
          int tz = tid; asm volatile("" : "+v"(tz)); const int wz = tz >> 6, lz = tz & 63;
          E(acc, cur, wz >> 2, wz & 3, lz & 15, lz >> 4); }
        if (!has_next) break;
#pragma unroll
        for (int a = 0; a < 2; ++a)
#pragma unroll
            for (int b = 0; b < 2; ++b)
#pragma unroll
                for (int m = 0; m < 4; ++m)
#pragma unroll
                    for (int n = 0; n < 2; ++n) acc[a][b][m][n] = (f32x4){0.f, 0.f, 0.f, 0.f};
        cur = nxt; cA = nA; cB = nB; ++ui;
        if constexpr (Sched::GATHER) { oa[0][0] = on[0][0]; oa[0][1] = on[0][1]; oa[1][0] = on[1][0]; oa[1][1] = on[1][1]; }
    }
    MM_WAIT_V(0);
    if (wr == 0) MM_BAR;
    MM_BAR;
#undef MM_SA
#undef MM_SB
#undef MM_STAGE_A
#undef MM_STAGE_B
#undef MM_LDA
#undef MM_LDB
#undef MM_MMA
#undef MM_WAIT_V
#undef MM_WAIT_L
#undef MM_BAR
#undef MM_SCHED
}
struct StaticSched {
    static constexpr bool GATHER = false, TABLE = false;
    const char* A; const char* Bt; int lda, K, nM, nN, nwg, G, c;
    DI size_t hstep_a() const { return (size_t)HALF * lda * 2; }
    DI unsigned boff(int Rb, int C, int Kk) const { return (unsigned)(Rb * Kk + C) * 2u; }
    DI size_t hstep_b(int Kk) const { return (size_t)HALF * Kk * 2; }
    DI void init(const void* A_, const void* Bt_, int M, int N, int K_, int lda_, int G_, int c_) { A = (const char*)A_; Bt = (const char*)Bt_; lda = lda_; K = K_; nM = M / BM; nN = N / BM; nwg = nM * nN; G = G_; c = c_; }
    DI void unit_at(int L, Unit& u) const {
        int wgid = L; { const int q = nwg / 8, r = nwg % 8, xcd = wgid % 8, off = wgid / 8; wgid = (xcd < r ? xcd * (q + 1) : r * (q + 1) + (xcd - r) * q) + off; }
        const int nig = 8 * nN, gid = wgid / nig, fm = gid * 8, gsz = (nM - fm) < 8 ? (nM - fm) : 8;
        u.pm = fm + ((wgid % nig) % gsz); u.pn = (wgid % nig) / gsz; u.e = 0; u.m = 0;
        u.A = A + (size_t)u.pm * BM * lda * 2; u.B = Bt + (size_t)u.pn * BM * K * 2;
    }
    DI bool next(int i, Unit& u) const { const int L = i * G + c; if (L >= nwg) return false; unit_at(L, u); return true; }
    DI void aoff(const Unit&, int R0, int C0, int R1, int C1, unsigned (&o)[2][2]) const {
        o[0][0] = (unsigned)(R0 * lda + C0) * 2u; o[0][1] = (unsigned)(R1 * lda + C1) * 2u;
        o[1][0] = (unsigned)((HALF + R0) * lda + C0) * 2u; o[1][1] = (unsigned)((HALF + R1) * lda + C1) * 2u;
    }
};
struct PairSched {
    static constexpr bool GATHER = false, TABLE = false;
    StaticSched s0, s1; int G, c;
    DI size_t hstep_a() const { return s0.hstep_a(); }
    DI unsigned boff(int Rb, int C, int Kk) const { return s0.boff(Rb, C, Kk); }
    DI size_t hstep_b(int Kk) const { return s0.hstep_b(Kk); }
    DI bool next(int i, Unit& u) const {
        const int L = i * G + c;
        if (L < s1.nwg) { s1.unit_at(L, u); u.e = 1; return true; }
        if (L - s1.nwg >= s0.nwg) return false;
        s0.unit_at(L - s1.nwg, u); u.e = 0; return true;
    }
    DI void aoff(const Unit& u, int R0, int C0, int R1, int C1, unsigned (&o)[2][2]) const { s0.aoff(u, R0, C0, R1, C1, o); }
};
struct BatchSched {
    static constexpr bool GATHER = false, TABLE = false;
    const char* A; const char* Bt; int K, nM, nN, nb, G, c; size_t bstride;
    DI size_t hstep_a() const { return (size_t)HALF * K * 2; }
    DI unsigned boff(int Rb, int C, int Kk) const { return (unsigned)(Rb * Kk + C) * 2u; }
    DI size_t hstep_b(int Kk) const { return (size_t)HALF * Kk * 2; }
    DI void init(const void* A_, const void* Bt_, size_t bstride_bytes, int nb_, int M, int N, int K_, int G_, int c_) { A = (const char*)A_; Bt = (const char*)Bt_; bstride = bstride_bytes; nb = nb_; K = K_; nM = M / BM; nN = N / BM; G = G_; c = c_; }
    DI bool next(int i, Unit& u) const {
        const int L = i * G + c; if (L >= nb * nM * nN) return false;
        const int b = L / (nM * nN), rem = L % (nM * nN); u.pm = rem / nN; u.pn = rem % nN; u.e = b; u.m = 0;
        u.A = A + (size_t)u.pm * BM * K * 2; u.B = Bt + (size_t)b * bstride + (size_t)u.pn * BM * K * 2; return true;
    }
    DI void aoff(const Unit&, int R0, int C0, int R1, int C1, unsigned (&o)[2][2]) const {
        o[0][0] = (unsigned)(R0 * K + C0) * 2u; o[0][1] = (unsigned)(R1 * K + C1) * 2u;
        o[1][0] = (unsigned)((HALF + R0) * K + C0) * 2u; o[1][1] = (unsigned)((HALF + R1) * K + C1) * 2u;
    }
};
struct EpiBf16Store {
    static constexpr bool PERM = true;
    bf16_t* O0; int ldc; size_t bstr = 0;
    DI void operator()(const f32x4 (&acc)[2][2][4][2], const Unit& u, int wr, int wc, int fr, int fq) const {
        bf16_t* O = O0 + (size_t)u.e * bstr;
        const int row0 = u.pm * BM + wr * 64 + fr, col0 = u.pn * BM + wc * 32 + 8 * fq;
#pragma unroll
        for (int ai = 0; ai < 2; ++ai)
#pragma unroll
            for (int m = 0; m < 4; ++m) { bf16_t* rowp = O + (size_t)(row0 + ai * HALF + m * 16) * ldc + col0;
#pragma unroll
                for (int bj = 0; bj < 2; ++bj) { const f32x4 v0 = acc[ai][bj][m][0], v1 = acc[ai][bj][m][1];
                    u32x4 w; w.x = cvt_pk_bf16(v0[0], v0[1]); w.y = cvt_pk_bf16(v0[2], v0[3]); w.z = cvt_pk_bf16(v1[0], v1[1]); w.w = cvt_pk_bf16(v1[2], v1[3]);
                    *(u32x4*)(rowp + bj * HALF) = w; } }
    }
};
struct EpiResid {
    static constexpr bool PERM = false;
    const float* xin_lat; const float* xin_ctx; float* out_lat; float* out_ctx; const float* modl; int batched_T;
    DI void operator()(const f32x4 (&acc)[2][2][4][2], const Unit& u, int wr, int wc, int fr, int fq) const {
        int grow0; if (batched_T == 0) grow0 = u.pm * BM; else if (batched_T > 0) grow0 = u.e * 2048 + u.pm * BM; else grow0 = NLAT + u.e * 256 + u.pm * BM;
        const bool lat = grow0 < NLAT; const int jj = lat ? (grow0 >> 11) : 16;
        const float* xi = lat ? xin_lat + (size_t)grow0 * 1024 : xin_ctx + (size_t)(grow0 - NLAT) * 1024;
        float* xo = lat ? out_lat + (size_t)grow0 * 1024 : out_ctx + (size_t)(grow0 - NLAT) * 1024;
        const float* g1 = modl + (size_t)jj * 6144 + 2 * 1024;
        const int r0 = wr * 64 + fr, col0 = u.pn * BM + wc * 32 + 4 * fq;
        f32x4 gv[2][2];
#pragma unroll
        for (int bj = 0; bj < 2; ++bj)
#pragma unroll
            for (int n = 0; n < 2; ++n) gv[bj][n] = *(const f32x4*)(g1 + col0 + bj * HALF + n * 16);
#pragma unroll
        for (int ai = 0; ai < 2; ++ai) {
            f32x4 xv[4][2][2];
#pragma unroll
            for (int m = 0; m < 4; ++m)
#pragma unroll
                for (int bj = 0; bj < 2; ++bj)
#pragma unroll
                    for (int n = 0; n < 2; ++n) xv[m][bj][n] = *(const f32x4*)(xi + (size_t)(r0 + ai * HALF + m * 16) * 1024 + col0 + bj * HALF + n * 16);
#pragma unroll
            for (int m = 0; m < 4; ++m)
#pragma unroll
                for (int bj = 0; bj < 2; ++bj)
#pragma unroll
                    for (int n = 0; n < 2; ++n) *(f32x4*)(xo + (size_t)(r0 + ai * HALF + m * 16) * 1024 + col0 + bj * HALF + n * 16) = xv[m][bj][n] + gv[bj][n] * acc[ai][bj][m][n];
            asm volatile("" ::: "memory");
        }
    }
};
struct EpiResidB {
    static constexpr bool PERM = true;
    const void* xin_lat; const void* xin_ctx; bf16_t* out_lat; bf16_t* out_ctx; const float* modl; int batched_T; int in_f32;
    DI void operator()(const f32x4 (&acc)[2][2][4][2], const Unit& u, int wr, int wc, int fr, int fq) const {
        int grow0; if (batched_T == 0) grow0 = u.pm * BM; else if (batched_T > 0) grow0 = u.e * 2048 + u.pm * BM; else grow0 = NLAT + u.e * 256 + u.pm * BM;
        const bool lat = grow0 < NLAT; const int jj = lat ? (grow0 >> 11) : 16; const size_t rb = lat ? (size_t)grow0 : (size_t)(grow0 - NLAT);
        const float* g1 = modl + (size_t)jj * 6144 + 2 * 1024;
        bf16_t* xo = (lat ? out_lat : out_ctx) + rb * 1024;
        const int r0 = wr * 64 + fr, col0 = u.pn * BM + wc * 32 + 8 * fq;
        f32x4 gv[2][2];
#pragma unroll
        for (int bj = 0; bj < 2; ++bj)
#pragma unroll
            for (int n = 0; n < 2; ++n) gv[bj][n] = *(const f32x4*)(g1 + col0 + bj * HALF + 4 * n);
        if (in_f32) {
            const float* xi = (const float*)(lat ? xin_lat : xin_ctx) + rb * 1024;
#pragma unroll
            for (int ai = 0; ai < 2; ++ai)
#pragma unroll
                for (int mp = 0; mp < 2; ++mp) {
                    f32x4 xv[2][2][2];
#pragma unroll
                    for (int mm_ = 0; mm_ < 2; ++mm_)
#pragma unroll
                        for (int bj = 0; bj < 2; ++bj)
#pragma unroll
                            for (int n = 0; n < 2; ++n) xv[mm_][bj][n] = *(const f32x4*)(xi + (size_t)(r0 + ai * HALF + (2 * mp + mm_) * 16) * 1024 + col0 + bj * HALF + 4 * n);
#pragma unroll
                    for (int mm_ = 0; mm_ < 2; ++mm_)
#pragma unroll
                        for (int bj = 0; bj < 2; ++bj) { const int m = 2 * mp + mm_; const f32x4 o0 = xv[mm_][bj][0] + gv[bj][0] * acc[ai][bj][m][0], o1 = xv[mm_][bj][1] + gv[bj][1] * acc[ai][bj][m][1];
                            u32x4 w; w.x = att_pk(o0[0], o0[1]); w.y = att_pk(o0[2], o0[3]); w.z = att_pk(o1[0], o1[1]); w.w = att_pk(o1[2], o1[3]);
                            *(u32x4*)(xo + (size_t)(r0 + ai * HALF + m * 16) * 1024 + col0 + bj * HALF) = w; }
                    asm volatile("" ::: "memory");
                }
        } else {
            const bf16_t* xi = (const bf16_t*)(lat ? xin_lat : xin_ctx) + rb * 1024;
#pragma unroll
            for (int ai = 0; ai < 2; ++ai) {
                u32x4 xv[4][2];
#pragma unroll
                for (int m = 0; m < 4; ++m)
#pragma unroll
                    for (int bj = 0; bj < 2; ++bj) xv[m][bj] = *(const u32x4*)(xi + (size_t)(r0 + ai * HALF + m * 16) * 1024 + col0 + bj * HALF);
#pragma unroll
                for (int m = 0; m < 4; ++m)
#pragma unroll
                    for (int bj = 0; bj < 2; ++bj) { const u32x4 x = xv[m][bj];
                        const f32x4 x0 = {__uint_as_float(x.x << 16), __uint_as_float(x.x & 0xffff0000u), __uint_as_float(x.y << 16), __uint_as_float(x.y & 0xffff0000u)};
                        const f32x4 x1 = {__uint_as_float(x.z << 16), __uint_as_float(x.z & 0xffff0000u), __uint_as_float(x.w << 16), __uint_as_float(x.w & 0xffff0000u)};
                        const f32x4 o0 = x0 + gv[bj][0] * acc[ai][bj][m][0], o1 = x1 + gv[bj][1] * acc[ai][bj][m][1];
                        u32x4 w; w.x = att_pk(o0[0], o0[1]); w.y = att_pk(o0[2], o0[3]); w.z = att_pk(o1[0], o1[1]); w.w = att_pk(o1[2], o1[3]);
                        *(u32x4*)(xo + (size_t)(r0 + ai * HALF + m * 16) * 1024 + col0 + bj * HALF) = w; }
                asm volatile("" ::: "memory");
            }
        }
    }
};
}

DI void tconv_tile(const Ctx& cx, float* T, const float* src, int ld_src, int k0, int n0, int kvalid, int nvalid, bf16_t* dst, int ldd, int drow0) {
    const int tid = cx.tid;
#pragma unroll
    for (int rr = 0; rr < 2; ++rr) {
        const int i = (tid >> 4) + 32 * rr, j = (tid & 15) * 4;
        float4 v = make_float4(0.f, 0.f, 0.f, 0.f);
        if (k0 + i < kvalid && n0 + j < nvalid) v = *(const float4*)(src + (size_t)(k0 + i) * ld_src + n0 + j);
        T[i * 65 + j] = v.x; T[i * 65 + j + 1] = v.y; T[i * 65 + j + 2] = v.z; T[i * 65 + j + 3] = v.w;
    }
    __syncthreads();
    { const int j = tid >> 3, ch = tid & 7; uint4 o;
      o.x = pack2(T[(ch * 8 + 0) * 65 + j], T[(ch * 8 + 1) * 65 + j]); o.y = pack2(T[(ch * 8 + 2) * 65 + j], T[(ch * 8 + 3) * 65 + j]);
      o.z = pack2(T[(ch * 8 + 4) * 65 + j], T[(ch * 8 + 5) * 65 + j]); o.w = pack2(T[(ch * 8 + 6) * 65 + j], T[(ch * 8 + 7) * 65 + j]);
      *(uint4*)(dst + (size_t)(drow0 + j) * ldd + k0 + ch * 8) = o; }
    __syncthreads();
}
DI void ph_prep_weights(const Ctx& cx, const Params& p, float* lds) {
    const int tid = cx.tid, gtid = cx.bid * NTHR + tid, gsz = cx.nblk * NTHR;
    const int tb0 = (cx.nblk >= 256) ? cx.bid - 128 : cx.bid, tbs = (cx.nblk >= 256) ? 128 : cx.nblk;
    for (int it = tb0; it < 2 * 1008 && tb0 >= 0; it += tbs) {
        const int j = it / 1008; int r = it % 1008;
        if (r < 640) { const int kt = r / 40, ntl = r % 40; tconv_tile(cx, lds, p.w_in + (size_t)j * 1024 * INC, INC, kt * 64, ntl * 64, 1024, INC, p.WinT + (size_t)j * 2560 * 1024, 1024, ntl * 64); continue; } r -= 640;
        if (r < 48) { const int kt = r / 12, ntl = r % 12; tconv_tile(cx, lds, p.b_w_q_up + (size_t)j * 256 * 768, 768, kt * 64, ntl * 64, 256, 768, p.WqT + (size_t)j * 768 * 256, 256, ntl * 64); continue; } r -= 48;
        if (r < 64) { const int kt = r / 16, ntl = r % 16; tconv_tile(cx, lds, p.b_w_kv_up + (size_t)j * 128 * 1024, 1024, kt * 64, ntl * 64, 128, 1024, p.WkvT + (size_t)j * 1024 * 256, 256, ntl * 64); continue; } r -= 64;
        { const int kt = r / 16, ntl = r % 16; tconv_tile(cx, lds, p.w_out_even + (size_t)j * 1024 * 1024, 1024, kt * 64, ntl * 64, 1024, 1024, p.WoutT + (size_t)j * 1024 * 1024, 1024, ntl * 64); }
    }
    for (int idx = gtid; idx < 2 * 2560 * 384; idx += gsz) {
        const int j = idx / (2560 * 384), rem = idx % (2560 * 384), n = rem / 384, k = rem % 384; const int seg = n >> 9, nn = n & 511;
        float v = 0.f;
        if (seg < 2) { if ((k >> 6) == seg) v = p.a_w2[((size_t)(j * 2 + seg) * 64 + (k & 63)) * 512 + nn]; }
        else if (seg < 4) { if ((k >> 6) == seg) v = p.a_a2[((size_t)(j * 2 + seg - 2) * 64 + (k & 63)) * 512 + nn]; }
        else { if (k >= 256) v = p.a_g2[((size_t)j * 128 + (k - 256)) * 512 + nn]; }
        p.WlrT[idx] = f2bf(v);
    }
    {
        constexpr int WP = 80;
        LAS float* Wt = (LAS float*)lds; LAS float* tab = Wt + 128 * WP;
        for (int i = tid; i < 128; i += NTHR) { tab[i] = cospif((float)i * (1.f / 64.f)); tab[128 + i] = sinpif((float)i * (1.f / 64.f)); }
        const int wid = tid >> 6, lane = tid & 63, lr = lane & 15, lq = lane >> 4, cb = wid & 3, eh = wid >> 2;
        for (int it = cx.bid; it < 2 * 256; it += cx.nblk) {
            const int j = it >> 8, ct = (it >> 4) & 15, et = it & 15, grp = ct >> 1, c = (ct & 1) * 64 + cb * 16 + lr;
            const float* Wf = p.w_out_fourier + (size_t)j * 1024 * 1024 + (size_t)grp * 128 * 1024 + et * 64;
            __syncthreads();
#pragma unroll
            for (int q = 0; q < 4; ++q) { const int idx = tid + 512 * q, g = idx >> 4, c4 = (idx & 15) * 4;
                const float4 v = *(const float4*)(Wf + (size_t)g * 1024 + c4); *(LAS mm::f32x4*)(Wt + g * WP + c4) = (mm::f32x4){v.x, v.y, v.z, v.w}; }
            __syncthreads();
            mm::f32x4 ac0 = {0.f, 0.f, 0.f, 0.f}, ac1 = ac0, as0 = ac0, as1 = ac0;
#pragma unroll 4
            for (int ks = 0; ks < 32; ++ks) {
                const int g = 4 * ks + lq, m = (c * g) & 127;
                const float tc = tab[m], ts = tab[128 + m];
                const float b0 = Wt[g * WP + eh * 32 + lr], b1 = Wt[g * WP + eh * 32 + 16 + lr];
                ac0 = __builtin_amdgcn_mfma_f32_16x16x4f32(tc, b0, ac0, 0, 0, 0); ac1 = __builtin_amdgcn_mfma_f32_16x16x4f32(tc, b1, ac1, 0, 0, 0);
                as0 = __builtin_amdgcn_mfma_f32_16x16x4f32(ts, b0, as0, 0, 0, 0); as1 = __builtin_amdgcn_mfma_f32_16x16x4f32(ts, b1, as1, 0, 0, 0);
            }
            bf16_t* d0 = p.A1 + (size_t)j * 2048 * 1024 + (size_t)(et * 64 + eh * 32 + lr) * 1024 + ct * 64 + cb * 16 + 4 * lq;
            *(uint2*)d0 = make_uint2(pack2(ac0[0], ac0[1]), pack2(ac0[2], ac0[3]));
            *(uint2*)(d0 + (size_t)16 * 1024) = make_uint2(pack2(ac1[0], ac1[1]), pack2(ac1[2], ac1[3]));
            *(uint2*)(d0 + (size_t)1024 * 1024) = make_uint2(pack2(as0[0], as0[1]), pack2(as0[2], as0[3]));
            *(uint2*)(d0 + (size_t)(1024 + 16) * 1024) = make_uint2(pack2(as1[0], as1[1]), pack2(as1[2], as1[3]));
        }
        __syncthreads();
    }
    for (int i = gtid; i < 256 * 256; i += gsz) {
        const int m = i >> 8, k = i & 255, f1 = m & 127, t1 = k & 127; const float a = (float)((f1 * t1) & 127) * (1.f / 64.f); const float cs = cospif(a), sn = sinpif(a);
        const float v = (m < 128) ? ((k < 128) ? cs : -sn) : ((k < 128) ? -sn : -cs);
        p.M1[i] = f2bf(v);
    }
    if (OPT < 12) for (int i = gtid; i < 2048 * 4096; i += gsz) {
        const int f = i >> 12, k = i & 4095, t = k & 2047, m = (f * t) & 2047; const float a = (float)m * (1.f / 1024.f);
        p.A2[i] = f2bf(((k < 2048) ? cospif(a) : -sinpif(a)) * (1.f / 512.f));
    }
    if (OPT < 12) for (int i = gtid; i < 256 * 512; i += gsz) {
        const int f = i >> 9, k = i & 511, t = k & 255, m = (f * t) & 255; const float a = (float)m * (1.f / 128.f);
        p.A2c[i] = f2bf(((k < 256) ? cospif(a) : -sinpif(a)) * 0.0055242717280199f);
    }
    __syncthreads();
}
DI void prep_moe_item(const Ctx& cx, const Params& p, float* lds, int layer, int s) {
    const int tid = cx.tid; constexpr int TP = 513;
    bf16_t* const WguT = p.WguT + (size_t)(layer & 1) * 17 * 1024 * 1024; bf16_t* const WdT = p.WdT + (size_t)(layer & 1) * 17 * 1024 * 512;
    {
        const int e = s / 48, r = s % 48;
        const float* src; int ld_src, kt, ldd; bf16_t* dst; int bj = 0, nh = 0; const bool gu = r < 32;
        if (gu) { bj = r >> 4; kt = r & 15; ld_src = 512; ldd = 1024;
            src = (bj ? ((e < 16) ? p.moe_w_up + ((size_t)layer * 16 + e) * 1024 * 512 : p.sh_up + (size_t)layer * 1024 * 512)
                      : ((e < 16) ? p.moe_w_gate + ((size_t)layer * 16 + e) * 1024 * 512 : p.sh_gate + (size_t)layer * 1024 * 512)) + (size_t)kt * 64 * 512;
            dst = WguT + (size_t)e * 1024 * 1024; }
        else { const int r2 = r - 32; kt = r2 >> 1; nh = r2 & 1; ld_src = 1024; ldd = 512;
            src = ((e < 16) ? p.moe_w_down + ((size_t)layer * 16 + e) * 512 * 1024 : p.sh_down + (size_t)layer * 512 * 1024) + (size_t)kt * 64 * 1024 + nh * 512;
            dst = WdT + (size_t)e * 1024 * 512; }
        float4 v[16];
#pragma unroll
        for (int i = 0; i < 16; ++i) v[i] = *(const float4*)(src + (size_t)((tid >> 7) + 4 * i) * ld_src + (tid & 127) * 4);
        __syncthreads();
#pragma unroll
        for (int i = 0; i < 16; ++i) { float* t = lds + ((tid >> 7) + 4 * i) * TP + (tid & 127) * 4; t[0] = v[i].x; t[1] = v[i].y; t[2] = v[i].z; t[3] = v[i].w; }
        __syncthreads();
#pragma unroll
        for (int it = 0; it < 8; ++it) {
            const int n = (tid >> 3) + 64 * it, ch = tid & 7; const float* t = lds + (ch * 8) * TP + n;
            uint4 o; o.x = att_pk(t[0], t[TP]); o.y = att_pk(t[2 * TP], t[3 * TP]); o.z = att_pk(t[4 * TP], t[5 * TP]); o.w = att_pk(t[6 * TP], t[7 * TP]);
            const int drow = gu ? ((n >> 7) * 256 + bj * 128 + (n & 127)) : (nh * 512 + n);
            *(uint4*)(dst + (size_t)drow * ldd + kt * 64 + ch * 8) = o;
        }
    }
}
DI void prep_moe_steal(const Ctx& cx, const Params& p, float* lds, int layer, int maxit) {
    LAS int* sh = (LAS int*)((LAS float*)lds + 64 * 513 + 16);
    for (int n = 0; n < maxit; ++n) {
        __syncthreads();
        if (cx.tid == 0) sh[0] = atomicAdd(p.cnt + (64 + layer) * 64, 1);
        __syncthreads();
        const int s = __builtin_amdgcn_readfirstlane(sh[0]);
        if (s >= 17 * 48) break;
        prep_moe_item(cx, p, lds, layer, s);
    }
    __syncthreads();
}
DI void ph_prep_moe(const Ctx& cx, const Params& p, float* lds, int layer) { prep_moe_steal(cx, p, lds, layer, 1 << 20); }
DI bool tail_idle(const Ctx& cx, int nunits) { const int full = nunits / cx.nblk, rem = nunits - full * cx.nblk; return rem != 0 && cx.bid >= rem; }

#define GEMM_LDS(lds) ((LAS unsigned char*)(lds))
DI void ph_win_mm(const Ctx& cx, const Params& p, float* lds, int j) {
    mm::StaticSched S; S.init(p.H, p.WinT + (size_t)j * 2560 * 1024, NT, 2560, 1024, 1024, cx.nblk, cx.bid);
    mm::EpiBf16Store E{p.P, PLD};
    mm::gemm_phase(GEMM_LDS(lds), 1024, S, E, cx.tid);
}
struct EpiNone { static constexpr bool PERM = true; DI void operator()(const mm::f32x4 (&acc)[2][2][4][2], const mm::Unit&, int, int, int, int) const {
#pragma unroll
    for (int ai = 0; ai < 2; ++ai)
#pragma unroll
        for (int bj = 0; bj < 2; ++bj)
#pragma unroll
            for (int m = 0; m < 4; ++m) asm volatile("" :: "v"(acc[ai][bj][m][0]), "v"(acc[ai][bj][m][1]));
} };
DI void ph_win_probe(const Ctx& cx, const Params& p, float* lds, int j) {
    mm::StaticSched S; S.init(p.H, p.WinT + (size_t)j * 2560 * 1024, NT, 2560, 1024, 1024, cx.nblk, cx.bid);
    if (PROBE_GEMM == 1) { mm::EpiBf16Store E{p.WAG, PLD}; mm::gemm_phase(GEMM_LDS(lds), 1024, S, E, cx.tid); }
    else { EpiNone E; mm::gemm_phase(GEMM_LDS(lds), 1024, S, E, cx.tid); }
}
DI void ph_wout_mmB(const Ctx& cx, const Params& p, float* lds, const bf16_t* A, const bf16_t* Bt, int nrows, const void* xin_lat, const void* xin_ctx, bf16_t* xo_lat, int in_f32, const float* modl) {
    mm::StaticSched S; S.init(A, Bt, nrows, 1024, 1024, 1024, cx.nblk, cx.bid);
    mm::EpiResidB E{xin_lat, xin_ctx, xo_lat, p.cs, modl, 0, in_f32};
    mm::gemm_phase(GEMM_LDS(lds), 1024, S, E, cx.tid);
}
DI void ph_wout_mm(const Ctx& cx, const Params& p, float* lds, const bf16_t* A, const bf16_t* Bt, int nrows, const float* xin_lat, const float* xin_ctx, const float* modl) {
    mm::StaticSched S; S.init(A, Bt, nrows, 1024, 1024, 1024, cx.nblk, cx.bid);
    mm::EpiResid E{xin_lat, xin_ctx, p.out, p.ctxs, modl, 0};
    mm::gemm_phase(GEMM_LDS(lds), 1024, S, E, cx.tid);
}

struct EpiPairStore {
    static constexpr bool PERM = true;
    bf16_t* O0; int ld0; bf16_t* O1; int ld1;
    DI void operator()(const mm::f32x4 (&acc)[2][2][4][2], const mm::Unit& u, int wr, int wc, int fr, int fq) const {
        bf16_t* O = u.e ? O1 : O0; const int ldc = u.e ? ld1 : ld0;
        const int row0 = u.pm * 256 + wr * 64 + fr, col0 = u.pn * 256 + wc * 32 + 8 * fq;
#pragma unroll
        for (int ai = 0; ai < 2; ++ai)
#pragma unroll
            for (int m = 0; m < 4; ++m) { bf16_t* rowp = O + (size_t)(row0 + ai * 128 + m * 16) * ldc + col0;
#pragma unroll
                for (int bj = 0; bj < 2; ++bj) { const mm::f32x4 v0 = acc[ai][bj][m][0], v1 = acc[ai][bj][m][1];
                    mm::u32x4 w; w.x = mm::cvt_pk_bf16(v0[0], v0[1]); w.y = mm::cvt_pk_bf16(v0[2], v0[3]); w.z = mm::cvt_pk_bf16(v1[0], v1[1]); w.w = mm::cvt_pk_bf16(v1[2], v1[3]);
                    *(mm::u32x4*)(rowp + bj * 128) = w; } }
    }
};
DI void ph_qkvup_mm(const Ctx& cx, const Params& p, float* lds, int j, int mq) {
    mm::PairSched S; S.G = cx.nblk; S.c = cx.bid;
    S.s0.init(p.QN, p.WqT + (size_t)j * 768 * 256, mq, 768, 256, 512, cx.nblk, cx.bid);
    S.s1.init(p.QN + 256, p.WkvT + (size_t)j * 1024 * 256, NT, 1024, 256, 512, cx.nblk, cx.bid);
    EpiPairStore E{p.Qraw, 768, p.KVraw, 1024};
    mm::gemm_phase(GEMM_LDS(lds), 256, S, E, cx.tid);
}
struct EpiWag {
    static constexpr bool PERM = true;
    bf16_t* O; const LAS float* bias;
    DI void operator()(const mm::f32x4 (&acc)[2][2][4][2], const mm::Unit& u, int wr, int wc, int fr, int fq) const {
        const int row0 = u.pm * 256 + wr * 64 + fr, col0 = u.pn * 256 + wc * 32 + 8 * fq; const int seg = u.pn >> 2;
        const LAS float* bp = bias + col0;
#pragma unroll
        for (int bj = 0; bj < 2; ++bj) {
            mm::f32x4 b0 = (mm::f32x4){0.f, 0.f, 0.f, 0.f}, b1 = b0;
            if (seg < 2) { b0 = *(const LAS mm::f32x4*)(bp + bj * 128); b1 = *(const LAS mm::f32x4*)(bp + bj * 128 + 4); }
#pragma unroll
            for (int ai = 0; ai < 2; ++ai)
#pragma unroll
                for (int m = 0; m < 4; ++m) {
                    mm::f32x4 v0 = acc[ai][bj][m][0] + b0, v1 = acc[ai][bj][m][1] + b1;
                    if (seg == 0) {
#pragma unroll
                        for (int c = 0; c < 4; ++c) { v0[c] = 1.f - __expf(-0.606531f * __builtin_amdgcn_rcpf(1.f + __expf(-v0[c]))); v1[c] = 1.f - __expf(-0.606531f * __builtin_amdgcn_rcpf(1.f + __expf(-v1[c]))); }
                    } else if (seg == 1) {
#pragma unroll
                        for (int c = 0; c < 4; ++c) { v0[c] = __builtin_amdgcn_rcpf(1.f + __expf(-v0[c])); v1[c] = __builtin_amdgcn_rcpf(1.f + __expf(-v1[c])); }
                    }
                    mm::u32x4 w; w.x = mm::cvt_pk_bf16(v0[0], v0[1]); w.y = mm::cvt_pk_bf16(v0[2], v0[3]); w.z = mm::cvt_pk_bf16(v1[0], v1[1]); w.w = mm::cvt_pk_bf16(v1[2], v1[3]);
                    *(mm::u32x4*)(O + (size_t)(row0 + ai * 128 + m * 16) * WLD + col0 + bj * 128) = w;
                }
        }
    }
};
DI void ph_wag_mm(const Ctx& cx, const Params& p, float* lds, int j) {
    mm::StaticSched S; S.init(p.LR, p.WlrT + (size_t)j * 2560 * 384, NT, 2560, 384, 384, cx.nblk, cx.bid);
    LAS float* bl = (LAS float*)lds + 32768 + 256 + 1024;
    for (int i = cx.tid; i < 2048; i += NTHR) bl[i] = (i < 1024) ? p.a_w0[j * 1024 + i] : p.a_a0[j * 1024 + i - 1024];
    __syncthreads();
    EpiWag E{p.WAG, bl};
    mm::gemm_phase(GEMM_LDS(lds), 384, S, E, cx.tid);
}
struct EpiZT {
    static constexpr bool PERM = true;
    bf16_t* Z; int T;
    DI void operator()(const mm::f32x4 (&acc)[2][2][4][2], const mm::Unit& u, int wr, int wc, int fr, int fq) const {
        const int b = (T == 2048) ? (u.pn >> 3) : u.pn, t0 = (T == 2048) ? ((u.pn & 7) * 256) : 0;
        const int m0 = u.pm * 256 + wr * 64 + fr; const int c0 = t0 + wc * 32 + 8 * fq;
#pragma unroll
        for (int ai = 0; ai < 2; ++ai)
#pragma unroll
            for (int m = 0; m < 4; ++m) { const int mr = m0 + ai * 128 + m * 16, part = mr >> 10, ch = mr & 1023;
                bf16_t* rowp = Z + ((size_t)(b * 1024 + ch) * 2 + part) * T + c0;
#pragma unroll
                for (int bj = 0; bj < 2; ++bj) { const mm::f32x4 v0 = acc[ai][bj][m][0], v1 = acc[ai][bj][m][1];
                    mm::u32x4 w; w.x = mm::cvt_pk_bf16(v0[0], v0[1]); w.y = mm::cvt_pk_bf16(v0[2], v0[3]); w.z = mm::cvt_pk_bf16(v1[0], v1[1]); w.w = mm::cvt_pk_bf16(v1[2], v1[3]);
                    *(mm::u32x4*)(rowp + bj * 128) = w; } }
    }
};
DI void ph_f1_mm(const Ctx& cx, const Params& p, float* lds, int j, bool with_ctx) {
    { mm::StaticSched S; S.init(p.A1 + (size_t)j * 2048 * 1024, p.H, 2048, NLAT, 1024, 1024, cx.nblk, cx.bid); EpiZT E{p.ZT, 2048}; mm::gemm_phase(GEMM_LDS(lds), 1024, S, E, cx.tid); }
    if (with_ctx) { mm::StaticSched S; S.init(p.A1 + (size_t)j * 2048 * 1024, p.H + (size_t)NLAT * 1024, 2048, NCTX, 1024, 1024, cx.nblk, cx.bid); EpiZT E{p.ZTC, 256}; mm::gemm_phase(GEMM_LDS(lds), 1024, S, E, cx.tid); }
}
DI void ph_f2_mmB(const Ctx& cx, const Params& p, float* lds, bool with_ctx, const void* xin_lat, const void* xin_ctx, bf16_t* xo_lat, const float* modl) {
    { mm::BatchSched S; S.init(p.A2, p.ZT, (size_t)1024 * 4096 * 2, 16, 2048, 1024, 4096, cx.nblk, cx.bid); mm::EpiResidB E{xin_lat, xin_ctx, xo_lat, p.cs, modl, 1, 0}; mm::gemm_phase(GEMM_LDS(lds), 4096, S, E, cx.tid); }
    if (with_ctx) { mm::BatchSched S; S.init(p.A2c, p.ZTC, (size_t)1024 * 512 * 2, 16, 256, 1024, 512, cx.nblk, cx.bid); mm::EpiResidB E{xin_lat, xin_ctx, xo_lat, p.cs, modl, -1, 0}; mm::gemm_phase(GEMM_LDS(lds), 512, S, E, cx.tid); }
}
DI void ph_f2_mm(const Ctx& cx, const Params& p, float* lds, bool with_ctx, const float* xin_lat, const float* xin_ctx, const float* modl) {
    { mm::BatchSched S; S.init(p.A2, p.ZT, (size_t)1024 * 4096 * 2, 16, 2048, 1024, 4096, cx.nblk, cx.bid); mm::EpiResid E{xin_lat, xin_ctx, p.out, p.ctxs, modl, 1}; mm::gemm_phase(GEMM_LDS(lds), 4096, S, E, cx.tid); }
    if (with_ctx) { mm::BatchSched S; S.init(p.A2c, p.ZTC, (size_t)1024 * 512 * 2, 16, 256, 1024, 512, cx.nblk, cx.bid); mm::EpiResid E{xin_lat, xin_ctx, p.out, p.ctxs, modl, -1}; mm::gemm_phase(GEMM_LDS(lds), 512, S, E, cx.tid); }
}
struct MoeSched {
    static constexpr bool GATHER = true, TABLE = true;
    const char* A; const char* Bt; const int* slot; const float* slotw; const int* tab; int lda, K, G, c, down;
    DI void tab_dma(const mm::Unit& u, LAS unsigned char* dst, int tid) const {
        const int Me = __builtin_amdgcn_readfirstlane(tab[32 + u.e]); const int r = tid & 255; int idx = u.m * 256 + r; idx = idx < Me ? idx : 0;
        const size_t off = (u.e < 16) ? (size_t)u.e * NT + idx : 0;
        const unsigned* src = (tid < 256) ? (const unsigned*)(slot + off) : (const unsigned*)(slotw + off);
        __builtin_amdgcn_global_load_lds(src, (LAS unsigned*)(dst + (tid >> 6) * 256), 4, 0, 0);
    }
    DI size_t hstep_a() const { return 0; }
    DI unsigned boff(int Rb, int C, int Kk) const { return (unsigned)(Rb * Kk + C) * 2u; }
    DI size_t hstep_b(int Kk) const { return (size_t)mm::HALF * Kk * 2; }
    DI bool next(int i, mm::Unit& u) const {
        const int L = i * G + c; const int total = __builtin_amdgcn_readfirstlane(tab[17]);
        if (L >= total * 4) return false;
        const int rtg = L >> 2; int e = 0;
        for (int q = 1; q < 17; ++q) e += (__builtin_amdgcn_readfirstlane(tab[q]) <= rtg) ? 1 : 0;
        u.e = e; u.m = rtg - __builtin_amdgcn_readfirstlane(tab[e]); u.pm = u.m; u.pn = L & 3;
        u.A = A; u.B = Bt + ((size_t)e * 1024 + (size_t)u.pn * 256) * K * 2; return true;
    }
    DI unsigned rowoff(const mm::Unit& u, int Me, int idx, int C) const {
        int row;
        if (u.e < 16) { const int s = (idx < Me) ? slot[(size_t)u.e * NT + idx] : 0; row = down ? ((s & 1) * NT + (s >> 1)) : (s >> 1); }
        else row = down ? (2 * NT + idx) : idx;
        return (unsigned)(row * lda + C) * 2u;
    }
    DI unsigned rowoff_s(const mm::Unit& u, int s, int r, int C) const { int row; if (u.e < 16) row = down ? ((s & 1) * NT + (s >> 1)) : (s >> 1); else row = down ? (2 * NT + u.m * 256 + r) : (u.m * 256 + r); return (unsigned)(row * lda + C) * 2u; }
    DI void aoff_lds(const mm::Unit& u, const LAS int* et, int R0, int C0, int R1, int C1, unsigned (&o)[2][2]) const {
        o[0][0] = rowoff_s(u, et[R0], R0, C0); o[0][1] = rowoff_s(u, et[R1], R1, C1); o[1][0] = rowoff_s(u, et[128 + R0], 128 + R0, C0); o[1][1] = rowoff_s(u, et[128 + R1], 128 + R1, C1);
    }
    DI void aoff(const mm::Unit& u, int R0, int C0, int R1, int C1, unsigned (&o)[2][2]) const {
        const int Me = __builtin_amdgcn_readfirstlane(tab[32 + u.e]), base = u.m * 256;
        o[0][0] = rowoff(u, Me, base + R0, C0); o[0][1] = rowoff(u, Me, base + R1, C1);
        o[1][0] = rowoff(u, Me, base + 128 + R0, C0); o[1][1] = rowoff(u, Me, base + 128 + R1, C1);
    }
};
DI void moe_table(const Ctx& cx, const Params& p, int* tab, int layer, int nrows) {
    if (cx.tid == 0) { int acc = 0;
        for (int e = 0; e < 17; ++e) { const int M = (e < 16) ? p.cnt[(layer * 16 + e) * 64] : nrows; tab[e] = acc; tab[32 + e] = M; acc += (M + 255) >> 8; }
        tab[17] = acc; }
    __syncthreads();
}
DI void lds_read8(const LAS int* base, int r0, int (&o)[8]) {
    const unsigned a = (unsigned)(size_t)(base + r0);
    asm volatile("ds_read_b32 %0, %8\n\tds_read_b32 %1, %8 offset:64\n\tds_read_b32 %2, %8 offset:128\n\tds_read_b32 %3, %8 offset:192\n\t"
                 "ds_read_b32 %4, %8 offset:512\n\tds_read_b32 %5, %8 offset:576\n\tds_read_b32 %6, %8 offset:640\n\tds_read_b32 %7, %8 offset:704\n\ts_waitcnt lgkmcnt(0)"
                 : "=&v"(o[0]), "=&v"(o[1]), "=&v"(o[2]), "=&v"(o[3]), "=&v"(o[4]), "=&v"(o[5]), "=&v"(o[6]), "=&v"(o[7]) : "v"(a) : "memory");
}
struct EpiSwiglu {
    static constexpr bool PERM = true;
    bf16_t* ACT; const int* slot; const int* tab; const LAS int* etab;
    DI void operator()(const mm::f32x4 (&acc)[2][2][4][2], const mm::Unit& u, int wr, int wc, int fr, int fq) const {
        const int Me = __builtin_amdgcn_readfirstlane(tab[32 + u.e]); const int col = u.pn * 128 + wc * 32 + 8 * fq; const LAS int* et = etab + u.tb * 512;
        int sl8[8]; lds_read8(et, wr * 64 + fr, sl8);
#pragma unroll
        for (int ai = 0; ai < 2; ++ai)
#pragma unroll
            for (int m = 0; m < 4; ++m) {
                const int idx = u.m * 256 + ai * 128 + wr * 64 + m * 16 + fr;
                if (idx < Me) {
                    int drow; if (u.e < 16) { const int s = sl8[ai * 4 + m]; drow = (s & 1) * NT + (s >> 1); } else drow = 2 * NT + idx;
                    float o[8];
#pragma unroll
                    for (int n = 0; n < 2; ++n)
#pragma unroll
                        for (int c = 0; c < 4; ++c) { const float g = acc[ai][0][m][n][c], uu = acc[ai][1][m][n][c]; o[n * 4 + c] = g * __builtin_amdgcn_rcpf(1.f + __expf(-g)) * uu; }
                    mm::u32x4 w; w.x = mm::cvt_pk_bf16(o[0], o[1]); w.y = mm::cvt_pk_bf16(o[2], o[3]); w.z = mm::cvt_pk_bf16(o[4], o[5]); w.w = mm::cvt_pk_bf16(o[6], o[7]);
                    *(mm::u32x4*)(ACT + (size_t)drow * 512 + col) = w;
                }
            }
    }
};
struct EpiDown {
    static constexpr bool PERM = true;
    bf16_t* Y; const int* slot; const float* tokw; const int* tab; const LAS int* etab;
    DI void operator()(const mm::f32x4 (&acc)[2][2][4][2], const mm::Unit& u, int wr, int wc, int fr, int fq) const {
        const int Me = __builtin_amdgcn_readfirstlane(tab[32 + u.e]); const int col = u.pn * 256 + wc * 32 + 8 * fq; const LAS int* et = etab + u.tb * 512;
        int sl8[8], sw8[8]; lds_read8(et, wr * 64 + fr, sl8); lds_read8(et + 256, wr * 64 + fr, sw8);
#pragma unroll
        for (int ai = 0; ai < 2; ++ai)
#pragma unroll
            for (int m = 0; m < 4; ++m) {
                const int idx = u.m * 256 + ai * 128 + wr * 64 + m * 16 + fr;
                if (idx < Me) {
                    int drow; float w = 1.f;
                    if (u.e < 16) { const int s = sl8[ai * 4 + m]; drow = (s & 1) * NT + (s >> 1); w = __int_as_float(sw8[ai * 4 + m]); } else drow = 2 * NT + idx;
#pragma unroll
                    for (int bj = 0; bj < 2; ++bj) { const mm::f32x4 v0 = acc[ai][bj][m][0] * w, v1 = acc[ai][bj][m][1] * w;
                        mm::u32x4 o; o.x = mm::cvt_pk_bf16(v0[0], v0[1]); o.y = mm::cvt_pk_bf16(v0[2], v0[3]); o.z = mm::cvt_pk_bf16(v1[0], v1[1]); o.w = mm::cvt_pk_bf16(v1[2], v1[3]);
                        *(mm::u32x4*)(Y + (size_t)drow * 1024 + col + bj * 128) = o; }
                }
            }
    }
};
DI void ph_moe_up_mm(const Ctx& cx, const Params& p, float* lds, int layer, int nrows) {
    int* tab = (int*)(lds + 32768); moe_table(cx, p, tab, layer, nrows);
    MoeSched S{(const char*)p.H, (const char*)(p.WguT + (size_t)(layer & 1) * 17 * 1024 * 1024), p.slot, p.slotw, tab, 1024, 1024, cx.nblk, cx.bid, 0};
    EpiSwiglu E{p.ACT, p.slot, tab, (const LAS int*)((LAS float*)lds + 32768 + 256)};
    const int nun = __builtin_amdgcn_readfirstlane(tab[17]) * 4;
    mm::gemm_phase(GEMM_LDS(lds), 1024, S, E, cx.tid);
    if (layer < 3 && tail_idle(cx, nun)) prep_moe_steal(cx, p, lds, layer + 1, 2);
}
DI void ph_moe_down_mm(const Ctx& cx, const Params& p, float* lds, int layer, int nrows) {
    int* tab = (int*)(lds + 32768); moe_table(cx, p, tab, layer, nrows);
    MoeSched S{(const char*)p.ACT, (const char*)(p.WdT + (size_t)(layer & 1) * 17 * 1024 * 512), p.slot, p.slotw, tab, 512, 512, cx.nblk, cx.bid, 1};
    EpiDown E{p.Y, p.slot, p.tokw, tab, (const LAS int*)((LAS float*)lds + 32768 + 256)};
    const int nun = __builtin_amdgcn_readfirstlane(tab[17]) * 4;
    mm::gemm_phase(GEMM_LDS(lds), 512, S, E, cx.tid);
    if (layer < 3 && tail_idle(cx, nun)) prep_moe_steal(cx, p, lds, layer + 1, 1);
}

namespace att {
typedef short bf16x8 __attribute__((ext_vector_type(8)));
typedef float f32x16 __attribute__((ext_vector_type(16)));
typedef unsigned u32x4 __attribute__((ext_vector_type(4)));
typedef unsigned u32x2 __attribute__((ext_vector_type(2)));
typedef __bf16 bf16x2_t __attribute__((ext_vector_type(2)));
typedef float f32x2_t __attribute__((ext_vector_type(2)));
constexpr int KP = 208, VP = 264, KT_BYTES = 128 * KP, VT_BYTES = 64 * VP, BUF = KT_BYTES + VT_BYTES;
DI unsigned pk(float a, float b) { f32x2_t f = {a, b}; bf16x2_t h = __builtin_convertvector(f, bf16x2_t); return __builtin_bit_cast(unsigned, h); }
DI float xhalf_max(float x) { const auto r = __builtin_amdgcn_permlane32_swap(__builtin_bit_cast(unsigned, x), __builtin_bit_cast(unsigned, x), false, false); return fmaxf(__builtin_bit_cast(float, r[0]), __builtin_bit_cast(float, r[1])); }
DI float xhalf_sum(float x) { const auto r = __builtin_amdgcn_permlane32_swap(__builtin_bit_cast(unsigned, x), __builtin_bit_cast(unsigned, x), false, false); return __builtin_bit_cast(float, r[0]) + __builtin_bit_cast(float, r[1]); }
#define ATT_MFMA(a, b, c) __builtin_amdgcn_mfma_f32_32x32x16_bf16((a), (b), (c), 0, 0, 0)
struct TileSt { f32x16 s[2]; u32x4 pk[2][2]; bf16x8 kf[6]; };
template<int J> DI void tile_iter(TileSt& T, const bf16x8 (&qf)[6], f32x16& ot0, f32x16& ot1, float& a, float& b, const LAS unsigned char* kbp, const LAS unsigned char* vbp) {
    constexpr bool HA = J < 3, HB = (J >= 0 && J <= 3), HC = J > 0, PF = J < 2;
    constexpr int C = J & 1, N = (J + 1) & 1, KPV = (J > 0) ? J - 1 : 0;
    u32x2 vf[4][2];
#pragma unroll
    for (int g = 0; g < 6; ++g) {
        if constexpr (HA) {
            if (g == 0) { f32x16 z;
#pragma unroll
                for (int i = 0; i < 16; ++i) z[i] = 0.f;
                T.s[N] = ATT_MFMA(T.kf[0], qf[0], z); }
            else T.s[N] = ATT_MFMA(T.kf[g], qf[g], T.s[N]);
        }
        if constexpr (HB) {
            const int i0 = g < 4 ? 3 * g : 12 + 2 * (g - 4), n = g < 4 ? 3 : 2;
#pragma unroll
            for (int i = i0; i < i0 + n; ++i) { const float e = __builtin_amdgcn_exp2f(T.s[C][i]); T.s[C][i] = e; if (i & 1) b += e; else a += e; }
        }
        if constexpr (HA && PF) T.kf[g] = *(const LAS bf16x8*)(kbp + (J + 2) * 32 * KP + 32 * g);
        if constexpr (HC) { if (g >= 2) { const int q = g - 2, sv = q >> 1, hf = q & 1;
            vf[q][0] = *(const LAS u32x2*)(vbp + hf * 32 * VP + KPV * 64 + 32 * sv); vf[q][1] = *(const LAS u32x2*)(vbp + hf * 32 * VP + KPV * 64 + 32 * sv + 16); } }
        __builtin_amdgcn_sched_barrier(0);
    }
#pragma unroll
    for (int g = 0; g < 4; ++g) {
        if constexpr (HC) { const u32x4 vv = {vf[g][0].x, vf[g][0].y, vf[g][1].x, vf[g][1].y}; const bf16x8 pb = __builtin_bit_cast(bf16x8, T.pk[C ^ 1][g >> 1]);
            if (g & 1) ot1 = ATT_MFMA(__builtin_bit_cast(bf16x8, vv), pb, ot1); else ot0 = ATT_MFMA(__builtin_bit_cast(bf16x8, vv), pb, ot0); }
        if constexpr (HB) { const int base = 8 * (g >> 1) + 4 * (g & 1); const unsigned w0 = pk(T.s[C][base], T.s[C][base + 1]), w1 = pk(T.s[C][base + 2], T.s[C][base + 3]);
            if (g & 1) { T.pk[C][g >> 1].z = w0; T.pk[C][g >> 1].w = w1; } else { T.pk[C][g >> 1].x = w0; T.pk[C][g >> 1].y = w1; } }
        __builtin_amdgcn_sched_barrier(0);
    }
}
}
DI void ph_attn_mm(const Ctx& cx, const Params& p, float* ldsf, bool with_ctx) {
    using namespace att;
    LAS unsigned char* lds = (LAS unsigned char*)ldsf;
    const int tid = cx.tid, wid = __builtin_amdgcn_readfirstlane(tid >> 6), lane = tid & 63, r = lane & 31, hh = lane >> 5;
    const int nunits = 1024 + (with_ctx ? 128 : 0);
    for (int u0 = cx.bid; u0 < nunits; u0 += cx.nblk) {
        int u = u0;
        if (u0 < 1024 && cx.nblk == 256) { const int k = u0 >> 8, x = u0 & 7, l = (u0 & 255) >> 3; u = (((k * 8 + x) * 4 + (l >> 3)) << 3) + (l & 7); }
        int tz = tid; asm volatile("" : "+v"(tz));
        int kg[3], kl[3], vg[2], vl[2];
#pragma unroll
        for (int i = 0; i < 3; ++i) { const int c = tz + 512 * i, row = c / 12, part = c % 12; kg[i] = row * 96 + part * 8; kl[i] = row * KP + part * 16; }
#pragma unroll
        for (int i = 0; i < 2; ++i) { const int c = tz + 512 * i, row = c >> 4, part = c & 15; vg[i] = row * 2304 + part * 8; vl[i] = KT_BYTES + row * VP + part * 16; }
        int bh, qrow0, nkeys;
        if (u < 1024) { bh = u >> 3; qrow0 = (bh >> 3) * 2048 + (u & 7) * 256; nkeys = 2304; }
        else { bh = u - 1024; qrow0 = NLAT + (bh >> 3) * 256; nkeys = 256; }
        const int h = bh & 7;
        const bf16_t* Kb = p.Kf + (size_t)bh * 2304 * 96; const bf16_t* Vb = p.Vt + (size_t)bh * 64 * 2304;
        const bf16_t* qp = p.Qraw + (size_t)(qrow0 + (tz >> 6) * 32 + (tz & 31)) * 768 + h * 96 + 8 * ((tz >> 5) & 1);
        bf16x8 qf[6];
#pragma unroll
        for (int s = 0; s < 6; ++s) qf[s] = *(const bf16x8*)(qp + 16 * s);
        f32x16 ot0, ot1;
#pragma unroll
        for (int i = 0; i < 16; ++i) { ot0[i] = 0.f; ot1[i] = 0.f; }
        float lrun = 0.f, lrun1 = 0.f;
        const int ntiles = nkeys >> 7;
        u32x4 kr[3], vr[2];
#pragma unroll
        for (int i = 0; i < 3; ++i) kr[i] = *(const u32x4*)(Kb + kg[i]);
#pragma unroll
        for (int i = 0; i < 2; ++i) vr[i] = *(const u32x4*)(Vb + vg[i]);
#pragma unroll
        for (int i = 0; i < 3; ++i) *(LAS u32x4*)(lds + kl[i]) = kr[i];
#pragma unroll
        for (int i = 0; i < 2; ++i) { *(LAS u32x2*)(lds + vl[i]) = (u32x2){vr[i].x, vr[i].y}; *(LAS u32x2*)(lds + vl[i] + 8) = (u32x2){vr[i].z, vr[i].w}; }
        __syncthreads();
        for (int it = 0; it < ntiles; ++it) {
            const int bo = (it & 1) * BUF, bn = ((it + 1) & 1) * BUF;
            const bool more = (it + 1 < ntiles);
            if (more) {
                const bf16_t* Kn = Kb + (size_t)(it + 1) * 128 * 96; const bf16_t* Vn = Vb + (it + 1) * 128;
#pragma unroll
                for (int i = 0; i < 3; ++i) kr[i] = *(const u32x4*)(Kn + kg[i]);
#pragma unroll
                for (int i = 0; i < 2; ++i) vr[i] = *(const u32x4*)(Vn + vg[i]);
            }
            { const LAS unsigned char* kbp = lds + bo + r * KP + 16 * hh; const LAS unsigned char* vbp = lds + bo + KT_BYTES + r * VP + 8 * hh;
                TileSt T;
#pragma unroll
                for (int s = 0; s < 6; ++s) T.kf[s] = *(const LAS bf16x8*)(kbp + 32 * s);
                tile_iter<-1>(T, qf, ot0, ot1, lrun, lrun1, kbp, vbp); tile_iter<0>(T, qf, ot0, ot1, lrun, lrun1, kbp, vbp); tile_iter<1>(T, qf, ot0, ot1, lrun, lrun1, kbp, vbp);
                tile_iter<2>(T, qf, ot0, ot1, lrun, lrun1, kbp, vbp); tile_iter<3>(T, qf, ot0, ot1, lrun, lrun1, kbp, vbp); tile_iter<4>(T, qf, ot0, ot1, lrun, lrun1, kbp, vbp); }
            if (more) {
#pragma unroll
                for (int i = 0; i < 3; ++i) *(LAS u32x4*)(lds + bn + kl[i]) = kr[i];
#pragma unroll
                for (int i = 0; i < 2; ++i) { *(LAS u32x2*)(lds + bn + vl[i]) = (u32x2){vr[i].x, vr[i].y}; *(LAS u32x2*)(lds + bn + vl[i] + 8) = (u32x2){vr[i].z, vr[i].w}; }
            }
            __syncthreads();
        }
        const float il = 1.f / xhalf_sum(lrun + lrun1);
        int t2 = tid; asm volatile("" : "+v"(t2));
        bf16_t* op = p.H + (size_t)(qrow0 + (t2 >> 6) * 32 + (t2 & 31)) * 1024 + 512 + h * 64 + 4 * ((t2 >> 5) & 1);
#pragma unroll
        for (int g = 0; g < 4; ++g) {
            u32x2 w0 = {pk(ot0[4 * g] * il, ot0[4 * g + 1] * il), pk(ot0[4 * g + 2] * il, ot0[4 * g + 3] * il)};
            u32x2 w1 = {pk(ot1[4 * g] * il, ot1[4 * g + 1] * il), pk(ot1[4 * g + 2] * il, ot1[4 * g + 3] * il)};
            *(u32x2*)(op + 8 * g) = w0; *(u32x2*)(op + 32 + 8 * g) = w1;
        }
    }
}

DI void ph_attn_mm_stag(const Ctx& cx, const Params& p, float* ldsf, bool with_ctx) {
    using namespace att;
    LAS unsigned char* lds = (LAS unsigned char*)ldsf;
    const int tid = cx.tid, wid = __builtin_amdgcn_readfirstlane(tid >> 6), lane = tid & 63, r = lane & 31, hh = lane >> 5, G = wid >> 2;
    const int nunits = 1024 + (with_ctx ? 128 : 0);
    int kg[3], kl[3], vg[2], vl[2];
#pragma unroll
    for (int i = 0; i < 3; ++i) { const int c = tid + 512 * i, row = c / 12, part = c % 12; kg[i] = row * 96 + part * 8; kl[i] = row * KP + part * 16; }
#pragma unroll
    for (int i = 0; i < 2; ++i) { const int c = tid + 512 * i, row = c >> 4, part = c & 15; vg[i] = row * 2304 + part * 8; vl[i] = KT_BYTES + row * VP + part * 16; }
    for (int u = cx.bid; u < nunits; u += cx.nblk) {
        int bh, qrow0, nkeys;
        if (u < 1024) { bh = u >> 3; qrow0 = (bh >> 3) * 2048 + (u & 7) * 256; nkeys = 2304; }
        else { bh = u - 1024; qrow0 = NLAT + (bh >> 3) * 256; nkeys = 256; }
        const int h = bh & 7;
        const bf16_t* Kb = p.Kf + (size_t)bh * 2304 * 96; const bf16_t* Vb = p.Vt + (size_t)bh * 64 * 2304;
        const bf16_t* qp = p.Qraw + (size_t)(qrow0 + wid * 32 + r) * 768 + h * 96 + 8 * hh;
        bf16x8 qf[6];
#pragma unroll
        for (int s = 0; s < 6; ++s) qf[s] = *(const bf16x8*)(qp + 16 * s);
        f32x16 ot0, ot1;
#pragma unroll
        for (int i = 0; i < 16; ++i) { ot0[i] = 0.f; ot1[i] = 0.f; }
        float mrun = -3.0e38f, lrun = 0.f;
        const int ntiles = nkeys >> 7;
        u32x4 kr[3], vr[2];
#define ATT_LOAD(t) do { const bf16_t* Kn = Kb + (size_t)(t) * 128 * 96; const bf16_t* Vn = Vb + (t) * 128; \
            _Pragma("unroll") for (int i = 0; i < 3; ++i) kr[i] = *(const u32x4*)(Kn + kg[i]); _Pragma("unroll") for (int i = 0; i < 2; ++i) vr[i] = *(const u32x4*)(Vn + vg[i]); } while (0)
#define ATT_WRITE(bufo) do { _Pragma("unroll") for (int i = 0; i < 3; ++i) *(LAS u32x4*)(lds + (bufo) + kl[i]) = kr[i]; \
            _Pragma("unroll") for (int i = 0; i < 2; ++i) { *(LAS u32x2*)(lds + (bufo) + vl[i]) = (u32x2){vr[i].x, vr[i].y}; *(LAS u32x2*)(lds + (bufo) + vl[i] + 8) = (u32x2){vr[i].z, vr[i].w}; } } while (0)
        ATT_LOAD(0); ATT_WRITE(0);
        ATT_LOAD(1); ATT_WRITE(BUF);
        __syncthreads();
        f32x16 st[4];
        for (int ph = 0; ph <= 2 * ntiles; ++ph) {
            if (ph & 1) {
                const int tw = (ph + 1) >> 1;
                if (tw >= 2 && tw < ntiles) ATT_WRITE((tw & 1) * BUF);
                if (tw + 1 < ntiles) ATT_LOAD(tw + 1);
            }
            const int e = ph - G;
            if (e >= 0 && e < 2 * ntiles) {
                const int bo = ((e >> 1) & 1) * BUF;
                if ((e & 1) == 0) {
#pragma unroll
                    for (int kb = 0; kb < 4; ++kb) {
#pragma unroll
                        for (int i = 0; i < 16; ++i) st[kb][i] = 0.f;
#pragma unroll
                        for (int s = 0; s < 6; ++s) { const bf16x8 kf = *(const LAS bf16x8*)(lds + bo + (kb * 32 + r) * KP + 32 * s + 16 * hh); st[kb] = ATT_MFMA(kf, qf[s], st[kb]); }
                    }
                    float mq[4];
#pragma unroll
                    for (int kb = 0; kb < 4; ++kb) { float a = fmaxf(st[kb][0], st[kb][1]), b = fmaxf(st[kb][2], st[kb][3]), c2 = fmaxf(st[kb][4], st[kb][5]), d = fmaxf(st[kb][6], st[kb][7]);
                        a = fmaxf(a, fmaxf(st[kb][8], st[kb][9])); b = fmaxf(b, fmaxf(st[kb][10], st[kb][11])); c2 = fmaxf(c2, fmaxf(st[kb][12], st[kb][13])); d = fmaxf(d, fmaxf(st[kb][14], st[kb][15]));
                        mq[kb] = fmaxf(fmaxf(a, b), fmaxf(c2, d)); }
                    float mt = fmaxf(fmaxf(mq[0], mq[1]), fmaxf(mq[2], mq[3]));
                    mt = xhalf_max(mt);
                    const float mnew = fmaxf(mrun, mt), alpha = __builtin_amdgcn_exp2f(mrun - mnew);
                    mrun = mnew;
                    float pq[4];
#pragma unroll
                    for (int kb = 0; kb < 4; ++kb) { float a = 0.f, b = 0.f;
#pragma unroll
                        for (int i = 0; i < 16; i += 2) { st[kb][i] = __builtin_amdgcn_exp2f(st[kb][i] - mnew); st[kb][i + 1] = __builtin_amdgcn_exp2f(st[kb][i + 1] - mnew); a += st[kb][i]; b += st[kb][i + 1]; }
                        pq[kb] = a + b; }
                    lrun = lrun * alpha + ((pq[0] + pq[1]) + (pq[2] + pq[3]));
#pragma unroll
                    for (int i = 0; i < 16; ++i) { ot0[i] *= alpha; ot1[i] *= alpha; }
                } else {
#pragma unroll
                    for (int kb = 0; kb < 4; ++kb)
#pragma unroll
                        for (int s = 0; s < 2; ++s) {
                            u32x4 pw; pw.x = pk(st[kb][8 * s], st[kb][8 * s + 1]); pw.y = pk(st[kb][8 * s + 2], st[kb][8 * s + 3]); pw.z = pk(st[kb][8 * s + 4], st[kb][8 * s + 5]); pw.w = pk(st[kb][8 * s + 6], st[kb][8 * s + 7]);
                            const bf16x8 pb = __builtin_bit_cast(bf16x8, pw);
                            const int col = (kb * 32 + 16 * s + 4 * hh) * 2;
                            const u32x2 a0 = *(const LAS u32x2*)(lds + bo + KT_BYTES + r * VP + col), a1 = *(const LAS u32x2*)(lds + bo + KT_BYTES + r * VP + col + 16);
                            const u32x2 b0 = *(const LAS u32x2*)(lds + bo + KT_BYTES + (32 + r) * VP + col), b1 = *(const LAS u32x2*)(lds + bo + KT_BYTES + (32 + r) * VP + col + 16);
                            const u32x4 va = {a0.x, a0.y, a1.x, a1.y}, vb = {b0.x, b0.y, b1.x, b1.y};
                            ot0 = ATT_MFMA(__builtin_bit_cast(bf16x8, va), pb, ot0);
                            ot1 = ATT_MFMA(__builtin_bit_cast(bf16x8, vb), pb, ot1);
                        }
                }
            }
            __syncthreads();
        }
#undef ATT_LOAD
#undef ATT_WRITE
        const float il = 1.f / xhalf_sum(lrun);
        bf16_t* op = p.H + (size_t)(qrow0 + wid * 32 + r) * 1024 + 512 + h * 64 + 4 * hh;
#pragma unroll
        for (int g = 0; g < 4; ++g) {
            u32x2 w0 = {pk(ot0[4 * g] * il, ot0[4 * g + 1] * il), pk(ot0[4 * g + 2] * il, ot0[4 * g + 3] * il)};
            u32x2 w1 = {pk(ot1[4 * g] * il, ot1[4 * g + 1] * il), pk(ot1[4 * g + 2] * il, ot1[4 * g + 3] * il)};
            *(u32x2*)(op + 8 * g) = w0; *(u32x2*)(op + 32 + 8 * g) = w1;
        }
    }
}

namespace scan {
typedef float f32x2 __attribute__((ext_vector_type(2)));
constexpr int REC = 400, CH = 32, BUFF = CH * REC, YOFF = 2 * BUFF;
DI float dppf(float v, int ctrl_sel) {
    const int x = __builtin_bit_cast(int, v);
    int r;
    if (ctrl_sel == 0) r = __builtin_amdgcn_update_dpp(0, x, 0xB1, 0xf, 0xf, true);
    else if (ctrl_sel == 1) r = __builtin_amdgcn_update_dpp(0, x, 0x4E, 0xf, 0xf, true);
    else r = __builtin_amdgcn_update_dpp(0, x, 0x141, 0xf, 0xf, true);
    return __builtin_bit_cast(float, r);
}
DI float red8(float v) { v += dppf(v, 0); v += dppf(v, 1); v += dppf(v, 2); return v; }
}
template <int ABL>
DI void ph_scan_opt(const Ctx& cx, const Params& p, float* lds, int j) {
    using namespace scan;
    const int tid = cx.tid, wid = __builtin_amdgcn_readfirstlane(tid >> 6), lane = tid & 63;
    for (int item = cx.bid; item < 256; item += cx.nblk) {
        const int b = item >> 4, h = (item >> 1) & 7, dir = item & 1;
        bf16_t* yout = dir ? p.YB : p.YF;
        if (wid >= 4) {
            const int pw = wid - 4, hc = h * 64 + lane;
            const float kkc = p.a_k_k[j * 512 + hc], kac = p.a_k_a[j * 512 + hc];
            const float mur = p.a_mu[j * ACOLS + hc], muk = p.a_mu[j * ACOLS + 512 + hc], muv = p.a_mu[j * ACOLS + 1024 + hc];
            LAS float* L = (LAS float*)lds;
            bf16_t raw[8][11];
#define SCAN_ROW(stepv, row_, t_, T_) const bool cp_ = (stepv) < 256; const int tt_ = cp_ ? (stepv) : (stepv) - 256, T_ = cp_ ? 256 : 2048, t_ = dir ? (T_ - 1 - tt_) : tt_; const int row_ = cp_ ? NLAT + b * 256 + t_ : b * 2048 + t_
#define SCAN_LOAD(cc) do { _Pragma("unroll") for (int it = 0; it < 8; ++it) { const int step = (cc) * CH + pw + 4 * it; SCAN_ROW(step, row, t, T); \
                const int rp_ = (t > 0) ? row - 1 : row, rn_ = (t < T - 1) ? row + 1 : row; \
                const bf16_t* pc = p.P + (size_t)row * PLD + hc; const bf16_t* pp = p.P + (size_t)rp_ * PLD + hc; const bf16_t* pn = p.P + (size_t)rn_ * PLD + hc; \
                raw[it][0] = pc[0]; raw[it][1] = pp[0]; raw[it][2] = pn[0]; raw[it][3] = pc[512]; raw[it][4] = pp[512]; raw[it][5] = pn[512]; raw[it][6] = pc[1024]; raw[it][7] = pp[1024]; raw[it][8] = pn[1024]; \
                raw[it][9] = p.WAG[(size_t)row * WLD + dir * 512 + hc]; raw[it][10] = p.WAG[(size_t)row * WLD + 1024 + dir * 512 + hc]; } } while (0)
            if (ABL != 1) SCAN_LOAD(0);
            for (int c = 0; c <= 73; ++c) {
                if (c >= 2 && ABL == 0) {
                    const LAS float* yb = L + YOFF + ((c - 2) & 1) * (CH * 64);
#pragma unroll
                    for (int it = 0; it < 8; ++it) {
                        const int sl = pw + 4 * it, step = (c - 2) * CH + sl; SCAN_ROW(step, row, t, T);
                        yout[(size_t)row * 512 + hc] = f2bf(yb[sl * 64 + lane]);
                    }
                }
                if (c < 72 && ABL != 1) {
                    LAS float* buf = L + (c & 1) * BUFF;
#pragma unroll
                    for (int it = 0; it < 8; ++it) {
                        const int sl = pw + 4 * it, step = c * CH + sl; SCAN_ROW(step, row, t, T); (void)row;
                        const float mp = (t > 0) ? 0.5f : 0.f, mn = (t < T - 1) ? 0.5f : 0.f;
                        const float rc = bf2f(raw[it][0]), kc_ = bf2f(raw[it][3]), vc = bf2f(raw[it][6]);
                        const float R = rc + mur * (mp * bf2f(raw[it][1]) + mn * bf2f(raw[it][2]) - rc);
                        const float K = kc_ + muk * (mp * bf2f(raw[it][4]) + mn * bf2f(raw[it][5]) - kc_);
                        const float V = vc + muv * (mp * bf2f(raw[it][7]) + mn * bf2f(raw[it][8]) - vc);
                        const float w = 1.f - bf2f(raw[it][9]), a = bf2f(raw[it][10]);
                        const float kkv = K * kkc, ssq = wave_sum(kkv * kkv), kk = kkv * rsqrtf(ssq + 1e-12f);
                        const float kd = K * (1.f + (a - 1.f) * kac), bd = kk * a;
                        const float br = wave_sum(bd * R), kr = wave_sum(kd * R);
                        LAS float* rec = buf + sl * REC;
                        rec[lane] = w; rec[64 + lane] = -kk; rec[128 + lane] = bd; rec[192 + lane] = kd; rec[256 + lane] = w * R; rec[320 + lane] = V;
                        if (lane == 0) { rec[384] = br; rec[385] = kr; }
                    }
                    if (c + 1 < 72) SCAN_LOAD(c + 1);
                }
                __syncthreads();
            }
#undef SCAN_LOAD
#undef SCAN_ROW
        } else {
            const int ct = tid, rp = ct >> 3, k8 = ct & 7;
            float S0[8], S1[8];
#pragma unroll
            for (int q = 0; q < 8; ++q) { S0[q] = 0.f; S1[q] = 0.f; }
            __syncthreads();
            for (int c = 0; c < 72; ++c) {
                const LAS float* buf = (const LAS float*)lds + (c & 1) * BUFF; LAS float* yb = (LAS float*)lds + YOFF + (c & 1) * (CH * 64);
                mm::f32x4 cw0, cw1, cn0, cn1, cb0, cb1, cd0, cd1, cr0, cr1; scan::f32x2 cvv, csc;
#define SCAN_LD(recp, W0, W1, N0, N1, B0, B1, D0, D1, R0_, R1_, VV, SC) do { const LAS float* r_ = (recp); \
                    W0 = *(const LAS mm::f32x4*)(r_ + k8 * 8); W1 = *(const LAS mm::f32x4*)(r_ + k8 * 8 + 4); N0 = *(const LAS mm::f32x4*)(r_ + 64 + k8 * 8); N1 = *(const LAS mm::f32x4*)(r_ + 64 + k8 * 8 + 4); \
                    B0 = *(const LAS mm::f32x4*)(r_ + 128 + k8 * 8); B1 = *(const LAS mm::f32x4*)(r_ + 128 + k8 * 8 + 4); D0 = *(const LAS mm::f32x4*)(r_ + 192 + k8 * 8); D1 = *(const LAS mm::f32x4*)(r_ + 192 + k8 * 8 + 4); \
                    R0_ = *(const LAS mm::f32x4*)(r_ + 256 + k8 * 8); R1_ = *(const LAS mm::f32x4*)(r_ + 256 + k8 * 8 + 4); VV = *(const LAS scan::f32x2*)(r_ + 320 + 2 * rp); SC = *(const LAS scan::f32x2*)(r_ + 384); } while (0)
                SCAN_LD(buf, cw0, cw1, cn0, cn1, cb0, cb1, cd0, cd1, cr0, cr1, cvv, csc);
#pragma unroll 2
                for (int sl = 0; sl < (ABL == 2 ? 0 : CH); ++sl) {
                    mm::f32x4 nw0, nw1, nn0, nn1, nb0, nb1, nd0, nd1, nr0, nr1; scan::f32x2 nvv, nsc;
                    SCAN_LD(buf + (sl + 1 < CH ? sl + 1 : sl) * REC, nw0, nw1, nn0, nn1, nb0, nb1, nd0, nd1, nr0, nr1, nvv, nsc);
                    const float wv[8] = {cw0[0], cw0[1], cw0[2], cw0[3], cw1[0], cw1[1], cw1[2], cw1[3]}, nv[8] = {cn0[0], cn0[1], cn0[2], cn0[3], cn1[0], cn1[1], cn1[2], cn1[3]};
                    const float bv[8] = {cb0[0], cb0[1], cb0[2], cb0[3], cb1[0], cb1[1], cb1[2], cb1[3]}, dv[8] = {cd0[0], cd0[1], cd0[2], cd0[3], cd1[0], cd1[1], cd1[2], cd1[3]};
                    const float rv[8] = {cr0[0], cr0[1], cr0[2], cr0[3], cr1[0], cr1[1], cr1[2], cr1[3]};
                    float sa0 = 0.f, sa1 = 0.f, y0 = 0.f, y1 = 0.f;
#pragma unroll
                    for (int q = 0; q < 8; ++q) { sa0 += S0[q] * nv[q]; sa1 += S1[q] * nv[q]; y0 += S0[q] * rv[q]; y1 += S1[q] * rv[q]; }
                    sa0 = red8(sa0); sa1 = red8(sa1); y0 = red8(y0); y1 = red8(y1);
                    y0 += sa0 * csc[0] + cvv[0] * csc[1]; y1 += sa1 * csc[0] + cvv[1] * csc[1];
#pragma unroll
                    for (int q = 0; q < 8; ++q) { S0[q] = S0[q] * wv[q] + sa0 * bv[q] + cvv[0] * dv[q]; S1[q] = S1[q] * wv[q] + sa1 * bv[q] + cvv[1] * dv[q]; }
                    if (k8 == 0) *(LAS scan::f32x2*)(yb + sl * 64 + 2 * rp) = (scan::f32x2){y0, y1};
                    cw0 = nw0; cw1 = nw1; cn0 = nn0; cn1 = nn1; cb0 = nb0; cb1 = nb1; cd0 = nd0; cd1 = nd1; cr0 = nr0; cr1 = nr1; cvv = nvv; csc = nsc;
                }
#undef SCAN_LD
                __syncthreads();
            }
            __syncthreads();
        }
    }
}

namespace sc2 {
typedef short bf16x8 __attribute__((ext_vector_type(8)));
typedef float f32x4 __attribute__((ext_vector_type(4)));
typedef unsigned u32x4 __attribute__((ext_vector_type(4)));
typedef unsigned u32x2 __attribute__((ext_vector_type(2)));
constexpr int NP = 6;
constexpr int O_AH = 0, O_RH = 2048, O_BK = 4096, O_VM = 8192, O_GC = 10240, O_AAB = 10496, O_AAK = 11520, O_ARK = 12032, O_BH = 13056, O_KH = 15104, SLOT = 17152;
constexpr int O_S0 = NP * SLOT, O_RHS = O_S0 + 8192, O_ZU = O_RHS + 4096, O_FLAG = O_ZU + 2048, TOTAL = O_FLAG + 256;
#define SC_MFMA(a, b, c) __builtin_amdgcn_mfma_f32_16x16x32_bf16((a), (b), (c), 0, 0, 0)
DI unsigned pk2(float a, float b) { return att::pk(a, b); }
DI int ldv(volatile LAS int* p) { return *p; }
}
template <int ABL>
DI void ph_scan_chunk(const Ctx& cx, const Params& p, float* ldsg, int j) {
    using namespace sc2;
    static_assert(TOTAL <= 128 * 1024, "scan LDS map");
    LAS unsigned char* L = (LAS unsigned char*)ldsg;
    volatile LAS int* ready = (volatile LAS int*)(L + O_FLAG); volatile LAS int* done = ready + 8;
    const int tid = cx.tid, wid = __builtin_amdgcn_readfirstlane(tid >> 6), lane = tid & 63, lq = lane >> 4, lr = lane & 15;
    constexpr int NCH = 144;
    for (int item = cx.bid; item < 256; item += cx.nblk) {
        const int b = item >> 4, h = (item >> 1) & 7, dir = item & 1;
        bf16_t* yout = dir ? p.YB : p.YF;
        __syncthreads();
        if (tid < 32) ready[tid] = 0;
        __syncthreads();
#define SC_ROW(stepv, row_, t_, T_) const bool cp_ = (stepv) < 256; const int tt_ = cp_ ? (stepv) : (stepv) - 256, T_ = cp_ ? 256 : 2048, t_ = dir ? (T_ - 1 - tt_) : tt_; const int row_ = cp_ ? NLAT + b * 256 + t_ : b * 2048 + t_
        if (wid < 2) {
            __builtin_amdgcn_s_setprio(3);
            const int g = wid, vb0 = 2 * g;
            f32x4 S[4][2];
#pragma unroll
            for (int kb = 0; kb < 4; ++kb)
#pragma unroll
                for (int vb = 0; vb < 2; ++vb) S[kb][vb] = (f32x4){0.f, 0.f, 0.f, 0.f};
            for (int c = 0; c < NCH; ++c) {
                const int sl = c % NP; LAS unsigned char* SB = L + sl * SLOT;
                { unsigned spins = 0; while (ldv(ready + sl) != c + 1) { __builtin_amdgcn_s_sleep(1); if (++spins > (1u << 22)) break; } }
                asm volatile("" ::: "memory");
                if (ABL == 2) { if (lane == 0) done[g * 8 + sl] = c + 1; continue; }
                f32x4 cA[4][4];
#pragma unroll
                for (int j = 0; j <= 3; ++j)
#pragma unroll
                    for (int q = (j + 1) / 4; q < 4; ++q) cA[j][q - (j + 1) / 4] = *(const LAS f32x4*)(SB + O_AAB + j * 64 + q * 16);
#pragma unroll
                for (int kb = 0; kb < 4; ++kb)
#pragma unroll
                    for (int vq = 0; vq < 2; ++vq) { const f32x4 x = S[kb][vq]; *(LAS u32x2*)(L + O_S0 + (16 * (vb0 + vq) + lr) * 128 + (16 * kb + 4 * lq) * 2) = (u32x2){pk2(x[0], x[1]), pk2(x[2], x[3])}; }
                {
                    bf16x8 ah[2], ak, sf[2][2], vmf[2];
#pragma unroll
                    for (int ks = 0; ks < 2; ++ks) ah[ks] = *(const LAS bf16x8*)(SB + O_AH + lr * 128 + ks * 64 + lq * 16);
                    { u32x4 z = {0u, 0u, 0u, 0u}; if (lq < 2) z = *(const LAS u32x4*)(SB + O_AAK + lr * 32 + lq * 16); ak = __builtin_bit_cast(bf16x8, z); }
#pragma unroll
                    for (int vq = 0; vq < 2; ++vq) { const int vb = vb0 + vq;
#pragma unroll
                        for (int ks = 0; ks < 2; ++ks) sf[vq][ks] = *(const LAS bf16x8*)(L + O_S0 + (16 * vb + lr) * 128 + ks * 64 + lq * 16);
                        u32x4 z = {0u, 0u, 0u, 0u}; if (lq < 2) z = *(const LAS u32x4*)(SB + O_VM + (16 * vb + lr) * 32 + lq * 16); vmf[vq] = __builtin_bit_cast(bf16x8, z);
                    }
                    f32x4 acc[2];
#pragma unroll
                    for (int vq = 0; vq < 2; ++vq) { acc[vq] = (f32x4){0.f, 0.f, 0.f, 0.f}; acc[vq] = SC_MFMA(sf[vq][0], ah[0], acc[vq]); acc[vq] = SC_MFMA(sf[vq][1], ah[1], acc[vq]); acc[vq] = SC_MFMA(vmf[vq], ak, acc[vq]); }
#pragma unroll
                    for (int vq = 0; vq < 2; ++vq)
#pragma unroll
                        for (int q = 0; q < 4; ++q) *(LAS float*)(L + O_RHS + ((16 * (vb0 + vq) + 4 * lq + q) * 16 + lr) * 4) = acc[vq][q];
                }
                float u[16];
                const int vl = 32 * g + (lane & 31);
                { const LAS f32x4* rp = (const LAS f32x4*)(L + O_RHS + vl * 64);
#pragma unroll
                  for (int q = 0; q < 4; ++q) { const f32x4 x = rp[q]; u[4 * q] = x[0]; u[4 * q + 1] = x[1]; u[4 * q + 2] = x[2]; u[4 * q + 3] = x[3]; } }
#define SC_COL(j, CF) do { _Pragma("unroll") for (int q = ((j) + 1) / 4; q < 4; ++q) { const f32x4 cf = CF[q - ((j) + 1) / 4]; \
                        _Pragma("unroll") for (int e = 0; e < 4; ++e) { if (4 * q + e > (j)) u[4 * q + e] += cf[e] * u[j]; } } } while (0)
                f32x4 cB[4][3], cC[7][2];
#pragma unroll
                for (int j = 4; j <= 7; ++j)
#pragma unroll
                    for (int q = (j + 1) / 4; q < 4; ++q) cB[j - 4][q - (j + 1) / 4] = *(const LAS f32x4*)(SB + O_AAB + j * 64 + q * 16);
                asm volatile("" ::: "memory");
                if (ABL != 3) {
                SC_COL(0, cA[0]); SC_COL(1, cA[1]); SC_COL(2, cA[2]); SC_COL(3, cA[3]);
                }
                asm volatile("" ::: "memory");
#pragma unroll
                for (int j = 8; j <= 14; ++j)
#pragma unroll
                    for (int q = (j + 1) / 4; q < 4; ++q) cC[j - 8][q - (j + 1) / 4] = *(const LAS f32x4*)(SB + O_AAB + j * 64 + q * 16);
                asm volatile("" ::: "memory");
                if (ABL != 3) {
                SC_COL(4, cB[0]); SC_COL(5, cB[1]); SC_COL(6, cB[2]); SC_COL(7, cB[3]);
                SC_COL(8, cC[0]); SC_COL(9, cC[1]); SC_COL(10, cC[2]); SC_COL(11, cC[3]); SC_COL(12, cC[4]); SC_COL(13, cC[5]); SC_COL(14, cC[6]);
                }
#undef SC_COL
                { u32x4 w0 = {pk2(u[0], u[1]), pk2(u[2], u[3]), pk2(u[4], u[5]), pk2(u[6], u[7])}, w1 = {pk2(u[8], u[9]), pk2(u[10], u[11]), pk2(u[12], u[13]), pk2(u[14], u[15])};
                  if (lane < 32) { *(LAS u32x4*)(L + O_ZU + vl * 32) = w0; *(LAS u32x4*)(L + O_ZU + vl * 32 + 16) = w1; } }
                {
                    bf16x8 zf[2], sf[2][2], bkf[4]; f32x4 gc[4];
#pragma unroll
                    for (int vq = 0; vq < 2; ++vq) { const int vb = vb0 + vq;
                        zf[vq] = (lq < 2) ? *(const LAS bf16x8*)(L + O_ZU + (16 * vb + lr) * 32 + lq * 16) : *(const LAS bf16x8*)(SB + O_VM + (16 * vb + lr) * 32 + (lq - 2) * 16);
#pragma unroll
                        for (int ks = 0; ks < 2; ++ks) sf[vq][ks] = *(const LAS bf16x8*)(L + O_S0 + (16 * vb + lr) * 128 + ks * 64 + lq * 16);
                    }
                    const bf16x8 rk = *(const LAS bf16x8*)(SB + O_ARK + lr * 64 + lq * 16);
                    const bf16x8 rh0 = *(const LAS bf16x8*)(SB + O_RH + lr * 128 + lq * 16), rh1 = *(const LAS bf16x8*)(SB + O_RH + lr * 128 + 64 + lq * 16);
#pragma unroll
                    for (int kb = 0; kb < 4; ++kb) { gc[kb] = *(const LAS f32x4*)(SB + O_GC + (16 * kb + 4 * lq) * 4); bkf[kb] = *(const LAS bf16x8*)(SB + O_BK + (16 * kb + lr) * 64 + lq * 16); }
                    const int step = c * 16 + lr; SC_ROW(step, row, tq, Tq); (void)tq; (void)Tq;
#pragma unroll
                    for (int vq = 0; vq < 2; ++vq) { f32x4 y = {0.f, 0.f, 0.f, 0.f};
                        y = SC_MFMA(sf[vq][0], rh0, y); y = SC_MFMA(sf[vq][1], rh1, y); y = SC_MFMA(zf[vq], rk, y);
                        if (ABL == 0) *(u32x2*)(yout + (size_t)row * 512 + h * 64 + 16 * (vb0 + vq) + 4 * lq) = (u32x2){pk2(y[0], y[1]), pk2(y[2], y[3])}; else asm volatile("" :: "v"(y[0]), "v"(y[1]), "v"(y[2]), "v"(y[3])); }
#pragma unroll
                    for (int kb = 0; kb < 4; ++kb)
#pragma unroll
                        for (int vq = 0; vq < 2; ++vq) S[kb][vq] = SC_MFMA(bkf[kb], zf[vq], S[kb][vq] * gc[kb]);
                }
                asm volatile("s_waitcnt lgkmcnt(0)" ::: "memory");
                if (lane == 0) done[g * 8 + sl] = c + 1;
            }
            __builtin_amdgcn_s_setprio(0);
        } else {
            const int pw = wid - 2, hc = h * 64 + lane; LAS unsigned char* SB = L + pw * SLOT;
            const float kkc = p.a_k_k[j * 512 + hc], kac = p.a_k_a[j * 512 + hc];
            const float mur = p.a_mu[j * ACOLS + hc], muk = p.a_mu[j * ACOLS + 512 + hc], muv = p.a_mu[j * ACOLS + 1024 + hc];
            for (int c = pw; c < NCH; c += NP) {
                if (ABL == 1 || ABL == 3 || ABL == 4) { if (c >= NP) { unsigned spins = 0; while (ldv(done + pw) != c - NP + 1 || ldv(done + 8 + pw) != c - NP + 1) { __builtin_amdgcn_s_sleep(2); if (++spins > (1u << 22)) break; } } if (lane == 0) ready[pw] = c + 1; continue; }
                bf16_t raw[16][11];
#define SC_LOAD(t) do { const int step = c * 16 + (t); SC_ROW(step, row, tq, Tq); \
                    const int rp_ = (tq > 0) ? row - 1 : row, rn_ = (tq < Tq - 1) ? row + 1 : row; \
                    const bf16_t* pc = p.P + (size_t)row * PLD + hc; const bf16_t* pp = p.P + (size_t)rp_ * PLD + hc; const bf16_t* pn = p.P + (size_t)rn_ * PLD + hc; \
                    raw[t][0] = pc[0]; raw[t][1] = pp[0]; raw[t][2] = pn[0]; raw[t][3] = pc[512]; raw[t][4] = pp[512]; raw[t][5] = pn[512]; raw[t][6] = pc[1024]; raw[t][7] = pp[1024]; raw[t][8] = pn[1024]; \
                    raw[t][9] = p.WAG[(size_t)row * WLD + dir * 512 + hc]; raw[t][10] = p.WAG[(size_t)row * WLD + 1024 + dir * 512 + hc]; } while (0)
#define SC_STEP(t) do { const int step = c * 16 + (t); SC_ROW(step, row, tq, Tq); (void)row; \
                    const float mp = (tq > 0) ? 0.5f : 0.f, mn = (tq < Tq - 1) ? 0.5f : 0.f; \
                    const float rc = bf2f(raw[t][0]), kc_ = bf2f(raw[t][3]), vc = bf2f(raw[t][6]); \
                    const float R = rc + mur * (mp * bf2f(raw[t][1]) + mn * bf2f(raw[t][2]) - rc); \
                    const float K = kc_ + muk * (mp * bf2f(raw[t][4]) + mn * bf2f(raw[t][5]) - kc_); \
                    const float Vv = vc + muv * (mp * bf2f(raw[t][7]) + mn * bf2f(raw[t][8]) - vc); \
                    const float w = 1.f - bf2f(raw[t][9]), a = bf2f(raw[t][10]); \
                    const float kkv = K * kkc, ssq = wave_sum(kkv * kkv), kk = kkv * rsqrtf(ssq + 1e-12f); \
                    const float kd = K * (1.f + (a - 1.f) * kac), bd = kk * a; \
                    const float gprev = g; g *= w; const float ig = __builtin_amdgcn_rcpf(g); \
                    *(LAS bf16_t*)(SB + O_AH + (t) * 128 + lane * 2) = f2bf(-kk * gprev); \
                    *(LAS bf16_t*)(SB + O_RH + (t) * 128 + lane * 2) = f2bf(R * g); \
                    *(LAS bf16_t*)(SB + O_BH + (t) * 128 + lane * 2) = f2bf(bd * ig); \
                    *(LAS bf16_t*)(SB + O_KH + (t) * 128 + lane * 2) = f2bf(kd * ig); \
                    *(LAS bf16_t*)(SB + O_VM + lane * 32 + (t) * 2) = f2bf(Vv); } while (0)
                SC_LOAD(0); SC_LOAD(1); SC_LOAD(2); SC_LOAD(3); SC_LOAD(4); SC_LOAD(5); SC_LOAD(6); SC_LOAD(7);
                if (c >= NP) { unsigned spins = 0; while (ldv(done + pw) != c - NP + 1 || ldv(done + 8 + pw) != c - NP + 1) { __builtin_amdgcn_s_sleep(2); if (++spins > (1u << 22)) break; } }
                asm volatile("" ::: "memory");
                float g = 1.f;
                SC_STEP(0); SC_STEP(1); SC_STEP(2); SC_STEP(3);
                asm volatile("" ::: "memory");
                SC_LOAD(8); SC_LOAD(9); SC_LOAD(10); SC_LOAD(11);
                asm volatile("" ::: "memory");
                SC_STEP(4); SC_STEP(5); SC_STEP(6); SC_STEP(7);
                asm volatile("" ::: "memory");
                SC_LOAD(12); SC_LOAD(13); SC_LOAD(14); SC_LOAD(15);
                asm volatile("" ::: "memory");
                SC_STEP(8); SC_STEP(9); SC_STEP(10); SC_STEP(11); SC_STEP(12); SC_STEP(13); SC_STEP(14); SC_STEP(15);
#undef SC_LOAD
#undef SC_STEP
#pragma unroll
                for (int q = 0; q < 2; ++q) {
                    float bq[8], kq[8];
#pragma unroll
                    for (int e = 0; e < 8; ++e) { bq[e] = bf2f(*(const LAS bf16_t*)(SB + O_BH + (8 * q + e) * 128 + lane * 2)) * g; kq[e] = bf2f(*(const LAS bf16_t*)(SB + O_KH + (8 * q + e) * 128 + lane * 2)) * g; }
                    u32x4 wb = {pk2(bq[0], bq[1]), pk2(bq[2], bq[3]), pk2(bq[4], bq[5]), pk2(bq[6], bq[7])}, wk = {pk2(kq[0], kq[1]), pk2(kq[2], kq[3]), pk2(kq[4], kq[5]), pk2(kq[6], kq[7])};
                    *(LAS u32x4*)(SB + O_BK + lane * 64 + q * 16) = wb; *(LAS u32x4*)(SB + O_BK + lane * 64 + 32 + q * 16) = wk;
                }
                *(LAS float*)(SB + O_GC + lane * 4) = g;
                f32x4 sab = {0.f, 0.f, 0.f, 0.f}, sak = sab, srb = sab, srk = sab;
#pragma unroll
                for (int ks = 0; ks < 2; ++ks) {
                    const bf16x8 fa = *(const LAS bf16x8*)(SB + O_AH + lr * 128 + ks * 64 + lq * 16), fr = *(const LAS bf16x8*)(SB + O_RH + lr * 128 + ks * 64 + lq * 16);
                    const bf16x8 fb = *(const LAS bf16x8*)(SB + O_BH + lr * 128 + ks * 64 + lq * 16), fk = *(const LAS bf16x8*)(SB + O_KH + lr * 128 + ks * 64 + lq * 16);
                    sab = SC_MFMA(fa, fb, sab); sak = SC_MFMA(fa, fk, sak); srb = SC_MFMA(fr, fb, srb); srk = SC_MFMA(fr, fk, srk);
                }
#pragma unroll
                for (int q = 0; q < 4; ++q) { const int t = 4 * lq + q; const bool lo = lr < t, le = lr <= t;
                    *(LAS bf16_t*)(SB + O_AAK + (t * 16 + lr) * 2) = f2bf(lo ? sak[q] : 0.f);
                    *(LAS bf16_t*)(SB + O_ARK + (t * 32 + lr) * 2) = f2bf(le ? srb[q] : 0.f);
                    *(LAS bf16_t*)(SB + O_ARK + (t * 32 + 16 + lr) * 2) = f2bf(le ? srk[q] : 0.f); }
                { f32x4 tq;
#pragma unroll
                  for (int q = 0; q < 4; ++q) tq[q] = (lr < 4 * lq + q) ? sab[q] : 0.f;
                  *(LAS f32x4*)(SB + O_AAB + (lr * 16 + 4 * lq) * 4) = tq; }
                asm volatile("s_waitcnt lgkmcnt(0)" ::: "memory");
                if (lane == 0) ready[pw] = c + 1;
            }
        }
#undef SC_ROW
        __syncthreads();
    }
}

DI void unpack8u(const uint4 u, float (&d)[8]) { d[0] = bflo(u.x); d[1] = bfhi(u.x); d[2] = bflo(u.y); d[3] = bfhi(u.y); d[4] = bflo(u.z); d[5] = bfhi(u.z); d[6] = bflo(u.w); d[7] = bfhi(u.w); }
DI uint4 pack8u(const float (&d)[8]) { uint4 u; u.x = att::pk(d[0], d[1]); u.y = att::pk(d[2], d[3]); u.z = att::pk(d[4], d[5]); u.w = att::pk(d[6], d[7]); return u; }
DI void shift8(const bf16_t* P, int row, int t, int T, int col0, const float (&mu)[8], float (&o)[8]) {
    float c[8], pv[8], nx[8];
    unpack8u(*(const uint4*)(P + (size_t)row * PLD + col0), c);
    if (t > 0) unpack8u(*(const uint4*)(P + (size_t)(row - 1) * PLD + col0), pv); else {
#pragma unroll
        for (int i = 0; i < 8; ++i) pv[i] = 0.f; }
    if (t < T - 1) unpack8u(*(const uint4*)(P + (size_t)(row + 1) * PLD + col0), nx); else {
#pragma unroll
        for (int i = 0; i < 8; ++i) nx[i] = 0.f; }
#pragma unroll
    for (int i = 0; i < 8; ++i) o[i] = c[i] + mu[i] * (0.5f * (pv[i] + nx[i]) - c[i]);
}
DI void ld8f(const float* p, float (&d)[8]) { const float4 a = *(const float4*)p, b = *(const float4*)(p + 4); d[0] = a.x; d[1] = a.y; d[2] = a.z; d[3] = a.w; d[4] = b.x; d[5] = b.y; d[6] = b.z; d[7] = b.w; }
DI void ph_post_opt(const Ctx& cx, const Params& p, int j, int nrows) {
    const int tid = cx.tid, wid = tid >> 6, lane = tid & 63, c0 = lane * 8;
    float mur[8], muk[8], muv[8], ka[8], rk[8], lw[8], lb[8];
    ld8f(p.a_mu + j * ACOLS + c0, mur); ld8f(p.a_mu + j * ACOLS + 512 + c0, muk); ld8f(p.a_mu + j * ACOLS + 1024 + c0, muv);
    ld8f(p.a_k_a + j * 512 + c0, ka); ld8f(p.a_r_k + j * 512 + c0, rk); ld8f(p.a_ln_w + j * 512 + c0, lw); ld8f(p.a_ln_b + j * 512 + c0, lb);
    for (int row = cx.bid * 8 + wid; row < nrows; row += cx.nblk * 8) {
        const bool lat = row < NLAT; const int t = lat ? (row & 2047) : ((row - NLAT) & 255); const int T = lat ? 2048 : 256;
        float yf[8], yb[8], R[8], K[8], V[8], af[8], ab[8], g[8];
        unpack8u(*(const uint4*)(p.YF + (size_t)row * 512 + c0), yf); unpack8u(*(const uint4*)(p.YB + (size_t)row * 512 + c0), yb);
        shift8(p.P, row, t, T, c0, mur, R); shift8(p.P, row, t, T, 512 + c0, muk, K); shift8(p.P, row, t, T, 1024 + c0, muv, V);
        unpack8u(*(const uint4*)(p.WAG + (size_t)row * WLD + 1024 + c0), af); unpack8u(*(const uint4*)(p.WAG + (size_t)row * WLD + 1536 + c0), ab); unpack8u(*(const uint4*)(p.WAG + (size_t)row * WLD + 2048 + c0), g);
        float sum = 0.f, sb = 0.f;
#pragma unroll
        for (int i = 0; i < 8; ++i) { yf[i] += yb[i]; sum += yf[i]; sb += R[i] * rk[i] * K[i] * (2.f + (af[i] + ab[i] - 2.f) * ka[i]); }
        sum = scan::red8(sum); sb = scan::red8(sb);
        const float mean = sum * (1.f / 64.f); float var = 0.f;
#pragma unroll
        for (int i = 0; i < 8; ++i) { const float d = yf[i] - mean; var += d * d; }
        var = scan::red8(var);
        const float rstd = rsqrtf(var * (1.f / 64.f) + 64e-5f);
        float o[8];
#pragma unroll
        for (int i = 0; i < 8; ++i) o[i] = ((yf[i] - mean) * rstd * lw[i] + lb[i] + sb * V[i]) * g[i];
        *(uint4*)(p.H + (size_t)row * 1024 + c0) = pack8u(o);
    }
}
DI void rope_cs(int c, int t, bool lat, float (&cs)[8], float (&sn)[8]) {
    const float invf[8] = {1.f, 0.316227766016838f, 0.1f, 0.0316227766016838f, 0.01f, 0.00316227766016838f, 0.001f, 0.000316227766016838f};
    const float pos = (c & 1) ? (float)(t & 63) : (float)(t >> 6);
#pragma unroll
    for (int i = 0; i < 8; ++i) { const float ang = pos * invf[i]; cs[i] = lat ? __cosf(ang) : 1.f; sn[i] = lat ? __sinf(ang) : 0.f; }
}
DI void fin_vec(float (&x)[8], int c, const float (&cs)[8], const float (&sn)[8], const float (&gn)[8], float scl, bf16_t* dst) {
    float ss = 0.f;
#pragma unroll
    for (int i = 0; i < 8; ++i) ss += x[i] * x[i];
    ss += dpp_f<0xB1>(ss); ss += dpp_f<0x4E>(ss); ss += dpp_f<0x141>(ss); ss += dpp_f<0x140>(ss);
    const float r = rsqrtf(ss * (1.f / 96.f) + 1e-6f);
#pragma unroll
    for (int i = 0; i < 8; ++i) x[i] = x[i] * r * gn[i];
    float y[8];
#pragma unroll
    for (int i = 0; i < 8; ++i) { const float up = dpp_f<0x102>(x[i]), dn = dpp_f<0x112>(x[i]); y[i] = (c < 10) ? up : dn; }
    if (c >= 8 && c < 12) {
#pragma unroll
        for (int i = 0; i < 8; ++i) x[i] = (c < 10) ? (x[i] * cs[i] - y[i] * sn[i]) : (x[i] * cs[i] + y[i] * sn[i]);
    }
    if (c < 12) {
#pragma unroll
        for (int i = 0; i < 8; ++i) x[i] *= scl;
        *(uint4*)(dst + c * 8) = pack8u(x);
    }
}
DI void ph_finalize_opt(const Ctx& cx, const Params& p, float* ldsf, int j, int mq) {
    const int tid = cx.tid, wid = tid >> 6, lane = tid & 63, c = lane & 15, hq = lane >> 4;
    float qg[8], kg[8]; ld8f(p.b_q_gain + j * 96 + (c < 12 ? c : 0) * 8, qg); ld8f(p.b_k_gain + j * 96 + (c < 12 ? c : 0) * 8, kg);
    for (int row0 = (cx.bid * 8 + wid) * 2; row0 < NT; row0 += cx.nblk * 16) {
        float xq[4][8], xk[4][8];
#pragma unroll
        for (int u = 0; u < 4; ++u) {
            const int row = row0 + (u >> 1), h = (u & 1) * 4 + hq;
#pragma unroll
            for (int i = 0; i < 8; ++i) { xq[u][i] = 0.f; xk[u][i] = 0.f; }
            if (row < mq && c < 12) unpack8u(*(const uint4*)(p.Qraw + (size_t)row * 768 + h * 96 + c * 8), xq[u]);
            if (c < 8) unpack8u(*(const uint4*)(p.KVraw + (size_t)row * 1024 + h * 128 + c * 8), xk[u]);
            else if (c < 12) unpack8u(*(const uint4*)(p.P + (size_t)row * PLD + ACOLS + 384 + (c - 8) * 8), xk[u]);
        }
#pragma unroll
        for (int rr = 0; rr < 2; ++rr) {
            const int row = row0 + rr;
            const bool lat = row < NLAT; const int b = lat ? (row >> 11) : ((row - NLAT) >> 8); const int t = lat ? (row & 2047) : ((row - NLAT) & 255);
            float cs[8], sn[8]; rope_cs(c, t, lat, cs, sn);
            const int key = lat ? 256 + t : t;
#pragma unroll
            for (int hf = 0; hf < 2; ++hf) { const int u = rr * 2 + hf, h = hf * 4 + hq;
                if (row < mq) fin_vec(xq[u], c, cs, sn, qg, 0.10206207261596577f * 1.4426950408889634f, p.Qraw + (size_t)row * 768 + h * 96);
                fin_vec(xk[u], c, cs, sn, kg, 1.f, p.Kf + ((size_t)(b * 8 + h) * 2304 + key) * 96); }
        }
    }
    bf16_t* T = (bf16_t*)ldsf; constexpr int TP = 520;
    for (int tile = cx.bid; tile < NT / 64; tile += cx.nblk) {
        const int row0 = tile * 64; const bool lat = row0 < NLAT; const int b = lat ? (row0 >> 11) : ((row0 - NLAT) >> 8); const int t0 = lat ? (row0 & 2047) : ((row0 - NLAT) & 255);
        const int key0 = lat ? 256 + t0 : t0;
        __syncthreads();
#pragma unroll
        for (int i = 0; i < 8; ++i) { const int ch = tid + 512 * i, kr = ch >> 6, cc = ch & 63, h = cc >> 3, part = cc & 7;
            *(uint4*)(T + kr * TP + h * 64 + part * 8) = *(const uint4*)(p.KVraw + (size_t)(row0 + kr) * 1024 + h * 128 + 64 + part * 8); }
        __syncthreads();
#pragma unroll
        for (int i = 0; i < 8; ++i) { const int ch = tid + 512 * i, hd = ch >> 3, kc = ch & 7;
            float v[8];
#pragma unroll
            for (int q = 0; q < 8; ++q) v[q] = bf2f(T[(kc * 8 + q) * TP + hd]);
            uint4 o; o.x = (unsigned)T[(kc * 8 + 0) * TP + hd] | ((unsigned)T[(kc * 8 + 1) * TP + hd] << 16); o.y = (unsigned)T[(kc * 8 + 2) * TP + hd] | ((unsigned)T[(kc * 8 + 3) * TP + hd] << 16);
            o.z = (unsigned)T[(kc * 8 + 4) * TP + hd] | ((unsigned)T[(kc * 8 + 5) * TP + hd] << 16); o.w = (unsigned)T[(kc * 8 + 6) * TP + hd] | ((unsigned)T[(kc * 8 + 7) * TP + hd] << 16);
            (void)v;
            *(uint4*)(p.Vt + ((size_t)(b * 8 + (hd >> 6)) * 64 + (hd & 63)) * 2304 + key0 + kc * 8) = o; }
    }
    __syncthreads();
}
DI void ph_mod_opt(const Ctx& cx, const Params& p, float* lds) {
    const int tid = cx.tid, wid = tid >> 6, lane = tid & 63;
    float* part = lds + 17 * 1024;
    for (int i = tid; i < 17 * 1024; i += NTHR) { const int jj = i >> 10, k = i & 1023; const float v = (jj < 16) ? p.c[jj * 1024 + k] : p.c_ctx[k]; lds[i] = siluf(v); }
    __syncthreads();
    for (int item = cx.bid; item < 4 * 96; item += cx.nblk) {
        const int l = item / 96, n = (item % 96) * 64 + lane;
        const float* w = p.mod_w + (size_t)l * 1024 * 6144 + n;
        float acc[17];
#pragma unroll
        for (int jj = 0; jj < 17; ++jj) acc[jj] = 0.f;
        for (int k0 = wid * 128; k0 < wid * 128 + 128; k0 += 16) {
            float wv[16];
#pragma unroll
            for (int q = 0; q < 16; ++q) wv[q] = w[(size_t)(k0 + q) * 6144];
#pragma unroll
            for (int q = 0; q < 16; ++q)
#pragma unroll
                for (int jj = 0; jj < 17; ++jj) acc[jj] += lds[jj * 1024 + k0 + q] * wv[q];
        }
#pragma unroll
        for (int jj = 0; jj < 17; ++jj) part[(wid * 17 + jj) * 64 + lane] = acc[jj];
        __syncthreads();
        for (int o = tid; o < 17 * 64; o += NTHR) { const int jj = o >> 6, ln = o & 63; float sacc = p.mod_b[l * 6144 + (item % 96) * 64 + ln];
#pragma unroll
            for (int q = 0; q < 8; ++q) sacc += part[(q * 17 + jj) * 64 + ln];
            p.mod[((size_t)l * 17 + jj) * 6144 + (item % 96) * 64 + ln] = sacc; }
        __syncthreads();
    }
}

DI void ph_norm2_router(const Ctx& cx, const Params& p, float* ldsg, int nrows, const float* gain, const float* modl, int layer, const bf16_t* xb_lat) {
    LAS float* lds = (LAS float*)ldsg;
    const int tid = cx.tid, wid = tid >> 6, lane = tid & 63;
    LAS float* rw = lds; LAS float* red = lds + 16 * 1024 + wid * (32 * 64 + 64); LAS float* my = red + 32 * 64;
    LAS int* lcnt = (LAS int*)(lds + 16 * 1024 + 8 * (32 * 64 + 64)); LAS int* lbase = lcnt + 16; LAS int* rlist = lcnt + 32;
    for (int i = tid; i < 16 * 1024; i += NTHR) { const int e = i >> 10, col = i & 1023; rw[i] = p.router_w[col * 16 + e]; }
    if (tid < 16) lcnt[tid] = 0;
    __syncthreads();
    int nlist = 0;
    uint2 raw[2][4];
#define N2_LOAD(pi) do { _Pragma("unroll") for (int r = 0; r < 2; ++r) { const int row = 2 * (pi) + r; const bf16_t* xr = (row < NLAT) ? xb_lat + (size_t)row * 1024 : p.cs + (size_t)(row - NLAT) * 1024; \
            _Pragma("unroll") for (int i = 0; i < 4; ++i) raw[r][i] = *(const uint2*)(xr + i * 256 + lane * 4); } } while (0)
    { const int p0 = cx.bid * 8 + wid; if (xb_lat && p0 < (nrows >> 1)) N2_LOAD(p0); }
    for (int pidx = cx.bid * 8 + wid; pidx < (nrows >> 1); pidx += cx.nblk * 8) {
        float4 xv[2][4];
        if (xb_lat) {
#pragma unroll
            for (int r = 0; r < 2; ++r)
#pragma unroll
                for (int i = 0; i < 4; ++i) xv[r][i] = make_float4(bflo(raw[r][i].x), bfhi(raw[r][i].x), bflo(raw[r][i].y), bfhi(raw[r][i].y));
            const int pn = pidx + cx.nblk * 8; if (pn < (nrows >> 1)) N2_LOAD(pn);
        } else {
#pragma unroll
            for (int r = 0; r < 2; ++r) { const int row = 2 * pidx + r; const float* xr = (row < NLAT) ? p.out + (size_t)row * 1024 : p.ctxs + (size_t)(row - NLAT) * 1024;
#pragma unroll
                for (int i = 0; i < 4; ++i) xv[r][i] = *(const float4*)(xr + i * 256 + lane * 4); }
        }
        const int row0 = 2 * pidx; const int jj = (row0 < NLAT) ? (row0 >> 11) : 16;
        const float* shp = modl + (size_t)jj * 6144 + 3 * 1024; const float* scp = modl + (size_t)jj * 6144 + 4 * 1024;
        float4 hv[2][4];
#pragma unroll
        for (int r = 0; r < 2; ++r) {
            float ss = 0.f;
#pragma unroll
            for (int i = 0; i < 4; ++i) ss += xv[r][i].x * xv[r][i].x + xv[r][i].y * xv[r][i].y + xv[r][i].z * xv[r][i].z + xv[r][i].w * xv[r][i].w;
            ss = wave_sum(ss);
            const float rstd = rsqrtf(ss * (1.f / 1024.f) + 1e-6f);
#pragma unroll
            for (int i = 0; i < 4; ++i) {
                const int col = i * 256 + lane * 4;
                const float4 g = *(const float4*)(gain + col), sh = *(const float4*)(shp + col), sc = *(const float4*)(scp + col);
                hv[r][i].x = xv[r][i].x * rstd * g.x * (1.f + sc.x) + sh.x; hv[r][i].y = xv[r][i].y * rstd * g.y * (1.f + sc.y) + sh.y;
                hv[r][i].z = xv[r][i].z * rstd * g.z * (1.f + sc.z) + sh.z; hv[r][i].w = xv[r][i].w * rstd * g.w * (1.f + sc.w) + sh.w;
                uint2 u; u.x = att::pk(hv[r][i].x, hv[r][i].y); u.y = att::pk(hv[r][i].z, hv[r][i].w);
                *(uint2*)(p.H + (size_t)(row0 + r) * 1024 + col) = u;
            }
        }
#pragma unroll
        for (int e = 0; e < 16; ++e) {
            float a0 = 0.f, a1 = 0.f;
#pragma unroll
            for (int i = 0; i < 4; ++i) { const mm::f32x4 w = *(const LAS mm::f32x4*)(rw + e * 1024 + i * 256 + lane * 4);
                a0 += hv[0][i].x * w[0] + hv[0][i].y * w[1] + hv[0][i].z * w[2] + hv[0][i].w * w[3]; a1 += hv[1][i].x * w[0] + hv[1][i].y * w[1] + hv[1][i].z * w[2] + hv[1][i].w * w[3]; }
            red[e * 64 + lane] = a0; red[(16 + e) * 64 + lane] = a1;
        }
        __builtin_amdgcn_wave_barrier();
        {
            const int r = lane >> 5, e = (lane >> 1) & 15, half = lane & 1; const LAS float* src = red + (r * 16 + e) * 64 + half * 32;
            float sacc = 0.f;
#pragma unroll
            for (int q = 0; q < 8; ++q) { const mm::f32x4 v = *(const LAS mm::f32x4*)(src + q * 4); sacc += (v[0] + v[1]) + (v[2] + v[3]); }
            sacc += dpp_f<0xB1>(sacc);
            const float sg = 1.f / (1.f + __expf(-sacc));
            if (half == 0) { my[r * 32 + e] = sg; my[r * 32 + 16 + e] = sg + p.router_b[e]; }
        }
        __builtin_amdgcn_wave_barrier();
        if ((lane & 31) == 0) {
            const int r = lane >> 5; const LAS float* m = my + r * 32;
            float best = -3.0e38f; int be1 = 0, be2 = 1;
#pragma unroll
            for (int g = 0; g < 4; ++g) {
                const mm::f32x4 v = *(const LAS mm::f32x4*)(m + 16 + 4 * g);
                int i1 = 0; float m1 = v[0];
                if (v[1] > m1) { m1 = v[1]; i1 = 1; } if (v[2] > m1) { m1 = v[2]; i1 = 2; } if (v[3] > m1) { m1 = v[3]; i1 = 3; }
                int i2 = -1; float m2 = -3.0e38f;
                if (i1 != 0 && v[0] > m2) { m2 = v[0]; i2 = 0; } if (i1 != 1 && v[1] > m2) { m2 = v[1]; i2 = 1; }
                if (i1 != 2 && v[2] > m2) { m2 = v[2]; i2 = 2; } if (i1 != 3 && v[3] > m2) { m2 = v[3]; i2 = 3; }
                const float gs = m1 + m2;
                if (gs > best) { best = gs; be1 = 4 * g + i1; be2 = 4 * g + i2; }
            }
            const float bs1 = m[be1], bs2 = m[be2]; const float inv = 1.f / (bs1 + bs2);
            const int p1 = atomicAdd((int*)&lcnt[be1], 1), p2 = atomicAdd((int*)&lcnt[be2], 1);
            LAS int* ent = rlist + (wid * 24 + nlist * 2 + r) * 6;
            const int row = row0 + r;
            ent[0] = row; ent[1] = be1 | (be2 << 8); ent[2] = p1; ent[3] = p2; ent[4] = __float_as_int(bs1 * inv); ent[5] = __float_as_int(bs2 * inv);
        }
        ++nlist;
        __builtin_amdgcn_wave_barrier();
    }
#undef N2_LOAD
    __syncthreads();
    if (tid < 16) lbase[tid] = atomicAdd(p.cnt + (layer * 16 + tid) * 64, lcnt[tid]);
    __syncthreads();
    for (int k = lane; k < 2 * nlist; k += 64) {
        const LAS int* ent = rlist + (wid * 24 + k) * 6; const int row = ent[0], be1 = ent[1] & 255, be2 = ent[1] >> 8;
        const size_t s1 = (size_t)be1 * NT + lbase[be1] + ent[2], s2 = (size_t)be2 * NT + lbase[be2] + ent[3];
        p.slot[s1] = row * 2; p.slot[s2] = row * 2 + 1; p.slotw[s1] = __int_as_float(ent[4]); p.slotw[s2] = __int_as_float(ent[5]);
    }
    __syncthreads();
}

DI void ph_prepBLR_opt(const Ctx& cx, const Params& p, int j) {
    const int tid = cx.tid, wid = tid >> 6, lane = tid & 63;
    const float4 gq = *(const float4*)(p.b_q_norm + j * 256 + lane * 4); const float2 gk = *(const float2*)(p.b_kv_norm + j * 128 + lane * 2);
    constexpr int U = 8;
    for (int row0 = (cx.bid * 8 + wid) * U; row0 < NT; row0 += cx.nblk * 8 * U) {
        uint2 uq[U]; unsigned ukv[U];
#pragma unroll
        for (int u = 0; u < U; ++u) { const bf16_t* pr = p.P + (size_t)(row0 + u) * PLD + ACOLS; uq[u] = *(const uint2*)(pr + lane * 4); ukv[u] = *(const unsigned*)(pr + 256 + lane * 2); }
#pragma unroll
        for (int u = 0; u < U; ++u) {
            const float q0 = bflo(uq[u].x), q1 = bfhi(uq[u].x), q2 = bflo(uq[u].y), q3 = bfhi(uq[u].y), k0 = bflo(ukv[u]), k1 = bfhi(ukv[u]);
            const float sq = wave_sum(q0 * q0 + q1 * q1 + q2 * q2 + q3 * q3), sk = wave_sum(k0 * k0 + k1 * k1);
            const float rq = rsqrtf(sq * (1.f / 256.f) + 1e-6f), rk = rsqrtf(sk * (1.f / 128.f) + 1e-6f);
            uint2 o; o.x = att::pk(q0 * rq * gq.x, q1 * rq * gq.y); o.y = att::pk(q2 * rq * gq.z, q3 * rq * gq.w);
            bf16_t* qn = p.QN + (size_t)(row0 + u) * 512;
            *(uint2*)(qn + lane * 4) = o; *(unsigned*)(qn + 256 + lane * 2) = att::pk(k0 * rk * gk.x, k1 * rk * gk.y); *(unsigned*)(qn + 384 + lane * 2) = 0u;
        }
    }
    const int gtid = cx.bid * NTHR + tid, gsz = cx.nblk * NTHR;
    for (int idx = gtid; idx < NT * 48; idx += gsz) {
        const int row = idx / 48, cg = idx % 48, col0 = cg * 8;
        const bool lat = row < NLAT; const int t = lat ? (row & 2047) : ((row - NLAT) & 255); const int T = lat ? 2048 : 256;
        float mu[8]; ld8f(p.a_mu + j * ACOLS + 1536 + col0, mu);
        float v[8]; shift8(p.P, row, t, T, 1536 + col0, mu, v);
        if (cg < 16) {
#pragma unroll
            for (int i = 0; i < 8; ++i) { const float e = __expf(2.f * v[i]); v[i] = 1.f - 2.f * __builtin_amdgcn_rcpf(e + 1.f); }
        } else if (cg >= 32) {
#pragma unroll
            for (int i = 0; i < 8; ++i) v[i] = __builtin_amdgcn_rcpf(1.f + __expf(-v[i]));
        }
        *(uint4*)(p.LR + (size_t)row * 384 + col0) = pack8u(v);
    }
}

template <bool FINAL>
DI void ph_normc(const Ctx& cx, const Params& p, int nrows, const bf16_t* xin_lat, bf16_t* xout_lat, const float* gain, const float* modl, const float* modprev) {
    const int tid = cx.tid, wid = tid >> 6, lane = tid & 63;
    for (int row = cx.bid * 8 + wid; row < nrows; row += cx.nblk * 8) {
        const bool lat = row < NLAT; const int jj = lat ? (row >> 11) : 16; const size_t rb = lat ? (size_t)row : (size_t)(row - NLAT);
        const bf16_t* xr = (lat ? xin_lat : p.cs) + rb * 1024;
        const float* g2 = modprev + (size_t)jj * 6144 + 5 * 1024;
        float4 xv[4];
#pragma unroll
        for (int i = 0; i < 4; ++i) {
            const int col = i * 256 + lane * 4;
            const uint2 ux = *(const uint2*)(xr + col);
            float s0 = 0.f, s1 = 0.f, s2 = 0.f, s3 = 0.f;
#pragma unroll
            for (int sl = 0; sl < 3; ++sl) { const uint2 u = *(const uint2*)(p.Y + ((size_t)sl * NT + row) * 1024 + col); s0 += bflo(u.x); s1 += bfhi(u.x); s2 += bflo(u.y); s3 += bfhi(u.y); }
            const float4 gv = *(const float4*)(g2 + col);
            xv[i].x = bflo(ux.x) + gv.x * s0; xv[i].y = bfhi(ux.x) + gv.y * s1; xv[i].z = bflo(ux.y) + gv.z * s2; xv[i].w = bfhi(ux.y) + gv.w * s3;
            if (FINAL) *(float4*)(p.out + (size_t)row * 1024 + col) = xv[i];
            else { uint2 o; o.x = att_pk(xv[i].x, xv[i].y); o.y = att_pk(xv[i].z, xv[i].w); *(uint2*)((lat ? xout_lat : p.cs) + rb * 1024 + col) = o; }
        }
        if (!FINAL) {
            float ss = 0.f;
#pragma unroll
            for (int i = 0; i < 4; ++i) ss += xv[i].x * xv[i].x + xv[i].y * xv[i].y + xv[i].z * xv[i].z + xv[i].w * xv[i].w;
            ss = wave_sum(ss);
            const float rstd = rsqrtf(ss * (1.f / 1024.f) + 1e-6f);
            const float* shp = modl + (size_t)jj * 6144; const float* scp = modl + (size_t)jj * 6144 + 1024;
#pragma unroll
            for (int i = 0; i < 4; ++i) {
                const int col = i * 256 + lane * 4;
                const float4 g = *(const float4*)(gain + col), sh = *(const float4*)(shp + col), sc = *(const float4*)(scp + col);
                uint2 u; u.x = att_pk(xv[i].x * rstd * g.x * (1.f + sc.x) + sh.x, xv[i].y * rstd * g.y * (1.f + sc.y) + sh.y);
                u.y = att_pk(xv[i].z * rstd * g.z * (1.f + sc.z) + sh.z, xv[i].w * rstd * g.w * (1.f + sc.w) + sh.w);
                *(uint2*)(p.H + (size_t)row * 1024 + col) = u;
            }
        }
    }
}

struct F1Sched {
    static constexpr bool GATHER = false, TABLE = false;
    const char* A; const char* Hb; int T2, nN, G, c;
    DI size_t hstep_a() const { return (size_t)mm::HALF * 1024 * 2; }
    DI unsigned boff(int Rb, int C, int Kk) const { return (unsigned)(Rb * T2 * Kk + C) * 2u; }
    DI size_t hstep_b(int Kk) const { return (size_t)Kk * 2; }
    DI bool next(int i, mm::Unit& u) const {
        const int L = i * G + c; if (L >= 8 * nN) return false;
        u.pm = L & 7; u.pn = L >> 3; u.e = 0; u.m = 0;
        const int b = (T2 == 16) ? (u.pn >> 3) : u.pn, t20 = (T2 == 16) ? 2 * (u.pn & 7) : 0;
        u.A = A + (size_t)u.pm * 256 * 1024 * 2; u.B = Hb + ((size_t)b * (128 * T2) + t20) * 1024 * 2; return true;
    }
    DI void aoff(const mm::Unit&, int R0, int C0, int R1, int C1, unsigned (&o)[2][2]) const {
        o[0][0] = (unsigned)(R0 * 1024 + C0) * 2u; o[0][1] = (unsigned)(R1 * 1024 + C1) * 2u; o[1][0] = o[0][0]; o[1][1] = o[0][1];
    }
};
struct EpiZT3 {
    static constexpr bool PERM = true;
    bf16_t* Z; int T2;
    DI void operator()(const mm::f32x4 (&acc)[2][2][4][2], const mm::Unit& u, int wr, int wc, int fr, int fq) const {
        const int b = (T2 == 16) ? (u.pn >> 3) : u.pn, t20 = (T2 == 16) ? 2 * (u.pn & 7) : 0;
        const int m0 = u.pm * 256 + wr * 64 + fr, t1 = wc * 32 + 8 * fq;
#pragma unroll
        for (int ai = 0; ai < 2; ++ai)
#pragma unroll
            for (int m = 0; m < 4; ++m) { const int mr = m0 + ai * 128 + m * 16, part = mr >> 10, ch = mr & 1023;
#pragma unroll
                for (int bj = 0; bj < 2; ++bj) { const mm::f32x4 v0 = acc[ai][bj][m][0], v1 = acc[ai][bj][m][1];
                    mm::u32x4 w; w.x = att_pk(v0[0], v0[1]); w.y = att_pk(v0[2], v0[3]); w.z = att_pk(v1[0], v1[1]); w.w = att_pk(v1[2], v1[3]);
                    *(mm::u32x4*)(Z + ((size_t)(b * 1024 + ch) * T2 + t20 + bj) * 256 + part * 128 + t1) = w; } }
    }
};
DI void ph_f1b(const Ctx& cx, const Params& p, float* lds, int j, bool with_ctx) {
    { F1Sched S{(const char*)(p.A1 + (size_t)j * 2048 * 1024), (const char*)p.H, 16, NLAT / 256, cx.nblk, cx.bid}; EpiZT3 E{p.ZT, 16}; mm::gemm_phase(GEMM_LDS(lds), 1024, S, E, cx.tid); }
    if (with_ctx) { F1Sched S{(const char*)(p.A1 + (size_t)j * 2048 * 1024), (const char*)(p.H + (size_t)NLAT * 1024), 2, NCTX / 256, cx.nblk, cx.bid}; EpiZT3 E{p.ZTC, 2}; mm::gemm_phase(GEMM_LDS(lds), 1024, S, E, cx.tid); }
}
DI void ph_fa(const Ctx& cx, const Params& p, float* lds, bool with_ctx) {
    int Kr = 256; asm volatile("" : "+s"(Kr));
    { mm::BatchSched S; S.init(p.M1, p.ZT, (size_t)16384 * 256 * 2, 16, 256, 16384, Kr, cx.nblk, cx.bid); mm::EpiBf16Store E{p.YF1, 16384, (size_t)256 * 16384}; mm::gemm_phase(GEMM_LDS(lds), Kr, S, E, cx.tid); }
    if (with_ctx) { mm::BatchSched S; S.init(p.M1, p.ZTC, (size_t)2048 * 256 * 2, 16, 256, 2048, Kr, cx.nblk, cx.bid); mm::EpiBf16Store E{p.YF1c, 2048, (size_t)256 * 2048}; mm::gemm_phase(GEMM_LDS(lds), Kr, S, E, cx.tid); }
}
template <int T2>
DI void fb_items(const Ctx& cx, const Params& p, const LAS float* tw, const bf16_t* Y, const bf16_t* xin, bf16_t* xout, const float* modl, bool ctx, float scale) {
    constexpr int T = 128 * T2; constexpr size_t NB = (size_t)1024 * T2;
    const int gtid = cx.bid * NTHR + cx.tid, gsz = cx.nblk * NTHR;
    for (int idx = gtid; idx < 16 * 128 * 512; idx += gsz) {
        const int cp = idx & 511, f1 = (idx >> 9) & 127, b = idx >> 16;
        float yr[2][T2], yi[2][T2];
        { const bf16_t* pr = Y + ((size_t)b * 256 + f1) * NB + (size_t)(2 * cp) * T2; const bf16_t* pi = pr + (size_t)128 * NB;
          if constexpr (T2 == 2) { const uint2 ur = *(const uint2*)pr, ui = *(const uint2*)pi;
              yr[0][0] = bflo(ur.x); yr[0][1] = bfhi(ur.x); yr[1][0] = bflo(ur.y); yr[1][1] = bfhi(ur.y); yi[0][0] = bflo(ui.x); yi[0][1] = bfhi(ui.x); yi[1][0] = bflo(ui.y); yi[1][1] = bfhi(ui.y); }
          else {
#pragma unroll
          for (int q = 0; q < (2 * T2) / 8; ++q) { float d[8]; unpack8u(*(const uint4*)(pr + q * 8), d);
#pragma unroll
              for (int e = 0; e < 8; ++e) yr[(q * 8 + e) / T2][(q * 8 + e) % T2] = d[e];
              unpack8u(*(const uint4*)(pi + q * 8), d);
#pragma unroll
              for (int e = 0; e < 8; ++e) yi[(q * 8 + e) / T2][(q * 8 + e) % T2] = d[e]; } } }
        const int jj = ctx ? 16 : b; const float2 g1 = *(const float2*)(modl + (size_t)jj * 6144 + 2 * 1024 + 2 * cp);
        constexpr int FG = (T2 >= 4) ? 4 : T2;
#pragma unroll 1
        for (int fg = 0; fg < T2; fg += FG) {
            unsigned xv[FG];
#pragma unroll
            for (int q = 0; q < FG; ++q) xv[q] = *(const unsigned*)(xin + ((size_t)b * T + f1 + 128 * (fg + q)) * 1024 + 2 * cp);
#pragma unroll
            for (int q = 0; q < FG; ++q) {
                const int f = f1 + 128 * (fg + q); float a0 = 0.f, a1 = 0.f;
#pragma unroll
                for (int t2 = 0; t2 < T2; ++t2) { const int mi = ((t2 * f) & (T - 1)) * (2048 / T); const float cs = tw[2 * mi], sn = tw[2 * mi + 1];
                    a0 += cs * yr[0][t2] + sn * yi[0][t2]; a1 += cs * yr[1][t2] + sn * yi[1][t2]; }
                *(unsigned*)(xout + ((size_t)b * T + f) * 1024 + 2 * cp) = att_pk(bflo(xv[q]) + g1.x * scale * a0, bfhi(xv[q]) + g1.y * scale * a1);
            }
        }
    }
}
DI void fb_mfma(const Ctx& cx, const Params& p, const LAS float* tw, const bf16_t* Y, const bf16_t* xin, bf16_t* xout, const float* modl) {
    typedef short bf16x8 __attribute__((ext_vector_type(8)));
    constexpr size_t NB = (size_t)1024 * 16;
    const int tid = cx.tid, wid = tid >> 6, lane = tid & 63, lq = lane >> 4, lr = lane & 15;
    const int part = lq >> 1, t20 = 8 * (lq & 1);
    for (int item = cx.bid * 8 + wid; item < 16 * 128 * 32; item += cx.nblk * 8) {
        const int cb = item & 31, f1 = (item >> 5) & 127, b = item >> 12, c0 = cb * 32;
        const bf16_t* yb = Y + ((size_t)b * 256 + part * 128 + f1) * NB + t20;
        const int chA = c0 + 8 * (lr >> 2) + (lr & 3);
        const bf16x8 a0 = *(const bf16x8*)(yb + (size_t)chA * 16), a1 = *(const bf16x8*)(yb + (size_t)(chA + 4) * 16);
        const int f = f1 + 128 * lr;
        mm::u32x4 bw;
        { float tv[8];
#pragma unroll
          for (int jj = 0; jj < 8; ++jj) { const int mi = ((t20 + jj) * f) & 2047; tv[jj] = tw[2 * mi + part]; }
          bw.x = att_pk(tv[0], tv[1]); bw.y = att_pk(tv[2], tv[3]); bw.z = att_pk(tv[4], tv[5]); bw.w = att_pk(tv[6], tv[7]); }
        const bf16x8 bf = __builtin_bit_cast(bf16x8, bw);
        mm::f32x4 d0 = {0.f, 0.f, 0.f, 0.f}, d1 = d0;
        d0 = __builtin_amdgcn_mfma_f32_16x16x32_bf16(a0, bf, d0, 0, 0, 0);
        d1 = __builtin_amdgcn_mfma_f32_16x16x32_bf16(a1, bf, d1, 0, 0, 0);
        const float* g1 = modl + (size_t)b * 6144 + 2 * 1024 + c0 + 8 * lq;
        const mm::f32x4 g0 = *(const mm::f32x4*)g1, g4 = *(const mm::f32x4*)(g1 + 4);
        const size_t off = ((size_t)b * 2048 + f) * 1024 + c0 + 8 * lq;
        const mm::u32x4 xv = *(const mm::u32x4*)(xin + off);
        const float sc = 1.f / 512.f;
        mm::u32x4 o;
        o.x = att_pk(bflo(xv.x) + g0[0] * sc * d0[0], bfhi(xv.x) + g0[1] * sc * d0[1]); o.y = att_pk(bflo(xv.y) + g0[2] * sc * d0[2], bfhi(xv.y) + g0[3] * sc * d0[3]);
        o.z = att_pk(bflo(xv.z) + g4[0] * sc * d1[0], bfhi(xv.z) + g4[1] * sc * d1[1]); o.w = att_pk(bflo(xv.w) + g4[2] * sc * d1[2], bfhi(xv.w) + g4[3] * sc * d1[3]);
        *(mm::u32x4*)(xout + off) = o;
    }
}
DI void ph_fb(const Ctx& cx, const Params& p, float* ldsg, bool with_ctx, const bf16_t* xin_lat, bf16_t* xout_lat, const float* modl) {
    LAS float* tw = (LAS float*)ldsg;
    for (int i = cx.tid; i < 2048; i += NTHR) { const float a = (float)i * (1.f / 1024.f); tw[2 * i] = cospif(a); tw[2 * i + 1] = sinpif(a); }
    __syncthreads();
    fb_mfma(cx, p, tw, p.YF1, xin_lat, xout_lat, modl);
    if (with_ctx) fb_items<2>(cx, p, tw, p.YF1c, p.cs, p.cs, modl, true, 0.0055242717280199f);
    __syncthreads();
}

DI void ph_norm2_router_mfma(const Ctx& cx, const Params& p, float* ldsg, int nrows, const float* gain, const float* modl, int layer, const bf16_t* xb_lat) {
    LAS float* lds = (LAS float*)ldsg;
    const int tid = cx.tid, wid = tid >> 6, lane = tid & 63, lq = lane >> 4, lr = lane & 15;
    constexpr int HP = 1026;
    LAS float* wl = lds; LAS float* hb = lds + 16384; LAS float* red = hb + 16 * HP; LAS float* myall = red + 2048;
    LAS int* lcnt = (LAS int*)(myall + 512); LAS int* lbase = lcnt + 16; LAS int* rlist = lcnt + 32;
    for (int i = tid; i < 16384; i += NTHR) wl[i] = p.router_w[i];
    if (tid < 16) lcnt[tid] = 0;
    __syncthreads();
    int nlist = 0;
    for (int grp = cx.bid; grp < (nrows >> 4); grp += cx.nblk) {
        const int row0 = 16 * grp + 2 * wid; const int jj = (row0 < NLAT) ? (row0 >> 11) : 16;
        const float* shp = modl + (size_t)jj * 6144 + 3 * 1024; const float* scp = modl + (size_t)jj * 6144 + 4 * 1024;
        float4 xv[2][4];
#pragma unroll
        for (int r = 0; r < 2; ++r) { const int row = row0 + r; const bf16_t* xr = (row < NLAT) ? xb_lat + (size_t)row * 1024 : p.cs + (size_t)(row - NLAT) * 1024;
#pragma unroll
            for (int i = 0; i < 4; ++i) { const uint2 u = *(const uint2*)(xr + i * 256 + lane * 4); xv[r][i] = make_float4(bflo(u.x), bfhi(u.x), bflo(u.y), bfhi(u.y)); } }
#pragma unroll
        for (int r = 0; r < 2; ++r) {
            float ss = 0.f;
#pragma unroll
            for (int i = 0; i < 4; ++i) ss += xv[r][i].x * xv[r][i].x + xv[r][i].y * xv[r][i].y + xv[r][i].z * xv[r][i].z + xv[r][i].w * xv[r][i].w;
            ss = wave_sum(ss);
            const float rstd = rsqrtf(ss * (1.f / 1024.f) + 1e-6f);
#pragma unroll
            for (int i = 0; i < 4; ++i) {
                const int col = i * 256 + lane * 4;
                const float4 g = *(const float4*)(gain + col), sh = *(const float4*)(shp + col), sc = *(const float4*)(scp + col);
                const float h0 = xv[r][i].x * rstd * g.x * (1.f + sc.x) + sh.x, h1 = xv[r][i].y * rstd * g.y * (1.f + sc.y) + sh.y;
                const float h2 = xv[r][i].z * rstd * g.z * (1.f + sc.z) + sh.z, h3 = xv[r][i].w * rstd * g.w * (1.f + sc.w) + sh.w;
                uint2 u; u.x = att_pk(h0, h1); u.y = att_pk(h2, h3);
                *(uint2*)(p.H + (size_t)(row0 + r) * 1024 + col) = u;
                LAS float* hp = hb + (2 * wid + r) * HP + col;
                *(LAS scan::f32x2*)hp = (scan::f32x2){h0, h1}; *(LAS scan::f32x2*)(hp + 2) = (scan::f32x2){h2, h3};
            }
        }
        __syncthreads();
        {
            mm::f32x4 acc = {0.f, 0.f, 0.f, 0.f};
            const LAS float* ap = hb + lr * HP + 128 * wid + lq; const LAS float* bp = wl + (128 * wid + lq) * 16 + lr;
#pragma unroll 8
            for (int s = 0; s < 32; ++s) acc = __builtin_amdgcn_mfma_f32_16x16x4f32(ap[4 * s], bp[64 * s], acc, 0, 0, 0);
#pragma unroll
            for (int q = 0; q < 4; ++q) red[wid * 256 + (4 * lq + q) * 16 + lr] = acc[q];
        }
        __syncthreads();
        if (tid < 256) { const int row = tid >> 4, e = tid & 15; float sacc = 0.f;
#pragma unroll
            for (int w = 0; w < 8; ++w) sacc += red[w * 256 + row * 16 + e];
            const float sg = 1.f / (1.f + __expf(-sacc));
            myall[row * 32 + e] = sg; myall[row * 32 + 16 + e] = sg + p.router_b[e]; }
        __syncthreads();
        if ((lane & 31) == 0) {
            const int r = lane >> 5; const LAS float* m = myall + (2 * wid + r) * 32;
            float best = -3.0e38f; int be1 = 0, be2 = 1;
#pragma unroll
            for (int g = 0; g < 4; ++g) {
                const mm::f32x4 v = *(const LAS mm::f32x4*)(m + 16 + 4 * g);
                int i1 = 0; float m1 = v[0];
                if (v[1] > m1) { m1 = v[1]; i1 = 1; } if (v[2] > m1) { m1 = v[2]; i1 = 2; } if (v[3] > m1) { m1 = v[3]; i1 = 3; }
                int i2 = -1; float m2 = -3.0e38f;
                if (i1 != 0 && v[0] > m2) { m2 = v[0]; i2 = 0; } if (i1 != 1 && v[1] > m2) { m2 = v[1]; i2 = 1; }
                if (i1 != 2 && v[2] > m2) { m2 = v[2]; i2 = 2; } if (i1 != 3 && v[3] > m2) { m2 = v[3]; i2 = 3; }
                const float gs = m1 + m2;
                if (gs > best) { best = gs; be1 = 4 * g + i1; be2 = 4 * g + i2; }
            }
            const float bs1 = m[be1], bs2 = m[be2]; const float inv = 1.f / (bs1 + bs2);
            const int p1 = atomicAdd((int*)&lcnt[be1], 1), p2 = atomicAdd((int*)&lcnt[be2], 1);
            LAS int* ent = rlist + (wid * 24 + nlist * 2 + r) * 6;
            ent[0] = row0 + r; ent[1] = be1 | (be2 << 8); ent[2] = p1; ent[3] = p2; ent[4] = __float_as_int(bs1 * inv); ent[5] = __float_as_int(bs2 * inv);
        }
        ++nlist;
    }
    __syncthreads();
    if (tid < 16) lbase[tid] = atomicAdd(p.cnt + (layer * 16 + tid) * 64, lcnt[tid]);
    __syncthreads();
    for (int k = lane; k < 2 * nlist; k += 64) {
        const LAS int* ent = rlist + (wid * 24 + k) * 6; const int row = ent[0], be1 = ent[1] & 255, be2 = ent[1] >> 8;
        const size_t s1 = (size_t)be1 * NT + lbase[be1] + ent[2], s2 = (size_t)be2 * NT + lbase[be2] + ent[3];
        p.slot[s1] = row * 2; p.slot[s2] = row * 2 + 1; p.slotw[s1] = __int_as_float(ent[4]); p.slotw[s2] = __int_as_float(ent[5]);
    }
    __syncthreads();
}

template <int PH>
DI void run_phase(const Params& p, float* lds, int L, int wave_id) {
    const Ctx cx = make_ctx(wave_id);
    const int j = L >> 1;
    const float* modl = p.mod + (size_t)L * 17 * 6144;
    const float* modprev = p.mod + (size_t)(L > 0 ? L - 1 : 0) * 17 * 6144;
    const bool last = (L == 3);
    const int rows_layer = (L == 3) ? NLAT : NT;
    const int rows_out = (L >= 2) ? NLAT : NT;
    const float* xin_lat = (L == 0) ? p.x : p.out; const float* xin_ctx = (L == 0) ? p.ctx : p.ctxs;
    constexpr bool BFS = (OPT >= 11);
    const void* bin_lat = (L == 0) ? (const void*)p.x : (const void*)p.xs; const void* bin_ctx = (L == 0) ? (const void*)p.ctx : (const void*)p.cs;
    bf16_t* bout_lat = (L == 3) ? p.xs3 : p.xs;
    if constexpr (PH == 0) { if (OPT >= 7) { ph_mod_opt(cx, p, lds); for (int i = cx.bid * NTHR + cx.tid; i < 1024; i += cx.nblk * NTHR) p.H[(size_t)NT * 1024 + i] = 0; } else ph_prologue(cx, p, lds); ph_prep_weights(cx, p, lds); }
    if constexpr (PH == 1) {
        if (OPT >= 4 && !PROBE_SPLIT1) ph_prep_moe(cx, p, lds, L);
        if (BFS && L > 0) { ph_normc<false>(cx, p, rows_layer, p.xs, p.xs, p.norm1_g + L * 1024, modl, modprev); return; }
        if (L == 0) ph_norm<false, true, false>(cx, p, lds, rows_layer, xin_lat, xin_ctx, p.norm1_g + L * 1024, modl, 0, 1, modprev, L);
        else ph_norm<true, true, false>(cx, p, lds, rows_layer, xin_lat, xin_ctx, p.norm1_g + L * 1024, modl, 0, 1, modprev, L);
    }
    if constexpr (PH == 2) { if (OPT >= 1) ph_win_mm(cx, p, lds, j); else ph_win(cx, p, lds, j); if (OPT >= 13 && L < 3 && tail_idle(cx, (NT / 256) * 10)) prep_moe_steal(cx, p, lds, L + 1, 2); }
    if constexpr (PH == 3) { if (OPT >= 10) ph_prepBLR_opt(cx, p, j); else ph_prepB(cx, p, j); }
    if constexpr (PH == 4) { if (OPT >= 2) ph_qkvup_mm(cx, p, lds, j, rows_out); else ph_qkvup(cx, p, lds, j, rows_out); if (OPT >= 13 && L < 3 && tail_idle(cx, (rows_out / 256) * 3 + (NT / 256) * 4)) prep_moe_steal(cx, p, lds, L + 1, 1); }
    if constexpr (PH == 5) { if (OPT >= 7) ph_finalize_opt(cx, p, lds, j, rows_out); else ph_finalize(cx, p, j, rows_out); }
    if constexpr (PH == 6) { if (OPT >= 5) ph_attn_mm(cx, p, lds, rows_out == NT); else ph_attn(cx, p, rows_out == NT); }
    if constexpr (PH == 7) { if (OPT < 10) ph_prepLR(cx, p, j); }
    if constexpr (PH == 8) { if (OPT >= 2) ph_wag_mm(cx, p, lds, j); else ph_wag(cx, p, lds, j); if (OPT >= 13 && L < 3 && tail_idle(cx, (NT / 256) * 10)) prep_moe_steal(cx, p, lds, L + 1, 2); }
    if constexpr (PH == 9) { if (OPT >= 9) ph_scan_chunk<0>(cx, p, lds, j); else if (OPT >= 6) ph_scan_opt<0>(cx, p, lds, j); else ph_scan(cx, p, lds, j); }
    if constexpr (PH == 19) ph_scan_chunk<PROBE_SCAN>(cx, p, lds, j);
    if constexpr (PH == 20) ph_prep_moe(cx, p, lds, L);
    if constexpr (PH == 21) ph_win_probe(cx, p, lds, j);
    if constexpr (PH == 10) { if (OPT >= 7) ph_post_opt(cx, p, j, rows_out); else ph_post(cx, p, j, rows_out); }
    if constexpr (PH == 11) { if (BFS) ph_wout_mmB(cx, p, lds, p.H, p.WoutT + (size_t)j * 1024 * 1024, rows_out, bin_lat, bin_ctx, bout_lat, L == 0, modl); else if (OPT >= 1) ph_wout_mm(cx, p, lds, p.H, p.WoutT + (size_t)j * 1024 * 1024, rows_out, xin_lat, xin_ctx, modl); else ph_wout(cx, p, lds, p.H, p.w_out_even + (size_t)j * 1024 * 1024, rows_out, xin_lat, xin_ctx, modl);  if (OPT >= 13 && L < 3 && tail_idle(cx, (rows_out / 256) * 4)) prep_moe_steal(cx, p, lds, L + 1, 3); }
    if constexpr (PH == 12) { if (OPT >= 12) ph_f1b(cx, p, lds, j, !last); else if (OPT >= 3) ph_f1_mm(cx, p, lds, j, !last); else ph_chdft(cx, p, lds, rows_layer); if (OPT >= 13 && !last && tail_idle(cx, 128)) prep_moe_steal(cx, p, lds, L + 1, 3); }
    if constexpr (PH == 13) { if (OPT >= 13 && !last && tail_idle(cx, 128)) { ph_fa(cx, p, lds, !last); prep_moe_steal(cx, p, lds, L + 1, 1); } else if (OPT >= 12) ph_fa(cx, p, lds, !last); else if (BFS) ph_f2_mmB(cx, p, lds, !last, bin_lat, bin_ctx, bout_lat, modl); else if (OPT >= 3) ph_f2_mm(cx, p, lds, !last, xin_lat, xin_ctx, modl); else ph_posdft(cx, p, lds, !last); }
    if constexpr (PH == 14) { if (OPT >= 12) ph_fb(cx, p, lds, !last, p.xs, bout_lat, modl); }
    if constexpr (PH == 14) { if (OPT < 3) ph_wout(cx, p, lds, p.F, p.w_out_fourier + (size_t)j * 1024 * 1024, rows_out, xin_lat, xin_ctx, modl); }
    if constexpr (PH == 15) { if (OPT >= 13) ph_norm2_router_mfma(cx, p, lds, rows_out, p.norm2_g + L * 1024, modl, L, bout_lat); else if (OPT >= 8) ph_norm2_router(cx, p, lds, rows_out, p.norm2_g + L * 1024, modl, L, BFS ? bout_lat : (const bf16_t*)nullptr); else ph_norm<false, true, true>(cx, p, lds, rows_out, p.out, p.ctxs, p.norm2_g + L * 1024, modl, 3, 4, modprev, L); }
    if constexpr (PH == 16) { if (OPT >= 4) ph_moe_up_mm(cx, p, lds, L, rows_out); else ph_moe_up(cx, p, lds, L, rows_out); }
    if constexpr (PH == 17) { if (OPT >= 4) ph_moe_down_mm(cx, p, lds, L, rows_out); else ph_moe_down(cx, p, lds, L, rows_out); }
    if constexpr (PH == 18) { if (BFS) { ph_normc<true>(cx, p, NLAT, p.xs3, nullptr, p.norm1_g, p.mod + (size_t)3 * 17 * 6144, p.mod + (size_t)3 * 17 * 6144); return; } }
    if constexpr (PH == 18) ph_norm<true, false, false>(cx, p, lds, NLAT, p.out, p.ctxs, p.norm1_g, p.mod + (size_t)3 * 17 * 6144, 0, 1, p.mod + (size_t)3 * 17 * 6144, 3);
}

template <int PH>
__global__ void __launch_bounds__(NTHR, 2) k_phase(Params p, int L) {
    extern __shared__ __attribute__((aligned(16))) float shm[];
    run_phase<PH>(p, shm, L, (int)(threadIdx.x >> 6));
}

#if ONE_LAUNCH
constexpr int PARAM_WORDS = (int)(sizeof(Params) / 4);
DI Params load_params(const unsigned* lp) {
    Params q; unsigned* d = (unsigned*)&q;
#pragma unroll
    for (int i = 0; i < PARAM_WORDS; ++i) d[i] = (unsigned)__builtin_amdgcn_readfirstlane((int)lp[i]);
    void** pp = (void**)&q;
#pragma unroll
    for (int i = 0; i < PARAM_WORDS / 2; ++i) pp[i] = (void*)(__attribute__((address_space(1))) void*)pp[i];
    return q;
}
#ifndef PROBE_MASK
#define PROBE_MASK 0u
#endif

#define PHASE(PH, L) do { unsigned long long t0_ = 0; if (PROBE_MASK & (1u << (PH))) t0_ = wall_clock64(); \
    { run_phase<PH>(p, lds, (L), wave_id); } xcd_barrier(bar, wave_id == 0 && lane_id_asm() == 0); \
    if (PROBE_MASK & (1u << (PH))) tacc += wall_clock64() - t0_; } while (0)
__global__ void __launch_bounds__(NTHR, 2) k_mega(Params p) {
    extern __shared__ __attribute__((aligned(16))) float shm[];
    unsigned* lp = (unsigned*)(shm + 4);
    float* lds = shm + 4 + ((PARAM_WORDS + 3) & ~3);
    if (threadIdx.x == 0) { shm[0] = 0.f; shm[1] = 0.f; shm[2] = 0.f; shm[3] = 0.f; }
    if (threadIdx.x < PARAM_WORDS) lp[threadIdx.x] = ((const unsigned*)&p)[threadIdx.x];
    __syncthreads();
    XcdBarrier bar; { const Params q_ = load_params(lp); bar = xcd_barrier_post(q_.bar, (volatile LAS unsigned*)shm); }
    unsigned long long tacc = 0;
    const int wave_id = __builtin_amdgcn_readfirstlane((int)(threadIdx.x >> 6));
    PHASE(0, 0);
#define LAYER_EVEN(L) if (PROBE_SPLIT1) { PHASE(20, L); } PHASE(1, L); PHASE(2, L); if (PROBE_GEMM) { PHASE(21, L); } PHASE(3, L); PHASE(4, L); PHASE(5, L); PHASE(6, L); if (OPT < 10) { PHASE(7, L); } PHASE(8, L); PHASE(9, L); if (PROBE_SCAN) { PHASE(19, L); } PHASE(10, L); PHASE(11, L); PHASE(15, L); PHASE(16, L); PHASE(17, L)
#define LAYER_ODD(L) if (PROBE_SPLIT1) { PHASE(20, L); } PHASE(1, L); PHASE(12, L); PHASE(13, L); if (OPT < 3 || OPT >= 12) { PHASE(14, L); } PHASE(15, L); PHASE(16, L); PHASE(17, L)
    LAYER_EVEN(0); LAYER_ODD(1); LAYER_EVEN(2); LAYER_ODD(3);
    { unsigned long long t0_ = 0; if (PROBE_MASK & (1u << 18)) t0_ = wall_clock64(); run_phase<18>(p, lds, 3, wave_id);
      if (PROBE_MASK & (1u << 18)) { xcd_barrier(bar, wave_id == 0 && lane_id_asm() == 0); tacc += wall_clock64() - t0_; } }
    if (PROBE_MASK != 0u && blockIdx.x == 0 && threadIdx.x == 0) {
        const unsigned long long t1 = wall_clock64(); while (wall_clock64() - t1 < 20ull * tacc) __builtin_amdgcn_s_sleep(8); }
}
#endif

static inline size_t al256(size_t v) { return (v + 255) & ~(size_t)255; }
constexpr size_t LDS_BYTES = 148 * 1024;

template <int PH> static void launch_phase(const Params& p, int L, int grid, hipStream_t s) {
    static bool attr = false;
    if (!attr) { hipFuncSetAttribute((const void*)k_phase<PH>, hipFuncAttributeMaxDynamicSharedMemorySize, (int)LDS_BYTES); attr = true; }
    hipLaunchKernelGGL(k_phase<PH>, dim3(grid), dim3(NTHR), LDS_BYTES, s, p, L);
}

extern "C" void kernel_launch(void* const* d_in, const int* in_sizes, int n_in, void* d_out, int out_size, void* d_ws, size_t ws_size, hipStream_t stream) {
    (void)in_sizes; (void)n_in; (void)out_size;
    Params p{};
    const float** ip = (const float**)&p.x;
    for (int i = 0; i < 36; ++i) ip[i] = (const float*)d_in[i];
    p.out = (float*)d_out;
    char* w = (char*)d_ws; size_t o = 0;
    auto take = [&](size_t bytes) { char* r = w + o; o += al256(bytes); return r; };
    p.bar = (unsigned*)take(XCD_BAR_WORDS * 4);
    p.cnt = (int*)take(72 * 64 * 4);
    const size_t zero_bytes = o;
    p.mod = (float*)take((size_t)4 * 17 * 6144 * 4);
    p.ctxs = (float*)take((size_t)NCTX * 1024 * 4);
    p.dftl = (bf16_t*)take(256);
    p.dftc = (bf16_t*)take(256);
    p.slot = (int*)take((size_t)16 * NT * 4);
    p.tokw = (float*)take((size_t)NT * 2 * 4);
    p.slotw = (float*)take((size_t)16 * NT * 4);
    p.H = (bf16_t*)take((size_t)(NT + 1) * 1024 * 2);
    char* big = w + o;
    p.P = (bf16_t*)take((size_t)NT * PLD * 2);
    char* r1 = w + o;
    p.WAG = (bf16_t*)take((size_t)NT * WLD * 2);
    p.YF = (bf16_t*)take((size_t)NT * 512 * 2);
    p.YB = (bf16_t*)take((size_t)NT * 512 * 2);
    p.LR = (bf16_t*)take((size_t)NT * 384 * 2);
    p.WinT = (bf16_t*)take((size_t)2 * 2560 * 1024 * 2); p.WqT = (bf16_t*)take((size_t)2 * 768 * 256 * 2); p.WkvT = (bf16_t*)take((size_t)2 * 1024 * 256 * 2);
    p.WlrT = (bf16_t*)take((size_t)2 * 2560 * 384 * 2); p.WoutT = (bf16_t*)take((size_t)2 * 1024 * 1024 * 2); p.A1 = (bf16_t*)take((size_t)2 * 2048 * 1024 * 2);
    p.A2 = (bf16_t*)take(256); p.A2c = (bf16_t*)take(256); p.M1 = (bf16_t*)take((size_t)256 * 256 * 2);
    p.WguT = (bf16_t*)take((size_t)2 * 17 * 1024 * 1024 * 2); p.WdT = (bf16_t*)take((size_t)2 * 17 * 1024 * 512 * 2);
    const size_t total = o;
    { size_t q = 0; auto t2 = [&](size_t bytes) { char* r = r1 + q; q += al256(bytes); return r; };
      p.QN = (bf16_t*)t2((size_t)NT * 512 * 2); p.Qraw = (bf16_t*)t2((size_t)NT * 768 * 2); p.KVraw = (bf16_t*)t2((size_t)NT * 1024 * 2);
      p.Kf = (bf16_t*)t2((size_t)NB * 8 * 2304 * 96 * 2); p.Vt = (bf16_t*)t2((size_t)NB * 8 * 64 * 2304 * 2); }
    { size_t q = 0; auto t3 = [&](size_t bytes) { char* r = big + q; q += al256(bytes); return r; };
      p.ACT = (bf16_t*)t3((size_t)3 * NT * 512 * 2); p.Y = (bf16_t*)t3((size_t)3 * NT * 1024 * 2); }
    { size_t q = 0; auto t4 = [&](size_t bytes) { char* r = big + q; q += al256(bytes); return r; };
      p.G = (float*)t4((size_t)NT * 2048 * 4); p.F = (bf16_t*)t4((size_t)NT * 1024 * 2); }
    { size_t q = 0; auto t5 = [&](size_t bytes) { char* r = big + q; q += al256(bytes); return r; };
      p.ZT = (bf16_t*)t5((size_t)16 * 1024 * 4096 * 2); p.ZTC = (bf16_t*)t5((size_t)16 * 1024 * 512 * 2);
      p.YF1 = (bf16_t*)t5((size_t)256 * 16 * 1024 * 16 * 2); p.YF1c = (bf16_t*)t5((size_t)256 * 16 * 1024 * 2 * 2); }
    p.xs = (bf16_t*)d_out; p.cs = (bf16_t*)p.ctxs; p.xs3 = (bf16_t*)(big + (size_t)344 * 1024 * 1024);
    if (total > ws_size) { fprintf(stderr, "workspace too small: need %zu have %zu\n", total, ws_size); return; }
    static int grid = 0;
    if (!grid) { int dev = 0, cus = 0; hipGetDevice(&dev); hipDeviceGetAttribute(&cus, hipDeviceAttributeMultiprocessorCount, dev); grid = cus > 0 ? cus : 256; if (grid > 256) grid = 256; }
    hipMemsetAsync(d_ws, 0, zero_bytes, stream);
#if ONE_LAUNCH
    static bool attr = false;
    if (!attr) { hipFuncSetAttribute((const void*)k_mega, hipFuncAttributeMaxDynamicSharedMemorySize, (int)LDS_BYTES); attr = true; }
    hipLaunchKernelGGL(k_mega, dim3(grid), dim3(NTHR), LDS_BYTES, stream, p);
#else
    launch_phase<0>(p, 0, grid, stream);
    for (int L = 0; L < 4; ++L) {
        launch_phase<1>(p, L, grid, stream);
        if ((L & 1) == 0) {
            launch_phase<2>(p, L, grid, stream); launch_phase<3>(p, L, grid, stream); launch_phase<4>(p, L, grid, stream); launch_phase<5>(p, L, grid, stream);
            launch_phase<6>(p, L, grid, stream); launch_phase<7>(p, L, grid, stream); launch_phase<8>(p, L, grid, stream); launch_phase<9>(p, L, grid, stream);
            launch_phase<10>(p, L, grid, stream); launch_phase<11>(p, L, grid, stream);
        } else {
            launch_phase<12>(p, L, grid, stream); launch_phase<13>(p, L, grid, stream); launch_phase<14>(p, L, grid, stream);
        }
        launch_phase<15>(p, L, grid, stream); launch_phase<16>(p, L, grid, stream); launch_phase<17>(p, L, grid, stream);
    }
    launch_phase<18>(p, 3, grid, stream);
#endif
}
```
